# Optimizing an MI355X kernel written in HIP

```python
import math
import jax, jax.numpy as jnp
from jax import lax
import numpy as np

D_MODEL = 1024
BATCH = 4
SEQ = 4096
DEPTH = 4

MIX_WIDTH = D_MODEL
LRU_WIDTH = D_MODEL // 2
LRU_BLOCKS = 8
LRU_BLOCK = LRU_WIDTH // LRU_BLOCKS
LRU_C = 8.0
GDN_HEAD_DIM = 128
GDN_HEADS = (MIX_WIDTH - LRU_WIDTH) // GDN_HEAD_DIM
GDN_WIDTH = GDN_HEADS * GDN_HEAD_DIM
GDN_CHUNK = 64
CONV_WIDTH = 4
D_FF = 4 * D_MODEL
N_MOD = 6
IN_COLS = 2 * LRU_WIDTH + 4 * GDN_WIDTH + 2 * GDN_HEADS
NORM_EPS = 1e-6

kernel_name = "hymba_rglru_gdn_hybrid"


def rms_norm(x, w):
    xf = x.astype(jnp.float32)
    y = xf * lax.rsqrt(jnp.mean(xf * xf, axis=-1, keepdims=True) + NORM_EPS)
    return (y * w.astype(jnp.float32)).astype(x.dtype)


def causal_depthwise_conv(x, w):
    K = w.shape[0]
    S = x.shape[1]
    xp = jnp.pad(x, ((0, 0), (K - 1, 0), (0, 0)))
    y = xp[:, 0:S] * w[0]
    for k in range(1, K):
        y = y + xp[:, k:k + S] * w[k]
    return y


def rg_lru(x, r_pre, i_pre, lam):
    dt = x.dtype
    xf = x.astype(jnp.float32)
    r = jax.nn.sigmoid(r_pre.astype(jnp.float32))
    i = jax.nn.sigmoid(i_pre.astype(jnp.float32))
    log_a = LRU_C * r * jax.nn.log_sigmoid(lam.astype(jnp.float32))
    a = jnp.exp(log_a)
    mult = jnp.sqrt(jnp.maximum(-jnp.expm1(2.0 * log_a), 1e-12))
    b = mult * (i * xf)

    def combine(left, right):
        a1, b1 = left
        a2, b2 = right
        return a1 * a2, a2 * b1 + b2

    _, h = lax.associative_scan(combine, (a, b), axis=1)
    return h.astype(dt)


def l2_normalize(t):
    return t * lax.rsqrt(jnp.sum(t * t, axis=-1, keepdims=True) + 1e-6)


def gated_delta_rule_chunked(q, k, v, g, beta):
    dt = v.dtype
    B, S, H, Dk = q.shape
    Dv = v.shape[-1]
    C = GDN_CHUNK
    N = S // C
    q = l2_normalize(q.astype(jnp.float32)) * (Dk ** -0.5)
    k = l2_normalize(k.astype(jnp.float32))
    v = v.astype(jnp.float32)

    def chunks(t):
        return t.reshape(B, N, C, H, -1).transpose(0, 3, 1, 2, 4)

    q, k, v = chunks(q), chunks(k), chunks(v)
    g = g.astype(jnp.float32).reshape(B, N, C, H).transpose(0, 3, 1, 2)
    beta = beta.astype(jnp.float32).reshape(B, N, C, H).transpose(0, 3, 1, 2)
    g = jnp.cumsum(g, axis=-1)

    causal = jnp.tril(jnp.ones((C, C), dtype=bool))
    strict = jnp.tril(jnp.ones((C, C), dtype=bool), k=-1)
    decay = jnp.exp(jnp.where(causal, g[..., :, None] - g[..., None, :], -jnp.inf))

    k_beta = k * beta[..., None]
    v_beta = v * beta[..., None]
    Lmat = jnp.where(strict, jnp.einsum('bhnid,bhnjd->bhnij', k_beta, k) * decay, 0.0)
    tmat = Lmat + jnp.eye(C, dtype=jnp.float32)
    u = lax.linalg.triangular_solve(tmat, v_beta, left_side=True, lower=True, unit_diagonal=True)
    w = lax.linalg.triangular_solve(tmat, k_beta * jnp.exp(g)[..., None],
                                    left_side=True, lower=True, unit_diagonal=True)
    attn = jnp.where(causal, jnp.einsum('bhnid,bhnjd->bhnij', q, k) * decay, 0.0)
    q_dec = q * jnp.exp(g)[..., None]
    k_tail = k * jnp.exp(g[..., -1:] - g)[..., None]
    g_last = jnp.exp(g[..., -1])

    def to_front(t):
        return jnp.moveaxis(t, 2, 0)

    xs = (to_front(u), to_front(w), to_front(attn), to_front(q_dec), to_front(k_tail),
          jnp.moveaxis(g_last, 2, 0))

    def step(state, inp):
        u_n, w_n, attn_n, qd_n, kt_n, gl_n = inp
        v_new = u_n - jnp.einsum('bhck,bhkv->bhcv', w_n, state)
        o = jnp.einsum('bhck,bhkv->bhcv', qd_n, state) + jnp.einsum('bhij,bhjv->bhiv', attn_n, v_new)
        state = state * gl_n[..., None, None] + jnp.einsum('bhck,bhcv->bhkv', kt_n, v_new)
        return state, o

    state0 = jnp.zeros((B, H, Dk, Dv), jnp.float32)
    _, o = lax.scan(step, state0, xs)
    o = o.transpose(1, 0, 3, 2, 4).reshape(B, S, H, Dv)
    return o.astype(dt)


def setup_inputs(seed: int = 0) -> dict:
    key = jax.random.key(seed)
    ks = jax.random.split(key, 24)
    f32 = jnp.float32
    L, D = DEPTH, D_MODEL

    def nrm(k, shape, std):
        return jax.random.normal(k, shape, f32) * std

    x = nrm(ks[0], (BATCH, SEQ, D), 1.0)
    c = nrm(ks[1], (BATCH, D), 1.0)
    norm_mix_w = 1.0 + nrm(ks[2], (L, D), 0.02)
    norm_mlp_w = 1.0 + nrm(ks[3], (L, D), 0.02)
    w_mod = nrm(ks[4], (L, D, N_MOD * D), 0.005)
    gate_offset = jnp.array([0.0, 0.0, 1.0, 0.0, 0.0, 1.0], f32)[None, :, None]
    b_mod = (nrm(ks[5], (L, N_MOD, D), 0.02) + gate_offset).reshape(L, N_MOD * D)
    w_in = nrm(ks[6], (L, D, IN_COLS), D ** -0.5)
    lru_conv_w = nrm(ks[7], (L, CONV_WIDTH, LRU_WIDTH), CONV_WIDTH ** -0.5)
    lru_conv_b = nrm(ks[8], (L, LRU_WIDTH), 0.01)
    lru_gate_a_w = nrm(ks[9], (L, LRU_BLOCKS, LRU_BLOCK, LRU_BLOCK), LRU_BLOCK ** -0.5)
    lru_gate_a_b = nrm(ks[10], (L, LRU_WIDTH), 0.01)
    lru_gate_x_w = nrm(ks[11], (L, LRU_BLOCKS, LRU_BLOCK, LRU_BLOCK), LRU_BLOCK ** -0.5)
    lru_gate_x_b = nrm(ks[12], (L, LRU_WIDTH), 0.01)
    u = jax.random.uniform(ks[13], (L, LRU_WIDTH), f32, 0.9, 0.999)
    p = u ** (1.0 / LRU_C)
    lru_lambda = jnp.log(p) - jnp.log1p(-p)
    lru_norm_w = 1.0 + nrm(ks[14], (L, LRU_WIDTH), 0.02)
    gdn_conv_w = nrm(ks[15], (L, CONV_WIDTH, 3 * GDN_WIDTH), CONV_WIDTH ** -0.5)
    gdn_a_log = jnp.log(jax.random.uniform(ks[16], (L, GDN_HEADS), f32, 1.0, 16.0))
    dt0 = jnp.exp(jax.random.uniform(ks[17], (L, GDN_HEADS), f32, math.log(1e-3), math.log(1e-1)))
    gdn_dt_bias = dt0 + jnp.log(-jnp.expm1(-dt0))
    gdn_norm_w = 1.0 + nrm(ks[18], (L, GDN_HEAD_DIM), 0.02)
    w_out = nrm(ks[19], (L, MIX_WIDTH, D), MIX_WIDTH ** -0.5)
    w_up = nrm(ks[20], (L, D, D_FF), D ** -0.5)
    w_down = nrm(ks[21], (L, D_FF, D), D_FF ** -0.5)
    final_norm_w = 1.0 + nrm(ks[22], (D,), 0.02)
    return {
        "x": x, "c": c,
        "norm_mix_w": norm_mix_w, "norm_mlp_w": norm_mlp_w,
        "w_mod": w_mod, "b_mod": b_mod,
        "w_in": w_in,
        "lru_conv_w": lru_conv_w, "lru_conv_b": lru_conv_b,
        "lru_gate_a_w": lru_gate_a_w, "lru_gate_a_b": lru_gate_a_b,
        "lru_gate_x_w": lru_gate_x_w, "lru_gate_x_b": lru_gate_x_b,
        "lru_lambda": lru_lambda, "lru_norm_w": lru_norm_w,
        "gdn_conv_w": gdn_conv_w, "gdn_a_log": gdn_a_log, "gdn_dt_bias": gdn_dt_bias,
        "gdn_norm_w": gdn_norm_w,
        "w_out": w_out, "w_up": w_up, "w_down": w_down,
        "final_norm_w": final_norm_w,
    }


def reference(x, c, norm_mix_w, norm_mlp_w, w_mod, b_mod, w_in,
              lru_conv_w, lru_conv_b, lru_gate_a_w, lru_gate_a_b,
              lru_gate_x_w, lru_gate_x_b, lru_lambda, lru_norm_w,
              gdn_conv_w, gdn_a_log, gdn_dt_bias, gdn_norm_w,
              w_out, w_up, w_down, final_norm_w):
    B, S, D = x.shape
    o_lx = 0
    o_ly = o_lx + LRU_WIDTH
    o_q = o_ly + LRU_WIDTH
    o_v_end = o_q + 3 * GDN_WIDTH
    o_z = o_v_end
    o_beta = o_z + GDN_WIDTH
    o_alpha = o_beta + GDN_HEADS
    c_act = jax.nn.silu(c)

    for l in range(DEPTH):
        mod = c_act @ w_mod[l] + b_mod[l]
        sh1, sc1, g1, sh2, sc2, g2 = jnp.split(mod[:, None, :], N_MOD, axis=-1)

        h = rms_norm(x, norm_mix_w[l]) * (1.0 + sc1) + sh1
        proj = h @ w_in[l]

        x_lru = proj[..., o_lx:o_ly]
        y_lru = proj[..., o_ly:o_q]
        xr = causal_depthwise_conv(x_lru, lru_conv_w[l]) + lru_conv_b[l]
        xb = xr.reshape(B, S, LRU_BLOCKS, LRU_BLOCK)
        r_pre = jnp.einsum('bsgi,gij->bsgj', xb, lru_gate_a_w[l]).reshape(B, S, LRU_WIDTH) + lru_gate_a_b[l]
        i_pre = jnp.einsum('bsgi,gij->bsgj', xb, lru_gate_x_w[l]).reshape(B, S, LRU_WIDTH) + lru_gate_x_b[l]
        h_lru = rg_lru(xr, r_pre, i_pre, lru_lambda[l])
        out_lru = rms_norm(h_lru * jax.nn.gelu(y_lru), lru_norm_w[l])

        qkv = jax.nn.silu(causal_depthwise_conv(proj[..., o_q:o_v_end], gdn_conv_w[l]))
        q, k, v = jnp.split(qkv.reshape(B, S, 3, GDN_HEADS, GDN_HEAD_DIM), 3, axis=2)
        q, k, v = q[:, :, 0], k[:, :, 0], v[:, :, 0]
        z = proj[..., o_z:o_beta].reshape(B, S, GDN_HEADS, GDN_HEAD_DIM)
        beta = jax.nn.sigmoid(proj[..., o_beta:o_alpha].astype(jnp.float32))
        g = -jnp.exp(gdn_a_log[l].astype(jnp.float32)) * jax.nn.softplus(
            proj[..., o_alpha:o_alpha + GDN_HEADS].astype(jnp.float32) + gdn_dt_bias[l].astype(jnp.float32))
        o = gated_delta_rule_chunked(q, k, v, g, beta)
        out_gdn = (rms_norm(o, gdn_norm_w[l]) * jax.nn.silu(z)).reshape(B, S, GDN_WIDTH)

        mix = jnp.concatenate([out_lru, out_gdn], axis=-1) @ w_out[l]
        x = x + g1 * mix

        h = rms_norm(x, norm_mlp_w[l]) * (1.0 + sc2) + sh2
        x = x + g2 * (jnp.square(jax.nn.relu(h @ w_up[l])) @ w_down[l])

    return rms_norm(x, final_norm_w)
```

```cpp
#include <hip/hip_runtime.h>
#include <cstdio>
#include <cstdint>
#include <cmath>
namespace pg8 {
#define PG8_LAS __attribute__((address_space(3)))
typedef unsigned short bf16_t;
typedef short bf16x8 __attribute__((ext_vector_type(8)));
typedef float f32x4 __attribute__((ext_vector_type(4)));
typedef unsigned u32x4 __attribute__((ext_vector_type(4)));
constexpr int BM = 256, BK = 64, HALF = 128, HTB = HALF * BK * 2  , STAGE_BYTES = 8 * HTB, NXCD = 8, WGM = 8;

__host__ __device__ __forceinline__ int lds_byte(int r, int c) { const int st = (r >> 4) * 2 + (c >> 5), rr = r & 15, cc = c & 31, ob = rr * 64 + cc * 2; return st * 1024 + (ob ^ (((ob >> 9) & 1) << 5)); }
__host__ __device__ __forceinline__ void stage_rc(int b, int& R, int& C) { const int st = b / 1024, sb = b % 1024, swz = sb ^ (((sb >> 9) & 1) << 5); R = (st >> 1) * 16 + swz / 64; C = (st & 1) * 32 + (swz % 64) / 2; }
__host__ __device__ __forceinline__ int perm32(int rho) { const int n = rho >> 4, i = rho & 15; return 8 * (i >> 2) + 4 * n + (i & 3); }

struct Unit { int pm, pn; };
struct Gemm { const bf16_t* A; const bf16_t* Bt; int M, N, K; };

struct StaticOrder {
    int nM, nN, nwg, G, c;
    __host__ __device__ void init(int M, int N, int G_, int c_) { nM = M / BM; nN = N / BM; nwg = nM * nN; G = G_; c = c_; }
    __host__ __device__ bool next(int i, Unit& u) const {
        const long L = (long)i * G + c; if (L >= nwg) return false;
        int wgid = (int)L; { const int q = nwg / NXCD, r = nwg % NXCD, xcd = wgid % NXCD, off = wgid / NXCD; wgid = (xcd < r ? xcd * (q + 1) : r * (q + 1) + (xcd - r) * q) + off; }
        const int nig = WGM * nN, gid = wgid / nig, fm = gid * WGM, gsz = (nM - fm) < WGM ? (nM - fm) : WGM;
        u.pm = fm + ((wgid % nig) % gsz); u.pn = (wgid % nig) / gsz; return true;
    }
    __device__ __forceinline__ void a_ready(const Unit&) const {}
    __device__ __forceinline__ void done(const Unit&) const {}
};

__device__ __forceinline__ unsigned cvt_pk_bf16(float lo, float hi) { unsigned r; asm volatile("v_cvt_pk_bf16_f32 %0, %1, %2" : "=v"(r) : "v"(lo), "v"(hi)); return r; }
typedef float f32x2 __attribute__((ext_vector_type(2)));
__device__ __forceinline__ f32x2 gelu_pk(f32x2 v) {
    const f32x2 av = __builtin_elementwise_abs(v), d = av * 0.2316418882f + 1.0f;
    f32x2 t; t.x = __builtin_amdgcn_rcpf(d.x); t.y = __builtin_amdgcn_rcpf(d.y);
    f32x2 q = t * 0.5307027145f + (-0.7265760135f); q = q * t + 0.7107068705f; q = q * t + (-0.142248368f); q = q * t + 0.127414796f; q = q * t;
    const f32x2 s = (v * v) * (-0.72134752044f);
    f32x2 e; e.x = __builtin_amdgcn_exp2f(s.x); e.y = __builtin_amdgcn_exp2f(s.y);
    const f32x2 m = v * (q * e), r = v - m;
    f32x2 o; o.x = v.x < 0.f ? m.x : r.x; o.y = v.y < 0.f ? m.y : r.y; return o;
}

template <int ACT  > struct EpiBf16 {
    static constexpr bool PERM = true, AFTER_DRAIN = false; static_assert(ACT == 0 || ACT == 1 || ACT == 2, "EpiBf16: ACT is 0 (none), 1 (gelu_pk) or 2 (squared relu)");
    bf16_t* O; int ldc; const float* bias; int split_cols; size_t split_stride; float scale0;
    __device__ __forceinline__ void operator()(const f32x4 (&acc)[2][2][4][2], const Unit& u, int wr, int wc, int fr, int fq) const {
        const int row0 = u.pm * BM + wr * 64 + fr; int colt = u.pn * BM; bf16_t* base = O;
        float sc = 1.f; if (split_cols) { const int t = colt / split_cols; base += (size_t)t * split_stride; colt -= t * split_cols; if (t == 0) sc = scale0; }
        const int col0 = colt + wc * 32 + 8 * fq, bcol0 = u.pn * BM + wc * 32 + 8 * fq;
        f32x4 bv[2][2];
#pragma unroll
        for (int bj = 0; bj < 2; ++bj)
#pragma unroll
            for (int n = 0; n < 2; ++n) bv[bj][n] = bias ? *(const f32x4*)(bias + bcol0 + bj * HALF + 4 * n) : (f32x4){0.f, 0.f, 0.f, 0.f};
#pragma unroll
        for (int ai = 0; ai < 2; ++ai)
#pragma unroll
            for (int m = 0; m < 4; ++m) { bf16_t* rowp = base + (size_t)(row0 + ai * HALF + m * 16) * ldc + col0;
#pragma unroll
                for (int bj = 0; bj < 2; ++bj) { f32x4 v0 = acc[ai][bj][m][0] + bv[bj][0], v1 = acc[ai][bj][m][1] + bv[bj][1];
                    if (ACT == 1) { f32x2 a = gelu_pk((f32x2){v0[0], v0[1]}), b = gelu_pk((f32x2){v0[2], v0[3]}), c = gelu_pk((f32x2){v1[0], v1[1]}), d = gelu_pk((f32x2){v1[2], v1[3]});
                        v0 = (f32x4){a.x, a.y, b.x, b.y}; v1 = (f32x4){c.x, c.y, d.x, d.y}; }
                    if (ACT == 2) { _Pragma("unroll") for (int q_ = 0; q_ < 4; ++q_) { const float a_ = fmaxf(v0[q_], 0.f), b_ = fmaxf(v1[q_], 0.f); v0[q_] = a_ * a_; v1[q_] = b_ * b_; } }
                    v0 = v0 * sc; v1 = v1 * sc; u32x4 w; w.x = cvt_pk_bf16(v0[0], v0[1]); w.y = cvt_pk_bf16(v0[2], v0[3]); w.z = cvt_pk_bf16(v1[0], v1[1]); w.w = cvt_pk_bf16(v1[2], v1[3]);
                    *(u32x4*)(rowp + bj * HALF) = w; } }
    }
};


struct EpiResid {
    static constexpr bool PERM = false, AFTER_DRAIN = false;
    const float* base; float* out; const float* gate; int ldc; int gate_stride; int rows_per_batch;
    __device__ __forceinline__ void operator()(const f32x4 (&acc)[2][2][4][2], const Unit& u, int wr, int wc, int fr, int fq) const {
        const int col0 = u.pn * BM + wc * 32 + 4 * fq;
        const float* gp = gate + (size_t)((u.pm * BM) / rows_per_batch) * gate_stride + col0;
        f32x4 gv[2][2];
#pragma unroll
        for (int bj = 0; bj < 2; ++bj)
#pragma unroll
            for (int n = 0; n < 2; ++n) gv[bj][n] = *(const f32x4*)(gp + bj * HALF + n * 16);
#pragma unroll
        for (int ai = 0; ai < 2; ++ai)
#pragma unroll
            for (int m = 0; m < 4; ++m) { const size_t off = (size_t)(u.pm * BM + ai * HALF + wr * 64 + m * 16 + fr) * ldc + col0;
#pragma unroll
                for (int bj = 0; bj < 2; ++bj)
#pragma unroll
                    for (int n = 0; n < 2; ++n) { const f32x4 bs = *(const f32x4*)(base + off + bj * HALF + n * 16);
                        *(f32x4*)(out + off + bj * HALF + n * 16) = bs + gv[bj][n] * acc[ai][bj][m][n]; } }
    }
};


struct EpiMulti {
    static constexpr bool AFTER_DRAIN = false;
    bool PERM; int mode, l;
    __device__ __forceinline__ void operator()(const f32x4 (&acc)[2][2][4][2], const Unit& u, int wr, int wc, int fr, int fq) const;
};

template <class Epi, class Sched, bool ALIGN_EPI = false, bool SP2 = false>
__device__ __forceinline__ void gemm_phase(PG8_LAS unsigned char* lds, const Gemm g, const Sched& S, const Epi& E) {
    int tid_l = threadIdx.x; asm volatile("" : "+v"(tid_l));
    const int tid = tid_l, wid = __builtin_amdgcn_readfirstlane(tid >> 6), lane = tid & 63, wr = wid >> 2, wc = wid & 3, fr = lane & 15, fq = lane >> 4;
    const int K = g.K, nt = K / BK;
    unsigned voffA[2], voffB[2];
#pragma unroll
    for (int i = 0; i < 2; ++i) { int R, C; stage_rc(tid * 16 + i * 8192, R, C); const int Rb = E.PERM ? ((R & ~31) + perm32(R & 31)) : R;
        voffA[i] = (unsigned)(R * K + C) * 2u; voffB[i] = (unsigned)(Rb * K + C) * 2u; }
    const size_t kstep = (size_t)(BK * 2);
    const size_t hstep = (size_t)HALF * K * 2;
    const size_t tstep = 2 * hstep;
    const unsigned ldsw = (unsigned)wid * 1024u;
    const int aoff = lds_byte(wr * 64 + fr, fq * 8), boff = lds_byte(wc * 32 + fr, fq * 8);
#define PG8_SA(b, h) (((b) * 2 + (h)) * HTB)
#define PG8_SB(b, h) ((4 + (b) * 2 + (h)) * HTB)
#define PG8_STAGE(bufoff, gbase, voff) do { _Pragma("unroll") for (int _i = 0; _i < 2; ++_i) \
        __builtin_amdgcn_global_load_lds((const unsigned*)((const char*)(gbase) + (voff)[_i]), (PG8_LAS unsigned*)(lds + (bufoff) + ldsw + _i * 8192), 16, 0, 0); } while (0)
#define PG8_LDA(dst, b, h) do { _Pragma("unroll") for (int m = 0; m < 4; ++m) _Pragma("unroll") for (int k = 0; k < 2; ++k) dst[m][k] = *(const PG8_LAS bf16x8*)(lds + PG8_SA(b, h) + aoff + m * 2048 + k * 1024); } while (0)
#define PG8_LDB(dst, b, h) do { _Pragma("unroll") for (int n = 0; n < 2; ++n) _Pragma("unroll") for (int k = 0; k < 2; ++k) dst[n][k] = *(const PG8_LAS bf16x8*)(lds + PG8_SB(b, h) + boff + n * 2048 + k * 1024); } while (0)
#define PG8_MMA(ai, bj, At, Bt) do { __builtin_amdgcn_s_setprio(1); _Pragma("unroll") for (int m = 0; m < 4; ++m) _Pragma("unroll") for (int n = 0; n < 2; ++n) _Pragma("unroll") for (int k = 0; k < 2; ++k) \
        acc[ai][bj][m][n] = __builtin_amdgcn_mfma_f32_16x16x32_bf16(Bt[n][k], At[m][k], acc[ai][bj][m][n], 0, 0, 0); __builtin_amdgcn_s_setprio(0); } while (0)
#define PG8_WAIT_V(n) asm volatile("s_waitcnt vmcnt(" #n ")" ::: "memory")
#define PG8_WAIT_L(n) asm volatile("s_waitcnt lgkmcnt(" #n ")" ::: "memory")
#define PG8_BAR __builtin_amdgcn_s_barrier()
#define PG8_SCHED __builtin_amdgcn_sched_barrier(0)
    Unit cur, nxt; int ui = 0;
    if (!S.next(0, cur)) return;
    f32x4 acc[2][2][4][2];
#pragma unroll
    for (int a = 0; a < 2; ++a)
#pragma unroll
        for (int b = 0; b < 2; ++b)
#pragma unroll
            for (int m = 0; m < 4; ++m)
#pragma unroll
                for (int n = 0; n < 2; ++n) acc[a][b][m][n] = (f32x4){0.f, 0.f, 0.f, 0.f};
    bf16x8 At[4][2], B0[2][2], B1[2][2];
    const char* cA = (const char*)g.A + (size_t)cur.pm * tstep; const char* cB = (const char*)g.Bt + (size_t)cur.pn * tstep;
    S.a_ready(cur);
    if constexpr (SP2) {
        PG8_STAGE(PG8_SB(0, 0), cB, voffB); PG8_STAGE(PG8_SB(0, 1), cB + hstep, voffB); PG8_STAGE(PG8_SA(0, 0), cA, voffA); PG8_STAGE(PG8_SA(0, 1), cA + hstep, voffA);
        if (wr == 1) PG8_BAR;
        PG8_WAIT_V(2); PG8_BAR;
        PG8_STAGE(PG8_SB(1, 0), cB + kstep, voffB); PG8_STAGE(PG8_SA(1, 0), cA + kstep, voffA); PG8_STAGE(PG8_SB(1, 1), cB + hstep + kstep, voffB);
        PG8_WAIT_V(6); PG8_BAR;
    } else {
        PG8_STAGE(PG8_SB(0, 0), cB, voffB); PG8_STAGE(PG8_SA(0, 0), cA, voffA); PG8_STAGE(PG8_SB(0, 1), cB + hstep, voffB); PG8_STAGE(PG8_SA(0, 1), cA + hstep, voffA);
        if (wr == 1) PG8_BAR;
        PG8_WAIT_V(4); PG8_BAR;
        PG8_STAGE(PG8_SB(1, 0), cB + kstep, voffB); PG8_STAGE(PG8_SA(1, 0), cA + kstep, voffA); PG8_STAGE(PG8_SB(1, 1), cB + hstep + kstep, voffB);
        PG8_WAIT_V(6); PG8_BAR;
    }
    for (;;) {
        const bool has_next = S.next(ui + 1, nxt);
        const char* nA = has_next ? (const char*)g.A + (size_t)nxt.pm * tstep : cA; const char* nB = has_next ? (const char*)g.Bt + (size_t)nxt.pn * tstep : cB;
        for (int t = 0; t < nt; t += 2) {
            const bool last = (t == nt - 2);
            const char* a1 = cA + (size_t)(t + 1) * kstep;
            const char* a2 = last ? nA : cA + (size_t)(t + 2) * kstep; const char* b2 = last ? nB : cB + (size_t)(t + 2) * kstep;
            const char* a3 = a2 + kstep; const char* b3 = b2 + kstep;
            if (last && has_next) S.a_ready(nxt);
            if constexpr (SP2) {
            PG8_LDB(B0, 0, 0); PG8_LDB(B1, 0, 1); PG8_SCHED; PG8_LDA(At, 0, 0); PG8_STAGE(PG8_SA(1, 1), a1 + hstep, voffA);
            PG8_WAIT_V(8); PG8_WAIT_L(0); PG8_BAR; PG8_MMA(0, 0, At, B0); PG8_MMA(0, 1, At, B1); PG8_BAR; PG8_SCHED;
            PG8_LDA(At, 0, 1); PG8_STAGE(PG8_SB(0, 0), b2, voffB); PG8_STAGE(PG8_SB(0, 1), b2 + hstep, voffB); PG8_STAGE(PG8_SA(0, 0), a2, voffA);
            PG8_WAIT_V(8); PG8_WAIT_L(0); PG8_BAR; PG8_MMA(1, 0, At, B0); PG8_MMA(1, 1, At, B1); PG8_BAR; PG8_SCHED;
            PG8_LDB(B0, 1, 0); PG8_LDB(B1, 1, 1); PG8_SCHED; PG8_LDA(At, 1, 0); PG8_STAGE(PG8_SA(0, 1), a2 + hstep, voffA);
            PG8_WAIT_V(8); PG8_WAIT_L(0); PG8_BAR; PG8_MMA(0, 0, At, B0); PG8_MMA(0, 1, At, B1); PG8_BAR; PG8_SCHED;
            PG8_LDA(At, 1, 1); PG8_STAGE(PG8_SB(1, 0), b3, voffB); PG8_STAGE(PG8_SB(1, 1), b3 + hstep, voffB); PG8_STAGE(PG8_SA(1, 0), a3, voffA);
            PG8_WAIT_V(8); PG8_WAIT_L(0); PG8_BAR; PG8_MMA(1, 0, At, B0); PG8_MMA(1, 1, At, B1); PG8_BAR; PG8_SCHED;
            } else {
            PG8_LDB(B0, 0, 0); PG8_SCHED; PG8_LDA(At, 0, 0); PG8_STAGE(PG8_SA(1, 1), a1 + hstep, voffA);
            PG8_WAIT_L(8); PG8_BAR; PG8_WAIT_L(0); PG8_MMA(0, 0, At, B0); PG8_BAR; PG8_SCHED;
            PG8_LDB(B1, 0, 1); PG8_STAGE(PG8_SB(0, 0), b2, voffB);
            PG8_BAR; PG8_WAIT_L(0); PG8_MMA(0, 1, At, B1); PG8_BAR;
            PG8_LDA(At, 0, 1); PG8_STAGE(PG8_SA(0, 0), a2, voffA);
            PG8_BAR; PG8_WAIT_L(0); PG8_MMA(1, 0, At, B0); PG8_BAR; PG8_SCHED;
            PG8_STAGE(PG8_SB(0, 1), b2 + hstep, voffB);
            PG8_WAIT_V(6); PG8_BAR; PG8_MMA(1, 1, At, B1); PG8_BAR;
            PG8_LDB(B0, 1, 0); PG8_SCHED; PG8_LDA(At, 1, 0); PG8_STAGE(PG8_SA(0, 1), a2 + hstep, voffA);
            PG8_WAIT_L(8); PG8_BAR; PG8_WAIT_L(0); PG8_MMA(0, 0, At, B0); PG8_BAR; PG8_SCHED;
            PG8_LDB(B1, 1, 1); PG8_STAGE(PG8_SB(1, 0), b3, voffB);
            PG8_BAR; PG8_WAIT_L(0); PG8_MMA(0, 1, At, B1); PG8_BAR;
            PG8_LDA(At, 1, 1); PG8_STAGE(PG8_SA(1, 0), a3, voffA);
            PG8_BAR; PG8_WAIT_L(0); PG8_MMA(1, 0, At, B0); PG8_BAR; PG8_SCHED;
            PG8_STAGE(PG8_SB(1, 1), b3 + hstep, voffB);
            PG8_WAIT_V(6); PG8_BAR; PG8_MMA(1, 1, At, B1); PG8_BAR;
            }
        }
        if constexpr (ALIGN_EPI) { if (wr == 0) PG8_BAR; }
        if constexpr (!Epi::AFTER_DRAIN) { E(acc, cur, wr, wc, fr, fq); S.done(cur); }
        if (!has_next) break;
#pragma unroll
        for (int a = 0; a < 2; ++a)
#pragma unroll
            for (int b = 0; b < 2; ++b)
#pragma unroll
                for (int m = 0; m < 4; ++m)
#pragma unroll
                    for (int n = 0; n < 2; ++n) acc[a][b][m][n] = (f32x4){0.f, 0.f, 0.f, 0.f};
        cur = nxt; cA = nA; cB = nB; ++ui;
        if constexpr (ALIGN_EPI) { if (wr == 1) PG8_BAR; }
    }
    PG8_WAIT_V(0);
    if constexpr (!ALIGN_EPI) { if (wr == 0) PG8_BAR; }
    PG8_BAR;
    if constexpr (Epi::AFTER_DRAIN) { E.fused(acc, cur, wr, wc, fr, fq, lds, wid, lane); S.done(cur); }
#undef PG8_SA
#undef PG8_SB
#undef PG8_STAGE
#undef PG8_LDA
#undef PG8_LDB
#undef PG8_MMA
#undef PG8_WAIT_V
#undef PG8_WAIT_L
#undef PG8_BAR
#undef PG8_SCHED
}
}
#define GAS __attribute__((address_space(1)))
#define LAS __attribute__((address_space(3)))
typedef unsigned short bf16;
typedef unsigned v4u __attribute__((ext_vector_type(4)));
typedef float f32x4 __attribute__((ext_vector_type(4)));
typedef short bf16x8 __attribute__((ext_vector_type(8)));
typedef GAS unsigned gu32;
typedef GAS unsigned long long gu64;
#define RLX_AGENT __ATOMIC_RELAXED, __HIP_MEMORY_SCOPE_AGENT
#define LDS_WAIT() asm volatile("s_waitcnt lgkmcnt(0)" ::: "memory")
#define VM_WAIT() asm volatile("s_waitcnt vmcnt(0)" ::: "memory")
__device__ __forceinline__ unsigned long long rt() { return __builtin_amdgcn_s_memrealtime(); }
__device__ __forceinline__ unsigned f2bf(float f) { unsigned u = __builtin_bit_cast(unsigned, f); return (u + 0x7fffu + ((u >> 16) & 1u)) >> 16; }
__device__ __forceinline__ unsigned pk2(float lo, float hi) { return f2bf(lo) | (f2bf(hi) << 16); }

#define XB_TMO      128
#define XB_XCNT(j)  (256  + 64 * (j))
#define XB_XSUB(j)  (1280 + 64 * (j))
#define XB_XGEN(j)  (2304 + 64 * (j))
#define XB_TOP      3328
#define XB_TOPGEN   3392
#define XCD_BAR_WORDS 3456
#define XB_SPIN_CAP (1u << 18)

__device__ __forceinline__ unsigned xb_ld(unsigned* p)              { return __hip_atomic_load(p, __ATOMIC_RELAXED, __HIP_MEMORY_SCOPE_AGENT); }
__device__ __forceinline__ unsigned xb_add(unsigned* p, unsigned v) { return __hip_atomic_fetch_add(p, v, __ATOMIC_RELAXED, __HIP_MEMORY_SCOPE_AGENT); }
__device__ __forceinline__ unsigned xb_xcc_id() { return (unsigned)__builtin_amdgcn_s_getreg((3 << 11) | 20) & 0xFu; }
#define XB_SPIN(cond, bar) do { unsigned _sp = 0; while (cond) { __builtin_amdgcn_s_sleep(1); \
    if ((++_sp & 255u) == 0u) { if (xb_ld(&(bar)[XB_TMO])) break; if (_sp > XB_SPIN_CAP) { atomicAdd(&(bar)[XB_TMO], 1u); break; } } } } while (0)

struct XcdBarrier {
    unsigned* bar; unsigned x;
    volatile LAS unsigned* st;
};

__device__ __forceinline__ XcdBarrier xcd_barrier_post(unsigned* bar, volatile LAS unsigned* st) {
    XcdBarrier b; b.bar = bar; b.x = xb_xcc_id(); b.st = st;
    if (threadIdx.x == 0) (void)xb_add(&bar[XB_XCNT(b.x)], 1u);
    return b;
}
__device__ __forceinline__ void xcd_barrier_complete(unsigned* bar, unsigned x, unsigned& nloc, unsigned& nx) {
    const unsigned G = gridDim.x * gridDim.y * gridDim.z;
    unsigned sum, cnt, mine, sp = 0u;
    for (;;) {
        sum = 0u; cnt = 0u; mine = 0u;
#pragma unroll
        for (unsigned j = 0; j < 16; ++j) { const unsigned c = xb_ld(&bar[XB_XCNT(j)]); sum += c; cnt += (c > 0u) ? 1u : 0u; mine = (j == x) ? c : mine; }
        if (sum == G) break;
        __builtin_amdgcn_s_sleep(1);
        if ((++sp & 255u) == 0u) { if (xb_ld(&bar[XB_TMO])) break; if (sp > XB_SPIN_CAP) { atomicAdd(&bar[XB_TMO], 1u); break; } }
    }
    nloc = mine > 0u ? mine : 1u; nx = cnt > 0u ? cnt : 1u;
}

__device__ __forceinline__ void xcd_barrier(const XcdBarrier& b) {
    asm volatile("s_waitcnt vmcnt(0)" ::: "memory");
    __syncthreads();
    if (threadIdx.x == 0) {
        unsigned* bar = b.bar;
        __builtin_amdgcn_s_waitcnt(0);
        unsigned nloc = b.st[0], nx = b.st[1];
        if (nloc == 0u) { xcd_barrier_complete(bar, b.x, nloc, nx); b.st[0] = nloc; b.st[1] = nx; }
        const unsigned old = xb_add(&bar[XB_XSUB(b.x)], 1u);
        const unsigned gen = old / nloc;
        if (old + 1u == (gen + 1u) * nloc) {
            __builtin_amdgcn_fence(__ATOMIC_RELEASE, "agent");
            asm volatile("s_waitcnt vmcnt(0)" ::: "memory");
            const unsigned og = xb_add(&bar[XB_TOP], 1u);
            const unsigned tg = og / nx;
            if (og + 1u == (tg + 1u) * nx) xb_add(&bar[XB_TOPGEN], 1u);
            else XB_SPIN(xb_ld(&bar[XB_TOPGEN]) == tg, bar);
            __builtin_amdgcn_fence(__ATOMIC_ACQUIRE, "agent");
            xb_add(&bar[XB_XGEN(b.x)], 1u);
            asm volatile("s_waitcnt vmcnt(0)" ::: "memory");
        } else {
            XB_SPIN(xb_ld(&bar[XB_XGEN(b.x)]) == gen, bar);
            __builtin_amdgcn_fence(__ATOMIC_ACQUIRE, "agent");
            asm volatile("s_waitcnt vmcnt(0)" ::: "memory");
        }
    }
    __syncthreads();
}

#ifndef PG8_SP2
#define PG8_SP2 true
#endif
#ifndef PG8_ALIGN
#define PG8_ALIGN true
#endif
constexpr int NWAVES = 8;
constexpr int N_STEPS = 38;
#ifndef MK_N_LAUNCHES
#define MK_N_LAUNCHES 38
#endif
#ifndef PH_MASK
#define PH_MASK 0xffff
#endif
constexpr int N_LAUNCHES = MK_N_LAUNCHES;

constexpr int D = 1024, BATCH = 4, SEQ = 4096, DEPTH = 4, M = BATCH * SEQ;
constexpr int LRUW = 512, NGB = 8, GBW = 64, GH = 4, HD = 128, GDNW = 512, CH = 64, NCH = SEQ / CH, FF = 4096;
constexpr int NMODC = 6 * D, INC = 3080, NPROJ = 3072;
constexpr int O_LX = 0, O_LY = 512, O_Q = 1024, O_Z = 2560;
constexpr float EPS = 1e-6f;

constexpr size_t MiB = 1u << 20;
constexpr size_t WS_CTL = 0, CTL_ZERO_BYTES = 1 * MiB;
constexpr size_t WS_MOD = 1 * MiB;
constexpr size_t WS_BG = 2 * MiB;
constexpr size_t WS_AGG = 3 * MiB;
constexpr size_t WS_CARRY = 4 * MiB;
constexpr size_t WS_GL = 5 * MiB;
constexpr size_t WS_W = 8 * MiB;
constexpr size_t LAYER_W = (size_t)12288 * 1024;
constexpr size_t W_OUT_OFF = (size_t)3072 * 1024, W_UP_OFF = (size_t)4096 * 1024, W_DOWN_OFF = (size_t)8192 * 1024;
constexpr size_t WS_H = 104 * MiB;
constexpr size_t WS_MIX = 136 * MiB;
constexpr size_t WS_PROJ = 168 * MiB;
constexpr size_t WS_ACT = 168 * MiB;
constexpr size_t WS_GQD = 264 * MiB, WS_GKT = 280 * MiB;
constexpr size_t WS_GATT = 296 * MiB;
constexpr size_t WS_GO = 312 * MiB;
constexpr size_t WS_LRUP = 344 * MiB;
constexpr size_t WS_END = 376 * MiB;
constexpr int CW_BAR = 4096;

constexpr int RING_OFF = 0, RING_BYTES = 131072;
constexpr int LDSCTL_OFF = RING_BYTES, MISC_OFF = LDSCTL_OFF + 320;
constexpr int LDS_BYTES = 147456;

typedef unsigned v2u __attribute__((ext_vector_type(2)));
#define DI __device__ __forceinline__
DI float bf2f(unsigned b) { return __builtin_bit_cast(float, b << 16); }
DI float bflo(unsigned w) { return __builtin_bit_cast(float, w << 16); }
DI float bfhi(unsigned w) { return __builtin_bit_cast(float, w & 0xffff0000u); }
DI float sigmoidf_(float x) { return 1.f / (1.f + expf(-x)); }
DI float siluf_(float x) { return x / (1.f + expf(-x)); }
DI float gelu_tanh(float x) { const float u = 0.7978845608028654f * (x + 0.044715f * x * x * x); return 0.5f * x * (1.f + tanhf(u)); }
DI float bperm_(int src_lane, float v) { return __builtin_bit_cast(float, __builtin_amdgcn_ds_bpermute(src_lane << 2, __builtin_bit_cast(int, v))); }
DI float wave_sum_(int lane, float v) {
#pragma unroll
    for (int o = 1; o < 64; o <<= 1) v += bperm_(lane ^ o, v);
    return v;
}
DI float half_sum_(int lane, float v) {
#pragma unroll
    for (int o = 1; o < 32; o <<= 1) v += bperm_(lane ^ o, v);
    return v;
}
DI float shfl_up_(int lane, float v, int off) { return bperm_(lane >= off ? lane - off : lane, v); }

struct Args { const float* in[23]; float* out; unsigned char* ws; int ph_lo, ph_hi; };
static_assert(sizeof(Args) == 23 * 8 + 8 + 8 + 8, "Args has no padding");
struct Frame {
    LAS unsigned char* lds;
    volatile LAS unsigned* MISC;
    gu32* ctl;
    int tid, lane, wave;
    int vcu, G;
    const Args* A;
};
#define IN_(k) (F.A->in[k])
#define X_IN IN_(0)
#define C_IN IN_(1)
#define NORM_MIX_W IN_(2)
#define NORM_MLP_W IN_(3)
#define W_MOD IN_(4)
#define B_MOD IN_(5)
#define W_IN IN_(6)
#define LRU_CONV_W IN_(7)
#define LRU_CONV_B IN_(8)
#define GATE_A_W IN_(9)
#define GATE_A_B IN_(10)
#define GATE_X_W IN_(11)
#define GATE_X_B IN_(12)
#define LRU_LAMBDA IN_(13)
#define LRU_NORM_W IN_(14)
#define GDN_CONV_W IN_(15)
#define GDN_A_LOG IN_(16)
#define GDN_DT_BIAS IN_(17)
#define GDN_NORM_W IN_(18)
#define W_OUT IN_(19)
#define W_UP IN_(20)
#define W_DOWN IN_(21)
#define FINAL_NORM_W IN_(22)
#define OUT_ (F.A->out)
#define WSF(off) ((float*)(F.A->ws + (off)))
#define WSH(off) ((bf16*)(F.A->ws + (off)))

DI void p_mod(Frame& F) {
    LAS float* cs = (LAS float*)F.lds;
    LAS float* red = cs + 4096;
    for (int i = F.tid; i < BATCH * D; i += NWAVES * 64) cs[i] = siluf_(C_IN[i]);
    __syncthreads();
    for (int item = blockIdx.x; item < DEPTH * 96; item += gridDim.x) {
        const int l = item / 96, cg = item % 96, col = cg * 64 + F.lane;
        const float* wp = W_MOD + ((size_t)l * D + F.wave * 128) * NMODC + col;
        float a0 = 0.f, a1 = 0.f, a2 = 0.f, a3 = 0.f;
#pragma unroll 8
        for (int kk = 0; kk < 128; ++kk) { const float wv = wp[(size_t)kk * NMODC]; const int k = F.wave * 128 + kk;
            a0 += cs[k] * wv; a1 += cs[1024 + k] * wv; a2 += cs[2048 + k] * wv; a3 += cs[3072 + k] * wv; }
        red[(F.wave * 4 + 0) * 64 + F.lane] = a0; red[(F.wave * 4 + 1) * 64 + F.lane] = a1; red[(F.wave * 4 + 2) * 64 + F.lane] = a2; red[(F.wave * 4 + 3) * 64 + F.lane] = a3;
        __syncthreads();
        if (F.tid < 256) { const int b = F.tid >> 6, ln = F.tid & 63; float s = 0.f;
#pragma unroll
            for (int w = 0; w < 8; ++w) s += red[(w * 4 + b) * 64 + ln];
            const int cc = cg * 64 + ln; WSF(WS_MOD)[((size_t)l * BATCH + b) * NMODC + cc] = s + B_MOD[(size_t)l * NMODC + cc]; }
        __syncthreads();
    }
}

DI void p0_transpose_item(const float* W, int K, int ldw, int N, bf16* WT, LAS float* scr, int item, int lane) {
    const int nblk = N / 32, kb = item / nblk, nb = item % nblk, k0 = 64 * kb, n0 = 32 * nb;
#pragma unroll 8
    for (int i = 0; i < 32; ++i) { const int kk = 2 * i + (lane >> 5); scr[kk * 33 + (lane & 31)] = W[(size_t)(k0 + kk) * ldw + n0 + (lane & 31)]; }
    LDS_WAIT(); asm volatile("" ::: "memory");
    const int c = lane & 7;
#pragma unroll
    for (int j = 0; j < 4; ++j) { const int n = (lane >> 3) + 8 * j; const LAS float* s = scr + (8 * c) * 33 + n;
        v4u o; o.x = pk2(s[0 * 33], s[1 * 33]); o.y = pk2(s[2 * 33], s[3 * 33]); o.z = pk2(s[4 * 33], s[5 * 33]); o.w = pk2(s[6 * 33], s[7 * 33]);
        *(v4u*)(WT + (size_t)(n0 + n) * K + k0 + 8 * c) = o; }
    LDS_WAIT(); asm volatile("" ::: "memory");
}
DI void p0_weights(Frame& F) {
    LAS float* scr = (LAS float*)(F.lds + RING_OFF + F.wave * 16384);
    const int gw = F.vcu * NWAVES + F.wave, NGW = F.G * NWAVES;
    constexpr int I_IN = (D / 64) * (NPROJ / 32), I_OUT = (D / 64) * (D / 32), I_UP = (D / 64) * (FF / 32), I_DN = (FF / 64) * (D / 32);
    constexpr int PER_LAYER = I_IN + I_OUT + I_UP + I_DN;
    for (int it = gw; it < DEPTH * PER_LAYER; it += NGW) {
        const int l = it / PER_LAYER; int r = it % PER_LAYER; bf16* wl = WSH(WS_W) + (size_t)l * LAYER_W;
        if (r < I_IN) { p0_transpose_item(W_IN + (size_t)l * D * INC, D, INC, NPROJ, wl, scr, r, F.lane); continue; } r -= I_IN;
        if (r < I_OUT) { p0_transpose_item(W_OUT + (size_t)l * D * D, D, D, D, wl + W_OUT_OFF, scr, r, F.lane); continue; } r -= I_OUT;
        if (r < I_UP) { p0_transpose_item(W_UP + (size_t)l * D * FF, D, FF, FF, wl + W_UP_OFF, scr, r, F.lane); continue; } r -= I_UP;
        p0_transpose_item(W_DOWN + (size_t)l * FF * D, FF, D, D, wl + W_DOWN_OFF, scr, r, F.lane);
    }
}

template <bool WITH_BG>
DI void p_normmod(Frame& F, int l, const float* xin, const float* normw, int off_sh, int off_sc) {
    LAS float* w8 = (LAS float*)F.lds;
    if (WITH_BG) {
        for (int i = F.tid; i < D * 8; i += NWAVES * 64) w8[i] = W_IN[((size_t)l * D + (i >> 3)) * INC + NPROJ + (i & 7)];
        __syncthreads();
    }
    const int gw = F.vcu * NWAVES + F.wave, NGW = F.G * NWAVES;
    for (int m = gw; m < M; m += NGW) {
        const int b = m >> 12;
        const float* modp = WSF(WS_MOD) + ((size_t)l * BATCH + b) * NMODC;
        f32x4 v[4]; float ss = 0.f;
#pragma unroll
        for (int j = 0; j < 4; ++j) { v[j] = *(const f32x4*)(xin + (size_t)m * D + 4 * F.lane + 256 * j); ss += (v[j].x * v[j].x + v[j].y * v[j].y) + (v[j].z * v[j].z + v[j].w * v[j].w); }
        ss = wave_sum_(F.lane, ss);
        const float rstd = 1.0f / sqrtf(ss * (1.0f / D) + EPS);
        float a0 = 0.f, a1 = 0.f, a2 = 0.f, a3 = 0.f, a4 = 0.f, a5 = 0.f, a6 = 0.f, a7 = 0.f;
#pragma unroll
        for (int j = 0; j < 4; ++j) {
            const int col = 4 * F.lane + 256 * j;
            const f32x4 nw = *(const f32x4*)(normw + (size_t)l * D + col), sc = *(const f32x4*)(modp + off_sc + col), sh = *(const f32x4*)(modp + off_sh + col);
            const f32x4 hv = v[j] * rstd * nw * (sc + 1.0f) + sh;
            v2u o; o.x = pk2(hv.x, hv.y); o.y = pk2(hv.z, hv.w);
            *(v2u*)(WSH(WS_H) + (size_t)m * D + col) = o;
            if (WITH_BG) {
#pragma unroll
                for (int e = 0; e < 4; ++e) { const f32x4 wa = *(const LAS f32x4*)(w8 + (col + e) * 8), wb = *(const LAS f32x4*)(w8 + (col + e) * 8 + 4); const float hh = hv[e];
                    a0 += hh * wa.x; a1 += hh * wa.y; a2 += hh * wa.z; a3 += hh * wa.w; a4 += hh * wb.x; a5 += hh * wb.y; a6 += hh * wb.z; a7 += hh * wb.w; }
            }
        }
        if (WITH_BG) {
            a0 = wave_sum_(F.lane, a0); a1 = wave_sum_(F.lane, a1); a2 = wave_sum_(F.lane, a2); a3 = wave_sum_(F.lane, a3); a4 = wave_sum_(F.lane, a4); a5 = wave_sum_(F.lane, a5); a6 = wave_sum_(F.lane, a6); a7 = wave_sum_(F.lane, a7);
            if (F.lane < 4) {
                const int hh = F.lane;
                const float bpre = hh == 0 ? a0 : hh == 1 ? a1 : hh == 2 ? a2 : a3;
                const float apre = hh == 0 ? a4 : hh == 1 ? a5 : hh == 2 ? a6 : a7;
                const float xx = apre + GDN_DT_BIAS[l * GH + hh];
                const float sp = xx > 20.f ? xx : log1pf(expf(xx));
                WSF(WS_BG)[(size_t)m * 8 + hh] = sigmoidf_(bpre);
                WSF(WS_BG)[(size_t)m * 8 + 4 + hh] = -expf(GDN_A_LOG[l * GH + hh]) * sp;
            }
        }
    }
}

DI void p_prep(Frame& F, int l) {
    LAS float* L = (LAS float*)F.lds;
    const int tid = F.tid, lane = F.lane, wave = F.wave;
    for (int item = blockIdx.x; item < BATCH * NCH; item += gridDim.x) {
        const int b = item / NCH, n = item % NCH, row0 = b * SEQ + n * CH, t0 = n * CH;
        {
            LAS float* xr = L;
            LAS float* Wa = L + 4352;
            LAS float* Wx = Wa + 4096;
            LAS float* sa = Wx + 4096;
            LAS float* sb = sa + 4160;
            for (int g = 0; g < NGB; ++g) {
#pragma unroll
                for (int e = 0; e < 8; ++e) { const int idx = tid + 512 * e, t = idx >> 6, c = idx & 63, cc = g * 64 + c;
                    float acc = LRU_CONV_B[l * LRUW + cc];
#pragma unroll
                    for (int k = 0; k < 4; ++k) { const int tt = t0 + t - 3 + k; if (tt >= 0) acc += LRU_CONV_W[((size_t)l * 4 + k) * LRUW + cc] * bf2f(WSH(WS_PROJ)[(size_t)(b * SEQ + tt) * NPROJ + O_LX + cc]); }
                    xr[t * 68 + c] = acc;
                    Wa[idx] = GATE_A_W[((size_t)(l * NGB + g)) * 4096 + idx]; Wx[idx] = GATE_X_W[((size_t)(l * NGB + g)) * 4096 + idx]; }
                __syncthreads();
                {
                    const int j = tid & 63, tq = tid >> 6, cc = g * 64 + j;
                    float ra[8], ia[8];
#pragma unroll
                    for (int e = 0; e < 8; ++e) { ra[e] = 0.f; ia[e] = 0.f; }
                    for (int i = 0; i < 64; i += 4) {
                        const float wa0 = Wa[(i + 0) * 64 + j], wa1 = Wa[(i + 1) * 64 + j], wa2 = Wa[(i + 2) * 64 + j], wa3 = Wa[(i + 3) * 64 + j];
                        const float wx0 = Wx[(i + 0) * 64 + j], wx1 = Wx[(i + 1) * 64 + j], wx2 = Wx[(i + 2) * 64 + j], wx3 = Wx[(i + 3) * 64 + j];
#pragma unroll
                        for (int e = 0; e < 8; ++e) { const f32x4 xv = *(const LAS f32x4*)(xr + (tq + 8 * e) * 68 + i);
                            ra[e] += xv.x * wa0 + xv.y * wa1 + xv.z * wa2 + xv.w * wa3; ia[e] += xv.x * wx0 + xv.y * wx1 + xv.z * wx2 + xv.w * wx3; }
                    }
                    const float lam = LRU_LAMBDA[l * LRUW + cc];
                    const float logsig = -(fmaxf(-lam, 0.f) + log1pf(expf(-fabsf(lam))));
                    const float ba = GATE_A_B[l * LRUW + cc], bx = GATE_X_B[l * LRUW + cc];
#pragma unroll
                    for (int e = 0; e < 8; ++e) { const int t = tq + 8 * e;
                        const float r = sigmoidf_(ra[e] + ba), ig = sigmoidf_(ia[e] + bx);
                        const float log_a = 8.0f * r * logsig, a = expf(log_a), mult = sqrtf(fmaxf(-expm1f(2.0f * log_a), 1e-12f));
                        sa[t * 65 + j] = a; sb[t * 65 + j] = mult * (ig * xr[t * 68 + j]); }
                }
                __syncthreads();
#pragma unroll 1
                for (int q = 0; q < 8; ++q) { const int c = wave * 8 + q;
                    float A = sa[lane * 65 + c], B = sb[lane * 65 + c];
#pragma unroll
                    for (int off = 1; off < 64; off <<= 1) { const float Ap = shfl_up_(F.lane, A, off), Bp = shfl_up_(F.lane, B, off); if (lane >= off) { B = A * Bp + B; A = A * Ap; } }
                    sa[lane * 65 + c] = A; sb[lane * 65 + c] = B;
                    if (lane == 63) { WSF(WS_AGG)[((size_t)(b * NCH + n)) * LRUW + g * 64 + c] = A; WSF(WS_AGG)[(size_t)BATCH * NCH * LRUW + ((size_t)(b * NCH + n)) * LRUW + g * 64 + c] = B; } }
                __syncthreads();
#pragma unroll
                for (int e = 0; e < 8; ++e) { const int idx = tid + 512 * e, t = idx >> 6, c = idx & 63;
                    WSF(WS_H)[(size_t)(row0 + t) * LRUW + g * 64 + c] = sb[t * 65 + c]; WSF(WS_LRUP)[(size_t)(row0 + t) * LRUW + g * 64 + c] = sa[t * 65 + c]; }
                __syncthreads();
            }
        }
        {
            LAS float* sk = L;
            LAS float* sq = L + 8448;
            LAS float* sv = L + 16896;
            LAS float* sL = L + 25344;
            LAS float* sgc = L + 29696;
            LAS float* sbeta = sgc + 64;
            for (int h = 0; h < GH; ++h) {
                const size_t item4 = (size_t)(b * GH + h) * NCH + n;
#pragma unroll 4
                for (int e = 0; e < 48; ++e) { const int idx = tid + 512 * e, which = idx >> 13, rem = idx & 8191, t = rem >> 7, d = rem & 127, ch = which * GDNW + h * HD + d;
                    float acc = 0.f;
#pragma unroll
                    for (int k = 0; k < 4; ++k) { const int tt = t0 + t - 3 + k; if (tt >= 0) acc += GDN_CONV_W[((size_t)l * 4 + k) * (3 * GDNW) + ch] * bf2f(WSH(WS_PROJ)[(size_t)(b * SEQ + tt) * NPROJ + O_Q + ch]); }
                    const float val = siluf_(acc);
                    LAS float* dst = which == 0 ? sq : which == 1 ? sk : sv;
                    dst[t * 132 + d] = val; }
                if (wave == 0) { float gcv = WSF(WS_BG)[(size_t)(row0 + lane) * 8 + 4 + h];
#pragma unroll
                    for (int off = 1; off < 64; off <<= 1) { const float p = shfl_up_(F.lane, gcv, off); if (lane >= off) gcv += p; }
                    sgc[lane] = gcv; sbeta[lane] = WSF(WS_BG)[(size_t)(row0 + lane) * 8 + h]; }
                __syncthreads();
#pragma unroll 1
                for (int r = wave; r < 128; r += 8) { LAS float* rowp = (r < 64 ? sq + r * 132 : sk + (r - 64) * 132);
                    const float x0 = rowp[lane], x1 = rowp[lane + 64]; const float ss = wave_sum_(F.lane, x0 * x0 + x1 * x1);
                    const float scl = (1.0f / sqrtf(ss + 1e-6f)) * (r < 64 ? 0.08838834764831845f : 1.0f);
                    rowp[lane] = x0 * scl; rowp[lane + 64] = x1 * scl; }
                __syncthreads();
                {
                    float kk[8], qk[8];
#pragma unroll
                    for (int e = 0; e < 8; ++e) { kk[e] = 0.f; qk[e] = 0.f; }
                    const int j = lane;
                    for (int d0 = 0; d0 < 128; d0 += 4) { const f32x4 kj = *(const LAS f32x4*)(sk + j * 132 + d0);
#pragma unroll
                        for (int e = 0; e < 8; ++e) { const int i = wave * 8 + e; const f32x4 ki = *(const LAS f32x4*)(sk + i * 132 + d0), qi = *(const LAS f32x4*)(sq + i * 132 + d0);
                            kk[e] += ki.x * kj.x + ki.y * kj.y + ki.z * kj.z + ki.w * kj.w; qk[e] += qi.x * kj.x + qi.y * kj.y + qi.z * kj.z + qi.w * kj.w; } }
#pragma unroll
                    for (int e = 0; e < 8; ++e) { const int i = wave * 8 + e;
                        const float dec = (j <= i) ? expf(sgc[i] - sgc[j]) : 0.f;
                        sL[i * 68 + j] = (j < i) ? sbeta[i] * kk[e] * dec : 0.f;
                        WSF(WS_GATT)[item4 * 4096 + i * 64 + j] = (j <= i) ? qk[e] * dec : 0.f; }
                }
                __syncthreads();
                {
                    const float glast = sgc[63];
#pragma unroll 4
                    for (int e = 0; e < 16; ++e) { const int idx = tid + 512 * e, t = idx >> 7, d = idx & 127;
                        const float qv = sq[t * 132 + d], kv = sk[t * 132 + d], gct = sgc[t], eg = expf(gct), bt = sbeta[t];
                        WSH(WS_GQD)[item4 * 8192 + idx] = (bf16)f2bf(qv * eg); WSH(WS_GKT)[item4 * 8192 + idx] = (bf16)f2bf(kv * expf(glast - gct));
                        sv[t * 132 + d] *= bt; sq[t * 132 + d] = kv * bt * eg; }
                    if (tid == 0) WSF(WS_GL)[item4] = expf(glast);
                }
                __syncthreads();
                if (tid < 256) { LAS float* arr = (tid < 128 ? sv : sq) + (tid & 127);
#pragma unroll 1
                    for (int i = 1; i < 64; ++i) { float acc = arr[i * 132]; int m = 0;
                        for (; m + 4 <= i; m += 4) { const f32x4 lv = *(const LAS f32x4*)(sL + i * 68 + m);
                            acc -= lv.x * arr[(m + 0) * 132] + lv.y * arr[(m + 1) * 132] + lv.z * arr[(m + 2) * 132] + lv.w * arr[(m + 3) * 132]; }
                        for (; m < i; ++m) acc -= sL[i * 68 + m] * arr[m * 132];
                        arr[i * 132] = acc; } }
                __syncthreads();
#pragma unroll 4
                for (int e = 0; e < 16; ++e) { const int idx = tid + 512 * e, t = idx >> 7, d = idx & 127;
                    WSH(WS_MIX)[item4 * 8192 + idx] = (bf16)f2bf(sv[t * 132 + d]); WSH(WS_MIX + 16 * MiB)[item4 * 8192 + idx] = (bf16)f2bf(sq[t * 132 + d]); }
                __syncthreads();
            }
        }
    }
}

DI void p_scan(Frame& F, int l) {
    LAS float* L = (LAS float*)F.lds;
    const int tid = F.tid, lane = F.lane, wave = F.wave;
    for (int p = blockIdx.x * NWAVES + wave; p < BATCH * LRUW; p += gridDim.x * NWAVES) { const int b = p / LRUW, c = p % LRUW;
        float A = WSF(WS_AGG)[((size_t)(b * NCH + lane)) * LRUW + c], B = WSF(WS_AGG)[(size_t)BATCH * NCH * LRUW + ((size_t)(b * NCH + lane)) * LRUW + c];
#pragma unroll
        for (int off = 1; off < 64; off <<= 1) { const float Ap = shfl_up_(F.lane, A, off), Bp = shfl_up_(F.lane, B, off); if (lane >= off) { B = A * Bp + B; A = A * Ap; } }
        if (lane < 63) WSF(WS_CARRY)[((size_t)(b * NCH + lane + 1)) * LRUW + c] = B; else WSF(WS_CARRY)[((size_t)(b * NCH)) * LRUW + c] = 0.f; }
    LAS float* sw = L;
    LAS float* sqd = L + 8448;
    LAS float* skt = L + 16896;
    LAS float* sat = L + 25344;
    LAS float* su = L + 29696;
    LAS float* svn = su + 512;
    LAS float* sS = svn + 512;
    for (int item = blockIdx.x; item < BATCH * GH * 16; item += gridDim.x) {
        const int bh = item >> 4, dv0 = (item & 15) * 8, b = bh >> 2, h = bh & 3;
        const int t = tid >> 3, j = tid & 7;
        sS[tid] = 0.f; sS[tid + 512] = 0.f;
        __syncthreads();
#pragma unroll 1
        for (int n = 0; n < NCH; ++n) {
            const size_t item4 = (size_t)bh * NCH + n;
#pragma unroll
            for (int e = 0; e < 2; ++e) { const int idx = tid * 8 + 4096 * e, tt = idx >> 7, d = idx & 127;
                const v4u w4 = *(const v4u*)(WSH(WS_MIX + 16 * MiB) + item4 * 8192 + idx), q4 = *(const v4u*)(WSH(WS_GQD) + item4 * 8192 + idx), k4 = *(const v4u*)(WSH(WS_GKT) + item4 * 8192 + idx);
                *(LAS f32x4*)(sw + tt * 132 + d) = (f32x4){bflo(w4.x), bfhi(w4.x), bflo(w4.y), bfhi(w4.y)}; *(LAS f32x4*)(sw + tt * 132 + d + 4) = (f32x4){bflo(w4.z), bfhi(w4.z), bflo(w4.w), bfhi(w4.w)};
                *(LAS f32x4*)(sqd + tt * 132 + d) = (f32x4){bflo(q4.x), bfhi(q4.x), bflo(q4.y), bfhi(q4.y)}; *(LAS f32x4*)(sqd + tt * 132 + d + 4) = (f32x4){bflo(q4.z), bfhi(q4.z), bflo(q4.w), bfhi(q4.w)};
                *(LAS f32x4*)(skt + tt * 132 + d) = (f32x4){bflo(k4.x), bfhi(k4.x), bflo(k4.y), bfhi(k4.y)}; *(LAS f32x4*)(skt + tt * 132 + d + 4) = (f32x4){bflo(k4.z), bfhi(k4.z), bflo(k4.w), bfhi(k4.w)};
                const int ia = tid * 4 + 2048 * e;
                *(LAS f32x4*)(sat + (ia >> 6) * 68 + (ia & 63)) = *(const f32x4*)(WSF(WS_GATT) + item4 * 4096 + ia); }
            su[tid] = bf2f(WSH(WS_MIX)[item4 * 8192 + t * 128 + dv0 + j]);
            const float gl = WSF(WS_GL)[item4];
            __syncthreads();
            float vacc = su[tid], oacc = 0.f;
            for (int k0 = 0; k0 < 128; k0 += 4) { const f32x4 wv = *(const LAS f32x4*)(sw + t * 132 + k0), qv = *(const LAS f32x4*)(sqd + t * 132 + k0);
                const float s0 = sS[(k0 + 0) * 8 + j], s1 = sS[(k0 + 1) * 8 + j], s2 = sS[(k0 + 2) * 8 + j], s3 = sS[(k0 + 3) * 8 + j];
                vacc -= wv.x * s0 + wv.y * s1 + wv.z * s2 + wv.w * s3; oacc += qv.x * s0 + qv.y * s1 + qv.z * s2 + qv.w * s3; }
            svn[tid] = vacc;
            __syncthreads();
            for (int s0 = 0; s0 < 64; s0 += 4) { const f32x4 av = *(const LAS f32x4*)(sat + t * 68 + s0);
                oacc += av.x * svn[(s0 + 0) * 8 + j] + av.y * svn[(s0 + 1) * 8 + j] + av.z * svn[(s0 + 2) * 8 + j] + av.w * svn[(s0 + 3) * 8 + j]; }
            WSF(WS_GO)[(size_t)(b * SEQ + n * CH + t) * GDNW + h * HD + dv0 + j] = oacc;
#pragma unroll
            for (int e = 0; e < 2; ++e) { const int k = t + 64 * e; float acc = gl * sS[k * 8 + j];
                for (int tt = 0; tt < 64; ++tt) acc += skt[tt * 132 + k] * svn[tt * 8 + j];
                sS[k * 8 + j] = acc; }
            __syncthreads();
        }
    }
}

DI void p_post(Frame& F, int l) {
    const int gw = F.vcu * NWAVES + F.wave, NGW = F.G * NWAVES, lane = F.lane;
    for (int m = gw; m < M; m += NGW) {
        const int b = m >> 12, n = (m & (SEQ - 1)) >> 6;
        f32x4 val[2]; float ss = 0.f;
#pragma unroll
        for (int j = 0; j < 2; ++j) { const int c = 4 * lane + 256 * j;
            const f32x4 hl = *(const f32x4*)(WSF(WS_H) + (size_t)m * LRUW + c), p = *(const f32x4*)(WSF(WS_LRUP) + (size_t)m * LRUW + c), cr = *(const f32x4*)(WSF(WS_CARRY) + ((size_t)(b * NCH + n)) * LRUW + c);
            const v2u y2 = *(const v2u*)(WSH(WS_PROJ) + (size_t)m * NPROJ + O_LY + c);
            const f32x4 hh = hl + p * cr;
            val[j] = (f32x4){hh.x * gelu_tanh(bflo(y2.x)), hh.y * gelu_tanh(bfhi(y2.x)), hh.z * gelu_tanh(bflo(y2.y)), hh.w * gelu_tanh(bfhi(y2.y))};
            ss += (val[j].x * val[j].x + val[j].y * val[j].y) + (val[j].z * val[j].z + val[j].w * val[j].w); }
        ss = wave_sum_(F.lane, ss);
        const float rl = 1.0f / sqrtf(ss * (1.0f / LRUW) + EPS);
#pragma unroll
        for (int j = 0; j < 2; ++j) { const int c = 4 * lane + 256 * j; const f32x4 nw = *(const f32x4*)(LRU_NORM_W + (size_t)l * LRUW + c);
            const f32x4 o = val[j] * rl * nw; v2u w; w.x = pk2(o.x, o.y); w.y = pk2(o.z, o.w); *(v2u*)(WSH(WS_MIX) + (size_t)m * D + c) = w; }
#pragma unroll
        for (int j = 0; j < 2; ++j) { const int c = 4 * lane + 256 * j, d = c & (HD - 1);
            const f32x4 o = *(const f32x4*)(WSF(WS_GO) + (size_t)m * GDNW + c);
            const float s2 = half_sum_(F.lane, (o.x * o.x + o.y * o.y) + (o.z * o.z + o.w * o.w));
            const float rg = 1.0f / sqrtf(s2 * (1.0f / HD) + EPS);
            const f32x4 nw = *(const f32x4*)(GDN_NORM_W + (size_t)l * HD + d);
            const v2u z2 = *(const v2u*)(WSH(WS_PROJ) + (size_t)m * NPROJ + O_Z + c);
            const f32x4 r = (f32x4){o.x * rg * nw.x * siluf_(bflo(z2.x)), o.y * rg * nw.y * siluf_(bfhi(z2.x)), o.z * rg * nw.z * siluf_(bflo(z2.y)), o.w * rg * nw.w * siluf_(bfhi(z2.y))};
            v2u w; w.x = pk2(r.x, r.y); w.y = pk2(r.z, r.w); *(v2u*)(WSH(WS_MIX) + (size_t)m * D + LRUW + c) = w; }
    }
}

DI void p_final(Frame& F) {
    const int gw = F.vcu * NWAVES + F.wave, NGW = F.G * NWAVES, lane = F.lane;
    for (int m = gw; m < M; m += NGW) {
        f32x4 v[4]; float ss = 0.f;
#pragma unroll
        for (int j = 0; j < 4; ++j) { v[j] = *(const f32x4*)(OUT_ + (size_t)m * D + 4 * lane + 256 * j); ss += (v[j].x * v[j].x + v[j].y * v[j].y) + (v[j].z * v[j].z + v[j].w * v[j].w); }
        ss = wave_sum_(F.lane, ss);
        const float rstd = 1.0f / sqrtf(ss * (1.0f / D) + EPS);
#pragma unroll
        for (int j = 0; j < 4; ++j) { const int col = 4 * lane + 256 * j; const f32x4 nw = *(const f32x4*)(FINAL_NORM_W + col); *(f32x4*)(OUT_ + (size_t)m * D + col) = v[j] * rstd * nw; }
    }
}

__device__ __forceinline__ void pg8::EpiMulti::operator()(const f32x4 (&acc)[2][2][4][2], const Unit& u, int wr, int wc, int fr, int fq) const {
    const Args* ap = (const Args*)__builtin_amdgcn_kernarg_segment_ptr(); asm volatile("" : "+s"(ap));
    unsigned char* ws = ap->ws;
    if (mode == 0) { EpiBf16<0> e{(bf16_t*)(ws + WS_PROJ), NPROJ, nullptr, 0, 0, 1.f}; e(acc, u, wr, wc, fr, fq); }
    else if (mode == 2) { EpiBf16<2> e{(bf16_t*)(ws + WS_ACT), FF, nullptr, 0, 0, 1.f}; e(acc, u, wr, wc, fr, fq); }
    else { const float* modl = (const float*)(ws + WS_MOD) + (size_t)l * BATCH * NMODC + (mode == 3 ? 2 * D : 5 * D);
        EpiResid r{(mode == 3 && l == 0) ? ap->in[0] : ap->out, ap->out, modl, D, NMODC, SEQ}; r(acc, u, wr, wc, fr, fq); }
}

__global__ void __launch_bounds__(NWAVES * 64, 2) mk_fwd(Args args) {
    extern __shared__ __attribute__((aligned(16))) unsigned char lds[];
    Frame F;
    F.lds = (LAS unsigned char*)lds;
    F.MISC = (volatile LAS unsigned*)(F.lds + MISC_OFF);
    F.tid = threadIdx.x; F.lane = F.tid & 63; F.wave = __builtin_amdgcn_readfirstlane(F.tid >> 6);
    F.G = gridDim.x; { const int bx = blockIdx.x; F.vcu = (F.G % 8 == 0) ? (bx % 8) * (F.G / 8) + bx / 8 : bx; }
    F.A = (const Args*)__builtin_amdgcn_kernarg_segment_ptr();
    F.ctl = (gu32*)(F.A->ws + WS_CTL);
    for (int u = F.tid; u < (LDS_BYTES - LDSCTL_OFF) / 4; u += NWAVES * 64) ((LAS unsigned*)(F.lds + LDSCTL_OFF))[u] = 0u;
    __syncthreads();
    XcdBarrier bar; bar.bar = (unsigned*)(F.ctl + CW_BAR); bar.x = 0; bar.st = nullptr;
    if (N_LAUNCHES == 1) bar = xcd_barrier_post((unsigned*)(F.ctl + CW_BAR), F.MISC + 8);

    const int lo = F.A->ph_lo, hi = F.A->ph_hi;
#pragma unroll 1
    for (int s = lo; s < hi; ++s) {
        { const Args* ap = (const Args*)__builtin_amdgcn_kernarg_segment_ptr(); asm volatile("" : "+s"(ap)); F.A = ap; }
        { int t_ = threadIdx.x; asm volatile("" : "+v"(t_)); F.tid = t_; F.lane = t_ & 63; F.wave = __builtin_amdgcn_readfirstlane(t_ >> 6); }
        if (s == 0) { if (PH_MASK & 1) { p_mod(F); __syncthreads(); p0_weights(F); } }
        else if (s == N_STEPS - 1) { if (PH_MASK & 2) p_final(F); }
        else {
            const int l = (s - 1) / 9, i = (s - 1) % 9;
            bf16* wl = WSH(WS_W) + (size_t)l * LAYER_W;
            const float* modl = WSF(WS_MOD) + (size_t)l * BATCH * NMODC;
            if (!((PH_MASK >> (2 + i)) & 1)) {}
            else if (i == 0) { p_normmod<true>(F, l, l == 0 ? X_IN : OUT_, NORM_MIX_W, 0, D); }
            else if (i == 2) { p_prep(F, l); }
            else if (i == 3) { p_scan(F, l); }
            else if (i == 4) { p_post(F, l); }
            else if (i == 6) { p_normmod<false>(F, l, OUT_, NORM_MLP_W, 3 * D, 4 * D); }
            else {
                pg8::Gemm g; pg8::EpiMulti E; E.l = l;
                if (i == 1) { g = pg8::Gemm{WSH(WS_H), wl, M, NPROJ, D}; E.PERM = true; E.mode = 0; }
                else if (i == 5) { g = pg8::Gemm{WSH(WS_MIX), wl + W_OUT_OFF, M, D, D}; E.PERM = false; E.mode = 3; }
                else if (i == 7) { g = pg8::Gemm{WSH(WS_H), wl + W_UP_OFF, M, FF, D}; E.PERM = true; E.mode = 2; }
                else { g = pg8::Gemm{WSH(WS_ACT), wl + W_DOWN_OFF, M, D, FF}; E.PERM = false; E.mode = 4; }
                pg8::StaticOrder S; S.init(g.M, g.N, F.G, (int)blockIdx.x);
                pg8::gemm_phase<pg8::EpiMulti, pg8::StaticOrder, PG8_ALIGN, PG8_SP2>(F.lds + RING_OFF, g, S, E);
            }
        }
        if (s + 1 < hi) xcd_barrier(bar);
    }
}

extern "C" void kernel_launch(void* const* d_in, const int* in_sizes, int n_in, void* d_out, int out_size, void* d_ws, size_t ws_size, hipStream_t stream) {
    static int grid = 0;
    if (grid == 0) {
        if (n_in != 23 || in_sizes[0] != M * D || out_size != M * D || ws_size < WS_END) { fprintf(stderr, "kernel_launch: unexpected shapes (n_in %d, in0 %d, out %d, ws %zu); nothing launched\n", n_in, n_in > 0 ? in_sizes[0] : -1, out_size, ws_size); grid = -1; return; }
        int dev = 0, cus = 0;
        if (hipGetDevice(&dev) != hipSuccess || hipDeviceGetAttribute(&cus, hipDeviceAttributeMultiprocessorCount, dev) != hipSuccess) { grid = -1; return; }
        if (hipFuncSetAttribute((const void*)mk_fwd, hipFuncAttributeMaxDynamicSharedMemorySize, LDS_BYTES) != hipSuccess) { fprintf(stderr, "kernel_launch: hipFuncSetAttribute failed\n"); grid = -1; return; }
        (void)hipGetLastError();
        grid = cus;
    }
    if (grid < 0) return;
    if (hipMemsetAsync((char*)d_ws + WS_CTL, 0, CTL_ZERO_BYTES, stream) != hipSuccess) return;
    Args a{};
    for (int i = 0; i < 23; ++i) a.in[i] = (const float*)d_in[i];
    a.out = (float*)d_out; a.ws = (unsigned char*)d_ws;
    if (N_LAUNCHES == 1) { a.ph_lo = 0; a.ph_hi = N_STEPS; hipLaunchKernelGGL(mk_fwd, dim3(grid), dim3(NWAVES * 64), LDS_BYTES, stream, a); }
    else for (int s = 0; s < N_STEPS; ++s) { a.ph_lo = s; a.ph_hi = s + 1; hipLaunchKernelGGL(mk_fwd, dim3(grid), dim3(NWAVES * 64), LDS_BYTES, stream, a); }
}
```

```cpp
#include <hip/hip_runtime.h>
#include <cstdio>
#include <cstdint>
#include <cmath>
namespace pg8 {
#define PG8_LAS __attribute__((address_space(3)))
typedef unsigned short bf16_t;
typedef short bf16x8 __attribute__((ext_vector_type(8)));
typedef float f32x4 __attribute__((ext_vector_type(4)));
typedef unsigned u32x4 __attribute__((ext_vector_type(4)));
constexpr int BM = 256, BK = 64, HALF = 128, HTB = HALF * BK * 2  , STAGE_BYTES = 8 * HTB, NXCD = 8, WGM = 8;

__host__ __device__ __forceinline__ int lds_byte(int r, int c) { const int st = (r >> 4) * 2 + (c >> 5), rr = r & 15, cc = c & 31, ob = rr * 64 + cc * 2; return st * 1024 + (ob ^ (((ob >> 9) & 1) << 5)); }
__host__ __device__ __forceinline__ void stage_rc(int b, int& R, int& C) { const int st = b / 1024, sb = b % 1024, swz = sb ^ (((sb >> 9) & 1) << 5); R = (st >> 1) * 16 + swz / 64; C = (st & 1) * 32 + (swz % 64) / 2; }
__host__ __device__ __forceinline__ int perm32(int rho) { const int n = rho >> 4, i = rho & 15; return 8 * (i >> 2) + 4 * n + (i & 3); }

struct Unit { int pm, pn; };
struct Gemm { const bf16_t* A; const bf16_t* Bt; int M, N, K; };

struct StaticOrder {
    int nM, nN, nwg, G, c;
    __host__ __device__ void init(int M, int N, int G_, int c_) { nM = M / BM; nN = N / BM; nwg = nM * nN; G = G_; c = c_; }
    __host__ __device__ bool next(int i, Unit& u) const {
        const long L = (long)i * G + c; if (L >= nwg) return false;
        int wgid = (int)L; { const int q = nwg / NXCD, r = nwg % NXCD, xcd = wgid % NXCD, off = wgid / NXCD; wgid = (xcd < r ? xcd * (q + 1) : r * (q + 1) + (xcd - r) * q) + off; }
        const int nig = WGM * nN, gid = wgid / nig, fm = gid * WGM, gsz = (nM - fm) < WGM ? (nM - fm) : WGM;
        u.pm = fm + ((wgid % nig) % gsz); u.pn = (wgid % nig) / gsz; return true;
    }
    __device__ __forceinline__ void a_ready(const Unit&) const {}
    __device__ __forceinline__ void done(const Unit&) const {}
};

__device__ __forceinline__ unsigned cvt_pk_bf16(float lo, float hi) { unsigned r; asm volatile("v_cvt_pk_bf16_f32 %0, %1, %2" : "=v"(r) : "v"(lo), "v"(hi)); return r; }
typedef float f32x2 __attribute__((ext_vector_type(2)));
__device__ __forceinline__ f32x2 gelu_pk(f32x2 v) {
    const f32x2 av = __builtin_elementwise_abs(v), d = av * 0.2316418882f + 1.0f;
    f32x2 t; t.x = __builtin_amdgcn_rcpf(d.x); t.y = __builtin_amdgcn_rcpf(d.y);
    f32x2 q = t * 0.5307027145f + (-0.7265760135f); q = q * t + 0.7107068705f; q = q * t + (-0.142248368f); q = q * t + 0.127414796f; q = q * t;
    const f32x2 s = (v * v) * (-0.72134752044f);
    f32x2 e; e.x = __builtin_amdgcn_exp2f(s.x); e.y = __builtin_amdgcn_exp2f(s.y);
    const f32x2 m = v * (q * e), r = v - m;
    f32x2 o; o.x = v.x < 0.f ? m.x : r.x; o.y = v.y < 0.f ? m.y : r.y; return o;
}

template <int ACT  > struct EpiBf16 {
    static constexpr bool PERM = true, AFTER_DRAIN = false; static_assert(ACT == 0 || ACT == 1 || ACT == 2, "EpiBf16: ACT is 0 (none), 1 (gelu_pk) or 2 (squared relu)");
    bf16_t* O; int ldc; const float* bias; int split_cols; size_t split_stride; float scale0;
    __device__ __forceinline__ void operator()(const f32x4 (&acc)[2][2][4][2], const Unit& u, int wr, int wc, int fr, int fq) const {
        const int row0 = u.pm * BM + wr * 64 + fr; int colt = u.pn * BM; bf16_t* base = O;
        float sc = 1.f; if (split_cols) { const int t = colt / split_cols; base += (size_t)t * split_stride; colt -= t * split_cols; if (t == 0) sc = scale0; }
        const int col0 = colt + wc * 32 + 8 * fq, bcol0 = u.pn * BM + wc * 32 + 8 * fq;
        f32x4 bv[2][2];
#pragma unroll
        for (int bj = 0; bj < 2; ++bj)
#pragma unroll
            for (int n = 0; n < 2; ++n) bv[bj][n] = bias ? *(const f32x4*)(bias + bcol0 + bj * HALF + 4 * n) : (f32x4){0.f, 0.f, 0.f, 0.f};
#pragma unroll
        for (int ai = 0; ai < 2; ++ai)
#pragma unroll
            for (int m = 0; m < 4; ++m) { bf16_t* rowp = base + (size_t)(row0 + ai * HALF + m * 16) * ldc + col0;
#pragma unroll
                for (int bj = 0; bj < 2; ++bj) { f32x4 v0 = acc[ai][bj][m][0] + bv[bj][0], v1 = acc[ai][bj][m][1] + bv[bj][1];
                    if (ACT == 1) { f32x2 a = gelu_pk((f32x2){v0[0], v0[1]}), b = gelu_pk((f32x2){v0[2], v0[3]}), c = gelu_pk((f32x2){v1[0], v1[1]}), d = gelu_pk((f32x2){v1[2], v1[3]});
                        v0 = (f32x4){a.x, a.y, b.x, b.y}; v1 = (f32x4){c.x, c.y, d.x, d.y}; }
                    if (ACT == 2) { _Pragma("unroll") for (int q_ = 0; q_ < 4; ++q_) { const float a_ = fmaxf(v0[q_], 0.f), b_ = fmaxf(v1[q_], 0.f); v0[q_] = a_ * a_; v1[q_] = b_ * b_; } }
                    v0 = v0 * sc; v1 = v1 * sc; u32x4 w; w.x = cvt_pk_bf16(v0[0], v0[1]); w.y = cvt_pk_bf16(v0[2], v0[3]); w.z = cvt_pk_bf16(v1[0], v1[1]); w.w = cvt_pk_bf16(v1[2], v1[3]);
                    *(u32x4*)(rowp + bj * HALF) = w; } }
    }
};


struct EpiResid {
    static constexpr bool PERM = false, AFTER_DRAIN = false;
    const float* base; float* out; const float* gate; int ldc; int gate_stride; int rows_per_batch;
    __device__ __forceinline__ void operator()(const f32x4 (&acc)[2][2][4][2], const Unit& u, int wr, int wc, int fr, int fq) const {
        const int col0 = u.pn * BM + wc * 32 + 4 * fq;
        const float* gp = gate + (size_t)((u.pm * BM) / rows_per_batch) * gate_stride + col0;
        f32x4 gv[2][2];
#pragma unroll
        for (int bj = 0; bj < 2; ++bj)
#pragma unroll
            for (int n = 0; n < 2; ++n) gv[bj][n] = *(const f32x4*)(gp + bj * HALF + n * 16);
#pragma unroll
        for (int ai = 0; ai < 2; ++ai)
#pragma unroll
            for (int m = 0; m < 4; ++m) { const size_t off = (size_t)(u.pm * BM + ai * HALF + wr * 64 + m * 16 + fr) * ldc + col0;
#pragma unroll
                for (int bj = 0; bj < 2; ++bj)
#pragma unroll
                    for (int n = 0; n < 2; ++n) { const f32x4 bs = *(const f32x4*)(base + off + bj * HALF + n * 16);
                        *(f32x4*)(out + off + bj * HALF + n * 16) = bs + gv[bj][n] * acc[ai][bj][m][n]; } }
    }
};


struct EpiMulti {
    static constexpr bool AFTER_DRAIN = false;
    bool PERM; int mode, l;
    __device__ __forceinline__ void operator()(const f32x4 (&acc)[2][2][4][2], const Unit& u, int wr, int wc, int fr, int fq) const;
};

template <class Epi, class Sched, bool ALIGN_EPI = false, bool SP2 = false>
__device__ __forceinline__ void gemm_phase(PG8_LAS unsigned char* lds, const Gemm g, const Sched& S, const Epi& E) {
    int tid_l = threadIdx.x; asm volatile("" : "+v"(tid_l));
    const int tid = tid_l, wid = __builtin_amdgcn_readfirstlane(tid >> 6), lane = tid & 63, wr = wid >> 2, wc = wid & 3, fr = lane & 15, fq = lane >> 4;
    const int K = g.K, nt = K / BK;
    unsigned voffA[2], voffB[2];
#pragma unroll
    for (int i = 0; i < 2; ++i) { int R, C; stage_rc(tid * 16 + i * 8192, R, C); const int Rb = E.PERM ? ((R & ~31) + perm32(R & 31)) : R;
        voffA[i] = (unsigned)(R * K + C) * 2u; voffB[i] = (unsigned)(Rb * K + C) * 2u; }
    const size_t kstep = (size_t)(BK * 2);
    const size_t hstep = (size_t)HALF * K * 2;
    const size_t tstep = 2 * hstep;
    const unsigned ldsw = (unsigned)wid * 1024u;
    const int aoff = lds_byte(wr * 64 + fr, fq * 8), boff = lds_byte(wc * 32 + fr, fq * 8);
#define PG8_SA(b, h) (((b) * 2 + (h)) * HTB)
#define PG8_SB(b, h) ((4 + (b) * 2 + (h)) * HTB)
#define PG8_STAGE(bufoff, gbase, voff) do { _Pragma("unroll") for (int _i = 0; _i < 2; ++_i) \
        __builtin_amdgcn_global_load_lds((const unsigned*)((const char*)(gbase) + (voff)[_i]), (PG8_LAS unsigned*)(lds + (bufoff) + ldsw + _i * 8192), 16, 0, 0); } while (0)
#define PG8_LDA(dst, b, h) do { _Pragma("unroll") for (int m = 0; m < 4; ++m) _Pragma("unroll") for (int k = 0; k < 2; ++k) dst[m][k] = *(const PG8_LAS bf16x8*)(lds + PG8_SA(b, h) + aoff + m * 2048 + k * 1024); } while (0)
#define PG8_LDB(dst, b, h) do { _Pragma("unroll") for (int n = 0; n < 2; ++n) _Pragma("unroll") for (int k = 0; k < 2; ++k) dst[n][k] = *(const PG8_LAS bf16x8*)(lds + PG8_SB(b, h) + boff + n * 2048 + k * 1024); } while (0)
#define PG8_MMA(ai, bj, At, Bt) do { __builtin_amdgcn_s_setprio(1); _Pragma("unroll") for (int m = 0; m < 4; ++m) _Pragma("unroll") for (int n = 0; n < 2; ++n) _Pragma("unroll") for (int k = 0; k < 2; ++k) \
        acc[ai][bj][m][n] = __builtin_amdgcn_mfma_f32_16x16x32_bf16(Bt[n][k], At[m][k], acc[ai][bj][m][n], 0, 0, 0); __builtin_amdgcn_s_setprio(0); } while (0)
#define PG8_WAIT_V(n) asm volatile("s_waitcnt vmcnt(" #n ")" ::: "memory")
#define PG8_WAIT_L(n) asm volatile("s_waitcnt lgkmcnt(" #n ")" ::: "memory")
#define PG8_BAR __builtin_amdgcn_s_barrier()
#define PG8_SCHED __builtin_amdgcn_sched_barrier(0)
    Unit cur, nxt; int ui = 0;
    if (!S.next(0, cur)) return;
    f32x4 acc[2][2][4][2];
#pragma unroll
    for (int a = 0; a < 2; ++a)
#pragma unroll
        for (int b = 0; b < 2; ++b)
#pragma unroll
            for (int m = 0; m < 4; ++m)
#pragma unroll
                for (int n = 0; n < 2; ++n) acc[a][b][m][n] = (f32x4){0.f, 0.f, 0.f, 0.f};
    bf16x8 At[4][2], B0[2][2], B1[2][2];
    const char* cA = (const char*)g.A + (size_t)cur.pm * tstep; const char* cB = (const char*)g.Bt + (size_t)cur.pn * tstep;
    S.a_ready(cur);
    if constexpr (SP2) {
        PG8_STAGE(PG8_SB(0, 0), cB, voffB); PG8_STAGE(PG8_SB(0, 1), cB + hstep, voffB); PG8_STAGE(PG8_SA(0, 0), cA, voffA); PG8_STAGE(PG8_SA(0, 1), cA + hstep, voffA);
        if (wr == 1) PG8_BAR;
        PG8_WAIT_V(2); PG8_BAR;
        PG8_STAGE(PG8_SB(1, 0), cB + kstep, voffB); PG8_STAGE(PG8_SA(1, 0), cA + kstep, voffA); PG8_STAGE(PG8_SB(1, 1), cB + hstep + kstep, voffB);
        PG8_WAIT_V(6); PG8_BAR;
    } else {
        PG8_STAGE(PG8_SB(0, 0), cB, voffB); PG8_STAGE(PG8_SA(0, 0), cA, voffA); PG8_STAGE(PG8_SB(0, 1), cB + hstep, voffB); PG8_STAGE(PG8_SA(0, 1), cA + hstep, voffA);
        if (wr == 1) PG8_BAR;
        PG8_WAIT_V(4); PG8_BAR;
        PG8_STAGE(PG8_SB(1, 0), cB + kstep, voffB); PG8_STAGE(PG8_SA(1, 0), cA + kstep, voffA); PG8_STAGE(PG8_SB(1, 1), cB + hstep + kstep, voffB);
        PG8_WAIT_V(6); PG8_BAR;
    }
    for (;;) {
        const bool has_next = S.next(ui + 1, nxt);
        const char* nA = has_next ? (const char*)g.A + (size_t)nxt.pm * tstep : cA; const char* nB = has_next ? (const char*)g.Bt + (size_t)nxt.pn * tstep : cB;
        for (int t = 0; t < nt; t += 2) {
            const bool last = (t == nt - 2);
            const char* a1 = cA + (size_t)(t + 1) * kstep;
            const char* a2 = last ? nA : cA + (size_t)(t + 2) * kstep; const char* b2 = last ? nB : cB + (size_t)(t + 2) * kstep;
            const char* a3 = a2 + kstep; const char* b3 = b2 + kstep;
            if (last && has_next) S.a_ready(nxt);
            if constexpr (SP2) {
            PG8_LDB(B0, 0, 0); PG8_LDB(B1, 0, 1); PG8_SCHED; PG8_LDA(At, 0, 0); PG8_STAGE(PG8_SA(1, 1), a1 + hstep, voffA);
            PG8_WAIT_V(8); PG8_WAIT_L(0); PG8_BAR; PG8_MMA(0, 0, At, B0); PG8_MMA(0, 1, At, B1); PG8_BAR; PG8_SCHED;
            PG8_LDA(At, 0, 1); PG8_STAGE(PG8_SB(0, 0), b2, voffB); PG8_STAGE(PG8_SB(0, 1), b2 + hstep, voffB); PG8_STAGE(PG8_SA(0, 0), a2, voffA);
            PG8_WAIT_V(8); PG8_WAIT_L(0); PG8_BAR; PG8_MMA(1, 0, At, B0); PG8_MMA(1, 1, At, B1); PG8_BAR; PG8_SCHED;
            PG8_LDB(B0, 1, 0); PG8_LDB(B1, 1, 1); PG8_SCHED; PG8_LDA(At, 1, 0); PG8_STAGE(PG8_SA(0, 1), a2 + hstep, voffA);
            PG8_WAIT_V(8); PG8_WAIT_L(0); PG8_BAR; PG8_MMA(0, 0, At, B0); PG8_MMA(0, 1, At, B1); PG8_BAR; PG8_SCHED;
            PG8_LDA(At, 1, 1); PG8_STAGE(PG8_SB(1, 0), b3, voffB); PG8_STAGE(PG8_SB(1, 1), b3 + hstep, voffB); PG8_STAGE(PG8_SA(1, 0), a3, voffA);
            PG8_WAIT_V(8); PG8_WAIT_L(0); PG8_BAR; PG8_MMA(1, 0, At, B0); PG8_MMA(1, 1, At, B1); PG8_BAR; PG8_SCHED;
            } else {
            PG8_LDB(B0, 0, 0); PG8_SCHED; PG8_LDA(At, 0, 0); PG8_STAGE(PG8_SA(1, 1), a1 + hstep, voffA);
            PG8_WAIT_L(8); PG8_BAR; PG8_WAIT_L(0); PG8_MMA(0, 0, At, B0); PG8_BAR; PG8_SCHED;
            PG8_LDB(B1, 0, 1); PG8_STAGE(PG8_SB(0, 0), b2, voffB);
            PG8_BAR; PG8_WAIT_L(0); PG8_MMA(0, 1, At, B1); PG8_BAR;
            PG8_LDA(At, 0, 1); PG8_STAGE(PG8_SA(0, 0), a2, voffA);
            PG8_BAR; PG8_WAIT_L(0); PG8_MMA(1, 0, At, B0); PG8_BAR; PG8_SCHED;
            PG8_STAGE(PG8_SB(0, 1), b2 + hstep, voffB);
            PG8_WAIT_V(6); PG8_BAR; PG8_MMA(1, 1, At, B1); PG8_BAR;
            PG8_LDB(B0, 1, 0); PG8_SCHED; PG8_LDA(At, 1, 0); PG8_STAGE(PG8_SA(0, 1), a2 + hstep, voffA);
            PG8_WAIT_L(8); PG8_BAR; PG8_WAIT_L(0); PG8_MMA(0, 0, At, B0); PG8_BAR; PG8_SCHED;
            PG8_LDB(B1, 1, 1); PG8_STAGE(PG8_SB(1, 0), b3, voffB);
            PG8_BAR; PG8_WAIT_L(0); PG8_MMA(0, 1, At, B1); PG8_BAR;
            PG8_LDA(At, 1, 1); PG8_STAGE(PG8_SA(1, 0), a3, voffA);
            PG8_BAR; PG8_WAIT_L(0); PG8_MMA(1, 0, At, B0); PG8_BAR; PG8_SCHED;
            PG8_STAGE(PG8_SB(1, 1), b3 + hstep, voffB);
            PG8_WAIT_V(6); PG8_BAR; PG8_MMA(1, 1, At, B1); PG8_BAR;
            }
        }
        if constexpr (ALIGN_EPI) { if (wr == 0) PG8_BAR; }
        if constexpr (!Epi::AFTER_DRAIN) { E(acc, cur, wr, wc, fr, fq); S.done(cur); }
        if (!has_next) break;
#pragma unroll
        for (int a = 0; a < 2; ++a)
#pragma unroll
            for (int b = 0; b < 2; ++b)
#pragma unroll
                for (int m = 0; m < 4; ++m)
#pragma unroll
                    for (int n = 0; n < 2; ++n) acc[a][b][m][n] = (f32x4){0.f, 0.f, 0.f, 0.f};
        cur = nxt; cA = nA; cB = nB; ++ui;
        if constexpr (ALIGN_EPI) { if (wr == 1) PG8_BAR; }
    }
    PG8_WAIT_V(0);
    if constexpr (!ALIGN_EPI) { if (wr == 0) PG8_BAR; }
    PG8_BAR;
    if constexpr (Epi::AFTER_DRAIN) { E.fused(acc, cur, wr, wc, fr, fq, lds, wid, lane); S.done(cur); }
#undef PG8_SA
#undef PG8_SB
#undef PG8_STAGE
#undef PG8_LDA
#undef PG8_LDB
#undef PG8_MMA
#undef PG8_WAIT_V
#undef PG8_WAIT_L
#undef PG8_BAR
#undef PG8_SCHED
}
}
#define GAS __attribute__((address_space(1)))
#define LAS __attribute__((address_space(3)))
typedef unsigned short bf16;
typedef unsigned v4u __attribute__((ext_vector_type(4)));
typedef float f32x4 __attribute__((ext_vector_type(4)));
typedef short bf16x8 __attribute__((ext_vector_type(8)));
typedef GAS unsigned gu32;
typedef GAS unsigned long long gu64;
#define RLX_AGENT __ATOMIC_RELAXED, __HIP_MEMORY_SCOPE_AGENT
#define LDS_WAIT() asm volatile("s_waitcnt lgkmcnt(0)" ::: "memory")
#define VM_WAIT() asm volatile("s_waitcnt vmcnt(0)" ::: "memory")
__device__ __forceinline__ unsigned long long rt() { return __builtin_amdgcn_s_memrealtime(); }
__device__ __forceinline__ unsigned f2bf(float f) { unsigned u = __builtin_bit_cast(unsigned, f); return (u + 0x7fffu + ((u >> 16) & 1u)) >> 16; }
__device__ __forceinline__ unsigned pk2(float lo, float hi) { return f2bf(lo) | (f2bf(hi) << 16); }

#define XB_TMO      128
#define XB_XCNT(j)  (256  + 64 * (j))
#define XB_XSUB(j)  (1280 + 64 * (j))
#define XB_XGEN(j)  (2304 + 64 * (j))
#define XB_TOP      3328
#define XB_TOPGEN   3392
#define XCD_BAR_WORDS 3456
#define XB_SPIN_CAP (1u << 18)

__device__ __forceinline__ unsigned xb_ld(unsigned* p)              { return __hip_atomic_load(p, __ATOMIC_RELAXED, __HIP_MEMORY_SCOPE_AGENT); }
__device__ __forceinline__ unsigned xb_add(unsigned* p, unsigned v) { return __hip_atomic_fetch_add(p, v, __ATOMIC_RELAXED, __HIP_MEMORY_SCOPE_AGENT); }
__device__ __forceinline__ unsigned xb_xcc_id() { return (unsigned)__builtin_amdgcn_s_getreg((3 << 11) | 20) & 0xFu; }
#define XB_SPIN(cond, bar) do { unsigned _sp = 0; while (cond) { __builtin_amdgcn_s_sleep(1); \
    if ((++_sp & 255u) == 0u) { if (xb_ld(&(bar)[XB_TMO])) break; if (_sp > XB_SPIN_CAP) { atomicAdd(&(bar)[XB_TMO], 1u); break; } } } } while (0)

struct XcdBarrier {
    unsigned* bar; unsigned x;
    volatile LAS unsigned* st;
};

__device__ __forceinline__ XcdBarrier xcd_barrier_post(unsigned* bar, volatile LAS unsigned* st) {
    XcdBarrier b; b.bar = bar; b.x = xb_xcc_id(); b.st = st;
    if (threadIdx.x == 0) (void)xb_add(&bar[XB_XCNT(b.x)], 1u);
    return b;
}
__device__ __forceinline__ void xcd_barrier_complete(unsigned* bar, unsigned x, unsigned& nloc, unsigned& nx) {
    const unsigned G = gridDim.x * gridDim.y * gridDim.z;
    unsigned sum, cnt, mine, sp = 0u;
    for (;;) {
        sum = 0u; cnt = 0u; mine = 0u;
#pragma unroll
        for (unsigned j = 0; j < 16; ++j) { const unsigned c = xb_ld(&bar[XB_XCNT(j)]); sum += c; cnt += (c > 0u) ? 1u : 0u; mine = (j == x) ? c : mine; }
        if (sum == G) break;
        __builtin_amdgcn_s_sleep(1);
        if ((++sp & 255u) == 0u) { if (xb_ld(&bar[XB_TMO])) break; if (sp > XB_SPIN_CAP) { atomicAdd(&bar[XB_TMO], 1u); break; } }
    }
    nloc = mine > 0u ? mine : 1u; nx = cnt > 0u ? cnt : 1u;
}

__device__ __forceinline__ void xcd_barrier(const XcdBarrier& b) {
    asm volatile("s_waitcnt vmcnt(0)" ::: "memory");
    __syncthreads();
    if (threadIdx.x == 0) {
        unsigned* bar = b.bar;
        __builtin_amdgcn_s_waitcnt(0);
        unsigned nloc = b.st[0], nx = b.st[1];
        if (nloc == 0u) { xcd_barrier_complete(bar, b.x, nloc, nx); b.st[0] = nloc; b.st[1] = nx; }
        const unsigned old = xb_add(&bar[XB_XSUB(b.x)], 1u);
        const unsigned gen = old / nloc;
        if (old + 1u == (gen + 1u) * nloc) {
            __builtin_amdgcn_fence(__ATOMIC_RELEASE, "agent");
            asm volatile("s_waitcnt vmcnt(0)" ::: "memory");
            const unsigned og = xb_add(&bar[XB_TOP], 1u);
            const unsigned tg = og / nx;
            if (og + 1u == (tg + 1u) * nx) xb_add(&bar[XB_TOPGEN], 1u);
            else XB_SPIN(xb_ld(&bar[XB_TOPGEN]) == tg, bar);
            __builtin_amdgcn_fence(__ATOMIC_ACQUIRE, "agent");
            xb_add(&bar[XB_XGEN(b.x)], 1u);
            asm volatile("s_waitcnt vmcnt(0)" ::: "memory");
        } else {
            XB_SPIN(xb_ld(&bar[XB_XGEN(b.x)]) == gen, bar);
            __builtin_amdgcn_fence(__ATOMIC_ACQUIRE, "agent");
            asm volatile("s_waitcnt vmcnt(0)" ::: "memory");
        }
    }
    __syncthreads();
}

#ifndef PG8_SP2
#define PG8_SP2 true
#endif
#ifndef PG8_ALIGN
#define PG8_ALIGN true
#endif
constexpr int NWAVES = 8;
constexpr int N_STEPS = 38;
#ifndef MK_N_LAUNCHES
#define MK_N_LAUNCHES 1
#endif
#ifndef PH_MASK
#define PH_MASK 0xffff
#endif
constexpr int N_LAUNCHES = MK_N_LAUNCHES;

constexpr int D = 1024, BATCH = 4, SEQ = 4096, DEPTH = 4, M = BATCH * SEQ;
constexpr int LRUW = 512, NGB = 8, GBW = 64, GH = 4, HD = 128, GDNW = 512, CH = 64, NCH = SEQ / CH, FF = 4096;
constexpr int NMODC = 6 * D, INC = 3080, NPROJ = 3072;
constexpr int O_LX = 0, O_LY = 512, O_Q = 1024, O_Z = 2560;
constexpr float EPS = 1e-6f;

constexpr size_t MiB = 1u << 20;
constexpr size_t WS_CTL = 0, CTL_ZERO_BYTES = 1 * MiB;
constexpr size_t WS_MOD = 1 * MiB;
constexpr size_t WS_BG = 2 * MiB;
constexpr size_t WS_AGG = 3 * MiB;
constexpr size_t WS_CARRY = 4 * MiB;
constexpr size_t WS_GL = 5 * MiB;
constexpr size_t WS_W = 8 * MiB;
constexpr size_t LAYER_W = (size_t)12288 * 1024;
constexpr size_t W_OUT_OFF = (size_t)3072 * 1024, W_UP_OFF = (size_t)4096 * 1024, W_DOWN_OFF = (size_t)8192 * 1024;
constexpr size_t WS_H = 104 * MiB;
constexpr size_t WS_MIX = 136 * MiB;
constexpr size_t WS_PROJ = 168 * MiB;
constexpr size_t WS_ACT = 168 * MiB;
constexpr size_t WS_GQD = 264 * MiB, WS_GKT = 280 * MiB;
constexpr size_t WS_GATT = 296 * MiB;
constexpr size_t WS_GO = 312 * MiB;
constexpr size_t WS_LRUP = 344 * MiB;
constexpr size_t WS_END = 376 * MiB;
constexpr int CW_BAR = 4096;

constexpr int RING_OFF = 0, RING_BYTES = 131072;
constexpr int LDSCTL_OFF = RING_BYTES, MISC_OFF = LDSCTL_OFF + 320;
constexpr int LDS_BYTES = 147456;

typedef unsigned v2u __attribute__((ext_vector_type(2)));
#define DI __device__ __forceinline__
DI float bf2f(unsigned b) { return __builtin_bit_cast(float, b << 16); }
DI float bflo(unsigned w) { return __builtin_bit_cast(float, w << 16); }
DI float bfhi(unsigned w) { return __builtin_bit_cast(float, w & 0xffff0000u); }
DI float sigmoidf_(float x) { return 1.f / (1.f + expf(-x)); }
DI float siluf_(float x) { return x / (1.f + expf(-x)); }
DI float gelu_tanh(float x) { const float u = 0.7978845608028654f * (x + 0.044715f * x * x * x); return 0.5f * x * (1.f + tanhf(u)); }
DI float bperm_(int src_lane, float v) { return __builtin_bit_cast(float, __builtin_amdgcn_ds_bpermute(src_lane << 2, __builtin_bit_cast(int, v))); }
DI float wave_sum_(int lane, float v) {
#pragma unroll
    for (int o = 1; o < 64; o <<= 1) v += bperm_(lane ^ o, v);
    return v;
}
DI float half_sum_(int lane, float v) {
#pragma unroll
    for (int o = 1; o < 32; o <<= 1) v += bperm_(lane ^ o, v);
    return v;
}
DI float shfl_up_(int lane, float v, int off) { return bperm_(lane >= off ? lane - off : lane, v); }

struct Args { const float* in[23]; float* out; unsigned char* ws; int ph_lo, ph_hi; };
static_assert(sizeof(Args) == 23 * 8 + 8 + 8 + 8, "Args has no padding");
struct Frame {
    LAS unsigned char* lds;
    volatile LAS unsigned* MISC;
    gu32* ctl;
    int tid, lane, wave;
    int vcu, G;
    const Args* A;
};
#define IN_(k) (F.A->in[k])
#define X_IN IN_(0)
#define C_IN IN_(1)
#define NORM_MIX_W IN_(2)
#define NORM_MLP_W IN_(3)
#define W_MOD IN_(4)
#define B_MOD IN_(5)
#define W_IN IN_(6)
#define LRU_CONV_W IN_(7)
#define LRU_CONV_B IN_(8)
#define GATE_A_W IN_(9)
#define GATE_A_B IN_(10)
#define GATE_X_W IN_(11)
#define GATE_X_B IN_(12)
#define LRU_LAMBDA IN_(13)
#define LRU_NORM_W IN_(14)
#define GDN_CONV_W IN_(15)
#define GDN_A_LOG IN_(16)
#define GDN_DT_BIAS IN_(17)
#define GDN_NORM_W IN_(18)
#define W_OUT IN_(19)
#define W_UP IN_(20)
#define W_DOWN IN_(21)
#define FINAL_NORM_W IN_(22)
#define OUT_ (F.A->out)
#define WSF(off) ((float*)(F.A->ws + (off)))
#define WSH(off) ((bf16*)(F.A->ws + (off)))

DI void p_mod(Frame& F) {
    LAS float* cs = (LAS float*)F.lds;
    LAS float* red = cs + 4096;
    for (int i = F.tid; i < BATCH * D; i += NWAVES * 64) cs[i] = siluf_(C_IN[i]);
    __syncthreads();
    for (int item = blockIdx.x; item < DEPTH * 96; item += gridDim.x) {
        const int l = item / 96, cg = item % 96, col = cg * 64 + F.lane;
        const float* wp = W_MOD + ((size_t)l * D + F.wave * 128) * NMODC + col;
        float a0 = 0.f, a1 = 0.f, a2 = 0.f, a3 = 0.f;
#pragma unroll 8
        for (int kk = 0; kk < 128; ++kk) { const float wv = wp[(size_t)kk * NMODC]; const int k = F.wave * 128 + kk;
            a0 += cs[k] * wv; a1 += cs[1024 + k] * wv; a2 += cs[2048 + k] * wv; a3 += cs[3072 + k] * wv; }
        red[(F.wave * 4 + 0) * 64 + F.lane] = a0; red[(F.wave * 4 + 1) * 64 + F.lane] = a1; red[(F.wave * 4 + 2) * 64 + F.lane] = a2; red[(F.wave * 4 + 3) * 64 + F.lane] = a3;
        __syncthreads();
        if (F.tid < 256) { const int b = F.tid >> 6, ln = F.tid & 63; float s = 0.f;
#pragma unroll
            for (int w = 0; w < 8; ++w) s += red[(w * 4 + b) * 64 + ln];
            const int cc = cg * 64 + ln; WSF(WS_MOD)[((size_t)l * BATCH + b) * NMODC + cc] = s + B_MOD[(size_t)l * NMODC + cc]; }
        __syncthreads();
    }
}

DI void p0_transpose_item(const float* W, int K, int ldw, int N, bf16* WT, LAS float* scr, int item, int lane) {
    const int nblk = N / 32, kb = item / nblk, nb = item % nblk, k0 = 64 * kb, n0 = 32 * nb;
#pragma unroll 8
    for (int i = 0; i < 32; ++i) { const int kk = 2 * i + (lane >> 5); scr[kk * 33 + (lane & 31)] = W[(size_t)(k0 + kk) * ldw + n0 + (lane & 31)]; }
    LDS_WAIT(); asm volatile("" ::: "memory");
    const int c = lane & 7;
#pragma unroll
    for (int j = 0; j < 4; ++j) { const int n = (lane >> 3) + 8 * j; const LAS float* s = scr + (8 * c) * 33 + n;
        v4u o; o.x = pk2(s[0 * 33], s[1 * 33]); o.y = pk2(s[2 * 33], s[3 * 33]); o.z = pk2(s[4 * 33], s[5 * 33]); o.w = pk2(s[6 * 33], s[7 * 33]);
        *(v4u*)(WT + (size_t)(n0 + n) * K + k0 + 8 * c) = o; }
    LDS_WAIT(); asm volatile("" ::: "memory");
}
DI void p0_weights(Frame& F) {
    LAS float* scr = (LAS float*)(F.lds + RING_OFF + F.wave * 16384);
    const int gw = F.vcu * NWAVES + F.wave, NGW = F.G * NWAVES;
    constexpr int I_IN = (D / 64) * (NPROJ / 32), I_OUT = (D / 64) * (D / 32), I_UP = (D / 64) * (FF / 32), I_DN = (FF / 64) * (D / 32);
    constexpr int PER_LAYER = I_IN + I_OUT + I_UP + I_DN;
    for (int it = gw; it < DEPTH * PER_LAYER; it += NGW) {
        const int l = it / PER_LAYER; int r = it % PER_LAYER; bf16* wl = WSH(WS_W) + (size_t)l * LAYER_W;
        if (r < I_IN) { p0_transpose_item(W_IN + (size_t)l * D * INC, D, INC, NPROJ, wl, scr, r, F.lane); continue; } r -= I_IN;
        if (r < I_OUT) { p0_transpose_item(W_OUT + (size_t)l * D * D, D, D, D, wl + W_OUT_OFF, scr, r, F.lane); continue; } r -= I_OUT;
        if (r < I_UP) { p0_transpose_item(W_UP + (size_t)l * D * FF, D, FF, FF, wl + W_UP_OFF, scr, r, F.lane); continue; } r -= I_UP;
        p0_transpose_item(W_DOWN + (size_t)l * FF * D, FF, D, D, wl + W_DOWN_OFF, scr, r, F.lane);
    }
}

template <bool WITH_BG>
DI void p_normmod(Frame& F, int l, const float* xin, const float* normw, int off_sh, int off_sc) {
    LAS float* w8 = (LAS float*)F.lds;
    if (WITH_BG) {
        for (int i = F.tid; i < D * 8; i += NWAVES * 64) w8[i] = W_IN[((size_t)l * D + (i >> 3)) * INC + NPROJ + (i & 7)];
        __syncthreads();
    }
    const int gw = F.vcu * NWAVES + F.wave, NGW = F.G * NWAVES;
    for (int m = gw; m < M; m += NGW) {
        const int b = m >> 12;
        const float* modp = WSF(WS_MOD) + ((size_t)l * BATCH + b) * NMODC;
        f32x4 v[4]; float ss = 0.f;
#pragma unroll
        for (int j = 0; j < 4; ++j) { v[j] = *(const f32x4*)(xin + (size_t)m * D + 4 * F.lane + 256 * j); ss += (v[j].x * v[j].x + v[j].y * v[j].y) + (v[j].z * v[j].z + v[j].w * v[j].w); }
        ss = wave_sum_(F.lane, ss);
        const float rstd = 1.0f / sqrtf(ss * (1.0f / D) + EPS);
        float a0 = 0.f, a1 = 0.f, a2 = 0.f, a3 = 0.f, a4 = 0.f, a5 = 0.f, a6 = 0.f, a7 = 0.f;
#pragma unroll
        for (int j = 0; j < 4; ++j) {
            const int col = 4 * F.lane + 256 * j;
            const f32x4 nw = *(const f32x4*)(normw + (size_t)l * D + col), sc = *(const f32x4*)(modp + off_sc + col), sh = *(const f32x4*)(modp + off_sh + col);
            const f32x4 hv = v[j] * rstd * nw * (sc + 1.0f) + sh;
            v2u o; o.x = pk2(hv.x, hv.y); o.y = pk2(hv.z, hv.w);
            *(v2u*)(WSH(WS_H) + (size_t)m * D + col) = o;
            if (WITH_BG) {
#pragma unroll
                for (int e = 0; e < 4; ++e) { const f32x4 wa = *(const LAS f32x4*)(w8 + (col + e) * 8), wb = *(const LAS f32x4*)(w8 + (col + e) * 8 + 4); const float hh = hv[e];
                    a0 += hh * wa.x; a1 += hh * wa.y; a2 += hh * wa.z; a3 += hh * wa.w; a4 += hh * wb.x; a5 += hh * wb.y; a6 += hh * wb.z; a7 += hh * wb.w; }
            }
        }
        if (WITH_BG) {
            a0 = wave_sum_(F.lane, a0); a1 = wave_sum_(F.lane, a1); a2 = wave_sum_(F.lane, a2); a3 = wave_sum_(F.lane, a3); a4 = wave_sum_(F.lane, a4); a5 = wave_sum_(F.lane, a5); a6 = wave_sum_(F.lane, a6); a7 = wave_sum_(F.lane, a7);
            if (F.lane < 4) {
                const int hh = F.lane;
                const float bpre = hh == 0 ? a0 : hh == 1 ? a1 : hh == 2 ? a2 : a3;
                const float apre = hh == 0 ? a4 : hh == 1 ? a5 : hh == 2 ? a6 : a7;
                const float xx = apre + GDN_DT_BIAS[l * GH + hh];
                const float sp = xx > 20.f ? xx : log1pf(expf(xx));
                WSF(WS_BG)[(size_t)m * 8 + hh] = sigmoidf_(bpre);
                WSF(WS_BG)[(size_t)m * 8 + 4 + hh] = -expf(GDN_A_LOG[l * GH + hh]) * sp;
            }
        }
    }
}

DI void p_prep(Frame& F, int l) {
    LAS float* L = (LAS float*)F.lds;
    const int tid = F.tid, lane = F.lane, wave = F.wave;
    for (int item = blockIdx.x; item < BATCH * NCH; item += gridDim.x) {
        const int b = item / NCH, n = item % NCH, row0 = b * SEQ + n * CH, t0 = n * CH;
        {
            LAS float* xr = L;
            LAS float* Wa = L + 4352;
            LAS float* Wx = Wa + 4096;
            LAS float* sa = Wx + 4096;
            LAS float* sb = sa + 4160;
            for (int g = 0; g < NGB; ++g) {
#pragma unroll
                for (int e = 0; e < 8; ++e) { const int idx = tid + 512 * e, t = idx >> 6, c = idx & 63, cc = g * 64 + c;
                    float acc = LRU_CONV_B[l * LRUW + cc];
#pragma unroll
                    for (int k = 0; k < 4; ++k) { const int tt = t0 + t - 3 + k; if (tt >= 0) acc += LRU_CONV_W[((size_t)l * 4 + k) * LRUW + cc] * bf2f(WSH(WS_PROJ)[(size_t)(b * SEQ + tt) * NPROJ + O_LX + cc]); }
                    xr[t * 68 + c] = acc;
                    Wa[idx] = GATE_A_W[((size_t)(l * NGB + g)) * 4096 + idx]; Wx[idx] = GATE_X_W[((size_t)(l * NGB + g)) * 4096 + idx]; }
                __syncthreads();
                {
                    const int j = tid & 63, tq = tid >> 6, cc = g * 64 + j;
                    float ra[8], ia[8];
#pragma unroll
                    for (int e = 0; e < 8; ++e) { ra[e] = 0.f; ia[e] = 0.f; }
                    for (int i = 0; i < 64; i += 4) {
                        const float wa0 = Wa[(i + 0) * 64 + j], wa1 = Wa[(i + 1) * 64 + j], wa2 = Wa[(i + 2) * 64 + j], wa3 = Wa[(i + 3) * 64 + j];
                        const float wx0 = Wx[(i + 0) * 64 + j], wx1 = Wx[(i + 1) * 64 + j], wx2 = Wx[(i + 2) * 64 + j], wx3 = Wx[(i + 3) * 64 + j];
#pragma unroll
                        for (int e = 0; e < 8; ++e) { const f32x4 xv = *(const LAS f32x4*)(xr + (tq + 8 * e) * 68 + i);
                            ra[e] += xv.x * wa0 + xv.y * wa1 + xv.z * wa2 + xv.w * wa3; ia[e] += xv.x * wx0 + xv.y * wx1 + xv.z * wx2 + xv.w * wx3; }
                    }
                    const float lam = LRU_LAMBDA[l * LRUW + cc];
                    const float logsig = -(fmaxf(-lam, 0.f) + log1pf(expf(-fabsf(lam))));
                    const float ba = GATE_A_B[l * LRUW + cc], bx = GATE_X_B[l * LRUW + cc];
#pragma unroll
                    for (int e = 0; e < 8; ++e) { const int t = tq + 8 * e;
                        const float r = sigmoidf_(ra[e] + ba), ig = sigmoidf_(ia[e] + bx);
                        const float log_a = 8.0f * r * logsig, a = expf(log_a), mult = sqrtf(fmaxf(-expm1f(2.0f * log_a), 1e-12f));
                        sa[t * 65 + j] = a; sb[t * 65 + j] = mult * (ig * xr[t * 68 + j]); }
                }
                __syncthreads();
#pragma unroll 1
                for (int q = 0; q < 8; ++q) { const int c = wave * 8 + q;
                    float A = sa[lane * 65 + c], B = sb[lane * 65 + c];
#pragma unroll
                    for (int off = 1; off < 64; off <<= 1) { const float Ap = shfl_up_(F.lane, A, off), Bp = shfl_up_(F.lane, B, off); if (lane >= off) { B = A * Bp + B; A = A * Ap; } }
                    sa[lane * 65 + c] = A; sb[lane * 65 + c] = B;
                    if (lane == 63) { WSF(WS_AGG)[((size_t)(b * NCH + n)) * LRUW + g * 64 + c] = A; WSF(WS_AGG)[(size_t)BATCH * NCH * LRUW + ((size_t)(b * NCH + n)) * LRUW + g * 64 + c] = B; } }
                __syncthreads();
#pragma unroll
                for (int e = 0; e < 8; ++e) { const int idx = tid + 512 * e, t = idx >> 6, c = idx & 63;
                    WSF(WS_H)[(size_t)(row0 + t) * LRUW + g * 64 + c] = sb[t * 65 + c]; WSF(WS_LRUP)[(size_t)(row0 + t) * LRUW + g * 64 + c] = sa[t * 65 + c]; }
                __syncthreads();
            }
        }
        {
            LAS float* sk = L;
            LAS float* sq = L + 8448;
            LAS float* sv = L + 16896;
            LAS float* sL = L + 25344;
            LAS float* sgc = L + 29696;
            LAS float* sbeta = sgc + 64;
            for (int h = 0; h < GH; ++h) {
                const size_t item4 = (size_t)(b * GH + h) * NCH + n;
#pragma unroll 4
                for (int e = 0; e < 48; ++e) { const int idx = tid + 512 * e, which = idx >> 13, rem = idx & 8191, t = rem >> 7, d = rem & 127, ch = which * GDNW + h * HD + d;
                    float acc = 0.f;
#pragma unroll
                    for (int k = 0; k < 4; ++k) { const int tt = t0 + t - 3 + k; if (tt >= 0) acc += GDN_CONV_W[((size_t)l * 4 + k) * (3 * GDNW) + ch] * bf2f(WSH(WS_PROJ)[(size_t)(b * SEQ + tt) * NPROJ + O_Q + ch]); }
                    const float val = siluf_(acc);
                    LAS float* dst = which == 0 ? sq : which == 1 ? sk : sv;
                    dst[t * 132 + d] = val; }
                if (wave == 0) { float gcv = WSF(WS_BG)[(size_t)(row0 + lane) * 8 + 4 + h];
#pragma unroll
                    for (int off = 1; off < 64; off <<= 1) { const float p = shfl_up_(F.lane, gcv, off); if (lane >= off) gcv += p; }
                    sgc[lane] = gcv; sbeta[lane] = WSF(WS_BG)[(size_t)(row0 + lane) * 8 + h]; }
                __syncthreads();
#pragma unroll 1
                for (int r = wave; r < 128; r += 8) { LAS float* rowp = (r < 64 ? sq + r * 132 : sk + (r - 64) * 132);
                    const float x0 = rowp[lane], x1 = rowp[lane + 64]; const float ss = wave_sum_(F.lane, x0 * x0 + x1 * x1);
                    const float scl = (1.0f / sqrtf(ss + 1e-6f)) * (r < 64 ? 0.08838834764831845f : 1.0f);
                    rowp[lane] = x0 * scl; rowp[lane + 64] = x1 * scl; }
                __syncthreads();
                {
                    float kk[8], qk[8];
#pragma unroll
                    for (int e = 0; e < 8; ++e) { kk[e] = 0.f; qk[e] = 0.f; }
                    const int j = lane;
                    for (int d0 = 0; d0 < 128; d0 += 4) { const f32x4 kj = *(const LAS f32x4*)(sk + j * 132 + d0);
#pragma unroll
                        for (int e = 0; e < 8; ++e) { const int i = wave * 8 + e; const f32x4 ki = *(const LAS f32x4*)(sk + i * 132 + d0), qi = *(const LAS f32x4*)(sq + i * 132 + d0);
                            kk[e] += ki.x * kj.x + ki.y * kj.y + ki.z * kj.z + ki.w * kj.w; qk[e] += qi.x * kj.x + qi.y * kj.y + qi.z * kj.z + qi.w * kj.w; } }
#pragma unroll
                    for (int e = 0; e < 8; ++e) { const int i = wave * 8 + e;
                        const float dec = (j <= i) ? expf(sgc[i] - sgc[j]) : 0.f;
                        sL[i * 68 + j] = (j < i) ? sbeta[i] * kk[e] * dec : 0.f;
                        WSF(WS_GATT)[item4 * 4096 + i * 64 + j] = (j <= i) ? qk[e] * dec : 0.f; }
                }
                __syncthreads();
                {
                    const float glast = sgc[63];
#pragma unroll 4
                    for (int e = 0; e < 16; ++e) { const int idx = tid + 512 * e, t = idx >> 7, d = idx & 127;
                        const float qv = sq[t * 132 + d], kv = sk[t * 132 + d], gct = sgc[t], eg = expf(gct), bt = sbeta[t];
                        WSH(WS_GQD)[item4 * 8192 + idx] = (bf16)f2bf(qv * eg); WSH(WS_GKT)[item4 * 8192 + idx] = (bf16)f2bf(kv * expf(glast - gct));
                        sv[t * 132 + d] *= bt; sq[t * 132 + d] = kv * bt * eg; }
                    if (tid == 0) WSF(WS_GL)[item4] = expf(glast);
                }
                __syncthreads();
                if (tid < 256) { LAS float* arr = (tid < 128 ? sv : sq) + (tid & 127);
#pragma unroll 1
                    for (int i = 1; i < 64; ++i) { float acc = arr[i * 132]; int m = 0;
                        for (; m + 4 <= i; m += 4) { const f32x4 lv = *(const LAS f32x4*)(sL + i * 68 + m);
                            acc -= lv.x * arr[(m + 0) * 132] + lv.y * arr[(m + 1) * 132] + lv.z * arr[(m + 2) * 132] + lv.w * arr[(m + 3) * 132]; }
                        for (; m < i; ++m) acc -= sL[i * 68 + m] * arr[m * 132];
                        arr[i * 132] = acc; } }
                __syncthreads();
#pragma unroll 4
                for (int e = 0; e < 16; ++e) { const int idx = tid + 512 * e, t = idx >> 7, d = idx & 127;
                    WSH(WS_MIX)[item4 * 8192 + idx] = (bf16)f2bf(sv[t * 132 + d]); WSH(WS_MIX + 16 * MiB)[item4 * 8192 + idx] = (bf16)f2bf(sq[t * 132 + d]); }
                __syncthreads();
            }
        }
    }
}

DI void p_scan(Frame& F, int l) {
    LAS float* L = (LAS float*)F.lds;
    const int tid = F.tid, lane = F.lane, wave = F.wave;
    for (int p = blockIdx.x * NWAVES + wave; p < BATCH * LRUW; p += gridDim.x * NWAVES) { const int b = p / LRUW, c = p % LRUW;
        float A = WSF(WS_AGG)[((size_t)(b * NCH + lane)) * LRUW + c], B = WSF(WS_AGG)[(size_t)BATCH * NCH * LRUW + ((size_t)(b * NCH + lane)) * LRUW + c];
#pragma unroll
        for (int off = 1; off < 64; off <<= 1) { const float Ap = shfl_up_(F.lane, A, off), Bp = shfl_up_(F.lane, B, off); if (lane >= off) { B = A * Bp + B; A = A * Ap; } }
        if (lane < 63) WSF(WS_CARRY)[((size_t)(b * NCH + lane + 1)) * LRUW + c] = B; else WSF(WS_CARRY)[((size_t)(b * NCH)) * LRUW + c] = 0.f; }
    LAS float* sw = L;
    LAS float* sqd = L + 8448;
    LAS float* skt = L + 16896;
    LAS float* sat = L + 25344;
    LAS float* su = L + 29696;
    LAS float* svn = su + 512;
    LAS float* sS = svn + 512;
    for (int item = blockIdx.x; item < BATCH * GH * 16; item += gridDim.x) {
        const int bh = item >> 4, dv0 = (item & 15) * 8, b = bh >> 2, h = bh & 3;
        const int t = tid >> 3, j = tid & 7;
        sS[tid] = 0.f; sS[tid + 512] = 0.f;
        __syncthreads();
#pragma unroll 1
        for (int n = 0; n < NCH; ++n) {
            const size_t item4 = (size_t)bh * NCH + n;
#pragma unroll
            for (int e = 0; e < 2; ++e) { const int idx = tid * 8 + 4096 * e, tt = idx >> 7, d = idx & 127;
                const v4u w4 = *(const v4u*)(WSH(WS_MIX + 16 * MiB) + item4 * 8192 + idx), q4 = *(const v4u*)(WSH(WS_GQD) + item4 * 8192 + idx), k4 = *(const v4u*)(WSH(WS_GKT) + item4 * 8192 + idx);
                *(LAS f32x4*)(sw + tt * 132 + d) = (f32x4){bflo(w4.x), bfhi(w4.x), bflo(w4.y), bfhi(w4.y)}; *(LAS f32x4*)(sw + tt * 132 + d + 4) = (f32x4){bflo(w4.z), bfhi(w4.z), bflo(w4.w), bfhi(w4.w)};
                *(LAS f32x4*)(sqd + tt * 132 + d) = (f32x4){bflo(q4.x), bfhi(q4.x), bflo(q4.y), bfhi(q4.y)}; *(LAS f32x4*)(sqd + tt * 132 + d + 4) = (f32x4){bflo(q4.z), bfhi(q4.z), bflo(q4.w), bfhi(q4.w)};
                *(LAS f32x4*)(skt + tt * 132 + d) = (f32x4){bflo(k4.x), bfhi(k4.x), bflo(k4.y), bfhi(k4.y)}; *(LAS f32x4*)(skt + tt * 132 + d + 4) = (f32x4){bflo(k4.z), bfhi(k4.z), bflo(k4.w), bfhi(k4.w)};
                const int ia = tid * 4 + 2048 * e;
                *(LAS f32x4*)(sat + (ia >> 6) * 68 + (ia & 63)) = *(const f32x4*)(WSF(WS_GATT) + item4 * 4096 + ia); }
            su[tid] = bf2f(WSH(WS_MIX)[item4 * 8192 + t * 128 + dv0 + j]);
            const float gl = WSF(WS_GL)[item4];
            __syncthreads();
            float vacc = su[tid], oacc = 0.f;
            for (int k0 = 0; k0 < 128; k0 += 4) { const f32x4 wv = *(const LAS f32x4*)(sw + t * 132 + k0), qv = *(const LAS f32x4*)(sqd + t * 132 + k0);
                const float s0 = sS[(k0 + 0) * 8 + j], s1 = sS[(k0 + 1) * 8 + j], s2 = sS[(k0 + 2) * 8 + j], s3 = sS[(k0 + 3) * 8 + j];
                vacc -= wv.x * s0 + wv.y * s1 + wv.z * s2 + wv.w * s3; oacc += qv.x * s0 + qv.y * s1 + qv.z * s2 + qv.w * s3; }
            svn[tid] = vacc;
            __syncthreads();
            for (int s0 = 0; s0 < 64; s0 += 4) { const f32x4 av = *(const LAS f32x4*)(sat + t * 68 + s0);
                oacc += av.x * svn[(s0 + 0) * 8 + j] + av.y * svn[(s0 + 1) * 8 + j] + av.z * svn[(s0 + 2) * 8 + j] + av.w * svn[(s0 + 3) * 8 + j]; }
            WSF(WS_GO)[(size_t)(b * SEQ + n * CH + t) * GDNW + h * HD + dv0 + j] = oacc;
#pragma unroll
            for (int e = 0; e < 2; ++e) { const int k = t + 64 * e; float acc = gl * sS[k * 8 + j];
                for (int tt = 0; tt < 64; ++tt) acc += skt[tt * 132 + k] * svn[tt * 8 + j];
                sS[k * 8 + j] = acc; }
            __syncthreads();
        }
    }
}

DI void p_post(Frame& F, int l) {
    const int gw = F.vcu * NWAVES + F.wave, NGW = F.G * NWAVES, lane = F.lane;
    for (int m = gw; m < M; m += NGW) {
        const int b = m >> 12, n = (m & (SEQ - 1)) >> 6;
        f32x4 val[2]; float ss = 0.f;
#pragma unroll
        for (int j = 0; j < 2; ++j) { const int c = 4 * lane + 256 * j;
            const f32x4 hl = *(const f32x4*)(WSF(WS_H) + (size_t)m * LRUW + c), p = *(const f32x4*)(WSF(WS_LRUP) + (size_t)m * LRUW + c), cr = *(const f32x4*)(WSF(WS_CARRY) + ((size_t)(b * NCH + n)) * LRUW + c);
            const v2u y2 = *(const v2u*)(WSH(WS_PROJ) + (size_t)m * NPROJ + O_LY + c);
            const f32x4 hh = hl + p * cr;
            val[j] = (f32x4){hh.x * gelu_tanh(bflo(y2.x)), hh.y * gelu_tanh(bfhi(y2.x)), hh.z * gelu_tanh(bflo(y2.y)), hh.w * gelu_tanh(bfhi(y2.y))};
            ss += (val[j].x * val[j].x + val[j].y * val[j].y) + (val[j].z * val[j].z + val[j].w * val[j].w); }
        ss = wave_sum_(F.lane, ss);
        const float rl = 1.0f / sqrtf(ss * (1.0f / LRUW) + EPS);
#pragma unroll
        for (int j = 0; j < 2; ++j) { const int c = 4 * lane + 256 * j; const f32x4 nw = *(const f32x4*)(LRU_NORM_W + (size_t)l * LRUW + c);
            const f32x4 o = val[j] * rl * nw; v2u w; w.x = pk2(o.x, o.y); w.y = pk2(o.z, o.w); *(v2u*)(WSH(WS_MIX) + (size_t)m * D + c) = w; }
#pragma unroll
        for (int j = 0; j < 2; ++j) { const int c = 4 * lane + 256 * j, d = c & (HD - 1);
            const f32x4 o = *(const f32x4*)(WSF(WS_GO) + (size_t)m * GDNW + c);
            const float s2 = half_sum_(F.lane, (o.x * o.x + o.y * o.y) + (o.z * o.z + o.w * o.w));
            const float rg = 1.0f / sqrtf(s2 * (1.0f / HD) + EPS);
            const f32x4 nw = *(const f32x4*)(GDN_NORM_W + (size_t)l * HD + d);
            const v2u z2 = *(const v2u*)(WSH(WS_PROJ) + (size_t)m * NPROJ + O_Z + c);
            const f32x4 r = (f32x4){o.x * rg * nw.x * siluf_(bflo(z2.x)), o.y * rg * nw.y * siluf_(bfhi(z2.x)), o.z * rg * nw.z * siluf_(bflo(z2.y)), o.w * rg * nw.w * siluf_(bfhi(z2.y))};
            v2u w; w.x = pk2(r.x, r.y); w.y = pk2(r.z, r.w); *(v2u*)(WSH(WS_MIX) + (size_t)m * D + LRUW + c) = w; }
    }
}

DI void p_final(Frame& F) {
    const int gw = F.vcu * NWAVES + F.wave, NGW = F.G * NWAVES, lane = F.lane;
    for (int m = gw; m < M; m += NGW) {
        f32x4 v[4]; float ss = 0.f;
#pragma unroll
        for (int j = 0; j < 4; ++j) { v[j] = *(const f32x4*)(OUT_ + (size_t)m * D + 4 * lane + 256 * j); ss += (v[j].x * v[j].x + v[j].y * v[j].y) + (v[j].z * v[j].z + v[j].w * v[j].w); }
        ss = wave_sum_(F.lane, ss);
        const float rstd = 1.0f / sqrtf(ss * (1.0f / D) + EPS);
#pragma unroll
        for (int j = 0; j < 4; ++j) { const int col = 4 * lane + 256 * j; const f32x4 nw = *(const f32x4*)(FINAL_NORM_W + col); *(f32x4*)(OUT_ + (size_t)m * D + col) = v[j] * rstd * nw; }
    }
}

__device__ __forceinline__ void pg8::EpiMulti::operator()(const f32x4 (&acc)[2][2][4][2], const Unit& u, int wr, int wc, int fr, int fq) const {
    const Args* ap = (const Args*)__builtin_amdgcn_kernarg_segment_ptr(); asm volatile("" : "+s"(ap));
    unsigned char* ws = ap->ws;
    if (mode == 0) { EpiBf16<0> e{(bf16_t*)(ws + WS_PROJ), NPROJ, nullptr, 0, 0, 1.f}; e(acc, u, wr, wc, fr, fq); }
    else if (mode == 2) { EpiBf16<2> e{(bf16_t*)(ws + WS_ACT), FF, nullptr, 0, 0, 1.f}; e(acc, u, wr, wc, fr, fq); }
    else { const float* modl = (const float*)(ws + WS_MOD) + (size_t)l * BATCH * NMODC + (mode == 3 ? 2 * D : 5 * D);
        EpiResid r{(mode == 3 && l == 0) ? ap->in[0] : ap->out, ap->out, modl, D, NMODC, SEQ}; r(acc, u, wr, wc, fr, fq); }
}

__global__ void __launch_bounds__(NWAVES * 64, 2) mk_fwd(Args args) {
    extern __shared__ __attribute__((aligned(16))) unsigned char lds[];
    Frame F;
    F.lds = (LAS unsigned char*)lds;
    F.MISC = (volatile LAS unsigned*)(F.lds + MISC_OFF);
    F.tid = threadIdx.x; F.lane = F.tid & 63; F.wave = __builtin_amdgcn_readfirstlane(F.tid >> 6);
    F.G = gridDim.x; { const int bx = blockIdx.x; F.vcu = (F.G % 8 == 0) ? (bx % 8) * (F.G / 8) + bx / 8 : bx; }
    F.A = (const Args*)__builtin_amdgcn_kernarg_segment_ptr();
    F.ctl = (gu32*)(F.A->ws + WS_CTL);
    for (int u = F.tid; u < (LDS_BYTES - LDSCTL_OFF) / 4; u += NWAVES * 64) ((LAS unsigned*)(F.lds + LDSCTL_OFF))[u] = 0u;
    __syncthreads();
    XcdBarrier bar; bar.bar = (unsigned*)(F.ctl + CW_BAR); bar.x = 0; bar.st = nullptr;
    if (N_LAUNCHES == 1) bar = xcd_barrier_post((unsigned*)(F.ctl + CW_BAR), F.MISC + 8);

    const int lo = F.A->ph_lo, hi = F.A->ph_hi;
#pragma unroll 1
    for (int s = lo; s < hi; ++s) {
        { const Args* ap = (const Args*)__builtin_amdgcn_kernarg_segment_ptr(); asm volatile("" : "+s"(ap)); F.A = ap; }
        { int t_ = threadIdx.x; asm volatile("" : "+v"(t_)); F.tid = t_; F.lane = t_ & 63; F.wave = __builtin_amdgcn_readfirstlane(t_ >> 6); }
        if (s == 0) { if (PH_MASK & 1) { p_mod(F); __syncthreads(); p0_weights(F); } }
        else if (s == N_STEPS - 1) { if (PH_MASK & 2) p_final(F); }
        else {
            const int l = (s - 1) / 9, i = (s - 1) % 9;
            bf16* wl = WSH(WS_W) + (size_t)l * LAYER_W;
            const float* modl = WSF(WS_MOD) + (size_t)l * BATCH * NMODC;
            if (!((PH_MASK >> (2 + i)) & 1)) {}
            else if (i == 0) { p_normmod<true>(F, l, l == 0 ? X_IN : OUT_, NORM_MIX_W, 0, D); }
            else if (i == 2) { p_prep(F, l); }
            else if (i == 3) { p_scan(F, l); }
            else if (i == 4) { p_post(F, l); }
            else if (i == 6) { p_normmod<false>(F, l, OUT_, NORM_MLP_W, 3 * D, 4 * D); }
            else {
                pg8::Gemm g; pg8::EpiMulti E; E.l = l;
                if (i == 1) { g = pg8::Gemm{WSH(WS_H), wl, M, NPROJ, D}; E.PERM = true; E.mode = 0; }
                else if (i == 5) { g = pg8::Gemm{WSH(WS_MIX), wl + W_OUT_OFF, M, D, D}; E.PERM = false; E.mode = 3; }
                else if (i == 7) { g = pg8::Gemm{WSH(WS_H), wl + W_UP_OFF, M, FF, D}; E.PERM = true; E.mode = 2; }
                else { g = pg8::Gemm{WSH(WS_ACT), wl + W_DOWN_OFF, M, D, FF}; E.PERM = false; E.mode = 4; }
                pg8::StaticOrder S; S.init(g.M, g.N, F.G, (int)blockIdx.x);
                pg8::gemm_phase<pg8::EpiMulti, pg8::StaticOrder, PG8_ALIGN, PG8_SP2>(F.lds + RING_OFF, g, S, E);
            }
        }
        if (s + 1 < hi) xcd_barrier(bar);
    }
}

extern "C" void kernel_launch(void* const* d_in, const int* in_sizes, int n_in, void* d_out, int out_size, void* d_ws, size_t ws_size, hipStream_t stream) {
    static int grid = 0;
    if (grid == 0) {
        if (n_in != 23 || in_sizes[0] != M * D || out_size != M * D || ws_size < WS_END) { fprintf(stderr, "kernel_launch: unexpected shapes (n_in %d, in0 %d, out %d, ws %zu); nothing launched\n", n_in, n_in > 0 ? in_sizes[0] : -1, out_size, ws_size); grid = -1; return; }
        int dev = 0, cus = 0;
        if (hipGetDevice(&dev) != hipSuccess || hipDeviceGetAttribute(&cus, hipDeviceAttributeMultiprocessorCount, dev) != hipSuccess) { grid = -1; return; }
        if (hipFuncSetAttribute((const void*)mk_fwd, hipFuncAttributeMaxDynamicSharedMemorySize, LDS_BYTES) != hipSuccess) { fprintf(stderr, "kernel_launch: hipFuncSetAttribute failed\n"); grid = -1; return; }
        (void)hipGetLastError();
        grid = cus;
    }
    if (grid < 0) return;
    if (hipMemsetAsync((char*)d_ws + WS_CTL, 0, CTL_ZERO_BYTES, stream) != hipSuccess) return;
    Args a{};
    for (int i = 0; i < 23; ++i) a.in[i] = (const float*)d_in[i];
    a.out = (float*)d_out; a.ws = (unsigned char*)d_ws;
    if (N_LAUNCHES == 1) { a.ph_lo = 0; a.ph_hi = N_STEPS; hipLaunchKernelGGL(mk_fwd, dim3(grid), dim3(NWAVES * 64), LDS_BYTES, stream, a); }
    else for (int s = 0; s < N_STEPS; ++s) { a.ph_lo = s; a.ph_hi = s + 1; hipLaunchKernelGGL(mk_fwd, dim3(grid), dim3(NWAVES * 64), LDS_BYTES, stream, a); }
}
```

```cpp
#include <hip/hip_runtime.h>
#include <cstdio>
#include <cstdint>
#include <cmath>
namespace pg8 {
#define PG8_LAS __attribute__((address_space(3)))
typedef unsigned short bf16_t;
typedef short bf16x8 __attribute__((ext_vector_type(8)));
typedef float f32x4 __attribute__((ext_vector_type(4)));
typedef unsigned u32x4 __attribute__((ext_vector_type(4)));
constexpr int BM = 256, BK = 64, HALF = 128, HTB = HALF * BK * 2  , STAGE_BYTES = 8 * HTB, NXCD = 8, WGM = 8;

__host__ __device__ __forceinline__ int lds_byte(int r, int c) { const int st = (r >> 4) * 2 + (c >> 5), rr = r & 15, cc = c & 31, ob = rr * 64 + cc * 2; return st * 1024 + (ob ^ (((ob >> 9) & 1) << 5)); }
__host__ __device__ __forceinline__ void stage_rc(int b, int& R, int& C) { const int st = b / 1024, sb = b % 1024, swz = sb ^ (((sb >> 9) & 1) << 5); R = (st >> 1) * 16 + swz / 64; C = (st & 1) * 32 + (swz % 64) / 2; }
__host__ __device__ __forceinline__ int perm32(int rho) { const int n = rho >> 4, i = rho & 15; return 8 * (i >> 2) + 4 * n + (i & 3); }

struct Unit { int pm, pn; };
struct Gemm { const bf16_t* A; const bf16_t* Bt; int M, N, K; };

struct StaticOrder {
    int nM, nN, nwg, G, c;
    __host__ __device__ void init(int M, int N, int G_, int c_) { nM = M / BM; nN = N / BM; nwg = nM * nN; G = G_; c = c_; }
    __host__ __device__ bool next(int i, Unit& u) const {
        const long L = (long)i * G + c; if (L >= nwg) return false;
        int wgid = (int)L; { const int q = nwg / NXCD, r = nwg % NXCD, xcd = wgid % NXCD, off = wgid / NXCD; wgid = (xcd < r ? xcd * (q + 1) : r * (q + 1) + (xcd - r) * q) + off; }
        const int nig = WGM * nN, gid = wgid / nig, fm = gid * WGM, gsz = (nM - fm) < WGM ? (nM - fm) : WGM;
        u.pm = fm + ((wgid % nig) % gsz); u.pn = (wgid % nig) / gsz; return true;
    }
    __device__ __forceinline__ void a_ready(const Unit&) const {}
    __device__ __forceinline__ void done(const Unit&) const {}
};

__device__ __forceinline__ unsigned cvt_pk_bf16(float lo, float hi) { unsigned r; asm volatile("v_cvt_pk_bf16_f32 %0, %1, %2" : "=v"(r) : "v"(lo), "v"(hi)); return r; }
typedef float f32x2 __attribute__((ext_vector_type(2)));
__device__ __forceinline__ f32x2 gelu_pk(f32x2 v) {
    const f32x2 av = __builtin_elementwise_abs(v), d = av * 0.2316418882f + 1.0f;
    f32x2 t; t.x = __builtin_amdgcn_rcpf(d.x); t.y = __builtin_amdgcn_rcpf(d.y);
    f32x2 q = t * 0.5307027145f + (-0.7265760135f); q = q * t + 0.7107068705f; q = q * t + (-0.142248368f); q = q * t + 0.127414796f; q = q * t;
    const f32x2 s = (v * v) * (-0.72134752044f);
    f32x2 e; e.x = __builtin_amdgcn_exp2f(s.x); e.y = __builtin_amdgcn_exp2f(s.y);
    const f32x2 m = v * (q * e), r = v - m;
    f32x2 o; o.x = v.x < 0.f ? m.x : r.x; o.y = v.y < 0.f ? m.y : r.y; return o;
}

template <int ACT  > struct EpiBf16 {
    static constexpr bool PERM = true, AFTER_DRAIN = false; static_assert(ACT == 0 || ACT == 1 || ACT == 2, "EpiBf16: ACT is 0 (none), 1 (gelu_pk) or 2 (squared relu)");
    bf16_t* O; int ldc; const float* bias; int split_cols; size_t split_stride; float scale0;
    __device__ __forceinline__ void operator()(const f32x4 (&acc)[2][2][4][2], const Unit& u, int wr, int wc, int fr, int fq) const {
        const int row0 = u.pm * BM + wr * 64 + fr; int colt = u.pn * BM; bf16_t* base = O;
        float sc = 1.f; if (split_cols) { const int t = colt / split_cols; base += (size_t)t * split_stride; colt -= t * split_cols; if (t == 0) sc = scale0; }
        const int col0 = colt + wc * 32 + 8 * fq, bcol0 = u.pn * BM + wc * 32 + 8 * fq;
        f32x4 bv[2][2];
#pragma unroll
        for (int bj = 0; bj < 2; ++bj)
#pragma unroll
            for (int n = 0; n < 2; ++n) bv[bj][n] = bias ? *(const f32x4*)(bias + bcol0 + bj * HALF + 4 * n) : (f32x4){0.f, 0.f, 0.f, 0.f};
#pragma unroll
        for (int ai = 0; ai < 2; ++ai)
#pragma unroll
            for (int m = 0; m < 4; ++m) { bf16_t* rowp = base + (size_t)(row0 + ai * HALF + m * 16) * ldc + col0;
#pragma unroll
                for (int bj = 0; bj < 2; ++bj) { f32x4 v0 = acc[ai][bj][m][0] + bv[bj][0], v1 = acc[ai][bj][m][1] + bv[bj][1];
                    if (ACT == 1) { f32x2 a = gelu_pk((f32x2){v0[0], v0[1]}), b = gelu_pk((f32x2){v0[2], v0[3]}), c = gelu_pk((f32x2){v1[0], v1[1]}), d = gelu_pk((f32x2){v1[2], v1[3]});
                        v0 = (f32x4){a.x, a.y, b.x, b.y}; v1 = (f32x4){c.x, c.y, d.x, d.y}; }
                    if (ACT == 2) { _Pragma("unroll") for (int q_ = 0; q_ < 4; ++q_) { const float a_ = fmaxf(v0[q_], 0.f), b_ = fmaxf(v1[q_], 0.f); v0[q_] = a_ * a_; v1[q_] = b_ * b_; } }
                    v0 = v0 * sc; v1 = v1 * sc; u32x4 w; w.x = cvt_pk_bf16(v0[0], v0[1]); w.y = cvt_pk_bf16(v0[2], v0[3]); w.z = cvt_pk_bf16(v1[0], v1[1]); w.w = cvt_pk_bf16(v1[2], v1[3]);
                    *(u32x4*)(rowp + bj * HALF) = w; } }
    }
};


struct EpiResid {
    static constexpr bool PERM = false, AFTER_DRAIN = false;
    const float* base; float* out; const float* gate; int ldc; int gate_stride; int rows_per_batch;
    __device__ __forceinline__ void operator()(const f32x4 (&acc)[2][2][4][2], const Unit& u, int wr, int wc, int fr, int fq) const {
        const int col0 = u.pn * BM + wc * 32 + 4 * fq;
        const float* gp = gate + (size_t)((u.pm * BM) / rows_per_batch) * gate_stride + col0;
        f32x4 gv[2][2];
#pragma unroll
        for (int bj = 0; bj < 2; ++bj)
#pragma unroll
            for (int n = 0; n < 2; ++n) gv[bj][n] = *(const f32x4*)(gp + bj * HALF + n * 16);
#pragma unroll
        for (int ai = 0; ai < 2; ++ai)
#pragma unroll
            for (int m = 0; m < 4; ++m) { const size_t off = (size_t)(u.pm * BM + ai * HALF + wr * 64 + m * 16 + fr) * ldc + col0;
#pragma unroll
                for (int bj = 0; bj < 2; ++bj)
#pragma unroll
                    for (int n = 0; n < 2; ++n) { const f32x4 bs = *(const f32x4*)(base + off + bj * HALF + n * 16);
                        *(f32x4*)(out + off + bj * HALF + n * 16) = bs + gv[bj][n] * acc[ai][bj][m][n]; } }
    }
};


struct EpiMulti {
    static constexpr bool AFTER_DRAIN = false;
    bool PERM; int mode, l;
    __device__ __forceinline__ void operator()(const f32x4 (&acc)[2][2][4][2], const Unit& u, int wr, int wc, int fr, int fq) const;
};

template <class Epi, class Sched, bool ALIGN_EPI = false, bool SP2 = false>
__device__ __forceinline__ void gemm_phase(PG8_LAS unsigned char* lds, const Gemm g, const Sched& S, const Epi& E) {
    int tid_l = threadIdx.x; asm volatile("" : "+v"(tid_l));
    const int tid = tid_l, wid = __builtin_amdgcn_readfirstlane(tid >> 6), lane = tid & 63, wr = wid >> 2, wc = wid & 3, fr = lane & 15, fq = lane >> 4;
    const int K = g.K, nt = K / BK;
    unsigned voffA[2], voffB[2];
#pragma unroll
    for (int i = 0; i < 2; ++i) { int R, C; stage_rc(tid * 16 + i * 8192, R, C); const int Rb = E.PERM ? ((R & ~31) + perm32(R & 31)) : R;
        voffA[i] = (unsigned)(R * K + C) * 2u; voffB[i] = (unsigned)(Rb * K + C) * 2u; }
    const size_t kstep = (size_t)(BK * 2);
    const size_t hstep = (size_t)HALF * K * 2;
    const size_t tstep = 2 * hstep;
    const unsigned ldsw = (unsigned)wid * 1024u;
    const int aoff = lds_byte(wr * 64 + fr, fq * 8), boff = lds_byte(wc * 32 + fr, fq * 8);
#define PG8_SA(b, h) (((b) * 2 + (h)) * HTB)
#define PG8_SB(b, h) ((4 + (b) * 2 + (h)) * HTB)
#define PG8_STAGE(bufoff, gbase, voff) do { _Pragma("unroll") for (int _i = 0; _i < 2; ++_i) \
        __builtin_amdgcn_global_load_lds((const unsigned*)((const char*)(gbase) + (voff)[_i]), (PG8_LAS unsigned*)(lds + (bufoff) + ldsw + _i * 8192), 16, 0, 0); } while (0)
#define PG8_LDA(dst, b, h) do { _Pragma("unroll") for (int m = 0; m < 4; ++m) _Pragma("unroll") for (int k = 0; k < 2; ++k) dst[m][k] = *(const PG8_LAS bf16x8*)(lds + PG8_SA(b, h) + aoff + m * 2048 + k * 1024); } while (0)
#define PG8_LDB(dst, b, h) do { _Pragma("unroll") for (int n = 0; n < 2; ++n) _Pragma("unroll") for (int k = 0; k < 2; ++k) dst[n][k] = *(const PG8_LAS bf16x8*)(lds + PG8_SB(b, h) + boff + n * 2048 + k * 1024); } while (0)
#define PG8_MMA(ai, bj, At, Bt) do { __builtin_amdgcn_s_setprio(1); _Pragma("unroll") for (int m = 0; m < 4; ++m) _Pragma("unroll") for (int n = 0; n < 2; ++n) _Pragma("unroll") for (int k = 0; k < 2; ++k) \
        acc[ai][bj][m][n] = __builtin_amdgcn_mfma_f32_16x16x32_bf16(Bt[n][k], At[m][k], acc[ai][bj][m][n], 0, 0, 0); __builtin_amdgcn_s_setprio(0); } while (0)
#define PG8_WAIT_V(n) asm volatile("s_waitcnt vmcnt(" #n ")" ::: "memory")
#define PG8_WAIT_L(n) asm volatile("s_waitcnt lgkmcnt(" #n ")" ::: "memory")
#define PG8_BAR __builtin_amdgcn_s_barrier()
#define PG8_SCHED __builtin_amdgcn_sched_barrier(0)
    Unit cur, nxt; int ui = 0;
    if (!S.next(0, cur)) return;
    f32x4 acc[2][2][4][2];
#pragma unroll
    for (int a = 0; a < 2; ++a)
#pragma unroll
        for (int b = 0; b < 2; ++b)
#pragma unroll
            for (int m = 0; m < 4; ++m)
#pragma unroll
                for (int n = 0; n < 2; ++n) acc[a][b][m][n] = (f32x4){0.f, 0.f, 0.f, 0.f};
    bf16x8 At[4][2], B0[2][2], B1[2][2];
    const char* cA = (const char*)g.A + (size_t)cur.pm * tstep; const char* cB = (const char*)g.Bt + (size_t)cur.pn * tstep;
    S.a_ready(cur);
    if constexpr (SP2) {
        PG8_STAGE(PG8_SB(0, 0), cB, voffB); PG8_STAGE(PG8_SB(0, 1), cB + hstep, voffB); PG8_STAGE(PG8_SA(0, 0), cA, voffA); PG8_STAGE(PG8_SA(0, 1), cA + hstep, voffA);
        if (wr == 1) PG8_BAR;
        PG8_WAIT_V(2); PG8_BAR;
        PG8_STAGE(PG8_SB(1, 0), cB + kstep, voffB); PG8_STAGE(PG8_SA(1, 0), cA + kstep, voffA); PG8_STAGE(PG8_SB(1, 1), cB + hstep + kstep, voffB);
        PG8_WAIT_V(6); PG8_BAR;
    } else {
        PG8_STAGE(PG8_SB(0, 0), cB, voffB); PG8_STAGE(PG8_SA(0, 0), cA, voffA); PG8_STAGE(PG8_SB(0, 1), cB + hstep, voffB); PG8_STAGE(PG8_SA(0, 1), cA + hstep, voffA);
        if (wr == 1) PG8_BAR;
        PG8_WAIT_V(4); PG8_BAR;
        PG8_STAGE(PG8_SB(1, 0), cB + kstep, voffB); PG8_STAGE(PG8_SA(1, 0), cA + kstep, voffA); PG8_STAGE(PG8_SB(1, 1), cB + hstep + kstep, voffB);
        PG8_WAIT_V(6); PG8_BAR;
    }
    for (;;) {
        const bool has_next = S.next(ui + 1, nxt);
        const char* nA = has_next ? (const char*)g.A + (size_t)nxt.pm * tstep : cA; const char* nB = has_next ? (const char*)g.Bt + (size_t)nxt.pn * tstep : cB;
        for (int t = 0; t < nt; t += 2) {
            const bool last = (t == nt - 2);
            const char* a1 = cA + (size_t)(t + 1) * kstep;
            const char* a2 = last ? nA : cA + (size_t)(t + 2) * kstep; const char* b2 = last ? nB : cB + (size_t)(t + 2) * kstep;
            const char* a3 = a2 + kstep; const char* b3 = b2 + kstep;
            if (last && has_next) S.a_ready(nxt);
            if constexpr (SP2) {
            PG8_LDB(B0, 0, 0); PG8_LDB(B1, 0, 1); PG8_SCHED; PG8_LDA(At, 0, 0); PG8_STAGE(PG8_SA(1, 1), a1 + hstep, voffA);
            PG8_WAIT_V(8); PG8_WAIT_L(0); PG8_BAR; PG8_MMA(0, 0, At, B0); PG8_MMA(0, 1, At, B1); PG8_BAR; PG8_SCHED;
            PG8_LDA(At, 0, 1); PG8_STAGE(PG8_SB(0, 0), b2, voffB); PG8_STAGE(PG8_SB(0, 1), b2 + hstep, voffB); PG8_STAGE(PG8_SA(0, 0), a2, voffA);
            PG8_WAIT_V(8); PG8_WAIT_L(0); PG8_BAR; PG8_MMA(1, 0, At, B0); PG8_MMA(1, 1, At, B1); PG8_BAR; PG8_SCHED;
            PG8_LDB(B0, 1, 0); PG8_LDB(B1, 1, 1); PG8_SCHED; PG8_LDA(At, 1, 0); PG8_STAGE(PG8_SA(0, 1), a2 + hstep, voffA);
            PG8_WAIT_V(8); PG8_WAIT_L(0); PG8_BAR; PG8_MMA(0, 0, At, B0); PG8_MMA(0, 1, At, B1); PG8_BAR; PG8_SCHED;
            PG8_LDA(At, 1, 1); PG8_STAGE(PG8_SB(1, 0), b3, voffB); PG8_STAGE(PG8_SB(1, 1), b3 + hstep, voffB); PG8_STAGE(PG8_SA(1, 0), a3, voffA);
            PG8_WAIT_V(8); PG8_WAIT_L(0); PG8_BAR; PG8_MMA(1, 0, At, B0); PG8_MMA(1, 1, At, B1); PG8_BAR; PG8_SCHED;
            } else {
            PG8_LDB(B0, 0, 0); PG8_SCHED; PG8_LDA(At, 0, 0); PG8_STAGE(PG8_SA(1, 1), a1 + hstep, voffA);
            PG8_WAIT_L(8); PG8_BAR; PG8_WAIT_L(0); PG8_MMA(0, 0, At, B0); PG8_BAR; PG8_SCHED;
            PG8_LDB(B1, 0, 1); PG8_STAGE(PG8_SB(0, 0), b2, voffB);
            PG8_BAR; PG8_WAIT_L(0); PG8_MMA(0, 1, At, B1); PG8_BAR;
            PG8_LDA(At, 0, 1); PG8_STAGE(PG8_SA(0, 0), a2, voffA);
            PG8_BAR; PG8_WAIT_L(0); PG8_MMA(1, 0, At, B0); PG8_BAR; PG8_SCHED;
            PG8_STAGE(PG8_SB(0, 1), b2 + hstep, voffB);
            PG8_WAIT_V(6); PG8_BAR; PG8_MMA(1, 1, At, B1); PG8_BAR;
            PG8_LDB(B0, 1, 0); PG8_SCHED; PG8_LDA(At, 1, 0); PG8_STAGE(PG8_SA(0, 1), a2 + hstep, voffA);
            PG8_WAIT_L(8); PG8_BAR; PG8_WAIT_L(0); PG8_MMA(0, 0, At, B0); PG8_BAR; PG8_SCHED;
            PG8_LDB(B1, 1, 1); PG8_STAGE(PG8_SB(1, 0), b3, voffB);
            PG8_BAR; PG8_WAIT_L(0); PG8_MMA(0, 1, At, B1); PG8_BAR;
            PG8_LDA(At, 1, 1); PG8_STAGE(PG8_SA(1, 0), a3, voffA);
            PG8_BAR; PG8_WAIT_L(0); PG8_MMA(1, 0, At, B0); PG8_BAR; PG8_SCHED;
            PG8_STAGE(PG8_SB(1, 1), b3 + hstep, voffB);
            PG8_WAIT_V(6); PG8_BAR; PG8_MMA(1, 1, At, B1); PG8_BAR;
            }
        }
        if constexpr (ALIGN_EPI) { if (wr == 0) PG8_BAR; }
        if constexpr (!Epi::AFTER_DRAIN) { E(acc, cur, wr, wc, fr, fq); S.done(cur); }
        if (!has_next) break;
#pragma unroll
        for (int a = 0; a < 2; ++a)
#pragma unroll
            for (int b = 0; b < 2; ++b)
#pragma unroll
                for (int m = 0; m < 4; ++m)
#pragma unroll
                    for (int n = 0; n < 2; ++n) acc[a][b][m][n] = (f32x4){0.f, 0.f, 0.f, 0.f};
        cur = nxt; cA = nA; cB = nB; ++ui;
        if constexpr (ALIGN_EPI) { if (wr == 1) PG8_BAR; }
    }
    PG8_WAIT_V(0);
    if constexpr (!ALIGN_EPI) { if (wr == 0) PG8_BAR; }
    PG8_BAR;
    if constexpr (Epi::AFTER_DRAIN) { E.fused(acc, cur, wr, wc, fr, fq, lds, wid, lane); S.done(cur); }
#undef PG8_SA
#undef PG8_SB
#undef PG8_STAGE
#undef PG8_LDA
#undef PG8_LDB
#undef PG8_MMA
#undef PG8_WAIT_V
#undef PG8_WAIT_L
#undef PG8_BAR
#undef PG8_SCHED
}
}
#define GAS __attribute__((address_space(1)))
#define LAS __attribute__((address_space(3)))
typedef unsigned short bf16;
typedef unsigned v4u __attribute__((ext_vector_type(4)));
typedef float f32x4 __attribute__((ext_vector_type(4)));
typedef short bf16x8 __attribute__((ext_vector_type(8)));
typedef GAS unsigned gu32;
typedef GAS unsigned long long gu64;
#define RLX_AGENT __ATOMIC_RELAXED, __HIP_MEMORY_SCOPE_AGENT
#define LDS_WAIT() asm volatile("s_waitcnt lgkmcnt(0)" ::: "memory")
#define VM_WAIT() asm volatile("s_waitcnt vmcnt(0)" ::: "memory")
__device__ __forceinline__ unsigned long long rt() { return __builtin_amdgcn_s_memrealtime(); }
__device__ __forceinline__ unsigned f2bf(float f) { unsigned u = __builtin_bit_cast(unsigned, f); return (u + 0x7fffu + ((u >> 16) & 1u)) >> 16; }
__device__ __forceinline__ unsigned pk2(float lo, float hi) { return f2bf(lo) | (f2bf(hi) << 16); }

#define XB_TMO      128
#define XB_XCNT(j)  (256  + 64 * (j))
#define XB_XSUB(j)  (1280 + 64 * (j))
#define XB_XGEN(j)  (2304 + 64 * (j))
#define XB_TOP      3328
#define XB_TOPGEN   3392
#define XCD_BAR_WORDS 3456
#define XB_SPIN_CAP (1u << 18)

__device__ __forceinline__ unsigned xb_ld(unsigned* p)              { return __hip_atomic_load(p, __ATOMIC_RELAXED, __HIP_MEMORY_SCOPE_AGENT); }
__device__ __forceinline__ unsigned xb_add(unsigned* p, unsigned v) { return __hip_atomic_fetch_add(p, v, __ATOMIC_RELAXED, __HIP_MEMORY_SCOPE_AGENT); }
__device__ __forceinline__ unsigned xb_xcc_id() { return (unsigned)__builtin_amdgcn_s_getreg((3 << 11) | 20) & 0xFu; }
#define XB_SPIN(cond, bar) do { unsigned _sp = 0; while (cond) { __builtin_amdgcn_s_sleep(1); \
    if ((++_sp & 255u) == 0u) { if (xb_ld(&(bar)[XB_TMO])) break; if (_sp > XB_SPIN_CAP) { atomicAdd(&(bar)[XB_TMO], 1u); break; } } } } while (0)

struct XcdBarrier {
    unsigned* bar; unsigned x;
    volatile LAS unsigned* st;
};

__device__ __forceinline__ XcdBarrier xcd_barrier_post(unsigned* bar, volatile LAS unsigned* st) {
    XcdBarrier b; b.bar = bar; b.x = xb_xcc_id(); b.st = st;
    if (threadIdx.x == 0) (void)xb_add(&bar[XB_XCNT(b.x)], 1u);
    return b;
}
__device__ __forceinline__ void xcd_barrier_complete(unsigned* bar, unsigned x, unsigned& nloc, unsigned& nx) {
    const unsigned G = gridDim.x * gridDim.y * gridDim.z;
    unsigned sum, cnt, mine, sp = 0u;
    for (;;) {
        sum = 0u; cnt = 0u; mine = 0u;
#pragma unroll
        for (unsigned j = 0; j < 16; ++j) { const unsigned c = xb_ld(&bar[XB_XCNT(j)]); sum += c; cnt += (c > 0u) ? 1u : 0u; mine = (j == x) ? c : mine; }
        if (sum == G) break;
        __builtin_amdgcn_s_sleep(1);
        if ((++sp & 255u) == 0u) { if (xb_ld(&bar[XB_TMO])) break; if (sp > XB_SPIN_CAP) { atomicAdd(&bar[XB_TMO], 1u); break; } }
    }
    nloc = mine > 0u ? mine : 1u; nx = cnt > 0u ? cnt : 1u;
}

__device__ __forceinline__ void xcd_barrier(const XcdBarrier& b, const bool t0  ) {
    asm volatile("s_waitcnt vmcnt(0)" ::: "memory");
    __syncthreads();
    if (t0) {
        unsigned* bar = b.bar;
        __builtin_amdgcn_s_waitcnt(0);
        unsigned nloc = b.st[0], nx = b.st[1];
        if (nloc == 0u) { xcd_barrier_complete(bar, b.x, nloc, nx); b.st[0] = nloc; b.st[1] = nx; }
        const unsigned old = xb_add(&bar[XB_XSUB(b.x)], 1u);
        const unsigned gen = old / nloc;
        if (old + 1u == (gen + 1u) * nloc) {
            __builtin_amdgcn_fence(__ATOMIC_RELEASE, "agent");
            asm volatile("s_waitcnt vmcnt(0)" ::: "memory");
            const unsigned og = xb_add(&bar[XB_TOP], 1u);
            const unsigned tg = og / nx;
            if (og + 1u == (tg + 1u) * nx) xb_add(&bar[XB_TOPGEN], 1u);
            else XB_SPIN(xb_ld(&bar[XB_TOPGEN]) == tg, bar);
            __builtin_amdgcn_fence(__ATOMIC_ACQUIRE, "agent");
            xb_add(&bar[XB_XGEN(b.x)], 1u);
            asm volatile("s_waitcnt vmcnt(0)" ::: "memory");
        } else {
            XB_SPIN(xb_ld(&bar[XB_XGEN(b.x)]) == gen, bar);
            __builtin_amdgcn_fence(__ATOMIC_ACQUIRE, "agent");
            asm volatile("s_waitcnt vmcnt(0)" ::: "memory");
        }
    }
    __syncthreads();
}

#ifndef PG8_SP2
#define PG8_SP2 true
#endif
#ifndef PG8_ALIGN
#define PG8_ALIGN true
#endif
constexpr int NWAVES = 8;
constexpr int N_STEPS = 38;
#ifndef MK_N_LAUNCHES
#define MK_N_LAUNCHES 1
#endif
#ifndef PH_MASK
#define PH_MASK 0xffff
#endif
#ifndef REP_MASK
#define REP_MASK 0
#endif
constexpr int N_LAUNCHES = MK_N_LAUNCHES;

constexpr int D = 1024, BATCH = 4, SEQ = 4096, DEPTH = 4, M = BATCH * SEQ;
constexpr int LRUW = 512, NGB = 8, GBW = 64, GH = 4, HD = 128, GDNW = 512, CH = 64, NCH = SEQ / CH, FF = 4096;
constexpr int NMODC = 6 * D, INC = 3080, NPROJ = 3072;
constexpr int O_LX = 0, O_LY = 512, O_Q = 1024, O_Z = 2560;
constexpr float EPS = 1e-6f;

constexpr size_t MiB = 1u << 20;
constexpr size_t WS_CTL = 0, CTL_ZERO_BYTES = 1 * MiB;
constexpr size_t WS_MOD = 1 * MiB;
constexpr size_t WS_BG = 2 * MiB;
constexpr size_t WS_AGG = 3 * MiB;
constexpr size_t WS_CARRY = 4 * MiB;
constexpr size_t WS_GL = 5 * MiB;
constexpr size_t WS_W = 8 * MiB;
constexpr size_t LAYER_W = (size_t)12288 * 1024;
constexpr size_t W_OUT_OFF = (size_t)3072 * 1024, W_UP_OFF = (size_t)4096 * 1024, W_DOWN_OFF = (size_t)8192 * 1024;
constexpr size_t WS_H = 104 * MiB;
constexpr size_t WS_MIX = 136 * MiB;
constexpr size_t WS_PROJ = 168 * MiB;
constexpr size_t WS_ACT = 168 * MiB;
constexpr size_t WS_GQD = 264 * MiB, WS_GKT = 280 * MiB;
constexpr size_t WS_GATT = 296 * MiB;
constexpr size_t WS_GO = 312 * MiB;
constexpr size_t WS_LRUP = 344 * MiB;
constexpr size_t WS_END = 376 * MiB;
constexpr int CW_BAR = 4096;

constexpr int RING_OFF = 0, RING_BYTES = 147456;
constexpr int LDSCTL_OFF = RING_BYTES, MISC_OFF = LDSCTL_OFF + 320;
constexpr int LDS_BYTES = 148480;

typedef unsigned v2u __attribute__((ext_vector_type(2)));
#define DI __device__ __forceinline__
DI float bf2f(unsigned b) { return __builtin_bit_cast(float, b << 16); }
DI float bflo(unsigned w) { return __builtin_bit_cast(float, w << 16); }
DI float bfhi(unsigned w) { return __builtin_bit_cast(float, w & 0xffff0000u); }
DI float sigmoidf_(float x) { return 1.f / (1.f + expf(-x)); }
DI float siluf_(float x) { return x / (1.f + expf(-x)); }
DI float gelu_tanh(float x) { const float u = 0.7978845608028654f * (x + 0.044715f * x * x * x); return 0.5f * x * (1.f + tanhf(u)); }
DI float bperm_(int src_lane, float v) { return __builtin_bit_cast(float, __builtin_amdgcn_ds_bpermute(src_lane << 2, __builtin_bit_cast(int, v))); }
DI float wave_sum_(int lane, float v) {
#pragma unroll
    for (int o = 1; o < 64; o <<= 1) v += bperm_(lane ^ o, v);
    return v;
}
DI float half_sum_(int lane, float v) {
#pragma unroll
    for (int o = 1; o < 32; o <<= 1) v += bperm_(lane ^ o, v);
    return v;
}
DI float shfl_up_(int lane, float v, int off) { return bperm_(lane >= off ? lane - off : lane, v); }

struct Args { const float* in[23]; float* out; unsigned char* ws; int ph_lo, ph_hi; };
static_assert(sizeof(Args) == 23 * 8 + 8 + 8 + 8, "Args has no padding");
struct Frame {
    LAS unsigned char* lds;
    volatile LAS unsigned* MISC;
    gu32* ctl;
    int tid, lane, wave;
    int vcu, G;
    const __attribute__((address_space(4))) Args* A;
};
#define IN_(k) (F.A->in[k])
#define X_IN IN_(0)
#define C_IN IN_(1)
#define NORM_MIX_W IN_(2)
#define NORM_MLP_W IN_(3)
#define W_MOD IN_(4)
#define B_MOD IN_(5)
#define W_IN IN_(6)
#define LRU_CONV_W IN_(7)
#define LRU_CONV_B IN_(8)
#define GATE_A_W IN_(9)
#define GATE_A_B IN_(10)
#define GATE_X_W IN_(11)
#define GATE_X_B IN_(12)
#define LRU_LAMBDA IN_(13)
#define LRU_NORM_W IN_(14)
#define GDN_CONV_W IN_(15)
#define GDN_A_LOG IN_(16)
#define GDN_DT_BIAS IN_(17)
#define GDN_NORM_W IN_(18)
#define W_OUT IN_(19)
#define W_UP IN_(20)
#define W_DOWN IN_(21)
#define FINAL_NORM_W IN_(22)
#define OUT_ (F.A->out)
#define WSF(off) ((float*)(F.A->ws + (off)))
#define WSH(off) ((bf16*)(F.A->ws + (off)))

DI void p_mod(Frame& F) {
    LAS float* cs = (LAS float*)F.lds;
    LAS float* red = cs + 4096;
    for (int i = F.tid; i < BATCH * D; i += NWAVES * 64) cs[i] = siluf_(C_IN[i]);
    __syncthreads();
    for (int item = blockIdx.x; item < DEPTH * 96; item += gridDim.x) {
        const int l = item / 96, cg = item % 96, col = cg * 64 + F.lane;
        const float* wp = W_MOD + ((size_t)l * D + F.wave * 128) * NMODC + col;
        float a0 = 0.f, a1 = 0.f, a2 = 0.f, a3 = 0.f;
#pragma unroll 8
        for (int kk = 0; kk < 128; ++kk) { const float wv = wp[(size_t)kk * NMODC]; const int k = F.wave * 128 + kk;
            a0 += cs[k] * wv; a1 += cs[1024 + k] * wv; a2 += cs[2048 + k] * wv; a3 += cs[3072 + k] * wv; }
        red[(F.wave * 4 + 0) * 64 + F.lane] = a0; red[(F.wave * 4 + 1) * 64 + F.lane] = a1; red[(F.wave * 4 + 2) * 64 + F.lane] = a2; red[(F.wave * 4 + 3) * 64 + F.lane] = a3;
        __syncthreads();
        if (F.tid < 256) { const int b = F.tid >> 6, ln = F.tid & 63; float s = 0.f;
#pragma unroll
            for (int w = 0; w < 8; ++w) s += red[(w * 4 + b) * 64 + ln];
            const int cc = cg * 64 + ln; WSF(WS_MOD)[((size_t)l * BATCH + b) * NMODC + cc] = s + B_MOD[(size_t)l * NMODC + cc]; }
        __syncthreads();
    }
}

DI void p0_transpose_item(const float* W, int K, int ldw, int N, bf16* WT, LAS float* scr, int item, int lane) {
    const int nblk = N / 32, kb = item / nblk, nb = item % nblk, k0 = 64 * kb, n0 = 32 * nb;
#pragma unroll 8
    for (int i = 0; i < 32; ++i) { const int kk = 2 * i + (lane >> 5); scr[kk * 33 + (lane & 31)] = W[(size_t)(k0 + kk) * ldw + n0 + (lane & 31)]; }
    LDS_WAIT(); asm volatile("" ::: "memory");
    const int c = lane & 7;
#pragma unroll
    for (int j = 0; j < 4; ++j) { const int n = (lane >> 3) + 8 * j; const LAS float* s = scr + (8 * c) * 33 + n;
        v4u o; o.x = pk2(s[0 * 33], s[1 * 33]); o.y = pk2(s[2 * 33], s[3 * 33]); o.z = pk2(s[4 * 33], s[5 * 33]); o.w = pk2(s[6 * 33], s[7 * 33]);
        *(v4u*)(WT + (size_t)(n0 + n) * K + k0 + 8 * c) = o; }
    LDS_WAIT(); asm volatile("" ::: "memory");
}
DI void p0_weights(Frame& F) {
    LAS float* scr = (LAS float*)(F.lds + RING_OFF + F.wave * 16384);
    const int gw = F.vcu * NWAVES + F.wave, NGW = F.G * NWAVES;
    constexpr int I_IN = (D / 64) * (NPROJ / 32), I_OUT = (D / 64) * (D / 32), I_UP = (D / 64) * (FF / 32), I_DN = (FF / 64) * (D / 32);
    constexpr int PER_LAYER = I_IN + I_OUT + I_UP + I_DN;
    for (int it = gw; it < DEPTH * PER_LAYER; it += NGW) {
        const int l = it / PER_LAYER; int r = it % PER_LAYER; bf16* wl = WSH(WS_W) + (size_t)l * LAYER_W;
        if (r < I_IN) { p0_transpose_item(W_IN + (size_t)l * D * INC, D, INC, NPROJ, wl, scr, r, F.lane); continue; } r -= I_IN;
        if (r < I_OUT) { p0_transpose_item(W_OUT + (size_t)l * D * D, D, D, D, wl + W_OUT_OFF, scr, r, F.lane); continue; } r -= I_OUT;
        if (r < I_UP) { p0_transpose_item(W_UP + (size_t)l * D * FF, D, FF, FF, wl + W_UP_OFF, scr, r, F.lane); continue; } r -= I_UP;
        p0_transpose_item(W_DOWN + (size_t)l * FF * D, FF, D, D, wl + W_DOWN_OFF, scr, r, F.lane);
    }
}

template <bool WITH_BG>
DI void p_normmod(Frame& F, int l, const float* xin, const float* normw, int off_sh, int off_sc) {
    LAS float* w8 = (LAS float*)F.lds;
    if (WITH_BG) {
        for (int i = F.tid; i < D * 8; i += NWAVES * 64) w8[i] = W_IN[((size_t)l * D + (i >> 3)) * INC + NPROJ + (i & 7)];
        __syncthreads();
    }
    const int gw = F.vcu * NWAVES + F.wave, NGW = F.G * NWAVES;
    for (int m = gw; m < M; m += NGW) {
        const int b = m >> 12;
        const float* modp = WSF(WS_MOD) + ((size_t)l * BATCH + b) * NMODC;
        f32x4 v[4]; float ss = 0.f;
#pragma unroll
        for (int j = 0; j < 4; ++j) { v[j] = *(const f32x4*)(xin + (size_t)m * D + 4 * F.lane + 256 * j); ss += (v[j].x * v[j].x + v[j].y * v[j].y) + (v[j].z * v[j].z + v[j].w * v[j].w); }
        ss = wave_sum_(F.lane, ss);
        const float rstd = 1.0f / sqrtf(ss * (1.0f / D) + EPS);
        float a0 = 0.f, a1 = 0.f, a2 = 0.f, a3 = 0.f, a4 = 0.f, a5 = 0.f, a6 = 0.f, a7 = 0.f;
#pragma unroll
        for (int j = 0; j < 4; ++j) {
            const int col = 4 * F.lane + 256 * j;
            const f32x4 nw = *(const f32x4*)(normw + (size_t)l * D + col), sc = *(const f32x4*)(modp + off_sc + col), sh = *(const f32x4*)(modp + off_sh + col);
            const f32x4 hv = v[j] * rstd * nw * (sc + 1.0f) + sh;
            v2u o; o.x = pk2(hv.x, hv.y); o.y = pk2(hv.z, hv.w);
            *(v2u*)(WSH(WS_H) + (size_t)m * D + col) = o;
            if (WITH_BG) {
#pragma unroll
                for (int e = 0; e < 4; ++e) { const f32x4 wa = *(const LAS f32x4*)(w8 + (col + e) * 8), wb = *(const LAS f32x4*)(w8 + (col + e) * 8 + 4); const float hh = hv[e];
                    a0 += hh * wa.x; a1 += hh * wa.y; a2 += hh * wa.z; a3 += hh * wa.w; a4 += hh * wb.x; a5 += hh * wb.y; a6 += hh * wb.z; a7 += hh * wb.w; }
            }
        }
        if (WITH_BG) {
            a0 = wave_sum_(F.lane, a0); a1 = wave_sum_(F.lane, a1); a2 = wave_sum_(F.lane, a2); a3 = wave_sum_(F.lane, a3); a4 = wave_sum_(F.lane, a4); a5 = wave_sum_(F.lane, a5); a6 = wave_sum_(F.lane, a6); a7 = wave_sum_(F.lane, a7);
            if (F.lane < 4) {
                const int hh = F.lane;
                const float bpre = hh == 0 ? a0 : hh == 1 ? a1 : hh == 2 ? a2 : a3;
                const float apre = hh == 0 ? a4 : hh == 1 ? a5 : hh == 2 ? a6 : a7;
                const float xx = apre + GDN_DT_BIAS[l * GH + hh];
                const float sp = xx > 20.f ? xx : log1pf(expf(xx));
                WSF(WS_BG)[(size_t)m * 8 + hh] = sigmoidf_(bpre);
                WSF(WS_BG)[(size_t)m * 8 + 4 + hh] = -expf(GDN_A_LOG[l * GH + hh]) * sp;
            }
        }
    }
}

DI void p_prep(Frame& F, int l) {
    LAS float* L = (LAS float*)F.lds;
    const int tid = F.tid, lane = F.lane, wave = F.wave;
    for (int item = blockIdx.x; item < BATCH * NCH; item += gridDim.x) {
        const int b = item / NCH, n = item % NCH, row0 = b * SEQ + n * CH, t0 = n * CH;
        {
            LAS float* xr = L;
            LAS float* Wa = L + 4352;
            LAS float* Wx = Wa + 4096;
            LAS float* sa = Wx + 4096;
            LAS float* sb = sa + 4160;
            for (int g = 0; g < NGB; ++g) {
#pragma unroll
                for (int e = 0; e < 8; ++e) { const int idx = tid + 512 * e, t = idx >> 6, c = idx & 63, cc = g * 64 + c;
                    float acc = LRU_CONV_B[l * LRUW + cc];
#pragma unroll
                    for (int k = 0; k < 4; ++k) { const int tt = t0 + t - 3 + k; if (tt >= 0) acc += LRU_CONV_W[((size_t)l * 4 + k) * LRUW + cc] * bf2f(WSH(WS_PROJ)[(size_t)(b * SEQ + tt) * NPROJ + O_LX + cc]); }
                    xr[t * 68 + c] = acc;
                    Wa[idx] = GATE_A_W[((size_t)(l * NGB + g)) * 4096 + idx]; Wx[idx] = GATE_X_W[((size_t)(l * NGB + g)) * 4096 + idx]; }
                __syncthreads();
                {
                    const int j = tid & 63, tq = tid >> 6, cc = g * 64 + j;
                    float ra[8], ia[8];
#pragma unroll
                    for (int e = 0; e < 8; ++e) { ra[e] = 0.f; ia[e] = 0.f; }
                    for (int i = 0; i < 64; i += 4) {
                        const float wa0 = Wa[(i + 0) * 64 + j], wa1 = Wa[(i + 1) * 64 + j], wa2 = Wa[(i + 2) * 64 + j], wa3 = Wa[(i + 3) * 64 + j];
                        const float wx0 = Wx[(i + 0) * 64 + j], wx1 = Wx[(i + 1) * 64 + j], wx2 = Wx[(i + 2) * 64 + j], wx3 = Wx[(i + 3) * 64 + j];
#pragma unroll
                        for (int e = 0; e < 8; ++e) { const f32x4 xv = *(const LAS f32x4*)(xr + (tq + 8 * e) * 68 + i);
                            ra[e] += xv.x * wa0 + xv.y * wa1 + xv.z * wa2 + xv.w * wa3; ia[e] += xv.x * wx0 + xv.y * wx1 + xv.z * wx2 + xv.w * wx3; }
                    }
                    const float lam = LRU_LAMBDA[l * LRUW + cc];
                    const float logsig = -(fmaxf(-lam, 0.f) + log1pf(expf(-fabsf(lam))));
                    const float ba = GATE_A_B[l * LRUW + cc], bx = GATE_X_B[l * LRUW + cc];
#pragma unroll
                    for (int e = 0; e < 8; ++e) { const int t = tq + 8 * e;
                        const float r = sigmoidf_(ra[e] + ba), ig = sigmoidf_(ia[e] + bx);
                        const float log_a = 8.0f * r * logsig, a = expf(log_a), mult = sqrtf(fmaxf(-expm1f(2.0f * log_a), 1e-12f));
                        sa[t * 65 + j] = a; sb[t * 65 + j] = mult * (ig * xr[t * 68 + j]); }
                }
                __syncthreads();
#pragma unroll 1
                for (int q = 0; q < 8; ++q) { const int c = wave * 8 + q;
                    float A = sa[lane * 65 + c], B = sb[lane * 65 + c];
#pragma unroll
                    for (int off = 1; off < 64; off <<= 1) { const float Ap = shfl_up_(F.lane, A, off), Bp = shfl_up_(F.lane, B, off); if (lane >= off) { B = A * Bp + B; A = A * Ap; } }
                    sa[lane * 65 + c] = A; sb[lane * 65 + c] = B;
                    if (lane == 63) { WSF(WS_AGG)[((size_t)(b * NCH + n)) * LRUW + g * 64 + c] = A; WSF(WS_AGG)[(size_t)BATCH * NCH * LRUW + ((size_t)(b * NCH + n)) * LRUW + g * 64 + c] = B; } }
                __syncthreads();
#pragma unroll
                for (int e = 0; e < 8; ++e) { const int idx = tid + 512 * e, t = idx >> 6, c = idx & 63;
                    WSF(WS_H)[(size_t)(row0 + t) * LRUW + g * 64 + c] = sb[t * 65 + c]; WSF(WS_LRUP)[(size_t)(row0 + t) * LRUW + g * 64 + c] = sa[t * 65 + c]; }
                __syncthreads();
            }
        }
        {
            LAS float* sk = L;
            LAS float* sq = L + 8448;
            LAS float* sv = L + 16896;
            LAS float* sL = L + 25344;
            LAS float* sgc = L + 29696;
            LAS float* sbeta = sgc + 64;
            for (int h = 0; h < GH; ++h) {
                const size_t item4 = (size_t)(b * GH + h) * NCH + n;
#pragma unroll 4
                for (int e = 0; e < 48; ++e) { const int idx = tid + 512 * e, which = idx >> 13, rem = idx & 8191, t = rem >> 7, d = rem & 127, ch = which * GDNW + h * HD + d;
                    float acc = 0.f;
#pragma unroll
                    for (int k = 0; k < 4; ++k) { const int tt = t0 + t - 3 + k; if (tt >= 0) acc += GDN_CONV_W[((size_t)l * 4 + k) * (3 * GDNW) + ch] * bf2f(WSH(WS_PROJ)[(size_t)(b * SEQ + tt) * NPROJ + O_Q + ch]); }
                    const float val = siluf_(acc);
                    LAS float* dst = which == 0 ? sq : which == 1 ? sk : sv;
                    dst[t * 132 + d] = val; }
                if (wave == 0) { float gcv = WSF(WS_BG)[(size_t)(row0 + lane) * 8 + 4 + h];
#pragma unroll
                    for (int off = 1; off < 64; off <<= 1) { const float p = shfl_up_(F.lane, gcv, off); if (lane >= off) gcv += p; }
                    sgc[lane] = gcv; sbeta[lane] = WSF(WS_BG)[(size_t)(row0 + lane) * 8 + h]; }
                __syncthreads();
#pragma unroll 1
                for (int r = wave; r < 128; r += 8) { LAS float* rowp = (r < 64 ? sq + r * 132 : sk + (r - 64) * 132);
                    const float x0 = rowp[lane], x1 = rowp[lane + 64]; const float ss = wave_sum_(F.lane, x0 * x0 + x1 * x1);
                    const float scl = (1.0f / sqrtf(ss + 1e-6f)) * (r < 64 ? 0.08838834764831845f : 1.0f);
                    rowp[lane] = x0 * scl; rowp[lane + 64] = x1 * scl; }
                __syncthreads();
                {
                    float kk[8], qk[8];
#pragma unroll
                    for (int e = 0; e < 8; ++e) { kk[e] = 0.f; qk[e] = 0.f; }
                    const int j = lane;
                    for (int d0 = 0; d0 < 128; d0 += 4) { const f32x4 kj = *(const LAS f32x4*)(sk + j * 132 + d0);
#pragma unroll
                        for (int e = 0; e < 8; ++e) { const int i = wave * 8 + e; const f32x4 ki = *(const LAS f32x4*)(sk + i * 132 + d0), qi = *(const LAS f32x4*)(sq + i * 132 + d0);
                            kk[e] += ki.x * kj.x + ki.y * kj.y + ki.z * kj.z + ki.w * kj.w; qk[e] += qi.x * kj.x + qi.y * kj.y + qi.z * kj.z + qi.w * kj.w; } }
#pragma unroll
                    for (int e = 0; e < 8; ++e) { const int i = wave * 8 + e;
                        const float dec = (j <= i) ? expf(sgc[i] - sgc[j]) : 0.f;
                        sL[i * 68 + j] = (j < i) ? sbeta[i] * kk[e] * dec : 0.f;
                        WSH(WS_GATT)[item4 * 4096 + i * 64 + j] = (bf16)f2bf((j <= i) ? qk[e] * dec : 0.f); }
                }
                __syncthreads();
                {
                    const float glast = sgc[63];
#pragma unroll 4
                    for (int e = 0; e < 16; ++e) { const int idx = tid + 512 * e, t = idx >> 7, d = idx & 127;
                        const float qv = sq[t * 132 + d], kv = sk[t * 132 + d], gct = sgc[t], eg = expf(gct), bt = sbeta[t];
                        WSH(WS_GQD)[item4 * 8192 + idx] = (bf16)f2bf(qv * eg); WSH(WS_GKT)[item4 * 8192 + d * 64 + t] = (bf16)f2bf(kv * expf(glast - gct));
                        sv[t * 132 + d] *= bt; sq[t * 132 + d] = kv * bt * eg; }
                    if (tid == 0) WSF(WS_GL)[item4] = expf(glast);
                }
                __syncthreads();
                if (tid < 256) { LAS float* arr = (tid < 128 ? sv : sq) + (tid & 127);
#pragma unroll 1
                    for (int i = 1; i < 64; ++i) { float acc = arr[i * 132]; int m = 0;
                        for (; m + 4 <= i; m += 4) { const f32x4 lv = *(const LAS f32x4*)(sL + i * 68 + m);
                            acc -= lv.x * arr[(m + 0) * 132] + lv.y * arr[(m + 1) * 132] + lv.z * arr[(m + 2) * 132] + lv.w * arr[(m + 3) * 132]; }
                        for (; m < i; ++m) acc -= sL[i * 68 + m] * arr[m * 132];
                        arr[i * 132] = acc; } }
                __syncthreads();
#pragma unroll 4
                for (int e = 0; e < 16; ++e) { const int idx = tid + 512 * e, t = idx >> 7, d = idx & 127;
                    WSH(WS_MIX)[item4 * 8192 + idx] = (bf16)f2bf(sv[t * 132 + d]); WSH(WS_MIX + 16 * MiB)[item4 * 8192 + idx] = (bf16)f2bf(-sq[t * 132 + d]); }
                __syncthreads();
            }
        }
    }
}

typedef float f32x2_t __attribute__((ext_vector_type(2))); typedef __bf16 bf16x2_t __attribute__((ext_vector_type(2)));
DI unsigned cvtpk(float lo, float hi) { f32x2_t v = {lo, hi}; bf16x2_t b = __builtin_convertvector(v, bf16x2_t); return __builtin_bit_cast(unsigned, b); }
DI bf16x8 pack8(f32x4 a, f32x4 b) { v4u p; p.x = cvtpk(a.x, a.y); p.y = cvtpk(a.z, a.w); p.z = cvtpk(b.x, b.y); p.w = cvtpk(b.z, b.w); return __builtin_bit_cast(bf16x8, p); }
DI bf16x8 ldfrag(const LAS unsigned char* p) { const v2u lo = *(const LAS v2u*)p, hi = *(const LAS v2u*)(p + 32); v4u r; r.x = lo.x; r.y = lo.y; r.z = hi.x; r.w = hi.y; return __builtin_bit_cast(bf16x8, r); }
#define MFMA16(a, b, c) __builtin_amdgcn_mfma_f32_16x16x32_bf16((a), (b), (c), 0, 0, 0)
constexpr int SC_W = 0, SC_QD = 17408, SC_KT = 34816, SC_AT = 53248, SC_U = 62464, SC_STAGE = 71680;
static_assert(2 * SC_STAGE <= RING_BYTES, "scan stages fit the ring");
DI void p_scan(Frame& F, int l) {
    const int tid = F.tid, lane = F.lane, wave = F.wave;
    for (int p = blockIdx.x * NWAVES + wave; p < BATCH * LRUW; p += gridDim.x * NWAVES) { const int b = p / LRUW, c = p % LRUW;
        float A = WSF(WS_AGG)[((size_t)(b * NCH + lane)) * LRUW + c], B = WSF(WS_AGG)[(size_t)BATCH * NCH * LRUW + ((size_t)(b * NCH + lane)) * LRUW + c];
#pragma unroll
        for (int off = 1; off < 64; off <<= 1) { const float Ap = shfl_up_(F.lane, A, off), Bp = shfl_up_(F.lane, B, off); if (lane >= off) { B = A * Bp + B; A = A * Ap; } }
        if (lane < 63) WSF(WS_CARRY)[((size_t)(b * NCH + lane + 1)) * LRUW + c] = B; else WSF(WS_CARRY)[((size_t)(b * NCH)) * LRUW + c] = 0.f; }
    const bool is_loader = wave >= 4;
    const int wv = wave & 3, m = lane & 15, q = lane >> 4, lt = tid & 255;
    for (int item = blockIdx.x; item < BATCH * GH * 2; item += gridDim.x) {
        const int bh = item >> 1, dvbase = (item & 1) * 64, b = bh >> 2, h = bh & 3;
        const size_t it0 = (size_t)bh * NCH;
        const unsigned char* gW = (const unsigned char*)(WSH(WS_MIX + 16 * MiB) + it0 * 8192);
        const unsigned char* gQD = (const unsigned char*)(WSH(WS_GQD) + it0 * 8192);
        const unsigned char* gKT = (const unsigned char*)(WSH(WS_GKT) + it0 * 8192);
        const unsigned char* gAT = (const unsigned char*)(WSH(WS_GATT) + it0 * 4096);
        const unsigned char* gU = (const unsigned char*)(WSH(WS_MIX) + it0 * 8192) + dvbase * 2;
#define SC_LOAD(n_) do { const size_t cb = (size_t)(n_) * 16384, ca = (size_t)(n_) * 8192; \
            _Pragma("unroll") for (int i = 0; i < 4; ++i) { const int p = lt + 256 * i; rg[i] = *(const v4u*)(gW + cb + (p >> 4) * 256 + (p & 15) * 16); rg[4 + i] = *(const v4u*)(gQD + cb + (p >> 4) * 256 + (p & 15) * 16); \
                rg[8 + i] = *(const v4u*)(gKT + cb + (p >> 3) * 128 + (p & 7) * 16); } \
            _Pragma("unroll") for (int i = 0; i < 2; ++i) { const int p = lt + 256 * i; rg[12 + i] = *(const v4u*)(gAT + ca + (p >> 3) * 128 + (p & 7) * 16); rg[14 + i] = *(const v4u*)(gU + cb + (p >> 3) * 256 + (p & 7) * 16); } } while (0)
#define SC_WRITE(buf_) do { LAS unsigned char* sb_ = F.lds + (buf_) * SC_STAGE; \
            _Pragma("unroll") for (int i = 0; i < 4; ++i) { const int p = lt + 256 * i; *(LAS v4u*)(sb_ + SC_W + (p >> 4) * 272 + (p & 15) * 16) = rg[i]; *(LAS v4u*)(sb_ + SC_QD + (p >> 4) * 272 + (p & 15) * 16) = rg[4 + i]; \
                *(LAS v4u*)(sb_ + SC_KT + (p >> 3) * 144 + (p & 7) * 16) = rg[8 + i]; } \
            _Pragma("unroll") for (int i = 0; i < 2; ++i) { const int p = lt + 256 * i; *(LAS v4u*)(sb_ + SC_AT + (p >> 3) * 144 + (p & 7) * 16) = rg[12 + i]; *(LAS v4u*)(sb_ + SC_U + (p >> 3) * 144 + (p & 7) * 16) = rg[14 + i]; } } while (0)
        if (is_loader) {
            v4u rg[16];
            SC_LOAD(0); SC_WRITE(0); SC_LOAD(1);
            __syncthreads();
#pragma unroll 1
            for (int n = 0; n < NCH; ++n) {
                if (n + 1 < NCH) SC_WRITE((n + 1) & 1);
                if (n + 2 < NCH) SC_LOAD(n + 2);
                __syncthreads();
            }
        } else {
            f32x4 Sacc[8];
#pragma unroll
            for (int dt = 0; dt < 8; ++dt) Sacc[dt] = (f32x4){0.f, 0.f, 0.f, 0.f};
            const float glv = WSF(WS_GL)[it0 + lane];
            __syncthreads();
#pragma unroll 1
            for (int n = 0; n < NCH; ++n) {
                const LAS unsigned char* B = F.lds + (n & 1) * SC_STAGE;
                bf16x8 Sb[4];
#pragma unroll
                for (int kb = 0; kb < 4; ++kb) Sb[kb] = pack8(Sacc[2 * kb], Sacc[2 * kb + 1]);
                f32x4 vn[4], o[4];
#pragma unroll
                for (int mt = 0; mt < 4; ++mt) { o[mt] = (f32x4){0.f, 0.f, 0.f, 0.f};
#pragma unroll
                    for (int r = 0; r < 4; ++r) vn[mt][r] = bf2f(*(const LAS unsigned short*)(B + SC_U + (16 * mt + 4 * q + r) * 144 + (16 * wv + m) * 2)); }
#pragma unroll
                for (int mt = 0; mt < 4; ++mt)
#pragma unroll
                    for (int kb = 0; kb < 4; ++kb) {
                        vn[mt] = MFMA16(ldfrag(B + SC_W + (16 * mt + m) * 272 + (32 * kb + 4 * q) * 2), Sb[kb], vn[mt]);
                        o[mt] = MFMA16(ldfrag(B + SC_QD + (16 * mt + m) * 272 + (32 * kb + 4 * q) * 2), Sb[kb], o[mt]); }
                bf16x8 vnb[2];
                vnb[0] = pack8(vn[0], vn[1]); vnb[1] = pack8(vn[2], vn[3]);
#pragma unroll
                for (int mt = 0; mt < 4; ++mt)
#pragma unroll
                    for (int kb2 = 0; kb2 < 2; ++kb2) if (32 * kb2 <= 16 * mt + 15) o[mt] = MFMA16(ldfrag(B + SC_AT + (16 * mt + m) * 144 + (32 * kb2 + 4 * q) * 2), vnb[kb2], o[mt]);
                const float gl = __builtin_bit_cast(float, __builtin_amdgcn_readlane(__builtin_bit_cast(int, glv), n));
#pragma unroll
                for (int dt = 0; dt < 8; ++dt) { Sacc[dt] = Sacc[dt] * gl;
#pragma unroll
                    for (int kb2 = 0; kb2 < 2; ++kb2) Sacc[dt] = MFMA16(ldfrag(B + SC_KT + (16 * dt + m) * 144 + (32 * kb2 + 4 * q) * 2), vnb[kb2], Sacc[dt]); }
                float* go = WSF(WS_GO) + (size_t)(b * SEQ + n * CH + 4 * q) * GDNW + h * HD + dvbase + 16 * wv + m;
#pragma unroll
                for (int mt = 0; mt < 4; ++mt)
#pragma unroll
                    for (int r = 0; r < 4; ++r) go[(size_t)(16 * mt + r) * GDNW] = o[mt][r];
                __syncthreads();
            }
        }
#undef SC_LOAD
#undef SC_WRITE
    }
}

DI void p_post(Frame& F, int l) {
    const int gw = F.vcu * NWAVES + F.wave, NGW = F.G * NWAVES, lane = F.lane;
    for (int m = gw; m < M; m += NGW) {
        const int b = m >> 12, n = (m & (SEQ - 1)) >> 6;
        f32x4 val[2]; float ss = 0.f;
#pragma unroll
        for (int j = 0; j < 2; ++j) { const int c = 4 * lane + 256 * j;
            const f32x4 hl = *(const f32x4*)(WSF(WS_H) + (size_t)m * LRUW + c), p = *(const f32x4*)(WSF(WS_LRUP) + (size_t)m * LRUW + c), cr = *(const f32x4*)(WSF(WS_CARRY) + ((size_t)(b * NCH + n)) * LRUW + c);
            const v2u y2 = *(const v2u*)(WSH(WS_PROJ) + (size_t)m * NPROJ + O_LY + c);
            const f32x4 hh = hl + p * cr;
            val[j] = (f32x4){hh.x * gelu_tanh(bflo(y2.x)), hh.y * gelu_tanh(bfhi(y2.x)), hh.z * gelu_tanh(bflo(y2.y)), hh.w * gelu_tanh(bfhi(y2.y))};
            ss += (val[j].x * val[j].x + val[j].y * val[j].y) + (val[j].z * val[j].z + val[j].w * val[j].w); }
        ss = wave_sum_(F.lane, ss);
        const float rl = 1.0f / sqrtf(ss * (1.0f / LRUW) + EPS);
#pragma unroll
        for (int j = 0; j < 2; ++j) { const int c = 4 * lane + 256 * j; const f32x4 nw = *(const f32x4*)(LRU_NORM_W + (size_t)l * LRUW + c);
            const f32x4 o = val[j] * rl * nw; v2u w; w.x = pk2(o.x, o.y); w.y = pk2(o.z, o.w); *(v2u*)(WSH(WS_MIX) + (size_t)m * D + c) = w; }
#pragma unroll
        for (int j = 0; j < 2; ++j) { const int c = 4 * lane + 256 * j, d = c & (HD - 1);
            const f32x4 o = *(const f32x4*)(WSF(WS_GO) + (size_t)m * GDNW + c);
            const float s2 = half_sum_(F.lane, (o.x * o.x + o.y * o.y) + (o.z * o.z + o.w * o.w));
            const float rg = 1.0f / sqrtf(s2 * (1.0f / HD) + EPS);
            const f32x4 nw = *(const f32x4*)(GDN_NORM_W + (size_t)l * HD + d);
            const v2u z2 = *(const v2u*)(WSH(WS_PROJ) + (size_t)m * NPROJ + O_Z + c);
            const f32x4 r = (f32x4){o.x * rg * nw.x * siluf_(bflo(z2.x)), o.y * rg * nw.y * siluf_(bfhi(z2.x)), o.z * rg * nw.z * siluf_(bflo(z2.y)), o.w * rg * nw.w * siluf_(bfhi(z2.y))};
            v2u w; w.x = pk2(r.x, r.y); w.y = pk2(r.z, r.w); *(v2u*)(WSH(WS_MIX) + (size_t)m * D + LRUW + c) = w; }
    }
}

DI void p_final(Frame& F) {
    const int gw = F.vcu * NWAVES + F.wave, NGW = F.G * NWAVES, lane = F.lane;
    for (int m = gw; m < M; m += NGW) {
        f32x4 v[4]; float ss = 0.f;
#pragma unroll
        for (int j = 0; j < 4; ++j) { v[j] = *(const f32x4*)(OUT_ + (size_t)m * D + 4 * lane + 256 * j); ss += (v[j].x * v[j].x + v[j].y * v[j].y) + (v[j].z * v[j].z + v[j].w * v[j].w); }
        ss = wave_sum_(F.lane, ss);
        const float rstd = 1.0f / sqrtf(ss * (1.0f / D) + EPS);
#pragma unroll
        for (int j = 0; j < 4; ++j) { const int col = 4 * lane + 256 * j; const f32x4 nw = *(const f32x4*)(FINAL_NORM_W + col); *(f32x4*)(OUT_ + (size_t)m * D + col) = v[j] * rstd * nw; }
    }
}

__device__ __forceinline__ void pg8::EpiMulti::operator()(const f32x4 (&acc)[2][2][4][2], const Unit& u, int wr, int wc, int fr, int fq) const {
    const __attribute__((address_space(4))) Args* ap = (const __attribute__((address_space(4))) Args*)__builtin_amdgcn_kernarg_segment_ptr(); asm volatile("" : "+s"(ap));
    unsigned char* ws = ap->ws;
    if (mode == 0) { EpiBf16<0> e{(bf16_t*)(ws + WS_PROJ), NPROJ, nullptr, 0, 0, 1.f}; e(acc, u, wr, wc, fr, fq); }
    else if (mode == 2) { EpiBf16<2> e{(bf16_t*)(ws + WS_ACT), FF, nullptr, 0, 0, 1.f}; e(acc, u, wr, wc, fr, fq); }
    else { const float* modl = (const float*)(ws + WS_MOD) + (size_t)l * BATCH * NMODC + (mode == 3 ? 2 * D : 5 * D);
        EpiResid r{(mode == 3 && l == 0) ? ap->in[0] : ap->out, ap->out, modl, D, NMODC, SEQ}; r(acc, u, wr, wc, fr, fq); }
}

__global__ void __launch_bounds__(NWAVES * 64, 2) mk_fwd(Args args) {
    extern __shared__ __attribute__((aligned(16))) unsigned char lds[];
    Frame F;
    F.lds = (LAS unsigned char*)lds;
    F.MISC = (volatile LAS unsigned*)(F.lds + MISC_OFF);
    F.tid = threadIdx.x; F.lane = F.tid & 63; F.wave = __builtin_amdgcn_readfirstlane(F.tid >> 6);
    F.G = gridDim.x; { const int bx = blockIdx.x; F.vcu = (F.G % 8 == 0) ? (bx % 8) * (F.G / 8) + bx / 8 : bx; }
    F.A = (const __attribute__((address_space(4))) Args*)__builtin_amdgcn_kernarg_segment_ptr();
    F.ctl = (gu32*)(F.A->ws + WS_CTL);
    for (int u = F.tid; u < (LDS_BYTES - LDSCTL_OFF) / 4; u += NWAVES * 64) ((LAS unsigned*)(F.lds + LDSCTL_OFF))[u] = 0u;
    __syncthreads();
    XcdBarrier bar; bar.bar = (unsigned*)(F.ctl + CW_BAR); bar.x = 0; bar.st = nullptr;
    if (N_LAUNCHES == 1) bar = xcd_barrier_post((unsigned*)(F.ctl + CW_BAR), F.MISC + 8);

    const int lo = F.A->ph_lo, hi = F.A->ph_hi;
    int rep_done = 0;
#pragma unroll 1
    for (int s = lo; s < hi; ++s) {
        { const __attribute__((address_space(4))) Args* ap = (const __attribute__((address_space(4))) Args*)__builtin_amdgcn_kernarg_segment_ptr(); asm volatile("" : "+s"(ap)); F.A = ap; }
        { int t_ = threadIdx.x; asm volatile("" : "+v"(t_)); F.tid = t_; F.lane = t_ & 63; F.wave = __builtin_amdgcn_readfirstlane(t_ >> 6); }
        if (s == 0) { if (PH_MASK & 1) { p_mod(F); __syncthreads(); p0_weights(F); } }
        else if (s == N_STEPS - 1) { if (PH_MASK & 2) p_final(F); }
        else {
            const int l = (s - 1) / 9, i = (s - 1) % 9;
            bf16* wl = WSH(WS_W) + (size_t)l * LAYER_W;
            const float* modl = WSF(WS_MOD) + (size_t)l * BATCH * NMODC;
            if (!((PH_MASK >> (2 + i)) & 1)) {}
            else if (i == 0) { p_normmod<true>(F, l, l == 0 ? X_IN : OUT_, NORM_MIX_W, 0, D); }
            else if (i == 2) { p_prep(F, l); }
            else if (i == 3) { p_scan(F, l); }
            else if (i == 4) { p_post(F, l); }
            else if (i == 6) { p_normmod<false>(F, l, OUT_, NORM_MLP_W, 3 * D, 4 * D); }
            else {
                pg8::Gemm g; pg8::EpiMulti E; E.l = l;
                if (i == 1) { g = pg8::Gemm{WSH(WS_H), wl, M, NPROJ, D}; E.PERM = true; E.mode = 0; }
                else if (i == 5) { g = pg8::Gemm{WSH(WS_MIX), wl + W_OUT_OFF, M, D, D}; E.PERM = false; E.mode = 3; }
                else if (i == 7) { g = pg8::Gemm{WSH(WS_H), wl + W_UP_OFF, M, FF, D}; E.PERM = true; E.mode = 2; }
                else { g = pg8::Gemm{WSH(WS_ACT), wl + W_DOWN_OFF, M, D, FF}; E.PERM = false; E.mode = 4; }
                pg8::StaticOrder S; S.init(g.M, g.N, F.G, (int)blockIdx.x);
                pg8::gemm_phase<pg8::EpiMulti, pg8::StaticOrder, PG8_ALIGN, PG8_SP2>(F.lds + RING_OFF, g, S, E);
            }
        }
        if (REP_MASK != 0 && s >= 1 && s < N_STEPS - 1 && ((REP_MASK >> ((s - 1) % 9)) & 1) && !rep_done) { rep_done = 1; --s; xcd_barrier(bar, F.tid == 0); continue; }
        rep_done = 0;
        if (s + 1 < hi) xcd_barrier(bar, F.tid == 0);
    }
}

extern "C" void kernel_launch(void* const* d_in, const int* in_sizes, int n_in, void* d_out, int out_size, void* d_ws, size_t ws_size, hipStream_t stream) {
    static int grid = 0;
    if (grid == 0) {
        if (n_in != 23 || in_sizes[0] != M * D || out_size != M * D || ws_size < WS_END) { fprintf(stderr, "kernel_launch: unexpected shapes (n_in %d, in0 %d, out %d, ws %zu); nothing launched\n", n_in, n_in > 0 ? in_sizes[0] : -1, out_size, ws_size); grid = -1; return; }
        int dev = 0, cus = 0;
        if (hipGetDevice(&dev) != hipSuccess || hipDeviceGetAttribute(&cus, hipDeviceAttributeMultiprocessorCount, dev) != hipSuccess) { grid = -1; return; }
        if (hipFuncSetAttribute((const void*)mk_fwd, hipFuncAttributeMaxDynamicSharedMemorySize, LDS_BYTES) != hipSuccess) { fprintf(stderr, "kernel_launch: hipFuncSetAttribute failed\n"); grid = -1; return; }
        (void)hipGetLastError();
        grid = cus;
    }
    if (grid < 0) return;
    if (hipMemsetAsync((char*)d_ws + WS_CTL, 0, CTL_ZERO_BYTES, stream) != hipSuccess) return;
    Args a{};
    for (int i = 0; i < 23; ++i) a.in[i] = (const float*)d_in[i];
    a.out = (float*)d_out; a.ws = (unsigned char*)d_ws;
    if (N_LAUNCHES == 1) { a.ph_lo = 0; a.ph_hi = N_STEPS; hipLaunchKernelGGL(mk_fwd, dim3(grid), dim3(NWAVES * 64), LDS_BYTES, stream, a); }
    else for (int s = 0; s < N_STEPS; ++s) { a.ph_lo = s; a.ph_hi = s + 1; hipLaunchKernelGGL(mk_fwd, dim3(grid), dim3(NWAVES * 64), LDS_BYTES, stream, a); }
}
```

```cpp
#include <hip/hip_runtime.h>
#include <cstdio>
#include <cstdint>
#include <cmath>
namespace pg8 {
#define PG8_LAS __attribute__((address_space(3)))
typedef unsigned short bf16_t;
typedef short bf16x8 __attribute__((ext_vector_type(8)));
typedef float f32x4 __attribute__((ext_vector_type(4)));
typedef unsigned u32x4 __attribute__((ext_vector_type(4)));
constexpr int BM = 256, BK = 64, HALF = 128, HTB = HALF * BK * 2  , STAGE_BYTES = 8 * HTB, NXCD = 8, WGM = 8;

__host__ __device__ __forceinline__ int lds_byte(int r, int c) { const int st = (r >> 4) * 2 + (c >> 5), rr = r & 15, cc = c & 31, ob = rr * 64 + cc * 2; return st * 1024 + (ob ^ (((ob >> 9) & 1) << 5)); }
__host__ __device__ __forceinline__ void stage_rc(int b, int& R, int& C) { const int st = b / 1024, sb = b % 1024, swz = sb ^ (((sb >> 9) & 1) << 5); R = (st >> 1) * 16 + swz / 64; C = (st & 1) * 32 + (swz % 64) / 2; }
__host__ __device__ __forceinline__ int perm32(int rho) { const int n = rho >> 4, i = rho & 15; return 8 * (i >> 2) + 4 * n + (i & 3); }

struct Unit { int pm, pn; };
struct Gemm { const bf16_t* A; const bf16_t* Bt; int M, N, K; };

struct StaticOrder {
    int nM, nN, nwg, G, c;
    __host__ __device__ void init(int M, int N, int G_, int c_) { nM = M / BM; nN = N / BM; nwg = nM * nN; G = G_; c = c_; }
    __host__ __device__ bool next(int i, Unit& u) const {
        const long L = (long)i * G + c; if (L >= nwg) return false;
        int wgid = (int)L; { const int q = nwg / NXCD, r = nwg % NXCD, xcd = wgid % NXCD, off = wgid / NXCD; wgid = (xcd < r ? xcd * (q + 1) : r * (q + 1) + (xcd - r) * q) + off; }
        const int nig = WGM * nN, gid = wgid / nig, fm = gid * WGM, gsz = (nM - fm) < WGM ? (nM - fm) : WGM;
        u.pm = fm + ((wgid % nig) % gsz); u.pn = (wgid % nig) / gsz; return true;
    }
    __device__ __forceinline__ void a_ready(const Unit&) const {}
    __device__ __forceinline__ void done(const Unit&) const {}
};

__device__ __forceinline__ unsigned cvt_pk_bf16(float lo, float hi) { unsigned r; asm volatile("v_cvt_pk_bf16_f32 %0, %1, %2" : "=v"(r) : "v"(lo), "v"(hi)); return r; }
typedef float f32x2 __attribute__((ext_vector_type(2)));
__device__ __forceinline__ f32x2 gelu_pk(f32x2 v) {
    const f32x2 av = __builtin_elementwise_abs(v), d = av * 0.2316418882f + 1.0f;
    f32x2 t; t.x = __builtin_amdgcn_rcpf(d.x); t.y = __builtin_amdgcn_rcpf(d.y);
    f32x2 q = t * 0.5307027145f + (-0.7265760135f); q = q * t + 0.7107068705f; q = q * t + (-0.142248368f); q = q * t + 0.127414796f; q = q * t;
    const f32x2 s = (v * v) * (-0.72134752044f);
    f32x2 e; e.x = __builtin_amdgcn_exp2f(s.x); e.y = __builtin_amdgcn_exp2f(s.y);
    const f32x2 m = v * (q * e), r = v - m;
    f32x2 o; o.x = v.x < 0.f ? m.x : r.x; o.y = v.y < 0.f ? m.y : r.y; return o;
}

template <int ACT  > struct EpiBf16 {
    static constexpr bool PERM = true, AFTER_DRAIN = false; static_assert(ACT == 0 || ACT == 1 || ACT == 2, "EpiBf16: ACT is 0 (none), 1 (gelu_pk) or 2 (squared relu)");
    bf16_t* O; int ldc; const float* bias; int split_cols; size_t split_stride; float scale0;
    __device__ __forceinline__ void operator()(const f32x4 (&acc)[2][2][4][2], const Unit& u, int wr, int wc, int fr, int fq) const {
        const int row0 = u.pm * BM + wr * 64 + fr; int colt = u.pn * BM; bf16_t* base = O;
        float sc = 1.f; if (split_cols) { const int t = colt / split_cols; base += (size_t)t * split_stride; colt -= t * split_cols; if (t == 0) sc = scale0; }
        const int col0 = colt + wc * 32 + 8 * fq, bcol0 = u.pn * BM + wc * 32 + 8 * fq;
        f32x4 bv[2][2];
#pragma unroll
        for (int bj = 0; bj < 2; ++bj)
#pragma unroll
            for (int n = 0; n < 2; ++n) bv[bj][n] = bias ? *(const f32x4*)(bias + bcol0 + bj * HALF + 4 * n) : (f32x4){0.f, 0.f, 0.f, 0.f};
#pragma unroll
        for (int ai = 0; ai < 2; ++ai)
#pragma unroll
            for (int m = 0; m < 4; ++m) { bf16_t* rowp = base + (size_t)(row0 + ai * HALF + m * 16) * ldc + col0;
#pragma unroll
                for (int bj = 0; bj < 2; ++bj) { f32x4 v0 = acc[ai][bj][m][0] + bv[bj][0], v1 = acc[ai][bj][m][1] + bv[bj][1];
                    if (ACT == 1) { f32x2 a = gelu_pk((f32x2){v0[0], v0[1]}), b = gelu_pk((f32x2){v0[2], v0[3]}), c = gelu_pk((f32x2){v1[0], v1[1]}), d = gelu_pk((f32x2){v1[2], v1[3]});
                        v0 = (f32x4){a.x, a.y, b.x, b.y}; v1 = (f32x4){c.x, c.y, d.x, d.y}; }
                    if (ACT == 2) { _Pragma("unroll") for (int q_ = 0; q_ < 4; ++q_) { const float a_ = fmaxf(v0[q_], 0.f), b_ = fmaxf(v1[q_], 0.f); v0[q_] = a_ * a_; v1[q_] = b_ * b_; } }
                    v0 = v0 * sc; v1 = v1 * sc; u32x4 w; w.x = cvt_pk_bf16(v0[0], v0[1]); w.y = cvt_pk_bf16(v0[2], v0[3]); w.z = cvt_pk_bf16(v1[0], v1[1]); w.w = cvt_pk_bf16(v1[2], v1[3]);
                    *(u32x4*)(rowp + bj * HALF) = w; } }
    }
};


struct EpiResid {
    static constexpr bool PERM = false, AFTER_DRAIN = false;
    const float* base; float* out; const float* gate; int ldc; int gate_stride; int rows_per_batch;
    __device__ __forceinline__ void operator()(const f32x4 (&acc)[2][2][4][2], const Unit& u, int wr, int wc, int fr, int fq) const {
        const int col0 = u.pn * BM + wc * 32 + 4 * fq;
        const float* gp = gate + (size_t)((u.pm * BM) / rows_per_batch) * gate_stride + col0;
        f32x4 gv[2][2];
#pragma unroll
        for (int bj = 0; bj < 2; ++bj)
#pragma unroll
            for (int n = 0; n < 2; ++n) gv[bj][n] = *(const f32x4*)(gp + bj * HALF + n * 16);
#pragma unroll
        for (int ai = 0; ai < 2; ++ai)
#pragma unroll
            for (int m = 0; m < 4; ++m) { const size_t off = (size_t)(u.pm * BM + ai * HALF + wr * 64 + m * 16 + fr) * ldc + col0;
#pragma unroll
                for (int bj = 0; bj < 2; ++bj)
#pragma unroll
                    for (int n = 0; n < 2; ++n) { const f32x4 bs = *(const f32x4*)(base + off + bj * HALF + n * 16);
                        *(f32x4*)(out + off + bj * HALF + n * 16) = bs + gv[bj][n] * acc[ai][bj][m][n]; } }
    }
};


struct EpiMulti {
    static constexpr bool AFTER_DRAIN = false;
    bool PERM; int mode, l;
    __device__ __forceinline__ void operator()(const f32x4 (&acc)[2][2][4][2], const Unit& u, int wr, int wc, int fr, int fq) const;
};

template <class Epi, class Sched, bool ALIGN_EPI = false, bool SP2 = false>
__device__ __forceinline__ void gemm_phase(PG8_LAS unsigned char* lds, const Gemm g, const Sched& S, const Epi& E) {
    int tid_l = threadIdx.x; asm volatile("" : "+v"(tid_l));
    const int tid = tid_l, wid = __builtin_amdgcn_readfirstlane(tid >> 6), lane = tid & 63, wr = wid >> 2, wc = wid & 3, fr = lane & 15, fq = lane >> 4;
    const int K = g.K, nt = K / BK;
    unsigned voffA[2], voffB[2];
#pragma unroll
    for (int i = 0; i < 2; ++i) { int R, C; stage_rc(tid * 16 + i * 8192, R, C); const int Rb = E.PERM ? ((R & ~31) + perm32(R & 31)) : R;
        voffA[i] = (unsigned)(R * K + C) * 2u; voffB[i] = (unsigned)(Rb * K + C) * 2u; }
    const size_t kstep = (size_t)(BK * 2);
    const size_t hstep = (size_t)HALF * K * 2;
    const size_t tstep = 2 * hstep;
    const unsigned ldsw = (unsigned)wid * 1024u;
    const int aoff = lds_byte(wr * 64 + fr, fq * 8), boff = lds_byte(wc * 32 + fr, fq * 8);
#define PG8_SA(b, h) (((b) * 2 + (h)) * HTB)
#define PG8_SB(b, h) ((4 + (b) * 2 + (h)) * HTB)
#define PG8_STAGE(bufoff, gbase, voff) do { _Pragma("unroll") for (int _i = 0; _i < 2; ++_i) \
        __builtin_amdgcn_global_load_lds((const unsigned*)((const char*)(gbase) + (voff)[_i]), (PG8_LAS unsigned*)(lds + (bufoff) + ldsw + _i * 8192), 16, 0, 0); } while (0)
#define PG8_LDA(dst, b, h) do { _Pragma("unroll") for (int m = 0; m < 4; ++m) _Pragma("unroll") for (int k = 0; k < 2; ++k) dst[m][k] = *(const PG8_LAS bf16x8*)(lds + PG8_SA(b, h) + aoff + m * 2048 + k * 1024); } while (0)
#define PG8_LDB(dst, b, h) do { _Pragma("unroll") for (int n = 0; n < 2; ++n) _Pragma("unroll") for (int k = 0; k < 2; ++k) dst[n][k] = *(const PG8_LAS bf16x8*)(lds + PG8_SB(b, h) + boff + n * 2048 + k * 1024); } while (0)
#define PG8_MMA(ai, bj, At, Bt) do { __builtin_amdgcn_s_setprio(1); _Pragma("unroll") for (int m = 0; m < 4; ++m) _Pragma("unroll") for (int n = 0; n < 2; ++n) _Pragma("unroll") for (int k = 0; k < 2; ++k) \
        acc[ai][bj][m][n] = __builtin_amdgcn_mfma_f32_16x16x32_bf16(Bt[n][k], At[m][k], acc[ai][bj][m][n], 0, 0, 0); __builtin_amdgcn_s_setprio(0); } while (0)
#define PG8_WAIT_V(n) asm volatile("s_waitcnt vmcnt(" #n ")" ::: "memory")
#define PG8_WAIT_L(n) asm volatile("s_waitcnt lgkmcnt(" #n ")" ::: "memory")
#define PG8_BAR __builtin_amdgcn_s_barrier()
#define PG8_SCHED __builtin_amdgcn_sched_barrier(0)
    Unit cur, nxt; int ui = 0;
    if (!S.next(0, cur)) return;
    f32x4 acc[2][2][4][2];
#pragma unroll
    for (int a = 0; a < 2; ++a)
#pragma unroll
        for (int b = 0; b < 2; ++b)
#pragma unroll
            for (int m = 0; m < 4; ++m)
#pragma unroll
                for (int n = 0; n < 2; ++n) acc[a][b][m][n] = (f32x4){0.f, 0.f, 0.f, 0.f};
    bf16x8 At[4][2], B0[2][2], B1[2][2];
    const char* cA = (const char*)g.A + (size_t)cur.pm * tstep; const char* cB = (const char*)g.Bt + (size_t)cur.pn * tstep;
    S.a_ready(cur);
    if constexpr (SP2) {
        PG8_STAGE(PG8_SB(0, 0), cB, voffB); PG8_STAGE(PG8_SB(0, 1), cB + hstep, voffB); PG8_STAGE(PG8_SA(0, 0), cA, voffA); PG8_STAGE(PG8_SA(0, 1), cA + hstep, voffA);
        if (wr == 1) PG8_BAR;
        PG8_WAIT_V(2); PG8_BAR;
        PG8_STAGE(PG8_SB(1, 0), cB + kstep, voffB); PG8_STAGE(PG8_SA(1, 0), cA + kstep, voffA); PG8_STAGE(PG8_SB(1, 1), cB + hstep + kstep, voffB);
        PG8_WAIT_V(6); PG8_BAR;
    } else {
        PG8_STAGE(PG8_SB(0, 0), cB, voffB); PG8_STAGE(PG8_SA(0, 0), cA, voffA); PG8_STAGE(PG8_SB(0, 1), cB + hstep, voffB); PG8_STAGE(PG8_SA(0, 1), cA + hstep, voffA);
        if (wr == 1) PG8_BAR;
        PG8_WAIT_V(4); PG8_BAR;
        PG8_STAGE(PG8_SB(1, 0), cB + kstep, voffB); PG8_STAGE(PG8_SA(1, 0), cA + kstep, voffA); PG8_STAGE(PG8_SB(1, 1), cB + hstep + kstep, voffB);
        PG8_WAIT_V(6); PG8_BAR;
    }
    for (;;) {
        const bool has_next = S.next(ui + 1, nxt);
        const char* nA = has_next ? (const char*)g.A + (size_t)nxt.pm * tstep : cA; const char* nB = has_next ? (const char*)g.Bt + (size_t)nxt.pn * tstep : cB;
        for (int t = 0; t < nt; t += 2) {
            const bool last = (t == nt - 2);
            const char* a1 = cA + (size_t)(t + 1) * kstep;
            const char* a2 = last ? nA : cA + (size_t)(t + 2) * kstep; const char* b2 = last ? nB : cB + (size_t)(t + 2) * kstep;
            const char* a3 = a2 + kstep; const char* b3 = b2 + kstep;
            if (last && has_next) S.a_ready(nxt);
            if constexpr (SP2) {
            PG8_LDB(B0, 0, 0); PG8_LDB(B1, 0, 1); PG8_SCHED; PG8_LDA(At, 0, 0); PG8_STAGE(PG8_SA(1, 1), a1 + hstep, voffA);
            PG8_WAIT_V(8); PG8_WAIT_L(0); PG8_BAR; PG8_MMA(0, 0, At, B0); PG8_MMA(0, 1, At, B1); PG8_BAR; PG8_SCHED;
            PG8_LDA(At, 0, 1); PG8_STAGE(PG8_SB(0, 0), b2, voffB); PG8_STAGE(PG8_SB(0, 1), b2 + hstep, voffB); PG8_STAGE(PG8_SA(0, 0), a2, voffA);
            PG8_WAIT_V(8); PG8_WAIT_L(0); PG8_BAR; PG8_MMA(1, 0, At, B0); PG8_MMA(1, 1, At, B1); PG8_BAR; PG8_SCHED;
            PG8_LDB(B0, 1, 0); PG8_LDB(B1, 1, 1); PG8_SCHED; PG8_LDA(At, 1, 0); PG8_STAGE(PG8_SA(0, 1), a2 + hstep, voffA);
            PG8_WAIT_V(8); PG8_WAIT_L(0); PG8_BAR; PG8_MMA(0, 0, At, B0); PG8_MMA(0, 1, At, B1); PG8_BAR; PG8_SCHED;
            PG8_LDA(At, 1, 1); PG8_STAGE(PG8_SB(1, 0), b3, voffB); PG8_STAGE(PG8_SB(1, 1), b3 + hstep, voffB); PG8_STAGE(PG8_SA(1, 0), a3, voffA);
            PG8_WAIT_V(8); PG8_WAIT_L(0); PG8_BAR; PG8_MMA(1, 0, At, B0); PG8_MMA(1, 1, At, B1); PG8_BAR; PG8_SCHED;
            } else {
            PG8_LDB(B0, 0, 0); PG8_SCHED; PG8_LDA(At, 0, 0); PG8_STAGE(PG8_SA(1, 1), a1 + hstep, voffA);
            PG8_WAIT_L(8); PG8_BAR; PG8_WAIT_L(0); PG8_MMA(0, 0, At, B0); PG8_BAR; PG8_SCHED;
            PG8_LDB(B1, 0, 1); PG8_STAGE(PG8_SB(0, 0), b2, voffB);
            PG8_BAR; PG8_WAIT_L(0); PG8_MMA(0, 1, At, B1); PG8_BAR;
            PG8_LDA(At, 0, 1); PG8_STAGE(PG8_SA(0, 0), a2, voffA);
            PG8_BAR; PG8_WAIT_L(0); PG8_MMA(1, 0, At, B0); PG8_BAR; PG8_SCHED;
            PG8_STAGE(PG8_SB(0, 1), b2 + hstep, voffB);
            PG8_WAIT_V(6); PG8_BAR; PG8_MMA(1, 1, At, B1); PG8_BAR;
            PG8_LDB(B0, 1, 0); PG8_SCHED; PG8_LDA(At, 1, 0); PG8_STAGE(PG8_SA(0, 1), a2 + hstep, voffA);
            PG8_WAIT_L(8); PG8_BAR; PG8_WAIT_L(0); PG8_MMA(0, 0, At, B0); PG8_BAR; PG8_SCHED;
            PG8_LDB(B1, 1, 1); PG8_STAGE(PG8_SB(1, 0), b3, voffB);
            PG8_BAR; PG8_WAIT_L(0); PG8_MMA(0, 1, At, B1); PG8_BAR;
            PG8_LDA(At, 1, 1); PG8_STAGE(PG8_SA(1, 0), a3, voffA);
            PG8_BAR; PG8_WAIT_L(0); PG8_MMA(1, 0, At, B0); PG8_BAR; PG8_SCHED;
            PG8_STAGE(PG8_SB(1, 1), b3 + hstep, voffB);
            PG8_WAIT_V(6); PG8_BAR; PG8_MMA(1, 1, At, B1); PG8_BAR;
            }
        }
        if constexpr (ALIGN_EPI) { if (wr == 0) PG8_BAR; }
        if constexpr (!Epi::AFTER_DRAIN) { E(acc, cur, wr, wc, fr, fq); S.done(cur); }
        if (!has_next) break;
#pragma unroll
        for (int a = 0; a < 2; ++a)
#pragma unroll
            for (int b = 0; b < 2; ++b)
#pragma unroll
                for (int m = 0; m < 4; ++m)
#pragma unroll
                    for (int n = 0; n < 2; ++n) acc[a][b][m][n] = (f32x4){0.f, 0.f, 0.f, 0.f};
        cur = nxt; cA = nA; cB = nB; ++ui;
        if constexpr (ALIGN_EPI) { if (wr == 1) PG8_BAR; }
    }
    PG8_WAIT_V(0);
    if constexpr (!ALIGN_EPI) { if (wr == 0) PG8_BAR; }
    PG8_BAR;
    if constexpr (Epi::AFTER_DRAIN) { E.fused(acc, cur, wr, wc, fr, fq, lds, wid, lane); S.done(cur); }
#undef PG8_SA
#undef PG8_SB
#undef PG8_STAGE
#undef PG8_LDA
#undef PG8_LDB
#undef PG8_MMA
#undef PG8_WAIT_V
#undef PG8_WAIT_L
#undef PG8_BAR
#undef PG8_SCHED
}
}
#define GAS __attribute__((address_space(1)))
#define LAS __attribute__((address_space(3)))
typedef unsigned short bf16;
typedef unsigned v4u __attribute__((ext_vector_type(4)));
typedef float f32x4 __attribute__((ext_vector_type(4)));
typedef short bf16x8 __attribute__((ext_vector_type(8)));
typedef GAS unsigned gu32;
typedef GAS unsigned long long gu64;
#define RLX_AGENT __ATOMIC_RELAXED, __HIP_MEMORY_SCOPE_AGENT
#define LDS_WAIT() asm volatile("s_waitcnt lgkmcnt(0)" ::: "memory")
#define VM_WAIT() asm volatile("s_waitcnt vmcnt(0)" ::: "memory")
__device__ __forceinline__ unsigned long long rt() { return __builtin_amdgcn_s_memrealtime(); }
__device__ __forceinline__ unsigned f2bf(float f) { unsigned u = __builtin_bit_cast(unsigned, f); return (u + 0x7fffu + ((u >> 16) & 1u)) >> 16; }
__device__ __forceinline__ unsigned pk2(float lo, float hi) { return f2bf(lo) | (f2bf(hi) << 16); }

#define XB_TMO      128
#define XB_XCNT(j)  (256  + 64 * (j))
#define XB_XSUB(j)  (1280 + 64 * (j))
#define XB_XGEN(j)  (2304 + 64 * (j))
#define XB_TOP      3328
#define XB_TOPGEN   3392
#define XCD_BAR_WORDS 3456
#define XB_SPIN_CAP (1u << 18)

__device__ __forceinline__ unsigned xb_ld(unsigned* p)              { return __hip_atomic_load(p, __ATOMIC_RELAXED, __HIP_MEMORY_SCOPE_AGENT); }
__device__ __forceinline__ unsigned xb_add(unsigned* p, unsigned v) { return __hip_atomic_fetch_add(p, v, __ATOMIC_RELAXED, __HIP_MEMORY_SCOPE_AGENT); }
__device__ __forceinline__ unsigned xb_xcc_id() { return (unsigned)__builtin_amdgcn_s_getreg((3 << 11) | 20) & 0xFu; }
#define XB_SPIN(cond, bar) do { unsigned _sp = 0; while (cond) { __builtin_amdgcn_s_sleep(1); \
    if ((++_sp & 255u) == 0u) { if (xb_ld(&(bar)[XB_TMO])) break; if (_sp > XB_SPIN_CAP) { atomicAdd(&(bar)[XB_TMO], 1u); break; } } } } while (0)

struct XcdBarrier {
    unsigned* bar; unsigned x;
    volatile LAS unsigned* st;
};

__device__ __forceinline__ XcdBarrier xcd_barrier_post(unsigned* bar, volatile LAS unsigned* st) {
    XcdBarrier b; b.bar = bar; b.x = xb_xcc_id(); b.st = st;
    if (threadIdx.x == 0) (void)xb_add(&bar[XB_XCNT(b.x)], 1u);
    return b;
}
__device__ __forceinline__ void xcd_barrier_complete(unsigned* bar, unsigned x, unsigned& nloc, unsigned& nx) {
    const unsigned G = gridDim.x * gridDim.y * gridDim.z;
    unsigned sum, cnt, mine, sp = 0u;
    for (;;) {
        sum = 0u; cnt = 0u; mine = 0u;
#pragma unroll
        for (unsigned j = 0; j < 16; ++j) { const unsigned c = xb_ld(&bar[XB_XCNT(j)]); sum += c; cnt += (c > 0u) ? 1u : 0u; mine = (j == x) ? c : mine; }
        if (sum == G) break;
        __builtin_amdgcn_s_sleep(1);
        if ((++sp & 255u) == 0u) { if (xb_ld(&bar[XB_TMO])) break; if (sp > XB_SPIN_CAP) { atomicAdd(&bar[XB_TMO], 1u); break; } }
    }
    nloc = mine > 0u ? mine : 1u; nx = cnt > 0u ? cnt : 1u;
}

__device__ __forceinline__ void xcd_barrier(const XcdBarrier& b, const bool t0  ) {
    asm volatile("s_waitcnt vmcnt(0)" ::: "memory");
    __syncthreads();
    if (t0) {
        unsigned* bar = b.bar;
        __builtin_amdgcn_s_waitcnt(0);
        unsigned nloc = b.st[0], nx = b.st[1];
        if (nloc == 0u) { xcd_barrier_complete(bar, b.x, nloc, nx); b.st[0] = nloc; b.st[1] = nx; }
        const unsigned old = xb_add(&bar[XB_XSUB(b.x)], 1u);
        const unsigned gen = old / nloc;
        if (old + 1u == (gen + 1u) * nloc) {
            __builtin_amdgcn_fence(__ATOMIC_RELEASE, "agent");
            asm volatile("s_waitcnt vmcnt(0)" ::: "memory");
            const unsigned og = xb_add(&bar[XB_TOP], 1u);
            const unsigned tg = og / nx;
            if (og + 1u == (tg + 1u) * nx) xb_add(&bar[XB_TOPGEN], 1u);
            else XB_SPIN(xb_ld(&bar[XB_TOPGEN]) == tg, bar);
            __builtin_amdgcn_fence(__ATOMIC_ACQUIRE, "agent");
            xb_add(&bar[XB_XGEN(b.x)], 1u);
            asm volatile("s_waitcnt vmcnt(0)" ::: "memory");
        } else {
            XB_SPIN(xb_ld(&bar[XB_XGEN(b.x)]) == gen, bar);
            __builtin_amdgcn_fence(__ATOMIC_ACQUIRE, "agent");
            asm volatile("s_waitcnt vmcnt(0)" ::: "memory");
        }
    }
    __syncthreads();
}

#ifndef PG8_SP2
#define PG8_SP2 true
#endif
#ifndef PG8_ALIGN
#define PG8_ALIGN true
#endif
constexpr int NWAVES = 8;
constexpr int N_STEPS = 38;
#ifndef MK_N_LAUNCHES
#define MK_N_LAUNCHES 1
#endif
#ifndef PH_MASK
#define PH_MASK 0xffff
#endif
#ifndef REP_MASK
#define REP_MASK 0
#endif
constexpr int N_LAUNCHES = MK_N_LAUNCHES;

constexpr int D = 1024, BATCH = 4, SEQ = 4096, DEPTH = 4, M = BATCH * SEQ;
constexpr int LRUW = 512, NGB = 8, GBW = 64, GH = 4, HD = 128, GDNW = 512, CH = 64, NCH = SEQ / CH, FF = 4096;
constexpr int NMODC = 6 * D, INC = 3080, NPROJ = 3072;
constexpr int O_LX = 0, O_LY = 512, O_Q = 1024, O_Z = 2560;
constexpr float EPS = 1e-6f;

constexpr size_t MiB = 1u << 20;
constexpr size_t WS_CTL = 0, CTL_ZERO_BYTES = 1 * MiB;
constexpr size_t WS_MOD = 1 * MiB;
constexpr size_t WS_BG = 2 * MiB;
constexpr size_t WS_AGG = 3 * MiB;
constexpr size_t WS_CARRY = 4 * MiB;
constexpr size_t WS_GL = 5 * MiB;
constexpr size_t WS_GT = 6 * MiB;
constexpr size_t WS_W = 8 * MiB;
constexpr size_t LAYER_W = (size_t)12288 * 1024;
constexpr size_t W_OUT_OFF = (size_t)3072 * 1024, W_UP_OFF = (size_t)4096 * 1024, W_DOWN_OFF = (size_t)8192 * 1024;
constexpr size_t WS_H = 104 * MiB;
constexpr size_t WS_MIX = 136 * MiB;
constexpr size_t WS_PROJ = 168 * MiB;
constexpr size_t WS_ACT = 168 * MiB;
constexpr size_t WS_GQD = 264 * MiB, WS_GKT = 280 * MiB;
constexpr size_t WS_GATT = 296 * MiB;
constexpr size_t WS_GO = 312 * MiB;
constexpr size_t WS_LRUP = 344 * MiB;
constexpr size_t WS_END = 376 * MiB;
constexpr int CW_BAR = 4096;

constexpr int RING_OFF = 0, RING_BYTES = 147456;
constexpr int LDSCTL_OFF = RING_BYTES, MISC_OFF = LDSCTL_OFF + 320;
constexpr int LDS_BYTES = 148480;

typedef unsigned v2u __attribute__((ext_vector_type(2)));
#define DI __device__ __forceinline__
DI float bf2f(unsigned b) { return __builtin_bit_cast(float, b << 16); }
DI float bflo(unsigned w) { return __builtin_bit_cast(float, w << 16); }
DI float bfhi(unsigned w) { return __builtin_bit_cast(float, w & 0xffff0000u); }
DI float sigmoidf_(float x) { return 1.f / (1.f + expf(-x)); }
DI float siluf_(float x) { return x / (1.f + expf(-x)); }
DI float gelu_tanh(float x) { const float u = 0.7978845608028654f * (x + 0.044715f * x * x * x); return 0.5f * x * (1.f + tanhf(u)); }
DI float bperm_(int src_lane, float v) { return __builtin_bit_cast(float, __builtin_amdgcn_ds_bpermute(src_lane << 2, __builtin_bit_cast(int, v))); }
DI float wave_sum_(int lane, float v) {
#pragma unroll
    for (int o = 1; o < 64; o <<= 1) v += bperm_(lane ^ o, v);
    return v;
}
DI float half_sum_(int lane, float v) {
#pragma unroll
    for (int o = 1; o < 32; o <<= 1) v += bperm_(lane ^ o, v);
    return v;
}
DI float shfl_up_(int lane, float v, int off) { return bperm_(lane >= off ? lane - off : lane, v); }

struct Args { const float* in[23]; float* out; unsigned char* ws; int ph_lo, ph_hi; };
static_assert(sizeof(Args) == 23 * 8 + 8 + 8 + 8, "Args has no padding");
struct Frame {
    LAS unsigned char* lds;
    volatile LAS unsigned* MISC;
    gu32* ctl;
    int tid, lane, wave;
    int vcu, G;
    const __attribute__((address_space(4))) Args* A;
};
#define IN_(k) (F.A->in[k])
#define X_IN IN_(0)
#define C_IN IN_(1)
#define NORM_MIX_W IN_(2)
#define NORM_MLP_W IN_(3)
#define W_MOD IN_(4)
#define B_MOD IN_(5)
#define W_IN IN_(6)
#define LRU_CONV_W IN_(7)
#define LRU_CONV_B IN_(8)
#define GATE_A_W IN_(9)
#define GATE_A_B IN_(10)
#define GATE_X_W IN_(11)
#define GATE_X_B IN_(12)
#define LRU_LAMBDA IN_(13)
#define LRU_NORM_W IN_(14)
#define GDN_CONV_W IN_(15)
#define GDN_A_LOG IN_(16)
#define GDN_DT_BIAS IN_(17)
#define GDN_NORM_W IN_(18)
#define W_OUT IN_(19)
#define W_UP IN_(20)
#define W_DOWN IN_(21)
#define FINAL_NORM_W IN_(22)
#define OUT_ (F.A->out)
#define WSF(off) ((float*)(F.A->ws + (off)))
#define WSH(off) ((bf16*)(F.A->ws + (off)))

DI void p_mod(Frame& F) {
    LAS float* cs = (LAS float*)F.lds;
    LAS float* red = cs + 4096;
    for (int i = F.tid; i < BATCH * D; i += NWAVES * 64) cs[i] = siluf_(C_IN[i]);
    __syncthreads();
    for (int item = blockIdx.x; item < DEPTH * 96; item += gridDim.x) {
        const int l = item / 96, cg = item % 96, col = cg * 64 + F.lane;
        const float* wp = W_MOD + ((size_t)l * D + F.wave * 128) * NMODC + col;
        float a0 = 0.f, a1 = 0.f, a2 = 0.f, a3 = 0.f;
#pragma unroll 8
        for (int kk = 0; kk < 128; ++kk) { const float wv = wp[(size_t)kk * NMODC]; const int k = F.wave * 128 + kk;
            a0 += cs[k] * wv; a1 += cs[1024 + k] * wv; a2 += cs[2048 + k] * wv; a3 += cs[3072 + k] * wv; }
        red[(F.wave * 4 + 0) * 64 + F.lane] = a0; red[(F.wave * 4 + 1) * 64 + F.lane] = a1; red[(F.wave * 4 + 2) * 64 + F.lane] = a2; red[(F.wave * 4 + 3) * 64 + F.lane] = a3;
        __syncthreads();
        if (F.tid < 256) { const int b = F.tid >> 6, ln = F.tid & 63; float s = 0.f;
#pragma unroll
            for (int w = 0; w < 8; ++w) s += red[(w * 4 + b) * 64 + ln];
            const int cc = cg * 64 + ln; WSF(WS_MOD)[((size_t)l * BATCH + b) * NMODC + cc] = s + B_MOD[(size_t)l * NMODC + cc]; }
        __syncthreads();
    }
}

DI void p0_transpose_item(const float* W, int K, int ldw, int N, bf16* WT, LAS float* scr, int item, int lane) {
    const int nblk = N / 32, kb = item / nblk, nb = item % nblk, k0 = 64 * kb, n0 = 32 * nb;
#pragma unroll 8
    for (int i = 0; i < 32; ++i) { const int kk = 2 * i + (lane >> 5); scr[kk * 33 + (lane & 31)] = W[(size_t)(k0 + kk) * ldw + n0 + (lane & 31)]; }
    LDS_WAIT(); asm volatile("" ::: "memory");
    const int c = lane & 7;
#pragma unroll
    for (int j = 0; j < 4; ++j) { const int n = (lane >> 3) + 8 * j; const LAS float* s = scr + (8 * c) * 33 + n;
        v4u o; o.x = pk2(s[0 * 33], s[1 * 33]); o.y = pk2(s[2 * 33], s[3 * 33]); o.z = pk2(s[4 * 33], s[5 * 33]); o.w = pk2(s[6 * 33], s[7 * 33]);
        *(v4u*)(WT + (size_t)(n0 + n) * K + k0 + 8 * c) = o; }
    LDS_WAIT(); asm volatile("" ::: "memory");
}
DI void p0_weights(Frame& F) {
    LAS float* scr = (LAS float*)(F.lds + RING_OFF + F.wave * 16384);
    const int gw = F.vcu * NWAVES + F.wave, NGW = F.G * NWAVES;
    constexpr int I_IN = (D / 64) * (NPROJ / 32), I_OUT = (D / 64) * (D / 32), I_UP = (D / 64) * (FF / 32), I_DN = (FF / 64) * (D / 32);
    constexpr int PER_LAYER = I_IN + I_OUT + I_UP + I_DN;
    for (int it = gw; it < DEPTH * PER_LAYER; it += NGW) {
        const int l = it / PER_LAYER; int r = it % PER_LAYER; bf16* wl = WSH(WS_W) + (size_t)l * LAYER_W;
        if (r < I_IN) { p0_transpose_item(W_IN + (size_t)l * D * INC, D, INC, NPROJ, wl, scr, r, F.lane); continue; } r -= I_IN;
        if (r < I_OUT) { p0_transpose_item(W_OUT + (size_t)l * D * D, D, D, D, wl + W_OUT_OFF, scr, r, F.lane); continue; } r -= I_OUT;
        if (r < I_UP) { p0_transpose_item(W_UP + (size_t)l * D * FF, D, FF, FF, wl + W_UP_OFF, scr, r, F.lane); continue; } r -= I_UP;
        p0_transpose_item(W_DOWN + (size_t)l * FF * D, FF, D, D, wl + W_DOWN_OFF, scr, r, F.lane);
    }
    for (int o = (int)blockIdx.x * NWAVES * 64 + F.tid; o < DEPTH * 2 * NGB * 4096; o += (int)gridDim.x * NWAVES * 64) {
        const int i = o & 63, j = (o >> 6) & 63, g = (o >> 12) & 7, gate = (o >> 15) & 1, l = o >> 16;
        const float* src = gate ? GATE_X_W : GATE_A_W;
        WSH(WS_GT)[o] = (bf16)f2bf(src[(size_t)(l * NGB + g) * 4096 + i * 64 + j]);
    }
}

template <bool WITH_BG>
DI void p_normmod(Frame& F, int l, const float* xin, const float* normw, int off_sh, int off_sc) {
    LAS float* w8 = (LAS float*)F.lds;
    if (WITH_BG) {
        for (int i = F.tid; i < D * 8; i += NWAVES * 64) w8[i] = W_IN[((size_t)l * D + (i >> 3)) * INC + NPROJ + (i & 7)];
        __syncthreads();
    }
    const int gw = F.vcu * NWAVES + F.wave, NGW = F.G * NWAVES;
    for (int m = gw; m < M; m += NGW) {
        const int b = m >> 12;
        const float* modp = WSF(WS_MOD) + ((size_t)l * BATCH + b) * NMODC;
        f32x4 v[4]; float ss = 0.f;
#pragma unroll
        for (int j = 0; j < 4; ++j) { v[j] = *(const f32x4*)(xin + (size_t)m * D + 4 * F.lane + 256 * j); ss += (v[j].x * v[j].x + v[j].y * v[j].y) + (v[j].z * v[j].z + v[j].w * v[j].w); }
        ss = wave_sum_(F.lane, ss);
        const float rstd = 1.0f / sqrtf(ss * (1.0f / D) + EPS);
        float a0 = 0.f, a1 = 0.f, a2 = 0.f, a3 = 0.f, a4 = 0.f, a5 = 0.f, a6 = 0.f, a7 = 0.f;
#pragma unroll
        for (int j = 0; j < 4; ++j) {
            const int col = 4 * F.lane + 256 * j;
            const f32x4 nw = *(const f32x4*)(normw + (size_t)l * D + col), sc = *(const f32x4*)(modp + off_sc + col), sh = *(const f32x4*)(modp + off_sh + col);
            const f32x4 hv = v[j] * rstd * nw * (sc + 1.0f) + sh;
            v2u o; o.x = pk2(hv.x, hv.y); o.y = pk2(hv.z, hv.w);
            *(v2u*)(WSH(WS_H) + (size_t)m * D + col) = o;
            if (WITH_BG) {
#pragma unroll
                for (int e = 0; e < 4; ++e) { const f32x4 wa = *(const LAS f32x4*)(w8 + (col + e) * 8), wb = *(const LAS f32x4*)(w8 + (col + e) * 8 + 4); const float hh = hv[e];
                    a0 += hh * wa.x; a1 += hh * wa.y; a2 += hh * wa.z; a3 += hh * wa.w; a4 += hh * wb.x; a5 += hh * wb.y; a6 += hh * wb.z; a7 += hh * wb.w; }
            }
        }
        if (WITH_BG) {
            a0 = wave_sum_(F.lane, a0); a1 = wave_sum_(F.lane, a1); a2 = wave_sum_(F.lane, a2); a3 = wave_sum_(F.lane, a3); a4 = wave_sum_(F.lane, a4); a5 = wave_sum_(F.lane, a5); a6 = wave_sum_(F.lane, a6); a7 = wave_sum_(F.lane, a7);
            if (F.lane < 4) {
                const int hh = F.lane;
                const float bpre = hh == 0 ? a0 : hh == 1 ? a1 : hh == 2 ? a2 : a3;
                const float apre = hh == 0 ? a4 : hh == 1 ? a5 : hh == 2 ? a6 : a7;
                const float xx = apre + GDN_DT_BIAS[l * GH + hh];
                const float sp = xx > 20.f ? xx : log1pf(expf(xx));
                WSF(WS_BG)[(size_t)m * 8 + hh] = sigmoidf_(bpre);
                WSF(WS_BG)[(size_t)m * 8 + 4 + hh] = -expf(GDN_A_LOG[l * GH + hh]) * sp;
            }
        }
    }
}

typedef float f32x2_t __attribute__((ext_vector_type(2))); typedef __bf16 bf16x2_t __attribute__((ext_vector_type(2)));
DI unsigned cvtpk(float lo, float hi) { f32x2_t v = {lo, hi}; bf16x2_t b = __builtin_convertvector(v, bf16x2_t); return __builtin_bit_cast(unsigned, b); }
DI bf16x8 pack8(f32x4 a, f32x4 b) { v4u p; p.x = cvtpk(a.x, a.y); p.y = cvtpk(a.z, a.w); p.z = cvtpk(b.x, b.y); p.w = cvtpk(b.z, b.w); return __builtin_bit_cast(bf16x8, p); }
DI bf16x8 ldfrag(const LAS unsigned char* p) { const v2u lo = *(const LAS v2u*)p, hi = *(const LAS v2u*)(p + 32); v4u r; r.x = lo.x; r.y = lo.y; r.z = hi.x; r.w = hi.y; return __builtin_bit_cast(bf16x8, r); }
#define MFMA16(a, b, c) __builtin_amdgcn_mfma_f32_16x16x32_bf16((a), (b), (c), 0, 0, 0)

DI bf16x8 ld128(const LAS unsigned char* p) { return *(const LAS bf16x8*)p; }
constexpr int PG_QB = 0, PG_KB = 17408, PG_KBET = 34816, PG_VT = 53248, PG_LS = 71680, PG_TS = 89088, PG_TB = 106496, PG_ATT = 115712, PG_XS = 124928, PG_SM = 128000, PG_END = 129024;
static_assert(PG_END <= RING_BYTES, "prep LDS map");
DI void p_prep(Frame& F, int l) {
    const int wave = F.wave;
#define PREP_IDS int tid_ = F.tid; asm volatile("" : "+v"(tid_)); const int tid = tid_, lane = tid & 63, m = lane & 15, q = lane >> 4; (void)m; (void)q;
    for (int item = blockIdx.x; item < BATCH * NCH; item += gridDim.x) {
        const int b = item / NCH, n = item % NCH, row0 = b * SEQ + n * CH, t0 = n * CH;
        {
            LAS float* xr = (LAS float*)F.lds;
            LAS unsigned char* xrb = F.lds + 17408;
            LAS float* sa = (LAS float*)(F.lds + 26624);
            LAS float* sb = (LAS float*)(F.lds + 43264);
            for (int g = 0; g < NGB; ++g) {
                PREP_IDS
                {
                    const int t = tid >> 3, c0 = (tid & 7) * 8, cc0 = g * 64 + c0;
                    f32x4 a0 = *(const f32x4*)(LRU_CONV_B + l * LRUW + cc0), a1 = *(const f32x4*)(LRU_CONV_B + l * LRUW + cc0 + 4);
#pragma unroll
                    for (int k = 0; k < 4; ++k) { const int tt = t0 + t - 3 + k;
                        if (tt >= 0) { const v4u xw = *(const v4u*)(WSH(WS_PROJ) + (size_t)(b * SEQ + tt) * NPROJ + O_LX + cc0);
                            const f32x4 w0 = *(const f32x4*)(LRU_CONV_W + ((size_t)l * 4 + k) * LRUW + cc0), w1 = *(const f32x4*)(LRU_CONV_W + ((size_t)l * 4 + k) * LRUW + cc0 + 4);
                            a0 += w0 * (f32x4){bflo(xw.x), bfhi(xw.x), bflo(xw.y), bfhi(xw.y)}; a1 += w1 * (f32x4){bflo(xw.z), bfhi(xw.z), bflo(xw.w), bfhi(xw.w)}; } }
                    *(LAS f32x4*)(xr + t * 68 + c0) = a0; *(LAS f32x4*)(xr + t * 68 + c0 + 4) = a1;
                    v4u pk; pk.x = cvtpk(a0.x, a0.y); pk.y = cvtpk(a0.z, a0.w); pk.z = cvtpk(a1.x, a1.y); pk.w = cvtpk(a1.z, a1.w);
                    *(LAS v4u*)(xrb + t * 144 + c0 * 2) = pk;
                }
                __syncthreads();
                {
                    const int mt = wave >> 1;
                    const bf16x8 A0 = ld128(xrb + (16 * mt + m) * 144 + (8 * q) * 2), A1 = ld128(xrb + (16 * mt + m) * 144 + (32 + 8 * q) * 2);
#pragma unroll
                    for (int jj = 0; jj < 2; ++jj) { const int nt = (wave & 1) * 2 + jj, j = 16 * nt + m, cc = g * 64 + j;
                        const bf16* ga = WSH(WS_GT) + ((size_t)((l * 2 + 0) * NGB + g)) * 4096 + (size_t)j * 64 + 8 * q;
                        const bf16* gx = WSH(WS_GT) + ((size_t)((l * 2 + 1) * NGB + g)) * 4096 + (size_t)j * 64 + 8 * q;
                        f32x4 ra = (f32x4){0.f, 0.f, 0.f, 0.f}, ia = (f32x4){0.f, 0.f, 0.f, 0.f};
                        ra = MFMA16(A0, *(const bf16x8*)ga, ra); ra = MFMA16(A1, *(const bf16x8*)(ga + 32), ra);
                        ia = MFMA16(A0, *(const bf16x8*)gx, ia); ia = MFMA16(A1, *(const bf16x8*)(gx + 32), ia);
                        const float lam = LRU_LAMBDA[l * LRUW + cc];
                        const float logsig = -(fmaxf(-lam, 0.f) + log1pf(expf(-fabsf(lam))));
                        const float ba = GATE_A_B[l * LRUW + cc], bx = GATE_X_B[l * LRUW + cc];
#pragma unroll
                        for (int r = 0; r < 4; ++r) { const int t = 16 * mt + 4 * q + r;
                            const float rr = sigmoidf_(ra[r] + ba), ig = sigmoidf_(ia[r] + bx);
                            const float log_a = 8.0f * rr * logsig, a = expf(log_a), mult = sqrtf(fmaxf(-expm1f(2.0f * log_a), 1e-12f));
                            sa[t * 65 + j] = a; sb[t * 65 + j] = mult * (ig * xr[t * 68 + j]); } }
                }
                __syncthreads();
#pragma unroll 1
                for (int qq = 0; qq < 8; ++qq) { const int c = wave * 8 + qq;
                    float A = sa[lane * 65 + c], B = sb[lane * 65 + c];
#pragma unroll
                    for (int off = 1; off < 64; off <<= 1) { const float Ap = shfl_up_(lane, A, off), Bp = shfl_up_(lane, B, off); if (lane >= off) { B = A * Bp + B; A = A * Ap; } }
                    sa[lane * 65 + c] = A; sb[lane * 65 + c] = B;
                    if (lane == 63) { WSF(WS_AGG)[((size_t)(b * NCH + n)) * LRUW + g * 64 + c] = A; WSF(WS_AGG)[(size_t)BATCH * NCH * LRUW + ((size_t)(b * NCH + n)) * LRUW + g * 64 + c] = B; } }
                __syncthreads();
#pragma unroll
                for (int e = 0; e < 8; ++e) { const int idx = tid + 512 * e, t = idx >> 6, c = idx & 63;
                    WSF(WS_H)[(size_t)(row0 + t) * LRUW + g * 64 + c] = sb[t * 65 + c]; WSF(WS_LRUP)[(size_t)(row0 + t) * LRUW + g * 64 + c] = sa[t * 65 + c]; }
                __syncthreads();
            }
        }
        {
            LAS unsigned char* qb = F.lds + PG_QB;
            LAS unsigned char* kb = F.lds + PG_KB;
            LAS unsigned char* kbeT = F.lds + PG_KBET;
            LAS unsigned char* vT = F.lds + PG_VT;
            LAS float* Ls = (LAS float*)(F.lds + PG_LS);
            LAS float* Ts = (LAS float*)(F.lds + PG_TS);
            LAS unsigned char* Tb = F.lds + PG_TB;
            LAS unsigned char* atts = F.lds + PG_ATT;
            LAS float* Xs = (LAS float*)(F.lds + PG_XS);
            LAS float* sgc = (LAS float*)(F.lds + PG_SM);
            LAS float* sbeta = sgc + 64, *seg = sgc + 128, *sel = sgc + 192;
            for (int h = 0; h < GH; ++h) {
                PREP_IDS
                const size_t item4 = (size_t)(b * GH + h) * NCH + n;
                if (wave == 0) { float gcv = WSF(WS_BG)[(size_t)(row0 + lane) * 8 + 4 + h];
#pragma unroll
                    for (int off = 1; off < 64; off <<= 1) { const float pv = shfl_up_(lane, gcv, off); if (lane >= off) gcv += pv; }
                    const float glast = bperm_(63, gcv);
                    sgc[lane] = gcv; sbeta[lane] = WSF(WS_BG)[(size_t)(row0 + lane) * 8 + h]; seg[lane] = expf(gcv); sel[lane] = expf(glast - gcv); }
                __syncthreads();
                if (tid < 384) {
                    const int cgp = tid & 15, wt = tid >> 4, which = wt >> 3, tr = wt & 7, d0 = cgp * 8, ch0 = which * GDNW + h * HD + d0;
                    v4u xp[11];
#pragma unroll
                    for (int i = 0; i < 11; ++i) { const int tt = t0 + tr * 8 - 3 + i;
                        xp[i] = (tt >= 0) ? *(const v4u*)(WSH(WS_PROJ) + (size_t)(b * SEQ + tt) * NPROJ + O_Q + ch0) : (v4u){0u, 0u, 0u, 0u}; }
                    f32x4 wl_[4], wh_[4];
#pragma unroll
                    for (int k = 0; k < 4; ++k) { wl_[k] = *(const f32x4*)(GDN_CONV_W + ((size_t)l * 4 + k) * (3 * GDNW) + ch0); wh_[k] = *(const f32x4*)(GDN_CONV_W + ((size_t)l * 4 + k) * (3 * GDNW) + ch0 + 4); }
                    f32x4 ol[8], oh[8]; float ss[8];
#pragma unroll
                    for (int tt = 0; tt < 8; ++tt) { f32x4 al = (f32x4){0.f, 0.f, 0.f, 0.f}, ah = (f32x4){0.f, 0.f, 0.f, 0.f};
#pragma unroll
                        for (int k = 0; k < 4; ++k) { const v4u xw = xp[tt + k];
                            al += wl_[k] * (f32x4){bflo(xw.x), bfhi(xw.x), bflo(xw.y), bfhi(xw.y)}; ah += wh_[k] * (f32x4){bflo(xw.z), bfhi(xw.z), bflo(xw.w), bfhi(xw.w)}; }
#pragma unroll
                        for (int c = 0; c < 4; ++c) { al[c] = siluf_(al[c]); ah[c] = siluf_(ah[c]); }
                        ol[tt] = al; oh[tt] = ah;
                        ss[tt] = (al.x * al.x + al.y * al.y) + (al.z * al.z + al.w * al.w) + (ah.x * ah.x + ah.y * ah.y) + (ah.z * ah.z + ah.w * ah.w); }
                    if (which < 2) {
#pragma unroll
                        for (int tt = 0; tt < 8; ++tt) { float v = ss[tt]; v += bperm_(lane ^ 1, v); v += bperm_(lane ^ 2, v); v += bperm_(lane ^ 4, v); v += bperm_(lane ^ 8, v);
                            const float scl = (1.0f / sqrtf(v + 1e-6f)) * (which == 0 ? 0.08838834764831845f : 1.0f); ol[tt] = ol[tt] * scl; oh[tt] = oh[tt] * scl; }
                    }
                    const int tb = tr * 8;
                    if (which == 0) {
#pragma unroll
                        for (int tt = 0; tt < 8; ++tt) { const int t = tb + tt; const float eg = seg[t];
                            v4u pk; pk.x = cvtpk(ol[tt].x, ol[tt].y); pk.y = cvtpk(ol[tt].z, ol[tt].w); pk.z = cvtpk(oh[tt].x, oh[tt].y); pk.w = cvtpk(oh[tt].z, oh[tt].w);
                            *(LAS v4u*)(qb + t * 272 + d0 * 2) = pk;
                            v4u pg; pg.x = cvtpk(ol[tt].x * eg, ol[tt].y * eg); pg.y = cvtpk(ol[tt].z * eg, ol[tt].w * eg); pg.z = cvtpk(oh[tt].x * eg, oh[tt].y * eg); pg.w = cvtpk(oh[tt].z * eg, oh[tt].w * eg);
                            *(v4u*)(WSH(WS_GQD) + item4 * 8192 + t * 128 + d0) = pg; }
                    } else if (which == 1) {
                        float fb[8], fl[8];
#pragma unroll
                        for (int tt = 0; tt < 8; ++tt) { const int t = tb + tt; fb[tt] = sbeta[t] * seg[t]; fl[tt] = sel[t];
                            v4u pk; pk.x = cvtpk(ol[tt].x, ol[tt].y); pk.y = cvtpk(ol[tt].z, ol[tt].w); pk.z = cvtpk(oh[tt].x, oh[tt].y); pk.w = cvtpk(oh[tt].z, oh[tt].w);
                            *(LAS v4u*)(kb + t * 272 + d0 * 2) = pk; }
#pragma unroll
                        for (int c = 0; c < 8; ++c) {
#define KV_(tt) ((c) < 4 ? ol[tt][(c) & 3] : oh[tt][(c) & 3])
                            v4u pe; pe.x = cvtpk(KV_(0) * fb[0], KV_(1) * fb[1]); pe.y = cvtpk(KV_(2) * fb[2], KV_(3) * fb[3]); pe.z = cvtpk(KV_(4) * fb[4], KV_(5) * fb[5]); pe.w = cvtpk(KV_(6) * fb[6], KV_(7) * fb[7]);
                            *(LAS v4u*)(kbeT + (d0 + c) * 144 + tb * 2) = pe;
                            v4u pt; pt.x = cvtpk(KV_(0) * fl[0], KV_(1) * fl[1]); pt.y = cvtpk(KV_(2) * fl[2], KV_(3) * fl[3]); pt.z = cvtpk(KV_(4) * fl[4], KV_(5) * fl[5]); pt.w = cvtpk(KV_(6) * fl[6], KV_(7) * fl[7]);
                            *(v4u*)(WSH(WS_GKT) + item4 * 8192 + (d0 + c) * 64 + tb) = pt; }
                    } else {
                        float fb[8];
#pragma unroll
                        for (int tt = 0; tt < 8; ++tt) fb[tt] = sbeta[tb + tt];
#pragma unroll
                        for (int c = 0; c < 8; ++c) {
                            v4u pe; pe.x = cvtpk(KV_(0) * fb[0], KV_(1) * fb[1]); pe.y = cvtpk(KV_(2) * fb[2], KV_(3) * fb[3]); pe.z = cvtpk(KV_(4) * fb[4], KV_(5) * fb[5]); pe.w = cvtpk(KV_(6) * fb[6], KV_(7) * fb[7]);
                            *(LAS v4u*)(vT + (d0 + c) * 144 + tb * 2) = pe; }
#undef KV_
                    }
                }
                __syncthreads();
                {
                    const int it = wave >> 1;
#pragma unroll
                    for (int jj = 0; jj < 2; ++jj) { const int jt = (wave & 1) * 2 + jj;
                        f32x4 kk = (f32x4){0.f, 0.f, 0.f, 0.f}, qk = (f32x4){0.f, 0.f, 0.f, 0.f};
                        if (jt <= it) {
#pragma unroll
                            for (int ks = 0; ks < 4; ++ks) { const bf16x8 Bk = ld128(kb + (16 * jt + m) * 272 + (32 * ks + 8 * q) * 2);
                                kk = MFMA16(ld128(kb + (16 * it + m) * 272 + (32 * ks + 8 * q) * 2), Bk, kk); qk = MFMA16(ld128(qb + (16 * it + m) * 272 + (32 * ks + 8 * q) * 2), Bk, qk); } }
                        const int j = 16 * jt + m; const float gj = sgc[j];
#pragma unroll
                        for (int r = 0; r < 4; ++r) { const int i = 16 * it + 4 * q + r;
                            const float dec = (j <= i) ? expf(sgc[i] - gj) : 0.f;
                            Ls[i * 68 + j] = (j < i) ? sbeta[i] * kk[r] * dec : 0.f;
                            *(LAS unsigned short*)(atts + i * 144 + j * 2) = (unsigned short)f2bf((j <= i) ? qk[r] * dec : 0.f); } }
                }
                __syncthreads();
                if (tid < 64) { const int bk = tid >> 4, c = tid & 15; float x[16];
#pragma unroll
                    for (int r = 0; r < 16; ++r) { float acc = (r == c) ? 1.f : 0.f;
#pragma unroll
                        for (int mm = 0; mm < r; ++mm) acc -= Ls[(16 * bk + r) * 68 + 16 * bk + mm] * x[mm];
                        x[r] = acc; Ts[(16 * bk + r) * 68 + 16 * bk + c] = acc; } }
                __syncthreads();
#pragma unroll 1
                for (int dl = 1; dl < 4; ++dl) {
                    const int nout = (4 - dl) * 256;
                    for (int idx = tid; idx < nout; idx += NWAVES * 64) { const int blk = idx >> 8, r = (idx >> 4) & 15, c = idx & 15, i = blk + dl, j = blk; float acc = 0.f;
                        for (int mm = 16 * j; mm < 16 * i; ++mm) acc += Ls[(16 * i + r) * 68 + mm] * Ts[mm * 68 + 16 * j + c];
                        Xs[idx] = acc; }
                    __syncthreads();
                    for (int idx = tid; idx < nout; idx += NWAVES * 64) { const int blk = idx >> 8, r = (idx >> 4) & 15, c = idx & 15, i = blk + dl, j = blk; float acc = 0.f;
#pragma unroll
                        for (int mm = 0; mm < 16; ++mm) acc -= Ts[(16 * i + r) * 68 + 16 * i + mm] * Xs[blk * 256 + mm * 16 + c];
                        Ts[(16 * i + r) * 68 + 16 * j + c] = acc; }
                    __syncthreads();
                }
#pragma unroll
                for (int e = 0; e < 8; ++e) { const int idx = tid + 512 * e, i = idx >> 6, j = idx & 63;
                    *(LAS unsigned short*)(Tb + i * 144 + j * 2) = (unsigned short)(((j >> 4) <= (i >> 4)) ? f2bf(Ts[i * 68 + j]) : 0u); }
                __syncthreads();
                {
                    const int nt = wave;
#pragma unroll
                    for (int mt = 0; mt < 4; ++mt) { f32x4 ua = (f32x4){0.f, 0.f, 0.f, 0.f}, wa = (f32x4){0.f, 0.f, 0.f, 0.f};
#pragma unroll
                        for (int ks = 0; ks < 2; ++ks) if (32 * ks <= 16 * mt + 15) { const bf16x8 A = ld128(Tb + (16 * mt + m) * 144 + (32 * ks + 8 * q) * 2);
                            ua = MFMA16(A, ld128(vT + (16 * nt + m) * 144 + (32 * ks + 8 * q) * 2), ua); wa = MFMA16(A, ld128(kbeT + (16 * nt + m) * 144 + (32 * ks + 8 * q) * 2), wa); }
#pragma unroll
                        for (int r = 0; r < 4; ++r) { const int t = 16 * mt + 4 * q + r, d = 16 * nt + m;
                            *(LAS unsigned short*)(qb + t * 272 + d * 2) = (unsigned short)f2bf(ua[r]); *(LAS unsigned short*)(kb + t * 272 + d * 2) = (unsigned short)f2bf(-wa[r]); } }
                }
                __syncthreads();
#pragma unroll
                for (int e = 0; e < 2; ++e) { const int p = tid + 512 * e, row = p >> 4, c16 = p & 15;
                    *(v4u*)((unsigned char*)(WSH(WS_MIX) + item4 * 8192) + row * 256 + c16 * 16) = *(const LAS v4u*)(qb + row * 272 + c16 * 16);
                    *(v4u*)((unsigned char*)(WSH(WS_MIX + 16 * MiB) + item4 * 8192) + row * 256 + c16 * 16) = *(const LAS v4u*)(kb + row * 272 + c16 * 16); }
                { const int row = tid >> 3, c16 = tid & 7;
                    *(v4u*)((unsigned char*)(WSH(WS_GATT) + item4 * 4096) + row * 128 + c16 * 16) = *(const LAS v4u*)(atts + row * 144 + c16 * 16); }
                if (tid == 0) WSF(WS_GL)[item4] = seg[63];
                __syncthreads();
            }
        }
    }
}

#undef PREP_IDS
constexpr int SC_W = 0, SC_QD = 17408, SC_KT = 34816, SC_AT = 53248, SC_U = 62464, SC_STAGE = 71680;
static_assert(2 * SC_STAGE <= RING_BYTES, "scan stages fit the ring");
DI void p_scan(Frame& F, int l) {
    const int tid = F.tid, lane = F.lane, wave = F.wave;
    for (int p = blockIdx.x * NWAVES + wave; p < BATCH * LRUW; p += gridDim.x * NWAVES) { const int b = p / LRUW, c = p % LRUW;
        float A = WSF(WS_AGG)[((size_t)(b * NCH + lane)) * LRUW + c], B = WSF(WS_AGG)[(size_t)BATCH * NCH * LRUW + ((size_t)(b * NCH + lane)) * LRUW + c];
#pragma unroll
        for (int off = 1; off < 64; off <<= 1) { const float Ap = shfl_up_(F.lane, A, off), Bp = shfl_up_(F.lane, B, off); if (lane >= off) { B = A * Bp + B; A = A * Ap; } }
        if (lane < 63) WSF(WS_CARRY)[((size_t)(b * NCH + lane + 1)) * LRUW + c] = B; else WSF(WS_CARRY)[((size_t)(b * NCH)) * LRUW + c] = 0.f; }
    const bool is_loader = wave >= 4;
    const int wv = wave & 3, m = lane & 15, q = lane >> 4, lt = tid & 255;
    for (int item = blockIdx.x; item < BATCH * GH * 2; item += gridDim.x) {
        const int bh = item >> 1, dvbase = (item & 1) * 64, b = bh >> 2, h = bh & 3;
        const size_t it0 = (size_t)bh * NCH;
        const unsigned char* gW = (const unsigned char*)(WSH(WS_MIX + 16 * MiB) + it0 * 8192);
        const unsigned char* gQD = (const unsigned char*)(WSH(WS_GQD) + it0 * 8192);
        const unsigned char* gKT = (const unsigned char*)(WSH(WS_GKT) + it0 * 8192);
        const unsigned char* gAT = (const unsigned char*)(WSH(WS_GATT) + it0 * 4096);
        const unsigned char* gU = (const unsigned char*)(WSH(WS_MIX) + it0 * 8192) + dvbase * 2;
#define SC_LOAD(n_) do { const size_t cb = (size_t)(n_) * 16384, ca = (size_t)(n_) * 8192; \
            _Pragma("unroll") for (int i = 0; i < 4; ++i) { const int p = lt + 256 * i; rg[i] = *(const v4u*)(gW + cb + (p >> 4) * 256 + (p & 15) * 16); rg[4 + i] = *(const v4u*)(gQD + cb + (p >> 4) * 256 + (p & 15) * 16); \
                rg[8 + i] = *(const v4u*)(gKT + cb + (p >> 3) * 128 + (p & 7) * 16); } \
            _Pragma("unroll") for (int i = 0; i < 2; ++i) { const int p = lt + 256 * i; rg[12 + i] = *(const v4u*)(gAT + ca + (p >> 3) * 128 + (p & 7) * 16); rg[14 + i] = *(const v4u*)(gU + cb + (p >> 3) * 256 + (p & 7) * 16); } } while (0)
#define SC_WRITE(buf_) do { LAS unsigned char* sb_ = F.lds + (buf_) * SC_STAGE; \
            _Pragma("unroll") for (int i = 0; i < 4; ++i) { const int p = lt + 256 * i; *(LAS v4u*)(sb_ + SC_W + (p >> 4) * 272 + (p & 15) * 16) = rg[i]; *(LAS v4u*)(sb_ + SC_QD + (p >> 4) * 272 + (p & 15) * 16) = rg[4 + i]; \
                *(LAS v4u*)(sb_ + SC_KT + (p >> 3) * 144 + (p & 7) * 16) = rg[8 + i]; } \
            _Pragma("unroll") for (int i = 0; i < 2; ++i) { const int p = lt + 256 * i; *(LAS v4u*)(sb_ + SC_AT + (p >> 3) * 144 + (p & 7) * 16) = rg[12 + i]; *(LAS v4u*)(sb_ + SC_U + (p >> 3) * 144 + (p & 7) * 16) = rg[14 + i]; } } while (0)
        if (is_loader) {
            v4u rg[16];
            SC_LOAD(0); SC_WRITE(0); SC_LOAD(1);
            __syncthreads();
#pragma unroll 1
            for (int n = 0; n < NCH; ++n) {
                if (n + 1 < NCH) SC_WRITE((n + 1) & 1);
                if (n + 2 < NCH) SC_LOAD(n + 2);
                __syncthreads();
            }
        } else {
            f32x4 Sacc[8];
#pragma unroll
            for (int dt = 0; dt < 8; ++dt) Sacc[dt] = (f32x4){0.f, 0.f, 0.f, 0.f};
            const float glv = WSF(WS_GL)[it0 + lane];
            __syncthreads();
#pragma unroll 1
            for (int n = 0; n < NCH; ++n) {
                const LAS unsigned char* B = F.lds + (n & 1) * SC_STAGE;
                bf16x8 Sb[4];
#pragma unroll
                for (int kb = 0; kb < 4; ++kb) Sb[kb] = pack8(Sacc[2 * kb], Sacc[2 * kb + 1]);
                f32x4 vn[4], o[4];
#pragma unroll
                for (int mt = 0; mt < 4; ++mt) { o[mt] = (f32x4){0.f, 0.f, 0.f, 0.f};
#pragma unroll
                    for (int r = 0; r < 4; ++r) vn[mt][r] = bf2f(*(const LAS unsigned short*)(B + SC_U + (16 * mt + 4 * q + r) * 144 + (16 * wv + m) * 2)); }
#pragma unroll
                for (int mt = 0; mt < 4; ++mt)
#pragma unroll
                    for (int kb = 0; kb < 4; ++kb) {
                        vn[mt] = MFMA16(ldfrag(B + SC_W + (16 * mt + m) * 272 + (32 * kb + 4 * q) * 2), Sb[kb], vn[mt]);
                        o[mt] = MFMA16(ldfrag(B + SC_QD + (16 * mt + m) * 272 + (32 * kb + 4 * q) * 2), Sb[kb], o[mt]); }
                bf16x8 vnb[2];
                vnb[0] = pack8(vn[0], vn[1]); vnb[1] = pack8(vn[2], vn[3]);
#pragma unroll
                for (int mt = 0; mt < 4; ++mt)
#pragma unroll
                    for (int kb2 = 0; kb2 < 2; ++kb2) if (32 * kb2 <= 16 * mt + 15) o[mt] = MFMA16(ldfrag(B + SC_AT + (16 * mt + m) * 144 + (32 * kb2 + 4 * q) * 2), vnb[kb2], o[mt]);
                const float gl = __builtin_bit_cast(float, __builtin_amdgcn_readlane(__builtin_bit_cast(int, glv), n));
#pragma unroll
                for (int dt = 0; dt < 8; ++dt) { Sacc[dt] = Sacc[dt] * gl;
#pragma unroll
                    for (int kb2 = 0; kb2 < 2; ++kb2) Sacc[dt] = MFMA16(ldfrag(B + SC_KT + (16 * dt + m) * 144 + (32 * kb2 + 4 * q) * 2), vnb[kb2], Sacc[dt]); }
                float* go = WSF(WS_GO) + (size_t)(b * SEQ + n * CH + 4 * q) * GDNW + h * HD + dvbase + 16 * wv + m;
#pragma unroll
                for (int mt = 0; mt < 4; ++mt)
#pragma unroll
                    for (int r = 0; r < 4; ++r) go[(size_t)(16 * mt + r) * GDNW] = o[mt][r];
                __syncthreads();
            }
        }
#undef SC_LOAD
#undef SC_WRITE
    }
}

DI void p_post(Frame& F, int l) {
    const int gw = F.vcu * NWAVES + F.wave, NGW = F.G * NWAVES, lane = F.lane;
    for (int m = gw; m < M; m += NGW) {
        const int b = m >> 12, n = (m & (SEQ - 1)) >> 6;
        f32x4 val[2]; float ss = 0.f;
#pragma unroll
        for (int j = 0; j < 2; ++j) { const int c = 4 * lane + 256 * j;
            const f32x4 hl = *(const f32x4*)(WSF(WS_H) + (size_t)m * LRUW + c), p = *(const f32x4*)(WSF(WS_LRUP) + (size_t)m * LRUW + c), cr = *(const f32x4*)(WSF(WS_CARRY) + ((size_t)(b * NCH + n)) * LRUW + c);
            const v2u y2 = *(const v2u*)(WSH(WS_PROJ) + (size_t)m * NPROJ + O_LY + c);
            const f32x4 hh = hl + p * cr;
            val[j] = (f32x4){hh.x * gelu_tanh(bflo(y2.x)), hh.y * gelu_tanh(bfhi(y2.x)), hh.z * gelu_tanh(bflo(y2.y)), hh.w * gelu_tanh(bfhi(y2.y))};
            ss += (val[j].x * val[j].x + val[j].y * val[j].y) + (val[j].z * val[j].z + val[j].w * val[j].w); }
        ss = wave_sum_(F.lane, ss);
        const float rl = 1.0f / sqrtf(ss * (1.0f / LRUW) + EPS);
#pragma unroll
        for (int j = 0; j < 2; ++j) { const int c = 4 * lane + 256 * j; const f32x4 nw = *(const f32x4*)(LRU_NORM_W + (size_t)l * LRUW + c);
            const f32x4 o = val[j] * rl * nw; v2u w; w.x = pk2(o.x, o.y); w.y = pk2(o.z, o.w); *(v2u*)(WSH(WS_MIX) + (size_t)m * D + c) = w; }
#pragma unroll
        for (int j = 0; j < 2; ++j) { const int c = 4 * lane + 256 * j, d = c & (HD - 1);
            const f32x4 o = *(const f32x4*)(WSF(WS_GO) + (size_t)m * GDNW + c);
            const float s2 = half_sum_(F.lane, (o.x * o.x + o.y * o.y) + (o.z * o.z + o.w * o.w));
            const float rg = 1.0f / sqrtf(s2 * (1.0f / HD) + EPS);
            const f32x4 nw = *(const f32x4*)(GDN_NORM_W + (size_t)l * HD + d);
            const v2u z2 = *(const v2u*)(WSH(WS_PROJ) + (size_t)m * NPROJ + O_Z + c);
            const f32x4 r = (f32x4){o.x * rg * nw.x * siluf_(bflo(z2.x)), o.y * rg * nw.y * siluf_(bfhi(z2.x)), o.z * rg * nw.z * siluf_(bflo(z2.y)), o.w * rg * nw.w * siluf_(bfhi(z2.y))};
            v2u w; w.x = pk2(r.x, r.y); w.y = pk2(r.z, r.w); *(v2u*)(WSH(WS_MIX) + (size_t)m * D + LRUW + c) = w; }
    }
}

DI void p_final(Frame& F) {
    const int gw = F.vcu * NWAVES + F.wave, NGW = F.G * NWAVES, lane = F.lane;
    for (int m = gw; m < M; m += NGW) {
        f32x4 v[4]; float ss = 0.f;
#pragma unroll
        for (int j = 0; j < 4; ++j) { v[j] = *(const f32x4*)(OUT_ + (size_t)m * D + 4 * lane + 256 * j); ss += (v[j].x * v[j].x + v[j].y * v[j].y) + (v[j].z * v[j].z + v[j].w * v[j].w); }
        ss = wave_sum_(F.lane, ss);
        const float rstd = 1.0f / sqrtf(ss * (1.0f / D) + EPS);
#pragma unroll
        for (int j = 0; j < 4; ++j) { const int col = 4 * lane + 256 * j; const f32x4 nw = *(const f32x4*)(FINAL_NORM_W + col); *(f32x4*)(OUT_ + (size_t)m * D + col) = v[j] * rstd * nw; }
    }
}

__device__ __forceinline__ void pg8::EpiMulti::operator()(const f32x4 (&acc)[2][2][4][2], const Unit& u, int wr, int wc, int fr, int fq) const {
    const __attribute__((address_space(4))) Args* ap = (const __attribute__((address_space(4))) Args*)__builtin_amdgcn_kernarg_segment_ptr(); asm volatile("" : "+s"(ap));
    unsigned char* ws = ap->ws;
    if (mode == 0) { EpiBf16<0> e{(bf16_t*)(ws + WS_PROJ), NPROJ, nullptr, 0, 0, 1.f}; e(acc, u, wr, wc, fr, fq); }
    else if (mode == 2) { EpiBf16<2> e{(bf16_t*)(ws + WS_ACT), FF, nullptr, 0, 0, 1.f}; e(acc, u, wr, wc, fr, fq); }
    else { const float* modl = (const float*)(ws + WS_MOD) + (size_t)l * BATCH * NMODC + (mode == 3 ? 2 * D : 5 * D);
        EpiResid r{(mode == 3 && l == 0) ? ap->in[0] : ap->out, ap->out, modl, D, NMODC, SEQ}; r(acc, u, wr, wc, fr, fq); }
}

__global__ void __launch_bounds__(NWAVES * 64, 2) mk_fwd(Args args) {
    extern __shared__ __attribute__((aligned(16))) unsigned char lds[];
    Frame F;
    F.lds = (LAS unsigned char*)lds;
    F.MISC = (volatile LAS unsigned*)(F.lds + MISC_OFF);
    F.tid = threadIdx.x; F.lane = F.tid & 63; F.wave = __builtin_amdgcn_readfirstlane(F.tid >> 6);
    F.G = gridDim.x; { const int bx = blockIdx.x; F.vcu = (F.G % 8 == 0) ? (bx % 8) * (F.G / 8) + bx / 8 : bx; }
    F.A = (const __attribute__((address_space(4))) Args*)__builtin_amdgcn_kernarg_segment_ptr();
    F.ctl = (gu32*)(F.A->ws + WS_CTL);
    for (int u = F.tid; u < (LDS_BYTES - LDSCTL_OFF) / 4; u += NWAVES * 64) ((LAS unsigned*)(F.lds + LDSCTL_OFF))[u] = 0u;
    __syncthreads();
    XcdBarrier bar; bar.bar = (unsigned*)(F.ctl + CW_BAR); bar.x = 0; bar.st = nullptr;
    if (N_LAUNCHES == 1) bar = xcd_barrier_post((unsigned*)(F.ctl + CW_BAR), F.MISC + 8);

    const int lo = F.A->ph_lo, hi = F.A->ph_hi;
    int rep_done = 0;
#pragma unroll 1
    for (int s = lo; s < hi; ++s) {
        { const __attribute__((address_space(4))) Args* ap = (const __attribute__((address_space(4))) Args*)__builtin_amdgcn_kernarg_segment_ptr(); asm volatile("" : "+s"(ap)); F.A = ap; }
        { int t_ = threadIdx.x; asm volatile("" : "+v"(t_)); F.tid = t_; F.lane = t_ & 63; F.wave = __builtin_amdgcn_readfirstlane(t_ >> 6); }
        if (s == 0) { if (PH_MASK & 1) { p_mod(F); __syncthreads(); p0_weights(F); } }
        else if (s == N_STEPS - 1) { if (PH_MASK & 2) p_final(F); }
        else {
            const int l = (s - 1) / 9, i = (s - 1) % 9;
            bf16* wl = WSH(WS_W) + (size_t)l * LAYER_W;
            const float* modl = WSF(WS_MOD) + (size_t)l * BATCH * NMODC;
            if (!((PH_MASK >> (2 + i)) & 1)) {}
            else if (i == 0) { p_normmod<true>(F, l, l == 0 ? X_IN : OUT_, NORM_MIX_W, 0, D); }
            else if (i == 2) { p_prep(F, l); }
            else if (i == 3) { p_scan(F, l); }
            else if (i == 4) { p_post(F, l); }
            else if (i == 6) { p_normmod<false>(F, l, OUT_, NORM_MLP_W, 3 * D, 4 * D); }
            else {
                pg8::Gemm g; pg8::EpiMulti E; E.l = l;
                if (i == 1) { g = pg8::Gemm{WSH(WS_H), wl, M, NPROJ, D}; E.PERM = true; E.mode = 0; }
                else if (i == 5) { g = pg8::Gemm{WSH(WS_MIX), wl + W_OUT_OFF, M, D, D}; E.PERM = false; E.mode = 3; }
                else if (i == 7) { g = pg8::Gemm{WSH(WS_H), wl + W_UP_OFF, M, FF, D}; E.PERM = true; E.mode = 2; }
                else { g = pg8::Gemm{WSH(WS_ACT), wl + W_DOWN_OFF, M, D, FF}; E.PERM = false; E.mode = 4; }
                pg8::StaticOrder S; S.init(g.M, g.N, F.G, (int)blockIdx.x);
                pg8::gemm_phase<pg8::EpiMulti, pg8::StaticOrder, PG8_ALIGN, PG8_SP2>(F.lds + RING_OFF, g, S, E);
            }
        }
        if (REP_MASK != 0 && s >= 1 && s < N_STEPS - 1 && ((REP_MASK >> ((s - 1) % 9)) & 1) && !rep_done) { rep_done = 1; --s; xcd_barrier(bar, F.tid == 0); continue; }
        rep_done = 0;
        if (s + 1 < hi) xcd_barrier(bar, F.tid == 0);
    }
}

extern "C" void kernel_launch(void* const* d_in, const int* in_sizes, int n_in, void* d_out, int out_size, void* d_ws, size_t ws_size, hipStream_t stream) {
    static int grid = 0;
    if (grid == 0) {
        if (n_in != 23 || in_sizes[0] != M * D || out_size != M * D || ws_size < WS_END) { fprintf(stderr, "kernel_launch: unexpected shapes (n_in %d, in0 %d, out %d, ws %zu); nothing launched\n", n_in, n_in > 0 ? in_sizes[0] : -1, out_size, ws_size); grid = -1; return; }
        int dev = 0, cus = 0;
        if (hipGetDevice(&dev) != hipSuccess || hipDeviceGetAttribute(&cus, hipDeviceAttributeMultiprocessorCount, dev) != hipSuccess) { grid = -1; return; }
        if (hipFuncSetAttribute((const void*)mk_fwd, hipFuncAttributeMaxDynamicSharedMemorySize, LDS_BYTES) != hipSuccess) { fprintf(stderr, "kernel_launch: hipFuncSetAttribute failed\n"); grid = -1; return; }
        (void)hipGetLastError();
        grid = cus;
    }
    if (grid < 0) return;
    if (hipMemsetAsync((char*)d_ws + WS_CTL, 0, CTL_ZERO_BYTES, stream) != hipSuccess) return;
    Args a{};
    for (int i = 0; i < 23; ++i) a.in[i] = (const float*)d_in[i];
    a.out = (float*)d_out; a.ws = (unsigned char*)d_ws;
    if (N_LAUNCHES == 1) { a.ph_lo = 0; a.ph_hi = N_STEPS; hipLaunchKernelGGL(mk_fwd, dim3(grid), dim3(NWAVES * 64), LDS_BYTES, stream, a); }
    else for (int s = 0; s < N_STEPS; ++s) { a.ph_lo = s; a.ph_hi = s + 1; hipLaunchKernelGGL(mk_fwd, dim3(grid), dim3(NWAVES * 64), LDS_BYTES, stream, a); }
}
```

```cpp
#include <hip/hip_runtime.h>
#include <cstdio>
#include <cstdint>
#include <cmath>
namespace pg8 {
#define PG8_LAS __attribute__((address_space(3)))
typedef unsigned short bf16_t;
typedef short bf16x8 __attribute__((ext_vector_type(8)));
typedef float f32x4 __attribute__((ext_vector_type(4)));
typedef unsigned u32x4 __attribute__((ext_vector_type(4)));
constexpr int BM = 256, BK = 64, HALF = 128, HTB = HALF * BK * 2  , STAGE_BYTES = 8 * HTB, NXCD = 8, WGM = 8;

__host__ __device__ __forceinline__ int lds_byte(int r, int c) { const int st = (r >> 4) * 2 + (c >> 5), rr = r & 15, cc = c & 31, ob = rr * 64 + cc * 2; return st * 1024 + (ob ^ (((ob >> 9) & 1) << 5)); }
__host__ __device__ __forceinline__ void stage_rc(int b, int& R, int& C) { const int st = b / 1024, sb = b % 1024, swz = sb ^ (((sb >> 9) & 1) << 5); R = (st >> 1) * 16 + swz / 64; C = (st & 1) * 32 + (swz % 64) / 2; }
__host__ __device__ __forceinline__ int perm32(int rho) { const int n = rho >> 4, i = rho & 15; return 8 * (i >> 2) + 4 * n + (i & 3); }

struct Unit { int pm, pn; };
struct Gemm { const bf16_t* A; const bf16_t* Bt; int M, N, K; };

struct StaticOrder {
    int nM, nN, nwg, G, c;
    __host__ __device__ void init(int M, int N, int G_, int c_) { nM = M / BM; nN = N / BM; nwg = nM * nN; G = G_; c = c_; }
    __host__ __device__ bool next(int i, Unit& u) const {
        const long L = (long)i * G + c; if (L >= nwg) return false;
        int wgid = (int)L; { const int q = nwg / NXCD, r = nwg % NXCD, xcd = wgid % NXCD, off = wgid / NXCD; wgid = (xcd < r ? xcd * (q + 1) : r * (q + 1) + (xcd - r) * q) + off; }
        const int nig = WGM * nN, gid = wgid / nig, fm = gid * WGM, gsz = (nM - fm) < WGM ? (nM - fm) : WGM;
        u.pm = fm + ((wgid % nig) % gsz); u.pn = (wgid % nig) / gsz; return true;
    }
    __device__ __forceinline__ void a_ready(const Unit&) const {}
    __device__ __forceinline__ void done(const Unit&) const {}
};

__device__ __forceinline__ unsigned cvt_pk_bf16(float lo, float hi) { unsigned r; asm volatile("v_cvt_pk_bf16_f32 %0, %1, %2" : "=v"(r) : "v"(lo), "v"(hi)); return r; }
typedef float f32x2 __attribute__((ext_vector_type(2)));
__device__ __forceinline__ f32x2 gelu_pk(f32x2 v) {
    const f32x2 av = __builtin_elementwise_abs(v), d = av * 0.2316418882f + 1.0f;
    f32x2 t; t.x = __builtin_amdgcn_rcpf(d.x); t.y = __builtin_amdgcn_rcpf(d.y);
    f32x2 q = t * 0.5307027145f + (-0.7265760135f); q = q * t + 0.7107068705f; q = q * t + (-0.142248368f); q = q * t + 0.127414796f; q = q * t;
    const f32x2 s = (v * v) * (-0.72134752044f);
    f32x2 e; e.x = __builtin_amdgcn_exp2f(s.x); e.y = __builtin_amdgcn_exp2f(s.y);
    const f32x2 m = v * (q * e), r = v - m;
    f32x2 o; o.x = v.x < 0.f ? m.x : r.x; o.y = v.y < 0.f ? m.y : r.y; return o;
}

template <int ACT  > struct EpiBf16 {
    static constexpr bool PERM = true, AFTER_DRAIN = false; static_assert(ACT == 0 || ACT == 1 || ACT == 2, "EpiBf16: ACT is 0 (none), 1 (gelu_pk) or 2 (squared relu)");
    bf16_t* O; int ldc; const float* bias; int split_cols; size_t split_stride; float scale0;
    __device__ __forceinline__ void operator()(const f32x4 (&acc)[2][2][4][2], const Unit& u, int wr, int wc, int fr, int fq) const {
        const int row0 = u.pm * BM + wr * 64 + fr; int colt = u.pn * BM; bf16_t* base = O;
        float sc = 1.f; if (split_cols) { const int t = colt / split_cols; base += (size_t)t * split_stride; colt -= t * split_cols; if (t == 0) sc = scale0; }
        const int col0 = colt + wc * 32 + 8 * fq, bcol0 = u.pn * BM + wc * 32 + 8 * fq;
        f32x4 bv[2][2];
#pragma unroll
        for (int bj = 0; bj < 2; ++bj)
#pragma unroll
            for (int n = 0; n < 2; ++n) bv[bj][n] = bias ? *(const f32x4*)(bias + bcol0 + bj * HALF + 4 * n) : (f32x4){0.f, 0.f, 0.f, 0.f};
#pragma unroll
        for (int ai = 0; ai < 2; ++ai)
#pragma unroll
            for (int m = 0; m < 4; ++m) { bf16_t* rowp = base + (size_t)(row0 + ai * HALF + m * 16) * ldc + col0;
#pragma unroll
                for (int bj = 0; bj < 2; ++bj) { f32x4 v0 = acc[ai][bj][m][0] + bv[bj][0], v1 = acc[ai][bj][m][1] + bv[bj][1];
                    if (ACT == 1) { f32x2 a = gelu_pk((f32x2){v0[0], v0[1]}), b = gelu_pk((f32x2){v0[2], v0[3]}), c = gelu_pk((f32x2){v1[0], v1[1]}), d = gelu_pk((f32x2){v1[2], v1[3]});
                        v0 = (f32x4){a.x, a.y, b.x, b.y}; v1 = (f32x4){c.x, c.y, d.x, d.y}; }
                    if (ACT == 2) { _Pragma("unroll") for (int q_ = 0; q_ < 4; ++q_) { const float a_ = fmaxf(v0[q_], 0.f), b_ = fmaxf(v1[q_], 0.f); v0[q_] = a_ * a_; v1[q_] = b_ * b_; } }
                    v0 = v0 * sc; v1 = v1 * sc; u32x4 w; w.x = cvt_pk_bf16(v0[0], v0[1]); w.y = cvt_pk_bf16(v0[2], v0[3]); w.z = cvt_pk_bf16(v1[0], v1[1]); w.w = cvt_pk_bf16(v1[2], v1[3]);
                    *(u32x4*)(rowp + bj * HALF) = w; } }
    }
};


struct EpiResid {
    static constexpr bool PERM = false, AFTER_DRAIN = false;
    const float* base; float* out; const float* gate; int ldc; int gate_stride; int rows_per_batch;
    __device__ __forceinline__ void operator()(const f32x4 (&acc)[2][2][4][2], const Unit& u, int wr, int wc, int fr, int fq) const {
        const int col0 = u.pn * BM + wc * 32 + 4 * fq;
        const float* gp = gate + (size_t)((u.pm * BM) / rows_per_batch) * gate_stride + col0;
        f32x4 gv[2][2];
#pragma unroll
        for (int bj = 0; bj < 2; ++bj)
#pragma unroll
            for (int n = 0; n < 2; ++n) gv[bj][n] = *(const f32x4*)(gp + bj * HALF + n * 16);
#pragma unroll
        for (int ai = 0; ai < 2; ++ai)
#pragma unroll
            for (int m = 0; m < 4; ++m) { const size_t off = (size_t)(u.pm * BM + ai * HALF + wr * 64 + m * 16 + fr) * ldc + col0;
#pragma unroll
                for (int bj = 0; bj < 2; ++bj)
#pragma unroll
                    for (int n = 0; n < 2; ++n) { const f32x4 bs = *(const f32x4*)(base + off + bj * HALF + n * 16);
                        *(f32x4*)(out + off + bj * HALF + n * 16) = bs + gv[bj][n] * acc[ai][bj][m][n]; } }
    }
};


struct EpiMulti {
    static constexpr bool AFTER_DRAIN = false;
    bool PERM; int mode, l;
    __device__ __forceinline__ void operator()(const f32x4 (&acc)[2][2][4][2], const Unit& u, int wr, int wc, int fr, int fq) const;
};

template <class Epi, class Sched, bool ALIGN_EPI = false, bool SP2 = false>
__device__ __forceinline__ void gemm_phase(PG8_LAS unsigned char* lds, const Gemm g, const Sched& S, const Epi& E) {
    int tid_l = threadIdx.x; asm volatile("" : "+v"(tid_l));
    const int tid = tid_l, wid = __builtin_amdgcn_readfirstlane(tid >> 6), lane = tid & 63, wr = wid >> 2, wc = wid & 3, fr = lane & 15, fq = lane >> 4;
    const int K = g.K, nt = K / BK;
    unsigned voffA[2], voffB[2];
#pragma unroll
    for (int i = 0; i < 2; ++i) { int R, C; stage_rc(tid * 16 + i * 8192, R, C); const int Rb = E.PERM ? ((R & ~31) + perm32(R & 31)) : R;
        voffA[i] = (unsigned)(R * K + C) * 2u; voffB[i] = (unsigned)(Rb * K + C) * 2u; }
    const size_t kstep = (size_t)(BK * 2);
    const size_t hstep = (size_t)HALF * K * 2;
    const size_t tstep = 2 * hstep;
    const unsigned ldsw = (unsigned)wid * 1024u;
    const int aoff = lds_byte(wr * 64 + fr, fq * 8), boff = lds_byte(wc * 32 + fr, fq * 8);
#define PG8_SA(b, h) (((b) * 2 + (h)) * HTB)
#define PG8_SB(b, h) ((4 + (b) * 2 + (h)) * HTB)
#define PG8_STAGE(bufoff, gbase, voff) do { _Pragma("unroll") for (int _i = 0; _i < 2; ++_i) \
        __builtin_amdgcn_global_load_lds((const unsigned*)((const char*)(gbase) + (voff)[_i]), (PG8_LAS unsigned*)(lds + (bufoff) + ldsw + _i * 8192), 16, 0, 0); } while (0)
#define PG8_LDA(dst, b, h) do { _Pragma("unroll") for (int m = 0; m < 4; ++m) _Pragma("unroll") for (int k = 0; k < 2; ++k) dst[m][k] = *(const PG8_LAS bf16x8*)(lds + PG8_SA(b, h) + aoff + m * 2048 + k * 1024); } while (0)
#define PG8_LDB(dst, b, h) do { _Pragma("unroll") for (int n = 0; n < 2; ++n) _Pragma("unroll") for (int k = 0; k < 2; ++k) dst[n][k] = *(const PG8_LAS bf16x8*)(lds + PG8_SB(b, h) + boff + n * 2048 + k * 1024); } while (0)
#define PG8_MMA(ai, bj, At, Bt) do { __builtin_amdgcn_s_setprio(1); _Pragma("unroll") for (int m = 0; m < 4; ++m) _Pragma("unroll") for (int n = 0; n < 2; ++n) _Pragma("unroll") for (int k = 0; k < 2; ++k) \
        acc[ai][bj][m][n] = __builtin_amdgcn_mfma_f32_16x16x32_bf16(Bt[n][k], At[m][k], acc[ai][bj][m][n], 0, 0, 0); __builtin_amdgcn_s_setprio(0); } while (0)
#define PG8_WAIT_V(n) asm volatile("s_waitcnt vmcnt(" #n ")" ::: "memory")
#define PG8_WAIT_L(n) asm volatile("s_waitcnt lgkmcnt(" #n ")" ::: "memory")
#define PG8_BAR __builtin_amdgcn_s_barrier()
#define PG8_SCHED __builtin_amdgcn_sched_barrier(0)
    Unit cur, nxt; int ui = 0;
    if (!S.next(0, cur)) return;
    f32x4 acc[2][2][4][2];
#pragma unroll
    for (int a = 0; a < 2; ++a)
#pragma unroll
        for (int b = 0; b < 2; ++b)
#pragma unroll
            for (int m = 0; m < 4; ++m)
#pragma unroll
                for (int n = 0; n < 2; ++n) acc[a][b][m][n] = (f32x4){0.f, 0.f, 0.f, 0.f};
    bf16x8 At[4][2], B0[2][2], B1[2][2];
    const char* cA = (const char*)g.A + (size_t)cur.pm * tstep; const char* cB = (const char*)g.Bt + (size_t)cur.pn * tstep;
    S.a_ready(cur);
    if constexpr (SP2) {
        PG8_STAGE(PG8_SB(0, 0), cB, voffB); PG8_STAGE(PG8_SB(0, 1), cB + hstep, voffB); PG8_STAGE(PG8_SA(0, 0), cA, voffA); PG8_STAGE(PG8_SA(0, 1), cA + hstep, voffA);
        if (wr == 1) PG8_BAR;
        PG8_WAIT_V(2); PG8_BAR;
        PG8_STAGE(PG8_SB(1, 0), cB + kstep, voffB); PG8_STAGE(PG8_SA(1, 0), cA + kstep, voffA); PG8_STAGE(PG8_SB(1, 1), cB + hstep + kstep, voffB);
        PG8_WAIT_V(6); PG8_BAR;
    } else {
        PG8_STAGE(PG8_SB(0, 0), cB, voffB); PG8_STAGE(PG8_SA(0, 0), cA, voffA); PG8_STAGE(PG8_SB(0, 1), cB + hstep, voffB); PG8_STAGE(PG8_SA(0, 1), cA + hstep, voffA);
        if (wr == 1) PG8_BAR;
        PG8_WAIT_V(4); PG8_BAR;
        PG8_STAGE(PG8_SB(1, 0), cB + kstep, voffB); PG8_STAGE(PG8_SA(1, 0), cA + kstep, voffA); PG8_STAGE(PG8_SB(1, 1), cB + hstep + kstep, voffB);
        PG8_WAIT_V(6); PG8_BAR;
    }
    for (;;) {
        const bool has_next = S.next(ui + 1, nxt);
        const char* nA = has_next ? (const char*)g.A + (size_t)nxt.pm * tstep : cA; const char* nB = has_next ? (const char*)g.Bt + (size_t)nxt.pn * tstep : cB;
        for (int t = 0; t < nt; t += 2) {
            const bool last = (t == nt - 2);
            const char* a1 = cA + (size_t)(t + 1) * kstep;
            const char* a2 = last ? nA : cA + (size_t)(t + 2) * kstep; const char* b2 = last ? nB : cB + (size_t)(t + 2) * kstep;
            const char* a3 = a2 + kstep; const char* b3 = b2 + kstep;
            if (last && has_next) S.a_ready(nxt);
            if constexpr (SP2) {
            PG8_LDB(B0, 0, 0); PG8_LDB(B1, 0, 1); PG8_SCHED; PG8_LDA(At, 0, 0); PG8_STAGE(PG8_SA(1, 1), a1 + hstep, voffA);
            PG8_WAIT_V(8); PG8_WAIT_L(0); PG8_BAR; PG8_MMA(0, 0, At, B0); PG8_MMA(0, 1, At, B1); PG8_BAR; PG8_SCHED;
            PG8_LDA(At, 0, 1); PG8_STAGE(PG8_SB(0, 0), b2, voffB); PG8_STAGE(PG8_SB(0, 1), b2 + hstep, voffB); PG8_STAGE(PG8_SA(0, 0), a2, voffA);
            PG8_WAIT_V(8); PG8_WAIT_L(0); PG8_BAR; PG8_MMA(1, 0, At, B0); PG8_MMA(1, 1, At, B1); PG8_BAR; PG8_SCHED;
            PG8_LDB(B0, 1, 0); PG8_LDB(B1, 1, 1); PG8_SCHED; PG8_LDA(At, 1, 0); PG8_STAGE(PG8_SA(0, 1), a2 + hstep, voffA);
            PG8_WAIT_V(8); PG8_WAIT_L(0); PG8_BAR; PG8_MMA(0, 0, At, B0); PG8_MMA(0, 1, At, B1); PG8_BAR; PG8_SCHED;
            PG8_LDA(At, 1, 1); PG8_STAGE(PG8_SB(1, 0), b3, voffB); PG8_STAGE(PG8_SB(1, 1), b3 + hstep, voffB); PG8_STAGE(PG8_SA(1, 0), a3, voffA);
            PG8_WAIT_V(8); PG8_WAIT_L(0); PG8_BAR; PG8_MMA(1, 0, At, B0); PG8_MMA(1, 1, At, B1); PG8_BAR; PG8_SCHED;
            } else {
            PG8_LDB(B0, 0, 0); PG8_SCHED; PG8_LDA(At, 0, 0); PG8_STAGE(PG8_SA(1, 1), a1 + hstep, voffA);
            PG8_WAIT_L(8); PG8_BAR; PG8_WAIT_L(0); PG8_MMA(0, 0, At, B0); PG8_BAR; PG8_SCHED;
            PG8_LDB(B1, 0, 1); PG8_STAGE(PG8_SB(0, 0), b2, voffB);
            PG8_BAR; PG8_WAIT_L(0); PG8_MMA(0, 1, At, B1); PG8_BAR;
            PG8_LDA(At, 0, 1); PG8_STAGE(PG8_SA(0, 0), a2, voffA);
            PG8_BAR; PG8_WAIT_L(0); PG8_MMA(1, 0, At, B0); PG8_BAR; PG8_SCHED;
            PG8_STAGE(PG8_SB(0, 1), b2 + hstep, voffB);
            PG8_WAIT_V(6); PG8_BAR; PG8_MMA(1, 1, At, B1); PG8_BAR;
            PG8_LDB(B0, 1, 0); PG8_SCHED; PG8_LDA(At, 1, 0); PG8_STAGE(PG8_SA(0, 1), a2 + hstep, voffA);
            PG8_WAIT_L(8); PG8_BAR; PG8_WAIT_L(0); PG8_MMA(0, 0, At, B0); PG8_BAR; PG8_SCHED;
            PG8_LDB(B1, 1, 1); PG8_STAGE(PG8_SB(1, 0), b3, voffB);
            PG8_BAR; PG8_WAIT_L(0); PG8_MMA(0, 1, At, B1); PG8_BAR;
            PG8_LDA(At, 1, 1); PG8_STAGE(PG8_SA(1, 0), a3, voffA);
            PG8_BAR; PG8_WAIT_L(0); PG8_MMA(1, 0, At, B0); PG8_BAR; PG8_SCHED;
            PG8_STAGE(PG8_SB(1, 1), b3 + hstep, voffB);
            PG8_WAIT_V(6); PG8_BAR; PG8_MMA(1, 1, At, B1); PG8_BAR;
            }
        }
        if constexpr (ALIGN_EPI) { if (wr == 0) PG8_BAR; }
        if constexpr (!Epi::AFTER_DRAIN) { E(acc, cur, wr, wc, fr, fq); S.done(cur); }
        if (!has_next) break;
#pragma unroll
        for (int a = 0; a < 2; ++a)
#pragma unroll
            for (int b = 0; b < 2; ++b)
#pragma unroll
                for (int m = 0; m < 4; ++m)
#pragma unroll
                    for (int n = 0; n < 2; ++n) acc[a][b][m][n] = (f32x4){0.f, 0.f, 0.f, 0.f};
        cur = nxt; cA = nA; cB = nB; ++ui;
        if constexpr (ALIGN_EPI) { if (wr == 1) PG8_BAR; }
    }
    PG8_WAIT_V(0);
    if constexpr (!ALIGN_EPI) { if (wr == 0) PG8_BAR; }
    PG8_BAR;
    if constexpr (Epi::AFTER_DRAIN) { E.fused(acc, cur, wr, wc, fr, fq, lds, wid, lane); S.done(cur); }
#undef PG8_SA
#undef PG8_SB
#undef PG8_STAGE
#undef PG8_LDA
#undef PG8_LDB
#undef PG8_MMA
#undef PG8_WAIT_V
#undef PG8_WAIT_L
#undef PG8_BAR
#undef PG8_SCHED
}
}
#define GAS __attribute__((address_space(1)))
#define LAS __attribute__((address_space(3)))
typedef unsigned short bf16;
typedef unsigned v4u __attribute__((ext_vector_type(4)));
typedef float f32x4 __attribute__((ext_vector_type(4)));
typedef short bf16x8 __attribute__((ext_vector_type(8)));
typedef GAS unsigned gu32;
typedef GAS unsigned long long gu64;
#define RLX_AGENT __ATOMIC_RELAXED, __HIP_MEMORY_SCOPE_AGENT
#define LDS_WAIT() asm volatile("s_waitcnt lgkmcnt(0)" ::: "memory")
#define VM_WAIT() asm volatile("s_waitcnt vmcnt(0)" ::: "memory")
__device__ __forceinline__ unsigned long long rt() { return __builtin_amdgcn_s_memrealtime(); }
__device__ __forceinline__ unsigned f2bf(float f) { unsigned u = __builtin_bit_cast(unsigned, f); return (u + 0x7fffu + ((u >> 16) & 1u)) >> 16; }
__device__ __forceinline__ unsigned pk2(float lo, float hi) { return f2bf(lo) | (f2bf(hi) << 16); }

#define XB_TMO      128
#define XB_XCNT(j)  (256  + 64 * (j))
#define XB_XSUB(j)  (1280 + 64 * (j))
#define XB_XGEN(j)  (2304 + 64 * (j))
#define XB_TOP      3328
#define XB_TOPGEN   3392
#define XCD_BAR_WORDS 3456
#define XB_SPIN_CAP (1u << 18)

__device__ __forceinline__ unsigned xb_ld(unsigned* p)              { return __hip_atomic_load(p, __ATOMIC_RELAXED, __HIP_MEMORY_SCOPE_AGENT); }
__device__ __forceinline__ unsigned xb_add(unsigned* p, unsigned v) { return __hip_atomic_fetch_add(p, v, __ATOMIC_RELAXED, __HIP_MEMORY_SCOPE_AGENT); }
__device__ __forceinline__ unsigned xb_xcc_id() { return (unsigned)__builtin_amdgcn_s_getreg((3 << 11) | 20) & 0xFu; }
#define XB_SPIN(cond, bar) do { unsigned _sp = 0; while (cond) { __builtin_amdgcn_s_sleep(1); \
    if ((++_sp & 255u) == 0u) { if (xb_ld(&(bar)[XB_TMO])) break; if (_sp > XB_SPIN_CAP) { atomicAdd(&(bar)[XB_TMO], 1u); break; } } } } while (0)

struct XcdBarrier {
    unsigned* bar; unsigned x;
    volatile LAS unsigned* st;
};

__device__ __forceinline__ XcdBarrier xcd_barrier_post(unsigned* bar, volatile LAS unsigned* st) {
    XcdBarrier b; b.bar = bar; b.x = xb_xcc_id(); b.st = st;
    if (threadIdx.x == 0) (void)xb_add(&bar[XB_XCNT(b.x)], 1u);
    return b;
}
__device__ __forceinline__ void xcd_barrier_complete(unsigned* bar, unsigned x, unsigned& nloc, unsigned& nx) {
    const unsigned G = gridDim.x * gridDim.y * gridDim.z;
    unsigned sum, cnt, mine, sp = 0u;
    for (;;) {
        sum = 0u; cnt = 0u; mine = 0u;
#pragma unroll
        for (unsigned j = 0; j < 16; ++j) { const unsigned c = xb_ld(&bar[XB_XCNT(j)]); sum += c; cnt += (c > 0u) ? 1u : 0u; mine = (j == x) ? c : mine; }
        if (sum == G) break;
        __builtin_amdgcn_s_sleep(1);
        if ((++sp & 255u) == 0u) { if (xb_ld(&bar[XB_TMO])) break; if (sp > XB_SPIN_CAP) { atomicAdd(&bar[XB_TMO], 1u); break; } }
    }
    nloc = mine > 0u ? mine : 1u; nx = cnt > 0u ? cnt : 1u;
}

__device__ __forceinline__ void xcd_barrier(const XcdBarrier& b, const bool t0  ) {
    asm volatile("s_waitcnt vmcnt(0)" ::: "memory");
    __syncthreads();
    if (t0) {
        unsigned* bar = b.bar;
        __builtin_amdgcn_s_waitcnt(0);
        unsigned nloc = b.st[0], nx = b.st[1];
        if (nloc == 0u) { xcd_barrier_complete(bar, b.x, nloc, nx); b.st[0] = nloc; b.st[1] = nx; }
        const unsigned old = xb_add(&bar[XB_XSUB(b.x)], 1u);
        const unsigned gen = old / nloc;
        if (old + 1u == (gen + 1u) * nloc) {
            __builtin_amdgcn_fence(__ATOMIC_RELEASE, "agent");
            asm volatile("s_waitcnt vmcnt(0)" ::: "memory");
            const unsigned og = xb_add(&bar[XB_TOP], 1u);
            const unsigned tg = og / nx;
            if (og + 1u == (tg + 1u) * nx) xb_add(&bar[XB_TOPGEN], 1u);
            else XB_SPIN(xb_ld(&bar[XB_TOPGEN]) == tg, bar);
            __builtin_amdgcn_fence(__ATOMIC_ACQUIRE, "agent");
            xb_add(&bar[XB_XGEN(b.x)], 1u);
            asm volatile("s_waitcnt vmcnt(0)" ::: "memory");
        } else {
            XB_SPIN(xb_ld(&bar[XB_XGEN(b.x)]) == gen, bar);
            __builtin_amdgcn_fence(__ATOMIC_ACQUIRE, "agent");
            asm volatile("s_waitcnt vmcnt(0)" ::: "memory");
        }
    }
    __syncthreads();
}

#ifndef PG8_SP2
#define PG8_SP2 true
#endif
#ifndef PG8_ALIGN
#define PG8_ALIGN true
#endif
constexpr int NWAVES = 8;
constexpr int N_STEPS = 38;
#ifndef MK_N_LAUNCHES
#define MK_N_LAUNCHES 1
#endif
#ifndef PH_MASK
#define PH_MASK 0xffff
#endif
#ifndef REP_MASK
#define REP_MASK 0
#endif
#ifndef PREP_REP_LRU
#define PREP_REP_LRU 1
#endif
#ifndef PREP_REP_GDN
#define PREP_REP_GDN 1
#endif
constexpr int N_LAUNCHES = MK_N_LAUNCHES;

constexpr int D = 1024, BATCH = 4, SEQ = 4096, DEPTH = 4, M = BATCH * SEQ;
constexpr int LRUW = 512, NGB = 8, GBW = 64, GH = 4, HD = 128, GDNW = 512, CH = 64, NCH = SEQ / CH, FF = 4096;
constexpr int NMODC = 6 * D, INC = 3080, NPROJ = 3072;
constexpr int O_LX = 0, O_LY = 512, O_Q = 1024, O_Z = 2560;
constexpr float EPS = 1e-6f;

constexpr size_t MiB = 1u << 20;
constexpr size_t WS_CTL = 0, CTL_ZERO_BYTES = 1 * MiB;
constexpr size_t WS_MOD = 1 * MiB;
constexpr size_t WS_BG = 2 * MiB;
constexpr size_t WS_AGG = 3 * MiB;
constexpr size_t WS_CARRY = 4 * MiB;
constexpr size_t WS_GL = 5 * MiB;
constexpr size_t WS_GT = 6 * MiB;
constexpr size_t WS_W = 8 * MiB;
constexpr size_t LAYER_W = (size_t)12288 * 1024;
constexpr size_t W_OUT_OFF = (size_t)3072 * 1024, W_UP_OFF = (size_t)4096 * 1024, W_DOWN_OFF = (size_t)8192 * 1024;
constexpr size_t WS_H = 104 * MiB;
constexpr size_t WS_MIX = 136 * MiB;
constexpr size_t WS_PROJ = 168 * MiB;
constexpr size_t WS_ACT = 168 * MiB;
constexpr size_t WS_GQD = 264 * MiB, WS_GKT = 280 * MiB;
constexpr size_t WS_GATT = 296 * MiB;
constexpr size_t WS_GO = 312 * MiB;
constexpr size_t WS_LRUP = 344 * MiB;
constexpr size_t WS_END = 376 * MiB;
constexpr int CW_BAR = 4096;

constexpr int RING_OFF = 0, RING_BYTES = 155648;
constexpr int LDSCTL_OFF = RING_BYTES, MISC_OFF = LDSCTL_OFF + 320;
constexpr int LDS_BYTES = 156672;

typedef unsigned v2u __attribute__((ext_vector_type(2)));
#define DI __device__ __forceinline__
DI float bf2f(unsigned b) { return __builtin_bit_cast(float, b << 16); }
DI float bflo(unsigned w) { return __builtin_bit_cast(float, w << 16); }
DI float bfhi(unsigned w) { return __builtin_bit_cast(float, w & 0xffff0000u); }
DI float sigmoidf_(float x) { return 1.f / (1.f + expf(-x)); }
DI float siluf_(float x) { return x / (1.f + expf(-x)); }
DI float rcp_(float x) { return __builtin_amdgcn_rcpf(x); }
DI float exp_fast(float x) { return __builtin_amdgcn_exp2f(x * 1.4426950408889634f); }
DI float sigmoid_fast(float x) { return rcp_(1.f + exp_fast(-x)); }
DI float silu_fast(float x) { return x * rcp_(1.f + exp_fast(-x)); }
DI float gelu_tanh(float x) { const float u = 0.7978845608028654f * (x + 0.044715f * x * x * x); return 0.5f * x * (1.f + tanhf(u)); }
DI float bperm_(int src_lane, float v) { return __builtin_bit_cast(float, __builtin_amdgcn_ds_bpermute(src_lane << 2, __builtin_bit_cast(int, v))); }
DI float wave_sum_(int lane, float v) {
#pragma unroll
    for (int o = 1; o < 64; o <<= 1) v += bperm_(lane ^ o, v);
    return v;
}
DI float half_sum_(int lane, float v) {
#pragma unroll
    for (int o = 1; o < 32; o <<= 1) v += bperm_(lane ^ o, v);
    return v;
}
DI float shfl_up_(int lane, float v, int off) { return bperm_(lane >= off ? lane - off : lane, v); }

struct Args { const float* in[23]; float* out; unsigned char* ws; int ph_lo, ph_hi; };
static_assert(sizeof(Args) == 23 * 8 + 8 + 8 + 8, "Args has no padding");
struct Frame {
    LAS unsigned char* lds;
    volatile LAS unsigned* MISC;
    gu32* ctl;
    int tid, lane, wave;
    int vcu, G;
    const __attribute__((address_space(4))) Args* A;
};
#define IN_(k) (F.A->in[k])
#define X_IN IN_(0)
#define C_IN IN_(1)
#define NORM_MIX_W IN_(2)
#define NORM_MLP_W IN_(3)
#define W_MOD IN_(4)
#define B_MOD IN_(5)
#define W_IN IN_(6)
#define LRU_CONV_W IN_(7)
#define LRU_CONV_B IN_(8)
#define GATE_A_W IN_(9)
#define GATE_A_B IN_(10)
#define GATE_X_W IN_(11)
#define GATE_X_B IN_(12)
#define LRU_LAMBDA IN_(13)
#define LRU_NORM_W IN_(14)
#define GDN_CONV_W IN_(15)
#define GDN_A_LOG IN_(16)
#define GDN_DT_BIAS IN_(17)
#define GDN_NORM_W IN_(18)
#define W_OUT IN_(19)
#define W_UP IN_(20)
#define W_DOWN IN_(21)
#define FINAL_NORM_W IN_(22)
#define OUT_ (F.A->out)
#define WSF(off) ((float*)(F.A->ws + (off)))
#define WSH(off) ((bf16*)(F.A->ws + (off)))

DI void p_mod(Frame& F) {
    LAS float* cs = (LAS float*)F.lds;
    LAS float* red = cs + 4096;
    for (int i = F.tid; i < BATCH * D; i += NWAVES * 64) cs[i] = siluf_(C_IN[i]);
    __syncthreads();
    for (int item = blockIdx.x; item < DEPTH * 96; item += gridDim.x) {
        const int l = item / 96, cg = item % 96, col = cg * 64 + F.lane;
        const float* wp = W_MOD + ((size_t)l * D + F.wave * 128) * NMODC + col;
        float a0 = 0.f, a1 = 0.f, a2 = 0.f, a3 = 0.f;
#pragma unroll 8
        for (int kk = 0; kk < 128; ++kk) { const float wv = wp[(size_t)kk * NMODC]; const int k = F.wave * 128 + kk;
            a0 += cs[k] * wv; a1 += cs[1024 + k] * wv; a2 += cs[2048 + k] * wv; a3 += cs[3072 + k] * wv; }
        red[(F.wave * 4 + 0) * 64 + F.lane] = a0; red[(F.wave * 4 + 1) * 64 + F.lane] = a1; red[(F.wave * 4 + 2) * 64 + F.lane] = a2; red[(F.wave * 4 + 3) * 64 + F.lane] = a3;
        __syncthreads();
        if (F.tid < 256) { const int b = F.tid >> 6, ln = F.tid & 63; float s = 0.f;
#pragma unroll
            for (int w = 0; w < 8; ++w) s += red[(w * 4 + b) * 64 + ln];
            const int cc = cg * 64 + ln; WSF(WS_MOD)[((size_t)l * BATCH + b) * NMODC + cc] = s + B_MOD[(size_t)l * NMODC + cc]; }
        __syncthreads();
    }
}

DI void p0_transpose_item(const float* W, int K, int ldw, int N, bf16* WT, LAS float* scr, int item, int lane) {
    const int nblk = N / 32, kb = item / nblk, nb = item % nblk, k0 = 64 * kb, n0 = 32 * nb;
#pragma unroll 8
    for (int i = 0; i < 32; ++i) { const int kk = 2 * i + (lane >> 5); scr[kk * 33 + (lane & 31)] = W[(size_t)(k0 + kk) * ldw + n0 + (lane & 31)]; }
    LDS_WAIT(); asm volatile("" ::: "memory");
    const int c = lane & 7;
#pragma unroll
    for (int j = 0; j < 4; ++j) { const int n = (lane >> 3) + 8 * j; const LAS float* s = scr + (8 * c) * 33 + n;
        v4u o; o.x = pk2(s[0 * 33], s[1 * 33]); o.y = pk2(s[2 * 33], s[3 * 33]); o.z = pk2(s[4 * 33], s[5 * 33]); o.w = pk2(s[6 * 33], s[7 * 33]);
        *(v4u*)(WT + (size_t)(n0 + n) * K + k0 + 8 * c) = o; }
    LDS_WAIT(); asm volatile("" ::: "memory");
}
DI void p0_weights(Frame& F) {
    LAS float* scr = (LAS float*)(F.lds + RING_OFF + F.wave * 16384);
    const int gw = F.vcu * NWAVES + F.wave, NGW = F.G * NWAVES;
    constexpr int I_IN = (D / 64) * (NPROJ / 32), I_OUT = (D / 64) * (D / 32), I_UP = (D / 64) * (FF / 32), I_DN = (FF / 64) * (D / 32);
    constexpr int PER_LAYER = I_IN + I_OUT + I_UP + I_DN;
    for (int it = gw; it < DEPTH * PER_LAYER; it += NGW) {
        const int l = it / PER_LAYER; int r = it % PER_LAYER; bf16* wl = WSH(WS_W) + (size_t)l * LAYER_W;
        if (r < I_IN) { p0_transpose_item(W_IN + (size_t)l * D * INC, D, INC, NPROJ, wl, scr, r, F.lane); continue; } r -= I_IN;
        if (r < I_OUT) { p0_transpose_item(W_OUT + (size_t)l * D * D, D, D, D, wl + W_OUT_OFF, scr, r, F.lane); continue; } r -= I_OUT;
        if (r < I_UP) { p0_transpose_item(W_UP + (size_t)l * D * FF, D, FF, FF, wl + W_UP_OFF, scr, r, F.lane); continue; } r -= I_UP;
        p0_transpose_item(W_DOWN + (size_t)l * FF * D, FF, D, D, wl + W_DOWN_OFF, scr, r, F.lane);
    }
    for (int o = (int)blockIdx.x * NWAVES * 64 + F.tid; o < DEPTH * 2 * NGB * 4096; o += (int)gridDim.x * NWAVES * 64) {
        const int i = o & 63, j = (o >> 6) & 63, g = (o >> 12) & 7, gate = (o >> 15) & 1, l = o >> 16;
        const float* src = gate ? GATE_X_W : GATE_A_W;
        WSH(WS_GT)[o] = (bf16)f2bf(src[(size_t)(l * NGB + g) * 4096 + i * 64 + j]);
    }
}

template <bool WITH_BG>
DI void p_normmod(Frame& F, int l, const float* xin, const float* normw, int off_sh, int off_sc) {
    LAS float* w8 = (LAS float*)F.lds;
    if (WITH_BG) {
        for (int i = F.tid; i < D * 8; i += NWAVES * 64) w8[i] = W_IN[((size_t)l * D + (i >> 3)) * INC + NPROJ + (i & 7)];
        __syncthreads();
    }
    const int gw = F.vcu * NWAVES + F.wave, NGW = F.G * NWAVES;
    for (int m = gw; m < M; m += NGW) {
        const int b = m >> 12;
        const float* modp = WSF(WS_MOD) + ((size_t)l * BATCH + b) * NMODC;
        f32x4 v[4]; float ss = 0.f;
#pragma unroll
        for (int j = 0; j < 4; ++j) { v[j] = *(const f32x4*)(xin + (size_t)m * D + 4 * F.lane + 256 * j); ss += (v[j].x * v[j].x + v[j].y * v[j].y) + (v[j].z * v[j].z + v[j].w * v[j].w); }
        ss = wave_sum_(F.lane, ss);
        const float rstd = 1.0f / sqrtf(ss * (1.0f / D) + EPS);
        float a0 = 0.f, a1 = 0.f, a2 = 0.f, a3 = 0.f, a4 = 0.f, a5 = 0.f, a6 = 0.f, a7 = 0.f;
#pragma unroll
        for (int j = 0; j < 4; ++j) {
            const int col = 4 * F.lane + 256 * j;
            const f32x4 nw = *(const f32x4*)(normw + (size_t)l * D + col), sc = *(const f32x4*)(modp + off_sc + col), sh = *(const f32x4*)(modp + off_sh + col);
            const f32x4 hv = v[j] * rstd * nw * (sc + 1.0f) + sh;
            v2u o; o.x = pk2(hv.x, hv.y); o.y = pk2(hv.z, hv.w);
            *(v2u*)(WSH(WS_H) + (size_t)m * D + col) = o;
            if (WITH_BG) {
#pragma unroll
                for (int e = 0; e < 4; ++e) { const f32x4 wa = *(const LAS f32x4*)(w8 + (col + e) * 8), wb = *(const LAS f32x4*)(w8 + (col + e) * 8 + 4); const float hh = hv[e];
                    a0 += hh * wa.x; a1 += hh * wa.y; a2 += hh * wa.z; a3 += hh * wa.w; a4 += hh * wb.x; a5 += hh * wb.y; a6 += hh * wb.z; a7 += hh * wb.w; }
            }
        }
        if (WITH_BG) {
            a0 = wave_sum_(F.lane, a0); a1 = wave_sum_(F.lane, a1); a2 = wave_sum_(F.lane, a2); a3 = wave_sum_(F.lane, a3); a4 = wave_sum_(F.lane, a4); a5 = wave_sum_(F.lane, a5); a6 = wave_sum_(F.lane, a6); a7 = wave_sum_(F.lane, a7);
            if (F.lane < 4) {
                const int hh = F.lane;
                const float bpre = hh == 0 ? a0 : hh == 1 ? a1 : hh == 2 ? a2 : a3;
                const float apre = hh == 0 ? a4 : hh == 1 ? a5 : hh == 2 ? a6 : a7;
                const float xx = apre + GDN_DT_BIAS[l * GH + hh];
                const float sp = xx > 20.f ? xx : log1pf(expf(xx));
                WSF(WS_BG)[(size_t)m * 8 + hh] = sigmoidf_(bpre);
                WSF(WS_BG)[(size_t)m * 8 + 4 + hh] = -expf(GDN_A_LOG[l * GH + hh]) * sp;
            }
        }
    }
}

typedef float f32x2_t __attribute__((ext_vector_type(2))); typedef __bf16 bf16x2_t __attribute__((ext_vector_type(2)));
DI unsigned cvtpk(float lo, float hi) { f32x2_t v = {lo, hi}; bf16x2_t b = __builtin_convertvector(v, bf16x2_t); return __builtin_bit_cast(unsigned, b); }
DI bf16x8 pack8(f32x4 a, f32x4 b) { v4u p; p.x = cvtpk(a.x, a.y); p.y = cvtpk(a.z, a.w); p.z = cvtpk(b.x, b.y); p.w = cvtpk(b.z, b.w); return __builtin_bit_cast(bf16x8, p); }
DI bf16x8 ldfrag(const LAS unsigned char* p) { const v2u lo = *(const LAS v2u*)p, hi = *(const LAS v2u*)(p + 32); v4u r; r.x = lo.x; r.y = lo.y; r.z = hi.x; r.w = hi.y; return __builtin_bit_cast(bf16x8, r); }
#define MFMA16(a, b, c) __builtin_amdgcn_mfma_f32_16x16x32_bf16((a), (b), (c), 0, 0, 0)

DI bf16x8 ld128(const LAS unsigned char* p) { return *(const LAS bf16x8*)p; }
DI int kperm4(int k4) { return k4 < 16 ? 2 * k4 : 2 * (k4 - 16) + 4; }
DI int kperm(int k) { return (k & ~31) + kperm4(k & 28) + (k & 3); }
constexpr int PG_QB = 0, PG_KB = 17408, PG_KBET = 34816, PG_VT = 53248, PG_LS = 71680, PG_TS = 89088, PG_TB = 106496, PG_ATT = 115712, PG_XS = 124928, PG_SM = 128000, PG_END = 129024;
static_assert(PG_END <= RING_BYTES, "prep LDS map");
DI void p_prep(Frame& F, int l) {
    const int wave = F.wave;
#define PREP_IDS int tid_ = F.tid; asm volatile("" : "+v"(tid_)); const int tid = tid_, lane = tid & 63, m = lane & 15, q = lane >> 4; (void)m; (void)q;
    for (int item = blockIdx.x; item < BATCH * NCH; item += gridDim.x) {
        const int b = item / NCH, n = item % NCH, row0 = b * SEQ + n * CH, t0 = n * CH;
        {
            LAS float* xr = (LAS float*)F.lds;
            LAS unsigned char* xrb = F.lds + 17408;
            LAS float* sa = (LAS float*)(F.lds + 26624);
            LAS float* sb = (LAS float*)(F.lds + 43264);
            for (int g_ = 0; g_ < NGB * PREP_REP_LRU; ++g_) { const int g = g_ % NGB;
                PREP_IDS
                {
                    const int t = tid >> 3, c0 = (tid & 7) * 8, cc0 = g * 64 + c0;
                    f32x4 a0 = *(const f32x4*)(LRU_CONV_B + l * LRUW + cc0), a1 = *(const f32x4*)(LRU_CONV_B + l * LRUW + cc0 + 4);
#pragma unroll
                    for (int k = 0; k < 4; ++k) { const int tt = t0 + t - 3 + k;
                        if (tt >= 0) { const v4u xw = *(const v4u*)(WSH(WS_PROJ) + (size_t)(b * SEQ + tt) * NPROJ + O_LX + cc0);
                            const f32x4 w0 = *(const f32x4*)(LRU_CONV_W + ((size_t)l * 4 + k) * LRUW + cc0), w1 = *(const f32x4*)(LRU_CONV_W + ((size_t)l * 4 + k) * LRUW + cc0 + 4);
                            a0 += w0 * (f32x4){bflo(xw.x), bfhi(xw.x), bflo(xw.y), bfhi(xw.y)}; a1 += w1 * (f32x4){bflo(xw.z), bfhi(xw.z), bflo(xw.w), bfhi(xw.w)}; } }
                    *(LAS f32x4*)(xr + t * 68 + c0) = a0; *(LAS f32x4*)(xr + t * 68 + c0 + 4) = a1;
                    v4u pk; pk.x = cvtpk(a0.x, a0.y); pk.y = cvtpk(a0.z, a0.w); pk.z = cvtpk(a1.x, a1.y); pk.w = cvtpk(a1.z, a1.w);
                    *(LAS v4u*)(xrb + t * 144 + c0 * 2) = pk;
                }
                __syncthreads();
                {
                    const int mt = wave >> 1;
                    const bf16x8 A0 = ld128(xrb + (16 * mt + m) * 144 + (8 * q) * 2), A1 = ld128(xrb + (16 * mt + m) * 144 + (32 + 8 * q) * 2);
#pragma unroll
                    for (int jj = 0; jj < 2; ++jj) { const int nt = (wave & 1) * 2 + jj, j = 16 * nt + m, cc = g * 64 + j;
                        const bf16* ga = WSH(WS_GT) + ((size_t)((l * 2 + 0) * NGB + g)) * 4096 + (size_t)j * 64 + 8 * q;
                        const bf16* gx = WSH(WS_GT) + ((size_t)((l * 2 + 1) * NGB + g)) * 4096 + (size_t)j * 64 + 8 * q;
                        f32x4 ra = (f32x4){0.f, 0.f, 0.f, 0.f}, ia = (f32x4){0.f, 0.f, 0.f, 0.f};
                        ra = MFMA16(A0, *(const bf16x8*)ga, ra); ra = MFMA16(A1, *(const bf16x8*)(ga + 32), ra);
                        ia = MFMA16(A0, *(const bf16x8*)gx, ia); ia = MFMA16(A1, *(const bf16x8*)(gx + 32), ia);
                        const float lam = LRU_LAMBDA[l * LRUW + cc];
                        const float logsig = -(fmaxf(-lam, 0.f) + log1pf(expf(-fabsf(lam))));
                        const float ba = GATE_A_B[l * LRUW + cc], bx = GATE_X_B[l * LRUW + cc];
#pragma unroll
                        for (int r = 0; r < 4; ++r) { const int t = 16 * mt + 4 * q + r;
                            const float rr = sigmoid_fast(ra[r] + ba), ig = sigmoid_fast(ia[r] + bx);
                            const float log_a = 8.0f * rr * logsig, a = exp_fast(log_a), mult = __builtin_amdgcn_sqrtf(fmaxf(1.0f - exp_fast(2.0f * log_a), 1e-12f));
                            sa[t * 65 + j] = a; sb[t * 65 + j] = mult * (ig * xr[t * 68 + j]); } }
                }
                __syncthreads();
                {
                    float A[8], B[8];
#pragma unroll
                    for (int qq = 0; qq < 8; ++qq) { A[qq] = sa[lane * 65 + wave * 8 + qq]; B[qq] = sb[lane * 65 + wave * 8 + qq]; }
#pragma unroll
                    for (int off = 1; off < 64; off <<= 1) {
                        float Ap[8], Bp[8];
#pragma unroll
                        for (int qq = 0; qq < 8; ++qq) { Ap[qq] = shfl_up_(lane, A[qq], off); Bp[qq] = shfl_up_(lane, B[qq], off); }
#pragma unroll
                        for (int qq = 0; qq < 8; ++qq) if (lane >= off) { B[qq] = A[qq] * Bp[qq] + B[qq]; A[qq] = A[qq] * Ap[qq]; } }
#pragma unroll
                    for (int qq = 0; qq < 8; ++qq) { const int c = wave * 8 + qq; sa[lane * 65 + c] = A[qq]; sb[lane * 65 + c] = B[qq];
                        if (lane == 63) { WSF(WS_AGG)[((size_t)(b * NCH + n)) * LRUW + g * 64 + c] = A[qq]; WSF(WS_AGG)[(size_t)BATCH * NCH * LRUW + ((size_t)(b * NCH + n)) * LRUW + g * 64 + c] = B[qq]; } }
                }
                __syncthreads();
#pragma unroll
                for (int e = 0; e < 8; ++e) { const int idx = tid + 512 * e, t = idx >> 6, c = idx & 63;
                    WSF(WS_H)[(size_t)(row0 + t) * LRUW + g * 64 + c] = sb[t * 65 + c]; WSF(WS_LRUP)[(size_t)(row0 + t) * LRUW + g * 64 + c] = sa[t * 65 + c]; }
                __syncthreads();
            }
        }
        {
            LAS unsigned char* qb = F.lds + PG_QB;
            LAS unsigned char* kb = F.lds + PG_KB;
            LAS unsigned char* kbeT = F.lds + PG_KBET;
            LAS unsigned char* vT = F.lds + PG_VT;
            LAS float* Ls = (LAS float*)(F.lds + PG_LS);
            LAS float* Ts = (LAS float*)(F.lds + PG_TS);
            LAS unsigned char* Tb = F.lds + PG_TB;
            LAS unsigned char* atts = F.lds + PG_ATT;
            LAS float* Xs = (LAS float*)(F.lds + PG_XS);
            LAS float* sm4 = (LAS float*)(F.lds + PG_SM);
            if (wave < GH) { int tl_ = F.tid; asm volatile("" : "+v"(tl_)); const int ln = tl_ & 63, hh = wave;
                float gcv = WSF(WS_BG)[(size_t)(row0 + ln) * 8 + 4 + hh];
#pragma unroll
                for (int off = 1; off < 64; off <<= 1) { const float pv = shfl_up_(ln, gcv, off); if (ln >= off) gcv += pv; }
                const float glast = bperm_(63, gcv);
                sm4[hh * 256 + ln] = gcv; sm4[hh * 256 + 64 + ln] = WSF(WS_BG)[(size_t)(row0 + ln) * 8 + hh]; sm4[hh * 256 + 128 + ln] = expf(gcv); sm4[hh * 256 + 192 + ln] = expf(glast - gcv); }
            __syncthreads();
            for (int h_ = 0; h_ < GH * PREP_REP_GDN; ++h_) { const int h = h_ % GH;
                PREP_IDS
                const size_t item4 = (size_t)(b * GH + h) * NCH + n;
                LAS float* sgc = sm4 + h * 256, *sbeta = sgc + 64, *seg = sgc + 128, *sel = sgc + 192;
                if (tid < 384) {
                    const int cgp = tid & 15, wt = tid >> 4, which = wt >> 3, tr = wt & 7, d0 = cgp * 8, ch0 = which * GDNW + h * HD + d0;
                    v4u xp[11];
#pragma unroll
                    for (int i = 0; i < 11; ++i) { const int tt = t0 + tr * 8 - 3 + i;
                        xp[i] = (tt >= 0) ? *(const v4u*)(WSH(WS_PROJ) + (size_t)(b * SEQ + tt) * NPROJ + O_Q + ch0) : (v4u){0u, 0u, 0u, 0u}; }
                    f32x4 wl_[4], wh_[4];
#pragma unroll
                    for (int k = 0; k < 4; ++k) { wl_[k] = *(const f32x4*)(GDN_CONV_W + ((size_t)l * 4 + k) * (3 * GDNW) + ch0); wh_[k] = *(const f32x4*)(GDN_CONV_W + ((size_t)l * 4 + k) * (3 * GDNW) + ch0 + 4); }
                    f32x4 ol[8], oh[8]; float ss[8];
#pragma unroll
                    for (int tt = 0; tt < 8; ++tt) { f32x4 al = (f32x4){0.f, 0.f, 0.f, 0.f}, ah = (f32x4){0.f, 0.f, 0.f, 0.f};
#pragma unroll
                        for (int k = 0; k < 4; ++k) { const v4u xw = xp[tt + k];
                            al += wl_[k] * (f32x4){bflo(xw.x), bfhi(xw.x), bflo(xw.y), bfhi(xw.y)}; ah += wh_[k] * (f32x4){bflo(xw.z), bfhi(xw.z), bflo(xw.w), bfhi(xw.w)}; }
#pragma unroll
                        for (int c = 0; c < 4; ++c) { al[c] = silu_fast(al[c]); ah[c] = silu_fast(ah[c]); }
                        ol[tt] = al; oh[tt] = ah;
                        ss[tt] = (al.x * al.x + al.y * al.y) + (al.z * al.z + al.w * al.w) + (ah.x * ah.x + ah.y * ah.y) + (ah.z * ah.z + ah.w * ah.w); }
                    if (which < 2) {
#pragma unroll
                        for (int tt = 0; tt < 8; ++tt) { float v = ss[tt]; v += bperm_(lane ^ 1, v); v += bperm_(lane ^ 2, v); v += bperm_(lane ^ 4, v); v += bperm_(lane ^ 8, v);
                            const float scl = __builtin_amdgcn_rsqf(v + 1e-6f) * (which == 0 ? 0.08838834764831845f : 1.0f); ol[tt] = ol[tt] * scl; oh[tt] = oh[tt] * scl; }
                    }
                    const int tb = tr * 8;
                    if (which == 0) {
#pragma unroll
                        for (int tt = 0; tt < 8; ++tt) { const int t = tb + tt; const float eg = seg[t];
                            v4u pk; pk.x = cvtpk(ol[tt].x, ol[tt].y); pk.y = cvtpk(ol[tt].z, ol[tt].w); pk.z = cvtpk(oh[tt].x, oh[tt].y); pk.w = cvtpk(oh[tt].z, oh[tt].w);
                            *(LAS v4u*)(qb + t * 272 + d0 * 2) = pk;
                            v4u pg; pg.x = cvtpk(ol[tt].x * eg, ol[tt].y * eg); pg.y = cvtpk(ol[tt].z * eg, ol[tt].w * eg); pg.z = cvtpk(oh[tt].x * eg, oh[tt].y * eg); pg.w = cvtpk(oh[tt].z * eg, oh[tt].w * eg);
                            { bf16* qrow = WSH(WS_GQD) + item4 * 8192 + t * 128 + (d0 & ~31); const int kl = d0 & 31;
                                v2u p0; p0.x = pg.x; p0.y = pg.y; v2u p1; p1.x = pg.z; p1.y = pg.w; *(v2u*)(qrow + kperm4(kl)) = p0; *(v2u*)(qrow + kperm4(kl + 4)) = p1; } }
                    } else if (which == 1) {
                        float fb[8], fl[8];
#pragma unroll
                        for (int tt = 0; tt < 8; ++tt) { const int t = tb + tt; fb[tt] = sbeta[t] * seg[t]; fl[tt] = sel[t];
                            v4u pk; pk.x = cvtpk(ol[tt].x, ol[tt].y); pk.y = cvtpk(ol[tt].z, ol[tt].w); pk.z = cvtpk(oh[tt].x, oh[tt].y); pk.w = cvtpk(oh[tt].z, oh[tt].w);
                            *(LAS v4u*)(kb + t * 272 + d0 * 2) = pk; }
#pragma unroll
                        for (int c = 0; c < 8; ++c) {
#define KV_(tt) ((c) < 4 ? ol[tt][(c) & 3] : oh[tt][(c) & 3])
                            v4u pe; pe.x = cvtpk(KV_(0) * fb[0], KV_(1) * fb[1]); pe.y = cvtpk(KV_(2) * fb[2], KV_(3) * fb[3]); pe.z = cvtpk(KV_(4) * fb[4], KV_(5) * fb[5]); pe.w = cvtpk(KV_(6) * fb[6], KV_(7) * fb[7]);
                            *(LAS v4u*)(kbeT + (d0 + c) * 144 + tb * 2) = pe;
                            v4u pt; pt.x = cvtpk(KV_(0) * fl[0], KV_(1) * fl[1]); pt.y = cvtpk(KV_(2) * fl[2], KV_(3) * fl[3]); pt.z = cvtpk(KV_(4) * fl[4], KV_(5) * fl[5]); pt.w = cvtpk(KV_(6) * fl[6], KV_(7) * fl[7]);
                            { bf16* krow = WSH(WS_GKT) + item4 * 8192 + (d0 + c) * 64 + (tb & ~31); const int kl = tb & 31;
                                v2u p0; p0.x = pt.x; p0.y = pt.y; v2u p1; p1.x = pt.z; p1.y = pt.w; *(v2u*)(krow + kperm4(kl)) = p0; *(v2u*)(krow + kperm4(kl + 4)) = p1; } }
                    } else {
                        float fb[8];
#pragma unroll
                        for (int tt = 0; tt < 8; ++tt) fb[tt] = sbeta[tb + tt];
#pragma unroll
                        for (int c = 0; c < 8; ++c) {
                            v4u pe; pe.x = cvtpk(KV_(0) * fb[0], KV_(1) * fb[1]); pe.y = cvtpk(KV_(2) * fb[2], KV_(3) * fb[3]); pe.z = cvtpk(KV_(4) * fb[4], KV_(5) * fb[5]); pe.w = cvtpk(KV_(6) * fb[6], KV_(7) * fb[7]);
                            *(LAS v4u*)(vT + (d0 + c) * 144 + tb * 2) = pe; }
#undef KV_
                    }
                }
                __syncthreads();
                {
                    const int it = wave >> 1;
#pragma unroll
                    for (int jj = 0; jj < 2; ++jj) { const int jt = (wave & 1) * 2 + jj;
                        f32x4 kk = (f32x4){0.f, 0.f, 0.f, 0.f}, qk = (f32x4){0.f, 0.f, 0.f, 0.f};
                        if (jt <= it) {
#pragma unroll
                            for (int ks = 0; ks < 4; ++ks) { const bf16x8 Bk = ld128(kb + (16 * jt + m) * 272 + (32 * ks + 8 * q) * 2);
                                kk = MFMA16(ld128(kb + (16 * it + m) * 272 + (32 * ks + 8 * q) * 2), Bk, kk); qk = MFMA16(ld128(qb + (16 * it + m) * 272 + (32 * ks + 8 * q) * 2), Bk, qk); } }
                        const int j = 16 * jt + m; const float gj = sgc[j];
#pragma unroll
                        for (int r = 0; r < 4; ++r) { const int i = 16 * it + 4 * q + r;
                            const float dec = (j <= i) ? exp_fast(sgc[i] - gj) : 0.f;
                            Ls[i * 68 + j] = (j < i) ? sbeta[i] * kk[r] * dec : 0.f;
                            *(LAS unsigned short*)(atts + i * 144 + kperm(j) * 2) = (unsigned short)f2bf((j <= i) ? qk[r] * dec : 0.f); } }
                }
                __syncthreads();
                if (tid < 64) { const int bk = tid >> 4, c = tid & 15; float x[16];
                    const LAS float* lb = Ls + (16 * bk) * 68 + 16 * bk;
#pragma unroll
                    for (int r = 0; r < 16; ++r) { float acc = (r == c) ? 1.f : 0.f;
#pragma unroll
                        for (int m4 = 0; m4 < (r + 3) / 4; ++m4) { const f32x4 lv = *(const LAS f32x4*)(lb + r * 68 + 4 * m4);
                            if (4 * m4 + 0 < r) acc -= lv.x * x[4 * m4 + 0]; if (4 * m4 + 1 < r) acc -= lv.y * x[4 * m4 + 1]; if (4 * m4 + 2 < r) acc -= lv.z * x[4 * m4 + 2]; if (4 * m4 + 3 < r) acc -= lv.w * x[4 * m4 + 3]; }
                        x[r] = acc; Ts[(16 * bk + r) * 68 + 16 * bk + c] = acc; } }
                __syncthreads();
#pragma unroll 1
                for (int dl = 1; dl < 4; ++dl) {
                    const int nout = (4 - dl) * 256;
                    for (int idx = tid; idx < nout; idx += NWAVES * 64) { const int blk = idx >> 8, r = (idx >> 4) & 15, c = idx & 15, i = blk + dl, j = blk; float acc = 0.f;
                        const LAS float* lrow = Ls + (16 * i + r) * 68 + 16 * j; const LAS float* tcol = Ts + (16 * j) * 68 + 16 * j + c;
                        for (int kk = 0; kk < dl; ++kk) {
#pragma unroll
                            for (int mm = 0; mm < 16; mm += 4) { const f32x4 lv = *(const LAS f32x4*)(lrow + 16 * kk + mm); const LAS float* tc = tcol + (16 * kk + mm) * 68;
                                acc += lv.x * tc[0] + lv.y * tc[68] + lv.z * tc[136] + lv.w * tc[204]; } }
                        Xs[idx] = acc; }
                    __syncthreads();
                    for (int idx = tid; idx < nout; idx += NWAVES * 64) { const int blk = idx >> 8, r = (idx >> 4) & 15, c = idx & 15, i = blk + dl, j = blk; float acc = 0.f;
                        const LAS float* trow = Ts + (16 * i + r) * 68 + 16 * i; const LAS float* xc = Xs + blk * 256 + c;
#pragma unroll
                        for (int mm = 0; mm < 16; mm += 4) { const f32x4 tv = *(const LAS f32x4*)(trow + mm); acc -= tv.x * xc[(mm + 0) * 16] + tv.y * xc[(mm + 1) * 16] + tv.z * xc[(mm + 2) * 16] + tv.w * xc[(mm + 3) * 16]; }
                        Ts[(16 * i + r) * 68 + 16 * j + c] = acc; }
                    __syncthreads();
                }
#pragma unroll
                for (int e = 0; e < 8; ++e) { const int idx = tid + 512 * e, i = idx >> 6, j = idx & 63;
                    *(LAS unsigned short*)(Tb + i * 144 + j * 2) = (unsigned short)(((j >> 4) <= (i >> 4)) ? f2bf(Ts[i * 68 + j]) : 0u); }
                __syncthreads();
                {
                    const int nt = wave;
#pragma unroll
                    for (int mt = 0; mt < 4; ++mt) { f32x4 ua = (f32x4){0.f, 0.f, 0.f, 0.f}, wa = (f32x4){0.f, 0.f, 0.f, 0.f};
#pragma unroll
                        for (int ks = 0; ks < 2; ++ks) if (32 * ks <= 16 * mt + 15) { const bf16x8 A = ld128(Tb + (16 * mt + m) * 144 + (32 * ks + 8 * q) * 2);
                            ua = MFMA16(A, ld128(vT + (16 * nt + m) * 144 + (32 * ks + 8 * q) * 2), ua); wa = MFMA16(A, ld128(kbeT + (16 * nt + m) * 144 + (32 * ks + 8 * q) * 2), wa); }
unsigned uts[4];
#pragma unroll
                        for (int r = 0; r < 4; ++r) { const int t = 16 * mt + 4 * q + r, d = 16 * nt + m;
                            uts[r] = f2bf(ua[r]); *(LAS unsigned short*)(kb + t * 272 + kperm(d) * 2) = (unsigned short)f2bf(-wa[r]); }
                        { v2u pu; pu.x = uts[0] | (uts[1] << 16); pu.y = uts[2] | (uts[3] << 16); *(LAS v2u*)(F.lds + PG_LS + (16 * nt + m) * 144 + (16 * mt + 4 * q) * 2) = pu; } }
                }
                __syncthreads();
#pragma unroll
                for (int e = 0; e < 2; ++e) { const int p = tid + 512 * e, row = p >> 4, c16 = p & 15;
                    *(v4u*)((unsigned char*)(WSH(WS_MIX + 16 * MiB) + item4 * 8192) + row * 256 + c16 * 16) = *(const LAS v4u*)(kb + row * 272 + c16 * 16);
                    const int ur = p >> 3, uc = p & 7;
                    *(v4u*)((unsigned char*)(WSH(WS_MIX) + item4 * 8192) + ur * 128 + uc * 16) = *(const LAS v4u*)(F.lds + PG_LS + ur * 144 + uc * 16); }
                { const int row = tid >> 3, c16 = tid & 7;
                    *(v4u*)((unsigned char*)(WSH(WS_GATT) + item4 * 4096) + row * 128 + c16 * 16) = *(const LAS v4u*)(atts + row * 144 + c16 * 16); }
                if (tid == 0) WSF(WS_GL)[item4] = seg[63];
                __syncthreads();
            }
        }
    }
}

#undef PREP_IDS
constexpr int SC_W = 0, SC_QD = 18432, SC_KT = 36864, SC_AT = 57344, SC_U = 67584, SC_STAGE = 76800;
static_assert(2 * SC_STAGE <= RING_BYTES, "scan stages fit the ring");
#define SBAR_() __builtin_amdgcn_sched_barrier(0)
#define WG_BAR() do { asm volatile("s_waitcnt lgkmcnt(0)" ::: "memory"); __builtin_amdgcn_s_barrier(); asm volatile("" ::: "memory"); } while (0)
template <int MODE  >
DI void p_scan(Frame& F, int l) {
    const int tid = F.tid, lane = F.lane, wave = F.wave;
    if (MODE == 0) for (int p = blockIdx.x * NWAVES + wave; p < BATCH * LRUW; p += gridDim.x * NWAVES) { const int b = p / LRUW, c = p % LRUW;
        float A = WSF(WS_AGG)[((size_t)(b * NCH + lane)) * LRUW + c], B = WSF(WS_AGG)[(size_t)BATCH * NCH * LRUW + ((size_t)(b * NCH + lane)) * LRUW + c];
#pragma unroll
        for (int off = 1; off < 64; off <<= 1) { const float Ap = shfl_up_(F.lane, A, off), Bp = shfl_up_(F.lane, B, off); if (lane >= off) { B = A * Bp + B; A = A * Ap; } }
        if (lane < 63) WSF(WS_CARRY)[((size_t)(b * NCH + lane + 1)) * LRUW + c] = B; else WSF(WS_CARRY)[((size_t)(b * NCH)) * LRUW + c] = 0.f; }
    const bool is_loader = wave >= 4;
    const int wv = wave & 3, m = lane & 15, q = lane >> 4, lt = tid & 255;
    for (int item = blockIdx.x; item < BATCH * GH * 2; item += gridDim.x) {
        const int bh = item >> 1, dvbase = (item & 1) * 64, b = bh >> 2, h = bh & 3;
        const size_t it0 = (size_t)bh * NCH;
        const unsigned char* gW = (const unsigned char*)(WSH(WS_MIX + 16 * MiB) + it0 * 8192);
        const unsigned char* gQD = (const unsigned char*)(WSH(WS_GQD) + it0 * 8192);
        const unsigned char* gKT = (const unsigned char*)(WSH(WS_GKT) + it0 * 8192);
        const unsigned char* gAT = (const unsigned char*)(WSH(WS_GATT) + it0 * 4096);
        const unsigned char* gU = (const unsigned char*)(WSH(WS_MIX) + it0 * 8192) + dvbase * 128;
#define SC_LOAD(rg, n_) do { const size_t cb = (size_t)(n_) * 16384, ca = (size_t)(n_) * 8192; \
            _Pragma("unroll") for (int i = 0; i < 4; ++i) { const int p = lt + 256 * i; rg[i] = *(const v4u*)(gW + cb + (p >> 4) * 256 + (p & 15) * 16); rg[4 + i] = *(const v4u*)(gQD + cb + (p >> 4) * 256 + (p & 15) * 16); \
                rg[8 + i] = *(const v4u*)(gKT + cb + (p >> 3) * 128 + (p & 7) * 16); } \
            _Pragma("unroll") for (int i = 0; i < 2; ++i) { const int p = lt + 256 * i; rg[12 + i] = *(const v4u*)(gAT + ca + (p >> 3) * 128 + (p & 7) * 16); rg[14 + i] = *(const v4u*)(gU + cb + (p >> 3) * 128 + (p & 7) * 16); } } while (0)
#define SC_WRITE(rg, buf_) do { LAS unsigned char* sb_ = F.lds + (buf_) * SC_STAGE; \
            _Pragma("unroll") for (int i = 0; i < 4; ++i) { const int p = lt + 256 * i; *(LAS v4u*)(sb_ + SC_W + (p >> 4) * 288 + (p & 15) * 16) = rg[i]; *(LAS v4u*)(sb_ + SC_QD + (p >> 4) * 288 + (p & 15) * 16) = rg[4 + i]; \
                *(LAS v4u*)(sb_ + SC_KT + (p >> 3) * 160 + (p & 7) * 16) = rg[8 + i]; } \
            _Pragma("unroll") for (int i = 0; i < 2; ++i) { const int p = lt + 256 * i; *(LAS v4u*)(sb_ + SC_AT + (p >> 3) * 160 + (p & 7) * 16) = rg[12 + i]; *(LAS v4u*)(sb_ + SC_U + (p >> 3) * 144 + (p & 7) * 16) = rg[14 + i]; } } while (0)
        if (is_loader) {
            v4u ra[16], rb[16];
            SC_LOAD(ra, 0); SC_WRITE(ra, 0); SC_LOAD(ra, 1); SC_LOAD(rb, 2);
            __syncthreads();
#pragma unroll 1
            for (int n = 0; n < NCH; n += 2) {
                SC_WRITE(ra, 1);
                if (MODE != 1) { const int nn = n + 3 < NCH ? n + 3 : NCH - 1; SC_LOAD(ra, nn); }
                WG_BAR();
                SC_WRITE(rb, 0);
                if (MODE != 1) { const int nn = n + 4 < NCH ? n + 4 : NCH - 1; SC_LOAD(rb, nn); }
                WG_BAR();
            }
        } else {
            f32x4 Sacc[8];
#pragma unroll
            for (int dt = 0; dt < 8; ++dt) Sacc[dt] = (f32x4){0.f, 0.f, 0.f, 0.f};
            const float glv = WSF(WS_GL)[it0 + lane];
            __syncthreads();
#define FR_W(dst, mt_) do { _Pragma("unroll") for (int kb = 0; kb < 4; ++kb) { dst[kb] = ld128(B + SC_W + (16 * (mt_) + m) * 288 + (32 * kb + 8 * q) * 2); dst[4 + kb] = ld128(B + SC_QD + (16 * (mt_) + m) * 288 + (32 * kb + 8 * q) * 2); } } while (0)
#define MM_W(src, mt_) do { _Pragma("unroll") for (int kb = 0; kb < 4; ++kb) { vn[mt_] = MFMA16(src[kb], Sb[kb], vn[mt_]); o[mt_] = MFMA16(src[4 + kb], Sb[kb], o[mt_]); } } while (0)
#define FR_KT(dst, hf_) do { _Pragma("unroll") for (int i = 0; i < 8; ++i) dst[i] = ld128(B + SC_KT + (16 * (4 * (hf_) + (i >> 1)) + m) * 160 + (32 * (i & 1) + 8 * q) * 2); } while (0)
#define MM_KT(src, hf_) do { _Pragma("unroll") for (int i = 0; i < 8; ++i) Sacc[4 * (hf_) + (i >> 1)] = MFMA16(src[i], vnb[i & 1], Sacc[4 * (hf_) + (i >> 1)]); } while (0)
#pragma unroll 1
            for (int n = 0; n < NCH; ++n) {
                if (MODE == 2) { WG_BAR(); continue; }
                const LAS unsigned char* B = F.lds + (n & 1) * SC_STAGE;
                bf16x8 fa[8], fb[8], Sb[4], vnb[2];
                f32x4 vn[4], o[4];
                v2u ut[4];
#pragma unroll
                for (int mt = 0; mt < 4; ++mt) ut[mt] = *(const LAS v2u*)(B + SC_U + (16 * wv + m) * 144 + (16 * mt + 4 * q) * 2);
                FR_W(fa, 0); SBAR_();
#pragma unroll
                for (int kb = 0; kb < 4; ++kb) Sb[kb] = pack8(Sacc[2 * kb], Sacc[2 * kb + 1]);
#pragma unroll
                for (int mt = 0; mt < 4; ++mt) { o[mt] = (f32x4){0.f, 0.f, 0.f, 0.f}; vn[mt] = (f32x4){bflo(ut[mt].x), bfhi(ut[mt].x), bflo(ut[mt].y), bfhi(ut[mt].y)}; }
                const float gl = __builtin_bit_cast(float, __builtin_amdgcn_readlane(__builtin_bit_cast(int, glv), n));
                SBAR_(); FR_W(fb, 1); SBAR_(); MM_W(fa, 0); SBAR_();
                FR_W(fa, 2); SBAR_(); MM_W(fb, 1); SBAR_();
                FR_W(fb, 3); SBAR_(); MM_W(fa, 2); SBAR_();
                fa[0] = ld128(B + SC_AT + (m) * 160 + (8 * q) * 2); fa[1] = ld128(B + SC_AT + (16 + m) * 160 + (8 * q) * 2);
                fa[2] = ld128(B + SC_AT + (32 + m) * 160 + (8 * q) * 2); fa[3] = ld128(B + SC_AT + (32 + m) * 160 + (32 + 8 * q) * 2);
                fa[4] = ld128(B + SC_AT + (48 + m) * 160 + (8 * q) * 2); fa[5] = ld128(B + SC_AT + (48 + m) * 160 + (32 + 8 * q) * 2);
                SBAR_(); MM_W(fb, 3); SBAR_();
                vnb[0] = pack8(vn[0], vn[1]); vnb[1] = pack8(vn[2], vn[3]);
#pragma unroll
                for (int dt = 0; dt < 8; ++dt) Sacc[dt] = Sacc[dt] * gl;
                SBAR_(); FR_KT(fb, 0); SBAR_();
                o[0] = MFMA16(fa[0], vnb[0], o[0]); o[1] = MFMA16(fa[1], vnb[0], o[1]); o[2] = MFMA16(fa[2], vnb[0], o[2]); o[3] = MFMA16(fa[4], vnb[0], o[3]);
                o[2] = MFMA16(fa[3], vnb[1], o[2]); o[3] = MFMA16(fa[5], vnb[1], o[3]);
                SBAR_(); FR_KT(fa, 1); SBAR_(); MM_KT(fb, 0); SBAR_();
                MM_KT(fa, 1); SBAR_();
                float* go = (MODE == 0 ? WSF(WS_GO) : WSF(WS_END)) + (MODE == 0 ? (size_t)(b * SEQ + n * CH + 4 * q) * GDNW + h * HD + dvbase + 16 * wv + m : (size_t)(4 * q) * GDNW + m);
#pragma unroll
                for (int mt = 0; mt < 4; ++mt)
#pragma unroll
                    for (int r = 0; r < 4; ++r) go[(size_t)(16 * mt + r) * GDNW] = o[mt][r];
                WG_BAR();
            }
#undef FR_W
#undef MM_W
#undef FR_KT
#undef MM_KT
        }
#undef SC_LOAD
#undef SC_WRITE
    }
}

DI void p_post(Frame& F, int l) {
    const int gw = F.vcu * NWAVES + F.wave, NGW = F.G * NWAVES, lane = F.lane;
    for (int m = gw; m < M; m += NGW) {
        const int b = m >> 12, n = (m & (SEQ - 1)) >> 6;
        f32x4 val[2]; float ss = 0.f;
#pragma unroll
        for (int j = 0; j < 2; ++j) { const int c = 4 * lane + 256 * j;
            const f32x4 hl = *(const f32x4*)(WSF(WS_H) + (size_t)m * LRUW + c), p = *(const f32x4*)(WSF(WS_LRUP) + (size_t)m * LRUW + c), cr = *(const f32x4*)(WSF(WS_CARRY) + ((size_t)(b * NCH + n)) * LRUW + c);
            const v2u y2 = *(const v2u*)(WSH(WS_PROJ) + (size_t)m * NPROJ + O_LY + c);
            const f32x4 hh = hl + p * cr;
            val[j] = (f32x4){hh.x * gelu_tanh(bflo(y2.x)), hh.y * gelu_tanh(bfhi(y2.x)), hh.z * gelu_tanh(bflo(y2.y)), hh.w * gelu_tanh(bfhi(y2.y))};
            ss += (val[j].x * val[j].x + val[j].y * val[j].y) + (val[j].z * val[j].z + val[j].w * val[j].w); }
        ss = wave_sum_(F.lane, ss);
        const float rl = 1.0f / sqrtf(ss * (1.0f / LRUW) + EPS);
#pragma unroll
        for (int j = 0; j < 2; ++j) { const int c = 4 * lane + 256 * j; const f32x4 nw = *(const f32x4*)(LRU_NORM_W + (size_t)l * LRUW + c);
            const f32x4 o = val[j] * rl * nw; v2u w; w.x = pk2(o.x, o.y); w.y = pk2(o.z, o.w); *(v2u*)(WSH(WS_MIX) + (size_t)m * D + c) = w; }
#pragma unroll
        for (int j = 0; j < 2; ++j) { const int c = 4 * lane + 256 * j, d = c & (HD - 1);
            const f32x4 o = *(const f32x4*)(WSF(WS_GO) + (size_t)m * GDNW + c);
            const float s2 = half_sum_(F.lane, (o.x * o.x + o.y * o.y) + (o.z * o.z + o.w * o.w));
            const float rg = 1.0f / sqrtf(s2 * (1.0f / HD) + EPS);
            const f32x4 nw = *(const f32x4*)(GDN_NORM_W + (size_t)l * HD + d);
            const v2u z2 = *(const v2u*)(WSH(WS_PROJ) + (size_t)m * NPROJ + O_Z + c);
            const f32x4 r = (f32x4){o.x * rg * nw.x * siluf_(bflo(z2.x)), o.y * rg * nw.y * siluf_(bfhi(z2.x)), o.z * rg * nw.z * siluf_(bflo(z2.y)), o.w * rg * nw.w * siluf_(bfhi(z2.y))};
            v2u w; w.x = pk2(r.x, r.y); w.y = pk2(r.z, r.w); *(v2u*)(WSH(WS_MIX) + (size_t)m * D + LRUW + c) = w; }
    }
}

DI void p_final(Frame& F) {
    const int gw = F.vcu * NWAVES + F.wave, NGW = F.G * NWAVES, lane = F.lane;
    for (int m = gw; m < M; m += NGW) {
        f32x4 v[4]; float ss = 0.f;
#pragma unroll
        for (int j = 0; j < 4; ++j) { v[j] = *(const f32x4*)(OUT_ + (size_t)m * D + 4 * lane + 256 * j); ss += (v[j].x * v[j].x + v[j].y * v[j].y) + (v[j].z * v[j].z + v[j].w * v[j].w); }
        ss = wave_sum_(F.lane, ss);
        const float rstd = 1.0f / sqrtf(ss * (1.0f / D) + EPS);
#pragma unroll
        for (int j = 0; j < 4; ++j) { const int col = 4 * lane + 256 * j; const f32x4 nw = *(const f32x4*)(FINAL_NORM_W + col); *(f32x4*)(OUT_ + (size_t)m * D + col) = v[j] * rstd * nw; }
    }
}

__device__ __forceinline__ void pg8::EpiMulti::operator()(const f32x4 (&acc)[2][2][4][2], const Unit& u, int wr, int wc, int fr, int fq) const {
    const __attribute__((address_space(4))) Args* ap = (const __attribute__((address_space(4))) Args*)__builtin_amdgcn_kernarg_segment_ptr(); asm volatile("" : "+s"(ap));
    unsigned char* ws = ap->ws;
    if (mode == 0) { EpiBf16<0> e{(bf16_t*)(ws + WS_PROJ), NPROJ, nullptr, 0, 0, 1.f}; e(acc, u, wr, wc, fr, fq); }
    else if (mode == 2) { EpiBf16<2> e{(bf16_t*)(ws + WS_ACT), FF, nullptr, 0, 0, 1.f}; e(acc, u, wr, wc, fr, fq); }
    else { const float* modl = (const float*)(ws + WS_MOD) + (size_t)l * BATCH * NMODC + (mode == 3 ? 2 * D : 5 * D);
        EpiResid r{(mode == 3 && l == 0) ? ap->in[0] : ap->out, ap->out, modl, D, NMODC, SEQ}; r(acc, u, wr, wc, fr, fq); }
}

__global__ void __launch_bounds__(NWAVES * 64, 2) mk_fwd(Args args) {
    extern __shared__ __attribute__((aligned(16))) unsigned char lds[];
    Frame F;
    F.lds = (LAS unsigned char*)lds;
    F.MISC = (volatile LAS unsigned*)(F.lds + MISC_OFF);
    F.tid = threadIdx.x; F.lane = F.tid & 63; F.wave = __builtin_amdgcn_readfirstlane(F.tid >> 6);
    F.G = gridDim.x; { const int bx = blockIdx.x; F.vcu = (F.G % 8 == 0) ? (bx % 8) * (F.G / 8) + bx / 8 : bx; }
    F.A = (const __attribute__((address_space(4))) Args*)__builtin_amdgcn_kernarg_segment_ptr();
    F.ctl = (gu32*)(F.A->ws + WS_CTL);
    for (int u = F.tid; u < (LDS_BYTES - LDSCTL_OFF) / 4; u += NWAVES * 64) ((LAS unsigned*)(F.lds + LDSCTL_OFF))[u] = 0u;
    __syncthreads();
    XcdBarrier bar; bar.bar = (unsigned*)(F.ctl + CW_BAR); bar.x = 0; bar.st = nullptr;
    if (N_LAUNCHES == 1) bar = xcd_barrier_post((unsigned*)(F.ctl + CW_BAR), F.MISC + 8);

    const int lo = F.A->ph_lo, hi = F.A->ph_hi;
    int rep_done = 0;
#pragma unroll 1
    for (int s = lo; s < hi; ++s) {
        { const __attribute__((address_space(4))) Args* ap = (const __attribute__((address_space(4))) Args*)__builtin_amdgcn_kernarg_segment_ptr(); asm volatile("" : "+s"(ap)); F.A = ap; }
        { int t_ = threadIdx.x; asm volatile("" : "+v"(t_)); F.tid = t_; F.lane = t_ & 63; F.wave = __builtin_amdgcn_readfirstlane(t_ >> 6); }
        if (s == 0) { if (PH_MASK & 1) { p_mod(F); __syncthreads(); p0_weights(F); } }
        else if (s == N_STEPS - 1) { if (PH_MASK & 2) p_final(F); }
        else {
            const int l = (s - 1) / 9, i = (s - 1) % 9;
            bf16* wl = WSH(WS_W) + (size_t)l * LAYER_W;
            const float* modl = WSF(WS_MOD) + (size_t)l * BATCH * NMODC;
            if (!((PH_MASK >> (2 + i)) & 1)) {}
            else if (i == 0) { p_normmod<true>(F, l, l == 0 ? X_IN : OUT_, NORM_MIX_W, 0, D); }
            else if (i == 2) { p_prep(F, l); }
            else if (i == 3) { p_scan<0>(F, l);
#ifdef PROBE_SCAN_MODE
                __syncthreads(); p_scan<PROBE_SCAN_MODE>(F, l);
#endif
            }
            else if (i == 4) { p_post(F, l); }
            else if (i == 6) { p_normmod<false>(F, l, OUT_, NORM_MLP_W, 3 * D, 4 * D); }
            else {
                pg8::Gemm g; pg8::EpiMulti E; E.l = l;
                if (i == 1) { g = pg8::Gemm{WSH(WS_H), wl, M, NPROJ, D}; E.PERM = true; E.mode = 0; }
                else if (i == 5) { g = pg8::Gemm{WSH(WS_MIX), wl + W_OUT_OFF, M, D, D}; E.PERM = false; E.mode = 3; }
                else if (i == 7) { g = pg8::Gemm{WSH(WS_H), wl + W_UP_OFF, M, FF, D}; E.PERM = true; E.mode = 2; }
                else { g = pg8::Gemm{WSH(WS_ACT), wl + W_DOWN_OFF, M, D, FF}; E.PERM = false; E.mode = 4; }
                pg8::StaticOrder S; S.init(g.M, g.N, F.G, (int)blockIdx.x);
                pg8::gemm_phase<pg8::EpiMulti, pg8::StaticOrder, PG8_ALIGN, PG8_SP2>(F.lds + RING_OFF, g, S, E);
            }
        }
        if (REP_MASK != 0 && s >= 1 && s < N_STEPS - 1 && ((REP_MASK >> ((s - 1) % 9)) & 1) && !rep_done) { rep_done = 1; --s; xcd_barrier(bar, F.tid == 0); continue; }
        rep_done = 0;
        if (s + 1 < hi) xcd_barrier(bar, F.tid == 0);
    }
}

extern "C" void kernel_launch(void* const* d_in, const int* in_sizes, int n_in, void* d_out, int out_size, void* d_ws, size_t ws_size, hipStream_t stream) {
    static int grid = 0;
    if (grid == 0) {
        if (n_in != 23 || in_sizes[0] != M * D || out_size != M * D || ws_size < WS_END) { fprintf(stderr, "kernel_launch: unexpected shapes (n_in %d, in0 %d, out %d, ws %zu); nothing launched\n", n_in, n_in > 0 ? in_sizes[0] : -1, out_size, ws_size); grid = -1; return; }
        int dev = 0, cus = 0;
        if (hipGetDevice(&dev) != hipSuccess || hipDeviceGetAttribute(&cus, hipDeviceAttributeMultiprocessorCount, dev) != hipSuccess) { grid = -1; return; }
        if (hipFuncSetAttribute((const void*)mk_fwd, hipFuncAttributeMaxDynamicSharedMemorySize, LDS_BYTES) != hipSuccess) { fprintf(stderr, "kernel_launch: hipFuncSetAttribute failed\n"); grid = -1; return; }
        (void)hipGetLastError();
        grid = cus;
    }
    if (grid < 0) return;
    if (hipMemsetAsync((char*)d_ws + WS_CTL, 0, CTL_ZERO_BYTES, stream) != hipSuccess) return;
    Args a{};
    for (int i = 0; i < 23; ++i) a.in[i] = (const float*)d_in[i];
    a.out = (float*)d_out; a.ws = (unsigned char*)d_ws;
    if (N_LAUNCHES == 1) { a.ph_lo = 0; a.ph_hi = N_STEPS; hipLaunchKernelGGL(mk_fwd, dim3(grid), dim3(NWAVES * 64), LDS_BYTES, stream, a); }
    else for (int s = 0; s < N_STEPS; ++s) { a.ph_lo = s; a.ph_hi = s + 1; hipLaunchKernelGGL(mk_fwd, dim3(grid), dim3(NWAVES * 64), LDS_BYTES, stream, a); }
}
```

```cpp
#include <hip/hip_runtime.h>
#include <cstdio>
#include <cstdint>
#include <cmath>
namespace pg8 {
#define PG8_LAS __attribute__((address_space(3)))
typedef unsigned short bf16_t;
typedef short bf16x8 __attribute__((ext_vector_type(8)));
typedef float f32x4 __attribute__((ext_vector_type(4)));
typedef unsigned u32x4 __attribute__((ext_vector_type(4)));
constexpr int BM = 256, BK = 64, HALF = 128, HTB = HALF * BK * 2  , STAGE_BYTES = 8 * HTB, NXCD = 8, WGM = 8;

__host__ __device__ __forceinline__ int lds_byte(int r, int c) { const int st = (r >> 4) * 2 + (c >> 5), rr = r & 15, cc = c & 31, ob = rr * 64 + cc * 2; return st * 1024 + (ob ^ (((ob >> 9) & 1) << 5)); }
__host__ __device__ __forceinline__ void stage_rc(int b, int& R, int& C) { const int st = b / 1024, sb = b % 1024, swz = sb ^ (((sb >> 9) & 1) << 5); R = (st >> 1) * 16 + swz / 64; C = (st & 1) * 32 + (swz % 64) / 2; }
__host__ __device__ __forceinline__ int perm32(int rho) { const int n = rho >> 4, i = rho & 15; return 8 * (i >> 2) + 4 * n + (i & 3); }

struct Unit { int pm, pn; };
struct Gemm { const bf16_t* A; const bf16_t* Bt; int M, N, K; };

struct StaticOrder {
    int nM, nN, nwg, G, c;
    __host__ __device__ void init(int M, int N, int G_, int c_) { nM = M / BM; nN = N / BM; nwg = nM * nN; G = G_; c = c_; }
    __host__ __device__ bool next(int i, Unit& u) const {
        const long L = (long)i * G + c; if (L >= nwg) return false;
        int wgid = (int)L; { const int q = nwg / NXCD, r = nwg % NXCD, xcd = wgid % NXCD, off = wgid / NXCD; wgid = (xcd < r ? xcd * (q + 1) : r * (q + 1) + (xcd - r) * q) + off; }
        const int nig = WGM * nN, gid = wgid / nig, fm = gid * WGM, gsz = (nM - fm) < WGM ? (nM - fm) : WGM;
        u.pm = fm + ((wgid % nig) % gsz); u.pn = (wgid % nig) / gsz; return true;
    }
    __device__ __forceinline__ void a_ready(const Unit&) const {}
    __device__ __forceinline__ void done(const Unit&) const {}
};

__device__ __forceinline__ unsigned cvt_pk_bf16(float lo, float hi) { unsigned r; asm volatile("v_cvt_pk_bf16_f32 %0, %1, %2" : "=v"(r) : "v"(lo), "v"(hi)); return r; }
typedef float f32x2 __attribute__((ext_vector_type(2)));
__device__ __forceinline__ f32x2 gelu_pk(f32x2 v) {
    const f32x2 av = __builtin_elementwise_abs(v), d = av * 0.2316418882f + 1.0f;
    f32x2 t; t.x = __builtin_amdgcn_rcpf(d.x); t.y = __builtin_amdgcn_rcpf(d.y);
    f32x2 q = t * 0.5307027145f + (-0.7265760135f); q = q * t + 0.7107068705f; q = q * t + (-0.142248368f); q = q * t + 0.127414796f; q = q * t;
    const f32x2 s = (v * v) * (-0.72134752044f);
    f32x2 e; e.x = __builtin_amdgcn_exp2f(s.x); e.y = __builtin_amdgcn_exp2f(s.y);
    const f32x2 m = v * (q * e), r = v - m;
    f32x2 o; o.x = v.x < 0.f ? m.x : r.x; o.y = v.y < 0.f ? m.y : r.y; return o;
}

template <int ACT  > struct EpiBf16 {
    static constexpr bool PERM = true, AFTER_DRAIN = false; static_assert(ACT == 0 || ACT == 1 || ACT == 2, "EpiBf16: ACT is 0 (none), 1 (gelu_pk) or 2 (squared relu)");
    bf16_t* O; int ldc; const float* bias; int split_cols; size_t split_stride; float scale0;
    __device__ __forceinline__ void operator()(const f32x4 (&acc)[2][2][4][2], const Unit& u, int wr, int wc, int fr, int fq) const {
        const int row0 = u.pm * BM + wr * 64 + fr; int colt = u.pn * BM; bf16_t* base = O;
        float sc = 1.f; if (split_cols) { const int t = colt / split_cols; base += (size_t)t * split_stride; colt -= t * split_cols; if (t == 0) sc = scale0; }
        const int col0 = colt + wc * 32 + 8 * fq, bcol0 = u.pn * BM + wc * 32 + 8 * fq;
        f32x4 bv[2][2];
#pragma unroll
        for (int bj = 0; bj < 2; ++bj)
#pragma unroll
            for (int n = 0; n < 2; ++n) bv[bj][n] = bias ? *(const f32x4*)(bias + bcol0 + bj * HALF + 4 * n) : (f32x4){0.f, 0.f, 0.f, 0.f};
#pragma unroll
        for (int ai = 0; ai < 2; ++ai)
#pragma unroll
            for (int m = 0; m < 4; ++m) { bf16_t* rowp = base + (size_t)(row0 + ai * HALF + m * 16) * ldc + col0;
#pragma unroll
                for (int bj = 0; bj < 2; ++bj) { f32x4 v0 = acc[ai][bj][m][0] + bv[bj][0], v1 = acc[ai][bj][m][1] + bv[bj][1];
                    if (ACT == 1) { f32x2 a = gelu_pk((f32x2){v0[0], v0[1]}), b = gelu_pk((f32x2){v0[2], v0[3]}), c = gelu_pk((f32x2){v1[0], v1[1]}), d = gelu_pk((f32x2){v1[2], v1[3]});
                        v0 = (f32x4){a.x, a.y, b.x, b.y}; v1 = (f32x4){c.x, c.y, d.x, d.y}; }
                    if (ACT == 2) { _Pragma("unroll") for (int q_ = 0; q_ < 4; ++q_) { const float a_ = fmaxf(v0[q_], 0.f), b_ = fmaxf(v1[q_], 0.f); v0[q_] = a_ * a_; v1[q_] = b_ * b_; } }
                    v0 = v0 * sc; v1 = v1 * sc; u32x4 w; w.x = cvt_pk_bf16(v0[0], v0[1]); w.y = cvt_pk_bf16(v0[2], v0[3]); w.z = cvt_pk_bf16(v1[0], v1[1]); w.w = cvt_pk_bf16(v1[2], v1[3]);
                    *(u32x4*)(rowp + bj * HALF) = w; } }
    }
};


struct EpiResid {
    static constexpr bool PERM = false, AFTER_DRAIN = false;
    const float* base; float* out; const float* gate; int ldc; int gate_stride; int rows_per_batch;
    __device__ __forceinline__ void operator()(const f32x4 (&acc)[2][2][4][2], const Unit& u, int wr, int wc, int fr, int fq) const {
        const int col0 = u.pn * BM + wc * 32 + 4 * fq;
        const float* gp = gate + (size_t)((u.pm * BM) / rows_per_batch) * gate_stride + col0;
        f32x4 gv[2][2];
#pragma unroll
        for (int bj = 0; bj < 2; ++bj)
#pragma unroll
            for (int n = 0; n < 2; ++n) gv[bj][n] = *(const f32x4*)(gp + bj * HALF + n * 16);
#pragma unroll
        for (int ai = 0; ai < 2; ++ai)
#pragma unroll
            for (int m = 0; m < 4; ++m) { const size_t off = (size_t)(u.pm * BM + ai * HALF + wr * 64 + m * 16 + fr) * ldc + col0;
#pragma unroll
                for (int bj = 0; bj < 2; ++bj)
#pragma unroll
                    for (int n = 0; n < 2; ++n) { const f32x4 bs = *(const f32x4*)(base + off + bj * HALF + n * 16);
                        *(f32x4*)(out + off + bj * HALF + n * 16) = bs + gv[bj][n] * acc[ai][bj][m][n]; } }
    }
};


struct EpiMulti {
    static constexpr bool AFTER_DRAIN = false;
    bool PERM; int mode, l;
    __device__ __forceinline__ void operator()(const f32x4 (&acc)[2][2][4][2], const Unit& u, int wr, int wc, int fr, int fq) const;
};

template <class Epi, class Sched, bool ALIGN_EPI = false, bool SP2 = false>
__device__ __forceinline__ void gemm_phase(PG8_LAS unsigned char* lds, const Gemm g, const Sched& S, const Epi& E) {
    int tid_l = threadIdx.x; asm volatile("" : "+v"(tid_l));
    const int tid = tid_l, wid = __builtin_amdgcn_readfirstlane(tid >> 6), lane = tid & 63, wr = wid >> 2, wc = wid & 3, fr = lane & 15, fq = lane >> 4;
    const int K = g.K, nt = K / BK;
    unsigned voffA[2], voffB[2];
#pragma unroll
    for (int i = 0; i < 2; ++i) { int R, C; stage_rc(tid * 16 + i * 8192, R, C); const int Rb = E.PERM ? ((R & ~31) + perm32(R & 31)) : R;
        voffA[i] = (unsigned)(R * K + C) * 2u; voffB[i] = (unsigned)(Rb * K + C) * 2u; }
    const size_t kstep = (size_t)(BK * 2);
    const size_t hstep = (size_t)HALF * K * 2;
    const size_t tstep = 2 * hstep;
    const unsigned ldsw = (unsigned)wid * 1024u;
    const int aoff = lds_byte(wr * 64 + fr, fq * 8), boff = lds_byte(wc * 32 + fr, fq * 8);
#define PG8_SA(b, h) (((b) * 2 + (h)) * HTB)
#define PG8_SB(b, h) ((4 + (b) * 2 + (h)) * HTB)
#define PG8_STAGE(bufoff, gbase, voff) do { _Pragma("unroll") for (int _i = 0; _i < 2; ++_i) \
        __builtin_amdgcn_global_load_lds((const unsigned*)((const char*)(gbase) + (voff)[_i]), (PG8_LAS unsigned*)(lds + (bufoff) + ldsw + _i * 8192), 16, 0, 0); } while (0)
#define PG8_LDA(dst, b, h) do { _Pragma("unroll") for (int m = 0; m < 4; ++m) _Pragma("unroll") for (int k = 0; k < 2; ++k) dst[m][k] = *(const PG8_LAS bf16x8*)(lds + PG8_SA(b, h) + aoff + m * 2048 + k * 1024); } while (0)
#define PG8_LDB(dst, b, h) do { _Pragma("unroll") for (int n = 0; n < 2; ++n) _Pragma("unroll") for (int k = 0; k < 2; ++k) dst[n][k] = *(const PG8_LAS bf16x8*)(lds + PG8_SB(b, h) + boff + n * 2048 + k * 1024); } while (0)
#define PG8_MMA(ai, bj, At, Bt) do { __builtin_amdgcn_s_setprio(1); _Pragma("unroll") for (int m = 0; m < 4; ++m) _Pragma("unroll") for (int n = 0; n < 2; ++n) _Pragma("unroll") for (int k = 0; k < 2; ++k) \
        acc[ai][bj][m][n] = __builtin_amdgcn_mfma_f32_16x16x32_bf16(Bt[n][k], At[m][k], acc[ai][bj][m][n], 0, 0, 0); __builtin_amdgcn_s_setprio(0); } while (0)
#define PG8_WAIT_V(n) asm volatile("s_waitcnt vmcnt(" #n ")" ::: "memory")
#define PG8_WAIT_L(n) asm volatile("s_waitcnt lgkmcnt(" #n ")" ::: "memory")
#define PG8_BAR __builtin_amdgcn_s_barrier()
#define PG8_SCHED __builtin_amdgcn_sched_barrier(0)
    Unit cur, nxt; int ui = 0;
    if (!S.next(0, cur)) return;
    f32x4 acc[2][2][4][2];
#pragma unroll
    for (int a = 0; a < 2; ++a)
#pragma unroll
        for (int b = 0; b < 2; ++b)
#pragma unroll
            for (int m = 0; m < 4; ++m)
#pragma unroll
                for (int n = 0; n < 2; ++n) acc[a][b][m][n] = (f32x4){0.f, 0.f, 0.f, 0.f};
    bf16x8 At[4][2], B0[2][2], B1[2][2];
    const char* cA = (const char*)g.A + (size_t)cur.pm * tstep; const char* cB = (const char*)g.Bt + (size_t)cur.pn * tstep;
    S.a_ready(cur);
    if constexpr (SP2) {
        PG8_STAGE(PG8_SB(0, 0), cB, voffB); PG8_STAGE(PG8_SB(0, 1), cB + hstep, voffB); PG8_STAGE(PG8_SA(0, 0), cA, voffA); PG8_STAGE(PG8_SA(0, 1), cA + hstep, voffA);
        if (wr == 1) PG8_BAR;
        PG8_WAIT_V(2); PG8_BAR;
        PG8_STAGE(PG8_SB(1, 0), cB + kstep, voffB); PG8_STAGE(PG8_SA(1, 0), cA + kstep, voffA); PG8_STAGE(PG8_SB(1, 1), cB + hstep + kstep, voffB);
        PG8_WAIT_V(6); PG8_BAR;
    } else {
        PG8_STAGE(PG8_SB(0, 0), cB, voffB); PG8_STAGE(PG8_SA(0, 0), cA, voffA); PG8_STAGE(PG8_SB(0, 1), cB + hstep, voffB); PG8_STAGE(PG8_SA(0, 1), cA + hstep, voffA);
        if (wr == 1) PG8_BAR;
        PG8_WAIT_V(4); PG8_BAR;
        PG8_STAGE(PG8_SB(1, 0), cB + kstep, voffB); PG8_STAGE(PG8_SA(1, 0), cA + kstep, voffA); PG8_STAGE(PG8_SB(1, 1), cB + hstep + kstep, voffB);
        PG8_WAIT_V(6); PG8_BAR;
    }
    for (;;) {
        const bool has_next = S.next(ui + 1, nxt);
        const char* nA = has_next ? (const char*)g.A + (size_t)nxt.pm * tstep : cA; const char* nB = has_next ? (const char*)g.Bt + (size_t)nxt.pn * tstep : cB;
        for (int t = 0; t < nt; t += 2) {
            const bool last = (t == nt - 2);
            const char* a1 = cA + (size_t)(t + 1) * kstep;
            const char* a2 = last ? nA : cA + (size_t)(t + 2) * kstep; const char* b2 = last ? nB : cB + (size_t)(t + 2) * kstep;
            const char* a3 = a2 + kstep; const char* b3 = b2 + kstep;
            if (last && has_next) S.a_ready(nxt);
            if constexpr (SP2) {
            PG8_LDB(B0, 0, 0); PG8_LDB(B1, 0, 1); PG8_SCHED; PG8_LDA(At, 0, 0); PG8_STAGE(PG8_SA(1, 1), a1 + hstep, voffA);
            PG8_WAIT_V(8); PG8_WAIT_L(0); PG8_BAR; PG8_MMA(0, 0, At, B0); PG8_MMA(0, 1, At, B1); PG8_BAR; PG8_SCHED;
            PG8_LDA(At, 0, 1); PG8_STAGE(PG8_SB(0, 0), b2, voffB); PG8_STAGE(PG8_SB(0, 1), b2 + hstep, voffB); PG8_STAGE(PG8_SA(0, 0), a2, voffA);
            PG8_WAIT_V(8); PG8_WAIT_L(0); PG8_BAR; PG8_MMA(1, 0, At, B0); PG8_MMA(1, 1, At, B1); PG8_BAR; PG8_SCHED;
            PG8_LDB(B0, 1, 0); PG8_LDB(B1, 1, 1); PG8_SCHED; PG8_LDA(At, 1, 0); PG8_STAGE(PG8_SA(0, 1), a2 + hstep, voffA);
            PG8_WAIT_V(8); PG8_WAIT_L(0); PG8_BAR; PG8_MMA(0, 0, At, B0); PG8_MMA(0, 1, At, B1); PG8_BAR; PG8_SCHED;
            PG8_LDA(At, 1, 1); PG8_STAGE(PG8_SB(1, 0), b3, voffB); PG8_STAGE(PG8_SB(1, 1), b3 + hstep, voffB); PG8_STAGE(PG8_SA(1, 0), a3, voffA);
            PG8_WAIT_V(8); PG8_WAIT_L(0); PG8_BAR; PG8_MMA(1, 0, At, B0); PG8_MMA(1, 1, At, B1); PG8_BAR; PG8_SCHED;
            } else {
            PG8_LDB(B0, 0, 0); PG8_SCHED; PG8_LDA(At, 0, 0); PG8_STAGE(PG8_SA(1, 1), a1 + hstep, voffA);
            PG8_WAIT_L(8); PG8_BAR; PG8_WAIT_L(0); PG8_MMA(0, 0, At, B0); PG8_BAR; PG8_SCHED;
            PG8_LDB(B1, 0, 1); PG8_STAGE(PG8_SB(0, 0), b2, voffB);
            PG8_BAR; PG8_WAIT_L(0); PG8_MMA(0, 1, At, B1); PG8_BAR;
            PG8_LDA(At, 0, 1); PG8_STAGE(PG8_SA(0, 0), a2, voffA);
            PG8_BAR; PG8_WAIT_L(0); PG8_MMA(1, 0, At, B0); PG8_BAR; PG8_SCHED;
            PG8_STAGE(PG8_SB(0, 1), b2 + hstep, voffB);
            PG8_WAIT_V(6); PG8_BAR; PG8_MMA(1, 1, At, B1); PG8_BAR;
            PG8_LDB(B0, 1, 0); PG8_SCHED; PG8_LDA(At, 1, 0); PG8_STAGE(PG8_SA(0, 1), a2 + hstep, voffA);
            PG8_WAIT_L(8); PG8_BAR; PG8_WAIT_L(0); PG8_MMA(0, 0, At, B0); PG8_BAR; PG8_SCHED;
            PG8_LDB(B1, 1, 1); PG8_STAGE(PG8_SB(1, 0), b3, voffB);
            PG8_BAR; PG8_WAIT_L(0); PG8_MMA(0, 1, At, B1); PG8_BAR;
            PG8_LDA(At, 1, 1); PG8_STAGE(PG8_SA(1, 0), a3, voffA);
            PG8_BAR; PG8_WAIT_L(0); PG8_MMA(1, 0, At, B0); PG8_BAR; PG8_SCHED;
            PG8_STAGE(PG8_SB(1, 1), b3 + hstep, voffB);
            PG8_WAIT_V(6); PG8_BAR; PG8_MMA(1, 1, At, B1); PG8_BAR;
            }
        }
        if constexpr (ALIGN_EPI) { if (wr == 0) PG8_BAR; }
        if constexpr (!Epi::AFTER_DRAIN) { E(acc, cur, wr, wc, fr, fq); S.done(cur); }
        if (!has_next) break;
#pragma unroll
        for (int a = 0; a < 2; ++a)
#pragma unroll
            for (int b = 0; b < 2; ++b)
#pragma unroll
                for (int m = 0; m < 4; ++m)
#pragma unroll
                    for (int n = 0; n < 2; ++n) acc[a][b][m][n] = (f32x4){0.f, 0.f, 0.f, 0.f};
        cur = nxt; cA = nA; cB = nB; ++ui;
        if constexpr (ALIGN_EPI) { if (wr == 1) PG8_BAR; }
    }
    PG8_WAIT_V(0);
    if constexpr (!ALIGN_EPI) { if (wr == 0) PG8_BAR; }
    PG8_BAR;
    if constexpr (Epi::AFTER_DRAIN) { E.fused(acc, cur, wr, wc, fr, fq, lds, wid, lane); S.done(cur); }
#undef PG8_SA
#undef PG8_SB
#undef PG8_STAGE
#undef PG8_LDA
#undef PG8_LDB
#undef PG8_MMA
#undef PG8_WAIT_V
#undef PG8_WAIT_L
#undef PG8_BAR
#undef PG8_SCHED
}
}
#define GAS __attribute__((address_space(1)))
#define LAS __attribute__((address_space(3)))
typedef unsigned short bf16;
typedef unsigned v4u __attribute__((ext_vector_type(4)));
typedef float f32x4 __attribute__((ext_vector_type(4)));
typedef short bf16x8 __attribute__((ext_vector_type(8)));
typedef GAS unsigned gu32;
typedef GAS unsigned long long gu64;
#define RLX_AGENT __ATOMIC_RELAXED, __HIP_MEMORY_SCOPE_AGENT
#define LDS_WAIT() asm volatile("s_waitcnt lgkmcnt(0)" ::: "memory")
#define VM_WAIT() asm volatile("s_waitcnt vmcnt(0)" ::: "memory")
__device__ __forceinline__ unsigned long long rt() { return __builtin_amdgcn_s_memrealtime(); }
__device__ __forceinline__ unsigned f2bf(float f) { unsigned u = __builtin_bit_cast(unsigned, f); return (u + 0x7fffu + ((u >> 16) & 1u)) >> 16; }
__device__ __forceinline__ unsigned pk2(float lo, float hi) { return f2bf(lo) | (f2bf(hi) << 16); }

#define XB_TMO      128
#define XB_XCNT(j)  (256  + 64 * (j))
#define XB_XSUB(j)  (1280 + 64 * (j))
#define XB_XGEN(j)  (2304 + 64 * (j))
#define XB_TOP      3328
#define XB_TOPGEN   3392
#define XCD_BAR_WORDS 3456
#define XB_SPIN_CAP (1u << 18)

__device__ __forceinline__ unsigned xb_ld(unsigned* p)              { return __hip_atomic_load(p, __ATOMIC_RELAXED, __HIP_MEMORY_SCOPE_AGENT); }
__device__ __forceinline__ unsigned xb_add(unsigned* p, unsigned v) { return __hip_atomic_fetch_add(p, v, __ATOMIC_RELAXED, __HIP_MEMORY_SCOPE_AGENT); }
__device__ __forceinline__ unsigned xb_xcc_id() { return (unsigned)__builtin_amdgcn_s_getreg((3 << 11) | 20) & 0xFu; }
#define XB_SPIN(cond, bar) do { unsigned _sp = 0; while (cond) { __builtin_amdgcn_s_sleep(1); \
    if ((++_sp & 255u) == 0u) { if (xb_ld(&(bar)[XB_TMO])) break; if (_sp > XB_SPIN_CAP) { atomicAdd(&(bar)[XB_TMO], 1u); break; } } } } while (0)

struct XcdBarrier {
    unsigned* bar; unsigned x;
    volatile LAS unsigned* st;
};

__device__ __forceinline__ XcdBarrier xcd_barrier_post(unsigned* bar, volatile LAS unsigned* st) {
    XcdBarrier b; b.bar = bar; b.x = xb_xcc_id(); b.st = st;
    if (threadIdx.x == 0) (void)xb_add(&bar[XB_XCNT(b.x)], 1u);
    return b;
}
__device__ __forceinline__ void xcd_barrier_complete(unsigned* bar, unsigned x, unsigned& nloc, unsigned& nx) {
    const unsigned G = gridDim.x * gridDim.y * gridDim.z;
    unsigned sum, cnt, mine, sp = 0u;
    for (;;) {
        sum = 0u; cnt = 0u; mine = 0u;
#pragma unroll
        for (unsigned j = 0; j < 16; ++j) { const unsigned c = xb_ld(&bar[XB_XCNT(j)]); sum += c; cnt += (c > 0u) ? 1u : 0u; mine = (j == x) ? c : mine; }
        if (sum == G) break;
        __builtin_amdgcn_s_sleep(1);
        if ((++sp & 255u) == 0u) { if (xb_ld(&bar[XB_TMO])) break; if (sp > XB_SPIN_CAP) { atomicAdd(&bar[XB_TMO], 1u); break; } }
    }
    nloc = mine > 0u ? mine : 1u; nx = cnt > 0u ? cnt : 1u;
}

__device__ __forceinline__ void xcd_barrier(const XcdBarrier& b, const bool t0  ) {
    asm volatile("s_waitcnt vmcnt(0)" ::: "memory");
    __syncthreads();
    if (t0) {
        unsigned* bar = b.bar;
        __builtin_amdgcn_s_waitcnt(0);
        unsigned nloc = b.st[0], nx = b.st[1];
        if (nloc == 0u) { xcd_barrier_complete(bar, b.x, nloc, nx); b.st[0] = nloc; b.st[1] = nx; }
        const unsigned old = xb_add(&bar[XB_XSUB(b.x)], 1u);
        const unsigned gen = old / nloc;
        if (old + 1u == (gen + 1u) * nloc) {
            __builtin_amdgcn_fence(__ATOMIC_RELEASE, "agent");
            asm volatile("s_waitcnt vmcnt(0)" ::: "memory");
            const unsigned og = xb_add(&bar[XB_TOP], 1u);
            const unsigned tg = og / nx;
            if (og + 1u == (tg + 1u) * nx) xb_add(&bar[XB_TOPGEN], 1u);
            else XB_SPIN(xb_ld(&bar[XB_TOPGEN]) == tg, bar);
            __builtin_amdgcn_fence(__ATOMIC_ACQUIRE, "agent");
            xb_add(&bar[XB_XGEN(b.x)], 1u);
            asm volatile("s_waitcnt vmcnt(0)" ::: "memory");
        } else {
            XB_SPIN(xb_ld(&bar[XB_XGEN(b.x)]) == gen, bar);
            __builtin_amdgcn_fence(__ATOMIC_ACQUIRE, "agent");
            asm volatile("s_waitcnt vmcnt(0)" ::: "memory");
        }
    }
    __syncthreads();
}

#ifndef PG8_SP2
#define PG8_SP2 true
#endif
#ifndef PG8_ALIGN
#define PG8_ALIGN true
#endif
constexpr int NWAVES = 8;
constexpr int N_STEPS = 38;
#ifndef MK_N_LAUNCHES
#define MK_N_LAUNCHES 1
#endif
#ifndef PH_MASK
#define PH_MASK 0xffff
#endif
#ifndef REP_MASK
#define REP_MASK 0
#endif
#ifndef PREP_REP_LRU
#define PREP_REP_LRU 1
#endif
#ifndef PREP_REP_GDN
#define PREP_REP_GDN 1
#endif
constexpr int N_LAUNCHES = MK_N_LAUNCHES;

constexpr int D = 1024, BATCH = 4, SEQ = 4096, DEPTH = 4, M = BATCH * SEQ;
constexpr int LRUW = 512, NGB = 8, GBW = 64, GH = 4, HD = 128, GDNW = 512, CH = 64, NCH = SEQ / CH, FF = 4096;
constexpr int NMODC = 6 * D, INC = 3080, NPROJ = 3072;
constexpr int O_LX = 0, O_LY = 512, O_Q = 1024, O_Z = 2560;
constexpr float EPS = 1e-6f;

constexpr size_t MiB = 1u << 20;
constexpr size_t WS_CTL = 0, CTL_ZERO_BYTES = 1 * MiB;
constexpr size_t WS_MOD = 1 * MiB;
constexpr size_t WS_BG = 2 * MiB;
constexpr size_t WS_AGG = 3 * MiB;
constexpr size_t WS_CARRY = 4 * MiB;
constexpr size_t WS_GL = 5 * MiB;
constexpr size_t WS_GT = 6 * MiB;
constexpr size_t WS_W = 8 * MiB;
constexpr size_t LAYER_W = (size_t)12288 * 1024;
constexpr size_t W_OUT_OFF = (size_t)3072 * 1024, W_UP_OFF = (size_t)4096 * 1024, W_DOWN_OFF = (size_t)8192 * 1024;
constexpr size_t WS_H = 104 * MiB;
constexpr size_t WS_MIX = 136 * MiB;
constexpr size_t WS_PROJ = 168 * MiB;
constexpr size_t WS_ACT = 168 * MiB;
constexpr size_t WS_GQD = 264 * MiB, WS_GKT = 280 * MiB;
constexpr size_t WS_GATT = 296 * MiB;
constexpr size_t WS_GO = 312 * MiB;
constexpr size_t WS_LRUP = 344 * MiB;
constexpr size_t WS_END = 376 * MiB;
constexpr int CW_BAR = 4096;

constexpr int RING_OFF = 0, RING_BYTES = 155648;
constexpr int LDSCTL_OFF = RING_BYTES, MISC_OFF = LDSCTL_OFF + 320;
constexpr int LDS_BYTES = 156672;

typedef unsigned v2u __attribute__((ext_vector_type(2)));
#define DI __device__ __forceinline__
DI float bf2f(unsigned b) { return __builtin_bit_cast(float, b << 16); }
DI float bflo(unsigned w) { return __builtin_bit_cast(float, w << 16); }
DI float bfhi(unsigned w) { return __builtin_bit_cast(float, w & 0xffff0000u); }
DI float sigmoidf_(float x) { return 1.f / (1.f + expf(-x)); }
DI float siluf_(float x) { return x / (1.f + expf(-x)); }
DI float rcp_(float x) { return __builtin_amdgcn_rcpf(x); }
DI float exp_fast(float x) { return __builtin_amdgcn_exp2f(x * 1.4426950408889634f); }
DI float sigmoid_fast(float x) { return rcp_(1.f + exp_fast(-x)); }
DI float silu_fast(float x) { return x * rcp_(1.f + exp_fast(-x)); }
DI float gelu_tanh(float x) { const float u = 0.7978845608028654f * (x + 0.044715f * x * x * x); return 0.5f * x * (1.f + tanhf(u)); }
DI float bperm_(int src_lane, float v) { return __builtin_bit_cast(float, __builtin_amdgcn_ds_bpermute(src_lane << 2, __builtin_bit_cast(int, v))); }
DI float wave_sum_(int lane, float v) {
#pragma unroll
    for (int o = 1; o < 64; o <<= 1) v += bperm_(lane ^ o, v);
    return v;
}
DI float half_sum_(int lane, float v) {
#pragma unroll
    for (int o = 1; o < 32; o <<= 1) v += bperm_(lane ^ o, v);
    return v;
}
DI float shfl_up_(int lane, float v, int off) { return bperm_(lane >= off ? lane - off : lane, v); }

struct Args { const float* in[23]; float* out; unsigned char* ws; int ph_lo, ph_hi; };
static_assert(sizeof(Args) == 23 * 8 + 8 + 8 + 8, "Args has no padding");
struct Frame {
    LAS unsigned char* lds;
    volatile LAS unsigned* MISC;
    gu32* ctl;
    int tid, lane, wave;
    int vcu, G;
    const __attribute__((address_space(4))) Args* A;
};
#define IN_(k) (F.A->in[k])
#define X_IN IN_(0)
#define C_IN IN_(1)
#define NORM_MIX_W IN_(2)
#define NORM_MLP_W IN_(3)
#define W_MOD IN_(4)
#define B_MOD IN_(5)
#define W_IN IN_(6)
#define LRU_CONV_W IN_(7)
#define LRU_CONV_B IN_(8)
#define GATE_A_W IN_(9)
#define GATE_A_B IN_(10)
#define GATE_X_W IN_(11)
#define GATE_X_B IN_(12)
#define LRU_LAMBDA IN_(13)
#define LRU_NORM_W IN_(14)
#define GDN_CONV_W IN_(15)
#define GDN_A_LOG IN_(16)
#define GDN_DT_BIAS IN_(17)
#define GDN_NORM_W IN_(18)
#define W_OUT IN_(19)
#define W_UP IN_(20)
#define W_DOWN IN_(21)
#define FINAL_NORM_W IN_(22)
#define OUT_ (F.A->out)
#define WSF(off) ((float*)(F.A->ws + (off)))
#define WSH(off) ((bf16*)(F.A->ws + (off)))

DI void p_mod(Frame& F) {
    LAS float* cs = (LAS float*)F.lds;
    LAS float* red = cs + 4096;
    for (int i = F.tid; i < BATCH * D; i += NWAVES * 64) cs[i] = siluf_(C_IN[i]);
    __syncthreads();
    for (int item = blockIdx.x; item < DEPTH * 96; item += gridDim.x) {
        const int l = item / 96, cg = item % 96, col = cg * 64 + F.lane;
        const float* wp = W_MOD + ((size_t)l * D + F.wave * 128) * NMODC + col;
        float a0 = 0.f, a1 = 0.f, a2 = 0.f, a3 = 0.f;
#pragma unroll 8
        for (int kk = 0; kk < 128; ++kk) { const float wv = wp[(size_t)kk * NMODC]; const int k = F.wave * 128 + kk;
            a0 += cs[k] * wv; a1 += cs[1024 + k] * wv; a2 += cs[2048 + k] * wv; a3 += cs[3072 + k] * wv; }
        red[(F.wave * 4 + 0) * 64 + F.lane] = a0; red[(F.wave * 4 + 1) * 64 + F.lane] = a1; red[(F.wave * 4 + 2) * 64 + F.lane] = a2; red[(F.wave * 4 + 3) * 64 + F.lane] = a3;
        __syncthreads();
        if (F.tid < 256) { const int b = F.tid >> 6, ln = F.tid & 63; float s = 0.f;
#pragma unroll
            for (int w = 0; w < 8; ++w) s += red[(w * 4 + b) * 64 + ln];
            const int cc = cg * 64 + ln; WSF(WS_MOD)[((size_t)l * BATCH + b) * NMODC + cc] = s + B_MOD[(size_t)l * NMODC + cc]; }
        __syncthreads();
    }
}

DI void p0_transpose_item(const float* W, int K, int ldw, int N, bf16* WT, LAS float* scr, int item, int lane) {
    const int nblk = N / 32, kb = item / nblk, nb = item % nblk, k0 = 64 * kb, n0 = 32 * nb;
#pragma unroll 8
    for (int i = 0; i < 32; ++i) { const int kk = 2 * i + (lane >> 5); scr[kk * 33 + (lane & 31)] = W[(size_t)(k0 + kk) * ldw + n0 + (lane & 31)]; }
    LDS_WAIT(); asm volatile("" ::: "memory");
    const int c = lane & 7;
#pragma unroll
    for (int j = 0; j < 4; ++j) { const int n = (lane >> 3) + 8 * j; const LAS float* s = scr + (8 * c) * 33 + n;
        v4u o; o.x = pk2(s[0 * 33], s[1 * 33]); o.y = pk2(s[2 * 33], s[3 * 33]); o.z = pk2(s[4 * 33], s[5 * 33]); o.w = pk2(s[6 * 33], s[7 * 33]);
        *(v4u*)(WT + (size_t)(n0 + n) * K + k0 + 8 * c) = o; }
    LDS_WAIT(); asm volatile("" ::: "memory");
}
DI void p0_weights(Frame& F) {
    LAS float* scr = (LAS float*)(F.lds + RING_OFF + F.wave * 16384);
    const int gw = F.vcu * NWAVES + F.wave, NGW = F.G * NWAVES;
    constexpr int I_IN = (D / 64) * (NPROJ / 32), I_OUT = (D / 64) * (D / 32), I_UP = (D / 64) * (FF / 32), I_DN = (FF / 64) * (D / 32);
    constexpr int PER_LAYER = I_IN + I_OUT + I_UP + I_DN;
    for (int it = gw; it < DEPTH * PER_LAYER; it += NGW) {
        const int l = it / PER_LAYER; int r = it % PER_LAYER; bf16* wl = WSH(WS_W) + (size_t)l * LAYER_W;
        if (r < I_IN) { p0_transpose_item(W_IN + (size_t)l * D * INC, D, INC, NPROJ, wl, scr, r, F.lane); continue; } r -= I_IN;
        if (r < I_OUT) { p0_transpose_item(W_OUT + (size_t)l * D * D, D, D, D, wl + W_OUT_OFF, scr, r, F.lane); continue; } r -= I_OUT;
        if (r < I_UP) { p0_transpose_item(W_UP + (size_t)l * D * FF, D, FF, FF, wl + W_UP_OFF, scr, r, F.lane); continue; } r -= I_UP;
        p0_transpose_item(W_DOWN + (size_t)l * FF * D, FF, D, D, wl + W_DOWN_OFF, scr, r, F.lane);
    }
    for (int o = (int)blockIdx.x * NWAVES * 64 + F.tid; o < DEPTH * 2 * NGB * 4096; o += (int)gridDim.x * NWAVES * 64) {
        const int i = o & 63, j = (o >> 6) & 63, g = (o >> 12) & 7, gate = (o >> 15) & 1, l = o >> 16;
        const float* src = gate ? GATE_X_W : GATE_A_W;
        WSH(WS_GT)[o] = (bf16)f2bf(src[(size_t)(l * NGB + g) * 4096 + i * 64 + j]);
    }
}

template <bool WITH_BG>
DI void p_normmod(Frame& F, int l, const float* xin, const float* normw, int off_sh, int off_sc) {
    LAS float* w8 = (LAS float*)F.lds;
    if (WITH_BG) {
        for (int i = F.tid; i < D * 8; i += NWAVES * 64) w8[i] = W_IN[((size_t)l * D + (i >> 3)) * INC + NPROJ + (i & 7)];
        __syncthreads();
    }
    const int gw = F.vcu * NWAVES + F.wave, NGW = F.G * NWAVES;
    for (int m = gw; m < M; m += NGW) {
        const int b = m >> 12;
        const float* modp = WSF(WS_MOD) + ((size_t)l * BATCH + b) * NMODC;
        f32x4 v[4]; float ss = 0.f;
#pragma unroll
        for (int j = 0; j < 4; ++j) { v[j] = *(const f32x4*)(xin + (size_t)m * D + 4 * F.lane + 256 * j); ss += (v[j].x * v[j].x + v[j].y * v[j].y) + (v[j].z * v[j].z + v[j].w * v[j].w); }
        ss = wave_sum_(F.lane, ss);
        const float rstd = 1.0f / sqrtf(ss * (1.0f / D) + EPS);
        float a0 = 0.f, a1 = 0.f, a2 = 0.f, a3 = 0.f, a4 = 0.f, a5 = 0.f, a6 = 0.f, a7 = 0.f;
#pragma unroll
        for (int j = 0; j < 4; ++j) {
            const int col = 4 * F.lane + 256 * j;
            const f32x4 nw = *(const f32x4*)(normw + (size_t)l * D + col), sc = *(const f32x4*)(modp + off_sc + col), sh = *(const f32x4*)(modp + off_sh + col);
            const f32x4 hv = v[j] * rstd * nw * (sc + 1.0f) + sh;
            v2u o; o.x = pk2(hv.x, hv.y); o.y = pk2(hv.z, hv.w);
            *(v2u*)(WSH(WS_H) + (size_t)m * D + col) = o;
            if (WITH_BG) {
#pragma unroll
                for (int e = 0; e < 4; ++e) { const f32x4 wa = *(const LAS f32x4*)(w8 + (col + e) * 8), wb = *(const LAS f32x4*)(w8 + (col + e) * 8 + 4); const float hh = hv[e];
                    a0 += hh * wa.x; a1 += hh * wa.y; a2 += hh * wa.z; a3 += hh * wa.w; a4 += hh * wb.x; a5 += hh * wb.y; a6 += hh * wb.z; a7 += hh * wb.w; }
            }
        }
        if (WITH_BG) {
            a0 = wave_sum_(F.lane, a0); a1 = wave_sum_(F.lane, a1); a2 = wave_sum_(F.lane, a2); a3 = wave_sum_(F.lane, a3); a4 = wave_sum_(F.lane, a4); a5 = wave_sum_(F.lane, a5); a6 = wave_sum_(F.lane, a6); a7 = wave_sum_(F.lane, a7);
            if (F.lane < 4) {
                const int hh = F.lane;
                const float bpre = hh == 0 ? a0 : hh == 1 ? a1 : hh == 2 ? a2 : a3;
                const float apre = hh == 0 ? a4 : hh == 1 ? a5 : hh == 2 ? a6 : a7;
                const float xx = apre + GDN_DT_BIAS[l * GH + hh];
                const float sp = xx > 20.f ? xx : log1pf(expf(xx));
                WSF(WS_BG)[(size_t)m * 8 + hh] = sigmoidf_(bpre);
                WSF(WS_BG)[(size_t)m * 8 + 4 + hh] = -expf(GDN_A_LOG[l * GH + hh]) * sp;
            }
        }
    }
}

typedef float f32x2_t __attribute__((ext_vector_type(2))); typedef __bf16 bf16x2_t __attribute__((ext_vector_type(2)));
DI unsigned cvtpk(float lo, float hi) { f32x2_t v = {lo, hi}; bf16x2_t b = __builtin_convertvector(v, bf16x2_t); return __builtin_bit_cast(unsigned, b); }
DI bf16x8 pack8(f32x4 a, f32x4 b) { v4u p; p.x = cvtpk(a.x, a.y); p.y = cvtpk(a.z, a.w); p.z = cvtpk(b.x, b.y); p.w = cvtpk(b.z, b.w); return __builtin_bit_cast(bf16x8, p); }
DI bf16x8 ldfrag(const LAS unsigned char* p) { const v2u lo = *(const LAS v2u*)p, hi = *(const LAS v2u*)(p + 32); v4u r; r.x = lo.x; r.y = lo.y; r.z = hi.x; r.w = hi.y; return __builtin_bit_cast(bf16x8, r); }
#define MFMA16(a, b, c) __builtin_amdgcn_mfma_f32_16x16x32_bf16((a), (b), (c), 0, 0, 0)

DI bf16x8 ld128(const LAS unsigned char* p) { return *(const LAS bf16x8*)p; }
DI int kperm4(int k4) { return k4 < 16 ? 2 * k4 : 2 * (k4 - 16) + 4; }
DI int kperm(int k) { return (k & ~31) + kperm4(k & 28) + (k & 3); }
constexpr int PG_QB = 0, PG_KB = 17408, PG_KBET = 34816, PG_VT = 53248, PG_LS = 71680, PG_TS = 89088, PG_TB = 106496, PG_ATT = 115712, PG_XS = 124928, PG_SM = 128000, PG_END = 129024;
static_assert(PG_END <= RING_BYTES, "prep LDS map");
DI void p_prep(Frame& F, int l) {
    const int wave = F.wave;
#define PREP_IDS int tid_ = F.tid; asm volatile("" : "+v"(tid_)); const int tid = tid_, lane = tid & 63, m = lane & 15, q = lane >> 4; (void)m; (void)q;
    for (int item = blockIdx.x; item < BATCH * NCH; item += gridDim.x) {
        const int b = item / NCH, n = item % NCH, row0 = b * SEQ + n * CH, t0 = n * CH;
        for (int rep_ = 0; rep_ < PREP_REP_LRU; ++rep_) {
            PREP_IDS
            const int g = wave;
            LAS float* xr = (LAS float*)(F.lds + wave * 17408);
            const int tg = lane >> 3, cg = lane & 7, c0 = 8 * cg, cc0 = g * 64 + c0;
            v4u xp[11];
#pragma unroll
            for (int i = 0; i < 11; ++i) { const int tt = t0 + 8 * tg - 3 + i;
                xp[i] = (tt >= 0) ? *(const v4u*)(WSH(WS_PROJ) + (size_t)(b * SEQ + tt) * NPROJ + O_LX + cc0) : (v4u){0u, 0u, 0u, 0u}; }
            f32x4 wl_[4], wh_[4];
#pragma unroll
            for (int k = 0; k < 4; ++k) { wl_[k] = *(const f32x4*)(LRU_CONV_W + ((size_t)l * 4 + k) * LRUW + cc0); wh_[k] = *(const f32x4*)(LRU_CONV_W + ((size_t)l * 4 + k) * LRUW + cc0 + 4); }
            const f32x4 bl_ = *(const f32x4*)(LRU_CONV_B + l * LRUW + cc0), bh_ = *(const f32x4*)(LRU_CONV_B + l * LRUW + cc0 + 4);
            bf16x8 Bf[2][4][2];
#pragma unroll
            for (int gate = 0; gate < 2; ++gate)
#pragma unroll
                for (int nt = 0; nt < 4; ++nt)
#pragma unroll
                    for (int ks = 0; ks < 2; ++ks) Bf[gate][nt][ks] = *(const bf16x8*)(WSH(WS_GT) + ((size_t)((l * 2 + gate) * NGB + g)) * 4096 + (size_t)(16 * nt + m) * 64 + 32 * ks + 8 * q);
            float ba_[4], bx_[4], ls_[4];
#pragma unroll
            for (int nt = 0; nt < 4; ++nt) { const int cc = g * 64 + 16 * nt + m; ba_[nt] = GATE_A_B[l * LRUW + cc]; bx_[nt] = GATE_X_B[l * LRUW + cc];
                const float lam = LRU_LAMBDA[l * LRUW + cc]; ls_[nt] = -8.0f * (fmaxf(-lam, 0.f) + log1pf(expf(-fabsf(lam)))); }
#pragma unroll
            for (int tt = 0; tt < 8; ++tt) { f32x4 al = bl_, ah = bh_;
#pragma unroll
                for (int k = 0; k < 4; ++k) { const v4u xw = xp[tt + k];
                    al += wl_[k] * (f32x4){bflo(xw.x), bfhi(xw.x), bflo(xw.y), bfhi(xw.y)}; ah += wh_[k] * (f32x4){bflo(xw.z), bfhi(xw.z), bflo(xw.w), bfhi(xw.w)}; }
                *(LAS f32x4*)(xr + (8 * tg + tt) * 68 + c0) = al; *(LAS f32x4*)(xr + (8 * tg + tt) * 68 + c0 + 4) = ah; }
            asm volatile("s_waitcnt lgkmcnt(0)" ::: "memory");
            bf16x8 Af[4][2];
#pragma unroll
            for (int mt = 0; mt < 4; ++mt)
#pragma unroll
                for (int ks = 0; ks < 2; ++ks) { const LAS float* pp = xr + (16 * mt + m) * 68 + 32 * ks + 8 * q; Af[mt][ks] = pack8(*(const LAS f32x4*)pp, *(const LAS f32x4*)(pp + 4)); }
#pragma unroll
            for (int nt = 0; nt < 4; ++nt) {
                float av[4][4], bv[4][4];
#pragma unroll
                for (int mt = 0; mt < 4; ++mt) { f32x4 ra = (f32x4){0.f, 0.f, 0.f, 0.f}, ia = (f32x4){0.f, 0.f, 0.f, 0.f};
                    ra = MFMA16(Af[mt][0], Bf[0][nt][0], ra); ra = MFMA16(Af[mt][1], Bf[0][nt][1], ra);
                    ia = MFMA16(Af[mt][0], Bf[1][nt][0], ia); ia = MFMA16(Af[mt][1], Bf[1][nt][1], ia);
#pragma unroll
                    for (int r = 0; r < 4; ++r) { const float rr = sigmoid_fast(ra[r] + ba_[nt]), ig = sigmoid_fast(ia[r] + bx_[nt]);
                        const float log_a = rr * ls_[nt], aa = exp_fast(log_a), mult = __builtin_amdgcn_sqrtf(fmaxf(1.0f - exp_fast(2.0f * log_a), 1e-12f));
                        av[mt][r] = aa; bv[mt][r] = mult * (ig * xr[(16 * mt + 4 * q + r) * 68 + 16 * nt + m]); } }
                float iP[4], iH[4];
#pragma unroll
                for (int mt = 0; mt < 4; ++mt) {
#pragma unroll
                    for (int r = 1; r < 4; ++r) { bv[mt][r] = av[mt][r] * bv[mt][r - 1] + bv[mt][r]; av[mt][r] = av[mt][r] * av[mt][r - 1]; }
                    float PA = av[mt][3], HA = bv[mt][3];
                    { const float Pp = shfl_up_(lane, PA, 16), Hp = shfl_up_(lane, HA, 16); if (q >= 1) { HA = PA * Hp + HA; PA = PA * Pp; } }
                    { const float Pp = shfl_up_(lane, PA, 32), Hp = shfl_up_(lane, HA, 32); if (q >= 2) { HA = PA * Hp + HA; PA = PA * Pp; } }
                    iP[mt] = PA; iH[mt] = HA; }
                float CP = 1.f, CH = 0.f;
#pragma unroll
                for (int mt = 0; mt < 4; ++mt) {
                    const float totP = bperm_(m + 48, iP[mt]), totH = bperm_(m + 48, iH[mt]);
                    float exP = shfl_up_(lane, iP[mt], 16), exH = shfl_up_(lane, iH[mt], 16); if (q == 0) { exP = 1.f; exH = 0.f; }
                    const float EP = CP * exP, EH = exP * CH + exH;
#pragma unroll
                    for (int r = 0; r < 4; ++r) { const float Pf = EP * av[mt][r], Hf = av[mt][r] * EH + bv[mt][r];
                        *(LAS unsigned*)(xr + (16 * mt + 4 * q + r) * 68 + 16 * nt + m) = f2bf(Hf) | (f2bf(Pf) << 16); }
                    CH = totP * CH + totH; CP = CP * totP; }
                if (q == 0) { WSF(WS_AGG)[((size_t)(b * NCH + n)) * LRUW + g * 64 + 16 * nt + m] = CP; WSF(WS_AGG)[(size_t)BATCH * NCH * LRUW + ((size_t)(b * NCH + n)) * LRUW + g * 64 + 16 * nt + m] = CH; }
            }
            asm volatile("s_waitcnt lgkmcnt(0)" ::: "memory");
#pragma unroll
            for (int i = 0; i < 16; ++i) { const int pz = lane + 64 * i, row = pz >> 4, c16 = pz & 15;
                *(v4u*)((unsigned*)(F.A->ws + WS_H) + (size_t)(row0 + row) * LRUW + g * 64 + 4 * c16) = *(const LAS v4u*)(xr + row * 68 + 4 * c16); }
        }
        __syncthreads();
        {
            LAS unsigned char* qb = F.lds + PG_QB;
            LAS unsigned char* kb = F.lds + PG_KB;
            LAS unsigned char* kbeT = F.lds + PG_KBET;
            LAS unsigned char* vT = F.lds + PG_VT;
            LAS float* Ls = (LAS float*)(F.lds + PG_LS);
            LAS float* Ts = (LAS float*)(F.lds + PG_TS);
            LAS unsigned char* Tb = F.lds + PG_TB;
            LAS unsigned char* atts = F.lds + PG_ATT;
            LAS float* Xs = (LAS float*)(F.lds + PG_XS);
            LAS float* sm4 = (LAS float*)(F.lds + PG_SM);
            if (wave < GH) { int tl_ = F.tid; asm volatile("" : "+v"(tl_)); const int ln = tl_ & 63, hh = wave;
                float gcv = WSF(WS_BG)[(size_t)(row0 + ln) * 8 + 4 + hh];
#pragma unroll
                for (int off = 1; off < 64; off <<= 1) { const float pv = shfl_up_(ln, gcv, off); if (ln >= off) gcv += pv; }
                const float glast = bperm_(63, gcv);
                sm4[hh * 256 + ln] = gcv; sm4[hh * 256 + 64 + ln] = WSF(WS_BG)[(size_t)(row0 + ln) * 8 + hh]; sm4[hh * 256 + 128 + ln] = expf(gcv); sm4[hh * 256 + 192 + ln] = expf(glast - gcv); }
            __syncthreads();
            for (int h_ = 0; h_ < GH * PREP_REP_GDN; ++h_) { const int h = h_ % GH;
                PREP_IDS
                const size_t item4 = (size_t)(b * GH + h) * NCH + n;
                LAS float* sgc = sm4 + h * 256, *sbeta = sgc + 64, *seg = sgc + 128, *sel = sgc + 192;
                if (tid < 384) {
                    const int cgp = tid & 15, wt = tid >> 4, which = wt >> 3, tr = wt & 7, d0 = cgp * 8, ch0 = which * GDNW + h * HD + d0;
                    v4u xp[11];
#pragma unroll
                    for (int i = 0; i < 11; ++i) { const int tt = t0 + tr * 8 - 3 + i;
                        xp[i] = (tt >= 0) ? *(const v4u*)(WSH(WS_PROJ) + (size_t)(b * SEQ + tt) * NPROJ + O_Q + ch0) : (v4u){0u, 0u, 0u, 0u}; }
                    f32x4 wl_[4], wh_[4];
#pragma unroll
                    for (int k = 0; k < 4; ++k) { wl_[k] = *(const f32x4*)(GDN_CONV_W + ((size_t)l * 4 + k) * (3 * GDNW) + ch0); wh_[k] = *(const f32x4*)(GDN_CONV_W + ((size_t)l * 4 + k) * (3 * GDNW) + ch0 + 4); }
                    f32x4 ol[8], oh[8]; float ss[8];
#pragma unroll
                    for (int tt = 0; tt < 8; ++tt) { f32x4 al = (f32x4){0.f, 0.f, 0.f, 0.f}, ah = (f32x4){0.f, 0.f, 0.f, 0.f};
#pragma unroll
                        for (int k = 0; k < 4; ++k) { const v4u xw = xp[tt + k];
                            al += wl_[k] * (f32x4){bflo(xw.x), bfhi(xw.x), bflo(xw.y), bfhi(xw.y)}; ah += wh_[k] * (f32x4){bflo(xw.z), bfhi(xw.z), bflo(xw.w), bfhi(xw.w)}; }
#pragma unroll
                        for (int c = 0; c < 4; ++c) { al[c] = silu_fast(al[c]); ah[c] = silu_fast(ah[c]); }
                        ol[tt] = al; oh[tt] = ah;
                        ss[tt] = (al.x * al.x + al.y * al.y) + (al.z * al.z + al.w * al.w) + (ah.x * ah.x + ah.y * ah.y) + (ah.z * ah.z + ah.w * ah.w); }
                    if (which < 2) {
#pragma unroll
                        for (int tt = 0; tt < 8; ++tt) { float v = ss[tt]; v += bperm_(lane ^ 1, v); v += bperm_(lane ^ 2, v); v += bperm_(lane ^ 4, v); v += bperm_(lane ^ 8, v);
                            const float scl = __builtin_amdgcn_rsqf(v + 1e-6f) * (which == 0 ? 0.08838834764831845f : 1.0f); ol[tt] = ol[tt] * scl; oh[tt] = oh[tt] * scl; }
                    }
                    const int tb = tr * 8;
                    if (which == 0) {
#pragma unroll
                        for (int tt = 0; tt < 8; ++tt) { const int t = tb + tt; const float eg = seg[t];
                            v4u pk; pk.x = cvtpk(ol[tt].x, ol[tt].y); pk.y = cvtpk(ol[tt].z, ol[tt].w); pk.z = cvtpk(oh[tt].x, oh[tt].y); pk.w = cvtpk(oh[tt].z, oh[tt].w);
                            *(LAS v4u*)(qb + t * 272 + d0 * 2) = pk;
                            v4u pg; pg.x = cvtpk(ol[tt].x * eg, ol[tt].y * eg); pg.y = cvtpk(ol[tt].z * eg, ol[tt].w * eg); pg.z = cvtpk(oh[tt].x * eg, oh[tt].y * eg); pg.w = cvtpk(oh[tt].z * eg, oh[tt].w * eg);
                            { bf16* qrow = WSH(WS_GQD) + item4 * 8192 + t * 128 + (d0 & ~31); const int kl = d0 & 31;
                                v2u p0; p0.x = pg.x; p0.y = pg.y; v2u p1; p1.x = pg.z; p1.y = pg.w; *(v2u*)(qrow + kperm4(kl)) = p0; *(v2u*)(qrow + kperm4(kl + 4)) = p1; } }
                    } else if (which == 1) {
                        float fb[8], fl[8];
#pragma unroll
                        for (int tt = 0; tt < 8; ++tt) { const int t = tb + tt; fb[tt] = sbeta[t] * seg[t]; fl[tt] = sel[t];
                            v4u pk; pk.x = cvtpk(ol[tt].x, ol[tt].y); pk.y = cvtpk(ol[tt].z, ol[tt].w); pk.z = cvtpk(oh[tt].x, oh[tt].y); pk.w = cvtpk(oh[tt].z, oh[tt].w);
                            *(LAS v4u*)(kb + t * 272 + d0 * 2) = pk; }
#pragma unroll
                        for (int c = 0; c < 8; ++c) {
#define KV_(tt) ((c) < 4 ? ol[tt][(c) & 3] : oh[tt][(c) & 3])
                            v4u pe; pe.x = cvtpk(KV_(0) * fb[0], KV_(1) * fb[1]); pe.y = cvtpk(KV_(2) * fb[2], KV_(3) * fb[3]); pe.z = cvtpk(KV_(4) * fb[4], KV_(5) * fb[5]); pe.w = cvtpk(KV_(6) * fb[6], KV_(7) * fb[7]);
                            *(LAS v4u*)(kbeT + (d0 + c) * 144 + tb * 2) = pe;
                            v4u pt; pt.x = cvtpk(KV_(0) * fl[0], KV_(1) * fl[1]); pt.y = cvtpk(KV_(2) * fl[2], KV_(3) * fl[3]); pt.z = cvtpk(KV_(4) * fl[4], KV_(5) * fl[5]); pt.w = cvtpk(KV_(6) * fl[6], KV_(7) * fl[7]);
                            { bf16* krow = WSH(WS_GKT) + item4 * 8192 + (d0 + c) * 64 + (tb & ~31); const int kl = tb & 31;
                                v2u p0; p0.x = pt.x; p0.y = pt.y; v2u p1; p1.x = pt.z; p1.y = pt.w; *(v2u*)(krow + kperm4(kl)) = p0; *(v2u*)(krow + kperm4(kl + 4)) = p1; } }
                    } else {
                        float fb[8];
#pragma unroll
                        for (int tt = 0; tt < 8; ++tt) fb[tt] = sbeta[tb + tt];
#pragma unroll
                        for (int c = 0; c < 8; ++c) {
                            v4u pe; pe.x = cvtpk(KV_(0) * fb[0], KV_(1) * fb[1]); pe.y = cvtpk(KV_(2) * fb[2], KV_(3) * fb[3]); pe.z = cvtpk(KV_(4) * fb[4], KV_(5) * fb[5]); pe.w = cvtpk(KV_(6) * fb[6], KV_(7) * fb[7]);
                            *(LAS v4u*)(vT + (d0 + c) * 144 + tb * 2) = pe; }
#undef KV_
                    }
                }
                __syncthreads();
                {
                    const int it = wave >> 1;
#pragma unroll
                    for (int jj = 0; jj < 2; ++jj) { const int jt = (wave & 1) * 2 + jj;
                        f32x4 kk = (f32x4){0.f, 0.f, 0.f, 0.f}, qk = (f32x4){0.f, 0.f, 0.f, 0.f};
                        if (jt <= it) {
#pragma unroll
                            for (int ks = 0; ks < 4; ++ks) { const bf16x8 Bk = ld128(kb + (16 * jt + m) * 272 + (32 * ks + 8 * q) * 2);
                                kk = MFMA16(ld128(kb + (16 * it + m) * 272 + (32 * ks + 8 * q) * 2), Bk, kk); qk = MFMA16(ld128(qb + (16 * it + m) * 272 + (32 * ks + 8 * q) * 2), Bk, qk); } }
                        const int j = 16 * jt + m; const float gj = sgc[j];
#pragma unroll
                        for (int r = 0; r < 4; ++r) { const int i = 16 * it + 4 * q + r;
                            const float dec = (j <= i) ? exp_fast(sgc[i] - gj) : 0.f;
                            Ls[i * 68 + j] = (j < i) ? sbeta[i] * kk[r] * dec : 0.f;
                            *(LAS unsigned short*)(atts + i * 144 + kperm(j) * 2) = (unsigned short)f2bf((j <= i) ? qk[r] * dec : 0.f); } }
                }
                __syncthreads();
                if (tid < 64) { const int bk = tid >> 4, c = tid & 15; float x[16];
                    const LAS float* lb = Ls + (16 * bk) * 68 + 16 * bk;
#pragma unroll
                    for (int r = 0; r < 16; ++r) { float acc = (r == c) ? 1.f : 0.f;
#pragma unroll
                        for (int m4 = 0; m4 < (r + 3) / 4; ++m4) { const f32x4 lv = *(const LAS f32x4*)(lb + r * 68 + 4 * m4);
                            if (4 * m4 + 0 < r) acc -= lv.x * x[4 * m4 + 0]; if (4 * m4 + 1 < r) acc -= lv.y * x[4 * m4 + 1]; if (4 * m4 + 2 < r) acc -= lv.z * x[4 * m4 + 2]; if (4 * m4 + 3 < r) acc -= lv.w * x[4 * m4 + 3]; }
                        x[r] = acc; Ts[(16 * bk + r) * 68 + 16 * bk + c] = acc; } }
                __syncthreads();
#pragma unroll 1
                for (int dl = 1; dl < 4; ++dl) {
                    const int nout = (4 - dl) * 256;
                    for (int idx = tid; idx < nout; idx += NWAVES * 64) { const int blk = idx >> 8, r = (idx >> 4) & 15, c = idx & 15, i = blk + dl, j = blk; float acc = 0.f;
                        const LAS float* lrow = Ls + (16 * i + r) * 68 + 16 * j; const LAS float* tcol = Ts + (16 * j) * 68 + 16 * j + c;
                        for (int kk = 0; kk < dl; ++kk) {
#pragma unroll
                            for (int mm = 0; mm < 16; mm += 4) { const f32x4 lv = *(const LAS f32x4*)(lrow + 16 * kk + mm); const LAS float* tc = tcol + (16 * kk + mm) * 68;
                                acc += lv.x * tc[0] + lv.y * tc[68] + lv.z * tc[136] + lv.w * tc[204]; } }
                        Xs[idx] = acc; }
                    __syncthreads();
                    for (int idx = tid; idx < nout; idx += NWAVES * 64) { const int blk = idx >> 8, r = (idx >> 4) & 15, c = idx & 15, i = blk + dl, j = blk; float acc = 0.f;
                        const LAS float* trow = Ts + (16 * i + r) * 68 + 16 * i; const LAS float* xc = Xs + blk * 256 + c;
#pragma unroll
                        for (int mm = 0; mm < 16; mm += 4) { const f32x4 tv = *(const LAS f32x4*)(trow + mm); acc -= tv.x * xc[(mm + 0) * 16] + tv.y * xc[(mm + 1) * 16] + tv.z * xc[(mm + 2) * 16] + tv.w * xc[(mm + 3) * 16]; }
                        Ts[(16 * i + r) * 68 + 16 * j + c] = acc; }
                    __syncthreads();
                }
#pragma unroll
                for (int e = 0; e < 8; ++e) { const int idx = tid + 512 * e, i = idx >> 6, j = idx & 63;
                    *(LAS unsigned short*)(Tb + i * 144 + j * 2) = (unsigned short)(((j >> 4) <= (i >> 4)) ? f2bf(Ts[i * 68 + j]) : 0u); }
                __syncthreads();
                {
                    const int nt = wave;
#pragma unroll
                    for (int mt = 0; mt < 4; ++mt) { f32x4 ua = (f32x4){0.f, 0.f, 0.f, 0.f}, wa = (f32x4){0.f, 0.f, 0.f, 0.f};
#pragma unroll
                        for (int ks = 0; ks < 2; ++ks) if (32 * ks <= 16 * mt + 15) { const bf16x8 A = ld128(Tb + (16 * mt + m) * 144 + (32 * ks + 8 * q) * 2);
                            ua = MFMA16(A, ld128(vT + (16 * nt + m) * 144 + (32 * ks + 8 * q) * 2), ua); wa = MFMA16(A, ld128(kbeT + (16 * nt + m) * 144 + (32 * ks + 8 * q) * 2), wa); }
unsigned uts[4];
#pragma unroll
                        for (int r = 0; r < 4; ++r) { const int t = 16 * mt + 4 * q + r, d = 16 * nt + m;
                            uts[r] = f2bf(ua[r]); *(LAS unsigned short*)(kb + t * 272 + kperm(d) * 2) = (unsigned short)f2bf(-wa[r]); }
                        { v2u pu; pu.x = uts[0] | (uts[1] << 16); pu.y = uts[2] | (uts[3] << 16); *(LAS v2u*)(F.lds + PG_LS + (16 * nt + m) * 144 + (16 * mt + 4 * q) * 2) = pu; } }
                }
                __syncthreads();
#pragma unroll
                for (int e = 0; e < 2; ++e) { const int p = tid + 512 * e, row = p >> 4, c16 = p & 15;
                    *(v4u*)((unsigned char*)(WSH(WS_MIX + 16 * MiB) + item4 * 8192) + row * 256 + c16 * 16) = *(const LAS v4u*)(kb + row * 272 + c16 * 16);
                    const int ur = p >> 3, uc = p & 7;
                    *(v4u*)((unsigned char*)(WSH(WS_MIX) + item4 * 8192) + ur * 128 + uc * 16) = *(const LAS v4u*)(F.lds + PG_LS + ur * 144 + uc * 16); }
                { const int row = tid >> 3, c16 = tid & 7;
                    *(v4u*)((unsigned char*)(WSH(WS_GATT) + item4 * 4096) + row * 128 + c16 * 16) = *(const LAS v4u*)(atts + row * 144 + c16 * 16); }
                if (tid == 0) WSF(WS_GL)[item4] = seg[63];
                __syncthreads();
            }
        }
    }
}

#undef PREP_IDS
constexpr int SC_W = 0, SC_QD = 18432, SC_KT = 36864, SC_AT = 57344, SC_U = 67584, SC_STAGE = 76800;
static_assert(2 * SC_STAGE <= RING_BYTES, "scan stages fit the ring");
#define SBAR_() __builtin_amdgcn_sched_barrier(0)
#define WG_BAR() do { asm volatile("s_waitcnt lgkmcnt(0)" ::: "memory"); __builtin_amdgcn_s_barrier(); asm volatile("" ::: "memory"); } while (0)
template <int MODE  >
DI void p_scan(Frame& F, int l) {
    const int tid = F.tid, lane = F.lane, wave = F.wave;
    if (MODE == 0) for (int p = blockIdx.x * NWAVES + wave; p < BATCH * LRUW; p += gridDim.x * NWAVES) { const int b = p / LRUW, c = p % LRUW;
        float A = WSF(WS_AGG)[((size_t)(b * NCH + lane)) * LRUW + c], B = WSF(WS_AGG)[(size_t)BATCH * NCH * LRUW + ((size_t)(b * NCH + lane)) * LRUW + c];
#pragma unroll
        for (int off = 1; off < 64; off <<= 1) { const float Ap = shfl_up_(F.lane, A, off), Bp = shfl_up_(F.lane, B, off); if (lane >= off) { B = A * Bp + B; A = A * Ap; } }
        if (lane < 63) WSF(WS_CARRY)[((size_t)(b * NCH + lane + 1)) * LRUW + c] = B; else WSF(WS_CARRY)[((size_t)(b * NCH)) * LRUW + c] = 0.f; }
    const bool is_loader = wave >= 4;
    const int wv = wave & 3, m = lane & 15, q = lane >> 4, lt = tid & 255;
    for (int item = blockIdx.x; item < BATCH * GH * 2; item += gridDim.x) {
        const int bh = item >> 1, dvbase = (item & 1) * 64, b = bh >> 2, h = bh & 3;
        const size_t it0 = (size_t)bh * NCH;
        const unsigned char* gW = (const unsigned char*)(WSH(WS_MIX + 16 * MiB) + it0 * 8192);
        const unsigned char* gQD = (const unsigned char*)(WSH(WS_GQD) + it0 * 8192);
        const unsigned char* gKT = (const unsigned char*)(WSH(WS_GKT) + it0 * 8192);
        const unsigned char* gAT = (const unsigned char*)(WSH(WS_GATT) + it0 * 4096);
        const unsigned char* gU = (const unsigned char*)(WSH(WS_MIX) + it0 * 8192) + dvbase * 128;
#define SC_LOAD(rg, n_) do { const size_t cb = (size_t)(n_) * 16384, ca = (size_t)(n_) * 8192; \
            _Pragma("unroll") for (int i = 0; i < 4; ++i) { const int p = lt + 256 * i; rg[i] = *(const v4u*)(gW + cb + (p >> 4) * 256 + (p & 15) * 16); rg[4 + i] = *(const v4u*)(gQD + cb + (p >> 4) * 256 + (p & 15) * 16); \
                rg[8 + i] = *(const v4u*)(gKT + cb + (p >> 3) * 128 + (p & 7) * 16); } \
            _Pragma("unroll") for (int i = 0; i < 2; ++i) { const int p = lt + 256 * i; rg[12 + i] = *(const v4u*)(gAT + ca + (p >> 3) * 128 + (p & 7) * 16); rg[14 + i] = *(const v4u*)(gU + cb + (p >> 3) * 128 + (p & 7) * 16); } } while (0)
#define SC_WRITE(rg, buf_) do { LAS unsigned char* sb_ = F.lds + (buf_) * SC_STAGE; \
            _Pragma("unroll") for (int i = 0; i < 4; ++i) { const int p = lt + 256 * i; *(LAS v4u*)(sb_ + SC_W + (p >> 4) * 288 + (p & 15) * 16) = rg[i]; *(LAS v4u*)(sb_ + SC_QD + (p >> 4) * 288 + (p & 15) * 16) = rg[4 + i]; \
                *(LAS v4u*)(sb_ + SC_KT + (p >> 3) * 160 + (p & 7) * 16) = rg[8 + i]; } \
            _Pragma("unroll") for (int i = 0; i < 2; ++i) { const int p = lt + 256 * i; *(LAS v4u*)(sb_ + SC_AT + (p >> 3) * 160 + (p & 7) * 16) = rg[12 + i]; *(LAS v4u*)(sb_ + SC_U + (p >> 3) * 144 + (p & 7) * 16) = rg[14 + i]; } } while (0)
        if (is_loader) {
            v4u ra[16], rb[16];
            SC_LOAD(ra, 0); SC_WRITE(ra, 0); SC_LOAD(ra, 1); SC_LOAD(rb, 2);
            __syncthreads();
#pragma unroll 1
            for (int n = 0; n < NCH; n += 2) {
                SC_WRITE(ra, 1);
                if (MODE != 1) { const int nn = n + 3 < NCH ? n + 3 : NCH - 1; SC_LOAD(ra, nn); }
                WG_BAR();
                SC_WRITE(rb, 0);
                if (MODE != 1) { const int nn = n + 4 < NCH ? n + 4 : NCH - 1; SC_LOAD(rb, nn); }
                WG_BAR();
            }
        } else {
            f32x4 Sacc[8];
#pragma unroll
            for (int dt = 0; dt < 8; ++dt) Sacc[dt] = (f32x4){0.f, 0.f, 0.f, 0.f};
            const float glv = WSF(WS_GL)[it0 + lane];
            __syncthreads();
#define FR_W(dst, mt_) do { _Pragma("unroll") for (int kb = 0; kb < 4; ++kb) { dst[kb] = ld128(B + SC_W + (16 * (mt_) + m) * 288 + (32 * kb + 8 * q) * 2); dst[4 + kb] = ld128(B + SC_QD + (16 * (mt_) + m) * 288 + (32 * kb + 8 * q) * 2); } } while (0)
#define MM_W(src, mt_) do { _Pragma("unroll") for (int kb = 0; kb < 4; ++kb) { vn[mt_] = MFMA16(src[kb], Sb[kb], vn[mt_]); o[mt_] = MFMA16(src[4 + kb], Sb[kb], o[mt_]); } } while (0)
#define FR_KT(dst, hf_) do { _Pragma("unroll") for (int i = 0; i < 8; ++i) dst[i] = ld128(B + SC_KT + (16 * (4 * (hf_) + (i >> 1)) + m) * 160 + (32 * (i & 1) + 8 * q) * 2); } while (0)
#define MM_KT(src, hf_) do { _Pragma("unroll") for (int i = 0; i < 8; ++i) Sacc[4 * (hf_) + (i >> 1)] = MFMA16(src[i], vnb[i & 1], Sacc[4 * (hf_) + (i >> 1)]); } while (0)
#pragma unroll 1
            for (int n = 0; n < NCH; ++n) {
                if (MODE == 2) { WG_BAR(); continue; }
                const LAS unsigned char* B = F.lds + (n & 1) * SC_STAGE;
                bf16x8 fa[8], fb[8], Sb[4], vnb[2];
                f32x4 vn[4], o[4];
                v2u ut[4];
#pragma unroll
                for (int mt = 0; mt < 4; ++mt) ut[mt] = *(const LAS v2u*)(B + SC_U + (16 * wv + m) * 144 + (16 * mt + 4 * q) * 2);
                FR_W(fa, 0); SBAR_();
#pragma unroll
                for (int kb = 0; kb < 4; ++kb) Sb[kb] = pack8(Sacc[2 * kb], Sacc[2 * kb + 1]);
#pragma unroll
                for (int mt = 0; mt < 4; ++mt) { o[mt] = (f32x4){0.f, 0.f, 0.f, 0.f}; vn[mt] = (f32x4){bflo(ut[mt].x), bfhi(ut[mt].x), bflo(ut[mt].y), bfhi(ut[mt].y)}; }
                const float gl = __builtin_bit_cast(float, __builtin_amdgcn_readlane(__builtin_bit_cast(int, glv), n));
                SBAR_(); FR_W(fb, 1); SBAR_(); MM_W(fa, 0); SBAR_();
                FR_W(fa, 2); SBAR_(); MM_W(fb, 1); SBAR_();
                FR_W(fb, 3); SBAR_(); MM_W(fa, 2); SBAR_();
                fa[0] = ld128(B + SC_AT + (m) * 160 + (8 * q) * 2); fa[1] = ld128(B + SC_AT + (16 + m) * 160 + (8 * q) * 2);
                fa[2] = ld128(B + SC_AT + (32 + m) * 160 + (8 * q) * 2); fa[3] = ld128(B + SC_AT + (32 + m) * 160 + (32 + 8 * q) * 2);
                fa[4] = ld128(B + SC_AT + (48 + m) * 160 + (8 * q) * 2); fa[5] = ld128(B + SC_AT + (48 + m) * 160 + (32 + 8 * q) * 2);
                SBAR_(); MM_W(fb, 3); SBAR_();
                vnb[0] = pack8(vn[0], vn[1]); vnb[1] = pack8(vn[2], vn[3]);
#pragma unroll
                for (int dt = 0; dt < 8; ++dt) Sacc[dt] = Sacc[dt] * gl;
                SBAR_(); FR_KT(fb, 0); SBAR_();
                o[0] = MFMA16(fa[0], vnb[0], o[0]); o[1] = MFMA16(fa[1], vnb[0], o[1]); o[2] = MFMA16(fa[2], vnb[0], o[2]); o[3] = MFMA16(fa[4], vnb[0], o[3]);
                o[2] = MFMA16(fa[3], vnb[1], o[2]); o[3] = MFMA16(fa[5], vnb[1], o[3]);
                SBAR_(); FR_KT(fa, 1); SBAR_(); MM_KT(fb, 0); SBAR_();
                MM_KT(fa, 1); SBAR_();
                float* go = (MODE == 0 ? WSF(WS_GO) : WSF(WS_END)) + (MODE == 0 ? (size_t)(b * SEQ + n * CH + 4 * q) * GDNW + h * HD + dvbase + 16 * wv + m : (size_t)(4 * q) * GDNW + m);
#pragma unroll
                for (int mt = 0; mt < 4; ++mt)
#pragma unroll
                    for (int r = 0; r < 4; ++r) go[(size_t)(16 * mt + r) * GDNW] = o[mt][r];
                WG_BAR();
            }
#undef FR_W
#undef MM_W
#undef FR_KT
#undef MM_KT
        }
#undef SC_LOAD
#undef SC_WRITE
    }
}

DI void p_post(Frame& F, int l) {
    const int gw = F.vcu * NWAVES + F.wave, NGW = F.G * NWAVES, lane = F.lane;
    for (int m = gw; m < M; m += NGW) {
        const int b = m >> 12, n = (m & (SEQ - 1)) >> 6;
        f32x4 val[2]; float ss = 0.f;
#pragma unroll
        for (int j = 0; j < 2; ++j) { const int c = 4 * lane + 256 * j;
            const v4u hp = *(const v4u*)((const unsigned*)(F.A->ws + WS_H) + (size_t)m * LRUW + c);
            const f32x4 hl = (f32x4){bflo(hp.x), bflo(hp.y), bflo(hp.z), bflo(hp.w)}, p = (f32x4){bfhi(hp.x), bfhi(hp.y), bfhi(hp.z), bfhi(hp.w)}, cr = *(const f32x4*)(WSF(WS_CARRY) + ((size_t)(b * NCH + n)) * LRUW + c);
            const v2u y2 = *(const v2u*)(WSH(WS_PROJ) + (size_t)m * NPROJ + O_LY + c);
            const f32x4 hh = hl + p * cr;
            val[j] = (f32x4){hh.x * gelu_tanh(bflo(y2.x)), hh.y * gelu_tanh(bfhi(y2.x)), hh.z * gelu_tanh(bflo(y2.y)), hh.w * gelu_tanh(bfhi(y2.y))};
            ss += (val[j].x * val[j].x + val[j].y * val[j].y) + (val[j].z * val[j].z + val[j].w * val[j].w); }
        ss = wave_sum_(F.lane, ss);
        const float rl = 1.0f / sqrtf(ss * (1.0f / LRUW) + EPS);
#pragma unroll
        for (int j = 0; j < 2; ++j) { const int c = 4 * lane + 256 * j; const f32x4 nw = *(const f32x4*)(LRU_NORM_W + (size_t)l * LRUW + c);
            const f32x4 o = val[j] * rl * nw; v2u w; w.x = pk2(o.x, o.y); w.y = pk2(o.z, o.w); *(v2u*)(WSH(WS_MIX) + (size_t)m * D + c) = w; }
#pragma unroll
        for (int j = 0; j < 2; ++j) { const int c = 4 * lane + 256 * j, d = c & (HD - 1);
            const f32x4 o = *(const f32x4*)(WSF(WS_GO) + (size_t)m * GDNW + c);
            const float s2 = half_sum_(F.lane, (o.x * o.x + o.y * o.y) + (o.z * o.z + o.w * o.w));
            const float rg = 1.0f / sqrtf(s2 * (1.0f / HD) + EPS);
            const f32x4 nw = *(const f32x4*)(GDN_NORM_W + (size_t)l * HD + d);
            const v2u z2 = *(const v2u*)(WSH(WS_PROJ) + (size_t)m * NPROJ + O_Z + c);
            const f32x4 r = (f32x4){o.x * rg * nw.x * siluf_(bflo(z2.x)), o.y * rg * nw.y * siluf_(bfhi(z2.x)), o.z * rg * nw.z * siluf_(bflo(z2.y)), o.w * rg * nw.w * siluf_(bfhi(z2.y))};
            v2u w; w.x = pk2(r.x, r.y); w.y = pk2(r.z, r.w); *(v2u*)(WSH(WS_MIX) + (size_t)m * D + LRUW + c) = w; }
    }
}

DI void p_final(Frame& F) {
    const int gw = F.vcu * NWAVES + F.wave, NGW = F.G * NWAVES, lane = F.lane;
    for (int m = gw; m < M; m += NGW) {
        f32x4 v[4]; float ss = 0.f;
#pragma unroll
        for (int j = 0; j < 4; ++j) { v[j] = *(const f32x4*)(OUT_ + (size_t)m * D + 4 * lane + 256 * j); ss += (v[j].x * v[j].x + v[j].y * v[j].y) + (v[j].z * v[j].z + v[j].w * v[j].w); }
        ss = wave_sum_(F.lane, ss);
        const float rstd = 1.0f / sqrtf(ss * (1.0f / D) + EPS);
#pragma unroll
        for (int j = 0; j < 4; ++j) { const int col = 4 * lane + 256 * j; const f32x4 nw = *(const f32x4*)(FINAL_NORM_W + col); *(f32x4*)(OUT_ + (size_t)m * D + col) = v[j] * rstd * nw; }
    }
}

__device__ __forceinline__ void pg8::EpiMulti::operator()(const f32x4 (&acc)[2][2][4][2], const Unit& u, int wr, int wc, int fr, int fq) const {
    const __attribute__((address_space(4))) Args* ap = (const __attribute__((address_space(4))) Args*)__builtin_amdgcn_kernarg_segment_ptr(); asm volatile("" : "+s"(ap));
    unsigned char* ws = ap->ws;
    if (mode == 0) { EpiBf16<0> e{(bf16_t*)(ws + WS_PROJ), NPROJ, nullptr, 0, 0, 1.f}; e(acc, u, wr, wc, fr, fq); }
    else if (mode == 2) { EpiBf16<2> e{(bf16_t*)(ws + WS_ACT), FF, nullptr, 0, 0, 1.f}; e(acc, u, wr, wc, fr, fq); }
    else { const float* modl = (const float*)(ws + WS_MOD) + (size_t)l * BATCH * NMODC + (mode == 3 ? 2 * D : 5 * D);
        EpiResid r{(mode == 3 && l == 0) ? ap->in[0] : ap->out, ap->out, modl, D, NMODC, SEQ}; r(acc, u, wr, wc, fr, fq); }
}

__global__ void __launch_bounds__(NWAVES * 64, 2) mk_fwd(Args args) {
    extern __shared__ __attribute__((aligned(16))) unsigned char lds[];
    Frame F;
    F.lds = (LAS unsigned char*)lds;
    F.MISC = (volatile LAS unsigned*)(F.lds + MISC_OFF);
    F.tid = threadIdx.x; F.lane = F.tid & 63; F.wave = __builtin_amdgcn_readfirstlane(F.tid >> 6);
    F.G = gridDim.x; { const int bx = blockIdx.x; F.vcu = (F.G % 8 == 0) ? (bx % 8) * (F.G / 8) + bx / 8 : bx; }
    F.A = (const __attribute__((address_space(4))) Args*)__builtin_amdgcn_kernarg_segment_ptr();
    F.ctl = (gu32*)(F.A->ws + WS_CTL);
    for (int u = F.tid; u < (LDS_BYTES - LDSCTL_OFF) / 4; u += NWAVES * 64) ((LAS unsigned*)(F.lds + LDSCTL_OFF))[u] = 0u;
    __syncthreads();
    XcdBarrier bar; bar.bar = (unsigned*)(F.ctl + CW_BAR); bar.x = 0; bar.st = nullptr;
    if (N_LAUNCHES == 1) bar = xcd_barrier_post((unsigned*)(F.ctl + CW_BAR), F.MISC + 8);

    const int lo = F.A->ph_lo, hi = F.A->ph_hi;
    int rep_done = 0;
#pragma unroll 1
    for (int s = lo; s < hi; ++s) {
        { const __attribute__((address_space(4))) Args* ap = (const __attribute__((address_space(4))) Args*)__builtin_amdgcn_kernarg_segment_ptr(); asm volatile("" : "+s"(ap)); F.A = ap; }
        { int t_ = threadIdx.x; asm volatile("" : "+v"(t_)); F.tid = t_; F.lane = t_ & 63; F.wave = __builtin_amdgcn_readfirstlane(t_ >> 6); }
        if (s == 0) { if (PH_MASK & 1) { p_mod(F); __syncthreads(); p0_weights(F); } }
        else if (s == N_STEPS - 1) { if (PH_MASK & 2) p_final(F); }
        else {
            const int l = (s - 1) / 9, i = (s - 1) % 9;
            bf16* wl = WSH(WS_W) + (size_t)l * LAYER_W;
            const float* modl = WSF(WS_MOD) + (size_t)l * BATCH * NMODC;
            if (!((PH_MASK >> (2 + i)) & 1)) {}
            else if (i == 0) { p_normmod<true>(F, l, l == 0 ? X_IN : OUT_, NORM_MIX_W, 0, D); }
            else if (i == 2) { p_prep(F, l); }
            else if (i == 3) { p_scan<0>(F, l);
#ifdef PROBE_SCAN_MODE
                __syncthreads(); p_scan<PROBE_SCAN_MODE>(F, l);
#endif
            }
            else if (i == 4) { p_post(F, l); }
            else if (i == 6) { p_normmod<false>(F, l, OUT_, NORM_MLP_W, 3 * D, 4 * D); }
            else {
                pg8::Gemm g; pg8::EpiMulti E; E.l = l;
                if (i == 1) { g = pg8::Gemm{WSH(WS_H), wl, M, NPROJ, D}; E.PERM = true; E.mode = 0; }
                else if (i == 5) { g = pg8::Gemm{WSH(WS_MIX), wl + W_OUT_OFF, M, D, D}; E.PERM = false; E.mode = 3; }
                else if (i == 7) { g = pg8::Gemm{WSH(WS_H), wl + W_UP_OFF, M, FF, D}; E.PERM = true; E.mode = 2; }
                else { g = pg8::Gemm{WSH(WS_ACT), wl + W_DOWN_OFF, M, D, FF}; E.PERM = false; E.mode = 4; }
                pg8::StaticOrder S; S.init(g.M, g.N, F.G, (int)blockIdx.x);
                pg8::gemm_phase<pg8::EpiMulti, pg8::StaticOrder, PG8_ALIGN, PG8_SP2>(F.lds + RING_OFF, g, S, E);
            }
        }
        if (REP_MASK != 0 && s >= 1 && s < N_STEPS - 1 && ((REP_MASK >> ((s - 1) % 9)) & 1) && !rep_done) { rep_done = 1; --s; xcd_barrier(bar, F.tid == 0); continue; }
        rep_done = 0;
        if (s + 1 < hi) xcd_barrier(bar, F.tid == 0);
    }
}

extern "C" void kernel_launch(void* const* d_in, const int* in_sizes, int n_in, void* d_out, int out_size, void* d_ws, size_t ws_size, hipStream_t stream) {
    static int grid = 0;
    if (grid == 0) {
        if (n_in != 23 || in_sizes[0] != M * D || out_size != M * D || ws_size < WS_END) { fprintf(stderr, "kernel_launch: unexpected shapes (n_in %d, in0 %d, out %d, ws %zu); nothing launched\n", n_in, n_in > 0 ? in_sizes[0] : -1, out_size, ws_size); grid = -1; return; }
        int dev = 0, cus = 0;
        if (hipGetDevice(&dev) != hipSuccess || hipDeviceGetAttribute(&cus, hipDeviceAttributeMultiprocessorCount, dev) != hipSuccess) { grid = -1; return; }
        if (hipFuncSetAttribute((const void*)mk_fwd, hipFuncAttributeMaxDynamicSharedMemorySize, LDS_BYTES) != hipSuccess) { fprintf(stderr, "kernel_launch: hipFuncSetAttribute failed\n"); grid = -1; return; }
        (void)hipGetLastError();
        grid = cus;
    }
    if (grid < 0) return;
    if (hipMemsetAsync((char*)d_ws + WS_CTL, 0, CTL_ZERO_BYTES, stream) != hipSuccess) return;
    Args a{};
    for (int i = 0; i < 23; ++i) a.in[i] = (const float*)d_in[i];
    a.out = (float*)d_out; a.ws = (unsigned char*)d_ws;
    if (N_LAUNCHES == 1) { a.ph_lo = 0; a.ph_hi = N_STEPS; hipLaunchKernelGGL(mk_fwd, dim3(grid), dim3(NWAVES * 64), LDS_BYTES, stream, a); }
    else for (int s = 0; s < N_STEPS; ++s) { a.ph_lo = s; a.ph_hi = s + 1; hipLaunchKernelGGL(mk_fwd, dim3(grid), dim3(NWAVES * 64), LDS_BYTES, stream, a); }
}
```

```cpp
#include <hip/hip_runtime.h>
#include <cstdio>
#include <cstdint>
#include <cmath>
namespace pg8 {
#define PG8_LAS __attribute__((address_space(3)))
typedef unsigned short bf16_t;
typedef short bf16x8 __attribute__((ext_vector_type(8)));
typedef float f32x4 __attribute__((ext_vector_type(4)));
typedef unsigned u32x4 __attribute__((ext_vector_type(4)));
constexpr int BM = 256, BK = 64, HALF = 128, HTB = HALF * BK * 2  , STAGE_BYTES = 8 * HTB, NXCD = 8, WGM = 8;

__host__ __device__ __forceinline__ int lds_byte(int r, int c) { const int st = (r >> 4) * 2 + (c >> 5), rr = r & 15, cc = c & 31, ob = rr * 64 + cc * 2; return st * 1024 + (ob ^ (((ob >> 9) & 1) << 5)); }
__host__ __device__ __forceinline__ void stage_rc(int b, int& R, int& C) { const int st = b / 1024, sb = b % 1024, swz = sb ^ (((sb >> 9) & 1) << 5); R = (st >> 1) * 16 + swz / 64; C = (st & 1) * 32 + (swz % 64) / 2; }
__host__ __device__ __forceinline__ int perm32(int rho) { const int n = rho >> 4, i = rho & 15; return 8 * (i >> 2) + 4 * n + (i & 3); }

struct Unit { int pm, pn; };
struct Gemm { const bf16_t* A; const bf16_t* Bt; int M, N, K; };

struct StaticOrder {
    int nM, nN, nwg, G, c;
    __host__ __device__ void init(int M, int N, int G_, int c_) { nM = M / BM; nN = N / BM; nwg = nM * nN; G = G_; c = c_; }
    __host__ __device__ bool next(int i, Unit& u) const {
        const long L = (long)i * G + c; if (L >= nwg) return false;
        int wgid = (int)L; { const int q = nwg / NXCD, r = nwg % NXCD, xcd = wgid % NXCD, off = wgid / NXCD; wgid = (xcd < r ? xcd * (q + 1) : r * (q + 1) + (xcd - r) * q) + off; }
        const int nig = WGM * nN, gid = wgid / nig, fm = gid * WGM, gsz = (nM - fm) < WGM ? (nM - fm) : WGM;
        u.pm = fm + ((wgid % nig) % gsz); u.pn = (wgid % nig) / gsz; return true;
    }
    __device__ __forceinline__ void a_ready(const Unit&) const {}
    __device__ __forceinline__ void done(const Unit&) const {}
};

__device__ __forceinline__ unsigned cvt_pk_bf16(float lo, float hi) { unsigned r; asm volatile("v_cvt_pk_bf16_f32 %0, %1, %2" : "=v"(r) : "v"(lo), "v"(hi)); return r; }
typedef float f32x2 __attribute__((ext_vector_type(2)));
__device__ __forceinline__ f32x2 gelu_pk(f32x2 v) {
    const f32x2 av = __builtin_elementwise_abs(v), d = av * 0.2316418882f + 1.0f;
    f32x2 t; t.x = __builtin_amdgcn_rcpf(d.x); t.y = __builtin_amdgcn_rcpf(d.y);
    f32x2 q = t * 0.5307027145f + (-0.7265760135f); q = q * t + 0.7107068705f; q = q * t + (-0.142248368f); q = q * t + 0.127414796f; q = q * t;
    const f32x2 s = (v * v) * (-0.72134752044f);
    f32x2 e; e.x = __builtin_amdgcn_exp2f(s.x); e.y = __builtin_amdgcn_exp2f(s.y);
    const f32x2 m = v * (q * e), r = v - m;
    f32x2 o; o.x = v.x < 0.f ? m.x : r.x; o.y = v.y < 0.f ? m.y : r.y; return o;
}

template <int ACT  > struct EpiBf16 {
    static constexpr bool PERM = true, AFTER_DRAIN = false; static_assert(ACT == 0 || ACT == 1 || ACT == 2, "EpiBf16: ACT is 0 (none), 1 (gelu_pk) or 2 (squared relu)");
    bf16_t* O; int ldc; const float* bias; int split_cols; size_t split_stride; float scale0;
    __device__ __forceinline__ void operator()(const f32x4 (&acc)[2][2][4][2], const Unit& u, int wr, int wc, int fr, int fq) const {
        const int row0 = u.pm * BM + wr * 64 + fr; int colt = u.pn * BM; bf16_t* base = O;
        float sc = 1.f; if (split_cols) { const int t = colt / split_cols; base += (size_t)t * split_stride; colt -= t * split_cols; if (t == 0) sc = scale0; }
        const int col0 = colt + wc * 32 + 8 * fq, bcol0 = u.pn * BM + wc * 32 + 8 * fq;
        f32x4 bv[2][2];
#pragma unroll
        for (int bj = 0; bj < 2; ++bj)
#pragma unroll
            for (int n = 0; n < 2; ++n) bv[bj][n] = bias ? *(const f32x4*)(bias + bcol0 + bj * HALF + 4 * n) : (f32x4){0.f, 0.f, 0.f, 0.f};
#pragma unroll
        for (int ai = 0; ai < 2; ++ai)
#pragma unroll
            for (int m = 0; m < 4; ++m) { bf16_t* rowp = base + (size_t)(row0 + ai * HALF + m * 16) * ldc + col0;
#pragma unroll
                for (int bj = 0; bj < 2; ++bj) { f32x4 v0 = acc[ai][bj][m][0] + bv[bj][0], v1 = acc[ai][bj][m][1] + bv[bj][1];
                    if (ACT == 1) { f32x2 a = gelu_pk((f32x2){v0[0], v0[1]}), b = gelu_pk((f32x2){v0[2], v0[3]}), c = gelu_pk((f32x2){v1[0], v1[1]}), d = gelu_pk((f32x2){v1[2], v1[3]});
                        v0 = (f32x4){a.x, a.y, b.x, b.y}; v1 = (f32x4){c.x, c.y, d.x, d.y}; }
                    if (ACT == 2) { _Pragma("unroll") for (int q_ = 0; q_ < 4; ++q_) { const float a_ = fmaxf(v0[q_], 0.f), b_ = fmaxf(v1[q_], 0.f); v0[q_] = a_ * a_; v1[q_] = b_ * b_; } }
                    v0 = v0 * sc; v1 = v1 * sc; u32x4 w; w.x = cvt_pk_bf16(v0[0], v0[1]); w.y = cvt_pk_bf16(v0[2], v0[3]); w.z = cvt_pk_bf16(v1[0], v1[1]); w.w = cvt_pk_bf16(v1[2], v1[3]);
                    *(u32x4*)(rowp + bj * HALF) = w; } }
    }
};


struct EpiResid {
    static constexpr bool PERM = false, AFTER_DRAIN = false;
    const float* base; float* out; const float* gate; int ldc; int gate_stride; int rows_per_batch;
    __device__ __forceinline__ void operator()(const f32x4 (&acc)[2][2][4][2], const Unit& u, int wr, int wc, int fr, int fq) const {
        const int col0 = u.pn * BM + wc * 32 + 4 * fq;
        const float* gp = gate + (size_t)((u.pm * BM) / rows_per_batch) * gate_stride + col0;
        f32x4 gv[2][2];
#pragma unroll
        for (int bj = 0; bj < 2; ++bj)
#pragma unroll
            for (int n = 0; n < 2; ++n) gv[bj][n] = *(const f32x4*)(gp + bj * HALF + n * 16);
#pragma unroll
        for (int ai = 0; ai < 2; ++ai)
#pragma unroll
            for (int m = 0; m < 4; ++m) { const size_t off = (size_t)(u.pm * BM + ai * HALF + wr * 64 + m * 16 + fr) * ldc + col0;
#pragma unroll
                for (int bj = 0; bj < 2; ++bj)
#pragma unroll
                    for (int n = 0; n < 2; ++n) { const f32x4 bs = *(const f32x4*)(base + off + bj * HALF + n * 16);
                        *(f32x4*)(out + off + bj * HALF + n * 16) = bs + gv[bj][n] * acc[ai][bj][m][n]; } }
    }
};


struct EpiMulti {
    static constexpr bool AFTER_DRAIN = false;
    bool PERM; int mode, l;
    __device__ __forceinline__ void operator()(const f32x4 (&acc)[2][2][4][2], const Unit& u, int wr, int wc, int fr, int fq) const;
};

template <class Epi, class Sched, bool ALIGN_EPI = false, bool SP2 = false>
__device__ __forceinline__ void gemm_phase(PG8_LAS unsigned char* lds, const Gemm g, const Sched& S, const Epi& E) {
    int tid_l = threadIdx.x; asm volatile("" : "+v"(tid_l));
    const int tid = tid_l, wid = __builtin_amdgcn_readfirstlane(tid >> 6), lane = tid & 63, wr = wid >> 2, wc = wid & 3, fr = lane & 15, fq = lane >> 4;
    const int K = g.K, nt = K / BK;
    unsigned voffA[2], voffB[2];
#pragma unroll
    for (int i = 0; i < 2; ++i) { int R, C; stage_rc(tid * 16 + i * 8192, R, C); const int Rb = E.PERM ? ((R & ~31) + perm32(R & 31)) : R;
        voffA[i] = (unsigned)(R * K + C) * 2u; voffB[i] = (unsigned)(Rb * K + C) * 2u; }
    const size_t kstep = (size_t)(BK * 2);
    const size_t hstep = (size_t)HALF * K * 2;
    const size_t tstep = 2 * hstep;
    const unsigned ldsw = (unsigned)wid * 1024u;
    const int aoff = lds_byte(wr * 64 + fr, fq * 8), boff = lds_byte(wc * 32 + fr, fq * 8);
#define PG8_SA(b, h) (((b) * 2 + (h)) * HTB)
#define PG8_SB(b, h) ((4 + (b) * 2 + (h)) * HTB)
#define PG8_STAGE(bufoff, gbase, voff) do { _Pragma("unroll") for (int _i = 0; _i < 2; ++_i) \
        __builtin_amdgcn_global_load_lds((const unsigned*)((const char*)(gbase) + (voff)[_i]), (PG8_LAS unsigned*)(lds + (bufoff) + ldsw + _i * 8192), 16, 0, 0); } while (0)
#define PG8_LDA(dst, b, h) do { _Pragma("unroll") for (int m = 0; m < 4; ++m) _Pragma("unroll") for (int k = 0; k < 2; ++k) dst[m][k] = *(const PG8_LAS bf16x8*)(lds + PG8_SA(b, h) + aoff + m * 2048 + k * 1024); } while (0)
#define PG8_LDB(dst, b, h) do { _Pragma("unroll") for (int n = 0; n < 2; ++n) _Pragma("unroll") for (int k = 0; k < 2; ++k) dst[n][k] = *(const PG8_LAS bf16x8*)(lds + PG8_SB(b, h) + boff + n * 2048 + k * 1024); } while (0)
#define PG8_MMA(ai, bj, At, Bt) do { __builtin_amdgcn_s_setprio(1); _Pragma("unroll") for (int m = 0; m < 4; ++m) _Pragma("unroll") for (int n = 0; n < 2; ++n) _Pragma("unroll") for (int k = 0; k < 2; ++k) \
        acc[ai][bj][m][n] = __builtin_amdgcn_mfma_f32_16x16x32_bf16(Bt[n][k], At[m][k], acc[ai][bj][m][n], 0, 0, 0); __builtin_amdgcn_s_setprio(0); } while (0)
#define PG8_WAIT_V(n) asm volatile("s_waitcnt vmcnt(" #n ")" ::: "memory")
#define PG8_WAIT_L(n) asm volatile("s_waitcnt lgkmcnt(" #n ")" ::: "memory")
#define PG8_BAR __builtin_amdgcn_s_barrier()
#define PG8_SCHED __builtin_amdgcn_sched_barrier(0)
    Unit cur, nxt; int ui = 0;
    if (!S.next(0, cur)) return;
    f32x4 acc[2][2][4][2];
#pragma unroll
    for (int a = 0; a < 2; ++a)
#pragma unroll
        for (int b = 0; b < 2; ++b)
#pragma unroll
            for (int m = 0; m < 4; ++m)
#pragma unroll
                for (int n = 0; n < 2; ++n) acc[a][b][m][n] = (f32x4){0.f, 0.f, 0.f, 0.f};
    bf16x8 At[4][2], B0[2][2], B1[2][2];
    const char* cA = (const char*)g.A + (size_t)cur.pm * tstep; const char* cB = (const char*)g.Bt + (size_t)cur.pn * tstep;
    S.a_ready(cur);
    if constexpr (SP2) {
        PG8_STAGE(PG8_SB(0, 0), cB, voffB); PG8_STAGE(PG8_SB(0, 1), cB + hstep, voffB); PG8_STAGE(PG8_SA(0, 0), cA, voffA); PG8_STAGE(PG8_SA(0, 1), cA + hstep, voffA);
        if (wr == 1) PG8_BAR;
        PG8_WAIT_V(2); PG8_BAR;
        PG8_STAGE(PG8_SB(1, 0), cB + kstep, voffB); PG8_STAGE(PG8_SA(1, 0), cA + kstep, voffA); PG8_STAGE(PG8_SB(1, 1), cB + hstep + kstep, voffB);
        PG8_WAIT_V(6); PG8_BAR;
    } else {
        PG8_STAGE(PG8_SB(0, 0), cB, voffB); PG8_STAGE(PG8_SA(0, 0), cA, voffA); PG8_STAGE(PG8_SB(0, 1), cB + hstep, voffB); PG8_STAGE(PG8_SA(0, 1), cA + hstep, voffA);
        if (wr == 1) PG8_BAR;
        PG8_WAIT_V(4); PG8_BAR;
        PG8_STAGE(PG8_SB(1, 0), cB + kstep, voffB); PG8_STAGE(PG8_SA(1, 0), cA + kstep, voffA); PG8_STAGE(PG8_SB(1, 1), cB + hstep + kstep, voffB);
        PG8_WAIT_V(6); PG8_BAR;
    }
    for (;;) {
        const bool has_next = S.next(ui + 1, nxt);
        const char* nA = has_next ? (const char*)g.A + (size_t)nxt.pm * tstep : cA; const char* nB = has_next ? (const char*)g.Bt + (size_t)nxt.pn * tstep : cB;
        for (int t = 0; t < nt; t += 2) {
            const bool last = (t == nt - 2);
            const char* a1 = cA + (size_t)(t + 1) * kstep;
            const char* a2 = last ? nA : cA + (size_t)(t + 2) * kstep; const char* b2 = last ? nB : cB + (size_t)(t + 2) * kstep;
            const char* a3 = a2 + kstep; const char* b3 = b2 + kstep;
            if (last && has_next) S.a_ready(nxt);
            if constexpr (SP2) {
            PG8_LDB(B0, 0, 0); PG8_LDB(B1, 0, 1); PG8_SCHED; PG8_LDA(At, 0, 0); PG8_STAGE(PG8_SA(1, 1), a1 + hstep, voffA);
            PG8_WAIT_V(8); PG8_WAIT_L(0); PG8_BAR; PG8_MMA(0, 0, At, B0); PG8_MMA(0, 1, At, B1); PG8_BAR; PG8_SCHED;
            PG8_LDA(At, 0, 1); PG8_STAGE(PG8_SB(0, 0), b2, voffB); PG8_STAGE(PG8_SB(0, 1), b2 + hstep, voffB); PG8_STAGE(PG8_SA(0, 0), a2, voffA);
            PG8_WAIT_V(8); PG8_WAIT_L(0); PG8_BAR; PG8_MMA(1, 0, At, B0); PG8_MMA(1, 1, At, B1); PG8_BAR; PG8_SCHED;
            PG8_LDB(B0, 1, 0); PG8_LDB(B1, 1, 1); PG8_SCHED; PG8_LDA(At, 1, 0); PG8_STAGE(PG8_SA(0, 1), a2 + hstep, voffA);
            PG8_WAIT_V(8); PG8_WAIT_L(0); PG8_BAR; PG8_MMA(0, 0, At, B0); PG8_MMA(0, 1, At, B1); PG8_BAR; PG8_SCHED;
            PG8_LDA(At, 1, 1); PG8_STAGE(PG8_SB(1, 0), b3, voffB); PG8_STAGE(PG8_SB(1, 1), b3 + hstep, voffB); PG8_STAGE(PG8_SA(1, 0), a3, voffA);
            PG8_WAIT_V(8); PG8_WAIT_L(0); PG8_BAR; PG8_MMA(1, 0, At, B0); PG8_MMA(1, 1, At, B1); PG8_BAR; PG8_SCHED;
            } else {
            PG8_LDB(B0, 0, 0); PG8_SCHED; PG8_LDA(At, 0, 0); PG8_STAGE(PG8_SA(1, 1), a1 + hstep, voffA);
            PG8_WAIT_L(8); PG8_BAR; PG8_WAIT_L(0); PG8_MMA(0, 0, At, B0); PG8_BAR; PG8_SCHED;
            PG8_LDB(B1, 0, 1); PG8_STAGE(PG8_SB(0, 0), b2, voffB);
            PG8_BAR; PG8_WAIT_L(0); PG8_MMA(0, 1, At, B1); PG8_BAR;
            PG8_LDA(At, 0, 1); PG8_STAGE(PG8_SA(0, 0), a2, voffA);
            PG8_BAR; PG8_WAIT_L(0); PG8_MMA(1, 0, At, B0); PG8_BAR; PG8_SCHED;
            PG8_STAGE(PG8_SB(0, 1), b2 + hstep, voffB);
            PG8_WAIT_V(6); PG8_BAR; PG8_MMA(1, 1, At, B1); PG8_BAR;
            PG8_LDB(B0, 1, 0); PG8_SCHED; PG8_LDA(At, 1, 0); PG8_STAGE(PG8_SA(0, 1), a2 + hstep, voffA);
            PG8_WAIT_L(8); PG8_BAR; PG8_WAIT_L(0); PG8_MMA(0, 0, At, B0); PG8_BAR; PG8_SCHED;
            PG8_LDB(B1, 1, 1); PG8_STAGE(PG8_SB(1, 0), b3, voffB);
            PG8_BAR; PG8_WAIT_L(0); PG8_MMA(0, 1, At, B1); PG8_BAR;
            PG8_LDA(At, 1, 1); PG8_STAGE(PG8_SA(1, 0), a3, voffA);
            PG8_BAR; PG8_WAIT_L(0); PG8_MMA(1, 0, At, B0); PG8_BAR; PG8_SCHED;
            PG8_STAGE(PG8_SB(1, 1), b3 + hstep, voffB);
            PG8_WAIT_V(6); PG8_BAR; PG8_MMA(1, 1, At, B1); PG8_BAR;
            }
        }
        if constexpr (ALIGN_EPI) { if (wr == 0) PG8_BAR; }
        if constexpr (!Epi::AFTER_DRAIN) { E(acc, cur, wr, wc, fr, fq); S.done(cur); }
        if (!has_next) break;
#pragma unroll
        for (int a = 0; a < 2; ++a)
#pragma unroll
            for (int b = 0; b < 2; ++b)
#pragma unroll
                for (int m = 0; m < 4; ++m)
#pragma unroll
                    for (int n = 0; n < 2; ++n) acc[a][b][m][n] = (f32x4){0.f, 0.f, 0.f, 0.f};
        cur = nxt; cA = nA; cB = nB; ++ui;
        if constexpr (ALIGN_EPI) { if (wr == 1) PG8_BAR; }
    }
    PG8_WAIT_V(0);
    if constexpr (!ALIGN_EPI) { if (wr == 0) PG8_BAR; }
    PG8_BAR;
    if constexpr (Epi::AFTER_DRAIN) { E.fused(acc, cur, wr, wc, fr, fq, lds, wid, lane); S.done(cur); }
#undef PG8_SA
#undef PG8_SB
#undef PG8_STAGE
#undef PG8_LDA
#undef PG8_LDB
#undef PG8_MMA
#undef PG8_WAIT_V
#undef PG8_WAIT_L
#undef PG8_BAR
#undef PG8_SCHED
}
}
#define GAS __attribute__((address_space(1)))
#define LAS __attribute__((address_space(3)))
typedef unsigned short bf16;
typedef unsigned v4u __attribute__((ext_vector_type(4)));
typedef float f32x4 __attribute__((ext_vector_type(4)));
typedef short bf16x8 __attribute__((ext_vector_type(8)));
typedef GAS unsigned gu32;
typedef GAS unsigned long long gu64;
#define RLX_AGENT __ATOMIC_RELAXED, __HIP_MEMORY_SCOPE_AGENT
#define LDS_WAIT() asm volatile("s_waitcnt lgkmcnt(0)" ::: "memory")
#define VM_WAIT() asm volatile("s_waitcnt vmcnt(0)" ::: "memory")
__device__ __forceinline__ unsigned long long rt() { return __builtin_amdgcn_s_memrealtime(); }
__device__ __forceinline__ unsigned f2bf(float f) { unsigned u = __builtin_bit_cast(unsigned, f); return (u + 0x7fffu + ((u >> 16) & 1u)) >> 16; }
__device__ __forceinline__ unsigned pk2(float lo, float hi) { return f2bf(lo) | (f2bf(hi) << 16); }

#define XB_TMO      128
#define XB_XCNT(j)  (256  + 64 * (j))
#define XB_XSUB(j)  (1280 + 64 * (j))
#define XB_XGEN(j)  (2304 + 64 * (j))
#define XB_TOP      3328
#define XB_TOPGEN   3392
#define XCD_BAR_WORDS 3456
#define XB_SPIN_CAP (1u << 18)

__device__ __forceinline__ unsigned xb_ld(unsigned* p)              { return __hip_atomic_load(p, __ATOMIC_RELAXED, __HIP_MEMORY_SCOPE_AGENT); }
__device__ __forceinline__ unsigned xb_add(unsigned* p, unsigned v) { return __hip_atomic_fetch_add(p, v, __ATOMIC_RELAXED, __HIP_MEMORY_SCOPE_AGENT); }
__device__ __forceinline__ unsigned xb_xcc_id() { return (unsigned)__builtin_amdgcn_s_getreg((3 << 11) | 20) & 0xFu; }
#define XB_SPIN(cond, bar) do { unsigned _sp = 0; while (cond) { __builtin_amdgcn_s_sleep(1); \
    if ((++_sp & 255u) == 0u) { if (xb_ld(&(bar)[XB_TMO])) break; if (_sp > XB_SPIN_CAP) { atomicAdd(&(bar)[XB_TMO], 1u); break; } } } } while (0)

struct XcdBarrier {
    unsigned* bar; unsigned x;
    volatile LAS unsigned* st;
};

__device__ __forceinline__ XcdBarrier xcd_barrier_post(unsigned* bar, volatile LAS unsigned* st) {
    XcdBarrier b; b.bar = bar; b.x = xb_xcc_id(); b.st = st;
    if (threadIdx.x == 0) (void)xb_add(&bar[XB_XCNT(b.x)], 1u);
    return b;
}
__device__ __forceinline__ void xcd_barrier_complete(unsigned* bar, unsigned x, unsigned& nloc, unsigned& nx) {
    const unsigned G = gridDim.x * gridDim.y * gridDim.z;
    unsigned sum, cnt, mine, sp = 0u;
    for (;;) {
        sum = 0u; cnt = 0u; mine = 0u;
#pragma unroll
        for (unsigned j = 0; j < 16; ++j) { const unsigned c = xb_ld(&bar[XB_XCNT(j)]); sum += c; cnt += (c > 0u) ? 1u : 0u; mine = (j == x) ? c : mine; }
        if (sum == G) break;
        __builtin_amdgcn_s_sleep(1);
        if ((++sp & 255u) == 0u) { if (xb_ld(&bar[XB_TMO])) break; if (sp > XB_SPIN_CAP) { atomicAdd(&bar[XB_TMO], 1u); break; } }
    }
    nloc = mine > 0u ? mine : 1u; nx = cnt > 0u ? cnt : 1u;
}

__device__ __forceinline__ void xcd_barrier(const XcdBarrier& b, const bool t0  ) {
    asm volatile("s_waitcnt vmcnt(0)" ::: "memory");
    __syncthreads();
    if (t0) {
        unsigned* bar = b.bar;
        __builtin_amdgcn_s_waitcnt(0);
        unsigned nloc = b.st[0], nx = b.st[1];
        if (nloc == 0u) { xcd_barrier_complete(bar, b.x, nloc, nx); b.st[0] = nloc; b.st[1] = nx; }
        const unsigned old = xb_add(&bar[XB_XSUB(b.x)], 1u);
        const unsigned gen = old / nloc;
        if (old + 1u == (gen + 1u) * nloc) {
            __builtin_amdgcn_fence(__ATOMIC_RELEASE, "agent");
            asm volatile("s_waitcnt vmcnt(0)" ::: "memory");
            const unsigned og = xb_add(&bar[XB_TOP], 1u);
            const unsigned tg = og / nx;
            if (og + 1u == (tg + 1u) * nx) xb_add(&bar[XB_TOPGEN], 1u);
            else XB_SPIN(xb_ld(&bar[XB_TOPGEN]) == tg, bar);
            __builtin_amdgcn_fence(__ATOMIC_ACQUIRE, "agent");
            xb_add(&bar[XB_XGEN(b.x)], 1u);
            asm volatile("s_waitcnt vmcnt(0)" ::: "memory");
        } else {
            XB_SPIN(xb_ld(&bar[XB_XGEN(b.x)]) == gen, bar);
            __builtin_amdgcn_fence(__ATOMIC_ACQUIRE, "agent");
            asm volatile("s_waitcnt vmcnt(0)" ::: "memory");
        }
    }
    __syncthreads();
}

#ifndef PG8_SP2
#define PG8_SP2 true
#endif
#ifndef PG8_ALIGN
#define PG8_ALIGN true
#endif
constexpr int NWAVES = 8;
constexpr int N_STEPS = 38;
#ifndef MK_N_LAUNCHES
#define MK_N_LAUNCHES 1
#endif
#ifndef PH_MASK
#define PH_MASK 0xffff
#endif
#ifndef REP_MASK
#define REP_MASK 0
#endif
#ifndef PREP_REP_LRU
#define PREP_REP_LRU 1
#endif
#ifndef PREP_REP_GDN
#define PREP_REP_GDN 1
#endif
constexpr int N_LAUNCHES = MK_N_LAUNCHES;

constexpr int D = 1024, BATCH = 4, SEQ = 4096, DEPTH = 4, M = BATCH * SEQ;
constexpr int LRUW = 512, NGB = 8, GBW = 64, GH = 4, HD = 128, GDNW = 512, CH = 64, NCH = SEQ / CH, FF = 4096;
constexpr int NMODC = 6 * D, INC = 3080, NPROJ = 3072;
constexpr int O_LX = 0, O_LY = 512, O_Q = 1024, O_Z = 2560;
constexpr float EPS = 1e-6f;

constexpr size_t MiB = 1u << 20;
constexpr size_t WS_CTL = 0, CTL_ZERO_BYTES = 1 * MiB;
constexpr size_t WS_MOD = 1 * MiB;
constexpr size_t WS_BG = 2 * MiB;
constexpr size_t WS_AGG = 3 * MiB;
constexpr size_t WS_CARRY = 4 * MiB;
constexpr size_t WS_GL = 5 * MiB;
constexpr size_t WS_GT = 6 * MiB;
constexpr size_t WS_W = 8 * MiB;
constexpr size_t LAYER_W = (size_t)12288 * 1024;
constexpr size_t W_OUT_OFF = (size_t)3072 * 1024, W_UP_OFF = (size_t)4096 * 1024, W_DOWN_OFF = (size_t)8192 * 1024;
constexpr size_t WS_H = 104 * MiB;
constexpr size_t WS_MIX = 136 * MiB;
constexpr size_t WS_PROJ = 168 * MiB;
constexpr size_t WS_ACT = 168 * MiB;
constexpr size_t WS_GQD = 264 * MiB, WS_GKT = 280 * MiB;
constexpr size_t WS_GATT = 296 * MiB;
constexpr size_t WS_GO = 312 * MiB;
constexpr size_t WS_LRUP = 344 * MiB;
constexpr size_t WS_END = 376 * MiB;
constexpr int CW_BAR = 4096;

constexpr int RING_OFF = 0, RING_BYTES = 155648;
constexpr int LDSCTL_OFF = RING_BYTES, MISC_OFF = LDSCTL_OFF + 320;
constexpr int LDS_BYTES = 156672;

typedef unsigned v2u __attribute__((ext_vector_type(2)));
#define DI __device__ __forceinline__
DI float bf2f(unsigned b) { return __builtin_bit_cast(float, b << 16); }
DI float bflo(unsigned w) { return __builtin_bit_cast(float, w << 16); }
DI float bfhi(unsigned w) { return __builtin_bit_cast(float, w & 0xffff0000u); }
DI float sigmoidf_(float x) { return 1.f / (1.f + expf(-x)); }
DI float siluf_(float x) { return x / (1.f + expf(-x)); }
DI float rcp_(float x) { return __builtin_amdgcn_rcpf(x); }
DI float exp_fast(float x) { return __builtin_amdgcn_exp2f(x * 1.4426950408889634f); }
DI float sigmoid_fast(float x) { return rcp_(1.f + exp_fast(-x)); }
DI float silu_fast(float x) { return x * rcp_(1.f + exp_fast(-x)); }
DI float gelu_tanh(float x) { const float u = 0.7978845608028654f * (x + 0.044715f * x * x * x); return 0.5f * x * (1.f + tanhf(u)); }
DI float bperm_(int src_lane, float v) { return __builtin_bit_cast(float, __builtin_amdgcn_ds_bpermute(src_lane << 2, __builtin_bit_cast(int, v))); }
DI float wave_sum_(int lane, float v) {
#pragma unroll
    for (int o = 1; o < 64; o <<= 1) v += bperm_(lane ^ o, v);
    return v;
}
DI float half_sum_(int lane, float v) {
#pragma unroll
    for (int o = 1; o < 32; o <<= 1) v += bperm_(lane ^ o, v);
    return v;
}
DI float shfl_up_(int lane, float v, int off) { return bperm_(lane >= off ? lane - off : lane, v); }

struct Args { const float* in[23]; float* out; unsigned char* ws; int ph_lo, ph_hi; };
static_assert(sizeof(Args) == 23 * 8 + 8 + 8 + 8, "Args has no padding");
struct Frame {
    LAS unsigned char* lds;
    volatile LAS unsigned* MISC;
    gu32* ctl;
    int tid, lane, wave;
    int vcu, G;
    const __attribute__((address_space(4))) Args* A;
};
#define IN_(k) (F.A->in[k])
#define X_IN IN_(0)
#define C_IN IN_(1)
#define NORM_MIX_W IN_(2)
#define NORM_MLP_W IN_(3)
#define W_MOD IN_(4)
#define B_MOD IN_(5)
#define W_IN IN_(6)
#define LRU_CONV_W IN_(7)
#define LRU_CONV_B IN_(8)
#define GATE_A_W IN_(9)
#define GATE_A_B IN_(10)
#define GATE_X_W IN_(11)
#define GATE_X_B IN_(12)
#define LRU_LAMBDA IN_(13)
#define LRU_NORM_W IN_(14)
#define GDN_CONV_W IN_(15)
#define GDN_A_LOG IN_(16)
#define GDN_DT_BIAS IN_(17)
#define GDN_NORM_W IN_(18)
#define W_OUT IN_(19)
#define W_UP IN_(20)
#define W_DOWN IN_(21)
#define FINAL_NORM_W IN_(22)
#define OUT_ (F.A->out)
#define WSF(off) ((float*)(F.A->ws + (off)))
#define WSH(off) ((bf16*)(F.A->ws + (off)))

DI void p_mod(Frame& F) {
    LAS float* cs = (LAS float*)F.lds;
    LAS float* red = cs + 4096;
    for (int i = F.tid; i < BATCH * D; i += NWAVES * 64) cs[i] = siluf_(C_IN[i]);
    __syncthreads();
    for (int item = F.vcu; item < DEPTH * 96; item += F.G) {
        const int l = item / 96, cg = item % 96, col = cg * 64 + F.lane;
        const float* wp = W_MOD + ((size_t)l * D + F.wave * 128) * NMODC + col;
        float a0 = 0.f, a1 = 0.f, a2 = 0.f, a3 = 0.f;
#pragma unroll 16
        for (int kk = 0; kk < 128; ++kk) { const float wv = wp[(size_t)kk * NMODC]; const int k = F.wave * 128 + kk;
            a0 += cs[k] * wv; a1 += cs[1024 + k] * wv; a2 += cs[2048 + k] * wv; a3 += cs[3072 + k] * wv; }
        red[(F.wave * 4 + 0) * 64 + F.lane] = a0; red[(F.wave * 4 + 1) * 64 + F.lane] = a1; red[(F.wave * 4 + 2) * 64 + F.lane] = a2; red[(F.wave * 4 + 3) * 64 + F.lane] = a3;
        __syncthreads();
        if (F.tid < 256) { const int b = F.tid >> 6, ln = F.tid & 63; float s = 0.f;
#pragma unroll
            for (int w = 0; w < 8; ++w) s += red[(w * 4 + b) * 64 + ln];
            const int cc = cg * 64 + ln; WSF(WS_MOD)[((size_t)l * BATCH + b) * NMODC + cc] = s + B_MOD[(size_t)l * NMODC + cc]; }
        __syncthreads();
    }
}

DI void p0_transpose_item(const float* W, int K, int ldw, int N, bf16* WT, LAS float* scr, int item, int lane) {
    const int nblk = N / 32, kb = item / nblk, nb = item % nblk, k0 = 64 * kb, n0 = 32 * nb;
    f32x4 v[8];
#pragma unroll
    for (int i = 0; i < 8; ++i) v[i] = *(const f32x4*)(W + (size_t)(k0 + (lane >> 3) + 8 * i) * ldw + n0 + 4 * (lane & 7));
#pragma unroll
    for (int i = 0; i < 8; ++i) { LAS float* d = scr + ((lane >> 3) + 8 * i) * 33 + 4 * (lane & 7); d[0] = v[i].x; d[1] = v[i].y; d[2] = v[i].z; d[3] = v[i].w; }
    LDS_WAIT(); asm volatile("" ::: "memory");
    const int c = lane & 7;
#pragma unroll
    for (int j = 0; j < 4; ++j) { const int n = (lane >> 3) + 8 * j; const LAS float* s = scr + (8 * c) * 33 + n;
        v4u o; o.x = pk2(s[0 * 33], s[1 * 33]); o.y = pk2(s[2 * 33], s[3 * 33]); o.z = pk2(s[4 * 33], s[5 * 33]); o.w = pk2(s[6 * 33], s[7 * 33]);
        *(v4u*)(WT + (size_t)(n0 + n) * K + k0 + 8 * c) = o; }
    LDS_WAIT(); asm volatile("" ::: "memory");
}
DI void p0_weights(Frame& F) {
    LAS float* scr = (LAS float*)(F.lds + RING_OFF + F.wave * 16384);
    const int gw = F.vcu * NWAVES + F.wave, NGW = F.G * NWAVES;
    constexpr int I_IN = (D / 64) * (NPROJ / 32), I_OUT = (D / 64) * (D / 32), I_UP = (D / 64) * (FF / 32), I_DN = (FF / 64) * (D / 32);
    constexpr int PER_LAYER = I_IN + I_OUT + I_UP + I_DN;
    for (int it = gw; it < DEPTH * PER_LAYER; it += NGW) {
        const int l = it / PER_LAYER; int r = it % PER_LAYER; bf16* wl = WSH(WS_W) + (size_t)l * LAYER_W;
        if (r < I_IN) { p0_transpose_item(W_IN + (size_t)l * D * INC, D, INC, NPROJ, wl, scr, r, F.lane); continue; } r -= I_IN;
        if (r < I_OUT) { p0_transpose_item(W_OUT + (size_t)l * D * D, D, D, D, wl + W_OUT_OFF, scr, r, F.lane); continue; } r -= I_OUT;
        if (r < I_UP) { p0_transpose_item(W_UP + (size_t)l * D * FF, D, FF, FF, wl + W_UP_OFF, scr, r, F.lane); continue; } r -= I_UP;
        p0_transpose_item(W_DOWN + (size_t)l * FF * D, FF, D, D, wl + W_DOWN_OFF, scr, r, F.lane);
    }
    for (int o = (int)blockIdx.x * NWAVES * 64 + F.tid; o < DEPTH * 2 * NGB * 4096; o += (int)gridDim.x * NWAVES * 64) {
        const int i = o & 63, j = (o >> 6) & 63, g = (o >> 12) & 7, gate = (o >> 15) & 1, l = o >> 16;
        const float* src = gate ? GATE_X_W : GATE_A_W;
        WSH(WS_GT)[o] = (bf16)f2bf(src[(size_t)(l * NGB + g) * 4096 + i * 64 + j]);
    }
}

template <bool WITH_BG>
DI void p_normmod(Frame& F, int l, const float* xin, const float* normw, int off_sh, int off_sc) {
    LAS float* w8 = (LAS float*)F.lds;
    if (WITH_BG) {
        for (int i = F.tid; i < D * 8; i += NWAVES * 64) w8[i] = W_IN[((size_t)l * D + (i >> 3)) * INC + NPROJ + (i & 7)];
        __syncthreads();
    }
    const int gw = F.vcu * NWAVES + F.wave, NGW = F.G * NWAVES, lane = F.lane;
    f32x4 v[4];
    if (gw < M) {
#pragma unroll
        for (int j = 0; j < 4; ++j) v[j] = *(const f32x4*)(xin + (size_t)gw * D + 4 * lane + 256 * j);
    }
    for (int m = gw; m < M; m += NGW) {
        const int b = m >> 12, mn = m + NGW;
        f32x4 vnx[4];
#pragma unroll
        for (int j = 0; j < 4; ++j) vnx[j] = (mn < M) ? *(const f32x4*)(xin + (size_t)mn * D + 4 * lane + 256 * j) : (f32x4){0.f, 0.f, 0.f, 0.f};
        const float* modp = WSF(WS_MOD) + ((size_t)l * BATCH + b) * NMODC;
        float ss = 0.f;
#pragma unroll
        for (int j = 0; j < 4; ++j) ss += (v[j].x * v[j].x + v[j].y * v[j].y) + (v[j].z * v[j].z + v[j].w * v[j].w);
        ss = wave_sum_(lane, ss);
        const float rstd = 1.0f / sqrtf(ss * (1.0f / D) + EPS);
        float a0 = 0.f, a1 = 0.f, a2 = 0.f, a3 = 0.f, a4 = 0.f, a5 = 0.f, a6 = 0.f, a7 = 0.f;
#pragma unroll
        for (int j = 0; j < 4; ++j) {
            const int col = 4 * lane + 256 * j;
            const f32x4 nw = *(const f32x4*)(normw + (size_t)l * D + col), sc = *(const f32x4*)(modp + off_sc + col), sh = *(const f32x4*)(modp + off_sh + col);
            const f32x4 hv = v[j] * rstd * nw * (sc + 1.0f) + sh;
            v2u o; o.x = pk2(hv.x, hv.y); o.y = pk2(hv.z, hv.w);
            *(v2u*)(WSH(WS_H) + (size_t)m * D + col) = o;
            if (WITH_BG) {
#pragma unroll
                for (int e = 0; e < 4; ++e) { const f32x4 wa = *(const LAS f32x4*)(w8 + (col + e) * 8), wb = *(const LAS f32x4*)(w8 + (col + e) * 8 + 4); const float hh = hv[e];
                    a0 += hh * wa.x; a1 += hh * wa.y; a2 += hh * wa.z; a3 += hh * wa.w; a4 += hh * wb.x; a5 += hh * wb.y; a6 += hh * wb.z; a7 += hh * wb.w; }
            }
        }
        if (WITH_BG) {
            const bool b0 = lane & 1, b1 = lane & 2, b2 = lane & 4;
            float k0 = b0 ? a1 : a0, k1 = b0 ? a3 : a2, k2 = b0 ? a5 : a4, k3 = b0 ? a7 : a6;
            k0 += bperm_(lane ^ 1, b0 ? a0 : a1); k1 += bperm_(lane ^ 1, b0 ? a2 : a3); k2 += bperm_(lane ^ 1, b0 ? a4 : a5); k3 += bperm_(lane ^ 1, b0 ? a6 : a7);
            float c0 = b1 ? k1 : k0, c1 = b1 ? k3 : k2;
            c0 += bperm_(lane ^ 2, b1 ? k0 : k1); c1 += bperm_(lane ^ 2, b1 ? k2 : k3);
            float d = b2 ? c1 : c0;
            d += bperm_(lane ^ 4, b2 ? c0 : c1);
            d += bperm_(lane ^ 8, d); d += bperm_(lane ^ 16, d); d += bperm_(lane ^ 32, d);
            if (lane < 8) {
                const int hh = lane & 3;
                float r;
                if (lane < 4) r = sigmoidf_(d);
                else { const float xx = d + GDN_DT_BIAS[l * GH + hh]; const float sp = xx > 20.f ? xx : log1pf(expf(xx)); r = -expf(GDN_A_LOG[l * GH + hh]) * sp; }
                WSF(WS_BG)[(size_t)m * 8 + lane] = r;
            }
        }
#pragma unroll
        for (int j = 0; j < 4; ++j) v[j] = vnx[j];
    }
}

typedef float f32x2_t __attribute__((ext_vector_type(2))); typedef __bf16 bf16x2_t __attribute__((ext_vector_type(2)));
DI unsigned cvtpk(float lo, float hi) { f32x2_t v = {lo, hi}; bf16x2_t b = __builtin_convertvector(v, bf16x2_t); return __builtin_bit_cast(unsigned, b); }
DI bf16x8 pack8(f32x4 a, f32x4 b) { v4u p; p.x = cvtpk(a.x, a.y); p.y = cvtpk(a.z, a.w); p.z = cvtpk(b.x, b.y); p.w = cvtpk(b.z, b.w); return __builtin_bit_cast(bf16x8, p); }
DI bf16x8 ldfrag(const LAS unsigned char* p) { const v2u lo = *(const LAS v2u*)p, hi = *(const LAS v2u*)(p + 32); v4u r; r.x = lo.x; r.y = lo.y; r.z = hi.x; r.w = hi.y; return __builtin_bit_cast(bf16x8, r); }
#define MFMA16(a, b, c) __builtin_amdgcn_mfma_f32_16x16x32_bf16((a), (b), (c), 0, 0, 0)

DI bf16x8 ld128(const LAS unsigned char* p) { return *(const LAS bf16x8*)p; }
DI int kperm4(int k4) { return k4 < 16 ? 2 * k4 : 2 * (k4 - 16) + 4; }
DI int kperm(int k) { return (k & ~31) + kperm4(k & 28) + (k & 3); }
constexpr int PG_QB = 0, PG_KB = 17408, PG_KBET = 34816, PG_VT = 53248, PG_LS = 71680, PG_TS = 89088, PG_TB = 106496, PG_ATT = 115712, PG_XS = 124928, PG_SM = 128000, PG_END = 129024;
static_assert(PG_END <= RING_BYTES, "prep LDS map");
DI void p_prep(Frame& F, int l) {
    const int wave = F.wave;
#define PREP_IDS int tid_ = F.tid; asm volatile("" : "+v"(tid_)); const int tid = tid_, lane = tid & 63, m = lane & 15, q = lane >> 4; (void)m; (void)q;
    for (int item = blockIdx.x; item < BATCH * NCH; item += gridDim.x) {
        const int b = item / NCH, n = item % NCH, row0 = b * SEQ + n * CH, t0 = n * CH;
        for (int rep_ = 0; rep_ < PREP_REP_LRU; ++rep_) {
            PREP_IDS
            const int g = wave;
            LAS float* xr = (LAS float*)(F.lds + wave * 17408);
            const int tg = lane >> 3, cg = lane & 7, c0 = 8 * cg, cc0 = g * 64 + c0;
            v4u xp[11];
#pragma unroll
            for (int i = 0; i < 11; ++i) { const int tt = t0 + 8 * tg - 3 + i;
                xp[i] = (tt >= 0) ? *(const v4u*)(WSH(WS_PROJ) + (size_t)(b * SEQ + tt) * NPROJ + O_LX + cc0) : (v4u){0u, 0u, 0u, 0u}; }
            f32x4 wl_[4], wh_[4];
#pragma unroll
            for (int k = 0; k < 4; ++k) { wl_[k] = *(const f32x4*)(LRU_CONV_W + ((size_t)l * 4 + k) * LRUW + cc0); wh_[k] = *(const f32x4*)(LRU_CONV_W + ((size_t)l * 4 + k) * LRUW + cc0 + 4); }
            const f32x4 bl_ = *(const f32x4*)(LRU_CONV_B + l * LRUW + cc0), bh_ = *(const f32x4*)(LRU_CONV_B + l * LRUW + cc0 + 4);
            bf16x8 Bf[2][4][2];
#pragma unroll
            for (int gate = 0; gate < 2; ++gate)
#pragma unroll
                for (int nt = 0; nt < 4; ++nt)
#pragma unroll
                    for (int ks = 0; ks < 2; ++ks) Bf[gate][nt][ks] = *(const bf16x8*)(WSH(WS_GT) + ((size_t)((l * 2 + gate) * NGB + g)) * 4096 + (size_t)(16 * nt + m) * 64 + 32 * ks + 8 * q);
            float ba_[4], bx_[4], ls_[4];
#pragma unroll
            for (int nt = 0; nt < 4; ++nt) { const int cc = g * 64 + 16 * nt + m; ba_[nt] = GATE_A_B[l * LRUW + cc]; bx_[nt] = GATE_X_B[l * LRUW + cc];
                const float lam = LRU_LAMBDA[l * LRUW + cc]; ls_[nt] = -8.0f * (fmaxf(-lam, 0.f) + log1pf(expf(-fabsf(lam)))); }
#pragma unroll
            for (int tt = 0; tt < 8; ++tt) { f32x4 al = bl_, ah = bh_;
#pragma unroll
                for (int k = 0; k < 4; ++k) { const v4u xw = xp[tt + k];
                    al += wl_[k] * (f32x4){bflo(xw.x), bfhi(xw.x), bflo(xw.y), bfhi(xw.y)}; ah += wh_[k] * (f32x4){bflo(xw.z), bfhi(xw.z), bflo(xw.w), bfhi(xw.w)}; }
                *(LAS f32x4*)(xr + (8 * tg + tt) * 68 + c0) = al; *(LAS f32x4*)(xr + (8 * tg + tt) * 68 + c0 + 4) = ah; }
            asm volatile("s_waitcnt lgkmcnt(0)" ::: "memory");
            bf16x8 Af[4][2];
#pragma unroll
            for (int mt = 0; mt < 4; ++mt)
#pragma unroll
                for (int ks = 0; ks < 2; ++ks) { const LAS float* pp = xr + (16 * mt + m) * 68 + 32 * ks + 8 * q; Af[mt][ks] = pack8(*(const LAS f32x4*)pp, *(const LAS f32x4*)(pp + 4)); }
#pragma unroll
            for (int nt = 0; nt < 4; ++nt) {
                float av[4][4], bv[4][4];
#pragma unroll
                for (int mt = 0; mt < 4; ++mt) { f32x4 ra = (f32x4){0.f, 0.f, 0.f, 0.f}, ia = (f32x4){0.f, 0.f, 0.f, 0.f};
                    ra = MFMA16(Af[mt][0], Bf[0][nt][0], ra); ra = MFMA16(Af[mt][1], Bf[0][nt][1], ra);
                    ia = MFMA16(Af[mt][0], Bf[1][nt][0], ia); ia = MFMA16(Af[mt][1], Bf[1][nt][1], ia);
#pragma unroll
                    for (int r = 0; r < 4; ++r) { const float rr = sigmoid_fast(ra[r] + ba_[nt]), ig = sigmoid_fast(ia[r] + bx_[nt]);
                        const float log_a = rr * ls_[nt], aa = exp_fast(log_a), mult = __builtin_amdgcn_sqrtf(fmaxf(1.0f - exp_fast(2.0f * log_a), 1e-12f));
                        av[mt][r] = aa; bv[mt][r] = mult * (ig * xr[(16 * mt + 4 * q + r) * 68 + 16 * nt + m]); } }
                float iP[4], iH[4];
#pragma unroll
                for (int mt = 0; mt < 4; ++mt) {
#pragma unroll
                    for (int r = 1; r < 4; ++r) { bv[mt][r] = av[mt][r] * bv[mt][r - 1] + bv[mt][r]; av[mt][r] = av[mt][r] * av[mt][r - 1]; }
                    float PA = av[mt][3], HA = bv[mt][3];
                    { const float Pp = shfl_up_(lane, PA, 16), Hp = shfl_up_(lane, HA, 16); if (q >= 1) { HA = PA * Hp + HA; PA = PA * Pp; } }
                    { const float Pp = shfl_up_(lane, PA, 32), Hp = shfl_up_(lane, HA, 32); if (q >= 2) { HA = PA * Hp + HA; PA = PA * Pp; } }
                    iP[mt] = PA; iH[mt] = HA; }
                float CP = 1.f, CH = 0.f;
#pragma unroll
                for (int mt = 0; mt < 4; ++mt) {
                    const float totP = bperm_(m + 48, iP[mt]), totH = bperm_(m + 48, iH[mt]);
                    float exP = shfl_up_(lane, iP[mt], 16), exH = shfl_up_(lane, iH[mt], 16); if (q == 0) { exP = 1.f; exH = 0.f; }
                    const float EP = CP * exP, EH = exP * CH + exH;
#pragma unroll
                    for (int r = 0; r < 4; ++r) { const float Pf = EP * av[mt][r], Hf = av[mt][r] * EH + bv[mt][r];
                        *(LAS unsigned*)(xr + (16 * mt + 4 * q + r) * 68 + 16 * nt + m) = f2bf(Hf) | (f2bf(Pf) << 16); }
                    CH = totP * CH + totH; CP = CP * totP; }
                if (q == 0) { WSF(WS_AGG)[((size_t)(b * NCH + n)) * LRUW + g * 64 + 16 * nt + m] = CP; WSF(WS_AGG)[(size_t)BATCH * NCH * LRUW + ((size_t)(b * NCH + n)) * LRUW + g * 64 + 16 * nt + m] = CH; }
            }
            asm volatile("s_waitcnt lgkmcnt(0)" ::: "memory");
#pragma unroll
            for (int i = 0; i < 16; ++i) { const int pz = lane + 64 * i, row = pz >> 4, c16 = pz & 15;
                *(v4u*)((unsigned*)(F.A->ws + WS_H) + (size_t)(row0 + row) * LRUW + g * 64 + 4 * c16) = *(const LAS v4u*)(xr + row * 68 + 4 * c16); }
        }
        __syncthreads();
        {
            LAS unsigned char* qb = F.lds + PG_QB;
            LAS unsigned char* kb = F.lds + PG_KB;
            LAS unsigned char* kbeT = F.lds + PG_KBET;
            LAS unsigned char* vT = F.lds + PG_VT;
            LAS float* Ls = (LAS float*)(F.lds + PG_LS);
            LAS float* Ts = (LAS float*)(F.lds + PG_TS);
            LAS unsigned char* Tb = F.lds + PG_TB;
            LAS unsigned char* atts = F.lds + PG_ATT;
            LAS float* Xs = (LAS float*)(F.lds + PG_XS);
            LAS float* sm4 = (LAS float*)(F.lds + PG_SM);
            if (wave < GH) { int tl_ = F.tid; asm volatile("" : "+v"(tl_)); const int ln = tl_ & 63, hh = wave;
                float gcv = WSF(WS_BG)[(size_t)(row0 + ln) * 8 + 4 + hh];
#pragma unroll
                for (int off = 1; off < 64; off <<= 1) { const float pv = shfl_up_(ln, gcv, off); if (ln >= off) gcv += pv; }
                const float glast = bperm_(63, gcv);
                sm4[hh * 256 + ln] = gcv; sm4[hh * 256 + 64 + ln] = WSF(WS_BG)[(size_t)(row0 + ln) * 8 + hh]; sm4[hh * 256 + 128 + ln] = expf(gcv); sm4[hh * 256 + 192 + ln] = expf(glast - gcv); }
            __syncthreads();
            for (int h_ = 0; h_ < GH * PREP_REP_GDN; ++h_) { const int h = h_ % GH;
                PREP_IDS
                const size_t item4 = (size_t)(b * GH + h) * NCH + n;
                LAS float* sgc = sm4 + h * 256, *sbeta = sgc + 64, *seg = sgc + 128, *sel = sgc + 192;
                if (tid < 384) {
                    const int cgp = tid & 15, wt = tid >> 4, which = wt >> 3, tr = wt & 7, d0 = cgp * 8, ch0 = which * GDNW + h * HD + d0;
                    v4u xp[11];
#pragma unroll
                    for (int i = 0; i < 11; ++i) { const int tt = t0 + tr * 8 - 3 + i;
                        xp[i] = (tt >= 0) ? *(const v4u*)(WSH(WS_PROJ) + (size_t)(b * SEQ + tt) * NPROJ + O_Q + ch0) : (v4u){0u, 0u, 0u, 0u}; }
                    f32x4 wl_[4], wh_[4];
#pragma unroll
                    for (int k = 0; k < 4; ++k) { wl_[k] = *(const f32x4*)(GDN_CONV_W + ((size_t)l * 4 + k) * (3 * GDNW) + ch0); wh_[k] = *(const f32x4*)(GDN_CONV_W + ((size_t)l * 4 + k) * (3 * GDNW) + ch0 + 4); }
                    f32x4 ol[8], oh[8]; float ss[8];
#pragma unroll
                    for (int tt = 0; tt < 8; ++tt) { f32x4 al = (f32x4){0.f, 0.f, 0.f, 0.f}, ah = (f32x4){0.f, 0.f, 0.f, 0.f};
#pragma unroll
                        for (int k = 0; k < 4; ++k) { const v4u xw = xp[tt + k];
                            al += wl_[k] * (f32x4){bflo(xw.x), bfhi(xw.x), bflo(xw.y), bfhi(xw.y)}; ah += wh_[k] * (f32x4){bflo(xw.z), bfhi(xw.z), bflo(xw.w), bfhi(xw.w)}; }
#pragma unroll
                        for (int c = 0; c < 4; ++c) { al[c] = silu_fast(al[c]); ah[c] = silu_fast(ah[c]); }
                        ol[tt] = al; oh[tt] = ah;
                        ss[tt] = (al.x * al.x + al.y * al.y) + (al.z * al.z + al.w * al.w) + (ah.x * ah.x + ah.y * ah.y) + (ah.z * ah.z + ah.w * ah.w); }
                    if (which < 2) {
#pragma unroll
                        for (int tt = 0; tt < 8; ++tt) { float v = ss[tt]; v += bperm_(lane ^ 1, v); v += bperm_(lane ^ 2, v); v += bperm_(lane ^ 4, v); v += bperm_(lane ^ 8, v);
                            const float scl = __builtin_amdgcn_rsqf(v + 1e-6f) * (which == 0 ? 0.08838834764831845f : 1.0f); ol[tt] = ol[tt] * scl; oh[tt] = oh[tt] * scl; }
                    }
                    const int tb = tr * 8;
                    if (which == 0) {
#pragma unroll
                        for (int tt = 0; tt < 8; ++tt) { const int t = tb + tt; const float eg = seg[t];
                            v4u pk; pk.x = cvtpk(ol[tt].x, ol[tt].y); pk.y = cvtpk(ol[tt].z, ol[tt].w); pk.z = cvtpk(oh[tt].x, oh[tt].y); pk.w = cvtpk(oh[tt].z, oh[tt].w);
                            *(LAS v4u*)(qb + t * 272 + d0 * 2) = pk;
                            v4u pg; pg.x = cvtpk(ol[tt].x * eg, ol[tt].y * eg); pg.y = cvtpk(ol[tt].z * eg, ol[tt].w * eg); pg.z = cvtpk(oh[tt].x * eg, oh[tt].y * eg); pg.w = cvtpk(oh[tt].z * eg, oh[tt].w * eg);
                            { bf16* qrow = WSH(WS_GQD) + item4 * 8192 + t * 128 + (d0 & ~31); const int kl = d0 & 31;
                                v2u p0; p0.x = pg.x; p0.y = pg.y; v2u p1; p1.x = pg.z; p1.y = pg.w; *(v2u*)(qrow + kperm4(kl)) = p0; *(v2u*)(qrow + kperm4(kl + 4)) = p1; } }
                    } else if (which == 1) {
                        float fb[8], fl[8];
#pragma unroll
                        for (int tt = 0; tt < 8; ++tt) { const int t = tb + tt; fb[tt] = sbeta[t] * seg[t]; fl[tt] = sel[t];
                            v4u pk; pk.x = cvtpk(ol[tt].x, ol[tt].y); pk.y = cvtpk(ol[tt].z, ol[tt].w); pk.z = cvtpk(oh[tt].x, oh[tt].y); pk.w = cvtpk(oh[tt].z, oh[tt].w);
                            *(LAS v4u*)(kb + t * 272 + d0 * 2) = pk; }
#pragma unroll
                        for (int c = 0; c < 8; ++c) {
#define KV_(tt) ((c) < 4 ? ol[tt][(c) & 3] : oh[tt][(c) & 3])
                            v4u pe; pe.x = cvtpk(KV_(0) * fb[0], KV_(1) * fb[1]); pe.y = cvtpk(KV_(2) * fb[2], KV_(3) * fb[3]); pe.z = cvtpk(KV_(4) * fb[4], KV_(5) * fb[5]); pe.w = cvtpk(KV_(6) * fb[6], KV_(7) * fb[7]);
                            *(LAS v4u*)(kbeT + (d0 + c) * 144 + tb * 2) = pe;
                            v4u pt; pt.x = cvtpk(KV_(0) * fl[0], KV_(1) * fl[1]); pt.y = cvtpk(KV_(2) * fl[2], KV_(3) * fl[3]); pt.z = cvtpk(KV_(4) * fl[4], KV_(5) * fl[5]); pt.w = cvtpk(KV_(6) * fl[6], KV_(7) * fl[7]);
                            { bf16* krow = WSH(WS_GKT) + item4 * 8192 + (d0 + c) * 64 + (tb & ~31); const int kl = tb & 31;
                                v2u p0; p0.x = pt.x; p0.y = pt.y; v2u p1; p1.x = pt.z; p1.y = pt.w; *(v2u*)(krow + kperm4(kl)) = p0; *(v2u*)(krow + kperm4(kl + 4)) = p1; } }
                    } else {
                        float fb[8];
#pragma unroll
                        for (int tt = 0; tt < 8; ++tt) fb[tt] = sbeta[tb + tt];
#pragma unroll
                        for (int c = 0; c < 8; ++c) {
                            v4u pe; pe.x = cvtpk(KV_(0) * fb[0], KV_(1) * fb[1]); pe.y = cvtpk(KV_(2) * fb[2], KV_(3) * fb[3]); pe.z = cvtpk(KV_(4) * fb[4], KV_(5) * fb[5]); pe.w = cvtpk(KV_(6) * fb[6], KV_(7) * fb[7]);
                            *(LAS v4u*)(vT + (d0 + c) * 144 + tb * 2) = pe; }
#undef KV_
                    }
                }
                __syncthreads();
                {
                    const int it = wave >> 1;
#pragma unroll
                    for (int jj = 0; jj < 2; ++jj) { const int jt = (wave & 1) * 2 + jj;
                        f32x4 kk = (f32x4){0.f, 0.f, 0.f, 0.f}, qk = (f32x4){0.f, 0.f, 0.f, 0.f};
                        if (jt <= it) {
#pragma unroll
                            for (int ks = 0; ks < 4; ++ks) { const bf16x8 Bk = ld128(kb + (16 * jt + m) * 272 + (32 * ks + 8 * q) * 2);
                                kk = MFMA16(ld128(kb + (16 * it + m) * 272 + (32 * ks + 8 * q) * 2), Bk, kk); qk = MFMA16(ld128(qb + (16 * it + m) * 272 + (32 * ks + 8 * q) * 2), Bk, qk); } }
                        const int j = 16 * jt + m; const float gj = sgc[j];
#pragma unroll
                        for (int r = 0; r < 4; ++r) { const int i = 16 * it + 4 * q + r;
                            const float dec = (j <= i) ? exp_fast(sgc[i] - gj) : 0.f;
                            Ls[i * 68 + j] = (j < i) ? sbeta[i] * kk[r] * dec : 0.f;
                            *(LAS unsigned short*)(atts + i * 144 + kperm(j) * 2) = (unsigned short)f2bf((j <= i) ? qk[r] * dec : 0.f); } }
                }
                __syncthreads();
                if (tid < 64) { const int bk = tid >> 4, c = tid & 15; float x[16];
                    const LAS float* lb = Ls + (16 * bk) * 68 + 16 * bk;
#pragma unroll
                    for (int r = 0; r < 16; ++r) { float acc = (r == c) ? 1.f : 0.f;
#pragma unroll
                        for (int m4 = 0; m4 < (r + 3) / 4; ++m4) { const f32x4 lv = *(const LAS f32x4*)(lb + r * 68 + 4 * m4);
                            if (4 * m4 + 0 < r) acc -= lv.x * x[4 * m4 + 0]; if (4 * m4 + 1 < r) acc -= lv.y * x[4 * m4 + 1]; if (4 * m4 + 2 < r) acc -= lv.z * x[4 * m4 + 2]; if (4 * m4 + 3 < r) acc -= lv.w * x[4 * m4 + 3]; }
                        x[r] = acc; Ts[(16 * bk + r) * 68 + 16 * bk + c] = acc; } }
                __syncthreads();
#pragma unroll 1
                for (int dl = 1; dl < 4; ++dl) {
                    const int nout = (4 - dl) * 256;
                    for (int idx = tid; idx < nout; idx += NWAVES * 64) { const int blk = idx >> 8, r = (idx >> 4) & 15, c = idx & 15, i = blk + dl, j = blk; float acc = 0.f;
                        const LAS float* lrow = Ls + (16 * i + r) * 68 + 16 * j; const LAS float* tcol = Ts + (16 * j) * 68 + 16 * j + c;
                        for (int kk = 0; kk < dl; ++kk) {
#pragma unroll
                            for (int mm = 0; mm < 16; mm += 4) { const f32x4 lv = *(const LAS f32x4*)(lrow + 16 * kk + mm); const LAS float* tc = tcol + (16 * kk + mm) * 68;
                                acc += lv.x * tc[0] + lv.y * tc[68] + lv.z * tc[136] + lv.w * tc[204]; } }
                        Xs[idx] = acc; }
                    __syncthreads();
                    for (int idx = tid; idx < nout; idx += NWAVES * 64) { const int blk = idx >> 8, r = (idx >> 4) & 15, c = idx & 15, i = blk + dl, j = blk; float acc = 0.f;
                        const LAS float* trow = Ts + (16 * i + r) * 68 + 16 * i; const LAS float* xc = Xs + blk * 256 + c;
#pragma unroll
                        for (int mm = 0; mm < 16; mm += 4) { const f32x4 tv = *(const LAS f32x4*)(trow + mm); acc -= tv.x * xc[(mm + 0) * 16] + tv.y * xc[(mm + 1) * 16] + tv.z * xc[(mm + 2) * 16] + tv.w * xc[(mm + 3) * 16]; }
                        Ts[(16 * i + r) * 68 + 16 * j + c] = acc; }
                    __syncthreads();
                }
#pragma unroll
                for (int e = 0; e < 8; ++e) { const int idx = tid + 512 * e, i = idx >> 6, j = idx & 63;
                    *(LAS unsigned short*)(Tb + i * 144 + j * 2) = (unsigned short)(((j >> 4) <= (i >> 4)) ? f2bf(Ts[i * 68 + j]) : 0u); }
                __syncthreads();
                {
                    const int nt = wave;
#pragma unroll
                    for (int mt = 0; mt < 4; ++mt) { f32x4 ua = (f32x4){0.f, 0.f, 0.f, 0.f}, wa = (f32x4){0.f, 0.f, 0.f, 0.f};
#pragma unroll
                        for (int ks = 0; ks < 2; ++ks) if (32 * ks <= 16 * mt + 15) { const bf16x8 A = ld128(Tb + (16 * mt + m) * 144 + (32 * ks + 8 * q) * 2);
                            ua = MFMA16(A, ld128(vT + (16 * nt + m) * 144 + (32 * ks + 8 * q) * 2), ua); wa = MFMA16(A, ld128(kbeT + (16 * nt + m) * 144 + (32 * ks + 8 * q) * 2), wa); }
unsigned uts[4];
#pragma unroll
                        for (int r = 0; r < 4; ++r) { const int t = 16 * mt + 4 * q + r, d = 16 * nt + m;
                            uts[r] = f2bf(ua[r]); *(LAS unsigned short*)(kb + t * 272 + kperm(d) * 2) = (unsigned short)f2bf(-wa[r]); }
                        { v2u pu; pu.x = uts[0] | (uts[1] << 16); pu.y = uts[2] | (uts[3] << 16); *(LAS v2u*)(F.lds + PG_LS + (16 * nt + m) * 144 + (16 * mt + 4 * q) * 2) = pu; } }
                }
                __syncthreads();
#pragma unroll
                for (int e = 0; e < 2; ++e) { const int p = tid + 512 * e, row = p >> 4, c16 = p & 15;
                    *(v4u*)((unsigned char*)(WSH(WS_MIX + 16 * MiB) + item4 * 8192) + row * 256 + c16 * 16) = *(const LAS v4u*)(kb + row * 272 + c16 * 16);
                    const int ur = p >> 3, uc = p & 7;
                    *(v4u*)((unsigned char*)(WSH(WS_MIX) + item4 * 8192) + ur * 128 + uc * 16) = *(const LAS v4u*)(F.lds + PG_LS + ur * 144 + uc * 16); }
                { const int row = tid >> 3, c16 = tid & 7;
                    *(v4u*)((unsigned char*)(WSH(WS_GATT) + item4 * 4096) + row * 128 + c16 * 16) = *(const LAS v4u*)(atts + row * 144 + c16 * 16); }
                if (tid == 0) WSF(WS_GL)[item4] = seg[63];
                __syncthreads();
            }
        }
    }
}

#undef PREP_IDS
constexpr int SC_W = 0, SC_QD = 18432, SC_KT = 36864, SC_AT = 57344, SC_U = 67584, SC_STAGE = 76800;
static_assert(2 * SC_STAGE <= RING_BYTES, "scan stages fit the ring");
#define SBAR_() __builtin_amdgcn_sched_barrier(0)
#define WG_BAR() do { asm volatile("s_waitcnt lgkmcnt(0)" ::: "memory"); __builtin_amdgcn_s_barrier(); asm volatile("" ::: "memory"); } while (0)
template <int MODE  >
DI void p_scan(Frame& F, int l) {
    const int tid = F.tid, lane = F.lane, wave = F.wave;
    if (MODE == 0) for (int p = blockIdx.x * NWAVES + wave; p < BATCH * LRUW; p += gridDim.x * NWAVES) { const int b = p / LRUW, c = p % LRUW;
        float A = WSF(WS_AGG)[((size_t)(b * NCH + lane)) * LRUW + c], B = WSF(WS_AGG)[(size_t)BATCH * NCH * LRUW + ((size_t)(b * NCH + lane)) * LRUW + c];
#pragma unroll
        for (int off = 1; off < 64; off <<= 1) { const float Ap = shfl_up_(F.lane, A, off), Bp = shfl_up_(F.lane, B, off); if (lane >= off) { B = A * Bp + B; A = A * Ap; } }
        if (lane < 63) WSF(WS_CARRY)[((size_t)(b * NCH + lane + 1)) * LRUW + c] = B; else WSF(WS_CARRY)[((size_t)(b * NCH)) * LRUW + c] = 0.f; }
    const bool is_loader = wave >= 4;
    const int wv = wave & 3, m = lane & 15, q = lane >> 4, lt = tid & 255;
    for (int item = blockIdx.x; item < BATCH * GH * 2; item += gridDim.x) {
        const int bh = item >> 1, dvbase = (item & 1) * 64, b = bh >> 2, h = bh & 3;
        const size_t it0 = (size_t)bh * NCH;
        const unsigned char* gW = (const unsigned char*)(WSH(WS_MIX + 16 * MiB) + it0 * 8192);
        const unsigned char* gQD = (const unsigned char*)(WSH(WS_GQD) + it0 * 8192);
        const unsigned char* gKT = (const unsigned char*)(WSH(WS_GKT) + it0 * 8192);
        const unsigned char* gAT = (const unsigned char*)(WSH(WS_GATT) + it0 * 4096);
        const unsigned char* gU = (const unsigned char*)(WSH(WS_MIX) + it0 * 8192) + dvbase * 128;
#define SC_LOAD(rg, n_) do { const size_t cb = (size_t)(n_) * 16384, ca = (size_t)(n_) * 8192; \
            _Pragma("unroll") for (int i = 0; i < 4; ++i) { const int p = lt + 256 * i; rg[i] = *(const v4u*)(gW + cb + (p >> 4) * 256 + (p & 15) * 16); rg[4 + i] = *(const v4u*)(gQD + cb + (p >> 4) * 256 + (p & 15) * 16); \
                rg[8 + i] = *(const v4u*)(gKT + cb + (p >> 3) * 128 + (p & 7) * 16); } \
            _Pragma("unroll") for (int i = 0; i < 2; ++i) { const int p = lt + 256 * i; rg[12 + i] = *(const v4u*)(gAT + ca + (p >> 3) * 128 + (p & 7) * 16); rg[14 + i] = *(const v4u*)(gU + cb + (p >> 3) * 128 + (p & 7) * 16); } } while (0)
#define SC_WRITE(rg, buf_) do { LAS unsigned char* sb_ = F.lds + (buf_) * SC_STAGE; \
            _Pragma("unroll") for (int i = 0; i < 4; ++i) { const int p = lt + 256 * i; *(LAS v4u*)(sb_ + SC_W + (p >> 4) * 288 + (p & 15) * 16) = rg[i]; *(LAS v4u*)(sb_ + SC_QD + (p >> 4) * 288 + (p & 15) * 16) = rg[4 + i]; \
                *(LAS v4u*)(sb_ + SC_KT + (p >> 3) * 160 + (p & 7) * 16) = rg[8 + i]; } \
            _Pragma("unroll") for (int i = 0; i < 2; ++i) { const int p = lt + 256 * i; *(LAS v4u*)(sb_ + SC_AT + (p >> 3) * 160 + (p & 7) * 16) = rg[12 + i]; *(LAS v4u*)(sb_ + SC_U + (p >> 3) * 144 + (p & 7) * 16) = rg[14 + i]; } } while (0)
        if (is_loader) {
            v4u ra[16], rb[16];
            SC_LOAD(ra, 0); SC_WRITE(ra, 0); SC_LOAD(ra, 1); SC_LOAD(rb, 2);
            __syncthreads();
#pragma unroll 1
            for (int n = 0; n < NCH; n += 2) {
                SC_WRITE(ra, 1);
                if (MODE != 1) { const int nn = n + 3 < NCH ? n + 3 : NCH - 1; SC_LOAD(ra, nn); }
                WG_BAR();
                SC_WRITE(rb, 0);
                if (MODE != 1) { const int nn = n + 4 < NCH ? n + 4 : NCH - 1; SC_LOAD(rb, nn); }
                WG_BAR();
            }
        } else {
            f32x4 Sacc[8];
#pragma unroll
            for (int dt = 0; dt < 8; ++dt) Sacc[dt] = (f32x4){0.f, 0.f, 0.f, 0.f};
            const float glv = WSF(WS_GL)[it0 + lane];
            __syncthreads();
#define FR_W(dst, mt_) do { _Pragma("unroll") for (int kb = 0; kb < 4; ++kb) { dst[kb] = ld128(B + SC_W + (16 * (mt_) + m) * 288 + (32 * kb + 8 * q) * 2); dst[4 + kb] = ld128(B + SC_QD + (16 * (mt_) + m) * 288 + (32 * kb + 8 * q) * 2); } } while (0)
#define MM_W(src, mt_) do { _Pragma("unroll") for (int kb = 0; kb < 4; ++kb) { vn[mt_] = MFMA16(src[kb], Sb[kb], vn[mt_]); o[mt_] = MFMA16(src[4 + kb], Sb[kb], o[mt_]); } } while (0)
#define FR_KT(dst, hf_) do { _Pragma("unroll") for (int i = 0; i < 8; ++i) dst[i] = ld128(B + SC_KT + (16 * (4 * (hf_) + (i >> 1)) + m) * 160 + (32 * (i & 1) + 8 * q) * 2); } while (0)
#define MM_KT(src, hf_) do { _Pragma("unroll") for (int i = 0; i < 8; ++i) Sacc[4 * (hf_) + (i >> 1)] = MFMA16(src[i], vnb[i & 1], Sacc[4 * (hf_) + (i >> 1)]); } while (0)
#pragma unroll 1
            for (int n = 0; n < NCH; ++n) {
                if (MODE == 2) { WG_BAR(); continue; }
                const LAS unsigned char* B = F.lds + (n & 1) * SC_STAGE;
                bf16x8 fa[8], fb[8], Sb[4], vnb[2];
                f32x4 vn[4], o[4];
                v2u ut[4];
#pragma unroll
                for (int mt = 0; mt < 4; ++mt) ut[mt] = *(const LAS v2u*)(B + SC_U + (16 * wv + m) * 144 + (16 * mt + 4 * q) * 2);
                FR_W(fa, 0); SBAR_();
#pragma unroll
                for (int kb = 0; kb < 4; ++kb) Sb[kb] = pack8(Sacc[2 * kb], Sacc[2 * kb + 1]);
#pragma unroll
                for (int mt = 0; mt < 4; ++mt) { o[mt] = (f32x4){0.f, 0.f, 0.f, 0.f}; vn[mt] = (f32x4){bflo(ut[mt].x), bfhi(ut[mt].x), bflo(ut[mt].y), bfhi(ut[mt].y)}; }
                const float gl = __builtin_bit_cast(float, __builtin_amdgcn_readlane(__builtin_bit_cast(int, glv), n));
                SBAR_(); FR_W(fb, 1); SBAR_(); MM_W(fa, 0); SBAR_();
                FR_W(fa, 2); SBAR_(); MM_W(fb, 1); SBAR_();
                FR_W(fb, 3); SBAR_(); MM_W(fa, 2); SBAR_();
                fa[0] = ld128(B + SC_AT + (m) * 160 + (8 * q) * 2); fa[1] = ld128(B + SC_AT + (16 + m) * 160 + (8 * q) * 2);
                fa[2] = ld128(B + SC_AT + (32 + m) * 160 + (8 * q) * 2); fa[3] = ld128(B + SC_AT + (32 + m) * 160 + (32 + 8 * q) * 2);
                fa[4] = ld128(B + SC_AT + (48 + m) * 160 + (8 * q) * 2); fa[5] = ld128(B + SC_AT + (48 + m) * 160 + (32 + 8 * q) * 2);
                SBAR_(); MM_W(fb, 3); SBAR_();
                vnb[0] = pack8(vn[0], vn[1]); vnb[1] = pack8(vn[2], vn[3]);
#pragma unroll
                for (int dt = 0; dt < 8; ++dt) Sacc[dt] = Sacc[dt] * gl;
                SBAR_(); FR_KT(fb, 0); SBAR_();
                o[0] = MFMA16(fa[0], vnb[0], o[0]); o[1] = MFMA16(fa[1], vnb[0], o[1]); o[2] = MFMA16(fa[2], vnb[0], o[2]); o[3] = MFMA16(fa[4], vnb[0], o[3]);
                o[2] = MFMA16(fa[3], vnb[1], o[2]); o[3] = MFMA16(fa[5], vnb[1], o[3]);
                SBAR_(); FR_KT(fa, 1); SBAR_(); MM_KT(fb, 0); SBAR_();
                MM_KT(fa, 1); SBAR_();
                float* go = (MODE == 0 ? WSF(WS_GO) : WSF(WS_END)) + (MODE == 0 ? (size_t)(b * SEQ + n * CH + 4 * q) * GDNW + h * HD + dvbase + 16 * wv + m : (size_t)(4 * q) * GDNW + m);
#pragma unroll
                for (int mt = 0; mt < 4; ++mt)
#pragma unroll
                    for (int r = 0; r < 4; ++r) go[(size_t)(16 * mt + r) * GDNW] = o[mt][r];
                WG_BAR();
            }
#undef FR_W
#undef MM_W
#undef FR_KT
#undef MM_KT
        }
#undef SC_LOAD
#undef SC_WRITE
    }
}

DI float gelu_fast(float x) { const float u2 = 1.5957691216057308f * (x + 0.044715f * x * x * x); return x * rcp_(1.f + exp_fast(-u2)); }
struct PostRow { v4u hp[2]; v2u y2[2], z2[2]; f32x4 go[2], cr[2]; };
DI void post_load(Frame& F, PostRow& R, int m, int lane) {
    const int b = m >> 12, n = (m & (SEQ - 1)) >> 6;
#pragma unroll
    for (int j = 0; j < 2; ++j) { const int c = 4 * lane + 256 * j;
        R.hp[j] = *(const v4u*)((const unsigned*)(F.A->ws + WS_H) + (size_t)m * LRUW + c);
        R.cr[j] = *(const f32x4*)(WSF(WS_CARRY) + ((size_t)(b * NCH + n)) * LRUW + c);
        R.y2[j] = *(const v2u*)(WSH(WS_PROJ) + (size_t)m * NPROJ + O_LY + c);
        R.go[j] = *(const f32x4*)(WSF(WS_GO) + (size_t)m * GDNW + c);
        R.z2[j] = *(const v2u*)(WSH(WS_PROJ) + (size_t)m * NPROJ + O_Z + c); }
}
DI void p_post(Frame& F, int l) {
    const int gw = F.vcu * NWAVES + F.wave, NGW = F.G * NWAVES, lane = F.lane;
    PostRow R;
    if (gw < M) post_load(F, R, gw, lane);
    for (int m = gw; m < M; m += NGW) {
        PostRow Rn; const int mn = m + NGW;
        post_load(F, Rn, mn < M ? mn : m, lane);
        f32x4 val[2]; float ss = 0.f;
#pragma unroll
        for (int j = 0; j < 2; ++j) { const v4u hp = R.hp[j]; const v2u y2 = R.y2[j];
            const f32x4 hl = (f32x4){bflo(hp.x), bflo(hp.y), bflo(hp.z), bflo(hp.w)}, p = (f32x4){bfhi(hp.x), bfhi(hp.y), bfhi(hp.z), bfhi(hp.w)};
            const f32x4 hh = hl + p * R.cr[j];
            val[j] = (f32x4){hh.x * gelu_fast(bflo(y2.x)), hh.y * gelu_fast(bfhi(y2.x)), hh.z * gelu_fast(bflo(y2.y)), hh.w * gelu_fast(bfhi(y2.y))};
            ss += (val[j].x * val[j].x + val[j].y * val[j].y) + (val[j].z * val[j].z + val[j].w * val[j].w); }
        ss = wave_sum_(lane, ss);
        const float rl = 1.0f / sqrtf(ss * (1.0f / LRUW) + EPS);
#pragma unroll
        for (int j = 0; j < 2; ++j) { const int c = 4 * lane + 256 * j; const f32x4 nw = *(const f32x4*)(LRU_NORM_W + (size_t)l * LRUW + c);
            const f32x4 o = val[j] * rl * nw; v2u w; w.x = pk2(o.x, o.y); w.y = pk2(o.z, o.w); *(v2u*)(WSH(WS_MIX) + (size_t)m * D + c) = w; }
#pragma unroll
        for (int j = 0; j < 2; ++j) { const int c = 4 * lane + 256 * j, d = c & (HD - 1);
            const f32x4 o = R.go[j]; const v2u z2 = R.z2[j];
            const float s2 = half_sum_(lane, (o.x * o.x + o.y * o.y) + (o.z * o.z + o.w * o.w));
            const float rg = 1.0f / sqrtf(s2 * (1.0f / HD) + EPS);
            const f32x4 nw = *(const f32x4*)(GDN_NORM_W + (size_t)l * HD + d);
            const f32x4 r = (f32x4){o.x * rg * nw.x * silu_fast(bflo(z2.x)), o.y * rg * nw.y * silu_fast(bfhi(z2.x)), o.z * rg * nw.z * silu_fast(bflo(z2.y)), o.w * rg * nw.w * silu_fast(bfhi(z2.y))};
            v2u w; w.x = pk2(r.x, r.y); w.y = pk2(r.z, r.w); *(v2u*)(WSH(WS_MIX) + (size_t)m * D + LRUW + c) = w; }
        R = Rn;
    }
}

DI void p_final(Frame& F) {
    const int gw = F.vcu * NWAVES + F.wave, NGW = F.G * NWAVES, lane = F.lane;
    for (int m = gw; m < M; m += NGW) {
        f32x4 v[4]; float ss = 0.f;
#pragma unroll
        for (int j = 0; j < 4; ++j) { v[j] = *(const f32x4*)(OUT_ + (size_t)m * D + 4 * lane + 256 * j); ss += (v[j].x * v[j].x + v[j].y * v[j].y) + (v[j].z * v[j].z + v[j].w * v[j].w); }
        ss = wave_sum_(F.lane, ss);
        const float rstd = 1.0f / sqrtf(ss * (1.0f / D) + EPS);
#pragma unroll
        for (int j = 0; j < 4; ++j) { const int col = 4 * lane + 256 * j; const f32x4 nw = *(const f32x4*)(FINAL_NORM_W + col); *(f32x4*)(OUT_ + (size_t)m * D + col) = v[j] * rstd * nw; }
    }
}

__device__ __forceinline__ void pg8::EpiMulti::operator()(const f32x4 (&acc)[2][2][4][2], const Unit& u, int wr, int wc, int fr, int fq) const {
    const __attribute__((address_space(4))) Args* ap = (const __attribute__((address_space(4))) Args*)__builtin_amdgcn_kernarg_segment_ptr(); asm volatile("" : "+s"(ap));
    unsigned char* ws = ap->ws;
    if (mode == 0) { EpiBf16<0> e{(bf16_t*)(ws + WS_PROJ), NPROJ, nullptr, 0, 0, 1.f}; e(acc, u, wr, wc, fr, fq); }
    else if (mode == 2) { EpiBf16<2> e{(bf16_t*)(ws + WS_ACT), FF, nullptr, 0, 0, 1.f}; e(acc, u, wr, wc, fr, fq); }
    else { const float* modl = (const float*)(ws + WS_MOD) + (size_t)l * BATCH * NMODC + (mode == 3 ? 2 * D : 5 * D);
        EpiResid r{(mode == 3 && l == 0) ? ap->in[0] : ap->out, ap->out, modl, D, NMODC, SEQ}; r(acc, u, wr, wc, fr, fq); }
}

__global__ void __launch_bounds__(NWAVES * 64, 2) mk_fwd(Args args) {
    extern __shared__ __attribute__((aligned(16))) unsigned char lds[];
    Frame F;
    F.lds = (LAS unsigned char*)lds;
    F.MISC = (volatile LAS unsigned*)(F.lds + MISC_OFF);
    F.tid = threadIdx.x; F.lane = F.tid & 63; F.wave = __builtin_amdgcn_readfirstlane(F.tid >> 6);
    F.G = gridDim.x; { const int bx = blockIdx.x; F.vcu = (F.G % 8 == 0) ? (bx % 8) * (F.G / 8) + bx / 8 : bx; }
    F.A = (const __attribute__((address_space(4))) Args*)__builtin_amdgcn_kernarg_segment_ptr();
    F.ctl = (gu32*)(F.A->ws + WS_CTL);
    for (int u = F.tid; u < (LDS_BYTES - LDSCTL_OFF) / 4; u += NWAVES * 64) ((LAS unsigned*)(F.lds + LDSCTL_OFF))[u] = 0u;
    __syncthreads();
    XcdBarrier bar; bar.bar = (unsigned*)(F.ctl + CW_BAR); bar.x = 0; bar.st = nullptr;
    if (N_LAUNCHES == 1) bar = xcd_barrier_post((unsigned*)(F.ctl + CW_BAR), F.MISC + 8);

    const int lo = F.A->ph_lo, hi = F.A->ph_hi;
    int rep_done = 0;
#pragma unroll 1
    for (int s = lo; s < hi; ++s) {
        { const __attribute__((address_space(4))) Args* ap = (const __attribute__((address_space(4))) Args*)__builtin_amdgcn_kernarg_segment_ptr(); asm volatile("" : "+s"(ap)); F.A = ap; }
        { int t_ = threadIdx.x; asm volatile("" : "+v"(t_)); F.tid = t_; F.lane = t_ & 63; F.wave = __builtin_amdgcn_readfirstlane(t_ >> 6); }
        if (s == 0) { if (PH_MASK & 1) { p_mod(F); __syncthreads(); p0_weights(F); } }
        else if (s == N_STEPS - 1) { if (PH_MASK & 2) p_final(F); }
        else {
            const int l = (s - 1) / 9, i = (s - 1) % 9;
            bf16* wl = WSH(WS_W) + (size_t)l * LAYER_W;
            const float* modl = WSF(WS_MOD) + (size_t)l * BATCH * NMODC;
            if (!((PH_MASK >> (2 + i)) & 1)) {}
            else if (i == 0) { p_normmod<true>(F, l, l == 0 ? X_IN : OUT_, NORM_MIX_W, 0, D); }
            else if (i == 2) { p_prep(F, l); }
            else if (i == 3) { p_scan<0>(F, l);
#ifdef PROBE_SCAN_MODE
                __syncthreads(); p_scan<PROBE_SCAN_MODE>(F, l);
#endif
            }
            else if (i == 4) { p_post(F, l); }
            else if (i == 6) { p_normmod<false>(F, l, OUT_, NORM_MLP_W, 3 * D, 4 * D); }
            else {
                pg8::Gemm g; pg8::EpiMulti E; E.l = l;
                if (i == 1) { g = pg8::Gemm{WSH(WS_H), wl, M, NPROJ, D}; E.PERM = true; E.mode = 0; }
                else if (i == 5) { g = pg8::Gemm{WSH(WS_MIX), wl + W_OUT_OFF, M, D, D}; E.PERM = false; E.mode = 3; }
                else if (i == 7) { g = pg8::Gemm{WSH(WS_H), wl + W_UP_OFF, M, FF, D}; E.PERM = true; E.mode = 2; }
                else { g = pg8::Gemm{WSH(WS_ACT), wl + W_DOWN_OFF, M, D, FF}; E.PERM = false; E.mode = 4; }
                pg8::StaticOrder S; S.init(g.M, g.N, F.G, (int)blockIdx.x);
                pg8::gemm_phase<pg8::EpiMulti, pg8::StaticOrder, PG8_ALIGN, PG8_SP2>(F.lds + RING_OFF, g, S, E);
            }
        }
        if (REP_MASK != 0 && ((s >= 1 && s < N_STEPS - 1 && ((REP_MASK >> ((s - 1) % 9)) & 1)) || (s == 0 && (REP_MASK & 0x10000))) && !rep_done) { rep_done = 1; --s; xcd_barrier(bar, F.tid == 0); continue; }
        rep_done = 0;
        if (s + 1 < hi) xcd_barrier(bar, F.tid == 0);
    }
}

extern "C" void kernel_launch(void* const* d_in, const int* in_sizes, int n_in, void* d_out, int out_size, void* d_ws, size_t ws_size, hipStream_t stream) {
    static int grid = 0;
    if (grid == 0) {
        if (n_in != 23 || in_sizes[0] != M * D || out_size != M * D || ws_size < WS_END) { fprintf(stderr, "kernel_launch: unexpected shapes (n_in %d, in0 %d, out %d, ws %zu); nothing launched\n", n_in, n_in > 0 ? in_sizes[0] : -1, out_size, ws_size); grid = -1; return; }
        int dev = 0, cus = 0;
        if (hipGetDevice(&dev) != hipSuccess || hipDeviceGetAttribute(&cus, hipDeviceAttributeMultiprocessorCount, dev) != hipSuccess) { grid = -1; return; }
        if (hipFuncSetAttribute((const void*)mk_fwd, hipFuncAttributeMaxDynamicSharedMemorySize, LDS_BYTES) != hipSuccess) { fprintf(stderr, "kernel_launch: hipFuncSetAttribute failed\n"); grid = -1; return; }
        (void)hipGetLastError();
        grid = cus;
    }
    if (grid < 0) return;
    if (hipMemsetAsync((char*)d_ws + WS_CTL, 0, CTL_ZERO_BYTES, stream) != hipSuccess) return;
    Args a{};
    for (int i = 0; i < 23; ++i) a.in[i] = (const float*)d_in[i];
    a.out = (float*)d_out; a.ws = (unsigned char*)d_ws;
    if (N_LAUNCHES == 1) { a.ph_lo = 0; a.ph_hi = N_STEPS; hipLaunchKernelGGL(mk_fwd, dim3(grid), dim3(NWAVES * 64), LDS_BYTES, stream, a); }
    else for (int s = 0; s < N_STEPS; ++s) { a.ph_lo = s; a.ph_hi = s + 1; hipLaunchKernelGGL(mk_fwd, dim3(grid), dim3(NWAVES * 64), LDS_BYTES, stream, a); }
}
```

```cpp
#include <hip/hip_runtime.h>
#include <cstdio>
#include <cstdint>
#include <cmath>
namespace pg8 {
#define PG8_LAS __attribute__((address_space(3)))
typedef unsigned short bf16_t;
typedef short bf16x8 __attribute__((ext_vector_type(8)));
typedef float f32x4 __attribute__((ext_vector_type(4)));
typedef unsigned u32x4 __attribute__((ext_vector_type(4)));
constexpr int BM = 256, BK = 64, HALF = 128, HTB = HALF * BK * 2  , STAGE_BYTES = 8 * HTB, NXCD = 8, WGM = 8;

__host__ __device__ __forceinline__ int lds_byte(int r, int c) { const int st = (r >> 4) * 2 + (c >> 5), rr = r & 15, cc = c & 31, ob = rr * 64 + cc * 2; return st * 1024 + (ob ^ (((ob >> 9) & 1) << 5)); }
__host__ __device__ __forceinline__ void stage_rc(int b, int& R, int& C) { const int st = b / 1024, sb = b % 1024, swz = sb ^ (((sb >> 9) & 1) << 5); R = (st >> 1) * 16 + swz / 64; C = (st & 1) * 32 + (swz % 64) / 2; }
__host__ __device__ __forceinline__ int perm32(int rho) { const int n = rho >> 4, i = rho & 15; return 8 * (i >> 2) + 4 * n + (i & 3); }

struct Unit { int pm, pn; };
struct Gemm { const bf16_t* A; const bf16_t* Bt; int M, N, K; };

struct StaticOrder {
    int nM, nN, nwg, G, c;
    __host__ __device__ void init(int M, int N, int G_, int c_) { nM = M / BM; nN = N / BM; nwg = nM * nN; G = G_; c = c_; }
    __host__ __device__ bool next(int i, Unit& u) const {
        const long L = (long)i * G + c; if (L >= nwg) return false;
        int wgid = (int)L; { const int q = nwg / NXCD, r = nwg % NXCD, xcd = wgid % NXCD, off = wgid / NXCD; wgid = (xcd < r ? xcd * (q + 1) : r * (q + 1) + (xcd - r) * q) + off; }
        const int nig = WGM * nN, gid = wgid / nig, fm = gid * WGM, gsz = (nM - fm) < WGM ? (nM - fm) : WGM;
        u.pm = fm + ((wgid % nig) % gsz); u.pn = (wgid % nig) / gsz; return true;
    }
    __device__ __forceinline__ void a_ready(const Unit&) const {}
    __device__ __forceinline__ void done(const Unit&) const {}
};

__device__ __forceinline__ unsigned cvt_pk_bf16(float lo, float hi) { unsigned r; asm volatile("v_cvt_pk_bf16_f32 %0, %1, %2" : "=v"(r) : "v"(lo), "v"(hi)); return r; }
typedef float f32x2 __attribute__((ext_vector_type(2)));
__device__ __forceinline__ f32x2 gelu_pk(f32x2 v) {
    const f32x2 av = __builtin_elementwise_abs(v), d = av * 0.2316418882f + 1.0f;
    f32x2 t; t.x = __builtin_amdgcn_rcpf(d.x); t.y = __builtin_amdgcn_rcpf(d.y);
    f32x2 q = t * 0.5307027145f + (-0.7265760135f); q = q * t + 0.7107068705f; q = q * t + (-0.142248368f); q = q * t + 0.127414796f; q = q * t;
    const f32x2 s = (v * v) * (-0.72134752044f);
    f32x2 e; e.x = __builtin_amdgcn_exp2f(s.x); e.y = __builtin_amdgcn_exp2f(s.y);
    const f32x2 m = v * (q * e), r = v - m;
    f32x2 o; o.x = v.x < 0.f ? m.x : r.x; o.y = v.y < 0.f ? m.y : r.y; return o;
}

template <int ACT  > struct EpiBf16 {
    static constexpr bool PERM = true, AFTER_DRAIN = false; static_assert(ACT == 0 || ACT == 1 || ACT == 2, "EpiBf16: ACT is 0 (none), 1 (gelu_pk) or 2 (squared relu)");
    bf16_t* O; int ldc; const float* bias; int split_cols; size_t split_stride; float scale0;
    __device__ __forceinline__ void operator()(const f32x4 (&acc)[2][2][4][2], const Unit& u, int wr, int wc, int fr, int fq) const {
        const int row0 = u.pm * BM + wr * 64 + fr; int colt = u.pn * BM; bf16_t* base = O;
        float sc = 1.f; if (split_cols) { const int t = colt / split_cols; base += (size_t)t * split_stride; colt -= t * split_cols; if (t == 0) sc = scale0; }
        const int col0 = colt + wc * 32 + 8 * fq, bcol0 = u.pn * BM + wc * 32 + 8 * fq;
        f32x4 bv[2][2];
#pragma unroll
        for (int bj = 0; bj < 2; ++bj)
#pragma unroll
            for (int n = 0; n < 2; ++n) bv[bj][n] = bias ? *(const f32x4*)(bias + bcol0 + bj * HALF + 4 * n) : (f32x4){0.f, 0.f, 0.f, 0.f};
#pragma unroll
        for (int ai = 0; ai < 2; ++ai)
#pragma unroll
            for (int m = 0; m < 4; ++m) { bf16_t* rowp = base + (size_t)(row0 + ai * HALF + m * 16) * ldc + col0;
#pragma unroll
                for (int bj = 0; bj < 2; ++bj) { f32x4 v0 = acc[ai][bj][m][0] + bv[bj][0], v1 = acc[ai][bj][m][1] + bv[bj][1];
                    if (ACT == 1) { f32x2 a = gelu_pk((f32x2){v0[0], v0[1]}), b = gelu_pk((f32x2){v0[2], v0[3]}), c = gelu_pk((f32x2){v1[0], v1[1]}), d = gelu_pk((f32x2){v1[2], v1[3]});
                        v0 = (f32x4){a.x, a.y, b.x, b.y}; v1 = (f32x4){c.x, c.y, d.x, d.y}; }
                    if (ACT == 2) { _Pragma("unroll") for (int q_ = 0; q_ < 4; ++q_) { const float a_ = fmaxf(v0[q_], 0.f), b_ = fmaxf(v1[q_], 0.f); v0[q_] = a_ * a_; v1[q_] = b_ * b_; } }
                    v0 = v0 * sc; v1 = v1 * sc; u32x4 w; w.x = cvt_pk_bf16(v0[0], v0[1]); w.y = cvt_pk_bf16(v0[2], v0[3]); w.z = cvt_pk_bf16(v1[0], v1[1]); w.w = cvt_pk_bf16(v1[2], v1[3]);
                    *(u32x4*)(rowp + bj * HALF) = w; } }
    }
};


struct EpiResid {
    static constexpr bool PERM = false, AFTER_DRAIN = false;
    const float* base; float* out; const float* gate; int ldc; int gate_stride; int rows_per_batch;
    __device__ __forceinline__ void operator()(const f32x4 (&acc)[2][2][4][2], const Unit& u, int wr, int wc, int fr, int fq) const {
        const int col0 = u.pn * BM + wc * 32 + 4 * fq;
        const float* gp = gate + (size_t)((u.pm * BM) / rows_per_batch) * gate_stride + col0;
        f32x4 gv[2][2];
#pragma unroll
        for (int bj = 0; bj < 2; ++bj)
#pragma unroll
            for (int n = 0; n < 2; ++n) gv[bj][n] = *(const f32x4*)(gp + bj * HALF + n * 16);
#pragma unroll
        for (int ai = 0; ai < 2; ++ai)
#pragma unroll
            for (int m = 0; m < 4; ++m) { const size_t off = (size_t)(u.pm * BM + ai * HALF + wr * 64 + m * 16 + fr) * ldc + col0;
#pragma unroll
                for (int bj = 0; bj < 2; ++bj)
#pragma unroll
                    for (int n = 0; n < 2; ++n) { const f32x4 bs = *(const f32x4*)(base + off + bj * HALF + n * 16);
                        *(f32x4*)(out + off + bj * HALF + n * 16) = bs + gv[bj][n] * acc[ai][bj][m][n]; } }
    }
};


struct EpiMulti {
    static constexpr bool AFTER_DRAIN = false;
    bool PERM; int mode, l;
    __device__ __forceinline__ void operator()(const f32x4 (&acc)[2][2][4][2], const Unit& u, int wr, int wc, int fr, int fq) const;
};

template <class Epi, class Sched, bool ALIGN_EPI = false, bool SP2 = false>
__device__ __forceinline__ void gemm_phase(PG8_LAS unsigned char* lds, const Gemm g, const Sched& S, const Epi& E) {
    int tid_l = threadIdx.x; asm volatile("" : "+v"(tid_l));
    const int tid = tid_l, wid = __builtin_amdgcn_readfirstlane(tid >> 6), lane = tid & 63, wr = wid >> 2, wc = wid & 3, fr = lane & 15, fq = lane >> 4;
    const int K = g.K, nt = K / BK;
    unsigned voffA[2], voffB[2];
#pragma unroll
    for (int i = 0; i < 2; ++i) { int R, C; stage_rc(tid * 16 + i * 8192, R, C); const int Rb = E.PERM ? ((R & ~31) + perm32(R & 31)) : R;
        voffA[i] = (unsigned)(R * K + C) * 2u; voffB[i] = (unsigned)(Rb * K + C) * 2u; }
    const size_t kstep = (size_t)(BK * 2);
    const size_t hstep = (size_t)HALF * K * 2;
    const size_t tstep = 2 * hstep;
    const unsigned ldsw = (unsigned)wid * 1024u;
    const int aoff = lds_byte(wr * 64 + fr, fq * 8), boff = lds_byte(wc * 32 + fr, fq * 8);
#define PG8_SA(b, h) (((b) * 2 + (h)) * HTB)
#define PG8_SB(b, h) ((4 + (b) * 2 + (h)) * HTB)
#define PG8_STAGE(bufoff, gbase, voff) do { _Pragma("unroll") for (int _i = 0; _i < 2; ++_i) \
        __builtin_amdgcn_global_load_lds((const unsigned*)((const char*)(gbase) + (voff)[_i]), (PG8_LAS unsigned*)(lds + (bufoff) + ldsw + _i * 8192), 16, 0, 0); } while (0)
#define PG8_LDA(dst, b, h) do { _Pragma("unroll") for (int m = 0; m < 4; ++m) _Pragma("unroll") for (int k = 0; k < 2; ++k) dst[m][k] = *(const PG8_LAS bf16x8*)(lds + PG8_SA(b, h) + aoff + m * 2048 + k * 1024); } while (0)
#define PG8_LDB(dst, b, h) do { _Pragma("unroll") for (int n = 0; n < 2; ++n) _Pragma("unroll") for (int k = 0; k < 2; ++k) dst[n][k] = *(const PG8_LAS bf16x8*)(lds + PG8_SB(b, h) + boff + n * 2048 + k * 1024); } while (0)
#define PG8_MMA(ai, bj, At, Bt) do { __builtin_amdgcn_s_setprio(1); _Pragma("unroll") for (int m = 0; m < 4; ++m) _Pragma("unroll") for (int n = 0; n < 2; ++n) _Pragma("unroll") for (int k = 0; k < 2; ++k) \
        acc[ai][bj][m][n] = __builtin_amdgcn_mfma_f32_16x16x32_bf16(Bt[n][k], At[m][k], acc[ai][bj][m][n], 0, 0, 0); __builtin_amdgcn_s_setprio(0); } while (0)
#define PG8_WAIT_V(n) asm volatile("s_waitcnt vmcnt(" #n ")" ::: "memory")
#define PG8_WAIT_L(n) asm volatile("s_waitcnt lgkmcnt(" #n ")" ::: "memory")
#define PG8_BAR __builtin_amdgcn_s_barrier()
#define PG8_SCHED __builtin_amdgcn_sched_barrier(0)
    Unit cur, nxt; int ui = 0;
    if (!S.next(0, cur)) return;
    f32x4 acc[2][2][4][2];
#pragma unroll
    for (int a = 0; a < 2; ++a)
#pragma unroll
        for (int b = 0; b < 2; ++b)
#pragma unroll
            for (int m = 0; m < 4; ++m)
#pragma unroll
                for (int n = 0; n < 2; ++n) acc[a][b][m][n] = (f32x4){0.f, 0.f, 0.f, 0.f};
    bf16x8 At[4][2], B0[2][2], B1[2][2];
    const char* cA = (const char*)g.A + (size_t)cur.pm * tstep; const char* cB = (const char*)g.Bt + (size_t)cur.pn * tstep;
    S.a_ready(cur);
    if constexpr (SP2) {
        PG8_STAGE(PG8_SB(0, 0), cB, voffB); PG8_STAGE(PG8_SB(0, 1), cB + hstep, voffB); PG8_STAGE(PG8_SA(0, 0), cA, voffA); PG8_STAGE(PG8_SA(0, 1), cA + hstep, voffA);
        if (wr == 1) PG8_BAR;
        PG8_WAIT_V(2); PG8_BAR;
        PG8_STAGE(PG8_SB(1, 0), cB + kstep, voffB); PG8_STAGE(PG8_SA(1, 0), cA + kstep, voffA); PG8_STAGE(PG8_SB(1, 1), cB + hstep + kstep, voffB);
        PG8_WAIT_V(6); PG8_BAR;
    } else {
        PG8_STAGE(PG8_SB(0, 0), cB, voffB); PG8_STAGE(PG8_SA(0, 0), cA, voffA); PG8_STAGE(PG8_SB(0, 1), cB + hstep, voffB); PG8_STAGE(PG8_SA(0, 1), cA + hstep, voffA);
        if (wr == 1) PG8_BAR;
        PG8_WAIT_V(4); PG8_BAR;
        PG8_STAGE(PG8_SB(1, 0), cB + kstep, voffB); PG8_STAGE(PG8_SA(1, 0), cA + kstep, voffA); PG8_STAGE(PG8_SB(1, 1), cB + hstep + kstep, voffB);
        PG8_WAIT_V(6); PG8_BAR;
    }
    for (;;) {
        const bool has_next = S.next(ui + 1, nxt);
        const char* nA = has_next ? (const char*)g.A + (size_t)nxt.pm * tstep : cA; const char* nB = has_next ? (const char*)g.Bt + (size_t)nxt.pn * tstep : cB;
        for (int t = 0; t < nt; t += 2) {
            const bool last = (t == nt - 2);
            const char* a1 = cA + (size_t)(t + 1) * kstep;
            const char* a2 = last ? nA : cA + (size_t)(t + 2) * kstep; const char* b2 = last ? nB : cB + (size_t)(t + 2) * kstep;
            const char* a3 = a2 + kstep; const char* b3 = b2 + kstep;
            if (last && has_next) S.a_ready(nxt);
            if constexpr (SP2) {
            PG8_LDB(B0, 0, 0); PG8_LDB(B1, 0, 1); PG8_SCHED; PG8_LDA(At, 0, 0); PG8_STAGE(PG8_SA(1, 1), a1 + hstep, voffA);
            PG8_WAIT_V(8); PG8_WAIT_L(0); PG8_BAR; PG8_MMA(0, 0, At, B0); PG8_MMA(0, 1, At, B1); PG8_BAR; PG8_SCHED;
            PG8_LDA(At, 0, 1); PG8_STAGE(PG8_SB(0, 0), b2, voffB); PG8_STAGE(PG8_SB(0, 1), b2 + hstep, voffB); PG8_STAGE(PG8_SA(0, 0), a2, voffA);
            PG8_WAIT_V(8); PG8_WAIT_L(0); PG8_BAR; PG8_MMA(1, 0, At, B0); PG8_MMA(1, 1, At, B1); PG8_BAR; PG8_SCHED;
            PG8_LDB(B0, 1, 0); PG8_LDB(B1, 1, 1); PG8_SCHED; PG8_LDA(At, 1, 0); PG8_STAGE(PG8_SA(0, 1), a2 + hstep, voffA);
            PG8_WAIT_V(8); PG8_WAIT_L(0); PG8_BAR; PG8_MMA(0, 0, At, B0); PG8_MMA(0, 1, At, B1); PG8_BAR; PG8_SCHED;
            PG8_LDA(At, 1, 1); PG8_STAGE(PG8_SB(1, 0), b3, voffB); PG8_STAGE(PG8_SB(1, 1), b3 + hstep, voffB); PG8_STAGE(PG8_SA(1, 0), a3, voffA);
            PG8_WAIT_V(8); PG8_WAIT_L(0); PG8_BAR; PG8_MMA(1, 0, At, B0); PG8_MMA(1, 1, At, B1); PG8_BAR; PG8_SCHED;
            } else {
            PG8_LDB(B0, 0, 0); PG8_SCHED; PG8_LDA(At, 0, 0); PG8_STAGE(PG8_SA(1, 1), a1 + hstep, voffA);
            PG8_WAIT_L(8); PG8_BAR; PG8_WAIT_L(0); PG8_MMA(0, 0, At, B0); PG8_BAR; PG8_SCHED;
            PG8_LDB(B1, 0, 1); PG8_STAGE(PG8_SB(0, 0), b2, voffB);
            PG8_BAR; PG8_WAIT_L(0); PG8_MMA(0, 1, At, B1); PG8_BAR;
            PG8_LDA(At, 0, 1); PG8_STAGE(PG8_SA(0, 0), a2, voffA);
            PG8_BAR; PG8_WAIT_L(0); PG8_MMA(1, 0, At, B0); PG8_BAR; PG8_SCHED;
            PG8_STAGE(PG8_SB(0, 1), b2 + hstep, voffB);
            PG8_WAIT_V(6); PG8_BAR; PG8_MMA(1, 1, At, B1); PG8_BAR;
            PG8_LDB(B0, 1, 0); PG8_SCHED; PG8_LDA(At, 1, 0); PG8_STAGE(PG8_SA(0, 1), a2 + hstep, voffA);
            PG8_WAIT_L(8); PG8_BAR; PG8_WAIT_L(0); PG8_MMA(0, 0, At, B0); PG8_BAR; PG8_SCHED;
            PG8_LDB(B1, 1, 1); PG8_STAGE(PG8_SB(1, 0), b3, voffB);
            PG8_BAR; PG8_WAIT_L(0); PG8_MMA(0, 1, At, B1); PG8_BAR;
            PG8_LDA(At, 1, 1); PG8_STAGE(PG8_SA(1, 0), a3, voffA);
            PG8_BAR; PG8_WAIT_L(0); PG8_MMA(1, 0, At, B0); PG8_BAR; PG8_SCHED;
            PG8_STAGE(PG8_SB(1, 1), b3 + hstep, voffB);
            PG8_WAIT_V(6); PG8_BAR; PG8_MMA(1, 1, At, B1); PG8_BAR;
            }
        }
        if constexpr (ALIGN_EPI) { if (wr == 0) PG8_BAR; }
        if constexpr (!Epi::AFTER_DRAIN) { E(acc, cur, wr, wc, fr, fq); S.done(cur); }
        if (!has_next) break;
#pragma unroll
        for (int a = 0; a < 2; ++a)
#pragma unroll
            for (int b = 0; b < 2; ++b)
#pragma unroll
                for (int m = 0; m < 4; ++m)
#pragma unroll
                    for (int n = 0; n < 2; ++n) acc[a][b][m][n] = (f32x4){0.f, 0.f, 0.f, 0.f};
        cur = nxt; cA = nA; cB = nB; ++ui;
        if constexpr (ALIGN_EPI) { if (wr == 1) PG8_BAR; }
    }
    PG8_WAIT_V(0);
    if constexpr (!ALIGN_EPI) { if (wr == 0) PG8_BAR; }
    PG8_BAR;
    if constexpr (Epi::AFTER_DRAIN) { E.fused(acc, cur, wr, wc, fr, fq, lds, wid, lane); S.done(cur); }
#undef PG8_SA
#undef PG8_SB
#undef PG8_STAGE
#undef PG8_LDA
#undef PG8_LDB
#undef PG8_MMA
#undef PG8_WAIT_V
#undef PG8_WAIT_L
#undef PG8_BAR
#undef PG8_SCHED
}
}
#define GAS __attribute__((address_space(1)))
#define LAS __attribute__((address_space(3)))
typedef unsigned short bf16;
typedef unsigned v4u __attribute__((ext_vector_type(4)));
typedef float f32x4 __attribute__((ext_vector_type(4)));
typedef short bf16x8 __attribute__((ext_vector_type(8)));
typedef GAS unsigned gu32;
typedef GAS unsigned long long gu64;
#define RLX_AGENT __ATOMIC_RELAXED, __HIP_MEMORY_SCOPE_AGENT
#define LDS_WAIT() asm volatile("s_waitcnt lgkmcnt(0)" ::: "memory")
#define VM_WAIT() asm volatile("s_waitcnt vmcnt(0)" ::: "memory")
__device__ __forceinline__ unsigned long long rt() { return __builtin_amdgcn_s_memrealtime(); }
__device__ __forceinline__ unsigned f2bf(float f) { unsigned u = __builtin_bit_cast(unsigned, f); return (u + 0x7fffu + ((u >> 16) & 1u)) >> 16; }
__device__ __forceinline__ unsigned pk2(float lo, float hi) { return f2bf(lo) | (f2bf(hi) << 16); }

#define XB_TMO      128
#define XB_XCNT(j)  (256  + 64 * (j))
#define XB_XSUB(j)  (1280 + 64 * (j))
#define XB_XGEN(j)  (2304 + 64 * (j))
#define XB_TOP      3328
#define XB_TOPGEN   3392
#define XCD_BAR_WORDS 3456
#define XB_SPIN_CAP (1u << 18)

__device__ __forceinline__ unsigned xb_ld(unsigned* p)              { return __hip_atomic_load(p, __ATOMIC_RELAXED, __HIP_MEMORY_SCOPE_AGENT); }
__device__ __forceinline__ unsigned xb_add(unsigned* p, unsigned v) { return __hip_atomic_fetch_add(p, v, __ATOMIC_RELAXED, __HIP_MEMORY_SCOPE_AGENT); }
__device__ __forceinline__ unsigned xb_xcc_id() { return (unsigned)__builtin_amdgcn_s_getreg((3 << 11) | 20) & 0xFu; }
#define XB_SPIN(cond, bar) do { unsigned _sp = 0; while (cond) { __builtin_amdgcn_s_sleep(1); \
    if ((++_sp & 255u) == 0u) { if (xb_ld(&(bar)[XB_TMO])) break; if (_sp > XB_SPIN_CAP) { atomicAdd(&(bar)[XB_TMO], 1u); break; } } } } while (0)

struct XcdBarrier {
    unsigned* bar; unsigned x;
    volatile LAS unsigned* st;
};

__device__ __forceinline__ XcdBarrier xcd_barrier_post(unsigned* bar, volatile LAS unsigned* st) {
    XcdBarrier b; b.bar = bar; b.x = xb_xcc_id(); b.st = st;
    if (threadIdx.x == 0) (void)xb_add(&bar[XB_XCNT(b.x)], 1u);
    return b;
}
__device__ __forceinline__ void xcd_barrier_complete(unsigned* bar, unsigned x, unsigned& nloc, unsigned& nx) {
    const unsigned G = gridDim.x * gridDim.y * gridDim.z;
    unsigned sum, cnt, mine, sp = 0u;
    for (;;) {
        sum = 0u; cnt = 0u; mine = 0u;
#pragma unroll
        for (unsigned j = 0; j < 16; ++j) { const unsigned c = xb_ld(&bar[XB_XCNT(j)]); sum += c; cnt += (c > 0u) ? 1u : 0u; mine = (j == x) ? c : mine; }
        if (sum == G) break;
        __builtin_amdgcn_s_sleep(1);
        if ((++sp & 255u) == 0u) { if (xb_ld(&bar[XB_TMO])) break; if (sp > XB_SPIN_CAP) { atomicAdd(&bar[XB_TMO], 1u); break; } }
    }
    nloc = mine > 0u ? mine : 1u; nx = cnt > 0u ? cnt : 1u;
}

__device__ __forceinline__ void xcd_barrier(const XcdBarrier& b, const bool t0  ) {
    asm volatile("s_waitcnt vmcnt(0)" ::: "memory");
    __syncthreads();
    if (t0) {
        unsigned* bar = b.bar;
        __builtin_amdgcn_s_waitcnt(0);
        unsigned nloc = b.st[0], nx = b.st[1];
        if (nloc == 0u) { xcd_barrier_complete(bar, b.x, nloc, nx); b.st[0] = nloc; b.st[1] = nx; }
        const unsigned old = xb_add(&bar[XB_XSUB(b.x)], 1u);
        const unsigned gen = old / nloc;
        if (old + 1u == (gen + 1u) * nloc) {
            __builtin_amdgcn_fence(__ATOMIC_RELEASE, "agent");
            asm volatile("s_waitcnt vmcnt(0)" ::: "memory");
            const unsigned og = xb_add(&bar[XB_TOP], 1u);
            const unsigned tg = og / nx;
            if (og + 1u == (tg + 1u) * nx) xb_add(&bar[XB_TOPGEN], 1u);
            else XB_SPIN(xb_ld(&bar[XB_TOPGEN]) == tg, bar);
            __builtin_amdgcn_fence(__ATOMIC_ACQUIRE, "agent");
            xb_add(&bar[XB_XGEN(b.x)], 1u);
            asm volatile("s_waitcnt vmcnt(0)" ::: "memory");
        } else {
            XB_SPIN(xb_ld(&bar[XB_XGEN(b.x)]) == gen, bar);
            __builtin_amdgcn_fence(__ATOMIC_ACQUIRE, "agent");
            asm volatile("s_waitcnt vmcnt(0)" ::: "memory");
        }
    }
    __syncthreads();
}

#ifndef PG8_SP2
#define PG8_SP2 true
#endif
#ifndef PG8_ALIGN
#define PG8_ALIGN true
#endif
constexpr int NWAVES = 8;
constexpr int N_STEPS = 38;
#ifndef MK_N_LAUNCHES
#define MK_N_LAUNCHES 1
#endif
#ifndef PH_MASK
#define PH_MASK 0xffff
#endif
#ifndef REP_MASK
#define REP_MASK 0
#endif
#ifndef PREP_REP_LRU
#define PREP_REP_LRU 1
#endif
#ifndef PREP_REP_GDN
#define PREP_REP_GDN 1
#endif
constexpr int N_LAUNCHES = MK_N_LAUNCHES;

constexpr int D = 1024, BATCH = 4, SEQ = 4096, DEPTH = 4, M = BATCH * SEQ;
constexpr int LRUW = 512, NGB = 8, GBW = 64, GH = 4, HD = 128, GDNW = 512, CH = 64, NCH = SEQ / CH, FF = 4096;
constexpr int NMODC = 6 * D, INC = 3080, NPROJ = 3072;
constexpr int O_LX = 0, O_LY = 512, O_Q = 1024, O_Z = 2560;
constexpr float EPS = 1e-6f;

constexpr size_t MiB = 1u << 20;
constexpr size_t WS_CTL = 0, CTL_ZERO_BYTES = 1 * MiB;
constexpr size_t WS_MOD = 1 * MiB;
constexpr size_t WS_BG = 2 * MiB;
constexpr size_t WS_AGG = 3 * MiB;
constexpr size_t WS_CARRY = 4 * MiB;
constexpr size_t WS_GL = 5 * MiB;
constexpr size_t WS_GT = 6 * MiB;
constexpr size_t WS_W = 8 * MiB;
constexpr size_t LAYER_W = (size_t)12288 * 1024;
constexpr size_t W_OUT_OFF = (size_t)3072 * 1024, W_UP_OFF = (size_t)4096 * 1024, W_DOWN_OFF = (size_t)8192 * 1024;
constexpr size_t WS_H = 104 * MiB;
constexpr size_t WS_MIX = 136 * MiB;
constexpr size_t WS_PROJ = 168 * MiB;
constexpr size_t WS_ACT = 168 * MiB;
constexpr size_t WS_GQD = 264 * MiB, WS_GKT = 280 * MiB;
constexpr size_t WS_GATT = 296 * MiB;
constexpr size_t WS_GO = 312 * MiB;
constexpr size_t WS_LRUP = 344 * MiB;
constexpr size_t WS_END = 376 * MiB;
constexpr int CW_BAR = 4096;

constexpr int RING_OFF = 0, RING_BYTES = 155648;
constexpr int LDSCTL_OFF = RING_BYTES, MISC_OFF = LDSCTL_OFF + 320;
constexpr int LDS_BYTES = 156672;

typedef unsigned v2u __attribute__((ext_vector_type(2)));
#define DI __device__ __forceinline__
DI float bf2f(unsigned b) { return __builtin_bit_cast(float, b << 16); }
DI float bflo(unsigned w) { return __builtin_bit_cast(float, w << 16); }
DI float bfhi(unsigned w) { return __builtin_bit_cast(float, w & 0xffff0000u); }
DI float sigmoidf_(float x) { return 1.f / (1.f + expf(-x)); }
DI float siluf_(float x) { return x / (1.f + expf(-x)); }
DI float rcp_(float x) { return __builtin_amdgcn_rcpf(x); }
DI float exp_fast(float x) { return __builtin_amdgcn_exp2f(x * 1.4426950408889634f); }
DI float sigmoid_fast(float x) { return rcp_(1.f + exp_fast(-x)); }
DI float silu_fast(float x) { return x * rcp_(1.f + exp_fast(-x)); }
DI float gelu_tanh(float x) { const float u = 0.7978845608028654f * (x + 0.044715f * x * x * x); return 0.5f * x * (1.f + tanhf(u)); }
DI float bperm_(int src_lane, float v) { return __builtin_bit_cast(float, __builtin_amdgcn_ds_bpermute(src_lane << 2, __builtin_bit_cast(int, v))); }
DI float wave_sum_(int lane, float v) {
#pragma unroll
    for (int o = 1; o < 64; o <<= 1) v += bperm_(lane ^ o, v);
    return v;
}
DI float half_sum_(int lane, float v) {
#pragma unroll
    for (int o = 1; o < 32; o <<= 1) v += bperm_(lane ^ o, v);
    return v;
}
DI float shfl_up_(int lane, float v, int off) { return bperm_(lane >= off ? lane - off : lane, v); }

struct Args { const float* in[23]; float* out; unsigned char* ws; int ph_lo, ph_hi; };
static_assert(sizeof(Args) == 23 * 8 + 8 + 8 + 8, "Args has no padding");
struct Frame {
    LAS unsigned char* lds;
    volatile LAS unsigned* MISC;
    gu32* ctl;
    int tid, lane, wave;
    int vcu, G;
    const __attribute__((address_space(4))) Args* A;
};
#define IN_(k) (F.A->in[k])
#define X_IN IN_(0)
#define C_IN IN_(1)
#define NORM_MIX_W IN_(2)
#define NORM_MLP_W IN_(3)
#define W_MOD IN_(4)
#define B_MOD IN_(5)
#define W_IN IN_(6)
#define LRU_CONV_W IN_(7)
#define LRU_CONV_B IN_(8)
#define GATE_A_W IN_(9)
#define GATE_A_B IN_(10)
#define GATE_X_W IN_(11)
#define GATE_X_B IN_(12)
#define LRU_LAMBDA IN_(13)
#define LRU_NORM_W IN_(14)
#define GDN_CONV_W IN_(15)
#define GDN_A_LOG IN_(16)
#define GDN_DT_BIAS IN_(17)
#define GDN_NORM_W IN_(18)
#define W_OUT IN_(19)
#define W_UP IN_(20)
#define W_DOWN IN_(21)
#define FINAL_NORM_W IN_(22)
#define OUT_ (F.A->out)
#define WSF(off) ((float*)(F.A->ws + (off)))
#define WSH(off) ((bf16*)(F.A->ws + (off)))

DI void p_mod(Frame& F) {
    LAS float* cs = (LAS float*)F.lds;
    LAS float* red = cs + 4096;
    for (int i = F.tid; i < BATCH * D; i += NWAVES * 64) cs[i] = siluf_(C_IN[i]);
    __syncthreads();
    for (int item = F.vcu; item < DEPTH * 96; item += F.G) {
        const int l = item / 96, cg = item % 96, col = cg * 64 + F.lane;
        const float* wp = W_MOD + ((size_t)l * D + F.wave * 128) * NMODC + col;
        float a0 = 0.f, a1 = 0.f, a2 = 0.f, a3 = 0.f;
#pragma unroll 16
        for (int kk = 0; kk < 128; ++kk) { const float wv = wp[(size_t)kk * NMODC]; const int k = F.wave * 128 + kk;
            a0 += cs[k] * wv; a1 += cs[1024 + k] * wv; a2 += cs[2048 + k] * wv; a3 += cs[3072 + k] * wv; }
        red[(F.wave * 4 + 0) * 64 + F.lane] = a0; red[(F.wave * 4 + 1) * 64 + F.lane] = a1; red[(F.wave * 4 + 2) * 64 + F.lane] = a2; red[(F.wave * 4 + 3) * 64 + F.lane] = a3;
        __syncthreads();
        if (F.tid < 256) { const int b = F.tid >> 6, ln = F.tid & 63; float s = 0.f;
#pragma unroll
            for (int w = 0; w < 8; ++w) s += red[(w * 4 + b) * 64 + ln];
            const int cc = cg * 64 + ln; WSF(WS_MOD)[((size_t)l * BATCH + b) * NMODC + cc] = s + B_MOD[(size_t)l * NMODC + cc]; }
        __syncthreads();
    }
}

DI void p0_transpose_item(const float* W, int K, int ldw, int N, bf16* WT, LAS float* scr, int item, int lane) {
    const int nblk = N / 32, kb = item / nblk, nb = item % nblk, k0 = 64 * kb, n0 = 32 * nb;
    f32x4 v[8];
#pragma unroll
    for (int i = 0; i < 8; ++i) v[i] = *(const f32x4*)(W + (size_t)(k0 + (lane >> 3) + 8 * i) * ldw + n0 + 4 * (lane & 7));
#pragma unroll
    for (int i = 0; i < 8; ++i) { LAS float* d = scr + ((lane >> 3) + 8 * i) * 33 + 4 * (lane & 7); d[0] = v[i].x; d[1] = v[i].y; d[2] = v[i].z; d[3] = v[i].w; }
    LDS_WAIT(); asm volatile("" ::: "memory");
    const int c = lane & 7;
#pragma unroll
    for (int j = 0; j < 4; ++j) { const int n = (lane >> 3) + 8 * j; const LAS float* s = scr + (8 * c) * 33 + n;
        v4u o; o.x = pk2(s[0 * 33], s[1 * 33]); o.y = pk2(s[2 * 33], s[3 * 33]); o.z = pk2(s[4 * 33], s[5 * 33]); o.w = pk2(s[6 * 33], s[7 * 33]);
        *(v4u*)(WT + (size_t)(n0 + n) * K + k0 + 8 * c) = o; }
    LDS_WAIT(); asm volatile("" ::: "memory");
}
DI void p0_weights(Frame& F) {
    LAS float* scr = (LAS float*)(F.lds + RING_OFF + F.wave * 16384);
    const int gw = F.vcu * NWAVES + F.wave, NGW = F.G * NWAVES;
    constexpr int I_IN = (D / 64) * (NPROJ / 32), I_OUT = (D / 64) * (D / 32), I_UP = (D / 64) * (FF / 32), I_DN = (FF / 64) * (D / 32);
    constexpr int PER_LAYER = I_IN + I_OUT + I_UP + I_DN;
    for (int it = gw; it < DEPTH * PER_LAYER; it += NGW) {
        const int l = it / PER_LAYER; int r = it % PER_LAYER; bf16* wl = WSH(WS_W) + (size_t)l * LAYER_W;
        if (r < I_IN) { p0_transpose_item(W_IN + (size_t)l * D * INC, D, INC, NPROJ, wl, scr, r, F.lane); continue; } r -= I_IN;
        if (r < I_OUT) { p0_transpose_item(W_OUT + (size_t)l * D * D, D, D, D, wl + W_OUT_OFF, scr, r, F.lane); continue; } r -= I_OUT;
        if (r < I_UP) { p0_transpose_item(W_UP + (size_t)l * D * FF, D, FF, FF, wl + W_UP_OFF, scr, r, F.lane); continue; } r -= I_UP;
        p0_transpose_item(W_DOWN + (size_t)l * FF * D, FF, D, D, wl + W_DOWN_OFF, scr, r, F.lane);
    }
    for (int o = (int)blockIdx.x * NWAVES * 64 + F.tid; o < DEPTH * 2 * NGB * 4096; o += (int)gridDim.x * NWAVES * 64) {
        const int i = o & 63, j = (o >> 6) & 63, g = (o >> 12) & 7, gate = (o >> 15) & 1, l = o >> 16;
        const float* src = gate ? GATE_X_W : GATE_A_W;
        WSH(WS_GT)[o] = (bf16)f2bf(src[(size_t)(l * NGB + g) * 4096 + i * 64 + j]);
    }
}

template <bool WITH_BG>
DI void p_normmod(Frame& F, int l, const float* xin, const float* normw, int off_sh, int off_sc) {
    LAS float* w8 = (LAS float*)F.lds;
    if (WITH_BG) {
        for (int i = F.tid; i < D * 8; i += NWAVES * 64) w8[i] = W_IN[((size_t)l * D + (i >> 3)) * INC + NPROJ + (i & 7)];
        __syncthreads();
    }
    const int gw = F.vcu * NWAVES + F.wave, NGW = F.G * NWAVES, lane = F.lane;
    f32x4 v[4];
    if (gw < M) {
#pragma unroll
        for (int j = 0; j < 4; ++j) v[j] = *(const f32x4*)(xin + (size_t)gw * D + 4 * lane + 256 * j);
    }
    for (int m = gw; m < M; m += NGW) {
        const int b = m >> 12, mn = m + NGW;
        f32x4 vnx[4];
#pragma unroll
        for (int j = 0; j < 4; ++j) vnx[j] = (mn < M) ? *(const f32x4*)(xin + (size_t)mn * D + 4 * lane + 256 * j) : (f32x4){0.f, 0.f, 0.f, 0.f};
        const float* modp = WSF(WS_MOD) + ((size_t)l * BATCH + b) * NMODC;
        float ss = 0.f;
#pragma unroll
        for (int j = 0; j < 4; ++j) ss += (v[j].x * v[j].x + v[j].y * v[j].y) + (v[j].z * v[j].z + v[j].w * v[j].w);
        ss = wave_sum_(lane, ss);
        const float rstd = 1.0f / sqrtf(ss * (1.0f / D) + EPS);
        float a0 = 0.f, a1 = 0.f, a2 = 0.f, a3 = 0.f, a4 = 0.f, a5 = 0.f, a6 = 0.f, a7 = 0.f;
#pragma unroll
        for (int j = 0; j < 4; ++j) {
            const int col = 4 * lane + 256 * j;
            const f32x4 nw = *(const f32x4*)(normw + (size_t)l * D + col), sc = *(const f32x4*)(modp + off_sc + col), sh = *(const f32x4*)(modp + off_sh + col);
            const f32x4 hv = v[j] * rstd * nw * (sc + 1.0f) + sh;
            v2u o; o.x = pk2(hv.x, hv.y); o.y = pk2(hv.z, hv.w);
            *(v2u*)(WSH(WS_H) + (size_t)m * D + col) = o;
            if (WITH_BG) {
#pragma unroll
                for (int e = 0; e < 4; ++e) { const f32x4 wa = *(const LAS f32x4*)(w8 + (col + e) * 8), wb = *(const LAS f32x4*)(w8 + (col + e) * 8 + 4); const float hh = hv[e];
                    a0 += hh * wa.x; a1 += hh * wa.y; a2 += hh * wa.z; a3 += hh * wa.w; a4 += hh * wb.x; a5 += hh * wb.y; a6 += hh * wb.z; a7 += hh * wb.w; }
            }
        }
        if (WITH_BG) {
            const bool b0 = lane & 1, b1 = lane & 2, b2 = lane & 4;
            float k0 = b0 ? a1 : a0, k1 = b0 ? a3 : a2, k2 = b0 ? a5 : a4, k3 = b0 ? a7 : a6;
            k0 += bperm_(lane ^ 1, b0 ? a0 : a1); k1 += bperm_(lane ^ 1, b0 ? a2 : a3); k2 += bperm_(lane ^ 1, b0 ? a4 : a5); k3 += bperm_(lane ^ 1, b0 ? a6 : a7);
            float c0 = b1 ? k1 : k0, c1 = b1 ? k3 : k2;
            c0 += bperm_(lane ^ 2, b1 ? k0 : k1); c1 += bperm_(lane ^ 2, b1 ? k2 : k3);
            float d = b2 ? c1 : c0;
            d += bperm_(lane ^ 4, b2 ? c0 : c1);
            d += bperm_(lane ^ 8, d); d += bperm_(lane ^ 16, d); d += bperm_(lane ^ 32, d);
            if (lane < 8) {
                const int hh = lane & 3;
                float r;
                if (lane < 4) r = sigmoidf_(d);
                else { const float xx = d + GDN_DT_BIAS[l * GH + hh]; const float sp = xx > 20.f ? xx : log1pf(expf(xx)); r = -expf(GDN_A_LOG[l * GH + hh]) * sp; }
                WSF(WS_BG)[(size_t)m * 8 + lane] = r;
            }
        }
#pragma unroll
        for (int j = 0; j < 4; ++j) v[j] = vnx[j];
    }
}

typedef float f32x2_t __attribute__((ext_vector_type(2))); typedef __bf16 bf16x2_t __attribute__((ext_vector_type(2)));
DI unsigned cvtpk(float lo, float hi) { f32x2_t v = {lo, hi}; bf16x2_t b = __builtin_convertvector(v, bf16x2_t); return __builtin_bit_cast(unsigned, b); }
DI bf16x8 pack8(f32x4 a, f32x4 b) { v4u p; p.x = cvtpk(a.x, a.y); p.y = cvtpk(a.z, a.w); p.z = cvtpk(b.x, b.y); p.w = cvtpk(b.z, b.w); return __builtin_bit_cast(bf16x8, p); }
DI bf16x8 ldfrag(const LAS unsigned char* p) { const v2u lo = *(const LAS v2u*)p, hi = *(const LAS v2u*)(p + 32); v4u r; r.x = lo.x; r.y = lo.y; r.z = hi.x; r.w = hi.y; return __builtin_bit_cast(bf16x8, r); }
#define MFMA16(a, b, c) __builtin_amdgcn_mfma_f32_16x16x32_bf16((a), (b), (c), 0, 0, 0)

DI bf16x8 ld128(const LAS unsigned char* p) { return *(const LAS bf16x8*)p; }
DI int kperm4(int k4) { return k4 < 16 ? 2 * k4 : 2 * (k4 - 16) + 4; }
DI int kperm(int k) { return (k & ~31) + kperm4(k & 28) + (k & 3); }
constexpr int PG_QB = 0, PG_KB = 17408, PG_KBET = 34816, PG_VT = 53248, PG_LS = 71680, PG_TS = 89088, PG_TB = 106496, PG_ATT = 115712, PG_XS = 124928, PG_SM = 128000, PG_END = 129024;
static_assert(PG_END <= RING_BYTES, "prep LDS map");
DI void p_prep(Frame& F, int l) {
    const int wave = F.wave;
#define PREP_IDS int tid_ = F.tid; asm volatile("" : "+v"(tid_)); const int tid = tid_, lane = tid & 63, m = lane & 15, q = lane >> 4; (void)m; (void)q;
    for (int item = blockIdx.x; item < BATCH * NCH; item += gridDim.x) {
        const int b = item / NCH, n = item % NCH, row0 = b * SEQ + n * CH, t0 = n * CH;
        for (int rep_ = 0; rep_ < PREP_REP_LRU; ++rep_) {
            PREP_IDS
            const int g = wave;
            LAS float* xr = (LAS float*)(F.lds + wave * 17408);
            const int tg = lane >> 3, cg = lane & 7, c0 = 8 * cg, cc0 = g * 64 + c0;
            v4u xp[11];
#pragma unroll
            for (int i = 0; i < 11; ++i) { const int tt = t0 + 8 * tg - 3 + i;
                xp[i] = (tt >= 0) ? *(const v4u*)(WSH(WS_PROJ) + (size_t)(b * SEQ + tt) * NPROJ + O_LX + cc0) : (v4u){0u, 0u, 0u, 0u}; }
            f32x4 wl_[4], wh_[4];
#pragma unroll
            for (int k = 0; k < 4; ++k) { wl_[k] = *(const f32x4*)(LRU_CONV_W + ((size_t)l * 4 + k) * LRUW + cc0); wh_[k] = *(const f32x4*)(LRU_CONV_W + ((size_t)l * 4 + k) * LRUW + cc0 + 4); }
            const f32x4 bl_ = *(const f32x4*)(LRU_CONV_B + l * LRUW + cc0), bh_ = *(const f32x4*)(LRU_CONV_B + l * LRUW + cc0 + 4);
            bf16x8 Bf[2][4][2];
#pragma unroll
            for (int gate = 0; gate < 2; ++gate)
#pragma unroll
                for (int nt = 0; nt < 4; ++nt)
#pragma unroll
                    for (int ks = 0; ks < 2; ++ks) Bf[gate][nt][ks] = *(const bf16x8*)(WSH(WS_GT) + ((size_t)((l * 2 + gate) * NGB + g)) * 4096 + (size_t)(16 * nt + m) * 64 + 32 * ks + 8 * q);
            float ba_[4], bx_[4], ls_[4];
#pragma unroll
            for (int nt = 0; nt < 4; ++nt) { const int cc = g * 64 + 16 * nt + m; ba_[nt] = GATE_A_B[l * LRUW + cc]; bx_[nt] = GATE_X_B[l * LRUW + cc];
                const float lam = LRU_LAMBDA[l * LRUW + cc]; ls_[nt] = -8.0f * (fmaxf(-lam, 0.f) + log1pf(expf(-fabsf(lam)))); }
#pragma unroll
            for (int tt = 0; tt < 8; ++tt) { f32x4 al = bl_, ah = bh_;
#pragma unroll
                for (int k = 0; k < 4; ++k) { const v4u xw = xp[tt + k];
                    al += wl_[k] * (f32x4){bflo(xw.x), bfhi(xw.x), bflo(xw.y), bfhi(xw.y)}; ah += wh_[k] * (f32x4){bflo(xw.z), bfhi(xw.z), bflo(xw.w), bfhi(xw.w)}; }
                *(LAS f32x4*)(xr + (8 * tg + tt) * 68 + c0) = al; *(LAS f32x4*)(xr + (8 * tg + tt) * 68 + c0 + 4) = ah; }
            asm volatile("s_waitcnt lgkmcnt(0)" ::: "memory");
            bf16x8 Af[4][2];
#pragma unroll
            for (int mt = 0; mt < 4; ++mt)
#pragma unroll
                for (int ks = 0; ks < 2; ++ks) { const LAS float* pp = xr + (16 * mt + m) * 68 + 32 * ks + 8 * q; Af[mt][ks] = pack8(*(const LAS f32x4*)pp, *(const LAS f32x4*)(pp + 4)); }
#pragma unroll
            for (int nt = 0; nt < 4; ++nt) {
                float av[4][4], bv[4][4];
#pragma unroll
                for (int mt = 0; mt < 4; ++mt) { f32x4 ra = (f32x4){0.f, 0.f, 0.f, 0.f}, ia = (f32x4){0.f, 0.f, 0.f, 0.f};
                    ra = MFMA16(Af[mt][0], Bf[0][nt][0], ra); ra = MFMA16(Af[mt][1], Bf[0][nt][1], ra);
                    ia = MFMA16(Af[mt][0], Bf[1][nt][0], ia); ia = MFMA16(Af[mt][1], Bf[1][nt][1], ia);
#pragma unroll
                    for (int r = 0; r < 4; ++r) { const float rr = sigmoid_fast(ra[r] + ba_[nt]), ig = sigmoid_fast(ia[r] + bx_[nt]);
                        const float log_a = rr * ls_[nt], aa = exp_fast(log_a), mult = __builtin_amdgcn_sqrtf(fmaxf(1.0f - exp_fast(2.0f * log_a), 1e-12f));
                        av[mt][r] = aa; bv[mt][r] = mult * (ig * xr[(16 * mt + 4 * q + r) * 68 + 16 * nt + m]); } }
                float iP[4], iH[4];
#pragma unroll
                for (int mt = 0; mt < 4; ++mt) {
#pragma unroll
                    for (int r = 1; r < 4; ++r) { bv[mt][r] = av[mt][r] * bv[mt][r - 1] + bv[mt][r]; av[mt][r] = av[mt][r] * av[mt][r - 1]; }
                    float PA = av[mt][3], HA = bv[mt][3];
                    { const float Pp = shfl_up_(lane, PA, 16), Hp = shfl_up_(lane, HA, 16); if (q >= 1) { HA = PA * Hp + HA; PA = PA * Pp; } }
                    { const float Pp = shfl_up_(lane, PA, 32), Hp = shfl_up_(lane, HA, 32); if (q >= 2) { HA = PA * Hp + HA; PA = PA * Pp; } }
                    iP[mt] = PA; iH[mt] = HA; }
                float CP = 1.f, CH = 0.f;
#pragma unroll
                for (int mt = 0; mt < 4; ++mt) {
                    const float totP = bperm_(m + 48, iP[mt]), totH = bperm_(m + 48, iH[mt]);
                    float exP = shfl_up_(lane, iP[mt], 16), exH = shfl_up_(lane, iH[mt], 16); if (q == 0) { exP = 1.f; exH = 0.f; }
                    const float EP = CP * exP, EH = exP * CH + exH;
#pragma unroll
                    for (int r = 0; r < 4; ++r) { const float Pf = EP * av[mt][r], Hf = av[mt][r] * EH + bv[mt][r];
                        *(LAS unsigned*)(xr + (16 * mt + 4 * q + r) * 68 + 16 * nt + m) = f2bf(Hf) | (f2bf(Pf) << 16); }
                    CH = totP * CH + totH; CP = CP * totP; }
                if (q == 0) { WSF(WS_AGG)[((size_t)(b * NCH + n)) * LRUW + g * 64 + 16 * nt + m] = CP; WSF(WS_AGG)[(size_t)BATCH * NCH * LRUW + ((size_t)(b * NCH + n)) * LRUW + g * 64 + 16 * nt + m] = CH; }
            }
            asm volatile("s_waitcnt lgkmcnt(0)" ::: "memory");
#pragma unroll
            for (int i = 0; i < 16; ++i) { const int pz = lane + 64 * i, row = pz >> 4, c16 = pz & 15;
                *(v4u*)((unsigned*)(F.A->ws + WS_H) + (size_t)(row0 + row) * LRUW + g * 64 + 4 * c16) = *(const LAS v4u*)(xr + row * 68 + 4 * c16); }
        }
        __syncthreads();
        {
            LAS unsigned char* qb = F.lds + PG_QB;
            LAS unsigned char* kb = F.lds + PG_KB;
            LAS unsigned char* kbeT = F.lds + PG_KBET;
            LAS unsigned char* vT = F.lds + PG_VT;
            LAS float* Ls = (LAS float*)(F.lds + PG_LS);
            LAS float* Ts = (LAS float*)(F.lds + PG_TS);
            LAS unsigned char* Tb = F.lds + PG_TB;
            LAS unsigned char* atts = F.lds + PG_ATT;
            LAS float* Xs = (LAS float*)(F.lds + PG_XS);
            LAS float* sm4 = (LAS float*)(F.lds + PG_SM);
            if (wave < GH) { int tl_ = F.tid; asm volatile("" : "+v"(tl_)); const int ln = tl_ & 63, hh = wave;
                float gcv = WSF(WS_BG)[(size_t)(row0 + ln) * 8 + 4 + hh];
#pragma unroll
                for (int off = 1; off < 64; off <<= 1) { const float pv = shfl_up_(ln, gcv, off); if (ln >= off) gcv += pv; }
                const float glast = bperm_(63, gcv);
                sm4[hh * 256 + ln] = gcv; sm4[hh * 256 + 64 + ln] = WSF(WS_BG)[(size_t)(row0 + ln) * 8 + hh]; sm4[hh * 256 + 128 + ln] = expf(gcv); sm4[hh * 256 + 192 + ln] = expf(glast - gcv); }
            __syncthreads();
            for (int h_ = 0; h_ < GH * PREP_REP_GDN; ++h_) { const int h = h_ % GH;
                PREP_IDS
                const size_t item4 = (size_t)(b * GH + h) * NCH + n;
                LAS float* sgc = sm4 + h * 256, *sbeta = sgc + 64, *seg = sgc + 128, *sel = sgc + 192;
                if (tid < 384) {
                    const int cgp = tid & 15, wt = tid >> 4, which = wt >> 3, tr = wt & 7, d0 = cgp * 8, ch0 = which * GDNW + h * HD + d0;
                    v4u xp[11];
#pragma unroll
                    for (int i = 0; i < 11; ++i) { const int tt = t0 + tr * 8 - 3 + i;
                        xp[i] = (tt >= 0) ? *(const v4u*)(WSH(WS_PROJ) + (size_t)(b * SEQ + tt) * NPROJ + O_Q + ch0) : (v4u){0u, 0u, 0u, 0u}; }
                    f32x4 wl_[4], wh_[4];
#pragma unroll
                    for (int k = 0; k < 4; ++k) { wl_[k] = *(const f32x4*)(GDN_CONV_W + ((size_t)l * 4 + k) * (3 * GDNW) + ch0); wh_[k] = *(const f32x4*)(GDN_CONV_W + ((size_t)l * 4 + k) * (3 * GDNW) + ch0 + 4); }
                    f32x4 ol[8], oh[8]; float ss[8];
#pragma unroll
                    for (int tt = 0; tt < 8; ++tt) { f32x4 al = (f32x4){0.f, 0.f, 0.f, 0.f}, ah = (f32x4){0.f, 0.f, 0.f, 0.f};
#pragma unroll
                        for (int k = 0; k < 4; ++k) { const v4u xw = xp[tt + k];
                            al += wl_[k] * (f32x4){bflo(xw.x), bfhi(xw.x), bflo(xw.y), bfhi(xw.y)}; ah += wh_[k] * (f32x4){bflo(xw.z), bfhi(xw.z), bflo(xw.w), bfhi(xw.w)}; }
#pragma unroll
                        for (int c = 0; c < 4; ++c) { al[c] = silu_fast(al[c]); ah[c] = silu_fast(ah[c]); }
                        ol[tt] = al; oh[tt] = ah;
                        ss[tt] = (al.x * al.x + al.y * al.y) + (al.z * al.z + al.w * al.w) + (ah.x * ah.x + ah.y * ah.y) + (ah.z * ah.z + ah.w * ah.w); }
                    if (which < 2) {
#pragma unroll
                        for (int tt = 0; tt < 8; ++tt) { float v = ss[tt]; v += bperm_(lane ^ 1, v); v += bperm_(lane ^ 2, v); v += bperm_(lane ^ 4, v); v += bperm_(lane ^ 8, v);
                            const float scl = __builtin_amdgcn_rsqf(v + 1e-6f) * (which == 0 ? 0.08838834764831845f : 1.0f); ol[tt] = ol[tt] * scl; oh[tt] = oh[tt] * scl; }
                    }
                    const int tb = tr * 8;
                    if (which == 0) {
#pragma unroll
                        for (int tt = 0; tt < 8; ++tt) { const int t = tb + tt; const float eg = seg[t];
                            v4u pk; pk.x = cvtpk(ol[tt].x, ol[tt].y); pk.y = cvtpk(ol[tt].z, ol[tt].w); pk.z = cvtpk(oh[tt].x, oh[tt].y); pk.w = cvtpk(oh[tt].z, oh[tt].w);
                            *(LAS v4u*)(qb + t * 272 + d0 * 2) = pk;
                            v4u pg; pg.x = cvtpk(ol[tt].x * eg, ol[tt].y * eg); pg.y = cvtpk(ol[tt].z * eg, ol[tt].w * eg); pg.z = cvtpk(oh[tt].x * eg, oh[tt].y * eg); pg.w = cvtpk(oh[tt].z * eg, oh[tt].w * eg);
                            { bf16* qrow = WSH(WS_GQD) + item4 * 8192 + t * 128 + (d0 & ~31); const int kl = d0 & 31;
                                v2u p0; p0.x = pg.x; p0.y = pg.y; v2u p1; p1.x = pg.z; p1.y = pg.w; *(v2u*)(qrow + kperm4(kl)) = p0; *(v2u*)(qrow + kperm4(kl + 4)) = p1; } }
                    } else if (which == 1) {
                        float fb[8], fl[8];
#pragma unroll
                        for (int tt = 0; tt < 8; ++tt) { const int t = tb + tt; fb[tt] = sbeta[t] * seg[t]; fl[tt] = sel[t];
                            v4u pk; pk.x = cvtpk(ol[tt].x, ol[tt].y); pk.y = cvtpk(ol[tt].z, ol[tt].w); pk.z = cvtpk(oh[tt].x, oh[tt].y); pk.w = cvtpk(oh[tt].z, oh[tt].w);
                            *(LAS v4u*)(kb + t * 272 + d0 * 2) = pk; }
#pragma unroll
                        for (int c = 0; c < 8; ++c) {
#define KV_(tt) ((c) < 4 ? ol[tt][(c) & 3] : oh[tt][(c) & 3])
                            v4u pe; pe.x = cvtpk(KV_(0) * fb[0], KV_(1) * fb[1]); pe.y = cvtpk(KV_(2) * fb[2], KV_(3) * fb[3]); pe.z = cvtpk(KV_(4) * fb[4], KV_(5) * fb[5]); pe.w = cvtpk(KV_(6) * fb[6], KV_(7) * fb[7]);
                            *(LAS v4u*)(kbeT + (d0 + c) * 144 + tb * 2) = pe;
                            v4u pt; pt.x = cvtpk(KV_(0) * fl[0], KV_(1) * fl[1]); pt.y = cvtpk(KV_(2) * fl[2], KV_(3) * fl[3]); pt.z = cvtpk(KV_(4) * fl[4], KV_(5) * fl[5]); pt.w = cvtpk(KV_(6) * fl[6], KV_(7) * fl[7]);
                            { bf16* krow = WSH(WS_GKT) + item4 * 8192 + (d0 + c) * 64 + (tb & ~31); const int kl = tb & 31;
                                v2u p0; p0.x = pt.x; p0.y = pt.y; v2u p1; p1.x = pt.z; p1.y = pt.w; *(v2u*)(krow + kperm4(kl)) = p0; *(v2u*)(krow + kperm4(kl + 4)) = p1; } }
                    } else {
                        float fb[8];
#pragma unroll
                        for (int tt = 0; tt < 8; ++tt) fb[tt] = sbeta[tb + tt];
#pragma unroll
                        for (int c = 0; c < 8; ++c) {
                            v4u pe; pe.x = cvtpk(KV_(0) * fb[0], KV_(1) * fb[1]); pe.y = cvtpk(KV_(2) * fb[2], KV_(3) * fb[3]); pe.z = cvtpk(KV_(4) * fb[4], KV_(5) * fb[5]); pe.w = cvtpk(KV_(6) * fb[6], KV_(7) * fb[7]);
                            *(LAS v4u*)(vT + (d0 + c) * 144 + tb * 2) = pe; }
#undef KV_
                    }
                }
                __syncthreads();
                {
                    const int it = wave >> 1;
#pragma unroll
                    for (int jj = 0; jj < 2; ++jj) { const int jt = (wave & 1) * 2 + jj;
                        f32x4 kk = (f32x4){0.f, 0.f, 0.f, 0.f}, qk = (f32x4){0.f, 0.f, 0.f, 0.f};
                        if (jt <= it) {
#pragma unroll
                            for (int ks = 0; ks < 4; ++ks) { const bf16x8 Bk = ld128(kb + (16 * jt + m) * 272 + (32 * ks + 8 * q) * 2);
                                kk = MFMA16(ld128(kb + (16 * it + m) * 272 + (32 * ks + 8 * q) * 2), Bk, kk); qk = MFMA16(ld128(qb + (16 * it + m) * 272 + (32 * ks + 8 * q) * 2), Bk, qk); } }
                        const int j = 16 * jt + m; const float gj = sgc[j];
#pragma unroll
                        for (int r = 0; r < 4; ++r) { const int i = 16 * it + 4 * q + r;
                            const float dec = (j <= i) ? exp_fast(sgc[i] - gj) : 0.f;
                            Ls[i * 68 + j] = (j < i) ? sbeta[i] * kk[r] * dec : 0.f;
                            *(LAS unsigned short*)(atts + i * 144 + kperm(j) * 2) = (unsigned short)f2bf((j <= i) ? qk[r] * dec : 0.f); } }
                }
                __syncthreads();
                if (tid < 64) { const int bk = tid >> 4, c = tid & 15; float x[16];
                    const LAS float* lb = Ls + (16 * bk) * 68 + 16 * bk;
#pragma unroll
                    for (int r = 0; r < 16; ++r) { float acc = (r == c) ? 1.f : 0.f;
#pragma unroll
                        for (int m4 = 0; m4 < (r + 3) / 4; ++m4) { const f32x4 lv = *(const LAS f32x4*)(lb + r * 68 + 4 * m4);
                            if (4 * m4 + 0 < r) acc -= lv.x * x[4 * m4 + 0]; if (4 * m4 + 1 < r) acc -= lv.y * x[4 * m4 + 1]; if (4 * m4 + 2 < r) acc -= lv.z * x[4 * m4 + 2]; if (4 * m4 + 3 < r) acc -= lv.w * x[4 * m4 + 3]; }
                        x[r] = acc; Ts[(16 * bk + r) * 68 + 16 * bk + c] = acc; } }
                __syncthreads();
#pragma unroll 1
                for (int dl = 1; dl < 4; ++dl) {
                    const int nout = (4 - dl) * 256;
                    for (int idx = tid; idx < nout; idx += NWAVES * 64) { const int blk = idx >> 8, r = (idx >> 4) & 15, c = idx & 15, i = blk + dl, j = blk; float acc = 0.f;
                        const LAS float* lrow = Ls + (16 * i + r) * 68 + 16 * j; const LAS float* tcol = Ts + (16 * j) * 68 + 16 * j + c;
                        for (int kk = 0; kk < dl; ++kk) {
#pragma unroll
                            for (int mm = 0; mm < 16; mm += 4) { const f32x4 lv = *(const LAS f32x4*)(lrow + 16 * kk + mm); const LAS float* tc = tcol + (16 * kk + mm) * 68;
                                acc += lv.x * tc[0] + lv.y * tc[68] + lv.z * tc[136] + lv.w * tc[204]; } }
                        Xs[idx] = acc; }
                    __syncthreads();
                    for (int idx = tid; idx < nout; idx += NWAVES * 64) { const int blk = idx >> 8, r = (idx >> 4) & 15, c = idx & 15, i = blk + dl, j = blk; float acc = 0.f;
                        const LAS float* trow = Ts + (16 * i + r) * 68 + 16 * i; const LAS float* xc = Xs + blk * 256 + c;
#pragma unroll
                        for (int mm = 0; mm < 16; mm += 4) { const f32x4 tv = *(const LAS f32x4*)(trow + mm); acc -= tv.x * xc[(mm + 0) * 16] + tv.y * xc[(mm + 1) * 16] + tv.z * xc[(mm + 2) * 16] + tv.w * xc[(mm + 3) * 16]; }
                        Ts[(16 * i + r) * 68 + 16 * j + c] = acc; }
                    __syncthreads();
                }
#pragma unroll
                for (int e = 0; e < 8; ++e) { const int idx = tid + 512 * e, i = idx >> 6, j = idx & 63;
                    *(LAS unsigned short*)(Tb + i * 144 + j * 2) = (unsigned short)(((j >> 4) <= (i >> 4)) ? f2bf(Ts[i * 68 + j]) : 0u); }
                __syncthreads();
                {
                    const int nt = wave;
#pragma unroll
                    for (int mt = 0; mt < 4; ++mt) { f32x4 ua = (f32x4){0.f, 0.f, 0.f, 0.f}, wa = (f32x4){0.f, 0.f, 0.f, 0.f};
#pragma unroll
                        for (int ks = 0; ks < 2; ++ks) if (32 * ks <= 16 * mt + 15) { const bf16x8 A = ld128(Tb + (16 * mt + m) * 144 + (32 * ks + 8 * q) * 2);
                            ua = MFMA16(A, ld128(vT + (16 * nt + m) * 144 + (32 * ks + 8 * q) * 2), ua); wa = MFMA16(A, ld128(kbeT + (16 * nt + m) * 144 + (32 * ks + 8 * q) * 2), wa); }
unsigned uts[4];
#pragma unroll
                        for (int r = 0; r < 4; ++r) { const int t = 16 * mt + 4 * q + r, d = 16 * nt + m;
                            uts[r] = f2bf(ua[r]); *(LAS unsigned short*)(kb + t * 272 + kperm(d) * 2) = (unsigned short)f2bf(-wa[r]); }
                        { v2u pu; pu.x = uts[0] | (uts[1] << 16); pu.y = uts[2] | (uts[3] << 16); *(LAS v2u*)(F.lds + PG_LS + (16 * nt + m) * 144 + (16 * mt + 4 * q) * 2) = pu; } }
                }
                __syncthreads();
#pragma unroll
                for (int e = 0; e < 2; ++e) { const int p = tid + 512 * e, row = p >> 4, c16 = p & 15;
                    *(v4u*)((unsigned char*)(WSH(WS_MIX + 16 * MiB) + item4 * 8192) + row * 256 + c16 * 16) = *(const LAS v4u*)(kb + row * 272 + c16 * 16);
                    const int ur = p >> 3, uc = p & 7;
                    *(v4u*)((unsigned char*)(WSH(WS_MIX) + item4 * 8192) + ur * 128 + uc * 16) = *(const LAS v4u*)(F.lds + PG_LS + ur * 144 + uc * 16); }
                { const int row = tid >> 3, c16 = tid & 7;
                    *(v4u*)((unsigned char*)(WSH(WS_GATT) + item4 * 4096) + row * 128 + c16 * 16) = *(const LAS v4u*)(atts + row * 144 + c16 * 16); }
                if (tid == 0) WSF(WS_GL)[item4] = seg[63];
                __syncthreads();
            }
        }
    }
}

#undef PREP_IDS
constexpr int SC_W = 0, SC_QD = 18432, SC_KT = 36864, SC_AT = 57344, SC_U = 67584, SC_STAGE = 76800;
static_assert(2 * SC_STAGE <= RING_BYTES, "scan stages fit the ring");
#define SBAR_() __builtin_amdgcn_sched_barrier(0)
#define WG_BAR() do { asm volatile("s_waitcnt lgkmcnt(0)" ::: "memory"); __builtin_amdgcn_s_barrier(); asm volatile("" ::: "memory"); } while (0)
constexpr int NSEG = 8, SEGC = NCH / NSEG;
constexpr size_t WS_PSI = 344 * MiB;
constexpr size_t WS_PHI = 352 * MiB;
constexpr size_t WS_SST = 356 * MiB;
static_assert(WS_SST + 8 * MiB <= WS_END, "two-level scan scratch");

#define SC_ADDR() \
        const unsigned char* gW = (const unsigned char*)(WSH(WS_MIX + 16 * MiB) + it0 * 8192); \
        const unsigned char* gQD = (const unsigned char*)(WSH(WS_GQD) + it0 * 8192); \
        const unsigned char* gKT = (const unsigned char*)(WSH(WS_GKT) + it0 * 8192); \
        const unsigned char* gAT = (const unsigned char*)(WSH(WS_GATT) + it0 * 4096); \
        const unsigned char* gU = (const unsigned char*)(WSH(WS_MIX) + it0 * 8192) + dvbase * 128;
#define SC_LOAD(rg, n_) do { const size_t cb = (size_t)(n_) * 16384, ca = (size_t)(n_) * 8192; \
            _Pragma("unroll") for (int i = 0; i < 4; ++i) { rg[i] = *(const v4u*)(gW + cb + gofW + i * 4096); if (FULL) rg[4 + i] = *(const v4u*)(gQD + cb + gofW + i * 4096); \
                rg[8 + i] = *(const v4u*)(gKT + cb + gofK + i * 4096); } \
            _Pragma("unroll") for (int i = 0; i < 2; ++i) { if (FULL) rg[12 + i] = *(const v4u*)(gAT + ca + gofK + i * 4096); rg[14 + i] = *(const v4u*)(gU + cb + gofK + i * 4096); } } while (0)
#define SC_WRITE(rg, buf_) do { LAS unsigned char* sb_ = F.lds + (buf_) * SC_STAGE; \
            _Pragma("unroll") for (int i = 0; i < 4; ++i) { *(LAS v4u*)(sb_ + SC_W + lofW + i * (16 * 288)) = rg[i]; if (FULL) *(LAS v4u*)(sb_ + SC_QD + lofW + i * (16 * 288)) = rg[4 + i]; \
                *(LAS v4u*)(sb_ + SC_KT + lofK + i * (32 * 160)) = rg[8 + i]; } \
            _Pragma("unroll") for (int i = 0; i < 2; ++i) { if (FULL) *(LAS v4u*)(sb_ + SC_AT + lofK + i * (32 * 160)) = rg[12 + i]; *(LAS v4u*)(sb_ + SC_U + lofU + i * (32 * 144)) = rg[14 + i]; } } while (0)
#define SC_LOADER_LOOP() do { \
            int lt_ = F.tid & 255; asm volatile("" : "+v"(lt_)); \
            const int gofW = (lt_ >> 4) * 256 + (lt_ & 15) * 16, gofK = (lt_ >> 3) * 128 + (lt_ & 7) * 16; \
            const int lofW = (lt_ >> 4) * 288 + (lt_ & 15) * 16, lofK = (lt_ >> 3) * 160 + (lt_ & 7) * 16, lofU = (lt_ >> 3) * 144 + (lt_ & 7) * 16; \
            const int nlast = n0 + SEGC - 1; \
            v4u ra[16], rb[16]; \
            SC_LOAD(ra, n0); SC_WRITE(ra, 0); SC_LOAD(ra, n0 + 1); SC_LOAD(rb, n0 + 2); \
            __syncthreads(); \
            _Pragma("unroll 1") for (int j = 0; j < SEGC; j += 2) { \
                  \
                  \
                SC_WRITE(ra, 1); \
                { const int nn = n0 + j + 3 < nlast ? n0 + j + 3 : nlast; SC_LOAD(ra, nn); } \
                WG_BAR(); \
                SC_WRITE(rb, 0); \
                { const int nn = n0 + j + 4 < nlast ? n0 + j + 4 : nlast; SC_LOAD(rb, nn); } \
                WG_BAR(); \
            } } while (0)

DI void p_scan1(Frame& F, int l) {
    constexpr bool FULL = false;
    const int wave = F.wave;
    { const int lane = F.lane;
        for (int p = blockIdx.x * NWAVES + wave; p < BATCH * LRUW; p += gridDim.x * NWAVES) { const int b = p / LRUW, c = p % LRUW;
            float A = WSF(WS_AGG)[((size_t)(b * NCH + lane)) * LRUW + c], B = WSF(WS_AGG)[(size_t)BATCH * NCH * LRUW + ((size_t)(b * NCH + lane)) * LRUW + c];
#pragma unroll
            for (int off = 1; off < 64; off <<= 1) { const float Ap = shfl_up_(lane, A, off), Bp = shfl_up_(lane, B, off); if (lane >= off) { B = A * Bp + B; A = A * Ap; } }
            if (lane < 63) WSF(WS_CARRY)[((size_t)(b * NCH + lane + 1)) * LRUW + c] = B; else WSF(WS_CARRY)[((size_t)(b * NCH)) * LRUW + c] = 0.f; } }
    const bool is_loader = wave >= 4;
    const int wv = wave & 3;
    for (int job = F.vcu; job < BATCH * GH * NSEG * 2; job += F.G) {
        const int bh = job >> 4, seg = (job >> 1) & (NSEG - 1), dvbase = (job & 1) * 64, n0 = seg * SEGC;
        const size_t it0 = (size_t)bh * NCH;
        SC_ADDR()
        (void)gQD; (void)gAT;
        if (seg == NSEG - 1) { __syncthreads(); continue; }
        if (is_loader) { SC_LOADER_LOOP(); }
        else {
            int tc_ = F.tid; asm volatile("" : "+v"(tc_)); const int lane = tc_ & 63, m = lane & 15, q = lane >> 4;
            const int col = dvbase + 16 * wv + m;
            f32x4 Sacc[2][8];
#pragma unroll
            for (int dt = 0; dt < 8; ++dt) { Sacc[0][dt] = (f32x4){0.f, 0.f, 0.f, 0.f};
#pragma unroll
                for (int r = 0; r < 4; ++r) Sacc[1][dt][r] = (16 * dt + 4 * q + r == col) ? 1.f : 0.f; }
            const float glv = WSF(WS_GL)[it0 + lane];
            __syncthreads();
#pragma unroll 1
            for (int j = 0; j < SEGC; ++j) {
                const LAS unsigned char* B = F.lds + (j & 1) * SC_STAGE;
                bf16x8 fa[4], fb[4], Sb[2][4], vnb[2][2];
                f32x4 vn[2][4];
                v2u ut[4];
#pragma unroll
                for (int mt = 0; mt < 4; ++mt) ut[mt] = *(const LAS v2u*)(B + SC_U + (16 * wv + m) * 144 + (16 * mt + 4 * q) * 2);
#define LDW4(dst, mt_) do { _Pragma("unroll") for (int kb = 0; kb < 4; ++kb) dst[kb] = ld128(B + SC_W + (16 * (mt_) + m) * 288 + (32 * kb + 8 * q) * 2); } while (0)
#define MMW2(src, mt_) do { _Pragma("unroll") for (int kb = 0; kb < 4; ++kb) { vn[0][mt_] = MFMA16(src[kb], Sb[0][kb], vn[0][mt_]); vn[1][mt_] = MFMA16(src[kb], Sb[1][kb], vn[1][mt_]); } } while (0)
#define LDK4(dst, dt_) do { dst[0] = ld128(B + SC_KT + (16 * (dt_) + m) * 160 + (8 * q) * 2); dst[1] = ld128(B + SC_KT + (16 * (dt_) + m) * 160 + (32 + 8 * q) * 2); \
                            dst[2] = ld128(B + SC_KT + (16 * ((dt_) + 1) + m) * 160 + (8 * q) * 2); dst[3] = ld128(B + SC_KT + (16 * ((dt_) + 1) + m) * 160 + (32 + 8 * q) * 2); } while (0)
#define MMK2(src, dt_) do { _Pragma("unroll") for (int e = 0; e < 2; ++e) { Sacc[e][dt_] = MFMA16(src[0], vnb[e][0], Sacc[e][dt_]); Sacc[e][dt_] = MFMA16(src[1], vnb[e][1], Sacc[e][dt_]); \
                            Sacc[e][(dt_) + 1] = MFMA16(src[2], vnb[e][0], Sacc[e][(dt_) + 1]); Sacc[e][(dt_) + 1] = MFMA16(src[3], vnb[e][1], Sacc[e][(dt_) + 1]); } } while (0)
                LDW4(fa, 0); SBAR_();
#pragma unroll
                for (int e = 0; e < 2; ++e)
#pragma unroll
                    for (int kb = 0; kb < 4; ++kb) Sb[e][kb] = pack8(Sacc[e][2 * kb], Sacc[e][2 * kb + 1]);
#pragma unroll
                for (int mt = 0; mt < 4; ++mt) { vn[0][mt] = (f32x4){bflo(ut[mt].x), bfhi(ut[mt].x), bflo(ut[mt].y), bfhi(ut[mt].y)}; vn[1][mt] = (f32x4){0.f, 0.f, 0.f, 0.f}; }
                const float gl = __builtin_bit_cast(float, __builtin_amdgcn_readlane(__builtin_bit_cast(int, glv), n0 + j));
                SBAR_(); LDW4(fb, 1); SBAR_(); MMW2(fa, 0); SBAR_();
                LDW4(fa, 2); SBAR_(); MMW2(fb, 1); SBAR_();
                LDW4(fb, 3); SBAR_(); MMW2(fa, 2); SBAR_();
                LDK4(fa, 0); SBAR_(); MMW2(fb, 3); SBAR_();
#pragma unroll
                for (int e = 0; e < 2; ++e) { vnb[e][0] = pack8(vn[e][0], vn[e][1]); vnb[e][1] = pack8(vn[e][2], vn[e][3]);
#pragma unroll
                    for (int dt = 0; dt < 8; ++dt) Sacc[e][dt] = Sacc[e][dt] * gl; }
                SBAR_(); LDK4(fb, 2); SBAR_(); MMK2(fa, 0); SBAR_();
                LDK4(fa, 4); SBAR_(); MMK2(fb, 2); SBAR_();
                LDK4(fb, 6); SBAR_(); MMK2(fa, 4); SBAR_();
                MMK2(fb, 6); SBAR_();
                WG_BAR();
            }
#undef LDW4
#undef MMW2
#undef LDK4
#undef MMK2
            float* psi = WSF(WS_PSI) + ((size_t)(bh * NSEG + seg) * 128) * 128 + col;
            bf16* phi = WSH(WS_PHI) + ((size_t)(bh * NSEG + seg) * 128) * 128 + kperm(col);
#pragma unroll
            for (int dt = 0; dt < 8; ++dt)
#pragma unroll
                for (int r = 0; r < 4; ++r) { const int dk = 16 * dt + 4 * q + r; psi[(size_t)dk * 128] = Sacc[0][dt][r]; phi[(size_t)dk * 128] = (bf16)f2bf(Sacc[1][dt][r]); }
        }
        __syncthreads();
    }
}

DI void p_scan2(Frame& F, int l) {
    const int wave = F.wave;
    for (int bh = blockIdx.x; bh < BATCH * GH; bh += gridDim.x) {
        int tc_ = F.tid; asm volatile("" : "+v"(tc_)); const int tid = tc_, lane = tc_ & 63, m = lane & 15, q = lane >> 4;
        const int col = 16 * wave + m;
        const int gof = (tid >> 4) * 256 + (tid & 15) * 16, lof = (tid >> 4) * 288 + (tid & 15) * 16;
        const unsigned char* phi0 = (const unsigned char*)(WSH(WS_PHI) + ((size_t)(bh * NSEG) * 128) * 128);
        const float* psi0 = WSF(WS_PSI) + ((size_t)(bh * NSEG) * 128) * 128 + col;
        float* sst0 = WSF(WS_SST) + ((size_t)(bh * NSEG) * 128) * 128 + col;
        f32x4 S[8], Ps[8]; v4u pr[4];
#pragma unroll
        for (int dt = 0; dt < 8; ++dt) { S[dt] = (f32x4){0.f, 0.f, 0.f, 0.f};
#pragma unroll
            for (int r = 0; r < 4; ++r) Ps[dt][r] = psi0[(size_t)(16 * dt + 4 * q + r) * 128]; }
#pragma unroll
        for (int i = 0; i < 4; ++i) pr[i] = *(const v4u*)(phi0 + gof + i * 8192);
#pragma unroll
        for (int i = 0; i < 4; ++i) *(LAS v4u*)(F.lds + lof + i * (32 * 288)) = pr[i];
        __syncthreads();
#pragma unroll 1
        for (int seg = 0; seg + 1 < NSEG; ++seg) {
            if (seg > 0) {
#pragma unroll
                for (int dt = 0; dt < 8; ++dt)
#pragma unroll
                    for (int r = 0; r < 4; ++r) sst0[((size_t)seg * 128 + 16 * dt + 4 * q + r) * 128] = S[dt][r]; }
            const int sn = seg + 2 < NSEG ? seg + 1 : seg;
#pragma unroll
            for (int i = 0; i < 4; ++i) pr[i] = *(const v4u*)(phi0 + (size_t)sn * 32768 + gof + i * 8192);
            f32x4 Pn[8];
#pragma unroll
            for (int dt = 0; dt < 8; ++dt)
#pragma unroll
                for (int r = 0; r < 4; ++r) Pn[dt][r] = psi0[((size_t)sn * 128 + 16 * dt + 4 * q + r) * 128];
            const LAS unsigned char* B = F.lds + (seg & 1) * 36864;
            bf16x8 Sb[4];
#pragma unroll
            for (int kb = 0; kb < 4; ++kb) Sb[kb] = pack8(S[2 * kb], S[2 * kb + 1]);
#pragma unroll
            for (int dt = 0; dt < 8; ++dt) { f32x4 acc = Ps[dt];
#pragma unroll
                for (int kb = 0; kb < 4; ++kb) acc = MFMA16(ld128(B + (16 * dt + m) * 288 + (32 * kb + 8 * q) * 2), Sb[kb], acc);
                S[dt] = acc; }
#pragma unroll
            for (int dt = 0; dt < 8; ++dt) Ps[dt] = Pn[dt];
#pragma unroll
            for (int i = 0; i < 4; ++i) *(LAS v4u*)(F.lds + ((seg + 1) & 1) * 36864 + lof + i * (32 * 288)) = pr[i];
            __syncthreads();
        }
#pragma unroll
        for (int dt = 0; dt < 8; ++dt)
#pragma unroll
            for (int r = 0; r < 4; ++r) sst0[((size_t)(NSEG - 1) * 128 + 16 * dt + 4 * q + r) * 128] = S[dt][r];
        __syncthreads();
    }
}

DI void p_scan3(Frame& F, int l) {
    constexpr bool FULL = true;
    const int wave = F.wave;
    const bool is_loader = wave >= 4;
    const int wv = wave & 3;
    for (int job = F.vcu; job < BATCH * GH * NSEG * 2; job += F.G) {
        const int bh = job >> 4, seg = (job >> 1) & (NSEG - 1), dvbase = (job & 1) * 64, n0 = seg * SEGC, b = bh >> 2, h = bh & 3;
        const size_t it0 = (size_t)bh * NCH;
        SC_ADDR()
        if (is_loader) { SC_LOADER_LOOP(); }
        else {
            int tc_ = F.tid; asm volatile("" : "+v"(tc_)); const int lane = tc_ & 63, m = lane & 15, q = lane >> 4;
            f32x4 Sacc[8];
            if (seg == 0) {
#pragma unroll
                for (int dt = 0; dt < 8; ++dt) Sacc[dt] = (f32x4){0.f, 0.f, 0.f, 0.f};
            } else { const float* sst = WSF(WS_SST) + ((size_t)(bh * NSEG + seg) * 128) * 128 + dvbase + 16 * wv + m;
#pragma unroll
                for (int dt = 0; dt < 8; ++dt)
#pragma unroll
                    for (int r = 0; r < 4; ++r) Sacc[dt][r] = sst[(size_t)(16 * dt + 4 * q + r) * 128]; }
            const float glv = WSF(WS_GL)[it0 + lane];
            __syncthreads();
#define FR_W(dst, mt_) do { _Pragma("unroll") for (int kb = 0; kb < 4; ++kb) { dst[kb] = ld128(B + SC_W + (16 * (mt_) + m) * 288 + (32 * kb + 8 * q) * 2); dst[4 + kb] = ld128(B + SC_QD + (16 * (mt_) + m) * 288 + (32 * kb + 8 * q) * 2); } } while (0)
#define MM_W(src, mt_) do { _Pragma("unroll") for (int kb = 0; kb < 4; ++kb) { vn[mt_] = MFMA16(src[kb], Sb[kb], vn[mt_]); o[mt_] = MFMA16(src[4 + kb], Sb[kb], o[mt_]); } } while (0)
#define FR_KT(dst, hf_) do { _Pragma("unroll") for (int i = 0; i < 8; ++i) dst[i] = ld128(B + SC_KT + (16 * (4 * (hf_) + (i >> 1)) + m) * 160 + (32 * (i & 1) + 8 * q) * 2); } while (0)
#define MM_KT(src, hf_) do { _Pragma("unroll") for (int i = 0; i < 8; ++i) Sacc[4 * (hf_) + (i >> 1)] = MFMA16(src[i], vnb[i & 1], Sacc[4 * (hf_) + (i >> 1)]); } while (0)
#pragma unroll 1
            for (int j = 0; j < SEGC; ++j) {
                const int n = n0 + j;
                const LAS unsigned char* B = F.lds + (j & 1) * SC_STAGE;
                bf16x8 fa[8], fb[8], Sb[4], vnb[2];
                f32x4 vn[4], o[4];
                v2u ut[4];
#pragma unroll
                for (int mt = 0; mt < 4; ++mt) ut[mt] = *(const LAS v2u*)(B + SC_U + (16 * wv + m) * 144 + (16 * mt + 4 * q) * 2);
                FR_W(fa, 0); SBAR_();
#pragma unroll
                for (int kb = 0; kb < 4; ++kb) Sb[kb] = pack8(Sacc[2 * kb], Sacc[2 * kb + 1]);
#pragma unroll
                for (int mt = 0; mt < 4; ++mt) { o[mt] = (f32x4){0.f, 0.f, 0.f, 0.f}; vn[mt] = (f32x4){bflo(ut[mt].x), bfhi(ut[mt].x), bflo(ut[mt].y), bfhi(ut[mt].y)}; }
                const float gl = __builtin_bit_cast(float, __builtin_amdgcn_readlane(__builtin_bit_cast(int, glv), n));
                SBAR_(); FR_W(fb, 1); SBAR_(); MM_W(fa, 0); SBAR_();
                FR_W(fa, 2); SBAR_(); MM_W(fb, 1); SBAR_();
                FR_W(fb, 3); SBAR_(); MM_W(fa, 2); SBAR_();
                fa[0] = ld128(B + SC_AT + (m) * 160 + (8 * q) * 2); fa[1] = ld128(B + SC_AT + (16 + m) * 160 + (8 * q) * 2);
                fa[2] = ld128(B + SC_AT + (32 + m) * 160 + (8 * q) * 2); fa[3] = ld128(B + SC_AT + (32 + m) * 160 + (32 + 8 * q) * 2);
                fa[4] = ld128(B + SC_AT + (48 + m) * 160 + (8 * q) * 2); fa[5] = ld128(B + SC_AT + (48 + m) * 160 + (32 + 8 * q) * 2);
                SBAR_(); MM_W(fb, 3); SBAR_();
                vnb[0] = pack8(vn[0], vn[1]); vnb[1] = pack8(vn[2], vn[3]);
#pragma unroll
                for (int dt = 0; dt < 8; ++dt) Sacc[dt] = Sacc[dt] * gl;
                SBAR_(); FR_KT(fb, 0); SBAR_();
                o[0] = MFMA16(fa[0], vnb[0], o[0]); o[1] = MFMA16(fa[1], vnb[0], o[1]); o[2] = MFMA16(fa[2], vnb[0], o[2]); o[3] = MFMA16(fa[4], vnb[0], o[3]);
                o[2] = MFMA16(fa[3], vnb[1], o[2]); o[3] = MFMA16(fa[5], vnb[1], o[3]);
                SBAR_(); FR_KT(fa, 1); SBAR_(); MM_KT(fb, 0); SBAR_();
                MM_KT(fa, 1); SBAR_();
                float* go = WSF(WS_GO) + (size_t)(b * SEQ + n * CH + 4 * q) * GDNW + h * HD + dvbase + 16 * wv + m;
#pragma unroll
                for (int mt = 0; mt < 4; ++mt)
#pragma unroll
                    for (int r = 0; r < 4; ++r) go[(size_t)(16 * mt + r) * GDNW] = o[mt][r];
                WG_BAR();
            }
#undef FR_W
#undef MM_W
#undef FR_KT
#undef MM_KT
        }
        __syncthreads();
    }
}
#undef SC_ADDR
#undef SC_LOAD
#undef SC_WRITE
#undef SC_LOADER_LOOP

DI float gelu_fast(float x) { const float u2 = 1.5957691216057308f * (x + 0.044715f * x * x * x); return x * rcp_(1.f + exp_fast(-u2)); }
struct PostRow { v4u hp[2]; v2u y2[2], z2[2]; f32x4 go[2], cr[2]; };
DI void post_load(Frame& F, PostRow& R, int m, int lane) {
    const int b = m >> 12, n = (m & (SEQ - 1)) >> 6;
#pragma unroll
    for (int j = 0; j < 2; ++j) { const int c = 4 * lane + 256 * j;
        R.hp[j] = *(const v4u*)((const unsigned*)(F.A->ws + WS_H) + (size_t)m * LRUW + c);
        R.cr[j] = *(const f32x4*)(WSF(WS_CARRY) + ((size_t)(b * NCH + n)) * LRUW + c);
        R.y2[j] = *(const v2u*)(WSH(WS_PROJ) + (size_t)m * NPROJ + O_LY + c);
        R.go[j] = *(const f32x4*)(WSF(WS_GO) + (size_t)m * GDNW + c);
        R.z2[j] = *(const v2u*)(WSH(WS_PROJ) + (size_t)m * NPROJ + O_Z + c); }
}
DI void p_post(Frame& F, int l) {
    const int gw = F.vcu * NWAVES + F.wave, NGW = F.G * NWAVES, lane = F.lane;
    PostRow R;
    if (gw < M) post_load(F, R, gw, lane);
    for (int m = gw; m < M; m += NGW) {
        PostRow Rn; const int mn = m + NGW;
        post_load(F, Rn, mn < M ? mn : m, lane);
        f32x4 val[2]; float ss = 0.f;
#pragma unroll
        for (int j = 0; j < 2; ++j) { const v4u hp = R.hp[j]; const v2u y2 = R.y2[j];
            const f32x4 hl = (f32x4){bflo(hp.x), bflo(hp.y), bflo(hp.z), bflo(hp.w)}, p = (f32x4){bfhi(hp.x), bfhi(hp.y), bfhi(hp.z), bfhi(hp.w)};
            const f32x4 hh = hl + p * R.cr[j];
            val[j] = (f32x4){hh.x * gelu_fast(bflo(y2.x)), hh.y * gelu_fast(bfhi(y2.x)), hh.z * gelu_fast(bflo(y2.y)), hh.w * gelu_fast(bfhi(y2.y))};
            ss += (val[j].x * val[j].x + val[j].y * val[j].y) + (val[j].z * val[j].z + val[j].w * val[j].w); }
        ss = wave_sum_(lane, ss);
        const float rl = 1.0f / sqrtf(ss * (1.0f / LRUW) + EPS);
#pragma unroll
        for (int j = 0; j < 2; ++j) { const int c = 4 * lane + 256 * j; const f32x4 nw = *(const f32x4*)(LRU_NORM_W + (size_t)l * LRUW + c);
            const f32x4 o = val[j] * rl * nw; v2u w; w.x = pk2(o.x, o.y); w.y = pk2(o.z, o.w); *(v2u*)(WSH(WS_MIX) + (size_t)m * D + c) = w; }
#pragma unroll
        for (int j = 0; j < 2; ++j) { const int c = 4 * lane + 256 * j, d = c & (HD - 1);
            const f32x4 o = R.go[j]; const v2u z2 = R.z2[j];
            const float s2 = half_sum_(lane, (o.x * o.x + o.y * o.y) + (o.z * o.z + o.w * o.w));
            const float rg = 1.0f / sqrtf(s2 * (1.0f / HD) + EPS);
            const f32x4 nw = *(const f32x4*)(GDN_NORM_W + (size_t)l * HD + d);
            const f32x4 r = (f32x4){o.x * rg * nw.x * silu_fast(bflo(z2.x)), o.y * rg * nw.y * silu_fast(bfhi(z2.x)), o.z * rg * nw.z * silu_fast(bflo(z2.y)), o.w * rg * nw.w * silu_fast(bfhi(z2.y))};
            v2u w; w.x = pk2(r.x, r.y); w.y = pk2(r.z, r.w); *(v2u*)(WSH(WS_MIX) + (size_t)m * D + LRUW + c) = w; }
        R = Rn;
    }
}

DI void p_final(Frame& F) {
    const int gw = F.vcu * NWAVES + F.wave, NGW = F.G * NWAVES, lane = F.lane;
    for (int m = gw; m < M; m += NGW) {
        f32x4 v[4]; float ss = 0.f;
#pragma unroll
        for (int j = 0; j < 4; ++j) { v[j] = *(const f32x4*)(OUT_ + (size_t)m * D + 4 * lane + 256 * j); ss += (v[j].x * v[j].x + v[j].y * v[j].y) + (v[j].z * v[j].z + v[j].w * v[j].w); }
        ss = wave_sum_(F.lane, ss);
        const float rstd = 1.0f / sqrtf(ss * (1.0f / D) + EPS);
#pragma unroll
        for (int j = 0; j < 4; ++j) { const int col = 4 * lane + 256 * j; const f32x4 nw = *(const f32x4*)(FINAL_NORM_W + col); *(f32x4*)(OUT_ + (size_t)m * D + col) = v[j] * rstd * nw; }
    }
}

__device__ __forceinline__ void pg8::EpiMulti::operator()(const f32x4 (&acc)[2][2][4][2], const Unit& u, int wr, int wc, int fr, int fq) const {
    const __attribute__((address_space(4))) Args* ap = (const __attribute__((address_space(4))) Args*)__builtin_amdgcn_kernarg_segment_ptr(); asm volatile("" : "+s"(ap));
    unsigned char* ws = ap->ws;
    if (mode == 0) { EpiBf16<0> e{(bf16_t*)(ws + WS_PROJ), NPROJ, nullptr, 0, 0, 1.f}; e(acc, u, wr, wc, fr, fq); }
    else if (mode == 2) { EpiBf16<2> e{(bf16_t*)(ws + WS_ACT), FF, nullptr, 0, 0, 1.f}; e(acc, u, wr, wc, fr, fq); }
    else { const float* modl = (const float*)(ws + WS_MOD) + (size_t)l * BATCH * NMODC + (mode == 3 ? 2 * D : 5 * D);
        EpiResid r{(mode == 3 && l == 0) ? ap->in[0] : ap->out, ap->out, modl, D, NMODC, SEQ}; r(acc, u, wr, wc, fr, fq); }
}

__global__ void __launch_bounds__(NWAVES * 64, 2) mk_fwd(Args args) {
    extern __shared__ __attribute__((aligned(16))) unsigned char lds[];
    Frame F;
    F.lds = (LAS unsigned char*)lds;
    F.MISC = (volatile LAS unsigned*)(F.lds + MISC_OFF);
    F.tid = threadIdx.x; F.lane = F.tid & 63; F.wave = __builtin_amdgcn_readfirstlane(F.tid >> 6);
    F.G = gridDim.x; { const int bx = blockIdx.x; F.vcu = (F.G % 8 == 0) ? (bx % 8) * (F.G / 8) + bx / 8 : bx; }
    F.A = (const __attribute__((address_space(4))) Args*)__builtin_amdgcn_kernarg_segment_ptr();
    F.ctl = (gu32*)(F.A->ws + WS_CTL);
    for (int u = F.tid; u < (LDS_BYTES - LDSCTL_OFF) / 4; u += NWAVES * 64) ((LAS unsigned*)(F.lds + LDSCTL_OFF))[u] = 0u;
    __syncthreads();
    XcdBarrier bar; bar.bar = (unsigned*)(F.ctl + CW_BAR); bar.x = 0; bar.st = nullptr;
    if (N_LAUNCHES == 1) bar = xcd_barrier_post((unsigned*)(F.ctl + CW_BAR), F.MISC + 8);

    const int lo = F.A->ph_lo, hi = F.A->ph_hi;
    int rep_done = 0;
#pragma unroll 1
    for (int s = lo; s < hi; ++s) {
        { const __attribute__((address_space(4))) Args* ap = (const __attribute__((address_space(4))) Args*)__builtin_amdgcn_kernarg_segment_ptr(); asm volatile("" : "+s"(ap)); F.A = ap; }
        { int t_ = threadIdx.x; asm volatile("" : "+v"(t_)); F.tid = t_; F.lane = t_ & 63; F.wave = __builtin_amdgcn_readfirstlane(t_ >> 6); }
        if (s == 0) { if (PH_MASK & 1) { p_mod(F); __syncthreads(); p0_weights(F); } }
        else if (s == N_STEPS - 1) { if (PH_MASK & 2) p_final(F); }
        else {
            const int l = (s - 1) / 9, i = (s - 1) % 9;
            bf16* wl = WSH(WS_W) + (size_t)l * LAYER_W;
            const float* modl = WSF(WS_MOD) + (size_t)l * BATCH * NMODC;
            if (!((PH_MASK >> (2 + i)) & 1)) {}
            else if (i == 0) { p_normmod<true>(F, l, l == 0 ? X_IN : OUT_, NORM_MIX_W, 0, D); }
            else if (i == 2) { p_prep(F, l); }
            else if (i == 3) {
                p_scan1(F, l); xcd_barrier(bar, F.tid == 0);
#if defined(SCAN_REP) && SCAN_REP == 1
                p_scan1(F, l); xcd_barrier(bar, F.tid == 0);
#endif
                p_scan2(F, l); xcd_barrier(bar, F.tid == 0);
#if defined(SCAN_REP) && SCAN_REP == 2
                p_scan2(F, l); xcd_barrier(bar, F.tid == 0);
#endif
                p_scan3(F, l);
#if defined(SCAN_REP) && SCAN_REP == 3
                xcd_barrier(bar, F.tid == 0); p_scan3(F, l);
#endif
            }
            else if (i == 4) { p_post(F, l); }
            else if (i == 6) { p_normmod<false>(F, l, OUT_, NORM_MLP_W, 3 * D, 4 * D); }
            else {
                pg8::Gemm g; pg8::EpiMulti E; E.l = l;
                if (i == 1) { g = pg8::Gemm{WSH(WS_H), wl, M, NPROJ, D}; E.PERM = true; E.mode = 0; }
                else if (i == 5) { g = pg8::Gemm{WSH(WS_MIX), wl + W_OUT_OFF, M, D, D}; E.PERM = false; E.mode = 3; }
                else if (i == 7) { g = pg8::Gemm{WSH(WS_H), wl + W_UP_OFF, M, FF, D}; E.PERM = true; E.mode = 2; }
                else { g = pg8::Gemm{WSH(WS_ACT), wl + W_DOWN_OFF, M, D, FF}; E.PERM = false; E.mode = 4; }
                pg8::StaticOrder S; S.init(g.M, g.N, F.G, (int)blockIdx.x);
                pg8::gemm_phase<pg8::EpiMulti, pg8::StaticOrder, PG8_ALIGN, PG8_SP2>(F.lds + RING_OFF, g, S, E);
            }
        }
        if (REP_MASK != 0 && ((s >= 1 && s < N_STEPS - 1 && ((REP_MASK >> ((s - 1) % 9)) & 1)) || (s == 0 && (REP_MASK & 0x10000))) && !rep_done) { rep_done = 1; --s; xcd_barrier(bar, F.tid == 0); continue; }
        rep_done = 0;
        if (s + 1 < hi) xcd_barrier(bar, F.tid == 0);
    }
}

extern "C" void kernel_launch(void* const* d_in, const int* in_sizes, int n_in, void* d_out, int out_size, void* d_ws, size_t ws_size, hipStream_t stream) {
    static int grid = 0;
    if (grid == 0) {
        if (n_in != 23 || in_sizes[0] != M * D || out_size != M * D || ws_size < WS_END) { fprintf(stderr, "kernel_launch: unexpected shapes (n_in %d, in0 %d, out %d, ws %zu); nothing launched\n", n_in, n_in > 0 ? in_sizes[0] : -1, out_size, ws_size); grid = -1; return; }
        int dev = 0, cus = 0;
        if (hipGetDevice(&dev) != hipSuccess || hipDeviceGetAttribute(&cus, hipDeviceAttributeMultiprocessorCount, dev) != hipSuccess) { grid = -1; return; }
        if (hipFuncSetAttribute((const void*)mk_fwd, hipFuncAttributeMaxDynamicSharedMemorySize, LDS_BYTES) != hipSuccess) { fprintf(stderr, "kernel_launch: hipFuncSetAttribute failed\n"); grid = -1; return; }
        (void)hipGetLastError();
        grid = cus;
    }
    if (grid < 0) return;
    if (hipMemsetAsync((char*)d_ws + WS_CTL, 0, CTL_ZERO_BYTES, stream) != hipSuccess) return;
    Args a{};
    for (int i = 0; i < 23; ++i) a.in[i] = (const float*)d_in[i];
    a.out = (float*)d_out; a.ws = (unsigned char*)d_ws;
    if (N_LAUNCHES == 1) { a.ph_lo = 0; a.ph_hi = N_STEPS; hipLaunchKernelGGL(mk_fwd, dim3(grid), dim3(NWAVES * 64), LDS_BYTES, stream, a); }
    else for (int s = 0; s < N_STEPS; ++s) { a.ph_lo = s; a.ph_hi = s + 1; hipLaunchKernelGGL(mk_fwd, dim3(grid), dim3(NWAVES * 64), LDS_BYTES, stream, a); }
}
```

```cpp
#include <hip/hip_runtime.h>
#include <cstdio>
#include <cstdint>
#include <cmath>
namespace pg8 {
#define PG8_LAS __attribute__((address_space(3)))
typedef unsigned short bf16_t;
typedef short bf16x8 __attribute__((ext_vector_type(8)));
typedef float f32x4 __attribute__((ext_vector_type(4)));
typedef unsigned u32x4 __attribute__((ext_vector_type(4)));
constexpr int BM = 256, BK = 64, HALF = 128, HTB = HALF * BK * 2  , STAGE_BYTES = 8 * HTB, NXCD = 8, WGM = 8;

__host__ __device__ __forceinline__ int lds_byte(int r, int c) { const int st = (r >> 4) * 2 + (c >> 5), rr = r & 15, cc = c & 31, ob = rr * 64 + cc * 2; return st * 1024 + (ob ^ (((ob >> 9) & 1) << 5)); }
__host__ __device__ __forceinline__ void stage_rc(int b, int& R, int& C) { const int st = b / 1024, sb = b % 1024, swz = sb ^ (((sb >> 9) & 1) << 5); R = (st >> 1) * 16 + swz / 64; C = (st & 1) * 32 + (swz % 64) / 2; }
__host__ __device__ __forceinline__ int perm32(int rho) { const int n = rho >> 4, i = rho & 15; return 8 * (i >> 2) + 4 * n + (i & 3); }

struct Unit { int pm, pn; };
struct Gemm { const bf16_t* A; const bf16_t* Bt; int M, N, K; };

struct StaticOrder {
    int nM, nN, nwg, G, c;
    __host__ __device__ void init(int M, int N, int G_, int c_) { nM = M / BM; nN = N / BM; nwg = nM * nN; G = G_; c = c_; }
    __host__ __device__ bool next(int i, Unit& u) const {
        const long L = (long)i * G + c; if (L >= nwg) return false;
        int wgid = (int)L; { const int q = nwg / NXCD, r = nwg % NXCD, xcd = wgid % NXCD, off = wgid / NXCD; wgid = (xcd < r ? xcd * (q + 1) : r * (q + 1) + (xcd - r) * q) + off; }
        const int nig = WGM * nN, gid = wgid / nig, fm = gid * WGM, gsz = (nM - fm) < WGM ? (nM - fm) : WGM;
        u.pm = fm + ((wgid % nig) % gsz); u.pn = (wgid % nig) / gsz; return true;
    }
    __device__ __forceinline__ void a_ready(const Unit&) const {}
    __device__ __forceinline__ void done(const Unit&) const {}
};

__device__ __forceinline__ unsigned cvt_pk_bf16(float lo, float hi) { unsigned r; asm volatile("v_cvt_pk_bf16_f32 %0, %1, %2" : "=v"(r) : "v"(lo), "v"(hi)); return r; }
typedef float f32x2 __attribute__((ext_vector_type(2)));
__device__ __forceinline__ f32x2 gelu_pk(f32x2 v) {
    const f32x2 av = __builtin_elementwise_abs(v), d = av * 0.2316418882f + 1.0f;
    f32x2 t; t.x = __builtin_amdgcn_rcpf(d.x); t.y = __builtin_amdgcn_rcpf(d.y);
    f32x2 q = t * 0.5307027145f + (-0.7265760135f); q = q * t + 0.7107068705f; q = q * t + (-0.142248368f); q = q * t + 0.127414796f; q = q * t;
    const f32x2 s = (v * v) * (-0.72134752044f);
    f32x2 e; e.x = __builtin_amdgcn_exp2f(s.x); e.y = __builtin_amdgcn_exp2f(s.y);
    const f32x2 m = v * (q * e), r = v - m;
    f32x2 o; o.x = v.x < 0.f ? m.x : r.x; o.y = v.y < 0.f ? m.y : r.y; return o;
}

template <int ACT  > struct EpiBf16 {
    static constexpr bool PERM = true, AFTER_DRAIN = false; static_assert(ACT == 0 || ACT == 1 || ACT == 2, "EpiBf16: ACT is 0 (none), 1 (gelu_pk) or 2 (squared relu)");
    bf16_t* O; int ldc; const float* bias; int split_cols; size_t split_stride; float scale0;
    const float* rs = nullptr;
    __device__ __forceinline__ void operator()(const f32x4 (&acc)[2][2][4][2], const Unit& u, int wr, int wc, int fr, int fq) const {
        const int row0 = u.pm * BM + wr * 64 + fr; int colt = u.pn * BM; bf16_t* base = O;
        float sc = 1.f; if (split_cols) { const int t = colt / split_cols; base += (size_t)t * split_stride; colt -= t * split_cols; if (t == 0) sc = scale0; }
        const int col0 = colt + wc * 32 + 8 * fq, bcol0 = u.pn * BM + wc * 32 + 8 * fq;
        f32x4 bv[2][2];
#pragma unroll
        for (int bj = 0; bj < 2; ++bj)
#pragma unroll
            for (int n = 0; n < 2; ++n) bv[bj][n] = bias ? *(const f32x4*)(bias + bcol0 + bj * HALF + 4 * n) : (f32x4){0.f, 0.f, 0.f, 0.f};
#pragma unroll
        for (int ai = 0; ai < 2; ++ai)
#pragma unroll
            for (int m = 0; m < 4; ++m) { bf16_t* rowp = base + (size_t)(row0 + ai * HALF + m * 16) * ldc + col0;
                float rsc = 1.f;
                if (rs) { const f32x4* rp = (const f32x4*)(rs + (size_t)(row0 + ai * HALF + m * 16) * 16); const f32x4 p0 = rp[0], p1 = rp[1], p2 = rp[2], p3 = rp[3];
                    const f32x4 t = (p0 + p1) + (p2 + p3); rsc = 1.0f / sqrtf(((t[0] + t[1]) + (t[2] + t[3])) * (1.0f / 1024.0f) + 1e-6f); }
#pragma unroll
                for (int bj = 0; bj < 2; ++bj) { f32x4 v0 = acc[ai][bj][m][0] * rsc + bv[bj][0], v1 = acc[ai][bj][m][1] * rsc + bv[bj][1];
                    if (ACT == 1) { f32x2 a = gelu_pk((f32x2){v0[0], v0[1]}), b = gelu_pk((f32x2){v0[2], v0[3]}), c = gelu_pk((f32x2){v1[0], v1[1]}), d = gelu_pk((f32x2){v1[2], v1[3]});
                        v0 = (f32x4){a.x, a.y, b.x, b.y}; v1 = (f32x4){c.x, c.y, d.x, d.y}; }
                    if (ACT == 2) { _Pragma("unroll") for (int q_ = 0; q_ < 4; ++q_) { const float a_ = fmaxf(v0[q_], 0.f), b_ = fmaxf(v1[q_], 0.f); v0[q_] = a_ * a_; v1[q_] = b_ * b_; } }
                    v0 = v0 * sc; v1 = v1 * sc; u32x4 w; w.x = cvt_pk_bf16(v0[0], v0[1]); w.y = cvt_pk_bf16(v0[2], v0[3]); w.z = cvt_pk_bf16(v1[0], v1[1]); w.w = cvt_pk_bf16(v1[2], v1[3]);
                    *(u32x4*)(rowp + bj * HALF) = w; } }
    }
};


struct EpiResid {
    static constexpr bool PERM = false, AFTER_DRAIN = false;
    const float* base; float* out; const float* gate; int ldc; int gate_stride; int rows_per_batch;
    __device__ __forceinline__ void operator()(const f32x4 (&acc)[2][2][4][2], const Unit& u, int wr, int wc, int fr, int fq) const {
        const int col0 = u.pn * BM + wc * 32 + 4 * fq;
        const float* gp = gate + (size_t)((u.pm * BM) / rows_per_batch) * gate_stride + col0;
        f32x4 gv[2][2];
#pragma unroll
        for (int bj = 0; bj < 2; ++bj)
#pragma unroll
            for (int n = 0; n < 2; ++n) gv[bj][n] = *(const f32x4*)(gp + bj * HALF + n * 16);
#pragma unroll
        for (int ai = 0; ai < 2; ++ai)
#pragma unroll
            for (int m = 0; m < 4; ++m) { const size_t off = (size_t)(u.pm * BM + ai * HALF + wr * 64 + m * 16 + fr) * ldc + col0;
#pragma unroll
                for (int bj = 0; bj < 2; ++bj)
#pragma unroll
                    for (int n = 0; n < 2; ++n) { const f32x4 bs = *(const f32x4*)(base + off + bj * HALF + n * 16);
                        *(f32x4*)(out + off + bj * HALF + n * 16) = bs + gv[bj][n] * acc[ai][bj][m][n]; } }
    }
};


struct EpiResid2 {
    static constexpr bool PERM = true, AFTER_DRAIN = false;
    const float* base; float* out; const float* gate;
    const float* nw; const float* sc;
    bf16_t* anext; float* rsum;
    __device__ __forceinline__ void operator()(const f32x4 (&acc)[2][2][4][2], const Unit& u, int wr, int wc, int fr, int fq) const {
        const int col0 = u.pn * BM + wc * 32 + 8 * fq, lane = fr + 16 * fq;
        f32x4 gv[2][2], ns[2][2];
#pragma unroll
        for (int bj = 0; bj < 2; ++bj)
#pragma unroll
            for (int n = 0; n < 2; ++n) { const int c = col0 + bj * HALF + 4 * n; gv[bj][n] = *(const f32x4*)(gate + c);
                ns[bj][n] = nw ? *(const f32x4*)(nw + c) * (*(const f32x4*)(sc + c) + 1.0f) : (f32x4){0.f, 0.f, 0.f, 0.f}; }
#pragma unroll
        for (int ai = 0; ai < 2; ++ai)
#pragma unroll
            for (int m = 0; m < 4; ++m) { const size_t off = (size_t)(u.pm * BM + ai * HALF + wr * 64 + m * 16 + fr) * 1024 + col0;
                f32x4 bs[2][2];
#pragma unroll
                for (int bj = 0; bj < 2; ++bj)
#pragma unroll
                    for (int n = 0; n < 2; ++n) bs[bj][n] = *(const f32x4*)(base + off + bj * HALF + 4 * n);
                float ssq = 0.f;
#pragma unroll
                for (int bj = 0; bj < 2; ++bj) { const f32x4 x0 = bs[bj][0] + gv[bj][0] * acc[ai][bj][m][0], x1 = bs[bj][1] + gv[bj][1] * acc[ai][bj][m][1];
                    *(f32x4*)(out + off + bj * HALF) = x0; *(f32x4*)(out + off + bj * HALF + 4) = x1;
                    if (nw) { const f32x4 h0 = x0 * ns[bj][0], h1 = x1 * ns[bj][1]; u32x4 w; w.x = cvt_pk_bf16(h0[0], h0[1]); w.y = cvt_pk_bf16(h0[2], h0[3]); w.z = cvt_pk_bf16(h1[0], h1[1]); w.w = cvt_pk_bf16(h1[2], h1[3]);
                        *(u32x4*)(anext + off + bj * HALF) = w;
                        ssq += ((x0[0] * x0[0] + x0[1] * x0[1]) + (x0[2] * x0[2] + x0[3] * x0[3])) + ((x1[0] * x1[0] + x1[1] * x1[1]) + (x1[2] * x1[2] + x1[3] * x1[3])); } }
                if (nw) { ssq += __builtin_bit_cast(float, __builtin_amdgcn_ds_bpermute((lane ^ 16) << 2, __builtin_bit_cast(int, ssq)));
                    ssq += __builtin_bit_cast(float, __builtin_amdgcn_ds_bpermute((lane ^ 32) << 2, __builtin_bit_cast(int, ssq)));
                    if (fq == 0) rsum[(size_t)(u.pm * BM + ai * HALF + wr * 64 + m * 16 + fr) * 16 + u.pn * 4 + wc] = ssq; }
                if (m & 1) asm volatile("" ::: "memory"); }
    }
};

struct EpiMulti {
    static constexpr bool AFTER_DRAIN = false;
    bool PERM; int mode, l;
    __device__ __forceinline__ void operator()(const f32x4 (&acc)[2][2][4][2], const Unit& u, int wr, int wc, int fr, int fq) const;
};

template <class Epi, class Sched, bool ALIGN_EPI = false, bool SP2 = false>
__device__ __forceinline__ void gemm_phase(PG8_LAS unsigned char* lds, const Gemm g, const Sched& S, const Epi& E) {
    int tid_l = threadIdx.x; asm volatile("" : "+v"(tid_l));
    const int tid = tid_l, wid = __builtin_amdgcn_readfirstlane(tid >> 6), lane = tid & 63, wr = wid >> 2, wc = wid & 3, fr = lane & 15, fq = lane >> 4;
    const int K = g.K, nt = K / BK;
    unsigned voffA[2], voffB[2];
#pragma unroll
    for (int i = 0; i < 2; ++i) { int R, C; stage_rc(tid * 16 + i * 8192, R, C); const int Rb = E.PERM ? ((R & ~31) + perm32(R & 31)) : R;
        voffA[i] = (unsigned)(R * K + C) * 2u; voffB[i] = (unsigned)(Rb * K + C) * 2u; }
    const size_t kstep = (size_t)(BK * 2);
    const size_t hstep = (size_t)HALF * K * 2;
    const size_t tstep = 2 * hstep;
    const unsigned ldsw = (unsigned)wid * 1024u;
    const int aoff = lds_byte(wr * 64 + fr, fq * 8), boff = lds_byte(wc * 32 + fr, fq * 8);
#define PG8_SA(b, h) (((b) * 2 + (h)) * HTB)
#define PG8_SB(b, h) ((4 + (b) * 2 + (h)) * HTB)
#define PG8_STAGE(bufoff, gbase, voff) do { _Pragma("unroll") for (int _i = 0; _i < 2; ++_i) \
        __builtin_amdgcn_global_load_lds((const unsigned*)((const char*)(gbase) + (voff)[_i]), (PG8_LAS unsigned*)(lds + (bufoff) + ldsw + _i * 8192), 16, 0, 0); } while (0)
#define PG8_LDA(dst, b, h) do { _Pragma("unroll") for (int m = 0; m < 4; ++m) _Pragma("unroll") for (int k = 0; k < 2; ++k) dst[m][k] = *(const PG8_LAS bf16x8*)(lds + PG8_SA(b, h) + aoff + m * 2048 + k * 1024); } while (0)
#define PG8_LDB(dst, b, h) do { _Pragma("unroll") for (int n = 0; n < 2; ++n) _Pragma("unroll") for (int k = 0; k < 2; ++k) dst[n][k] = *(const PG8_LAS bf16x8*)(lds + PG8_SB(b, h) + boff + n * 2048 + k * 1024); } while (0)
#define PG8_MMA(ai, bj, At, Bt) do { __builtin_amdgcn_s_setprio(1); _Pragma("unroll") for (int m = 0; m < 4; ++m) _Pragma("unroll") for (int n = 0; n < 2; ++n) _Pragma("unroll") for (int k = 0; k < 2; ++k) \
        acc[ai][bj][m][n] = __builtin_amdgcn_mfma_f32_16x16x32_bf16(Bt[n][k], At[m][k], acc[ai][bj][m][n], 0, 0, 0); __builtin_amdgcn_s_setprio(0); } while (0)
#define PG8_WAIT_V(n) asm volatile("s_waitcnt vmcnt(" #n ")" ::: "memory")
#define PG8_WAIT_L(n) asm volatile("s_waitcnt lgkmcnt(" #n ")" ::: "memory")
#define PG8_BAR __builtin_amdgcn_s_barrier()
#define PG8_SCHED __builtin_amdgcn_sched_barrier(0)
    Unit cur, nxt; int ui = 0;
    if (!S.next(0, cur)) return;
    f32x4 acc[2][2][4][2];
#pragma unroll
    for (int a = 0; a < 2; ++a)
#pragma unroll
        for (int b = 0; b < 2; ++b)
#pragma unroll
            for (int m = 0; m < 4; ++m)
#pragma unroll
                for (int n = 0; n < 2; ++n) acc[a][b][m][n] = (f32x4){0.f, 0.f, 0.f, 0.f};
    bf16x8 At[4][2], B0[2][2], B1[2][2];
    const char* cA = (const char*)g.A + (size_t)cur.pm * tstep; const char* cB = (const char*)g.Bt + (size_t)cur.pn * tstep;
    S.a_ready(cur);
    if constexpr (SP2) {
        PG8_STAGE(PG8_SB(0, 0), cB, voffB); PG8_STAGE(PG8_SB(0, 1), cB + hstep, voffB); PG8_STAGE(PG8_SA(0, 0), cA, voffA); PG8_STAGE(PG8_SA(0, 1), cA + hstep, voffA);
        if (wr == 1) PG8_BAR;
        PG8_WAIT_V(2); PG8_BAR;
        PG8_STAGE(PG8_SB(1, 0), cB + kstep, voffB); PG8_STAGE(PG8_SA(1, 0), cA + kstep, voffA); PG8_STAGE(PG8_SB(1, 1), cB + hstep + kstep, voffB);
        PG8_WAIT_V(6); PG8_BAR;
    } else {
        PG8_STAGE(PG8_SB(0, 0), cB, voffB); PG8_STAGE(PG8_SA(0, 0), cA, voffA); PG8_STAGE(PG8_SB(0, 1), cB + hstep, voffB); PG8_STAGE(PG8_SA(0, 1), cA + hstep, voffA);
        if (wr == 1) PG8_BAR;
        PG8_WAIT_V(4); PG8_BAR;
        PG8_STAGE(PG8_SB(1, 0), cB + kstep, voffB); PG8_STAGE(PG8_SA(1, 0), cA + kstep, voffA); PG8_STAGE(PG8_SB(1, 1), cB + hstep + kstep, voffB);
        PG8_WAIT_V(6); PG8_BAR;
    }
    for (;;) {
        const bool has_next = S.next(ui + 1, nxt);
        const char* nA = has_next ? (const char*)g.A + (size_t)nxt.pm * tstep : cA; const char* nB = has_next ? (const char*)g.Bt + (size_t)nxt.pn * tstep : cB;
        for (int t = 0; t < nt; t += 2) {
            const bool last = (t == nt - 2);
            const char* a1 = cA + (size_t)(t + 1) * kstep;
            const char* a2 = last ? nA : cA + (size_t)(t + 2) * kstep; const char* b2 = last ? nB : cB + (size_t)(t + 2) * kstep;
            const char* a3 = a2 + kstep; const char* b3 = b2 + kstep;
            if (last && has_next) S.a_ready(nxt);
            if constexpr (SP2) {
            PG8_LDB(B0, 0, 0); PG8_LDB(B1, 0, 1); PG8_SCHED; PG8_LDA(At, 0, 0); PG8_STAGE(PG8_SA(1, 1), a1 + hstep, voffA);
            PG8_WAIT_V(8); PG8_WAIT_L(0); PG8_BAR; PG8_MMA(0, 0, At, B0); PG8_MMA(0, 1, At, B1); PG8_BAR; PG8_SCHED;
            PG8_LDA(At, 0, 1); PG8_STAGE(PG8_SB(0, 0), b2, voffB); PG8_STAGE(PG8_SB(0, 1), b2 + hstep, voffB); PG8_STAGE(PG8_SA(0, 0), a2, voffA);
            PG8_WAIT_V(8); PG8_WAIT_L(0); PG8_BAR; PG8_MMA(1, 0, At, B0); PG8_MMA(1, 1, At, B1); PG8_BAR; PG8_SCHED;
            PG8_LDB(B0, 1, 0); PG8_LDB(B1, 1, 1); PG8_SCHED; PG8_LDA(At, 1, 0); PG8_STAGE(PG8_SA(0, 1), a2 + hstep, voffA);
            PG8_WAIT_V(8); PG8_WAIT_L(0); PG8_BAR; PG8_MMA(0, 0, At, B0); PG8_MMA(0, 1, At, B1); PG8_BAR; PG8_SCHED;
            PG8_LDA(At, 1, 1); PG8_STAGE(PG8_SB(1, 0), b3, voffB); PG8_STAGE(PG8_SB(1, 1), b3 + hstep, voffB); PG8_STAGE(PG8_SA(1, 0), a3, voffA);
            PG8_WAIT_V(8); PG8_WAIT_L(0); PG8_BAR; PG8_MMA(1, 0, At, B0); PG8_MMA(1, 1, At, B1); PG8_BAR; PG8_SCHED;
            } else {
            PG8_LDB(B0, 0, 0); PG8_SCHED; PG8_LDA(At, 0, 0); PG8_STAGE(PG8_SA(1, 1), a1 + hstep, voffA);
            PG8_WAIT_L(8); PG8_BAR; PG8_WAIT_L(0); PG8_MMA(0, 0, At, B0); PG8_BAR; PG8_SCHED;
            PG8_LDB(B1, 0, 1); PG8_STAGE(PG8_SB(0, 0), b2, voffB);
            PG8_BAR; PG8_WAIT_L(0); PG8_MMA(0, 1, At, B1); PG8_BAR;
            PG8_LDA(At, 0, 1); PG8_STAGE(PG8_SA(0, 0), a2, voffA);
            PG8_BAR; PG8_WAIT_L(0); PG8_MMA(1, 0, At, B0); PG8_BAR; PG8_SCHED;
            PG8_STAGE(PG8_SB(0, 1), b2 + hstep, voffB);
            PG8_WAIT_V(6); PG8_BAR; PG8_MMA(1, 1, At, B1); PG8_BAR;
            PG8_LDB(B0, 1, 0); PG8_SCHED; PG8_LDA(At, 1, 0); PG8_STAGE(PG8_SA(0, 1), a2 + hstep, voffA);
            PG8_WAIT_L(8); PG8_BAR; PG8_WAIT_L(0); PG8_MMA(0, 0, At, B0); PG8_BAR; PG8_SCHED;
            PG8_LDB(B1, 1, 1); PG8_STAGE(PG8_SB(1, 0), b3, voffB);
            PG8_BAR; PG8_WAIT_L(0); PG8_MMA(0, 1, At, B1); PG8_BAR;
            PG8_LDA(At, 1, 1); PG8_STAGE(PG8_SA(1, 0), a3, voffA);
            PG8_BAR; PG8_WAIT_L(0); PG8_MMA(1, 0, At, B0); PG8_BAR; PG8_SCHED;
            PG8_STAGE(PG8_SB(1, 1), b3 + hstep, voffB);
            PG8_WAIT_V(6); PG8_BAR; PG8_MMA(1, 1, At, B1); PG8_BAR;
            }
        }
        if constexpr (ALIGN_EPI) { if (wr == 0) PG8_BAR; }
        if constexpr (!Epi::AFTER_DRAIN) { E(acc, cur, wr, wc, fr, fq); S.done(cur); }
        if (!has_next) break;
#pragma unroll
        for (int a = 0; a < 2; ++a)
#pragma unroll
            for (int b = 0; b < 2; ++b)
#pragma unroll
                for (int m = 0; m < 4; ++m)
#pragma unroll
                    for (int n = 0; n < 2; ++n) acc[a][b][m][n] = (f32x4){0.f, 0.f, 0.f, 0.f};
        cur = nxt; cA = nA; cB = nB; ++ui;
        if constexpr (ALIGN_EPI) { if (wr == 1) PG8_BAR; }
    }
    PG8_WAIT_V(0);
    if constexpr (!ALIGN_EPI) { if (wr == 0) PG8_BAR; }
    PG8_BAR;
    if constexpr (Epi::AFTER_DRAIN) { E.fused(acc, cur, wr, wc, fr, fq, lds, wid, lane); S.done(cur); }
#undef PG8_SA
#undef PG8_SB
#undef PG8_STAGE
#undef PG8_LDA
#undef PG8_LDB
#undef PG8_MMA
#undef PG8_WAIT_V
#undef PG8_WAIT_L
#undef PG8_BAR
#undef PG8_SCHED
}
}
#define GAS __attribute__((address_space(1)))
#define LAS __attribute__((address_space(3)))
typedef unsigned short bf16;
typedef unsigned v4u __attribute__((ext_vector_type(4)));
typedef float f32x4 __attribute__((ext_vector_type(4)));
typedef short bf16x8 __attribute__((ext_vector_type(8)));
typedef GAS unsigned gu32;
typedef GAS unsigned long long gu64;
#define RLX_AGENT __ATOMIC_RELAXED, __HIP_MEMORY_SCOPE_AGENT
#define LDS_WAIT() asm volatile("s_waitcnt lgkmcnt(0)" ::: "memory")
#define VM_WAIT() asm volatile("s_waitcnt vmcnt(0)" ::: "memory")
__device__ __forceinline__ unsigned long long rt() { return __builtin_amdgcn_s_memrealtime(); }
__device__ __forceinline__ unsigned f2bf(float f) { unsigned u = __builtin_bit_cast(unsigned, f); return (u + 0x7fffu + ((u >> 16) & 1u)) >> 16; }
__device__ __forceinline__ unsigned pk2(float lo, float hi) { return f2bf(lo) | (f2bf(hi) << 16); }

#define XB_TMO      128
#define XB_XCNT(j)  (256  + 64 * (j))
#define XB_XSUB(j)  (1280 + 64 * (j))
#define XB_XGEN(j)  (2304 + 64 * (j))
#define XB_TOP      3328
#define XB_TOPGEN   3392
#define XCD_BAR_WORDS 3456
#define XB_SPIN_CAP (1u << 18)

__device__ __forceinline__ unsigned xb_ld(unsigned* p)              { return __hip_atomic_load(p, __ATOMIC_RELAXED, __HIP_MEMORY_SCOPE_AGENT); }
__device__ __forceinline__ unsigned xb_add(unsigned* p, unsigned v) { return __hip_atomic_fetch_add(p, v, __ATOMIC_RELAXED, __HIP_MEMORY_SCOPE_AGENT); }
__device__ __forceinline__ unsigned xb_xcc_id() { return (unsigned)__builtin_amdgcn_s_getreg((3 << 11) | 20) & 0xFu; }
#define XB_SPIN(cond, bar) do { unsigned _sp = 0; while (cond) { __builtin_amdgcn_s_sleep(1); \
    if ((++_sp & 255u) == 0u) { if (xb_ld(&(bar)[XB_TMO])) break; if (_sp > XB_SPIN_CAP) { atomicAdd(&(bar)[XB_TMO], 1u); break; } } } } while (0)

struct XcdBarrier {
    unsigned* bar; unsigned x;
    volatile LAS unsigned* st;
};

__device__ __forceinline__ XcdBarrier xcd_barrier_post(unsigned* bar, volatile LAS unsigned* st) {
    XcdBarrier b; b.bar = bar; b.x = xb_xcc_id(); b.st = st;
    if (threadIdx.x == 0) (void)xb_add(&bar[XB_XCNT(b.x)], 1u);
    return b;
}
__device__ __forceinline__ void xcd_barrier_complete(unsigned* bar, unsigned x, unsigned& nloc, unsigned& nx) {
    const unsigned G = gridDim.x * gridDim.y * gridDim.z;
    unsigned sum, cnt, mine, sp = 0u;
    for (;;) {
        sum = 0u; cnt = 0u; mine = 0u;
#pragma unroll
        for (unsigned j = 0; j < 16; ++j) { const unsigned c = xb_ld(&bar[XB_XCNT(j)]); sum += c; cnt += (c > 0u) ? 1u : 0u; mine = (j == x) ? c : mine; }
        if (sum == G) break;
        __builtin_amdgcn_s_sleep(1);
        if ((++sp & 255u) == 0u) { if (xb_ld(&bar[XB_TMO])) break; if (sp > XB_SPIN_CAP) { atomicAdd(&bar[XB_TMO], 1u); break; } }
    }
    nloc = mine > 0u ? mine : 1u; nx = cnt > 0u ? cnt : 1u;
}

__device__ __forceinline__ void xcd_barrier(const XcdBarrier& b, const bool t0  ) {
    asm volatile("s_waitcnt vmcnt(0)" ::: "memory");
    __syncthreads();
    if (t0) {
        unsigned* bar = b.bar;
        __builtin_amdgcn_s_waitcnt(0);
        unsigned nloc = b.st[0], nx = b.st[1];
        if (nloc == 0u) { xcd_barrier_complete(bar, b.x, nloc, nx); b.st[0] = nloc; b.st[1] = nx; }
        const unsigned old = xb_add(&bar[XB_XSUB(b.x)], 1u);
        const unsigned gen = old / nloc;
        if (old + 1u == (gen + 1u) * nloc) {
            __builtin_amdgcn_fence(__ATOMIC_RELEASE, "agent");
            asm volatile("s_waitcnt vmcnt(0)" ::: "memory");
            const unsigned og = xb_add(&bar[XB_TOP], 1u);
            const unsigned tg = og / nx;
            if (og + 1u == (tg + 1u) * nx) xb_add(&bar[XB_TOPGEN], 1u);
            else XB_SPIN(xb_ld(&bar[XB_TOPGEN]) == tg, bar);
            __builtin_amdgcn_fence(__ATOMIC_ACQUIRE, "agent");
            xb_add(&bar[XB_XGEN(b.x)], 1u);
            asm volatile("s_waitcnt vmcnt(0)" ::: "memory");
        } else {
            XB_SPIN(xb_ld(&bar[XB_XGEN(b.x)]) == gen, bar);
            __builtin_amdgcn_fence(__ATOMIC_ACQUIRE, "agent");
            asm volatile("s_waitcnt vmcnt(0)" ::: "memory");
        }
    }
    __syncthreads();
}

#ifndef PG8_SP2
#define PG8_SP2 true
#endif
#ifndef PG8_ALIGN
#define PG8_ALIGN true
#endif
constexpr int NWAVES = 8;
constexpr int N_STEPS = 38;
#ifndef MK_N_LAUNCHES
#define MK_N_LAUNCHES 1
#endif
#ifndef PH_MASK
#define PH_MASK 0xffff
#endif
#ifndef REP_MASK
#define REP_MASK 0
#endif
#ifndef PREP_REP_LRU
#define PREP_REP_LRU 1
#endif
#ifndef PREP_REP_GDN
#define PREP_REP_GDN 1
#endif
constexpr int N_LAUNCHES = MK_N_LAUNCHES;

constexpr int D = 1024, BATCH = 4, SEQ = 4096, DEPTH = 4, M = BATCH * SEQ;
constexpr int LRUW = 512, NGB = 8, GBW = 64, GH = 4, HD = 128, GDNW = 512, CH = 64, NCH = SEQ / CH, FF = 4096;
constexpr int NMODC = 6 * D, INC = 3080, NPROJ = 3072;
constexpr int O_LX = 0, O_LY = 512, O_Q = 1024, O_Z = 2560;
constexpr float EPS = 1e-6f;

constexpr size_t MiB = 1u << 20;
constexpr size_t WS_CTL = 0, CTL_ZERO_BYTES = 1 * MiB;
constexpr size_t WS_MOD = 1 * MiB;
constexpr size_t WS_BG = 2 * MiB;
constexpr size_t WS_AGG = 3 * MiB;
constexpr size_t WS_CARRY = 4 * MiB;
constexpr size_t WS_GL = 5 * MiB;
constexpr size_t WS_GT = 6 * MiB;
constexpr size_t WS_C1 = 6 * MiB + 512 * 1024;
constexpr size_t WS_C2 = 6 * MiB + 768 * 1024;
constexpr size_t WS_CB8 = 7 * MiB;
constexpr size_t WS_W8T = 7 * MiB + 64 * 1024;
constexpr size_t WS_RS1 = 364 * MiB, WS_RS2 = 365 * MiB;
constexpr size_t WS_A1 = 312 * MiB;
constexpr size_t WS_W = 8 * MiB;
constexpr size_t LAYER_W = (size_t)12288 * 1024;
constexpr size_t W_OUT_OFF = (size_t)3072 * 1024, W_UP_OFF = (size_t)4096 * 1024, W_DOWN_OFF = (size_t)8192 * 1024;
constexpr size_t WS_H = 104 * MiB;
constexpr size_t WS_MIX = 136 * MiB;
constexpr size_t WS_PROJ = 168 * MiB;
constexpr size_t WS_ACT = 168 * MiB;
constexpr size_t WS_GQD = 264 * MiB, WS_GKT = 280 * MiB;
constexpr size_t WS_GATT = 296 * MiB;
constexpr size_t WS_GO = 312 * MiB;
constexpr size_t WS_LRUP = 344 * MiB;
constexpr size_t WS_END = 376 * MiB;
constexpr int CW_BAR = 4096;

constexpr int RING_OFF = 0, RING_BYTES = 155648;
constexpr int LDSCTL_OFF = RING_BYTES, MISC_OFF = LDSCTL_OFF + 320;
constexpr int LDS_BYTES = 156672;

typedef unsigned v2u __attribute__((ext_vector_type(2)));
#define DI __device__ __forceinline__
DI float bf2f(unsigned b) { return __builtin_bit_cast(float, b << 16); }
DI float bflo(unsigned w) { return __builtin_bit_cast(float, w << 16); }
DI float bfhi(unsigned w) { return __builtin_bit_cast(float, w & 0xffff0000u); }
DI float sigmoidf_(float x) { return 1.f / (1.f + expf(-x)); }
DI float siluf_(float x) { return x / (1.f + expf(-x)); }
DI float rcp_(float x) { return __builtin_amdgcn_rcpf(x); }
DI float exp_fast(float x) { return __builtin_amdgcn_exp2f(x * 1.4426950408889634f); }
DI float sigmoid_fast(float x) { return rcp_(1.f + exp_fast(-x)); }
DI float silu_fast(float x) { return x * rcp_(1.f + exp_fast(-x)); }
DI float gelu_tanh(float x) { const float u = 0.7978845608028654f * (x + 0.044715f * x * x * x); return 0.5f * x * (1.f + tanhf(u)); }
DI float bperm_(int src_lane, float v) { return __builtin_bit_cast(float, __builtin_amdgcn_ds_bpermute(src_lane << 2, __builtin_bit_cast(int, v))); }
DI float wave_sum_(int lane, float v) {
#pragma unroll
    for (int o = 1; o < 64; o <<= 1) v += bperm_(lane ^ o, v);
    return v;
}
DI float half_sum_(int lane, float v) {
#pragma unroll
    for (int o = 1; o < 32; o <<= 1) v += bperm_(lane ^ o, v);
    return v;
}
DI float shfl_up_(int lane, float v, int off) { return bperm_(lane >= off ? lane - off : lane, v); }

struct Args { const float* in[23]; float* out; unsigned char* ws; int ph_lo, ph_hi; };
static_assert(sizeof(Args) == 23 * 8 + 8 + 8 + 8, "Args has no padding");
struct Frame {
    LAS unsigned char* lds;
    volatile LAS unsigned* MISC;
    gu32* ctl;
    int tid, lane, wave;
    int vcu, G;
    const __attribute__((address_space(4))) Args* A;
};
#define IN_(k) (F.A->in[k])
#define X_IN IN_(0)
#define C_IN IN_(1)
#define NORM_MIX_W IN_(2)
#define NORM_MLP_W IN_(3)
#define W_MOD IN_(4)
#define B_MOD IN_(5)
#define W_IN IN_(6)
#define LRU_CONV_W IN_(7)
#define LRU_CONV_B IN_(8)
#define GATE_A_W IN_(9)
#define GATE_A_B IN_(10)
#define GATE_X_W IN_(11)
#define GATE_X_B IN_(12)
#define LRU_LAMBDA IN_(13)
#define LRU_NORM_W IN_(14)
#define GDN_CONV_W IN_(15)
#define GDN_A_LOG IN_(16)
#define GDN_DT_BIAS IN_(17)
#define GDN_NORM_W IN_(18)
#define W_OUT IN_(19)
#define W_UP IN_(20)
#define W_DOWN IN_(21)
#define FINAL_NORM_W IN_(22)
#define OUT_ (F.A->out)
#define WSF(off) ((float*)(F.A->ws + (off)))
#define WSH(off) ((bf16*)(F.A->ws + (off)))

DI void p_mod(Frame& F) {
    LAS float* cs = (LAS float*)F.lds;
    LAS float* red = cs + 4096;
    for (int i = F.tid; i < BATCH * D; i += NWAVES * 64) cs[i] = siluf_(C_IN[i]);
    __syncthreads();
    for (int item = F.vcu; item < DEPTH * 96; item += F.G) {
        const int l = item / 96, cg = item % 96, col = cg * 64 + F.lane;
        const float* wp = W_MOD + ((size_t)l * D + F.wave * 128) * NMODC + col;
        float a0 = 0.f, a1 = 0.f, a2 = 0.f, a3 = 0.f;
#pragma unroll 16
        for (int kk = 0; kk < 128; ++kk) { const float wv = wp[(size_t)kk * NMODC]; const int k = F.wave * 128 + kk;
            a0 += cs[k] * wv; a1 += cs[1024 + k] * wv; a2 += cs[2048 + k] * wv; a3 += cs[3072 + k] * wv; }
        red[(F.wave * 4 + 0) * 64 + F.lane] = a0; red[(F.wave * 4 + 1) * 64 + F.lane] = a1; red[(F.wave * 4 + 2) * 64 + F.lane] = a2; red[(F.wave * 4 + 3) * 64 + F.lane] = a3;
        __syncthreads();
        if (F.tid < 256) { const int b = F.tid >> 6, ln = F.tid & 63; float s = 0.f;
#pragma unroll
            for (int w = 0; w < 8; ++w) s += red[(w * 4 + b) * 64 + ln];
            const int cc = cg * 64 + ln; WSF(WS_MOD)[((size_t)l * BATCH + b) * NMODC + cc] = s + B_MOD[(size_t)l * NMODC + cc]; }
        __syncthreads();
    }
}

struct TrItem { const float* src; bf16* dst; int K, ldw; };
DI void p0_item(Frame& F, int it, TrItem& T) {
    constexpr int I_IN = (D / 64) * (NPROJ / 32), I_OUT = (D / 64) * (D / 32), I_UP = (D / 64) * (FF / 32), I_DN = (FF / 64) * (D / 32);
    constexpr int PER_LAYER = I_IN + I_OUT + I_UP + I_DN;
    const int l = it / PER_LAYER; int r = it % PER_LAYER; bf16* wl = WSH(WS_W) + (size_t)l * LAYER_W;
    const float* W; int K, ldw, N; bf16* WT;
    if (r < I_IN) { W = W_IN + (size_t)l * D * INC; K = D; ldw = INC; N = NPROJ; WT = wl; }
    else if ((r -= I_IN) < I_OUT) { W = W_OUT + (size_t)l * D * D; K = D; ldw = D; N = D; WT = wl + W_OUT_OFF; }
    else if ((r -= I_OUT) < I_UP) { W = W_UP + (size_t)l * D * FF; K = D; ldw = FF; N = FF; WT = wl + W_UP_OFF; }
    else { r -= I_UP; W = W_DOWN + (size_t)l * FF * D; K = FF; ldw = D; N = D; WT = wl + W_DOWN_OFF; }
    const int nblk = N / 32, kb = r / nblk, nb = r % nblk, k0 = 64 * kb, n0 = 32 * nb;
    T.src = W + (size_t)k0 * ldw + n0; T.dst = WT + (size_t)n0 * K + k0; T.K = K; T.ldw = ldw;
}
DI void p0_weights(Frame& F) {
    LAS float* scr = (LAS float*)(F.lds + RING_OFF + F.wave * 16384);
    const int gw = F.vcu * NWAVES + F.wave, NGW = F.G * NWAVES, lane = F.lane;
    constexpr int NIT = DEPTH * ((D / 64) * (NPROJ / 32) + (D / 64) * (D / 32) + (D / 64) * (FF / 32) + (FF / 64) * (D / 32));
    TrItem T; f32x4 v[8];
    if (gw < NIT) { p0_item(F, gw, T);
#pragma unroll
        for (int i = 0; i < 8; ++i) v[i] = *(const f32x4*)(T.src + (size_t)((lane >> 3) + 8 * i) * T.ldw + 4 * (lane & 7)); }
    for (int it = gw; it < NIT; it += NGW) {
        TrItem Tn; f32x4 vn[8]; const int itn = it + NGW < NIT ? it + NGW : it;
        p0_item(F, itn, Tn);
#pragma unroll
        for (int i = 0; i < 8; ++i) vn[i] = *(const f32x4*)(Tn.src + (size_t)((lane >> 3) + 8 * i) * Tn.ldw + 4 * (lane & 7));
#pragma unroll
        for (int i = 0; i < 8; ++i) { LAS float* d = scr + ((lane >> 3) + 8 * i) * 33 + 4 * (lane & 7); d[0] = v[i].x; d[1] = v[i].y; d[2] = v[i].z; d[3] = v[i].w; }
        LDS_WAIT(); asm volatile("" ::: "memory");
        const int c = lane & 7;
#pragma unroll
        for (int j = 0; j < 4; ++j) { const int n = (lane >> 3) + 8 * j; const LAS float* sp = scr + (8 * c) * 33 + n;
            v4u o; o.x = pk2(sp[0 * 33], sp[1 * 33]); o.y = pk2(sp[2 * 33], sp[3 * 33]); o.z = pk2(sp[4 * 33], sp[5 * 33]); o.w = pk2(sp[6 * 33], sp[7 * 33]);
            *(v4u*)(T.dst + (size_t)n * T.K + 8 * c) = o; }
        LDS_WAIT(); asm volatile("" ::: "memory");
        T = Tn;
#pragma unroll
        for (int i = 0; i < 8; ++i) v[i] = vn[i];
    }
    for (int o = (int)blockIdx.x * NWAVES * 64 + F.tid; o < DEPTH * 16 * 1024; o += (int)gridDim.x * NWAVES * 64) {
        const int k = o & 1023, j = (o >> 10) & 15, l = o >> 14;
        WSH(WS_W8T)[o] = (bf16)(j < 8 ? f2bf(W_IN[((size_t)l * D + k) * INC + NPROJ + j]) : 0u);
    }
    for (int o = (int)blockIdx.x * NWAVES * 64 + F.tid; o < DEPTH * 2 * NGB * 4096; o += (int)gridDim.x * NWAVES * 64) {
        const int i = o & 63, j = (o >> 6) & 63, g = (o >> 12) & 7, gate = (o >> 15) & 1, l = o >> 16;
        const float* src = gate ? GATE_X_W : GATE_A_W;
        WSH(WS_GT)[o] = (bf16)f2bf(src[(size_t)(l * NGB + g) * 4096 + i * 64 + j]);
    }
}

DI void p_cvec(Frame& F) {
    const int gw = F.vcu * NWAVES + F.wave, NGW = F.G * NWAVES, lane = F.lane;
    constexpr int IT_IN = NPROJ / 16, IT_UP = FF / 16, PER_L = IT_IN + IT_UP;
    for (int it = gw; it < DEPTH * PER_L; it += NGW) {
        const int l = it / PER_L, r = it % PER_L, which = r >= IT_IN, rg = which ? r - IT_IN : r, N = which ? FF : NPROJ;
        const bf16* wt = WSH(WS_W) + (size_t)l * LAYER_W + (which ? W_UP_OFF : 0) + (size_t)(rg * 16) * 1024 + 16 * lane;
        const float* shb = WSF(WS_MOD) + (size_t)l * BATCH * NMODC + (which ? 3 * D : 0) + 16 * lane;
        float* cout = (which ? WSF(WS_C2) + (size_t)l * BATCH * FF : WSF(WS_C1) + (size_t)l * BATCH * NPROJ) + rg * 16;
        f32x4 sh[4][4];
#pragma unroll
        for (int b = 0; b < 4; ++b)
#pragma unroll
            for (int j = 0; j < 4; ++j) sh[b][j] = *(const f32x4*)(shb + (size_t)b * NMODC + 4 * j);
        float v[64];
#pragma unroll
        for (int row = 0; row < 16; ++row) { const v4u w0 = *(const v4u*)(wt + (size_t)row * 1024), w1 = *(const v4u*)(wt + (size_t)row * 1024 + 8);
            const f32x4 wa = (f32x4){bflo(w0.x), bfhi(w0.x), bflo(w0.y), bfhi(w0.y)}, wb = (f32x4){bflo(w0.z), bfhi(w0.z), bflo(w0.w), bfhi(w0.w)};
            const f32x4 wc = (f32x4){bflo(w1.x), bfhi(w1.x), bflo(w1.y), bfhi(w1.y)}, wd = (f32x4){bflo(w1.z), bfhi(w1.z), bflo(w1.w), bfhi(w1.w)};
#pragma unroll
            for (int b = 0; b < 4; ++b) { const f32x4 t = sh[b][0] * wa + sh[b][1] * wb + sh[b][2] * wc + sh[b][3] * wd; v[row * 4 + b] = (t[0] + t[1]) + (t[2] + t[3]); } }
#pragma unroll
        for (int st = 0; st < 6; ++st) { const int bit = 1 << st; const bool up = lane & bit;
#pragma unroll
            for (int i = 0; i < (32 >> st); ++i) { const float keep = up ? v[2 * i + 1] : v[2 * i], send = up ? v[2 * i] : v[2 * i + 1]; v[i] = keep + bperm_(lane ^ bit, send); } }
        cout[(size_t)(lane & 3) * N + (lane >> 2)] = v[0];
    }
    if (gw < DEPTH * BATCH) { const int l = gw >> 2, b = gw & 3; float a[8];
#pragma unroll
        for (int j = 0; j < 8; ++j) a[j] = 0.f;
        for (int kk = 0; kk < 16; ++kk) { const int k = 16 * lane + kk; const float shv = WSF(WS_MOD)[((size_t)l * BATCH + b) * NMODC + k];
#pragma unroll
            for (int j = 0; j < 8; ++j) a[j] += shv * W_IN[((size_t)l * D + k) * INC + NPROJ + j]; }
#pragma unroll
        for (int j = 0; j < 8; ++j) a[j] = wave_sum_(lane, a[j]);
        if (lane < 8) { float r = a[0];
#pragma unroll
            for (int j = 1; j < 8; ++j) r = (lane == j) ? a[j] : r;
            WSF(WS_CB8)[(size_t)gw * 8 + lane] = r; } }
}

template <bool WITH_BG>
DI void p_normmod(Frame& F, int l, const float* xin, const float* normw, int off_sh, int off_sc) {
    LAS float* w8 = (LAS float*)F.lds;
    if (WITH_BG) {
        for (int i = F.tid; i < D * 8; i += NWAVES * 64) w8[i] = W_IN[((size_t)l * D + (i >> 3)) * INC + NPROJ + (i & 7)];
        __syncthreads();
    }
    const int gw = F.vcu * NWAVES + F.wave, NGW = F.G * NWAVES, lane = F.lane;
    f32x4 v[4];
    if (gw < M) {
#pragma unroll
        for (int j = 0; j < 4; ++j) v[j] = *(const f32x4*)(xin + (size_t)gw * D + 4 * lane + 256 * j);
    }
    for (int m = gw; m < M; m += NGW) {
        const int b = m >> 12, mn = m + NGW;
        f32x4 vnx[4];
#pragma unroll
        for (int j = 0; j < 4; ++j) vnx[j] = (mn < M) ? *(const f32x4*)(xin + (size_t)mn * D + 4 * lane + 256 * j) : (f32x4){0.f, 0.f, 0.f, 0.f};
        const float* modp = WSF(WS_MOD) + ((size_t)l * BATCH + b) * NMODC;
        float ss = 0.f;
#pragma unroll
        for (int j = 0; j < 4; ++j) ss += (v[j].x * v[j].x + v[j].y * v[j].y) + (v[j].z * v[j].z + v[j].w * v[j].w);
        ss = wave_sum_(lane, ss);
        const float rstd = 1.0f / sqrtf(ss * (1.0f / D) + EPS);
        float a0 = 0.f, a1 = 0.f, a2 = 0.f, a3 = 0.f, a4 = 0.f, a5 = 0.f, a6 = 0.f, a7 = 0.f;
#pragma unroll
        for (int j = 0; j < 4; ++j) {
            const int col = 4 * lane + 256 * j;
            const f32x4 nw = *(const f32x4*)(normw + (size_t)l * D + col), sc = *(const f32x4*)(modp + off_sc + col), sh = *(const f32x4*)(modp + off_sh + col);
            const f32x4 hv = v[j] * rstd * nw * (sc + 1.0f) + sh;
            v2u o; o.x = pk2(hv.x, hv.y); o.y = pk2(hv.z, hv.w);
            *(v2u*)(WSH(WS_H) + (size_t)m * D + col) = o;
            if (WITH_BG) {
#pragma unroll
                for (int e = 0; e < 4; ++e) { const f32x4 wa = *(const LAS f32x4*)(w8 + (col + e) * 8), wb = *(const LAS f32x4*)(w8 + (col + e) * 8 + 4); const float hh = hv[e];
                    a0 += hh * wa.x; a1 += hh * wa.y; a2 += hh * wa.z; a3 += hh * wa.w; a4 += hh * wb.x; a5 += hh * wb.y; a6 += hh * wb.z; a7 += hh * wb.w; }
            }
        }
        if (WITH_BG) {
            const bool b0 = lane & 1, b1 = lane & 2, b2 = lane & 4;
            float k0 = b0 ? a1 : a0, k1 = b0 ? a3 : a2, k2 = b0 ? a5 : a4, k3 = b0 ? a7 : a6;
            k0 += bperm_(lane ^ 1, b0 ? a0 : a1); k1 += bperm_(lane ^ 1, b0 ? a2 : a3); k2 += bperm_(lane ^ 1, b0 ? a4 : a5); k3 += bperm_(lane ^ 1, b0 ? a6 : a7);
            float c0 = b1 ? k1 : k0, c1 = b1 ? k3 : k2;
            c0 += bperm_(lane ^ 2, b1 ? k0 : k1); c1 += bperm_(lane ^ 2, b1 ? k2 : k3);
            float d = b2 ? c1 : c0;
            d += bperm_(lane ^ 4, b2 ? c0 : c1);
            d += bperm_(lane ^ 8, d); d += bperm_(lane ^ 16, d); d += bperm_(lane ^ 32, d);
            if (lane < 8) {
                const int hh = lane & 3;
                float r;
                if (lane < 4) r = sigmoidf_(d);
                else { const float xx = d + GDN_DT_BIAS[l * GH + hh]; const float sp = xx > 20.f ? xx : log1pf(expf(xx)); r = -expf(GDN_A_LOG[l * GH + hh]) * sp; }
                WSF(WS_BG)[(size_t)m * 8 + lane] = r;
            }
        }
#pragma unroll
        for (int j = 0; j < 4; ++j) v[j] = vnx[j];
    }
}

typedef float f32x2_t __attribute__((ext_vector_type(2))); typedef __bf16 bf16x2_t __attribute__((ext_vector_type(2)));
DI unsigned cvtpk(float lo, float hi) { f32x2_t v = {lo, hi}; bf16x2_t b = __builtin_convertvector(v, bf16x2_t); return __builtin_bit_cast(unsigned, b); }
DI bf16x8 pack8(f32x4 a, f32x4 b) { v4u p; p.x = cvtpk(a.x, a.y); p.y = cvtpk(a.z, a.w); p.z = cvtpk(b.x, b.y); p.w = cvtpk(b.z, b.w); return __builtin_bit_cast(bf16x8, p); }
DI bf16x8 ldfrag(const LAS unsigned char* p) { const v2u lo = *(const LAS v2u*)p, hi = *(const LAS v2u*)(p + 32); v4u r; r.x = lo.x; r.y = lo.y; r.z = hi.x; r.w = hi.y; return __builtin_bit_cast(bf16x8, r); }
#define MFMA16(a, b, c) __builtin_amdgcn_mfma_f32_16x16x32_bf16((a), (b), (c), 0, 0, 0)

DI bf16x8 ld128(const LAS unsigned char* p) { return *(const LAS bf16x8*)p; }
DI int kperm4(int k4) { return k4 < 16 ? 2 * k4 : 2 * (k4 - 16) + 4; }
DI int kperm(int k) { return (k & ~31) + kperm4(k & 28) + (k & 3); }
constexpr int PG_QB = 0, PG_KB = 17408, PG_KBET = 34816, PG_VT = 53248, PG_LS = 71680, PG_TS = 89088, PG_TB = 106496, PG_ATT = 115712, PG_XS = 124928, PG_SM = 128000, PG_END = 129024, PG_BGS = 140288;
static_assert(PG_END <= RING_BYTES && PG_BGS >= 8 * 17408 && PG_BGS + 2048 <= RING_BYTES, "prep LDS map");
DI void p_prep(Frame& F, int l) {
    const int wave = F.wave;
#define PREP_IDS int tid_ = F.tid; asm volatile("" : "+v"(tid_)); const int tid = tid_, lane = tid & 63, m = lane & 15, q = lane >> 4; (void)m; (void)q;
    for (int item = blockIdx.x; item < BATCH * NCH; item += gridDim.x) {
        const int b = item / NCH, n = item % NCH, row0 = b * SEQ + n * CH, t0 = n * CH;
        LAS float* bgs = (LAS float*)(F.lds + PG_BGS);
        if (l > 0 && wave < 4) {
            PREP_IDS
            const int mt = wave;
            const bf16* a1 = WSH(WS_A1) + (size_t)(row0 + 16 * mt + m) * D + 8 * q;
            const bf16* w8t = WSH(WS_W8T) + (size_t)l * 16 * 1024 + (size_t)m * 1024 + 8 * q;
            f32x4 acc = (f32x4){0.f, 0.f, 0.f, 0.f};
#pragma unroll 16
            for (int kb = 0; kb < 32; ++kb) acc = MFMA16(*(const bf16x8*)(a1 + 32 * kb), *(const bf16x8*)(w8t + 32 * kb), acc);
            if (m < 8) { const int hh = m & 3; const float cb = WSF(WS_CB8)[((size_t)l * BATCH + b) * 8 + m], dtb = GDN_DT_BIAS[l * GH + hh], alog = GDN_A_LOG[l * GH + hh];
#pragma unroll
                for (int r = 0; r < 4; ++r) { const int t = 16 * mt + 4 * q + r; const f32x4* rp = (const f32x4*)(WSF(WS_RS1) + (size_t)(row0 + t) * 16);
                    const f32x4 p0 = rp[0], p1 = rp[1], p2 = rp[2], p3 = rp[3], ts = (p0 + p1) + (p2 + p3);
                    const float rstd = 1.0f / sqrtf(((ts[0] + ts[1]) + (ts[2] + ts[3])) * (1.0f / D) + EPS), v = acc[r] * rstd + cb;
                    float res;
                    if (m < 4) res = sigmoidf_(v); else { const float xx = v + dtb; const float sp = xx > 20.f ? xx : log1pf(expf(xx)); res = -expf(alog) * sp; }
                    bgs[t * 8 + m] = res; } }
        }
        for (int rep_ = 0; rep_ < PREP_REP_LRU; ++rep_) {
            PREP_IDS
            const int g = wave;
            LAS float* xr = (LAS float*)(F.lds + wave * 17408);
            const int tg = lane >> 3, cg = lane & 7, c0 = 8 * cg, cc0 = g * 64 + c0;
            v4u xp[11];
#pragma unroll
            for (int i = 0; i < 11; ++i) { const int tt = t0 + 8 * tg - 3 + i;
                xp[i] = (tt >= 0) ? *(const v4u*)(WSH(WS_PROJ) + (size_t)(b * SEQ + tt) * NPROJ + O_LX + cc0) : (v4u){0u, 0u, 0u, 0u}; }
            f32x4 wl_[4], wh_[4];
#pragma unroll
            for (int k = 0; k < 4; ++k) { wl_[k] = *(const f32x4*)(LRU_CONV_W + ((size_t)l * 4 + k) * LRUW + cc0); wh_[k] = *(const f32x4*)(LRU_CONV_W + ((size_t)l * 4 + k) * LRUW + cc0 + 4); }
            const f32x4 bl_ = *(const f32x4*)(LRU_CONV_B + l * LRUW + cc0), bh_ = *(const f32x4*)(LRU_CONV_B + l * LRUW + cc0 + 4);
            bf16x8 Bf[2][4][2];
#pragma unroll
            for (int gate = 0; gate < 2; ++gate)
#pragma unroll
                for (int nt = 0; nt < 4; ++nt)
#pragma unroll
                    for (int ks = 0; ks < 2; ++ks) Bf[gate][nt][ks] = *(const bf16x8*)(WSH(WS_GT) + ((size_t)((l * 2 + gate) * NGB + g)) * 4096 + (size_t)(16 * nt + m) * 64 + 32 * ks + 8 * q);
            float ba_[4], bx_[4], ls_[4];
#pragma unroll
            for (int nt = 0; nt < 4; ++nt) { const int cc = g * 64 + 16 * nt + m; ba_[nt] = GATE_A_B[l * LRUW + cc]; bx_[nt] = GATE_X_B[l * LRUW + cc];
                const float lam = LRU_LAMBDA[l * LRUW + cc]; ls_[nt] = -8.0f * (fmaxf(-lam, 0.f) + log1pf(expf(-fabsf(lam)))); }
#pragma unroll
            for (int tt = 0; tt < 8; ++tt) { f32x4 al = bl_, ah = bh_;
#pragma unroll
                for (int k = 0; k < 4; ++k) { const v4u xw = xp[tt + k];
                    al += wl_[k] * (f32x4){bflo(xw.x), bfhi(xw.x), bflo(xw.y), bfhi(xw.y)}; ah += wh_[k] * (f32x4){bflo(xw.z), bfhi(xw.z), bflo(xw.w), bfhi(xw.w)}; }
                *(LAS f32x4*)(xr + (8 * tg + tt) * 68 + c0) = al; *(LAS f32x4*)(xr + (8 * tg + tt) * 68 + c0 + 4) = ah; }
            asm volatile("s_waitcnt lgkmcnt(0)" ::: "memory");
            bf16x8 Af[4][2];
#pragma unroll
            for (int mt = 0; mt < 4; ++mt)
#pragma unroll
                for (int ks = 0; ks < 2; ++ks) { const LAS float* pp = xr + (16 * mt + m) * 68 + 32 * ks + 8 * q; Af[mt][ks] = pack8(*(const LAS f32x4*)pp, *(const LAS f32x4*)(pp + 4)); }
#pragma unroll
            for (int nt = 0; nt < 4; ++nt) {
                float av[4][4], bv[4][4];
#pragma unroll
                for (int mt = 0; mt < 4; ++mt) { f32x4 ra = (f32x4){0.f, 0.f, 0.f, 0.f}, ia = (f32x4){0.f, 0.f, 0.f, 0.f};
                    ra = MFMA16(Af[mt][0], Bf[0][nt][0], ra); ra = MFMA16(Af[mt][1], Bf[0][nt][1], ra);
                    ia = MFMA16(Af[mt][0], Bf[1][nt][0], ia); ia = MFMA16(Af[mt][1], Bf[1][nt][1], ia);
#pragma unroll
                    for (int r = 0; r < 4; ++r) { const float rr = sigmoid_fast(ra[r] + ba_[nt]), ig = sigmoid_fast(ia[r] + bx_[nt]);
                        const float log_a = rr * ls_[nt], aa = exp_fast(log_a), mult = __builtin_amdgcn_sqrtf(fmaxf(1.0f - exp_fast(2.0f * log_a), 1e-12f));
                        av[mt][r] = aa; bv[mt][r] = mult * (ig * xr[(16 * mt + 4 * q + r) * 68 + 16 * nt + m]); } }
                float iP[4], iH[4];
#pragma unroll
                for (int mt = 0; mt < 4; ++mt) {
#pragma unroll
                    for (int r = 1; r < 4; ++r) { bv[mt][r] = av[mt][r] * bv[mt][r - 1] + bv[mt][r]; av[mt][r] = av[mt][r] * av[mt][r - 1]; }
                    float PA = av[mt][3], HA = bv[mt][3];
                    { const float Pp = shfl_up_(lane, PA, 16), Hp = shfl_up_(lane, HA, 16); if (q >= 1) { HA = PA * Hp + HA; PA = PA * Pp; } }
                    { const float Pp = shfl_up_(lane, PA, 32), Hp = shfl_up_(lane, HA, 32); if (q >= 2) { HA = PA * Hp + HA; PA = PA * Pp; } }
                    iP[mt] = PA; iH[mt] = HA; }
                float CP = 1.f, CH = 0.f;
#pragma unroll
                for (int mt = 0; mt < 4; ++mt) {
                    const float totP = bperm_(m + 48, iP[mt]), totH = bperm_(m + 48, iH[mt]);
                    float exP = shfl_up_(lane, iP[mt], 16), exH = shfl_up_(lane, iH[mt], 16); if (q == 0) { exP = 1.f; exH = 0.f; }
                    const float EP = CP * exP, EH = exP * CH + exH;
#pragma unroll
                    for (int r = 0; r < 4; ++r) { const float Pf = EP * av[mt][r], Hf = av[mt][r] * EH + bv[mt][r];
                        *(LAS unsigned*)(xr + (16 * mt + 4 * q + r) * 68 + 16 * nt + m) = f2bf(Hf) | (f2bf(Pf) << 16); }
                    CH = totP * CH + totH; CP = CP * totP; }
                if (q == 0) { WSF(WS_AGG)[((size_t)(b * NCH + n)) * LRUW + g * 64 + 16 * nt + m] = CP; WSF(WS_AGG)[(size_t)BATCH * NCH * LRUW + ((size_t)(b * NCH + n)) * LRUW + g * 64 + 16 * nt + m] = CH; }
            }
            asm volatile("s_waitcnt lgkmcnt(0)" ::: "memory");
#pragma unroll
            for (int i = 0; i < 16; ++i) { const int pz = lane + 64 * i, row = pz >> 4, c16 = pz & 15;
                *(v4u*)((unsigned*)(F.A->ws + WS_H) + (size_t)(row0 + row) * LRUW + g * 64 + 4 * c16) = *(const LAS v4u*)(xr + row * 68 + 4 * c16); }
        }
        __syncthreads();
        {
            LAS unsigned char* qb = F.lds + PG_QB;
            LAS unsigned char* kb = F.lds + PG_KB;
            LAS unsigned char* kbeT = F.lds + PG_KBET;
            LAS unsigned char* vT = F.lds + PG_VT;
            LAS float* Ls = (LAS float*)(F.lds + PG_LS);
            LAS float* Ts = (LAS float*)(F.lds + PG_TS);
            LAS unsigned char* Tb = F.lds + PG_TB;
            LAS unsigned char* atts = F.lds + PG_ATT;
            LAS float* Xs = (LAS float*)(F.lds + PG_XS);
            LAS float* sm4 = (LAS float*)(F.lds + PG_SM);
            if (wave < GH) { int tl_ = F.tid; asm volatile("" : "+v"(tl_)); const int ln = tl_ & 63, hh = wave;
                float gcv = l > 0 ? bgs[ln * 8 + 4 + hh] : WSF(WS_BG)[(size_t)(row0 + ln) * 8 + 4 + hh];
#pragma unroll
                for (int off = 1; off < 64; off <<= 1) { const float pv = shfl_up_(ln, gcv, off); if (ln >= off) gcv += pv; }
                const float glast = bperm_(63, gcv);
                sm4[hh * 256 + ln] = gcv; sm4[hh * 256 + 64 + ln] = l > 0 ? bgs[ln * 8 + hh] : WSF(WS_BG)[(size_t)(row0 + ln) * 8 + hh]; sm4[hh * 256 + 128 + ln] = expf(gcv); sm4[hh * 256 + 192 + ln] = expf(glast - gcv); }
            __syncthreads();
            for (int h_ = 0; h_ < GH * PREP_REP_GDN; ++h_) { const int h = h_ % GH;
                PREP_IDS
                const size_t item4 = (size_t)(b * GH + h) * NCH + n;
                LAS float* sgc = sm4 + h * 256, *sbeta = sgc + 64, *seg = sgc + 128, *sel = sgc + 192;
                if (tid < 384) {
                    const int cgp = tid & 15, wt = tid >> 4, which = wt >> 3, tr = wt & 7, d0 = cgp * 8, ch0 = which * GDNW + h * HD + d0;
                    v4u xp[11];
#pragma unroll
                    for (int i = 0; i < 11; ++i) { const int tt = t0 + tr * 8 - 3 + i;
                        xp[i] = (tt >= 0) ? *(const v4u*)(WSH(WS_PROJ) + (size_t)(b * SEQ + tt) * NPROJ + O_Q + ch0) : (v4u){0u, 0u, 0u, 0u}; }
                    f32x4 wl_[4], wh_[4];
#pragma unroll
                    for (int k = 0; k < 4; ++k) { wl_[k] = *(const f32x4*)(GDN_CONV_W + ((size_t)l * 4 + k) * (3 * GDNW) + ch0); wh_[k] = *(const f32x4*)(GDN_CONV_W + ((size_t)l * 4 + k) * (3 * GDNW) + ch0 + 4); }
                    f32x4 ol[8], oh[8]; float ss[8];
#pragma unroll
                    for (int tt = 0; tt < 8; ++tt) { f32x4 al = (f32x4){0.f, 0.f, 0.f, 0.f}, ah = (f32x4){0.f, 0.f, 0.f, 0.f};
#pragma unroll
                        for (int k = 0; k < 4; ++k) { const v4u xw = xp[tt + k];
                            al += wl_[k] * (f32x4){bflo(xw.x), bfhi(xw.x), bflo(xw.y), bfhi(xw.y)}; ah += wh_[k] * (f32x4){bflo(xw.z), bfhi(xw.z), bflo(xw.w), bfhi(xw.w)}; }
#pragma unroll
                        for (int c = 0; c < 4; ++c) { al[c] = silu_fast(al[c]); ah[c] = silu_fast(ah[c]); }
                        ol[tt] = al; oh[tt] = ah;
                        ss[tt] = (al.x * al.x + al.y * al.y) + (al.z * al.z + al.w * al.w) + (ah.x * ah.x + ah.y * ah.y) + (ah.z * ah.z + ah.w * ah.w); }
                    if (which < 2) {
#pragma unroll
                        for (int tt = 0; tt < 8; ++tt) { float v = ss[tt]; v += bperm_(lane ^ 1, v); v += bperm_(lane ^ 2, v); v += bperm_(lane ^ 4, v); v += bperm_(lane ^ 8, v);
                            const float scl = __builtin_amdgcn_rsqf(v + 1e-6f) * (which == 0 ? 0.08838834764831845f : 1.0f); ol[tt] = ol[tt] * scl; oh[tt] = oh[tt] * scl; }
                    }
                    const int tb = tr * 8;
                    if (which == 0) {
#pragma unroll
                        for (int tt = 0; tt < 8; ++tt) { const int t = tb + tt; const float eg = seg[t];
                            v4u pk; pk.x = cvtpk(ol[tt].x, ol[tt].y); pk.y = cvtpk(ol[tt].z, ol[tt].w); pk.z = cvtpk(oh[tt].x, oh[tt].y); pk.w = cvtpk(oh[tt].z, oh[tt].w);
                            *(LAS v4u*)(qb + t * 272 + d0 * 2) = pk;
                            v4u pg; pg.x = cvtpk(ol[tt].x * eg, ol[tt].y * eg); pg.y = cvtpk(ol[tt].z * eg, ol[tt].w * eg); pg.z = cvtpk(oh[tt].x * eg, oh[tt].y * eg); pg.w = cvtpk(oh[tt].z * eg, oh[tt].w * eg);
                            { bf16* qrow = WSH(WS_GQD) + item4 * 8192 + t * 128 + (d0 & ~31); const int kl = d0 & 31;
                                v2u p0; p0.x = pg.x; p0.y = pg.y; v2u p1; p1.x = pg.z; p1.y = pg.w; *(v2u*)(qrow + kperm4(kl)) = p0; *(v2u*)(qrow + kperm4(kl + 4)) = p1; } }
                    } else if (which == 1) {
                        float fb[8], fl[8];
#pragma unroll
                        for (int tt = 0; tt < 8; ++tt) { const int t = tb + tt; fb[tt] = sbeta[t] * seg[t]; fl[tt] = sel[t];
                            v4u pk; pk.x = cvtpk(ol[tt].x, ol[tt].y); pk.y = cvtpk(ol[tt].z, ol[tt].w); pk.z = cvtpk(oh[tt].x, oh[tt].y); pk.w = cvtpk(oh[tt].z, oh[tt].w);
                            *(LAS v4u*)(kb + t * 272 + d0 * 2) = pk; }
#pragma unroll
                        for (int c = 0; c < 8; ++c) {
#define KV_(tt) ((c) < 4 ? ol[tt][(c) & 3] : oh[tt][(c) & 3])
                            v4u pe; pe.x = cvtpk(KV_(0) * fb[0], KV_(1) * fb[1]); pe.y = cvtpk(KV_(2) * fb[2], KV_(3) * fb[3]); pe.z = cvtpk(KV_(4) * fb[4], KV_(5) * fb[5]); pe.w = cvtpk(KV_(6) * fb[6], KV_(7) * fb[7]);
                            *(LAS v4u*)(kbeT + (d0 + c) * 144 + tb * 2) = pe;
                            v4u pt; pt.x = cvtpk(KV_(0) * fl[0], KV_(1) * fl[1]); pt.y = cvtpk(KV_(2) * fl[2], KV_(3) * fl[3]); pt.z = cvtpk(KV_(4) * fl[4], KV_(5) * fl[5]); pt.w = cvtpk(KV_(6) * fl[6], KV_(7) * fl[7]);
                            { bf16* krow = WSH(WS_GKT) + item4 * 8192 + (d0 + c) * 64 + (tb & ~31); const int kl = tb & 31;
                                v2u p0; p0.x = pt.x; p0.y = pt.y; v2u p1; p1.x = pt.z; p1.y = pt.w; *(v2u*)(krow + kperm4(kl)) = p0; *(v2u*)(krow + kperm4(kl + 4)) = p1; } }
                    } else {
                        float fb[8];
#pragma unroll
                        for (int tt = 0; tt < 8; ++tt) fb[tt] = sbeta[tb + tt];
#pragma unroll
                        for (int c = 0; c < 8; ++c) {
                            v4u pe; pe.x = cvtpk(KV_(0) * fb[0], KV_(1) * fb[1]); pe.y = cvtpk(KV_(2) * fb[2], KV_(3) * fb[3]); pe.z = cvtpk(KV_(4) * fb[4], KV_(5) * fb[5]); pe.w = cvtpk(KV_(6) * fb[6], KV_(7) * fb[7]);
                            *(LAS v4u*)(vT + (d0 + c) * 144 + tb * 2) = pe; }
#undef KV_
                    }
                }
                __syncthreads();
                {
                    const int it = wave >> 1;
#pragma unroll
                    for (int jj = 0; jj < 2; ++jj) { const int jt = (wave & 1) * 2 + jj;
                        f32x4 kk = (f32x4){0.f, 0.f, 0.f, 0.f}, qk = (f32x4){0.f, 0.f, 0.f, 0.f};
                        if (jt <= it) {
#pragma unroll
                            for (int ks = 0; ks < 4; ++ks) { const bf16x8 Bk = ld128(kb + (16 * jt + m) * 272 + (32 * ks + 8 * q) * 2);
                                kk = MFMA16(ld128(kb + (16 * it + m) * 272 + (32 * ks + 8 * q) * 2), Bk, kk); qk = MFMA16(ld128(qb + (16 * it + m) * 272 + (32 * ks + 8 * q) * 2), Bk, qk); } }
                        const int j = 16 * jt + m; const float gj = sgc[j];
#pragma unroll
                        for (int r = 0; r < 4; ++r) { const int i = 16 * it + 4 * q + r;
                            const float dec = (j <= i) ? exp_fast(sgc[i] - gj) : 0.f;
                            Ls[i * 68 + j] = (j < i) ? sbeta[i] * kk[r] * dec : 0.f;
                            *(LAS unsigned short*)(atts + i * 144 + kperm(j) * 2) = (unsigned short)f2bf((j <= i) ? qk[r] * dec : 0.f); } }
                }
                __syncthreads();
                if (tid < 64) { const int bk = tid >> 4, c = tid & 15; float x[16];
                    const LAS float* lb = Ls + (16 * bk) * 68 + 16 * bk;
#pragma unroll
                    for (int r = 0; r < 16; ++r) { float acc = (r == c) ? 1.f : 0.f;
#pragma unroll
                        for (int m4 = 0; m4 < (r + 3) / 4; ++m4) { const f32x4 lv = *(const LAS f32x4*)(lb + r * 68 + 4 * m4);
                            if (4 * m4 + 0 < r) acc -= lv.x * x[4 * m4 + 0]; if (4 * m4 + 1 < r) acc -= lv.y * x[4 * m4 + 1]; if (4 * m4 + 2 < r) acc -= lv.z * x[4 * m4 + 2]; if (4 * m4 + 3 < r) acc -= lv.w * x[4 * m4 + 3]; }
                        x[r] = acc; Ts[(16 * bk + r) * 68 + 16 * bk + c] = acc; } }
                __syncthreads();
#pragma unroll 1
                for (int dl = 1; dl < 4; ++dl) {
                    const int nout = (4 - dl) * 256;
                    for (int idx = tid; idx < nout; idx += NWAVES * 64) { const int blk = idx >> 8, r = (idx >> 4) & 15, c = idx & 15, i = blk + dl, j = blk; float acc = 0.f;
                        const LAS float* lrow = Ls + (16 * i + r) * 68 + 16 * j; const LAS float* tcol = Ts + (16 * j) * 68 + 16 * j + c;
                        for (int kk = 0; kk < dl; ++kk) {
#pragma unroll
                            for (int mm = 0; mm < 16; mm += 4) { const f32x4 lv = *(const LAS f32x4*)(lrow + 16 * kk + mm); const LAS float* tc = tcol + (16 * kk + mm) * 68;
                                acc += lv.x * tc[0] + lv.y * tc[68] + lv.z * tc[136] + lv.w * tc[204]; } }
                        Xs[idx] = acc; }
                    __syncthreads();
                    for (int idx = tid; idx < nout; idx += NWAVES * 64) { const int blk = idx >> 8, r = (idx >> 4) & 15, c = idx & 15, i = blk + dl, j = blk; float acc = 0.f;
                        const LAS float* trow = Ts + (16 * i + r) * 68 + 16 * i; const LAS float* xc = Xs + blk * 256 + c;
#pragma unroll
                        for (int mm = 0; mm < 16; mm += 4) { const f32x4 tv = *(const LAS f32x4*)(trow + mm); acc -= tv.x * xc[(mm + 0) * 16] + tv.y * xc[(mm + 1) * 16] + tv.z * xc[(mm + 2) * 16] + tv.w * xc[(mm + 3) * 16]; }
                        Ts[(16 * i + r) * 68 + 16 * j + c] = acc; }
                    __syncthreads();
                }
#pragma unroll
                for (int e = 0; e < 8; ++e) { const int idx = tid + 512 * e, i = idx >> 6, j = idx & 63;
                    *(LAS unsigned short*)(Tb + i * 144 + j * 2) = (unsigned short)(((j >> 4) <= (i >> 4)) ? f2bf(Ts[i * 68 + j]) : 0u); }
                __syncthreads();
                {
                    const int nt = wave;
#pragma unroll
                    for (int mt = 0; mt < 4; ++mt) { f32x4 ua = (f32x4){0.f, 0.f, 0.f, 0.f}, wa = (f32x4){0.f, 0.f, 0.f, 0.f};
#pragma unroll
                        for (int ks = 0; ks < 2; ++ks) if (32 * ks <= 16 * mt + 15) { const bf16x8 A = ld128(Tb + (16 * mt + m) * 144 + (32 * ks + 8 * q) * 2);
                            ua = MFMA16(A, ld128(vT + (16 * nt + m) * 144 + (32 * ks + 8 * q) * 2), ua); wa = MFMA16(A, ld128(kbeT + (16 * nt + m) * 144 + (32 * ks + 8 * q) * 2), wa); }
unsigned uts[4];
#pragma unroll
                        for (int r = 0; r < 4; ++r) { const int t = 16 * mt + 4 * q + r, d = 16 * nt + m;
                            uts[r] = f2bf(ua[r]); *(LAS unsigned short*)(kb + t * 272 + kperm(d) * 2) = (unsigned short)f2bf(-wa[r]); }
                        { v2u pu; pu.x = uts[0] | (uts[1] << 16); pu.y = uts[2] | (uts[3] << 16); *(LAS v2u*)(F.lds + PG_LS + (16 * nt + m) * 144 + (16 * mt + 4 * q) * 2) = pu; } }
                }
                __syncthreads();
#pragma unroll
                for (int e = 0; e < 2; ++e) { const int p = tid + 512 * e, row = p >> 4, c16 = p & 15;
                    *(v4u*)((unsigned char*)(WSH(WS_MIX + 16 * MiB) + item4 * 8192) + row * 256 + c16 * 16) = *(const LAS v4u*)(kb + row * 272 + c16 * 16);
                    const int ur = p >> 3, uc = p & 7;
                    *(v4u*)((unsigned char*)(WSH(WS_MIX) + item4 * 8192) + ur * 128 + uc * 16) = *(const LAS v4u*)(F.lds + PG_LS + ur * 144 + uc * 16); }
                { const int row = tid >> 3, c16 = tid & 7;
                    *(v4u*)((unsigned char*)(WSH(WS_GATT) + item4 * 4096) + row * 128 + c16 * 16) = *(const LAS v4u*)(atts + row * 144 + c16 * 16); }
                if (tid == 0) WSF(WS_GL)[item4] = seg[63];
                __syncthreads();
            }
        }
    }
}

#undef PREP_IDS
constexpr int SC_W = 0, SC_QD = 18432, SC_KT = 36864, SC_AT = 57344, SC_U = 67584, SC_STAGE = 76800;
static_assert(2 * SC_STAGE <= RING_BYTES, "scan stages fit the ring");
#define SBAR_() __builtin_amdgcn_sched_barrier(0)
#define WG_BAR() do { asm volatile("s_waitcnt lgkmcnt(0)" ::: "memory"); __builtin_amdgcn_s_barrier(); asm volatile("" ::: "memory"); } while (0)
constexpr int NSEG = 8, SEGC = NCH / NSEG;
constexpr size_t WS_PSI = 344 * MiB;
constexpr size_t WS_PHI = 352 * MiB;
constexpr size_t WS_SST = 356 * MiB;
static_assert(WS_SST + 8 * MiB <= WS_END, "two-level scan scratch");

#define SC_ADDR() \
        const unsigned char* gW = (const unsigned char*)(WSH(WS_MIX + 16 * MiB) + it0 * 8192); \
        const unsigned char* gQD = (const unsigned char*)(WSH(WS_GQD) + it0 * 8192); \
        const unsigned char* gKT = (const unsigned char*)(WSH(WS_GKT) + it0 * 8192); \
        const unsigned char* gAT = (const unsigned char*)(WSH(WS_GATT) + it0 * 4096); \
        const unsigned char* gU = (const unsigned char*)(WSH(WS_MIX) + it0 * 8192) + dvbase * 128;
#define SC_LOAD(rg, n_) do { const size_t cb = (size_t)(n_) * 16384, ca = (size_t)(n_) * 8192; \
            _Pragma("unroll") for (int i = 0; i < 4; ++i) { rg[i] = *(const v4u*)(gW + cb + gofW + i * 4096); if (FULL) rg[4 + i] = *(const v4u*)(gQD + cb + gofW + i * 4096); \
                rg[8 + i] = *(const v4u*)(gKT + cb + gofK + i * 4096); } \
            _Pragma("unroll") for (int i = 0; i < 2; ++i) { if (FULL) rg[12 + i] = *(const v4u*)(gAT + ca + gofK + i * 4096); rg[14 + i] = *(const v4u*)(gU + cb + gofK + i * 4096); } } while (0)
#define SC_WRITE(rg, buf_) do { LAS unsigned char* sb_ = F.lds + (buf_) * SC_STAGE; \
            _Pragma("unroll") for (int i = 0; i < 4; ++i) { *(LAS v4u*)(sb_ + SC_W + lofW + i * (16 * 288)) = rg[i]; if (FULL) *(LAS v4u*)(sb_ + SC_QD + lofW + i * (16 * 288)) = rg[4 + i]; \
                *(LAS v4u*)(sb_ + SC_KT + lofK + i * (32 * 160)) = rg[8 + i]; } \
            _Pragma("unroll") for (int i = 0; i < 2; ++i) { if (FULL) *(LAS v4u*)(sb_ + SC_AT + lofK + i * (32 * 160)) = rg[12 + i]; *(LAS v4u*)(sb_ + SC_U + lofU + i * (32 * 144)) = rg[14 + i]; } } while (0)
#define SC_LOADER_LOOP() do { \
            int lt_ = F.tid & 255; asm volatile("" : "+v"(lt_)); \
            const int gofW = (lt_ >> 4) * 256 + (lt_ & 15) * 16, gofK = (lt_ >> 3) * 128 + (lt_ & 7) * 16; \
            const int lofW = (lt_ >> 4) * 288 + (lt_ & 15) * 16, lofK = (lt_ >> 3) * 160 + (lt_ & 7) * 16, lofU = (lt_ >> 3) * 144 + (lt_ & 7) * 16; \
            const int nlast = n0 + SEGC - 1; \
            v4u ra[16], rb[16]; \
            SC_LOAD(ra, n0); SC_WRITE(ra, 0); SC_LOAD(ra, n0 + 1); SC_LOAD(rb, n0 + 2); \
            __syncthreads(); \
            _Pragma("unroll 1") for (int j = 0; j < SEGC; j += 2) { \
                  \
                  \
                SC_WRITE(ra, 1); \
                { const int nn = n0 + j + 3 < nlast ? n0 + j + 3 : nlast; SC_LOAD(ra, nn); } \
                WG_BAR(); \
                SC_WRITE(rb, 0); \
                { const int nn = n0 + j + 4 < nlast ? n0 + j + 4 : nlast; SC_LOAD(rb, nn); } \
                WG_BAR(); \
            } } while (0)

DI void p_scan1(Frame& F, int l) {
    constexpr bool FULL = false;
    const int wave = F.wave;
    { const int lane = F.lane;
        for (int p = blockIdx.x * NWAVES + wave; p < BATCH * LRUW; p += gridDim.x * NWAVES) { const int b = p / LRUW, c = p % LRUW;
            float A = WSF(WS_AGG)[((size_t)(b * NCH + lane)) * LRUW + c], B = WSF(WS_AGG)[(size_t)BATCH * NCH * LRUW + ((size_t)(b * NCH + lane)) * LRUW + c];
#pragma unroll
            for (int off = 1; off < 64; off <<= 1) { const float Ap = shfl_up_(lane, A, off), Bp = shfl_up_(lane, B, off); if (lane >= off) { B = A * Bp + B; A = A * Ap; } }
            if (lane < 63) WSF(WS_CARRY)[((size_t)(b * NCH + lane + 1)) * LRUW + c] = B; else WSF(WS_CARRY)[((size_t)(b * NCH)) * LRUW + c] = 0.f; } }
    const bool is_loader = wave >= 4;
    const int wv = wave & 3;
    for (int job = F.vcu; job < BATCH * GH * NSEG * 2; job += F.G) {
        const int bh = job >> 4, seg = (job >> 1) & (NSEG - 1), dvbase = (job & 1) * 64, n0 = seg * SEGC;
        const size_t it0 = (size_t)bh * NCH;
        SC_ADDR()
        (void)gQD; (void)gAT;
        if (seg == NSEG - 1) { __syncthreads(); continue; }
        if (is_loader) { SC_LOADER_LOOP(); }
        else {
            int tc_ = F.tid; asm volatile("" : "+v"(tc_)); const int lane = tc_ & 63, m = lane & 15, q = lane >> 4;
            const int col = dvbase + 16 * wv + m;
            f32x4 Sacc[2][8];
#pragma unroll
            for (int dt = 0; dt < 8; ++dt) { Sacc[0][dt] = (f32x4){0.f, 0.f, 0.f, 0.f};
#pragma unroll
                for (int r = 0; r < 4; ++r) Sacc[1][dt][r] = (16 * dt + 4 * q + r == col) ? 1.f : 0.f; }
            const float glv = WSF(WS_GL)[it0 + lane];
            __syncthreads();
#pragma unroll 1
            for (int j = 0; j < SEGC; ++j) {
                const LAS unsigned char* B = F.lds + (j & 1) * SC_STAGE;
                bf16x8 fa[4], fb[4], Sb[2][4], vnb[2][2];
                f32x4 vn[2][4];
                v2u ut[4];
#pragma unroll
                for (int mt = 0; mt < 4; ++mt) ut[mt] = *(const LAS v2u*)(B + SC_U + (16 * wv + m) * 144 + (16 * mt + 4 * q) * 2);
#define LDW4(dst, mt_) do { _Pragma("unroll") for (int kb = 0; kb < 4; ++kb) dst[kb] = ld128(B + SC_W + (16 * (mt_) + m) * 288 + (32 * kb + 8 * q) * 2); } while (0)
#define MMW2(src, mt_) do { _Pragma("unroll") for (int kb = 0; kb < 4; ++kb) { vn[0][mt_] = MFMA16(src[kb], Sb[0][kb], vn[0][mt_]); vn[1][mt_] = MFMA16(src[kb], Sb[1][kb], vn[1][mt_]); } } while (0)
#define LDK4(dst, dt_) do { dst[0] = ld128(B + SC_KT + (16 * (dt_) + m) * 160 + (8 * q) * 2); dst[1] = ld128(B + SC_KT + (16 * (dt_) + m) * 160 + (32 + 8 * q) * 2); \
                            dst[2] = ld128(B + SC_KT + (16 * ((dt_) + 1) + m) * 160 + (8 * q) * 2); dst[3] = ld128(B + SC_KT + (16 * ((dt_) + 1) + m) * 160 + (32 + 8 * q) * 2); } while (0)
#define MMK2(src, dt_) do { _Pragma("unroll") for (int e = 0; e < 2; ++e) { Sacc[e][dt_] = MFMA16(src[0], vnb[e][0], Sacc[e][dt_]); Sacc[e][dt_] = MFMA16(src[1], vnb[e][1], Sacc[e][dt_]); \
                            Sacc[e][(dt_) + 1] = MFMA16(src[2], vnb[e][0], Sacc[e][(dt_) + 1]); Sacc[e][(dt_) + 1] = MFMA16(src[3], vnb[e][1], Sacc[e][(dt_) + 1]); } } while (0)
                LDW4(fa, 0); SBAR_();
#pragma unroll
                for (int e = 0; e < 2; ++e)
#pragma unroll
                    for (int kb = 0; kb < 4; ++kb) Sb[e][kb] = pack8(Sacc[e][2 * kb], Sacc[e][2 * kb + 1]);
#pragma unroll
                for (int mt = 0; mt < 4; ++mt) { vn[0][mt] = (f32x4){bflo(ut[mt].x), bfhi(ut[mt].x), bflo(ut[mt].y), bfhi(ut[mt].y)}; vn[1][mt] = (f32x4){0.f, 0.f, 0.f, 0.f}; }
                const float gl = __builtin_bit_cast(float, __builtin_amdgcn_readlane(__builtin_bit_cast(int, glv), n0 + j));
                SBAR_(); LDW4(fb, 1); SBAR_(); MMW2(fa, 0); SBAR_();
                LDW4(fa, 2); SBAR_(); MMW2(fb, 1); SBAR_();
                LDW4(fb, 3); SBAR_(); MMW2(fa, 2); SBAR_();
                LDK4(fa, 0); SBAR_(); MMW2(fb, 3); SBAR_();
#pragma unroll
                for (int e = 0; e < 2; ++e) { vnb[e][0] = pack8(vn[e][0], vn[e][1]); vnb[e][1] = pack8(vn[e][2], vn[e][3]);
#pragma unroll
                    for (int dt = 0; dt < 8; ++dt) Sacc[e][dt] = Sacc[e][dt] * gl; }
                SBAR_(); LDK4(fb, 2); SBAR_(); MMK2(fa, 0); SBAR_();
                LDK4(fa, 4); SBAR_(); MMK2(fb, 2); SBAR_();
                LDK4(fb, 6); SBAR_(); MMK2(fa, 4); SBAR_();
                MMK2(fb, 6); SBAR_();
                WG_BAR();
            }
#undef LDW4
#undef MMW2
#undef LDK4
#undef MMK2
            float* psi = WSF(WS_PSI) + ((size_t)(bh * NSEG + seg) * 128) * 128 + col;
            bf16* phi = WSH(WS_PHI) + ((size_t)(bh * NSEG + seg) * 128) * 128 + kperm(col);
#pragma unroll
            for (int dt = 0; dt < 8; ++dt)
#pragma unroll
                for (int r = 0; r < 4; ++r) { const int dk = 16 * dt + 4 * q + r; psi[(size_t)dk * 128] = Sacc[0][dt][r]; phi[(size_t)dk * 128] = (bf16)f2bf(Sacc[1][dt][r]); }
        }
        __syncthreads();
    }
}

DI void p_scan2(Frame& F, int l) {
    const int wave = F.wave;
    for (int bh = blockIdx.x; bh < BATCH * GH; bh += gridDim.x) {
        int tc_ = F.tid; asm volatile("" : "+v"(tc_)); const int tid = tc_, lane = tc_ & 63, m = lane & 15, q = lane >> 4;
        const int col = 16 * wave + m;
        const int gof = (tid >> 4) * 256 + (tid & 15) * 16, lof = (tid >> 4) * 288 + (tid & 15) * 16;
        const unsigned char* phi0 = (const unsigned char*)(WSH(WS_PHI) + ((size_t)(bh * NSEG) * 128) * 128);
        const float* psi0 = WSF(WS_PSI) + ((size_t)(bh * NSEG) * 128) * 128 + col;
        float* sst0 = WSF(WS_SST) + ((size_t)(bh * NSEG) * 128) * 128 + col;
        f32x4 S[8], Ps[8]; v4u pr[4];
#pragma unroll
        for (int dt = 0; dt < 8; ++dt) { S[dt] = (f32x4){0.f, 0.f, 0.f, 0.f};
#pragma unroll
            for (int r = 0; r < 4; ++r) Ps[dt][r] = psi0[(size_t)(16 * dt + 4 * q + r) * 128]; }
#pragma unroll
        for (int i = 0; i < 4; ++i) pr[i] = *(const v4u*)(phi0 + gof + i * 8192);
#pragma unroll
        for (int i = 0; i < 4; ++i) *(LAS v4u*)(F.lds + lof + i * (32 * 288)) = pr[i];
        __syncthreads();
#pragma unroll 1
        for (int seg = 0; seg + 1 < NSEG; ++seg) {
            if (seg > 0) {
#pragma unroll
                for (int dt = 0; dt < 8; ++dt)
#pragma unroll
                    for (int r = 0; r < 4; ++r) sst0[((size_t)seg * 128 + 16 * dt + 4 * q + r) * 128] = S[dt][r]; }
            const int sn = seg + 2 < NSEG ? seg + 1 : seg;
#pragma unroll
            for (int i = 0; i < 4; ++i) pr[i] = *(const v4u*)(phi0 + (size_t)sn * 32768 + gof + i * 8192);
            f32x4 Pn[8];
#pragma unroll
            for (int dt = 0; dt < 8; ++dt)
#pragma unroll
                for (int r = 0; r < 4; ++r) Pn[dt][r] = psi0[((size_t)sn * 128 + 16 * dt + 4 * q + r) * 128];
            const LAS unsigned char* B = F.lds + (seg & 1) * 36864;
            bf16x8 Sb[4];
#pragma unroll
            for (int kb = 0; kb < 4; ++kb) Sb[kb] = pack8(S[2 * kb], S[2 * kb + 1]);
#pragma unroll
            for (int dt = 0; dt < 8; ++dt) { f32x4 acc = Ps[dt];
#pragma unroll
                for (int kb = 0; kb < 4; ++kb) acc = MFMA16(ld128(B + (16 * dt + m) * 288 + (32 * kb + 8 * q) * 2), Sb[kb], acc);
                S[dt] = acc; }
#pragma unroll
            for (int dt = 0; dt < 8; ++dt) Ps[dt] = Pn[dt];
#pragma unroll
            for (int i = 0; i < 4; ++i) *(LAS v4u*)(F.lds + ((seg + 1) & 1) * 36864 + lof + i * (32 * 288)) = pr[i];
            __syncthreads();
        }
#pragma unroll
        for (int dt = 0; dt < 8; ++dt)
#pragma unroll
            for (int r = 0; r < 4; ++r) sst0[((size_t)(NSEG - 1) * 128 + 16 * dt + 4 * q + r) * 128] = S[dt][r];
        __syncthreads();
    }
}

DI void p_scan3(Frame& F, int l) {
    constexpr bool FULL = true;
    const int wave = F.wave;
    const bool is_loader = wave >= 4;
    const int wv = wave & 3;
    for (int job = F.vcu; job < BATCH * GH * NSEG * 2; job += F.G) {
        const int bh = job >> 4, seg = (job >> 1) & (NSEG - 1), dvbase = (job & 1) * 64, n0 = seg * SEGC, b = bh >> 2, h = bh & 3;
        const size_t it0 = (size_t)bh * NCH;
        SC_ADDR()
        if (is_loader) { SC_LOADER_LOOP(); }
        else {
            int tc_ = F.tid; asm volatile("" : "+v"(tc_)); const int lane = tc_ & 63, m = lane & 15, q = lane >> 4;
            f32x4 Sacc[8];
            if (seg == 0) {
#pragma unroll
                for (int dt = 0; dt < 8; ++dt) Sacc[dt] = (f32x4){0.f, 0.f, 0.f, 0.f};
            } else { const float* sst = WSF(WS_SST) + ((size_t)(bh * NSEG + seg) * 128) * 128 + dvbase + 16 * wv + m;
#pragma unroll
                for (int dt = 0; dt < 8; ++dt)
#pragma unroll
                    for (int r = 0; r < 4; ++r) Sacc[dt][r] = sst[(size_t)(16 * dt + 4 * q + r) * 128]; }
            const float glv = WSF(WS_GL)[it0 + lane];
            __syncthreads();
#define FR_W(dst, mt_) do { _Pragma("unroll") for (int kb = 0; kb < 4; ++kb) { dst[kb] = ld128(B + SC_W + (16 * (mt_) + m) * 288 + (32 * kb + 8 * q) * 2); dst[4 + kb] = ld128(B + SC_QD + (16 * (mt_) + m) * 288 + (32 * kb + 8 * q) * 2); } } while (0)
#define MM_W(src, mt_) do { _Pragma("unroll") for (int kb = 0; kb < 4; ++kb) { vn[mt_] = MFMA16(src[kb], Sb[kb], vn[mt_]); o[mt_] = MFMA16(src[4 + kb], Sb[kb], o[mt_]); } } while (0)
#define FR_KT(dst, hf_) do { _Pragma("unroll") for (int i = 0; i < 8; ++i) dst[i] = ld128(B + SC_KT + (16 * (4 * (hf_) + (i >> 1)) + m) * 160 + (32 * (i & 1) + 8 * q) * 2); } while (0)
#define MM_KT(src, hf_) do { _Pragma("unroll") for (int i = 0; i < 8; ++i) Sacc[4 * (hf_) + (i >> 1)] = MFMA16(src[i], vnb[i & 1], Sacc[4 * (hf_) + (i >> 1)]); } while (0)
#pragma unroll 1
            for (int j = 0; j < SEGC; ++j) {
                const int n = n0 + j;
                const LAS unsigned char* B = F.lds + (j & 1) * SC_STAGE;
                bf16x8 fa[8], fb[8], Sb[4], vnb[2];
                f32x4 vn[4], o[4];
                v2u ut[4];
#pragma unroll
                for (int mt = 0; mt < 4; ++mt) ut[mt] = *(const LAS v2u*)(B + SC_U + (16 * wv + m) * 144 + (16 * mt + 4 * q) * 2);
                FR_W(fa, 0); SBAR_();
#pragma unroll
                for (int kb = 0; kb < 4; ++kb) Sb[kb] = pack8(Sacc[2 * kb], Sacc[2 * kb + 1]);
#pragma unroll
                for (int mt = 0; mt < 4; ++mt) { o[mt] = (f32x4){0.f, 0.f, 0.f, 0.f}; vn[mt] = (f32x4){bflo(ut[mt].x), bfhi(ut[mt].x), bflo(ut[mt].y), bfhi(ut[mt].y)}; }
                const float gl = __builtin_bit_cast(float, __builtin_amdgcn_readlane(__builtin_bit_cast(int, glv), n));
                SBAR_(); FR_W(fb, 1); SBAR_(); MM_W(fa, 0); SBAR_();
                FR_W(fa, 2); SBAR_(); MM_W(fb, 1); SBAR_();
                FR_W(fb, 3); SBAR_(); MM_W(fa, 2); SBAR_();
                fa[0] = ld128(B + SC_AT + (m) * 160 + (8 * q) * 2); fa[1] = ld128(B + SC_AT + (16 + m) * 160 + (8 * q) * 2);
                fa[2] = ld128(B + SC_AT + (32 + m) * 160 + (8 * q) * 2); fa[3] = ld128(B + SC_AT + (32 + m) * 160 + (32 + 8 * q) * 2);
                fa[4] = ld128(B + SC_AT + (48 + m) * 160 + (8 * q) * 2); fa[5] = ld128(B + SC_AT + (48 + m) * 160 + (32 + 8 * q) * 2);
                SBAR_(); MM_W(fb, 3); SBAR_();
                vnb[0] = pack8(vn[0], vn[1]); vnb[1] = pack8(vn[2], vn[3]);
#pragma unroll
                for (int dt = 0; dt < 8; ++dt) Sacc[dt] = Sacc[dt] * gl;
                SBAR_(); FR_KT(fb, 0); SBAR_();
                o[0] = MFMA16(fa[0], vnb[0], o[0]); o[1] = MFMA16(fa[1], vnb[0], o[1]); o[2] = MFMA16(fa[2], vnb[0], o[2]); o[3] = MFMA16(fa[4], vnb[0], o[3]);
                o[2] = MFMA16(fa[3], vnb[1], o[2]); o[3] = MFMA16(fa[5], vnb[1], o[3]);
                SBAR_(); FR_KT(fa, 1); SBAR_(); MM_KT(fb, 0); SBAR_();
                MM_KT(fa, 1); SBAR_();
                float* go = WSF(WS_GO) + (size_t)(b * SEQ + n * CH + 4 * q) * GDNW + h * HD + dvbase + 16 * wv + m;
#pragma unroll
                for (int mt = 0; mt < 4; ++mt)
#pragma unroll
                    for (int r = 0; r < 4; ++r) go[(size_t)(16 * mt + r) * GDNW] = o[mt][r];
                WG_BAR();
            }
#undef FR_W
#undef MM_W
#undef FR_KT
#undef MM_KT
        }
        __syncthreads();
    }
}
#undef SC_ADDR
#undef SC_LOAD
#undef SC_WRITE
#undef SC_LOADER_LOOP

DI float gelu_fast(float x) { const float u2 = 1.5957691216057308f * (x + 0.044715f * x * x * x); return x * rcp_(1.f + exp_fast(-u2)); }
struct PostRow { v4u hp[2]; v2u y2[2], z2[2]; f32x4 go[2], cr[2]; };
DI void post_load(Frame& F, PostRow& R, int m, int lane) {
    const int b = m >> 12, n = (m & (SEQ - 1)) >> 6;
#pragma unroll
    for (int j = 0; j < 2; ++j) { const int c = 4 * lane + 256 * j;
        R.hp[j] = *(const v4u*)((const unsigned*)(F.A->ws + WS_H) + (size_t)m * LRUW + c);
        R.cr[j] = *(const f32x4*)(WSF(WS_CARRY) + ((size_t)(b * NCH + n)) * LRUW + c);
        R.y2[j] = *(const v2u*)(WSH(WS_PROJ) + (size_t)m * NPROJ + O_LY + c);
        R.go[j] = *(const f32x4*)(WSF(WS_GO) + (size_t)m * GDNW + c);
        R.z2[j] = *(const v2u*)(WSH(WS_PROJ) + (size_t)m * NPROJ + O_Z + c); }
}
DI void p_post(Frame& F, int l) {
    const int gw = F.vcu * NWAVES + F.wave, NGW = F.G * NWAVES, lane = F.lane;
    PostRow R;
    if (gw < M) post_load(F, R, gw, lane);
    for (int m = gw; m < M; m += NGW) {
        PostRow Rn; const int mn = m + NGW;
        post_load(F, Rn, mn < M ? mn : m, lane);
        f32x4 val[2]; float ss = 0.f;
#pragma unroll
        for (int j = 0; j < 2; ++j) { const v4u hp = R.hp[j]; const v2u y2 = R.y2[j];
            const f32x4 hl = (f32x4){bflo(hp.x), bflo(hp.y), bflo(hp.z), bflo(hp.w)}, p = (f32x4){bfhi(hp.x), bfhi(hp.y), bfhi(hp.z), bfhi(hp.w)};
            const f32x4 hh = hl + p * R.cr[j];
            val[j] = (f32x4){hh.x * gelu_fast(bflo(y2.x)), hh.y * gelu_fast(bfhi(y2.x)), hh.z * gelu_fast(bflo(y2.y)), hh.w * gelu_fast(bfhi(y2.y))};
            ss += (val[j].x * val[j].x + val[j].y * val[j].y) + (val[j].z * val[j].z + val[j].w * val[j].w); }
        ss = wave_sum_(lane, ss);
        const float rl = 1.0f / sqrtf(ss * (1.0f / LRUW) + EPS);
#pragma unroll
        for (int j = 0; j < 2; ++j) { const int c = 4 * lane + 256 * j; const f32x4 nw = *(const f32x4*)(LRU_NORM_W + (size_t)l * LRUW + c);
            const f32x4 o = val[j] * rl * nw; v2u w; w.x = pk2(o.x, o.y); w.y = pk2(o.z, o.w); *(v2u*)(WSH(WS_MIX) + (size_t)m * D + c) = w; }
#pragma unroll
        for (int j = 0; j < 2; ++j) { const int c = 4 * lane + 256 * j, d = c & (HD - 1);
            const f32x4 o = R.go[j]; const v2u z2 = R.z2[j];
            const float s2 = half_sum_(lane, (o.x * o.x + o.y * o.y) + (o.z * o.z + o.w * o.w));
            const float rg = 1.0f / sqrtf(s2 * (1.0f / HD) + EPS);
            const f32x4 nw = *(const f32x4*)(GDN_NORM_W + (size_t)l * HD + d);
            const f32x4 r = (f32x4){o.x * rg * nw.x * silu_fast(bflo(z2.x)), o.y * rg * nw.y * silu_fast(bfhi(z2.x)), o.z * rg * nw.z * silu_fast(bflo(z2.y)), o.w * rg * nw.w * silu_fast(bfhi(z2.y))};
            v2u w; w.x = pk2(r.x, r.y); w.y = pk2(r.z, r.w); *(v2u*)(WSH(WS_MIX) + (size_t)m * D + LRUW + c) = w; }
        R = Rn;
    }
}

DI void p_final(Frame& F) {
    const int gw = F.vcu * NWAVES + F.wave, NGW = F.G * NWAVES, lane = F.lane;
    for (int m = gw; m < M; m += NGW) {
        f32x4 v[4]; float ss = 0.f;
#pragma unroll
        for (int j = 0; j < 4; ++j) { v[j] = *(const f32x4*)(OUT_ + (size_t)m * D + 4 * lane + 256 * j); ss += (v[j].x * v[j].x + v[j].y * v[j].y) + (v[j].z * v[j].z + v[j].w * v[j].w); }
        ss = wave_sum_(F.lane, ss);
        const float rstd = 1.0f / sqrtf(ss * (1.0f / D) + EPS);
#pragma unroll
        for (int j = 0; j < 4; ++j) { const int col = 4 * lane + 256 * j; const f32x4 nw = *(const f32x4*)(FINAL_NORM_W + col); *(f32x4*)(OUT_ + (size_t)m * D + col) = v[j] * rstd * nw; }
    }
}

__device__ __forceinline__ void pg8::EpiMulti::operator()(const f32x4 (&acc)[2][2][4][2], const Unit& u, int wr, int wc, int fr, int fq) const {
    const __attribute__((address_space(4))) Args* ap = (const __attribute__((address_space(4))) Args*)__builtin_amdgcn_kernarg_segment_ptr(); asm volatile("" : "+s"(ap));
    unsigned char* ws = ap->ws;
    const int b = (u.pm * BM) / SEQ;
    if (mode == 0) { EpiBf16<0> e{(bf16_t*)(ws + WS_PROJ), NPROJ, nullptr, 0, 0, 1.f, nullptr}; e(acc, u, wr, wc, fr, fq); }
    else if (mode == 5) { EpiBf16<0> e{(bf16_t*)(ws + WS_PROJ), NPROJ, (const float*)(ws + WS_C1) + ((size_t)l * BATCH + b) * NPROJ, 0, 0, 1.f, (const float*)(ws + WS_RS1)}; e(acc, u, wr, wc, fr, fq); }
    else if (mode == 6) { EpiBf16<2> e{(bf16_t*)(ws + WS_ACT), FF, (const float*)(ws + WS_C2) + ((size_t)l * BATCH + b) * FF, 0, 0, 1.f, (const float*)(ws + WS_RS2)}; e(acc, u, wr, wc, fr, fq); }
    else if (mode == 3) { const float* modb = (const float*)(ws + WS_MOD) + ((size_t)l * BATCH + b) * NMODC;
        EpiResid2 r{l == 0 ? ap->in[0] : ap->out, ap->out, modb + 2 * D, ap->in[3] + (size_t)l * D, modb + 4 * D, (bf16_t*)(ws + WS_H), (float*)(ws + WS_RS2)}; r(acc, u, wr, wc, fr, fq); }
    else { const float* modb = (const float*)(ws + WS_MOD) + ((size_t)l * BATCH + b) * NMODC; const bool nx = l + 1 < DEPTH;
        EpiResid2 r{ap->out, ap->out, modb + 5 * D, nx ? ap->in[2] + (size_t)(l + 1) * D : nullptr, modb + NMODC * BATCH + D, (bf16_t*)(ws + WS_A1), (float*)(ws + WS_RS1)}; r(acc, u, wr, wc, fr, fq); }
}

__global__ void __launch_bounds__(NWAVES * 64, 2) mk_fwd(Args args) {
    extern __shared__ __attribute__((aligned(16))) unsigned char lds[];
    Frame F;
    F.lds = (LAS unsigned char*)lds;
    F.MISC = (volatile LAS unsigned*)(F.lds + MISC_OFF);
    F.tid = threadIdx.x; F.lane = F.tid & 63; F.wave = __builtin_amdgcn_readfirstlane(F.tid >> 6);
    F.G = gridDim.x; { const int bx = blockIdx.x; F.vcu = (F.G % 8 == 0) ? (bx % 8) * (F.G / 8) + bx / 8 : bx; }
    F.A = (const __attribute__((address_space(4))) Args*)__builtin_amdgcn_kernarg_segment_ptr();
    F.ctl = (gu32*)(F.A->ws + WS_CTL);
    for (int u = F.tid; u < (LDS_BYTES - LDSCTL_OFF) / 4; u += NWAVES * 64) ((LAS unsigned*)(F.lds + LDSCTL_OFF))[u] = 0u;
    __syncthreads();
    XcdBarrier bar; bar.bar = (unsigned*)(F.ctl + CW_BAR); bar.x = 0; bar.st = nullptr;
    if (N_LAUNCHES == 1) bar = xcd_barrier_post((unsigned*)(F.ctl + CW_BAR), F.MISC + 8);

    const int lo = F.A->ph_lo, hi = F.A->ph_hi;
    int rep_done = 0;
#pragma unroll 1
    for (int s = lo; s < hi; ++s) {
        { const __attribute__((address_space(4))) Args* ap = (const __attribute__((address_space(4))) Args*)__builtin_amdgcn_kernarg_segment_ptr(); asm volatile("" : "+s"(ap)); F.A = ap; }
        { int t_ = threadIdx.x; asm volatile("" : "+v"(t_)); F.tid = t_; F.lane = t_ & 63; F.wave = __builtin_amdgcn_readfirstlane(t_ >> 6); }
        if (s == 0) { if (PH_MASK & 1) { p_mod(F); __syncthreads(); p0_weights(F); xcd_barrier(bar, F.tid == 0); p_cvec(F); } }
        else if (s == N_STEPS - 1) { if (PH_MASK & 2) p_final(F); }
        else {
            const int l = (s - 1) / 9, i = (s - 1) % 9;
            if ((i == 0 && l > 0) || i == 6) continue;
            bf16* wl = WSH(WS_W) + (size_t)l * LAYER_W;
            const float* modl = WSF(WS_MOD) + (size_t)l * BATCH * NMODC;
            if (!((PH_MASK >> (2 + i)) & 1)) {}
            else if (i == 0) { p_normmod<true>(F, l, l == 0 ? X_IN : OUT_, NORM_MIX_W, 0, D); }
            else if (i == 2) { p_prep(F, l); }
            else if (i == 3) {
                p_scan1(F, l); xcd_barrier(bar, F.tid == 0);
#if defined(SCAN_REP) && SCAN_REP == 1
                p_scan1(F, l); xcd_barrier(bar, F.tid == 0);
#endif
                p_scan2(F, l); xcd_barrier(bar, F.tid == 0);
#if defined(SCAN_REP) && SCAN_REP == 2
                p_scan2(F, l); xcd_barrier(bar, F.tid == 0);
#endif
                p_scan3(F, l);
#if defined(SCAN_REP) && SCAN_REP == 3
                xcd_barrier(bar, F.tid == 0); p_scan3(F, l);
#endif
            }
            else if (i == 4) { p_post(F, l); }
            else if (i == 6) { p_normmod<false>(F, l, OUT_, NORM_MLP_W, 3 * D, 4 * D); }
            else {
                pg8::Gemm g; pg8::EpiMulti E; E.l = l;
                if (i == 1) { g = pg8::Gemm{l == 0 ? WSH(WS_H) : WSH(WS_A1), wl, M, NPROJ, D}; E.PERM = true; E.mode = (l == 0 ? 0 : 5); }
                else if (i == 5) { g = pg8::Gemm{WSH(WS_MIX), wl + W_OUT_OFF, M, D, D}; E.PERM = true; E.mode = 3; }
                else if (i == 7) { g = pg8::Gemm{WSH(WS_H), wl + W_UP_OFF, M, FF, D}; E.PERM = true; E.mode = 6; }
                else { g = pg8::Gemm{WSH(WS_ACT), wl + W_DOWN_OFF, M, D, FF}; E.PERM = true; E.mode = 4; }
                pg8::StaticOrder S; S.init(g.M, g.N, F.G, (int)blockIdx.x);
                pg8::gemm_phase<pg8::EpiMulti, pg8::StaticOrder, PG8_ALIGN, PG8_SP2>(F.lds + RING_OFF, g, S, E);
            }
        }
        if (REP_MASK != 0 && ((s >= 1 && s < N_STEPS - 1 && ((REP_MASK >> ((s - 1) % 9)) & 1)) || (s == 0 && (REP_MASK & 0x10000))) && !rep_done) { rep_done = 1; --s; xcd_barrier(bar, F.tid == 0); continue; }
        rep_done = 0;
        if (s + 1 < hi) xcd_barrier(bar, F.tid == 0);
#ifdef PROBE_XBAR
        if (s >= 1 && s < N_STEPS - 1) { xcd_barrier(bar, F.tid == 0); xcd_barrier(bar, F.tid == 0); }
#endif
    }
}

extern "C" void kernel_launch(void* const* d_in, const int* in_sizes, int n_in, void* d_out, int out_size, void* d_ws, size_t ws_size, hipStream_t stream) {
    static int grid = 0;
    if (grid == 0) {
        if (n_in != 23 || in_sizes[0] != M * D || out_size != M * D || ws_size < WS_END) { fprintf(stderr, "kernel_launch: unexpected shapes (n_in %d, in0 %d, out %d, ws %zu); nothing launched\n", n_in, n_in > 0 ? in_sizes[0] : -1, out_size, ws_size); grid = -1; return; }
        int dev = 0, cus = 0;
        if (hipGetDevice(&dev) != hipSuccess || hipDeviceGetAttribute(&cus, hipDeviceAttributeMultiprocessorCount, dev) != hipSuccess) { grid = -1; return; }
        if (hipFuncSetAttribute((const void*)mk_fwd, hipFuncAttributeMaxDynamicSharedMemorySize, LDS_BYTES) != hipSuccess) { fprintf(stderr, "kernel_launch: hipFuncSetAttribute failed\n"); grid = -1; return; }
        (void)hipGetLastError();
        grid = cus;
    }
    if (grid < 0) return;
    if (hipMemsetAsync((char*)d_ws + WS_CTL, 0, CTL_ZERO_BYTES, stream) != hipSuccess) return;
    Args a{};
    for (int i = 0; i < 23; ++i) a.in[i] = (const float*)d_in[i];
    a.out = (float*)d_out; a.ws = (unsigned char*)d_ws;
    if (N_LAUNCHES == 1) { a.ph_lo = 0; a.ph_hi = N_STEPS; hipLaunchKernelGGL(mk_fwd, dim3(grid), dim3(NWAVES * 64), LDS_BYTES, stream, a); }
    else for (int s = 0; s < N_STEPS; ++s) { a.ph_lo = s; a.ph_hi = s + 1; hipLaunchKernelGGL(mk_fwd, dim3(grid), dim3(NWAVES * 64), LDS_BYTES, stream, a); }
}
```

```cpp
#include <hip/hip_runtime.h>
#include <cstdio>
#include <cstdint>
#include <cmath>
namespace pg8 {
#define PG8_LAS __attribute__((address_space(3)))
typedef unsigned short bf16_t;
typedef short bf16x8 __attribute__((ext_vector_type(8)));
typedef float f32x4 __attribute__((ext_vector_type(4)));
typedef unsigned u32x4 __attribute__((ext_vector_type(4)));
constexpr int BM = 256, BK = 64, HALF = 128, HTB = HALF * BK * 2  , STAGE_BYTES = 8 * HTB, NXCD = 8, WGM = 8;

__host__ __device__ __forceinline__ int lds_byte(int r, int c) { const int st = (r >> 4) * 2 + (c >> 5), rr = r & 15, cc = c & 31, ob = rr * 64 + cc * 2; return st * 1024 + (ob ^ (((ob >> 9) & 1) << 5)); }
__host__ __device__ __forceinline__ void stage_rc(int b, int& R, int& C) { const int st = b / 1024, sb = b % 1024, swz = sb ^ (((sb >> 9) & 1) << 5); R = (st >> 1) * 16 + swz / 64; C = (st & 1) * 32 + (swz % 64) / 2; }
__host__ __device__ __forceinline__ int perm32(int rho) { const int n = rho >> 4, i = rho & 15; return 8 * (i >> 2) + 4 * n + (i & 3); }

struct Unit { int pm, pn; };
struct Gemm { const bf16_t* A; const bf16_t* Bt; int M, N, K; };

struct StaticOrder {
    int nM, nN, nwg, G, c;
    __host__ __device__ void init(int M, int N, int G_, int c_) { nM = M / BM; nN = N / BM; nwg = nM * nN; G = G_; c = c_; }
    __host__ __device__ bool next(int i, Unit& u) const {
        const long L = (long)i * G + c; if (L >= nwg) return false;
        int wgid = (int)L; { const int q = nwg / NXCD, r = nwg % NXCD, xcd = wgid % NXCD, off = wgid / NXCD; wgid = (xcd < r ? xcd * (q + 1) : r * (q + 1) + (xcd - r) * q) + off; }
        const int nig = WGM * nN, gid = wgid / nig, fm = gid * WGM, gsz = (nM - fm) < WGM ? (nM - fm) : WGM;
        u.pm = fm + ((wgid % nig) % gsz); u.pn = (wgid % nig) / gsz; return true;
    }
    __device__ __forceinline__ void a_ready(const Unit&) const {}
    __device__ __forceinline__ void done(const Unit&) const {}
};

__device__ __forceinline__ unsigned cvt_pk_bf16(float lo, float hi) { unsigned r; asm volatile("v_cvt_pk_bf16_f32 %0, %1, %2" : "=v"(r) : "v"(lo), "v"(hi)); return r; }
typedef float f32x2 __attribute__((ext_vector_type(2)));
__device__ __forceinline__ f32x2 gelu_pk(f32x2 v) {
    const f32x2 av = __builtin_elementwise_abs(v), d = av * 0.2316418882f + 1.0f;
    f32x2 t; t.x = __builtin_amdgcn_rcpf(d.x); t.y = __builtin_amdgcn_rcpf(d.y);
    f32x2 q = t * 0.5307027145f + (-0.7265760135f); q = q * t + 0.7107068705f; q = q * t + (-0.142248368f); q = q * t + 0.127414796f; q = q * t;
    const f32x2 s = (v * v) * (-0.72134752044f);
    f32x2 e; e.x = __builtin_amdgcn_exp2f(s.x); e.y = __builtin_amdgcn_exp2f(s.y);
    const f32x2 m = v * (q * e), r = v - m;
    f32x2 o; o.x = v.x < 0.f ? m.x : r.x; o.y = v.y < 0.f ? m.y : r.y; return o;
}

template <int ACT  > struct EpiBf16 {
    static constexpr bool PERM = true, AFTER_DRAIN = false; static_assert(ACT == 0 || ACT == 1 || ACT == 2, "EpiBf16: ACT is 0 (none), 1 (gelu_pk) or 2 (squared relu)");
    bf16_t* O; int ldc; const float* bias; int split_cols; size_t split_stride; float scale0;
    const float* rs = nullptr;
    __device__ __forceinline__ void operator()(const f32x4 (&acc)[2][2][4][2], const Unit& u, int wr, int wc, int fr, int fq) const {
        const int row0 = u.pm * BM + wr * 64 + fr; int colt = u.pn * BM; bf16_t* base = O;
        float sc = 1.f; if (split_cols) { const int t = colt / split_cols; base += (size_t)t * split_stride; colt -= t * split_cols; if (t == 0) sc = scale0; }
        const int col0 = colt + wc * 32 + 8 * fq, bcol0 = u.pn * BM + wc * 32 + 8 * fq;
        f32x4 bv[2][2];
#pragma unroll
        for (int bj = 0; bj < 2; ++bj)
#pragma unroll
            for (int n = 0; n < 2; ++n) bv[bj][n] = bias ? *(const f32x4*)(bias + bcol0 + bj * HALF + 4 * n) : (f32x4){0.f, 0.f, 0.f, 0.f};
#pragma unroll
        for (int ai = 0; ai < 2; ++ai)
#pragma unroll
            for (int m = 0; m < 4; ++m) { bf16_t* rowp = base + (size_t)(row0 + ai * HALF + m * 16) * ldc + col0;
                float rsc = 1.f;
                if (rs) { const f32x4* rp = (const f32x4*)(rs + (size_t)(row0 + ai * HALF + m * 16) * 16); const f32x4 p0 = rp[0], p1 = rp[1], p2 = rp[2], p3 = rp[3];
                    const f32x4 t = (p0 + p1) + (p2 + p3); rsc = 1.0f / sqrtf(((t[0] + t[1]) + (t[2] + t[3])) * (1.0f / 1024.0f) + 1e-6f); }
#pragma unroll
                for (int bj = 0; bj < 2; ++bj) { f32x4 v0 = acc[ai][bj][m][0] * rsc + bv[bj][0], v1 = acc[ai][bj][m][1] * rsc + bv[bj][1];
                    if (ACT == 1) { f32x2 a = gelu_pk((f32x2){v0[0], v0[1]}), b = gelu_pk((f32x2){v0[2], v0[3]}), c = gelu_pk((f32x2){v1[0], v1[1]}), d = gelu_pk((f32x2){v1[2], v1[3]});
                        v0 = (f32x4){a.x, a.y, b.x, b.y}; v1 = (f32x4){c.x, c.y, d.x, d.y}; }
                    if (ACT == 2) { _Pragma("unroll") for (int q_ = 0; q_ < 4; ++q_) { const float a_ = fmaxf(v0[q_], 0.f), b_ = fmaxf(v1[q_], 0.f); v0[q_] = a_ * a_; v1[q_] = b_ * b_; } }
                    v0 = v0 * sc; v1 = v1 * sc; u32x4 w; w.x = cvt_pk_bf16(v0[0], v0[1]); w.y = cvt_pk_bf16(v0[2], v0[3]); w.z = cvt_pk_bf16(v1[0], v1[1]); w.w = cvt_pk_bf16(v1[2], v1[3]);
                    *(u32x4*)(rowp + bj * HALF) = w; } }
    }
};


struct EpiResid {
    static constexpr bool PERM = false, AFTER_DRAIN = false;
    const float* base; float* out; const float* gate; int ldc; int gate_stride; int rows_per_batch;
    __device__ __forceinline__ void operator()(const f32x4 (&acc)[2][2][4][2], const Unit& u, int wr, int wc, int fr, int fq) const {
        const int col0 = u.pn * BM + wc * 32 + 4 * fq;
        const float* gp = gate + (size_t)((u.pm * BM) / rows_per_batch) * gate_stride + col0;
        f32x4 gv[2][2];
#pragma unroll
        for (int bj = 0; bj < 2; ++bj)
#pragma unroll
            for (int n = 0; n < 2; ++n) gv[bj][n] = *(const f32x4*)(gp + bj * HALF + n * 16);
#pragma unroll
        for (int ai = 0; ai < 2; ++ai)
#pragma unroll
            for (int m = 0; m < 4; ++m) { const size_t off = (size_t)(u.pm * BM + ai * HALF + wr * 64 + m * 16 + fr) * ldc + col0;
#pragma unroll
                for (int bj = 0; bj < 2; ++bj)
#pragma unroll
                    for (int n = 0; n < 2; ++n) { const f32x4 bs = *(const f32x4*)(base + off + bj * HALF + n * 16);
                        *(f32x4*)(out + off + bj * HALF + n * 16) = bs + gv[bj][n] * acc[ai][bj][m][n]; } }
    }
};


struct EpiResid2 {
    static constexpr bool PERM = true, AFTER_DRAIN = false;
    const float* base; float* out; const float* gate;
    const float* nw; const float* sc;
    bf16_t* anext; float* rsum; float* dup = nullptr;
    __device__ __forceinline__ void operator()(const f32x4 (&acc)[2][2][4][2], const Unit& u, int wr, int wc, int fr, int fq) const {
        const int col0 = u.pn * BM + wc * 32 + 8 * fq, lane = fr + 16 * fq;
        f32x4 gv[2][2], ns[2][2];
#pragma unroll
        for (int bj = 0; bj < 2; ++bj)
#pragma unroll
            for (int n = 0; n < 2; ++n) { const int c = col0 + bj * HALF + 4 * n; gv[bj][n] = *(const f32x4*)(gate + c);
                ns[bj][n] = nw ? *(const f32x4*)(nw + c) * (*(const f32x4*)(sc + c) + 1.0f) : (f32x4){0.f, 0.f, 0.f, 0.f}; }
#pragma unroll
        for (int ai = 0; ai < 2; ++ai)
#pragma unroll
            for (int m = 0; m < 4; ++m) { const size_t off = (size_t)(u.pm * BM + ai * HALF + wr * 64 + m * 16 + fr) * 1024 + col0;
                f32x4 bs[2][2];
#pragma unroll
                for (int bj = 0; bj < 2; ++bj)
#pragma unroll
                    for (int n = 0; n < 2; ++n) bs[bj][n] = *(const f32x4*)(base + off + bj * HALF + 4 * n);
                float ssq = 0.f;
#pragma unroll
                for (int bj = 0; bj < 2; ++bj) { const f32x4 x0 = bs[bj][0] + gv[bj][0] * acc[ai][bj][m][0], x1 = bs[bj][1] + gv[bj][1] * acc[ai][bj][m][1];
                    *(f32x4*)(out + off + bj * HALF) = x0; *(f32x4*)(out + off + bj * HALF + 4) = x1;
#ifdef PROBE_EPI_DUP
                    *(f32x4*)(dup + off + bj * HALF) = x0; *(f32x4*)(dup + off + bj * HALF + 4) = x1;
#endif
                    if (nw) { const f32x4 h0 = x0 * ns[bj][0], h1 = x1 * ns[bj][1]; u32x4 w; w.x = cvt_pk_bf16(h0[0], h0[1]); w.y = cvt_pk_bf16(h0[2], h0[3]); w.z = cvt_pk_bf16(h1[0], h1[1]); w.w = cvt_pk_bf16(h1[2], h1[3]);
                        *(u32x4*)(anext + off + bj * HALF) = w;
                        ssq += ((x0[0] * x0[0] + x0[1] * x0[1]) + (x0[2] * x0[2] + x0[3] * x0[3])) + ((x1[0] * x1[0] + x1[1] * x1[1]) + (x1[2] * x1[2] + x1[3] * x1[3])); } }
                if (nw) { ssq += __builtin_bit_cast(float, __builtin_amdgcn_ds_bpermute((lane ^ 16) << 2, __builtin_bit_cast(int, ssq)));
                    ssq += __builtin_bit_cast(float, __builtin_amdgcn_ds_bpermute((lane ^ 32) << 2, __builtin_bit_cast(int, ssq)));
                    if (fq == 0) rsum[(size_t)(u.pm * BM + ai * HALF + wr * 64 + m * 16 + fr) * 16 + u.pn * 4 + wc] = ssq; }
                if (m & 1) asm volatile("" ::: "memory"); }
    }
};

struct EpiMulti {
    static constexpr bool AFTER_DRAIN = false;
    bool PERM; int mode, l;
    __device__ __forceinline__ void operator()(const f32x4 (&acc)[2][2][4][2], const Unit& u, int wr, int wc, int fr, int fq) const;
};

template <class Epi, class Sched, bool ALIGN_EPI = false, bool SP2 = false>
__device__ __forceinline__ void gemm_phase(PG8_LAS unsigned char* lds, const Gemm g, const Sched& S, const Epi& E) {
    int tid_l = threadIdx.x; asm volatile("" : "+v"(tid_l));
    const int tid = tid_l, wid = __builtin_amdgcn_readfirstlane(tid >> 6), lane = tid & 63, wr = wid >> 2, wc = wid & 3, fr = lane & 15, fq = lane >> 4;
    const int K = g.K, nt = K / BK;
    unsigned voffA[2], voffB[2];
#pragma unroll
    for (int i = 0; i < 2; ++i) { int R, C; stage_rc(tid * 16 + i * 8192, R, C); const int Rb = E.PERM ? ((R & ~31) + perm32(R & 31)) : R;
        voffA[i] = (unsigned)(R * K + C) * 2u; voffB[i] = (unsigned)(Rb * K + C) * 2u; }
    const size_t kstep = (size_t)(BK * 2);
    const size_t hstep = (size_t)HALF * K * 2;
    const size_t tstep = 2 * hstep;
    const unsigned ldsw = (unsigned)wid * 1024u;
    const int aoff = lds_byte(wr * 64 + fr, fq * 8), boff = lds_byte(wc * 32 + fr, fq * 8);
#define PG8_SA(b, h) (((b) * 2 + (h)) * HTB)
#define PG8_SB(b, h) ((4 + (b) * 2 + (h)) * HTB)
#define PG8_STAGE(bufoff, gbase, voff) do { _Pragma("unroll") for (int _i = 0; _i < 2; ++_i) \
        __builtin_amdgcn_global_load_lds((const unsigned*)((const char*)(gbase) + (voff)[_i]), (PG8_LAS unsigned*)(lds + (bufoff) + ldsw + _i * 8192), 16, 0, 0); } while (0)
#define PG8_LDA(dst, b, h) do { _Pragma("unroll") for (int m = 0; m < 4; ++m) _Pragma("unroll") for (int k = 0; k < 2; ++k) dst[m][k] = *(const PG8_LAS bf16x8*)(lds + PG8_SA(b, h) + aoff + m * 2048 + k * 1024); } while (0)
#define PG8_LDB(dst, b, h) do { _Pragma("unroll") for (int n = 0; n < 2; ++n) _Pragma("unroll") for (int k = 0; k < 2; ++k) dst[n][k] = *(const PG8_LAS bf16x8*)(lds + PG8_SB(b, h) + boff + n * 2048 + k * 1024); } while (0)
#define PG8_MMA(ai, bj, At, Bt) do { __builtin_amdgcn_s_setprio(1); _Pragma("unroll") for (int m = 0; m < 4; ++m) _Pragma("unroll") for (int n = 0; n < 2; ++n) _Pragma("unroll") for (int k = 0; k < 2; ++k) \
        acc[ai][bj][m][n] = __builtin_amdgcn_mfma_f32_16x16x32_bf16(Bt[n][k], At[m][k], acc[ai][bj][m][n], 0, 0, 0); __builtin_amdgcn_s_setprio(0); } while (0)
#define PG8_WAIT_V(n) asm volatile("s_waitcnt vmcnt(" #n ")" ::: "memory")
#define PG8_WAIT_L(n) asm volatile("s_waitcnt lgkmcnt(" #n ")" ::: "memory")
#define PG8_BAR __builtin_amdgcn_s_barrier()
#define PG8_SCHED __builtin_amdgcn_sched_barrier(0)
    Unit cur, nxt; int ui = 0;
    if (!S.next(0, cur)) return;
    f32x4 acc[2][2][4][2];
#pragma unroll
    for (int a = 0; a < 2; ++a)
#pragma unroll
        for (int b = 0; b < 2; ++b)
#pragma unroll
            for (int m = 0; m < 4; ++m)
#pragma unroll
                for (int n = 0; n < 2; ++n) acc[a][b][m][n] = (f32x4){0.f, 0.f, 0.f, 0.f};
    bf16x8 At[4][2], B0[2][2], B1[2][2];
    const char* cA = (const char*)g.A + (size_t)cur.pm * tstep; const char* cB = (const char*)g.Bt + (size_t)cur.pn * tstep;
    S.a_ready(cur);
    if constexpr (SP2) {
        PG8_STAGE(PG8_SB(0, 0), cB, voffB); PG8_STAGE(PG8_SB(0, 1), cB + hstep, voffB); PG8_STAGE(PG8_SA(0, 0), cA, voffA); PG8_STAGE(PG8_SA(0, 1), cA + hstep, voffA);
        if (wr == 1) PG8_BAR;
        PG8_WAIT_V(2); PG8_BAR;
        PG8_STAGE(PG8_SB(1, 0), cB + kstep, voffB); PG8_STAGE(PG8_SA(1, 0), cA + kstep, voffA); PG8_STAGE(PG8_SB(1, 1), cB + hstep + kstep, voffB);
        PG8_WAIT_V(6); PG8_BAR;
    } else {
        PG8_STAGE(PG8_SB(0, 0), cB, voffB); PG8_STAGE(PG8_SA(0, 0), cA, voffA); PG8_STAGE(PG8_SB(0, 1), cB + hstep, voffB); PG8_STAGE(PG8_SA(0, 1), cA + hstep, voffA);
        if (wr == 1) PG8_BAR;
        PG8_WAIT_V(4); PG8_BAR;
        PG8_STAGE(PG8_SB(1, 0), cB + kstep, voffB); PG8_STAGE(PG8_SA(1, 0), cA + kstep, voffA); PG8_STAGE(PG8_SB(1, 1), cB + hstep + kstep, voffB);
        PG8_WAIT_V(6); PG8_BAR;
    }
    for (;;) {
        const bool has_next = S.next(ui + 1, nxt);
        const char* nA = has_next ? (const char*)g.A + (size_t)nxt.pm * tstep : cA; const char* nB = has_next ? (const char*)g.Bt + (size_t)nxt.pn * tstep : cB;
        for (int t = 0; t < nt; t += 2) {
            const bool last = (t == nt - 2);
            const char* a1 = cA + (size_t)(t + 1) * kstep;
            const char* a2 = last ? nA : cA + (size_t)(t + 2) * kstep; const char* b2 = last ? nB : cB + (size_t)(t + 2) * kstep;
            const char* a3 = a2 + kstep; const char* b3 = b2 + kstep;
            if (last && has_next) S.a_ready(nxt);
            if constexpr (SP2) {
            PG8_LDB(B0, 0, 0); PG8_LDB(B1, 0, 1); PG8_SCHED; PG8_LDA(At, 0, 0); PG8_STAGE(PG8_SA(1, 1), a1 + hstep, voffA);
            PG8_WAIT_V(8); PG8_WAIT_L(0); PG8_BAR; PG8_MMA(0, 0, At, B0); PG8_MMA(0, 1, At, B1); PG8_BAR; PG8_SCHED;
            PG8_LDA(At, 0, 1); PG8_STAGE(PG8_SB(0, 0), b2, voffB); PG8_STAGE(PG8_SB(0, 1), b2 + hstep, voffB); PG8_STAGE(PG8_SA(0, 0), a2, voffA);
            PG8_WAIT_V(8); PG8_WAIT_L(0); PG8_BAR; PG8_MMA(1, 0, At, B0); PG8_MMA(1, 1, At, B1); PG8_BAR; PG8_SCHED;
            PG8_LDB(B0, 1, 0); PG8_LDB(B1, 1, 1); PG8_SCHED; PG8_LDA(At, 1, 0); PG8_STAGE(PG8_SA(0, 1), a2 + hstep, voffA);
            PG8_WAIT_V(8); PG8_WAIT_L(0); PG8_BAR; PG8_MMA(0, 0, At, B0); PG8_MMA(0, 1, At, B1); PG8_BAR; PG8_SCHED;
            PG8_LDA(At, 1, 1); PG8_STAGE(PG8_SB(1, 0), b3, voffB); PG8_STAGE(PG8_SB(1, 1), b3 + hstep, voffB); PG8_STAGE(PG8_SA(1, 0), a3, voffA);
            PG8_WAIT_V(8); PG8_WAIT_L(0); PG8_BAR; PG8_MMA(1, 0, At, B0); PG8_MMA(1, 1, At, B1); PG8_BAR; PG8_SCHED;
            } else {
            PG8_LDB(B0, 0, 0); PG8_SCHED; PG8_LDA(At, 0, 0); PG8_STAGE(PG8_SA(1, 1), a1 + hstep, voffA);
            PG8_WAIT_L(8); PG8_BAR; PG8_WAIT_L(0); PG8_MMA(0, 0, At, B0); PG8_BAR; PG8_SCHED;
            PG8_LDB(B1, 0, 1); PG8_STAGE(PG8_SB(0, 0), b2, voffB);
            PG8_BAR; PG8_WAIT_L(0); PG8_MMA(0, 1, At, B1); PG8_BAR;
            PG8_LDA(At, 0, 1); PG8_STAGE(PG8_SA(0, 0), a2, voffA);
            PG8_BAR; PG8_WAIT_L(0); PG8_MMA(1, 0, At, B0); PG8_BAR; PG8_SCHED;
            PG8_STAGE(PG8_SB(0, 1), b2 + hstep, voffB);
            PG8_WAIT_V(6); PG8_BAR; PG8_MMA(1, 1, At, B1); PG8_BAR;
            PG8_LDB(B0, 1, 0); PG8_SCHED; PG8_LDA(At, 1, 0); PG8_STAGE(PG8_SA(0, 1), a2 + hstep, voffA);
            PG8_WAIT_L(8); PG8_BAR; PG8_WAIT_L(0); PG8_MMA(0, 0, At, B0); PG8_BAR; PG8_SCHED;
            PG8_LDB(B1, 1, 1); PG8_STAGE(PG8_SB(1, 0), b3, voffB);
            PG8_BAR; PG8_WAIT_L(0); PG8_MMA(0, 1, At, B1); PG8_BAR;
            PG8_LDA(At, 1, 1); PG8_STAGE(PG8_SA(1, 0), a3, voffA);
            PG8_BAR; PG8_WAIT_L(0); PG8_MMA(1, 0, At, B0); PG8_BAR; PG8_SCHED;
            PG8_STAGE(PG8_SB(1, 1), b3 + hstep, voffB);
            PG8_WAIT_V(6); PG8_BAR; PG8_MMA(1, 1, At, B1); PG8_BAR;
            }
        }
        if constexpr (ALIGN_EPI) { if (wr == 0) PG8_BAR; }
        if constexpr (!Epi::AFTER_DRAIN) { E(acc, cur, wr, wc, fr, fq); S.done(cur); }
        if (!has_next) break;
#pragma unroll
        for (int a = 0; a < 2; ++a)
#pragma unroll
            for (int b = 0; b < 2; ++b)
#pragma unroll
                for (int m = 0; m < 4; ++m)
#pragma unroll
                    for (int n = 0; n < 2; ++n) acc[a][b][m][n] = (f32x4){0.f, 0.f, 0.f, 0.f};
        cur = nxt; cA = nA; cB = nB; ++ui;
        if constexpr (ALIGN_EPI) { if (wr == 1) PG8_BAR; }
    }
    PG8_WAIT_V(0);
    if constexpr (!ALIGN_EPI) { if (wr == 0) PG8_BAR; }
    PG8_BAR;
    if constexpr (Epi::AFTER_DRAIN) { E.fused(acc, cur, wr, wc, fr, fq, lds, wid, lane); S.done(cur); }
#undef PG8_SA
#undef PG8_SB
#undef PG8_STAGE
#undef PG8_LDA
#undef PG8_LDB
#undef PG8_MMA
#undef PG8_WAIT_V
#undef PG8_WAIT_L
#undef PG8_BAR
#undef PG8_SCHED
}
}
#define GAS __attribute__((address_space(1)))
#define LAS __attribute__((address_space(3)))
typedef unsigned short bf16;
typedef unsigned v4u __attribute__((ext_vector_type(4)));
typedef float f32x4 __attribute__((ext_vector_type(4)));
typedef short bf16x8 __attribute__((ext_vector_type(8)));
typedef GAS unsigned gu32;
typedef GAS unsigned long long gu64;
#define RLX_AGENT __ATOMIC_RELAXED, __HIP_MEMORY_SCOPE_AGENT
#define LDS_WAIT() asm volatile("s_waitcnt lgkmcnt(0)" ::: "memory")
#define VM_WAIT() asm volatile("s_waitcnt vmcnt(0)" ::: "memory")
__device__ __forceinline__ unsigned long long rt() { return __builtin_amdgcn_s_memrealtime(); }
__device__ __forceinline__ unsigned f2bf(float f) { unsigned u = __builtin_bit_cast(unsigned, f); return (u + 0x7fffu + ((u >> 16) & 1u)) >> 16; }
__device__ __forceinline__ unsigned pk2(float lo, float hi) { return f2bf(lo) | (f2bf(hi) << 16); }

#define XB_TMO      128
#define XB_XCNT(j)  (256  + 64 * (j))
#define XB_XSUB(j)  (1280 + 64 * (j))
#define XB_XGEN(j)  (2304 + 64 * (j))
#define XB_TOP      3328
#define XB_TOPGEN   3392
#define XCD_BAR_WORDS 3456
#define XB_SPIN_CAP (1u << 18)

__device__ __forceinline__ unsigned xb_ld(unsigned* p)              { return __hip_atomic_load(p, __ATOMIC_RELAXED, __HIP_MEMORY_SCOPE_AGENT); }
__device__ __forceinline__ unsigned xb_add(unsigned* p, unsigned v) { return __hip_atomic_fetch_add(p, v, __ATOMIC_RELAXED, __HIP_MEMORY_SCOPE_AGENT); }
__device__ __forceinline__ unsigned xb_xcc_id() { return (unsigned)__builtin_amdgcn_s_getreg((3 << 11) | 20) & 0xFu; }
#define XB_SPIN(cond, bar) do { unsigned _sp = 0; while (cond) { __builtin_amdgcn_s_sleep(1); \
    if ((++_sp & 255u) == 0u) { if (xb_ld(&(bar)[XB_TMO])) break; if (_sp > XB_SPIN_CAP) { atomicAdd(&(bar)[XB_TMO], 1u); break; } } } } while (0)

struct XcdBarrier {
    unsigned* bar; unsigned x;
    volatile LAS unsigned* st;
};

__device__ __forceinline__ XcdBarrier xcd_barrier_post(unsigned* bar, volatile LAS unsigned* st) {
    XcdBarrier b; b.bar = bar; b.x = xb_xcc_id(); b.st = st;
    if (threadIdx.x == 0) (void)xb_add(&bar[XB_XCNT(b.x)], 1u);
    return b;
}
__device__ __forceinline__ void xcd_barrier_complete(unsigned* bar, unsigned x, unsigned& nloc, unsigned& nx) {
    const unsigned G = gridDim.x * gridDim.y * gridDim.z;
    unsigned sum, cnt, mine, sp = 0u;
    for (;;) {
        sum = 0u; cnt = 0u; mine = 0u;
#pragma unroll
        for (unsigned j = 0; j < 16; ++j) { const unsigned c = xb_ld(&bar[XB_XCNT(j)]); sum += c; cnt += (c > 0u) ? 1u : 0u; mine = (j == x) ? c : mine; }
        if (sum == G) break;
        __builtin_amdgcn_s_sleep(1);
        if ((++sp & 255u) == 0u) { if (xb_ld(&bar[XB_TMO])) break; if (sp > XB_SPIN_CAP) { atomicAdd(&bar[XB_TMO], 1u); break; } }
    }
    nloc = mine > 0u ? mine : 1u; nx = cnt > 0u ? cnt : 1u;
}

__device__ __forceinline__ void xcd_barrier(const XcdBarrier& b, const bool t0  ) {
    asm volatile("s_waitcnt vmcnt(0)" ::: "memory");
    __syncthreads();
    if (t0) {
        unsigned* bar = b.bar;
        __builtin_amdgcn_s_waitcnt(0);
        unsigned nloc = b.st[0], nx = b.st[1];
        if (nloc == 0u) { xcd_barrier_complete(bar, b.x, nloc, nx); b.st[0] = nloc; b.st[1] = nx; }
        const unsigned old = xb_add(&bar[XB_XSUB(b.x)], 1u);
        const unsigned gen = old / nloc;
        if (old + 1u == (gen + 1u) * nloc) {
            __builtin_amdgcn_fence(__ATOMIC_RELEASE, "agent");
            asm volatile("s_waitcnt vmcnt(0)" ::: "memory");
            const unsigned og = xb_add(&bar[XB_TOP], 1u);
            const unsigned tg = og / nx;
            if (og + 1u == (tg + 1u) * nx) xb_add(&bar[XB_TOPGEN], 1u);
            else XB_SPIN(xb_ld(&bar[XB_TOPGEN]) == tg, bar);
            __builtin_amdgcn_fence(__ATOMIC_ACQUIRE, "agent");
            xb_add(&bar[XB_XGEN(b.x)], 1u);
            asm volatile("s_waitcnt vmcnt(0)" ::: "memory");
        } else {
            XB_SPIN(xb_ld(&bar[XB_XGEN(b.x)]) == gen, bar);
            __builtin_amdgcn_fence(__ATOMIC_ACQUIRE, "agent");
            asm volatile("s_waitcnt vmcnt(0)" ::: "memory");
        }
    }
    __syncthreads();
}

#ifndef PG8_SP2
#define PG8_SP2 true
#endif
#ifndef PG8_ALIGN
#define PG8_ALIGN true
#endif
constexpr int NWAVES = 8;
constexpr int N_STEPS = 38;
#ifndef MK_N_LAUNCHES
#define MK_N_LAUNCHES 1
#endif
#ifndef PH_MASK
#define PH_MASK 0xffff
#endif
#ifndef REP_MASK
#define REP_MASK 0
#endif
#ifndef PREP_REP_LRU
#define PREP_REP_LRU 1
#endif
#ifndef PREP_REP_GDN
#define PREP_REP_GDN 1
#endif
constexpr int N_LAUNCHES = MK_N_LAUNCHES;

constexpr int D = 1024, BATCH = 4, SEQ = 4096, DEPTH = 4, M = BATCH * SEQ;
constexpr int LRUW = 512, NGB = 8, GBW = 64, GH = 4, HD = 128, GDNW = 512, CH = 64, NCH = SEQ / CH, FF = 4096;
constexpr int NMODC = 6 * D, INC = 3080, NPROJ = 3072;
constexpr int O_LX = 0, O_LY = 512, O_Q = 1024, O_Z = 2560;
constexpr float EPS = 1e-6f;

constexpr size_t MiB = 1u << 20;
constexpr size_t WS_CTL = 0, CTL_ZERO_BYTES = 1 * MiB;
constexpr size_t WS_MOD = 1 * MiB;
constexpr size_t WS_BG = 2 * MiB;
constexpr size_t WS_AGG = 3 * MiB;
constexpr size_t WS_CARRY = 4 * MiB;
constexpr size_t WS_GL = 5 * MiB;
constexpr size_t WS_GT = 6 * MiB;
constexpr size_t WS_C1 = 6 * MiB + 512 * 1024;
constexpr size_t WS_C2 = 6 * MiB + 768 * 1024;
constexpr size_t WS_CB8 = 7 * MiB;
constexpr size_t WS_W8T = 7 * MiB + 64 * 1024;
constexpr size_t WS_RS1 = 364 * MiB, WS_RS2 = 365 * MiB;
constexpr size_t WS_A1 = 312 * MiB;
constexpr size_t WS_W = 8 * MiB;
constexpr size_t LAYER_W = (size_t)12288 * 1024;
constexpr size_t W_OUT_OFF = (size_t)3072 * 1024, W_UP_OFF = (size_t)4096 * 1024, W_DOWN_OFF = (size_t)8192 * 1024;
constexpr size_t WS_H = 104 * MiB;
constexpr size_t WS_MIX = 136 * MiB;
constexpr size_t WS_PROJ = 168 * MiB;
constexpr size_t WS_ACT = 168 * MiB;
constexpr size_t WS_GQD = 264 * MiB, WS_GKT = 280 * MiB;
constexpr size_t WS_GATT = 296 * MiB;
constexpr size_t WS_GO = 312 * MiB;
constexpr size_t WS_LRUP = 344 * MiB;
constexpr size_t WS_END = 376 * MiB;
constexpr int CW_BAR = 4096;

constexpr int RING_OFF = 0, RING_BYTES = 155648;
constexpr int LDSCTL_OFF = RING_BYTES, MISC_OFF = LDSCTL_OFF + 320;
constexpr int LDS_BYTES = 156672;

typedef unsigned v2u __attribute__((ext_vector_type(2)));
#define DI __device__ __forceinline__
DI float bf2f(unsigned b) { return __builtin_bit_cast(float, b << 16); }
DI float bflo(unsigned w) { return __builtin_bit_cast(float, w << 16); }
DI float bfhi(unsigned w) { return __builtin_bit_cast(float, w & 0xffff0000u); }
DI float sigmoidf_(float x) { return 1.f / (1.f + expf(-x)); }
DI float siluf_(float x) { return x / (1.f + expf(-x)); }
DI float rcp_(float x) { return __builtin_amdgcn_rcpf(x); }
DI float exp_fast(float x) { return __builtin_amdgcn_exp2f(x * 1.4426950408889634f); }
DI float sigmoid_fast(float x) { return rcp_(1.f + exp_fast(-x)); }
DI float silu_fast(float x) { return x * rcp_(1.f + exp_fast(-x)); }
DI float gelu_tanh(float x) { const float u = 0.7978845608028654f * (x + 0.044715f * x * x * x); return 0.5f * x * (1.f + tanhf(u)); }
DI float bperm_(int src_lane, float v) { return __builtin_bit_cast(float, __builtin_amdgcn_ds_bpermute(src_lane << 2, __builtin_bit_cast(int, v))); }
DI float wave_sum_(int lane, float v) {
#pragma unroll
    for (int o = 1; o < 64; o <<= 1) v += bperm_(lane ^ o, v);
    return v;
}
DI float half_sum_(int lane, float v) {
#pragma unroll
    for (int o = 1; o < 32; o <<= 1) v += bperm_(lane ^ o, v);
    return v;
}
DI float shfl_up_(int lane, float v, int off) { return bperm_(lane >= off ? lane - off : lane, v); }

struct Args { const float* in[23]; float* out; unsigned char* ws; int ph_lo, ph_hi; };
static_assert(sizeof(Args) == 23 * 8 + 8 + 8 + 8, "Args has no padding");
struct Frame {
    LAS unsigned char* lds;
    volatile LAS unsigned* MISC;
    gu32* ctl;
    int tid, lane, wave;
    int vcu, G;
    const __attribute__((address_space(4))) Args* A;
};
#define IN_(k) (F.A->in[k])
#define X_IN IN_(0)
#define C_IN IN_(1)
#define NORM_MIX_W IN_(2)
#define NORM_MLP_W IN_(3)
#define W_MOD IN_(4)
#define B_MOD IN_(5)
#define W_IN IN_(6)
#define LRU_CONV_W IN_(7)
#define LRU_CONV_B IN_(8)
#define GATE_A_W IN_(9)
#define GATE_A_B IN_(10)
#define GATE_X_W IN_(11)
#define GATE_X_B IN_(12)
#define LRU_LAMBDA IN_(13)
#define LRU_NORM_W IN_(14)
#define GDN_CONV_W IN_(15)
#define GDN_A_LOG IN_(16)
#define GDN_DT_BIAS IN_(17)
#define GDN_NORM_W IN_(18)
#define W_OUT IN_(19)
#define W_UP IN_(20)
#define W_DOWN IN_(21)
#define FINAL_NORM_W IN_(22)
#define OUT_ (F.A->out)
#define WSF(off) ((float*)(F.A->ws + (off)))
#define WSH(off) ((bf16*)(F.A->ws + (off)))

DI void p_mod(Frame& F) {
    LAS float* cs = (LAS float*)F.lds;
    LAS float* red = cs + 4096;
    for (int i = F.tid; i < BATCH * D; i += NWAVES * 64) cs[i] = siluf_(C_IN[i]);
    __syncthreads();
    for (int item = F.vcu; item < DEPTH * 96; item += F.G) {
        const int l = item / 96, cg = item % 96, col = cg * 64 + F.lane;
        const float* wp = W_MOD + ((size_t)l * D + F.wave * 128) * NMODC + col;
        float a0 = 0.f, a1 = 0.f, a2 = 0.f, a3 = 0.f;
#pragma unroll 16
        for (int kk = 0; kk < 128; ++kk) { const float wv = wp[(size_t)kk * NMODC]; const int k = F.wave * 128 + kk;
            a0 += cs[k] * wv; a1 += cs[1024 + k] * wv; a2 += cs[2048 + k] * wv; a3 += cs[3072 + k] * wv; }
        red[(F.wave * 4 + 0) * 64 + F.lane] = a0; red[(F.wave * 4 + 1) * 64 + F.lane] = a1; red[(F.wave * 4 + 2) * 64 + F.lane] = a2; red[(F.wave * 4 + 3) * 64 + F.lane] = a3;
        __syncthreads();
        if (F.tid < 256) { const int b = F.tid >> 6, ln = F.tid & 63; float s = 0.f;
#pragma unroll
            for (int w = 0; w < 8; ++w) s += red[(w * 4 + b) * 64 + ln];
            const int cc = cg * 64 + ln; WSF(WS_MOD)[((size_t)l * BATCH + b) * NMODC + cc] = s + B_MOD[(size_t)l * NMODC + cc]; }
        __syncthreads();
    }
}

struct TrItem { const float* src; bf16* dst; int K, ldw; };
DI void p0_item(Frame& F, int it, TrItem& T) {
    constexpr int I_IN = (D / 64) * (NPROJ / 32), I_OUT = (D / 64) * (D / 32), I_UP = (D / 64) * (FF / 32), I_DN = (FF / 64) * (D / 32);
    constexpr int PER_LAYER = I_IN + I_OUT + I_UP + I_DN;
    const int l = it / PER_LAYER; int r = it % PER_LAYER; bf16* wl = WSH(WS_W) + (size_t)l * LAYER_W;
    const float* W; int K, ldw, N; bf16* WT;
    if (r < I_IN) { W = W_IN + (size_t)l * D * INC; K = D; ldw = INC; N = NPROJ; WT = wl; }
    else if ((r -= I_IN) < I_OUT) { W = W_OUT + (size_t)l * D * D; K = D; ldw = D; N = D; WT = wl + W_OUT_OFF; }
    else if ((r -= I_OUT) < I_UP) { W = W_UP + (size_t)l * D * FF; K = D; ldw = FF; N = FF; WT = wl + W_UP_OFF; }
    else { r -= I_UP; W = W_DOWN + (size_t)l * FF * D; K = FF; ldw = D; N = D; WT = wl + W_DOWN_OFF; }
    const int nblk = N / 32, kb = r / nblk, nb = r % nblk, k0 = 64 * kb, n0 = 32 * nb;
    T.src = W + (size_t)k0 * ldw + n0; T.dst = WT + (size_t)n0 * K + k0; T.K = K; T.ldw = ldw;
}
DI void p0_weights(Frame& F) {
    LAS float* scr = (LAS float*)(F.lds + RING_OFF + F.wave * 16384);
    const int gw = F.vcu * NWAVES + F.wave, NGW = F.G * NWAVES, lane = F.lane;
    constexpr int NIT = DEPTH * ((D / 64) * (NPROJ / 32) + (D / 64) * (D / 32) + (D / 64) * (FF / 32) + (FF / 64) * (D / 32));
    TrItem T; f32x4 v[8];
    if (gw < NIT) { p0_item(F, gw, T);
#pragma unroll
        for (int i = 0; i < 8; ++i) v[i] = *(const f32x4*)(T.src + (size_t)((lane >> 3) + 8 * i) * T.ldw + 4 * (lane & 7)); }
    for (int it = gw; it < NIT; it += NGW) {
        TrItem Tn; f32x4 vn[8]; const int itn = it + NGW < NIT ? it + NGW : it;
        p0_item(F, itn, Tn);
#pragma unroll
        for (int i = 0; i < 8; ++i) vn[i] = *(const f32x4*)(Tn.src + (size_t)((lane >> 3) + 8 * i) * Tn.ldw + 4 * (lane & 7));
#pragma unroll
        for (int i = 0; i < 8; ++i) { LAS float* d = scr + ((lane >> 3) + 8 * i) * 33 + 4 * (lane & 7); d[0] = v[i].x; d[1] = v[i].y; d[2] = v[i].z; d[3] = v[i].w; }
        LDS_WAIT(); asm volatile("" ::: "memory");
        const int c = lane & 7;
#pragma unroll
        for (int j = 0; j < 4; ++j) { const int n = (lane >> 3) + 8 * j; const LAS float* sp = scr + (8 * c) * 33 + n;
            v4u o; o.x = pk2(sp[0 * 33], sp[1 * 33]); o.y = pk2(sp[2 * 33], sp[3 * 33]); o.z = pk2(sp[4 * 33], sp[5 * 33]); o.w = pk2(sp[6 * 33], sp[7 * 33]);
            *(v4u*)(T.dst + (size_t)n * T.K + 8 * c) = o; }
        LDS_WAIT(); asm volatile("" ::: "memory");
        T = Tn;
#pragma unroll
        for (int i = 0; i < 8; ++i) v[i] = vn[i];
    }
    for (int o = (int)blockIdx.x * NWAVES * 64 + F.tid; o < DEPTH * 16 * 1024; o += (int)gridDim.x * NWAVES * 64) {
        const int k = o & 1023, j = (o >> 10) & 15, l = o >> 14;
        WSH(WS_W8T)[o] = (bf16)(j < 8 ? f2bf(W_IN[((size_t)l * D + k) * INC + NPROJ + j]) : 0u);
    }
    for (int o = (int)blockIdx.x * NWAVES * 64 + F.tid; o < DEPTH * 2 * NGB * 4096; o += (int)gridDim.x * NWAVES * 64) {
        const int i = o & 63, j = (o >> 6) & 63, g = (o >> 12) & 7, gate = (o >> 15) & 1, l = o >> 16;
        const float* src = gate ? GATE_X_W : GATE_A_W;
        WSH(WS_GT)[o] = (bf16)f2bf(src[(size_t)(l * NGB + g) * 4096 + i * 64 + j]);
    }
}

DI void p_cvec(Frame& F) {
    const int gw = F.vcu * NWAVES + F.wave, NGW = F.G * NWAVES, lane = F.lane;
    constexpr int IT_IN = NPROJ / 16, IT_UP = FF / 16, PER_L = IT_IN + IT_UP;
    for (int it = gw; it < DEPTH * PER_L; it += NGW) {
        const int l = it / PER_L, r = it % PER_L, which = r >= IT_IN, rg = which ? r - IT_IN : r, N = which ? FF : NPROJ;
        const bf16* wt = WSH(WS_W) + (size_t)l * LAYER_W + (which ? W_UP_OFF : 0) + (size_t)(rg * 16) * 1024 + 16 * lane;
        const float* shb = WSF(WS_MOD) + (size_t)l * BATCH * NMODC + (which ? 3 * D : 0) + 16 * lane;
        float* cout = (which ? WSF(WS_C2) + (size_t)l * BATCH * FF : WSF(WS_C1) + (size_t)l * BATCH * NPROJ) + rg * 16;
        f32x4 sh[4][4];
#pragma unroll
        for (int b = 0; b < 4; ++b)
#pragma unroll
            for (int j = 0; j < 4; ++j) sh[b][j] = *(const f32x4*)(shb + (size_t)b * NMODC + 4 * j);
        float v[64];
#pragma unroll
        for (int row = 0; row < 16; ++row) { const v4u w0 = *(const v4u*)(wt + (size_t)row * 1024), w1 = *(const v4u*)(wt + (size_t)row * 1024 + 8);
            const f32x4 wa = (f32x4){bflo(w0.x), bfhi(w0.x), bflo(w0.y), bfhi(w0.y)}, wb = (f32x4){bflo(w0.z), bfhi(w0.z), bflo(w0.w), bfhi(w0.w)};
            const f32x4 wc = (f32x4){bflo(w1.x), bfhi(w1.x), bflo(w1.y), bfhi(w1.y)}, wd = (f32x4){bflo(w1.z), bfhi(w1.z), bflo(w1.w), bfhi(w1.w)};
#pragma unroll
            for (int b = 0; b < 4; ++b) { const f32x4 t = sh[b][0] * wa + sh[b][1] * wb + sh[b][2] * wc + sh[b][3] * wd; v[row * 4 + b] = (t[0] + t[1]) + (t[2] + t[3]); } }
#pragma unroll
        for (int st = 0; st < 6; ++st) { const int bit = 1 << st; const bool up = lane & bit;
#pragma unroll
            for (int i = 0; i < (32 >> st); ++i) { const float keep = up ? v[2 * i + 1] : v[2 * i], send = up ? v[2 * i] : v[2 * i + 1]; v[i] = keep + bperm_(lane ^ bit, send); } }
        cout[(size_t)(lane & 3) * N + (lane >> 2)] = v[0];
    }
    if (gw < DEPTH * BATCH) { const int l = gw >> 2, b = gw & 3; float a[8];
#pragma unroll
        for (int j = 0; j < 8; ++j) a[j] = 0.f;
        for (int kk = 0; kk < 16; ++kk) { const int k = 16 * lane + kk; const float shv = WSF(WS_MOD)[((size_t)l * BATCH + b) * NMODC + k];
#pragma unroll
            for (int j = 0; j < 8; ++j) a[j] += shv * W_IN[((size_t)l * D + k) * INC + NPROJ + j]; }
#pragma unroll
        for (int j = 0; j < 8; ++j) a[j] = wave_sum_(lane, a[j]);
        if (lane < 8) { float r = a[0];
#pragma unroll
            for (int j = 1; j < 8; ++j) r = (lane == j) ? a[j] : r;
            WSF(WS_CB8)[(size_t)gw * 8 + lane] = r; } }
}

template <bool WITH_BG>
DI void p_normmod(Frame& F, int l, const float* xin, const float* normw, int off_sh, int off_sc) {
    LAS float* w8 = (LAS float*)F.lds;
    if (WITH_BG) {
        for (int i = F.tid; i < D * 8; i += NWAVES * 64) w8[i] = W_IN[((size_t)l * D + (i >> 3)) * INC + NPROJ + (i & 7)];
        __syncthreads();
    }
    const int gw = F.vcu * NWAVES + F.wave, NGW = F.G * NWAVES, lane = F.lane;
    f32x4 v[4];
    if (gw < M) {
#pragma unroll
        for (int j = 0; j < 4; ++j) v[j] = *(const f32x4*)(xin + (size_t)gw * D + 4 * lane + 256 * j);
    }
    for (int m = gw; m < M; m += NGW) {
        const int b = m >> 12, mn = m + NGW;
        f32x4 vnx[4];
#pragma unroll
        for (int j = 0; j < 4; ++j) vnx[j] = (mn < M) ? *(const f32x4*)(xin + (size_t)mn * D + 4 * lane + 256 * j) : (f32x4){0.f, 0.f, 0.f, 0.f};
        const float* modp = WSF(WS_MOD) + ((size_t)l * BATCH + b) * NMODC;
        float ss = 0.f;
#pragma unroll
        for (int j = 0; j < 4; ++j) ss += (v[j].x * v[j].x + v[j].y * v[j].y) + (v[j].z * v[j].z + v[j].w * v[j].w);
        ss = wave_sum_(lane, ss);
        const float rstd = 1.0f / sqrtf(ss * (1.0f / D) + EPS);
        float a0 = 0.f, a1 = 0.f, a2 = 0.f, a3 = 0.f, a4 = 0.f, a5 = 0.f, a6 = 0.f, a7 = 0.f;
#pragma unroll
        for (int j = 0; j < 4; ++j) {
            const int col = 4 * lane + 256 * j;
            const f32x4 nw = *(const f32x4*)(normw + (size_t)l * D + col), sc = *(const f32x4*)(modp + off_sc + col), sh = *(const f32x4*)(modp + off_sh + col);
            const f32x4 hv = v[j] * rstd * nw * (sc + 1.0f) + sh;
            v2u o; o.x = pk2(hv.x, hv.y); o.y = pk2(hv.z, hv.w);
            *(v2u*)(WSH(WS_H) + (size_t)m * D + col) = o;
            if (WITH_BG) {
#pragma unroll
                for (int e = 0; e < 4; ++e) { const f32x4 wa = *(const LAS f32x4*)(w8 + (col + e) * 8), wb = *(const LAS f32x4*)(w8 + (col + e) * 8 + 4); const float hh = hv[e];
                    a0 += hh * wa.x; a1 += hh * wa.y; a2 += hh * wa.z; a3 += hh * wa.w; a4 += hh * wb.x; a5 += hh * wb.y; a6 += hh * wb.z; a7 += hh * wb.w; }
            }
        }
        if (WITH_BG) {
            const bool b0 = lane & 1, b1 = lane & 2, b2 = lane & 4;
            float k0 = b0 ? a1 : a0, k1 = b0 ? a3 : a2, k2 = b0 ? a5 : a4, k3 = b0 ? a7 : a6;
            k0 += bperm_(lane ^ 1, b0 ? a0 : a1); k1 += bperm_(lane ^ 1, b0 ? a2 : a3); k2 += bperm_(lane ^ 1, b0 ? a4 : a5); k3 += bperm_(lane ^ 1, b0 ? a6 : a7);
            float c0 = b1 ? k1 : k0, c1 = b1 ? k3 : k2;
            c0 += bperm_(lane ^ 2, b1 ? k0 : k1); c1 += bperm_(lane ^ 2, b1 ? k2 : k3);
            float d = b2 ? c1 : c0;
            d += bperm_(lane ^ 4, b2 ? c0 : c1);
            d += bperm_(lane ^ 8, d); d += bperm_(lane ^ 16, d); d += bperm_(lane ^ 32, d);
            if (lane < 8) {
                const int hh = lane & 3;
                float r;
                if (lane < 4) r = sigmoidf_(d);
                else { const float xx = d + GDN_DT_BIAS[l * GH + hh]; const float sp = xx > 20.f ? xx : log1pf(expf(xx)); r = -expf(GDN_A_LOG[l * GH + hh]) * sp; }
                WSF(WS_BG)[(size_t)m * 8 + lane] = r;
            }
        }
#pragma unroll
        for (int j = 0; j < 4; ++j) v[j] = vnx[j];
    }
}

typedef float f32x2_t __attribute__((ext_vector_type(2))); typedef __bf16 bf16x2_t __attribute__((ext_vector_type(2)));
DI unsigned cvtpk(float lo, float hi) { f32x2_t v = {lo, hi}; bf16x2_t b = __builtin_convertvector(v, bf16x2_t); return __builtin_bit_cast(unsigned, b); }
DI bf16x8 pack8(f32x4 a, f32x4 b) { v4u p; p.x = cvtpk(a.x, a.y); p.y = cvtpk(a.z, a.w); p.z = cvtpk(b.x, b.y); p.w = cvtpk(b.z, b.w); return __builtin_bit_cast(bf16x8, p); }
DI bf16x8 ldfrag(const LAS unsigned char* p) { const v2u lo = *(const LAS v2u*)p, hi = *(const LAS v2u*)(p + 32); v4u r; r.x = lo.x; r.y = lo.y; r.z = hi.x; r.w = hi.y; return __builtin_bit_cast(bf16x8, r); }
#define MFMA16(a, b, c) __builtin_amdgcn_mfma_f32_16x16x32_bf16((a), (b), (c), 0, 0, 0)

#define WG_BAR() do { asm volatile("s_waitcnt lgkmcnt(0)" ::: "memory"); __builtin_amdgcn_s_barrier(); asm volatile("" ::: "memory"); } while (0)
DI bf16x8 ld128(const LAS unsigned char* p) { return *(const LAS bf16x8*)p; }
DI int kperm4(int k4) { return k4 < 16 ? 2 * k4 : 2 * (k4 - 16) + 4; }
DI int kperm(int k) { return (k & ~31) + kperm4(k & 28) + (k & 3); }
constexpr int PG_QB = 0, PG_KB = 17408, PG_KBET = 34816, PG_VT = 53248, PG_LS = 71680, PG_TS = 89088, PG_TB = 106496, PG_ATT = 115712, PG_XS = 124928, PG_SM = 128000, PG_END = 129024, PG_BGS = 140288;
static_assert(PG_END <= RING_BYTES && PG_BGS >= 8 * 17408 && PG_BGS + 2048 <= RING_BYTES, "prep LDS map");
DI void p_prep(Frame& F, int l) {
    const int wave = F.wave;
#define PREP_IDS int tid_ = F.tid; asm volatile("" : "+v"(tid_)); const int tid = tid_, lane = tid & 63, m = lane & 15, q = lane >> 4; (void)m; (void)q;
    for (int item = blockIdx.x; item < BATCH * NCH; item += gridDim.x) {
        const int b = item / NCH, n = item % NCH, row0 = b * SEQ + n * CH, t0 = n * CH;
        LAS float* bgs = (LAS float*)(F.lds + PG_BGS);
        if (l > 0 && wave < 4) {
            PREP_IDS
            const int mt = wave;
            const bf16* a1 = WSH(WS_A1) + (size_t)(row0 + 16 * mt + m) * D + 8 * q;
            const bf16* w8t = WSH(WS_W8T) + (size_t)l * 16 * 1024 + (size_t)m * 1024 + 8 * q;
            f32x4 acc = (f32x4){0.f, 0.f, 0.f, 0.f};
#pragma unroll 16
            for (int kb = 0; kb < 32; ++kb) acc = MFMA16(*(const bf16x8*)(a1 + 32 * kb), *(const bf16x8*)(w8t + 32 * kb), acc);
            if (m < 8) { const int hh = m & 3; const float cb = WSF(WS_CB8)[((size_t)l * BATCH + b) * 8 + m], dtb = GDN_DT_BIAS[l * GH + hh], alog = GDN_A_LOG[l * GH + hh];
#pragma unroll
                for (int r = 0; r < 4; ++r) { const int t = 16 * mt + 4 * q + r; const f32x4* rp = (const f32x4*)(WSF(WS_RS1) + (size_t)(row0 + t) * 16);
                    const f32x4 p0 = rp[0], p1 = rp[1], p2 = rp[2], p3 = rp[3], ts = (p0 + p1) + (p2 + p3);
                    const float rstd = 1.0f / sqrtf(((ts[0] + ts[1]) + (ts[2] + ts[3])) * (1.0f / D) + EPS), v = acc[r] * rstd + cb;
                    float res;
                    if (m < 4) res = sigmoidf_(v); else { const float xx = v + dtb; const float sp = xx > 20.f ? xx : log1pf(expf(xx)); res = -expf(alog) * sp; }
                    bgs[t * 8 + m] = res; } }
        }
        for (int rep_ = 0; rep_ < PREP_REP_LRU; ++rep_) {
            PREP_IDS
            const int g = wave;
            LAS float* xr = (LAS float*)(F.lds + wave * 17408);
            const int tg = lane >> 3, cg = lane & 7, c0 = 8 * cg, cc0 = g * 64 + c0;
            v4u xp[11];
#pragma unroll
            for (int i = 0; i < 11; ++i) { const int tt = t0 + 8 * tg - 3 + i;
                xp[i] = (tt >= 0) ? *(const v4u*)(WSH(WS_PROJ) + (size_t)(b * SEQ + tt) * NPROJ + O_LX + cc0) : (v4u){0u, 0u, 0u, 0u}; }
            f32x4 wl_[4], wh_[4];
#pragma unroll
            for (int k = 0; k < 4; ++k) { wl_[k] = *(const f32x4*)(LRU_CONV_W + ((size_t)l * 4 + k) * LRUW + cc0); wh_[k] = *(const f32x4*)(LRU_CONV_W + ((size_t)l * 4 + k) * LRUW + cc0 + 4); }
            const f32x4 bl_ = *(const f32x4*)(LRU_CONV_B + l * LRUW + cc0), bh_ = *(const f32x4*)(LRU_CONV_B + l * LRUW + cc0 + 4);
            bf16x8 Bf[2][4][2];
#pragma unroll
            for (int gate = 0; gate < 2; ++gate)
#pragma unroll
                for (int nt = 0; nt < 4; ++nt)
#pragma unroll
                    for (int ks = 0; ks < 2; ++ks) Bf[gate][nt][ks] = *(const bf16x8*)(WSH(WS_GT) + ((size_t)((l * 2 + gate) * NGB + g)) * 4096 + (size_t)(16 * nt + m) * 64 + 32 * ks + 8 * q);
            float ba_[4], bx_[4], ls_[4];
#pragma unroll
            for (int nt = 0; nt < 4; ++nt) { const int cc = g * 64 + 16 * nt + m; ba_[nt] = GATE_A_B[l * LRUW + cc]; bx_[nt] = GATE_X_B[l * LRUW + cc];
                const float lam = LRU_LAMBDA[l * LRUW + cc]; ls_[nt] = -8.0f * (fmaxf(-lam, 0.f) + log1pf(expf(-fabsf(lam)))); }
#pragma unroll
            for (int tt = 0; tt < 8; ++tt) { f32x4 al = bl_, ah = bh_;
#pragma unroll
                for (int k = 0; k < 4; ++k) { const v4u xw = xp[tt + k];
                    al += wl_[k] * (f32x4){bflo(xw.x), bfhi(xw.x), bflo(xw.y), bfhi(xw.y)}; ah += wh_[k] * (f32x4){bflo(xw.z), bfhi(xw.z), bflo(xw.w), bfhi(xw.w)}; }
                *(LAS f32x4*)(xr + (8 * tg + tt) * 68 + c0) = al; *(LAS f32x4*)(xr + (8 * tg + tt) * 68 + c0 + 4) = ah; }
            asm volatile("s_waitcnt lgkmcnt(0)" ::: "memory");
            bf16x8 Af[4][2];
#pragma unroll
            for (int mt = 0; mt < 4; ++mt)
#pragma unroll
                for (int ks = 0; ks < 2; ++ks) { const LAS float* pp = xr + (16 * mt + m) * 68 + 32 * ks + 8 * q; Af[mt][ks] = pack8(*(const LAS f32x4*)pp, *(const LAS f32x4*)(pp + 4)); }
#pragma unroll
            for (int nt = 0; nt < 4; ++nt) {
                float av[4][4], bv[4][4];
#pragma unroll
                for (int mt = 0; mt < 4; ++mt) { f32x4 ra = (f32x4){0.f, 0.f, 0.f, 0.f}, ia = (f32x4){0.f, 0.f, 0.f, 0.f};
                    ra = MFMA16(Af[mt][0], Bf[0][nt][0], ra); ra = MFMA16(Af[mt][1], Bf[0][nt][1], ra);
                    ia = MFMA16(Af[mt][0], Bf[1][nt][0], ia); ia = MFMA16(Af[mt][1], Bf[1][nt][1], ia);
#pragma unroll
                    for (int r = 0; r < 4; ++r) { const float rr = sigmoid_fast(ra[r] + ba_[nt]), ig = sigmoid_fast(ia[r] + bx_[nt]);
                        const float log_a = rr * ls_[nt], aa = exp_fast(log_a), mult = __builtin_amdgcn_sqrtf(fmaxf(1.0f - exp_fast(2.0f * log_a), 1e-12f));
                        av[mt][r] = aa; bv[mt][r] = mult * (ig * xr[(16 * mt + 4 * q + r) * 68 + 16 * nt + m]); } }
                float iP[4], iH[4];
#pragma unroll
                for (int mt = 0; mt < 4; ++mt) {
#pragma unroll
                    for (int r = 1; r < 4; ++r) { bv[mt][r] = av[mt][r] * bv[mt][r - 1] + bv[mt][r]; av[mt][r] = av[mt][r] * av[mt][r - 1]; }
                    float PA = av[mt][3], HA = bv[mt][3];
                    { const float Pp = shfl_up_(lane, PA, 16), Hp = shfl_up_(lane, HA, 16); if (q >= 1) { HA = PA * Hp + HA; PA = PA * Pp; } }
                    { const float Pp = shfl_up_(lane, PA, 32), Hp = shfl_up_(lane, HA, 32); if (q >= 2) { HA = PA * Hp + HA; PA = PA * Pp; } }
                    iP[mt] = PA; iH[mt] = HA; }
                float CP = 1.f, CH = 0.f;
#pragma unroll
                for (int mt = 0; mt < 4; ++mt) {
                    const float totP = bperm_(m + 48, iP[mt]), totH = bperm_(m + 48, iH[mt]);
                    float exP = shfl_up_(lane, iP[mt], 16), exH = shfl_up_(lane, iH[mt], 16); if (q == 0) { exP = 1.f; exH = 0.f; }
                    const float EP = CP * exP, EH = exP * CH + exH;
#pragma unroll
                    for (int r = 0; r < 4; ++r) { const float Pf = EP * av[mt][r], Hf = av[mt][r] * EH + bv[mt][r];
                        *(LAS unsigned*)(xr + (16 * mt + 4 * q + r) * 68 + 16 * nt + m) = f2bf(Hf) | (f2bf(Pf) << 16); }
                    CH = totP * CH + totH; CP = CP * totP; }
                if (q == 0) { WSF(WS_AGG)[((size_t)(b * NCH + n)) * LRUW + g * 64 + 16 * nt + m] = CP; WSF(WS_AGG)[(size_t)BATCH * NCH * LRUW + ((size_t)(b * NCH + n)) * LRUW + g * 64 + 16 * nt + m] = CH; }
            }
            asm volatile("s_waitcnt lgkmcnt(0)" ::: "memory");
#pragma unroll
            for (int i = 0; i < 16; ++i) { const int pz = lane + 64 * i, row = pz >> 4, c16 = pz & 15;
                *(v4u*)((unsigned*)(F.A->ws + WS_H) + (size_t)(row0 + row) * LRUW + g * 64 + 4 * c16) = *(const LAS v4u*)(xr + row * 68 + 4 * c16); }
        }
        __syncthreads();
        {
            LAS unsigned char* qb = F.lds + PG_QB;
            LAS unsigned char* kb = F.lds + PG_KB;
            LAS unsigned char* kbeT = F.lds + PG_KBET;
            LAS unsigned char* vT = F.lds + PG_VT;
            LAS float* Ls = (LAS float*)(F.lds + PG_LS);
            LAS float* Ts = (LAS float*)(F.lds + PG_TS);
            LAS unsigned char* Tb = F.lds + PG_TB;
            LAS unsigned char* atts = F.lds + PG_ATT;
            LAS float* Xs = (LAS float*)(F.lds + PG_XS);
            LAS float* sm4 = (LAS float*)(F.lds + PG_SM);
            if (wave < GH) { int tl_ = F.tid; asm volatile("" : "+v"(tl_)); const int ln = tl_ & 63, hh = wave;
                float gcv = l > 0 ? bgs[ln * 8 + 4 + hh] : WSF(WS_BG)[(size_t)(row0 + ln) * 8 + 4 + hh];
#pragma unroll
                for (int off = 1; off < 64; off <<= 1) { const float pv = shfl_up_(ln, gcv, off); if (ln >= off) gcv += pv; }
                const float glast = bperm_(63, gcv);
                sm4[hh * 256 + ln] = gcv; sm4[hh * 256 + 64 + ln] = l > 0 ? bgs[ln * 8 + hh] : WSF(WS_BG)[(size_t)(row0 + ln) * 8 + hh]; sm4[hh * 256 + 128 + ln] = expf(gcv); sm4[hh * 256 + 192 + ln] = expf(glast - gcv); }
            WG_BAR();
            v4u xpn[11];
#define G1_FETCH(hh_) do { int tf_ = F.tid; asm volatile("" : "+v"(tf_)); if (tf_ < 384) { const int cgp_ = tf_ & 15, wt_ = tf_ >> 4, which_ = wt_ >> 3, tr_ = wt_ & 7, ch_ = which_ * GDNW + (hh_) * HD + cgp_ * 8; \
                _Pragma("unroll") for (int i = 0; i < 11; ++i) { const int tt = t0 + tr_ * 8 - 3 + i; \
                    xpn[i] = (tt >= 0) ? *(const v4u*)(WSH(WS_PROJ) + (size_t)(b * SEQ + tt) * NPROJ + O_Q + ch_) : (v4u){0u, 0u, 0u, 0u}; } \
                } } while (0)
            G1_FETCH(0);
            for (int h_ = 0; h_ < GH * PREP_REP_GDN; ++h_) { const int h = h_ % GH;
                PREP_IDS
                const size_t item4 = (size_t)(b * GH + h) * NCH + n;
                LAS float* sgc = sm4 + h * 256, *sbeta = sgc + 64, *seg = sgc + 128, *sel = sgc + 192;
#if defined(PROBE_G) && PROBE_G == 1
                for (int prb_ = 0; prb_ < 2; ++prb_) {
#else
                {
#endif
                if (tid < 384) {
                    const int cgp = tid & 15, wt = tid >> 4, which = wt >> 3, tr = wt & 7, d0 = cgp * 8, ch0 = which * GDNW + h * HD + d0;
                    v4u xp[11]; f32x4 wl_[4], wh_[4];
#pragma unroll
                    for (int i = 0; i < 11; ++i) xp[i] = xpn[i];
#pragma unroll
                    for (int k = 0; k < 4; ++k) { wl_[k] = *(const f32x4*)(GDN_CONV_W + ((size_t)l * 4 + k) * (3 * GDNW) + ch0); wh_[k] = *(const f32x4*)(GDN_CONV_W + ((size_t)l * 4 + k) * (3 * GDNW) + ch0 + 4); }
                    f32x4 ol[8], oh[8]; float ss[8];
#pragma unroll
                    for (int tt = 0; tt < 8; ++tt) { f32x4 al = (f32x4){0.f, 0.f, 0.f, 0.f}, ah = (f32x4){0.f, 0.f, 0.f, 0.f};
#pragma unroll
                        for (int k = 0; k < 4; ++k) { const v4u xw = xp[tt + k];
                            al += wl_[k] * (f32x4){bflo(xw.x), bfhi(xw.x), bflo(xw.y), bfhi(xw.y)}; ah += wh_[k] * (f32x4){bflo(xw.z), bfhi(xw.z), bflo(xw.w), bfhi(xw.w)}; }
#pragma unroll
                        for (int c = 0; c < 4; ++c) { al[c] = silu_fast(al[c]); ah[c] = silu_fast(ah[c]); }
                        ol[tt] = al; oh[tt] = ah;
                        ss[tt] = (al.x * al.x + al.y * al.y) + (al.z * al.z + al.w * al.w) + (ah.x * ah.x + ah.y * ah.y) + (ah.z * ah.z + ah.w * ah.w); }
                    if (h_ + 1 < GH * PREP_REP_GDN) G1_FETCH((h_ + 1) % GH);
                    if (which < 2) {
#pragma unroll
                        for (int tt = 0; tt < 8; ++tt) { float v = ss[tt]; v += bperm_(lane ^ 1, v); v += bperm_(lane ^ 2, v); v += bperm_(lane ^ 4, v); v += bperm_(lane ^ 8, v);
                            const float scl = __builtin_amdgcn_rsqf(v + 1e-6f) * (which == 0 ? 0.08838834764831845f : 1.0f); ol[tt] = ol[tt] * scl; oh[tt] = oh[tt] * scl; }
                    }
                    const int tb = tr * 8;
                    if (which == 0) {
#pragma unroll
                        for (int tt = 0; tt < 8; ++tt) { const int t = tb + tt; const float eg = seg[t];
                            v4u pk; pk.x = cvtpk(ol[tt].x, ol[tt].y); pk.y = cvtpk(ol[tt].z, ol[tt].w); pk.z = cvtpk(oh[tt].x, oh[tt].y); pk.w = cvtpk(oh[tt].z, oh[tt].w);
                            *(LAS v4u*)(qb + t * 272 + d0 * 2) = pk;
                            v4u pg; pg.x = cvtpk(ol[tt].x * eg, ol[tt].y * eg); pg.y = cvtpk(ol[tt].z * eg, ol[tt].w * eg); pg.z = cvtpk(oh[tt].x * eg, oh[tt].y * eg); pg.w = cvtpk(oh[tt].z * eg, oh[tt].w * eg);
                            { bf16* qrow = WSH(WS_GQD) + item4 * 8192 + t * 128 + (d0 & ~31); const int kl = d0 & 31;
                                v2u p0; p0.x = pg.x; p0.y = pg.y; v2u p1; p1.x = pg.z; p1.y = pg.w; *(v2u*)(qrow + kperm4(kl)) = p0; *(v2u*)(qrow + kperm4(kl + 4)) = p1; } }
                    } else if (which == 1) {
                        float fb[8], fl[8];
#pragma unroll
                        for (int tt = 0; tt < 8; ++tt) { const int t = tb + tt; fb[tt] = sbeta[t] * seg[t]; fl[tt] = sel[t];
                            v4u pk; pk.x = cvtpk(ol[tt].x, ol[tt].y); pk.y = cvtpk(ol[tt].z, ol[tt].w); pk.z = cvtpk(oh[tt].x, oh[tt].y); pk.w = cvtpk(oh[tt].z, oh[tt].w);
                            *(LAS v4u*)(kb + t * 272 + d0 * 2) = pk; }
#pragma unroll
                        for (int c = 0; c < 8; ++c) {
#define KV_(tt) ((c) < 4 ? ol[tt][(c) & 3] : oh[tt][(c) & 3])
                            v4u pe; pe.x = cvtpk(KV_(0) * fb[0], KV_(1) * fb[1]); pe.y = cvtpk(KV_(2) * fb[2], KV_(3) * fb[3]); pe.z = cvtpk(KV_(4) * fb[4], KV_(5) * fb[5]); pe.w = cvtpk(KV_(6) * fb[6], KV_(7) * fb[7]);
                            *(LAS v4u*)(kbeT + (d0 + c) * 144 + ((tr ^ (cgp & 7)) * 16)) = pe;
                            v4u pt; pt.x = cvtpk(KV_(0) * fl[0], KV_(1) * fl[1]); pt.y = cvtpk(KV_(2) * fl[2], KV_(3) * fl[3]); pt.z = cvtpk(KV_(4) * fl[4], KV_(5) * fl[5]); pt.w = cvtpk(KV_(6) * fl[6], KV_(7) * fl[7]);
                            { bf16* krow = WSH(WS_GKT) + item4 * 8192 + (d0 + c) * 64 + (tb & ~31); const int kl = tb & 31;
                                v2u p0; p0.x = pt.x; p0.y = pt.y; v2u p1; p1.x = pt.z; p1.y = pt.w; *(v2u*)(krow + kperm4(kl)) = p0; *(v2u*)(krow + kperm4(kl + 4)) = p1; } }
                    } else {
                        float fb[8];
#pragma unroll
                        for (int tt = 0; tt < 8; ++tt) fb[tt] = sbeta[tb + tt];
#pragma unroll
                        for (int c = 0; c < 8; ++c) {
                            v4u pe; pe.x = cvtpk(KV_(0) * fb[0], KV_(1) * fb[1]); pe.y = cvtpk(KV_(2) * fb[2], KV_(3) * fb[3]); pe.z = cvtpk(KV_(4) * fb[4], KV_(5) * fb[5]); pe.w = cvtpk(KV_(6) * fb[6], KV_(7) * fb[7]);
                            *(LAS v4u*)(vT + (d0 + c) * 144 + ((tr ^ (cgp & 7)) * 16)) = pe; }
#undef KV_
                    }
                }
                WG_BAR();
                }
#if defined(PROBE_G) && PROBE_G == 2
                for (int prb_ = 0; prb_ < 2; ++prb_) {
#else
                {
#endif
                {
                    const int it = wave >> 1;
                    bf16x8 Ak[4], Aq[4], Bk[2][4];
#pragma unroll
                    for (int ks = 0; ks < 4; ++ks) { Ak[ks] = ld128(kb + (16 * it + m) * 272 + (32 * ks + 8 * q) * 2); Aq[ks] = ld128(qb + (16 * it + m) * 272 + (32 * ks + 8 * q) * 2);
                        Bk[0][ks] = ld128(kb + (16 * ((wave & 1) * 2) + m) * 272 + (32 * ks + 8 * q) * 2); Bk[1][ks] = ld128(kb + (16 * ((wave & 1) * 2 + 1) + m) * 272 + (32 * ks + 8 * q) * 2); }
#pragma unroll
                    for (int jj = 0; jj < 2; ++jj) { const int jt = (wave & 1) * 2 + jj;
                        f32x4 kk = (f32x4){0.f, 0.f, 0.f, 0.f}, qk = (f32x4){0.f, 0.f, 0.f, 0.f};
                        if (jt <= it) {
#pragma unroll
                            for (int ks = 0; ks < 4; ++ks) { kk = MFMA16(Ak[ks], Bk[jj][ks], kk); qk = MFMA16(Aq[ks], Bk[jj][ks], qk); } }
                        const int j = 16 * jt + m; const float gj = sgc[j];
#pragma unroll
                        for (int r = 0; r < 4; ++r) { const int i = 16 * it + 4 * q + r;
                            const float dec = (j <= i) ? exp_fast(sgc[i] - gj) : 0.f;
                            Ls[i * 68 + j] = (j < i) ? sbeta[i] * kk[r] * dec : 0.f;
                            *(LAS unsigned short*)(atts + i * 144 + kperm(j) * 2) = (unsigned short)f2bf((j <= i) ? qk[r] * dec : 0.f); } }
                }
                WG_BAR();
                }
#if defined(PROBE_G) && PROBE_G == 3
                for (int prb_ = 0; prb_ < 2; ++prb_) {
#else
                {
#endif
                if (tid < 64) { const int bk = tid >> 4, c = tid & 15; float x[16];
                    const LAS float* lb = Ls + (16 * bk) * 68 + 16 * bk;
#pragma unroll
                    for (int r = 0; r < 16; ++r) { float acc = (r == c) ? 1.f : 0.f;
#pragma unroll
                        for (int m4 = 0; m4 < (r + 3) / 4; ++m4) { const f32x4 lv = *(const LAS f32x4*)(lb + r * 68 + 4 * m4);
                            if (4 * m4 + 0 < r) acc -= lv.x * x[4 * m4 + 0]; if (4 * m4 + 1 < r) acc -= lv.y * x[4 * m4 + 1]; if (4 * m4 + 2 < r) acc -= lv.z * x[4 * m4 + 2]; if (4 * m4 + 3 < r) acc -= lv.w * x[4 * m4 + 3]; }
                        x[r] = acc; Ts[(16 * bk + r) * 68 + 16 * bk + c] = acc; } }
                WG_BAR();
#pragma unroll 1
                for (int dl = 1; dl < 4; ++dl) {
                    const int nout = (4 - dl) * 256;
                    for (int idx = tid; idx < nout; idx += NWAVES * 64) { const int blk = idx >> 8, r = (idx >> 4) & 15, c = idx & 15, i = blk + dl, j = blk; float acc = 0.f;
                        const LAS float* lrow = Ls + (16 * i + r) * 68 + 16 * j; const LAS float* tcol = Ts + (16 * j) * 68 + 16 * j + c;
                        for (int kk = 0; kk < dl; ++kk) {
#pragma unroll
                            for (int mm = 0; mm < 16; mm += 4) { const f32x4 lv = *(const LAS f32x4*)(lrow + 16 * kk + mm); const LAS float* tc = tcol + (16 * kk + mm) * 68;
                                acc += lv.x * tc[0] + lv.y * tc[68] + lv.z * tc[136] + lv.w * tc[204]; } }
                        Xs[idx] = acc; }
                    WG_BAR();
                    for (int idx = tid; idx < nout; idx += NWAVES * 64) { const int blk = idx >> 8, r = (idx >> 4) & 15, c = idx & 15, i = blk + dl, j = blk; float acc = 0.f;
                        const LAS float* trow = Ts + (16 * i + r) * 68 + 16 * i; const LAS float* xc = Xs + blk * 256 + c;
#pragma unroll
                        for (int mm = 0; mm < 16; mm += 4) { const f32x4 tv = *(const LAS f32x4*)(trow + mm); acc -= tv.x * xc[(mm + 0) * 16] + tv.y * xc[(mm + 1) * 16] + tv.z * xc[(mm + 2) * 16] + tv.w * xc[(mm + 3) * 16]; }
                        Ts[(16 * i + r) * 68 + 16 * j + c] = acc; }
                    WG_BAR();
                }
#pragma unroll
                for (int e = 0; e < 8; ++e) { const int idx = tid + 512 * e, i = idx >> 6, j = idx & 63;
                    *(LAS unsigned short*)(Tb + i * 144 + j * 2) = (unsigned short)(((j >> 4) <= (i >> 4)) ? f2bf(Ts[i * 68 + j]) : 0u); }
                WG_BAR();
                }
#if defined(PROBE_G) && PROBE_G == 4
                for (int prb_ = 0; prb_ < 2; ++prb_) {
#else
                {
#endif
                {
                    const int nt = wave;
#pragma unroll
                    for (int mt = 0; mt < 4; ++mt) { f32x4 ua = (f32x4){0.f, 0.f, 0.f, 0.f}, wa = (f32x4){0.f, 0.f, 0.f, 0.f};
#pragma unroll
                        for (int ks = 0; ks < 2; ++ks) if (32 * ks <= 16 * mt + 15) { const bf16x8 A = ld128(Tb + (16 * mt + m) * 144 + (32 * ks + 8 * q) * 2);
                            const int swz = (((4 * ks + q) ^ ((2 * nt + (m >> 3)) & 7)) * 16);
                            ua = MFMA16(A, ld128(vT + (16 * nt + m) * 144 + swz), ua); wa = MFMA16(A, ld128(kbeT + (16 * nt + m) * 144 + swz), wa); }
unsigned uts[4];
#pragma unroll
                        for (int r = 0; r < 4; ++r) { const int t = 16 * mt + 4 * q + r, d = 16 * nt + m;
                            uts[r] = f2bf(ua[r]); *(LAS unsigned short*)(kb + t * 272 + kperm(d) * 2) = (unsigned short)f2bf(-wa[r]); }
                        { v2u pu; pu.x = uts[0] | (uts[1] << 16); pu.y = uts[2] | (uts[3] << 16); *(LAS v2u*)(F.lds + PG_LS + (16 * nt + m) * 144 + (16 * mt + 4 * q) * 2) = pu; } }
                }
                WG_BAR();
                }
#if defined(PROBE_G) && PROBE_G == 5
                for (int prb_ = 0; prb_ < 2; ++prb_) {
#else
                {
#endif
#pragma unroll
                for (int e = 0; e < 2; ++e) { const int p = tid + 512 * e, row = p >> 4, c16 = p & 15;
                    *(v4u*)((unsigned char*)(WSH(WS_MIX + 16 * MiB) + item4 * 8192) + row * 256 + c16 * 16) = *(const LAS v4u*)(kb + row * 272 + c16 * 16);
                    const int ur = p >> 3, uc = p & 7;
                    *(v4u*)((unsigned char*)(WSH(WS_MIX) + item4 * 8192) + ur * 128 + uc * 16) = *(const LAS v4u*)(F.lds + PG_LS + ur * 144 + uc * 16); }
                { const int row = tid >> 3, c16 = tid & 7;
                    *(v4u*)((unsigned char*)(WSH(WS_GATT) + item4 * 4096) + row * 128 + c16 * 16) = *(const LAS v4u*)(atts + row * 144 + c16 * 16); }
                if (tid == 0) WSF(WS_GL)[item4] = seg[63];
                WG_BAR();
                }
            }
        }
    }
}

#undef PREP_IDS
constexpr int SC_W = 0, SC_QD = 18432, SC_KT = 36864, SC_AT = 57344, SC_U = 67584, SC_STAGE = 76800;
static_assert(2 * SC_STAGE <= RING_BYTES, "scan stages fit the ring");
#define SBAR_() __builtin_amdgcn_sched_barrier(0)
constexpr int NSEG = 8, SEGC = NCH / NSEG;
constexpr size_t WS_PSI = 344 * MiB;
constexpr size_t WS_PHI = 352 * MiB;
constexpr size_t WS_SST = 356 * MiB;
static_assert(WS_SST + 8 * MiB <= WS_END, "two-level scan scratch");

#define SC_ADDR() \
        const unsigned char* gW = (const unsigned char*)(WSH(WS_MIX + 16 * MiB) + it0 * 8192); \
        const unsigned char* gQD = (const unsigned char*)(WSH(WS_GQD) + it0 * 8192); \
        const unsigned char* gKT = (const unsigned char*)(WSH(WS_GKT) + it0 * 8192); \
        const unsigned char* gAT = (const unsigned char*)(WSH(WS_GATT) + it0 * 4096); \
        const unsigned char* gU = (const unsigned char*)(WSH(WS_MIX) + it0 * 8192) + dvbase * 128;
#define SC_LOAD(rg, n_) do { const size_t cb = (size_t)(n_) * 16384, ca = (size_t)(n_) * 8192; \
            _Pragma("unroll") for (int i = 0; i < 4; ++i) { rg[i] = *(const v4u*)(gW + cb + gofW + i * 4096); if (FULL) rg[4 + i] = *(const v4u*)(gQD + cb + gofW + i * 4096); \
                rg[8 + i] = *(const v4u*)(gKT + cb + gofK + i * 4096); } \
            _Pragma("unroll") for (int i = 0; i < 2; ++i) { if (FULL) rg[12 + i] = *(const v4u*)(gAT + ca + gofK + i * 4096); rg[14 + i] = *(const v4u*)(gU + cb + gofK + i * 4096); } } while (0)
#define SC_WRITE(rg, buf_) do { LAS unsigned char* sb_ = F.lds + (buf_) * SC_STAGE; \
            _Pragma("unroll") for (int i = 0; i < 4; ++i) { *(LAS v4u*)(sb_ + SC_W + lofW + i * (16 * 288)) = rg[i]; if (FULL) *(LAS v4u*)(sb_ + SC_QD + lofW + i * (16 * 288)) = rg[4 + i]; \
                *(LAS v4u*)(sb_ + SC_KT + lofK + i * (32 * 160)) = rg[8 + i]; } \
            _Pragma("unroll") for (int i = 0; i < 2; ++i) { if (FULL) *(LAS v4u*)(sb_ + SC_AT + lofK + i * (32 * 160)) = rg[12 + i]; *(LAS v4u*)(sb_ + SC_U + lofU + i * (32 * 144)) = rg[14 + i]; } } while (0)
#define SC_LOADER_LOOP() do { \
            int lt_ = F.tid & 255; asm volatile("" : "+v"(lt_)); \
            const int gofW = (lt_ >> 4) * 256 + (lt_ & 15) * 16, gofK = (lt_ >> 3) * 128 + (lt_ & 7) * 16; \
            const int lofW = (lt_ >> 4) * 288 + (lt_ & 15) * 16, lofK = (lt_ >> 3) * 160 + (lt_ & 7) * 16, lofU = (lt_ >> 3) * 144 + (lt_ & 7) * 16; \
            const int nlast = n0 + SEGC - 1; \
            v4u ra[16], rb[16]; \
            SC_LOAD(ra, n0); SC_WRITE(ra, 0); SC_LOAD(ra, n0 + 1); SC_LOAD(rb, n0 + 2); \
            __syncthreads(); \
            _Pragma("unroll 1") for (int j = 0; j < SEGC; j += 2) { \
                  \
                  \
                SC_WRITE(ra, 1); \
                { const int nn = n0 + j + 3 < nlast ? n0 + j + 3 : nlast; SC_LOAD(ra, nn); } \
                WG_BAR(); \
                SC_WRITE(rb, 0); \
                { const int nn = n0 + j + 4 < nlast ? n0 + j + 4 : nlast; SC_LOAD(rb, nn); } \
                WG_BAR(); \
            } } while (0)

DI void p_scan1(Frame& F, int l) {
    constexpr bool FULL = false;
    const int wave = F.wave;
    { const int lane = F.lane;
        for (int p = blockIdx.x * NWAVES + wave; p < BATCH * LRUW; p += gridDim.x * NWAVES) { const int b = p / LRUW, c = p % LRUW;
            float A = WSF(WS_AGG)[((size_t)(b * NCH + lane)) * LRUW + c], B = WSF(WS_AGG)[(size_t)BATCH * NCH * LRUW + ((size_t)(b * NCH + lane)) * LRUW + c];
#pragma unroll
            for (int off = 1; off < 64; off <<= 1) { const float Ap = shfl_up_(lane, A, off), Bp = shfl_up_(lane, B, off); if (lane >= off) { B = A * Bp + B; A = A * Ap; } }
            if (lane < 63) WSF(WS_CARRY)[((size_t)(b * NCH + lane + 1)) * LRUW + c] = B; else WSF(WS_CARRY)[((size_t)(b * NCH)) * LRUW + c] = 0.f; } }
    const bool is_loader = wave >= 4;
    const int wv = wave & 3;
    for (int job = F.vcu; job < BATCH * GH * NSEG * 2; job += F.G) {
        const int bh = job >> 4, seg = (job >> 1) & (NSEG - 1), dvbase = (job & 1) * 64, n0 = seg * SEGC;
        const size_t it0 = (size_t)bh * NCH;
        SC_ADDR()
        (void)gQD; (void)gAT;
        if (seg == NSEG - 1) { __syncthreads(); continue; }
        if (is_loader) { SC_LOADER_LOOP(); }
        else {
            int tc_ = F.tid; asm volatile("" : "+v"(tc_)); const int lane = tc_ & 63, m = lane & 15, q = lane >> 4;
            const int col = dvbase + 16 * wv + m;
            f32x4 Sacc[2][8];
#pragma unroll
            for (int dt = 0; dt < 8; ++dt) { Sacc[0][dt] = (f32x4){0.f, 0.f, 0.f, 0.f};
#pragma unroll
                for (int r = 0; r < 4; ++r) Sacc[1][dt][r] = (16 * dt + 4 * q + r == col) ? 1.f : 0.f; }
            const float glv = WSF(WS_GL)[it0 + lane];
            __syncthreads();
#pragma unroll 1
            for (int j = 0; j < SEGC; ++j) {
                const LAS unsigned char* B = F.lds + (j & 1) * SC_STAGE;
                bf16x8 fa[4], fb[4], Sb[2][4], vnb[2][2];
                f32x4 vn[2][4];
                v2u ut[4];
#pragma unroll
                for (int mt = 0; mt < 4; ++mt) ut[mt] = *(const LAS v2u*)(B + SC_U + (16 * wv + m) * 144 + (16 * mt + 4 * q) * 2);
#define LDW4(dst, mt_) do { _Pragma("unroll") for (int kb = 0; kb < 4; ++kb) dst[kb] = ld128(B + SC_W + (16 * (mt_) + m) * 288 + (32 * kb + 8 * q) * 2); } while (0)
#define MMW2(src, mt_) do { _Pragma("unroll") for (int kb = 0; kb < 4; ++kb) { vn[0][mt_] = MFMA16(src[kb], Sb[0][kb], vn[0][mt_]); vn[1][mt_] = MFMA16(src[kb], Sb[1][kb], vn[1][mt_]); } } while (0)
#define LDK4(dst, dt_) do { dst[0] = ld128(B + SC_KT + (16 * (dt_) + m) * 160 + (8 * q) * 2); dst[1] = ld128(B + SC_KT + (16 * (dt_) + m) * 160 + (32 + 8 * q) * 2); \
                            dst[2] = ld128(B + SC_KT + (16 * ((dt_) + 1) + m) * 160 + (8 * q) * 2); dst[3] = ld128(B + SC_KT + (16 * ((dt_) + 1) + m) * 160 + (32 + 8 * q) * 2); } while (0)
#define MMK2(src, dt_) do { _Pragma("unroll") for (int e = 0; e < 2; ++e) { Sacc[e][dt_] = MFMA16(src[0], vnb[e][0], Sacc[e][dt_]); Sacc[e][dt_] = MFMA16(src[1], vnb[e][1], Sacc[e][dt_]); \
                            Sacc[e][(dt_) + 1] = MFMA16(src[2], vnb[e][0], Sacc[e][(dt_) + 1]); Sacc[e][(dt_) + 1] = MFMA16(src[3], vnb[e][1], Sacc[e][(dt_) + 1]); } } while (0)
                LDW4(fa, 0); SBAR_();
#pragma unroll
                for (int e = 0; e < 2; ++e)
#pragma unroll
                    for (int kb = 0; kb < 4; ++kb) Sb[e][kb] = pack8(Sacc[e][2 * kb], Sacc[e][2 * kb + 1]);
#pragma unroll
                for (int mt = 0; mt < 4; ++mt) { vn[0][mt] = (f32x4){bflo(ut[mt].x), bfhi(ut[mt].x), bflo(ut[mt].y), bfhi(ut[mt].y)}; vn[1][mt] = (f32x4){0.f, 0.f, 0.f, 0.f}; }
                const float gl = __builtin_bit_cast(float, __builtin_amdgcn_readlane(__builtin_bit_cast(int, glv), n0 + j));
                SBAR_(); LDW4(fb, 1); SBAR_(); MMW2(fa, 0); SBAR_();
                LDW4(fa, 2); SBAR_(); MMW2(fb, 1); SBAR_();
                LDW4(fb, 3); SBAR_(); MMW2(fa, 2); SBAR_();
                LDK4(fa, 0); SBAR_(); MMW2(fb, 3); SBAR_();
#pragma unroll
                for (int e = 0; e < 2; ++e) { vnb[e][0] = pack8(vn[e][0], vn[e][1]); vnb[e][1] = pack8(vn[e][2], vn[e][3]);
#pragma unroll
                    for (int dt = 0; dt < 8; ++dt) Sacc[e][dt] = Sacc[e][dt] * gl; }
                SBAR_(); LDK4(fb, 2); SBAR_(); MMK2(fa, 0); SBAR_();
                LDK4(fa, 4); SBAR_(); MMK2(fb, 2); SBAR_();
                LDK4(fb, 6); SBAR_(); MMK2(fa, 4); SBAR_();
                MMK2(fb, 6); SBAR_();
                WG_BAR();
            }
#undef LDW4
#undef MMW2
#undef LDK4
#undef MMK2
            float* psi = WSF(WS_PSI) + ((size_t)(bh * NSEG + seg) * 128) * 128 + col;
            bf16* phi = WSH(WS_PHI) + ((size_t)(bh * NSEG + seg) * 128) * 128 + kperm(col);
#pragma unroll
            for (int dt = 0; dt < 8; ++dt)
#pragma unroll
                for (int r = 0; r < 4; ++r) { const int dk = 16 * dt + 4 * q + r; psi[(size_t)dk * 128] = Sacc[0][dt][r]; phi[(size_t)dk * 128] = (bf16)f2bf(Sacc[1][dt][r]); }
        }
        __syncthreads();
    }
}

DI void p_scan2(Frame& F, int l) {
    const int wave = F.wave;
    for (int bh = blockIdx.x; bh < BATCH * GH; bh += gridDim.x) {
        int tc_ = F.tid; asm volatile("" : "+v"(tc_)); const int tid = tc_, lane = tc_ & 63, m = lane & 15, q = lane >> 4;
        const int col = 16 * wave + m;
        const int gof = (tid >> 4) * 256 + (tid & 15) * 16, lof = (tid >> 4) * 288 + (tid & 15) * 16;
        const unsigned char* phi0 = (const unsigned char*)(WSH(WS_PHI) + ((size_t)(bh * NSEG) * 128) * 128);
        const float* psi0 = WSF(WS_PSI) + ((size_t)(bh * NSEG) * 128) * 128 + col;
        float* sst0 = WSF(WS_SST) + ((size_t)(bh * NSEG) * 128) * 128 + col;
        f32x4 S[8], Ps[8]; v4u pr[4];
#pragma unroll
        for (int dt = 0; dt < 8; ++dt) { S[dt] = (f32x4){0.f, 0.f, 0.f, 0.f};
#pragma unroll
            for (int r = 0; r < 4; ++r) Ps[dt][r] = psi0[(size_t)(16 * dt + 4 * q + r) * 128]; }
#pragma unroll
        for (int i = 0; i < 4; ++i) pr[i] = *(const v4u*)(phi0 + gof + i * 8192);
#pragma unroll
        for (int i = 0; i < 4; ++i) *(LAS v4u*)(F.lds + lof + i * (32 * 288)) = pr[i];
        __syncthreads();
#pragma unroll 1
        for (int seg = 0; seg + 1 < NSEG; ++seg) {
            if (seg > 0) {
#pragma unroll
                for (int dt = 0; dt < 8; ++dt)
#pragma unroll
                    for (int r = 0; r < 4; ++r) sst0[((size_t)seg * 128 + 16 * dt + 4 * q + r) * 128] = S[dt][r]; }
            const int sn = seg + 2 < NSEG ? seg + 1 : seg;
#pragma unroll
            for (int i = 0; i < 4; ++i) pr[i] = *(const v4u*)(phi0 + (size_t)sn * 32768 + gof + i * 8192);
            f32x4 Pn[8];
#pragma unroll
            for (int dt = 0; dt < 8; ++dt)
#pragma unroll
                for (int r = 0; r < 4; ++r) Pn[dt][r] = psi0[((size_t)sn * 128 + 16 * dt + 4 * q + r) * 128];
            const LAS unsigned char* B = F.lds + (seg & 1) * 36864;
            bf16x8 Sb[4];
#pragma unroll
            for (int kb = 0; kb < 4; ++kb) Sb[kb] = pack8(S[2 * kb], S[2 * kb + 1]);
#pragma unroll
            for (int dt = 0; dt < 8; ++dt) { f32x4 acc = Ps[dt];
#pragma unroll
                for (int kb = 0; kb < 4; ++kb) acc = MFMA16(ld128(B + (16 * dt + m) * 288 + (32 * kb + 8 * q) * 2), Sb[kb], acc);
                S[dt] = acc; }
#pragma unroll
            for (int dt = 0; dt < 8; ++dt) Ps[dt] = Pn[dt];
#pragma unroll
            for (int i = 0; i < 4; ++i) *(LAS v4u*)(F.lds + ((seg + 1) & 1) * 36864 + lof + i * (32 * 288)) = pr[i];
            __syncthreads();
        }
#pragma unroll
        for (int dt = 0; dt < 8; ++dt)
#pragma unroll
            for (int r = 0; r < 4; ++r) sst0[((size_t)(NSEG - 1) * 128 + 16 * dt + 4 * q + r) * 128] = S[dt][r];
        __syncthreads();
    }
}

DI void p_scan3(Frame& F, int l) {
    constexpr bool FULL = true;
    const int wave = F.wave;
    const bool is_loader = wave >= 4;
    const int wv = wave & 3;
    for (int job = F.vcu; job < BATCH * GH * NSEG * 2; job += F.G) {
        const int bh = job >> 4, seg = (job >> 1) & (NSEG - 1), dvbase = (job & 1) * 64, n0 = seg * SEGC, b = bh >> 2, h = bh & 3;
        const size_t it0 = (size_t)bh * NCH;
        SC_ADDR()
        if (is_loader) { SC_LOADER_LOOP(); }
        else {
            int tc_ = F.tid; asm volatile("" : "+v"(tc_)); const int lane = tc_ & 63, m = lane & 15, q = lane >> 4;
            f32x4 Sacc[8];
            if (seg == 0) {
#pragma unroll
                for (int dt = 0; dt < 8; ++dt) Sacc[dt] = (f32x4){0.f, 0.f, 0.f, 0.f};
            } else { const float* sst = WSF(WS_SST) + ((size_t)(bh * NSEG + seg) * 128) * 128 + dvbase + 16 * wv + m;
#pragma unroll
                for (int dt = 0; dt < 8; ++dt)
#pragma unroll
                    for (int r = 0; r < 4; ++r) Sacc[dt][r] = sst[(size_t)(16 * dt + 4 * q + r) * 128]; }
            const float glv = WSF(WS_GL)[it0 + lane];
            __syncthreads();
#define FR_W(dst, mt_) do { _Pragma("unroll") for (int kb = 0; kb < 4; ++kb) { dst[kb] = ld128(B + SC_W + (16 * (mt_) + m) * 288 + (32 * kb + 8 * q) * 2); dst[4 + kb] = ld128(B + SC_QD + (16 * (mt_) + m) * 288 + (32 * kb + 8 * q) * 2); } } while (0)
#define MM_W(src, mt_) do { _Pragma("unroll") for (int kb = 0; kb < 4; ++kb) { vn[mt_] = MFMA16(src[kb], Sb[kb], vn[mt_]); o[mt_] = MFMA16(src[4 + kb], Sb[kb], o[mt_]); } } while (0)
#define FR_KT(dst, hf_) do { _Pragma("unroll") for (int i = 0; i < 8; ++i) dst[i] = ld128(B + SC_KT + (16 * (4 * (hf_) + (i >> 1)) + m) * 160 + (32 * (i & 1) + 8 * q) * 2); } while (0)
#define MM_KT(src, hf_) do { _Pragma("unroll") for (int i = 0; i < 8; ++i) Sacc[4 * (hf_) + (i >> 1)] = MFMA16(src[i], vnb[i & 1], Sacc[4 * (hf_) + (i >> 1)]); } while (0)
#pragma unroll 1
            for (int j = 0; j < SEGC; ++j) {
                const int n = n0 + j;
                const LAS unsigned char* B = F.lds + (j & 1) * SC_STAGE;
                bf16x8 fa[8], fb[8], Sb[4], vnb[2];
                f32x4 vn[4], o[4];
                v2u ut[4];
#pragma unroll
                for (int mt = 0; mt < 4; ++mt) ut[mt] = *(const LAS v2u*)(B + SC_U + (16 * wv + m) * 144 + (16 * mt + 4 * q) * 2);
                FR_W(fa, 0); SBAR_();
#pragma unroll
                for (int kb = 0; kb < 4; ++kb) Sb[kb] = pack8(Sacc[2 * kb], Sacc[2 * kb + 1]);
#pragma unroll
                for (int mt = 0; mt < 4; ++mt) { o[mt] = (f32x4){0.f, 0.f, 0.f, 0.f}; vn[mt] = (f32x4){bflo(ut[mt].x), bfhi(ut[mt].x), bflo(ut[mt].y), bfhi(ut[mt].y)}; }
                const float gl = __builtin_bit_cast(float, __builtin_amdgcn_readlane(__builtin_bit_cast(int, glv), n));
                SBAR_(); FR_W(fb, 1); SBAR_(); MM_W(fa, 0); SBAR_();
                FR_W(fa, 2); SBAR_(); MM_W(fb, 1); SBAR_();
                FR_W(fb, 3); SBAR_(); MM_W(fa, 2); SBAR_();
                fa[0] = ld128(B + SC_AT + (m) * 160 + (8 * q) * 2); fa[1] = ld128(B + SC_AT + (16 + m) * 160 + (8 * q) * 2);
                fa[2] = ld128(B + SC_AT + (32 + m) * 160 + (8 * q) * 2); fa[3] = ld128(B + SC_AT + (32 + m) * 160 + (32 + 8 * q) * 2);
                fa[4] = ld128(B + SC_AT + (48 + m) * 160 + (8 * q) * 2); fa[5] = ld128(B + SC_AT + (48 + m) * 160 + (32 + 8 * q) * 2);
                SBAR_(); MM_W(fb, 3); SBAR_();
                vnb[0] = pack8(vn[0], vn[1]); vnb[1] = pack8(vn[2], vn[3]);
#pragma unroll
                for (int dt = 0; dt < 8; ++dt) Sacc[dt] = Sacc[dt] * gl;
                SBAR_(); FR_KT(fb, 0); SBAR_();
                o[0] = MFMA16(fa[0], vnb[0], o[0]); o[1] = MFMA16(fa[1], vnb[0], o[1]); o[2] = MFMA16(fa[2], vnb[0], o[2]); o[3] = MFMA16(fa[4], vnb[0], o[3]);
                o[2] = MFMA16(fa[3], vnb[1], o[2]); o[3] = MFMA16(fa[5], vnb[1], o[3]);
                SBAR_(); FR_KT(fa, 1); SBAR_(); MM_KT(fb, 0); SBAR_();
                MM_KT(fa, 1); SBAR_();
                float* go = WSF(WS_GO) + (size_t)(b * SEQ + n * CH + 4 * q) * GDNW + h * HD + dvbase + 16 * wv + m;
#pragma unroll
                for (int mt = 0; mt < 4; ++mt)
#pragma unroll
                    for (int r = 0; r < 4; ++r) go[(size_t)(16 * mt + r) * GDNW] = o[mt][r];
                WG_BAR();
            }
#undef FR_W
#undef MM_W
#undef FR_KT
#undef MM_KT
        }
        __syncthreads();
    }
}
#undef SC_ADDR
#undef SC_LOAD
#undef SC_WRITE
#undef SC_LOADER_LOOP

DI float gelu_fast(float x) { const float u2 = 1.5957691216057308f * (x + 0.044715f * x * x * x); return x * rcp_(1.f + exp_fast(-u2)); }
struct PostRow { v4u hp[2]; v2u y2[2], z2[2]; f32x4 go[2], cr[2]; };
DI void post_load(Frame& F, PostRow& R, int m, int lane) {
    const int b = m >> 12, n = (m & (SEQ - 1)) >> 6;
#pragma unroll
    for (int j = 0; j < 2; ++j) { const int c = 4 * lane + 256 * j;
        R.hp[j] = *(const v4u*)((const unsigned*)(F.A->ws + WS_H) + (size_t)m * LRUW + c);
        R.cr[j] = *(const f32x4*)(WSF(WS_CARRY) + ((size_t)(b * NCH + n)) * LRUW + c);
        R.y2[j] = *(const v2u*)(WSH(WS_PROJ) + (size_t)m * NPROJ + O_LY + c);
        R.go[j] = *(const f32x4*)(WSF(WS_GO) + (size_t)m * GDNW + c);
        R.z2[j] = *(const v2u*)(WSH(WS_PROJ) + (size_t)m * NPROJ + O_Z + c); }
}
DI void p_post(Frame& F, int l) {
    const int gw = F.vcu * NWAVES + F.wave, NGW = F.G * NWAVES, lane = F.lane;
    PostRow R;
    if (gw < M) post_load(F, R, gw, lane);
    for (int m = gw; m < M; m += NGW) {
        PostRow Rn; const int mn = m + NGW;
        post_load(F, Rn, mn < M ? mn : m, lane);
        f32x4 val[2]; float ss = 0.f;
#pragma unroll
        for (int j = 0; j < 2; ++j) { const v4u hp = R.hp[j]; const v2u y2 = R.y2[j];
            const f32x4 hl = (f32x4){bflo(hp.x), bflo(hp.y), bflo(hp.z), bflo(hp.w)}, p = (f32x4){bfhi(hp.x), bfhi(hp.y), bfhi(hp.z), bfhi(hp.w)};
            const f32x4 hh = hl + p * R.cr[j];
            val[j] = (f32x4){hh.x * gelu_fast(bflo(y2.x)), hh.y * gelu_fast(bfhi(y2.x)), hh.z * gelu_fast(bflo(y2.y)), hh.w * gelu_fast(bfhi(y2.y))};
            ss += (val[j].x * val[j].x + val[j].y * val[j].y) + (val[j].z * val[j].z + val[j].w * val[j].w); }
        ss = wave_sum_(lane, ss);
        const float rl = 1.0f / sqrtf(ss * (1.0f / LRUW) + EPS);
#pragma unroll
        for (int j = 0; j < 2; ++j) { const int c = 4 * lane + 256 * j; const f32x4 nw = *(const f32x4*)(LRU_NORM_W + (size_t)l * LRUW + c);
            const f32x4 o = val[j] * rl * nw; v2u w; w.x = pk2(o.x, o.y); w.y = pk2(o.z, o.w); *(v2u*)(WSH(WS_MIX) + (size_t)m * D + c) = w; }
#pragma unroll
        for (int j = 0; j < 2; ++j) { const int c = 4 * lane + 256 * j, d = c & (HD - 1);
            const f32x4 o = R.go[j]; const v2u z2 = R.z2[j];
            const float s2 = half_sum_(lane, (o.x * o.x + o.y * o.y) + (o.z * o.z + o.w * o.w));
            const float rg = 1.0f / sqrtf(s2 * (1.0f / HD) + EPS);
            const f32x4 nw = *(const f32x4*)(GDN_NORM_W + (size_t)l * HD + d);
            const f32x4 r = (f32x4){o.x * rg * nw.x * silu_fast(bflo(z2.x)), o.y * rg * nw.y * silu_fast(bfhi(z2.x)), o.z * rg * nw.z * silu_fast(bflo(z2.y)), o.w * rg * nw.w * silu_fast(bfhi(z2.y))};
            v2u w; w.x = pk2(r.x, r.y); w.y = pk2(r.z, r.w); *(v2u*)(WSH(WS_MIX) + (size_t)m * D + LRUW + c) = w; }
        R = Rn;
    }
}

DI void p_final(Frame& F) {
    const int gw = F.vcu * NWAVES + F.wave, NGW = F.G * NWAVES, lane = F.lane;
    for (int m = gw; m < M; m += NGW) {
        f32x4 v[4]; float ss = 0.f;
#pragma unroll
        for (int j = 0; j < 4; ++j) { v[j] = *(const f32x4*)(OUT_ + (size_t)m * D + 4 * lane + 256 * j); ss += (v[j].x * v[j].x + v[j].y * v[j].y) + (v[j].z * v[j].z + v[j].w * v[j].w); }
        ss = wave_sum_(F.lane, ss);
        const float rstd = 1.0f / sqrtf(ss * (1.0f / D) + EPS);
#pragma unroll
        for (int j = 0; j < 4; ++j) { const int col = 4 * lane + 256 * j; const f32x4 nw = *(const f32x4*)(FINAL_NORM_W + col); *(f32x4*)(OUT_ + (size_t)m * D + col) = v[j] * rstd * nw; }
    }
}

__device__ __forceinline__ void pg8::EpiMulti::operator()(const f32x4 (&acc)[2][2][4][2], const Unit& u, int wr, int wc, int fr, int fq) const {
    const __attribute__((address_space(4))) Args* ap = (const __attribute__((address_space(4))) Args*)__builtin_amdgcn_kernarg_segment_ptr(); asm volatile("" : "+s"(ap));
    unsigned char* ws = ap->ws;
    const int b = (u.pm * BM) / SEQ;
    if (mode == 0) { EpiBf16<0> e{(bf16_t*)(ws + WS_PROJ), NPROJ, nullptr, 0, 0, 1.f, nullptr}; e(acc, u, wr, wc, fr, fq); }
    else if (mode == 5) { EpiBf16<0> e{(bf16_t*)(ws + WS_PROJ), NPROJ, (const float*)(ws + WS_C1) + ((size_t)l * BATCH + b) * NPROJ, 0, 0, 1.f, (const float*)(ws + WS_RS1)}; e(acc, u, wr, wc, fr, fq); }
    else if (mode == 6) { EpiBf16<2> e{(bf16_t*)(ws + WS_ACT), FF, (const float*)(ws + WS_C2) + ((size_t)l * BATCH + b) * FF, 0, 0, 1.f, (const float*)(ws + WS_RS2)}; e(acc, u, wr, wc, fr, fq); }
    else if (mode == 3) { const float* modb = (const float*)(ws + WS_MOD) + ((size_t)l * BATCH + b) * NMODC;
        EpiResid2 r{l == 0 ? ap->in[0] : ap->out, ap->out, modb + 2 * D, ap->in[3] + (size_t)l * D, modb + 4 * D, (bf16_t*)(ws + WS_H), (float*)(ws + WS_RS2), (float*)(ws + WS_PROJ)}; r(acc, u, wr, wc, fr, fq); }
    else { const float* modb = (const float*)(ws + WS_MOD) + ((size_t)l * BATCH + b) * NMODC; const bool nx = l + 1 < DEPTH;
        EpiResid2 r{ap->out, ap->out, modb + 5 * D, nx ? ap->in[2] + (size_t)(l + 1) * D : nullptr, modb + NMODC * BATCH + D, (bf16_t*)(ws + WS_A1), (float*)(ws + WS_RS1), (float*)(ws + WS_PROJ)}; r(acc, u, wr, wc, fr, fq); }
}

__global__ void __launch_bounds__(NWAVES * 64, 2) mk_fwd(Args args) {
    extern __shared__ __attribute__((aligned(16))) unsigned char lds[];
    Frame F;
    F.lds = (LAS unsigned char*)lds;
    F.MISC = (volatile LAS unsigned*)(F.lds + MISC_OFF);
    F.tid = threadIdx.x; F.lane = F.tid & 63; F.wave = __builtin_amdgcn_readfirstlane(F.tid >> 6);
    F.G = gridDim.x; { const int bx = blockIdx.x; F.vcu = (F.G % 8 == 0) ? (bx % 8) * (F.G / 8) + bx / 8 : bx; }
    F.A = (const __attribute__((address_space(4))) Args*)__builtin_amdgcn_kernarg_segment_ptr();
    F.ctl = (gu32*)(F.A->ws + WS_CTL);
    for (int u = F.tid; u < (LDS_BYTES - LDSCTL_OFF) / 4; u += NWAVES * 64) ((LAS unsigned*)(F.lds + LDSCTL_OFF))[u] = 0u;
    __syncthreads();
    XcdBarrier bar; bar.bar = (unsigned*)(F.ctl + CW_BAR); bar.x = 0; bar.st = nullptr;
    if (N_LAUNCHES == 1) bar = xcd_barrier_post((unsigned*)(F.ctl + CW_BAR), F.MISC + 8);

    const int lo = F.A->ph_lo, hi = F.A->ph_hi;
    int rep_done = 0;
#pragma unroll 1
    for (int s = lo; s < hi; ++s) {
        { const __attribute__((address_space(4))) Args* ap = (const __attribute__((address_space(4))) Args*)__builtin_amdgcn_kernarg_segment_ptr(); asm volatile("" : "+s"(ap)); F.A = ap; }
        { int t_ = threadIdx.x; asm volatile("" : "+v"(t_)); F.tid = t_; F.lane = t_ & 63; F.wave = __builtin_amdgcn_readfirstlane(t_ >> 6); }
        if (s == 0) { if (PH_MASK & 1) { p_mod(F); __syncthreads(); p0_weights(F); xcd_barrier(bar, F.tid == 0); p_cvec(F); } }
        else if (s == N_STEPS - 1) { if (PH_MASK & 2) p_final(F); }
        else {
            const int l = (s - 1) / 9, i = (s - 1) % 9;
            if ((i == 0 && l > 0) || i == 6) continue;
            bf16* wl = WSH(WS_W) + (size_t)l * LAYER_W;
            const float* modl = WSF(WS_MOD) + (size_t)l * BATCH * NMODC;
            if (!((PH_MASK >> (2 + i)) & 1)) {}
            else if (i == 0) { p_normmod<true>(F, l, l == 0 ? X_IN : OUT_, NORM_MIX_W, 0, D); }
            else if (i == 2) { p_prep(F, l); }
            else if (i == 3) {
                p_scan1(F, l); xcd_barrier(bar, F.tid == 0);
#if defined(SCAN_REP) && SCAN_REP == 1
                p_scan1(F, l); xcd_barrier(bar, F.tid == 0);
#endif
                p_scan2(F, l); xcd_barrier(bar, F.tid == 0);
#if defined(SCAN_REP) && SCAN_REP == 2
                p_scan2(F, l); xcd_barrier(bar, F.tid == 0);
#endif
                p_scan3(F, l);
#if defined(SCAN_REP) && SCAN_REP == 3
                xcd_barrier(bar, F.tid == 0); p_scan3(F, l);
#endif
            }
            else if (i == 4) { p_post(F, l); }
            else if (i == 6) { p_normmod<false>(F, l, OUT_, NORM_MLP_W, 3 * D, 4 * D); }
            else {
                pg8::Gemm g; pg8::EpiMulti E; E.l = l;
                if (i == 1) { g = pg8::Gemm{l == 0 ? WSH(WS_H) : WSH(WS_A1), wl, M, NPROJ, D}; E.PERM = true; E.mode = (l == 0 ? 0 : 5); }
                else if (i == 5) { g = pg8::Gemm{WSH(WS_MIX), wl + W_OUT_OFF, M, D, D}; E.PERM = true; E.mode = 3; }
                else if (i == 7) { g = pg8::Gemm{WSH(WS_H), wl + W_UP_OFF, M, FF, D}; E.PERM = true; E.mode = 6; }
                else { g = pg8::Gemm{WSH(WS_ACT), wl + W_DOWN_OFF, M, D, FF}; E.PERM = true; E.mode = 4; }
                pg8::StaticOrder S; S.init(g.M, g.N, F.G, (int)blockIdx.x);
                pg8::gemm_phase<pg8::EpiMulti, pg8::StaticOrder, PG8_ALIGN, PG8_SP2>(F.lds + RING_OFF, g, S, E);
            }
        }
        if (REP_MASK != 0 && ((s >= 1 && s < N_STEPS - 1 && ((REP_MASK >> ((s - 1) % 9)) & 1)) || (s == 0 && (REP_MASK & 0x10000))) && !rep_done) { rep_done = 1; --s; xcd_barrier(bar, F.tid == 0); continue; }
        rep_done = 0;
        if (s + 1 < hi) xcd_barrier(bar, F.tid == 0);
#ifdef PROBE_XBAR
        if (s >= 1 && s < N_STEPS - 1) { xcd_barrier(bar, F.tid == 0); xcd_barrier(bar, F.tid == 0); }
#endif
    }
}

extern "C" void kernel_launch(void* const* d_in, const int* in_sizes, int n_in, void* d_out, int out_size, void* d_ws, size_t ws_size, hipStream_t stream) {
    static int grid = 0;
    if (grid == 0) {
        if (n_in != 23 || in_sizes[0] != M * D || out_size != M * D || ws_size < WS_END) { fprintf(stderr, "kernel_launch: unexpected shapes (n_in %d, in0 %d, out %d, ws %zu); nothing launched\n", n_in, n_in > 0 ? in_sizes[0] : -1, out_size, ws_size); grid = -1; return; }
        int dev = 0, cus = 0;
        if (hipGetDevice(&dev) != hipSuccess || hipDeviceGetAttribute(&cus, hipDeviceAttributeMultiprocessorCount, dev) != hipSuccess) { grid = -1; return; }
        if (hipFuncSetAttribute((const void*)mk_fwd, hipFuncAttributeMaxDynamicSharedMemorySize, LDS_BYTES) != hipSuccess) { fprintf(stderr, "kernel_launch: hipFuncSetAttribute failed\n"); grid = -1; return; }
        (void)hipGetLastError();
        grid = cus;
    }
    if (grid < 0) return;
    if (hipMemsetAsync((char*)d_ws + WS_CTL, 0, CTL_ZERO_BYTES, stream) != hipSuccess) return;
    Args a{};
    for (int i = 0; i < 23; ++i) a.in[i] = (const float*)d_in[i];
    a.out = (float*)d_out; a.ws = (unsigned char*)d_ws;
    if (N_LAUNCHES == 1) { a.ph_lo = 0; a.ph_hi = N_STEPS; hipLaunchKernelGGL(mk_fwd, dim3(grid), dim3(NWAVES * 64), LDS_BYTES, stream, a); }
    else for (int s = 0; s < N_STEPS; ++s) { a.ph_lo = s; a.ph_hi = s + 1; hipLaunchKernelGGL(mk_fwd, dim3(grid), dim3(NWAVES * 64), LDS_BYTES, stream, a); }
}
```

```cpp
#include <hip/hip_runtime.h>
#include <cstdio>
#include <cstdint>
#include <cmath>
namespace pg8 {
#define PG8_LAS __attribute__((address_space(3)))
typedef unsigned short bf16_t;
typedef short bf16x8 __attribute__((ext_vector_type(8)));
typedef float f32x4 __attribute__((ext_vector_type(4)));
typedef unsigned u32x4 __attribute__((ext_vector_type(4)));
constexpr int BM = 256, BK = 64, HALF = 128, HTB = HALF * BK * 2  , STAGE_BYTES = 8 * HTB, NXCD = 8, WGM = 8;

__host__ __device__ __forceinline__ int lds_byte(int r, int c) { const int st = (r >> 4) * 2 + (c >> 5), rr = r & 15, cc = c & 31, ob = rr * 64 + cc * 2; return st * 1024 + (ob ^ (((ob >> 9) & 1) << 5)); }
__host__ __device__ __forceinline__ void stage_rc(int b, int& R, int& C) { const int st = b / 1024, sb = b % 1024, swz = sb ^ (((sb >> 9) & 1) << 5); R = (st >> 1) * 16 + swz / 64; C = (st & 1) * 32 + (swz % 64) / 2; }
__host__ __device__ __forceinline__ int perm32(int rho) { const int n = rho >> 4, i = rho & 15; return 8 * (i >> 2) + 4 * n + (i & 3); }

struct Unit { int pm, pn; };
struct Gemm { const bf16_t* A; const bf16_t* Bt; int M, N, K; };

struct StaticOrder {
    int nM, nN, nwg, G, c;
    __host__ __device__ void init(int M, int N, int G_, int c_) { nM = M / BM; nN = N / BM; nwg = nM * nN; G = G_; c = c_; }
    __host__ __device__ bool next(int i, Unit& u) const {
        const long L = (long)i * G + c; if (L >= nwg) return false;
        int wgid = (int)L; { const int q = nwg / NXCD, r = nwg % NXCD, xcd = wgid % NXCD, off = wgid / NXCD; wgid = (xcd < r ? xcd * (q + 1) : r * (q + 1) + (xcd - r) * q) + off; }
        const int nig = WGM * nN, gid = wgid / nig, fm = gid * WGM, gsz = (nM - fm) < WGM ? (nM - fm) : WGM;
        u.pm = fm + ((wgid % nig) % gsz); u.pn = (wgid % nig) / gsz; return true;
    }
    __device__ __forceinline__ void a_ready(const Unit&) const {}
    __device__ __forceinline__ void done(const Unit&) const {}
};

__device__ __forceinline__ unsigned cvt_pk_bf16(float lo, float hi) { unsigned r; asm volatile("v_cvt_pk_bf16_f32 %0, %1, %2" : "=v"(r) : "v"(lo), "v"(hi)); return r; }
typedef float f32x2 __attribute__((ext_vector_type(2)));
__device__ __forceinline__ f32x2 gelu_pk(f32x2 v) {
    const f32x2 av = __builtin_elementwise_abs(v), d = av * 0.2316418882f + 1.0f;
    f32x2 t; t.x = __builtin_amdgcn_rcpf(d.x); t.y = __builtin_amdgcn_rcpf(d.y);
    f32x2 q = t * 0.5307027145f + (-0.7265760135f); q = q * t + 0.7107068705f; q = q * t + (-0.142248368f); q = q * t + 0.127414796f; q = q * t;
    const f32x2 s = (v * v) * (-0.72134752044f);
    f32x2 e; e.x = __builtin_amdgcn_exp2f(s.x); e.y = __builtin_amdgcn_exp2f(s.y);
    const f32x2 m = v * (q * e), r = v - m;
    f32x2 o; o.x = v.x < 0.f ? m.x : r.x; o.y = v.y < 0.f ? m.y : r.y; return o;
}

template <int ACT  > struct EpiBf16 {
    static constexpr bool PERM = true, AFTER_DRAIN = false; static_assert(ACT == 0 || ACT == 1 || ACT == 2, "EpiBf16: ACT is 0 (none), 1 (gelu_pk) or 2 (squared relu)");
    bf16_t* O; int ldc; const float* bias; int split_cols; size_t split_stride; float scale0;
    const float* rs = nullptr;
    __device__ __forceinline__ void operator()(const f32x4 (&acc)[2][2][4][2], const Unit& u, int wr, int wc, int fr, int fq) const {
        const int row0 = u.pm * BM + wr * 64 + fr; int colt = u.pn * BM; bf16_t* base = O;
        float sc = 1.f; if (split_cols) { const int t = colt / split_cols; base += (size_t)t * split_stride; colt -= t * split_cols; if (t == 0) sc = scale0; }
        const int col0 = colt + wc * 32 + 8 * fq, bcol0 = u.pn * BM + wc * 32 + 8 * fq;
        f32x4 bv[2][2];
#pragma unroll
        for (int bj = 0; bj < 2; ++bj)
#pragma unroll
            for (int n = 0; n < 2; ++n) bv[bj][n] = bias ? *(const f32x4*)(bias + bcol0 + bj * HALF + 4 * n) : (f32x4){0.f, 0.f, 0.f, 0.f};
#pragma unroll
        for (int ai = 0; ai < 2; ++ai)
#pragma unroll
            for (int m = 0; m < 4; ++m) { bf16_t* rowp = base + (size_t)(row0 + ai * HALF + m * 16) * ldc + col0;
                float rsc = 1.f;
                if (rs) { const f32x4* rp = (const f32x4*)(rs + (size_t)(row0 + ai * HALF + m * 16) * 16); const f32x4 p0 = rp[0], p1 = rp[1], p2 = rp[2], p3 = rp[3];
                    const f32x4 t = (p0 + p1) + (p2 + p3); rsc = 1.0f / sqrtf(((t[0] + t[1]) + (t[2] + t[3])) * (1.0f / 1024.0f) + 1e-6f); }
#pragma unroll
                for (int bj = 0; bj < 2; ++bj) { f32x4 v0 = acc[ai][bj][m][0] * rsc + bv[bj][0], v1 = acc[ai][bj][m][1] * rsc + bv[bj][1];
                    if (ACT == 1) { f32x2 a = gelu_pk((f32x2){v0[0], v0[1]}), b = gelu_pk((f32x2){v0[2], v0[3]}), c = gelu_pk((f32x2){v1[0], v1[1]}), d = gelu_pk((f32x2){v1[2], v1[3]});
                        v0 = (f32x4){a.x, a.y, b.x, b.y}; v1 = (f32x4){c.x, c.y, d.x, d.y}; }
                    if (ACT == 2) { _Pragma("unroll") for (int q_ = 0; q_ < 4; ++q_) { const float a_ = fmaxf(v0[q_], 0.f), b_ = fmaxf(v1[q_], 0.f); v0[q_] = a_ * a_; v1[q_] = b_ * b_; } }
                    v0 = v0 * sc; v1 = v1 * sc; u32x4 w; w.x = cvt_pk_bf16(v0[0], v0[1]); w.y = cvt_pk_bf16(v0[2], v0[3]); w.z = cvt_pk_bf16(v1[0], v1[1]); w.w = cvt_pk_bf16(v1[2], v1[3]);
                    *(u32x4*)(rowp + bj * HALF) = w; } }
    }
};


struct EpiResid {
    static constexpr bool PERM = false, AFTER_DRAIN = false;
    const float* base; float* out; const float* gate; int ldc; int gate_stride; int rows_per_batch;
    __device__ __forceinline__ void operator()(const f32x4 (&acc)[2][2][4][2], const Unit& u, int wr, int wc, int fr, int fq) const {
        const int col0 = u.pn * BM + wc * 32 + 4 * fq;
        const float* gp = gate + (size_t)((u.pm * BM) / rows_per_batch) * gate_stride + col0;
        f32x4 gv[2][2];
#pragma unroll
        for (int bj = 0; bj < 2; ++bj)
#pragma unroll
            for (int n = 0; n < 2; ++n) gv[bj][n] = *(const f32x4*)(gp + bj * HALF + n * 16);
#pragma unroll
        for (int ai = 0; ai < 2; ++ai)
#pragma unroll
            for (int m = 0; m < 4; ++m) { const size_t off = (size_t)(u.pm * BM + ai * HALF + wr * 64 + m * 16 + fr) * ldc + col0;
#pragma unroll
                for (int bj = 0; bj < 2; ++bj)
#pragma unroll
                    for (int n = 0; n < 2; ++n) { const f32x4 bs = *(const f32x4*)(base + off + bj * HALF + n * 16);
                        *(f32x4*)(out + off + bj * HALF + n * 16) = bs + gv[bj][n] * acc[ai][bj][m][n]; } }
    }
};


struct EpiResid2 {
    static constexpr bool PERM = true, AFTER_DRAIN = false;
    const float* base; float* out; const float* gate;
    const float* nw; const float* sc;
    bf16_t* anext; float* rsum; float* dup = nullptr;
    __device__ __forceinline__ void operator()(const f32x4 (&acc)[2][2][4][2], const Unit& u, int wr, int wc, int fr, int fq) const {
        const int col0 = u.pn * BM + wc * 32 + 8 * fq, lane = fr + 16 * fq;
        f32x4 gv[2][2], ns[2][2];
#pragma unroll
        for (int bj = 0; bj < 2; ++bj)
#pragma unroll
            for (int n = 0; n < 2; ++n) { const int c = col0 + bj * HALF + 4 * n; gv[bj][n] = *(const f32x4*)(gate + c);
                ns[bj][n] = nw ? *(const f32x4*)(nw + c) * (*(const f32x4*)(sc + c) + 1.0f) : (f32x4){0.f, 0.f, 0.f, 0.f}; }
#pragma unroll
        for (int ai = 0; ai < 2; ++ai)
#pragma unroll
            for (int m = 0; m < 4; ++m) { const size_t off = (size_t)(u.pm * BM + ai * HALF + wr * 64 + m * 16 + fr) * 1024 + col0;
                f32x4 bs[2][2];
#pragma unroll
                for (int bj = 0; bj < 2; ++bj)
#pragma unroll
                    for (int n = 0; n < 2; ++n) bs[bj][n] = *(const f32x4*)(base + off + bj * HALF + 4 * n);
                float ssq = 0.f;
#pragma unroll
                for (int bj = 0; bj < 2; ++bj) { const f32x4 x0 = bs[bj][0] + gv[bj][0] * acc[ai][bj][m][0], x1 = bs[bj][1] + gv[bj][1] * acc[ai][bj][m][1];
                    *(f32x4*)(out + off + bj * HALF) = x0; *(f32x4*)(out + off + bj * HALF + 4) = x1;
#ifdef PROBE_EPI_DUP
                    *(f32x4*)(dup + off + bj * HALF) = x0; *(f32x4*)(dup + off + bj * HALF + 4) = x1;
#endif
                    if (nw) { const f32x4 h0 = x0 * ns[bj][0], h1 = x1 * ns[bj][1]; u32x4 w; w.x = cvt_pk_bf16(h0[0], h0[1]); w.y = cvt_pk_bf16(h0[2], h0[3]); w.z = cvt_pk_bf16(h1[0], h1[1]); w.w = cvt_pk_bf16(h1[2], h1[3]);
                        *(u32x4*)(anext + off + bj * HALF) = w;
                        ssq += ((x0[0] * x0[0] + x0[1] * x0[1]) + (x0[2] * x0[2] + x0[3] * x0[3])) + ((x1[0] * x1[0] + x1[1] * x1[1]) + (x1[2] * x1[2] + x1[3] * x1[3])); } }
                if (nw) { ssq += __builtin_bit_cast(float, __builtin_amdgcn_ds_bpermute((lane ^ 16) << 2, __builtin_bit_cast(int, ssq)));
                    ssq += __builtin_bit_cast(float, __builtin_amdgcn_ds_bpermute((lane ^ 32) << 2, __builtin_bit_cast(int, ssq)));
                    if (fq == 0) rsum[(size_t)(u.pm * BM + ai * HALF + wr * 64 + m * 16 + fr) * 16 + u.pn * 4 + wc] = ssq; }
                if (m & 1) asm volatile("" ::: "memory"); }
    }
};

struct EpiMulti {
    static constexpr bool AFTER_DRAIN = false;
    bool PERM; int mode, l;
    __device__ __forceinline__ void operator()(const f32x4 (&acc)[2][2][4][2], const Unit& u, int wr, int wc, int fr, int fq) const;
};

template <class Epi, class Sched, bool ALIGN_EPI = false, bool SP2 = false>
__device__ __forceinline__ void gemm_phase(PG8_LAS unsigned char* lds, const Gemm g, const Sched& S, const Epi& E) {
    int tid_l = threadIdx.x; asm volatile("" : "+v"(tid_l));
    const int tid = tid_l, wid = __builtin_amdgcn_readfirstlane(tid >> 6), lane = tid & 63, wr = wid >> 2, wc = wid & 3, fr = lane & 15, fq = lane >> 4;
    const int K = g.K, nt = K / BK;
    unsigned voffA[2], voffB[2];
#pragma unroll
    for (int i = 0; i < 2; ++i) { int R, C; stage_rc(tid * 16 + i * 8192, R, C); const int Rb = E.PERM ? ((R & ~31) + perm32(R & 31)) : R;
        voffA[i] = (unsigned)(R * K + C) * 2u; voffB[i] = (unsigned)(Rb * K + C) * 2u; }
    const size_t kstep = (size_t)(BK * 2);
    const size_t hstep = (size_t)HALF * K * 2;
    const size_t tstep = 2 * hstep;
    const unsigned ldsw = (unsigned)wid * 1024u;
    const int aoff = lds_byte(wr * 64 + fr, fq * 8), boff = lds_byte(wc * 32 + fr, fq * 8);
#define PG8_SA(b, h) (((b) * 2 + (h)) * HTB)
#define PG8_SB(b, h) ((4 + (b) * 2 + (h)) * HTB)
#define PG8_STAGE(bufoff, gbase, voff) do { _Pragma("unroll") for (int _i = 0; _i < 2; ++_i) \
        __builtin_amdgcn_global_load_lds((const unsigned*)((const char*)(gbase) + (voff)[_i]), (PG8_LAS unsigned*)(lds + (bufoff) + ldsw + _i * 8192), 16, 0, 0); } while (0)
#define PG8_LDA(dst, b, h) do { _Pragma("unroll") for (int m = 0; m < 4; ++m) _Pragma("unroll") for (int k = 0; k < 2; ++k) dst[m][k] = *(const PG8_LAS bf16x8*)(lds + PG8_SA(b, h) + aoff + m * 2048 + k * 1024); } while (0)
#define PG8_LDB(dst, b, h) do { _Pragma("unroll") for (int n = 0; n < 2; ++n) _Pragma("unroll") for (int k = 0; k < 2; ++k) dst[n][k] = *(const PG8_LAS bf16x8*)(lds + PG8_SB(b, h) + boff + n * 2048 + k * 1024); } while (0)
#define PG8_MMA(ai, bj, At, Bt) do { __builtin_amdgcn_s_setprio(1); _Pragma("unroll") for (int m = 0; m < 4; ++m) _Pragma("unroll") for (int n = 0; n < 2; ++n) _Pragma("unroll") for (int k = 0; k < 2; ++k) \
        acc[ai][bj][m][n] = __builtin_amdgcn_mfma_f32_16x16x32_bf16(Bt[n][k], At[m][k], acc[ai][bj][m][n], 0, 0, 0); __builtin_amdgcn_s_setprio(0); } while (0)
#define PG8_WAIT_V(n) asm volatile("s_waitcnt vmcnt(" #n ")" ::: "memory")
#define PG8_WAIT_L(n) asm volatile("s_waitcnt lgkmcnt(" #n ")" ::: "memory")
#define PG8_BAR __builtin_amdgcn_s_barrier()
#define PG8_SCHED __builtin_amdgcn_sched_barrier(0)
    Unit cur, nxt; int ui = 0;
    if (!S.next(0, cur)) return;
    f32x4 acc[2][2][4][2];
#pragma unroll
    for (int a = 0; a < 2; ++a)
#pragma unroll
        for (int b = 0; b < 2; ++b)
#pragma unroll
            for (int m = 0; m < 4; ++m)
#pragma unroll
                for (int n = 0; n < 2; ++n) acc[a][b][m][n] = (f32x4){0.f, 0.f, 0.f, 0.f};
    bf16x8 At[4][2], B0[2][2], B1[2][2];
    const char* cA = (const char*)g.A + (size_t)cur.pm * tstep; const char* cB = (const char*)g.Bt + (size_t)cur.pn * tstep;
    S.a_ready(cur);
    if constexpr (SP2) {
        PG8_STAGE(PG8_SB(0, 0), cB, voffB); PG8_STAGE(PG8_SB(0, 1), cB + hstep, voffB); PG8_STAGE(PG8_SA(0, 0), cA, voffA); PG8_STAGE(PG8_SA(0, 1), cA + hstep, voffA);
        if (wr == 1) PG8_BAR;
        PG8_WAIT_V(2); PG8_BAR;
        PG8_STAGE(PG8_SB(1, 0), cB + kstep, voffB); PG8_STAGE(PG8_SA(1, 0), cA + kstep, voffA); PG8_STAGE(PG8_SB(1, 1), cB + hstep + kstep, voffB);
        PG8_WAIT_V(6); PG8_BAR;
    } else {
        PG8_STAGE(PG8_SB(0, 0), cB, voffB); PG8_STAGE(PG8_SA(0, 0), cA, voffA); PG8_STAGE(PG8_SB(0, 1), cB + hstep, voffB); PG8_STAGE(PG8_SA(0, 1), cA + hstep, voffA);
        if (wr == 1) PG8_BAR;
        PG8_WAIT_V(4); PG8_BAR;
        PG8_STAGE(PG8_SB(1, 0), cB + kstep, voffB); PG8_STAGE(PG8_SA(1, 0), cA + kstep, voffA); PG8_STAGE(PG8_SB(1, 1), cB + hstep + kstep, voffB);
        PG8_WAIT_V(6); PG8_BAR;
    }
    for (;;) {
        const bool has_next = S.next(ui + 1, nxt);
        const char* nA = has_next ? (const char*)g.A + (size_t)nxt.pm * tstep : cA; const char* nB = has_next ? (const char*)g.Bt + (size_t)nxt.pn * tstep : cB;
        for (int t = 0; t < nt; t += 2) {
            const bool last = (t == nt - 2);
            const char* a1 = cA + (size_t)(t + 1) * kstep;
            const char* a2 = last ? nA : cA + (size_t)(t + 2) * kstep; const char* b2 = last ? nB : cB + (size_t)(t + 2) * kstep;
            const char* a3 = a2 + kstep; const char* b3 = b2 + kstep;
            if (last && has_next) S.a_ready(nxt);
            if constexpr (SP2) {
            PG8_LDB(B0, 0, 0); PG8_LDB(B1, 0, 1); PG8_SCHED; PG8_LDA(At, 0, 0); PG8_STAGE(PG8_SA(1, 1), a1 + hstep, voffA);
            PG8_WAIT_V(8); PG8_WAIT_L(0); PG8_BAR; PG8_MMA(0, 0, At, B0); PG8_MMA(0, 1, At, B1); PG8_BAR; PG8_SCHED;
            PG8_LDA(At, 0, 1); PG8_STAGE(PG8_SB(0, 0), b2, voffB); PG8_STAGE(PG8_SB(0, 1), b2 + hstep, voffB); PG8_STAGE(PG8_SA(0, 0), a2, voffA);
            PG8_WAIT_V(8); PG8_WAIT_L(0); PG8_BAR; PG8_MMA(1, 0, At, B0); PG8_MMA(1, 1, At, B1); PG8_BAR; PG8_SCHED;
            PG8_LDB(B0, 1, 0); PG8_LDB(B1, 1, 1); PG8_SCHED; PG8_LDA(At, 1, 0); PG8_STAGE(PG8_SA(0, 1), a2 + hstep, voffA);
            PG8_WAIT_V(8); PG8_WAIT_L(0); PG8_BAR; PG8_MMA(0, 0, At, B0); PG8_MMA(0, 1, At, B1); PG8_BAR; PG8_SCHED;
            PG8_LDA(At, 1, 1); PG8_STAGE(PG8_SB(1, 0), b3, voffB); PG8_STAGE(PG8_SB(1, 1), b3 + hstep, voffB); PG8_STAGE(PG8_SA(1, 0), a3, voffA);
            PG8_WAIT_V(8); PG8_WAIT_L(0); PG8_BAR; PG8_MMA(1, 0, At, B0); PG8_MMA(1, 1, At, B1); PG8_BAR; PG8_SCHED;
            } else {
            PG8_LDB(B0, 0, 0); PG8_SCHED; PG8_LDA(At, 0, 0); PG8_STAGE(PG8_SA(1, 1), a1 + hstep, voffA);
            PG8_WAIT_L(8); PG8_BAR; PG8_WAIT_L(0); PG8_MMA(0, 0, At, B0); PG8_BAR; PG8_SCHED;
            PG8_LDB(B1, 0, 1); PG8_STAGE(PG8_SB(0, 0), b2, voffB);
            PG8_BAR; PG8_WAIT_L(0); PG8_MMA(0, 1, At, B1); PG8_BAR;
            PG8_LDA(At, 0, 1); PG8_STAGE(PG8_SA(0, 0), a2, voffA);
            PG8_BAR; PG8_WAIT_L(0); PG8_MMA(1, 0, At, B0); PG8_BAR; PG8_SCHED;
            PG8_STAGE(PG8_SB(0, 1), b2 + hstep, voffB);
            PG8_WAIT_V(6); PG8_BAR; PG8_MMA(1, 1, At, B1); PG8_BAR;
            PG8_LDB(B0, 1, 0); PG8_SCHED; PG8_LDA(At, 1, 0); PG8_STAGE(PG8_SA(0, 1), a2 + hstep, voffA);
            PG8_WAIT_L(8); PG8_BAR; PG8_WAIT_L(0); PG8_MMA(0, 0, At, B0); PG8_BAR; PG8_SCHED;
            PG8_LDB(B1, 1, 1); PG8_STAGE(PG8_SB(1, 0), b3, voffB);
            PG8_BAR; PG8_WAIT_L(0); PG8_MMA(0, 1, At, B1); PG8_BAR;
            PG8_LDA(At, 1, 1); PG8_STAGE(PG8_SA(1, 0), a3, voffA);
            PG8_BAR; PG8_WAIT_L(0); PG8_MMA(1, 0, At, B0); PG8_BAR; PG8_SCHED;
            PG8_STAGE(PG8_SB(1, 1), b3 + hstep, voffB);
            PG8_WAIT_V(6); PG8_BAR; PG8_MMA(1, 1, At, B1); PG8_BAR;
            }
        }
        if constexpr (ALIGN_EPI) { if (wr == 0) PG8_BAR; }
        if constexpr (!Epi::AFTER_DRAIN) { E(acc, cur, wr, wc, fr, fq); S.done(cur); }
        if (!has_next) break;
#pragma unroll
        for (int a = 0; a < 2; ++a)
#pragma unroll
            for (int b = 0; b < 2; ++b)
#pragma unroll
                for (int m = 0; m < 4; ++m)
#pragma unroll
                    for (int n = 0; n < 2; ++n) acc[a][b][m][n] = (f32x4){0.f, 0.f, 0.f, 0.f};
        cur = nxt; cA = nA; cB = nB; ++ui;
        if constexpr (ALIGN_EPI) { if (wr == 1) PG8_BAR; }
    }
    PG8_WAIT_V(0);
    if constexpr (!ALIGN_EPI) { if (wr == 0) PG8_BAR; }
    PG8_BAR;
    if constexpr (Epi::AFTER_DRAIN) { E.fused(acc, cur, wr, wc, fr, fq, lds, wid, lane); S.done(cur); }
#undef PG8_SA
#undef PG8_SB
#undef PG8_STAGE
#undef PG8_LDA
#undef PG8_LDB
#undef PG8_MMA
#undef PG8_WAIT_V
#undef PG8_WAIT_L
#undef PG8_BAR
#undef PG8_SCHED
}
}
#define GAS __attribute__((address_space(1)))
#define LAS __attribute__((address_space(3)))
typedef unsigned short bf16;
typedef unsigned v4u __attribute__((ext_vector_type(4)));
typedef float f32x4 __attribute__((ext_vector_type(4)));
typedef short bf16x8 __attribute__((ext_vector_type(8)));
typedef GAS unsigned gu32;
typedef GAS unsigned long long gu64;
#define RLX_AGENT __ATOMIC_RELAXED, __HIP_MEMORY_SCOPE_AGENT
#define LDS_WAIT() asm volatile("s_waitcnt lgkmcnt(0)" ::: "memory")
#define VM_WAIT() asm volatile("s_waitcnt vmcnt(0)" ::: "memory")
__device__ __forceinline__ unsigned long long rt() { return __builtin_amdgcn_s_memrealtime(); }
__device__ __forceinline__ unsigned f2bf(float f) { unsigned u = __builtin_bit_cast(unsigned, f); return (u + 0x7fffu + ((u >> 16) & 1u)) >> 16; }
__device__ __forceinline__ unsigned pk2(float lo, float hi) { return f2bf(lo) | (f2bf(hi) << 16); }

#define XB_TMO      128
#define XB_XCNT(j)  (256  + 64 * (j))
#define XB_XSUB(j)  (1280 + 64 * (j))
#define XB_XGEN(j)  (2304 + 64 * (j))
#define XB_TOP      3328
#define XB_TOPGEN   3392
#define XCD_BAR_WORDS 3456
#define XB_SPIN_CAP (1u << 18)

__device__ __forceinline__ unsigned xb_ld(unsigned* p)              { return __hip_atomic_load(p, __ATOMIC_RELAXED, __HIP_MEMORY_SCOPE_AGENT); }
__device__ __forceinline__ unsigned xb_add(unsigned* p, unsigned v) { return __hip_atomic_fetch_add(p, v, __ATOMIC_RELAXED, __HIP_MEMORY_SCOPE_AGENT); }
__device__ __forceinline__ unsigned xb_xcc_id() { return (unsigned)__builtin_amdgcn_s_getreg((3 << 11) | 20) & 0xFu; }
#define XB_SPIN(cond, bar) do { unsigned _sp = 0; while (cond) { __builtin_amdgcn_s_sleep(1); \
    if ((++_sp & 255u) == 0u) { if (xb_ld(&(bar)[XB_TMO])) break; if (_sp > XB_SPIN_CAP) { atomicAdd(&(bar)[XB_TMO], 1u); break; } } } } while (0)

struct XcdBarrier {
    unsigned* bar; unsigned x;
    volatile LAS unsigned* st;
};

__device__ __forceinline__ XcdBarrier xcd_barrier_post(unsigned* bar, volatile LAS unsigned* st) {
    XcdBarrier b; b.bar = bar; b.x = xb_xcc_id(); b.st = st;
    if (threadIdx.x == 0) (void)xb_add(&bar[XB_XCNT(b.x)], 1u);
    return b;
}
__device__ __forceinline__ void xcd_barrier_complete(unsigned* bar, unsigned x, unsigned& nloc, unsigned& nx) {
    const unsigned G = gridDim.x * gridDim.y * gridDim.z;
    unsigned sum, cnt, mine, sp = 0u;
    for (;;) {
        sum = 0u; cnt = 0u; mine = 0u;
#pragma unroll
        for (unsigned j = 0; j < 16; ++j) { const unsigned c = xb_ld(&bar[XB_XCNT(j)]); sum += c; cnt += (c > 0u) ? 1u : 0u; mine = (j == x) ? c : mine; }
        if (sum == G) break;
        __builtin_amdgcn_s_sleep(1);
        if ((++sp & 255u) == 0u) { if (xb_ld(&bar[XB_TMO])) break; if (sp > XB_SPIN_CAP) { atomicAdd(&bar[XB_TMO], 1u); break; } }
    }
    nloc = mine > 0u ? mine : 1u; nx = cnt > 0u ? cnt : 1u;
}

__device__ __forceinline__ void xcd_barrier(const XcdBarrier& b, const bool t0  ) {
    asm volatile("s_waitcnt vmcnt(0)" ::: "memory");
    __syncthreads();
    if (t0) {
        unsigned* bar = b.bar;
        __builtin_amdgcn_s_waitcnt(0);
        unsigned nloc = b.st[0], nx = b.st[1];
        if (nloc == 0u) { xcd_barrier_complete(bar, b.x, nloc, nx); b.st[0] = nloc; b.st[1] = nx; }
        const unsigned old = xb_add(&bar[XB_XSUB(b.x)], 1u);
        const unsigned gen = old / nloc;
        if (old + 1u == (gen + 1u) * nloc) {
            __builtin_amdgcn_fence(__ATOMIC_RELEASE, "agent");
            asm volatile("s_waitcnt vmcnt(0)" ::: "memory");
            const unsigned og = xb_add(&bar[XB_TOP], 1u);
            const unsigned tg = og / nx;
            if (og + 1u == (tg + 1u) * nx) xb_add(&bar[XB_TOPGEN], 1u);
            else XB_SPIN(xb_ld(&bar[XB_TOPGEN]) == tg, bar);
            __builtin_amdgcn_fence(__ATOMIC_ACQUIRE, "agent");
            xb_add(&bar[XB_XGEN(b.x)], 1u);
            asm volatile("s_waitcnt vmcnt(0)" ::: "memory");
        } else {
            XB_SPIN(xb_ld(&bar[XB_XGEN(b.x)]) == gen, bar);
            __builtin_amdgcn_fence(__ATOMIC_ACQUIRE, "agent");
            asm volatile("s_waitcnt vmcnt(0)" ::: "memory");
        }
    }
    __syncthreads();
}

#ifndef PG8_SP2
#define PG8_SP2 true
#endif
#ifndef PG8_ALIGN
#define PG8_ALIGN true
#endif
constexpr int NWAVES = 8;
constexpr int N_STEPS = 38;
#ifndef MK_N_LAUNCHES
#define MK_N_LAUNCHES 1
#endif
#ifndef PH_MASK
#define PH_MASK 0xffff
#endif
#ifndef REP_MASK
#define REP_MASK 0
#endif
#ifndef PREP_REP_LRU
#define PREP_REP_LRU 1
#endif
#ifndef PREP_REP_GDN
#define PREP_REP_GDN 1
#endif
constexpr int N_LAUNCHES = MK_N_LAUNCHES;

constexpr int D = 1024, BATCH = 4, SEQ = 4096, DEPTH = 4, M = BATCH * SEQ;
constexpr int LRUW = 512, NGB = 8, GBW = 64, GH = 4, HD = 128, GDNW = 512, CH = 64, NCH = SEQ / CH, FF = 4096;
constexpr int NMODC = 6 * D, INC = 3080, NPROJ = 3072;
constexpr int O_LX = 0, O_LY = 512, O_Q = 1024, O_Z = 2560;
constexpr float EPS = 1e-6f;

constexpr size_t MiB = 1u << 20;
constexpr size_t WS_CTL = 0, CTL_ZERO_BYTES = 1 * MiB;
constexpr size_t WS_MOD = 1 * MiB;
constexpr size_t WS_BG = 2 * MiB;
constexpr size_t WS_AGG = 3 * MiB;
constexpr size_t WS_CARRY = 4 * MiB;
constexpr size_t WS_GL = 5 * MiB;
constexpr size_t WS_GT = 6 * MiB;
constexpr size_t WS_C1 = 6 * MiB + 512 * 1024;
constexpr size_t WS_C2 = 6 * MiB + 768 * 1024;
constexpr size_t WS_CB8 = 7 * MiB;
constexpr size_t WS_W8T = 7 * MiB + 64 * 1024;
constexpr size_t WS_RS1 = 364 * MiB, WS_RS2 = 365 * MiB;
constexpr size_t WS_A1 = 312 * MiB;
constexpr size_t WS_W = 8 * MiB;
constexpr size_t LAYER_W = (size_t)12288 * 1024;
constexpr size_t W_OUT_OFF = (size_t)3072 * 1024, W_UP_OFF = (size_t)4096 * 1024, W_DOWN_OFF = (size_t)8192 * 1024;
constexpr size_t WS_H = 104 * MiB;
constexpr size_t WS_MIX = 136 * MiB;
constexpr size_t WS_PROJ = 168 * MiB;
constexpr size_t WS_ACT = 168 * MiB;
constexpr size_t WS_GQD = 264 * MiB, WS_GKT = 280 * MiB;
constexpr size_t WS_GATT = 296 * MiB;
constexpr size_t WS_GO = 312 * MiB;
constexpr size_t WS_LRUP = 344 * MiB;
constexpr size_t WS_END = 376 * MiB;
constexpr int CW_BAR = 4096;

constexpr int RING_OFF = 0, RING_BYTES = 155648;
constexpr int LDSCTL_OFF = RING_BYTES, MISC_OFF = LDSCTL_OFF + 320;
constexpr int LDS_BYTES = 156672;

typedef unsigned v2u __attribute__((ext_vector_type(2)));
#define DI __device__ __forceinline__
DI float bf2f(unsigned b) { return __builtin_bit_cast(float, b << 16); }
DI float bflo(unsigned w) { return __builtin_bit_cast(float, w << 16); }
DI float bfhi(unsigned w) { return __builtin_bit_cast(float, w & 0xffff0000u); }
DI float sigmoidf_(float x) { return 1.f / (1.f + expf(-x)); }
DI float siluf_(float x) { return x / (1.f + expf(-x)); }
DI float rcp_(float x) { return __builtin_amdgcn_rcpf(x); }
DI float exp_fast(float x) { return __builtin_amdgcn_exp2f(x * 1.4426950408889634f); }
DI float sigmoid_fast(float x) { return rcp_(1.f + exp_fast(-x)); }
DI float silu_fast(float x) { return x * rcp_(1.f + exp_fast(-x)); }
DI float gelu_tanh(float x) { const float u = 0.7978845608028654f * (x + 0.044715f * x * x * x); return 0.5f * x * (1.f + tanhf(u)); }
DI float bperm_(int src_lane, float v) { return __builtin_bit_cast(float, __builtin_amdgcn_ds_bpermute(src_lane << 2, __builtin_bit_cast(int, v))); }
DI float wave_sum_(int lane, float v) {
#pragma unroll
    for (int o = 1; o < 64; o <<= 1) v += bperm_(lane ^ o, v);
    return v;
}
DI float half_sum_(int lane, float v) {
#pragma unroll
    for (int o = 1; o < 32; o <<= 1) v += bperm_(lane ^ o, v);
    return v;
}
DI float shfl_up_(int lane, float v, int off) { return bperm_(lane >= off ? lane - off : lane, v); }

struct Args { const float* in[23]; float* out; unsigned char* ws; int ph_lo, ph_hi; };
static_assert(sizeof(Args) == 23 * 8 + 8 + 8 + 8, "Args has no padding");
struct Frame {
    LAS unsigned char* lds;
    volatile LAS unsigned* MISC;
    gu32* ctl;
    int tid, lane, wave;
    int vcu, G;
    const __attribute__((address_space(4))) Args* A;
};
#define IN_(k) (F.A->in[k])
#define X_IN IN_(0)
#define C_IN IN_(1)
#define NORM_MIX_W IN_(2)
#define NORM_MLP_W IN_(3)
#define W_MOD IN_(4)
#define B_MOD IN_(5)
#define W_IN IN_(6)
#define LRU_CONV_W IN_(7)
#define LRU_CONV_B IN_(8)
#define GATE_A_W IN_(9)
#define GATE_A_B IN_(10)
#define GATE_X_W IN_(11)
#define GATE_X_B IN_(12)
#define LRU_LAMBDA IN_(13)
#define LRU_NORM_W IN_(14)
#define GDN_CONV_W IN_(15)
#define GDN_A_LOG IN_(16)
#define GDN_DT_BIAS IN_(17)
#define GDN_NORM_W IN_(18)
#define W_OUT IN_(19)
#define W_UP IN_(20)
#define W_DOWN IN_(21)
#define FINAL_NORM_W IN_(22)
#define OUT_ (F.A->out)
#define WSF(off) ((float*)(F.A->ws + (off)))
#define WSH(off) ((bf16*)(F.A->ws + (off)))

DI void p_mod(Frame& F) {
    LAS float* cs = (LAS float*)F.lds;
    LAS float* red = cs + 4096;
    for (int i = F.tid; i < BATCH * D; i += NWAVES * 64) cs[i] = siluf_(C_IN[i]);
    __syncthreads();
    const int hl = F.lane >> 5, cl = F.lane & 31;
    for (int item = F.vcu; item < DEPTH * 192; item += F.G) {
        const int l = item / 192, cg = item % 192, col = cg * 32 + cl, kbase = F.wave * 128 + hl * 64;
        const float* wp = W_MOD + ((size_t)l * D + kbase) * NMODC + col;
        float a0 = 0.f, a1 = 0.f, a2 = 0.f, a3 = 0.f;
#pragma unroll 16
        for (int kk = 0; kk < 64; ++kk) { const float wv = wp[(size_t)kk * NMODC]; const int k = kbase + kk;
            a0 += cs[k] * wv; a1 += cs[1024 + k] * wv; a2 += cs[2048 + k] * wv; a3 += cs[3072 + k] * wv; }
        const int sl = F.wave * 2 + hl;
        red[(sl * 4 + 0) * 32 + cl] = a0; red[(sl * 4 + 1) * 32 + cl] = a1; red[(sl * 4 + 2) * 32 + cl] = a2; red[(sl * 4 + 3) * 32 + cl] = a3;
        __syncthreads();
        if (F.tid < 128) { const int b = F.tid >> 5, ln = F.tid & 31; float sum = 0.f;
#pragma unroll
            for (int w = 0; w < 16; ++w) sum += red[(w * 4 + b) * 32 + ln];
            const int cc = cg * 32 + ln; WSF(WS_MOD)[((size_t)l * BATCH + b) * NMODC + cc] = sum + B_MOD[(size_t)l * NMODC + cc]; }
        __syncthreads();
    }
}

struct TrItem { const float* src; bf16* dst; int K, ldw; };
DI void p0_item(Frame& F, int it, TrItem& T) {
    constexpr int I_IN = (D / 64) * (NPROJ / 32), I_OUT = (D / 64) * (D / 32), I_UP = (D / 64) * (FF / 32), I_DN = (FF / 64) * (D / 32);
    constexpr int PER_LAYER = I_IN + I_OUT + I_UP + I_DN;
    const int l = it / PER_LAYER; int r = it % PER_LAYER; bf16* wl = WSH(WS_W) + (size_t)l * LAYER_W;
    const float* W; int K, ldw, N; bf16* WT;
    if (r < I_IN) { W = W_IN + (size_t)l * D * INC; K = D; ldw = INC; N = NPROJ; WT = wl; }
    else if ((r -= I_IN) < I_OUT) { W = W_OUT + (size_t)l * D * D; K = D; ldw = D; N = D; WT = wl + W_OUT_OFF; }
    else if ((r -= I_OUT) < I_UP) { W = W_UP + (size_t)l * D * FF; K = D; ldw = FF; N = FF; WT = wl + W_UP_OFF; }
    else { r -= I_UP; W = W_DOWN + (size_t)l * FF * D; K = FF; ldw = D; N = D; WT = wl + W_DOWN_OFF; }
    const int nblk = N / 32, kb = r / nblk, nb = r % nblk, k0 = 64 * kb, n0 = 32 * nb;
    T.src = W + (size_t)k0 * ldw + n0; T.dst = WT + (size_t)n0 * K + k0; T.K = K; T.ldw = ldw;
}
DI void p0_weights(Frame& F) {
    LAS float* scr = (LAS float*)(F.lds + RING_OFF + F.wave * 16384);
    const int gw = F.vcu * NWAVES + F.wave, NGW = F.G * NWAVES, lane = F.lane;
    constexpr int NIT = DEPTH * ((D / 64) * (NPROJ / 32) + (D / 64) * (D / 32) + (D / 64) * (FF / 32) + (FF / 64) * (D / 32));
    TrItem T; f32x4 v[8];
    if (gw < NIT) { p0_item(F, gw, T);
#pragma unroll
        for (int i = 0; i < 8; ++i) v[i] = *(const f32x4*)(T.src + (size_t)((lane >> 3) + 8 * i) * T.ldw + 4 * (lane & 7)); }
    for (int it = gw; it < NIT; it += NGW) {
        TrItem Tn; f32x4 vn[8]; const int itn = it + NGW < NIT ? it + NGW : it;
        p0_item(F, itn, Tn);
#pragma unroll
        for (int i = 0; i < 8; ++i) vn[i] = *(const f32x4*)(Tn.src + (size_t)((lane >> 3) + 8 * i) * Tn.ldw + 4 * (lane & 7));
#pragma unroll
        for (int i = 0; i < 8; ++i) { LAS float* d = scr + ((lane >> 3) + 8 * i) * 33 + 4 * (lane & 7); d[0] = v[i].x; d[1] = v[i].y; d[2] = v[i].z; d[3] = v[i].w; }
        LDS_WAIT(); asm volatile("" ::: "memory");
        const int c = lane & 7;
#pragma unroll
        for (int j = 0; j < 4; ++j) { const int n = (lane >> 3) + 8 * j; const LAS float* sp = scr + (8 * c) * 33 + n;
            v4u o; o.x = pk2(sp[0 * 33], sp[1 * 33]); o.y = pk2(sp[2 * 33], sp[3 * 33]); o.z = pk2(sp[4 * 33], sp[5 * 33]); o.w = pk2(sp[6 * 33], sp[7 * 33]);
            *(v4u*)(T.dst + (size_t)n * T.K + 8 * c) = o; }
        LDS_WAIT(); asm volatile("" ::: "memory");
        T = Tn;
#pragma unroll
        for (int i = 0; i < 8; ++i) v[i] = vn[i];
    }
    for (int o = (int)blockIdx.x * NWAVES * 64 + F.tid; o < DEPTH * 16 * 1024; o += (int)gridDim.x * NWAVES * 64) {
        const int k = o & 1023, j = (o >> 10) & 15, l = o >> 14;
        WSH(WS_W8T)[o] = (bf16)(j < 8 ? f2bf(W_IN[((size_t)l * D + k) * INC + NPROJ + j]) : 0u);
    }
    for (int o = (int)blockIdx.x * NWAVES * 64 + F.tid; o < DEPTH * 2 * NGB * 4096; o += (int)gridDim.x * NWAVES * 64) {
        const int i = o & 63, j = (o >> 6) & 63, g = (o >> 12) & 7, gate = (o >> 15) & 1, l = o >> 16;
        const float* src = gate ? GATE_X_W : GATE_A_W;
        WSH(WS_GT)[o] = (bf16)f2bf(src[(size_t)(l * NGB + g) * 4096 + i * 64 + j]);
    }
}

DI void p_cvec(Frame& F) {
    const int gw = F.vcu * NWAVES + F.wave, NGW = F.G * NWAVES, lane = F.lane;
    constexpr int IT_IN = NPROJ / 16, IT_UP = FF / 16, PER_L = IT_IN + IT_UP;
    for (int it = gw; it < DEPTH * PER_L; it += NGW) {
        const int l = it / PER_L, r = it % PER_L, which = r >= IT_IN, rg = which ? r - IT_IN : r, N = which ? FF : NPROJ;
        const bf16* wt = WSH(WS_W) + (size_t)l * LAYER_W + (which ? W_UP_OFF : 0) + (size_t)(rg * 16) * 1024 + 16 * lane;
        const float* shb = WSF(WS_MOD) + (size_t)l * BATCH * NMODC + (which ? 3 * D : 0) + 16 * lane;
        float* cout = (which ? WSF(WS_C2) + (size_t)l * BATCH * FF : WSF(WS_C1) + (size_t)l * BATCH * NPROJ) + rg * 16;
        f32x4 sh[4][4];
#pragma unroll
        for (int b = 0; b < 4; ++b)
#pragma unroll
            for (int j = 0; j < 4; ++j) sh[b][j] = *(const f32x4*)(shb + (size_t)b * NMODC + 4 * j);
        float v[64];
#pragma unroll
        for (int row = 0; row < 16; ++row) { const v4u w0 = *(const v4u*)(wt + (size_t)row * 1024), w1 = *(const v4u*)(wt + (size_t)row * 1024 + 8);
            const f32x4 wa = (f32x4){bflo(w0.x), bfhi(w0.x), bflo(w0.y), bfhi(w0.y)}, wb = (f32x4){bflo(w0.z), bfhi(w0.z), bflo(w0.w), bfhi(w0.w)};
            const f32x4 wc = (f32x4){bflo(w1.x), bfhi(w1.x), bflo(w1.y), bfhi(w1.y)}, wd = (f32x4){bflo(w1.z), bfhi(w1.z), bflo(w1.w), bfhi(w1.w)};
#pragma unroll
            for (int b = 0; b < 4; ++b) { const f32x4 t = sh[b][0] * wa + sh[b][1] * wb + sh[b][2] * wc + sh[b][3] * wd; v[row * 4 + b] = (t[0] + t[1]) + (t[2] + t[3]); } }
#pragma unroll
        for (int st = 0; st < 6; ++st) { const int bit = 1 << st; const bool up = lane & bit;
#pragma unroll
            for (int i = 0; i < (32 >> st); ++i) { const float keep = up ? v[2 * i + 1] : v[2 * i], send = up ? v[2 * i] : v[2 * i + 1]; v[i] = keep + bperm_(lane ^ bit, send); } }
        cout[(size_t)(lane & 3) * N + (lane >> 2)] = v[0];
    }
    if (gw < DEPTH * BATCH) { const int l = gw >> 2, b = gw & 3; float a[8];
#pragma unroll
        for (int j = 0; j < 8; ++j) a[j] = 0.f;
        for (int kk = 0; kk < 16; ++kk) { const int k = 16 * lane + kk; const float shv = WSF(WS_MOD)[((size_t)l * BATCH + b) * NMODC + k];
#pragma unroll
            for (int j = 0; j < 8; ++j) a[j] += shv * W_IN[((size_t)l * D + k) * INC + NPROJ + j]; }
#pragma unroll
        for (int j = 0; j < 8; ++j) a[j] = wave_sum_(lane, a[j]);
        if (lane < 8) { float r = a[0];
#pragma unroll
            for (int j = 1; j < 8; ++j) r = (lane == j) ? a[j] : r;
            WSF(WS_CB8)[(size_t)gw * 8 + lane] = r; } }
}

template <bool WITH_BG>
DI void p_normmod(Frame& F, int l, const float* xin, const float* normw, int off_sh, int off_sc) {
    LAS float* w8 = (LAS float*)F.lds;
    if (WITH_BG) {
        for (int i = F.tid; i < D * 8; i += NWAVES * 64) w8[i] = W_IN[((size_t)l * D + (i >> 3)) * INC + NPROJ + (i & 7)];
        __syncthreads();
    }
    const int gw = F.vcu * NWAVES + F.wave, NGW = F.G * NWAVES, lane = F.lane;
    f32x4 v[4];
    if (gw < M) {
#pragma unroll
        for (int j = 0; j < 4; ++j) v[j] = *(const f32x4*)(xin + (size_t)gw * D + 4 * lane + 256 * j);
    }
    for (int m = gw; m < M; m += NGW) {
        const int b = m >> 12, mn = m + NGW;
        f32x4 vnx[4];
#pragma unroll
        for (int j = 0; j < 4; ++j) vnx[j] = (mn < M) ? *(const f32x4*)(xin + (size_t)mn * D + 4 * lane + 256 * j) : (f32x4){0.f, 0.f, 0.f, 0.f};
        const float* modp = WSF(WS_MOD) + ((size_t)l * BATCH + b) * NMODC;
        float ss = 0.f;
#pragma unroll
        for (int j = 0; j < 4; ++j) ss += (v[j].x * v[j].x + v[j].y * v[j].y) + (v[j].z * v[j].z + v[j].w * v[j].w);
        ss = wave_sum_(lane, ss);
        const float rstd = 1.0f / sqrtf(ss * (1.0f / D) + EPS);
        float a0 = 0.f, a1 = 0.f, a2 = 0.f, a3 = 0.f, a4 = 0.f, a5 = 0.f, a6 = 0.f, a7 = 0.f;
#pragma unroll
        for (int j = 0; j < 4; ++j) {
            const int col = 4 * lane + 256 * j;
            const f32x4 nw = *(const f32x4*)(normw + (size_t)l * D + col), sc = *(const f32x4*)(modp + off_sc + col), sh = *(const f32x4*)(modp + off_sh + col);
            const f32x4 hv = v[j] * rstd * nw * (sc + 1.0f) + sh;
            v2u o; o.x = pk2(hv.x, hv.y); o.y = pk2(hv.z, hv.w);
            *(v2u*)(WSH(WS_H) + (size_t)m * D + col) = o;
            if (WITH_BG) {
#pragma unroll
                for (int e = 0; e < 4; ++e) { const f32x4 wa = *(const LAS f32x4*)(w8 + (col + e) * 8), wb = *(const LAS f32x4*)(w8 + (col + e) * 8 + 4); const float hh = hv[e];
                    a0 += hh * wa.x; a1 += hh * wa.y; a2 += hh * wa.z; a3 += hh * wa.w; a4 += hh * wb.x; a5 += hh * wb.y; a6 += hh * wb.z; a7 += hh * wb.w; }
            }
        }
        if (WITH_BG) {
            const bool b0 = lane & 1, b1 = lane & 2, b2 = lane & 4;
            float k0 = b0 ? a1 : a0, k1 = b0 ? a3 : a2, k2 = b0 ? a5 : a4, k3 = b0 ? a7 : a6;
            k0 += bperm_(lane ^ 1, b0 ? a0 : a1); k1 += bperm_(lane ^ 1, b0 ? a2 : a3); k2 += bperm_(lane ^ 1, b0 ? a4 : a5); k3 += bperm_(lane ^ 1, b0 ? a6 : a7);
            float c0 = b1 ? k1 : k0, c1 = b1 ? k3 : k2;
            c0 += bperm_(lane ^ 2, b1 ? k0 : k1); c1 += bperm_(lane ^ 2, b1 ? k2 : k3);
            float d = b2 ? c1 : c0;
            d += bperm_(lane ^ 4, b2 ? c0 : c1);
            d += bperm_(lane ^ 8, d); d += bperm_(lane ^ 16, d); d += bperm_(lane ^ 32, d);
            if (lane < 8) {
                const int hh = lane & 3;
                float r;
                if (lane < 4) r = sigmoidf_(d);
                else { const float xx = d + GDN_DT_BIAS[l * GH + hh]; const float sp = xx > 20.f ? xx : log1pf(expf(xx)); r = -expf(GDN_A_LOG[l * GH + hh]) * sp; }
                WSF(WS_BG)[(size_t)m * 8 + lane] = r;
            }
        }
#pragma unroll
        for (int j = 0; j < 4; ++j) v[j] = vnx[j];
    }
}

typedef float f32x2_t __attribute__((ext_vector_type(2))); typedef __bf16 bf16x2_t __attribute__((ext_vector_type(2)));
DI unsigned cvtpk(float lo, float hi) { f32x2_t v = {lo, hi}; bf16x2_t b = __builtin_convertvector(v, bf16x2_t); return __builtin_bit_cast(unsigned, b); }
DI bf16x8 pack8(f32x4 a, f32x4 b) { v4u p; p.x = cvtpk(a.x, a.y); p.y = cvtpk(a.z, a.w); p.z = cvtpk(b.x, b.y); p.w = cvtpk(b.z, b.w); return __builtin_bit_cast(bf16x8, p); }
DI bf16x8 ldfrag(const LAS unsigned char* p) { const v2u lo = *(const LAS v2u*)p, hi = *(const LAS v2u*)(p + 32); v4u r; r.x = lo.x; r.y = lo.y; r.z = hi.x; r.w = hi.y; return __builtin_bit_cast(bf16x8, r); }
#define MFMA16(a, b, c) __builtin_amdgcn_mfma_f32_16x16x32_bf16((a), (b), (c), 0, 0, 0)

#define WG_BAR() do { asm volatile("s_waitcnt lgkmcnt(0)" ::: "memory"); __builtin_amdgcn_s_barrier(); asm volatile("" ::: "memory"); } while (0)
DI bf16x8 ld128(const LAS unsigned char* p) { return *(const LAS bf16x8*)p; }
DI int kperm4(int k4) { return k4 < 16 ? 2 * k4 : 2 * (k4 - 16) + 4; }
DI int kperm(int k) { return (k & ~31) + kperm4(k & 28) + (k & 3); }
constexpr int PG_QB = 0, PG_KB = 17408, PG_KBET = 34816, PG_VT = 53248, PG_LS = 71680, PG_TS = 89088, PG_TB = 106496, PG_ATT = 115712, PG_XS = 124928, PG_SM = 128000, PG_END = 129024, PG_BGS = 140288;
static_assert(PG_END <= RING_BYTES && PG_BGS >= 8 * 17408 && PG_BGS + 2048 <= RING_BYTES, "prep LDS map");
DI void p_prep(Frame& F, int l) {
    const int wave = F.wave;
#define PREP_IDS int tid_ = F.tid; asm volatile("" : "+v"(tid_)); const int tid = tid_, lane = tid & 63, m = lane & 15, q = lane >> 4; (void)m; (void)q;
    for (int item = blockIdx.x; item < BATCH * NCH; item += gridDim.x) {
        const int b = item / NCH, n = item % NCH, row0 = b * SEQ + n * CH, t0 = n * CH;
        LAS float* bgs = (LAS float*)(F.lds + PG_BGS);
        if (l > 0 && wave < 4) {
            PREP_IDS
            const int mt = wave;
            const bf16* a1 = WSH(WS_A1) + (size_t)(row0 + 16 * mt + m) * D + 8 * q;
            const bf16* w8t = WSH(WS_W8T) + (size_t)l * 16 * 1024 + (size_t)m * 1024 + 8 * q;
            f32x4 acc = (f32x4){0.f, 0.f, 0.f, 0.f};
#pragma unroll 16
            for (int kb = 0; kb < 32; ++kb) acc = MFMA16(*(const bf16x8*)(a1 + 32 * kb), *(const bf16x8*)(w8t + 32 * kb), acc);
            if (m < 8) { const int hh = m & 3; const float cb = WSF(WS_CB8)[((size_t)l * BATCH + b) * 8 + m], dtb = GDN_DT_BIAS[l * GH + hh], alog = GDN_A_LOG[l * GH + hh];
#pragma unroll
                for (int r = 0; r < 4; ++r) { const int t = 16 * mt + 4 * q + r; const f32x4* rp = (const f32x4*)(WSF(WS_RS1) + (size_t)(row0 + t) * 16);
                    const f32x4 p0 = rp[0], p1 = rp[1], p2 = rp[2], p3 = rp[3], ts = (p0 + p1) + (p2 + p3);
                    const float rstd = 1.0f / sqrtf(((ts[0] + ts[1]) + (ts[2] + ts[3])) * (1.0f / D) + EPS), v = acc[r] * rstd + cb;
                    float res;
                    if (m < 4) res = sigmoidf_(v); else { const float xx = v + dtb; const float sp = xx > 20.f ? xx : log1pf(expf(xx)); res = -expf(alog) * sp; }
                    bgs[t * 8 + m] = res; } }
        }
        for (int rep_ = 0; rep_ < PREP_REP_LRU; ++rep_) {
            PREP_IDS
            const int g = wave;
            LAS float* xr = (LAS float*)(F.lds + wave * 17408);
            const int tg = lane >> 3, cg = lane & 7, c0 = 8 * cg, cc0 = g * 64 + c0;
            v4u xp[11];
#pragma unroll
            for (int i = 0; i < 11; ++i) { const int tt = t0 + 8 * tg - 3 + i;
                xp[i] = (tt >= 0) ? *(const v4u*)(WSH(WS_PROJ) + (size_t)(b * SEQ + tt) * NPROJ + O_LX + cc0) : (v4u){0u, 0u, 0u, 0u}; }
            f32x4 wl_[4], wh_[4];
#pragma unroll
            for (int k = 0; k < 4; ++k) { wl_[k] = *(const f32x4*)(LRU_CONV_W + ((size_t)l * 4 + k) * LRUW + cc0); wh_[k] = *(const f32x4*)(LRU_CONV_W + ((size_t)l * 4 + k) * LRUW + cc0 + 4); }
            const f32x4 bl_ = *(const f32x4*)(LRU_CONV_B + l * LRUW + cc0), bh_ = *(const f32x4*)(LRU_CONV_B + l * LRUW + cc0 + 4);
            bf16x8 Bf[2][4][2];
#pragma unroll
            for (int gate = 0; gate < 2; ++gate)
#pragma unroll
                for (int nt = 0; nt < 4; ++nt)
#pragma unroll
                    for (int ks = 0; ks < 2; ++ks) Bf[gate][nt][ks] = *(const bf16x8*)(WSH(WS_GT) + ((size_t)((l * 2 + gate) * NGB + g)) * 4096 + (size_t)(16 * nt + m) * 64 + 32 * ks + 8 * q);
            float ba_[4], bx_[4], ls_[4];
#pragma unroll
            for (int nt = 0; nt < 4; ++nt) { const int cc = g * 64 + 16 * nt + m; ba_[nt] = GATE_A_B[l * LRUW + cc]; bx_[nt] = GATE_X_B[l * LRUW + cc];
                const float lam = LRU_LAMBDA[l * LRUW + cc]; ls_[nt] = -8.0f * (fmaxf(-lam, 0.f) + log1pf(expf(-fabsf(lam)))); }
#pragma unroll
            for (int tt = 0; tt < 8; ++tt) { f32x4 al = bl_, ah = bh_;
#pragma unroll
                for (int k = 0; k < 4; ++k) { const v4u xw = xp[tt + k];
                    al += wl_[k] * (f32x4){bflo(xw.x), bfhi(xw.x), bflo(xw.y), bfhi(xw.y)}; ah += wh_[k] * (f32x4){bflo(xw.z), bfhi(xw.z), bflo(xw.w), bfhi(xw.w)}; }
                *(LAS f32x4*)(xr + (8 * tg + tt) * 68 + c0) = al; *(LAS f32x4*)(xr + (8 * tg + tt) * 68 + c0 + 4) = ah; }
            asm volatile("s_waitcnt lgkmcnt(0)" ::: "memory");
            bf16x8 Af[4][2];
#pragma unroll
            for (int mt = 0; mt < 4; ++mt)
#pragma unroll
                for (int ks = 0; ks < 2; ++ks) { const LAS float* pp = xr + (16 * mt + m) * 68 + 32 * ks + 8 * q; Af[mt][ks] = pack8(*(const LAS f32x4*)pp, *(const LAS f32x4*)(pp + 4)); }
#pragma unroll
            for (int nt = 0; nt < 4; ++nt) {
                float av[4][4], bv[4][4];
#pragma unroll
                for (int mt = 0; mt < 4; ++mt) { f32x4 ra = (f32x4){0.f, 0.f, 0.f, 0.f}, ia = (f32x4){0.f, 0.f, 0.f, 0.f};
                    ra = MFMA16(Af[mt][0], Bf[0][nt][0], ra); ra = MFMA16(Af[mt][1], Bf[0][nt][1], ra);
                    ia = MFMA16(Af[mt][0], Bf[1][nt][0], ia); ia = MFMA16(Af[mt][1], Bf[1][nt][1], ia);
#pragma unroll
                    for (int r = 0; r < 4; ++r) { const float rr = sigmoid_fast(ra[r] + ba_[nt]), ig = sigmoid_fast(ia[r] + bx_[nt]);
                        const float log_a = rr * ls_[nt], aa = exp_fast(log_a), mult = __builtin_amdgcn_sqrtf(fmaxf(1.0f - exp_fast(2.0f * log_a), 1e-12f));
                        av[mt][r] = aa; bv[mt][r] = mult * (ig * xr[(16 * mt + 4 * q + r) * 68 + 16 * nt + m]); } }
                float iP[4], iH[4];
#pragma unroll
                for (int mt = 0; mt < 4; ++mt) {
#pragma unroll
                    for (int r = 1; r < 4; ++r) { bv[mt][r] = av[mt][r] * bv[mt][r - 1] + bv[mt][r]; av[mt][r] = av[mt][r] * av[mt][r - 1]; }
                    float PA = av[mt][3], HA = bv[mt][3];
                    { const float Pp = shfl_up_(lane, PA, 16), Hp = shfl_up_(lane, HA, 16); if (q >= 1) { HA = PA * Hp + HA; PA = PA * Pp; } }
                    { const float Pp = shfl_up_(lane, PA, 32), Hp = shfl_up_(lane, HA, 32); if (q >= 2) { HA = PA * Hp + HA; PA = PA * Pp; } }
                    iP[mt] = PA; iH[mt] = HA; }
                float CP = 1.f, CH = 0.f;
#pragma unroll
                for (int mt = 0; mt < 4; ++mt) {
                    const float totP = bperm_(m + 48, iP[mt]), totH = bperm_(m + 48, iH[mt]);
                    float exP = shfl_up_(lane, iP[mt], 16), exH = shfl_up_(lane, iH[mt], 16); if (q == 0) { exP = 1.f; exH = 0.f; }
                    const float EP = CP * exP, EH = exP * CH + exH;
#pragma unroll
                    for (int r = 0; r < 4; ++r) { const float Pf = EP * av[mt][r], Hf = av[mt][r] * EH + bv[mt][r];
                        *(LAS unsigned*)(xr + (16 * mt + 4 * q + r) * 68 + 16 * nt + m) = f2bf(Hf) | (f2bf(Pf) << 16); }
                    CH = totP * CH + totH; CP = CP * totP; }
                if (q == 0) { WSF(WS_AGG)[((size_t)(b * NCH + n)) * LRUW + g * 64 + 16 * nt + m] = CP; WSF(WS_AGG)[(size_t)BATCH * NCH * LRUW + ((size_t)(b * NCH + n)) * LRUW + g * 64 + 16 * nt + m] = CH; }
            }
            asm volatile("s_waitcnt lgkmcnt(0)" ::: "memory");
#pragma unroll
            for (int i = 0; i < 16; ++i) { const int pz = lane + 64 * i, row = pz >> 4, c16 = pz & 15;
                *(v4u*)((unsigned*)(F.A->ws + WS_H) + (size_t)(row0 + row) * LRUW + g * 64 + 4 * c16) = *(const LAS v4u*)(xr + row * 68 + 4 * c16); }
        }
        __syncthreads();
        {
            LAS unsigned char* qb = F.lds + PG_QB;
            LAS unsigned char* kb = F.lds + PG_KB;
            LAS unsigned char* kbeT = F.lds + PG_KBET;
            LAS unsigned char* vT = F.lds + PG_VT;
            LAS float* Ls = (LAS float*)(F.lds + PG_LS);
            LAS float* Ts = (LAS float*)(F.lds + PG_TS);
            LAS unsigned char* Tb = F.lds + PG_TB;
            LAS unsigned char* atts = F.lds + PG_ATT;
            LAS float* Xs = (LAS float*)(F.lds + PG_XS);
            LAS float* sm4 = (LAS float*)(F.lds + PG_SM);
            if (wave < GH) { int tl_ = F.tid; asm volatile("" : "+v"(tl_)); const int ln = tl_ & 63, hh = wave;
                float gcv = l > 0 ? bgs[ln * 8 + 4 + hh] : WSF(WS_BG)[(size_t)(row0 + ln) * 8 + 4 + hh];
#pragma unroll
                for (int off = 1; off < 64; off <<= 1) { const float pv = shfl_up_(ln, gcv, off); if (ln >= off) gcv += pv; }
                const float glast = bperm_(63, gcv);
                sm4[hh * 256 + ln] = gcv; sm4[hh * 256 + 64 + ln] = l > 0 ? bgs[ln * 8 + hh] : WSF(WS_BG)[(size_t)(row0 + ln) * 8 + hh]; sm4[hh * 256 + 128 + ln] = expf(gcv); sm4[hh * 256 + 192 + ln] = expf(glast - gcv); }
            WG_BAR();
            v4u xpn[11];
#define G1_FETCH(hh_) do { int tf_ = F.tid; asm volatile("" : "+v"(tf_)); if (tf_ < 384) { const int cgp_ = tf_ & 15, wt_ = tf_ >> 4, which_ = wt_ >> 3, tr_ = wt_ & 7, ch_ = which_ * GDNW + (hh_) * HD + cgp_ * 8; \
                _Pragma("unroll") for (int i = 0; i < 11; ++i) { const int tt = t0 + tr_ * 8 - 3 + i; \
                    xpn[i] = (tt >= 0) ? *(const v4u*)(WSH(WS_PROJ) + (size_t)(b * SEQ + tt) * NPROJ + O_Q + ch_) : (v4u){0u, 0u, 0u, 0u}; } \
                } } while (0)
            G1_FETCH(0);
            for (int h_ = 0; h_ < GH * PREP_REP_GDN; ++h_) { const int h = h_ % GH;
                PREP_IDS
                const size_t item4 = (size_t)(b * GH + h) * NCH + n;
                LAS float* sgc = sm4 + h * 256, *sbeta = sgc + 64, *seg = sgc + 128, *sel = sgc + 192;
#if defined(PROBE_G) && PROBE_G == 1
                for (int prb_ = 0; prb_ < 2; ++prb_) {
#else
                {
#endif
                if (tid < 384) {
                    const int cgp = tid & 15, wt = tid >> 4, which = wt >> 3, tr = wt & 7, d0 = cgp * 8, ch0 = which * GDNW + h * HD + d0;
                    v4u xp[11]; f32x4 wl_[4], wh_[4];
#pragma unroll
                    for (int i = 0; i < 11; ++i) xp[i] = xpn[i];
#pragma unroll
                    for (int k = 0; k < 4; ++k) { wl_[k] = *(const f32x4*)(GDN_CONV_W + ((size_t)l * 4 + k) * (3 * GDNW) + ch0); wh_[k] = *(const f32x4*)(GDN_CONV_W + ((size_t)l * 4 + k) * (3 * GDNW) + ch0 + 4); }
                    f32x4 ol[8], oh[8]; float ss[8];
#pragma unroll
                    for (int tt = 0; tt < 8; ++tt) { f32x4 al = (f32x4){0.f, 0.f, 0.f, 0.f}, ah = (f32x4){0.f, 0.f, 0.f, 0.f};
#pragma unroll
                        for (int k = 0; k < 4; ++k) { const v4u xw = xp[tt + k];
                            al += wl_[k] * (f32x4){bflo(xw.x), bfhi(xw.x), bflo(xw.y), bfhi(xw.y)}; ah += wh_[k] * (f32x4){bflo(xw.z), bfhi(xw.z), bflo(xw.w), bfhi(xw.w)}; }
#pragma unroll
                        for (int c = 0; c < 4; ++c) { al[c] = silu_fast(al[c]); ah[c] = silu_fast(ah[c]); }
                        ol[tt] = al; oh[tt] = ah;
                        ss[tt] = (al.x * al.x + al.y * al.y) + (al.z * al.z + al.w * al.w) + (ah.x * ah.x + ah.y * ah.y) + (ah.z * ah.z + ah.w * ah.w); }
                    if (h_ + 1 < GH * PREP_REP_GDN) G1_FETCH((h_ + 1) % GH);
                    if (which < 2) {
#pragma unroll
                        for (int tt = 0; tt < 8; ++tt) { float v = ss[tt]; v += bperm_(lane ^ 1, v); v += bperm_(lane ^ 2, v); v += bperm_(lane ^ 4, v); v += bperm_(lane ^ 8, v);
                            const float scl = __builtin_amdgcn_rsqf(v + 1e-6f) * (which == 0 ? 0.08838834764831845f : 1.0f); ol[tt] = ol[tt] * scl; oh[tt] = oh[tt] * scl; }
                    }
                    const int tb = tr * 8;
                    if (which == 0) {
#pragma unroll
                        for (int tt = 0; tt < 8; ++tt) { const int t = tb + tt; const float eg = seg[t];
                            v4u pk; pk.x = cvtpk(ol[tt].x, ol[tt].y); pk.y = cvtpk(ol[tt].z, ol[tt].w); pk.z = cvtpk(oh[tt].x, oh[tt].y); pk.w = cvtpk(oh[tt].z, oh[tt].w);
                            *(LAS v4u*)(qb + t * 272 + d0 * 2) = pk;
                            v4u pg; pg.x = cvtpk(ol[tt].x * eg, ol[tt].y * eg); pg.y = cvtpk(ol[tt].z * eg, ol[tt].w * eg); pg.z = cvtpk(oh[tt].x * eg, oh[tt].y * eg); pg.w = cvtpk(oh[tt].z * eg, oh[tt].w * eg);
                            { bf16* qrow = WSH(WS_GQD) + item4 * 8192 + t * 128 + (d0 & ~31); const int kl = d0 & 31;
                                v2u p0; p0.x = pg.x; p0.y = pg.y; v2u p1; p1.x = pg.z; p1.y = pg.w; *(v2u*)(qrow + kperm4(kl)) = p0; *(v2u*)(qrow + kperm4(kl + 4)) = p1; } }
                    } else if (which == 1) {
                        float fb[8], fl[8];
#pragma unroll
                        for (int tt = 0; tt < 8; ++tt) { const int t = tb + tt; fb[tt] = sbeta[t] * seg[t]; fl[tt] = sel[t];
                            v4u pk; pk.x = cvtpk(ol[tt].x, ol[tt].y); pk.y = cvtpk(ol[tt].z, ol[tt].w); pk.z = cvtpk(oh[tt].x, oh[tt].y); pk.w = cvtpk(oh[tt].z, oh[tt].w);
                            *(LAS v4u*)(kb + t * 272 + d0 * 2) = pk; }
#pragma unroll
                        for (int c = 0; c < 8; ++c) {
#define KV_(tt) ((c) < 4 ? ol[tt][(c) & 3] : oh[tt][(c) & 3])
                            v4u pe; pe.x = cvtpk(KV_(0) * fb[0], KV_(1) * fb[1]); pe.y = cvtpk(KV_(2) * fb[2], KV_(3) * fb[3]); pe.z = cvtpk(KV_(4) * fb[4], KV_(5) * fb[5]); pe.w = cvtpk(KV_(6) * fb[6], KV_(7) * fb[7]);
                            *(LAS v4u*)(kbeT + (d0 + c) * 144 + ((tr ^ (cgp & 7)) * 16)) = pe;
                            v4u pt; pt.x = cvtpk(KV_(0) * fl[0], KV_(1) * fl[1]); pt.y = cvtpk(KV_(2) * fl[2], KV_(3) * fl[3]); pt.z = cvtpk(KV_(4) * fl[4], KV_(5) * fl[5]); pt.w = cvtpk(KV_(6) * fl[6], KV_(7) * fl[7]);
                            { bf16* krow = WSH(WS_GKT) + item4 * 8192 + (d0 + c) * 64 + (tb & ~31); const int kl = tb & 31;
                                v2u p0; p0.x = pt.x; p0.y = pt.y; v2u p1; p1.x = pt.z; p1.y = pt.w; *(v2u*)(krow + kperm4(kl)) = p0; *(v2u*)(krow + kperm4(kl + 4)) = p1; } }
                    } else {
                        float fb[8];
#pragma unroll
                        for (int tt = 0; tt < 8; ++tt) fb[tt] = sbeta[tb + tt];
#pragma unroll
                        for (int c = 0; c < 8; ++c) {
                            v4u pe; pe.x = cvtpk(KV_(0) * fb[0], KV_(1) * fb[1]); pe.y = cvtpk(KV_(2) * fb[2], KV_(3) * fb[3]); pe.z = cvtpk(KV_(4) * fb[4], KV_(5) * fb[5]); pe.w = cvtpk(KV_(6) * fb[6], KV_(7) * fb[7]);
                            *(LAS v4u*)(vT + (d0 + c) * 144 + ((tr ^ (cgp & 7)) * 16)) = pe; }
#undef KV_
                    }
                }
                WG_BAR();
                }
#if defined(PROBE_G) && PROBE_G == 2
                for (int prb_ = 0; prb_ < 2; ++prb_) {
#else
                {
#endif
                {
                    const int it = wave >> 1;
                    bf16x8 Ak[4], Aq[4], Bk[2][4];
#pragma unroll
                    for (int ks = 0; ks < 4; ++ks) { Ak[ks] = ld128(kb + (16 * it + m) * 272 + (32 * ks + 8 * q) * 2); Aq[ks] = ld128(qb + (16 * it + m) * 272 + (32 * ks + 8 * q) * 2);
                        Bk[0][ks] = ld128(kb + (16 * ((wave & 1) * 2) + m) * 272 + (32 * ks + 8 * q) * 2); Bk[1][ks] = ld128(kb + (16 * ((wave & 1) * 2 + 1) + m) * 272 + (32 * ks + 8 * q) * 2); }
#pragma unroll
                    for (int jj = 0; jj < 2; ++jj) { const int jt = (wave & 1) * 2 + jj;
                        f32x4 kk = (f32x4){0.f, 0.f, 0.f, 0.f}, qk = (f32x4){0.f, 0.f, 0.f, 0.f};
                        if (jt <= it) {
#pragma unroll
                            for (int ks = 0; ks < 4; ++ks) { kk = MFMA16(Ak[ks], Bk[jj][ks], kk); qk = MFMA16(Aq[ks], Bk[jj][ks], qk); } }
                        const int j = 16 * jt + m; const float gj = sgc[j];
#pragma unroll
                        for (int r = 0; r < 4; ++r) { const int i = 16 * it + 4 * q + r;
                            const float dec = (j <= i) ? exp_fast(sgc[i] - gj) : 0.f;
                            Ls[i * 68 + j] = (j < i) ? sbeta[i] * kk[r] * dec : 0.f;
                            *(LAS unsigned short*)(atts + i * 144 + kperm(j) * 2) = (unsigned short)f2bf((j <= i) ? qk[r] * dec : 0.f); } }
                }
                WG_BAR();
                }
#if defined(PROBE_G) && PROBE_G == 3
                for (int prb_ = 0; prb_ < 2; ++prb_) {
#else
                {
#endif
                if (tid < 64) { const int bk = tid >> 4, c = tid & 15; float x[16];
                    const LAS float* lb = Ls + (16 * bk) * 68 + 16 * bk;
#pragma unroll
                    for (int r = 0; r < 16; ++r) { float acc = (r == c) ? 1.f : 0.f;
#pragma unroll
                        for (int m4 = 0; m4 < (r + 3) / 4; ++m4) { const f32x4 lv = *(const LAS f32x4*)(lb + r * 68 + 4 * m4);
                            if (4 * m4 + 0 < r) acc -= lv.x * x[4 * m4 + 0]; if (4 * m4 + 1 < r) acc -= lv.y * x[4 * m4 + 1]; if (4 * m4 + 2 < r) acc -= lv.z * x[4 * m4 + 2]; if (4 * m4 + 3 < r) acc -= lv.w * x[4 * m4 + 3]; }
                        x[r] = acc; Ts[(16 * bk + r) * 68 + 16 * bk + c] = acc; } }
                WG_BAR();
#pragma unroll 1
                for (int dl = 1; dl < 4; ++dl) {
                    const int nout = (4 - dl) * 256;
                    for (int idx = tid; idx < nout; idx += NWAVES * 64) { const int blk = idx >> 8, r = (idx >> 4) & 15, c = idx & 15, i = blk + dl, j = blk; float acc = 0.f;
                        const LAS float* lrow = Ls + (16 * i + r) * 68 + 16 * j; const LAS float* tcol = Ts + (16 * j) * 68 + 16 * j + c;
                        for (int kk = 0; kk < dl; ++kk) {
#pragma unroll
                            for (int mm = 0; mm < 16; mm += 4) { const f32x4 lv = *(const LAS f32x4*)(lrow + 16 * kk + mm); const LAS float* tc = tcol + (16 * kk + mm) * 68;
                                acc += lv.x * tc[0] + lv.y * tc[68] + lv.z * tc[136] + lv.w * tc[204]; } }
                        Xs[idx] = acc; }
                    WG_BAR();
                    for (int idx = tid; idx < nout; idx += NWAVES * 64) { const int blk = idx >> 8, r = (idx >> 4) & 15, c = idx & 15, i = blk + dl, j = blk; float acc = 0.f;
                        const LAS float* trow = Ts + (16 * i + r) * 68 + 16 * i; const LAS float* xc = Xs + blk * 256 + c;
#pragma unroll
                        for (int mm = 0; mm < 16; mm += 4) { const f32x4 tv = *(const LAS f32x4*)(trow + mm); acc -= tv.x * xc[(mm + 0) * 16] + tv.y * xc[(mm + 1) * 16] + tv.z * xc[(mm + 2) * 16] + tv.w * xc[(mm + 3) * 16]; }
                        Ts[(16 * i + r) * 68 + 16 * j + c] = acc; }
                    WG_BAR();
                }
#pragma unroll
                for (int e = 0; e < 8; ++e) { const int idx = tid + 512 * e, i = idx >> 6, j = idx & 63;
                    *(LAS unsigned short*)(Tb + i * 144 + j * 2) = (unsigned short)(((j >> 4) <= (i >> 4)) ? f2bf(Ts[i * 68 + j]) : 0u); }
                WG_BAR();
                }
#if defined(PROBE_G) && PROBE_G == 4
                for (int prb_ = 0; prb_ < 2; ++prb_) {
#else
                {
#endif
                {
                    const int nt = wave;
#pragma unroll
                    for (int mt = 0; mt < 4; ++mt) { f32x4 ua = (f32x4){0.f, 0.f, 0.f, 0.f}, wa = (f32x4){0.f, 0.f, 0.f, 0.f};
#pragma unroll
                        for (int ks = 0; ks < 2; ++ks) if (32 * ks <= 16 * mt + 15) { const bf16x8 A = ld128(Tb + (16 * mt + m) * 144 + (32 * ks + 8 * q) * 2);
                            const int swz = (((4 * ks + q) ^ ((2 * nt + (m >> 3)) & 7)) * 16);
                            ua = MFMA16(A, ld128(vT + (16 * nt + m) * 144 + swz), ua); wa = MFMA16(A, ld128(kbeT + (16 * nt + m) * 144 + swz), wa); }
unsigned uts[4];
#pragma unroll
                        for (int r = 0; r < 4; ++r) { const int t = 16 * mt + 4 * q + r, d = 16 * nt + m;
                            uts[r] = f2bf(ua[r]); *(LAS unsigned short*)(kb + t * 272 + kperm(d) * 2) = (unsigned short)f2bf(-wa[r]); }
                        { v2u pu; pu.x = uts[0] | (uts[1] << 16); pu.y = uts[2] | (uts[3] << 16); *(LAS v2u*)(F.lds + PG_LS + (16 * nt + m) * 144 + (16 * mt + 4 * q) * 2) = pu; } }
                }
                WG_BAR();
                }
#if defined(PROBE_G) && PROBE_G == 5
                for (int prb_ = 0; prb_ < 2; ++prb_) {
#else
                {
#endif
#pragma unroll
                for (int e = 0; e < 2; ++e) { const int p = tid + 512 * e, row = p >> 4, c16 = p & 15;
                    *(v4u*)((unsigned char*)(WSH(WS_MIX + 16 * MiB) + item4 * 8192) + row * 256 + c16 * 16) = *(const LAS v4u*)(kb + row * 272 + c16 * 16);
                    const int ur = p >> 3, uc = p & 7;
                    *(v4u*)((unsigned char*)(WSH(WS_MIX) + item4 * 8192) + ur * 128 + uc * 16) = *(const LAS v4u*)(F.lds + PG_LS + ur * 144 + uc * 16); }
                { const int row = tid >> 3, c16 = tid & 7;
                    *(v4u*)((unsigned char*)(WSH(WS_GATT) + item4 * 4096) + row * 128 + c16 * 16) = *(const LAS v4u*)(atts + row * 144 + c16 * 16); }
                if (tid == 0) WSF(WS_GL)[item4] = seg[63];
                WG_BAR();
                }
            }
        }
    }
}

#undef PREP_IDS
constexpr int SC_W = 0, SC_QD = 18432, SC_KT = 36864, SC_AT = 57344, SC_U = 67584, SC_STAGE = 76800;
static_assert(2 * SC_STAGE <= RING_BYTES, "scan stages fit the ring");
#define SBAR_() __builtin_amdgcn_sched_barrier(0)
constexpr int NSEG = 8, SEGC = NCH / NSEG;
constexpr size_t WS_PSI = 344 * MiB;
constexpr size_t WS_PHI = 352 * MiB;
constexpr size_t WS_SST = 356 * MiB;
static_assert(WS_SST + 8 * MiB <= WS_END, "two-level scan scratch");

#define SC_ADDR() \
        const unsigned char* gW = (const unsigned char*)(WSH(WS_MIX + 16 * MiB) + it0 * 8192); \
        const unsigned char* gQD = (const unsigned char*)(WSH(WS_GQD) + it0 * 8192); \
        const unsigned char* gKT = (const unsigned char*)(WSH(WS_GKT) + it0 * 8192); \
        const unsigned char* gAT = (const unsigned char*)(WSH(WS_GATT) + it0 * 4096); \
        const unsigned char* gU = (const unsigned char*)(WSH(WS_MIX) + it0 * 8192) + dvbase * 128;
#define SC_LOAD(rg, n_) do { const size_t cb = (size_t)(n_) * 16384, ca = (size_t)(n_) * 8192; \
            _Pragma("unroll") for (int i = 0; i < 4; ++i) { rg[i] = *(const v4u*)(gW + cb + gofW + i * 4096); if (FULL) rg[4 + i] = *(const v4u*)(gQD + cb + gofW + i * 4096); \
                rg[8 + i] = *(const v4u*)(gKT + cb + gofK + i * 4096); } \
            _Pragma("unroll") for (int i = 0; i < 2; ++i) { if (FULL) rg[12 + i] = *(const v4u*)(gAT + ca + gofK + i * 4096); rg[14 + i] = *(const v4u*)(gU + cb + gofK + i * 4096); } } while (0)
#define SC_WRITE(rg, buf_) do { LAS unsigned char* sb_ = F.lds + (buf_) * SC_STAGE; \
            _Pragma("unroll") for (int i = 0; i < 4; ++i) { *(LAS v4u*)(sb_ + SC_W + lofW + i * (16 * 288)) = rg[i]; if (FULL) *(LAS v4u*)(sb_ + SC_QD + lofW + i * (16 * 288)) = rg[4 + i]; \
                *(LAS v4u*)(sb_ + SC_KT + lofK + i * (32 * 160)) = rg[8 + i]; } \
            _Pragma("unroll") for (int i = 0; i < 2; ++i) { if (FULL) *(LAS v4u*)(sb_ + SC_AT + lofK + i * (32 * 160)) = rg[12 + i]; *(LAS v4u*)(sb_ + SC_U + lofU + i * (32 * 144)) = rg[14 + i]; } } while (0)
#define SC_LOADER_LOOP() do { \
            int lt_ = F.tid & 255; asm volatile("" : "+v"(lt_)); \
            const int gofW = (lt_ >> 4) * 256 + (lt_ & 15) * 16, gofK = (lt_ >> 3) * 128 + (lt_ & 7) * 16; \
            const int lofW = (lt_ >> 4) * 288 + (lt_ & 15) * 16, lofK = (lt_ >> 3) * 160 + (lt_ & 7) * 16, lofU = (lt_ >> 3) * 144 + (lt_ & 7) * 16; \
            const int nlast = n0 + SEGC - 1; \
            v4u ra[16], rb[16]; \
            SC_LOAD(ra, n0); SC_WRITE(ra, 0); SC_LOAD(ra, n0 + 1); SC_LOAD(rb, n0 + 2); \
            __syncthreads(); \
            _Pragma("unroll 1") for (int j = 0; j < SEGC; j += 2) { \
                  \
                  \
                SC_WRITE(ra, 1); \
                { const int nn = n0 + j + 3 < nlast ? n0 + j + 3 : nlast; SC_LOAD(ra, nn); } \
                WG_BAR(); \
                SC_WRITE(rb, 0); \
                { const int nn = n0 + j + 4 < nlast ? n0 + j + 4 : nlast; SC_LOAD(rb, nn); } \
                WG_BAR(); \
            } } while (0)

DI void p_scan1(Frame& F, int l) {
    constexpr bool FULL = false;
    const int wave = F.wave;
    { const int lane = F.lane;
        for (int p = blockIdx.x * NWAVES + wave; p < BATCH * LRUW; p += gridDim.x * NWAVES) { const int b = p / LRUW, c = p % LRUW;
            float A = WSF(WS_AGG)[((size_t)(b * NCH + lane)) * LRUW + c], B = WSF(WS_AGG)[(size_t)BATCH * NCH * LRUW + ((size_t)(b * NCH + lane)) * LRUW + c];
#pragma unroll
            for (int off = 1; off < 64; off <<= 1) { const float Ap = shfl_up_(lane, A, off), Bp = shfl_up_(lane, B, off); if (lane >= off) { B = A * Bp + B; A = A * Ap; } }
            if (lane < 63) WSF(WS_CARRY)[((size_t)(b * NCH + lane + 1)) * LRUW + c] = B; else WSF(WS_CARRY)[((size_t)(b * NCH)) * LRUW + c] = 0.f; } }
    const bool is_loader = wave >= 4;
    const int wv = wave & 3;
    for (int job = F.vcu; job < BATCH * GH * NSEG * 2; job += F.G) {
        const int bh = job >> 4, seg = (job >> 1) & (NSEG - 1), dvbase = (job & 1) * 64, n0 = seg * SEGC;
        const size_t it0 = (size_t)bh * NCH;
        SC_ADDR()
        (void)gQD; (void)gAT;
        if (seg == NSEG - 1) { __syncthreads(); continue; }
        if (is_loader) { SC_LOADER_LOOP(); }
        else {
            int tc_ = F.tid; asm volatile("" : "+v"(tc_)); const int lane = tc_ & 63, m = lane & 15, q = lane >> 4;
            const int col = dvbase + 16 * wv + m;
            f32x4 Sacc[2][8];
#pragma unroll
            for (int dt = 0; dt < 8; ++dt) { Sacc[0][dt] = (f32x4){0.f, 0.f, 0.f, 0.f};
#pragma unroll
                for (int r = 0; r < 4; ++r) Sacc[1][dt][r] = (16 * dt + 4 * q + r == col) ? 1.f : 0.f; }
            const float glv = WSF(WS_GL)[it0 + lane];
            __syncthreads();
#pragma unroll 1
            for (int j = 0; j < SEGC; ++j) {
                const LAS unsigned char* B = F.lds + (j & 1) * SC_STAGE;
                bf16x8 fa[4], fb[4], Sb[2][4], vnb[2][2];
                f32x4 vn[2][4];
                v2u ut[4];
#pragma unroll
                for (int mt = 0; mt < 4; ++mt) ut[mt] = *(const LAS v2u*)(B + SC_U + (16 * wv + m) * 144 + (16 * mt + 4 * q) * 2);
#define LDW4(dst, mt_) do { _Pragma("unroll") for (int kb = 0; kb < 4; ++kb) dst[kb] = ld128(B + SC_W + (16 * (mt_) + m) * 288 + (32 * kb + 8 * q) * 2); } while (0)
#define MMW2(src, mt_) do { _Pragma("unroll") for (int kb = 0; kb < 4; ++kb) { vn[0][mt_] = MFMA16(src[kb], Sb[0][kb], vn[0][mt_]); vn[1][mt_] = MFMA16(src[kb], Sb[1][kb], vn[1][mt_]); } } while (0)
#define LDK4(dst, dt_) do { dst[0] = ld128(B + SC_KT + (16 * (dt_) + m) * 160 + (8 * q) * 2); dst[1] = ld128(B + SC_KT + (16 * (dt_) + m) * 160 + (32 + 8 * q) * 2); \
                            dst[2] = ld128(B + SC_KT + (16 * ((dt_) + 1) + m) * 160 + (8 * q) * 2); dst[3] = ld128(B + SC_KT + (16 * ((dt_) + 1) + m) * 160 + (32 + 8 * q) * 2); } while (0)
#define MMK2(src, dt_) do { _Pragma("unroll") for (int e = 0; e < 2; ++e) { Sacc[e][dt_] = MFMA16(src[0], vnb[e][0], Sacc[e][dt_]); Sacc[e][dt_] = MFMA16(src[1], vnb[e][1], Sacc[e][dt_]); \
                            Sacc[e][(dt_) + 1] = MFMA16(src[2], vnb[e][0], Sacc[e][(dt_) + 1]); Sacc[e][(dt_) + 1] = MFMA16(src[3], vnb[e][1], Sacc[e][(dt_) + 1]); } } while (0)
                LDW4(fa, 0); SBAR_();
#pragma unroll
                for (int e = 0; e < 2; ++e)
#pragma unroll
                    for (int kb = 0; kb < 4; ++kb) Sb[e][kb] = pack8(Sacc[e][2 * kb], Sacc[e][2 * kb + 1]);
#pragma unroll
                for (int mt = 0; mt < 4; ++mt) { vn[0][mt] = (f32x4){bflo(ut[mt].x), bfhi(ut[mt].x), bflo(ut[mt].y), bfhi(ut[mt].y)}; vn[1][mt] = (f32x4){0.f, 0.f, 0.f, 0.f}; }
                const float gl = __builtin_bit_cast(float, __builtin_amdgcn_readlane(__builtin_bit_cast(int, glv), n0 + j));
                SBAR_(); LDW4(fb, 1); SBAR_(); MMW2(fa, 0); SBAR_();
                LDW4(fa, 2); SBAR_(); MMW2(fb, 1); SBAR_();
                LDW4(fb, 3); SBAR_(); MMW2(fa, 2); SBAR_();
                LDK4(fa, 0); SBAR_(); MMW2(fb, 3); SBAR_();
#pragma unroll
                for (int e = 0; e < 2; ++e) { vnb[e][0] = pack8(vn[e][0], vn[e][1]); vnb[e][1] = pack8(vn[e][2], vn[e][3]);
#pragma unroll
                    for (int dt = 0; dt < 8; ++dt) Sacc[e][dt] = Sacc[e][dt] * gl; }
                SBAR_(); LDK4(fb, 2); SBAR_(); MMK2(fa, 0); SBAR_();
                LDK4(fa, 4); SBAR_(); MMK2(fb, 2); SBAR_();
                LDK4(fb, 6); SBAR_(); MMK2(fa, 4); SBAR_();
                MMK2(fb, 6); SBAR_();
                WG_BAR();
            }
#undef LDW4
#undef MMW2
#undef LDK4
#undef MMK2
            float* psi = WSF(WS_PSI) + ((size_t)(bh * NSEG + seg) * 128) * 128 + col;
            bf16* phi = WSH(WS_PHI) + ((size_t)(bh * NSEG + seg) * 128) * 128 + kperm(col);
#pragma unroll
            for (int dt = 0; dt < 8; ++dt)
#pragma unroll
                for (int r = 0; r < 4; ++r) { const int dk = 16 * dt + 4 * q + r; psi[(size_t)dk * 128] = Sacc[0][dt][r]; phi[(size_t)dk * 128] = (bf16)f2bf(Sacc[1][dt][r]); }
        }
        __syncthreads();
    }
}

DI void p_scan2(Frame& F, int l) {
    const int wave = F.wave;
    for (int bh = blockIdx.x; bh < BATCH * GH; bh += gridDim.x) {
        int tc_ = F.tid; asm volatile("" : "+v"(tc_)); const int tid = tc_, lane = tc_ & 63, m = lane & 15, q = lane >> 4;
        const int col = 16 * wave + m;
        const int gof = (tid >> 4) * 256 + (tid & 15) * 16, lof = (tid >> 4) * 288 + (tid & 15) * 16;
        const unsigned char* phi0 = (const unsigned char*)(WSH(WS_PHI) + ((size_t)(bh * NSEG) * 128) * 128);
        const float* psi0 = WSF(WS_PSI) + ((size_t)(bh * NSEG) * 128) * 128 + col;
        float* sst0 = WSF(WS_SST) + ((size_t)(bh * NSEG) * 128) * 128 + col;
        f32x4 S[8], Ps[8]; v4u pr[4];
#pragma unroll
        for (int dt = 0; dt < 8; ++dt) { S[dt] = (f32x4){0.f, 0.f, 0.f, 0.f};
#pragma unroll
            for (int r = 0; r < 4; ++r) Ps[dt][r] = psi0[(size_t)(16 * dt + 4 * q + r) * 128]; }
#pragma unroll
        for (int i = 0; i < 4; ++i) pr[i] = *(const v4u*)(phi0 + gof + i * 8192);
#pragma unroll
        for (int i = 0; i < 4; ++i) *(LAS v4u*)(F.lds + lof + i * (32 * 288)) = pr[i];
        __syncthreads();
#pragma unroll 1
        for (int seg = 0; seg + 1 < NSEG; ++seg) {
            if (seg > 0) {
#pragma unroll
                for (int dt = 0; dt < 8; ++dt)
#pragma unroll
                    for (int r = 0; r < 4; ++r) sst0[((size_t)seg * 128 + 16 * dt + 4 * q + r) * 128] = S[dt][r]; }
            const int sn = seg + 2 < NSEG ? seg + 1 : seg;
#pragma unroll
            for (int i = 0; i < 4; ++i) pr[i] = *(const v4u*)(phi0 + (size_t)sn * 32768 + gof + i * 8192);
            f32x4 Pn[8];
#pragma unroll
            for (int dt = 0; dt < 8; ++dt)
#pragma unroll
                for (int r = 0; r < 4; ++r) Pn[dt][r] = psi0[((size_t)sn * 128 + 16 * dt + 4 * q + r) * 128];
            const LAS unsigned char* B = F.lds + (seg & 1) * 36864;
            bf16x8 Sb[4];
#pragma unroll
            for (int kb = 0; kb < 4; ++kb) Sb[kb] = pack8(S[2 * kb], S[2 * kb + 1]);
#pragma unroll
            for (int dt = 0; dt < 8; ++dt) { f32x4 acc = Ps[dt];
#pragma unroll
                for (int kb = 0; kb < 4; ++kb) acc = MFMA16(ld128(B + (16 * dt + m) * 288 + (32 * kb + 8 * q) * 2), Sb[kb], acc);
                S[dt] = acc; }
#pragma unroll
            for (int dt = 0; dt < 8; ++dt) Ps[dt] = Pn[dt];
#pragma unroll
            for (int i = 0; i < 4; ++i) *(LAS v4u*)(F.lds + ((seg + 1) & 1) * 36864 + lof + i * (32 * 288)) = pr[i];
            __syncthreads();
        }
#pragma unroll
        for (int dt = 0; dt < 8; ++dt)
#pragma unroll
            for (int r = 0; r < 4; ++r) sst0[((size_t)(NSEG - 1) * 128 + 16 * dt + 4 * q + r) * 128] = S[dt][r];
        __syncthreads();
    }
}

DI void p_scan3(Frame& F, int l) {
    constexpr bool FULL = true;
    const int wave = F.wave;
    const bool is_loader = wave >= 4;
    const int wv = wave & 3;
    for (int job = F.vcu; job < BATCH * GH * NSEG * 2; job += F.G) {
        const int bh = job >> 4, seg = (job >> 1) & (NSEG - 1), dvbase = (job & 1) * 64, n0 = seg * SEGC, b = bh >> 2, h = bh & 3;
        const size_t it0 = (size_t)bh * NCH;
        SC_ADDR()
        if (is_loader) { SC_LOADER_LOOP(); }
        else {
            int tc_ = F.tid; asm volatile("" : "+v"(tc_)); const int lane = tc_ & 63, m = lane & 15, q = lane >> 4;
            f32x4 Sacc[8];
            if (seg == 0) {
#pragma unroll
                for (int dt = 0; dt < 8; ++dt) Sacc[dt] = (f32x4){0.f, 0.f, 0.f, 0.f};
            } else { const float* sst = WSF(WS_SST) + ((size_t)(bh * NSEG + seg) * 128) * 128 + dvbase + 16 * wv + m;
#pragma unroll
                for (int dt = 0; dt < 8; ++dt)
#pragma unroll
                    for (int r = 0; r < 4; ++r) Sacc[dt][r] = sst[(size_t)(16 * dt + 4 * q + r) * 128]; }
            const float glv = WSF(WS_GL)[it0 + lane];
            __syncthreads();
#define FR_W(dst, mt_) do { _Pragma("unroll") for (int kb = 0; kb < 4; ++kb) { dst[kb] = ld128(B + SC_W + (16 * (mt_) + m) * 288 + (32 * kb + 8 * q) * 2); dst[4 + kb] = ld128(B + SC_QD + (16 * (mt_) + m) * 288 + (32 * kb + 8 * q) * 2); } } while (0)
#define MM_W(src, mt_) do { _Pragma("unroll") for (int kb = 0; kb < 4; ++kb) { vn[mt_] = MFMA16(src[kb], Sb[kb], vn[mt_]); o[mt_] = MFMA16(src[4 + kb], Sb[kb], o[mt_]); } } while (0)
#define FR_KT(dst, hf_) do { _Pragma("unroll") for (int i = 0; i < 8; ++i) dst[i] = ld128(B + SC_KT + (16 * (4 * (hf_) + (i >> 1)) + m) * 160 + (32 * (i & 1) + 8 * q) * 2); } while (0)
#define MM_KT(src, hf_) do { _Pragma("unroll") for (int i = 0; i < 8; ++i) Sacc[4 * (hf_) + (i >> 1)] = MFMA16(src[i], vnb[i & 1], Sacc[4 * (hf_) + (i >> 1)]); } while (0)
#pragma unroll 1
            for (int j = 0; j < SEGC; ++j) {
                const int n = n0 + j;
                const LAS unsigned char* B = F.lds + (j & 1) * SC_STAGE;
                bf16x8 fa[8], fb[8], Sb[4], vnb[2];
                f32x4 vn[4], o[4];
                v2u ut[4];
#pragma unroll
                for (int mt = 0; mt < 4; ++mt) ut[mt] = *(const LAS v2u*)(B + SC_U + (16 * wv + m) * 144 + (16 * mt + 4 * q) * 2);
                FR_W(fa, 0); SBAR_();
#pragma unroll
                for (int kb = 0; kb < 4; ++kb) Sb[kb] = pack8(Sacc[2 * kb], Sacc[2 * kb + 1]);
#pragma unroll
                for (int mt = 0; mt < 4; ++mt) { o[mt] = (f32x4){0.f, 0.f, 0.f, 0.f}; vn[mt] = (f32x4){bflo(ut[mt].x), bfhi(ut[mt].x), bflo(ut[mt].y), bfhi(ut[mt].y)}; }
                const float gl = __builtin_bit_cast(float, __builtin_amdgcn_readlane(__builtin_bit_cast(int, glv), n));
                SBAR_(); FR_W(fb, 1); SBAR_(); MM_W(fa, 0); SBAR_();
                FR_W(fa, 2); SBAR_(); MM_W(fb, 1); SBAR_();
                FR_W(fb, 3); SBAR_(); MM_W(fa, 2); SBAR_();
                fa[0] = ld128(B + SC_AT + (m) * 160 + (8 * q) * 2); fa[1] = ld128(B + SC_AT + (16 + m) * 160 + (8 * q) * 2);
                fa[2] = ld128(B + SC_AT + (32 + m) * 160 + (8 * q) * 2); fa[3] = ld128(B + SC_AT + (32 + m) * 160 + (32 + 8 * q) * 2);
                fa[4] = ld128(B + SC_AT + (48 + m) * 160 + (8 * q) * 2); fa[5] = ld128(B + SC_AT + (48 + m) * 160 + (32 + 8 * q) * 2);
                SBAR_(); MM_W(fb, 3); SBAR_();
                vnb[0] = pack8(vn[0], vn[1]); vnb[1] = pack8(vn[2], vn[3]);
#pragma unroll
                for (int dt = 0; dt < 8; ++dt) Sacc[dt] = Sacc[dt] * gl;
                SBAR_(); FR_KT(fb, 0); SBAR_();
                o[0] = MFMA16(fa[0], vnb[0], o[0]); o[1] = MFMA16(fa[1], vnb[0], o[1]); o[2] = MFMA16(fa[2], vnb[0], o[2]); o[3] = MFMA16(fa[4], vnb[0], o[3]);
                o[2] = MFMA16(fa[3], vnb[1], o[2]); o[3] = MFMA16(fa[5], vnb[1], o[3]);
                SBAR_(); FR_KT(fa, 1); SBAR_(); MM_KT(fb, 0); SBAR_();
                MM_KT(fa, 1); SBAR_();
                float* go = WSF(WS_GO) + (size_t)(b * SEQ + n * CH + 4 * q) * GDNW + h * HD + dvbase + 16 * wv + m;
#pragma unroll
                for (int mt = 0; mt < 4; ++mt)
#pragma unroll
                    for (int r = 0; r < 4; ++r) go[(size_t)(16 * mt + r) * GDNW] = o[mt][r];
                WG_BAR();
            }
#undef FR_W
#undef MM_W
#undef FR_KT
#undef MM_KT
        }
        __syncthreads();
    }
}
#undef SC_ADDR
#undef SC_LOAD
#undef SC_WRITE
#undef SC_LOADER_LOOP

DI float gelu_fast(float x) { const float u2 = 1.5957691216057308f * (x + 0.044715f * x * x * x); return x * rcp_(1.f + exp_fast(-u2)); }
struct PostRow { v4u hp[2]; v2u y2[2], z2[2]; f32x4 go[2], cr[2]; };
DI void post_load(Frame& F, PostRow& R, int m, int lane) {
    const int b = m >> 12, n = (m & (SEQ - 1)) >> 6;
#pragma unroll
    for (int j = 0; j < 2; ++j) { const int c = 4 * lane + 256 * j;
        R.hp[j] = *(const v4u*)((const unsigned*)(F.A->ws + WS_H) + (size_t)m * LRUW + c);
        R.cr[j] = *(const f32x4*)(WSF(WS_CARRY) + ((size_t)(b * NCH + n)) * LRUW + c);
        R.y2[j] = *(const v2u*)(WSH(WS_PROJ) + (size_t)m * NPROJ + O_LY + c);
        R.go[j] = *(const f32x4*)(WSF(WS_GO) + (size_t)m * GDNW + c);
        R.z2[j] = *(const v2u*)(WSH(WS_PROJ) + (size_t)m * NPROJ + O_Z + c); }
}
DI void p_post(Frame& F, int l) {
    const int gw = F.vcu * NWAVES + F.wave, NGW = F.G * NWAVES, lane = F.lane;
    PostRow R;
    if (gw < M) post_load(F, R, gw, lane);
    for (int m = gw; m < M; m += NGW) {
        PostRow Rn; const int mn = m + NGW;
        post_load(F, Rn, mn < M ? mn : m, lane);
        f32x4 val[2]; float ss = 0.f;
#pragma unroll
        for (int j = 0; j < 2; ++j) { const v4u hp = R.hp[j]; const v2u y2 = R.y2[j];
            const f32x4 hl = (f32x4){bflo(hp.x), bflo(hp.y), bflo(hp.z), bflo(hp.w)}, p = (f32x4){bfhi(hp.x), bfhi(hp.y), bfhi(hp.z), bfhi(hp.w)};
            const f32x4 hh = hl + p * R.cr[j];
            val[j] = (f32x4){hh.x * gelu_fast(bflo(y2.x)), hh.y * gelu_fast(bfhi(y2.x)), hh.z * gelu_fast(bflo(y2.y)), hh.w * gelu_fast(bfhi(y2.y))};
            ss += (val[j].x * val[j].x + val[j].y * val[j].y) + (val[j].z * val[j].z + val[j].w * val[j].w); }
        ss = wave_sum_(lane, ss);
        const float rl = 1.0f / sqrtf(ss * (1.0f / LRUW) + EPS);
#pragma unroll
        for (int j = 0; j < 2; ++j) { const int c = 4 * lane + 256 * j; const f32x4 nw = *(const f32x4*)(LRU_NORM_W + (size_t)l * LRUW + c);
            const f32x4 o = val[j] * rl * nw; v2u w; w.x = pk2(o.x, o.y); w.y = pk2(o.z, o.w); *(v2u*)(WSH(WS_MIX) + (size_t)m * D + c) = w; }
#pragma unroll
        for (int j = 0; j < 2; ++j) { const int c = 4 * lane + 256 * j, d = c & (HD - 1);
            const f32x4 o = R.go[j]; const v2u z2 = R.z2[j];
            const float s2 = half_sum_(lane, (o.x * o.x + o.y * o.y) + (o.z * o.z + o.w * o.w));
            const float rg = 1.0f / sqrtf(s2 * (1.0f / HD) + EPS);
            const f32x4 nw = *(const f32x4*)(GDN_NORM_W + (size_t)l * HD + d);
            const f32x4 r = (f32x4){o.x * rg * nw.x * silu_fast(bflo(z2.x)), o.y * rg * nw.y * silu_fast(bfhi(z2.x)), o.z * rg * nw.z * silu_fast(bflo(z2.y)), o.w * rg * nw.w * silu_fast(bfhi(z2.y))};
            v2u w; w.x = pk2(r.x, r.y); w.y = pk2(r.z, r.w); *(v2u*)(WSH(WS_MIX) + (size_t)m * D + LRUW + c) = w; }
        R = Rn;
    }
}

DI void p_final(Frame& F) {
    const int gw = F.vcu * NWAVES + F.wave, NGW = F.G * NWAVES, lane = F.lane;
    for (int m = gw; m < M; m += NGW) {
        f32x4 v[4]; float ss = 0.f;
#pragma unroll
        for (int j = 0; j < 4; ++j) { v[j] = *(const f32x4*)(OUT_ + (size_t)m * D + 4 * lane + 256 * j); ss += (v[j].x * v[j].x + v[j].y * v[j].y) + (v[j].z * v[j].z + v[j].w * v[j].w); }
        ss = wave_sum_(F.lane, ss);
        const float rstd = 1.0f / sqrtf(ss * (1.0f / D) + EPS);
#pragma unroll
        for (int j = 0; j < 4; ++j) { const int col = 4 * lane + 256 * j; const f32x4 nw = *(const f32x4*)(FINAL_NORM_W + col); *(f32x4*)(OUT_ + (size_t)m * D + col) = v[j] * rstd * nw; }
    }
}

__device__ __forceinline__ void pg8::EpiMulti::operator()(const f32x4 (&acc)[2][2][4][2], const Unit& u, int wr, int wc, int fr, int fq) const {
    const __attribute__((address_space(4))) Args* ap = (const __attribute__((address_space(4))) Args*)__builtin_amdgcn_kernarg_segment_ptr(); asm volatile("" : "+s"(ap));
    unsigned char* ws = ap->ws;
    const int b = (u.pm * BM) / SEQ;
    if (mode == 0) { EpiBf16<0> e{(bf16_t*)(ws + WS_PROJ), NPROJ, nullptr, 0, 0, 1.f, nullptr}; e(acc, u, wr, wc, fr, fq); }
    else if (mode == 5) { EpiBf16<0> e{(bf16_t*)(ws + WS_PROJ), NPROJ, (const float*)(ws + WS_C1) + ((size_t)l * BATCH + b) * NPROJ, 0, 0, 1.f, (const float*)(ws + WS_RS1)}; e(acc, u, wr, wc, fr, fq); }
    else if (mode == 6) { EpiBf16<2> e{(bf16_t*)(ws + WS_ACT), FF, (const float*)(ws + WS_C2) + ((size_t)l * BATCH + b) * FF, 0, 0, 1.f, (const float*)(ws + WS_RS2)}; e(acc, u, wr, wc, fr, fq); }
    else if (mode == 3) { const float* modb = (const float*)(ws + WS_MOD) + ((size_t)l * BATCH + b) * NMODC;
        EpiResid2 r{l == 0 ? ap->in[0] : ap->out, ap->out, modb + 2 * D, ap->in[3] + (size_t)l * D, modb + 4 * D, (bf16_t*)(ws + WS_H), (float*)(ws + WS_RS2), (float*)(ws + WS_PROJ)}; r(acc, u, wr, wc, fr, fq); }
    else { const float* modb = (const float*)(ws + WS_MOD) + ((size_t)l * BATCH + b) * NMODC; const bool nx = l + 1 < DEPTH;
        EpiResid2 r{ap->out, ap->out, modb + 5 * D, nx ? ap->in[2] + (size_t)(l + 1) * D : nullptr, modb + NMODC * BATCH + D, (bf16_t*)(ws + WS_A1), (float*)(ws + WS_RS1), (float*)(ws + WS_PROJ)}; r(acc, u, wr, wc, fr, fq); }
}

__global__ void __launch_bounds__(NWAVES * 64, 2) mk_fwd(Args args) {
    extern __shared__ __attribute__((aligned(16))) unsigned char lds[];
    Frame F;
    F.lds = (LAS unsigned char*)lds;
    F.MISC = (volatile LAS unsigned*)(F.lds + MISC_OFF);
    F.tid = threadIdx.x; F.lane = F.tid & 63; F.wave = __builtin_amdgcn_readfirstlane(F.tid >> 6);
    F.G = gridDim.x; { const int bx = blockIdx.x; F.vcu = (F.G % 8 == 0) ? (bx % 8) * (F.G / 8) + bx / 8 : bx; }
    F.A = (const __attribute__((address_space(4))) Args*)__builtin_amdgcn_kernarg_segment_ptr();
    F.ctl = (gu32*)(F.A->ws + WS_CTL);
    for (int u = F.tid; u < (LDS_BYTES - LDSCTL_OFF) / 4; u += NWAVES * 64) ((LAS unsigned*)(F.lds + LDSCTL_OFF))[u] = 0u;
    __syncthreads();
    XcdBarrier bar; bar.bar = (unsigned*)(F.ctl + CW_BAR); bar.x = 0; bar.st = nullptr;
    if (N_LAUNCHES == 1) bar = xcd_barrier_post((unsigned*)(F.ctl + CW_BAR), F.MISC + 8);

    const int lo = F.A->ph_lo, hi = F.A->ph_hi;
    int rep_done = 0;
#pragma unroll 1
    for (int s = lo; s < hi; ++s) {
        { const __attribute__((address_space(4))) Args* ap = (const __attribute__((address_space(4))) Args*)__builtin_amdgcn_kernarg_segment_ptr(); asm volatile("" : "+s"(ap)); F.A = ap; }
        { int t_ = threadIdx.x; asm volatile("" : "+v"(t_)); F.tid = t_; F.lane = t_ & 63; F.wave = __builtin_amdgcn_readfirstlane(t_ >> 6); }
        if (s == 0) { if (PH_MASK & 1) { p_mod(F); __syncthreads(); p0_weights(F); xcd_barrier(bar, F.tid == 0); p_cvec(F); __syncthreads(); p_normmod<true>(F, 0, X_IN, NORM_MIX_W, 0, D); } }
        else if (s == N_STEPS - 1) { if (PH_MASK & 2) p_final(F); }
        else {
            const int l = (s - 1) / 9, i = (s - 1) % 9;
            if (i == 0 || i == 6) continue;
            bf16* wl = WSH(WS_W) + (size_t)l * LAYER_W;
            const float* modl = WSF(WS_MOD) + (size_t)l * BATCH * NMODC;
            if (!((PH_MASK >> (2 + i)) & 1)) {}
            else if (i == 0) { p_normmod<true>(F, l, l == 0 ? X_IN : OUT_, NORM_MIX_W, 0, D); }
            else if (i == 2) { p_prep(F, l); }
            else if (i == 3) {
                p_scan1(F, l); xcd_barrier(bar, F.tid == 0);
#if defined(SCAN_REP) && SCAN_REP == 1
                p_scan1(F, l); xcd_barrier(bar, F.tid == 0);
#endif
                p_scan2(F, l); xcd_barrier(bar, F.tid == 0);
#if defined(SCAN_REP) && SCAN_REP == 2
                p_scan2(F, l); xcd_barrier(bar, F.tid == 0);
#endif
                p_scan3(F, l);
#if defined(SCAN_REP) && SCAN_REP == 3
                xcd_barrier(bar, F.tid == 0); p_scan3(F, l);
#endif
            }
            else if (i == 4) { p_post(F, l); }
            else if (i == 6) { p_normmod<false>(F, l, OUT_, NORM_MLP_W, 3 * D, 4 * D); }
            else {
                pg8::Gemm g; pg8::EpiMulti E; E.l = l;
                if (i == 1) { g = pg8::Gemm{l == 0 ? WSH(WS_H) : WSH(WS_A1), wl, M, NPROJ, D}; E.PERM = true; E.mode = (l == 0 ? 0 : 5); }
                else if (i == 5) { g = pg8::Gemm{WSH(WS_MIX), wl + W_OUT_OFF, M, D, D}; E.PERM = true; E.mode = 3; }
                else if (i == 7) { g = pg8::Gemm{WSH(WS_H), wl + W_UP_OFF, M, FF, D}; E.PERM = true; E.mode = 6; }
                else { g = pg8::Gemm{WSH(WS_ACT), wl + W_DOWN_OFF, M, D, FF}; E.PERM = true; E.mode = 4; }
                pg8::StaticOrder S; S.init(g.M, g.N, F.G, (int)blockIdx.x);
                pg8::gemm_phase<pg8::EpiMulti, pg8::StaticOrder, PG8_ALIGN, PG8_SP2>(F.lds + RING_OFF, g, S, E);
            }
        }
        if (REP_MASK != 0 && ((s >= 1 && s < N_STEPS - 1 && ((REP_MASK >> ((s - 1) % 9)) & 1)) || (s == 0 && (REP_MASK & 0x10000))) && !rep_done) { rep_done = 1; --s; xcd_barrier(bar, F.tid == 0); continue; }
        rep_done = 0;
        if (s + 1 < hi) xcd_barrier(bar, F.tid == 0);
#ifdef PROBE_XBAR
        if (s >= 1 && s < N_STEPS - 1) { xcd_barrier(bar, F.tid == 0); xcd_barrier(bar, F.tid == 0); }
#endif
    }
}

extern "C" void kernel_launch(void* const* d_in, const int* in_sizes, int n_in, void* d_out, int out_size, void* d_ws, size_t ws_size, hipStream_t stream) {
    static int grid = 0;
    if (grid == 0) {
        if (n_in != 23 || in_sizes[0] != M * D || out_size != M * D || ws_size < WS_END) { fprintf(stderr, "kernel_launch: unexpected shapes (n_in %d, in0 %d, out %d, ws %zu); nothing launched\n", n_in, n_in > 0 ? in_sizes[0] : -1, out_size, ws_size); grid = -1; return; }
        int dev = 0, cus = 0;
        if (hipGetDevice(&dev) != hipSuccess || hipDeviceGetAttribute(&cus, hipDeviceAttributeMultiprocessorCount, dev) != hipSuccess) { grid = -1; return; }
        if (hipFuncSetAttribute((const void*)mk_fwd, hipFuncAttributeMaxDynamicSharedMemorySize, LDS_BYTES) != hipSuccess) { fprintf(stderr, "kernel_launch: hipFuncSetAttribute failed\n"); grid = -1; return; }
        (void)hipGetLastError();
        grid = cus;
    }
    if (grid < 0) return;
    if (hipMemsetAsync((char*)d_ws + WS_CTL, 0, CTL_ZERO_BYTES, stream) != hipSuccess) return;
    Args a{};
    for (int i = 0; i < 23; ++i) a.in[i] = (const float*)d_in[i];
    a.out = (float*)d_out; a.ws = (unsigned char*)d_ws;
    if (N_LAUNCHES == 1) { a.ph_lo = 0; a.ph_hi = N_STEPS; hipLaunchKernelGGL(mk_fwd, dim3(grid), dim3(NWAVES * 64), LDS_BYTES, stream, a); }
    else for (int s = 0; s < N_STEPS; ++s) { a.ph_lo = s; a.ph_hi = s + 1; hipLaunchKernelGGL(mk_fwd, dim3(grid), dim3(NWAVES * 64), LDS_BYTES, stream, a); }
}
```

```cpp
#include <hip/hip_runtime.h>
#include <cstdio>
#include <cstdint>
#include <cmath>
namespace pg8 {
#define PG8_LAS __attribute__((address_space(3)))
typedef unsigned short bf16_t;
typedef short bf16x8 __attribute__((ext_vector_type(8)));
typedef float f32x4 __attribute__((ext_vector_type(4)));
typedef unsigned u32x4 __attribute__((ext_vector_type(4)));
constexpr int BM = 256, BK = 64, HALF = 128, HTB = HALF * BK * 2  , STAGE_BYTES = 8 * HTB, NXCD = 8, WGM = 8;

__host__ __device__ __forceinline__ int lds_byte(int r, int c) { const int st = (r >> 4) * 2 + (c >> 5), rr = r & 15, cc = c & 31, ob = rr * 64 + cc * 2; return st * 1024 + (ob ^ (((ob >> 9) & 1) << 5)); }
__host__ __device__ __forceinline__ void stage_rc(int b, int& R, int& C) { const int st = b / 1024, sb = b % 1024, swz = sb ^ (((sb >> 9) & 1) << 5); R = (st >> 1) * 16 + swz / 64; C = (st & 1) * 32 + (swz % 64) / 2; }
__host__ __device__ __forceinline__ int perm32(int rho) { const int n = rho >> 4, i = rho & 15; return 8 * (i >> 2) + 4 * n + (i & 3); }

struct Unit { int pm, pn; };
struct Gemm { const bf16_t* A; const bf16_t* Bt; int M, N, K; };

struct StaticOrder {
    int nM, nN, nwg, G, c;
    __host__ __device__ void init(int M, int N, int G_, int c_) { nM = M / BM; nN = N / BM; nwg = nM * nN; G = G_; c = c_; }
    __host__ __device__ bool next(int i, Unit& u) const {
        const long L = (long)i * G + c; if (L >= nwg) return false;
        int wgid = (int)L; { const int q = nwg / NXCD, r = nwg % NXCD, xcd = wgid % NXCD, off = wgid / NXCD; wgid = (xcd < r ? xcd * (q + 1) : r * (q + 1) + (xcd - r) * q) + off; }
        const int nig = WGM * nN, gid = wgid / nig, fm = gid * WGM, gsz = (nM - fm) < WGM ? (nM - fm) : WGM;
        u.pm = fm + ((wgid % nig) % gsz); u.pn = (wgid % nig) / gsz; return true;
    }
    __device__ __forceinline__ void a_ready(const Unit&) const {}
    __device__ __forceinline__ void done(const Unit&) const {}
};

__device__ __forceinline__ unsigned cvt_pk_bf16(float lo, float hi) { unsigned r; asm volatile("v_cvt_pk_bf16_f32 %0, %1, %2" : "=v"(r) : "v"(lo), "v"(hi)); return r; }
typedef float f32x2 __attribute__((ext_vector_type(2)));
__device__ __forceinline__ f32x2 gelu_pk(f32x2 v) {
    const f32x2 av = __builtin_elementwise_abs(v), d = av * 0.2316418882f + 1.0f;
    f32x2 t; t.x = __builtin_amdgcn_rcpf(d.x); t.y = __builtin_amdgcn_rcpf(d.y);
    f32x2 q = t * 0.5307027145f + (-0.7265760135f); q = q * t + 0.7107068705f; q = q * t + (-0.142248368f); q = q * t + 0.127414796f; q = q * t;
    const f32x2 s = (v * v) * (-0.72134752044f);
    f32x2 e; e.x = __builtin_amdgcn_exp2f(s.x); e.y = __builtin_amdgcn_exp2f(s.y);
    const f32x2 m = v * (q * e), r = v - m;
    f32x2 o; o.x = v.x < 0.f ? m.x : r.x; o.y = v.y < 0.f ? m.y : r.y; return o;
}

template <int ACT  > struct EpiBf16 {
    static constexpr bool PERM = true, AFTER_DRAIN = false; static_assert(ACT == 0 || ACT == 1 || ACT == 2, "EpiBf16: ACT is 0 (none), 1 (gelu_pk) or 2 (squared relu)");
    bf16_t* O; int ldc; const float* bias; int split_cols; size_t split_stride; float scale0;
    const float* rs = nullptr;
    __device__ __forceinline__ void operator()(const f32x4 (&acc)[2][2][4][2], const Unit& u, int wr, int wc, int fr, int fq) const {
        const int row0 = u.pm * BM + wr * 64 + fr; int colt = u.pn * BM; bf16_t* base = O;
        float sc = 1.f; if (split_cols) { const int t = colt / split_cols; base += (size_t)t * split_stride; colt -= t * split_cols; if (t == 0) sc = scale0; }
        const int col0 = colt + wc * 32 + 8 * fq, bcol0 = u.pn * BM + wc * 32 + 8 * fq;
        f32x4 bv[2][2];
#pragma unroll
        for (int bj = 0; bj < 2; ++bj)
#pragma unroll
            for (int n = 0; n < 2; ++n) bv[bj][n] = bias ? *(const f32x4*)(bias + bcol0 + bj * HALF + 4 * n) : (f32x4){0.f, 0.f, 0.f, 0.f};
#pragma unroll
        for (int ai = 0; ai < 2; ++ai)
#pragma unroll
            for (int m = 0; m < 4; ++m) { bf16_t* rowp = base + (size_t)(row0 + ai * HALF + m * 16) * ldc + col0;
                float rsc = 1.f;
                if (rs) { const f32x4* rp = (const f32x4*)(rs + (size_t)(row0 + ai * HALF + m * 16) * 16); const f32x4 p0 = rp[0], p1 = rp[1], p2 = rp[2], p3 = rp[3];
                    const f32x4 t = (p0 + p1) + (p2 + p3); rsc = 1.0f / sqrtf(((t[0] + t[1]) + (t[2] + t[3])) * (1.0f / 1024.0f) + 1e-6f); }
#pragma unroll
                for (int bj = 0; bj < 2; ++bj) { f32x4 v0 = acc[ai][bj][m][0] * rsc + bv[bj][0], v1 = acc[ai][bj][m][1] * rsc + bv[bj][1];
                    if (ACT == 1) { f32x2 a = gelu_pk((f32x2){v0[0], v0[1]}), b = gelu_pk((f32x2){v0[2], v0[3]}), c = gelu_pk((f32x2){v1[0], v1[1]}), d = gelu_pk((f32x2){v1[2], v1[3]});
                        v0 = (f32x4){a.x, a.y, b.x, b.y}; v1 = (f32x4){c.x, c.y, d.x, d.y}; }
                    if (ACT == 2) { _Pragma("unroll") for (int q_ = 0; q_ < 4; ++q_) { const float a_ = fmaxf(v0[q_], 0.f), b_ = fmaxf(v1[q_], 0.f); v0[q_] = a_ * a_; v1[q_] = b_ * b_; } }
                    v0 = v0 * sc; v1 = v1 * sc; u32x4 w; w.x = cvt_pk_bf16(v0[0], v0[1]); w.y = cvt_pk_bf16(v0[2], v0[3]); w.z = cvt_pk_bf16(v1[0], v1[1]); w.w = cvt_pk_bf16(v1[2], v1[3]);
                    *(u32x4*)(rowp + bj * HALF) = w; } }
    }
};


struct EpiResid {
    static constexpr bool PERM = false, AFTER_DRAIN = false;
    const float* base; float* out; const float* gate; int ldc; int gate_stride; int rows_per_batch;
    __device__ __forceinline__ void operator()(const f32x4 (&acc)[2][2][4][2], const Unit& u, int wr, int wc, int fr, int fq) const {
        const int col0 = u.pn * BM + wc * 32 + 4 * fq;
        const float* gp = gate + (size_t)((u.pm * BM) / rows_per_batch) * gate_stride + col0;
        f32x4 gv[2][2];
#pragma unroll
        for (int bj = 0; bj < 2; ++bj)
#pragma unroll
            for (int n = 0; n < 2; ++n) gv[bj][n] = *(const f32x4*)(gp + bj * HALF + n * 16);
#pragma unroll
        for (int ai = 0; ai < 2; ++ai)
#pragma unroll
            for (int m = 0; m < 4; ++m) { const size_t off = (size_t)(u.pm * BM + ai * HALF + wr * 64 + m * 16 + fr) * ldc + col0;
#pragma unroll
                for (int bj = 0; bj < 2; ++bj)
#pragma unroll
                    for (int n = 0; n < 2; ++n) { const f32x4 bs = *(const f32x4*)(base + off + bj * HALF + n * 16);
                        *(f32x4*)(out + off + bj * HALF + n * 16) = bs + gv[bj][n] * acc[ai][bj][m][n]; } }
    }
};


typedef _Float16 f16x8 __attribute__((ext_vector_type(8)));
typedef _Float16 f16x4 __attribute__((ext_vector_type(4)));
struct EpiResid2 {
    static constexpr bool PERM = true, AFTER_DRAIN = false;
    const float* base32; const _Float16* base16; _Float16* out16; const float* gate;
    const float* nw; const float* sc;
    bf16_t* anext; float* rsum;
    __device__ __forceinline__ void operator()(const f32x4 (&acc)[2][2][4][2], const Unit& u, int wr, int wc, int fr, int fq) const {
        const int col0 = u.pn * BM + wc * 32 + 8 * fq, lane = fr + 16 * fq;
        f32x4 gv[2][2], ns[2][2];
#pragma unroll
        for (int bj = 0; bj < 2; ++bj)
#pragma unroll
            for (int n = 0; n < 2; ++n) { const int c = col0 + bj * HALF + 4 * n; gv[bj][n] = *(const f32x4*)(gate + c);
                ns[bj][n] = nw ? *(const f32x4*)(nw + c) * (*(const f32x4*)(sc + c) + 1.0f) : (f32x4){0.f, 0.f, 0.f, 0.f}; }
#pragma unroll
        for (int ai = 0; ai < 2; ++ai)
#pragma unroll
            for (int m = 0; m < 4; ++m) { const size_t off = (size_t)(u.pm * BM + ai * HALF + wr * 64 + m * 16 + fr) * 1024 + col0;
                f32x4 bs[2][2];
                if (base16) {
                    f16x8 hb[2];
#pragma unroll
                    for (int bj = 0; bj < 2; ++bj) hb[bj] = *(const f16x8*)(base16 + off + bj * HALF);
#pragma unroll
                    for (int bj = 0; bj < 2; ++bj) { bs[bj][0] = (f32x4){(float)hb[bj][0], (float)hb[bj][1], (float)hb[bj][2], (float)hb[bj][3]}; bs[bj][1] = (f32x4){(float)hb[bj][4], (float)hb[bj][5], (float)hb[bj][6], (float)hb[bj][7]}; }
                } else {
#pragma unroll
                    for (int bj = 0; bj < 2; ++bj)
#pragma unroll
                        for (int n = 0; n < 2; ++n) bs[bj][n] = *(const f32x4*)(base32 + off + bj * HALF + 4 * n);
                }
                float ssq = 0.f;
#pragma unroll
                for (int bj = 0; bj < 2; ++bj) { const f32x4 x0 = bs[bj][0] + gv[bj][0] * acc[ai][bj][m][0], x1 = bs[bj][1] + gv[bj][1] * acc[ai][bj][m][1];
                    f16x8 ho; ho[0] = (_Float16)x0[0]; ho[1] = (_Float16)x0[1]; ho[2] = (_Float16)x0[2]; ho[3] = (_Float16)x0[3]; ho[4] = (_Float16)x1[0]; ho[5] = (_Float16)x1[1]; ho[6] = (_Float16)x1[2]; ho[7] = (_Float16)x1[3];
                    *(f16x8*)(out16 + off + bj * HALF) = ho;
                    if (nw) { const f32x4 h0 = x0 * ns[bj][0], h1 = x1 * ns[bj][1]; u32x4 w; w.x = cvt_pk_bf16(h0[0], h0[1]); w.y = cvt_pk_bf16(h0[2], h0[3]); w.z = cvt_pk_bf16(h1[0], h1[1]); w.w = cvt_pk_bf16(h1[2], h1[3]);
                        *(u32x4*)(anext + off + bj * HALF) = w;
                        ssq += ((x0[0] * x0[0] + x0[1] * x0[1]) + (x0[2] * x0[2] + x0[3] * x0[3])) + ((x1[0] * x1[0] + x1[1] * x1[1]) + (x1[2] * x1[2] + x1[3] * x1[3])); } }
                if (nw) { ssq += __builtin_bit_cast(float, __builtin_amdgcn_ds_bpermute((lane ^ 16) << 2, __builtin_bit_cast(int, ssq)));
                    ssq += __builtin_bit_cast(float, __builtin_amdgcn_ds_bpermute((lane ^ 32) << 2, __builtin_bit_cast(int, ssq)));
                    if (fq == 0) rsum[(size_t)(u.pm * BM + ai * HALF + wr * 64 + m * 16 + fr) * 16 + u.pn * 4 + wc] = ssq; }
                if (m & 1) asm volatile("" ::: "memory"); }
    }
};

struct EpiMulti {
    static constexpr bool AFTER_DRAIN = false;
    bool PERM; int mode, l;
    __device__ __forceinline__ void operator()(const f32x4 (&acc)[2][2][4][2], const Unit& u, int wr, int wc, int fr, int fq) const;
};

template <class Epi, class Sched, bool ALIGN_EPI = false, bool SP2 = false>
__device__ __forceinline__ void gemm_phase(PG8_LAS unsigned char* lds, const Gemm g, const Sched& S, const Epi& E) {
    int tid_l = threadIdx.x; asm volatile("" : "+v"(tid_l));
    const int tid = tid_l, wid = __builtin_amdgcn_readfirstlane(tid >> 6), lane = tid & 63, wr = wid >> 2, wc = wid & 3, fr = lane & 15, fq = lane >> 4;
    const int K = g.K, nt = K / BK;
    unsigned voffA[2], voffB[2];
#pragma unroll
    for (int i = 0; i < 2; ++i) { int R, C; stage_rc(tid * 16 + i * 8192, R, C); const int Rb = E.PERM ? ((R & ~31) + perm32(R & 31)) : R;
        voffA[i] = (unsigned)(R * K + C) * 2u; voffB[i] = (unsigned)(Rb * K + C) * 2u; }
    const size_t kstep = (size_t)(BK * 2);
    const size_t hstep = (size_t)HALF * K * 2;
    const size_t tstep = 2 * hstep;
    const unsigned ldsw = (unsigned)wid * 1024u;
    const int aoff = lds_byte(wr * 64 + fr, fq * 8), boff = lds_byte(wc * 32 + fr, fq * 8);
#define PG8_SA(b, h) (((b) * 2 + (h)) * HTB)
#define PG8_SB(b, h) ((4 + (b) * 2 + (h)) * HTB)
#define PG8_STAGE(bufoff, gbase, voff) do { _Pragma("unroll") for (int _i = 0; _i < 2; ++_i) \
        __builtin_amdgcn_global_load_lds((const unsigned*)((const char*)(gbase) + (voff)[_i]), (PG8_LAS unsigned*)(lds + (bufoff) + ldsw + _i * 8192), 16, 0, 0); } while (0)
#define PG8_LDA(dst, b, h) do { _Pragma("unroll") for (int m = 0; m < 4; ++m) _Pragma("unroll") for (int k = 0; k < 2; ++k) dst[m][k] = *(const PG8_LAS bf16x8*)(lds + PG8_SA(b, h) + aoff + m * 2048 + k * 1024); } while (0)
#define PG8_LDB(dst, b, h) do { _Pragma("unroll") for (int n = 0; n < 2; ++n) _Pragma("unroll") for (int k = 0; k < 2; ++k) dst[n][k] = *(const PG8_LAS bf16x8*)(lds + PG8_SB(b, h) + boff + n * 2048 + k * 1024); } while (0)
#define PG8_MMA(ai, bj, At, Bt) do { __builtin_amdgcn_s_setprio(1); _Pragma("unroll") for (int m = 0; m < 4; ++m) _Pragma("unroll") for (int n = 0; n < 2; ++n) _Pragma("unroll") for (int k = 0; k < 2; ++k) \
        acc[ai][bj][m][n] = __builtin_amdgcn_mfma_f32_16x16x32_bf16(Bt[n][k], At[m][k], acc[ai][bj][m][n], 0, 0, 0); __builtin_amdgcn_s_setprio(0); } while (0)
#define PG8_WAIT_V(n) asm volatile("s_waitcnt vmcnt(" #n ")" ::: "memory")
#define PG8_WAIT_L(n) asm volatile("s_waitcnt lgkmcnt(" #n ")" ::: "memory")
#define PG8_BAR __builtin_amdgcn_s_barrier()
#define PG8_SCHED __builtin_amdgcn_sched_barrier(0)
    Unit cur, nxt; int ui = 0;
    if (!S.next(0, cur)) return;
    f32x4 acc[2][2][4][2];
#pragma unroll
    for (int a = 0; a < 2; ++a)
#pragma unroll
        for (int b = 0; b < 2; ++b)
#pragma unroll
            for (int m = 0; m < 4; ++m)
#pragma unroll
                for (int n = 0; n < 2; ++n) acc[a][b][m][n] = (f32x4){0.f, 0.f, 0.f, 0.f};
    bf16x8 At[4][2], B0[2][2], B1[2][2];
    const char* cA = (const char*)g.A + (size_t)cur.pm * tstep; const char* cB = (const char*)g.Bt + (size_t)cur.pn * tstep;
    S.a_ready(cur);
    if constexpr (SP2) {
        PG8_STAGE(PG8_SB(0, 0), cB, voffB); PG8_STAGE(PG8_SB(0, 1), cB + hstep, voffB); PG8_STAGE(PG8_SA(0, 0), cA, voffA); PG8_STAGE(PG8_SA(0, 1), cA + hstep, voffA);
        if (wr == 1) PG8_BAR;
        PG8_WAIT_V(2); PG8_BAR;
        PG8_STAGE(PG8_SB(1, 0), cB + kstep, voffB); PG8_STAGE(PG8_SA(1, 0), cA + kstep, voffA); PG8_STAGE(PG8_SB(1, 1), cB + hstep + kstep, voffB);
        PG8_WAIT_V(6); PG8_BAR;
    } else {
        PG8_STAGE(PG8_SB(0, 0), cB, voffB); PG8_STAGE(PG8_SA(0, 0), cA, voffA); PG8_STAGE(PG8_SB(0, 1), cB + hstep, voffB); PG8_STAGE(PG8_SA(0, 1), cA + hstep, voffA);
        if (wr == 1) PG8_BAR;
        PG8_WAIT_V(4); PG8_BAR;
        PG8_STAGE(PG8_SB(1, 0), cB + kstep, voffB); PG8_STAGE(PG8_SA(1, 0), cA + kstep, voffA); PG8_STAGE(PG8_SB(1, 1), cB + hstep + kstep, voffB);
        PG8_WAIT_V(6); PG8_BAR;
    }
    for (;;) {
        const bool has_next = S.next(ui + 1, nxt);
        const char* nA = has_next ? (const char*)g.A + (size_t)nxt.pm * tstep : cA; const char* nB = has_next ? (const char*)g.Bt + (size_t)nxt.pn * tstep : cB;
        for (int t = 0; t < nt; t += 2) {
            const bool last = (t == nt - 2);
            const char* a1 = cA + (size_t)(t + 1) * kstep;
            const char* a2 = last ? nA : cA + (size_t)(t + 2) * kstep; const char* b2 = last ? nB : cB + (size_t)(t + 2) * kstep;
            const char* a3 = a2 + kstep; const char* b3 = b2 + kstep;
            if (last && has_next) S.a_ready(nxt);
            if constexpr (SP2) {
            PG8_LDB(B0, 0, 0); PG8_LDB(B1, 0, 1); PG8_SCHED; PG8_LDA(At, 0, 0); PG8_STAGE(PG8_SA(1, 1), a1 + hstep, voffA);
            PG8_WAIT_V(8); PG8_WAIT_L(0); PG8_BAR; PG8_MMA(0, 0, At, B0); PG8_MMA(0, 1, At, B1); PG8_BAR; PG8_SCHED;
            PG8_LDA(At, 0, 1); PG8_STAGE(PG8_SB(0, 0), b2, voffB); PG8_STAGE(PG8_SB(0, 1), b2 + hstep, voffB); PG8_STAGE(PG8_SA(0, 0), a2, voffA);
            PG8_WAIT_V(8); PG8_WAIT_L(0); PG8_BAR; PG8_MMA(1, 0, At, B0); PG8_MMA(1, 1, At, B1); PG8_BAR; PG8_SCHED;
            PG8_LDB(B0, 1, 0); PG8_LDB(B1, 1, 1); PG8_SCHED; PG8_LDA(At, 1, 0); PG8_STAGE(PG8_SA(0, 1), a2 + hstep, voffA);
            PG8_WAIT_V(8); PG8_WAIT_L(0); PG8_BAR; PG8_MMA(0, 0, At, B0); PG8_MMA(0, 1, At, B1); PG8_BAR; PG8_SCHED;
            PG8_LDA(At, 1, 1); PG8_STAGE(PG8_SB(1, 0), b3, voffB); PG8_STAGE(PG8_SB(1, 1), b3 + hstep, voffB); PG8_STAGE(PG8_SA(1, 0), a3, voffA);
            PG8_WAIT_V(8); PG8_WAIT_L(0); PG8_BAR; PG8_MMA(1, 0, At, B0); PG8_MMA(1, 1, At, B1); PG8_BAR; PG8_SCHED;
            } else {
            PG8_LDB(B0, 0, 0); PG8_SCHED; PG8_LDA(At, 0, 0); PG8_STAGE(PG8_SA(1, 1), a1 + hstep, voffA);
            PG8_WAIT_L(8); PG8_BAR; PG8_WAIT_L(0); PG8_MMA(0, 0, At, B0); PG8_BAR; PG8_SCHED;
            PG8_LDB(B1, 0, 1); PG8_STAGE(PG8_SB(0, 0), b2, voffB);
            PG8_BAR; PG8_WAIT_L(0); PG8_MMA(0, 1, At, B1); PG8_BAR;
            PG8_LDA(At, 0, 1); PG8_STAGE(PG8_SA(0, 0), a2, voffA);
            PG8_BAR; PG8_WAIT_L(0); PG8_MMA(1, 0, At, B0); PG8_BAR; PG8_SCHED;
            PG8_STAGE(PG8_SB(0, 1), b2 + hstep, voffB);
            PG8_WAIT_V(6); PG8_BAR; PG8_MMA(1, 1, At, B1); PG8_BAR;
            PG8_LDB(B0, 1, 0); PG8_SCHED; PG8_LDA(At, 1, 0); PG8_STAGE(PG8_SA(0, 1), a2 + hstep, voffA);
            PG8_WAIT_L(8); PG8_BAR; PG8_WAIT_L(0); PG8_MMA(0, 0, At, B0); PG8_BAR; PG8_SCHED;
            PG8_LDB(B1, 1, 1); PG8_STAGE(PG8_SB(1, 0), b3, voffB);
            PG8_BAR; PG8_WAIT_L(0); PG8_MMA(0, 1, At, B1); PG8_BAR;
            PG8_LDA(At, 1, 1); PG8_STAGE(PG8_SA(1, 0), a3, voffA);
            PG8_BAR; PG8_WAIT_L(0); PG8_MMA(1, 0, At, B0); PG8_BAR; PG8_SCHED;
            PG8_STAGE(PG8_SB(1, 1), b3 + hstep, voffB);
            PG8_WAIT_V(6); PG8_BAR; PG8_MMA(1, 1, At, B1); PG8_BAR;
            }
        }
        if constexpr (ALIGN_EPI) { if (wr == 0) PG8_BAR; }
        if constexpr (!Epi::AFTER_DRAIN) { E(acc, cur, wr, wc, fr, fq); S.done(cur); }
        if (!has_next) break;
#pragma unroll
        for (int a = 0; a < 2; ++a)
#pragma unroll
            for (int b = 0; b < 2; ++b)
#pragma unroll
                for (int m = 0; m < 4; ++m)
#pragma unroll
                    for (int n = 0; n < 2; ++n) acc[a][b][m][n] = (f32x4){0.f, 0.f, 0.f, 0.f};
        cur = nxt; cA = nA; cB = nB; ++ui;
        if constexpr (ALIGN_EPI) { if (wr == 1) PG8_BAR; }
    }
    PG8_WAIT_V(0);
    if constexpr (!ALIGN_EPI) { if (wr == 0) PG8_BAR; }
    PG8_BAR;
    if constexpr (Epi::AFTER_DRAIN) { E.fused(acc, cur, wr, wc, fr, fq, lds, wid, lane); S.done(cur); }
#undef PG8_SA
#undef PG8_SB
#undef PG8_STAGE
#undef PG8_LDA
#undef PG8_LDB
#undef PG8_MMA
#undef PG8_WAIT_V
#undef PG8_WAIT_L
#undef PG8_BAR
#undef PG8_SCHED
}
}
#define GAS __attribute__((address_space(1)))
#define LAS __attribute__((address_space(3)))
typedef unsigned short bf16;
typedef unsigned v4u __attribute__((ext_vector_type(4)));
typedef float f32x4 __attribute__((ext_vector_type(4)));
typedef short bf16x8 __attribute__((ext_vector_type(8)));
typedef GAS unsigned gu32;
typedef GAS unsigned long long gu64;
#define RLX_AGENT __ATOMIC_RELAXED, __HIP_MEMORY_SCOPE_AGENT
#define LDS_WAIT() asm volatile("s_waitcnt lgkmcnt(0)" ::: "memory")
#define VM_WAIT() asm volatile("s_waitcnt vmcnt(0)" ::: "memory")
__device__ __forceinline__ unsigned long long rt() { return __builtin_amdgcn_s_memrealtime(); }
__device__ __forceinline__ unsigned f2bf(float f) { unsigned u = __builtin_bit_cast(unsigned, f); return (u + 0x7fffu + ((u >> 16) & 1u)) >> 16; }
__device__ __forceinline__ unsigned pk2(float lo, float hi) { return f2bf(lo) | (f2bf(hi) << 16); }

#define XB_TMO      128
#define XB_XCNT(j)  (256  + 64 * (j))
#define XB_XSUB(j)  (1280 + 64 * (j))
#define XB_XGEN(j)  (2304 + 64 * (j))
#define XB_TOP      3328
#define XB_TOPGEN   3392
#define XCD_BAR_WORDS 3456
#define XB_SPIN_CAP (1u << 18)

__device__ __forceinline__ unsigned xb_ld(unsigned* p)              { return __hip_atomic_load(p, __ATOMIC_RELAXED, __HIP_MEMORY_SCOPE_AGENT); }
__device__ __forceinline__ unsigned xb_add(unsigned* p, unsigned v) { return __hip_atomic_fetch_add(p, v, __ATOMIC_RELAXED, __HIP_MEMORY_SCOPE_AGENT); }
__device__ __forceinline__ unsigned xb_xcc_id() { return (unsigned)__builtin_amdgcn_s_getreg((3 << 11) | 20) & 0xFu; }
#define XB_SPIN(cond, bar) do { unsigned _sp = 0; while (cond) { __builtin_amdgcn_s_sleep(1); \
    if ((++_sp & 255u) == 0u) { if (xb_ld(&(bar)[XB_TMO])) break; if (_sp > XB_SPIN_CAP) { atomicAdd(&(bar)[XB_TMO], 1u); break; } } } } while (0)

struct XcdBarrier {
    unsigned* bar; unsigned x;
    volatile LAS unsigned* st;
};

__device__ __forceinline__ XcdBarrier xcd_barrier_post(unsigned* bar, volatile LAS unsigned* st) {
    XcdBarrier b; b.bar = bar; b.x = xb_xcc_id(); b.st = st;
    if (threadIdx.x == 0) (void)xb_add(&bar[XB_XCNT(b.x)], 1u);
    return b;
}
__device__ __forceinline__ void xcd_barrier_complete(unsigned* bar, unsigned x, unsigned& nloc, unsigned& nx) {
    const unsigned G = gridDim.x * gridDim.y * gridDim.z;
    unsigned sum, cnt, mine, sp = 0u;
    for (;;) {
        sum = 0u; cnt = 0u; mine = 0u;
#pragma unroll
        for (unsigned j = 0; j < 16; ++j) { const unsigned c = xb_ld(&bar[XB_XCNT(j)]); sum += c; cnt += (c > 0u) ? 1u : 0u; mine = (j == x) ? c : mine; }
        if (sum == G) break;
        __builtin_amdgcn_s_sleep(1);
        if ((++sp & 255u) == 0u) { if (xb_ld(&bar[XB_TMO])) break; if (sp > XB_SPIN_CAP) { atomicAdd(&bar[XB_TMO], 1u); break; } }
    }
    nloc = mine > 0u ? mine : 1u; nx = cnt > 0u ? cnt : 1u;
}

__device__ __forceinline__ void xcd_barrier(const XcdBarrier& b, const bool t0  ) {
    asm volatile("s_waitcnt vmcnt(0)" ::: "memory");
    __syncthreads();
    if (t0) {
        unsigned* bar = b.bar;
        __builtin_amdgcn_s_waitcnt(0);
        unsigned nloc = b.st[0], nx = b.st[1];
        if (nloc == 0u) { xcd_barrier_complete(bar, b.x, nloc, nx); b.st[0] = nloc; b.st[1] = nx; }
        const unsigned old = xb_add(&bar[XB_XSUB(b.x)], 1u);
        const unsigned gen = old / nloc;
        if (old + 1u == (gen + 1u) * nloc) {
            __builtin_amdgcn_fence(__ATOMIC_RELEASE, "agent");
            asm volatile("s_waitcnt vmcnt(0)" ::: "memory");
            const unsigned og = xb_add(&bar[XB_TOP], 1u);
            const unsigned tg = og / nx;
            if (og + 1u == (tg + 1u) * nx) xb_add(&bar[XB_TOPGEN], 1u);
            else XB_SPIN(xb_ld(&bar[XB_TOPGEN]) == tg, bar);
            __builtin_amdgcn_fence(__ATOMIC_ACQUIRE, "agent");
            xb_add(&bar[XB_XGEN(b.x)], 1u);
            asm volatile("s_waitcnt vmcnt(0)" ::: "memory");
        } else {
            XB_SPIN(xb_ld(&bar[XB_XGEN(b.x)]) == gen, bar);
            __builtin_amdgcn_fence(__ATOMIC_ACQUIRE, "agent");
            asm volatile("s_waitcnt vmcnt(0)" ::: "memory");
        }
    }
    __syncthreads();
}

#ifndef PG8_SP2
#define PG8_SP2 true
#endif
#ifndef PG8_ALIGN
#define PG8_ALIGN true
#endif
constexpr int NWAVES = 8;
constexpr int N_STEPS = 38;
#ifndef MK_N_LAUNCHES
#define MK_N_LAUNCHES 1
#endif
#ifndef PH_MASK
#define PH_MASK 0xffff
#endif
#ifndef REP_MASK
#define REP_MASK 0
#endif
#ifndef PREP_REP_LRU
#define PREP_REP_LRU 1
#endif
#ifndef PREP_REP_GDN
#define PREP_REP_GDN 1
#endif
constexpr int N_LAUNCHES = MK_N_LAUNCHES;

constexpr int D = 1024, BATCH = 4, SEQ = 4096, DEPTH = 4, M = BATCH * SEQ;
constexpr int LRUW = 512, NGB = 8, GBW = 64, GH = 4, HD = 128, GDNW = 512, CH = 64, NCH = SEQ / CH, FF = 4096;
constexpr int NMODC = 6 * D, INC = 3080, NPROJ = 3072;
constexpr int O_LX = 0, O_LY = 512, O_Q = 1024, O_Z = 2560;
constexpr float EPS = 1e-6f;

constexpr size_t MiB = 1u << 20;
constexpr size_t WS_CTL = 0, CTL_ZERO_BYTES = 1 * MiB;
constexpr size_t WS_MOD = 1 * MiB;
constexpr size_t WS_BG = 2 * MiB;
constexpr size_t WS_AGG = 3 * MiB;
constexpr size_t WS_CARRY = 4 * MiB;
constexpr size_t WS_GL = 5 * MiB;
constexpr size_t WS_GT = 6 * MiB;
constexpr size_t WS_C1 = 6 * MiB + 512 * 1024;
constexpr size_t WS_C2 = 6 * MiB + 768 * 1024;
constexpr size_t WS_CB8 = 7 * MiB;
constexpr size_t WS_W8T = 7 * MiB + 64 * 1024;
constexpr size_t WS_RS1 = 364 * MiB, WS_RS2 = 365 * MiB;
constexpr size_t WS_A1 = 312 * MiB;
constexpr size_t WS_W = 8 * MiB;
constexpr size_t LAYER_W = (size_t)12288 * 1024;
constexpr size_t W_OUT_OFF = (size_t)3072 * 1024, W_UP_OFF = (size_t)4096 * 1024, W_DOWN_OFF = (size_t)8192 * 1024;
constexpr size_t WS_H = 104 * MiB;
constexpr size_t WS_MIX = 136 * MiB;
constexpr size_t WS_PROJ = 168 * MiB;
constexpr size_t WS_ACT = 168 * MiB;
constexpr size_t WS_GQD = 264 * MiB, WS_GKT = 280 * MiB;
constexpr size_t WS_GATT = 296 * MiB;
constexpr size_t WS_GO = 312 * MiB;
constexpr size_t WS_LRUP = 344 * MiB;
constexpr size_t WS_XT = 366 * MiB;
constexpr size_t WS_END = 384 * MiB;
constexpr int CW_BAR = 4096;
constexpr size_t X16_OFF = 32 * MiB;

constexpr int RING_OFF = 0, RING_BYTES = 155648;
constexpr int LDSCTL_OFF = RING_BYTES, MISC_OFF = LDSCTL_OFF + 320;
constexpr int LDS_BYTES = 156672;

typedef unsigned v2u __attribute__((ext_vector_type(2)));
#define DI __device__ __forceinline__
DI float bf2f(unsigned b) { return __builtin_bit_cast(float, b << 16); }
DI float bflo(unsigned w) { return __builtin_bit_cast(float, w << 16); }
DI float bfhi(unsigned w) { return __builtin_bit_cast(float, w & 0xffff0000u); }
DI float sigmoidf_(float x) { return 1.f / (1.f + expf(-x)); }
DI float siluf_(float x) { return x / (1.f + expf(-x)); }
DI float rcp_(float x) { return __builtin_amdgcn_rcpf(x); }
DI float exp_fast(float x) { return __builtin_amdgcn_exp2f(x * 1.4426950408889634f); }
DI float sigmoid_fast(float x) { return rcp_(1.f + exp_fast(-x)); }
DI float silu_fast(float x) { return x * rcp_(1.f + exp_fast(-x)); }
DI float gelu_tanh(float x) { const float u = 0.7978845608028654f * (x + 0.044715f * x * x * x); return 0.5f * x * (1.f + tanhf(u)); }
DI float bperm_(int src_lane, float v) { return __builtin_bit_cast(float, __builtin_amdgcn_ds_bpermute(src_lane << 2, __builtin_bit_cast(int, v))); }
DI float wave_sum_(int lane, float v) {
#pragma unroll
    for (int o = 1; o < 64; o <<= 1) v += bperm_(lane ^ o, v);
    return v;
}
DI float half_sum_(int lane, float v) {
#pragma unroll
    for (int o = 1; o < 32; o <<= 1) v += bperm_(lane ^ o, v);
    return v;
}
DI float shfl_up_(int lane, float v, int off) { return bperm_(lane >= off ? lane - off : lane, v); }

struct Args { const float* in[23]; float* out; unsigned char* ws; int ph_lo, ph_hi; };
static_assert(sizeof(Args) == 23 * 8 + 8 + 8 + 8, "Args has no padding");
struct Frame {
    LAS unsigned char* lds;
    volatile LAS unsigned* MISC;
    gu32* ctl;
    int tid, lane, wave;
    int vcu, G;
    const __attribute__((address_space(4))) Args* A;
};
#define IN_(k) (F.A->in[k])
#define X_IN IN_(0)
#define C_IN IN_(1)
#define NORM_MIX_W IN_(2)
#define NORM_MLP_W IN_(3)
#define W_MOD IN_(4)
#define B_MOD IN_(5)
#define W_IN IN_(6)
#define LRU_CONV_W IN_(7)
#define LRU_CONV_B IN_(8)
#define GATE_A_W IN_(9)
#define GATE_A_B IN_(10)
#define GATE_X_W IN_(11)
#define GATE_X_B IN_(12)
#define LRU_LAMBDA IN_(13)
#define LRU_NORM_W IN_(14)
#define GDN_CONV_W IN_(15)
#define GDN_A_LOG IN_(16)
#define GDN_DT_BIAS IN_(17)
#define GDN_NORM_W IN_(18)
#define W_OUT IN_(19)
#define W_UP IN_(20)
#define W_DOWN IN_(21)
#define FINAL_NORM_W IN_(22)
#define OUT_ (F.A->out)
#define WSF(off) ((float*)(F.A->ws + (off)))
#define WSH(off) ((bf16*)(F.A->ws + (off)))

DI void p_mod(Frame& F) {
    LAS float* cs = (LAS float*)F.lds;
    LAS float* red = cs + 4096;
    for (int i = F.tid; i < BATCH * D; i += NWAVES * 64) cs[i] = siluf_(C_IN[i]);
    __syncthreads();
    const int hl = F.lane >> 5, cl = F.lane & 31;
    for (int item = F.vcu; item < DEPTH * 192; item += F.G) {
        const int l = item / 192, cg = item % 192, col = cg * 32 + cl, kbase = F.wave * 128 + hl * 64;
        const float* wp = W_MOD + ((size_t)l * D + kbase) * NMODC + col;
        float a0 = 0.f, a1 = 0.f, a2 = 0.f, a3 = 0.f;
#pragma unroll 16
        for (int kk = 0; kk < 64; ++kk) { const float wv = wp[(size_t)kk * NMODC]; const int k = kbase + kk;
            a0 += cs[k] * wv; a1 += cs[1024 + k] * wv; a2 += cs[2048 + k] * wv; a3 += cs[3072 + k] * wv; }
        const int sl = F.wave * 2 + hl;
        red[(sl * 4 + 0) * 32 + cl] = a0; red[(sl * 4 + 1) * 32 + cl] = a1; red[(sl * 4 + 2) * 32 + cl] = a2; red[(sl * 4 + 3) * 32 + cl] = a3;
        __syncthreads();
        if (F.tid < 128) { const int b = F.tid >> 5, ln = F.tid & 31; float sum = 0.f;
#pragma unroll
            for (int w = 0; w < 16; ++w) sum += red[(w * 4 + b) * 32 + ln];
            const int cc = cg * 32 + ln; WSF(WS_MOD)[((size_t)l * BATCH + b) * NMODC + cc] = sum + B_MOD[(size_t)l * NMODC + cc]; }
        __syncthreads();
    }
}

struct TrItem { const float* src; bf16* dst; int K, ldw; };
DI void p0_item(Frame& F, int it, TrItem& T) {
    constexpr int I_IN = (D / 64) * (NPROJ / 32), I_OUT = (D / 64) * (D / 32), I_UP = (D / 64) * (FF / 32), I_DN = (FF / 64) * (D / 32);
    constexpr int PER_LAYER = I_IN + I_OUT + I_UP + I_DN;
    const int l = it / PER_LAYER; int r = it % PER_LAYER; bf16* wl = WSH(WS_W) + (size_t)l * LAYER_W;
    const float* W; int K, ldw, N; bf16* WT;
    if (r < I_IN) { W = W_IN + (size_t)l * D * INC; K = D; ldw = INC; N = NPROJ; WT = wl; }
    else if ((r -= I_IN) < I_OUT) { W = W_OUT + (size_t)l * D * D; K = D; ldw = D; N = D; WT = wl + W_OUT_OFF; }
    else if ((r -= I_OUT) < I_UP) { W = W_UP + (size_t)l * D * FF; K = D; ldw = FF; N = FF; WT = wl + W_UP_OFF; }
    else { r -= I_UP; W = W_DOWN + (size_t)l * FF * D; K = FF; ldw = D; N = D; WT = wl + W_DOWN_OFF; }
    const int nblk = N / 32, kb = r / nblk, nb = r % nblk, k0 = 64 * kb, n0 = 32 * nb;
    T.src = W + (size_t)k0 * ldw + n0; T.dst = WT + (size_t)n0 * K + k0; T.K = K; T.ldw = ldw;
}
DI void p0_weights(Frame& F) {
    LAS float* scr = (LAS float*)(F.lds + RING_OFF + F.wave * 16384);
    const int gw = F.vcu * NWAVES + F.wave, NGW = F.G * NWAVES, lane = F.lane;
    constexpr int NIT = DEPTH * ((D / 64) * (NPROJ / 32) + (D / 64) * (D / 32) + (D / 64) * (FF / 32) + (FF / 64) * (D / 32));
    TrItem T; f32x4 v[8];
    if (gw < NIT) { p0_item(F, gw, T);
#pragma unroll
        for (int i = 0; i < 8; ++i) v[i] = *(const f32x4*)(T.src + (size_t)((lane >> 3) + 8 * i) * T.ldw + 4 * (lane & 7)); }
    for (int it = gw; it < NIT; it += NGW) {
        TrItem Tn; f32x4 vn[8]; const int itn = it + NGW < NIT ? it + NGW : it;
        p0_item(F, itn, Tn);
#pragma unroll
        for (int i = 0; i < 8; ++i) vn[i] = *(const f32x4*)(Tn.src + (size_t)((lane >> 3) + 8 * i) * Tn.ldw + 4 * (lane & 7));
#pragma unroll
        for (int i = 0; i < 8; ++i) { LAS float* d = scr + ((lane >> 3) + 8 * i) * 33 + 4 * (lane & 7); d[0] = v[i].x; d[1] = v[i].y; d[2] = v[i].z; d[3] = v[i].w; }
        LDS_WAIT(); asm volatile("" ::: "memory");
        const int c = lane & 7;
#pragma unroll
        for (int j = 0; j < 4; ++j) { const int n = (lane >> 3) + 8 * j; const LAS float* sp = scr + (8 * c) * 33 + n;
            v4u o; o.x = pk2(sp[0 * 33], sp[1 * 33]); o.y = pk2(sp[2 * 33], sp[3 * 33]); o.z = pk2(sp[4 * 33], sp[5 * 33]); o.w = pk2(sp[6 * 33], sp[7 * 33]);
            *(v4u*)(T.dst + (size_t)n * T.K + 8 * c) = o; }
        LDS_WAIT(); asm volatile("" ::: "memory");
        T = Tn;
#pragma unroll
        for (int i = 0; i < 8; ++i) v[i] = vn[i];
    }
    for (int o = (int)blockIdx.x * NWAVES * 64 + F.tid; o < DEPTH * 16 * 1024; o += (int)gridDim.x * NWAVES * 64) {
        const int k = o & 1023, j = (o >> 10) & 15, l = o >> 14;
        WSH(WS_W8T)[o] = (bf16)(j < 8 ? f2bf(W_IN[((size_t)l * D + k) * INC + NPROJ + j]) : 0u);
    }
    for (int o = (int)blockIdx.x * NWAVES * 64 + F.tid; o < DEPTH * 2 * NGB * 4096; o += (int)gridDim.x * NWAVES * 64) {
        const int i = o & 63, j = (o >> 6) & 63, g = (o >> 12) & 7, gate = (o >> 15) & 1, l = o >> 16;
        const float* src = gate ? GATE_X_W : GATE_A_W;
        WSH(WS_GT)[o] = (bf16)f2bf(src[(size_t)(l * NGB + g) * 4096 + i * 64 + j]);
    }
}

DI void p_cvec(Frame& F) {
    const int gw = F.vcu * NWAVES + F.wave, NGW = F.G * NWAVES, lane = F.lane;
    constexpr int IT_IN = NPROJ / 16, IT_UP = FF / 16, PER_L = IT_IN + IT_UP;
    for (int it = gw; it < DEPTH * PER_L; it += NGW) {
        const int l = it / PER_L, r = it % PER_L, which = r >= IT_IN, rg = which ? r - IT_IN : r, N = which ? FF : NPROJ;
        const bf16* wt = WSH(WS_W) + (size_t)l * LAYER_W + (which ? W_UP_OFF : 0) + (size_t)(rg * 16) * 1024 + 16 * lane;
        const float* shb = WSF(WS_MOD) + (size_t)l * BATCH * NMODC + (which ? 3 * D : 0) + 16 * lane;
        float* cout = (which ? WSF(WS_C2) + (size_t)l * BATCH * FF : WSF(WS_C1) + (size_t)l * BATCH * NPROJ) + rg * 16;
        f32x4 sh[4][4];
#pragma unroll
        for (int b = 0; b < 4; ++b)
#pragma unroll
            for (int j = 0; j < 4; ++j) sh[b][j] = *(const f32x4*)(shb + (size_t)b * NMODC + 4 * j);
        float v[64];
#pragma unroll
        for (int row = 0; row < 16; ++row) { const v4u w0 = *(const v4u*)(wt + (size_t)row * 1024), w1 = *(const v4u*)(wt + (size_t)row * 1024 + 8);
            const f32x4 wa = (f32x4){bflo(w0.x), bfhi(w0.x), bflo(w0.y), bfhi(w0.y)}, wb = (f32x4){bflo(w0.z), bfhi(w0.z), bflo(w0.w), bfhi(w0.w)};
            const f32x4 wc = (f32x4){bflo(w1.x), bfhi(w1.x), bflo(w1.y), bfhi(w1.y)}, wd = (f32x4){bflo(w1.z), bfhi(w1.z), bflo(w1.w), bfhi(w1.w)};
#pragma unroll
            for (int b = 0; b < 4; ++b) { const f32x4 t = sh[b][0] * wa + sh[b][1] * wb + sh[b][2] * wc + sh[b][3] * wd; v[row * 4 + b] = (t[0] + t[1]) + (t[2] + t[3]); } }
#pragma unroll
        for (int st = 0; st < 6; ++st) { const int bit = 1 << st; const bool up = lane & bit;
#pragma unroll
            for (int i = 0; i < (32 >> st); ++i) { const float keep = up ? v[2 * i + 1] : v[2 * i], send = up ? v[2 * i] : v[2 * i + 1]; v[i] = keep + bperm_(lane ^ bit, send); } }
        cout[(size_t)(lane & 3) * N + (lane >> 2)] = v[0];
    }
    if (gw < DEPTH * BATCH) { const int l = gw >> 2, b = gw & 3; float a[8];
#pragma unroll
        for (int j = 0; j < 8; ++j) a[j] = 0.f;
        for (int kk = 0; kk < 16; ++kk) { const int k = 16 * lane + kk; const float shv = WSF(WS_MOD)[((size_t)l * BATCH + b) * NMODC + k];
#pragma unroll
            for (int j = 0; j < 8; ++j) a[j] += shv * W_IN[((size_t)l * D + k) * INC + NPROJ + j]; }
#pragma unroll
        for (int j = 0; j < 8; ++j) a[j] = wave_sum_(lane, a[j]);
        if (lane < 8) { float r = a[0];
#pragma unroll
            for (int j = 1; j < 8; ++j) r = (lane == j) ? a[j] : r;
            WSF(WS_CB8)[(size_t)gw * 8 + lane] = r; } }
}

template <bool WITH_BG>
DI void p_normmod(Frame& F, int l, const float* xin, const float* normw, int off_sh, int off_sc) {
    LAS float* w8 = (LAS float*)F.lds;
    if (WITH_BG) {
        for (int i = F.tid; i < D * 8; i += NWAVES * 64) w8[i] = W_IN[((size_t)l * D + (i >> 3)) * INC + NPROJ + (i & 7)];
        __syncthreads();
    }
    const int gw = F.vcu * NWAVES + F.wave, NGW = F.G * NWAVES, lane = F.lane;
    f32x4 v[4];
    if (gw < M) {
#pragma unroll
        for (int j = 0; j < 4; ++j) v[j] = *(const f32x4*)(xin + (size_t)gw * D + 4 * lane + 256 * j);
    }
    for (int m = gw; m < M; m += NGW) {
        const int b = m >> 12, mn = m + NGW;
        f32x4 vnx[4];
#pragma unroll
        for (int j = 0; j < 4; ++j) vnx[j] = (mn < M) ? *(const f32x4*)(xin + (size_t)mn * D + 4 * lane + 256 * j) : (f32x4){0.f, 0.f, 0.f, 0.f};
        const float* modp = WSF(WS_MOD) + ((size_t)l * BATCH + b) * NMODC;
        float ss = 0.f;
#pragma unroll
        for (int j = 0; j < 4; ++j) ss += (v[j].x * v[j].x + v[j].y * v[j].y) + (v[j].z * v[j].z + v[j].w * v[j].w);
        ss = wave_sum_(lane, ss);
        const float rstd = 1.0f / sqrtf(ss * (1.0f / D) + EPS);
        float a0 = 0.f, a1 = 0.f, a2 = 0.f, a3 = 0.f, a4 = 0.f, a5 = 0.f, a6 = 0.f, a7 = 0.f;
#pragma unroll
        for (int j = 0; j < 4; ++j) {
            const int col = 4 * lane + 256 * j;
            const f32x4 nw = *(const f32x4*)(normw + (size_t)l * D + col), sc = *(const f32x4*)(modp + off_sc + col), sh = *(const f32x4*)(modp + off_sh + col);
            const f32x4 hv = v[j] * rstd * nw * (sc + 1.0f) + sh;
            v2u o; o.x = pk2(hv.x, hv.y); o.y = pk2(hv.z, hv.w);
            *(v2u*)(WSH(WS_H) + (size_t)m * D + col) = o;
            if (WITH_BG) {
#pragma unroll
                for (int e = 0; e < 4; ++e) { const f32x4 wa = *(const LAS f32x4*)(w8 + (col + e) * 8), wb = *(const LAS f32x4*)(w8 + (col + e) * 8 + 4); const float hh = hv[e];
                    a0 += hh * wa.x; a1 += hh * wa.y; a2 += hh * wa.z; a3 += hh * wa.w; a4 += hh * wb.x; a5 += hh * wb.y; a6 += hh * wb.z; a7 += hh * wb.w; }
            }
        }
        if (WITH_BG) {
            const bool b0 = lane & 1, b1 = lane & 2, b2 = lane & 4;
            float k0 = b0 ? a1 : a0, k1 = b0 ? a3 : a2, k2 = b0 ? a5 : a4, k3 = b0 ? a7 : a6;
            k0 += bperm_(lane ^ 1, b0 ? a0 : a1); k1 += bperm_(lane ^ 1, b0 ? a2 : a3); k2 += bperm_(lane ^ 1, b0 ? a4 : a5); k3 += bperm_(lane ^ 1, b0 ? a6 : a7);
            float c0 = b1 ? k1 : k0, c1 = b1 ? k3 : k2;
            c0 += bperm_(lane ^ 2, b1 ? k0 : k1); c1 += bperm_(lane ^ 2, b1 ? k2 : k3);
            float d = b2 ? c1 : c0;
            d += bperm_(lane ^ 4, b2 ? c0 : c1);
            d += bperm_(lane ^ 8, d); d += bperm_(lane ^ 16, d); d += bperm_(lane ^ 32, d);
            if (lane < 8) {
                const int hh = lane & 3;
                float r;
                if (lane < 4) r = sigmoidf_(d);
                else { const float xx = d + GDN_DT_BIAS[l * GH + hh]; const float sp = xx > 20.f ? xx : log1pf(expf(xx)); r = -expf(GDN_A_LOG[l * GH + hh]) * sp; }
                WSF(WS_BG)[(size_t)m * 8 + lane] = r;
            }
        }
#pragma unroll
        for (int j = 0; j < 4; ++j) v[j] = vnx[j];
    }
}

typedef float f32x2_t __attribute__((ext_vector_type(2))); typedef __bf16 bf16x2_t __attribute__((ext_vector_type(2)));
DI unsigned cvtpk(float lo, float hi) { f32x2_t v = {lo, hi}; bf16x2_t b = __builtin_convertvector(v, bf16x2_t); return __builtin_bit_cast(unsigned, b); }
DI bf16x8 pack8(f32x4 a, f32x4 b) { v4u p; p.x = cvtpk(a.x, a.y); p.y = cvtpk(a.z, a.w); p.z = cvtpk(b.x, b.y); p.w = cvtpk(b.z, b.w); return __builtin_bit_cast(bf16x8, p); }
DI bf16x8 ldfrag(const LAS unsigned char* p) { const v2u lo = *(const LAS v2u*)p, hi = *(const LAS v2u*)(p + 32); v4u r; r.x = lo.x; r.y = lo.y; r.z = hi.x; r.w = hi.y; return __builtin_bit_cast(bf16x8, r); }
#define MFMA16(a, b, c) __builtin_amdgcn_mfma_f32_16x16x32_bf16((a), (b), (c), 0, 0, 0)

#define WG_BAR() do { asm volatile("s_waitcnt lgkmcnt(0)" ::: "memory"); __builtin_amdgcn_s_barrier(); asm volatile("" ::: "memory"); } while (0)
DI bf16x8 ld128(const LAS unsigned char* p) { return *(const LAS bf16x8*)p; }
DI int kperm4(int k4) { return k4 < 16 ? 2 * k4 : 2 * (k4 - 16) + 4; }
DI int kperm(int k) { return (k & ~31) + kperm4(k & 28) + (k & 3); }
constexpr int PG_QB = 0, PG_KB = 17408, PG_KBET = 34816, PG_VT = 53248, PG_LS = 71680, PG_TS = 89088, PG_TB = 106496, PG_ATT = 115712, PG_XS = 124928, PG_SM = 128000, PG_END = 129024, PG_BGS = 140288;
static_assert(PG_END <= RING_BYTES && PG_BGS >= 8 * 17408 && PG_BGS + 2048 <= RING_BYTES, "prep LDS map");
DI void p_prep(Frame& F, int l) {
    const int wave = F.wave;
#define PREP_IDS int tid_ = F.tid; asm volatile("" : "+v"(tid_)); const int tid = tid_, lane = tid & 63, m = lane & 15, q = lane >> 4; (void)m; (void)q;
    for (int item = blockIdx.x; item < BATCH * NCH; item += gridDim.x) {
        const int b = item / NCH, n = item % NCH, row0 = b * SEQ + n * CH, t0 = n * CH;
        LAS float* bgs = (LAS float*)(F.lds + PG_BGS);
        if (l > 0 && wave < 4) {
            PREP_IDS
            const int mt = wave;
            const bf16* a1 = WSH(WS_A1) + (size_t)(row0 + 16 * mt + m) * D + 8 * q;
            const bf16* w8t = WSH(WS_W8T) + (size_t)l * 16 * 1024 + (size_t)m * 1024 + 8 * q;
            f32x4 acc = (f32x4){0.f, 0.f, 0.f, 0.f};
#pragma unroll 16
            for (int kb = 0; kb < 32; ++kb) acc = MFMA16(*(const bf16x8*)(a1 + 32 * kb), *(const bf16x8*)(w8t + 32 * kb), acc);
            if (m < 8) { const int hh = m & 3; const float cb = WSF(WS_CB8)[((size_t)l * BATCH + b) * 8 + m], dtb = GDN_DT_BIAS[l * GH + hh], alog = GDN_A_LOG[l * GH + hh];
#pragma unroll
                for (int r = 0; r < 4; ++r) { const int t = 16 * mt + 4 * q + r; const f32x4* rp = (const f32x4*)(WSF(WS_RS1) + (size_t)(row0 + t) * 16);
                    const f32x4 p0 = rp[0], p1 = rp[1], p2 = rp[2], p3 = rp[3], ts = (p0 + p1) + (p2 + p3);
                    const float rstd = 1.0f / sqrtf(((ts[0] + ts[1]) + (ts[2] + ts[3])) * (1.0f / D) + EPS), v = acc[r] * rstd + cb;
                    float res;
                    if (m < 4) res = sigmoidf_(v); else { const float xx = v + dtb; const float sp = xx > 20.f ? xx : log1pf(expf(xx)); res = -expf(alog) * sp; }
                    bgs[t * 8 + m] = res; } }
        }
        for (int rep_ = 0; rep_ < PREP_REP_LRU; ++rep_) {
            PREP_IDS
            const int g = wave;
            LAS float* xr = (LAS float*)(F.lds + wave * 17408);
            const int tg = lane >> 3, cg = lane & 7, c0 = 8 * cg, cc0 = g * 64 + c0;
            v4u xp[11];
#pragma unroll
            for (int i = 0; i < 11; ++i) { const int tt = t0 + 8 * tg - 3 + i;
                xp[i] = (tt >= 0) ? *(const v4u*)(WSH(WS_PROJ) + (size_t)(b * SEQ + tt) * NPROJ + O_LX + cc0) : (v4u){0u, 0u, 0u, 0u}; }
            f32x4 wl_[4], wh_[4];
#pragma unroll
            for (int k = 0; k < 4; ++k) { wl_[k] = *(const f32x4*)(LRU_CONV_W + ((size_t)l * 4 + k) * LRUW + cc0); wh_[k] = *(const f32x4*)(LRU_CONV_W + ((size_t)l * 4 + k) * LRUW + cc0 + 4); }
            const f32x4 bl_ = *(const f32x4*)(LRU_CONV_B + l * LRUW + cc0), bh_ = *(const f32x4*)(LRU_CONV_B + l * LRUW + cc0 + 4);
            bf16x8 Bf[2][4][2];
#pragma unroll
            for (int gate = 0; gate < 2; ++gate)
#pragma unroll
                for (int nt = 0; nt < 4; ++nt)
#pragma unroll
                    for (int ks = 0; ks < 2; ++ks) Bf[gate][nt][ks] = *(const bf16x8*)(WSH(WS_GT) + ((size_t)((l * 2 + gate) * NGB + g)) * 4096 + (size_t)(16 * nt + m) * 64 + 32 * ks + 8 * q);
            float ba_[4], bx_[4], ls_[4];
#pragma unroll
            for (int nt = 0; nt < 4; ++nt) { const int cc = g * 64 + 16 * nt + m; ba_[nt] = GATE_A_B[l * LRUW + cc]; bx_[nt] = GATE_X_B[l * LRUW + cc];
                const float lam = LRU_LAMBDA[l * LRUW + cc]; ls_[nt] = -8.0f * (fmaxf(-lam, 0.f) + log1pf(expf(-fabsf(lam)))); }
#pragma unroll
            for (int tt = 0; tt < 8; ++tt) { f32x4 al = bl_, ah = bh_;
#pragma unroll
                for (int k = 0; k < 4; ++k) { const v4u xw = xp[tt + k];
                    al += wl_[k] * (f32x4){bflo(xw.x), bfhi(xw.x), bflo(xw.y), bfhi(xw.y)}; ah += wh_[k] * (f32x4){bflo(xw.z), bfhi(xw.z), bflo(xw.w), bfhi(xw.w)}; }
                *(LAS f32x4*)(xr + (8 * tg + tt) * 68 + c0) = al; *(LAS f32x4*)(xr + (8 * tg + tt) * 68 + c0 + 4) = ah; }
            asm volatile("s_waitcnt lgkmcnt(0)" ::: "memory");
            bf16x8 Af[4][2];
#pragma unroll
            for (int mt = 0; mt < 4; ++mt)
#pragma unroll
                for (int ks = 0; ks < 2; ++ks) { const LAS float* pp = xr + (16 * mt + m) * 68 + 32 * ks + 8 * q; Af[mt][ks] = pack8(*(const LAS f32x4*)pp, *(const LAS f32x4*)(pp + 4)); }
#pragma unroll
            for (int nt = 0; nt < 4; ++nt) {
                float av[4][4], bv[4][4];
#pragma unroll
                for (int mt = 0; mt < 4; ++mt) { f32x4 ra = (f32x4){0.f, 0.f, 0.f, 0.f}, ia = (f32x4){0.f, 0.f, 0.f, 0.f};
                    ra = MFMA16(Af[mt][0], Bf[0][nt][0], ra); ra = MFMA16(Af[mt][1], Bf[0][nt][1], ra);
                    ia = MFMA16(Af[mt][0], Bf[1][nt][0], ia); ia = MFMA16(Af[mt][1], Bf[1][nt][1], ia);
#pragma unroll
                    for (int r = 0; r < 4; ++r) { const float rr = sigmoid_fast(ra[r] + ba_[nt]), ig = sigmoid_fast(ia[r] + bx_[nt]);
                        const float log_a = rr * ls_[nt], aa = exp_fast(log_a), mult = __builtin_amdgcn_sqrtf(fmaxf(1.0f - exp_fast(2.0f * log_a), 1e-12f));
                        av[mt][r] = aa; bv[mt][r] = mult * (ig * xr[(16 * mt + 4 * q + r) * 68 + 16 * nt + m]); } }
                float iP[4], iH[4];
#pragma unroll
                for (int mt = 0; mt < 4; ++mt) {
#pragma unroll
                    for (int r = 1; r < 4; ++r) { bv[mt][r] = av[mt][r] * bv[mt][r - 1] + bv[mt][r]; av[mt][r] = av[mt][r] * av[mt][r - 1]; }
                    float PA = av[mt][3], HA = bv[mt][3];
                    { const float Pp = shfl_up_(lane, PA, 16), Hp = shfl_up_(lane, HA, 16); if (q >= 1) { HA = PA * Hp + HA; PA = PA * Pp; } }
                    { const float Pp = shfl_up_(lane, PA, 32), Hp = shfl_up_(lane, HA, 32); if (q >= 2) { HA = PA * Hp + HA; PA = PA * Pp; } }
                    iP[mt] = PA; iH[mt] = HA; }
                float CP = 1.f, CH = 0.f;
#pragma unroll
                for (int mt = 0; mt < 4; ++mt) {
                    const float totP = bperm_(m + 48, iP[mt]), totH = bperm_(m + 48, iH[mt]);
                    float exP = shfl_up_(lane, iP[mt], 16), exH = shfl_up_(lane, iH[mt], 16); if (q == 0) { exP = 1.f; exH = 0.f; }
                    const float EP = CP * exP, EH = exP * CH + exH;
#pragma unroll
                    for (int r = 0; r < 4; ++r) { const float Pf = EP * av[mt][r], Hf = av[mt][r] * EH + bv[mt][r];
                        *(LAS unsigned*)(xr + (16 * mt + 4 * q + r) * 68 + 16 * nt + m) = f2bf(Hf) | (f2bf(Pf) << 16); }
                    CH = totP * CH + totH; CP = CP * totP; }
                if (q == 0) { WSF(WS_AGG)[((size_t)(b * NCH + n)) * LRUW + g * 64 + 16 * nt + m] = CP; WSF(WS_AGG)[(size_t)BATCH * NCH * LRUW + ((size_t)(b * NCH + n)) * LRUW + g * 64 + 16 * nt + m] = CH; }
            }
            asm volatile("s_waitcnt lgkmcnt(0)" ::: "memory");
#pragma unroll
            for (int i = 0; i < 16; ++i) { const int pz = lane + 64 * i, row = pz >> 4, c16 = pz & 15;
                *(v4u*)((unsigned*)(F.A->ws + WS_H) + (size_t)(row0 + row) * LRUW + g * 64 + 4 * c16) = *(const LAS v4u*)(xr + row * 68 + 4 * c16); }
        }
        __syncthreads();
        {
            LAS unsigned char* qb = F.lds + PG_QB;
            LAS unsigned char* kb = F.lds + PG_KB;
            LAS unsigned char* kbeT = F.lds + PG_KBET;
            LAS unsigned char* vT = F.lds + PG_VT;
            LAS float* Ls = (LAS float*)(F.lds + PG_LS);
            LAS float* Ts = (LAS float*)(F.lds + PG_TS);
            LAS unsigned char* Tb = F.lds + PG_TB;
            LAS unsigned char* atts = F.lds + PG_ATT;
            LAS float* Xs = (LAS float*)(F.lds + PG_XS);
            LAS float* sm4 = (LAS float*)(F.lds + PG_SM);
            if (wave < GH) { int tl_ = F.tid; asm volatile("" : "+v"(tl_)); const int ln = tl_ & 63, hh = wave;
                float gcv = l > 0 ? bgs[ln * 8 + 4 + hh] : WSF(WS_BG)[(size_t)(row0 + ln) * 8 + 4 + hh];
#pragma unroll
                for (int off = 1; off < 64; off <<= 1) { const float pv = shfl_up_(ln, gcv, off); if (ln >= off) gcv += pv; }
                const float glast = bperm_(63, gcv);
                sm4[hh * 256 + ln] = gcv; sm4[hh * 256 + 64 + ln] = l > 0 ? bgs[ln * 8 + hh] : WSF(WS_BG)[(size_t)(row0 + ln) * 8 + hh]; sm4[hh * 256 + 128 + ln] = expf(gcv); sm4[hh * 256 + 192 + ln] = expf(glast - gcv); }
            WG_BAR();
            v4u xpn[11];
#define G1_FETCH(hh_) do { int tf_ = F.tid; asm volatile("" : "+v"(tf_)); if (tf_ < 384) { const int cgp_ = tf_ & 15, wt_ = tf_ >> 4, which_ = wt_ >> 3, tr_ = wt_ & 7, ch_ = which_ * GDNW + (hh_) * HD + cgp_ * 8; \
                _Pragma("unroll") for (int i = 0; i < 11; ++i) { const int tt = t0 + tr_ * 8 - 3 + i; \
                    xpn[i] = (tt >= 0) ? *(const v4u*)(WSH(WS_PROJ) + (size_t)(b * SEQ + tt) * NPROJ + O_Q + ch_) : (v4u){0u, 0u, 0u, 0u}; } \
                } } while (0)
            G1_FETCH(0);
            for (int h_ = 0; h_ < GH * PREP_REP_GDN; ++h_) { const int h = h_ % GH;
                PREP_IDS
                const size_t item4 = (size_t)(b * GH + h) * NCH + n;
                LAS float* sgc = sm4 + h * 256, *sbeta = sgc + 64, *seg = sgc + 128, *sel = sgc + 192;
#if defined(PROBE_G) && PROBE_G == 1
                for (int prb_ = 0; prb_ < 2; ++prb_) {
#else
                {
#endif
                if (tid < 384) {
                    const int cgp = tid & 15, wt = tid >> 4, which = wt >> 3, tr = wt & 7, d0 = cgp * 8, ch0 = which * GDNW + h * HD + d0;
                    v4u xp[11]; f32x4 wl_[4], wh_[4];
#pragma unroll
                    for (int i = 0; i < 11; ++i) xp[i] = xpn[i];
#pragma unroll
                    for (int k = 0; k < 4; ++k) { wl_[k] = *(const f32x4*)(GDN_CONV_W + ((size_t)l * 4 + k) * (3 * GDNW) + ch0); wh_[k] = *(const f32x4*)(GDN_CONV_W + ((size_t)l * 4 + k) * (3 * GDNW) + ch0 + 4); }
                    f32x4 ol[8], oh[8]; float ss[8];
#pragma unroll
                    for (int tt = 0; tt < 8; ++tt) { f32x4 al = (f32x4){0.f, 0.f, 0.f, 0.f}, ah = (f32x4){0.f, 0.f, 0.f, 0.f};
#pragma unroll
                        for (int k = 0; k < 4; ++k) { const v4u xw = xp[tt + k];
                            al += wl_[k] * (f32x4){bflo(xw.x), bfhi(xw.x), bflo(xw.y), bfhi(xw.y)}; ah += wh_[k] * (f32x4){bflo(xw.z), bfhi(xw.z), bflo(xw.w), bfhi(xw.w)}; }
#pragma unroll
                        for (int c = 0; c < 4; ++c) { al[c] = silu_fast(al[c]); ah[c] = silu_fast(ah[c]); }
                        ol[tt] = al; oh[tt] = ah;
                        ss[tt] = (al.x * al.x + al.y * al.y) + (al.z * al.z + al.w * al.w) + (ah.x * ah.x + ah.y * ah.y) + (ah.z * ah.z + ah.w * ah.w); }
                    if (h_ + 1 < GH * PREP_REP_GDN) G1_FETCH((h_ + 1) % GH);
                    if (which < 2) {
#pragma unroll
                        for (int tt = 0; tt < 8; ++tt) { float v = ss[tt]; v += bperm_(lane ^ 1, v); v += bperm_(lane ^ 2, v); v += bperm_(lane ^ 4, v); v += bperm_(lane ^ 8, v);
                            const float scl = __builtin_amdgcn_rsqf(v + 1e-6f) * (which == 0 ? 0.08838834764831845f : 1.0f); ol[tt] = ol[tt] * scl; oh[tt] = oh[tt] * scl; }
                    }
                    const int tb = tr * 8;
                    if (which == 0) {
#pragma unroll
                        for (int tt = 0; tt < 8; ++tt) { const int t = tb + tt; const float eg = seg[t];
                            v4u pk; pk.x = cvtpk(ol[tt].x, ol[tt].y); pk.y = cvtpk(ol[tt].z, ol[tt].w); pk.z = cvtpk(oh[tt].x, oh[tt].y); pk.w = cvtpk(oh[tt].z, oh[tt].w);
                            *(LAS v4u*)(qb + t * 272 + d0 * 2) = pk;
                            v4u pg; pg.x = cvtpk(ol[tt].x * eg, ol[tt].y * eg); pg.y = cvtpk(ol[tt].z * eg, ol[tt].w * eg); pg.z = cvtpk(oh[tt].x * eg, oh[tt].y * eg); pg.w = cvtpk(oh[tt].z * eg, oh[tt].w * eg);
                            { bf16* qrow = WSH(WS_GQD) + item4 * 8192 + t * 128 + (d0 & ~31); const int kl = d0 & 31;
                                v2u p0; p0.x = pg.x; p0.y = pg.y; v2u p1; p1.x = pg.z; p1.y = pg.w; *(v2u*)(qrow + kperm4(kl)) = p0; *(v2u*)(qrow + kperm4(kl + 4)) = p1; } }
                    } else if (which == 1) {
                        float fb[8], fl[8];
#pragma unroll
                        for (int tt = 0; tt < 8; ++tt) { const int t = tb + tt; fb[tt] = sbeta[t] * seg[t]; fl[tt] = sel[t];
                            v4u pk; pk.x = cvtpk(ol[tt].x, ol[tt].y); pk.y = cvtpk(ol[tt].z, ol[tt].w); pk.z = cvtpk(oh[tt].x, oh[tt].y); pk.w = cvtpk(oh[tt].z, oh[tt].w);
                            *(LAS v4u*)(kb + t * 272 + d0 * 2) = pk; }
#pragma unroll
                        for (int c = 0; c < 8; ++c) {
#define KV_(tt) ((c) < 4 ? ol[tt][(c) & 3] : oh[tt][(c) & 3])
                            v4u pe; pe.x = cvtpk(KV_(0) * fb[0], KV_(1) * fb[1]); pe.y = cvtpk(KV_(2) * fb[2], KV_(3) * fb[3]); pe.z = cvtpk(KV_(4) * fb[4], KV_(5) * fb[5]); pe.w = cvtpk(KV_(6) * fb[6], KV_(7) * fb[7]);
                            *(LAS v4u*)(kbeT + (d0 + c) * 144 + ((tr ^ (cgp & 7)) * 16)) = pe;
                            v4u pt; pt.x = cvtpk(KV_(0) * fl[0], KV_(1) * fl[1]); pt.y = cvtpk(KV_(2) * fl[2], KV_(3) * fl[3]); pt.z = cvtpk(KV_(4) * fl[4], KV_(5) * fl[5]); pt.w = cvtpk(KV_(6) * fl[6], KV_(7) * fl[7]);
                            { bf16* krow = WSH(WS_GKT) + item4 * 8192 + (d0 + c) * 64 + (tb & ~31); const int kl = tb & 31;
                                v2u p0; p0.x = pt.x; p0.y = pt.y; v2u p1; p1.x = pt.z; p1.y = pt.w; *(v2u*)(krow + kperm4(kl)) = p0; *(v2u*)(krow + kperm4(kl + 4)) = p1; } }
                    } else {
                        float fb[8];
#pragma unroll
                        for (int tt = 0; tt < 8; ++tt) fb[tt] = sbeta[tb + tt];
#pragma unroll
                        for (int c = 0; c < 8; ++c) {
                            v4u pe; pe.x = cvtpk(KV_(0) * fb[0], KV_(1) * fb[1]); pe.y = cvtpk(KV_(2) * fb[2], KV_(3) * fb[3]); pe.z = cvtpk(KV_(4) * fb[4], KV_(5) * fb[5]); pe.w = cvtpk(KV_(6) * fb[6], KV_(7) * fb[7]);
                            *(LAS v4u*)(vT + (d0 + c) * 144 + ((tr ^ (cgp & 7)) * 16)) = pe; }
#undef KV_
                    }
                }
                WG_BAR();
                }
#if defined(PROBE_G) && PROBE_G == 2
                for (int prb_ = 0; prb_ < 2; ++prb_) {
#else
                {
#endif
                {
                    const int it = wave >> 1;
                    bf16x8 Ak[4], Aq[4], Bk[2][4];
#pragma unroll
                    for (int ks = 0; ks < 4; ++ks) { Ak[ks] = ld128(kb + (16 * it + m) * 272 + (32 * ks + 8 * q) * 2); Aq[ks] = ld128(qb + (16 * it + m) * 272 + (32 * ks + 8 * q) * 2);
                        Bk[0][ks] = ld128(kb + (16 * ((wave & 1) * 2) + m) * 272 + (32 * ks + 8 * q) * 2); Bk[1][ks] = ld128(kb + (16 * ((wave & 1) * 2 + 1) + m) * 272 + (32 * ks + 8 * q) * 2); }
#pragma unroll
                    for (int jj = 0; jj < 2; ++jj) { const int jt = (wave & 1) * 2 + jj;
                        f32x4 kk = (f32x4){0.f, 0.f, 0.f, 0.f}, qk = (f32x4){0.f, 0.f, 0.f, 0.f};
                        if (jt <= it) {
#pragma unroll
                            for (int ks = 0; ks < 4; ++ks) { kk = MFMA16(Ak[ks], Bk[jj][ks], kk); qk = MFMA16(Aq[ks], Bk[jj][ks], qk); } }
                        const int j = 16 * jt + m; const float gj = sgc[j];
#pragma unroll
                        for (int r = 0; r < 4; ++r) { const int i = 16 * it + 4 * q + r;
                            const float dec = (j <= i) ? exp_fast(sgc[i] - gj) : 0.f;
                            Ls[i * 68 + j] = (j < i) ? sbeta[i] * kk[r] * dec : 0.f;
                            *(LAS unsigned short*)(atts + i * 144 + kperm(j) * 2) = (unsigned short)f2bf((j <= i) ? qk[r] * dec : 0.f); } }
                }
                WG_BAR();
                }
#if defined(PROBE_G) && PROBE_G == 3
                for (int prb_ = 0; prb_ < 2; ++prb_) {
#else
                {
#endif
                if (tid < 64) { const int bk = tid >> 4, c = tid & 15; float x[16];
                    const LAS float* lb = Ls + (16 * bk) * 68 + 16 * bk;
#pragma unroll
                    for (int r = 0; r < 16; ++r) { float acc = (r == c) ? 1.f : 0.f;
#pragma unroll
                        for (int m4 = 0; m4 < (r + 3) / 4; ++m4) { const f32x4 lv = *(const LAS f32x4*)(lb + r * 68 + 4 * m4);
                            if (4 * m4 + 0 < r) acc -= lv.x * x[4 * m4 + 0]; if (4 * m4 + 1 < r) acc -= lv.y * x[4 * m4 + 1]; if (4 * m4 + 2 < r) acc -= lv.z * x[4 * m4 + 2]; if (4 * m4 + 3 < r) acc -= lv.w * x[4 * m4 + 3]; }
                        x[r] = acc; Ts[(16 * bk + r) * 68 + 16 * bk + c] = acc; } }
                WG_BAR();
#pragma unroll 1
                for (int dl = 1; dl < 4; ++dl) {
                    const int nout = (4 - dl) * 256;
                    for (int idx = tid; idx < nout; idx += NWAVES * 64) { const int blk = idx >> 8, r = (idx >> 4) & 15, c = idx & 15, i = blk + dl, j = blk; float acc = 0.f;
                        const LAS float* lrow = Ls + (16 * i + r) * 68 + 16 * j; const LAS float* tcol = Ts + (16 * j) * 68 + 16 * j + c;
                        for (int kk = 0; kk < dl; ++kk) {
#pragma unroll
                            for (int mm = 0; mm < 16; mm += 4) { const f32x4 lv = *(const LAS f32x4*)(lrow + 16 * kk + mm); const LAS float* tc = tcol + (16 * kk + mm) * 68;
                                acc += lv.x * tc[0] + lv.y * tc[68] + lv.z * tc[136] + lv.w * tc[204]; } }
                        Xs[idx] = acc; }
                    WG_BAR();
                    for (int idx = tid; idx < nout; idx += NWAVES * 64) { const int blk = idx >> 8, r = (idx >> 4) & 15, c = idx & 15, i = blk + dl, j = blk; float acc = 0.f;
                        const LAS float* trow = Ts + (16 * i + r) * 68 + 16 * i; const LAS float* xc = Xs + blk * 256 + c;
#pragma unroll
                        for (int mm = 0; mm < 16; mm += 4) { const f32x4 tv = *(const LAS f32x4*)(trow + mm); acc -= tv.x * xc[(mm + 0) * 16] + tv.y * xc[(mm + 1) * 16] + tv.z * xc[(mm + 2) * 16] + tv.w * xc[(mm + 3) * 16]; }
                        Ts[(16 * i + r) * 68 + 16 * j + c] = acc; }
                    WG_BAR();
                }
#pragma unroll
                for (int e = 0; e < 8; ++e) { const int idx = tid + 512 * e, i = idx >> 6, j = idx & 63;
                    *(LAS unsigned short*)(Tb + i * 144 + j * 2) = (unsigned short)(((j >> 4) <= (i >> 4)) ? f2bf(Ts[i * 68 + j]) : 0u); }
                WG_BAR();
                }
#if defined(PROBE_G) && PROBE_G == 4
                for (int prb_ = 0; prb_ < 2; ++prb_) {
#else
                {
#endif
                {
                    const int nt = wave;
#pragma unroll
                    for (int mt = 0; mt < 4; ++mt) { f32x4 ua = (f32x4){0.f, 0.f, 0.f, 0.f}, wa = (f32x4){0.f, 0.f, 0.f, 0.f};
#pragma unroll
                        for (int ks = 0; ks < 2; ++ks) if (32 * ks <= 16 * mt + 15) { const bf16x8 A = ld128(Tb + (16 * mt + m) * 144 + (32 * ks + 8 * q) * 2);
                            const int swz = (((4 * ks + q) ^ ((2 * nt + (m >> 3)) & 7)) * 16);
                            ua = MFMA16(A, ld128(vT + (16 * nt + m) * 144 + swz), ua); wa = MFMA16(A, ld128(kbeT + (16 * nt + m) * 144 + swz), wa); }
unsigned uts[4];
#pragma unroll
                        for (int r = 0; r < 4; ++r) { const int t = 16 * mt + 4 * q + r, d = 16 * nt + m;
                            uts[r] = f2bf(ua[r]); *(LAS unsigned short*)(kb + t * 272 + kperm(d) * 2) = (unsigned short)f2bf(-wa[r]); }
                        { v2u pu; pu.x = uts[0] | (uts[1] << 16); pu.y = uts[2] | (uts[3] << 16); *(LAS v2u*)(F.lds + PG_LS + (16 * nt + m) * 144 + (16 * mt + 4 * q) * 2) = pu; } }
                }
                WG_BAR();
                }
#if defined(PROBE_G) && PROBE_G == 5
                for (int prb_ = 0; prb_ < 2; ++prb_) {
#else
                {
#endif
#pragma unroll
                for (int e = 0; e < 2; ++e) { const int p = tid + 512 * e, row = p >> 4, c16 = p & 15;
                    *(v4u*)((unsigned char*)(WSH(WS_MIX + 16 * MiB) + item4 * 8192) + row * 256 + c16 * 16) = *(const LAS v4u*)(kb + row * 272 + c16 * 16);
                    const int ur = p >> 3, uc = p & 7;
                    *(v4u*)((unsigned char*)(WSH(WS_MIX) + item4 * 8192) + ur * 128 + uc * 16) = *(const LAS v4u*)(F.lds + PG_LS + ur * 144 + uc * 16); }
                { const int row = tid >> 3, c16 = tid & 7;
                    *(v4u*)((unsigned char*)(WSH(WS_GATT) + item4 * 4096) + row * 128 + c16 * 16) = *(const LAS v4u*)(atts + row * 144 + c16 * 16); }
                if (tid == 0) WSF(WS_GL)[item4] = seg[63];
                WG_BAR();
                }
            }
        }
    }
}

#undef PREP_IDS
constexpr int SC_W = 0, SC_QD = 18432, SC_KT = 36864, SC_AT = 57344, SC_U = 67584, SC_STAGE = 76800;
static_assert(2 * SC_STAGE <= RING_BYTES, "scan stages fit the ring");
#define SBAR_() __builtin_amdgcn_sched_barrier(0)
constexpr int NSEG = 8, SEGC = NCH / NSEG;
constexpr size_t WS_PSI = 344 * MiB;
constexpr size_t WS_PHI = 352 * MiB;
constexpr size_t WS_SST = 356 * MiB;
static_assert(WS_SST + 8 * MiB <= WS_END, "two-level scan scratch");

#define SC_ADDR() \
        const unsigned char* gW = (const unsigned char*)(WSH(WS_MIX + 16 * MiB) + it0 * 8192); \
        const unsigned char* gQD = (const unsigned char*)(WSH(WS_GQD) + it0 * 8192); \
        const unsigned char* gKT = (const unsigned char*)(WSH(WS_GKT) + it0 * 8192); \
        const unsigned char* gAT = (const unsigned char*)(WSH(WS_GATT) + it0 * 4096); \
        const unsigned char* gU = (const unsigned char*)(WSH(WS_MIX) + it0 * 8192) + dvbase * 128;
#define SC_LOAD(rg, n_) do { const size_t cb = (size_t)(n_) * 16384, ca = (size_t)(n_) * 8192; \
            _Pragma("unroll") for (int i = 0; i < 4; ++i) { rg[i] = *(const v4u*)(gW + cb + gofW + i * 4096); if (FULL) rg[4 + i] = *(const v4u*)(gQD + cb + gofW + i * 4096); \
                rg[8 + i] = *(const v4u*)(gKT + cb + gofK + i * 4096); } \
            _Pragma("unroll") for (int i = 0; i < 2; ++i) { if (FULL) rg[12 + i] = *(const v4u*)(gAT + ca + gofK + i * 4096); rg[14 + i] = *(const v4u*)(gU + cb + gofK + i * 4096); } } while (0)
#define SC_WRITE(rg, buf_) do { LAS unsigned char* sb_ = F.lds + (buf_) * SC_STAGE; \
            _Pragma("unroll") for (int i = 0; i < 4; ++i) { *(LAS v4u*)(sb_ + SC_W + lofW + i * (16 * 288)) = rg[i]; if (FULL) *(LAS v4u*)(sb_ + SC_QD + lofW + i * (16 * 288)) = rg[4 + i]; \
                *(LAS v4u*)(sb_ + SC_KT + lofK + i * (32 * 160)) = rg[8 + i]; } \
            _Pragma("unroll") for (int i = 0; i < 2; ++i) { if (FULL) *(LAS v4u*)(sb_ + SC_AT + lofK + i * (32 * 160)) = rg[12 + i]; *(LAS v4u*)(sb_ + SC_U + lofU + i * (32 * 144)) = rg[14 + i]; } } while (0)
#define SC_LOADER_LOOP() do { \
            int lt_ = F.tid & 255; asm volatile("" : "+v"(lt_)); \
            const int gofW = (lt_ >> 4) * 256 + (lt_ & 15) * 16, gofK = (lt_ >> 3) * 128 + (lt_ & 7) * 16; \
            const int lofW = (lt_ >> 4) * 288 + (lt_ & 15) * 16, lofK = (lt_ >> 3) * 160 + (lt_ & 7) * 16, lofU = (lt_ >> 3) * 144 + (lt_ & 7) * 16; \
            const int nlast = n0 + SEGC - 1; \
            v4u ra[16], rb[16]; \
            SC_LOAD(ra, n0); SC_WRITE(ra, 0); SC_LOAD(ra, n0 + 1); SC_LOAD(rb, n0 + 2); \
            __syncthreads(); \
            _Pragma("unroll 1") for (int j = 0; j < SEGC; j += 2) { \
                  \
                  \
                SC_WRITE(ra, 1); \
                { const int nn = n0 + j + 3 < nlast ? n0 + j + 3 : nlast; SC_LOAD(ra, nn); } \
                WG_BAR(); \
                SC_WRITE(rb, 0); \
                { const int nn = n0 + j + 4 < nlast ? n0 + j + 4 : nlast; SC_LOAD(rb, nn); } \
                WG_BAR(); \
            } } while (0)

DI void p_scan1(Frame& F, int l) {
    constexpr bool FULL = false;
    const int wave = F.wave;
    { const int lane = F.lane;
        for (int p = blockIdx.x * NWAVES + wave; p < BATCH * LRUW; p += gridDim.x * NWAVES) { const int b = p / LRUW, c = p % LRUW;
            float A = WSF(WS_AGG)[((size_t)(b * NCH + lane)) * LRUW + c], B = WSF(WS_AGG)[(size_t)BATCH * NCH * LRUW + ((size_t)(b * NCH + lane)) * LRUW + c];
#pragma unroll
            for (int off = 1; off < 64; off <<= 1) { const float Ap = shfl_up_(lane, A, off), Bp = shfl_up_(lane, B, off); if (lane >= off) { B = A * Bp + B; A = A * Ap; } }
            if (lane < 63) WSF(WS_CARRY)[((size_t)(b * NCH + lane + 1)) * LRUW + c] = B; else WSF(WS_CARRY)[((size_t)(b * NCH)) * LRUW + c] = 0.f; } }
    const bool is_loader = wave >= 4;
    const int wv = wave & 3;
    for (int job = F.vcu; job < BATCH * GH * NSEG * 2; job += F.G) {
        const int bh = job >> 4, seg = (job >> 1) & (NSEG - 1), dvbase = (job & 1) * 64, n0 = seg * SEGC;
        const size_t it0 = (size_t)bh * NCH;
        SC_ADDR()
        (void)gQD; (void)gAT;
        if (seg == NSEG - 1) { __syncthreads(); continue; }
        if (is_loader) { SC_LOADER_LOOP(); }
        else {
            int tc_ = F.tid; asm volatile("" : "+v"(tc_)); const int lane = tc_ & 63, m = lane & 15, q = lane >> 4;
            const int col = dvbase + 16 * wv + m;
            f32x4 Sacc[2][8];
#pragma unroll
            for (int dt = 0; dt < 8; ++dt) { Sacc[0][dt] = (f32x4){0.f, 0.f, 0.f, 0.f};
#pragma unroll
                for (int r = 0; r < 4; ++r) Sacc[1][dt][r] = (16 * dt + 4 * q + r == col) ? 1.f : 0.f; }
            const float glv = WSF(WS_GL)[it0 + lane];
            __syncthreads();
#pragma unroll 1
            for (int j = 0; j < SEGC; ++j) {
                const LAS unsigned char* B = F.lds + (j & 1) * SC_STAGE;
                bf16x8 fa[4], fb[4], Sb[2][4], vnb[2][2];
                f32x4 vn[2][4];
                v2u ut[4];
#pragma unroll
                for (int mt = 0; mt < 4; ++mt) ut[mt] = *(const LAS v2u*)(B + SC_U + (16 * wv + m) * 144 + (16 * mt + 4 * q) * 2);
#define LDW4(dst, mt_) do { _Pragma("unroll") for (int kb = 0; kb < 4; ++kb) dst[kb] = ld128(B + SC_W + (16 * (mt_) + m) * 288 + (32 * kb + 8 * q) * 2); } while (0)
#define MMW2(src, mt_) do { _Pragma("unroll") for (int kb = 0; kb < 4; ++kb) { vn[0][mt_] = MFMA16(src[kb], Sb[0][kb], vn[0][mt_]); vn[1][mt_] = MFMA16(src[kb], Sb[1][kb], vn[1][mt_]); } } while (0)
#define LDK4(dst, dt_) do { dst[0] = ld128(B + SC_KT + (16 * (dt_) + m) * 160 + (8 * q) * 2); dst[1] = ld128(B + SC_KT + (16 * (dt_) + m) * 160 + (32 + 8 * q) * 2); \
                            dst[2] = ld128(B + SC_KT + (16 * ((dt_) + 1) + m) * 160 + (8 * q) * 2); dst[3] = ld128(B + SC_KT + (16 * ((dt_) + 1) + m) * 160 + (32 + 8 * q) * 2); } while (0)
#define MMK2(src, dt_) do { _Pragma("unroll") for (int e = 0; e < 2; ++e) { Sacc[e][dt_] = MFMA16(src[0], vnb[e][0], Sacc[e][dt_]); Sacc[e][dt_] = MFMA16(src[1], vnb[e][1], Sacc[e][dt_]); \
                            Sacc[e][(dt_) + 1] = MFMA16(src[2], vnb[e][0], Sacc[e][(dt_) + 1]); Sacc[e][(dt_) + 1] = MFMA16(src[3], vnb[e][1], Sacc[e][(dt_) + 1]); } } while (0)
                LDW4(fa, 0); SBAR_();
#pragma unroll
                for (int e = 0; e < 2; ++e)
#pragma unroll
                    for (int kb = 0; kb < 4; ++kb) Sb[e][kb] = pack8(Sacc[e][2 * kb], Sacc[e][2 * kb + 1]);
#pragma unroll
                for (int mt = 0; mt < 4; ++mt) { vn[0][mt] = (f32x4){bflo(ut[mt].x), bfhi(ut[mt].x), bflo(ut[mt].y), bfhi(ut[mt].y)}; vn[1][mt] = (f32x4){0.f, 0.f, 0.f, 0.f}; }
                const float gl = __builtin_bit_cast(float, __builtin_amdgcn_readlane(__builtin_bit_cast(int, glv), n0 + j));
                SBAR_(); LDW4(fb, 1); SBAR_(); MMW2(fa, 0); SBAR_();
                LDW4(fa, 2); SBAR_(); MMW2(fb, 1); SBAR_();
                LDW4(fb, 3); SBAR_(); MMW2(fa, 2); SBAR_();
                LDK4(fa, 0); SBAR_(); MMW2(fb, 3); SBAR_();
#pragma unroll
                for (int e = 0; e < 2; ++e) { vnb[e][0] = pack8(vn[e][0], vn[e][1]); vnb[e][1] = pack8(vn[e][2], vn[e][3]);
#pragma unroll
                    for (int dt = 0; dt < 8; ++dt) Sacc[e][dt] = Sacc[e][dt] * gl; }
                SBAR_(); LDK4(fb, 2); SBAR_(); MMK2(fa, 0); SBAR_();
                LDK4(fa, 4); SBAR_(); MMK2(fb, 2); SBAR_();
                LDK4(fb, 6); SBAR_(); MMK2(fa, 4); SBAR_();
                MMK2(fb, 6); SBAR_();
                WG_BAR();
            }
#undef LDW4
#undef MMW2
#undef LDK4
#undef MMK2
            float* psi = WSF(WS_PSI) + ((size_t)(bh * NSEG + seg) * 128) * 128 + col;
            bf16* phi = WSH(WS_PHI) + ((size_t)(bh * NSEG + seg) * 128) * 128 + kperm(col);
#pragma unroll
            for (int dt = 0; dt < 8; ++dt)
#pragma unroll
                for (int r = 0; r < 4; ++r) { const int dk = 16 * dt + 4 * q + r; psi[(size_t)dk * 128] = Sacc[0][dt][r]; phi[(size_t)dk * 128] = (bf16)f2bf(Sacc[1][dt][r]); }
        }
        __syncthreads();
    }
}

DI void p_scan2(Frame& F, int l) {
    const int wave = F.wave;
    for (int bh = blockIdx.x; bh < BATCH * GH; bh += gridDim.x) {
        int tc_ = F.tid; asm volatile("" : "+v"(tc_)); const int tid = tc_, lane = tc_ & 63, m = lane & 15, q = lane >> 4;
        const int col = 16 * wave + m;
        const int gof = (tid >> 4) * 256 + (tid & 15) * 16, lof = (tid >> 4) * 288 + (tid & 15) * 16;
        const unsigned char* phi0 = (const unsigned char*)(WSH(WS_PHI) + ((size_t)(bh * NSEG) * 128) * 128);
        const float* psi0 = WSF(WS_PSI) + ((size_t)(bh * NSEG) * 128) * 128 + col;
        float* sst0 = WSF(WS_SST) + ((size_t)(bh * NSEG) * 128) * 128 + col;
        f32x4 S[8], Ps[8]; v4u pr[4];
#pragma unroll
        for (int dt = 0; dt < 8; ++dt) { S[dt] = (f32x4){0.f, 0.f, 0.f, 0.f};
#pragma unroll
            for (int r = 0; r < 4; ++r) Ps[dt][r] = psi0[(size_t)(16 * dt + 4 * q + r) * 128]; }
#pragma unroll
        for (int i = 0; i < 4; ++i) pr[i] = *(const v4u*)(phi0 + gof + i * 8192);
#pragma unroll
        for (int i = 0; i < 4; ++i) *(LAS v4u*)(F.lds + lof + i * (32 * 288)) = pr[i];
        __syncthreads();
#pragma unroll 1
        for (int seg = 0; seg + 1 < NSEG; ++seg) {
            if (seg > 0) {
#pragma unroll
                for (int dt = 0; dt < 8; ++dt)
#pragma unroll
                    for (int r = 0; r < 4; ++r) sst0[((size_t)seg * 128 + 16 * dt + 4 * q + r) * 128] = S[dt][r]; }
            const int sn = seg + 2 < NSEG ? seg + 1 : seg;
#pragma unroll
            for (int i = 0; i < 4; ++i) pr[i] = *(const v4u*)(phi0 + (size_t)sn * 32768 + gof + i * 8192);
            f32x4 Pn[8];
#pragma unroll
            for (int dt = 0; dt < 8; ++dt)
#pragma unroll
                for (int r = 0; r < 4; ++r) Pn[dt][r] = psi0[((size_t)sn * 128 + 16 * dt + 4 * q + r) * 128];
            const LAS unsigned char* B = F.lds + (seg & 1) * 36864;
            bf16x8 Sb[4];
#pragma unroll
            for (int kb = 0; kb < 4; ++kb) Sb[kb] = pack8(S[2 * kb], S[2 * kb + 1]);
#pragma unroll
            for (int dt = 0; dt < 8; ++dt) { f32x4 acc = Ps[dt];
#pragma unroll
                for (int kb = 0; kb < 4; ++kb) acc = MFMA16(ld128(B + (16 * dt + m) * 288 + (32 * kb + 8 * q) * 2), Sb[kb], acc);
                S[dt] = acc; }
#pragma unroll
            for (int dt = 0; dt < 8; ++dt) Ps[dt] = Pn[dt];
#pragma unroll
            for (int i = 0; i < 4; ++i) *(LAS v4u*)(F.lds + ((seg + 1) & 1) * 36864 + lof + i * (32 * 288)) = pr[i];
            __syncthreads();
        }
#pragma unroll
        for (int dt = 0; dt < 8; ++dt)
#pragma unroll
            for (int r = 0; r < 4; ++r) sst0[((size_t)(NSEG - 1) * 128 + 16 * dt + 4 * q + r) * 128] = S[dt][r];
        __syncthreads();
    }
}

DI void p_scan3(Frame& F, int l) {
    constexpr bool FULL = true;
    const int wave = F.wave;
    const bool is_loader = wave >= 4;
    const int wv = wave & 3;
    for (int job = F.vcu; job < BATCH * GH * NSEG * 2; job += F.G) {
        const int bh = job >> 4, seg = (job >> 1) & (NSEG - 1), dvbase = (job & 1) * 64, n0 = seg * SEGC, b = bh >> 2, h = bh & 3;
        const size_t it0 = (size_t)bh * NCH;
        SC_ADDR()
        if (is_loader) { SC_LOADER_LOOP(); }
        else {
            int tc_ = F.tid; asm volatile("" : "+v"(tc_)); const int lane = tc_ & 63, m = lane & 15, q = lane >> 4;
            f32x4 Sacc[8];
            if (seg == 0) {
#pragma unroll
                for (int dt = 0; dt < 8; ++dt) Sacc[dt] = (f32x4){0.f, 0.f, 0.f, 0.f};
            } else { const float* sst = WSF(WS_SST) + ((size_t)(bh * NSEG + seg) * 128) * 128 + dvbase + 16 * wv + m;
#pragma unroll
                for (int dt = 0; dt < 8; ++dt)
#pragma unroll
                    for (int r = 0; r < 4; ++r) Sacc[dt][r] = sst[(size_t)(16 * dt + 4 * q + r) * 128]; }
            const float glv = WSF(WS_GL)[it0 + lane];
            __syncthreads();
#define FR_W(dst, mt_) do { _Pragma("unroll") for (int kb = 0; kb < 4; ++kb) { dst[kb] = ld128(B + SC_W + (16 * (mt_) + m) * 288 + (32 * kb + 8 * q) * 2); dst[4 + kb] = ld128(B + SC_QD + (16 * (mt_) + m) * 288 + (32 * kb + 8 * q) * 2); } } while (0)
#define MM_W(src, mt_) do { _Pragma("unroll") for (int kb = 0; kb < 4; ++kb) { vn[mt_] = MFMA16(src[kb], Sb[kb], vn[mt_]); o[mt_] = MFMA16(src[4 + kb], Sb[kb], o[mt_]); } } while (0)
#define FR_KT(dst, hf_) do { _Pragma("unroll") for (int i = 0; i < 8; ++i) dst[i] = ld128(B + SC_KT + (16 * (4 * (hf_) + (i >> 1)) + m) * 160 + (32 * (i & 1) + 8 * q) * 2); } while (0)
#define MM_KT(src, hf_) do { _Pragma("unroll") for (int i = 0; i < 8; ++i) Sacc[4 * (hf_) + (i >> 1)] = MFMA16(src[i], vnb[i & 1], Sacc[4 * (hf_) + (i >> 1)]); } while (0)
#pragma unroll 1
            for (int j = 0; j < SEGC; ++j) {
                const int n = n0 + j;
                const LAS unsigned char* B = F.lds + (j & 1) * SC_STAGE;
                bf16x8 fa[8], fb[8], Sb[4], vnb[2];
                f32x4 vn[4], o[4];
                v2u ut[4];
#pragma unroll
                for (int mt = 0; mt < 4; ++mt) ut[mt] = *(const LAS v2u*)(B + SC_U + (16 * wv + m) * 144 + (16 * mt + 4 * q) * 2);
                FR_W(fa, 0); SBAR_();
#pragma unroll
                for (int kb = 0; kb < 4; ++kb) Sb[kb] = pack8(Sacc[2 * kb], Sacc[2 * kb + 1]);
#pragma unroll
                for (int mt = 0; mt < 4; ++mt) { o[mt] = (f32x4){0.f, 0.f, 0.f, 0.f}; vn[mt] = (f32x4){bflo(ut[mt].x), bfhi(ut[mt].x), bflo(ut[mt].y), bfhi(ut[mt].y)}; }
                const float gl = __builtin_bit_cast(float, __builtin_amdgcn_readlane(__builtin_bit_cast(int, glv), n));
                SBAR_(); FR_W(fb, 1); SBAR_(); MM_W(fa, 0); SBAR_();
                FR_W(fa, 2); SBAR_(); MM_W(fb, 1); SBAR_();
                FR_W(fb, 3); SBAR_(); MM_W(fa, 2); SBAR_();
                fa[0] = ld128(B + SC_AT + (m) * 160 + (8 * q) * 2); fa[1] = ld128(B + SC_AT + (16 + m) * 160 + (8 * q) * 2);
                fa[2] = ld128(B + SC_AT + (32 + m) * 160 + (8 * q) * 2); fa[3] = ld128(B + SC_AT + (32 + m) * 160 + (32 + 8 * q) * 2);
                fa[4] = ld128(B + SC_AT + (48 + m) * 160 + (8 * q) * 2); fa[5] = ld128(B + SC_AT + (48 + m) * 160 + (32 + 8 * q) * 2);
                SBAR_(); MM_W(fb, 3); SBAR_();
                vnb[0] = pack8(vn[0], vn[1]); vnb[1] = pack8(vn[2], vn[3]);
#pragma unroll
                for (int dt = 0; dt < 8; ++dt) Sacc[dt] = Sacc[dt] * gl;
                SBAR_(); FR_KT(fb, 0); SBAR_();
                o[0] = MFMA16(fa[0], vnb[0], o[0]); o[1] = MFMA16(fa[1], vnb[0], o[1]); o[2] = MFMA16(fa[2], vnb[0], o[2]); o[3] = MFMA16(fa[4], vnb[0], o[3]);
                o[2] = MFMA16(fa[3], vnb[1], o[2]); o[3] = MFMA16(fa[5], vnb[1], o[3]);
                SBAR_(); FR_KT(fa, 1); SBAR_(); MM_KT(fb, 0); SBAR_();
                MM_KT(fa, 1); SBAR_();
                float* go = WSF(WS_GO) + (size_t)(b * SEQ + n * CH + 4 * q) * GDNW + h * HD + dvbase + 16 * wv + m;
#pragma unroll
                for (int mt = 0; mt < 4; ++mt)
#pragma unroll
                    for (int r = 0; r < 4; ++r) go[(size_t)(16 * mt + r) * GDNW] = o[mt][r];
                WG_BAR();
            }
#undef FR_W
#undef MM_W
#undef FR_KT
#undef MM_KT
        }
        __syncthreads();
    }
}
#undef SC_ADDR
#undef SC_LOAD
#undef SC_WRITE
#undef SC_LOADER_LOOP

DI float gelu_fast(float x) { const float u2 = 1.5957691216057308f * (x + 0.044715f * x * x * x); return x * rcp_(1.f + exp_fast(-u2)); }
struct PostRow { v4u hp[2]; v2u y2[2], z2[2]; f32x4 go[2], cr[2]; };
DI void post_load(Frame& F, PostRow& R, int m, int lane) {
    const int b = m >> 12, n = (m & (SEQ - 1)) >> 6;
#pragma unroll
    for (int j = 0; j < 2; ++j) { const int c = 4 * lane + 256 * j;
        R.hp[j] = *(const v4u*)((const unsigned*)(F.A->ws + WS_H) + (size_t)m * LRUW + c);
        R.cr[j] = *(const f32x4*)(WSF(WS_CARRY) + ((size_t)(b * NCH + n)) * LRUW + c);
        R.y2[j] = *(const v2u*)(WSH(WS_PROJ) + (size_t)m * NPROJ + O_LY + c);
        R.go[j] = *(const f32x4*)(WSF(WS_GO) + (size_t)m * GDNW + c);
        R.z2[j] = *(const v2u*)(WSH(WS_PROJ) + (size_t)m * NPROJ + O_Z + c); }
}
DI void p_post(Frame& F, int l) {
    const int gw = F.vcu * NWAVES + F.wave, NGW = F.G * NWAVES, lane = F.lane;
    PostRow R;
    if (gw < M) post_load(F, R, gw, lane);
    for (int m = gw; m < M; m += NGW) {
        PostRow Rn; const int mn = m + NGW;
        post_load(F, Rn, mn < M ? mn : m, lane);
        f32x4 val[2]; float ss = 0.f;
#pragma unroll
        for (int j = 0; j < 2; ++j) { const v4u hp = R.hp[j]; const v2u y2 = R.y2[j];
            const f32x4 hl = (f32x4){bflo(hp.x), bflo(hp.y), bflo(hp.z), bflo(hp.w)}, p = (f32x4){bfhi(hp.x), bfhi(hp.y), bfhi(hp.z), bfhi(hp.w)};
            const f32x4 hh = hl + p * R.cr[j];
            val[j] = (f32x4){hh.x * gelu_fast(bflo(y2.x)), hh.y * gelu_fast(bfhi(y2.x)), hh.z * gelu_fast(bflo(y2.y)), hh.w * gelu_fast(bfhi(y2.y))};
            ss += (val[j].x * val[j].x + val[j].y * val[j].y) + (val[j].z * val[j].z + val[j].w * val[j].w); }
        ss = wave_sum_(lane, ss);
        const float rl = 1.0f / sqrtf(ss * (1.0f / LRUW) + EPS);
#pragma unroll
        for (int j = 0; j < 2; ++j) { const int c = 4 * lane + 256 * j; const f32x4 nw = *(const f32x4*)(LRU_NORM_W + (size_t)l * LRUW + c);
            const f32x4 o = val[j] * rl * nw; v2u w; w.x = pk2(o.x, o.y); w.y = pk2(o.z, o.w); *(v2u*)(WSH(WS_MIX) + (size_t)m * D + c) = w; }
#pragma unroll
        for (int j = 0; j < 2; ++j) { const int c = 4 * lane + 256 * j, d = c & (HD - 1);
            const f32x4 o = R.go[j]; const v2u z2 = R.z2[j];
            const float s2 = half_sum_(lane, (o.x * o.x + o.y * o.y) + (o.z * o.z + o.w * o.w));
            const float rg = 1.0f / sqrtf(s2 * (1.0f / HD) + EPS);
            const f32x4 nw = *(const f32x4*)(GDN_NORM_W + (size_t)l * HD + d);
            const f32x4 r = (f32x4){o.x * rg * nw.x * silu_fast(bflo(z2.x)), o.y * rg * nw.y * silu_fast(bfhi(z2.x)), o.z * rg * nw.z * silu_fast(bflo(z2.y)), o.w * rg * nw.w * silu_fast(bfhi(z2.y))};
            v2u w; w.x = pk2(r.x, r.y); w.y = pk2(r.z, r.w); *(v2u*)(WSH(WS_MIX) + (size_t)m * D + LRUW + c) = w; }
        R = Rn;
    }
}

typedef _Float16 h16x4 __attribute__((ext_vector_type(4)));
DI void final_row(Frame& F, const _Float16* xrow, float* orow, int lane) {
    f32x4 v[4]; float ss = 0.f;
#pragma unroll
    for (int j = 0; j < 4; ++j) { const h16x4 hv = *(const h16x4*)(xrow + 4 * lane + 256 * j); v[j] = (f32x4){(float)hv[0], (float)hv[1], (float)hv[2], (float)hv[3]};
        ss += (v[j].x * v[j].x + v[j].y * v[j].y) + (v[j].z * v[j].z + v[j].w * v[j].w); }
    ss = wave_sum_(lane, ss);
    const float rstd = 1.0f / sqrtf(ss * (1.0f / D) + EPS);
#pragma unroll
    for (int j = 0; j < 4; ++j) { const int col = 4 * lane + 256 * j; const f32x4 nw = *(const f32x4*)(FINAL_NORM_W + col); *(f32x4*)(orow + col) = v[j] * rstd * nw; }
}
DI void p_final_a(Frame& F) {
    const int gw = F.vcu * NWAVES + F.wave, NGW = F.G * NWAVES, lane = F.lane;
    const _Float16* x16 = (const _Float16*)((const unsigned char*)OUT_ + X16_OFF);
    for (int m = gw; m < M; m += NGW) {
        if (m < M / 2) final_row(F, x16 + (size_t)m * D, OUT_ + (size_t)m * D, lane);
        else { const v4u* src = (const v4u*)(x16 + (size_t)m * D); v4u* dst = (v4u*)((_Float16*)(F.A->ws + WS_XT) + (size_t)(m - M / 2) * D); dst[lane] = src[lane]; dst[lane + 64] = src[lane + 64]; }
    }
}
DI void p_final_b(Frame& F) {
    const int gw = F.vcu * NWAVES + F.wave, NGW = F.G * NWAVES, lane = F.lane;
    for (int m = M / 2 + gw; m < M; m += NGW) final_row(F, (const _Float16*)(F.A->ws + WS_XT) + (size_t)(m - M / 2) * D, OUT_ + (size_t)m * D, lane);
}

__device__ __forceinline__ void pg8::EpiMulti::operator()(const f32x4 (&acc)[2][2][4][2], const Unit& u, int wr, int wc, int fr, int fq) const {
    const __attribute__((address_space(4))) Args* ap = (const __attribute__((address_space(4))) Args*)__builtin_amdgcn_kernarg_segment_ptr(); asm volatile("" : "+s"(ap));
    unsigned char* ws = ap->ws;
    const int b = (u.pm * BM) / SEQ;
    if (mode == 0) { EpiBf16<0> e{(bf16_t*)(ws + WS_PROJ), NPROJ, nullptr, 0, 0, 1.f, nullptr}; e(acc, u, wr, wc, fr, fq); }
    else if (mode == 5) { EpiBf16<0> e{(bf16_t*)(ws + WS_PROJ), NPROJ, (const float*)(ws + WS_C1) + ((size_t)l * BATCH + b) * NPROJ, 0, 0, 1.f, (const float*)(ws + WS_RS1)}; e(acc, u, wr, wc, fr, fq); }
    else if (mode == 6) { EpiBf16<2> e{(bf16_t*)(ws + WS_ACT), FF, (const float*)(ws + WS_C2) + ((size_t)l * BATCH + b) * FF, 0, 0, 1.f, (const float*)(ws + WS_RS2)}; e(acc, u, wr, wc, fr, fq); }
    else if (mode == 3) { const float* modb = (const float*)(ws + WS_MOD) + ((size_t)l * BATCH + b) * NMODC; _Float16* x16 = (_Float16*)((unsigned char*)ap->out + X16_OFF);
        EpiResid2 r{ap->in[0], l == 0 ? nullptr : x16, x16, modb + 2 * D, ap->in[3] + (size_t)l * D, modb + 4 * D, (bf16_t*)(ws + WS_H), (float*)(ws + WS_RS2)}; r(acc, u, wr, wc, fr, fq); }
    else { const float* modb = (const float*)(ws + WS_MOD) + ((size_t)l * BATCH + b) * NMODC; const bool nx = l + 1 < DEPTH; _Float16* x16 = (_Float16*)((unsigned char*)ap->out + X16_OFF);
        EpiResid2 r{nullptr, x16, x16, modb + 5 * D, nx ? ap->in[2] + (size_t)(l + 1) * D : nullptr, modb + NMODC * BATCH + D, (bf16_t*)(ws + WS_A1), (float*)(ws + WS_RS1)}; r(acc, u, wr, wc, fr, fq); }
}

__global__ void __launch_bounds__(NWAVES * 64, 2) mk_fwd(Args args) {
    extern __shared__ __attribute__((aligned(16))) unsigned char lds[];
    Frame F;
    F.lds = (LAS unsigned char*)lds;
    F.MISC = (volatile LAS unsigned*)(F.lds + MISC_OFF);
    F.tid = threadIdx.x; F.lane = F.tid & 63; F.wave = __builtin_amdgcn_readfirstlane(F.tid >> 6);
    F.G = gridDim.x; { const int bx = blockIdx.x; F.vcu = (F.G % 8 == 0) ? (bx % 8) * (F.G / 8) + bx / 8 : bx; }
    F.A = (const __attribute__((address_space(4))) Args*)__builtin_amdgcn_kernarg_segment_ptr();
    F.ctl = (gu32*)(F.A->ws + WS_CTL);
    for (int u = F.tid; u < (LDS_BYTES - LDSCTL_OFF) / 4; u += NWAVES * 64) ((LAS unsigned*)(F.lds + LDSCTL_OFF))[u] = 0u;
    __syncthreads();
    XcdBarrier bar; bar.bar = (unsigned*)(F.ctl + CW_BAR); bar.x = 0; bar.st = nullptr;
    if (N_LAUNCHES == 1) bar = xcd_barrier_post((unsigned*)(F.ctl + CW_BAR), F.MISC + 8);

    const int lo = F.A->ph_lo, hi = F.A->ph_hi;
    int rep_done = 0;
#pragma unroll 1
    for (int s = lo; s < hi; ++s) {
        { const __attribute__((address_space(4))) Args* ap = (const __attribute__((address_space(4))) Args*)__builtin_amdgcn_kernarg_segment_ptr(); asm volatile("" : "+s"(ap)); F.A = ap; }
        { int t_ = threadIdx.x; asm volatile("" : "+v"(t_)); F.tid = t_; F.lane = t_ & 63; F.wave = __builtin_amdgcn_readfirstlane(t_ >> 6); }
        if (s == 0) { if (PH_MASK & 1) { p_mod(F); __syncthreads(); p0_weights(F); xcd_barrier(bar, F.tid == 0); p_cvec(F); __syncthreads(); p_normmod<true>(F, 0, X_IN, NORM_MIX_W, 0, D); } }
        else if (s == N_STEPS - 1) { if (PH_MASK & 2) { p_final_a(F); xcd_barrier(bar, F.tid == 0); p_final_b(F); } }
        else {
            const int l = (s - 1) / 9, i = (s - 1) % 9;
            if (i == 0 || i == 6) continue;
            bf16* wl = WSH(WS_W) + (size_t)l * LAYER_W;
            const float* modl = WSF(WS_MOD) + (size_t)l * BATCH * NMODC;
            if (!((PH_MASK >> (2 + i)) & 1)) {}
            else if (i == 0) { p_normmod<true>(F, l, l == 0 ? X_IN : OUT_, NORM_MIX_W, 0, D); }
            else if (i == 2) { p_prep(F, l); }
            else if (i == 3) {
                p_scan1(F, l); xcd_barrier(bar, F.tid == 0);
#if defined(SCAN_REP) && SCAN_REP == 1
                p_scan1(F, l); xcd_barrier(bar, F.tid == 0);
#endif
                p_scan2(F, l); xcd_barrier(bar, F.tid == 0);
#if defined(SCAN_REP) && SCAN_REP == 2
                p_scan2(F, l); xcd_barrier(bar, F.tid == 0);
#endif
                p_scan3(F, l);
#if defined(SCAN_REP) && SCAN_REP == 3
                xcd_barrier(bar, F.tid == 0); p_scan3(F, l);
#endif
            }
            else if (i == 4) { p_post(F, l); }
            else if (i == 6) { p_normmod<false>(F, l, OUT_, NORM_MLP_W, 3 * D, 4 * D); }
            else {
                pg8::Gemm g; pg8::EpiMulti E; E.l = l;
                if (i == 1) { g = pg8::Gemm{l == 0 ? WSH(WS_H) : WSH(WS_A1), wl, M, NPROJ, D}; E.PERM = true; E.mode = (l == 0 ? 0 : 5); }
                else if (i == 5) { g = pg8::Gemm{WSH(WS_MIX), wl + W_OUT_OFF, M, D, D}; E.PERM = true; E.mode = 3; }
                else if (i == 7) { g = pg8::Gemm{WSH(WS_H), wl + W_UP_OFF, M, FF, D}; E.PERM = true; E.mode = 6; }
                else { g = pg8::Gemm{WSH(WS_ACT), wl + W_DOWN_OFF, M, D, FF}; E.PERM = true; E.mode = 4; }
                pg8::StaticOrder S; S.init(g.M, g.N, F.G, (int)blockIdx.x);
                pg8::gemm_phase<pg8::EpiMulti, pg8::StaticOrder, PG8_ALIGN, PG8_SP2>(F.lds + RING_OFF, g, S, E);
            }
        }
        if (REP_MASK != 0 && ((s >= 1 && s < N_STEPS - 1 && ((REP_MASK >> ((s - 1) % 9)) & 1)) || (s == 0 && (REP_MASK & 0x10000))) && !rep_done) { rep_done = 1; --s; xcd_barrier(bar, F.tid == 0); continue; }
        rep_done = 0;
        if (s + 1 < hi) xcd_barrier(bar, F.tid == 0);
#ifdef PROBE_XBAR
        if (s >= 1 && s < N_STEPS - 1) { xcd_barrier(bar, F.tid == 0); xcd_barrier(bar, F.tid == 0); }
#endif
    }
}

extern "C" void kernel_launch(void* const* d_in, const int* in_sizes, int n_in, void* d_out, int out_size, void* d_ws, size_t ws_size, hipStream_t stream) {
    static int grid = 0;
    if (grid == 0) {
        if (n_in != 23 || in_sizes[0] != M * D || out_size != M * D || ws_size < WS_END) { fprintf(stderr, "kernel_launch: unexpected shapes (n_in %d, in0 %d, out %d, ws %zu); nothing launched\n", n_in, n_in > 0 ? in_sizes[0] : -1, out_size, ws_size); grid = -1; return; }
        int dev = 0, cus = 0;
        if (hipGetDevice(&dev) != hipSuccess || hipDeviceGetAttribute(&cus, hipDeviceAttributeMultiprocessorCount, dev) != hipSuccess) { grid = -1; return; }
        if (hipFuncSetAttribute((const void*)mk_fwd, hipFuncAttributeMaxDynamicSharedMemorySize, LDS_BYTES) != hipSuccess) { fprintf(stderr, "kernel_launch: hipFuncSetAttribute failed\n"); grid = -1; return; }
        (void)hipGetLastError();
        grid = cus;
    }
    if (grid < 0) return;
    if (hipMemsetAsync((char*)d_ws + WS_CTL, 0, CTL_ZERO_BYTES, stream) != hipSuccess) return;
    Args a{};
    for (int i = 0; i < 23; ++i) a.in[i] = (const float*)d_in[i];
    a.out = (float*)d_out; a.ws = (unsigned char*)d_ws;
    if (N_LAUNCHES == 1) { a.ph_lo = 0; a.ph_hi = N_STEPS; hipLaunchKernelGGL(mk_fwd, dim3(grid), dim3(NWAVES * 64), LDS_BYTES, stream, a); }
    else for (int s = 0; s < N_STEPS; ++s) { a.ph_lo = s; a.ph_hi = s + 1; hipLaunchKernelGGL(mk_fwd, dim3(grid), dim3(NWAVES * 64), LDS_BYTES, stream, a); }
}
```

```cpp
#include <hip/hip_runtime.h>
#include <cstdio>
#include <cstdint>
#include <cmath>
namespace pg8 {
#define PG8_LAS __attribute__((address_space(3)))
typedef unsigned short bf16_t;
typedef short bf16x8 __attribute__((ext_vector_type(8)));
typedef float f32x4 __attribute__((ext_vector_type(4)));
typedef unsigned u32x4 __attribute__((ext_vector_type(4)));
constexpr int BM = 256, BK = 64, HALF = 128, HTB = HALF * BK * 2  , STAGE_BYTES = 8 * HTB, NXCD = 8, WGM = 8;

__host__ __device__ __forceinline__ int lds_byte(int r, int c) { const int st = (r >> 4) * 2 + (c >> 5), rr = r & 15, cc = c & 31, ob = rr * 64 + cc * 2; return st * 1024 + (ob ^ (((ob >> 9) & 1) << 5)); }
__host__ __device__ __forceinline__ void stage_rc(int b, int& R, int& C) { const int st = b / 1024, sb = b % 1024, swz = sb ^ (((sb >> 9) & 1) << 5); R = (st >> 1) * 16 + swz / 64; C = (st & 1) * 32 + (swz % 64) / 2; }
__host__ __device__ __forceinline__ int perm32(int rho) { const int n = rho >> 4, i = rho & 15; return 8 * (i >> 2) + 4 * n + (i & 3); }

struct Unit { int pm, pn; };
struct Gemm { const bf16_t* A; const bf16_t* Bt; int M, N, K; };

struct StaticOrder {
    int nM, nN, nwg, G, c;
    __host__ __device__ void init(int M, int N, int G_, int c_) { nM = M / BM; nN = N / BM; nwg = nM * nN; G = G_; c = c_; }
    __host__ __device__ bool next(int i, Unit& u) const {
        const long L = (long)i * G + c; if (L >= nwg) return false;
        int wgid = (int)L; { const int q = nwg / NXCD, r = nwg % NXCD, xcd = wgid % NXCD, off = wgid / NXCD; wgid = (xcd < r ? xcd * (q + 1) : r * (q + 1) + (xcd - r) * q) + off; }
        const int nig = WGM * nN, gid = wgid / nig, fm = gid * WGM, gsz = (nM - fm) < WGM ? (nM - fm) : WGM;
        u.pm = fm + ((wgid % nig) % gsz); u.pn = (wgid % nig) / gsz; return true;
    }
    __device__ __forceinline__ void a_ready(const Unit&) const {}
    __device__ __forceinline__ void done(const Unit&) const {}
};

__device__ __forceinline__ unsigned cvt_pk_bf16(float lo, float hi) { unsigned r; asm volatile("v_cvt_pk_bf16_f32 %0, %1, %2" : "=v"(r) : "v"(lo), "v"(hi)); return r; }
typedef float f32x2 __attribute__((ext_vector_type(2)));
__device__ __forceinline__ f32x2 gelu_pk(f32x2 v) {
    const f32x2 av = __builtin_elementwise_abs(v), d = av * 0.2316418882f + 1.0f;
    f32x2 t; t.x = __builtin_amdgcn_rcpf(d.x); t.y = __builtin_amdgcn_rcpf(d.y);
    f32x2 q = t * 0.5307027145f + (-0.7265760135f); q = q * t + 0.7107068705f; q = q * t + (-0.142248368f); q = q * t + 0.127414796f; q = q * t;
    const f32x2 s = (v * v) * (-0.72134752044f);
    f32x2 e; e.x = __builtin_amdgcn_exp2f(s.x); e.y = __builtin_amdgcn_exp2f(s.y);
    const f32x2 m = v * (q * e), r = v - m;
    f32x2 o; o.x = v.x < 0.f ? m.x : r.x; o.y = v.y < 0.f ? m.y : r.y; return o;
}

template <int ACT  > struct EpiBf16 {
    static constexpr bool PERM = true, AFTER_DRAIN = false; static_assert(ACT == 0 || ACT == 1 || ACT == 2, "EpiBf16: ACT is 0 (none), 1 (gelu_pk) or 2 (squared relu)");
    bf16_t* O; int ldc; const float* bias; int split_cols; size_t split_stride; float scale0;
    const PG8_LAS float* rtab = nullptr;
    const float* rs = nullptr;
    __device__ __forceinline__ void operator()(const f32x4 (&acc)[2][2][4][2], const Unit& u, int wr, int wc, int fr, int fq) const {
        const int row0 = u.pm * BM + wr * 64 + fr; int colt = u.pn * BM; bf16_t* base = O;
        float sc = 1.f; if (split_cols) { const int t = colt / split_cols; base += (size_t)t * split_stride; colt -= t * split_cols; if (t == 0) sc = scale0; }
        const int col0 = colt + wc * 32 + 8 * fq, bcol0 = u.pn * BM + wc * 32 + 8 * fq;
        f32x4 bv[2][2];
#pragma unroll
        for (int bj = 0; bj < 2; ++bj)
#pragma unroll
            for (int n = 0; n < 2; ++n) bv[bj][n] = bias ? *(const f32x4*)(bias + bcol0 + bj * HALF + 4 * n) : (f32x4){0.f, 0.f, 0.f, 0.f};
#pragma unroll
        for (int ai = 0; ai < 2; ++ai)
#pragma unroll
            for (int m = 0; m < 4; ++m) { bf16_t* rowp = base + (size_t)(row0 + ai * HALF + m * 16) * ldc + col0;
                float rsc = 1.f;
                if (rtab) rsc = rtab[wr * 64 + fr + ai * HALF + m * 16];
                else if (rs) { const f32x4* rp = (const f32x4*)(rs + (size_t)(row0 + ai * HALF + m * 16) * 16); const f32x4 p0 = rp[0], p1 = rp[1], p2 = rp[2], p3 = rp[3];
                    const f32x4 t = (p0 + p1) + (p2 + p3); rsc = 1.0f / sqrtf(((t[0] + t[1]) + (t[2] + t[3])) * (1.0f / 1024.0f) + 1e-6f); }
#pragma unroll
                for (int bj = 0; bj < 2; ++bj) { f32x4 v0 = acc[ai][bj][m][0] * rsc + bv[bj][0], v1 = acc[ai][bj][m][1] * rsc + bv[bj][1];
                    if (ACT == 1) { f32x2 a = gelu_pk((f32x2){v0[0], v0[1]}), b = gelu_pk((f32x2){v0[2], v0[3]}), c = gelu_pk((f32x2){v1[0], v1[1]}), d = gelu_pk((f32x2){v1[2], v1[3]});
                        v0 = (f32x4){a.x, a.y, b.x, b.y}; v1 = (f32x4){c.x, c.y, d.x, d.y}; }
                    if (ACT == 2) { _Pragma("unroll") for (int q_ = 0; q_ < 4; ++q_) { const float a_ = fmaxf(v0[q_], 0.f), b_ = fmaxf(v1[q_], 0.f); v0[q_] = a_ * a_; v1[q_] = b_ * b_; } }
                    v0 = v0 * sc; v1 = v1 * sc; u32x4 w; w.x = cvt_pk_bf16(v0[0], v0[1]); w.y = cvt_pk_bf16(v0[2], v0[3]); w.z = cvt_pk_bf16(v1[0], v1[1]); w.w = cvt_pk_bf16(v1[2], v1[3]);
                    *(u32x4*)(rowp + bj * HALF) = w; } }
    }
};


struct EpiResid {
    static constexpr bool PERM = false, AFTER_DRAIN = false;
    const float* base; float* out; const float* gate; int ldc; int gate_stride; int rows_per_batch;
    __device__ __forceinline__ void operator()(const f32x4 (&acc)[2][2][4][2], const Unit& u, int wr, int wc, int fr, int fq) const {
        const int col0 = u.pn * BM + wc * 32 + 4 * fq;
        const float* gp = gate + (size_t)((u.pm * BM) / rows_per_batch) * gate_stride + col0;
        f32x4 gv[2][2];
#pragma unroll
        for (int bj = 0; bj < 2; ++bj)
#pragma unroll
            for (int n = 0; n < 2; ++n) gv[bj][n] = *(const f32x4*)(gp + bj * HALF + n * 16);
#pragma unroll
        for (int ai = 0; ai < 2; ++ai)
#pragma unroll
            for (int m = 0; m < 4; ++m) { const size_t off = (size_t)(u.pm * BM + ai * HALF + wr * 64 + m * 16 + fr) * ldc + col0;
#pragma unroll
                for (int bj = 0; bj < 2; ++bj)
#pragma unroll
                    for (int n = 0; n < 2; ++n) { const f32x4 bs = *(const f32x4*)(base + off + bj * HALF + n * 16);
                        *(f32x4*)(out + off + bj * HALF + n * 16) = bs + gv[bj][n] * acc[ai][bj][m][n]; } }
    }
};


typedef _Float16 f16x8 __attribute__((ext_vector_type(8)));
typedef _Float16 f16x4 __attribute__((ext_vector_type(4)));
struct EpiResid2 {
    static constexpr bool PERM = true, AFTER_DRAIN = false;
    const float* base32; const _Float16* base16; _Float16* out16; const float* gate;
    const float* nw; const float* sc;
    bf16_t* anext; float* rsum;
    __device__ __forceinline__ void operator()(const f32x4 (&acc)[2][2][4][2], const Unit& u, int wr, int wc, int fr, int fq) const {
        const int col0 = u.pn * BM + wc * 32 + 8 * fq, lane = fr + 16 * fq;
        f32x4 gv[2][2], ns[2][2];
#pragma unroll
        for (int bj = 0; bj < 2; ++bj)
#pragma unroll
            for (int n = 0; n < 2; ++n) { const int c = col0 + bj * HALF + 4 * n; gv[bj][n] = *(const f32x4*)(gate + c);
                ns[bj][n] = nw ? *(const f32x4*)(nw + c) * (*(const f32x4*)(sc + c) + 1.0f) : (f32x4){0.f, 0.f, 0.f, 0.f}; }
#pragma unroll
        for (int ai = 0; ai < 2; ++ai)
#pragma unroll
            for (int m = 0; m < 4; ++m) { const size_t off = (size_t)(u.pm * BM + ai * HALF + wr * 64 + m * 16 + fr) * 1024 + col0;
                f32x4 bs[2][2];
                if (base16) {
                    f16x8 hb[2];
#pragma unroll
                    for (int bj = 0; bj < 2; ++bj) hb[bj] = *(const f16x8*)(base16 + off + bj * HALF);
#pragma unroll
                    for (int bj = 0; bj < 2; ++bj) { bs[bj][0] = (f32x4){(float)hb[bj][0], (float)hb[bj][1], (float)hb[bj][2], (float)hb[bj][3]}; bs[bj][1] = (f32x4){(float)hb[bj][4], (float)hb[bj][5], (float)hb[bj][6], (float)hb[bj][7]}; }
                } else {
#pragma unroll
                    for (int bj = 0; bj < 2; ++bj)
#pragma unroll
                        for (int n = 0; n < 2; ++n) bs[bj][n] = *(const f32x4*)(base32 + off + bj * HALF + 4 * n);
                }
                float ssq = 0.f;
#pragma unroll
                for (int bj = 0; bj < 2; ++bj) { const f32x4 x0 = bs[bj][0] + gv[bj][0] * acc[ai][bj][m][0], x1 = bs[bj][1] + gv[bj][1] * acc[ai][bj][m][1];
                    f16x8 ho; ho[0] = (_Float16)x0[0]; ho[1] = (_Float16)x0[1]; ho[2] = (_Float16)x0[2]; ho[3] = (_Float16)x0[3]; ho[4] = (_Float16)x1[0]; ho[5] = (_Float16)x1[1]; ho[6] = (_Float16)x1[2]; ho[7] = (_Float16)x1[3];
                    *(f16x8*)(out16 + off + bj * HALF) = ho;
                    if (nw) { const f32x4 h0 = x0 * ns[bj][0], h1 = x1 * ns[bj][1]; u32x4 w; w.x = cvt_pk_bf16(h0[0], h0[1]); w.y = cvt_pk_bf16(h0[2], h0[3]); w.z = cvt_pk_bf16(h1[0], h1[1]); w.w = cvt_pk_bf16(h1[2], h1[3]);
                        *(u32x4*)(anext + off + bj * HALF) = w;
                        ssq += ((x0[0] * x0[0] + x0[1] * x0[1]) + (x0[2] * x0[2] + x0[3] * x0[3])) + ((x1[0] * x1[0] + x1[1] * x1[1]) + (x1[2] * x1[2] + x1[3] * x1[3])); } }
                if (nw) { ssq += __builtin_bit_cast(float, __builtin_amdgcn_ds_bpermute((lane ^ 16) << 2, __builtin_bit_cast(int, ssq)));
                    ssq += __builtin_bit_cast(float, __builtin_amdgcn_ds_bpermute((lane ^ 32) << 2, __builtin_bit_cast(int, ssq)));
                    if (fq == 0) rsum[(size_t)(u.pm * BM + ai * HALF + wr * 64 + m * 16 + fr) * 16 + u.pn * 4 + wc] = ssq; }
                if (m & 1) asm volatile("" ::: "memory"); }
    }
};

struct EpiMulti {
    static constexpr bool AFTER_DRAIN = false;
    bool PERM; int mode, l; const PG8_LAS float* rt;
    __device__ __forceinline__ void operator()(const f32x4 (&acc)[2][2][4][2], const Unit& u, int wr, int wc, int fr, int fq, int ui) const;
};

template <class Epi, class Sched, bool ALIGN_EPI = false, bool SP2 = false>
__device__ __forceinline__ void gemm_phase(PG8_LAS unsigned char* lds, const Gemm g, const Sched& S, const Epi& E) {
    int tid_l = threadIdx.x; asm volatile("" : "+v"(tid_l));
    const int tid = tid_l, wid = __builtin_amdgcn_readfirstlane(tid >> 6), lane = tid & 63, wr = wid >> 2, wc = wid & 3, fr = lane & 15, fq = lane >> 4;
    const int K = g.K, nt = K / BK;
    unsigned voffA[2], voffB[2];
#pragma unroll
    for (int i = 0; i < 2; ++i) { int R, C; stage_rc(tid * 16 + i * 8192, R, C); const int Rb = E.PERM ? ((R & ~31) + perm32(R & 31)) : R;
        voffA[i] = (unsigned)(R * K + C) * 2u; voffB[i] = (unsigned)(Rb * K + C) * 2u; }
    const size_t kstep = (size_t)(BK * 2);
    const size_t hstep = (size_t)HALF * K * 2;
    const size_t tstep = 2 * hstep;
    const unsigned ldsw = (unsigned)wid * 1024u;
    const int aoff = lds_byte(wr * 64 + fr, fq * 8), boff = lds_byte(wc * 32 + fr, fq * 8);
#define PG8_SA(b, h) (((b) * 2 + (h)) * HTB)
#define PG8_SB(b, h) ((4 + (b) * 2 + (h)) * HTB)
#define PG8_STAGE(bufoff, gbase, voff) do { _Pragma("unroll") for (int _i = 0; _i < 2; ++_i) \
        __builtin_amdgcn_global_load_lds((const unsigned*)((const char*)(gbase) + (voff)[_i]), (PG8_LAS unsigned*)(lds + (bufoff) + ldsw + _i * 8192), 16, 0, 0); } while (0)
#define PG8_LDA(dst, b, h) do { _Pragma("unroll") for (int m = 0; m < 4; ++m) _Pragma("unroll") for (int k = 0; k < 2; ++k) dst[m][k] = *(const PG8_LAS bf16x8*)(lds + PG8_SA(b, h) + aoff + m * 2048 + k * 1024); } while (0)
#define PG8_LDB(dst, b, h) do { _Pragma("unroll") for (int n = 0; n < 2; ++n) _Pragma("unroll") for (int k = 0; k < 2; ++k) dst[n][k] = *(const PG8_LAS bf16x8*)(lds + PG8_SB(b, h) + boff + n * 2048 + k * 1024); } while (0)
#define PG8_MMA(ai, bj, At, Bt) do { __builtin_amdgcn_s_setprio(1); _Pragma("unroll") for (int m = 0; m < 4; ++m) _Pragma("unroll") for (int n = 0; n < 2; ++n) _Pragma("unroll") for (int k = 0; k < 2; ++k) \
        acc[ai][bj][m][n] = __builtin_amdgcn_mfma_f32_16x16x32_bf16(Bt[n][k], At[m][k], acc[ai][bj][m][n], 0, 0, 0); __builtin_amdgcn_s_setprio(0); } while (0)
#define PG8_WAIT_V(n) asm volatile("s_waitcnt vmcnt(" #n ")" ::: "memory")
#define PG8_WAIT_L(n) asm volatile("s_waitcnt lgkmcnt(" #n ")" ::: "memory")
#define PG8_BAR __builtin_amdgcn_s_barrier()
#define PG8_SCHED __builtin_amdgcn_sched_barrier(0)
    Unit cur, nxt; int ui = 0;
    if (!S.next(0, cur)) return;
    f32x4 acc[2][2][4][2];
#pragma unroll
    for (int a = 0; a < 2; ++a)
#pragma unroll
        for (int b = 0; b < 2; ++b)
#pragma unroll
            for (int m = 0; m < 4; ++m)
#pragma unroll
                for (int n = 0; n < 2; ++n) acc[a][b][m][n] = (f32x4){0.f, 0.f, 0.f, 0.f};
    bf16x8 At[4][2], B0[2][2], B1[2][2];
    const char* cA = (const char*)g.A + (size_t)cur.pm * tstep; const char* cB = (const char*)g.Bt + (size_t)cur.pn * tstep;
    S.a_ready(cur);
    if constexpr (SP2) {
        PG8_STAGE(PG8_SB(0, 0), cB, voffB); PG8_STAGE(PG8_SB(0, 1), cB + hstep, voffB); PG8_STAGE(PG8_SA(0, 0), cA, voffA); PG8_STAGE(PG8_SA(0, 1), cA + hstep, voffA);
        if (wr == 1) PG8_BAR;
        PG8_WAIT_V(2); PG8_BAR;
        PG8_STAGE(PG8_SB(1, 0), cB + kstep, voffB); PG8_STAGE(PG8_SA(1, 0), cA + kstep, voffA); PG8_STAGE(PG8_SB(1, 1), cB + hstep + kstep, voffB);
        PG8_WAIT_V(6); PG8_BAR;
    } else {
        PG8_STAGE(PG8_SB(0, 0), cB, voffB); PG8_STAGE(PG8_SA(0, 0), cA, voffA); PG8_STAGE(PG8_SB(0, 1), cB + hstep, voffB); PG8_STAGE(PG8_SA(0, 1), cA + hstep, voffA);
        if (wr == 1) PG8_BAR;
        PG8_WAIT_V(4); PG8_BAR;
        PG8_STAGE(PG8_SB(1, 0), cB + kstep, voffB); PG8_STAGE(PG8_SA(1, 0), cA + kstep, voffA); PG8_STAGE(PG8_SB(1, 1), cB + hstep + kstep, voffB);
        PG8_WAIT_V(6); PG8_BAR;
    }
    for (;;) {
        const bool has_next = S.next(ui + 1, nxt);
        const char* nA = has_next ? (const char*)g.A + (size_t)nxt.pm * tstep : cA; const char* nB = has_next ? (const char*)g.Bt + (size_t)nxt.pn * tstep : cB;
        for (int t = 0; t < nt; t += 2) {
            const bool last = (t == nt - 2);
            const char* a1 = cA + (size_t)(t + 1) * kstep;
            const char* a2 = last ? nA : cA + (size_t)(t + 2) * kstep; const char* b2 = last ? nB : cB + (size_t)(t + 2) * kstep;
            const char* a3 = a2 + kstep; const char* b3 = b2 + kstep;
            if (last && has_next) S.a_ready(nxt);
            if constexpr (SP2) {
            PG8_LDB(B0, 0, 0); PG8_LDB(B1, 0, 1); PG8_SCHED; PG8_LDA(At, 0, 0); PG8_STAGE(PG8_SA(1, 1), a1 + hstep, voffA);
            PG8_WAIT_V(8); PG8_WAIT_L(0); PG8_BAR; PG8_MMA(0, 0, At, B0); PG8_MMA(0, 1, At, B1); PG8_BAR; PG8_SCHED;
            PG8_LDA(At, 0, 1); PG8_STAGE(PG8_SB(0, 0), b2, voffB); PG8_STAGE(PG8_SB(0, 1), b2 + hstep, voffB); PG8_STAGE(PG8_SA(0, 0), a2, voffA);
            PG8_WAIT_V(8); PG8_WAIT_L(0); PG8_BAR; PG8_MMA(1, 0, At, B0); PG8_MMA(1, 1, At, B1); PG8_BAR; PG8_SCHED;
            PG8_LDB(B0, 1, 0); PG8_LDB(B1, 1, 1); PG8_SCHED; PG8_LDA(At, 1, 0); PG8_STAGE(PG8_SA(0, 1), a2 + hstep, voffA);
            PG8_WAIT_V(8); PG8_WAIT_L(0); PG8_BAR; PG8_MMA(0, 0, At, B0); PG8_MMA(0, 1, At, B1); PG8_BAR; PG8_SCHED;
            PG8_LDA(At, 1, 1); PG8_STAGE(PG8_SB(1, 0), b3, voffB); PG8_STAGE(PG8_SB(1, 1), b3 + hstep, voffB); PG8_STAGE(PG8_SA(1, 0), a3, voffA);
            PG8_WAIT_V(8); PG8_WAIT_L(0); PG8_BAR; PG8_MMA(1, 0, At, B0); PG8_MMA(1, 1, At, B1); PG8_BAR; PG8_SCHED;
            } else {
            PG8_LDB(B0, 0, 0); PG8_SCHED; PG8_LDA(At, 0, 0); PG8_STAGE(PG8_SA(1, 1), a1 + hstep, voffA);
            PG8_WAIT_L(8); PG8_BAR; PG8_WAIT_L(0); PG8_MMA(0, 0, At, B0); PG8_BAR; PG8_SCHED;
            PG8_LDB(B1, 0, 1); PG8_STAGE(PG8_SB(0, 0), b2, voffB);
            PG8_BAR; PG8_WAIT_L(0); PG8_MMA(0, 1, At, B1); PG8_BAR;
            PG8_LDA(At, 0, 1); PG8_STAGE(PG8_SA(0, 0), a2, voffA);
            PG8_BAR; PG8_WAIT_L(0); PG8_MMA(1, 0, At, B0); PG8_BAR; PG8_SCHED;
            PG8_STAGE(PG8_SB(0, 1), b2 + hstep, voffB);
            PG8_WAIT_V(6); PG8_BAR; PG8_MMA(1, 1, At, B1); PG8_BAR;
            PG8_LDB(B0, 1, 0); PG8_SCHED; PG8_LDA(At, 1, 0); PG8_STAGE(PG8_SA(0, 1), a2 + hstep, voffA);
            PG8_WAIT_L(8); PG8_BAR; PG8_WAIT_L(0); PG8_MMA(0, 0, At, B0); PG8_BAR; PG8_SCHED;
            PG8_LDB(B1, 1, 1); PG8_STAGE(PG8_SB(1, 0), b3, voffB);
            PG8_BAR; PG8_WAIT_L(0); PG8_MMA(0, 1, At, B1); PG8_BAR;
            PG8_LDA(At, 1, 1); PG8_STAGE(PG8_SA(1, 0), a3, voffA);
            PG8_BAR; PG8_WAIT_L(0); PG8_MMA(1, 0, At, B0); PG8_BAR; PG8_SCHED;
            PG8_STAGE(PG8_SB(1, 1), b3 + hstep, voffB);
            PG8_WAIT_V(6); PG8_BAR; PG8_MMA(1, 1, At, B1); PG8_BAR;
            }
        }
        if constexpr (ALIGN_EPI) { if (wr == 0) PG8_BAR; }
        if constexpr (!Epi::AFTER_DRAIN) { E(acc, cur, wr, wc, fr, fq, ui); S.done(cur); }
        if (!has_next) break;
#pragma unroll
        for (int a = 0; a < 2; ++a)
#pragma unroll
            for (int b = 0; b < 2; ++b)
#pragma unroll
                for (int m = 0; m < 4; ++m)
#pragma unroll
                    for (int n = 0; n < 2; ++n) acc[a][b][m][n] = (f32x4){0.f, 0.f, 0.f, 0.f};
        cur = nxt; cA = nA; cB = nB; ++ui;
        if constexpr (ALIGN_EPI) { if (wr == 1) PG8_BAR; }
    }
    PG8_WAIT_V(0);
    if constexpr (!ALIGN_EPI) { if (wr == 0) PG8_BAR; }
    PG8_BAR;
    if constexpr (Epi::AFTER_DRAIN) { E.fused(acc, cur, wr, wc, fr, fq, lds, wid, lane); S.done(cur); }
#undef PG8_SA
#undef PG8_SB
#undef PG8_STAGE
#undef PG8_LDA
#undef PG8_LDB
#undef PG8_MMA
#undef PG8_WAIT_V
#undef PG8_WAIT_L
#undef PG8_BAR
#undef PG8_SCHED
}
}
#define GAS __attribute__((address_space(1)))
#define LAS __attribute__((address_space(3)))
typedef unsigned short bf16;
typedef unsigned v4u __attribute__((ext_vector_type(4)));
typedef float f32x4 __attribute__((ext_vector_type(4)));
typedef short bf16x8 __attribute__((ext_vector_type(8)));
typedef GAS unsigned gu32;
typedef GAS unsigned long long gu64;
#define RLX_AGENT __ATOMIC_RELAXED, __HIP_MEMORY_SCOPE_AGENT
#define LDS_WAIT() asm volatile("s_waitcnt lgkmcnt(0)" ::: "memory")
#define VM_WAIT() asm volatile("s_waitcnt vmcnt(0)" ::: "memory")
__device__ __forceinline__ unsigned long long rt() { return __builtin_amdgcn_s_memrealtime(); }
__device__ __forceinline__ unsigned f2bf(float f) { unsigned u = __builtin_bit_cast(unsigned, f); return (u + 0x7fffu + ((u >> 16) & 1u)) >> 16; }
__device__ __forceinline__ unsigned pk2(float lo, float hi) { return f2bf(lo) | (f2bf(hi) << 16); }

#define XB_TMO      128
#define XB_XCNT(j)  (256  + 64 * (j))
#define XB_XSUB(j)  (1280 + 64 * (j))
#define XB_XGEN(j)  (2304 + 64 * (j))
#define XB_TOP      3328
#define XB_TOPGEN   3392
#define XCD_BAR_WORDS 3456
#define XB_SPIN_CAP (1u << 18)

__device__ __forceinline__ unsigned xb_ld(unsigned* p)              { return __hip_atomic_load(p, __ATOMIC_RELAXED, __HIP_MEMORY_SCOPE_AGENT); }
__device__ __forceinline__ unsigned xb_add(unsigned* p, unsigned v) { return __hip_atomic_fetch_add(p, v, __ATOMIC_RELAXED, __HIP_MEMORY_SCOPE_AGENT); }
__device__ __forceinline__ unsigned xb_xcc_id() { return (unsigned)__builtin_amdgcn_s_getreg((3 << 11) | 20) & 0xFu; }
#define XB_SPIN(cond, bar) do { unsigned _sp = 0; while (cond) { __builtin_amdgcn_s_sleep(1); \
    if ((++_sp & 255u) == 0u) { if (xb_ld(&(bar)[XB_TMO])) break; if (_sp > XB_SPIN_CAP) { atomicAdd(&(bar)[XB_TMO], 1u); break; } } } } while (0)

struct XcdBarrier {
    unsigned* bar; unsigned x;
    volatile LAS unsigned* st;
};

__device__ __forceinline__ XcdBarrier xcd_barrier_post(unsigned* bar, volatile LAS unsigned* st) {
    XcdBarrier b; b.bar = bar; b.x = xb_xcc_id(); b.st = st;
    if (threadIdx.x == 0) (void)xb_add(&bar[XB_XCNT(b.x)], 1u);
    return b;
}
__device__ __forceinline__ void xcd_barrier_complete(unsigned* bar, unsigned x, unsigned& nloc, unsigned& nx) {
    const unsigned G = gridDim.x * gridDim.y * gridDim.z;
    unsigned sum, cnt, mine, sp = 0u;
    for (;;) {
        sum = 0u; cnt = 0u; mine = 0u;
#pragma unroll
        for (unsigned j = 0; j < 16; ++j) { const unsigned c = xb_ld(&bar[XB_XCNT(j)]); sum += c; cnt += (c > 0u) ? 1u : 0u; mine = (j == x) ? c : mine; }
        if (sum == G) break;
        __builtin_amdgcn_s_sleep(1);
        if ((++sp & 255u) == 0u) { if (xb_ld(&bar[XB_TMO])) break; if (sp > XB_SPIN_CAP) { atomicAdd(&bar[XB_TMO], 1u); break; } }
    }
    nloc = mine > 0u ? mine : 1u; nx = cnt > 0u ? cnt : 1u;
}

__device__ __forceinline__ void xcd_barrier(const XcdBarrier& b, const bool t0  ) {
    asm volatile("s_waitcnt vmcnt(0)" ::: "memory");
    __syncthreads();
    if (t0) {
        unsigned* bar = b.bar;
        __builtin_amdgcn_s_waitcnt(0);
        unsigned nloc = b.st[0], nx = b.st[1];
        if (nloc == 0u) { xcd_barrier_complete(bar, b.x, nloc, nx); b.st[0] = nloc; b.st[1] = nx; }
        const unsigned old = xb_add(&bar[XB_XSUB(b.x)], 1u);
        const unsigned gen = old / nloc;
        if (old + 1u == (gen + 1u) * nloc) {
            __builtin_amdgcn_fence(__ATOMIC_RELEASE, "agent");
            asm volatile("s_waitcnt vmcnt(0)" ::: "memory");
            const unsigned og = xb_add(&bar[XB_TOP], 1u);
            const unsigned tg = og / nx;
            if (og + 1u == (tg + 1u) * nx) xb_add(&bar[XB_TOPGEN], 1u);
            else XB_SPIN(xb_ld(&bar[XB_TOPGEN]) == tg, bar);
            __builtin_amdgcn_fence(__ATOMIC_ACQUIRE, "agent");
            xb_add(&bar[XB_XGEN(b.x)], 1u);
            asm volatile("s_waitcnt vmcnt(0)" ::: "memory");
        } else {
            XB_SPIN(xb_ld(&bar[XB_XGEN(b.x)]) == gen, bar);
            __builtin_amdgcn_fence(__ATOMIC_ACQUIRE, "agent");
            asm volatile("s_waitcnt vmcnt(0)" ::: "memory");
        }
    }
    __syncthreads();
}

#ifndef PG8_SP2
#define PG8_SP2 true
#endif
#ifndef PG8_ALIGN
#define PG8_ALIGN true
#endif
constexpr int NWAVES = 8;
constexpr int N_STEPS = 38;
#ifndef MK_N_LAUNCHES
#define MK_N_LAUNCHES 1
#endif
#ifndef PH_MASK
#define PH_MASK 0xffff
#endif
#ifndef REP_MASK
#define REP_MASK 0
#endif
#ifndef PREP_REP_LRU
#define PREP_REP_LRU 1
#endif
#ifndef PREP_REP_GDN
#define PREP_REP_GDN 1
#endif
constexpr int N_LAUNCHES = MK_N_LAUNCHES;

constexpr int D = 1024, BATCH = 4, SEQ = 4096, DEPTH = 4, M = BATCH * SEQ;
constexpr int LRUW = 512, NGB = 8, GBW = 64, GH = 4, HD = 128, GDNW = 512, CH = 64, NCH = SEQ / CH, FF = 4096;
constexpr int NMODC = 6 * D, INC = 3080, NPROJ = 3072;
constexpr int O_LX = 0, O_LY = 512, O_Q = 1024, O_Z = 2560;
constexpr float EPS = 1e-6f;

constexpr size_t MiB = 1u << 20;
constexpr size_t WS_CTL = 0, CTL_ZERO_BYTES = 1 * MiB;
constexpr size_t WS_MOD = 1 * MiB;
constexpr size_t WS_BG = 2 * MiB;
constexpr size_t WS_AGG = 3 * MiB;
constexpr size_t WS_CARRY = 4 * MiB;
constexpr size_t WS_GL = 5 * MiB;
constexpr size_t WS_GT = 6 * MiB;
constexpr size_t WS_C1 = 6 * MiB + 512 * 1024;
constexpr size_t WS_C2 = 6 * MiB + 768 * 1024;
constexpr size_t WS_CB8 = 7 * MiB;
constexpr size_t WS_W8T = 7 * MiB + 64 * 1024;
constexpr size_t WS_RS1 = 364 * MiB, WS_RS2 = 365 * MiB;
constexpr size_t WS_A1 = 312 * MiB;
constexpr size_t WS_W = 8 * MiB;
constexpr size_t LAYER_W = (size_t)12288 * 1024;
constexpr size_t W_OUT_OFF = (size_t)3072 * 1024, W_UP_OFF = (size_t)4096 * 1024, W_DOWN_OFF = (size_t)8192 * 1024;
constexpr size_t WS_H = 104 * MiB;
constexpr size_t WS_MIX = 136 * MiB;
constexpr size_t WS_PROJ = 168 * MiB;
constexpr size_t WS_ACT = 168 * MiB;
constexpr size_t WS_GQD = 264 * MiB, WS_GKT = 280 * MiB;
constexpr size_t WS_GATT = 296 * MiB;
constexpr size_t WS_GO = 312 * MiB;
constexpr size_t WS_LRUP = 344 * MiB;
constexpr size_t WS_XT = 366 * MiB;
constexpr size_t WS_END = 384 * MiB;
constexpr int CW_BAR = 4096;
constexpr size_t X16_OFF = 32 * MiB;

constexpr int RING_OFF = 0, RING_BYTES = 155648;
constexpr int RSTAB_OFF = 131072;
constexpr int LDSCTL_OFF = RING_BYTES, MISC_OFF = LDSCTL_OFF + 320;
constexpr int LDS_BYTES = 156672;

typedef unsigned v2u __attribute__((ext_vector_type(2)));
#define DI __device__ __forceinline__
DI float bf2f(unsigned b) { return __builtin_bit_cast(float, b << 16); }
DI float bflo(unsigned w) { return __builtin_bit_cast(float, w << 16); }
DI float bfhi(unsigned w) { return __builtin_bit_cast(float, w & 0xffff0000u); }
DI float sigmoidf_(float x) { return 1.f / (1.f + expf(-x)); }
DI float siluf_(float x) { return x / (1.f + expf(-x)); }
DI float rcp_(float x) { return __builtin_amdgcn_rcpf(x); }
DI float exp_fast(float x) { return __builtin_amdgcn_exp2f(x * 1.4426950408889634f); }
DI float sigmoid_fast(float x) { return rcp_(1.f + exp_fast(-x)); }
DI float silu_fast(float x) { return x * rcp_(1.f + exp_fast(-x)); }
DI float gelu_tanh(float x) { const float u = 0.7978845608028654f * (x + 0.044715f * x * x * x); return 0.5f * x * (1.f + tanhf(u)); }
DI float bperm_(int src_lane, float v) { return __builtin_bit_cast(float, __builtin_amdgcn_ds_bpermute(src_lane << 2, __builtin_bit_cast(int, v))); }
DI float wave_sum_(int lane, float v) {
#pragma unroll
    for (int o = 1; o < 64; o <<= 1) v += bperm_(lane ^ o, v);
    return v;
}
DI float half_sum_(int lane, float v) {
#pragma unroll
    for (int o = 1; o < 32; o <<= 1) v += bperm_(lane ^ o, v);
    return v;
}
DI float shfl_up_(int lane, float v, int off) { return bperm_(lane >= off ? lane - off : lane, v); }

struct Args { const float* in[23]; float* out; unsigned char* ws; int ph_lo, ph_hi; };
static_assert(sizeof(Args) == 23 * 8 + 8 + 8 + 8, "Args has no padding");
struct Frame {
    LAS unsigned char* lds;
    volatile LAS unsigned* MISC;
    gu32* ctl;
    int tid, lane, wave;
    int vcu, G;
    const __attribute__((address_space(4))) Args* A;
};
#define IN_(k) (F.A->in[k])
#define X_IN IN_(0)
#define C_IN IN_(1)
#define NORM_MIX_W IN_(2)
#define NORM_MLP_W IN_(3)
#define W_MOD IN_(4)
#define B_MOD IN_(5)
#define W_IN IN_(6)
#define LRU_CONV_W IN_(7)
#define LRU_CONV_B IN_(8)
#define GATE_A_W IN_(9)
#define GATE_A_B IN_(10)
#define GATE_X_W IN_(11)
#define GATE_X_B IN_(12)
#define LRU_LAMBDA IN_(13)
#define LRU_NORM_W IN_(14)
#define GDN_CONV_W IN_(15)
#define GDN_A_LOG IN_(16)
#define GDN_DT_BIAS IN_(17)
#define GDN_NORM_W IN_(18)
#define W_OUT IN_(19)
#define W_UP IN_(20)
#define W_DOWN IN_(21)
#define FINAL_NORM_W IN_(22)
#define OUT_ (F.A->out)
#define WSF(off) ((float*)(F.A->ws + (off)))
#define WSH(off) ((bf16*)(F.A->ws + (off)))

DI void p_mod(Frame& F) {
    LAS float* cs = (LAS float*)F.lds;
    LAS float* red = cs + 4096;
    for (int i = F.tid; i < BATCH * D; i += NWAVES * 64) cs[i] = siluf_(C_IN[i]);
    __syncthreads();
    const int hl = F.lane >> 5, cl = F.lane & 31;
    for (int item = F.vcu; item < DEPTH * 192; item += F.G) {
        const int l = item / 192, cg = item % 192, col = cg * 32 + cl, kbase = F.wave * 128 + hl * 64;
        const float* wp = W_MOD + ((size_t)l * D + kbase) * NMODC + col;
        float a0 = 0.f, a1 = 0.f, a2 = 0.f, a3 = 0.f;
#pragma unroll 16
        for (int kk = 0; kk < 64; ++kk) { const float wv = wp[(size_t)kk * NMODC]; const int k = kbase + kk;
            a0 += cs[k] * wv; a1 += cs[1024 + k] * wv; a2 += cs[2048 + k] * wv; a3 += cs[3072 + k] * wv; }
        const int sl = F.wave * 2 + hl;
        red[(sl * 4 + 0) * 32 + cl] = a0; red[(sl * 4 + 1) * 32 + cl] = a1; red[(sl * 4 + 2) * 32 + cl] = a2; red[(sl * 4 + 3) * 32 + cl] = a3;
        __syncthreads();
        if (F.tid < 128) { const int b = F.tid >> 5, ln = F.tid & 31; float sum = 0.f;
#pragma unroll
            for (int w = 0; w < 16; ++w) sum += red[(w * 4 + b) * 32 + ln];
            const int cc = cg * 32 + ln; WSF(WS_MOD)[((size_t)l * BATCH + b) * NMODC + cc] = sum + B_MOD[(size_t)l * NMODC + cc]; }
        __syncthreads();
    }
}

struct TrItem { const float* src; bf16* dst; int K, ldw; };
DI void p0_item(Frame& F, int it, TrItem& T) {
    constexpr int I_IN = (D / 64) * (NPROJ / 32), I_OUT = (D / 64) * (D / 32), I_UP = (D / 64) * (FF / 32), I_DN = (FF / 64) * (D / 32);
    constexpr int PER_LAYER = I_IN + I_OUT + I_UP + I_DN;
    const int l = it / PER_LAYER; int r = it % PER_LAYER; bf16* wl = WSH(WS_W) + (size_t)l * LAYER_W;
    const float* W; int K, ldw, N; bf16* WT;
    if (r < I_IN) { W = W_IN + (size_t)l * D * INC; K = D; ldw = INC; N = NPROJ; WT = wl; }
    else if ((r -= I_IN) < I_OUT) { W = W_OUT + (size_t)l * D * D; K = D; ldw = D; N = D; WT = wl + W_OUT_OFF; }
    else if ((r -= I_OUT) < I_UP) { W = W_UP + (size_t)l * D * FF; K = D; ldw = FF; N = FF; WT = wl + W_UP_OFF; }
    else { r -= I_UP; W = W_DOWN + (size_t)l * FF * D; K = FF; ldw = D; N = D; WT = wl + W_DOWN_OFF; }
    const int nblk = N / 32, kb = r / nblk, nb = r % nblk, k0 = 64 * kb, n0 = 32 * nb;
    T.src = W + (size_t)k0 * ldw + n0; T.dst = WT + (size_t)n0 * K + k0; T.K = K; T.ldw = ldw;
}
DI void p0_weights(Frame& F) {
    LAS float* scr = (LAS float*)(F.lds + RING_OFF + F.wave * 16384);
    const int gw = F.vcu * NWAVES + F.wave, NGW = F.G * NWAVES, lane = F.lane;
    constexpr int NIT = DEPTH * ((D / 64) * (NPROJ / 32) + (D / 64) * (D / 32) + (D / 64) * (FF / 32) + (FF / 64) * (D / 32));
    TrItem T; f32x4 v[8];
    if (gw < NIT) { p0_item(F, gw, T);
#pragma unroll
        for (int i = 0; i < 8; ++i) v[i] = *(const f32x4*)(T.src + (size_t)((lane >> 3) + 8 * i) * T.ldw + 4 * (lane & 7)); }
    for (int it = gw; it < NIT; it += NGW) {
        TrItem Tn; f32x4 vn[8]; const int itn = it + NGW < NIT ? it + NGW : it;
        p0_item(F, itn, Tn);
#pragma unroll
        for (int i = 0; i < 8; ++i) vn[i] = *(const f32x4*)(Tn.src + (size_t)((lane >> 3) + 8 * i) * Tn.ldw + 4 * (lane & 7));
#pragma unroll
        for (int i = 0; i < 8; ++i) { LAS float* d = scr + ((lane >> 3) + 8 * i) * 33 + 4 * (lane & 7); d[0] = v[i].x; d[1] = v[i].y; d[2] = v[i].z; d[3] = v[i].w; }
        LDS_WAIT(); asm volatile("" ::: "memory");
        const int c = lane & 7;
#pragma unroll
        for (int j = 0; j < 4; ++j) { const int n = (lane >> 3) + 8 * j; const LAS float* sp = scr + (8 * c) * 33 + n;
            v4u o; o.x = pk2(sp[0 * 33], sp[1 * 33]); o.y = pk2(sp[2 * 33], sp[3 * 33]); o.z = pk2(sp[4 * 33], sp[5 * 33]); o.w = pk2(sp[6 * 33], sp[7 * 33]);
            *(v4u*)(T.dst + (size_t)n * T.K + 8 * c) = o; }
        LDS_WAIT(); asm volatile("" ::: "memory");
        T = Tn;
#pragma unroll
        for (int i = 0; i < 8; ++i) v[i] = vn[i];
    }
    for (int o = (int)blockIdx.x * NWAVES * 64 + F.tid; o < DEPTH * 16 * 1024; o += (int)gridDim.x * NWAVES * 64) {
        const int k = o & 1023, j = (o >> 10) & 15, l = o >> 14;
        WSH(WS_W8T)[o] = (bf16)(j < 8 ? f2bf(W_IN[((size_t)l * D + k) * INC + NPROJ + j]) : 0u);
    }
    for (int o = (int)blockIdx.x * NWAVES * 64 + F.tid; o < DEPTH * 2 * NGB * 4096; o += (int)gridDim.x * NWAVES * 64) {
        const int i = o & 63, j = (o >> 6) & 63, g = (o >> 12) & 7, gate = (o >> 15) & 1, l = o >> 16;
        const float* src = gate ? GATE_X_W : GATE_A_W;
        WSH(WS_GT)[o] = (bf16)f2bf(src[(size_t)(l * NGB + g) * 4096 + i * 64 + j]);
    }
}

DI void p_cvec(Frame& F) {
    const int gw = F.vcu * NWAVES + F.wave, NGW = F.G * NWAVES, lane = F.lane;
    constexpr int IT_IN = NPROJ / 16, IT_UP = FF / 16, PER_L = IT_IN + IT_UP;
    for (int it = gw; it < DEPTH * PER_L; it += NGW) {
        const int l = it / PER_L, r = it % PER_L, which = r >= IT_IN, rg = which ? r - IT_IN : r, N = which ? FF : NPROJ;
        const bf16* wt = WSH(WS_W) + (size_t)l * LAYER_W + (which ? W_UP_OFF : 0) + (size_t)(rg * 16) * 1024 + 16 * lane;
        const float* shb = WSF(WS_MOD) + (size_t)l * BATCH * NMODC + (which ? 3 * D : 0) + 16 * lane;
        float* cout = (which ? WSF(WS_C2) + (size_t)l * BATCH * FF : WSF(WS_C1) + (size_t)l * BATCH * NPROJ) + rg * 16;
        f32x4 sh[4][4];
#pragma unroll
        for (int b = 0; b < 4; ++b)
#pragma unroll
            for (int j = 0; j < 4; ++j) sh[b][j] = *(const f32x4*)(shb + (size_t)b * NMODC + 4 * j);
        float v[64];
#pragma unroll
        for (int row = 0; row < 16; ++row) { const v4u w0 = *(const v4u*)(wt + (size_t)row * 1024), w1 = *(const v4u*)(wt + (size_t)row * 1024 + 8);
            const f32x4 wa = (f32x4){bflo(w0.x), bfhi(w0.x), bflo(w0.y), bfhi(w0.y)}, wb = (f32x4){bflo(w0.z), bfhi(w0.z), bflo(w0.w), bfhi(w0.w)};
            const f32x4 wc = (f32x4){bflo(w1.x), bfhi(w1.x), bflo(w1.y), bfhi(w1.y)}, wd = (f32x4){bflo(w1.z), bfhi(w1.z), bflo(w1.w), bfhi(w1.w)};
#pragma unroll
            for (int b = 0; b < 4; ++b) { const f32x4 t = sh[b][0] * wa + sh[b][1] * wb + sh[b][2] * wc + sh[b][3] * wd; v[row * 4 + b] = (t[0] + t[1]) + (t[2] + t[3]); } }
#pragma unroll
        for (int st = 0; st < 6; ++st) { const int bit = 1 << st; const bool up = lane & bit;
#pragma unroll
            for (int i = 0; i < (32 >> st); ++i) { const float keep = up ? v[2 * i + 1] : v[2 * i], send = up ? v[2 * i] : v[2 * i + 1]; v[i] = keep + bperm_(lane ^ bit, send); } }
        cout[(size_t)(lane & 3) * N + (lane >> 2)] = v[0];
    }
    if (gw < DEPTH * BATCH) { const int l = gw >> 2, b = gw & 3; float a[8];
#pragma unroll
        for (int j = 0; j < 8; ++j) a[j] = 0.f;
        for (int kk = 0; kk < 16; ++kk) { const int k = 16 * lane + kk; const float shv = WSF(WS_MOD)[((size_t)l * BATCH + b) * NMODC + k];
#pragma unroll
            for (int j = 0; j < 8; ++j) a[j] += shv * W_IN[((size_t)l * D + k) * INC + NPROJ + j]; }
#pragma unroll
        for (int j = 0; j < 8; ++j) a[j] = wave_sum_(lane, a[j]);
        if (lane < 8) { float r = a[0];
#pragma unroll
            for (int j = 1; j < 8; ++j) r = (lane == j) ? a[j] : r;
            WSF(WS_CB8)[(size_t)gw * 8 + lane] = r; } }
}

template <bool WITH_BG>
DI void p_normmod(Frame& F, int l, const float* xin, const float* normw, int off_sh, int off_sc) {
    LAS float* w8 = (LAS float*)F.lds;
    if (WITH_BG) {
        for (int i = F.tid; i < D * 8; i += NWAVES * 64) w8[i] = W_IN[((size_t)l * D + (i >> 3)) * INC + NPROJ + (i & 7)];
        __syncthreads();
    }
    const int gw = F.vcu * NWAVES + F.wave, NGW = F.G * NWAVES, lane = F.lane;
    f32x4 v[4];
    if (gw < M) {
#pragma unroll
        for (int j = 0; j < 4; ++j) v[j] = *(const f32x4*)(xin + (size_t)gw * D + 4 * lane + 256 * j);
    }
    for (int m = gw; m < M; m += NGW) {
        const int b = m >> 12, mn = m + NGW;
        f32x4 vnx[4];
#pragma unroll
        for (int j = 0; j < 4; ++j) vnx[j] = (mn < M) ? *(const f32x4*)(xin + (size_t)mn * D + 4 * lane + 256 * j) : (f32x4){0.f, 0.f, 0.f, 0.f};
        const float* modp = WSF(WS_MOD) + ((size_t)l * BATCH + b) * NMODC;
        float ss = 0.f;
#pragma unroll
        for (int j = 0; j < 4; ++j) ss += (v[j].x * v[j].x + v[j].y * v[j].y) + (v[j].z * v[j].z + v[j].w * v[j].w);
        ss = wave_sum_(lane, ss);
        const float rstd = 1.0f / sqrtf(ss * (1.0f / D) + EPS);
        float a0 = 0.f, a1 = 0.f, a2 = 0.f, a3 = 0.f, a4 = 0.f, a5 = 0.f, a6 = 0.f, a7 = 0.f;
#pragma unroll
        for (int j = 0; j < 4; ++j) {
            const int col = 4 * lane + 256 * j;
            const f32x4 nw = *(const f32x4*)(normw + (size_t)l * D + col), sc = *(const f32x4*)(modp + off_sc + col), sh = *(const f32x4*)(modp + off_sh + col);
            const f32x4 hv = v[j] * rstd * nw * (sc + 1.0f) + sh;
            v2u o; o.x = pk2(hv.x, hv.y); o.y = pk2(hv.z, hv.w);
            *(v2u*)(WSH(WS_H) + (size_t)m * D + col) = o;
            if (WITH_BG) {
#pragma unroll
                for (int e = 0; e < 4; ++e) { const f32x4 wa = *(const LAS f32x4*)(w8 + (col + e) * 8), wb = *(const LAS f32x4*)(w8 + (col + e) * 8 + 4); const float hh = hv[e];
                    a0 += hh * wa.x; a1 += hh * wa.y; a2 += hh * wa.z; a3 += hh * wa.w; a4 += hh * wb.x; a5 += hh * wb.y; a6 += hh * wb.z; a7 += hh * wb.w; }
            }
        }
        if (WITH_BG) {
            const bool b0 = lane & 1, b1 = lane & 2, b2 = lane & 4;
            float k0 = b0 ? a1 : a0, k1 = b0 ? a3 : a2, k2 = b0 ? a5 : a4, k3 = b0 ? a7 : a6;
            k0 += bperm_(lane ^ 1, b0 ? a0 : a1); k1 += bperm_(lane ^ 1, b0 ? a2 : a3); k2 += bperm_(lane ^ 1, b0 ? a4 : a5); k3 += bperm_(lane ^ 1, b0 ? a6 : a7);
            float c0 = b1 ? k1 : k0, c1 = b1 ? k3 : k2;
            c0 += bperm_(lane ^ 2, b1 ? k0 : k1); c1 += bperm_(lane ^ 2, b1 ? k2 : k3);
            float d = b2 ? c1 : c0;
            d += bperm_(lane ^ 4, b2 ? c0 : c1);
            d += bperm_(lane ^ 8, d); d += bperm_(lane ^ 16, d); d += bperm_(lane ^ 32, d);
            if (lane < 8) {
                const int hh = lane & 3;
                float r;
                if (lane < 4) r = sigmoidf_(d);
                else { const float xx = d + GDN_DT_BIAS[l * GH + hh]; const float sp = xx > 20.f ? xx : log1pf(expf(xx)); r = -expf(GDN_A_LOG[l * GH + hh]) * sp; }
                WSF(WS_BG)[(size_t)m * 8 + lane] = r;
            }
        }
#pragma unroll
        for (int j = 0; j < 4; ++j) v[j] = vnx[j];
    }
}

typedef float f32x2_t __attribute__((ext_vector_type(2))); typedef __bf16 bf16x2_t __attribute__((ext_vector_type(2)));
DI unsigned cvtpk(float lo, float hi) { f32x2_t v = {lo, hi}; bf16x2_t b = __builtin_convertvector(v, bf16x2_t); return __builtin_bit_cast(unsigned, b); }
DI bf16x8 pack8(f32x4 a, f32x4 b) { v4u p; p.x = cvtpk(a.x, a.y); p.y = cvtpk(a.z, a.w); p.z = cvtpk(b.x, b.y); p.w = cvtpk(b.z, b.w); return __builtin_bit_cast(bf16x8, p); }
DI bf16x8 ldfrag(const LAS unsigned char* p) { const v2u lo = *(const LAS v2u*)p, hi = *(const LAS v2u*)(p + 32); v4u r; r.x = lo.x; r.y = lo.y; r.z = hi.x; r.w = hi.y; return __builtin_bit_cast(bf16x8, r); }
#define MFMA16(a, b, c) __builtin_amdgcn_mfma_f32_16x16x32_bf16((a), (b), (c), 0, 0, 0)

#define WG_BAR() do { asm volatile("s_waitcnt lgkmcnt(0)" ::: "memory"); __builtin_amdgcn_s_barrier(); asm volatile("" ::: "memory"); } while (0)
DI bf16x8 ld128(const LAS unsigned char* p) { return *(const LAS bf16x8*)p; }
DI int kperm4(int k4) { return k4 < 16 ? 2 * k4 : 2 * (k4 - 16) + 4; }
DI int kperm(int k) { return (k & ~31) + kperm4(k & 28) + (k & 3); }
constexpr int PG_QB = 0, PG_KB = 17408, PG_KBET = 34816, PG_VT = 53248, PG_LS = 71680, PG_TS = 89088, PG_TB = 106496, PG_ATT = 115712, PG_XS = 124928, PG_SM = 128000, PG_END = 129024, PG_BGS = 140288;
static_assert(PG_END <= RING_BYTES && PG_BGS >= 8 * 17408 && PG_BGS + 2048 <= RING_BYTES, "prep LDS map");
DI void p_prep(Frame& F, int l) {
    const int wave = F.wave;
#define PREP_IDS int tid_ = F.tid; asm volatile("" : "+v"(tid_)); const int tid = tid_, lane = tid & 63, m = lane & 15, q = lane >> 4; (void)m; (void)q;
    for (int item = blockIdx.x; item < BATCH * NCH; item += gridDim.x) {
        const int b = item / NCH, n = item % NCH, row0 = b * SEQ + n * CH, t0 = n * CH;
        LAS float* bgs = (LAS float*)(F.lds + PG_BGS);
        if (l > 0 && wave < 4) {
            PREP_IDS
            const int mt = wave;
            const bf16* a1 = WSH(WS_A1) + (size_t)(row0 + 16 * mt + m) * D + 8 * q;
            const bf16* w8t = WSH(WS_W8T) + (size_t)l * 16 * 1024 + (size_t)m * 1024 + 8 * q;
            f32x4 acc = (f32x4){0.f, 0.f, 0.f, 0.f};
#pragma unroll 16
            for (int kb = 0; kb < 32; ++kb) acc = MFMA16(*(const bf16x8*)(a1 + 32 * kb), *(const bf16x8*)(w8t + 32 * kb), acc);
            if (m < 8) { const int hh = m & 3; const float cb = WSF(WS_CB8)[((size_t)l * BATCH + b) * 8 + m], dtb = GDN_DT_BIAS[l * GH + hh], alog = GDN_A_LOG[l * GH + hh];
#pragma unroll
                for (int r = 0; r < 4; ++r) { const int t = 16 * mt + 4 * q + r; const f32x4* rp = (const f32x4*)(WSF(WS_RS1) + (size_t)(row0 + t) * 16);
                    const f32x4 p0 = rp[0], p1 = rp[1], p2 = rp[2], p3 = rp[3], ts = (p0 + p1) + (p2 + p3);
                    const float rstd = 1.0f / sqrtf(((ts[0] + ts[1]) + (ts[2] + ts[3])) * (1.0f / D) + EPS), v = acc[r] * rstd + cb;
                    float res;
                    if (m < 4) res = sigmoidf_(v); else { const float xx = v + dtb; const float sp = xx > 20.f ? xx : log1pf(expf(xx)); res = -expf(alog) * sp; }
                    bgs[t * 8 + m] = res; } }
        }
        for (int rep_ = 0; rep_ < PREP_REP_LRU; ++rep_) {
            PREP_IDS
            const int g = wave;
            LAS float* xr = (LAS float*)(F.lds + wave * 17408);
            const int tg = lane >> 3, cg = lane & 7, c0 = 8 * cg, cc0 = g * 64 + c0;
            v4u xp[11];
#pragma unroll
            for (int i = 0; i < 11; ++i) { const int tt = t0 + 8 * tg - 3 + i;
                xp[i] = (tt >= 0) ? *(const v4u*)(WSH(WS_PROJ) + (size_t)(b * SEQ + tt) * NPROJ + O_LX + cc0) : (v4u){0u, 0u, 0u, 0u}; }
            f32x4 wl_[4], wh_[4];
#pragma unroll
            for (int k = 0; k < 4; ++k) { wl_[k] = *(const f32x4*)(LRU_CONV_W + ((size_t)l * 4 + k) * LRUW + cc0); wh_[k] = *(const f32x4*)(LRU_CONV_W + ((size_t)l * 4 + k) * LRUW + cc0 + 4); }
            const f32x4 bl_ = *(const f32x4*)(LRU_CONV_B + l * LRUW + cc0), bh_ = *(const f32x4*)(LRU_CONV_B + l * LRUW + cc0 + 4);
            bf16x8 Bf[2][4][2];
#pragma unroll
            for (int gate = 0; gate < 2; ++gate)
#pragma unroll
                for (int nt = 0; nt < 4; ++nt)
#pragma unroll
                    for (int ks = 0; ks < 2; ++ks) Bf[gate][nt][ks] = *(const bf16x8*)(WSH(WS_GT) + ((size_t)((l * 2 + gate) * NGB + g)) * 4096 + (size_t)(16 * nt + m) * 64 + 32 * ks + 8 * q);
            float ba_[4], bx_[4], ls_[4];
#pragma unroll
            for (int nt = 0; nt < 4; ++nt) { const int cc = g * 64 + 16 * nt + m; ba_[nt] = GATE_A_B[l * LRUW + cc]; bx_[nt] = GATE_X_B[l * LRUW + cc];
                const float lam = LRU_LAMBDA[l * LRUW + cc]; ls_[nt] = -8.0f * (fmaxf(-lam, 0.f) + log1pf(expf(-fabsf(lam)))); }
#pragma unroll
            for (int tt = 0; tt < 8; ++tt) { f32x4 al = bl_, ah = bh_;
#pragma unroll
                for (int k = 0; k < 4; ++k) { const v4u xw = xp[tt + k];
                    al += wl_[k] * (f32x4){bflo(xw.x), bfhi(xw.x), bflo(xw.y), bfhi(xw.y)}; ah += wh_[k] * (f32x4){bflo(xw.z), bfhi(xw.z), bflo(xw.w), bfhi(xw.w)}; }
                *(LAS f32x4*)(xr + (8 * tg + tt) * 68 + c0) = al; *(LAS f32x4*)(xr + (8 * tg + tt) * 68 + c0 + 4) = ah; }
            asm volatile("s_waitcnt lgkmcnt(0)" ::: "memory");
            bf16x8 Af[4][2];
#pragma unroll
            for (int mt = 0; mt < 4; ++mt)
#pragma unroll
                for (int ks = 0; ks < 2; ++ks) { const LAS float* pp = xr + (16 * mt + m) * 68 + 32 * ks + 8 * q; Af[mt][ks] = pack8(*(const LAS f32x4*)pp, *(const LAS f32x4*)(pp + 4)); }
#pragma unroll
            for (int nt = 0; nt < 4; ++nt) {
                float av[4][4], bv[4][4];
#pragma unroll
                for (int mt = 0; mt < 4; ++mt) { f32x4 ra = (f32x4){0.f, 0.f, 0.f, 0.f}, ia = (f32x4){0.f, 0.f, 0.f, 0.f};
                    ra = MFMA16(Af[mt][0], Bf[0][nt][0], ra); ra = MFMA16(Af[mt][1], Bf[0][nt][1], ra);
                    ia = MFMA16(Af[mt][0], Bf[1][nt][0], ia); ia = MFMA16(Af[mt][1], Bf[1][nt][1], ia);
#pragma unroll
                    for (int r = 0; r < 4; ++r) { const float rr = sigmoid_fast(ra[r] + ba_[nt]), ig = sigmoid_fast(ia[r] + bx_[nt]);
                        const float log_a = rr * ls_[nt], aa = exp_fast(log_a), mult = __builtin_amdgcn_sqrtf(fmaxf(1.0f - exp_fast(2.0f * log_a), 1e-12f));
                        av[mt][r] = aa; bv[mt][r] = mult * (ig * xr[(16 * mt + 4 * q + r) * 68 + 16 * nt + m]); } }
                float iP[4], iH[4];
#pragma unroll
                for (int mt = 0; mt < 4; ++mt) {
#pragma unroll
                    for (int r = 1; r < 4; ++r) { bv[mt][r] = av[mt][r] * bv[mt][r - 1] + bv[mt][r]; av[mt][r] = av[mt][r] * av[mt][r - 1]; }
                    float PA = av[mt][3], HA = bv[mt][3];
                    { const float Pp = shfl_up_(lane, PA, 16), Hp = shfl_up_(lane, HA, 16); if (q >= 1) { HA = PA * Hp + HA; PA = PA * Pp; } }
                    { const float Pp = shfl_up_(lane, PA, 32), Hp = shfl_up_(lane, HA, 32); if (q >= 2) { HA = PA * Hp + HA; PA = PA * Pp; } }
                    iP[mt] = PA; iH[mt] = HA; }
                float CP = 1.f, CH = 0.f;
#pragma unroll
                for (int mt = 0; mt < 4; ++mt) {
                    const float totP = bperm_(m + 48, iP[mt]), totH = bperm_(m + 48, iH[mt]);
                    float exP = shfl_up_(lane, iP[mt], 16), exH = shfl_up_(lane, iH[mt], 16); if (q == 0) { exP = 1.f; exH = 0.f; }
                    const float EP = CP * exP, EH = exP * CH + exH;
#pragma unroll
                    for (int r = 0; r < 4; ++r) { const float Pf = EP * av[mt][r], Hf = av[mt][r] * EH + bv[mt][r];
                        *(LAS unsigned*)(xr + (16 * mt + 4 * q + r) * 68 + 16 * nt + m) = f2bf(Hf) | (f2bf(Pf) << 16); }
                    CH = totP * CH + totH; CP = CP * totP; }
                if (q == 0) { WSF(WS_AGG)[((size_t)(b * NCH + n)) * LRUW + g * 64 + 16 * nt + m] = CP; WSF(WS_AGG)[(size_t)BATCH * NCH * LRUW + ((size_t)(b * NCH + n)) * LRUW + g * 64 + 16 * nt + m] = CH; }
            }
            asm volatile("s_waitcnt lgkmcnt(0)" ::: "memory");
#pragma unroll
            for (int i = 0; i < 16; ++i) { const int pz = lane + 64 * i, row = pz >> 4, c16 = pz & 15;
                *(v4u*)((unsigned*)(F.A->ws + WS_H) + (size_t)(row0 + row) * LRUW + g * 64 + 4 * c16) = *(const LAS v4u*)(xr + row * 68 + 4 * c16); }
        }
        __syncthreads();
        {
            LAS unsigned char* qb = F.lds + PG_QB;
            LAS unsigned char* kb = F.lds + PG_KB;
            LAS unsigned char* kbeT = F.lds + PG_KBET;
            LAS unsigned char* vT = F.lds + PG_VT;
            LAS float* Ls = (LAS float*)(F.lds + PG_LS);
            LAS float* Ts = (LAS float*)(F.lds + PG_TS);
            LAS unsigned char* Tb = F.lds + PG_TB;
            LAS unsigned char* atts = F.lds + PG_ATT;
            LAS float* Xs = (LAS float*)(F.lds + PG_XS);
            LAS float* sm4 = (LAS float*)(F.lds + PG_SM);
            if (wave < GH) { int tl_ = F.tid; asm volatile("" : "+v"(tl_)); const int ln = tl_ & 63, hh = wave;
                float gcv = l > 0 ? bgs[ln * 8 + 4 + hh] : WSF(WS_BG)[(size_t)(row0 + ln) * 8 + 4 + hh];
#pragma unroll
                for (int off = 1; off < 64; off <<= 1) { const float pv = shfl_up_(ln, gcv, off); if (ln >= off) gcv += pv; }
                const float glast = bperm_(63, gcv);
                sm4[hh * 256 + ln] = gcv; sm4[hh * 256 + 64 + ln] = l > 0 ? bgs[ln * 8 + hh] : WSF(WS_BG)[(size_t)(row0 + ln) * 8 + hh]; sm4[hh * 256 + 128 + ln] = expf(gcv); sm4[hh * 256 + 192 + ln] = expf(glast - gcv); }
            WG_BAR();
            v4u xpn[11];
#define G1_FETCH(hh_) do { int tf_ = F.tid; asm volatile("" : "+v"(tf_)); if (tf_ < 384) { const int cgp_ = tf_ & 15, wt_ = tf_ >> 4, which_ = wt_ >> 3, tr_ = wt_ & 7, ch_ = which_ * GDNW + (hh_) * HD + cgp_ * 8; \
                _Pragma("unroll") for (int i = 0; i < 11; ++i) { const int tt = t0 + tr_ * 8 - 3 + i; \
                    xpn[i] = (tt >= 0) ? *(const v4u*)(WSH(WS_PROJ) + (size_t)(b * SEQ + tt) * NPROJ + O_Q + ch_) : (v4u){0u, 0u, 0u, 0u}; } \
                } } while (0)
            G1_FETCH(0);
            for (int h_ = 0; h_ < GH * PREP_REP_GDN; ++h_) { const int h = h_ % GH;
                PREP_IDS
                const size_t item4 = (size_t)(b * GH + h) * NCH + n;
                LAS float* sgc = sm4 + h * 256, *sbeta = sgc + 64, *seg = sgc + 128, *sel = sgc + 192;
#if defined(PROBE_G) && PROBE_G == 1
                for (int prb_ = 0; prb_ < 2; ++prb_) {
#else
                {
#endif
                if (tid < 384) {
                    const int cgp = tid & 15, wt = tid >> 4, which = wt >> 3, tr = wt & 7, d0 = cgp * 8, ch0 = which * GDNW + h * HD + d0;
                    v4u xp[11]; f32x4 wl_[4], wh_[4];
#pragma unroll
                    for (int i = 0; i < 11; ++i) xp[i] = xpn[i];
#pragma unroll
                    for (int k = 0; k < 4; ++k) { wl_[k] = *(const f32x4*)(GDN_CONV_W + ((size_t)l * 4 + k) * (3 * GDNW) + ch0); wh_[k] = *(const f32x4*)(GDN_CONV_W + ((size_t)l * 4 + k) * (3 * GDNW) + ch0 + 4); }
                    f32x4 ol[8], oh[8]; float ss[8];
#pragma unroll
                    for (int tt = 0; tt < 8; ++tt) { f32x4 al = (f32x4){0.f, 0.f, 0.f, 0.f}, ah = (f32x4){0.f, 0.f, 0.f, 0.f};
#pragma unroll
                        for (int k = 0; k < 4; ++k) { const v4u xw = xp[tt + k];
                            al += wl_[k] * (f32x4){bflo(xw.x), bfhi(xw.x), bflo(xw.y), bfhi(xw.y)}; ah += wh_[k] * (f32x4){bflo(xw.z), bfhi(xw.z), bflo(xw.w), bfhi(xw.w)}; }
#pragma unroll
                        for (int c = 0; c < 4; ++c) { al[c] = silu_fast(al[c]); ah[c] = silu_fast(ah[c]); }
                        ol[tt] = al; oh[tt] = ah;
                        ss[tt] = (al.x * al.x + al.y * al.y) + (al.z * al.z + al.w * al.w) + (ah.x * ah.x + ah.y * ah.y) + (ah.z * ah.z + ah.w * ah.w); }
                    if (h_ + 1 < GH * PREP_REP_GDN) G1_FETCH((h_ + 1) % GH);
                    if (which < 2) {
#pragma unroll
                        for (int tt = 0; tt < 8; ++tt) { float v = ss[tt]; v += bperm_(lane ^ 1, v); v += bperm_(lane ^ 2, v); v += bperm_(lane ^ 4, v); v += bperm_(lane ^ 8, v);
                            const float scl = __builtin_amdgcn_rsqf(v + 1e-6f) * (which == 0 ? 0.08838834764831845f : 1.0f); ol[tt] = ol[tt] * scl; oh[tt] = oh[tt] * scl; }
                    }
                    const int tb = tr * 8;
                    if (which == 0) {
#pragma unroll
                        for (int tt = 0; tt < 8; ++tt) { const int t = tb + tt; const float eg = seg[t];
                            v4u pk; pk.x = cvtpk(ol[tt].x, ol[tt].y); pk.y = cvtpk(ol[tt].z, ol[tt].w); pk.z = cvtpk(oh[tt].x, oh[tt].y); pk.w = cvtpk(oh[tt].z, oh[tt].w);
                            *(LAS v4u*)(qb + t * 272 + d0 * 2) = pk;
                            v4u pg; pg.x = cvtpk(ol[tt].x * eg, ol[tt].y * eg); pg.y = cvtpk(ol[tt].z * eg, ol[tt].w * eg); pg.z = cvtpk(oh[tt].x * eg, oh[tt].y * eg); pg.w = cvtpk(oh[tt].z * eg, oh[tt].w * eg);
                            { bf16* qrow = WSH(WS_GQD) + item4 * 8192 + t * 128 + (d0 & ~31); const int kl = d0 & 31;
                                v2u p0; p0.x = pg.x; p0.y = pg.y; v2u p1; p1.x = pg.z; p1.y = pg.w; *(v2u*)(qrow + kperm4(kl)) = p0; *(v2u*)(qrow + kperm4(kl + 4)) = p1; } }
                    } else if (which == 1) {
                        float fb[8], fl[8];
#pragma unroll
                        for (int tt = 0; tt < 8; ++tt) { const int t = tb + tt; fb[tt] = sbeta[t] * seg[t]; fl[tt] = sel[t];
                            v4u pk; pk.x = cvtpk(ol[tt].x, ol[tt].y); pk.y = cvtpk(ol[tt].z, ol[tt].w); pk.z = cvtpk(oh[tt].x, oh[tt].y); pk.w = cvtpk(oh[tt].z, oh[tt].w);
                            *(LAS v4u*)(kb + t * 272 + d0 * 2) = pk; }
#pragma unroll
                        for (int c = 0; c < 8; ++c) {
#define KV_(tt) ((c) < 4 ? ol[tt][(c) & 3] : oh[tt][(c) & 3])
                            v4u pe; pe.x = cvtpk(KV_(0) * fb[0], KV_(1) * fb[1]); pe.y = cvtpk(KV_(2) * fb[2], KV_(3) * fb[3]); pe.z = cvtpk(KV_(4) * fb[4], KV_(5) * fb[5]); pe.w = cvtpk(KV_(6) * fb[6], KV_(7) * fb[7]);
                            *(LAS v4u*)(kbeT + (d0 + c) * 144 + ((tr ^ (cgp & 7)) * 16)) = pe;
                            v4u pt; pt.x = cvtpk(KV_(0) * fl[0], KV_(1) * fl[1]); pt.y = cvtpk(KV_(2) * fl[2], KV_(3) * fl[3]); pt.z = cvtpk(KV_(4) * fl[4], KV_(5) * fl[5]); pt.w = cvtpk(KV_(6) * fl[6], KV_(7) * fl[7]);
                            { bf16* krow = WSH(WS_GKT) + item4 * 8192 + (d0 + c) * 64 + (tb & ~31); const int kl = tb & 31;
                                v2u p0; p0.x = pt.x; p0.y = pt.y; v2u p1; p1.x = pt.z; p1.y = pt.w; *(v2u*)(krow + kperm4(kl)) = p0; *(v2u*)(krow + kperm4(kl + 4)) = p1; } }
                    } else {
                        float fb[8];
#pragma unroll
                        for (int tt = 0; tt < 8; ++tt) fb[tt] = sbeta[tb + tt];
#pragma unroll
                        for (int c = 0; c < 8; ++c) {
                            v4u pe; pe.x = cvtpk(KV_(0) * fb[0], KV_(1) * fb[1]); pe.y = cvtpk(KV_(2) * fb[2], KV_(3) * fb[3]); pe.z = cvtpk(KV_(4) * fb[4], KV_(5) * fb[5]); pe.w = cvtpk(KV_(6) * fb[6], KV_(7) * fb[7]);
                            *(LAS v4u*)(vT + (d0 + c) * 144 + ((tr ^ (cgp & 7)) * 16)) = pe; }
#undef KV_
                    }
                }
                WG_BAR();
                }
#if defined(PROBE_G) && PROBE_G == 2
                for (int prb_ = 0; prb_ < 2; ++prb_) {
#else
                {
#endif
                {
                    const int it = wave >> 1;
                    bf16x8 Ak[4], Aq[4], Bk[2][4];
#pragma unroll
                    for (int ks = 0; ks < 4; ++ks) { Ak[ks] = ld128(kb + (16 * it + m) * 272 + (32 * ks + 8 * q) * 2); Aq[ks] = ld128(qb + (16 * it + m) * 272 + (32 * ks + 8 * q) * 2);
                        Bk[0][ks] = ld128(kb + (16 * ((wave & 1) * 2) + m) * 272 + (32 * ks + 8 * q) * 2); Bk[1][ks] = ld128(kb + (16 * ((wave & 1) * 2 + 1) + m) * 272 + (32 * ks + 8 * q) * 2); }
#pragma unroll
                    for (int jj = 0; jj < 2; ++jj) { const int jt = (wave & 1) * 2 + jj;
                        f32x4 kk = (f32x4){0.f, 0.f, 0.f, 0.f}, qk = (f32x4){0.f, 0.f, 0.f, 0.f};
                        if (jt <= it) {
#pragma unroll
                            for (int ks = 0; ks < 4; ++ks) { kk = MFMA16(Ak[ks], Bk[jj][ks], kk); qk = MFMA16(Aq[ks], Bk[jj][ks], qk); } }
                        const int j = 16 * jt + m; const float gj = sgc[j];
#pragma unroll
                        for (int r = 0; r < 4; ++r) { const int i = 16 * it + 4 * q + r;
                            const float dec = (j <= i) ? exp_fast(sgc[i] - gj) : 0.f;
                            Ls[i * 68 + j] = (j < i) ? sbeta[i] * kk[r] * dec : 0.f;
                            *(LAS unsigned short*)(atts + i * 144 + kperm(j) * 2) = (unsigned short)f2bf((j <= i) ? qk[r] * dec : 0.f); } }
                }
                WG_BAR();
                }
#if defined(PROBE_G) && PROBE_G == 3
                for (int prb_ = 0; prb_ < 2; ++prb_) {
#else
                {
#endif
                if (tid < 64) { const int bk = tid >> 4, c = tid & 15; float x[16];
                    const LAS float* lb = Ls + (16 * bk) * 68 + 16 * bk;
#pragma unroll
                    for (int r = 0; r < 16; ++r) { float acc = (r == c) ? 1.f : 0.f;
#pragma unroll
                        for (int m4 = 0; m4 < (r + 3) / 4; ++m4) { const f32x4 lv = *(const LAS f32x4*)(lb + r * 68 + 4 * m4);
                            if (4 * m4 + 0 < r) acc -= lv.x * x[4 * m4 + 0]; if (4 * m4 + 1 < r) acc -= lv.y * x[4 * m4 + 1]; if (4 * m4 + 2 < r) acc -= lv.z * x[4 * m4 + 2]; if (4 * m4 + 3 < r) acc -= lv.w * x[4 * m4 + 3]; }
                        x[r] = acc; Ts[(16 * bk + r) * 68 + 16 * bk + c] = acc; } }
                WG_BAR();
#pragma unroll 1
                for (int dl = 1; dl < 4; ++dl) {
                    const int nout = (4 - dl) * 256;
                    for (int idx = tid; idx < nout; idx += NWAVES * 64) { const int blk = idx >> 8, r = (idx >> 4) & 15, c = idx & 15, i = blk + dl, j = blk; float acc = 0.f;
                        const LAS float* lrow = Ls + (16 * i + r) * 68 + 16 * j; const LAS float* tcol = Ts + (16 * j) * 68 + 16 * j + c;
                        for (int kk = 0; kk < dl; ++kk) {
#pragma unroll
                            for (int mm = 0; mm < 16; mm += 4) { const f32x4 lv = *(const LAS f32x4*)(lrow + 16 * kk + mm); const LAS float* tc = tcol + (16 * kk + mm) * 68;
                                acc += lv.x * tc[0] + lv.y * tc[68] + lv.z * tc[136] + lv.w * tc[204]; } }
                        Xs[idx] = acc; }
                    WG_BAR();
                    for (int idx = tid; idx < nout; idx += NWAVES * 64) { const int blk = idx >> 8, r = (idx >> 4) & 15, c = idx & 15, i = blk + dl, j = blk; float acc = 0.f;
                        const LAS float* trow = Ts + (16 * i + r) * 68 + 16 * i; const LAS float* xc = Xs + blk * 256 + c;
#pragma unroll
                        for (int mm = 0; mm < 16; mm += 4) { const f32x4 tv = *(const LAS f32x4*)(trow + mm); acc -= tv.x * xc[(mm + 0) * 16] + tv.y * xc[(mm + 1) * 16] + tv.z * xc[(mm + 2) * 16] + tv.w * xc[(mm + 3) * 16]; }
                        Ts[(16 * i + r) * 68 + 16 * j + c] = acc; }
                    WG_BAR();
                }
#pragma unroll
                for (int e = 0; e < 8; ++e) { const int idx = tid + 512 * e, i = idx >> 6, j = idx & 63;
                    *(LAS unsigned short*)(Tb + i * 144 + j * 2) = (unsigned short)(((j >> 4) <= (i >> 4)) ? f2bf(Ts[i * 68 + j]) : 0u); }
                WG_BAR();
                }
#if defined(PROBE_G) && PROBE_G == 4
                for (int prb_ = 0; prb_ < 2; ++prb_) {
#else
                {
#endif
                {
                    const int nt = wave;
#pragma unroll
                    for (int mt = 0; mt < 4; ++mt) { f32x4 ua = (f32x4){0.f, 0.f, 0.f, 0.f}, wa = (f32x4){0.f, 0.f, 0.f, 0.f};
#pragma unroll
                        for (int ks = 0; ks < 2; ++ks) if (32 * ks <= 16 * mt + 15) { const bf16x8 A = ld128(Tb + (16 * mt + m) * 144 + (32 * ks + 8 * q) * 2);
                            const int swz = (((4 * ks + q) ^ ((2 * nt + (m >> 3)) & 7)) * 16);
                            ua = MFMA16(A, ld128(vT + (16 * nt + m) * 144 + swz), ua); wa = MFMA16(A, ld128(kbeT + (16 * nt + m) * 144 + swz), wa); }
unsigned uts[4];
#pragma unroll
                        for (int r = 0; r < 4; ++r) { const int t = 16 * mt + 4 * q + r, d = 16 * nt + m;
                            uts[r] = f2bf(ua[r]); *(LAS unsigned short*)(kb + t * 272 + kperm(d) * 2) = (unsigned short)f2bf(-wa[r]); }
                        { v2u pu; pu.x = uts[0] | (uts[1] << 16); pu.y = uts[2] | (uts[3] << 16); *(LAS v2u*)(F.lds + PG_LS + (16 * nt + m) * 144 + (16 * mt + 4 * q) * 2) = pu; } }
                }
                WG_BAR();
                }
#if defined(PROBE_G) && PROBE_G == 5
                for (int prb_ = 0; prb_ < 2; ++prb_) {
#else
                {
#endif
#pragma unroll
                for (int e = 0; e < 2; ++e) { const int p = tid + 512 * e, row = p >> 4, c16 = p & 15;
                    *(v4u*)((unsigned char*)(WSH(WS_MIX + 16 * MiB) + item4 * 8192) + row * 256 + c16 * 16) = *(const LAS v4u*)(kb + row * 272 + c16 * 16);
                    const int ur = p >> 3, uc = p & 7;
                    *(v4u*)((unsigned char*)(WSH(WS_MIX) + item4 * 8192) + ur * 128 + uc * 16) = *(const LAS v4u*)(F.lds + PG_LS + ur * 144 + uc * 16); }
                { const int row = tid >> 3, c16 = tid & 7;
                    *(v4u*)((unsigned char*)(WSH(WS_GATT) + item4 * 4096) + row * 128 + c16 * 16) = *(const LAS v4u*)(atts + row * 144 + c16 * 16); }
                if (tid == 0) WSF(WS_GL)[item4] = seg[63];
                WG_BAR();
                }
            }
        }
    }
}

#undef PREP_IDS
constexpr int SC_W = 0, SC_QD = 18432, SC_KT = 36864, SC_AT = 57344, SC_U = 67584, SC_STAGE = 76800;
static_assert(2 * SC_STAGE <= RING_BYTES, "scan stages fit the ring");
#define SBAR_() __builtin_amdgcn_sched_barrier(0)
constexpr int NSEG = 8, SEGC = NCH / NSEG;
constexpr size_t WS_PSI = 344 * MiB;
constexpr size_t WS_PHI = 352 * MiB;
constexpr size_t WS_SST = 356 * MiB;
static_assert(WS_SST + 8 * MiB <= WS_END, "two-level scan scratch");

#define SC_ADDR() \
        const unsigned char* gW = (const unsigned char*)(WSH(WS_MIX + 16 * MiB) + it0 * 8192); \
        const unsigned char* gQD = (const unsigned char*)(WSH(WS_GQD) + it0 * 8192); \
        const unsigned char* gKT = (const unsigned char*)(WSH(WS_GKT) + it0 * 8192); \
        const unsigned char* gAT = (const unsigned char*)(WSH(WS_GATT) + it0 * 4096); \
        const unsigned char* gU = (const unsigned char*)(WSH(WS_MIX) + it0 * 8192) + dvbase * 128;
#define SC_LOAD(rg, n_) do { const size_t cb = (size_t)(n_) * 16384, ca = (size_t)(n_) * 8192; \
            _Pragma("unroll") for (int i = 0; i < 4; ++i) { rg[i] = *(const v4u*)(gW + cb + gofW + i * 4096); if (FULL) rg[4 + i] = *(const v4u*)(gQD + cb + gofW + i * 4096); \
                rg[8 + i] = *(const v4u*)(gKT + cb + gofK + i * 4096); } \
            _Pragma("unroll") for (int i = 0; i < 2; ++i) { if (FULL) rg[12 + i] = *(const v4u*)(gAT + ca + gofK + i * 4096); rg[14 + i] = *(const v4u*)(gU + cb + gofK + i * 4096); } } while (0)
#define SC_WRITE(rg, buf_) do { LAS unsigned char* sb_ = F.lds + (buf_) * SC_STAGE; \
            _Pragma("unroll") for (int i = 0; i < 4; ++i) { *(LAS v4u*)(sb_ + SC_W + lofW + i * (16 * 288)) = rg[i]; if (FULL) *(LAS v4u*)(sb_ + SC_QD + lofW + i * (16 * 288)) = rg[4 + i]; \
                *(LAS v4u*)(sb_ + SC_KT + lofK + i * (32 * 160)) = rg[8 + i]; } \
            _Pragma("unroll") for (int i = 0; i < 2; ++i) { if (FULL) *(LAS v4u*)(sb_ + SC_AT + lofK + i * (32 * 160)) = rg[12 + i]; *(LAS v4u*)(sb_ + SC_U + lofU + i * (32 * 144)) = rg[14 + i]; } } while (0)
#define SC_LOADER_LOOP() do { \
            int lt_ = F.tid & 255; asm volatile("" : "+v"(lt_)); \
            const int gofW = (lt_ >> 4) * 256 + (lt_ & 15) * 16, gofK = (lt_ >> 3) * 128 + (lt_ & 7) * 16; \
            const int lofW = (lt_ >> 4) * 288 + (lt_ & 15) * 16, lofK = (lt_ >> 3) * 160 + (lt_ & 7) * 16, lofU = (lt_ >> 3) * 144 + (lt_ & 7) * 16; \
            const int nlast = n0 + SEGC - 1; \
            v4u ra[16], rb[16]; \
            SC_LOAD(ra, n0); SC_WRITE(ra, 0); SC_LOAD(ra, n0 + 1); SC_LOAD(rb, n0 + 2); \
            __syncthreads(); \
            _Pragma("unroll 1") for (int j = 0; j < SEGC; j += 2) { \
                  \
                  \
                SC_WRITE(ra, 1); \
                { const int nn = n0 + j + 3 < nlast ? n0 + j + 3 : nlast; SC_LOAD(ra, nn); } \
                WG_BAR(); \
                SC_WRITE(rb, 0); \
                { const int nn = n0 + j + 4 < nlast ? n0 + j + 4 : nlast; SC_LOAD(rb, nn); } \
                WG_BAR(); \
            } } while (0)

DI void p_scan1(Frame& F, int l) {
    constexpr bool FULL = false;
    const int wave = F.wave;
    { const int lane = F.lane;
        for (int p = blockIdx.x * NWAVES + wave; p < BATCH * LRUW; p += gridDim.x * NWAVES) { const int b = p / LRUW, c = p % LRUW;
            float A = WSF(WS_AGG)[((size_t)(b * NCH + lane)) * LRUW + c], B = WSF(WS_AGG)[(size_t)BATCH * NCH * LRUW + ((size_t)(b * NCH + lane)) * LRUW + c];
#pragma unroll
            for (int off = 1; off < 64; off <<= 1) { const float Ap = shfl_up_(lane, A, off), Bp = shfl_up_(lane, B, off); if (lane >= off) { B = A * Bp + B; A = A * Ap; } }
            if (lane < 63) WSF(WS_CARRY)[((size_t)(b * NCH + lane + 1)) * LRUW + c] = B; else WSF(WS_CARRY)[((size_t)(b * NCH)) * LRUW + c] = 0.f; } }
    const bool is_loader = wave >= 4;
    const int wv = wave & 3;
    for (int job = F.vcu; job < BATCH * GH * NSEG * 2; job += F.G) {
        const int bh = job >> 4, seg = (job >> 1) & (NSEG - 1), dvbase = (job & 1) * 64, n0 = seg * SEGC;
        const size_t it0 = (size_t)bh * NCH;
        SC_ADDR()
        (void)gQD; (void)gAT;
        if (seg == NSEG - 1) { __syncthreads(); continue; }
        if (is_loader) { SC_LOADER_LOOP(); }
        else {
            int tc_ = F.tid; asm volatile("" : "+v"(tc_)); const int lane = tc_ & 63, m = lane & 15, q = lane >> 4;
            const int col = dvbase + 16 * wv + m;
            f32x4 Sacc[2][8];
#pragma unroll
            for (int dt = 0; dt < 8; ++dt) { Sacc[0][dt] = (f32x4){0.f, 0.f, 0.f, 0.f};
#pragma unroll
                for (int r = 0; r < 4; ++r) Sacc[1][dt][r] = (16 * dt + 4 * q + r == col) ? 1.f : 0.f; }
            const float glv = WSF(WS_GL)[it0 + lane];
            __syncthreads();
#pragma unroll 1
            for (int j = 0; j < SEGC; ++j) {
                const LAS unsigned char* B = F.lds + (j & 1) * SC_STAGE;
                bf16x8 fa[4], fb[4], Sb[2][4], vnb[2][2];
                f32x4 vn[2][4];
                v2u ut[4];
#pragma unroll
                for (int mt = 0; mt < 4; ++mt) ut[mt] = *(const LAS v2u*)(B + SC_U + (16 * wv + m) * 144 + (16 * mt + 4 * q) * 2);
#define LDW4(dst, mt_) do { _Pragma("unroll") for (int kb = 0; kb < 4; ++kb) dst[kb] = ld128(B + SC_W + (16 * (mt_) + m) * 288 + (32 * kb + 8 * q) * 2); } while (0)
#define MMW2(src, mt_) do { _Pragma("unroll") for (int kb = 0; kb < 4; ++kb) { vn[0][mt_] = MFMA16(src[kb], Sb[0][kb], vn[0][mt_]); vn[1][mt_] = MFMA16(src[kb], Sb[1][kb], vn[1][mt_]); } } while (0)
#define LDK4(dst, dt_) do { dst[0] = ld128(B + SC_KT + (16 * (dt_) + m) * 160 + (8 * q) * 2); dst[1] = ld128(B + SC_KT + (16 * (dt_) + m) * 160 + (32 + 8 * q) * 2); \
                            dst[2] = ld128(B + SC_KT + (16 * ((dt_) + 1) + m) * 160 + (8 * q) * 2); dst[3] = ld128(B + SC_KT + (16 * ((dt_) + 1) + m) * 160 + (32 + 8 * q) * 2); } while (0)
#define MMK2(src, dt_) do { _Pragma("unroll") for (int e = 0; e < 2; ++e) { Sacc[e][dt_] = MFMA16(src[0], vnb[e][0], Sacc[e][dt_]); Sacc[e][dt_] = MFMA16(src[1], vnb[e][1], Sacc[e][dt_]); \
                            Sacc[e][(dt_) + 1] = MFMA16(src[2], vnb[e][0], Sacc[e][(dt_) + 1]); Sacc[e][(dt_) + 1] = MFMA16(src[3], vnb[e][1], Sacc[e][(dt_) + 1]); } } while (0)
                LDW4(fa, 0); SBAR_();
#pragma unroll
                for (int e = 0; e < 2; ++e)
#pragma unroll
                    for (int kb = 0; kb < 4; ++kb) Sb[e][kb] = pack8(Sacc[e][2 * kb], Sacc[e][2 * kb + 1]);
#pragma unroll
                for (int mt = 0; mt < 4; ++mt) { vn[0][mt] = (f32x4){bflo(ut[mt].x), bfhi(ut[mt].x), bflo(ut[mt].y), bfhi(ut[mt].y)}; vn[1][mt] = (f32x4){0.f, 0.f, 0.f, 0.f}; }
                const float gl = __builtin_bit_cast(float, __builtin_amdgcn_readlane(__builtin_bit_cast(int, glv), n0 + j));
                SBAR_(); LDW4(fb, 1); SBAR_(); MMW2(fa, 0); SBAR_();
                LDW4(fa, 2); SBAR_(); MMW2(fb, 1); SBAR_();
                LDW4(fb, 3); SBAR_(); MMW2(fa, 2); SBAR_();
                LDK4(fa, 0); SBAR_(); MMW2(fb, 3); SBAR_();
#pragma unroll
                for (int e = 0; e < 2; ++e) { vnb[e][0] = pack8(vn[e][0], vn[e][1]); vnb[e][1] = pack8(vn[e][2], vn[e][3]);
#pragma unroll
                    for (int dt = 0; dt < 8; ++dt) Sacc[e][dt] = Sacc[e][dt] * gl; }
                SBAR_(); LDK4(fb, 2); SBAR_(); MMK2(fa, 0); SBAR_();
                LDK4(fa, 4); SBAR_(); MMK2(fb, 2); SBAR_();
                LDK4(fb, 6); SBAR_(); MMK2(fa, 4); SBAR_();
                MMK2(fb, 6); SBAR_();
                WG_BAR();
            }
#undef LDW4
#undef MMW2
#undef LDK4
#undef MMK2
            float* psi = WSF(WS_PSI) + ((size_t)(bh * NSEG + seg) * 128) * 128 + col;
            bf16* phi = WSH(WS_PHI) + ((size_t)(bh * NSEG + seg) * 128) * 128 + kperm(col);
#pragma unroll
            for (int dt = 0; dt < 8; ++dt)
#pragma unroll
                for (int r = 0; r < 4; ++r) { const int dk = 16 * dt + 4 * q + r; psi[(size_t)dk * 128] = Sacc[0][dt][r]; phi[(size_t)dk * 128] = (bf16)f2bf(Sacc[1][dt][r]); }
        }
        __syncthreads();
    }
}

DI void p_scan2(Frame& F, int l) {
    const int wave = F.wave;
    for (int bh = blockIdx.x; bh < BATCH * GH; bh += gridDim.x) {
        int tc_ = F.tid; asm volatile("" : "+v"(tc_)); const int tid = tc_, lane = tc_ & 63, m = lane & 15, q = lane >> 4;
        const int col = 16 * wave + m;
        const int gof = (tid >> 4) * 256 + (tid & 15) * 16, lof = (tid >> 4) * 288 + (tid & 15) * 16;
        const unsigned char* phi0 = (const unsigned char*)(WSH(WS_PHI) + ((size_t)(bh * NSEG) * 128) * 128);
        const float* psi0 = WSF(WS_PSI) + ((size_t)(bh * NSEG) * 128) * 128 + col;
        float* sst0 = WSF(WS_SST) + ((size_t)(bh * NSEG) * 128) * 128 + col;
        f32x4 S[8], Ps[8]; v4u pr[4];
#pragma unroll
        for (int dt = 0; dt < 8; ++dt) { S[dt] = (f32x4){0.f, 0.f, 0.f, 0.f};
#pragma unroll
            for (int r = 0; r < 4; ++r) Ps[dt][r] = psi0[(size_t)(16 * dt + 4 * q + r) * 128]; }
#pragma unroll
        for (int i = 0; i < 4; ++i) pr[i] = *(const v4u*)(phi0 + gof + i * 8192);
#pragma unroll
        for (int i = 0; i < 4; ++i) *(LAS v4u*)(F.lds + lof + i * (32 * 288)) = pr[i];
        __syncthreads();
#pragma unroll 1
        for (int seg = 0; seg + 1 < NSEG; ++seg) {
            if (seg > 0) {
#pragma unroll
                for (int dt = 0; dt < 8; ++dt)
#pragma unroll
                    for (int r = 0; r < 4; ++r) sst0[((size_t)seg * 128 + 16 * dt + 4 * q + r) * 128] = S[dt][r]; }
            const int sn = seg + 2 < NSEG ? seg + 1 : seg;
#pragma unroll
            for (int i = 0; i < 4; ++i) pr[i] = *(const v4u*)(phi0 + (size_t)sn * 32768 + gof + i * 8192);
            f32x4 Pn[8];
#pragma unroll
            for (int dt = 0; dt < 8; ++dt)
#pragma unroll
                for (int r = 0; r < 4; ++r) Pn[dt][r] = psi0[((size_t)sn * 128 + 16 * dt + 4 * q + r) * 128];
            const LAS unsigned char* B = F.lds + (seg & 1) * 36864;
            bf16x8 Sb[4];
#pragma unroll
            for (int kb = 0; kb < 4; ++kb) Sb[kb] = pack8(S[2 * kb], S[2 * kb + 1]);
#pragma unroll
            for (int dt = 0; dt < 8; ++dt) { f32x4 acc = Ps[dt];
#pragma unroll
                for (int kb = 0; kb < 4; ++kb) acc = MFMA16(ld128(B + (16 * dt + m) * 288 + (32 * kb + 8 * q) * 2), Sb[kb], acc);
                S[dt] = acc; }
#pragma unroll
            for (int dt = 0; dt < 8; ++dt) Ps[dt] = Pn[dt];
#pragma unroll
            for (int i = 0; i < 4; ++i) *(LAS v4u*)(F.lds + ((seg + 1) & 1) * 36864 + lof + i * (32 * 288)) = pr[i];
            __syncthreads();
        }
#pragma unroll
        for (int dt = 0; dt < 8; ++dt)
#pragma unroll
            for (int r = 0; r < 4; ++r) sst0[((size_t)(NSEG - 1) * 128 + 16 * dt + 4 * q + r) * 128] = S[dt][r];
        __syncthreads();
    }
}

DI void p_scan3(Frame& F, int l) {
    constexpr bool FULL = true;
    const int wave = F.wave;
    const bool is_loader = wave >= 4;
    const int wv = wave & 3;
    for (int job = F.vcu; job < BATCH * GH * NSEG * 2; job += F.G) {
        const int bh = job >> 4, seg = (job >> 1) & (NSEG - 1), dvbase = (job & 1) * 64, n0 = seg * SEGC, b = bh >> 2, h = bh & 3;
        const size_t it0 = (size_t)bh * NCH;
        SC_ADDR()
        if (is_loader) { SC_LOADER_LOOP(); }
        else {
            int tc_ = F.tid; asm volatile("" : "+v"(tc_)); const int lane = tc_ & 63, m = lane & 15, q = lane >> 4;
            f32x4 Sacc[8];
            if (seg == 0) {
#pragma unroll
                for (int dt = 0; dt < 8; ++dt) Sacc[dt] = (f32x4){0.f, 0.f, 0.f, 0.f};
            } else { const float* sst = WSF(WS_SST) + ((size_t)(bh * NSEG + seg) * 128) * 128 + dvbase + 16 * wv + m;
#pragma unroll
                for (int dt = 0; dt < 8; ++dt)
#pragma unroll
                    for (int r = 0; r < 4; ++r) Sacc[dt][r] = sst[(size_t)(16 * dt + 4 * q + r) * 128]; }
            const float glv = WSF(WS_GL)[it0 + lane];
            __syncthreads();
#define FR_W(dst, mt_) do { _Pragma("unroll") for (int kb = 0; kb < 4; ++kb) { dst[kb] = ld128(B + SC_W + (16 * (mt_) + m) * 288 + (32 * kb + 8 * q) * 2); dst[4 + kb] = ld128(B + SC_QD + (16 * (mt_) + m) * 288 + (32 * kb + 8 * q) * 2); } } while (0)
#define MM_W(src, mt_) do { _Pragma("unroll") for (int kb = 0; kb < 4; ++kb) { vn[mt_] = MFMA16(src[kb], Sb[kb], vn[mt_]); o[mt_] = MFMA16(src[4 + kb], Sb[kb], o[mt_]); } } while (0)
#define FR_KT(dst, hf_) do { _Pragma("unroll") for (int i = 0; i < 8; ++i) dst[i] = ld128(B + SC_KT + (16 * (4 * (hf_) + (i >> 1)) + m) * 160 + (32 * (i & 1) + 8 * q) * 2); } while (0)
#define MM_KT(src, hf_) do { _Pragma("unroll") for (int i = 0; i < 8; ++i) Sacc[4 * (hf_) + (i >> 1)] = MFMA16(src[i], vnb[i & 1], Sacc[4 * (hf_) + (i >> 1)]); } while (0)
#pragma unroll 1
            for (int j = 0; j < SEGC; ++j) {
                const int n = n0 + j;
                const LAS unsigned char* B = F.lds + (j & 1) * SC_STAGE;
                bf16x8 fa[8], fb[8], Sb[4], vnb[2];
                f32x4 vn[4], o[4];
                v2u ut[4];
#pragma unroll
                for (int mt = 0; mt < 4; ++mt) ut[mt] = *(const LAS v2u*)(B + SC_U + (16 * wv + m) * 144 + (16 * mt + 4 * q) * 2);
                FR_W(fa, 0); SBAR_();
#pragma unroll
                for (int kb = 0; kb < 4; ++kb) Sb[kb] = pack8(Sacc[2 * kb], Sacc[2 * kb + 1]);
#pragma unroll
                for (int mt = 0; mt < 4; ++mt) { o[mt] = (f32x4){0.f, 0.f, 0.f, 0.f}; vn[mt] = (f32x4){bflo(ut[mt].x), bfhi(ut[mt].x), bflo(ut[mt].y), bfhi(ut[mt].y)}; }
                const float gl = __builtin_bit_cast(float, __builtin_amdgcn_readlane(__builtin_bit_cast(int, glv), n));
                SBAR_(); FR_W(fb, 1); SBAR_(); MM_W(fa, 0); SBAR_();
                FR_W(fa, 2); SBAR_(); MM_W(fb, 1); SBAR_();
                FR_W(fb, 3); SBAR_(); MM_W(fa, 2); SBAR_();
                fa[0] = ld128(B + SC_AT + (m) * 160 + (8 * q) * 2); fa[1] = ld128(B + SC_AT + (16 + m) * 160 + (8 * q) * 2);
                fa[2] = ld128(B + SC_AT + (32 + m) * 160 + (8 * q) * 2); fa[3] = ld128(B + SC_AT + (32 + m) * 160 + (32 + 8 * q) * 2);
                fa[4] = ld128(B + SC_AT + (48 + m) * 160 + (8 * q) * 2); fa[5] = ld128(B + SC_AT + (48 + m) * 160 + (32 + 8 * q) * 2);
                SBAR_(); MM_W(fb, 3); SBAR_();
                vnb[0] = pack8(vn[0], vn[1]); vnb[1] = pack8(vn[2], vn[3]);
#pragma unroll
                for (int dt = 0; dt < 8; ++dt) Sacc[dt] = Sacc[dt] * gl;
                SBAR_(); FR_KT(fb, 0); SBAR_();
                o[0] = MFMA16(fa[0], vnb[0], o[0]); o[1] = MFMA16(fa[1], vnb[0], o[1]); o[2] = MFMA16(fa[2], vnb[0], o[2]); o[3] = MFMA16(fa[4], vnb[0], o[3]);
                o[2] = MFMA16(fa[3], vnb[1], o[2]); o[3] = MFMA16(fa[5], vnb[1], o[3]);
                SBAR_(); FR_KT(fa, 1); SBAR_(); MM_KT(fb, 0); SBAR_();
                MM_KT(fa, 1); SBAR_();
                float* go = WSF(WS_GO) + (size_t)(b * SEQ + n * CH + 4 * q) * GDNW + h * HD + dvbase + 16 * wv + m;
#pragma unroll
                for (int mt = 0; mt < 4; ++mt)
#pragma unroll
                    for (int r = 0; r < 4; ++r) go[(size_t)(16 * mt + r) * GDNW] = o[mt][r];
                WG_BAR();
            }
#undef FR_W
#undef MM_W
#undef FR_KT
#undef MM_KT
        }
        __syncthreads();
    }
}
#undef SC_ADDR
#undef SC_LOAD
#undef SC_WRITE
#undef SC_LOADER_LOOP

DI float gelu_fast(float x) { const float u2 = 1.5957691216057308f * (x + 0.044715f * x * x * x); return x * rcp_(1.f + exp_fast(-u2)); }
struct PostRow { v4u hp[2]; v2u y2[2], z2[2]; f32x4 go[2], cr[2]; };
DI void post_load(Frame& F, PostRow& R, int m, int lane) {
    const int b = m >> 12, n = (m & (SEQ - 1)) >> 6;
#pragma unroll
    for (int j = 0; j < 2; ++j) { const int c = 4 * lane + 256 * j;
        R.hp[j] = *(const v4u*)((const unsigned*)(F.A->ws + WS_H) + (size_t)m * LRUW + c);
        R.cr[j] = *(const f32x4*)(WSF(WS_CARRY) + ((size_t)(b * NCH + n)) * LRUW + c);
        R.y2[j] = *(const v2u*)(WSH(WS_PROJ) + (size_t)m * NPROJ + O_LY + c);
        R.go[j] = *(const f32x4*)(WSF(WS_GO) + (size_t)m * GDNW + c);
        R.z2[j] = *(const v2u*)(WSH(WS_PROJ) + (size_t)m * NPROJ + O_Z + c); }
}
DI void p_post(Frame& F, int l) {
    const int gw = F.vcu * NWAVES + F.wave, NGW = F.G * NWAVES, lane = F.lane;
    PostRow R;
    if (gw < M) post_load(F, R, gw, lane);
    for (int m = gw; m < M; m += NGW) {
        PostRow Rn; const int mn = m + NGW;
        post_load(F, Rn, mn < M ? mn : m, lane);
        f32x4 val[2]; float ss = 0.f;
#pragma unroll
        for (int j = 0; j < 2; ++j) { const v4u hp = R.hp[j]; const v2u y2 = R.y2[j];
            const f32x4 hl = (f32x4){bflo(hp.x), bflo(hp.y), bflo(hp.z), bflo(hp.w)}, p = (f32x4){bfhi(hp.x), bfhi(hp.y), bfhi(hp.z), bfhi(hp.w)};
            const f32x4 hh = hl + p * R.cr[j];
            val[j] = (f32x4){hh.x * gelu_fast(bflo(y2.x)), hh.y * gelu_fast(bfhi(y2.x)), hh.z * gelu_fast(bflo(y2.y)), hh.w * gelu_fast(bfhi(y2.y))};
            ss += (val[j].x * val[j].x + val[j].y * val[j].y) + (val[j].z * val[j].z + val[j].w * val[j].w); }
        ss = wave_sum_(lane, ss);
        const float rl = 1.0f / sqrtf(ss * (1.0f / LRUW) + EPS);
#pragma unroll
        for (int j = 0; j < 2; ++j) { const int c = 4 * lane + 256 * j; const f32x4 nw = *(const f32x4*)(LRU_NORM_W + (size_t)l * LRUW + c);
            const f32x4 o = val[j] * rl * nw; v2u w; w.x = pk2(o.x, o.y); w.y = pk2(o.z, o.w); *(v2u*)(WSH(WS_MIX) + (size_t)m * D + c) = w; }
#pragma unroll
        for (int j = 0; j < 2; ++j) { const int c = 4 * lane + 256 * j, d = c & (HD - 1);
            const f32x4 o = R.go[j]; const v2u z2 = R.z2[j];
            const float s2 = half_sum_(lane, (o.x * o.x + o.y * o.y) + (o.z * o.z + o.w * o.w));
            const float rg = 1.0f / sqrtf(s2 * (1.0f / HD) + EPS);
            const f32x4 nw = *(const f32x4*)(GDN_NORM_W + (size_t)l * HD + d);
            const f32x4 r = (f32x4){o.x * rg * nw.x * silu_fast(bflo(z2.x)), o.y * rg * nw.y * silu_fast(bfhi(z2.x)), o.z * rg * nw.z * silu_fast(bflo(z2.y)), o.w * rg * nw.w * silu_fast(bfhi(z2.y))};
            v2u w; w.x = pk2(r.x, r.y); w.y = pk2(r.z, r.w); *(v2u*)(WSH(WS_MIX) + (size_t)m * D + LRUW + c) = w; }
        R = Rn;
    }
}

typedef _Float16 h16x4 __attribute__((ext_vector_type(4)));
DI void final_row(Frame& F, const _Float16* xrow, float* orow, int lane) {
    f32x4 v[4]; float ss = 0.f;
#pragma unroll
    for (int j = 0; j < 4; ++j) { const h16x4 hv = *(const h16x4*)(xrow + 4 * lane + 256 * j); v[j] = (f32x4){(float)hv[0], (float)hv[1], (float)hv[2], (float)hv[3]};
        ss += (v[j].x * v[j].x + v[j].y * v[j].y) + (v[j].z * v[j].z + v[j].w * v[j].w); }
    ss = wave_sum_(lane, ss);
    const float rstd = 1.0f / sqrtf(ss * (1.0f / D) + EPS);
#pragma unroll
    for (int j = 0; j < 4; ++j) { const int col = 4 * lane + 256 * j; const f32x4 nw = *(const f32x4*)(FINAL_NORM_W + col); *(f32x4*)(orow + col) = v[j] * rstd * nw; }
}
DI void p_final_a(Frame& F) {
    const int gw = F.vcu * NWAVES + F.wave, NGW = F.G * NWAVES, lane = F.lane;
    const _Float16* x16 = (const _Float16*)((const unsigned char*)OUT_ + X16_OFF);
    for (int m = gw; m < M; m += NGW) {
        if (m < M / 2) final_row(F, x16 + (size_t)m * D, OUT_ + (size_t)m * D, lane);
        else { const v4u* src = (const v4u*)(x16 + (size_t)m * D); v4u* dst = (v4u*)((_Float16*)(F.A->ws + WS_XT) + (size_t)(m - M / 2) * D); dst[lane] = src[lane]; dst[lane + 64] = src[lane + 64]; }
    }
}
DI void p_final_b(Frame& F) {
    const int gw = F.vcu * NWAVES + F.wave, NGW = F.G * NWAVES, lane = F.lane;
    for (int m = M / 2 + gw; m < M; m += NGW) final_row(F, (const _Float16*)(F.A->ws + WS_XT) + (size_t)(m - M / 2) * D, OUT_ + (size_t)m * D, lane);
}

__device__ __forceinline__ void pg8::EpiMulti::operator()(const f32x4 (&acc)[2][2][4][2], const Unit& u, int wr, int wc, int fr, int fq, int ui) const {
    const PG8_LAS float* rtab = ui < 4 ? rt + ui * 256 : nullptr;
    const __attribute__((address_space(4))) Args* ap = (const __attribute__((address_space(4))) Args*)__builtin_amdgcn_kernarg_segment_ptr(); asm volatile("" : "+s"(ap));
    unsigned char* ws = ap->ws;
    const int b = (u.pm * BM) / SEQ;
    if (mode == 0) { EpiBf16<0> e{(bf16_t*)(ws + WS_PROJ), NPROJ, nullptr, 0, 0, 1.f, nullptr, nullptr}; e(acc, u, wr, wc, fr, fq); }
    else if (mode == 5) { EpiBf16<0> e{(bf16_t*)(ws + WS_PROJ), NPROJ, (const float*)(ws + WS_C1) + ((size_t)l * BATCH + b) * NPROJ, 0, 0, 1.f, rtab, (const float*)(ws + WS_RS1)}; e(acc, u, wr, wc, fr, fq); }
    else if (mode == 6) { EpiBf16<2> e{(bf16_t*)(ws + WS_ACT), FF, (const float*)(ws + WS_C2) + ((size_t)l * BATCH + b) * FF, 0, 0, 1.f, rtab, (const float*)(ws + WS_RS2)}; e(acc, u, wr, wc, fr, fq); }
    else if (mode == 3) { const float* modb = (const float*)(ws + WS_MOD) + ((size_t)l * BATCH + b) * NMODC; _Float16* x16 = (_Float16*)((unsigned char*)ap->out + X16_OFF);
        EpiResid2 r{ap->in[0], l == 0 ? nullptr : x16, x16, modb + 2 * D, ap->in[3] + (size_t)l * D, modb + 4 * D, (bf16_t*)(ws + WS_H), (float*)(ws + WS_RS2)}; r(acc, u, wr, wc, fr, fq); }
    else { const float* modb = (const float*)(ws + WS_MOD) + ((size_t)l * BATCH + b) * NMODC; const bool nx = l + 1 < DEPTH; _Float16* x16 = (_Float16*)((unsigned char*)ap->out + X16_OFF);
        EpiResid2 r{nullptr, x16, x16, modb + 5 * D, nx ? ap->in[2] + (size_t)(l + 1) * D : nullptr, modb + NMODC * BATCH + D, (bf16_t*)(ws + WS_A1), (float*)(ws + WS_RS1)}; r(acc, u, wr, wc, fr, fq); }
}

__global__ void __launch_bounds__(NWAVES * 64, 2) mk_fwd(Args args) {
    extern __shared__ __attribute__((aligned(16))) unsigned char lds[];
    Frame F;
    F.lds = (LAS unsigned char*)lds;
    F.MISC = (volatile LAS unsigned*)(F.lds + MISC_OFF);
    F.tid = threadIdx.x; F.lane = F.tid & 63; F.wave = __builtin_amdgcn_readfirstlane(F.tid >> 6);
    F.G = gridDim.x; { const int bx = blockIdx.x; F.vcu = (F.G % 8 == 0) ? (bx % 8) * (F.G / 8) + bx / 8 : bx; }
    F.A = (const __attribute__((address_space(4))) Args*)__builtin_amdgcn_kernarg_segment_ptr();
    F.ctl = (gu32*)(F.A->ws + WS_CTL);
    for (int u = F.tid; u < (LDS_BYTES - LDSCTL_OFF) / 4; u += NWAVES * 64) ((LAS unsigned*)(F.lds + LDSCTL_OFF))[u] = 0u;
    __syncthreads();
    XcdBarrier bar; bar.bar = (unsigned*)(F.ctl + CW_BAR); bar.x = 0; bar.st = nullptr;
    if (N_LAUNCHES == 1) bar = xcd_barrier_post((unsigned*)(F.ctl + CW_BAR), F.MISC + 8);

    const int lo = F.A->ph_lo, hi = F.A->ph_hi;
    int rep_done = 0;
#pragma unroll 1
    for (int s = lo; s < hi; ++s) {
        { const __attribute__((address_space(4))) Args* ap = (const __attribute__((address_space(4))) Args*)__builtin_amdgcn_kernarg_segment_ptr(); asm volatile("" : "+s"(ap)); F.A = ap; }
        { int t_ = threadIdx.x; asm volatile("" : "+v"(t_)); F.tid = t_; F.lane = t_ & 63; F.wave = __builtin_amdgcn_readfirstlane(t_ >> 6); }
        if (s == 0) { if (PH_MASK & 1) { p_mod(F); __syncthreads(); p0_weights(F); xcd_barrier(bar, F.tid == 0); p_cvec(F); __syncthreads(); p_normmod<true>(F, 0, X_IN, NORM_MIX_W, 0, D); } }
        else if (s == N_STEPS - 1) { if (PH_MASK & 2) { p_final_a(F); xcd_barrier(bar, F.tid == 0); p_final_b(F); } }
        else {
            const int l = (s - 1) / 9, i = (s - 1) % 9;
            if (i == 0 || i == 6) continue;
            bf16* wl = WSH(WS_W) + (size_t)l * LAYER_W;
            const float* modl = WSF(WS_MOD) + (size_t)l * BATCH * NMODC;
            if (!((PH_MASK >> (2 + i)) & 1)) {}
            else if (i == 0) { p_normmod<true>(F, l, l == 0 ? X_IN : OUT_, NORM_MIX_W, 0, D); }
            else if (i == 2) { p_prep(F, l); }
            else if (i == 3) {
                p_scan1(F, l); xcd_barrier(bar, F.tid == 0);
#if defined(SCAN_REP) && SCAN_REP == 1
                p_scan1(F, l); xcd_barrier(bar, F.tid == 0);
#endif
                p_scan2(F, l); xcd_barrier(bar, F.tid == 0);
#if defined(SCAN_REP) && SCAN_REP == 2
                p_scan2(F, l); xcd_barrier(bar, F.tid == 0);
#endif
                p_scan3(F, l);
#if defined(SCAN_REP) && SCAN_REP == 3
                xcd_barrier(bar, F.tid == 0); p_scan3(F, l);
#endif
            }
            else if (i == 4) { p_post(F, l); }
            else if (i == 6) { p_normmod<false>(F, l, OUT_, NORM_MLP_W, 3 * D, 4 * D); }
            else {
                pg8::Gemm g; pg8::EpiMulti E; E.l = l; E.rt = (const LAS float*)(F.lds + RSTAB_OFF);
                if (i == 1) { g = pg8::Gemm{l == 0 ? WSH(WS_H) : WSH(WS_A1), wl, M, NPROJ, D}; E.PERM = true; E.mode = (l == 0 ? 0 : 5); }
                else if (i == 5) { g = pg8::Gemm{WSH(WS_MIX), wl + W_OUT_OFF, M, D, D}; E.PERM = true; E.mode = 3; }
                else if (i == 7) { g = pg8::Gemm{WSH(WS_H), wl + W_UP_OFF, M, FF, D}; E.PERM = true; E.mode = 6; }
                else { g = pg8::Gemm{WSH(WS_ACT), wl + W_DOWN_OFF, M, D, FF}; E.PERM = true; E.mode = 4; }
                pg8::StaticOrder S; S.init(g.M, g.N, F.G, (int)blockIdx.x);
                if (E.mode == 5 || E.mode == 6) {
                    LAS float* tab = (LAS float*)(F.lds + RSTAB_OFF); const float* rsp = WSF(E.mode == 5 ? WS_RS1 : WS_RS2);
                    const int slot = F.tid >> 7; pg8::Unit uu;
                    if (S.next(slot, uu)) for (int rr = F.tid & 127; rr < 256; rr += 128) { const f32x4* rp = (const f32x4*)(rsp + (size_t)(uu.pm * 256 + rr) * 16);
                        const f32x4 p0 = rp[0], p1 = rp[1], p2 = rp[2], p3 = rp[3], ts = (p0 + p1) + (p2 + p3);
                        tab[slot * 256 + rr] = 1.0f / sqrtf(((ts[0] + ts[1]) + (ts[2] + ts[3])) * (1.0f / D) + EPS); }
                    __syncthreads(); }
                pg8::gemm_phase<pg8::EpiMulti, pg8::StaticOrder, PG8_ALIGN, PG8_SP2>(F.lds + RING_OFF, g, S, E);
            }
        }
        if (REP_MASK != 0 && ((s >= 1 && s < N_STEPS - 1 && ((REP_MASK >> ((s - 1) % 9)) & 1)) || (s == 0 && (REP_MASK & 0x10000))) && !rep_done) { rep_done = 1; --s; xcd_barrier(bar, F.tid == 0); continue; }
        rep_done = 0;
        if (s + 1 < hi) xcd_barrier(bar, F.tid == 0);
#ifdef PROBE_XBAR
        if (s >= 1 && s < N_STEPS - 1) { xcd_barrier(bar, F.tid == 0); xcd_barrier(bar, F.tid == 0); }
#endif
    }
}

extern "C" void kernel_launch(void* const* d_in, const int* in_sizes, int n_in, void* d_out, int out_size, void* d_ws, size_t ws_size, hipStream_t stream) {
    static int grid = 0;
    if (grid == 0) {
        if (n_in != 23 || in_sizes[0] != M * D || out_size != M * D || ws_size < WS_END) { fprintf(stderr, "kernel_launch: unexpected shapes (n_in %d, in0 %d, out %d, ws %zu); nothing launched\n", n_in, n_in > 0 ? in_sizes[0] : -1, out_size, ws_size); grid = -1; return; }
        int dev = 0, cus = 0;
        if (hipGetDevice(&dev) != hipSuccess || hipDeviceGetAttribute(&cus, hipDeviceAttributeMultiprocessorCount, dev) != hipSuccess) { grid = -1; return; }
        if (hipFuncSetAttribute((const void*)mk_fwd, hipFuncAttributeMaxDynamicSharedMemorySize, LDS_BYTES) != hipSuccess) { fprintf(stderr, "kernel_launch: hipFuncSetAttribute failed\n"); grid = -1; return; }
        (void)hipGetLastError();
        grid = cus;
    }
    if (grid < 0) return;
    if (hipMemsetAsync((char*)d_ws + WS_CTL, 0, CTL_ZERO_BYTES, stream) != hipSuccess) return;
    Args a{};
    for (int i = 0; i < 23; ++i) a.in[i] = (const float*)d_in[i];
    a.out = (float*)d_out; a.ws = (unsigned char*)d_ws;
    if (N_LAUNCHES == 1) { a.ph_lo = 0; a.ph_hi = N_STEPS; hipLaunchKernelGGL(mk_fwd, dim3(grid), dim3(NWAVES * 64), LDS_BYTES, stream, a); }
    else for (int s = 0; s < N_STEPS; ++s) { a.ph_lo = s; a.ph_hi = s + 1; hipLaunchKernelGGL(mk_fwd, dim3(grid), dim3(NWAVES * 64), LDS_BYTES, stream, a); }
}
```

```cpp
#include <hip/hip_runtime.h>
#include <cstdio>
#include <cstdint>
#include <cmath>
namespace pg8 {
#define PG8_LAS __attribute__((address_space(3)))
typedef unsigned short bf16_t;
typedef short bf16x8 __attribute__((ext_vector_type(8)));
typedef float f32x4 __attribute__((ext_vector_type(4)));
typedef unsigned u32x4 __attribute__((ext_vector_type(4)));
constexpr int BM = 256, BK = 64, HALF = 128, HTB = HALF * BK * 2  , STAGE_BYTES = 8 * HTB, NXCD = 8, WGM = 8;

__host__ __device__ __forceinline__ int lds_byte(int r, int c) { const int st = (r >> 4) * 2 + (c >> 5), rr = r & 15, cc = c & 31, ob = rr * 64 + cc * 2; return st * 1024 + (ob ^ (((ob >> 9) & 1) << 5)); }
__host__ __device__ __forceinline__ void stage_rc(int b, int& R, int& C) { const int st = b / 1024, sb = b % 1024, swz = sb ^ (((sb >> 9) & 1) << 5); R = (st >> 1) * 16 + swz / 64; C = (st & 1) * 32 + (swz % 64) / 2; }
__host__ __device__ __forceinline__ int perm32(int rho) { const int n = rho >> 4, i = rho & 15; return 8 * (i >> 2) + 4 * n + (i & 3); }

struct Unit { int pm, pn; };
struct Gemm { const bf16_t* A; const bf16_t* Bt; int M, N, K; };

struct StaticOrder {
    int nM, nN, nwg, G, c;
    __host__ __device__ void init(int M, int N, int G_, int c_) { nM = M / BM; nN = N / BM; nwg = nM * nN; G = G_; c = c_; }
    __host__ __device__ bool next(int i, Unit& u) const {
        const long L = (long)i * G + c; if (L >= nwg) return false;
        int wgid = (int)L; { const int q = nwg / NXCD, r = nwg % NXCD, xcd = wgid % NXCD, off = wgid / NXCD; wgid = (xcd < r ? xcd * (q + 1) : r * (q + 1) + (xcd - r) * q) + off; }
        const int nig = WGM * nN, gid = wgid / nig, fm = gid * WGM, gsz = (nM - fm) < WGM ? (nM - fm) : WGM;
        u.pm = fm + ((wgid % nig) % gsz); u.pn = (wgid % nig) / gsz; return true;
    }
    __device__ __forceinline__ void a_ready(const Unit&) const {}
    __device__ __forceinline__ void done(const Unit&) const {}
};

__device__ __forceinline__ unsigned cvt_pk_bf16(float lo, float hi) { unsigned r; asm volatile("v_cvt_pk_bf16_f32 %0, %1, %2" : "=v"(r) : "v"(lo), "v"(hi)); return r; }
typedef float f32x2 __attribute__((ext_vector_type(2)));
__device__ __forceinline__ f32x2 gelu_pk(f32x2 v) {
    const f32x2 av = __builtin_elementwise_abs(v), d = av * 0.2316418882f + 1.0f;
    f32x2 t; t.x = __builtin_amdgcn_rcpf(d.x); t.y = __builtin_amdgcn_rcpf(d.y);
    f32x2 q = t * 0.5307027145f + (-0.7265760135f); q = q * t + 0.7107068705f; q = q * t + (-0.142248368f); q = q * t + 0.127414796f; q = q * t;
    const f32x2 s = (v * v) * (-0.72134752044f);
    f32x2 e; e.x = __builtin_amdgcn_exp2f(s.x); e.y = __builtin_amdgcn_exp2f(s.y);
    const f32x2 m = v * (q * e), r = v - m;
    f32x2 o; o.x = v.x < 0.f ? m.x : r.x; o.y = v.y < 0.f ? m.y : r.y; return o;
}

template <int ACT  > struct EpiBf16 {
    static constexpr bool PERM = true, AFTER_DRAIN = false; static_assert(ACT == 0 || ACT == 1 || ACT == 2, "EpiBf16: ACT is 0 (none), 1 (gelu_pk) or 2 (squared relu)");
    bf16_t* O; int ldc; const float* bias; int split_cols; size_t split_stride; float scale0;
    const PG8_LAS float* rtab = nullptr;
    const float* rs = nullptr;
    __device__ __forceinline__ void operator()(const f32x4 (&acc)[2][2][4][2], const Unit& u, int wr, int wc, int fr, int fq) const {
        const int row0 = u.pm * BM + wr * 64 + fr; int colt = u.pn * BM; bf16_t* base = O;
        float sc = 1.f; if (split_cols) { const int t = colt / split_cols; base += (size_t)t * split_stride; colt -= t * split_cols; if (t == 0) sc = scale0; }
        const int col0 = colt + wc * 32 + 8 * fq, bcol0 = u.pn * BM + wc * 32 + 8 * fq;
        f32x4 bv[2][2];
#pragma unroll
        for (int bj = 0; bj < 2; ++bj)
#pragma unroll
            for (int n = 0; n < 2; ++n) bv[bj][n] = bias ? *(const f32x4*)(bias + bcol0 + bj * HALF + 4 * n) : (f32x4){0.f, 0.f, 0.f, 0.f};
#pragma unroll
        for (int ai = 0; ai < 2; ++ai)
#pragma unroll
            for (int m = 0; m < 4; ++m) { bf16_t* rowp = base + (size_t)(row0 + ai * HALF + m * 16) * ldc + col0;
                float rsc = 1.f;
                if (rtab) rsc = rtab[wr * 64 + fr + ai * HALF + m * 16];
                else if (rs) { const f32x4* rp = (const f32x4*)(rs + (size_t)(row0 + ai * HALF + m * 16) * 16); const f32x4 p0 = rp[0], p1 = rp[1], p2 = rp[2], p3 = rp[3];
                    const f32x4 t = (p0 + p1) + (p2 + p3); rsc = 1.0f / sqrtf(((t[0] + t[1]) + (t[2] + t[3])) * (1.0f / 1024.0f) + 1e-6f); }
#pragma unroll
                for (int bj = 0; bj < 2; ++bj) { f32x4 v0 = acc[ai][bj][m][0] * rsc + bv[bj][0], v1 = acc[ai][bj][m][1] * rsc + bv[bj][1];
                    if (ACT == 1) { f32x2 a = gelu_pk((f32x2){v0[0], v0[1]}), b = gelu_pk((f32x2){v0[2], v0[3]}), c = gelu_pk((f32x2){v1[0], v1[1]}), d = gelu_pk((f32x2){v1[2], v1[3]});
                        v0 = (f32x4){a.x, a.y, b.x, b.y}; v1 = (f32x4){c.x, c.y, d.x, d.y}; }
                    if (ACT == 2) { _Pragma("unroll") for (int q_ = 0; q_ < 4; ++q_) { const float a_ = fmaxf(v0[q_], 0.f), b_ = fmaxf(v1[q_], 0.f); v0[q_] = a_ * a_; v1[q_] = b_ * b_; } }
                    v0 = v0 * sc; v1 = v1 * sc; u32x4 w; w.x = cvt_pk_bf16(v0[0], v0[1]); w.y = cvt_pk_bf16(v0[2], v0[3]); w.z = cvt_pk_bf16(v1[0], v1[1]); w.w = cvt_pk_bf16(v1[2], v1[3]);
                    *(u32x4*)(rowp + bj * HALF) = w; } }
    }
};


struct EpiResid {
    static constexpr bool PERM = false, AFTER_DRAIN = false;
    const float* base; float* out; const float* gate; int ldc; int gate_stride; int rows_per_batch;
    __device__ __forceinline__ void operator()(const f32x4 (&acc)[2][2][4][2], const Unit& u, int wr, int wc, int fr, int fq) const {
        const int col0 = u.pn * BM + wc * 32 + 4 * fq;
        const float* gp = gate + (size_t)((u.pm * BM) / rows_per_batch) * gate_stride + col0;
        f32x4 gv[2][2];
#pragma unroll
        for (int bj = 0; bj < 2; ++bj)
#pragma unroll
            for (int n = 0; n < 2; ++n) gv[bj][n] = *(const f32x4*)(gp + bj * HALF + n * 16);
#pragma unroll
        for (int ai = 0; ai < 2; ++ai)
#pragma unroll
            for (int m = 0; m < 4; ++m) { const size_t off = (size_t)(u.pm * BM + ai * HALF + wr * 64 + m * 16 + fr) * ldc + col0;
#pragma unroll
                for (int bj = 0; bj < 2; ++bj)
#pragma unroll
                    for (int n = 0; n < 2; ++n) { const f32x4 bs = *(const f32x4*)(base + off + bj * HALF + n * 16);
                        *(f32x4*)(out + off + bj * HALF + n * 16) = bs + gv[bj][n] * acc[ai][bj][m][n]; } }
    }
};


typedef _Float16 f16x8 __attribute__((ext_vector_type(8)));
typedef _Float16 f16x4 __attribute__((ext_vector_type(4)));
struct EpiResid2 {
    static constexpr bool PERM = true, AFTER_DRAIN = false;
    const float* base32; const _Float16* base16; _Float16* out16; const float* gate;
    const float* nw; const float* sc;
    bf16_t* anext; float* rsum;
    __device__ __forceinline__ void operator()(const f32x4 (&acc)[2][2][4][2], const Unit& u, int wr, int wc, int fr, int fq) const {
        const int col0 = u.pn * BM + wc * 32 + 8 * fq, lane = fr + 16 * fq;
        f32x4 gv[2][2], ns[2][2];
#pragma unroll
        for (int bj = 0; bj < 2; ++bj)
#pragma unroll
            for (int n = 0; n < 2; ++n) { const int c = col0 + bj * HALF + 4 * n; gv[bj][n] = *(const f32x4*)(gate + c);
                ns[bj][n] = nw ? *(const f32x4*)(nw + c) * (*(const f32x4*)(sc + c) + 1.0f) : (f32x4){0.f, 0.f, 0.f, 0.f}; }
#pragma unroll
        for (int ai = 0; ai < 2; ++ai)
#pragma unroll
            for (int m = 0; m < 4; ++m) { const size_t off = (size_t)(u.pm * BM + ai * HALF + wr * 64 + m * 16 + fr) * 1024 + col0;
                f32x4 bs[2][2];
                if (base16) {
                    f16x8 hb[2];
#pragma unroll
                    for (int bj = 0; bj < 2; ++bj) hb[bj] = *(const f16x8*)(base16 + off + bj * HALF);
#pragma unroll
                    for (int bj = 0; bj < 2; ++bj) { bs[bj][0] = (f32x4){(float)hb[bj][0], (float)hb[bj][1], (float)hb[bj][2], (float)hb[bj][3]}; bs[bj][1] = (f32x4){(float)hb[bj][4], (float)hb[bj][5], (float)hb[bj][6], (float)hb[bj][7]}; }
                } else {
#pragma unroll
                    for (int bj = 0; bj < 2; ++bj)
#pragma unroll
                        for (int n = 0; n < 2; ++n) bs[bj][n] = *(const f32x4*)(base32 + off + bj * HALF + 4 * n);
                }
                float ssq = 0.f;
#pragma unroll
                for (int bj = 0; bj < 2; ++bj) { const f32x4 x0 = bs[bj][0] + gv[bj][0] * acc[ai][bj][m][0], x1 = bs[bj][1] + gv[bj][1] * acc[ai][bj][m][1];
                    f16x8 ho; ho[0] = (_Float16)x0[0]; ho[1] = (_Float16)x0[1]; ho[2] = (_Float16)x0[2]; ho[3] = (_Float16)x0[3]; ho[4] = (_Float16)x1[0]; ho[5] = (_Float16)x1[1]; ho[6] = (_Float16)x1[2]; ho[7] = (_Float16)x1[3];
                    *(f16x8*)(out16 + off + bj * HALF) = ho;
                    if (nw) { const f32x4 h0 = x0 * ns[bj][0], h1 = x1 * ns[bj][1]; u32x4 w; w.x = cvt_pk_bf16(h0[0], h0[1]); w.y = cvt_pk_bf16(h0[2], h0[3]); w.z = cvt_pk_bf16(h1[0], h1[1]); w.w = cvt_pk_bf16(h1[2], h1[3]);
                        *(u32x4*)(anext + off + bj * HALF) = w;
                        ssq += ((x0[0] * x0[0] + x0[1] * x0[1]) + (x0[2] * x0[2] + x0[3] * x0[3])) + ((x1[0] * x1[0] + x1[1] * x1[1]) + (x1[2] * x1[2] + x1[3] * x1[3])); } }
                if (nw) { ssq += __builtin_bit_cast(float, __builtin_amdgcn_ds_bpermute((lane ^ 16) << 2, __builtin_bit_cast(int, ssq)));
                    ssq += __builtin_bit_cast(float, __builtin_amdgcn_ds_bpermute((lane ^ 32) << 2, __builtin_bit_cast(int, ssq)));
                    if (fq == 0) rsum[(size_t)(u.pm * BM + ai * HALF + wr * 64 + m * 16 + fr) * 16 + u.pn * 4 + wc] = ssq; }
                if (m & 1) asm volatile("" ::: "memory"); }
    }
};

struct EpiMulti {
    static constexpr bool AFTER_DRAIN = false;
    bool PERM; int mode, l; const PG8_LAS float* rt;
    __device__ __forceinline__ void operator()(const f32x4 (&acc)[2][2][4][2], const Unit& u, int wr, int wc, int fr, int fq, int ui) const;
};

template <class Epi, class Sched, bool ALIGN_EPI = false, bool SP2 = false>
__device__ __forceinline__ void gemm_phase(PG8_LAS unsigned char* lds, const Gemm g, const Sched& S, const Epi& E) {
    int tid_l = threadIdx.x; asm volatile("" : "+v"(tid_l));
    const int tid = tid_l, wid = __builtin_amdgcn_readfirstlane(tid >> 6), lane = tid & 63, wr = wid >> 2, wc = wid & 3, fr = lane & 15, fq = lane >> 4;
    const int K = g.K, nt = K / BK;
    unsigned voffA[2], voffB[2];
#pragma unroll
    for (int i = 0; i < 2; ++i) { int R, C; stage_rc(tid * 16 + i * 8192, R, C); const int Rb = E.PERM ? ((R & ~31) + perm32(R & 31)) : R;
        voffA[i] = (unsigned)(R * K + C) * 2u; voffB[i] = (unsigned)(Rb * K + C) * 2u; }
    const size_t kstep = (size_t)(BK * 2);
    const size_t hstep = (size_t)HALF * K * 2;
    const size_t tstep = 2 * hstep;
    const unsigned ldsw = (unsigned)wid * 1024u;
    const int aoff = lds_byte(wr * 64 + fr, fq * 8), boff = lds_byte(wc * 32 + fr, fq * 8);
#define PG8_SA(b, h) (((b) * 2 + (h)) * HTB)
#define PG8_SB(b, h) ((4 + (b) * 2 + (h)) * HTB)
#define PG8_STAGE(bufoff, gbase, voff) do { _Pragma("unroll") for (int _i = 0; _i < 2; ++_i) \
        __builtin_amdgcn_global_load_lds((const unsigned*)((const char*)(gbase) + (voff)[_i]), (PG8_LAS unsigned*)(lds + (bufoff) + ldsw + _i * 8192), 16, 0, 0); } while (0)
#define PG8_LDA(dst, b, h) do { _Pragma("unroll") for (int m = 0; m < 4; ++m) _Pragma("unroll") for (int k = 0; k < 2; ++k) dst[m][k] = *(const PG8_LAS bf16x8*)(lds + PG8_SA(b, h) + aoff + m * 2048 + k * 1024); } while (0)
#define PG8_LDB(dst, b, h) do { _Pragma("unroll") for (int n = 0; n < 2; ++n) _Pragma("unroll") for (int k = 0; k < 2; ++k) dst[n][k] = *(const PG8_LAS bf16x8*)(lds + PG8_SB(b, h) + boff + n * 2048 + k * 1024); } while (0)
#define PG8_MMA(ai, bj, At, Bt) do { __builtin_amdgcn_s_setprio(1); _Pragma("unroll") for (int m = 0; m < 4; ++m) _Pragma("unroll") for (int n = 0; n < 2; ++n) _Pragma("unroll") for (int k = 0; k < 2; ++k) \
        acc[ai][bj][m][n] = __builtin_amdgcn_mfma_f32_16x16x32_bf16(Bt[n][k], At[m][k], acc[ai][bj][m][n], 0, 0, 0); __builtin_amdgcn_s_setprio(0); } while (0)
#define PG8_WAIT_V(n) asm volatile("s_waitcnt vmcnt(" #n ")" ::: "memory")
#define PG8_WAIT_L(n) asm volatile("s_waitcnt lgkmcnt(" #n ")" ::: "memory")
#define PG8_BAR __builtin_amdgcn_s_barrier()
#define PG8_SCHED __builtin_amdgcn_sched_barrier(0)
    Unit cur, nxt; int ui = 0;
    if (!S.next(0, cur)) return;
    f32x4 acc[2][2][4][2];
#pragma unroll
    for (int a = 0; a < 2; ++a)
#pragma unroll
        for (int b = 0; b < 2; ++b)
#pragma unroll
            for (int m = 0; m < 4; ++m)
#pragma unroll
                for (int n = 0; n < 2; ++n) acc[a][b][m][n] = (f32x4){0.f, 0.f, 0.f, 0.f};
    bf16x8 At[4][2], B0[2][2], B1[2][2];
    const char* cA = (const char*)g.A + (size_t)cur.pm * tstep; const char* cB = (const char*)g.Bt + (size_t)cur.pn * tstep;
    S.a_ready(cur);
    if constexpr (SP2) {
        PG8_STAGE(PG8_SB(0, 0), cB, voffB); PG8_STAGE(PG8_SB(0, 1), cB + hstep, voffB); PG8_STAGE(PG8_SA(0, 0), cA, voffA); PG8_STAGE(PG8_SA(0, 1), cA + hstep, voffA);
        if (wr == 1) PG8_BAR;
        PG8_WAIT_V(2); PG8_BAR;
        PG8_STAGE(PG8_SB(1, 0), cB + kstep, voffB); PG8_STAGE(PG8_SA(1, 0), cA + kstep, voffA); PG8_STAGE(PG8_SB(1, 1), cB + hstep + kstep, voffB);
        PG8_WAIT_V(6); PG8_BAR;
    } else {
        PG8_STAGE(PG8_SB(0, 0), cB, voffB); PG8_STAGE(PG8_SA(0, 0), cA, voffA); PG8_STAGE(PG8_SB(0, 1), cB + hstep, voffB); PG8_STAGE(PG8_SA(0, 1), cA + hstep, voffA);
        if (wr == 1) PG8_BAR;
        PG8_WAIT_V(4); PG8_BAR;
        PG8_STAGE(PG8_SB(1, 0), cB + kstep, voffB); PG8_STAGE(PG8_SA(1, 0), cA + kstep, voffA); PG8_STAGE(PG8_SB(1, 1), cB + hstep + kstep, voffB);
        PG8_WAIT_V(6); PG8_BAR;
    }
    for (;;) {
        const bool has_next = S.next(ui + 1, nxt);
        const char* nA = has_next ? (const char*)g.A + (size_t)nxt.pm * tstep : cA; const char* nB = has_next ? (const char*)g.Bt + (size_t)nxt.pn * tstep : cB;
        for (int t = 0; t < nt; t += 2) {
            const bool last = (t == nt - 2);
            const char* a1 = cA + (size_t)(t + 1) * kstep;
            const char* a2 = last ? nA : cA + (size_t)(t + 2) * kstep; const char* b2 = last ? nB : cB + (size_t)(t + 2) * kstep;
            const char* a3 = a2 + kstep; const char* b3 = b2 + kstep;
            if (last && has_next) S.a_ready(nxt);
            if constexpr (SP2) {
            PG8_LDB(B0, 0, 0); PG8_LDB(B1, 0, 1); PG8_SCHED; PG8_LDA(At, 0, 0); PG8_STAGE(PG8_SA(1, 1), a1 + hstep, voffA);
            PG8_WAIT_V(8); PG8_WAIT_L(0); PG8_BAR; PG8_MMA(0, 0, At, B0); PG8_MMA(0, 1, At, B1); PG8_BAR; PG8_SCHED;
            PG8_LDA(At, 0, 1); PG8_STAGE(PG8_SB(0, 0), b2, voffB); PG8_STAGE(PG8_SB(0, 1), b2 + hstep, voffB); PG8_STAGE(PG8_SA(0, 0), a2, voffA);
            PG8_WAIT_V(8); PG8_WAIT_L(0); PG8_BAR; PG8_MMA(1, 0, At, B0); PG8_MMA(1, 1, At, B1); PG8_BAR; PG8_SCHED;
            PG8_LDB(B0, 1, 0); PG8_LDB(B1, 1, 1); PG8_SCHED; PG8_LDA(At, 1, 0); PG8_STAGE(PG8_SA(0, 1), a2 + hstep, voffA);
            PG8_WAIT_V(8); PG8_WAIT_L(0); PG8_BAR; PG8_MMA(0, 0, At, B0); PG8_MMA(0, 1, At, B1); PG8_BAR; PG8_SCHED;
            PG8_LDA(At, 1, 1); PG8_STAGE(PG8_SB(1, 0), b3, voffB); PG8_STAGE(PG8_SB(1, 1), b3 + hstep, voffB); PG8_STAGE(PG8_SA(1, 0), a3, voffA);
            PG8_WAIT_V(8); PG8_WAIT_L(0); PG8_BAR; PG8_MMA(1, 0, At, B0); PG8_MMA(1, 1, At, B1); PG8_BAR; PG8_SCHED;
            } else {
            PG8_LDB(B0, 0, 0); PG8_SCHED; PG8_LDA(At, 0, 0); PG8_STAGE(PG8_SA(1, 1), a1 + hstep, voffA);
            PG8_WAIT_L(8); PG8_BAR; PG8_WAIT_L(0); PG8_MMA(0, 0, At, B0); PG8_BAR; PG8_SCHED;
            PG8_LDB(B1, 0, 1); PG8_STAGE(PG8_SB(0, 0), b2, voffB);
            PG8_BAR; PG8_WAIT_L(0); PG8_MMA(0, 1, At, B1); PG8_BAR;
            PG8_LDA(At, 0, 1); PG8_STAGE(PG8_SA(0, 0), a2, voffA);
            PG8_BAR; PG8_WAIT_L(0); PG8_MMA(1, 0, At, B0); PG8_BAR; PG8_SCHED;
            PG8_STAGE(PG8_SB(0, 1), b2 + hstep, voffB);
            PG8_WAIT_V(6); PG8_BAR; PG8_MMA(1, 1, At, B1); PG8_BAR;
            PG8_LDB(B0, 1, 0); PG8_SCHED; PG8_LDA(At, 1, 0); PG8_STAGE(PG8_SA(0, 1), a2 + hstep, voffA);
            PG8_WAIT_L(8); PG8_BAR; PG8_WAIT_L(0); PG8_MMA(0, 0, At, B0); PG8_BAR; PG8_SCHED;
            PG8_LDB(B1, 1, 1); PG8_STAGE(PG8_SB(1, 0), b3, voffB);
            PG8_BAR; PG8_WAIT_L(0); PG8_MMA(0, 1, At, B1); PG8_BAR;
            PG8_LDA(At, 1, 1); PG8_STAGE(PG8_SA(1, 0), a3, voffA);
            PG8_BAR; PG8_WAIT_L(0); PG8_MMA(1, 0, At, B0); PG8_BAR; PG8_SCHED;
            PG8_STAGE(PG8_SB(1, 1), b3 + hstep, voffB);
            PG8_WAIT_V(6); PG8_BAR; PG8_MMA(1, 1, At, B1); PG8_BAR;
            }
        }
        if constexpr (ALIGN_EPI) { if (wr == 0) PG8_BAR; }
        if constexpr (!Epi::AFTER_DRAIN) { E(acc, cur, wr, wc, fr, fq, ui); S.done(cur); }
        if (!has_next) break;
#pragma unroll
        for (int a = 0; a < 2; ++a)
#pragma unroll
            for (int b = 0; b < 2; ++b)
#pragma unroll
                for (int m = 0; m < 4; ++m)
#pragma unroll
                    for (int n = 0; n < 2; ++n) acc[a][b][m][n] = (f32x4){0.f, 0.f, 0.f, 0.f};
        cur = nxt; cA = nA; cB = nB; ++ui;
        if constexpr (ALIGN_EPI) { if (wr == 1) PG8_BAR; }
    }
    PG8_WAIT_V(0);
    if constexpr (!ALIGN_EPI) { if (wr == 0) PG8_BAR; }
    PG8_BAR;
    if constexpr (Epi::AFTER_DRAIN) { E.fused(acc, cur, wr, wc, fr, fq, lds, wid, lane); S.done(cur); }
#undef PG8_SA
#undef PG8_SB
#undef PG8_STAGE
#undef PG8_LDA
#undef PG8_LDB
#undef PG8_MMA
#undef PG8_WAIT_V
#undef PG8_WAIT_L
#undef PG8_BAR
#undef PG8_SCHED
}
}
#define GAS __attribute__((address_space(1)))
#define LAS __attribute__((address_space(3)))
typedef unsigned short bf16;
typedef unsigned v4u __attribute__((ext_vector_type(4)));
typedef float f32x4 __attribute__((ext_vector_type(4)));
typedef short bf16x8 __attribute__((ext_vector_type(8)));
typedef GAS unsigned gu32;
typedef GAS unsigned long long gu64;
#define RLX_AGENT __ATOMIC_RELAXED, __HIP_MEMORY_SCOPE_AGENT
#define LDS_WAIT() asm volatile("s_waitcnt lgkmcnt(0)" ::: "memory")
#define VM_WAIT() asm volatile("s_waitcnt vmcnt(0)" ::: "memory")
__device__ __forceinline__ unsigned long long rt() { return __builtin_amdgcn_s_memrealtime(); }
__device__ __forceinline__ unsigned f2bf(float f) { unsigned u = __builtin_bit_cast(unsigned, f); return (u + 0x7fffu + ((u >> 16) & 1u)) >> 16; }
__device__ __forceinline__ unsigned pk2(float lo, float hi) { return f2bf(lo) | (f2bf(hi) << 16); }

#define XB_TMO      128
#define XB_XCNT(j)  (256  + 64 * (j))
#define XB_XSUB(j)  (1280 + 64 * (j))
#define XB_XGEN(j)  (2304 + 64 * (j))
#define XB_TOP      3328
#define XB_TOPGEN   3392
#define XCD_BAR_WORDS 3456
#define XB_SPIN_CAP (1u << 18)

__device__ __forceinline__ unsigned xb_ld(unsigned* p)              { return __hip_atomic_load(p, __ATOMIC_RELAXED, __HIP_MEMORY_SCOPE_AGENT); }
__device__ __forceinline__ unsigned xb_add(unsigned* p, unsigned v) { return __hip_atomic_fetch_add(p, v, __ATOMIC_RELAXED, __HIP_MEMORY_SCOPE_AGENT); }
__device__ __forceinline__ unsigned xb_xcc_id() { return (unsigned)__builtin_amdgcn_s_getreg((3 << 11) | 20) & 0xFu; }
#define XB_SPIN(cond, bar) do { unsigned _sp = 0; while (cond) { __builtin_amdgcn_s_sleep(1); \
    if ((++_sp & 255u) == 0u) { if (xb_ld(&(bar)[XB_TMO])) break; if (_sp > XB_SPIN_CAP) { atomicAdd(&(bar)[XB_TMO], 1u); break; } } } } while (0)

struct XcdBarrier {
    unsigned* bar; unsigned x;
    volatile LAS unsigned* st;
};

__device__ __forceinline__ XcdBarrier xcd_barrier_post(unsigned* bar, volatile LAS unsigned* st) {
    XcdBarrier b; b.bar = bar; b.x = xb_xcc_id(); b.st = st;
    if (threadIdx.x == 0) (void)xb_add(&bar[XB_XCNT(b.x)], 1u);
    return b;
}
__device__ __forceinline__ void xcd_barrier_complete(unsigned* bar, unsigned x, unsigned& nloc, unsigned& nx) {
    const unsigned G = gridDim.x * gridDim.y * gridDim.z;
    unsigned sum, cnt, mine, sp = 0u;
    for (;;) {
        sum = 0u; cnt = 0u; mine = 0u;
#pragma unroll
        for (unsigned j = 0; j < 16; ++j) { const unsigned c = xb_ld(&bar[XB_XCNT(j)]); sum += c; cnt += (c > 0u) ? 1u : 0u; mine = (j == x) ? c : mine; }
        if (sum == G) break;
        __builtin_amdgcn_s_sleep(1);
        if ((++sp & 255u) == 0u) { if (xb_ld(&bar[XB_TMO])) break; if (sp > XB_SPIN_CAP) { atomicAdd(&bar[XB_TMO], 1u); break; } }
    }
    nloc = mine > 0u ? mine : 1u; nx = cnt > 0u ? cnt : 1u;
}

__device__ __forceinline__ void xcd_barrier(const XcdBarrier& b, const bool t0  ) {
    asm volatile("s_waitcnt vmcnt(0)" ::: "memory");
    __syncthreads();
    if (t0) {
        unsigned* bar = b.bar;
        __builtin_amdgcn_s_waitcnt(0);
        unsigned nloc = b.st[0], nx = b.st[1];
        if (nloc == 0u) { xcd_barrier_complete(bar, b.x, nloc, nx); b.st[0] = nloc; b.st[1] = nx; }
        const unsigned old = xb_add(&bar[XB_XSUB(b.x)], 1u);
        const unsigned gen = old / nloc;
        if (old + 1u == (gen + 1u) * nloc) {
            __builtin_amdgcn_fence(__ATOMIC_RELEASE, "agent");
            asm volatile("s_waitcnt vmcnt(0)" ::: "memory");
            const unsigned og = xb_add(&bar[XB_TOP], 1u);
            const unsigned tg = og / nx;
            if (og + 1u == (tg + 1u) * nx) xb_add(&bar[XB_TOPGEN], 1u);
            else XB_SPIN(xb_ld(&bar[XB_TOPGEN]) == tg, bar);
            __builtin_amdgcn_fence(__ATOMIC_ACQUIRE, "agent");
            xb_add(&bar[XB_XGEN(b.x)], 1u);
            asm volatile("s_waitcnt vmcnt(0)" ::: "memory");
        } else {
            XB_SPIN(xb_ld(&bar[XB_XGEN(b.x)]) == gen, bar);
            __builtin_amdgcn_fence(__ATOMIC_ACQUIRE, "agent");
            asm volatile("s_waitcnt vmcnt(0)" ::: "memory");
        }
    }
    __syncthreads();
}

#ifndef PG8_SP2
#define PG8_SP2 true
#endif
#ifndef PG8_ALIGN
#define PG8_ALIGN true
#endif
constexpr int NWAVES = 8;
constexpr int N_STEPS = 38;
#ifndef MK_N_LAUNCHES
#define MK_N_LAUNCHES 1
#endif
#ifndef PH_MASK
#define PH_MASK 0xffff
#endif
#ifndef REP_MASK
#define REP_MASK 0
#endif
#ifndef PREP_REP_LRU
#define PREP_REP_LRU 1
#endif
#ifndef PREP_REP_GDN
#define PREP_REP_GDN 1
#endif
constexpr int N_LAUNCHES = MK_N_LAUNCHES;

constexpr int D = 1024, BATCH = 4, SEQ = 4096, DEPTH = 4, M = BATCH * SEQ;
constexpr int LRUW = 512, NGB = 8, GBW = 64, GH = 4, HD = 128, GDNW = 512, CH = 64, NCH = SEQ / CH, FF = 4096;
constexpr int NMODC = 6 * D, INC = 3080, NPROJ = 3072;
constexpr int O_LX = 0, O_LY = 512, O_Q = 1024, O_Z = 2560;
constexpr float EPS = 1e-6f;

constexpr size_t MiB = 1u << 20;
constexpr size_t WS_CTL = 0, CTL_ZERO_BYTES = 1 * MiB;
constexpr size_t WS_MOD = 1 * MiB;
constexpr size_t WS_BG = 2 * MiB;
constexpr size_t WS_AGG = 3 * MiB;
constexpr size_t WS_CARRY = 4 * MiB;
constexpr size_t WS_GL = 5 * MiB;
constexpr size_t WS_GT = 6 * MiB;
constexpr size_t WS_C1 = 6 * MiB + 512 * 1024;
constexpr size_t WS_C2 = 6 * MiB + 768 * 1024;
constexpr size_t WS_CB8 = 7 * MiB;
constexpr size_t WS_W8T = 7 * MiB + 64 * 1024;
constexpr size_t WS_RS1 = 364 * MiB, WS_RS2 = 365 * MiB;
constexpr size_t WS_A1 = 312 * MiB;
constexpr size_t WS_W = 8 * MiB;
constexpr size_t LAYER_W = (size_t)12288 * 1024;
constexpr size_t W_OUT_OFF = (size_t)3072 * 1024, W_UP_OFF = (size_t)4096 * 1024, W_DOWN_OFF = (size_t)8192 * 1024;
constexpr size_t WS_H = 104 * MiB;
constexpr size_t WS_MIX = 136 * MiB;
constexpr size_t WS_PROJ = 168 * MiB;
constexpr size_t WS_ACT = 168 * MiB;
constexpr size_t WS_GQD = 264 * MiB, WS_GKT = 280 * MiB;
constexpr size_t WS_GATT = 296 * MiB;
constexpr size_t WS_GO = 312 * MiB;
constexpr size_t WS_LRUP = 344 * MiB;
constexpr size_t WS_XT = 366 * MiB;
constexpr size_t WS_END = 384 * MiB;
constexpr int CW_BAR = 4096;
constexpr size_t X16_OFF = 32 * MiB;

constexpr int RING_OFF = 0, RING_BYTES = 155648;
constexpr int RSTAB_OFF = 131072;
constexpr int LDSCTL_OFF = RING_BYTES, MISC_OFF = LDSCTL_OFF + 320;
constexpr int LDS_BYTES = 156672;

typedef unsigned v2u __attribute__((ext_vector_type(2)));
#define DI __device__ __forceinline__
DI float bf2f(unsigned b) { return __builtin_bit_cast(float, b << 16); }
DI float bflo(unsigned w) { return __builtin_bit_cast(float, w << 16); }
DI float bfhi(unsigned w) { return __builtin_bit_cast(float, w & 0xffff0000u); }
DI float sigmoidf_(float x) { return 1.f / (1.f + expf(-x)); }
DI float siluf_(float x) { return x / (1.f + expf(-x)); }
DI float rcp_(float x) { return __builtin_amdgcn_rcpf(x); }
DI float exp_fast(float x) { return __builtin_amdgcn_exp2f(x * 1.4426950408889634f); }
DI float sigmoid_fast(float x) { return rcp_(1.f + exp_fast(-x)); }
DI float silu_fast(float x) { return x * rcp_(1.f + exp_fast(-x)); }
DI float log1p_acc(float x) { float ln2 = 0.6931471805599453f; asm volatile("" : "+v"(ln2));
    const float u = 1.0f + x, d = u - 1.0f; return d == 0.f ? x : (__builtin_amdgcn_logf(u) * ln2) * (x * rcp_(d)); }
DI float gelu_tanh(float x) { const float u = 0.7978845608028654f * (x + 0.044715f * x * x * x); return 0.5f * x * (1.f + tanhf(u)); }
DI float bperm_(int src_lane, float v) { return __builtin_bit_cast(float, __builtin_amdgcn_ds_bpermute(src_lane << 2, __builtin_bit_cast(int, v))); }
DI float wave_sum_(int lane, float v) {
#pragma unroll
    for (int o = 1; o < 64; o <<= 1) v += bperm_(lane ^ o, v);
    return v;
}
DI float half_sum_(int lane, float v) {
#pragma unroll
    for (int o = 1; o < 32; o <<= 1) v += bperm_(lane ^ o, v);
    return v;
}
DI float shfl_up_(int lane, float v, int off) { return bperm_(lane >= off ? lane - off : lane, v); }

struct Args { const float* in[23]; float* out; unsigned char* ws; int ph_lo, ph_hi; };
static_assert(sizeof(Args) == 23 * 8 + 8 + 8 + 8, "Args has no padding");
struct Frame {
    LAS unsigned char* lds;
    volatile LAS unsigned* MISC;
    gu32* ctl;
    int tid, lane, wave;
    int vcu, G;
    const __attribute__((address_space(4))) Args* A;
};
#define IN_(k) (F.A->in[k])
#define X_IN IN_(0)
#define C_IN IN_(1)
#define NORM_MIX_W IN_(2)
#define NORM_MLP_W IN_(3)
#define W_MOD IN_(4)
#define B_MOD IN_(5)
#define W_IN IN_(6)
#define LRU_CONV_W IN_(7)
#define LRU_CONV_B IN_(8)
#define GATE_A_W IN_(9)
#define GATE_A_B IN_(10)
#define GATE_X_W IN_(11)
#define GATE_X_B IN_(12)
#define LRU_LAMBDA IN_(13)
#define LRU_NORM_W IN_(14)
#define GDN_CONV_W IN_(15)
#define GDN_A_LOG IN_(16)
#define GDN_DT_BIAS IN_(17)
#define GDN_NORM_W IN_(18)
#define W_OUT IN_(19)
#define W_UP IN_(20)
#define W_DOWN IN_(21)
#define FINAL_NORM_W IN_(22)
#define OUT_ (F.A->out)
#define WSF(off) ((float*)(F.A->ws + (off)))
#define WSH(off) ((bf16*)(F.A->ws + (off)))

DI void p_mod(Frame& F) {
    LAS float* cs = (LAS float*)F.lds;
    LAS float* red = cs + 4096;
    for (int i = F.tid; i < BATCH * D; i += NWAVES * 64) cs[i] = siluf_(C_IN[i]);
    __syncthreads();
    const int hl = F.lane >> 5, cl = F.lane & 31;
    for (int item = F.vcu; item < DEPTH * 192; item += F.G) {
        const int l = item / 192, cg = item % 192, col = cg * 32 + cl, kbase = F.wave * 128 + hl * 64;
        const float* wp = W_MOD + ((size_t)l * D + kbase) * NMODC + col;
        float a0 = 0.f, a1 = 0.f, a2 = 0.f, a3 = 0.f;
#pragma unroll 16
        for (int kk = 0; kk < 64; ++kk) { const float wv = wp[(size_t)kk * NMODC]; const int k = kbase + kk;
            a0 += cs[k] * wv; a1 += cs[1024 + k] * wv; a2 += cs[2048 + k] * wv; a3 += cs[3072 + k] * wv; }
        const int sl = F.wave * 2 + hl;
        red[(sl * 4 + 0) * 32 + cl] = a0; red[(sl * 4 + 1) * 32 + cl] = a1; red[(sl * 4 + 2) * 32 + cl] = a2; red[(sl * 4 + 3) * 32 + cl] = a3;
        __syncthreads();
        if (F.tid < 128) { const int b = F.tid >> 5, ln = F.tid & 31; float sum = 0.f;
#pragma unroll
            for (int w = 0; w < 16; ++w) sum += red[(w * 4 + b) * 32 + ln];
            const int cc = cg * 32 + ln; WSF(WS_MOD)[((size_t)l * BATCH + b) * NMODC + cc] = sum + B_MOD[(size_t)l * NMODC + cc]; }
        __syncthreads();
    }
}

struct TrItem { const float* src; bf16* dst; int K, ldw; };
DI void p0_item(Frame& F, int it, TrItem& T) {
    constexpr int I_IN = (D / 64) * (NPROJ / 32), I_OUT = (D / 64) * (D / 32), I_UP = (D / 64) * (FF / 32), I_DN = (FF / 64) * (D / 32);
    constexpr int PER_LAYER = I_IN + I_OUT + I_UP + I_DN;
    const int l = it / PER_LAYER; int r = it % PER_LAYER; bf16* wl = WSH(WS_W) + (size_t)l * LAYER_W;
    const float* W; int K, ldw, N; bf16* WT;
    if (r < I_IN) { W = W_IN + (size_t)l * D * INC; K = D; ldw = INC; N = NPROJ; WT = wl; }
    else if ((r -= I_IN) < I_OUT) { W = W_OUT + (size_t)l * D * D; K = D; ldw = D; N = D; WT = wl + W_OUT_OFF; }
    else if ((r -= I_OUT) < I_UP) { W = W_UP + (size_t)l * D * FF; K = D; ldw = FF; N = FF; WT = wl + W_UP_OFF; }
    else { r -= I_UP; W = W_DOWN + (size_t)l * FF * D; K = FF; ldw = D; N = D; WT = wl + W_DOWN_OFF; }
    const int nblk = N / 32, kb = r / nblk, nb = r % nblk, k0 = 64 * kb, n0 = 32 * nb;
    T.src = W + (size_t)k0 * ldw + n0; T.dst = WT + (size_t)n0 * K + k0; T.K = K; T.ldw = ldw;
}
DI void p0_weights(Frame& F) {
    LAS float* scr = (LAS float*)(F.lds + RING_OFF + F.wave * 16384);
    const int gw = F.vcu * NWAVES + F.wave, NGW = F.G * NWAVES, lane = F.lane;
    constexpr int NIT = DEPTH * ((D / 64) * (NPROJ / 32) + (D / 64) * (D / 32) + (D / 64) * (FF / 32) + (FF / 64) * (D / 32));
    TrItem T; f32x4 v[8];
    if (gw < NIT) { p0_item(F, gw, T);
#pragma unroll
        for (int i = 0; i < 8; ++i) v[i] = *(const f32x4*)(T.src + (size_t)((lane >> 3) + 8 * i) * T.ldw + 4 * (lane & 7)); }
    for (int it = gw; it < NIT; it += NGW) {
        TrItem Tn; f32x4 vn[8]; const int itn = it + NGW < NIT ? it + NGW : it;
        p0_item(F, itn, Tn);
#pragma unroll
        for (int i = 0; i < 8; ++i) vn[i] = *(const f32x4*)(Tn.src + (size_t)((lane >> 3) + 8 * i) * Tn.ldw + 4 * (lane & 7));
#pragma unroll
        for (int i = 0; i < 8; ++i) { LAS float* d = scr + ((lane >> 3) + 8 * i) * 33 + 4 * (lane & 7); d[0] = v[i].x; d[1] = v[i].y; d[2] = v[i].z; d[3] = v[i].w; }
        LDS_WAIT(); asm volatile("" ::: "memory");
        const int c = lane & 7;
#pragma unroll
        for (int j = 0; j < 4; ++j) { const int n = (lane >> 3) + 8 * j; const LAS float* sp = scr + (8 * c) * 33 + n;
            v4u o; o.x = pk2(sp[0 * 33], sp[1 * 33]); o.y = pk2(sp[2 * 33], sp[3 * 33]); o.z = pk2(sp[4 * 33], sp[5 * 33]); o.w = pk2(sp[6 * 33], sp[7 * 33]);
            *(v4u*)(T.dst + (size_t)n * T.K + 8 * c) = o; }
        LDS_WAIT(); asm volatile("" ::: "memory");
        T = Tn;
#pragma unroll
        for (int i = 0; i < 8; ++i) v[i] = vn[i];
    }
    for (int o = (int)blockIdx.x * NWAVES * 64 + F.tid; o < DEPTH * 16 * 1024; o += (int)gridDim.x * NWAVES * 64) {
        const int k = o & 1023, j = (o >> 10) & 15, l = o >> 14;
        WSH(WS_W8T)[o] = (bf16)(j < 8 ? f2bf(W_IN[((size_t)l * D + k) * INC + NPROJ + j]) : 0u);
    }
    for (int o = (int)blockIdx.x * NWAVES * 64 + F.tid; o < DEPTH * 2 * NGB * 4096; o += (int)gridDim.x * NWAVES * 64) {
        const int i = o & 63, j = (o >> 6) & 63, g = (o >> 12) & 7, gate = (o >> 15) & 1, l = o >> 16;
        const float* src = gate ? GATE_X_W : GATE_A_W;
        WSH(WS_GT)[o] = (bf16)f2bf(src[(size_t)(l * NGB + g) * 4096 + i * 64 + j]);
    }
}

DI void p_cvec(Frame& F) {
    const int gw = F.vcu * NWAVES + F.wave, NGW = F.G * NWAVES, lane = F.lane;
    constexpr int IT_IN = NPROJ / 16, IT_UP = FF / 16, PER_L = IT_IN + IT_UP;
    for (int it = gw; it < DEPTH * PER_L; it += NGW) {
        const int l = it / PER_L, r = it % PER_L, which = r >= IT_IN, rg = which ? r - IT_IN : r, N = which ? FF : NPROJ;
        const bf16* wt = WSH(WS_W) + (size_t)l * LAYER_W + (which ? W_UP_OFF : 0) + (size_t)(rg * 16) * 1024 + 16 * lane;
        const float* shb = WSF(WS_MOD) + (size_t)l * BATCH * NMODC + (which ? 3 * D : 0) + 16 * lane;
        float* cout = (which ? WSF(WS_C2) + (size_t)l * BATCH * FF : WSF(WS_C1) + (size_t)l * BATCH * NPROJ) + rg * 16;
        f32x4 sh[4][4];
#pragma unroll
        for (int b = 0; b < 4; ++b)
#pragma unroll
            for (int j = 0; j < 4; ++j) sh[b][j] = *(const f32x4*)(shb + (size_t)b * NMODC + 4 * j);
        float v[64];
#pragma unroll
        for (int row = 0; row < 16; ++row) { const v4u w0 = *(const v4u*)(wt + (size_t)row * 1024), w1 = *(const v4u*)(wt + (size_t)row * 1024 + 8);
            const f32x4 wa = (f32x4){bflo(w0.x), bfhi(w0.x), bflo(w0.y), bfhi(w0.y)}, wb = (f32x4){bflo(w0.z), bfhi(w0.z), bflo(w0.w), bfhi(w0.w)};
            const f32x4 wc = (f32x4){bflo(w1.x), bfhi(w1.x), bflo(w1.y), bfhi(w1.y)}, wd = (f32x4){bflo(w1.z), bfhi(w1.z), bflo(w1.w), bfhi(w1.w)};
#pragma unroll
            for (int b = 0; b < 4; ++b) { const f32x4 t = sh[b][0] * wa + sh[b][1] * wb + sh[b][2] * wc + sh[b][3] * wd; v[row * 4 + b] = (t[0] + t[1]) + (t[2] + t[3]); } }
#pragma unroll
        for (int st = 0; st < 6; ++st) { const int bit = 1 << st; const bool up = lane & bit;
#pragma unroll
            for (int i = 0; i < (32 >> st); ++i) { const float keep = up ? v[2 * i + 1] : v[2 * i], send = up ? v[2 * i] : v[2 * i + 1]; v[i] = keep + bperm_(lane ^ bit, send); } }
        cout[(size_t)(lane & 3) * N + (lane >> 2)] = v[0];
    }
    if (gw < DEPTH * BATCH) { const int l = gw >> 2, b = gw & 3; float a[8];
#pragma unroll
        for (int j = 0; j < 8; ++j) a[j] = 0.f;
        for (int kk = 0; kk < 16; ++kk) { const int k = 16 * lane + kk; const float shv = WSF(WS_MOD)[((size_t)l * BATCH + b) * NMODC + k];
#pragma unroll
            for (int j = 0; j < 8; ++j) a[j] += shv * W_IN[((size_t)l * D + k) * INC + NPROJ + j]; }
#pragma unroll
        for (int j = 0; j < 8; ++j) a[j] = wave_sum_(lane, a[j]);
        if (lane < 8) { float r = a[0];
#pragma unroll
            for (int j = 1; j < 8; ++j) r = (lane == j) ? a[j] : r;
            WSF(WS_CB8)[(size_t)gw * 8 + lane] = r; } }
}

template <bool WITH_BG>
DI void p_normmod(Frame& F, int l, const float* xin, const float* normw, int off_sh, int off_sc) {
    LAS float* w8 = (LAS float*)F.lds;
    if (WITH_BG) {
        for (int i = F.tid; i < D * 8; i += NWAVES * 64) w8[i] = W_IN[((size_t)l * D + (i >> 3)) * INC + NPROJ + (i & 7)];
        __syncthreads();
    }
    const int gw = F.vcu * NWAVES + F.wave, NGW = F.G * NWAVES, lane = F.lane;
    f32x4 v[4];
    if (gw < M) {
#pragma unroll
        for (int j = 0; j < 4; ++j) v[j] = *(const f32x4*)(xin + (size_t)gw * D + 4 * lane + 256 * j);
    }
    for (int m = gw; m < M; m += NGW) {
        const int b = m >> 12, mn = m + NGW;
        f32x4 vnx[4];
#pragma unroll
        for (int j = 0; j < 4; ++j) vnx[j] = (mn < M) ? *(const f32x4*)(xin + (size_t)mn * D + 4 * lane + 256 * j) : (f32x4){0.f, 0.f, 0.f, 0.f};
        const float* modp = WSF(WS_MOD) + ((size_t)l * BATCH + b) * NMODC;
        float ss = 0.f;
#pragma unroll
        for (int j = 0; j < 4; ++j) ss += (v[j].x * v[j].x + v[j].y * v[j].y) + (v[j].z * v[j].z + v[j].w * v[j].w);
        ss = wave_sum_(lane, ss);
        const float rstd = 1.0f / sqrtf(ss * (1.0f / D) + EPS);
        float a0 = 0.f, a1 = 0.f, a2 = 0.f, a3 = 0.f, a4 = 0.f, a5 = 0.f, a6 = 0.f, a7 = 0.f;
#pragma unroll
        for (int j = 0; j < 4; ++j) {
            const int col = 4 * lane + 256 * j;
            const f32x4 nw = *(const f32x4*)(normw + (size_t)l * D + col), sc = *(const f32x4*)(modp + off_sc + col), sh = *(const f32x4*)(modp + off_sh + col);
            const f32x4 hv = v[j] * rstd * nw * (sc + 1.0f) + sh;
            v2u o; o.x = pk2(hv.x, hv.y); o.y = pk2(hv.z, hv.w);
            *(v2u*)(WSH(WS_H) + (size_t)m * D + col) = o;
            if (WITH_BG) {
#pragma unroll
                for (int e = 0; e < 4; ++e) { const f32x4 wa = *(const LAS f32x4*)(w8 + (col + e) * 8), wb = *(const LAS f32x4*)(w8 + (col + e) * 8 + 4); const float hh = hv[e];
                    a0 += hh * wa.x; a1 += hh * wa.y; a2 += hh * wa.z; a3 += hh * wa.w; a4 += hh * wb.x; a5 += hh * wb.y; a6 += hh * wb.z; a7 += hh * wb.w; }
            }
        }
        if (WITH_BG) {
            const bool b0 = lane & 1, b1 = lane & 2, b2 = lane & 4;
            float k0 = b0 ? a1 : a0, k1 = b0 ? a3 : a2, k2 = b0 ? a5 : a4, k3 = b0 ? a7 : a6;
            k0 += bperm_(lane ^ 1, b0 ? a0 : a1); k1 += bperm_(lane ^ 1, b0 ? a2 : a3); k2 += bperm_(lane ^ 1, b0 ? a4 : a5); k3 += bperm_(lane ^ 1, b0 ? a6 : a7);
            float c0 = b1 ? k1 : k0, c1 = b1 ? k3 : k2;
            c0 += bperm_(lane ^ 2, b1 ? k0 : k1); c1 += bperm_(lane ^ 2, b1 ? k2 : k3);
            float d = b2 ? c1 : c0;
            d += bperm_(lane ^ 4, b2 ? c0 : c1);
            d += bperm_(lane ^ 8, d); d += bperm_(lane ^ 16, d); d += bperm_(lane ^ 32, d);
            if (lane < 8) {
                const int hh = lane & 3;
                float r;
                if (lane < 4) r = sigmoidf_(d);
                else { const float xx = d + GDN_DT_BIAS[l * GH + hh]; const float sp = xx > 20.f ? xx : log1pf(expf(xx)); r = -expf(GDN_A_LOG[l * GH + hh]) * sp; }
                WSF(WS_BG)[(size_t)m * 8 + lane] = r;
            }
        }
#pragma unroll
        for (int j = 0; j < 4; ++j) v[j] = vnx[j];
    }
}

typedef float f32x2_t __attribute__((ext_vector_type(2))); typedef __bf16 bf16x2_t __attribute__((ext_vector_type(2)));
DI unsigned cvtpk(float lo, float hi) { f32x2_t v = {lo, hi}; bf16x2_t b = __builtin_convertvector(v, bf16x2_t); return __builtin_bit_cast(unsigned, b); }
DI bf16x8 pack8(f32x4 a, f32x4 b) { v4u p; p.x = cvtpk(a.x, a.y); p.y = cvtpk(a.z, a.w); p.z = cvtpk(b.x, b.y); p.w = cvtpk(b.z, b.w); return __builtin_bit_cast(bf16x8, p); }
DI bf16x8 ldfrag(const LAS unsigned char* p) { const v2u lo = *(const LAS v2u*)p, hi = *(const LAS v2u*)(p + 32); v4u r; r.x = lo.x; r.y = lo.y; r.z = hi.x; r.w = hi.y; return __builtin_bit_cast(bf16x8, r); }
#define MFMA16(a, b, c) __builtin_amdgcn_mfma_f32_16x16x32_bf16((a), (b), (c), 0, 0, 0)

#define WG_BAR() do { asm volatile("s_waitcnt lgkmcnt(0)" ::: "memory"); __builtin_amdgcn_s_barrier(); asm volatile("" ::: "memory"); } while (0)
DI bf16x8 ld128(const LAS unsigned char* p) { return *(const LAS bf16x8*)p; }
DI int kperm4(int k4) { return k4 < 16 ? 2 * k4 : 2 * (k4 - 16) + 4; }
DI int kperm(int k) { return (k & ~31) + kperm4(k & 28) + (k & 3); }
constexpr int PG_QB = 0, PG_KB = 17408, PG_KBET = 34816, PG_VT = 53248, PG_LS = 71680, PG_TS = 89088, PG_TB = 106496, PG_ATT = 115712, PG_XS = 124928, PG_SM = 128000, PG_END = 129024, PG_BGS = 140288;
static_assert(PG_END <= RING_BYTES && PG_BGS >= 8 * 17408 && PG_BGS + 2048 <= RING_BYTES, "prep LDS map");
DI void p_prep(Frame& F, int l) {
    const int wave = F.wave;
#define PREP_IDS int tid_ = F.tid; asm volatile("" : "+v"(tid_)); const int tid = tid_, lane = tid & 63, m = lane & 15, q = lane >> 4; (void)m; (void)q;
    for (int item = blockIdx.x; item < BATCH * NCH; item += gridDim.x) {
        const int b = item / NCH, n = item % NCH, row0 = b * SEQ + n * CH, t0 = n * CH;
        LAS float* bgs = (LAS float*)(F.lds + PG_BGS);
        if (wave < 4) {
            PREP_IDS
            const int mt = wave;
            const bf16* a1 = (l > 0 ? WSH(WS_A1) : WSH(WS_H)) + (size_t)(row0 + 16 * mt + m) * D + 8 * q;
            const bf16* w8t = WSH(WS_W8T) + (size_t)l * 16 * 1024 + (size_t)m * 1024 + 8 * q;
            f32x4 acc = (f32x4){0.f, 0.f, 0.f, 0.f};
#pragma unroll 8
            for (int kb = 0; kb < 32; ++kb) acc = MFMA16(*(const bf16x8*)(a1 + 32 * kb), *(const bf16x8*)(w8t + 32 * kb), acc);
            if (m < 8) { const int hh = m & 3; const float cb = l > 0 ? WSF(WS_CB8)[((size_t)l * BATCH + b) * 8 + m] : 0.f, dtb = GDN_DT_BIAS[l * GH + hh], alog = GDN_A_LOG[l * GH + hh];
#pragma unroll
                for (int r = 0; r < 4; ++r) { const int t = 16 * mt + 4 * q + r; const f32x4* rp = (const f32x4*)(WSF(WS_RS1) + (size_t)(row0 + t) * 16);
                    const f32x4 p0 = rp[0], p1 = rp[1], p2 = rp[2], p3 = rp[3], ts = (p0 + p1) + (p2 + p3);
                    const float rstd = l > 0 ? 1.0f / sqrtf(((ts[0] + ts[1]) + (ts[2] + ts[3])) * (1.0f / D) + EPS) : 1.0f, v = acc[r] * rstd + cb;
                    float res;
                    if (m < 4) res = sigmoidf_(v); else { const float xx = v + dtb; const float sp = xx > 20.f ? xx : log1p_acc(exp_fast(xx)); res = -expf(alog) * sp; }
                    bgs[t * 8 + m] = res; } }
        }
        for (int rep_ = 0; rep_ < PREP_REP_LRU; ++rep_) {
            PREP_IDS
            const int g = wave;
            LAS float* xr = (LAS float*)(F.lds + wave * 17408);
            const int tg = lane >> 3, cg = lane & 7, c0 = 8 * cg, cc0 = g * 64 + c0;
            v4u xp[11];
#pragma unroll
            for (int i = 0; i < 11; ++i) { const int tt = t0 + 8 * tg - 3 + i;
                xp[i] = (tt >= 0) ? *(const v4u*)(WSH(WS_PROJ) + (size_t)(b * SEQ + tt) * NPROJ + O_LX + cc0) : (v4u){0u, 0u, 0u, 0u}; }
            f32x4 wl_[4], wh_[4];
#pragma unroll
            for (int k = 0; k < 4; ++k) { wl_[k] = *(const f32x4*)(LRU_CONV_W + ((size_t)l * 4 + k) * LRUW + cc0); wh_[k] = *(const f32x4*)(LRU_CONV_W + ((size_t)l * 4 + k) * LRUW + cc0 + 4); }
            const f32x4 bl_ = *(const f32x4*)(LRU_CONV_B + l * LRUW + cc0), bh_ = *(const f32x4*)(LRU_CONV_B + l * LRUW + cc0 + 4);
            float ba_[4], bx_[4], ls_[4];
#pragma unroll
            for (int nt = 0; nt < 4; ++nt) { const int cc = g * 64 + 16 * nt + m; ba_[nt] = GATE_A_B[l * LRUW + cc]; bx_[nt] = GATE_X_B[l * LRUW + cc];
                const float lam = LRU_LAMBDA[l * LRUW + cc]; ls_[nt] = -8.0f * (fmaxf(-lam, 0.f) + log1p_acc(exp_fast(-fabsf(lam)))); }
#pragma unroll
            for (int tt = 0; tt < 8; ++tt) { f32x4 al = bl_, ah = bh_;
#pragma unroll
                for (int k = 0; k < 4; ++k) { const v4u xw = xp[tt + k];
                    al += wl_[k] * (f32x4){bflo(xw.x), bfhi(xw.x), bflo(xw.y), bfhi(xw.y)}; ah += wh_[k] * (f32x4){bflo(xw.z), bfhi(xw.z), bflo(xw.w), bfhi(xw.w)}; }
                *(LAS f32x4*)(xr + (8 * tg + tt) * 68 + c0) = al; *(LAS f32x4*)(xr + (8 * tg + tt) * 68 + c0 + 4) = ah; }
            asm volatile("s_waitcnt lgkmcnt(0)" ::: "memory");
            bf16x8 Bf[2][4][2];
#pragma unroll
            for (int gate = 0; gate < 2; ++gate)
#pragma unroll
                for (int nt = 0; nt < 4; ++nt)
#pragma unroll
                    for (int ks = 0; ks < 2; ++ks) Bf[gate][nt][ks] = *(const bf16x8*)(WSH(WS_GT) + ((size_t)((l * 2 + gate) * NGB + g)) * 4096 + (size_t)(16 * nt + m) * 64 + 32 * ks + 8 * q);
            bf16x8 Af[4][2];
#pragma unroll
            for (int mt = 0; mt < 4; ++mt)
#pragma unroll
                for (int ks = 0; ks < 2; ++ks) { const LAS float* pp = xr + (16 * mt + m) * 68 + 32 * ks + 8 * q; Af[mt][ks] = pack8(*(const LAS f32x4*)pp, *(const LAS f32x4*)(pp + 4)); }
#pragma unroll
            for (int nt = 0; nt < 4; ++nt) {
                float av[4][4], bv[4][4];
#pragma unroll
                for (int mt = 0; mt < 4; ++mt) { f32x4 ra = (f32x4){0.f, 0.f, 0.f, 0.f}, ia = (f32x4){0.f, 0.f, 0.f, 0.f};
                    ra = MFMA16(Af[mt][0], Bf[0][nt][0], ra); ra = MFMA16(Af[mt][1], Bf[0][nt][1], ra);
                    ia = MFMA16(Af[mt][0], Bf[1][nt][0], ia); ia = MFMA16(Af[mt][1], Bf[1][nt][1], ia);
#pragma unroll
                    for (int r = 0; r < 4; ++r) { const float rr = sigmoid_fast(ra[r] + ba_[nt]), ig = sigmoid_fast(ia[r] + bx_[nt]);
                        const float log_a = rr * ls_[nt], aa = exp_fast(log_a), mult = __builtin_amdgcn_sqrtf(fmaxf(1.0f - exp_fast(2.0f * log_a), 1e-12f));
                        av[mt][r] = aa; bv[mt][r] = mult * (ig * xr[(16 * mt + 4 * q + r) * 68 + 16 * nt + m]); } }
                float iP[4], iH[4];
#pragma unroll
                for (int mt = 0; mt < 4; ++mt) {
#pragma unroll
                    for (int r = 1; r < 4; ++r) { bv[mt][r] = av[mt][r] * bv[mt][r - 1] + bv[mt][r]; av[mt][r] = av[mt][r] * av[mt][r - 1]; }
                    float PA = av[mt][3], HA = bv[mt][3];
                    { const float Pp = shfl_up_(lane, PA, 16), Hp = shfl_up_(lane, HA, 16); if (q >= 1) { HA = PA * Hp + HA; PA = PA * Pp; } }
                    { const float Pp = shfl_up_(lane, PA, 32), Hp = shfl_up_(lane, HA, 32); if (q >= 2) { HA = PA * Hp + HA; PA = PA * Pp; } }
                    iP[mt] = PA; iH[mt] = HA; }
                float CP = 1.f, CH = 0.f;
#pragma unroll
                for (int mt = 0; mt < 4; ++mt) {
                    const float totP = bperm_(m + 48, iP[mt]), totH = bperm_(m + 48, iH[mt]);
                    float exP = shfl_up_(lane, iP[mt], 16), exH = shfl_up_(lane, iH[mt], 16); if (q == 0) { exP = 1.f; exH = 0.f; }
                    const float EP = CP * exP, EH = exP * CH + exH;
#pragma unroll
                    for (int r = 0; r < 4; ++r) { const float Pf = EP * av[mt][r], Hf = av[mt][r] * EH + bv[mt][r];
                        *(LAS unsigned*)(xr + (16 * mt + 4 * q + r) * 68 + 16 * nt + m) = f2bf(Hf) | (f2bf(Pf) << 16); }
                    CH = totP * CH + totH; CP = CP * totP; }
                if (q == 0) { WSF(WS_AGG)[((size_t)(b * NCH + n)) * LRUW + g * 64 + 16 * nt + m] = CP; WSF(WS_AGG)[(size_t)BATCH * NCH * LRUW + ((size_t)(b * NCH + n)) * LRUW + g * 64 + 16 * nt + m] = CH; }
            }
            if (l == 0) WG_BAR(); else asm volatile("s_waitcnt lgkmcnt(0)" ::: "memory");
#pragma unroll
            for (int i = 0; i < 16; ++i) { const int pz = lane + 64 * i, row = pz >> 4, c16 = pz & 15;
                *(v4u*)((unsigned*)(F.A->ws + WS_H) + (size_t)(row0 + row) * LRUW + g * 64 + 4 * c16) = *(const LAS v4u*)(xr + row * 68 + 4 * c16); }
        }
        __syncthreads();
        {
            LAS unsigned char* qb = F.lds + PG_QB;
            LAS unsigned char* kb = F.lds + PG_KB;
            LAS unsigned char* kbeT = F.lds + PG_KBET;
            LAS unsigned char* vT = F.lds + PG_VT;
            LAS float* Ls = (LAS float*)(F.lds + PG_LS);
            LAS float* Ts = (LAS float*)(F.lds + PG_TS);
            LAS unsigned char* wst = F.lds + PG_TS;
            LAS unsigned char* Tb = F.lds + PG_TB;
            LAS unsigned char* atts = F.lds + PG_ATT;
            LAS float* Xs = (LAS float*)(F.lds + PG_XS);
            LAS float* sm4 = (LAS float*)(F.lds + PG_SM);
            if (wave < GH) { int tl_ = F.tid; asm volatile("" : "+v"(tl_)); const int ln = tl_ & 63, hh = wave;
                float gcv = bgs[ln * 8 + 4 + hh];
#pragma unroll
                for (int off = 1; off < 64; off <<= 1) { const float pv = shfl_up_(ln, gcv, off); if (ln >= off) gcv += pv; }
                const float glast = bperm_(63, gcv);
                sm4[hh * 256 + ln] = gcv; sm4[hh * 256 + 64 + ln] = bgs[ln * 8 + hh]; sm4[hh * 256 + 128 + ln] = expf(gcv); sm4[hh * 256 + 192 + ln] = expf(glast - gcv); }
            WG_BAR();
#define G1_FETCH(hh_) do { int tf_ = F.tid; asm volatile("" : "+v"(tf_)); if (tf_ < 384) { const int cgp_ = tf_ & 15, wt_ = tf_ >> 4, which_ = wt_ >> 3, tr_ = wt_ & 7, ch_ = which_ * GDNW + (hh_) * HD + cgp_ * 8; \
                _Pragma("unroll") for (int i = 0; i < 11; ++i) { const int tt = t0 + tr_ * 8 - 3 + i; \
                    xpn[i] = (tt >= 0) ? *(const v4u*)(WSH(WS_PROJ) + (size_t)(b * SEQ + tt) * NPROJ + O_Q + ch_) : (v4u){0u, 0u, 0u, 0u}; } \
                } } while (0)
#pragma unroll 1
            for (int h = -1; h < GH; ++h) {
                PREP_IDS
                v4u xpn[11], pe[8];
                G1_FETCH(h + 1 < GH ? h + 1 : GH - 1);
                const int hn = h + 1;
                const size_t item4 = (size_t)(b * GH + h) * NCH + n, item4n = (size_t)(b * GH + hn) * NCH + n;
                LAS float* sgc = sm4 + h * 256, *sbeta = sgc + 64, *seg = sgc + 128;
                LAS float* sbetan = sm4 + hn * 256 + 64, *segn = sbetan + 64, *seln = sbetan + 128;
                if (h >= 0) {
                    const int it = wave >> 1;
                    bf16x8 Ak[4], Aq[4], Bk[2][4];
#pragma unroll
                    for (int ks = 0; ks < 4; ++ks) { Ak[ks] = ld128(kb + (16 * it + m) * 272 + (32 * ks + 8 * q) * 2); Aq[ks] = ld128(qb + (16 * it + m) * 272 + (32 * ks + 8 * q) * 2);
                        Bk[0][ks] = ld128(kb + (16 * ((wave & 1) * 2) + m) * 272 + (32 * ks + 8 * q) * 2); Bk[1][ks] = ld128(kb + (16 * ((wave & 1) * 2 + 1) + m) * 272 + (32 * ks + 8 * q) * 2); }
#pragma unroll
                    for (int jj = 0; jj < 2; ++jj) { const int jt = (wave & 1) * 2 + jj;
                        f32x4 kk = (f32x4){0.f, 0.f, 0.f, 0.f}, qk = (f32x4){0.f, 0.f, 0.f, 0.f};
                        if (jt <= it) {
#pragma unroll
                            for (int ks = 0; ks < 4; ++ks) { kk = MFMA16(Ak[ks], Bk[jj][ks], kk); qk = MFMA16(Aq[ks], Bk[jj][ks], qk); } }
                        const int j = 16 * jt + m; const float gj = sgc[j];
#pragma unroll
                        for (int r = 0; r < 4; ++r) { const int i = 16 * it + 4 * q + r;
                            const float dec = (j <= i) ? exp_fast(sgc[i] - gj) : 0.f;
                            Ls[i * 68 + j] = (j < i) ? sbeta[i] * kk[r] * dec : 0.f;
                            *(LAS unsigned short*)(atts + i * 144 + kperm(j) * 2) = (unsigned short)f2bf((j <= i) ? qk[r] * dec : 0.f); } }
                    WG_BAR();
                }
                if (h >= 0 && wave == 7) {
#ifdef PROBE_G3X2
                    for (int prb_ = 0; prb_ < 2; ++prb_) {
#else
                    {
#endif
                    { const int bk = lane >> 4, c = lane & 15; float x[16];
                        const LAS float* lb = Ls + (16 * bk) * 68 + 16 * bk;
#pragma unroll
                        for (int r = 0; r < 16; ++r) { float acc = (r == c) ? 1.f : 0.f;
#pragma unroll
                            for (int m4 = 0; m4 < (r + 3) / 4; ++m4) { const f32x4 lv = *(const LAS f32x4*)(lb + r * 68 + 4 * m4);
                                if (4 * m4 + 0 < r) acc -= lv.x * x[4 * m4 + 0]; if (4 * m4 + 1 < r) acc -= lv.y * x[4 * m4 + 1]; if (4 * m4 + 2 < r) acc -= lv.z * x[4 * m4 + 2]; if (4 * m4 + 3 < r) acc -= lv.w * x[4 * m4 + 3]; }
                            x[r] = acc; Ts[(16 * bk + r) * 68 + 16 * bk + c] = acc; *(LAS unsigned short*)(Tb + (16 * bk + r) * 144 + (16 * bk + c) * 2) = (unsigned short)f2bf(acc); } }
#pragma unroll
                    for (int e = 0; e < 4; ++e) { const int idx = lane + 64 * e, bz = idx >> 7, r = (idx >> 3) & 15, w = idx & 7;
                        *(LAS unsigned*)(Tb + (32 * bz + r) * 144 + (32 * bz + 16) * 2 + w * 4) = 0u; }
                    asm volatile("s_waitcnt lgkmcnt(0)" ::: "memory");
#pragma unroll
                    for (int dl = 1; dl < 4; ++dl) {
                        f32x4 xacc[3];
#pragma unroll
                        for (int e = 0; e < 4 - dl; ++e) { const int qd = lane + 64 * e, blk = qd >> 6, r = (qd >> 2) & 15, c4 = (qd & 3) * 4, i = blk + dl, j = blk;
                            const LAS float* lrow = Ls + (16 * i + r) * 68 + 16 * j; const LAS float* tcol = Ts + (16 * j) * 68 + 16 * j + c4;
                            f32x4 pa[4];
#pragma unroll
                            for (int mm4 = 0; mm4 < 4; ++mm4) pa[mm4] = (f32x4){0.f, 0.f, 0.f, 0.f};
#pragma unroll
                            for (int kk = 0; kk < dl; ++kk) {
#pragma unroll
                                for (int mm4 = 0; mm4 < 4; ++mm4) { const int mm = 4 * mm4; const f32x4 lv = *(const LAS f32x4*)(lrow + 16 * kk + mm); const LAS float* tc = tcol + (16 * kk + mm) * 68;
                                    pa[mm4] += lv.x * *(const LAS f32x4*)(tc) + lv.y * *(const LAS f32x4*)(tc + 68) + lv.z * *(const LAS f32x4*)(tc + 136) + lv.w * *(const LAS f32x4*)(tc + 204); } }
                            xacc[e] = (pa[0] + pa[1]) + (pa[2] + pa[3]); }
#pragma unroll
                        for (int e = 0; e < 4 - dl; ++e) { const int qd = lane + 64 * e, blk = qd >> 6, r = (qd >> 2) & 15, c4 = (qd & 3) * 4; *(LAS f32x4*)(Xs + blk * 256 + r * 16 + c4) = xacc[e]; }
                        asm volatile("s_waitcnt lgkmcnt(0)" ::: "memory");
#pragma unroll
                        for (int e = 0; e < 4 - dl; ++e) { const int qd = lane + 64 * e, blk = qd >> 6, r = (qd >> 2) & 15, c4 = (qd & 3) * 4, i = blk + dl, j = blk;
                            const LAS float* trow = Ts + (16 * i + r) * 68 + 16 * i; const LAS float* xc = Xs + blk * 256 + c4;
                            f32x4 pa[4];
#pragma unroll
                            for (int mm4 = 0; mm4 < 4; ++mm4) { const int mm = 4 * mm4; const f32x4 tv = *(const LAS f32x4*)(trow + mm);
                                pa[mm4] = tv.x * *(const LAS f32x4*)(xc + (mm + 0) * 16) + tv.y * *(const LAS f32x4*)(xc + (mm + 1) * 16) + tv.z * *(const LAS f32x4*)(xc + (mm + 2) * 16) + tv.w * *(const LAS f32x4*)(xc + (mm + 3) * 16); }
                            xacc[e] = -((pa[0] + pa[1]) + (pa[2] + pa[3])); }
#pragma unroll
                        for (int e = 0; e < 4 - dl; ++e) { const int qd = lane + 64 * e, blk = qd >> 6, r = (qd >> 2) & 15, c4 = (qd & 3) * 4, i = blk + dl, j = blk; const f32x4 acc = xacc[e];
                            *(LAS f32x4*)(Ts + (16 * i + r) * 68 + 16 * j + c4) = acc;
                            v2u pb; pb.x = f2bf(acc.x) | (f2bf(acc.y) << 16); pb.y = f2bf(acc.z) | (f2bf(acc.w) << 16); *(LAS v2u*)(Tb + (16 * i + r) * 144 + (16 * j + c4) * 2) = pb; }
                        asm volatile("s_waitcnt lgkmcnt(0)" ::: "memory");
                    }
                    }
                } else if (tid < 384 && hn < GH) {
                    const int cgp = tid & 15, wt = tid >> 4, which = wt >> 3, tr = wt & 7, d0 = cgp * 8, ch0 = which * GDNW + hn * HD + d0;
                    f32x4 wl_[4], wh_[4], ol[8], oh[8];
#pragma unroll
                    for (int k = 0; k < 4; ++k) { wl_[k] = *(const f32x4*)(GDN_CONV_W + ((size_t)l * 4 + k) * (3 * GDNW) + ch0); wh_[k] = *(const f32x4*)(GDN_CONV_W + ((size_t)l * 4 + k) * (3 * GDNW) + ch0 + 4); }
                    float ss[8];
#pragma unroll
                    for (int tt = 0; tt < 8; ++tt) { f32x4 al = (f32x4){0.f, 0.f, 0.f, 0.f}, ah = (f32x4){0.f, 0.f, 0.f, 0.f};
#pragma unroll
                        for (int k = 0; k < 4; ++k) { const v4u xw = xpn[tt + k];
                            al += wl_[k] * (f32x4){bflo(xw.x), bfhi(xw.x), bflo(xw.y), bfhi(xw.y)}; ah += wh_[k] * (f32x4){bflo(xw.z), bfhi(xw.z), bflo(xw.w), bfhi(xw.w)}; }
#pragma unroll
                        for (int c = 0; c < 4; ++c) { al[c] = silu_fast(al[c]); ah[c] = silu_fast(ah[c]); }
                        ol[tt] = al; oh[tt] = ah;
                        ss[tt] = (al.x * al.x + al.y * al.y) + (al.z * al.z + al.w * al.w) + (ah.x * ah.x + ah.y * ah.y) + (ah.z * ah.z + ah.w * ah.w); }
                    if (which < 2) {
#pragma unroll
                        for (int tt = 0; tt < 8; ++tt) { float v = ss[tt]; v += bperm_(lane ^ 1, v); v += bperm_(lane ^ 2, v); v += bperm_(lane ^ 4, v); v += bperm_(lane ^ 8, v);
                            const float scl = __builtin_amdgcn_rsqf(v + 1e-6f) * (which == 0 ? 0.08838834764831845f : 1.0f); ol[tt] = ol[tt] * scl; oh[tt] = oh[tt] * scl; }
                    }
                    const int tb = tr * 8;
                    if (which == 0) {
#pragma unroll
                        for (int tt = 0; tt < 8; ++tt) { const int t = tb + tt; const float eg = segn[t];
                            v4u pk; pk.x = cvtpk(ol[tt].x, ol[tt].y); pk.y = cvtpk(ol[tt].z, ol[tt].w); pk.z = cvtpk(oh[tt].x, oh[tt].y); pk.w = cvtpk(oh[tt].z, oh[tt].w);
                            *(LAS v4u*)(qb + t * 272 + d0 * 2) = pk;
                            v4u pg; pg.x = cvtpk(ol[tt].x * eg, ol[tt].y * eg); pg.y = cvtpk(ol[tt].z * eg, ol[tt].w * eg); pg.z = cvtpk(oh[tt].x * eg, oh[tt].y * eg); pg.w = cvtpk(oh[tt].z * eg, oh[tt].w * eg);
                            { bf16* qrow = WSH(WS_GQD) + item4n * 8192 + t * 128 + (d0 & ~31); const int kl = d0 & 31;
                                v2u p0; p0.x = pg.x; p0.y = pg.y; v2u p1; p1.x = pg.z; p1.y = pg.w; *(v2u*)(qrow + kperm4(kl)) = p0; *(v2u*)(qrow + kperm4(kl + 4)) = p1; } }
                    } else if (which == 1) {
                        float fb[8], fl[8];
#pragma unroll
                        for (int tt = 0; tt < 8; ++tt) { const int t = tb + tt; fb[tt] = sbetan[t] * segn[t]; fl[tt] = seln[t];
                            v4u pk; pk.x = cvtpk(ol[tt].x, ol[tt].y); pk.y = cvtpk(ol[tt].z, ol[tt].w); pk.z = cvtpk(oh[tt].x, oh[tt].y); pk.w = cvtpk(oh[tt].z, oh[tt].w);
                            *(LAS v4u*)(kb + t * 272 + d0 * 2) = pk; }
#define KV_(tt) ((c) < 4 ? ol[tt][(c) & 3] : oh[tt][(c) & 3])
#pragma unroll
                        for (int c = 0; c < 8; ++c) {
                            pe[c].x = cvtpk(KV_(0) * fb[0], KV_(1) * fb[1]); pe[c].y = cvtpk(KV_(2) * fb[2], KV_(3) * fb[3]); pe[c].z = cvtpk(KV_(4) * fb[4], KV_(5) * fb[5]); pe[c].w = cvtpk(KV_(6) * fb[6], KV_(7) * fb[7]);
                            v4u pt; pt.x = cvtpk(KV_(0) * fl[0], KV_(1) * fl[1]); pt.y = cvtpk(KV_(2) * fl[2], KV_(3) * fl[3]); pt.z = cvtpk(KV_(4) * fl[4], KV_(5) * fl[5]); pt.w = cvtpk(KV_(6) * fl[6], KV_(7) * fl[7]);
                            { bf16* krow = WSH(WS_GKT) + item4n * 8192 + (d0 + c) * 64 + (tb & ~31); const int kl = tb & 31;
                                v2u p0; p0.x = pt.x; p0.y = pt.y; v2u p1; p1.x = pt.z; p1.y = pt.w; *(v2u*)(krow + kperm4(kl)) = p0; *(v2u*)(krow + kperm4(kl + 4)) = p1; } }
                    } else {
                        float fb[8];
#pragma unroll
                        for (int tt = 0; tt < 8; ++tt) fb[tt] = sbetan[tb + tt];
#pragma unroll
                        for (int c = 0; c < 8; ++c) { pe[c].x = cvtpk(KV_(0) * fb[0], KV_(1) * fb[1]); pe[c].y = cvtpk(KV_(2) * fb[2], KV_(3) * fb[3]); pe[c].z = cvtpk(KV_(4) * fb[4], KV_(5) * fb[5]); pe[c].w = cvtpk(KV_(6) * fb[6], KV_(7) * fb[7]); }
#undef KV_
                    }
                }
                WG_BAR();
                if (h >= 0) {
                    const int nt = wave;
#pragma unroll
                    for (int mt = 0; mt < 4; ++mt) { f32x4 ua = (f32x4){0.f, 0.f, 0.f, 0.f}, wa = (f32x4){0.f, 0.f, 0.f, 0.f};
#pragma unroll
                        for (int ks = 0; ks < 2; ++ks) if (32 * ks <= 16 * mt + 15) { const bf16x8 A = ld128(Tb + (16 * mt + m) * 144 + (32 * ks + 8 * q) * 2);
                            const int swz = (((4 * ks + q) ^ ((2 * nt + (m >> 3)) & 7)) * 16);
                            ua = MFMA16(A, ld128(vT + (16 * nt + m) * 144 + swz), ua); wa = MFMA16(A, ld128(kbeT + (16 * nt + m) * 144 + swz), wa); }
                        unsigned uts[4];
#pragma unroll
                        for (int r = 0; r < 4; ++r) { const int t = 16 * mt + 4 * q + r, d = 16 * nt + m;
                            uts[r] = f2bf(ua[r]); *(LAS unsigned short*)(wst + t * 272 + kperm(d) * 2) = (unsigned short)f2bf(-wa[r]); }
                        { v2u pu; pu.x = uts[0] | (uts[1] << 16); pu.y = uts[2] | (uts[3] << 16); *(LAS v2u*)(F.lds + PG_LS + (16 * nt + m) * 128 + (((2 * mt + (q >> 1)) ^ (m & 7)) * 16) + (q & 1) * 8) = pu; } }
                    WG_BAR();
                }
                if (h >= 0) {
#pragma unroll
                    for (int e = 0; e < 2; ++e) { const int p = tid + 512 * e, row = p >> 4, c16 = p & 15;
                        *(v4u*)((unsigned char*)(WSH(WS_MIX + 16 * MiB) + item4 * 8192) + row * 256 + c16 * 16) = *(const LAS v4u*)(wst + row * 272 + c16 * 16);
                        const int ur = p >> 3, uc = p & 7;
                        *(v4u*)((unsigned char*)(WSH(WS_MIX) + item4 * 8192) + ur * 128 + uc * 16) = *(const LAS v4u*)(F.lds + PG_LS + ur * 128 + ((uc ^ (ur & 7)) * 16)); }
                    { const int row = tid >> 3, c16 = tid & 7;
                        *(v4u*)((unsigned char*)(WSH(WS_GATT) + item4 * 4096) + row * 128 + c16 * 16) = *(const LAS v4u*)(atts + row * 144 + c16 * 16); }
                    if (tid == 0) WSF(WS_GL)[item4] = seg[63];
                }
                if (tid >= 128 && tid < 384 && hn < GH) {
                    const int cgp = tid & 15, wt = tid >> 4, which = wt >> 3, tr = wt & 7, d0 = cgp * 8;
                    LAS unsigned char* dstT = which == 1 ? kbeT : vT;
#pragma unroll
                    for (int c = 0; c < 8; ++c) *(LAS v4u*)(dstT + (d0 + c) * 144 + ((tr ^ (cgp & 7)) * 16)) = pe[c];
                }
                WG_BAR();
            }
        }
    }
}

#undef PREP_IDS
constexpr int SC_W = 0, SC_QD = 18432, SC_KT = 36864, SC_AT = 57344, SC_U = 67584, SC_STAGE = 76800;
static_assert(2 * SC_STAGE <= RING_BYTES, "scan stages fit the ring");
#define SBAR_() __builtin_amdgcn_sched_barrier(0)
constexpr int NSEG = 8, SEGC = NCH / NSEG;
constexpr size_t WS_PSI = 344 * MiB;
constexpr size_t WS_PHI = 352 * MiB;
constexpr size_t WS_SST = 356 * MiB;
static_assert(WS_SST + 8 * MiB <= WS_END, "two-level scan scratch");

#define SC_ADDR() \
        const unsigned char* gW = (const unsigned char*)(WSH(WS_MIX + 16 * MiB) + it0 * 8192); \
        const unsigned char* gQD = (const unsigned char*)(WSH(WS_GQD) + it0 * 8192); \
        const unsigned char* gKT = (const unsigned char*)(WSH(WS_GKT) + it0 * 8192); \
        const unsigned char* gAT = (const unsigned char*)(WSH(WS_GATT) + it0 * 4096); \
        const unsigned char* gU = (const unsigned char*)(WSH(WS_MIX) + it0 * 8192) + dvbase * 128;
#define SC_LOAD(rg, n_) do { const size_t cb = (size_t)(n_) * 16384, ca = (size_t)(n_) * 8192; \
            _Pragma("unroll") for (int i = 0; i < 4; ++i) { rg[i] = *(const v4u*)(gW + cb + gofW + i * 4096); if (FULL) rg[4 + i] = *(const v4u*)(gQD + cb + gofW + i * 4096); \
                rg[8 + i] = *(const v4u*)(gKT + cb + gofK + i * 4096); } \
            _Pragma("unroll") for (int i = 0; i < 2; ++i) { if (FULL) rg[12 + i] = *(const v4u*)(gAT + ca + gofK + i * 4096); rg[14 + i] = *(const v4u*)(gU + cb + gofK + i * 4096); } } while (0)
#define SC_WRITE(rg, buf_) do { LAS unsigned char* sb_ = F.lds + (buf_) * SC_STAGE; \
            _Pragma("unroll") for (int i = 0; i < 4; ++i) { *(LAS v4u*)(sb_ + SC_W + lofW + i * (16 * 288)) = rg[i]; if (FULL) *(LAS v4u*)(sb_ + SC_QD + lofW + i * (16 * 288)) = rg[4 + i]; \
                *(LAS v4u*)(sb_ + SC_KT + lofK + i * (32 * 160)) = rg[8 + i]; } \
            _Pragma("unroll") for (int i = 0; i < 2; ++i) { if (FULL) *(LAS v4u*)(sb_ + SC_AT + lofK + i * (32 * 160)) = rg[12 + i]; *(LAS v4u*)(sb_ + SC_U + lofU + i * (32 * 144)) = rg[14 + i]; } } while (0)
#define SC_LOADER_LOOP() do { \
            int lt_ = F.tid & 255; asm volatile("" : "+v"(lt_)); \
            const int gofW = (lt_ >> 4) * 256 + (lt_ & 15) * 16, gofK = (lt_ >> 3) * 128 + (lt_ & 7) * 16; \
            const int lofW = (lt_ >> 4) * 288 + (lt_ & 15) * 16, lofK = (lt_ >> 3) * 160 + (lt_ & 7) * 16, lofU = (lt_ >> 3) * 144 + (lt_ & 7) * 16; \
            const int nlast = n0 + SEGC - 1; \
            v4u ra[16], rb[16]; \
            SC_LOAD(ra, n0); SC_WRITE(ra, 0); SC_LOAD(ra, n0 + 1); SC_LOAD(rb, n0 + 2); \
            __syncthreads(); \
            _Pragma("unroll 1") for (int j = 0; j < SEGC; j += 2) { \
                  \
                  \
                SC_WRITE(ra, 1); \
                { const int nn = n0 + j + 3 < nlast ? n0 + j + 3 : nlast; SC_LOAD(ra, nn); } \
                WG_BAR(); \
                SC_WRITE(rb, 0); \
                { const int nn = n0 + j + 4 < nlast ? n0 + j + 4 : nlast; SC_LOAD(rb, nn); } \
                WG_BAR(); \
            } } while (0)

DI void p_scan1(Frame& F, int l) {
    constexpr bool FULL = false;
    const int wave = F.wave;
    { const int lane = F.lane;
        for (int p = blockIdx.x * NWAVES + wave; p < BATCH * LRUW; p += gridDim.x * NWAVES) { const int b = p / LRUW, c = p % LRUW;
            float A = WSF(WS_AGG)[((size_t)(b * NCH + lane)) * LRUW + c], B = WSF(WS_AGG)[(size_t)BATCH * NCH * LRUW + ((size_t)(b * NCH + lane)) * LRUW + c];
#pragma unroll
            for (int off = 1; off < 64; off <<= 1) { const float Ap = shfl_up_(lane, A, off), Bp = shfl_up_(lane, B, off); if (lane >= off) { B = A * Bp + B; A = A * Ap; } }
            if (lane < 63) WSF(WS_CARRY)[((size_t)(b * NCH + lane + 1)) * LRUW + c] = B; else WSF(WS_CARRY)[((size_t)(b * NCH)) * LRUW + c] = 0.f; } }
    const bool is_loader = wave >= 4;
    const int wv = wave & 3;
    for (int job = F.vcu; job < BATCH * GH * NSEG * 2; job += F.G) {
        const int bh = job >> 4, seg = (job >> 1) & (NSEG - 1), dvbase = (job & 1) * 64, n0 = seg * SEGC;
        const size_t it0 = (size_t)bh * NCH;
        SC_ADDR()
        (void)gQD; (void)gAT;
        if (seg == NSEG - 1) { __syncthreads(); continue; }
        if (is_loader) { SC_LOADER_LOOP(); }
        else {
            int tc_ = F.tid; asm volatile("" : "+v"(tc_)); const int lane = tc_ & 63, m = lane & 15, q = lane >> 4;
            const int col = dvbase + 16 * wv + m;
            f32x4 Sacc[2][8];
#pragma unroll
            for (int dt = 0; dt < 8; ++dt) { Sacc[0][dt] = (f32x4){0.f, 0.f, 0.f, 0.f};
#pragma unroll
                for (int r = 0; r < 4; ++r) Sacc[1][dt][r] = (16 * dt + 4 * q + r == col) ? 1.f : 0.f; }
            const float glv = WSF(WS_GL)[it0 + lane];
            __syncthreads();
#pragma unroll 1
            for (int j = 0; j < SEGC; ++j) {
                const LAS unsigned char* B = F.lds + (j & 1) * SC_STAGE;
                bf16x8 fa[4], fb[4], Sb[2][4], vnb[2][2];
                f32x4 vn[2][4];
                v2u ut[4];
#pragma unroll
                for (int mt = 0; mt < 4; ++mt) ut[mt] = *(const LAS v2u*)(B + SC_U + (16 * wv + m) * 144 + (16 * mt + 4 * q) * 2);
#define LDW4(dst, mt_) do { _Pragma("unroll") for (int kb = 0; kb < 4; ++kb) dst[kb] = ld128(B + SC_W + (16 * (mt_) + m) * 288 + (32 * kb + 8 * q) * 2); } while (0)
#define MMW2(src, mt_) do { _Pragma("unroll") for (int kb = 0; kb < 4; ++kb) { vn[0][mt_] = MFMA16(src[kb], Sb[0][kb], vn[0][mt_]); vn[1][mt_] = MFMA16(src[kb], Sb[1][kb], vn[1][mt_]); } } while (0)
#define LDK4(dst, dt_) do { dst[0] = ld128(B + SC_KT + (16 * (dt_) + m) * 160 + (8 * q) * 2); dst[1] = ld128(B + SC_KT + (16 * (dt_) + m) * 160 + (32 + 8 * q) * 2); \
                            dst[2] = ld128(B + SC_KT + (16 * ((dt_) + 1) + m) * 160 + (8 * q) * 2); dst[3] = ld128(B + SC_KT + (16 * ((dt_) + 1) + m) * 160 + (32 + 8 * q) * 2); } while (0)
#define MMK2(src, dt_) do { _Pragma("unroll") for (int e = 0; e < 2; ++e) { Sacc[e][dt_] = MFMA16(src[0], vnb[e][0], Sacc[e][dt_]); Sacc[e][dt_] = MFMA16(src[1], vnb[e][1], Sacc[e][dt_]); \
                            Sacc[e][(dt_) + 1] = MFMA16(src[2], vnb[e][0], Sacc[e][(dt_) + 1]); Sacc[e][(dt_) + 1] = MFMA16(src[3], vnb[e][1], Sacc[e][(dt_) + 1]); } } while (0)
                LDW4(fa, 0); SBAR_();
#pragma unroll
                for (int e = 0; e < 2; ++e)
#pragma unroll
                    for (int kb = 0; kb < 4; ++kb) Sb[e][kb] = pack8(Sacc[e][2 * kb], Sacc[e][2 * kb + 1]);
#pragma unroll
                for (int mt = 0; mt < 4; ++mt) { vn[0][mt] = (f32x4){bflo(ut[mt].x), bfhi(ut[mt].x), bflo(ut[mt].y), bfhi(ut[mt].y)}; vn[1][mt] = (f32x4){0.f, 0.f, 0.f, 0.f}; }
                const float gl = __builtin_bit_cast(float, __builtin_amdgcn_readlane(__builtin_bit_cast(int, glv), n0 + j));
                SBAR_(); LDW4(fb, 1); SBAR_(); MMW2(fa, 0); SBAR_();
                LDW4(fa, 2); SBAR_(); MMW2(fb, 1); SBAR_();
                LDW4(fb, 3); SBAR_(); MMW2(fa, 2); SBAR_();
                LDK4(fa, 0); SBAR_(); MMW2(fb, 3); SBAR_();
#pragma unroll
                for (int e = 0; e < 2; ++e) { vnb[e][0] = pack8(vn[e][0], vn[e][1]); vnb[e][1] = pack8(vn[e][2], vn[e][3]);
#pragma unroll
                    for (int dt = 0; dt < 8; ++dt) Sacc[e][dt] = Sacc[e][dt] * gl; }
                SBAR_(); LDK4(fb, 2); SBAR_(); MMK2(fa, 0); SBAR_();
                LDK4(fa, 4); SBAR_(); MMK2(fb, 2); SBAR_();
                LDK4(fb, 6); SBAR_(); MMK2(fa, 4); SBAR_();
                MMK2(fb, 6); SBAR_();
                WG_BAR();
            }
#undef LDW4
#undef MMW2
#undef LDK4
#undef MMK2
            float* psi = WSF(WS_PSI) + ((size_t)(bh * NSEG + seg) * 128) * 128 + col;
            bf16* phi = WSH(WS_PHI) + ((size_t)(bh * NSEG + seg) * 128) * 128 + kperm(col);
#pragma unroll
            for (int dt = 0; dt < 8; ++dt)
#pragma unroll
                for (int r = 0; r < 4; ++r) { const int dk = 16 * dt + 4 * q + r; psi[(size_t)dk * 128] = Sacc[0][dt][r]; phi[(size_t)dk * 128] = (bf16)f2bf(Sacc[1][dt][r]); }
        }
        __syncthreads();
    }
}

DI void p_scan2(Frame& F, int l) {
    const int wave = F.wave;
    for (int bh = blockIdx.x; bh < BATCH * GH; bh += gridDim.x) {
        int tc_ = F.tid; asm volatile("" : "+v"(tc_)); const int tid = tc_, lane = tc_ & 63, m = lane & 15, q = lane >> 4;
        const int col = 16 * wave + m;
        const int gof = (tid >> 4) * 256 + (tid & 15) * 16, lof = (tid >> 4) * 288 + (tid & 15) * 16;
        const unsigned char* phi0 = (const unsigned char*)(WSH(WS_PHI) + ((size_t)(bh * NSEG) * 128) * 128);
        const float* psi0 = WSF(WS_PSI) + ((size_t)(bh * NSEG) * 128) * 128 + col;
        float* sst0 = WSF(WS_SST) + ((size_t)(bh * NSEG) * 128) * 128 + col;
        f32x4 S[8], Ps[8]; v4u pr[4];
#pragma unroll
        for (int dt = 0; dt < 8; ++dt) { S[dt] = (f32x4){0.f, 0.f, 0.f, 0.f};
#pragma unroll
            for (int r = 0; r < 4; ++r) Ps[dt][r] = psi0[(size_t)(16 * dt + 4 * q + r) * 128]; }
#pragma unroll
        for (int i = 0; i < 4; ++i) pr[i] = *(const v4u*)(phi0 + gof + i * 8192);
#pragma unroll
        for (int i = 0; i < 4; ++i) *(LAS v4u*)(F.lds + lof + i * (32 * 288)) = pr[i];
        __syncthreads();
#pragma unroll 1
        for (int seg = 0; seg + 1 < NSEG; ++seg) {
            if (seg > 0) {
#pragma unroll
                for (int dt = 0; dt < 8; ++dt)
#pragma unroll
                    for (int r = 0; r < 4; ++r) sst0[((size_t)seg * 128 + 16 * dt + 4 * q + r) * 128] = S[dt][r]; }
            const int sn = seg + 2 < NSEG ? seg + 1 : seg;
#pragma unroll
            for (int i = 0; i < 4; ++i) pr[i] = *(const v4u*)(phi0 + (size_t)sn * 32768 + gof + i * 8192);
            f32x4 Pn[8];
#pragma unroll
            for (int dt = 0; dt < 8; ++dt)
#pragma unroll
                for (int r = 0; r < 4; ++r) Pn[dt][r] = psi0[((size_t)sn * 128 + 16 * dt + 4 * q + r) * 128];
            const LAS unsigned char* B = F.lds + (seg & 1) * 36864;
            bf16x8 Sb[4];
#pragma unroll
            for (int kb = 0; kb < 4; ++kb) Sb[kb] = pack8(S[2 * kb], S[2 * kb + 1]);
#pragma unroll
            for (int dt = 0; dt < 8; ++dt) { f32x4 acc = Ps[dt];
#pragma unroll
                for (int kb = 0; kb < 4; ++kb) acc = MFMA16(ld128(B + (16 * dt + m) * 288 + (32 * kb + 8 * q) * 2), Sb[kb], acc);
                S[dt] = acc; }
#pragma unroll
            for (int dt = 0; dt < 8; ++dt) Ps[dt] = Pn[dt];
#pragma unroll
            for (int i = 0; i < 4; ++i) *(LAS v4u*)(F.lds + ((seg + 1) & 1) * 36864 + lof + i * (32 * 288)) = pr[i];
            __syncthreads();
        }
#pragma unroll
        for (int dt = 0; dt < 8; ++dt)
#pragma unroll
            for (int r = 0; r < 4; ++r) sst0[((size_t)(NSEG - 1) * 128 + 16 * dt + 4 * q + r) * 128] = S[dt][r];
        __syncthreads();
    }
}

DI void p_scan3(Frame& F, int l) {
    constexpr bool FULL = true;
    const int wave = F.wave;
    const bool is_loader = wave >= 4;
    const int wv = wave & 3;
    for (int job = F.vcu; job < BATCH * GH * NSEG * 2; job += F.G) {
        const int bh = job >> 4, seg = (job >> 1) & (NSEG - 1), dvbase = (job & 1) * 64, n0 = seg * SEGC, b = bh >> 2, h = bh & 3;
        const size_t it0 = (size_t)bh * NCH;
        SC_ADDR()
        if (is_loader) { SC_LOADER_LOOP(); }
        else {
            int tc_ = F.tid; asm volatile("" : "+v"(tc_)); const int lane = tc_ & 63, m = lane & 15, q = lane >> 4;
            f32x4 Sacc[8];
            if (seg == 0) {
#pragma unroll
                for (int dt = 0; dt < 8; ++dt) Sacc[dt] = (f32x4){0.f, 0.f, 0.f, 0.f};
            } else { const float* sst = WSF(WS_SST) + ((size_t)(bh * NSEG + seg) * 128) * 128 + dvbase + 16 * wv + m;
#pragma unroll
                for (int dt = 0; dt < 8; ++dt)
#pragma unroll
                    for (int r = 0; r < 4; ++r) Sacc[dt][r] = sst[(size_t)(16 * dt + 4 * q + r) * 128]; }
            const float glv = WSF(WS_GL)[it0 + lane];
            __syncthreads();
#define FR_W(dst, mt_) do { _Pragma("unroll") for (int kb = 0; kb < 4; ++kb) { dst[kb] = ld128(B + SC_W + (16 * (mt_) + m) * 288 + (32 * kb + 8 * q) * 2); dst[4 + kb] = ld128(B + SC_QD + (16 * (mt_) + m) * 288 + (32 * kb + 8 * q) * 2); } } while (0)
#define MM_W(src, mt_) do { _Pragma("unroll") for (int kb = 0; kb < 4; ++kb) { vn[mt_] = MFMA16(src[kb], Sb[kb], vn[mt_]); o[mt_] = MFMA16(src[4 + kb], Sb[kb], o[mt_]); } } while (0)
#define FR_KT(dst, hf_) do { _Pragma("unroll") for (int i = 0; i < 8; ++i) dst[i] = ld128(B + SC_KT + (16 * (4 * (hf_) + (i >> 1)) + m) * 160 + (32 * (i & 1) + 8 * q) * 2); } while (0)
#define MM_KT(src, hf_) do { _Pragma("unroll") for (int i = 0; i < 8; ++i) Sacc[4 * (hf_) + (i >> 1)] = MFMA16(src[i], vnb[i & 1], Sacc[4 * (hf_) + (i >> 1)]); } while (0)
#pragma unroll 1
            for (int j = 0; j < SEGC; ++j) {
                const int n = n0 + j;
                const LAS unsigned char* B = F.lds + (j & 1) * SC_STAGE;
                bf16x8 fa[8], fb[8], Sb[4], vnb[2];
                f32x4 vn[4], o[4];
                v2u ut[4];
#pragma unroll
                for (int mt = 0; mt < 4; ++mt) ut[mt] = *(const LAS v2u*)(B + SC_U + (16 * wv + m) * 144 + (16 * mt + 4 * q) * 2);
                FR_W(fa, 0); SBAR_();
#pragma unroll
                for (int kb = 0; kb < 4; ++kb) Sb[kb] = pack8(Sacc[2 * kb], Sacc[2 * kb + 1]);
#pragma unroll
                for (int mt = 0; mt < 4; ++mt) { o[mt] = (f32x4){0.f, 0.f, 0.f, 0.f}; vn[mt] = (f32x4){bflo(ut[mt].x), bfhi(ut[mt].x), bflo(ut[mt].y), bfhi(ut[mt].y)}; }
                const float gl = __builtin_bit_cast(float, __builtin_amdgcn_readlane(__builtin_bit_cast(int, glv), n));
                SBAR_(); FR_W(fb, 1); SBAR_(); MM_W(fa, 0); SBAR_();
                FR_W(fa, 2); SBAR_(); MM_W(fb, 1); SBAR_();
                FR_W(fb, 3); SBAR_(); MM_W(fa, 2); SBAR_();
                fa[0] = ld128(B + SC_AT + (m) * 160 + (8 * q) * 2); fa[1] = ld128(B + SC_AT + (16 + m) * 160 + (8 * q) * 2);
                fa[2] = ld128(B + SC_AT + (32 + m) * 160 + (8 * q) * 2); fa[3] = ld128(B + SC_AT + (32 + m) * 160 + (32 + 8 * q) * 2);
                fa[4] = ld128(B + SC_AT + (48 + m) * 160 + (8 * q) * 2); fa[5] = ld128(B + SC_AT + (48 + m) * 160 + (32 + 8 * q) * 2);
                SBAR_(); MM_W(fb, 3); SBAR_();
                vnb[0] = pack8(vn[0], vn[1]); vnb[1] = pack8(vn[2], vn[3]);
#pragma unroll
                for (int dt = 0; dt < 8; ++dt) Sacc[dt] = Sacc[dt] * gl;
                SBAR_(); FR_KT(fb, 0); SBAR_();
                o[0] = MFMA16(fa[0], vnb[0], o[0]); o[1] = MFMA16(fa[1], vnb[0], o[1]); o[2] = MFMA16(fa[2], vnb[0], o[2]); o[3] = MFMA16(fa[4], vnb[0], o[3]);
                o[2] = MFMA16(fa[3], vnb[1], o[2]); o[3] = MFMA16(fa[5], vnb[1], o[3]);
                SBAR_(); FR_KT(fa, 1); SBAR_(); MM_KT(fb, 0); SBAR_();
                MM_KT(fa, 1); SBAR_();
                float* go = WSF(WS_GO) + (size_t)(b * SEQ + n * CH + 4 * q) * GDNW + h * HD + dvbase + 16 * wv + m;
#pragma unroll
                for (int mt = 0; mt < 4; ++mt)
#pragma unroll
                    for (int r = 0; r < 4; ++r) go[(size_t)(16 * mt + r) * GDNW] = o[mt][r];
                WG_BAR();
            }
#undef FR_W
#undef MM_W
#undef FR_KT
#undef MM_KT
        }
        __syncthreads();
    }
}
#undef SC_ADDR
#undef SC_LOAD
#undef SC_WRITE
#undef SC_LOADER_LOOP

DI float gelu_fast(float x) { const float u2 = 1.5957691216057308f * (x + 0.044715f * x * x * x); return x * rcp_(1.f + exp_fast(-u2)); }
struct PostRow { v4u hp[2]; v2u y2[2], z2[2]; f32x4 go[2], cr[2]; };
DI void post_load(Frame& F, PostRow& R, int m, int lane) {
    const int b = m >> 12, n = (m & (SEQ - 1)) >> 6;
#pragma unroll
    for (int j = 0; j < 2; ++j) { const int c = 4 * lane + 256 * j;
        R.hp[j] = *(const v4u*)((const unsigned*)(F.A->ws + WS_H) + (size_t)m * LRUW + c);
        R.cr[j] = *(const f32x4*)(WSF(WS_CARRY) + ((size_t)(b * NCH + n)) * LRUW + c);
        R.y2[j] = *(const v2u*)(WSH(WS_PROJ) + (size_t)m * NPROJ + O_LY + c);
        R.go[j] = *(const f32x4*)(WSF(WS_GO) + (size_t)m * GDNW + c);
        R.z2[j] = *(const v2u*)(WSH(WS_PROJ) + (size_t)m * NPROJ + O_Z + c); }
}
DI void p_post(Frame& F, int l) {
    const int gw = F.vcu * NWAVES + F.wave, NGW = F.G * NWAVES, lane = F.lane;
    PostRow R;
    if (gw < M) post_load(F, R, gw, lane);
    for (int m = gw; m < M; m += NGW) {
        PostRow Rn; const int mn = m + NGW;
        post_load(F, Rn, mn < M ? mn : m, lane);
        f32x4 val[2]; float ss = 0.f;
#pragma unroll
        for (int j = 0; j < 2; ++j) { const v4u hp = R.hp[j]; const v2u y2 = R.y2[j];
            const f32x4 hl = (f32x4){bflo(hp.x), bflo(hp.y), bflo(hp.z), bflo(hp.w)}, p = (f32x4){bfhi(hp.x), bfhi(hp.y), bfhi(hp.z), bfhi(hp.w)};
            const f32x4 hh = hl + p * R.cr[j];
            val[j] = (f32x4){hh.x * gelu_fast(bflo(y2.x)), hh.y * gelu_fast(bfhi(y2.x)), hh.z * gelu_fast(bflo(y2.y)), hh.w * gelu_fast(bfhi(y2.y))};
            ss += (val[j].x * val[j].x + val[j].y * val[j].y) + (val[j].z * val[j].z + val[j].w * val[j].w); }
        ss = wave_sum_(lane, ss);
        const float rl = 1.0f / sqrtf(ss * (1.0f / LRUW) + EPS);
#pragma unroll
        for (int j = 0; j < 2; ++j) { const int c = 4 * lane + 256 * j; const f32x4 nw = *(const f32x4*)(LRU_NORM_W + (size_t)l * LRUW + c);
            const f32x4 o = val[j] * rl * nw; v2u w; w.x = pk2(o.x, o.y); w.y = pk2(o.z, o.w); *(v2u*)(WSH(WS_MIX) + (size_t)m * D + c) = w; }
#pragma unroll
        for (int j = 0; j < 2; ++j) { const int c = 4 * lane + 256 * j, d = c & (HD - 1);
            const f32x4 o = R.go[j]; const v2u z2 = R.z2[j];
            const float s2 = half_sum_(lane, (o.x * o.x + o.y * o.y) + (o.z * o.z + o.w * o.w));
            const float rg = 1.0f / sqrtf(s2 * (1.0f / HD) + EPS);
            const f32x4 nw = *(const f32x4*)(GDN_NORM_W + (size_t)l * HD + d);
            const f32x4 r = (f32x4){o.x * rg * nw.x * silu_fast(bflo(z2.x)), o.y * rg * nw.y * silu_fast(bfhi(z2.x)), o.z * rg * nw.z * silu_fast(bflo(z2.y)), o.w * rg * nw.w * silu_fast(bfhi(z2.y))};
            v2u w; w.x = pk2(r.x, r.y); w.y = pk2(r.z, r.w); *(v2u*)(WSH(WS_MIX) + (size_t)m * D + LRUW + c) = w; }
        R = Rn;
    }
}

typedef _Float16 h16x4 __attribute__((ext_vector_type(4)));
DI void final_row(Frame& F, const _Float16* xrow, float* orow, int lane) {
    f32x4 v[4]; float ss = 0.f;
#pragma unroll
    for (int j = 0; j < 4; ++j) { const h16x4 hv = *(const h16x4*)(xrow + 4 * lane + 256 * j); v[j] = (f32x4){(float)hv[0], (float)hv[1], (float)hv[2], (float)hv[3]};
        ss += (v[j].x * v[j].x + v[j].y * v[j].y) + (v[j].z * v[j].z + v[j].w * v[j].w); }
    ss = wave_sum_(lane, ss);
    const float rstd = 1.0f / sqrtf(ss * (1.0f / D) + EPS);
#pragma unroll
    for (int j = 0; j < 4; ++j) { const int col = 4 * lane + 256 * j; const f32x4 nw = *(const f32x4*)(FINAL_NORM_W + col); *(f32x4*)(orow + col) = v[j] * rstd * nw; }
}
DI void p_final(Frame& F) {
    const int gw = F.vcu * NWAVES + F.wave, NGW = F.G * NWAVES, lane = F.lane;
    for (int m = gw; m < M; m += NGW) final_row(F, (const _Float16*)(F.A->ws + WS_H) + (size_t)m * D, OUT_ + (size_t)m * D, lane);
}

__device__ __forceinline__ void pg8::EpiMulti::operator()(const f32x4 (&acc)[2][2][4][2], const Unit& u, int wr, int wc, int fr, int fq, int ui) const {
    const PG8_LAS float* rtab = ui < 4 ? rt + ui * 256 : nullptr;
    const __attribute__((address_space(4))) Args* ap = (const __attribute__((address_space(4))) Args*)__builtin_amdgcn_kernarg_segment_ptr(); asm volatile("" : "+s"(ap));
    unsigned char* ws = ap->ws;
    const int b = (u.pm * BM) / SEQ;
    if (mode == 0) { EpiBf16<0> e{(bf16_t*)(ws + WS_PROJ), NPROJ, nullptr, 0, 0, 1.f, nullptr, nullptr}; e(acc, u, wr, wc, fr, fq); }
    else if (mode == 5) { EpiBf16<0> e{(bf16_t*)(ws + WS_PROJ), NPROJ, (const float*)(ws + WS_C1) + ((size_t)l * BATCH + b) * NPROJ, 0, 0, 1.f, rtab, (const float*)(ws + WS_RS1)}; e(acc, u, wr, wc, fr, fq); }
    else if (mode == 6) { EpiBf16<2> e{(bf16_t*)(ws + WS_ACT), FF, (const float*)(ws + WS_C2) + ((size_t)l * BATCH + b) * FF, 0, 0, 1.f, rtab, (const float*)(ws + WS_RS2)}; e(acc, u, wr, wc, fr, fq); }
    else if (mode == 3) { const float* modb = (const float*)(ws + WS_MOD) + ((size_t)l * BATCH + b) * NMODC; _Float16* x16 = (_Float16*)((unsigned char*)ap->out + X16_OFF);
        EpiResid2 r{ap->in[0], l == 0 ? nullptr : x16, x16, modb + 2 * D, ap->in[3] + (size_t)l * D, modb + 4 * D, (bf16_t*)(ws + WS_H), (float*)(ws + WS_RS2)}; r(acc, u, wr, wc, fr, fq); }
    else { const float* modb = (const float*)(ws + WS_MOD) + ((size_t)l * BATCH + b) * NMODC; const bool nx = l + 1 < DEPTH; _Float16* x16 = (_Float16*)((unsigned char*)ap->out + X16_OFF);
        EpiResid2 r{nullptr, x16, nx ? x16 : (_Float16*)(ws + WS_H), modb + 5 * D, nx ? ap->in[2] + (size_t)(l + 1) * D : nullptr, modb + NMODC * BATCH + D, (bf16_t*)(ws + WS_A1), (float*)(ws + WS_RS1)}; r(acc, u, wr, wc, fr, fq); }
}

__global__ void __launch_bounds__(NWAVES * 64, 2) mk_fwd(Args args) {
    extern __shared__ __attribute__((aligned(16))) unsigned char lds[];
    Frame F;
    F.lds = (LAS unsigned char*)lds;
    F.MISC = (volatile LAS unsigned*)(F.lds + MISC_OFF);
    F.tid = threadIdx.x; F.lane = F.tid & 63; F.wave = __builtin_amdgcn_readfirstlane(F.tid >> 6);
    F.G = gridDim.x; { const int bx = blockIdx.x; F.vcu = (F.G % 8 == 0) ? (bx % 8) * (F.G / 8) + bx / 8 : bx; }
    F.A = (const __attribute__((address_space(4))) Args*)__builtin_amdgcn_kernarg_segment_ptr();
    F.ctl = (gu32*)(F.A->ws + WS_CTL);
    for (int u = F.tid; u < (LDS_BYTES - LDSCTL_OFF) / 4; u += NWAVES * 64) ((LAS unsigned*)(F.lds + LDSCTL_OFF))[u] = 0u;
    __syncthreads();
    XcdBarrier bar; bar.bar = (unsigned*)(F.ctl + CW_BAR); bar.x = 0; bar.st = nullptr;
    if (N_LAUNCHES == 1) bar = xcd_barrier_post((unsigned*)(F.ctl + CW_BAR), F.MISC + 8);

    const int lo = F.A->ph_lo, hi = F.A->ph_hi;
    int rep_done = 0;
#pragma unroll 1
    for (int s = lo; s < hi; ++s) {
        { const __attribute__((address_space(4))) Args* ap = (const __attribute__((address_space(4))) Args*)__builtin_amdgcn_kernarg_segment_ptr(); asm volatile("" : "+s"(ap)); F.A = ap; }
        { int t_ = threadIdx.x; asm volatile("" : "+v"(t_)); F.tid = t_; F.lane = t_ & 63; F.wave = __builtin_amdgcn_readfirstlane(t_ >> 6); }
        if (s == 0) { if (PH_MASK & 1) { p_mod(F); __syncthreads(); p0_weights(F); xcd_barrier(bar, F.tid == 0); p_cvec(F); __syncthreads(); p_normmod<false>(F, 0, X_IN, NORM_MIX_W, 0, D); } }
        else if (s == N_STEPS - 1) { if (PH_MASK & 2) { p_final(F); } }
        else {
            const int l = (s - 1) / 9, i = (s - 1) % 9;
            if (i == 0 || i == 6) continue;
            bf16* wl = WSH(WS_W) + (size_t)l * LAYER_W;
            const float* modl = WSF(WS_MOD) + (size_t)l * BATCH * NMODC;
            if (!((PH_MASK >> (2 + i)) & 1)) {}
            else if (i == 0) { p_normmod<true>(F, l, l == 0 ? X_IN : OUT_, NORM_MIX_W, 0, D); }
            else if (i == 2) { p_prep(F, l); }
            else if (i == 3) {
                p_scan1(F, l); xcd_barrier(bar, F.tid == 0);
#if defined(SCAN_REP) && SCAN_REP == 1
                p_scan1(F, l); xcd_barrier(bar, F.tid == 0);
#endif
                p_scan2(F, l); xcd_barrier(bar, F.tid == 0);
#if defined(SCAN_REP) && SCAN_REP == 2
                p_scan2(F, l); xcd_barrier(bar, F.tid == 0);
#endif
                p_scan3(F, l);
#if defined(SCAN_REP) && SCAN_REP == 3
                xcd_barrier(bar, F.tid == 0); p_scan3(F, l);
#endif
            }
            else if (i == 4) { p_post(F, l); }
            else if (i == 6) { p_normmod<false>(F, l, OUT_, NORM_MLP_W, 3 * D, 4 * D); }
            else {
                pg8::Gemm g; pg8::EpiMulti E; E.l = l; E.rt = (const LAS float*)(F.lds + RSTAB_OFF);
                if (i == 1) { g = pg8::Gemm{l == 0 ? WSH(WS_H) : WSH(WS_A1), wl, M, NPROJ, D}; E.PERM = true; E.mode = (l == 0 ? 0 : 5); }
                else if (i == 5) { g = pg8::Gemm{WSH(WS_MIX), wl + W_OUT_OFF, M, D, D}; E.PERM = true; E.mode = 3; }
                else if (i == 7) { g = pg8::Gemm{WSH(WS_H), wl + W_UP_OFF, M, FF, D}; E.PERM = true; E.mode = 6; }
                else { g = pg8::Gemm{WSH(WS_ACT), wl + W_DOWN_OFF, M, D, FF}; E.PERM = true; E.mode = 4; }
                pg8::StaticOrder S; S.init(g.M, g.N, F.G, (int)blockIdx.x);
                if (E.mode == 5 || E.mode == 6) {
                    LAS float* tab = (LAS float*)(F.lds + RSTAB_OFF); const float* rsp = WSF(E.mode == 5 ? WS_RS1 : WS_RS2);
                    const int slot = F.tid >> 7; pg8::Unit uu;
                    if (S.next(slot, uu)) for (int rr = F.tid & 127; rr < 256; rr += 128) { const f32x4* rp = (const f32x4*)(rsp + (size_t)(uu.pm * 256 + rr) * 16);
                        const f32x4 p0 = rp[0], p1 = rp[1], p2 = rp[2], p3 = rp[3], ts = (p0 + p1) + (p2 + p3);
                        tab[slot * 256 + rr] = 1.0f / sqrtf(((ts[0] + ts[1]) + (ts[2] + ts[3])) * (1.0f / D) + EPS); }
                    __syncthreads(); }
                pg8::gemm_phase<pg8::EpiMulti, pg8::StaticOrder, PG8_ALIGN, PG8_SP2>(F.lds + RING_OFF, g, S, E);
            }
        }
        if (REP_MASK != 0 && ((s >= 1 && s < N_STEPS - 1 && ((REP_MASK >> ((s - 1) % 9)) & 1)) || (s == 0 && (REP_MASK & 0x10000))) && !rep_done) { rep_done = 1; --s; xcd_barrier(bar, F.tid == 0); continue; }
        rep_done = 0;
        if (s + 1 < hi) xcd_barrier(bar, F.tid == 0);
#ifdef PROBE_XBAR
        if (s >= 1 && s < N_STEPS - 1) { xcd_barrier(bar, F.tid == 0); xcd_barrier(bar, F.tid == 0); }
#endif
    }
}

extern "C" void kernel_launch(void* const* d_in, const int* in_sizes, int n_in, void* d_out, int out_size, void* d_ws, size_t ws_size, hipStream_t stream) {
    static int grid = 0;
    if (grid == 0) {
        if (n_in != 23 || in_sizes[0] != M * D || out_size != M * D || ws_size < WS_END) { fprintf(stderr, "kernel_launch: unexpected shapes (n_in %d, in0 %d, out %d, ws %zu); nothing launched\n", n_in, n_in > 0 ? in_sizes[0] : -1, out_size, ws_size); grid = -1; return; }
        int dev = 0, cus = 0;
        if (hipGetDevice(&dev) != hipSuccess || hipDeviceGetAttribute(&cus, hipDeviceAttributeMultiprocessorCount, dev) != hipSuccess) { grid = -1; return; }
        if (hipFuncSetAttribute((const void*)mk_fwd, hipFuncAttributeMaxDynamicSharedMemorySize, LDS_BYTES) != hipSuccess) { fprintf(stderr, "kernel_launch: hipFuncSetAttribute failed\n"); grid = -1; return; }
        (void)hipGetLastError();
        grid = cus;
    }
    if (grid < 0) return;
    if (hipMemsetAsync((char*)d_ws + WS_CTL, 0, CTL_ZERO_BYTES, stream) != hipSuccess) return;
    Args a{};
    for (int i = 0; i < 23; ++i) a.in[i] = (const float*)d_in[i];
    a.out = (float*)d_out; a.ws = (unsigned char*)d_ws;
    if (N_LAUNCHES == 1) { a.ph_lo = 0; a.ph_hi = N_STEPS; hipLaunchKernelGGL(mk_fwd, dim3(grid), dim3(NWAVES * 64), LDS_BYTES, stream, a); }
    else for (int s = 0; s < N_STEPS; ++s) { a.ph_lo = s; a.ph_hi = s + 1; hipLaunchKernelGGL(mk_fwd, dim3(grid), dim3(NWAVES * 64), LDS_BYTES, stream, a); }
}
```

```cpp
#include <hip/hip_runtime.h>
#include <cstdio>
#include <cstdint>
#include <cmath>
namespace pg8 {
#define PG8_LAS __attribute__((address_space(3)))
typedef unsigned short bf16_t;
typedef short bf16x8 __attribute__((ext_vector_type(8)));
typedef float f32x4 __attribute__((ext_vector_type(4)));
typedef unsigned u32x4 __attribute__((ext_vector_type(4)));
constexpr int BM = 256, BK = 64, HALF = 128, HTB = HALF * BK * 2  , STAGE_BYTES = 8 * HTB, NXCD = 8, WGM = 8;

__host__ __device__ __forceinline__ int lds_byte(int r, int c) { const int st = (r >> 4) * 2 + (c >> 5), rr = r & 15, cc = c & 31, ob = rr * 64 + cc * 2; return st * 1024 + (ob ^ (((ob >> 9) & 1) << 5)); }
__host__ __device__ __forceinline__ void stage_rc(int b, int& R, int& C) { const int st = b / 1024, sb = b % 1024, swz = sb ^ (((sb >> 9) & 1) << 5); R = (st >> 1) * 16 + swz / 64; C = (st & 1) * 32 + (swz % 64) / 2; }
__host__ __device__ __forceinline__ int perm32(int rho) { const int n = rho >> 4, i = rho & 15; return 8 * (i >> 2) + 4 * n + (i & 3); }

struct Unit { int pm, pn; };
struct Gemm { const bf16_t* A; const bf16_t* Bt; int M, N, K; };

struct StaticOrder {
    int nM, nN, nwg, G, c;
    __host__ __device__ void init(int M, int N, int G_, int c_) { nM = M / BM; nN = N / BM; nwg = nM * nN; G = G_; c = c_; }
    __host__ __device__ bool next(int i, Unit& u) const {
        const long L = (long)i * G + c; if (L >= nwg) return false;
        int wgid = (int)L; { const int q = nwg / NXCD, r = nwg % NXCD, xcd = wgid % NXCD, off = wgid / NXCD; wgid = (xcd < r ? xcd * (q + 1) : r * (q + 1) + (xcd - r) * q) + off; }
        const int nig = WGM * nN, gid = wgid / nig, fm = gid * WGM, gsz = (nM - fm) < WGM ? (nM - fm) : WGM;
        u.pm = fm + ((wgid % nig) % gsz); u.pn = (wgid % nig) / gsz; return true;
    }
    __device__ __forceinline__ void a_ready(const Unit&) const {}
    __device__ __forceinline__ void done(const Unit&) const {}
};

__device__ __forceinline__ unsigned cvt_pk_bf16(float lo, float hi) { unsigned r; asm volatile("v_cvt_pk_bf16_f32 %0, %1, %2" : "=v"(r) : "v"(lo), "v"(hi)); return r; }
typedef float f32x2 __attribute__((ext_vector_type(2)));
__device__ __forceinline__ f32x2 gelu_pk(f32x2 v) {
    const f32x2 av = __builtin_elementwise_abs(v), d = av * 0.2316418882f + 1.0f;
    f32x2 t; t.x = __builtin_amdgcn_rcpf(d.x); t.y = __builtin_amdgcn_rcpf(d.y);
    f32x2 q = t * 0.5307027145f + (-0.7265760135f); q = q * t + 0.7107068705f; q = q * t + (-0.142248368f); q = q * t + 0.127414796f; q = q * t;
    const f32x2 s = (v * v) * (-0.72134752044f);
    f32x2 e; e.x = __builtin_amdgcn_exp2f(s.x); e.y = __builtin_amdgcn_exp2f(s.y);
    const f32x2 m = v * (q * e), r = v - m;
    f32x2 o; o.x = v.x < 0.f ? m.x : r.x; o.y = v.y < 0.f ? m.y : r.y; return o;
}

template <int ACT  > struct EpiBf16 {
    static constexpr bool PERM = true, AFTER_DRAIN = false; static_assert(ACT == 0 || ACT == 1 || ACT == 2, "EpiBf16: ACT is 0 (none), 1 (gelu_pk) or 2 (squared relu)");
    bf16_t* O; int ldc; const float* bias; int split_cols; size_t split_stride; float scale0;
    const PG8_LAS float* rtab = nullptr;
    const float* rs = nullptr;
    __device__ __forceinline__ void operator()(const f32x4 (&acc)[2][2][4][2], const Unit& u, int wr, int wc, int fr, int fq) const {
        const int row0 = u.pm * BM + wr * 64 + fr; int colt = u.pn * BM; bf16_t* base = O;
        float sc = 1.f; if (split_cols) { const int t = colt / split_cols; base += (size_t)t * split_stride; colt -= t * split_cols; if (t == 0) sc = scale0; }
        const int col0 = colt + wc * 32 + 8 * fq, bcol0 = u.pn * BM + wc * 32 + 8 * fq;
        f32x4 bv[2][2];
#pragma unroll
        for (int bj = 0; bj < 2; ++bj)
#pragma unroll
            for (int n = 0; n < 2; ++n) bv[bj][n] = bias ? *(const f32x4*)(bias + bcol0 + bj * HALF + 4 * n) : (f32x4){0.f, 0.f, 0.f, 0.f};
#pragma unroll
        for (int ai = 0; ai < 2; ++ai)
#pragma unroll
            for (int m = 0; m < 4; ++m) { bf16_t* rowp = base + (size_t)(row0 + ai * HALF + m * 16) * ldc + col0;
                float rsc = 1.f;
                if (rtab) rsc = rtab[wr * 64 + fr + ai * HALF + m * 16];
                else if (rs) { const f32x4* rp = (const f32x4*)(rs + (size_t)(row0 + ai * HALF + m * 16) * 16); const f32x4 p0 = rp[0], p1 = rp[1], p2 = rp[2], p3 = rp[3];
                    const f32x4 t = (p0 + p1) + (p2 + p3); rsc = 1.0f / sqrtf(((t[0] + t[1]) + (t[2] + t[3])) * (1.0f / 1024.0f) + 1e-6f); }
#pragma unroll
                for (int bj = 0; bj < 2; ++bj) { f32x4 v0 = acc[ai][bj][m][0] * rsc + bv[bj][0], v1 = acc[ai][bj][m][1] * rsc + bv[bj][1];
                    if (ACT == 1) { f32x2 a = gelu_pk((f32x2){v0[0], v0[1]}), b = gelu_pk((f32x2){v0[2], v0[3]}), c = gelu_pk((f32x2){v1[0], v1[1]}), d = gelu_pk((f32x2){v1[2], v1[3]});
                        v0 = (f32x4){a.x, a.y, b.x, b.y}; v1 = (f32x4){c.x, c.y, d.x, d.y}; }
                    if (ACT == 2) { _Pragma("unroll") for (int q_ = 0; q_ < 4; ++q_) { const float a_ = fmaxf(v0[q_], 0.f), b_ = fmaxf(v1[q_], 0.f); v0[q_] = a_ * a_; v1[q_] = b_ * b_; } }
                    v0 = v0 * sc; v1 = v1 * sc; u32x4 w; w.x = cvt_pk_bf16(v0[0], v0[1]); w.y = cvt_pk_bf16(v0[2], v0[3]); w.z = cvt_pk_bf16(v1[0], v1[1]); w.w = cvt_pk_bf16(v1[2], v1[3]);
                    *(u32x4*)(rowp + bj * HALF) = w; } }
    }
};


struct EpiResid {
    static constexpr bool PERM = false, AFTER_DRAIN = false;
    const float* base; float* out; const float* gate; int ldc; int gate_stride; int rows_per_batch;
    __device__ __forceinline__ void operator()(const f32x4 (&acc)[2][2][4][2], const Unit& u, int wr, int wc, int fr, int fq) const {
        const int col0 = u.pn * BM + wc * 32 + 4 * fq;
        const float* gp = gate + (size_t)((u.pm * BM) / rows_per_batch) * gate_stride + col0;
        f32x4 gv[2][2];
#pragma unroll
        for (int bj = 0; bj < 2; ++bj)
#pragma unroll
            for (int n = 0; n < 2; ++n) gv[bj][n] = *(const f32x4*)(gp + bj * HALF + n * 16);
#pragma unroll
        for (int ai = 0; ai < 2; ++ai)
#pragma unroll
            for (int m = 0; m < 4; ++m) { const size_t off = (size_t)(u.pm * BM + ai * HALF + wr * 64 + m * 16 + fr) * ldc + col0;
#pragma unroll
                for (int bj = 0; bj < 2; ++bj)
#pragma unroll
                    for (int n = 0; n < 2; ++n) { const f32x4 bs = *(const f32x4*)(base + off + bj * HALF + n * 16);
                        *(f32x4*)(out + off + bj * HALF + n * 16) = bs + gv[bj][n] * acc[ai][bj][m][n]; } }
    }
};


typedef _Float16 f16x8 __attribute__((ext_vector_type(8)));
typedef _Float16 f16x4 __attribute__((ext_vector_type(4)));
struct EpiResid2 {
    static constexpr bool PERM = true, AFTER_DRAIN = false;
    const float* base32; const _Float16* base16; _Float16* out16; const float* gate;
    const float* nw; const float* sc;
    bf16_t* anext; float* rsum;
    __device__ __forceinline__ void operator()(const f32x4 (&acc)[2][2][4][2], const Unit& u, int wr, int wc, int fr, int fq) const {
        const int col0 = u.pn * BM + wc * 32 + 8 * fq, lane = fr + 16 * fq;
        f32x4 gv[2][2], ns[2][2];
#pragma unroll
        for (int bj = 0; bj < 2; ++bj)
#pragma unroll
            for (int n = 0; n < 2; ++n) { const int c = col0 + bj * HALF + 4 * n; gv[bj][n] = *(const f32x4*)(gate + c);
                ns[bj][n] = nw ? *(const f32x4*)(nw + c) * (*(const f32x4*)(sc + c) + 1.0f) : (f32x4){0.f, 0.f, 0.f, 0.f}; }
#pragma unroll
        for (int ai = 0; ai < 2; ++ai)
#pragma unroll
            for (int m = 0; m < 4; ++m) { const size_t off = (size_t)(u.pm * BM + ai * HALF + wr * 64 + m * 16 + fr) * 1024 + col0;
                f32x4 bs[2][2];
                if (base16) {
                    f16x8 hb[2];
#pragma unroll
                    for (int bj = 0; bj < 2; ++bj) hb[bj] = *(const f16x8*)(base16 + off + bj * HALF);
#pragma unroll
                    for (int bj = 0; bj < 2; ++bj) { bs[bj][0] = (f32x4){(float)hb[bj][0], (float)hb[bj][1], (float)hb[bj][2], (float)hb[bj][3]}; bs[bj][1] = (f32x4){(float)hb[bj][4], (float)hb[bj][5], (float)hb[bj][6], (float)hb[bj][7]}; }
                } else {
#pragma unroll
                    for (int bj = 0; bj < 2; ++bj)
#pragma unroll
                        for (int n = 0; n < 2; ++n) bs[bj][n] = *(const f32x4*)(base32 + off + bj * HALF + 4 * n);
                }
                float ssq = 0.f;
#pragma unroll
                for (int bj = 0; bj < 2; ++bj) { const f32x4 x0 = bs[bj][0] + gv[bj][0] * acc[ai][bj][m][0], x1 = bs[bj][1] + gv[bj][1] * acc[ai][bj][m][1];
                    f16x8 ho; ho[0] = (_Float16)x0[0]; ho[1] = (_Float16)x0[1]; ho[2] = (_Float16)x0[2]; ho[3] = (_Float16)x0[3]; ho[4] = (_Float16)x1[0]; ho[5] = (_Float16)x1[1]; ho[6] = (_Float16)x1[2]; ho[7] = (_Float16)x1[3];
                    *(f16x8*)(out16 + off + bj * HALF) = ho;
                    if (nw) { const f32x4 h0 = x0 * ns[bj][0], h1 = x1 * ns[bj][1]; u32x4 w; w.x = cvt_pk_bf16(h0[0], h0[1]); w.y = cvt_pk_bf16(h0[2], h0[3]); w.z = cvt_pk_bf16(h1[0], h1[1]); w.w = cvt_pk_bf16(h1[2], h1[3]);
                        *(u32x4*)(anext + off + bj * HALF) = w;
                        ssq += ((x0[0] * x0[0] + x0[1] * x0[1]) + (x0[2] * x0[2] + x0[3] * x0[3])) + ((x1[0] * x1[0] + x1[1] * x1[1]) + (x1[2] * x1[2] + x1[3] * x1[3])); } }
                if (nw) { ssq += __builtin_bit_cast(float, __builtin_amdgcn_ds_bpermute((lane ^ 16) << 2, __builtin_bit_cast(int, ssq)));
                    ssq += __builtin_bit_cast(float, __builtin_amdgcn_ds_bpermute((lane ^ 32) << 2, __builtin_bit_cast(int, ssq)));
                    if (fq == 0) rsum[(size_t)(u.pm * BM + ai * HALF + wr * 64 + m * 16 + fr) * 16 + u.pn * 4 + wc] = ssq; }
                if (m & 1) asm volatile("" ::: "memory"); }
    }
};

struct EpiMulti {
    static constexpr bool AFTER_DRAIN = false;
    bool PERM; int mode, l; const PG8_LAS float* rt;
    __device__ __forceinline__ void operator()(const f32x4 (&acc)[2][2][4][2], const Unit& u, int wr, int wc, int fr, int fq, int ui) const;
};

template <class Epi, class Sched, bool ALIGN_EPI = false, bool SP2 = false>
__device__ __forceinline__ void gemm_phase(PG8_LAS unsigned char* lds, const Gemm g, const Sched& S, const Epi& E) {
    int tid_l = threadIdx.x; asm volatile("" : "+v"(tid_l));
    const int tid = tid_l, wid = __builtin_amdgcn_readfirstlane(tid >> 6), lane = tid & 63, wr = wid >> 2, wc = wid & 3, fr = lane & 15, fq = lane >> 4;
    const int K = g.K, nt = K / BK;
    unsigned voffA[2], voffB[2];
#pragma unroll
    for (int i = 0; i < 2; ++i) { int R, C; stage_rc(tid * 16 + i * 8192, R, C); const int Rb = E.PERM ? ((R & ~31) + perm32(R & 31)) : R;
        voffA[i] = (unsigned)(R * K + C) * 2u; voffB[i] = (unsigned)(Rb * K + C) * 2u; }
    const size_t kstep = (size_t)(BK * 2);
    const size_t hstep = (size_t)HALF * K * 2;
    const size_t tstep = 2 * hstep;
    const unsigned ldsw = (unsigned)wid * 1024u;
    const int aoff = lds_byte(wr * 64 + fr, fq * 8), boff = lds_byte(wc * 32 + fr, fq * 8);
#define PG8_SA(b, h) (((b) * 2 + (h)) * HTB)
#define PG8_SB(b, h) ((4 + (b) * 2 + (h)) * HTB)
#define PG8_STAGE(bufoff, gbase, voff) do { _Pragma("unroll") for (int _i = 0; _i < 2; ++_i) \
        __builtin_amdgcn_global_load_lds((const unsigned*)((const char*)(gbase) + (voff)[_i]), (PG8_LAS unsigned*)(lds + (bufoff) + ldsw + _i * 8192), 16, 0, 0); } while (0)
#define PG8_LDA(dst, b, h) do { _Pragma("unroll") for (int m = 0; m < 4; ++m) _Pragma("unroll") for (int k = 0; k < 2; ++k) dst[m][k] = *(const PG8_LAS bf16x8*)(lds + PG8_SA(b, h) + aoff + m * 2048 + k * 1024); } while (0)
#define PG8_LDB(dst, b, h) do { _Pragma("unroll") for (int n = 0; n < 2; ++n) _Pragma("unroll") for (int k = 0; k < 2; ++k) dst[n][k] = *(const PG8_LAS bf16x8*)(lds + PG8_SB(b, h) + boff + n * 2048 + k * 1024); } while (0)
#define PG8_MMA(ai, bj, At, Bt) do { __builtin_amdgcn_s_setprio(1); _Pragma("unroll") for (int m = 0; m < 4; ++m) _Pragma("unroll") for (int n = 0; n < 2; ++n) _Pragma("unroll") for (int k = 0; k < 2; ++k) \
        acc[ai][bj][m][n] = __builtin_amdgcn_mfma_f32_16x16x32_bf16(Bt[n][k], At[m][k], acc[ai][bj][m][n], 0, 0, 0); __builtin_amdgcn_s_setprio(0); } while (0)
#define PG8_WAIT_V(n) asm volatile("s_waitcnt vmcnt(" #n ")" ::: "memory")
#define PG8_WAIT_L(n) asm volatile("s_waitcnt lgkmcnt(" #n ")" ::: "memory")
#define PG8_BAR __builtin_amdgcn_s_barrier()
#define PG8_SCHED __builtin_amdgcn_sched_barrier(0)
    Unit cur, nxt; int ui = 0;
    if (!S.next(0, cur)) return;
    f32x4 acc[2][2][4][2];
#pragma unroll
    for (int a = 0; a < 2; ++a)
#pragma unroll
        for (int b = 0; b < 2; ++b)
#pragma unroll
            for (int m = 0; m < 4; ++m)
#pragma unroll
                for (int n = 0; n < 2; ++n) acc[a][b][m][n] = (f32x4){0.f, 0.f, 0.f, 0.f};
    bf16x8 At[4][2], B0[2][2], B1[2][2];
    const char* cA = (const char*)g.A + (size_t)cur.pm * tstep; const char* cB = (const char*)g.Bt + (size_t)cur.pn * tstep;
    S.a_ready(cur);
    if constexpr (SP2) {
        PG8_STAGE(PG8_SB(0, 0), cB, voffB); PG8_STAGE(PG8_SB(0, 1), cB + hstep, voffB); PG8_STAGE(PG8_SA(0, 0), cA, voffA); PG8_STAGE(PG8_SA(0, 1), cA + hstep, voffA);
        if (wr == 1) PG8_BAR;
        PG8_WAIT_V(2); PG8_BAR;
        PG8_STAGE(PG8_SB(1, 0), cB + kstep, voffB); PG8_STAGE(PG8_SA(1, 0), cA + kstep, voffA); PG8_STAGE(PG8_SB(1, 1), cB + hstep + kstep, voffB);
        PG8_WAIT_V(6); PG8_BAR;
    } else {
        PG8_STAGE(PG8_SB(0, 0), cB, voffB); PG8_STAGE(PG8_SA(0, 0), cA, voffA); PG8_STAGE(PG8_SB(0, 1), cB + hstep, voffB); PG8_STAGE(PG8_SA(0, 1), cA + hstep, voffA);
        if (wr == 1) PG8_BAR;
        PG8_WAIT_V(4); PG8_BAR;
        PG8_STAGE(PG8_SB(1, 0), cB + kstep, voffB); PG8_STAGE(PG8_SA(1, 0), cA + kstep, voffA); PG8_STAGE(PG8_SB(1, 1), cB + hstep + kstep, voffB);
        PG8_WAIT_V(6); PG8_BAR;
    }
    for (;;) {
        const bool has_next = S.next(ui + 1, nxt);
        const char* nA = has_next ? (const char*)g.A + (size_t)nxt.pm * tstep : cA; const char* nB = has_next ? (const char*)g.Bt + (size_t)nxt.pn * tstep : cB;
        for (int t = 0; t < nt; t += 2) {
            const bool last = (t == nt - 2);
            const char* a1 = cA + (size_t)(t + 1) * kstep;
            const char* a2 = last ? nA : cA + (size_t)(t + 2) * kstep; const char* b2 = last ? nB : cB + (size_t)(t + 2) * kstep;
            const char* a3 = a2 + kstep; const char* b3 = b2 + kstep;
            if (last && has_next) S.a_ready(nxt);
            if constexpr (SP2) {
            PG8_LDB(B0, 0, 0); PG8_LDB(B1, 0, 1); PG8_SCHED; PG8_LDA(At, 0, 0); PG8_STAGE(PG8_SA(1, 1), a1 + hstep, voffA);
            PG8_WAIT_V(8); PG8_WAIT_L(0); PG8_BAR; PG8_MMA(0, 0, At, B0); PG8_MMA(0, 1, At, B1); PG8_BAR; PG8_SCHED;
            PG8_LDA(At, 0, 1); PG8_STAGE(PG8_SB(0, 0), b2, voffB); PG8_STAGE(PG8_SB(0, 1), b2 + hstep, voffB); PG8_STAGE(PG8_SA(0, 0), a2, voffA);
            PG8_WAIT_V(8); PG8_WAIT_L(0); PG8_BAR; PG8_MMA(1, 0, At, B0); PG8_MMA(1, 1, At, B1); PG8_BAR; PG8_SCHED;
            PG8_LDB(B0, 1, 0); PG8_LDB(B1, 1, 1); PG8_SCHED; PG8_LDA(At, 1, 0); PG8_STAGE(PG8_SA(0, 1), a2 + hstep, voffA);
            PG8_WAIT_V(8); PG8_WAIT_L(0); PG8_BAR; PG8_MMA(0, 0, At, B0); PG8_MMA(0, 1, At, B1); PG8_BAR; PG8_SCHED;
            PG8_LDA(At, 1, 1); PG8_STAGE(PG8_SB(1, 0), b3, voffB); PG8_STAGE(PG8_SB(1, 1), b3 + hstep, voffB); PG8_STAGE(PG8_SA(1, 0), a3, voffA);
            PG8_WAIT_V(8); PG8_WAIT_L(0); PG8_BAR; PG8_MMA(1, 0, At, B0); PG8_MMA(1, 1, At, B1); PG8_BAR; PG8_SCHED;
            } else {
            PG8_LDB(B0, 0, 0); PG8_SCHED; PG8_LDA(At, 0, 0); PG8_STAGE(PG8_SA(1, 1), a1 + hstep, voffA);
            PG8_WAIT_L(8); PG8_BAR; PG8_WAIT_L(0); PG8_MMA(0, 0, At, B0); PG8_BAR; PG8_SCHED;
            PG8_LDB(B1, 0, 1); PG8_STAGE(PG8_SB(0, 0), b2, voffB);
            PG8_BAR; PG8_WAIT_L(0); PG8_MMA(0, 1, At, B1); PG8_BAR;
            PG8_LDA(At, 0, 1); PG8_STAGE(PG8_SA(0, 0), a2, voffA);
            PG8_BAR; PG8_WAIT_L(0); PG8_MMA(1, 0, At, B0); PG8_BAR; PG8_SCHED;
            PG8_STAGE(PG8_SB(0, 1), b2 + hstep, voffB);
            PG8_WAIT_V(6); PG8_BAR; PG8_MMA(1, 1, At, B1); PG8_BAR;
            PG8_LDB(B0, 1, 0); PG8_SCHED; PG8_LDA(At, 1, 0); PG8_STAGE(PG8_SA(0, 1), a2 + hstep, voffA);
            PG8_WAIT_L(8); PG8_BAR; PG8_WAIT_L(0); PG8_MMA(0, 0, At, B0); PG8_BAR; PG8_SCHED;
            PG8_LDB(B1, 1, 1); PG8_STAGE(PG8_SB(1, 0), b3, voffB);
            PG8_BAR; PG8_WAIT_L(0); PG8_MMA(0, 1, At, B1); PG8_BAR;
            PG8_LDA(At, 1, 1); PG8_STAGE(PG8_SA(1, 0), a3, voffA);
            PG8_BAR; PG8_WAIT_L(0); PG8_MMA(1, 0, At, B0); PG8_BAR; PG8_SCHED;
            PG8_STAGE(PG8_SB(1, 1), b3 + hstep, voffB);
            PG8_WAIT_V(6); PG8_BAR; PG8_MMA(1, 1, At, B1); PG8_BAR;
            }
        }
        if constexpr (ALIGN_EPI) { if (wr == 0) PG8_BAR; }
        if constexpr (!Epi::AFTER_DRAIN) { E(acc, cur, wr, wc, fr, fq, ui); S.done(cur); }
        if (!has_next) break;
#pragma unroll
        for (int a = 0; a < 2; ++a)
#pragma unroll
            for (int b = 0; b < 2; ++b)
#pragma unroll
                for (int m = 0; m < 4; ++m)
#pragma unroll
                    for (int n = 0; n < 2; ++n) acc[a][b][m][n] = (f32x4){0.f, 0.f, 0.f, 0.f};
        cur = nxt; cA = nA; cB = nB; ++ui;
        if constexpr (ALIGN_EPI) { if (wr == 1) PG8_BAR; }
    }
    PG8_WAIT_V(0);
    if constexpr (!ALIGN_EPI) { if (wr == 0) PG8_BAR; }
    PG8_BAR;
    if constexpr (Epi::AFTER_DRAIN) { E.fused(acc, cur, wr, wc, fr, fq, lds, wid, lane); S.done(cur); }
#undef PG8_SA
#undef PG8_SB
#undef PG8_STAGE
#undef PG8_LDA
#undef PG8_LDB
#undef PG8_MMA
#undef PG8_WAIT_V
#undef PG8_WAIT_L
#undef PG8_BAR
#undef PG8_SCHED
}
}
#define GAS __attribute__((address_space(1)))
#define LAS __attribute__((address_space(3)))
typedef unsigned short bf16;
typedef unsigned v4u __attribute__((ext_vector_type(4)));
typedef float f32x4 __attribute__((ext_vector_type(4)));
typedef short bf16x8 __attribute__((ext_vector_type(8)));
typedef GAS unsigned gu32;
typedef GAS unsigned long long gu64;
#define RLX_AGENT __ATOMIC_RELAXED, __HIP_MEMORY_SCOPE_AGENT
#define LDS_WAIT() asm volatile("s_waitcnt lgkmcnt(0)" ::: "memory")
#define VM_WAIT() asm volatile("s_waitcnt vmcnt(0)" ::: "memory")
__device__ __forceinline__ unsigned long long rt() { return __builtin_amdgcn_s_memrealtime(); }
__device__ __forceinline__ unsigned f2bf(float f) { unsigned u = __builtin_bit_cast(unsigned, f); return (u + 0x7fffu + ((u >> 16) & 1u)) >> 16; }
__device__ __forceinline__ unsigned pk2(float lo, float hi) { return f2bf(lo) | (f2bf(hi) << 16); }

#define XB_TMO      128
#define XB_XCNT(j)  (256  + 64 * (j))
#define XB_XSUB(j)  (1280 + 64 * (j))
#define XB_XGEN(j)  (2304 + 64 * (j))
#define XB_TOP      3328
#define XB_TOPGEN   3392
#define XCD_BAR_WORDS 3456
#define XB_SPIN_CAP (1u << 18)

__device__ __forceinline__ unsigned xb_ld(unsigned* p)              { return __hip_atomic_load(p, __ATOMIC_RELAXED, __HIP_MEMORY_SCOPE_AGENT); }
__device__ __forceinline__ unsigned xb_add(unsigned* p, unsigned v) { return __hip_atomic_fetch_add(p, v, __ATOMIC_RELAXED, __HIP_MEMORY_SCOPE_AGENT); }
__device__ __forceinline__ unsigned xb_xcc_id() { return (unsigned)__builtin_amdgcn_s_getreg((3 << 11) | 20) & 0xFu; }
#define XB_SPIN(cond, bar) do { unsigned _sp = 0; while (cond) { __builtin_amdgcn_s_sleep(1); \
    if ((++_sp & 255u) == 0u) { if (xb_ld(&(bar)[XB_TMO])) break; if (_sp > XB_SPIN_CAP) { atomicAdd(&(bar)[XB_TMO], 1u); break; } } } } while (0)

struct XcdBarrier {
    unsigned* bar; unsigned x;
    volatile LAS unsigned* st;
};

__device__ __forceinline__ XcdBarrier xcd_barrier_post(unsigned* bar, volatile LAS unsigned* st) {
    XcdBarrier b; b.bar = bar; b.x = xb_xcc_id(); b.st = st;
    if (threadIdx.x == 0) (void)xb_add(&bar[XB_XCNT(b.x)], 1u);
    return b;
}
__device__ __forceinline__ void xcd_barrier_complete(unsigned* bar, unsigned x, unsigned& nloc, unsigned& nx) {
    const unsigned G = gridDim.x * gridDim.y * gridDim.z;
    unsigned sum, cnt, mine, sp = 0u;
    for (;;) {
        sum = 0u; cnt = 0u; mine = 0u;
#pragma unroll
        for (unsigned j = 0; j < 16; ++j) { const unsigned c = xb_ld(&bar[XB_XCNT(j)]); sum += c; cnt += (c > 0u) ? 1u : 0u; mine = (j == x) ? c : mine; }
        if (sum == G) break;
        __builtin_amdgcn_s_sleep(1);
        if ((++sp & 255u) == 0u) { if (xb_ld(&bar[XB_TMO])) break; if (sp > XB_SPIN_CAP) { atomicAdd(&bar[XB_TMO], 1u); break; } }
    }
    nloc = mine > 0u ? mine : 1u; nx = cnt > 0u ? cnt : 1u;
}

__device__ __forceinline__ void xcd_barrier(const XcdBarrier& b, const bool t0  ) {
    asm volatile("s_waitcnt vmcnt(0)" ::: "memory");
    __syncthreads();
    if (t0) {
        unsigned* bar = b.bar;
        __builtin_amdgcn_s_waitcnt(0);
        unsigned nloc = b.st[0], nx = b.st[1];
        if (nloc == 0u) { xcd_barrier_complete(bar, b.x, nloc, nx); b.st[0] = nloc; b.st[1] = nx; }
        const unsigned old = xb_add(&bar[XB_XSUB(b.x)], 1u);
        const unsigned gen = old / nloc;
        if (old + 1u == (gen + 1u) * nloc) {
            __builtin_amdgcn_fence(__ATOMIC_RELEASE, "agent");
            asm volatile("s_waitcnt vmcnt(0)" ::: "memory");
            const unsigned og = xb_add(&bar[XB_TOP], 1u);
            const unsigned tg = og / nx;
            if (og + 1u == (tg + 1u) * nx) xb_add(&bar[XB_TOPGEN], 1u);
            else XB_SPIN(xb_ld(&bar[XB_TOPGEN]) == tg, bar);
            __builtin_amdgcn_fence(__ATOMIC_ACQUIRE, "agent");
            xb_add(&bar[XB_XGEN(b.x)], 1u);
            asm volatile("s_waitcnt vmcnt(0)" ::: "memory");
        } else {
            XB_SPIN(xb_ld(&bar[XB_XGEN(b.x)]) == gen, bar);
            __builtin_amdgcn_fence(__ATOMIC_ACQUIRE, "agent");
            asm volatile("s_waitcnt vmcnt(0)" ::: "memory");
        }
    }
    __syncthreads();
}

#ifndef PG8_SP2
#define PG8_SP2 true
#endif
#ifndef PG8_ALIGN
#define PG8_ALIGN true
#endif
constexpr int NWAVES = 8;
constexpr int N_STEPS = 38;
#ifndef MK_N_LAUNCHES
#define MK_N_LAUNCHES 1
#endif
#ifndef PH_MASK
#define PH_MASK 0xffff
#endif
#ifndef REP_MASK
#define REP_MASK 0
#endif
#ifndef PREP_REP_LRU
#define PREP_REP_LRU 1
#endif
#ifndef PREP_REP_GDN
#define PREP_REP_GDN 1
#endif
constexpr int N_LAUNCHES = MK_N_LAUNCHES;

constexpr int D = 1024, BATCH = 4, SEQ = 4096, DEPTH = 4, M = BATCH * SEQ;
constexpr int LRUW = 512, NGB = 8, GBW = 64, GH = 4, HD = 128, GDNW = 512, CH = 64, NCH = SEQ / CH, FF = 4096;
constexpr int NMODC = 6 * D, INC = 3080, NPROJ = 3072;
constexpr int O_LX = 0, O_LY = 512, O_Q = 1024, O_Z = 2560;
constexpr float EPS = 1e-6f;

constexpr size_t MiB = 1u << 20;
constexpr size_t WS_CTL = 0, CTL_ZERO_BYTES = 1 * MiB;
constexpr size_t WS_MOD = 1 * MiB;
constexpr size_t WS_BG = 2 * MiB;
constexpr size_t WS_AGG = 3 * MiB;
constexpr size_t WS_CARRY = 4 * MiB;
constexpr size_t WS_GL = 5 * MiB;
constexpr size_t WS_GT = 6 * MiB;
constexpr size_t WS_C1 = 6 * MiB + 512 * 1024;
constexpr size_t WS_C2 = 6 * MiB + 768 * 1024;
constexpr size_t WS_CB8 = 7 * MiB;
constexpr size_t WS_W8T = 7 * MiB + 64 * 1024;
constexpr size_t WS_RS1 = 364 * MiB, WS_RS2 = 365 * MiB;
constexpr size_t WS_A1 = 312 * MiB;
constexpr size_t WS_W = 8 * MiB;
constexpr size_t LAYER_W = (size_t)12288 * 1024;
constexpr size_t W_OUT_OFF = (size_t)3072 * 1024, W_UP_OFF = (size_t)4096 * 1024, W_DOWN_OFF = (size_t)8192 * 1024;
constexpr size_t WS_H = 104 * MiB;
constexpr size_t WS_MIX = 136 * MiB;
constexpr size_t WS_PROJ = 168 * MiB;
constexpr size_t WS_ACT = 168 * MiB;
constexpr size_t WS_GQD = 264 * MiB, WS_GKT = 280 * MiB;
constexpr size_t WS_GATT = 296 * MiB;
constexpr size_t WS_GO = 312 * MiB;
constexpr size_t WS_LRUP = 344 * MiB;
constexpr size_t WS_XT = 366 * MiB;
constexpr size_t WS_END = 384 * MiB;
constexpr int CW_BAR = 4096;
constexpr size_t X16_OFF = 32 * MiB;

constexpr int RING_OFF = 0, RING_BYTES = 155648;
constexpr int RSTAB_OFF = 131072;
constexpr int LDSCTL_OFF = RING_BYTES, MISC_OFF = LDSCTL_OFF + 320;
constexpr int LDS_BYTES = 156672;

typedef unsigned v2u __attribute__((ext_vector_type(2)));
#define DI __device__ __forceinline__
DI float bf2f(unsigned b) { return __builtin_bit_cast(float, b << 16); }
DI float bflo(unsigned w) { return __builtin_bit_cast(float, w << 16); }
DI float bfhi(unsigned w) { return __builtin_bit_cast(float, w & 0xffff0000u); }
DI float sigmoidf_(float x) { return 1.f / (1.f + expf(-x)); }
DI float siluf_(float x) { return x / (1.f + expf(-x)); }
DI float rcp_(float x) { return __builtin_amdgcn_rcpf(x); }
DI float exp_fast(float x) { return __builtin_amdgcn_exp2f(x * 1.4426950408889634f); }
DI float sigmoid_fast(float x) { return rcp_(1.f + exp_fast(-x)); }
DI float silu_fast(float x) { return x * rcp_(1.f + exp_fast(-x)); }
DI float log1p_acc(float x) { float ln2 = 0.6931471805599453f; asm volatile("" : "+v"(ln2));
    const float u = 1.0f + x, d = u - 1.0f; return d == 0.f ? x : (__builtin_amdgcn_logf(u) * ln2) * (x * rcp_(d)); }
DI float gelu_tanh(float x) { const float u = 0.7978845608028654f * (x + 0.044715f * x * x * x); return 0.5f * x * (1.f + tanhf(u)); }
DI float bperm_(int src_lane, float v) { return __builtin_bit_cast(float, __builtin_amdgcn_ds_bpermute(src_lane << 2, __builtin_bit_cast(int, v))); }
DI float wave_sum_(int lane, float v) {
#pragma unroll
    for (int o = 1; o < 64; o <<= 1) v += bperm_(lane ^ o, v);
    return v;
}
DI float half_sum_(int lane, float v) {
#pragma unroll
    for (int o = 1; o < 32; o <<= 1) v += bperm_(lane ^ o, v);
    return v;
}
DI float shfl_up_(int lane, float v, int off) { return bperm_(lane >= off ? lane - off : lane, v); }

struct Args { const float* in[23]; float* out; unsigned char* ws; int ph_lo, ph_hi; };
static_assert(sizeof(Args) == 23 * 8 + 8 + 8 + 8, "Args has no padding");
struct Frame {
    LAS unsigned char* lds;
    volatile LAS unsigned* MISC;
    gu32* ctl;
    int tid, lane, wave;
    int vcu, G;
    const __attribute__((address_space(4))) Args* A;
};
#define IN_(k) (F.A->in[k])
#define X_IN IN_(0)
#define C_IN IN_(1)
#define NORM_MIX_W IN_(2)
#define NORM_MLP_W IN_(3)
#define W_MOD IN_(4)
#define B_MOD IN_(5)
#define W_IN IN_(6)
#define LRU_CONV_W IN_(7)
#define LRU_CONV_B IN_(8)
#define GATE_A_W IN_(9)
#define GATE_A_B IN_(10)
#define GATE_X_W IN_(11)
#define GATE_X_B IN_(12)
#define LRU_LAMBDA IN_(13)
#define LRU_NORM_W IN_(14)
#define GDN_CONV_W IN_(15)
#define GDN_A_LOG IN_(16)
#define GDN_DT_BIAS IN_(17)
#define GDN_NORM_W IN_(18)
#define W_OUT IN_(19)
#define W_UP IN_(20)
#define W_DOWN IN_(21)
#define FINAL_NORM_W IN_(22)
#define OUT_ (F.A->out)
#define WSF(off) ((float*)(F.A->ws + (off)))
#define WSH(off) ((bf16*)(F.A->ws + (off)))

DI void p_mod(Frame& F) {
    LAS float* cs = (LAS float*)F.lds;
    LAS float* red = cs + 4096;
    for (int i = F.tid; i < BATCH * D; i += NWAVES * 64) cs[i] = siluf_(C_IN[i]);
    __syncthreads();
    const int hl = F.lane >> 5, cl = F.lane & 31;
    for (int item = F.vcu; item < DEPTH * 192; item += F.G) {
        const int l = item / 192, cg = item % 192, col = cg * 32 + cl, kbase = F.wave * 128 + hl * 64;
        const float* wp = W_MOD + ((size_t)l * D + kbase) * NMODC + col;
        float a0 = 0.f, a1 = 0.f, a2 = 0.f, a3 = 0.f;
#pragma unroll 16
        for (int kk = 0; kk < 64; ++kk) { const float wv = wp[(size_t)kk * NMODC]; const int k = kbase + kk;
            a0 += cs[k] * wv; a1 += cs[1024 + k] * wv; a2 += cs[2048 + k] * wv; a3 += cs[3072 + k] * wv; }
        const int sl = F.wave * 2 + hl;
        red[(sl * 4 + 0) * 32 + cl] = a0; red[(sl * 4 + 1) * 32 + cl] = a1; red[(sl * 4 + 2) * 32 + cl] = a2; red[(sl * 4 + 3) * 32 + cl] = a3;
        __syncthreads();
        if (F.tid < 128) { const int b = F.tid >> 5, ln = F.tid & 31; float sum = 0.f;
#pragma unroll
            for (int w = 0; w < 16; ++w) sum += red[(w * 4 + b) * 32 + ln];
            const int cc = cg * 32 + ln; WSF(WS_MOD)[((size_t)l * BATCH + b) * NMODC + cc] = sum + B_MOD[(size_t)l * NMODC + cc]; }
        __syncthreads();
    }
}

struct TrItem { const float* src; bf16* dst; int K, ldw; };
DI void p0_item(Frame& F, int it, TrItem& T) {
    constexpr int I_IN = (D / 64) * (NPROJ / 32), I_OUT = (D / 64) * (D / 32), I_UP = (D / 64) * (FF / 32), I_DN = (FF / 64) * (D / 32);
    constexpr int PER_LAYER = I_IN + I_OUT + I_UP + I_DN;
    const int l = it / PER_LAYER; int r = it % PER_LAYER; bf16* wl = WSH(WS_W) + (size_t)l * LAYER_W;
    const float* W; int K, ldw, N; bf16* WT;
    if (r < I_IN) { W = W_IN + (size_t)l * D * INC; K = D; ldw = INC; N = NPROJ; WT = wl; }
    else if ((r -= I_IN) < I_OUT) { W = W_OUT + (size_t)l * D * D; K = D; ldw = D; N = D; WT = wl + W_OUT_OFF; }
    else if ((r -= I_OUT) < I_UP) { W = W_UP + (size_t)l * D * FF; K = D; ldw = FF; N = FF; WT = wl + W_UP_OFF; }
    else { r -= I_UP; W = W_DOWN + (size_t)l * FF * D; K = FF; ldw = D; N = D; WT = wl + W_DOWN_OFF; }
    const int nblk = N / 32, kb = r / nblk, nb = r % nblk, k0 = 64 * kb, n0 = 32 * nb;
    T.src = W + (size_t)k0 * ldw + n0; T.dst = WT + (size_t)n0 * K + k0; T.K = K; T.ldw = ldw;
}
DI void p0_weights(Frame& F) {
    LAS float* scr = (LAS float*)(F.lds + RING_OFF + F.wave * 16384);
    const int gw = F.vcu * NWAVES + F.wave, NGW = F.G * NWAVES, lane = F.lane;
    constexpr int NIT = DEPTH * ((D / 64) * (NPROJ / 32) + (D / 64) * (D / 32) + (D / 64) * (FF / 32) + (FF / 64) * (D / 32));
    TrItem T; f32x4 v[8];
    if (gw < NIT) { p0_item(F, gw, T);
#pragma unroll
        for (int i = 0; i < 8; ++i) v[i] = *(const f32x4*)(T.src + (size_t)((lane >> 3) + 8 * i) * T.ldw + 4 * (lane & 7)); }
    for (int it = gw; it < NIT; it += NGW) {
        TrItem Tn; f32x4 vn[8]; const int itn = it + NGW < NIT ? it + NGW : it;
        p0_item(F, itn, Tn);
#pragma unroll
        for (int i = 0; i < 8; ++i) vn[i] = *(const f32x4*)(Tn.src + (size_t)((lane >> 3) + 8 * i) * Tn.ldw + 4 * (lane & 7));
#pragma unroll
        for (int i = 0; i < 8; ++i) { LAS float* d = scr + ((lane >> 3) + 8 * i) * 33 + 4 * (lane & 7); d[0] = v[i].x; d[1] = v[i].y; d[2] = v[i].z; d[3] = v[i].w; }
        LDS_WAIT(); asm volatile("" ::: "memory");
        const int c = lane & 7;
#pragma unroll
        for (int j = 0; j < 4; ++j) { const int n = (lane >> 3) + 8 * j; const LAS float* sp = scr + (8 * c) * 33 + n;
            v4u o; o.x = pk2(sp[0 * 33], sp[1 * 33]); o.y = pk2(sp[2 * 33], sp[3 * 33]); o.z = pk2(sp[4 * 33], sp[5 * 33]); o.w = pk2(sp[6 * 33], sp[7 * 33]);
            *(v4u*)(T.dst + (size_t)n * T.K + 8 * c) = o; }
        LDS_WAIT(); asm volatile("" ::: "memory");
        T = Tn;
#pragma unroll
        for (int i = 0; i < 8; ++i) v[i] = vn[i];
    }
    for (int o = (int)blockIdx.x * NWAVES * 64 + F.tid; o < DEPTH * 16 * 1024; o += (int)gridDim.x * NWAVES * 64) {
        const int k = o & 1023, j = (o >> 10) & 15, l = o >> 14;
        WSH(WS_W8T)[o] = (bf16)(j < 8 ? f2bf(W_IN[((size_t)l * D + k) * INC + NPROJ + j]) : 0u);
    }
    for (int o = (int)blockIdx.x * NWAVES * 64 + F.tid; o < DEPTH * 2 * NGB * 4096; o += (int)gridDim.x * NWAVES * 64) {
        const int i = o & 63, j = (o >> 6) & 63, g = (o >> 12) & 7, gate = (o >> 15) & 1, l = o >> 16;
        const float* src = gate ? GATE_X_W : GATE_A_W;
        WSH(WS_GT)[o] = (bf16)f2bf(src[(size_t)(l * NGB + g) * 4096 + i * 64 + j]);
    }
}

DI void p_cvec(Frame& F) {
    const int gw = F.vcu * NWAVES + F.wave, NGW = F.G * NWAVES, lane = F.lane;
    constexpr int IT_IN = NPROJ / 16, IT_UP = FF / 16, PER_L = IT_IN + IT_UP;
    for (int it = gw; it < DEPTH * PER_L; it += NGW) {
        const int l = it / PER_L, r = it % PER_L, which = r >= IT_IN, rg = which ? r - IT_IN : r, N = which ? FF : NPROJ;
        const bf16* wt = WSH(WS_W) + (size_t)l * LAYER_W + (which ? W_UP_OFF : 0) + (size_t)(rg * 16) * 1024 + 16 * lane;
        const float* shb = WSF(WS_MOD) + (size_t)l * BATCH * NMODC + (which ? 3 * D : 0) + 16 * lane;
        float* cout = (which ? WSF(WS_C2) + (size_t)l * BATCH * FF : WSF(WS_C1) + (size_t)l * BATCH * NPROJ) + rg * 16;
        f32x4 sh[4][4];
#pragma unroll
        for (int b = 0; b < 4; ++b)
#pragma unroll
            for (int j = 0; j < 4; ++j) sh[b][j] = *(const f32x4*)(shb + (size_t)b * NMODC + 4 * j);
        float v[64];
#pragma unroll
        for (int row = 0; row < 16; ++row) { const v4u w0 = *(const v4u*)(wt + (size_t)row * 1024), w1 = *(const v4u*)(wt + (size_t)row * 1024 + 8);
            const f32x4 wa = (f32x4){bflo(w0.x), bfhi(w0.x), bflo(w0.y), bfhi(w0.y)}, wb = (f32x4){bflo(w0.z), bfhi(w0.z), bflo(w0.w), bfhi(w0.w)};
            const f32x4 wc = (f32x4){bflo(w1.x), bfhi(w1.x), bflo(w1.y), bfhi(w1.y)}, wd = (f32x4){bflo(w1.z), bfhi(w1.z), bflo(w1.w), bfhi(w1.w)};
#pragma unroll
            for (int b = 0; b < 4; ++b) { const f32x4 t = sh[b][0] * wa + sh[b][1] * wb + sh[b][2] * wc + sh[b][3] * wd; v[row * 4 + b] = (t[0] + t[1]) + (t[2] + t[3]); } }
#pragma unroll
        for (int st = 0; st < 6; ++st) { const int bit = 1 << st; const bool up = lane & bit;
#pragma unroll
            for (int i = 0; i < (32 >> st); ++i) { const float keep = up ? v[2 * i + 1] : v[2 * i], send = up ? v[2 * i] : v[2 * i + 1]; v[i] = keep + bperm_(lane ^ bit, send); } }
        cout[(size_t)(lane & 3) * N + (lane >> 2)] = v[0];
    }
    if (gw < DEPTH * BATCH) { const int l = gw >> 2, b = gw & 3; float a[8];
#pragma unroll
        for (int j = 0; j < 8; ++j) a[j] = 0.f;
        for (int kk = 0; kk < 16; ++kk) { const int k = 16 * lane + kk; const float shv = WSF(WS_MOD)[((size_t)l * BATCH + b) * NMODC + k];
#pragma unroll
            for (int j = 0; j < 8; ++j) a[j] += shv * W_IN[((size_t)l * D + k) * INC + NPROJ + j]; }
#pragma unroll
        for (int j = 0; j < 8; ++j) a[j] = wave_sum_(lane, a[j]);
        if (lane < 8) { float r = a[0];
#pragma unroll
            for (int j = 1; j < 8; ++j) r = (lane == j) ? a[j] : r;
            WSF(WS_CB8)[(size_t)gw * 8 + lane] = r; } }
}

template <bool WITH_BG>
DI void p_normmod(Frame& F, int l, const float* xin, const float* normw, int off_sh, int off_sc) {
    LAS float* w8 = (LAS float*)F.lds;
    if (WITH_BG) {
        for (int i = F.tid; i < D * 8; i += NWAVES * 64) w8[i] = W_IN[((size_t)l * D + (i >> 3)) * INC + NPROJ + (i & 7)];
        __syncthreads();
    }
    const int gw = F.vcu * NWAVES + F.wave, NGW = F.G * NWAVES, lane = F.lane;
    f32x4 v[4];
    if (gw < M) {
#pragma unroll
        for (int j = 0; j < 4; ++j) v[j] = *(const f32x4*)(xin + (size_t)gw * D + 4 * lane + 256 * j);
    }
    for (int m = gw; m < M; m += NGW) {
        const int b = m >> 12, mn = m + NGW;
        f32x4 vnx[4];
#pragma unroll
        for (int j = 0; j < 4; ++j) vnx[j] = (mn < M) ? *(const f32x4*)(xin + (size_t)mn * D + 4 * lane + 256 * j) : (f32x4){0.f, 0.f, 0.f, 0.f};
        const float* modp = WSF(WS_MOD) + ((size_t)l * BATCH + b) * NMODC;
        float ss = 0.f;
#pragma unroll
        for (int j = 0; j < 4; ++j) ss += (v[j].x * v[j].x + v[j].y * v[j].y) + (v[j].z * v[j].z + v[j].w * v[j].w);
        ss = wave_sum_(lane, ss);
        const float rstd = 1.0f / sqrtf(ss * (1.0f / D) + EPS);
        float a0 = 0.f, a1 = 0.f, a2 = 0.f, a3 = 0.f, a4 = 0.f, a5 = 0.f, a6 = 0.f, a7 = 0.f;
#pragma unroll
        for (int j = 0; j < 4; ++j) {
            const int col = 4 * lane + 256 * j;
            const f32x4 nw = *(const f32x4*)(normw + (size_t)l * D + col), sc = *(const f32x4*)(modp + off_sc + col), sh = *(const f32x4*)(modp + off_sh + col);
            const f32x4 hv = v[j] * rstd * nw * (sc + 1.0f) + sh;
            v2u o; o.x = pk2(hv.x, hv.y); o.y = pk2(hv.z, hv.w);
            *(v2u*)(WSH(WS_H) + (size_t)m * D + col) = o;
            if (WITH_BG) {
#pragma unroll
                for (int e = 0; e < 4; ++e) { const f32x4 wa = *(const LAS f32x4*)(w8 + (col + e) * 8), wb = *(const LAS f32x4*)(w8 + (col + e) * 8 + 4); const float hh = hv[e];
                    a0 += hh * wa.x; a1 += hh * wa.y; a2 += hh * wa.z; a3 += hh * wa.w; a4 += hh * wb.x; a5 += hh * wb.y; a6 += hh * wb.z; a7 += hh * wb.w; }
            }
        }
        if (WITH_BG) {
            const bool b0 = lane & 1, b1 = lane & 2, b2 = lane & 4;
            float k0 = b0 ? a1 : a0, k1 = b0 ? a3 : a2, k2 = b0 ? a5 : a4, k3 = b0 ? a7 : a6;
            k0 += bperm_(lane ^ 1, b0 ? a0 : a1); k1 += bperm_(lane ^ 1, b0 ? a2 : a3); k2 += bperm_(lane ^ 1, b0 ? a4 : a5); k3 += bperm_(lane ^ 1, b0 ? a6 : a7);
            float c0 = b1 ? k1 : k0, c1 = b1 ? k3 : k2;
            c0 += bperm_(lane ^ 2, b1 ? k0 : k1); c1 += bperm_(lane ^ 2, b1 ? k2 : k3);
            float d = b2 ? c1 : c0;
            d += bperm_(lane ^ 4, b2 ? c0 : c1);
            d += bperm_(lane ^ 8, d); d += bperm_(lane ^ 16, d); d += bperm_(lane ^ 32, d);
            if (lane < 8) {
                const int hh = lane & 3;
                float r;
                if (lane < 4) r = sigmoidf_(d);
                else { const float xx = d + GDN_DT_BIAS[l * GH + hh]; const float sp = xx > 20.f ? xx : log1pf(expf(xx)); r = -expf(GDN_A_LOG[l * GH + hh]) * sp; }
                WSF(WS_BG)[(size_t)m * 8 + lane] = r;
            }
        }
#pragma unroll
        for (int j = 0; j < 4; ++j) v[j] = vnx[j];
    }
}

typedef float f32x2_t __attribute__((ext_vector_type(2))); typedef __bf16 bf16x2_t __attribute__((ext_vector_type(2)));
DI unsigned cvtpk(float lo, float hi) { f32x2_t v = {lo, hi}; bf16x2_t b = __builtin_convertvector(v, bf16x2_t); return __builtin_bit_cast(unsigned, b); }
DI bf16x8 pack8(f32x4 a, f32x4 b) { v4u p; p.x = cvtpk(a.x, a.y); p.y = cvtpk(a.z, a.w); p.z = cvtpk(b.x, b.y); p.w = cvtpk(b.z, b.w); return __builtin_bit_cast(bf16x8, p); }
DI bf16x8 ldfrag(const LAS unsigned char* p) { const v2u lo = *(const LAS v2u*)p, hi = *(const LAS v2u*)(p + 32); v4u r; r.x = lo.x; r.y = lo.y; r.z = hi.x; r.w = hi.y; return __builtin_bit_cast(bf16x8, r); }
#define MFMA16(a, b, c) __builtin_amdgcn_mfma_f32_16x16x32_bf16((a), (b), (c), 0, 0, 0)

#define WG_BAR() do { asm volatile("s_waitcnt lgkmcnt(0)" ::: "memory"); __builtin_amdgcn_s_barrier(); asm volatile("" ::: "memory"); } while (0)
DI bf16x8 ld128(const LAS unsigned char* p) { return *(const LAS bf16x8*)p; }
DI int kperm4(int k4) { return k4 < 16 ? 2 * k4 : 2 * (k4 - 16) + 4; }
DI int kperm(int k) { return (k & ~31) + kperm4(k & 28) + (k & 3); }
constexpr int PG_QB = 0, PG_KB = 17408, PG_KBET = 34816, PG_VT = 53248, PG_LS = 71680, PG_TS = 89088, PG_TB = 106496, PG_ATT = 115712, PG_XS = 124928, PG_SM = 128000, PG_END = 129024, PG_BGS = 140288;
static_assert(PG_END <= RING_BYTES && PG_BGS >= 8 * 17408 && PG_BGS + 2048 <= RING_BYTES, "prep LDS map");
DI void p_prep(Frame& F, int l) {
    const int wave = F.wave;
#define PREP_IDS int tid_ = F.tid; asm volatile("" : "+v"(tid_)); const int tid = tid_, lane = tid & 63, m = lane & 15, q = lane >> 4; (void)m; (void)q;
    for (int item = blockIdx.x; item < BATCH * NCH; item += gridDim.x) {
        const int b = item / NCH, n = item % NCH, row0 = b * SEQ + n * CH, t0 = n * CH;
        LAS float* bgs = (LAS float*)(F.lds + PG_BGS);
        if (wave < 4) {
            PREP_IDS
            const int mt = wave;
            const bf16* a1 = (l > 0 ? WSH(WS_A1) : WSH(WS_H)) + (size_t)(row0 + 16 * mt + m) * D + 8 * q;
            const bf16* w8t = WSH(WS_W8T) + (size_t)l * 16 * 1024 + (size_t)m * 1024 + 8 * q;
            f32x4 acc = (f32x4){0.f, 0.f, 0.f, 0.f};
#pragma unroll 8
            for (int kb = 0; kb < 32; ++kb) acc = MFMA16(*(const bf16x8*)(a1 + 32 * kb), *(const bf16x8*)(w8t + 32 * kb), acc);
            if (m < 8) { const int hh = m & 3; const float cb = l > 0 ? WSF(WS_CB8)[((size_t)l * BATCH + b) * 8 + m] : 0.f, dtb = GDN_DT_BIAS[l * GH + hh], alog = GDN_A_LOG[l * GH + hh];
#pragma unroll
                for (int r = 0; r < 4; ++r) { const int t = 16 * mt + 4 * q + r; const f32x4* rp = (const f32x4*)(WSF(WS_RS1) + (size_t)(row0 + t) * 16);
                    const f32x4 p0 = rp[0], p1 = rp[1], p2 = rp[2], p3 = rp[3], ts = (p0 + p1) + (p2 + p3);
                    const float rstd = l > 0 ? 1.0f / sqrtf(((ts[0] + ts[1]) + (ts[2] + ts[3])) * (1.0f / D) + EPS) : 1.0f, v = acc[r] * rstd + cb;
                    float res;
                    if (m < 4) res = sigmoidf_(v); else { const float xx = v + dtb; const float sp = xx > 20.f ? xx : log1p_acc(exp_fast(xx)); res = -expf(alog) * sp; }
                    bgs[t * 8 + m] = res; } }
        }
        for (int rep_ = 0; rep_ < PREP_REP_LRU; ++rep_) {
            PREP_IDS
            const int g = wave;
            LAS float* xr = (LAS float*)(F.lds + wave * 17408);
            const int tg = lane >> 3, cg = lane & 7, c0 = 8 * cg, cc0 = g * 64 + c0;
            v4u xp[11];
#pragma unroll
            for (int i = 0; i < 11; ++i) { const int tt = t0 + 8 * tg - 3 + i;
                xp[i] = (tt >= 0) ? *(const v4u*)(WSH(WS_PROJ) + (size_t)(b * SEQ + tt) * NPROJ + O_LX + cc0) : (v4u){0u, 0u, 0u, 0u}; }
            f32x4 wl_[4], wh_[4];
#pragma unroll
            for (int k = 0; k < 4; ++k) { wl_[k] = *(const f32x4*)(LRU_CONV_W + ((size_t)l * 4 + k) * LRUW + cc0); wh_[k] = *(const f32x4*)(LRU_CONV_W + ((size_t)l * 4 + k) * LRUW + cc0 + 4); }
            const f32x4 bl_ = *(const f32x4*)(LRU_CONV_B + l * LRUW + cc0), bh_ = *(const f32x4*)(LRU_CONV_B + l * LRUW + cc0 + 4);
            float ba_[4], bx_[4], ls_[4];
#pragma unroll
            for (int nt = 0; nt < 4; ++nt) { const int cc = g * 64 + 16 * nt + m; ba_[nt] = GATE_A_B[l * LRUW + cc]; bx_[nt] = GATE_X_B[l * LRUW + cc];
                const float lam = LRU_LAMBDA[l * LRUW + cc]; ls_[nt] = -8.0f * (fmaxf(-lam, 0.f) + log1p_acc(exp_fast(-fabsf(lam)))); }
#pragma unroll
            for (int tt = 0; tt < 8; ++tt) { f32x4 al = bl_, ah = bh_;
#pragma unroll
                for (int k = 0; k < 4; ++k) { const v4u xw = xp[tt + k];
                    al += wl_[k] * (f32x4){bflo(xw.x), bfhi(xw.x), bflo(xw.y), bfhi(xw.y)}; ah += wh_[k] * (f32x4){bflo(xw.z), bfhi(xw.z), bflo(xw.w), bfhi(xw.w)}; }
                *(LAS f32x4*)(xr + (8 * tg + tt) * 68 + c0) = al; *(LAS f32x4*)(xr + (8 * tg + tt) * 68 + c0 + 4) = ah; }
            asm volatile("s_waitcnt lgkmcnt(0)" ::: "memory");
            bf16x8 Bf[2][4][2];
#pragma unroll
            for (int gate = 0; gate < 2; ++gate)
#pragma unroll
                for (int nt = 0; nt < 4; ++nt)
#pragma unroll
                    for (int ks = 0; ks < 2; ++ks) Bf[gate][nt][ks] = *(const bf16x8*)(WSH(WS_GT) + ((size_t)((l * 2 + gate) * NGB + g)) * 4096 + (size_t)(16 * nt + m) * 64 + 32 * ks + 8 * q);
            bf16x8 Af[4][2];
#pragma unroll
            for (int mt = 0; mt < 4; ++mt)
#pragma unroll
                for (int ks = 0; ks < 2; ++ks) { const LAS float* pp = xr + (16 * mt + m) * 68 + 32 * ks + 8 * q; Af[mt][ks] = pack8(*(const LAS f32x4*)pp, *(const LAS f32x4*)(pp + 4)); }
#pragma unroll
            for (int nt = 0; nt < 4; ++nt) {
                float av[4][4], bv[4][4];
#pragma unroll
                for (int mt = 0; mt < 4; ++mt) { f32x4 ra = (f32x4){0.f, 0.f, 0.f, 0.f}, ia = (f32x4){0.f, 0.f, 0.f, 0.f};
                    ra = MFMA16(Af[mt][0], Bf[0][nt][0], ra); ra = MFMA16(Af[mt][1], Bf[0][nt][1], ra);
                    ia = MFMA16(Af[mt][0], Bf[1][nt][0], ia); ia = MFMA16(Af[mt][1], Bf[1][nt][1], ia);
#pragma unroll
                    for (int r = 0; r < 4; ++r) { const float rr = sigmoid_fast(ra[r] + ba_[nt]), ig = sigmoid_fast(ia[r] + bx_[nt]);
                        const float log_a = rr * ls_[nt], aa = exp_fast(log_a), mult = __builtin_amdgcn_sqrtf(fmaxf(1.0f - exp_fast(2.0f * log_a), 1e-12f));
                        av[mt][r] = aa; bv[mt][r] = mult * (ig * xr[(16 * mt + 4 * q + r) * 68 + 16 * nt + m]); } }
                float iP[4], iH[4];
#pragma unroll
                for (int mt = 0; mt < 4; ++mt) {
#pragma unroll
                    for (int r = 1; r < 4; ++r) { bv[mt][r] = av[mt][r] * bv[mt][r - 1] + bv[mt][r]; av[mt][r] = av[mt][r] * av[mt][r - 1]; }
                    float PA = av[mt][3], HA = bv[mt][3];
                    { const float Pp = shfl_up_(lane, PA, 16), Hp = shfl_up_(lane, HA, 16); if (q >= 1) { HA = PA * Hp + HA; PA = PA * Pp; } }
                    { const float Pp = shfl_up_(lane, PA, 32), Hp = shfl_up_(lane, HA, 32); if (q >= 2) { HA = PA * Hp + HA; PA = PA * Pp; } }
                    iP[mt] = PA; iH[mt] = HA; }
                float CP = 1.f, CH = 0.f;
#pragma unroll
                for (int mt = 0; mt < 4; ++mt) {
                    const float totP = bperm_(m + 48, iP[mt]), totH = bperm_(m + 48, iH[mt]);
                    float exP = shfl_up_(lane, iP[mt], 16), exH = shfl_up_(lane, iH[mt], 16); if (q == 0) { exP = 1.f; exH = 0.f; }
                    const float EP = CP * exP, EH = exP * CH + exH;
#pragma unroll
                    for (int r = 0; r < 4; ++r) { const float Pf = EP * av[mt][r], Hf = av[mt][r] * EH + bv[mt][r];
                        *(LAS unsigned*)(xr + (16 * mt + 4 * q + r) * 68 + 16 * nt + m) = f2bf(Hf) | (f2bf(Pf) << 16); }
                    CH = totP * CH + totH; CP = CP * totP; }
                if (q == 0) { WSF(WS_AGG)[((size_t)(b * NCH + n)) * LRUW + g * 64 + 16 * nt + m] = CP; WSF(WS_AGG)[(size_t)BATCH * NCH * LRUW + ((size_t)(b * NCH + n)) * LRUW + g * 64 + 16 * nt + m] = CH; }
            }
            if (l == 0) WG_BAR(); else asm volatile("s_waitcnt lgkmcnt(0)" ::: "memory");
#pragma unroll
            for (int i = 0; i < 16; ++i) { const int pz = lane + 64 * i, row = pz >> 4, c16 = pz & 15;
                *(v4u*)((unsigned*)(F.A->ws + WS_H) + (size_t)(row0 + row) * LRUW + g * 64 + 4 * c16) = *(const LAS v4u*)(xr + row * 68 + 4 * c16); }
        }
        WG_BAR();
        {
            LAS unsigned char* qb = F.lds + PG_QB;
            LAS unsigned char* kb = F.lds + PG_KB;
            LAS unsigned char* kbeT = F.lds + PG_KBET;
            LAS unsigned char* vT = F.lds + PG_VT;
            LAS float* Ls = (LAS float*)(F.lds + PG_LS);
            LAS float* Ts = (LAS float*)(F.lds + PG_TS);
            LAS unsigned char* wst = F.lds + PG_TS;
            LAS unsigned char* Tb = F.lds + PG_TB;
            LAS unsigned char* atts = F.lds + PG_ATT;
            LAS float* Xs = (LAS float*)(F.lds + PG_XS);
            LAS float* sm4 = (LAS float*)(F.lds + PG_SM);
            if (wave < GH) { int tl_ = F.tid; asm volatile("" : "+v"(tl_)); const int ln = tl_ & 63, hh = wave;
                float gcv = bgs[ln * 8 + 4 + hh];
#pragma unroll
                for (int off = 1; off < 64; off <<= 1) { const float pv = shfl_up_(ln, gcv, off); if (ln >= off) gcv += pv; }
                const float glast = bperm_(63, gcv);
                sm4[hh * 256 + ln] = gcv; sm4[hh * 256 + 64 + ln] = bgs[ln * 8 + hh]; sm4[hh * 256 + 128 + ln] = expf(gcv); sm4[hh * 256 + 192 + ln] = expf(glast - gcv); }
            WG_BAR();
#define G1_FETCH(hh_) do { int tf_ = F.tid; asm volatile("" : "+v"(tf_)); if (tf_ < 384) { const int cgp_ = tf_ & 15, wt_ = tf_ >> 4, which_ = wt_ >> 3, tr_ = wt_ & 7, ch_ = which_ * GDNW + (hh_) * HD + cgp_ * 8; \
                _Pragma("unroll") for (int i = 0; i < 11; ++i) { const int tt = t0 + tr_ * 8 - 3 + i; \
                    xpn[i] = (tt >= 0) ? *(const v4u*)(WSH(WS_PROJ) + (size_t)(b * SEQ + tt) * NPROJ + O_Q + ch_) : (v4u){0u, 0u, 0u, 0u}; } \
                } } while (0)
#pragma unroll 1
            for (int h = -1; h < GH; ++h) {
                PREP_IDS
                v4u xpn[11], pe[8];
                G1_FETCH(h + 1 < GH ? h + 1 : GH - 1);
                const int hn = h + 1;
                const size_t item4 = (size_t)(b * GH + h) * NCH + n, item4n = (size_t)(b * GH + hn) * NCH + n;
                LAS float* sgc = sm4 + h * 256, *sbeta = sgc + 64, *seg = sgc + 128;
                LAS float* sbetan = sm4 + hn * 256 + 64, *segn = sbetan + 64, *seln = sbetan + 128;
                if (h >= 0) {
                    const int it = wave >> 1;
                    bf16x8 Ak[4], Aq[4], Bk[2][4];
#pragma unroll
                    for (int ks = 0; ks < 4; ++ks) { Ak[ks] = ld128(kb + (16 * it + m) * 272 + (32 * ks + 8 * q) * 2); Aq[ks] = ld128(qb + (16 * it + m) * 272 + (32 * ks + 8 * q) * 2);
                        Bk[0][ks] = ld128(kb + (16 * ((wave & 1) * 2) + m) * 272 + (32 * ks + 8 * q) * 2); Bk[1][ks] = ld128(kb + (16 * ((wave & 1) * 2 + 1) + m) * 272 + (32 * ks + 8 * q) * 2); }
#pragma unroll
                    for (int jj = 0; jj < 2; ++jj) { const int jt = (wave & 1) * 2 + jj;
                        f32x4 kk = (f32x4){0.f, 0.f, 0.f, 0.f}, qk = (f32x4){0.f, 0.f, 0.f, 0.f};
                        if (jt <= it) {
#pragma unroll
                            for (int ks = 0; ks < 4; ++ks) { kk = MFMA16(Ak[ks], Bk[jj][ks], kk); qk = MFMA16(Aq[ks], Bk[jj][ks], qk); } }
                        const int j = 16 * jt + m; const float gj = sgc[j];
#pragma unroll
                        for (int r = 0; r < 4; ++r) { const int i = 16 * it + 4 * q + r;
                            const float dec = (j <= i) ? exp_fast(sgc[i] - gj) : 0.f;
                            Ls[i * 68 + j] = (j < i) ? sbeta[i] * kk[r] * dec : 0.f;
                            *(LAS unsigned short*)(atts + i * 144 + kperm(j) * 2) = (unsigned short)f2bf((j <= i) ? qk[r] * dec : 0.f); } }
                    WG_BAR();
                }
                if (h >= 0 && wave == 7) {
#ifdef PROBE_G3X2
                    for (int prb_ = 0; prb_ < 2; ++prb_) {
#else
                    {
#endif
                    { const int bk = lane >> 4, c = lane & 15; float x[16];
                        const LAS float* lb = Ls + (16 * bk) * 68 + 16 * bk;
#pragma unroll
                        for (int r = 0; r < 16; ++r) { float acc = (r == c) ? 1.f : 0.f;
#pragma unroll
                            for (int m4 = 0; m4 < (r + 3) / 4; ++m4) { const f32x4 lv = *(const LAS f32x4*)(lb + r * 68 + 4 * m4);
                                if (4 * m4 + 0 < r) acc -= lv.x * x[4 * m4 + 0]; if (4 * m4 + 1 < r) acc -= lv.y * x[4 * m4 + 1]; if (4 * m4 + 2 < r) acc -= lv.z * x[4 * m4 + 2]; if (4 * m4 + 3 < r) acc -= lv.w * x[4 * m4 + 3]; }
                            x[r] = acc; Ts[(16 * bk + r) * 68 + 16 * bk + c] = acc; *(LAS unsigned short*)(Tb + (16 * bk + r) * 144 + (16 * bk + c) * 2) = (unsigned short)f2bf(acc); } }
#pragma unroll
                    for (int e = 0; e < 4; ++e) { const int idx = lane + 64 * e, bz = idx >> 7, r = (idx >> 3) & 15, w = idx & 7;
                        *(LAS unsigned*)(Tb + (32 * bz + r) * 144 + (32 * bz + 16) * 2 + w * 4) = 0u; }
                    asm volatile("s_waitcnt lgkmcnt(0)" ::: "memory");
#pragma unroll
                    for (int dl = 1; dl < 4; ++dl) {
                        f32x4 xacc[3];
#pragma unroll
                        for (int e = 0; e < 4 - dl; ++e) { const int qd = lane + 64 * e, blk = qd >> 6, r = (qd >> 2) & 15, c4 = (qd & 3) * 4, i = blk + dl, j = blk;
                            const LAS float* lrow = Ls + (16 * i + r) * 68 + 16 * j; const LAS float* tcol = Ts + (16 * j) * 68 + 16 * j + c4;
                            f32x4 pa[4];
#pragma unroll
                            for (int mm4 = 0; mm4 < 4; ++mm4) pa[mm4] = (f32x4){0.f, 0.f, 0.f, 0.f};
#pragma unroll
                            for (int kk = 0; kk < dl; ++kk) {
#pragma unroll
                                for (int mm4 = 0; mm4 < 4; ++mm4) { const int mm = 4 * mm4; const f32x4 lv = *(const LAS f32x4*)(lrow + 16 * kk + mm); const LAS float* tc = tcol + (16 * kk + mm) * 68;
                                    pa[mm4] += lv.x * *(const LAS f32x4*)(tc) + lv.y * *(const LAS f32x4*)(tc + 68) + lv.z * *(const LAS f32x4*)(tc + 136) + lv.w * *(const LAS f32x4*)(tc + 204); } }
                            xacc[e] = (pa[0] + pa[1]) + (pa[2] + pa[3]); }
#pragma unroll
                        for (int e = 0; e < 4 - dl; ++e) { const int qd = lane + 64 * e, blk = qd >> 6, r = (qd >> 2) & 15, c4 = (qd & 3) * 4; *(LAS f32x4*)(Xs + blk * 256 + r * 16 + c4) = xacc[e]; }
                        asm volatile("s_waitcnt lgkmcnt(0)" ::: "memory");
#pragma unroll
                        for (int e = 0; e < 4 - dl; ++e) { const int qd = lane + 64 * e, blk = qd >> 6, r = (qd >> 2) & 15, c4 = (qd & 3) * 4, i = blk + dl, j = blk;
                            const LAS float* trow = Ts + (16 * i + r) * 68 + 16 * i; const LAS float* xc = Xs + blk * 256 + c4;
                            f32x4 pa[4];
#pragma unroll
                            for (int mm4 = 0; mm4 < 4; ++mm4) { const int mm = 4 * mm4; const f32x4 tv = *(const LAS f32x4*)(trow + mm);
                                pa[mm4] = tv.x * *(const LAS f32x4*)(xc + (mm + 0) * 16) + tv.y * *(const LAS f32x4*)(xc + (mm + 1) * 16) + tv.z * *(const LAS f32x4*)(xc + (mm + 2) * 16) + tv.w * *(const LAS f32x4*)(xc + (mm + 3) * 16); }
                            xacc[e] = -((pa[0] + pa[1]) + (pa[2] + pa[3])); }
#pragma unroll
                        for (int e = 0; e < 4 - dl; ++e) { const int qd = lane + 64 * e, blk = qd >> 6, r = (qd >> 2) & 15, c4 = (qd & 3) * 4, i = blk + dl, j = blk; const f32x4 acc = xacc[e];
                            *(LAS f32x4*)(Ts + (16 * i + r) * 68 + 16 * j + c4) = acc;
                            v2u pb; pb.x = f2bf(acc.x) | (f2bf(acc.y) << 16); pb.y = f2bf(acc.z) | (f2bf(acc.w) << 16); *(LAS v2u*)(Tb + (16 * i + r) * 144 + (16 * j + c4) * 2) = pb; }
                        asm volatile("s_waitcnt lgkmcnt(0)" ::: "memory");
                    }
                    }
                } else if (tid < 384 && hn < GH) {
                    const int cgp = tid & 15, wt = tid >> 4, which = wt >> 3, tr = wt & 7, d0 = cgp * 8, ch0 = which * GDNW + hn * HD + d0;
                    f32x4 wl_[4], wh_[4], ol[8], oh[8];
#pragma unroll
                    for (int k = 0; k < 4; ++k) { wl_[k] = *(const f32x4*)(GDN_CONV_W + ((size_t)l * 4 + k) * (3 * GDNW) + ch0); wh_[k] = *(const f32x4*)(GDN_CONV_W + ((size_t)l * 4 + k) * (3 * GDNW) + ch0 + 4); }
                    float ss[8];
#pragma unroll
                    for (int tt = 0; tt < 8; ++tt) { f32x4 al = (f32x4){0.f, 0.f, 0.f, 0.f}, ah = (f32x4){0.f, 0.f, 0.f, 0.f};
#pragma unroll
                        for (int k = 0; k < 4; ++k) { const v4u xw = xpn[tt + k];
                            al += wl_[k] * (f32x4){bflo(xw.x), bfhi(xw.x), bflo(xw.y), bfhi(xw.y)}; ah += wh_[k] * (f32x4){bflo(xw.z), bfhi(xw.z), bflo(xw.w), bfhi(xw.w)}; }
#pragma unroll
                        for (int c = 0; c < 4; ++c) { al[c] = silu_fast(al[c]); ah[c] = silu_fast(ah[c]); }
                        ol[tt] = al; oh[tt] = ah;
                        ss[tt] = (al.x * al.x + al.y * al.y) + (al.z * al.z + al.w * al.w) + (ah.x * ah.x + ah.y * ah.y) + (ah.z * ah.z + ah.w * ah.w); }
                    if (which < 2) {
#pragma unroll
                        for (int tt = 0; tt < 8; ++tt) { float v = ss[tt]; v += bperm_(lane ^ 1, v); v += bperm_(lane ^ 2, v); v += bperm_(lane ^ 4, v); v += bperm_(lane ^ 8, v);
                            const float scl = __builtin_amdgcn_rsqf(v + 1e-6f) * (which == 0 ? 0.08838834764831845f : 1.0f); ol[tt] = ol[tt] * scl; oh[tt] = oh[tt] * scl; }
                    }
                    const int tb = tr * 8;
                    if (which == 0) {
#pragma unroll
                        for (int tt = 0; tt < 8; ++tt) { const int t = tb + tt; const float eg = segn[t];
                            v4u pk; pk.x = cvtpk(ol[tt].x, ol[tt].y); pk.y = cvtpk(ol[tt].z, ol[tt].w); pk.z = cvtpk(oh[tt].x, oh[tt].y); pk.w = cvtpk(oh[tt].z, oh[tt].w);
                            *(LAS v4u*)(qb + t * 272 + d0 * 2) = pk;
                            v4u pg; pg.x = cvtpk(ol[tt].x * eg, ol[tt].y * eg); pg.y = cvtpk(ol[tt].z * eg, ol[tt].w * eg); pg.z = cvtpk(oh[tt].x * eg, oh[tt].y * eg); pg.w = cvtpk(oh[tt].z * eg, oh[tt].w * eg);
                            { bf16* qrow = WSH(WS_GQD) + item4n * 8192 + t * 128 + (d0 & ~31); const int kl = d0 & 31;
                                v2u p0; p0.x = pg.x; p0.y = pg.y; v2u p1; p1.x = pg.z; p1.y = pg.w; *(v2u*)(qrow + kperm4(kl)) = p0; *(v2u*)(qrow + kperm4(kl + 4)) = p1; } }
                    } else if (which == 1) {
                        float fb[8], fl[8];
#pragma unroll
                        for (int tt = 0; tt < 8; ++tt) { const int t = tb + tt; fb[tt] = sbetan[t] * segn[t]; fl[tt] = seln[t];
                            v4u pk; pk.x = cvtpk(ol[tt].x, ol[tt].y); pk.y = cvtpk(ol[tt].z, ol[tt].w); pk.z = cvtpk(oh[tt].x, oh[tt].y); pk.w = cvtpk(oh[tt].z, oh[tt].w);
                            *(LAS v4u*)(kb + t * 272 + d0 * 2) = pk; }
#define KV_(tt) ((c) < 4 ? ol[tt][(c) & 3] : oh[tt][(c) & 3])
#pragma unroll
                        for (int c = 0; c < 8; ++c) {
                            pe[c].x = cvtpk(KV_(0) * fb[0], KV_(1) * fb[1]); pe[c].y = cvtpk(KV_(2) * fb[2], KV_(3) * fb[3]); pe[c].z = cvtpk(KV_(4) * fb[4], KV_(5) * fb[5]); pe[c].w = cvtpk(KV_(6) * fb[6], KV_(7) * fb[7]);
                            v4u pt; pt.x = cvtpk(KV_(0) * fl[0], KV_(1) * fl[1]); pt.y = cvtpk(KV_(2) * fl[2], KV_(3) * fl[3]); pt.z = cvtpk(KV_(4) * fl[4], KV_(5) * fl[5]); pt.w = cvtpk(KV_(6) * fl[6], KV_(7) * fl[7]);
                            { bf16* krow = WSH(WS_GKT) + item4n * 8192 + (d0 + c) * 64 + (tb & ~31); const int kl = tb & 31;
                                v2u p0; p0.x = pt.x; p0.y = pt.y; v2u p1; p1.x = pt.z; p1.y = pt.w; *(v2u*)(krow + kperm4(kl)) = p0; *(v2u*)(krow + kperm4(kl + 4)) = p1; } }
                    } else {
                        float fb[8];
#pragma unroll
                        for (int tt = 0; tt < 8; ++tt) fb[tt] = sbetan[tb + tt];
#pragma unroll
                        for (int c = 0; c < 8; ++c) { pe[c].x = cvtpk(KV_(0) * fb[0], KV_(1) * fb[1]); pe[c].y = cvtpk(KV_(2) * fb[2], KV_(3) * fb[3]); pe[c].z = cvtpk(KV_(4) * fb[4], KV_(5) * fb[5]); pe[c].w = cvtpk(KV_(6) * fb[6], KV_(7) * fb[7]); }
#undef KV_
                    }
                }
                WG_BAR();
                if (h >= 0) {
                    const int nt = wave;
#pragma unroll
                    for (int mt = 0; mt < 4; ++mt) { f32x4 ua = (f32x4){0.f, 0.f, 0.f, 0.f}, wa = (f32x4){0.f, 0.f, 0.f, 0.f};
#pragma unroll
                        for (int ks = 0; ks < 2; ++ks) if (32 * ks <= 16 * mt + 15) { const bf16x8 A = ld128(Tb + (16 * mt + m) * 144 + (32 * ks + 8 * q) * 2);
                            const int swz = (((4 * ks + q) ^ ((2 * nt + (m >> 3)) & 7)) * 16);
                            ua = MFMA16(A, ld128(vT + (16 * nt + m) * 144 + swz), ua); wa = MFMA16(A, ld128(kbeT + (16 * nt + m) * 144 + swz), wa); }
                        unsigned uts[4];
#pragma unroll
                        for (int r = 0; r < 4; ++r) { const int t = 16 * mt + 4 * q + r, d = 16 * nt + m;
                            uts[r] = f2bf(ua[r]); *(LAS unsigned short*)(wst + t * 272 + kperm(d) * 2) = (unsigned short)f2bf(-wa[r]); }
                        { v2u pu; pu.x = uts[0] | (uts[1] << 16); pu.y = uts[2] | (uts[3] << 16); *(LAS v2u*)(F.lds + PG_LS + (16 * nt + m) * 128 + (((2 * mt + (q >> 1)) ^ (m & 7)) * 16) + (q & 1) * 8) = pu; } }
                    WG_BAR();
                }
                if (h >= 0) {
#pragma unroll
                    for (int e = 0; e < 2; ++e) { const int p = tid + 512 * e, row = p >> 4, c16 = p & 15;
                        *(v4u*)((unsigned char*)(WSH(WS_MIX + 16 * MiB) + item4 * 8192) + row * 256 + c16 * 16) = *(const LAS v4u*)(wst + row * 272 + c16 * 16);
                        const int ur = p >> 3, uc = p & 7;
                        *(v4u*)((unsigned char*)(WSH(WS_MIX) + item4 * 8192) + ur * 128 + uc * 16) = *(const LAS v4u*)(F.lds + PG_LS + ur * 128 + ((uc ^ (ur & 7)) * 16)); }
                    { const int row = tid >> 3, c16 = tid & 7;
                        *(v4u*)((unsigned char*)(WSH(WS_GATT) + item4 * 4096) + row * 128 + c16 * 16) = *(const LAS v4u*)(atts + row * 144 + c16 * 16); }
                    if (tid == 0) WSF(WS_GL)[item4] = seg[63];
                }
                if (tid >= 128 && tid < 384 && hn < GH) {
                    const int cgp = tid & 15, wt = tid >> 4, which = wt >> 3, tr = wt & 7, d0 = cgp * 8;
                    LAS unsigned char* dstT = which == 1 ? kbeT : vT;
#pragma unroll
                    for (int c = 0; c < 8; ++c) *(LAS v4u*)(dstT + (d0 + c) * 144 + ((tr ^ (cgp & 7)) * 16)) = pe[c];
                }
                WG_BAR();
            }
        }
    }
}

#undef PREP_IDS
constexpr int SC_W = 0, SC_QD = 18432, SC_KT = 36864, SC_AT = 57344, SC_U = 67584, SC_STAGE = 76800;
static_assert(2 * SC_STAGE <= RING_BYTES, "scan stages fit the ring");
#define SBAR_() __builtin_amdgcn_sched_barrier(0)
constexpr int NSEG = 8, SEGC = NCH / NSEG;
constexpr size_t WS_PSI = 344 * MiB;
constexpr size_t WS_PHI = 352 * MiB;
constexpr size_t WS_SST = 356 * MiB;
static_assert(WS_SST + 8 * MiB <= WS_END, "two-level scan scratch");

#define SC_ADDR() \
        const unsigned char* gW = (const unsigned char*)(WSH(WS_MIX + 16 * MiB) + it0 * 8192); \
        const unsigned char* gQD = (const unsigned char*)(WSH(WS_GQD) + it0 * 8192); \
        const unsigned char* gKT = (const unsigned char*)(WSH(WS_GKT) + it0 * 8192); \
        const unsigned char* gAT = (const unsigned char*)(WSH(WS_GATT) + it0 * 4096); \
        const unsigned char* gU = (const unsigned char*)(WSH(WS_MIX) + it0 * 8192) + dvbase * 128;
#define SC_LOAD(rg, n_) do { const size_t cb = (size_t)(n_) * 16384, ca = (size_t)(n_) * 8192; \
            _Pragma("unroll") for (int i = 0; i < 4; ++i) { rg[i] = *(const v4u*)(gW + cb + gofW + i * 4096); if (FULL) rg[4 + i] = *(const v4u*)(gQD + cb + gofW + i * 4096); \
                rg[8 + i] = *(const v4u*)(gKT + cb + gofK + i * 4096); } \
            _Pragma("unroll") for (int i = 0; i < 2; ++i) { if (FULL) rg[12 + i] = *(const v4u*)(gAT + ca + gofK + i * 4096); rg[14 + i] = *(const v4u*)(gU + cb + gofK + i * 4096); } } while (0)
#define SC_WRITE(rg, buf_) do { LAS unsigned char* sb_ = F.lds + (buf_) * SC_STAGE; \
            _Pragma("unroll") for (int i = 0; i < 4; ++i) { *(LAS v4u*)(sb_ + SC_W + lofW + i * (16 * 288)) = rg[i]; if (FULL) *(LAS v4u*)(sb_ + SC_QD + lofW + i * (16 * 288)) = rg[4 + i]; \
                *(LAS v4u*)(sb_ + SC_KT + lofK + i * (32 * 160)) = rg[8 + i]; } \
            _Pragma("unroll") for (int i = 0; i < 2; ++i) { if (FULL) *(LAS v4u*)(sb_ + SC_AT + lofK + i * (32 * 160)) = rg[12 + i]; *(LAS v4u*)(sb_ + SC_U + lofU + i * (32 * 144)) = rg[14 + i]; } } while (0)
#define SC_LOADER_LOOP() do { \
            int lt_ = F.tid & 255; asm volatile("" : "+v"(lt_)); \
            const int gofW = (lt_ >> 4) * 256 + (lt_ & 15) * 16, gofK = (lt_ >> 3) * 128 + (lt_ & 7) * 16; \
            const int lofW = (lt_ >> 4) * 288 + (lt_ & 15) * 16, lofK = (lt_ >> 3) * 160 + (lt_ & 7) * 16, lofU = (lt_ >> 3) * 144 + (lt_ & 7) * 16; \
            const int nlast = n0 + SEGC - 1; \
            v4u ra[16], rb[16]; \
            SC_LOAD(ra, n0); SC_WRITE(ra, 0); SC_LOAD(ra, n0 + 1); SC_LOAD(rb, n0 + 2); \
            __syncthreads(); \
            _Pragma("unroll 1") for (int j = 0; j < SEGC; j += 2) { \
                  \
                  \
                SC_WRITE(ra, 1); \
                { const int nn = n0 + j + 3 < nlast ? n0 + j + 3 : nlast; SC_LOAD(ra, nn); } \
                WG_BAR(); \
                SC_WRITE(rb, 0); \
                { const int nn = n0 + j + 4 < nlast ? n0 + j + 4 : nlast; SC_LOAD(rb, nn); } \
                WG_BAR(); \
            } } while (0)

DI void p_scan1(Frame& F, int l) {
    constexpr bool FULL = false;
    const int wave = F.wave;
    { const int lane = F.lane;
        for (int p = blockIdx.x * NWAVES + wave; p < BATCH * LRUW; p += gridDim.x * NWAVES) { const int b = p / LRUW, c = p % LRUW;
            float A = WSF(WS_AGG)[((size_t)(b * NCH + lane)) * LRUW + c], B = WSF(WS_AGG)[(size_t)BATCH * NCH * LRUW + ((size_t)(b * NCH + lane)) * LRUW + c];
#pragma unroll
            for (int off = 1; off < 64; off <<= 1) { const float Ap = shfl_up_(lane, A, off), Bp = shfl_up_(lane, B, off); if (lane >= off) { B = A * Bp + B; A = A * Ap; } }
            if (lane < 63) WSF(WS_CARRY)[((size_t)(b * NCH + lane + 1)) * LRUW + c] = B; else WSF(WS_CARRY)[((size_t)(b * NCH)) * LRUW + c] = 0.f; } }
    const bool is_loader = wave >= 4;
    const int wv = wave & 3;
    for (int job = F.vcu; job < BATCH * GH * NSEG * 2; job += F.G) {
        const int bh = job >> 4, seg = (job >> 1) & (NSEG - 1), dvbase = (job & 1) * 64, n0 = seg * SEGC;
        const size_t it0 = (size_t)bh * NCH;
        SC_ADDR()
        (void)gQD; (void)gAT;
        if (seg == NSEG - 1) { __syncthreads(); continue; }
        if (is_loader) { SC_LOADER_LOOP(); }
        else {
            int tc_ = F.tid; asm volatile("" : "+v"(tc_)); const int lane = tc_ & 63, m = lane & 15, q = lane >> 4;
            const int col = dvbase + 16 * wv + m;
            f32x4 Sacc[2][8];
#pragma unroll
            for (int dt = 0; dt < 8; ++dt) { Sacc[0][dt] = (f32x4){0.f, 0.f, 0.f, 0.f};
#pragma unroll
                for (int r = 0; r < 4; ++r) Sacc[1][dt][r] = (16 * dt + 4 * q + r == col) ? 1.f : 0.f; }
            const float glv = WSF(WS_GL)[it0 + lane];
            __syncthreads();
#pragma unroll 1
            for (int j = 0; j < SEGC; ++j) {
                const LAS unsigned char* B = F.lds + (j & 1) * SC_STAGE;
                bf16x8 fa[4], fb[4], Sb[2][4], vnb[2][2];
                f32x4 vn[2][4];
                v2u ut[4];
#pragma unroll
                for (int mt = 0; mt < 4; ++mt) ut[mt] = *(const LAS v2u*)(B + SC_U + (16 * wv + m) * 144 + (16 * mt + 4 * q) * 2);
#define LDW4(dst, mt_) do { _Pragma("unroll") for (int kb = 0; kb < 4; ++kb) dst[kb] = ld128(B + SC_W + (16 * (mt_) + m) * 288 + (32 * kb + 8 * q) * 2); } while (0)
#define MMW2(src, mt_) do { _Pragma("unroll") for (int kb = 0; kb < 4; ++kb) { vn[0][mt_] = MFMA16(src[kb], Sb[0][kb], vn[0][mt_]); vn[1][mt_] = MFMA16(src[kb], Sb[1][kb], vn[1][mt_]); } } while (0)
#define LDK4(dst, dt_) do { dst[0] = ld128(B + SC_KT + (16 * (dt_) + m) * 160 + (8 * q) * 2); dst[1] = ld128(B + SC_KT + (16 * (dt_) + m) * 160 + (32 + 8 * q) * 2); \
                            dst[2] = ld128(B + SC_KT + (16 * ((dt_) + 1) + m) * 160 + (8 * q) * 2); dst[3] = ld128(B + SC_KT + (16 * ((dt_) + 1) + m) * 160 + (32 + 8 * q) * 2); } while (0)
#define MMK2(src, dt_) do { _Pragma("unroll") for (int e = 0; e < 2; ++e) { Sacc[e][dt_] = MFMA16(src[0], vnb[e][0], Sacc[e][dt_]); Sacc[e][dt_] = MFMA16(src[1], vnb[e][1], Sacc[e][dt_]); \
                            Sacc[e][(dt_) + 1] = MFMA16(src[2], vnb[e][0], Sacc[e][(dt_) + 1]); Sacc[e][(dt_) + 1] = MFMA16(src[3], vnb[e][1], Sacc[e][(dt_) + 1]); } } while (0)
                LDW4(fa, 0); SBAR_();
#pragma unroll
                for (int e = 0; e < 2; ++e)
#pragma unroll
                    for (int kb = 0; kb < 4; ++kb) Sb[e][kb] = pack8(Sacc[e][2 * kb], Sacc[e][2 * kb + 1]);
#pragma unroll
                for (int mt = 0; mt < 4; ++mt) { vn[0][mt] = (f32x4){bflo(ut[mt].x), bfhi(ut[mt].x), bflo(ut[mt].y), bfhi(ut[mt].y)}; vn[1][mt] = (f32x4){0.f, 0.f, 0.f, 0.f}; }
                const float gl = __builtin_bit_cast(float, __builtin_amdgcn_readlane(__builtin_bit_cast(int, glv), n0 + j));
                SBAR_(); LDW4(fb, 1); SBAR_(); MMW2(fa, 0); SBAR_();
                LDW4(fa, 2); SBAR_(); MMW2(fb, 1); SBAR_();
                LDW4(fb, 3); SBAR_(); MMW2(fa, 2); SBAR_();
                LDK4(fa, 0); SBAR_(); MMW2(fb, 3); SBAR_();
#pragma unroll
                for (int e = 0; e < 2; ++e) { vnb[e][0] = pack8(vn[e][0], vn[e][1]); vnb[e][1] = pack8(vn[e][2], vn[e][3]);
#pragma unroll
                    for (int dt = 0; dt < 8; ++dt) Sacc[e][dt] = Sacc[e][dt] * gl; }
                SBAR_(); LDK4(fb, 2); SBAR_(); MMK2(fa, 0); SBAR_();
                LDK4(fa, 4); SBAR_(); MMK2(fb, 2); SBAR_();
                LDK4(fb, 6); SBAR_(); MMK2(fa, 4); SBAR_();
                MMK2(fb, 6); SBAR_();
                WG_BAR();
            }
#undef LDW4
#undef MMW2
#undef LDK4
#undef MMK2
            float* psi = WSF(WS_PSI) + ((size_t)(bh * NSEG + seg) * 128) * 128 + col;
            bf16* phi = WSH(WS_PHI) + ((size_t)(bh * NSEG + seg) * 128) * 128 + kperm(col);
#pragma unroll
            for (int dt = 0; dt < 8; ++dt)
#pragma unroll
                for (int r = 0; r < 4; ++r) { const int dk = 16 * dt + 4 * q + r; psi[(size_t)dk * 128] = Sacc[0][dt][r]; phi[(size_t)dk * 128] = (bf16)f2bf(Sacc[1][dt][r]); }
        }
        __syncthreads();
    }
}

DI void p_scan2(Frame& F, int l) {
    const int wave = F.wave;
    for (int bh = blockIdx.x; bh < BATCH * GH; bh += gridDim.x) {
        int tc_ = F.tid; asm volatile("" : "+v"(tc_)); const int tid = tc_, lane = tc_ & 63, m = lane & 15, q = lane >> 4;
        const int col = 16 * wave + m;
        const int gof = (tid >> 4) * 256 + (tid & 15) * 16, lof = (tid >> 4) * 288 + (tid & 15) * 16;
        const unsigned char* phi0 = (const unsigned char*)(WSH(WS_PHI) + ((size_t)(bh * NSEG) * 128) * 128);
        const float* psi0 = WSF(WS_PSI) + ((size_t)(bh * NSEG) * 128) * 128 + col;
        float* sst0 = WSF(WS_SST) + ((size_t)(bh * NSEG) * 128) * 128 + col;
        f32x4 S[8], Ps[8]; v4u pr[4];
#pragma unroll
        for (int dt = 0; dt < 8; ++dt) { S[dt] = (f32x4){0.f, 0.f, 0.f, 0.f};
#pragma unroll
            for (int r = 0; r < 4; ++r) Ps[dt][r] = psi0[(size_t)(16 * dt + 4 * q + r) * 128]; }
#pragma unroll
        for (int i = 0; i < 4; ++i) pr[i] = *(const v4u*)(phi0 + gof + i * 8192);
#pragma unroll
        for (int i = 0; i < 4; ++i) *(LAS v4u*)(F.lds + lof + i * (32 * 288)) = pr[i];
        __syncthreads();
#pragma unroll 1
        for (int seg = 0; seg + 1 < NSEG; ++seg) {
            if (seg > 0) {
#pragma unroll
                for (int dt = 0; dt < 8; ++dt)
#pragma unroll
                    for (int r = 0; r < 4; ++r) sst0[((size_t)seg * 128 + 16 * dt + 4 * q + r) * 128] = S[dt][r]; }
            const int sn = seg + 2 < NSEG ? seg + 1 : seg;
#pragma unroll
            for (int i = 0; i < 4; ++i) pr[i] = *(const v4u*)(phi0 + (size_t)sn * 32768 + gof + i * 8192);
            f32x4 Pn[8];
#pragma unroll
            for (int dt = 0; dt < 8; ++dt)
#pragma unroll
                for (int r = 0; r < 4; ++r) Pn[dt][r] = psi0[((size_t)sn * 128 + 16 * dt + 4 * q + r) * 128];
            const LAS unsigned char* B = F.lds + (seg & 1) * 36864;
            bf16x8 Sb[4];
#pragma unroll
            for (int kb = 0; kb < 4; ++kb) Sb[kb] = pack8(S[2 * kb], S[2 * kb + 1]);
#pragma unroll
            for (int dt = 0; dt < 8; ++dt) { f32x4 acc = Ps[dt];
#pragma unroll
                for (int kb = 0; kb < 4; ++kb) acc = MFMA16(ld128(B + (16 * dt + m) * 288 + (32 * kb + 8 * q) * 2), Sb[kb], acc);
                S[dt] = acc; }
#pragma unroll
            for (int dt = 0; dt < 8; ++dt) Ps[dt] = Pn[dt];
#pragma unroll
            for (int i = 0; i < 4; ++i) *(LAS v4u*)(F.lds + ((seg + 1) & 1) * 36864 + lof + i * (32 * 288)) = pr[i];
            __syncthreads();
        }
#pragma unroll
        for (int dt = 0; dt < 8; ++dt)
#pragma unroll
            for (int r = 0; r < 4; ++r) sst0[((size_t)(NSEG - 1) * 128 + 16 * dt + 4 * q + r) * 128] = S[dt][r];
        __syncthreads();
    }
}

DI void p_scan3(Frame& F, int l) {
    constexpr bool FULL = true;
    const int wave = F.wave;
    const bool is_loader = wave >= 4;
    const int wv = wave & 3;
    for (int job = F.vcu; job < BATCH * GH * NSEG * 2; job += F.G) {
        const int bh = job >> 4, seg = (job >> 1) & (NSEG - 1), dvbase = (job & 1) * 64, n0 = seg * SEGC, b = bh >> 2, h = bh & 3;
        const size_t it0 = (size_t)bh * NCH;
        SC_ADDR()
        if (is_loader) { SC_LOADER_LOOP(); }
        else {
            int tc_ = F.tid; asm volatile("" : "+v"(tc_)); const int lane = tc_ & 63, m = lane & 15, q = lane >> 4;
            f32x4 Sacc[8];
            if (seg == 0) {
#pragma unroll
                for (int dt = 0; dt < 8; ++dt) Sacc[dt] = (f32x4){0.f, 0.f, 0.f, 0.f};
            } else { const float* sst = WSF(WS_SST) + ((size_t)(bh * NSEG + seg) * 128) * 128 + dvbase + 16 * wv + m;
#pragma unroll
                for (int dt = 0; dt < 8; ++dt)
#pragma unroll
                    for (int r = 0; r < 4; ++r) Sacc[dt][r] = sst[(size_t)(16 * dt + 4 * q + r) * 128]; }
            const float glv = WSF(WS_GL)[it0 + lane];
            __syncthreads();
#define FR_W(dst, mt_) do { _Pragma("unroll") for (int kb = 0; kb < 4; ++kb) { dst[kb] = ld128(B + SC_W + (16 * (mt_) + m) * 288 + (32 * kb + 8 * q) * 2); dst[4 + kb] = ld128(B + SC_QD + (16 * (mt_) + m) * 288 + (32 * kb + 8 * q) * 2); } } while (0)
#define MM_W(src, mt_) do { _Pragma("unroll") for (int kb = 0; kb < 4; ++kb) { vn[mt_] = MFMA16(src[kb], Sb[kb], vn[mt_]); o[mt_] = MFMA16(src[4 + kb], Sb[kb], o[mt_]); } } while (0)
#define FR_KT(dst, hf_) do { _Pragma("unroll") for (int i = 0; i < 8; ++i) dst[i] = ld128(B + SC_KT + (16 * (4 * (hf_) + (i >> 1)) + m) * 160 + (32 * (i & 1) + 8 * q) * 2); } while (0)
#define MM_KT(src, hf_) do { _Pragma("unroll") for (int i = 0; i < 8; ++i) Sacc[4 * (hf_) + (i >> 1)] = MFMA16(src[i], vnb[i & 1], Sacc[4 * (hf_) + (i >> 1)]); } while (0)
#pragma unroll 1
            for (int j = 0; j < SEGC; ++j) {
                const int n = n0 + j;
                const LAS unsigned char* B = F.lds + (j & 1) * SC_STAGE;
                bf16x8 fa[8], fb[8], Sb[4], vnb[2];
                f32x4 vn[4], o[4];
                v2u ut[4];
#pragma unroll
                for (int mt = 0; mt < 4; ++mt) ut[mt] = *(const LAS v2u*)(B + SC_U + (16 * wv + m) * 144 + (16 * mt + 4 * q) * 2);
                FR_W(fa, 0); SBAR_();
#pragma unroll
                for (int kb = 0; kb < 4; ++kb) Sb[kb] = pack8(Sacc[2 * kb], Sacc[2 * kb + 1]);
#pragma unroll
                for (int mt = 0; mt < 4; ++mt) { o[mt] = (f32x4){0.f, 0.f, 0.f, 0.f}; vn[mt] = (f32x4){bflo(ut[mt].x), bfhi(ut[mt].x), bflo(ut[mt].y), bfhi(ut[mt].y)}; }
                const float gl = __builtin_bit_cast(float, __builtin_amdgcn_readlane(__builtin_bit_cast(int, glv), n));
                SBAR_(); FR_W(fb, 1); SBAR_(); MM_W(fa, 0); SBAR_();
                FR_W(fa, 2); SBAR_(); MM_W(fb, 1); SBAR_();
                FR_W(fb, 3); SBAR_(); MM_W(fa, 2); SBAR_();
                fa[0] = ld128(B + SC_AT + (m) * 160 + (8 * q) * 2); fa[1] = ld128(B + SC_AT + (16 + m) * 160 + (8 * q) * 2);
                fa[2] = ld128(B + SC_AT + (32 + m) * 160 + (8 * q) * 2); fa[3] = ld128(B + SC_AT + (32 + m) * 160 + (32 + 8 * q) * 2);
                fa[4] = ld128(B + SC_AT + (48 + m) * 160 + (8 * q) * 2); fa[5] = ld128(B + SC_AT + (48 + m) * 160 + (32 + 8 * q) * 2);
                SBAR_(); MM_W(fb, 3); SBAR_();
                vnb[0] = pack8(vn[0], vn[1]); vnb[1] = pack8(vn[2], vn[3]);
#pragma unroll
                for (int dt = 0; dt < 8; ++dt) Sacc[dt] = Sacc[dt] * gl;
                SBAR_(); FR_KT(fb, 0); SBAR_();
                o[0] = MFMA16(fa[0], vnb[0], o[0]); o[1] = MFMA16(fa[1], vnb[0], o[1]); o[2] = MFMA16(fa[2], vnb[0], o[2]); o[3] = MFMA16(fa[4], vnb[0], o[3]);
                o[2] = MFMA16(fa[3], vnb[1], o[2]); o[3] = MFMA16(fa[5], vnb[1], o[3]);
                SBAR_(); FR_KT(fa, 1); SBAR_(); MM_KT(fb, 0); SBAR_();
                MM_KT(fa, 1); SBAR_();
                float* go = WSF(WS_GO) + (size_t)(b * SEQ + n * CH + 4 * q) * GDNW + h * HD + dvbase + 16 * wv + m;
#pragma unroll
                for (int mt = 0; mt < 4; ++mt)
#pragma unroll
                    for (int r = 0; r < 4; ++r) go[(size_t)(16 * mt + r) * GDNW] = o[mt][r];
                WG_BAR();
            }
#undef FR_W
#undef MM_W
#undef FR_KT
#undef MM_KT
        }
        __syncthreads();
    }
}
#undef SC_ADDR
#undef SC_LOAD
#undef SC_WRITE
#undef SC_LOADER_LOOP

DI float gelu_fast(float x) { const float u2 = 1.5957691216057308f * (x + 0.044715f * x * x * x); return x * rcp_(1.f + exp_fast(-u2)); }
struct PostRow { v4u hp[2]; v2u y2[2], z2[2]; f32x4 go[2], cr[2]; };
DI void post_load(Frame& F, PostRow& R, int m, int lane) {
    const int b = m >> 12, n = (m & (SEQ - 1)) >> 6;
#pragma unroll
    for (int j = 0; j < 2; ++j) { const int c = 4 * lane + 256 * j;
        R.hp[j] = *(const v4u*)((const unsigned*)(F.A->ws + WS_H) + (size_t)m * LRUW + c);
        R.cr[j] = *(const f32x4*)(WSF(WS_CARRY) + ((size_t)(b * NCH + n)) * LRUW + c);
        R.y2[j] = *(const v2u*)(WSH(WS_PROJ) + (size_t)m * NPROJ + O_LY + c);
        R.go[j] = *(const f32x4*)(WSF(WS_GO) + (size_t)m * GDNW + c);
        R.z2[j] = *(const v2u*)(WSH(WS_PROJ) + (size_t)m * NPROJ + O_Z + c); }
}
DI void p_post(Frame& F, int l) {
    const int gw = F.vcu * NWAVES + F.wave, NGW = F.G * NWAVES, lane = F.lane;
    PostRow R;
    if (gw < M) post_load(F, R, gw, lane);
    for (int m = gw; m < M; m += NGW) {
        PostRow Rn; const int mn = m + NGW;
        post_load(F, Rn, mn < M ? mn : m, lane);
        f32x4 val[2]; float ss = 0.f;
#pragma unroll
        for (int j = 0; j < 2; ++j) { const v4u hp = R.hp[j]; const v2u y2 = R.y2[j];
            const f32x4 hl = (f32x4){bflo(hp.x), bflo(hp.y), bflo(hp.z), bflo(hp.w)}, p = (f32x4){bfhi(hp.x), bfhi(hp.y), bfhi(hp.z), bfhi(hp.w)};
            const f32x4 hh = hl + p * R.cr[j];
            val[j] = (f32x4){hh.x * gelu_fast(bflo(y2.x)), hh.y * gelu_fast(bfhi(y2.x)), hh.z * gelu_fast(bflo(y2.y)), hh.w * gelu_fast(bfhi(y2.y))};
            ss += (val[j].x * val[j].x + val[j].y * val[j].y) + (val[j].z * val[j].z + val[j].w * val[j].w); }
        ss = wave_sum_(lane, ss);
        const float rl = 1.0f / sqrtf(ss * (1.0f / LRUW) + EPS);
#pragma unroll
        for (int j = 0; j < 2; ++j) { const int c = 4 * lane + 256 * j; const f32x4 nw = *(const f32x4*)(LRU_NORM_W + (size_t)l * LRUW + c);
            const f32x4 o = val[j] * rl * nw; v2u w; w.x = pk2(o.x, o.y); w.y = pk2(o.z, o.w); *(v2u*)(WSH(WS_MIX) + (size_t)m * D + c) = w; }
#pragma unroll
        for (int j = 0; j < 2; ++j) { const int c = 4 * lane + 256 * j, d = c & (HD - 1);
            const f32x4 o = R.go[j]; const v2u z2 = R.z2[j];
            const float s2 = half_sum_(lane, (o.x * o.x + o.y * o.y) + (o.z * o.z + o.w * o.w));
            const float rg = 1.0f / sqrtf(s2 * (1.0f / HD) + EPS);
            const f32x4 nw = *(const f32x4*)(GDN_NORM_W + (size_t)l * HD + d);
            const f32x4 r = (f32x4){o.x * rg * nw.x * silu_fast(bflo(z2.x)), o.y * rg * nw.y * silu_fast(bfhi(z2.x)), o.z * rg * nw.z * silu_fast(bflo(z2.y)), o.w * rg * nw.w * silu_fast(bfhi(z2.y))};
            v2u w; w.x = pk2(r.x, r.y); w.y = pk2(r.z, r.w); *(v2u*)(WSH(WS_MIX) + (size_t)m * D + LRUW + c) = w; }
        R = Rn;
    }
}

typedef _Float16 h16x4 __attribute__((ext_vector_type(4)));
DI void final_row(Frame& F, const _Float16* xrow, float* orow, int lane) {
    f32x4 v[4]; float ss = 0.f;
#pragma unroll
    for (int j = 0; j < 4; ++j) { const h16x4 hv = *(const h16x4*)(xrow + 4 * lane + 256 * j); v[j] = (f32x4){(float)hv[0], (float)hv[1], (float)hv[2], (float)hv[3]};
        ss += (v[j].x * v[j].x + v[j].y * v[j].y) + (v[j].z * v[j].z + v[j].w * v[j].w); }
    ss = wave_sum_(lane, ss);
    const float rstd = 1.0f / sqrtf(ss * (1.0f / D) + EPS);
#pragma unroll
    for (int j = 0; j < 4; ++j) { const int col = 4 * lane + 256 * j; const f32x4 nw = *(const f32x4*)(FINAL_NORM_W + col); *(f32x4*)(orow + col) = v[j] * rstd * nw; }
}
DI void p_final(Frame& F) {
    const int gw = F.vcu * NWAVES + F.wave, NGW = F.G * NWAVES, lane = F.lane;
    for (int m = gw; m < M; m += NGW) final_row(F, (const _Float16*)(F.A->ws + WS_H) + (size_t)m * D, OUT_ + (size_t)m * D, lane);
}

__device__ __forceinline__ void pg8::EpiMulti::operator()(const f32x4 (&acc)[2][2][4][2], const Unit& u, int wr, int wc, int fr, int fq, int ui) const {
    const PG8_LAS float* rtab = ui < 4 ? rt + ui * 256 : nullptr;
    const __attribute__((address_space(4))) Args* ap = (const __attribute__((address_space(4))) Args*)__builtin_amdgcn_kernarg_segment_ptr(); asm volatile("" : "+s"(ap));
    unsigned char* ws = ap->ws;
    const int b = (u.pm * BM) / SEQ;
    if (mode == 0) { EpiBf16<0> e{(bf16_t*)(ws + WS_PROJ), NPROJ, nullptr, 0, 0, 1.f, nullptr, nullptr}; e(acc, u, wr, wc, fr, fq); }
    else if (mode == 5) { EpiBf16<0> e{(bf16_t*)(ws + WS_PROJ), NPROJ, (const float*)(ws + WS_C1) + ((size_t)l * BATCH + b) * NPROJ, 0, 0, 1.f, rtab, (const float*)(ws + WS_RS1)}; e(acc, u, wr, wc, fr, fq); }
    else if (mode == 6) { EpiBf16<2> e{(bf16_t*)(ws + WS_ACT), FF, (const float*)(ws + WS_C2) + ((size_t)l * BATCH + b) * FF, 0, 0, 1.f, rtab, (const float*)(ws + WS_RS2)}; e(acc, u, wr, wc, fr, fq); }
    else if (mode == 3) { const float* modb = (const float*)(ws + WS_MOD) + ((size_t)l * BATCH + b) * NMODC; _Float16* x16 = (_Float16*)((unsigned char*)ap->out + X16_OFF);
        EpiResid2 r{ap->in[0], l == 0 ? nullptr : x16, x16, modb + 2 * D, ap->in[3] + (size_t)l * D, modb + 4 * D, (bf16_t*)(ws + WS_H), (float*)(ws + WS_RS2)}; r(acc, u, wr, wc, fr, fq); }
    else { const float* modb = (const float*)(ws + WS_MOD) + ((size_t)l * BATCH + b) * NMODC; const bool nx = l + 1 < DEPTH; _Float16* x16 = (_Float16*)((unsigned char*)ap->out + X16_OFF);
        EpiResid2 r{nullptr, x16, nx ? x16 : (_Float16*)(ws + WS_H), modb + 5 * D, nx ? ap->in[2] + (size_t)(l + 1) * D : nullptr, modb + NMODC * BATCH + D, (bf16_t*)(ws + WS_A1), (float*)(ws + WS_RS1)}; r(acc, u, wr, wc, fr, fq); }
}

__global__ void __launch_bounds__(NWAVES * 64, 2) mk_fwd(Args args) {
    extern __shared__ __attribute__((aligned(16))) unsigned char lds[];
    Frame F;
    F.lds = (LAS unsigned char*)lds;
    F.MISC = (volatile LAS unsigned*)(F.lds + MISC_OFF);
    F.tid = threadIdx.x; F.lane = F.tid & 63; F.wave = __builtin_amdgcn_readfirstlane(F.tid >> 6);
    F.G = gridDim.x; { const int bx = blockIdx.x; F.vcu = (F.G % 8 == 0) ? (bx % 8) * (F.G / 8) + bx / 8 : bx; }
    F.A = (const __attribute__((address_space(4))) Args*)__builtin_amdgcn_kernarg_segment_ptr();
    F.ctl = (gu32*)(F.A->ws + WS_CTL);
    for (int u = F.tid; u < (LDS_BYTES - LDSCTL_OFF) / 4; u += NWAVES * 64) ((LAS unsigned*)(F.lds + LDSCTL_OFF))[u] = 0u;
    __syncthreads();
    XcdBarrier bar; bar.bar = (unsigned*)(F.ctl + CW_BAR); bar.x = 0; bar.st = nullptr;
    if (N_LAUNCHES == 1) bar = xcd_barrier_post((unsigned*)(F.ctl + CW_BAR), F.MISC + 8);

    const int lo = F.A->ph_lo, hi = F.A->ph_hi;
    int rep_done = 0;
#pragma unroll 1
    for (int s = lo; s < hi; ++s) {
        { const __attribute__((address_space(4))) Args* ap = (const __attribute__((address_space(4))) Args*)__builtin_amdgcn_kernarg_segment_ptr(); asm volatile("" : "+s"(ap)); F.A = ap; }
        { int t_ = threadIdx.x; asm volatile("" : "+v"(t_)); F.tid = t_; F.lane = t_ & 63; F.wave = __builtin_amdgcn_readfirstlane(t_ >> 6); }
        if (s == 0) { if (PH_MASK & 1) { p_mod(F); __syncthreads(); p0_weights(F); xcd_barrier(bar, F.tid == 0); p_cvec(F); __syncthreads(); p_normmod<false>(F, 0, X_IN, NORM_MIX_W, 0, D); } }
        else if (s == N_STEPS - 1) { if (PH_MASK & 2) { p_final(F); } }
        else {
            const int l = (s - 1) / 9, i = (s - 1) % 9;
            if (i == 0 || i == 6) continue;
            bf16* wl = WSH(WS_W) + (size_t)l * LAYER_W;
            const float* modl = WSF(WS_MOD) + (size_t)l * BATCH * NMODC;
            if (!((PH_MASK >> (2 + i)) & 1)) {}
            else if (i == 0) { p_normmod<true>(F, l, l == 0 ? X_IN : OUT_, NORM_MIX_W, 0, D); }
            else if (i == 2) { p_prep(F, l); }
            else if (i == 3) {
                p_scan1(F, l); xcd_barrier(bar, F.tid == 0);
#if defined(SCAN_REP) && SCAN_REP == 1
                p_scan1(F, l); xcd_barrier(bar, F.tid == 0);
#endif
                p_scan2(F, l); xcd_barrier(bar, F.tid == 0);
#if defined(SCAN_REP) && SCAN_REP == 2
                p_scan2(F, l); xcd_barrier(bar, F.tid == 0);
#endif
                p_scan3(F, l);
#if defined(SCAN_REP) && SCAN_REP == 3
                xcd_barrier(bar, F.tid == 0); p_scan3(F, l);
#endif
            }
            else if (i == 4) { p_post(F, l); }
            else if (i == 6) { p_normmod<false>(F, l, OUT_, NORM_MLP_W, 3 * D, 4 * D); }
            else {
                pg8::Gemm g; pg8::EpiMulti E; E.l = l; E.rt = (const LAS float*)(F.lds + RSTAB_OFF);
                if (i == 1) { g = pg8::Gemm{l == 0 ? WSH(WS_H) : WSH(WS_A1), wl, M, NPROJ, D}; E.PERM = true; E.mode = (l == 0 ? 0 : 5); }
                else if (i == 5) { g = pg8::Gemm{WSH(WS_MIX), wl + W_OUT_OFF, M, D, D}; E.PERM = true; E.mode = 3; }
                else if (i == 7) { g = pg8::Gemm{WSH(WS_H), wl + W_UP_OFF, M, FF, D}; E.PERM = true; E.mode = 6; }
                else { g = pg8::Gemm{WSH(WS_ACT), wl + W_DOWN_OFF, M, D, FF}; E.PERM = true; E.mode = 4; }
                pg8::StaticOrder S; S.init(g.M, g.N, F.G, (int)blockIdx.x);
                if (E.mode == 5 || E.mode == 6) {
                    LAS float* tab = (LAS float*)(F.lds + RSTAB_OFF); const float* rsp = WSF(E.mode == 5 ? WS_RS1 : WS_RS2);
                    const int slot = F.tid >> 7; pg8::Unit uu;
                    if (S.next(slot, uu)) for (int rr = F.tid & 127; rr < 256; rr += 128) { const f32x4* rp = (const f32x4*)(rsp + (size_t)(uu.pm * 256 + rr) * 16);
                        const f32x4 p0 = rp[0], p1 = rp[1], p2 = rp[2], p3 = rp[3], ts = (p0 + p1) + (p2 + p3);
                        tab[slot * 256 + rr] = 1.0f / sqrtf(((ts[0] + ts[1]) + (ts[2] + ts[3])) * (1.0f / D) + EPS); }
                    __syncthreads(); }
                pg8::gemm_phase<pg8::EpiMulti, pg8::StaticOrder, PG8_ALIGN, PG8_SP2>(F.lds + RING_OFF, g, S, E);
            }
        }
        if (REP_MASK != 0 && ((s >= 1 && s < N_STEPS - 1 && ((REP_MASK >> ((s - 1) % 9)) & 1)) || (s == 0 && (REP_MASK & 0x10000))) && !rep_done) { rep_done = 1; --s; xcd_barrier(bar, F.tid == 0); continue; }
        rep_done = 0;
        if (s + 1 < hi) xcd_barrier(bar, F.tid == 0);
#ifdef PROBE_XBAR
        if (s >= 1 && s < N_STEPS - 1) { xcd_barrier(bar, F.tid == 0); xcd_barrier(bar, F.tid == 0); }
#endif
    }
}

extern "C" void kernel_launch(void* const* d_in, const int* in_sizes, int n_in, void* d_out, int out_size, void* d_ws, size_t ws_size, hipStream_t stream) {
    static int grid = 0;
    if (grid == 0) {
        if (n_in != 23 || in_sizes[0] != M * D || out_size != M * D || ws_size < WS_END) { fprintf(stderr, "kernel_launch: unexpected shapes (n_in %d, in0 %d, out %d, ws %zu); nothing launched\n", n_in, n_in > 0 ? in_sizes[0] : -1, out_size, ws_size); grid = -1; return; }
        int dev = 0, cus = 0;
        if (hipGetDevice(&dev) != hipSuccess || hipDeviceGetAttribute(&cus, hipDeviceAttributeMultiprocessorCount, dev) != hipSuccess) { grid = -1; return; }
        if (hipFuncSetAttribute((const void*)mk_fwd, hipFuncAttributeMaxDynamicSharedMemorySize, LDS_BYTES) != hipSuccess) { fprintf(stderr, "kernel_launch: hipFuncSetAttribute failed\n"); grid = -1; return; }
        (void)hipGetLastError();
        grid = cus;
    }
    if (grid < 0) return;
    if (hipMemsetAsync((char*)d_ws + WS_CTL, 0, CTL_ZERO_BYTES, stream) != hipSuccess) return;
    Args a{};
    for (int i = 0; i < 23; ++i) a.in[i] = (const float*)d_in[i];
    a.out = (float*)d_out; a.ws = (unsigned char*)d_ws;
    if (N_LAUNCHES == 1) { a.ph_lo = 0; a.ph_hi = N_STEPS; hipLaunchKernelGGL(mk_fwd, dim3(grid), dim3(NWAVES * 64), LDS_BYTES, stream, a); }
    else for (int s = 0; s < N_STEPS; ++s) { a.ph_lo = s; a.ph_hi = s + 1; hipLaunchKernelGGL(mk_fwd, dim3(grid), dim3(NWAVES * 64), LDS_BYTES, stream, a); }
}
```

```cpp
#include <hip/hip_runtime.h>
#include <cstdio>
#include <cstdint>
#include <cmath>
namespace pg8 {
#define PG8_LAS __attribute__((address_space(3)))
typedef unsigned short bf16_t;
typedef short bf16x8 __attribute__((ext_vector_type(8)));
typedef float f32x4 __attribute__((ext_vector_type(4)));
typedef unsigned u32x4 __attribute__((ext_vector_type(4)));
constexpr int BM = 256, BK = 64, HALF = 128, HTB = HALF * BK * 2  , STAGE_BYTES = 8 * HTB, NXCD = 8, WGM = 8;

__host__ __device__ __forceinline__ int lds_byte(int r, int c) { const int st = (r >> 4) * 2 + (c >> 5), rr = r & 15, cc = c & 31, ob = rr * 64 + cc * 2; return st * 1024 + (ob ^ (((ob >> 9) & 1) << 5)); }
__host__ __device__ __forceinline__ void stage_rc(int b, int& R, int& C) { const int st = b / 1024, sb = b % 1024, swz = sb ^ (((sb >> 9) & 1) << 5); R = (st >> 1) * 16 + swz / 64; C = (st & 1) * 32 + (swz % 64) / 2; }
__host__ __device__ __forceinline__ int perm32(int rho) { const int n = rho >> 4, i = rho & 15; return 8 * (i >> 2) + 4 * n + (i & 3); }

struct Unit { int pm, pn; };
struct Gemm { const bf16_t* A; const bf16_t* Bt; int M, N, K; };

struct StaticOrder {
    int nM, nN, nwg, G, c;
    __host__ __device__ void init(int M, int N, int G_, int c_) { nM = M / BM; nN = N / BM; nwg = nM * nN; G = G_; c = c_; }
    __host__ __device__ bool next(int i, Unit& u) const {
        const long L = (long)i * G + c; if (L >= nwg) return false;
        int wgid = (int)L; { const int q = nwg / NXCD, r = nwg % NXCD, xcd = wgid % NXCD, off = wgid / NXCD; wgid = (xcd < r ? xcd * (q + 1) : r * (q + 1) + (xcd - r) * q) + off; }
        const int nig = WGM * nN, gid = wgid / nig, fm = gid * WGM, gsz = (nM - fm) < WGM ? (nM - fm) : WGM;
        u.pm = fm + ((wgid % nig) % gsz); u.pn = (wgid % nig) / gsz; return true;
    }
    __device__ __forceinline__ void a_ready(const Unit&) const {}
    __device__ __forceinline__ void done(const Unit&) const {}
};

__device__ __forceinline__ unsigned cvt_pk_bf16(float lo, float hi) { unsigned r; asm volatile("v_cvt_pk_bf16_f32 %0, %1, %2" : "=v"(r) : "v"(lo), "v"(hi)); return r; }
typedef float f32x2 __attribute__((ext_vector_type(2)));
__device__ __forceinline__ f32x2 gelu_pk(f32x2 v) {
    const f32x2 av = __builtin_elementwise_abs(v), d = av * 0.2316418882f + 1.0f;
    f32x2 t; t.x = __builtin_amdgcn_rcpf(d.x); t.y = __builtin_amdgcn_rcpf(d.y);
    f32x2 q = t * 0.5307027145f + (-0.7265760135f); q = q * t + 0.7107068705f; q = q * t + (-0.142248368f); q = q * t + 0.127414796f; q = q * t;
    const f32x2 s = (v * v) * (-0.72134752044f);
    f32x2 e; e.x = __builtin_amdgcn_exp2f(s.x); e.y = __builtin_amdgcn_exp2f(s.y);
    const f32x2 m = v * (q * e), r = v - m;
    f32x2 o; o.x = v.x < 0.f ? m.x : r.x; o.y = v.y < 0.f ? m.y : r.y; return o;
}

template <int ACT  > struct EpiBf16 {
    static constexpr bool PERM = true, AFTER_DRAIN = false; static_assert(ACT == 0 || ACT == 1 || ACT == 2, "EpiBf16: ACT is 0 (none), 1 (gelu_pk) or 2 (squared relu)");
    bf16_t* O; int ldc; const float* bias; int split_cols; size_t split_stride; float scale0;
    const PG8_LAS float* rtab = nullptr;
    const float* rs = nullptr;
    __device__ __forceinline__ void operator()(const f32x4 (&acc)[2][2][4][2], const Unit& u, int wr, int wc, int fr, int fq) const {
        const int row0 = u.pm * BM + wr * 64 + fr; int colt = u.pn * BM; bf16_t* base = O;
        float sc = 1.f; if (split_cols) { const int t = colt / split_cols; base += (size_t)t * split_stride; colt -= t * split_cols; if (t == 0) sc = scale0; }
        const int col0 = colt + wc * 64 + 8 * fq, bcol0 = u.pn * BM + wc * 64 + 8 * fq;
        f32x4 bv[2][2];
#pragma unroll
        for (int bj = 0; bj < 2; ++bj)
#pragma unroll
            for (int n = 0; n < 2; ++n) bv[bj][n] = bias ? *(const f32x4*)(bias + bcol0 + bj * 32 + 4 * n) : (f32x4){0.f, 0.f, 0.f, 0.f};
#pragma unroll
        for (int ai = 0; ai < 2; ++ai)
#pragma unroll
            for (int m = 0; m < 4; ++m) { bf16_t* rowp = base + (size_t)(row0 + ai * HALF + m * 16) * ldc + col0;
                float rsc = 1.f;
                if (rtab) rsc = rtab[wr * 64 + fr + ai * HALF + m * 16];
                else if (rs) { const f32x4* rp = (const f32x4*)(rs + (size_t)(row0 + ai * HALF + m * 16) * 16); const f32x4 p0 = rp[0], p1 = rp[1], p2 = rp[2], p3 = rp[3];
                    const f32x4 t = (p0 + p1) + (p2 + p3); rsc = 1.0f / sqrtf(((t[0] + t[1]) + (t[2] + t[3])) * (1.0f / 1024.0f) + 1e-6f); }
#pragma unroll
                for (int bj = 0; bj < 2; ++bj) { f32x4 v0 = acc[ai][bj][m][0] * rsc + bv[bj][0], v1 = acc[ai][bj][m][1] * rsc + bv[bj][1];
                    if (ACT == 1) { f32x2 a = gelu_pk((f32x2){v0[0], v0[1]}), b = gelu_pk((f32x2){v0[2], v0[3]}), c = gelu_pk((f32x2){v1[0], v1[1]}), d = gelu_pk((f32x2){v1[2], v1[3]});
                        v0 = (f32x4){a.x, a.y, b.x, b.y}; v1 = (f32x4){c.x, c.y, d.x, d.y}; }
                    if (ACT == 2) { _Pragma("unroll") for (int q_ = 0; q_ < 4; ++q_) { const float a_ = fmaxf(v0[q_], 0.f), b_ = fmaxf(v1[q_], 0.f); v0[q_] = a_ * a_; v1[q_] = b_ * b_; } }
                    v0 = v0 * sc; v1 = v1 * sc; u32x4 w; w.x = cvt_pk_bf16(v0[0], v0[1]); w.y = cvt_pk_bf16(v0[2], v0[3]); w.z = cvt_pk_bf16(v1[0], v1[1]); w.w = cvt_pk_bf16(v1[2], v1[3]);
                    *(u32x4*)(rowp + bj * 32) = w; } }
    }
};


struct EpiResid {
    static constexpr bool PERM = false, AFTER_DRAIN = false;
    const float* base; float* out; const float* gate; int ldc; int gate_stride; int rows_per_batch;
    __device__ __forceinline__ void operator()(const f32x4 (&acc)[2][2][4][2], const Unit& u, int wr, int wc, int fr, int fq) const {
        const int col0 = u.pn * BM + wc * 32 + 4 * fq;
        const float* gp = gate + (size_t)((u.pm * BM) / rows_per_batch) * gate_stride + col0;
        f32x4 gv[2][2];
#pragma unroll
        for (int bj = 0; bj < 2; ++bj)
#pragma unroll
            for (int n = 0; n < 2; ++n) gv[bj][n] = *(const f32x4*)(gp + bj * HALF + n * 16);
#pragma unroll
        for (int ai = 0; ai < 2; ++ai)
#pragma unroll
            for (int m = 0; m < 4; ++m) { const size_t off = (size_t)(u.pm * BM + ai * HALF + wr * 64 + m * 16 + fr) * ldc + col0;
#pragma unroll
                for (int bj = 0; bj < 2; ++bj)
#pragma unroll
                    for (int n = 0; n < 2; ++n) { const f32x4 bs = *(const f32x4*)(base + off + bj * HALF + n * 16);
                        *(f32x4*)(out + off + bj * HALF + n * 16) = bs + gv[bj][n] * acc[ai][bj][m][n]; } }
    }
};


typedef _Float16 f16x8 __attribute__((ext_vector_type(8)));
typedef _Float16 f16x4 __attribute__((ext_vector_type(4)));
struct EpiResid2 {
    static constexpr bool PERM = true, AFTER_DRAIN = false;
    const float* base32; const _Float16* base16; _Float16* out16; const float* gate;
    const float* nw; const float* sc;
    bf16_t* anext; float* rsum;
    __device__ __forceinline__ void operator()(const f32x4 (&acc)[2][2][4][2], const Unit& u, int wr, int wc, int fr, int fq) const {
        const int col0 = u.pn * BM + wc * 64 + 8 * fq, lane = fr + 16 * fq;
        f32x4 gv[2][2], ns[2][2];
#pragma unroll
        for (int bj = 0; bj < 2; ++bj)
#pragma unroll
            for (int n = 0; n < 2; ++n) { const int c = col0 + bj * 32 + 4 * n; gv[bj][n] = *(const f32x4*)(gate + c);
                ns[bj][n] = nw ? *(const f32x4*)(nw + c) * (*(const f32x4*)(sc + c) + 1.0f) : (f32x4){0.f, 0.f, 0.f, 0.f}; }
#pragma unroll
        for (int ai = 0; ai < 2; ++ai)
#pragma unroll
            for (int m = 0; m < 4; ++m) { const size_t off = (size_t)(u.pm * BM + ai * HALF + wr * 64 + m * 16 + fr) * 1024 + col0;
                f32x4 bs[2][2];
                if (base16) {
                    f16x8 hb[2];
#pragma unroll
                    for (int bj = 0; bj < 2; ++bj) hb[bj] = *(const f16x8*)(base16 + off + bj * 32);
#pragma unroll
                    for (int bj = 0; bj < 2; ++bj) { bs[bj][0] = (f32x4){(float)hb[bj][0], (float)hb[bj][1], (float)hb[bj][2], (float)hb[bj][3]}; bs[bj][1] = (f32x4){(float)hb[bj][4], (float)hb[bj][5], (float)hb[bj][6], (float)hb[bj][7]}; }
                } else {
#pragma unroll
                    for (int bj = 0; bj < 2; ++bj)
#pragma unroll
                        for (int n = 0; n < 2; ++n) bs[bj][n] = *(const f32x4*)(base32 + off + bj * 32 + 4 * n);
                }
                float ssq = 0.f;
#pragma unroll
                for (int bj = 0; bj < 2; ++bj) { const f32x4 x0 = bs[bj][0] + gv[bj][0] * acc[ai][bj][m][0], x1 = bs[bj][1] + gv[bj][1] * acc[ai][bj][m][1];
                    f16x8 ho; ho[0] = (_Float16)x0[0]; ho[1] = (_Float16)x0[1]; ho[2] = (_Float16)x0[2]; ho[3] = (_Float16)x0[3]; ho[4] = (_Float16)x1[0]; ho[5] = (_Float16)x1[1]; ho[6] = (_Float16)x1[2]; ho[7] = (_Float16)x1[3];
                    *(f16x8*)(out16 + off + bj * 32) = ho;
                    if (nw) { const f32x4 h0 = x0 * ns[bj][0], h1 = x1 * ns[bj][1]; u32x4 w; w.x = cvt_pk_bf16(h0[0], h0[1]); w.y = cvt_pk_bf16(h0[2], h0[3]); w.z = cvt_pk_bf16(h1[0], h1[1]); w.w = cvt_pk_bf16(h1[2], h1[3]);
                        *(u32x4*)(anext + off + bj * 32) = w;
                        ssq += ((x0[0] * x0[0] + x0[1] * x0[1]) + (x0[2] * x0[2] + x0[3] * x0[3])) + ((x1[0] * x1[0] + x1[1] * x1[1]) + (x1[2] * x1[2] + x1[3] * x1[3])); } }
                if (nw) { ssq += __builtin_bit_cast(float, __builtin_amdgcn_ds_bpermute((lane ^ 16) << 2, __builtin_bit_cast(int, ssq)));
                    ssq += __builtin_bit_cast(float, __builtin_amdgcn_ds_bpermute((lane ^ 32) << 2, __builtin_bit_cast(int, ssq)));
                    if (fq == 0) rsum[(size_t)(u.pm * BM + ai * HALF + wr * 64 + m * 16 + fr) * 16 + u.pn * 4 + wc] = ssq; }
                if (m & 1) asm volatile("" ::: "memory"); }
    }
};

struct EpiMulti {
    static constexpr bool AFTER_DRAIN = false;
    bool PERM; int mode, l; const PG8_LAS float* rt;
    __device__ __forceinline__ void operator()(const f32x4 (&acc)[2][2][4][2], const Unit& u, int wr, int wc, int fr, int fq, int ui) const;
};

template <class Epi, class Sched, bool ALIGN_EPI = false, bool SP2 = false>
__device__ __forceinline__ void gemm_phase(PG8_LAS unsigned char* lds, const Gemm g, const Sched& S, const Epi& E) {
    int tid_l = threadIdx.x; asm volatile("" : "+v"(tid_l));
    const int tid = tid_l, wid = __builtin_amdgcn_readfirstlane(tid >> 6), lane = tid & 63, wr = wid >> 2, wc = wid & 3, fr = lane & 15, fq = lane >> 4;
    const int K = g.K, nt = K / BK;
    unsigned voffA[2], voffB[2];
#pragma unroll
    for (int i = 0; i < 2; ++i) { int R, C; stage_rc(tid * 16 + i * 8192, R, C); const int Rb = E.PERM ? (64 * (R >> 5) + perm32(R & 31)) : R;
        voffA[i] = (unsigned)(R * K + C) * 2u; voffB[i] = (unsigned)(Rb * K + C) * 2u; }
    const size_t kstep = (size_t)(BK * 2);
    const size_t hstep = (size_t)HALF * K * 2;
    const size_t tstep = 2 * hstep;
    const size_t hstepB = E.PERM ? (size_t)32 * K * 2 : hstep;
    const unsigned ldsw = (unsigned)wid * 1024u;
    const int aoff = lds_byte(wr * 64 + fr, fq * 8), boff = lds_byte(wc * 32 + fr, fq * 8);
#define PG8_SA(b, h) (((b) * 2 + (h)) * HTB)
#define PG8_SB(b, h) ((4 + (b) * 2 + (h)) * HTB)
#define PG8_STAGE(bufoff, gbase, voff) do { _Pragma("unroll") for (int _i = 0; _i < 2; ++_i) \
        __builtin_amdgcn_global_load_lds((const unsigned*)((const char*)(gbase) + (voff)[_i]), (PG8_LAS unsigned*)(lds + (bufoff) + ldsw + _i * 8192), 16, 0, 0); } while (0)
#define PG8_LDA(dst, b, h) do { _Pragma("unroll") for (int m = 0; m < 4; ++m) _Pragma("unroll") for (int k = 0; k < 2; ++k) dst[m][k] = *(const PG8_LAS bf16x8*)(lds + PG8_SA(b, h) + aoff + m * 2048 + k * 1024); } while (0)
#define PG8_LDB(dst, b, h) do { _Pragma("unroll") for (int n = 0; n < 2; ++n) _Pragma("unroll") for (int k = 0; k < 2; ++k) dst[n][k] = *(const PG8_LAS bf16x8*)(lds + PG8_SB(b, h) + boff + n * 2048 + k * 1024); } while (0)
#define PG8_MMA(ai, bj, At, Bt) do { __builtin_amdgcn_s_setprio(1); _Pragma("unroll") for (int m = 0; m < 4; ++m) _Pragma("unroll") for (int n = 0; n < 2; ++n) _Pragma("unroll") for (int k = 0; k < 2; ++k) \
        acc[ai][bj][m][n] = __builtin_amdgcn_mfma_f32_16x16x32_bf16(Bt[n][k], At[m][k], acc[ai][bj][m][n], 0, 0, 0); __builtin_amdgcn_s_setprio(0); } while (0)
#define PG8_WAIT_V(n) asm volatile("s_waitcnt vmcnt(" #n ")" ::: "memory")
#define PG8_WAIT_L(n) asm volatile("s_waitcnt lgkmcnt(" #n ")" ::: "memory")
#define PG8_BAR __builtin_amdgcn_s_barrier()
#define PG8_SCHED __builtin_amdgcn_sched_barrier(0)
    Unit cur, nxt; int ui = 0;
    if (!S.next(0, cur)) return;
    f32x4 acc[2][2][4][2];
#pragma unroll
    for (int a = 0; a < 2; ++a)
#pragma unroll
        for (int b = 0; b < 2; ++b)
#pragma unroll
            for (int m = 0; m < 4; ++m)
#pragma unroll
                for (int n = 0; n < 2; ++n) acc[a][b][m][n] = (f32x4){0.f, 0.f, 0.f, 0.f};
    bf16x8 At[4][2], B0[2][2], B1[2][2];
    const char* cA = (const char*)g.A + (size_t)cur.pm * tstep; const char* cB = (const char*)g.Bt + (size_t)cur.pn * tstep;
    S.a_ready(cur);
    if constexpr (SP2) {
        PG8_STAGE(PG8_SB(0, 0), cB, voffB); PG8_STAGE(PG8_SB(0, 1), cB + hstepB, voffB); PG8_STAGE(PG8_SA(0, 0), cA, voffA); PG8_STAGE(PG8_SA(0, 1), cA + hstep, voffA);
        if (wr == 1) PG8_BAR;
        PG8_WAIT_V(2); PG8_BAR;
        PG8_STAGE(PG8_SB(1, 0), cB + kstep, voffB); PG8_STAGE(PG8_SA(1, 0), cA + kstep, voffA); PG8_STAGE(PG8_SB(1, 1), cB + hstepB + kstep, voffB);
        PG8_WAIT_V(6); PG8_BAR;
    } else {
        PG8_STAGE(PG8_SB(0, 0), cB, voffB); PG8_STAGE(PG8_SA(0, 0), cA, voffA); PG8_STAGE(PG8_SB(0, 1), cB + hstepB, voffB); PG8_STAGE(PG8_SA(0, 1), cA + hstep, voffA);
        if (wr == 1) PG8_BAR;
        PG8_WAIT_V(4); PG8_BAR;
        PG8_STAGE(PG8_SB(1, 0), cB + kstep, voffB); PG8_STAGE(PG8_SA(1, 0), cA + kstep, voffA); PG8_STAGE(PG8_SB(1, 1), cB + hstepB + kstep, voffB);
        PG8_WAIT_V(6); PG8_BAR;
    }
    for (;;) {
        const bool has_next = S.next(ui + 1, nxt);
        const char* nA = has_next ? (const char*)g.A + (size_t)nxt.pm * tstep : cA; const char* nB = has_next ? (const char*)g.Bt + (size_t)nxt.pn * tstep : cB;
        for (int t = 0; t < nt; t += 2) {
            const bool last = (t == nt - 2);
            const char* a1 = cA + (size_t)(t + 1) * kstep;
            const char* a2 = last ? nA : cA + (size_t)(t + 2) * kstep; const char* b2 = last ? nB : cB + (size_t)(t + 2) * kstep;
            const char* a3 = a2 + kstep; const char* b3 = b2 + kstep;
            if (last && has_next) S.a_ready(nxt);
            if constexpr (SP2) {
            PG8_LDB(B0, 0, 0); PG8_LDB(B1, 0, 1); PG8_SCHED; PG8_LDA(At, 0, 0); PG8_STAGE(PG8_SA(1, 1), a1 + hstep, voffA);
            PG8_WAIT_V(8); PG8_WAIT_L(0); PG8_BAR; PG8_MMA(0, 0, At, B0); PG8_MMA(0, 1, At, B1); PG8_BAR; PG8_SCHED;
            PG8_LDA(At, 0, 1); PG8_STAGE(PG8_SB(0, 0), b2, voffB); PG8_STAGE(PG8_SB(0, 1), b2 + hstepB, voffB); PG8_STAGE(PG8_SA(0, 0), a2, voffA);
            PG8_WAIT_V(8); PG8_WAIT_L(0); PG8_BAR; PG8_MMA(1, 0, At, B0); PG8_MMA(1, 1, At, B1); PG8_BAR; PG8_SCHED;
            PG8_LDB(B0, 1, 0); PG8_LDB(B1, 1, 1); PG8_SCHED; PG8_LDA(At, 1, 0); PG8_STAGE(PG8_SA(0, 1), a2 + hstep, voffA);
            PG8_WAIT_V(8); PG8_WAIT_L(0); PG8_BAR; PG8_MMA(0, 0, At, B0); PG8_MMA(0, 1, At, B1); PG8_BAR; PG8_SCHED;
            PG8_LDA(At, 1, 1); PG8_STAGE(PG8_SB(1, 0), b3, voffB); PG8_STAGE(PG8_SB(1, 1), b3 + hstepB, voffB); PG8_STAGE(PG8_SA(1, 0), a3, voffA);
            PG8_WAIT_V(8); PG8_WAIT_L(0); PG8_BAR; PG8_MMA(1, 0, At, B0); PG8_MMA(1, 1, At, B1); PG8_BAR; PG8_SCHED;
            } else {
            PG8_LDB(B0, 0, 0); PG8_SCHED; PG8_LDA(At, 0, 0); PG8_STAGE(PG8_SA(1, 1), a1 + hstep, voffA);
            PG8_WAIT_L(8); PG8_BAR; PG8_WAIT_L(0); PG8_MMA(0, 0, At, B0); PG8_BAR; PG8_SCHED;
            PG8_LDB(B1, 0, 1); PG8_STAGE(PG8_SB(0, 0), b2, voffB);
            PG8_BAR; PG8_WAIT_L(0); PG8_MMA(0, 1, At, B1); PG8_BAR;
            PG8_LDA(At, 0, 1); PG8_STAGE(PG8_SA(0, 0), a2, voffA);
            PG8_BAR; PG8_WAIT_L(0); PG8_MMA(1, 0, At, B0); PG8_BAR; PG8_SCHED;
            PG8_STAGE(PG8_SB(0, 1), b2 + hstepB, voffB);
            PG8_WAIT_V(6); PG8_BAR; PG8_MMA(1, 1, At, B1); PG8_BAR;
            PG8_LDB(B0, 1, 0); PG8_SCHED; PG8_LDA(At, 1, 0); PG8_STAGE(PG8_SA(0, 1), a2 + hstep, voffA);
            PG8_WAIT_L(8); PG8_BAR; PG8_WAIT_L(0); PG8_MMA(0, 0, At, B0); PG8_BAR; PG8_SCHED;
            PG8_LDB(B1, 1, 1); PG8_STAGE(PG8_SB(1, 0), b3, voffB);
            PG8_BAR; PG8_WAIT_L(0); PG8_MMA(0, 1, At, B1); PG8_BAR;
            PG8_LDA(At, 1, 1); PG8_STAGE(PG8_SA(1, 0), a3, voffA);
            PG8_BAR; PG8_WAIT_L(0); PG8_MMA(1, 0, At, B0); PG8_BAR; PG8_SCHED;
            PG8_STAGE(PG8_SB(1, 1), b3 + hstepB, voffB);
            PG8_WAIT_V(6); PG8_BAR; PG8_MMA(1, 1, At, B1); PG8_BAR;
            }
        }
        if constexpr (ALIGN_EPI) { if (wr == 0) PG8_BAR; }
        if constexpr (!Epi::AFTER_DRAIN) { E(acc, cur, wr, wc, fr, fq, ui); S.done(cur); }
        if (!has_next) break;
#pragma unroll
        for (int a = 0; a < 2; ++a)
#pragma unroll
            for (int b = 0; b < 2; ++b)
#pragma unroll
                for (int m = 0; m < 4; ++m)
#pragma unroll
                    for (int n = 0; n < 2; ++n) acc[a][b][m][n] = (f32x4){0.f, 0.f, 0.f, 0.f};
        cur = nxt; cA = nA; cB = nB; ++ui;
        if constexpr (ALIGN_EPI) { if (wr == 1) PG8_BAR; }
    }
    PG8_WAIT_V(0);
    if constexpr (!ALIGN_EPI) { if (wr == 0) PG8_BAR; }
    PG8_BAR;
    if constexpr (Epi::AFTER_DRAIN) { E.fused(acc, cur, wr, wc, fr, fq, lds, wid, lane); S.done(cur); }
#undef PG8_SA
#undef PG8_SB
#undef PG8_STAGE
#undef PG8_LDA
#undef PG8_LDB
#undef PG8_MMA
#undef PG8_WAIT_V
#undef PG8_WAIT_L
#undef PG8_BAR
#undef PG8_SCHED
}
}
#define GAS __attribute__((address_space(1)))
#define LAS __attribute__((address_space(3)))
typedef unsigned short bf16;
typedef unsigned v4u __attribute__((ext_vector_type(4)));
typedef float f32x4 __attribute__((ext_vector_type(4)));
typedef short bf16x8 __attribute__((ext_vector_type(8)));
typedef GAS unsigned gu32;
typedef GAS unsigned long long gu64;
#define RLX_AGENT __ATOMIC_RELAXED, __HIP_MEMORY_SCOPE_AGENT
#define LDS_WAIT() asm volatile("s_waitcnt lgkmcnt(0)" ::: "memory")
#define VM_WAIT() asm volatile("s_waitcnt vmcnt(0)" ::: "memory")
__device__ __forceinline__ unsigned long long rt() { return __builtin_amdgcn_s_memrealtime(); }
__device__ __forceinline__ unsigned f2bf(float f) { unsigned u = __builtin_bit_cast(unsigned, f); return (u + 0x7fffu + ((u >> 16) & 1u)) >> 16; }
__device__ __forceinline__ unsigned pk2(float lo, float hi) { return f2bf(lo) | (f2bf(hi) << 16); }

#define XB_TMO      128
#define XB_XCNT(j)  (256  + 64 * (j))
#define XB_XSUB(j)  (1280 + 64 * (j))
#define XB_XGEN(j)  (2304 + 64 * (j))
#define XB_TOP      3328
#define XB_TOPGEN   3392
#define XCD_BAR_WORDS 3456
#define XB_SPIN_CAP (1u << 18)

__device__ __forceinline__ unsigned xb_ld(unsigned* p)              { return __hip_atomic_load(p, __ATOMIC_RELAXED, __HIP_MEMORY_SCOPE_AGENT); }
__device__ __forceinline__ unsigned xb_add(unsigned* p, unsigned v) { return __hip_atomic_fetch_add(p, v, __ATOMIC_RELAXED, __HIP_MEMORY_SCOPE_AGENT); }
__device__ __forceinline__ unsigned xb_xcc_id() { return (unsigned)__builtin_amdgcn_s_getreg((3 << 11) | 20) & 0xFu; }
#define XB_SPIN(cond, bar) do { unsigned _sp = 0; while (cond) { __builtin_amdgcn_s_sleep(1); \
    if ((++_sp & 255u) == 0u) { if (xb_ld(&(bar)[XB_TMO])) break; if (_sp > XB_SPIN_CAP) { atomicAdd(&(bar)[XB_TMO], 1u); break; } } } } while (0)

struct XcdBarrier {
    unsigned* bar; unsigned x;
    volatile LAS unsigned* st;
};

__device__ __forceinline__ XcdBarrier xcd_barrier_post(unsigned* bar, volatile LAS unsigned* st) {
    XcdBarrier b; b.bar = bar; b.x = xb_xcc_id(); b.st = st;
    if (threadIdx.x == 0) (void)xb_add(&bar[XB_XCNT(b.x)], 1u);
    return b;
}
__device__ __forceinline__ void xcd_barrier_complete(unsigned* bar, unsigned x, unsigned& nloc, unsigned& nx) {
    const unsigned G = gridDim.x * gridDim.y * gridDim.z;
    unsigned sum, cnt, mine, sp = 0u;
    for (;;) {
        sum = 0u; cnt = 0u; mine = 0u;
#pragma unroll
        for (unsigned j = 0; j < 16; ++j) { const unsigned c = xb_ld(&bar[XB_XCNT(j)]); sum += c; cnt += (c > 0u) ? 1u : 0u; mine = (j == x) ? c : mine; }
        if (sum == G) break;
        __builtin_amdgcn_s_sleep(1);
        if ((++sp & 255u) == 0u) { if (xb_ld(&bar[XB_TMO])) break; if (sp > XB_SPIN_CAP) { atomicAdd(&bar[XB_TMO], 1u); break; } }
    }
    nloc = mine > 0u ? mine : 1u; nx = cnt > 0u ? cnt : 1u;
}

__device__ __forceinline__ void xcd_barrier(const XcdBarrier& b, const bool t0  ) {
    asm volatile("s_waitcnt vmcnt(0)" ::: "memory");
    __syncthreads();
    if (t0) {
        unsigned* bar = b.bar;
        __builtin_amdgcn_s_waitcnt(0);
        unsigned nloc = b.st[0], nx = b.st[1];
        if (nloc == 0u) { xcd_barrier_complete(bar, b.x, nloc, nx); b.st[0] = nloc; b.st[1] = nx; }
        const unsigned old = xb_add(&bar[XB_XSUB(b.x)], 1u);
        const unsigned gen = old / nloc;
        if (old + 1u == (gen + 1u) * nloc) {
            __builtin_amdgcn_fence(__ATOMIC_RELEASE, "agent");
            asm volatile("s_waitcnt vmcnt(0)" ::: "memory");
            const unsigned og = xb_add(&bar[XB_TOP], 1u);
            const unsigned tg = og / nx;
            if (og + 1u == (tg + 1u) * nx) xb_add(&bar[XB_TOPGEN], 1u);
            else XB_SPIN(xb_ld(&bar[XB_TOPGEN]) == tg, bar);
            __builtin_amdgcn_fence(__ATOMIC_ACQUIRE, "agent");
            xb_add(&bar[XB_XGEN(b.x)], 1u);
            asm volatile("s_waitcnt vmcnt(0)" ::: "memory");
        } else {
            XB_SPIN(xb_ld(&bar[XB_XGEN(b.x)]) == gen, bar);
            __builtin_amdgcn_fence(__ATOMIC_ACQUIRE, "agent");
            asm volatile("s_waitcnt vmcnt(0)" ::: "memory");
        }
    }
    __syncthreads();
}

#ifndef PG8_SP2
#define PG8_SP2 true
#endif
#ifndef PG8_ALIGN
#define PG8_ALIGN true
#endif
constexpr int NWAVES = 8;
constexpr int N_STEPS = 38;
#ifndef MK_N_LAUNCHES
#define MK_N_LAUNCHES 1
#endif
#ifndef PH_MASK
#define PH_MASK 0xffff
#endif
#ifndef REP_MASK
#define REP_MASK 0
#endif
#ifndef PREP_REP_LRU
#define PREP_REP_LRU 1
#endif
#ifndef PREP_REP_GDN
#define PREP_REP_GDN 1
#endif
constexpr int N_LAUNCHES = MK_N_LAUNCHES;

constexpr int D = 1024, BATCH = 4, SEQ = 4096, DEPTH = 4, M = BATCH * SEQ;
constexpr int LRUW = 512, NGB = 8, GBW = 64, GH = 4, HD = 128, GDNW = 512, CH = 64, NCH = SEQ / CH, FF = 4096;
constexpr int NMODC = 6 * D, INC = 3080, NPROJ = 3072;
constexpr int O_LX = 0, O_LY = 512, O_Q = 1024, O_Z = 2560;
constexpr float EPS = 1e-6f;

constexpr size_t MiB = 1u << 20;
constexpr size_t WS_CTL = 0, CTL_ZERO_BYTES = 1 * MiB;
constexpr size_t WS_MOD = 1 * MiB;
constexpr size_t WS_BG = 2 * MiB;
constexpr size_t WS_AGG = 3 * MiB;
constexpr size_t WS_CARRY = 4 * MiB;
constexpr size_t WS_GL = 5 * MiB;
constexpr size_t WS_GT = 6 * MiB;
constexpr size_t WS_C1 = 6 * MiB + 512 * 1024;
constexpr size_t WS_C2 = 6 * MiB + 768 * 1024;
constexpr size_t WS_CB8 = 7 * MiB;
constexpr size_t WS_W8T = 7 * MiB + 64 * 1024;
constexpr size_t WS_RS1 = 364 * MiB, WS_RS2 = 365 * MiB;
constexpr size_t WS_A1 = 312 * MiB;
constexpr size_t WS_W = 8 * MiB;
constexpr size_t LAYER_W = (size_t)12288 * 1024;
constexpr size_t W_OUT_OFF = (size_t)3072 * 1024, W_UP_OFF = (size_t)4096 * 1024, W_DOWN_OFF = (size_t)8192 * 1024;
constexpr size_t WS_H = 104 * MiB;
constexpr size_t WS_MIX = 136 * MiB;
constexpr size_t WS_PROJ = 168 * MiB;
constexpr size_t WS_ACT = 168 * MiB;
constexpr size_t WS_GQD = 264 * MiB, WS_GKT = 280 * MiB;
constexpr size_t WS_GATT = 296 * MiB;
constexpr size_t WS_GO = 312 * MiB;
constexpr size_t WS_LRUP = 344 * MiB;
constexpr size_t WS_XT = 366 * MiB;
constexpr size_t WS_END = 384 * MiB;
constexpr int CW_BAR = 4096;
constexpr size_t X16_OFF = 32 * MiB;

constexpr int RING_OFF = 0, RING_BYTES = 155648;
constexpr int RSTAB_OFF = 131072;
constexpr int LDSCTL_OFF = RING_BYTES, MISC_OFF = LDSCTL_OFF + 320;
constexpr int LDS_BYTES = 156672;

typedef unsigned v2u __attribute__((ext_vector_type(2)));
#define DI __device__ __forceinline__
DI float bf2f(unsigned b) { return __builtin_bit_cast(float, b << 16); }
DI float bflo(unsigned w) { return __builtin_bit_cast(float, w << 16); }
DI float bfhi(unsigned w) { return __builtin_bit_cast(float, w & 0xffff0000u); }
DI float sigmoidf_(float x) { return 1.f / (1.f + expf(-x)); }
DI float siluf_(float x) { return x / (1.f + expf(-x)); }
DI float rcp_(float x) { return __builtin_amdgcn_rcpf(x); }
DI float exp_fast(float x) { return __builtin_amdgcn_exp2f(x * 1.4426950408889634f); }
DI float sigmoid_fast(float x) { return rcp_(1.f + exp_fast(-x)); }
DI float silu_fast(float x) { return x * rcp_(1.f + exp_fast(-x)); }
DI float log1p_acc(float x) { float ln2 = 0.6931471805599453f; asm volatile("" : "+v"(ln2));
    const float u = 1.0f + x, d = u - 1.0f; return d == 0.f ? x : (__builtin_amdgcn_logf(u) * ln2) * (x * rcp_(d)); }
DI float gelu_tanh(float x) { const float u = 0.7978845608028654f * (x + 0.044715f * x * x * x); return 0.5f * x * (1.f + tanhf(u)); }
DI float bperm_(int src_lane, float v) { return __builtin_bit_cast(float, __builtin_amdgcn_ds_bpermute(src_lane << 2, __builtin_bit_cast(int, v))); }
DI float wave_sum_(int lane, float v) {
#pragma unroll
    for (int o = 1; o < 64; o <<= 1) v += bperm_(lane ^ o, v);
    return v;
}
DI float half_sum_(int lane, float v) {
#pragma unroll
    for (int o = 1; o < 32; o <<= 1) v += bperm_(lane ^ o, v);
    return v;
}
DI float shfl_up_(int lane, float v, int off) { return bperm_(lane >= off ? lane - off : lane, v); }

struct Args { const float* in[23]; float* out; unsigned char* ws; int ph_lo, ph_hi; };
static_assert(sizeof(Args) == 23 * 8 + 8 + 8 + 8, "Args has no padding");
struct Frame {
    LAS unsigned char* lds;
    volatile LAS unsigned* MISC;
    gu32* ctl;
    int tid, lane, wave;
    int vcu, G;
    const __attribute__((address_space(4))) Args* A;
};
#define IN_(k) (F.A->in[k])
#define X_IN IN_(0)
#define C_IN IN_(1)
#define NORM_MIX_W IN_(2)
#define NORM_MLP_W IN_(3)
#define W_MOD IN_(4)
#define B_MOD IN_(5)
#define W_IN IN_(6)
#define LRU_CONV_W IN_(7)
#define LRU_CONV_B IN_(8)
#define GATE_A_W IN_(9)
#define GATE_A_B IN_(10)
#define GATE_X_W IN_(11)
#define GATE_X_B IN_(12)
#define LRU_LAMBDA IN_(13)
#define LRU_NORM_W IN_(14)
#define GDN_CONV_W IN_(15)
#define GDN_A_LOG IN_(16)
#define GDN_DT_BIAS IN_(17)
#define GDN_NORM_W IN_(18)
#define W_OUT IN_(19)
#define W_UP IN_(20)
#define W_DOWN IN_(21)
#define FINAL_NORM_W IN_(22)
#define OUT_ (F.A->out)
#define WSF(off) ((float*)(F.A->ws + (off)))
#define WSH(off) ((bf16*)(F.A->ws + (off)))

DI void p_mod(Frame& F) {
    LAS float* cs = (LAS float*)F.lds;
    LAS float* red = cs + 4096;
    for (int i = F.tid; i < BATCH * D; i += NWAVES * 64) cs[i] = siluf_(C_IN[i]);
    __syncthreads();
    const int hl = F.lane >> 5, cl = F.lane & 31;
    for (int item = F.vcu; item < DEPTH * 192; item += F.G) {
        const int l = item / 192, cg = item % 192, col = cg * 32 + cl, kbase = F.wave * 128 + hl * 64;
        const float* wp = W_MOD + ((size_t)l * D + kbase) * NMODC + col;
        float a0 = 0.f, a1 = 0.f, a2 = 0.f, a3 = 0.f;
#pragma unroll 16
        for (int kk = 0; kk < 64; ++kk) { const float wv = wp[(size_t)kk * NMODC]; const int k = kbase + kk;
            a0 += cs[k] * wv; a1 += cs[1024 + k] * wv; a2 += cs[2048 + k] * wv; a3 += cs[3072 + k] * wv; }
        const int sl = F.wave * 2 + hl;
        red[(sl * 4 + 0) * 32 + cl] = a0; red[(sl * 4 + 1) * 32 + cl] = a1; red[(sl * 4 + 2) * 32 + cl] = a2; red[(sl * 4 + 3) * 32 + cl] = a3;
        __syncthreads();
        if (F.tid < 128) { const int b = F.tid >> 5, ln = F.tid & 31; float sum = 0.f;
#pragma unroll
            for (int w = 0; w < 16; ++w) sum += red[(w * 4 + b) * 32 + ln];
            const int cc = cg * 32 + ln; WSF(WS_MOD)[((size_t)l * BATCH + b) * NMODC + cc] = sum + B_MOD[(size_t)l * NMODC + cc]; }
        __syncthreads();
    }
}

struct TrItem { const float* src; bf16* dst; int K, ldw; };
DI void p0_item(Frame& F, int it, TrItem& T) {
    constexpr int I_IN = (D / 64) * (NPROJ / 32), I_OUT = (D / 64) * (D / 32), I_UP = (D / 64) * (FF / 32), I_DN = (FF / 64) * (D / 32);
    constexpr int PER_LAYER = I_IN + I_OUT + I_UP + I_DN;
    const int l = it / PER_LAYER; int r = it % PER_LAYER; bf16* wl = WSH(WS_W) + (size_t)l * LAYER_W;
    const float* W; int K, ldw, N; bf16* WT;
    if (r < I_IN) { W = W_IN + (size_t)l * D * INC; K = D; ldw = INC; N = NPROJ; WT = wl; }
    else if ((r -= I_IN) < I_OUT) { W = W_OUT + (size_t)l * D * D; K = D; ldw = D; N = D; WT = wl + W_OUT_OFF; }
    else if ((r -= I_OUT) < I_UP) { W = W_UP + (size_t)l * D * FF; K = D; ldw = FF; N = FF; WT = wl + W_UP_OFF; }
    else { r -= I_UP; W = W_DOWN + (size_t)l * FF * D; K = FF; ldw = D; N = D; WT = wl + W_DOWN_OFF; }
    const int nblk = N / 32, kb = r / nblk, nb = r % nblk, k0 = 64 * kb, n0 = 32 * nb;
    T.src = W + (size_t)k0 * ldw + n0; T.dst = WT + (size_t)n0 * K + k0; T.K = K; T.ldw = ldw;
}
DI void p0_weights(Frame& F) {
    LAS float* scr = (LAS float*)(F.lds + RING_OFF + F.wave * 16384);
    const int gw = F.vcu * NWAVES + F.wave, NGW = F.G * NWAVES, lane = F.lane;
    constexpr int NIT = DEPTH * ((D / 64) * (NPROJ / 32) + (D / 64) * (D / 32) + (D / 64) * (FF / 32) + (FF / 64) * (D / 32));
    TrItem T; f32x4 v[8];
    if (gw < NIT) { p0_item(F, gw, T);
#pragma unroll
        for (int i = 0; i < 8; ++i) v[i] = *(const f32x4*)(T.src + (size_t)((lane >> 3) + 8 * i) * T.ldw + 4 * (lane & 7)); }
    for (int it = gw; it < NIT; it += NGW) {
        TrItem Tn; f32x4 vn[8]; const int itn = it + NGW < NIT ? it + NGW : it;
        p0_item(F, itn, Tn);
#pragma unroll
        for (int i = 0; i < 8; ++i) vn[i] = *(const f32x4*)(Tn.src + (size_t)((lane >> 3) + 8 * i) * Tn.ldw + 4 * (lane & 7));
#pragma unroll
        for (int i = 0; i < 8; ++i) { LAS float* d = scr + ((lane >> 3) + 8 * i) * 33 + 4 * (lane & 7); d[0] = v[i].x; d[1] = v[i].y; d[2] = v[i].z; d[3] = v[i].w; }
        LDS_WAIT(); asm volatile("" ::: "memory");
        const int c = lane & 7;
#pragma unroll
        for (int j = 0; j < 4; ++j) { const int n = (lane >> 3) + 8 * j; const LAS float* sp = scr + (8 * c) * 33 + n;
            v4u o; o.x = pk2(sp[0 * 33], sp[1 * 33]); o.y = pk2(sp[2 * 33], sp[3 * 33]); o.z = pk2(sp[4 * 33], sp[5 * 33]); o.w = pk2(sp[6 * 33], sp[7 * 33]);
            *(v4u*)(T.dst + (size_t)n * T.K + 8 * c) = o; }
        LDS_WAIT(); asm volatile("" ::: "memory");
        T = Tn;
#pragma unroll
        for (int i = 0; i < 8; ++i) v[i] = vn[i];
    }
    for (int o = (int)blockIdx.x * NWAVES * 64 + F.tid; o < DEPTH * 16 * 1024; o += (int)gridDim.x * NWAVES * 64) {
        const int k = o & 1023, j = (o >> 10) & 15, l = o >> 14;
        WSH(WS_W8T)[o] = (bf16)(j < 8 ? f2bf(W_IN[((size_t)l * D + k) * INC + NPROJ + j]) : 0u);
    }
    for (int o = (int)blockIdx.x * NWAVES * 64 + F.tid; o < DEPTH * 2 * NGB * 4096; o += (int)gridDim.x * NWAVES * 64) {
        const int i = o & 63, j = (o >> 6) & 63, g = (o >> 12) & 7, gate = (o >> 15) & 1, l = o >> 16;
        const float* src = gate ? GATE_X_W : GATE_A_W;
        WSH(WS_GT)[o] = (bf16)f2bf(src[(size_t)(l * NGB + g) * 4096 + i * 64 + j]);
    }
}

DI void p_cvec(Frame& F) {
    const int gw = F.vcu * NWAVES + F.wave, NGW = F.G * NWAVES, lane = F.lane;
    constexpr int IT_IN = NPROJ / 16, IT_UP = FF / 16, PER_L = IT_IN + IT_UP;
    for (int it = gw; it < DEPTH * PER_L; it += NGW) {
        const int l = it / PER_L, r = it % PER_L, which = r >= IT_IN, rg = which ? r - IT_IN : r, N = which ? FF : NPROJ;
        const bf16* wt = WSH(WS_W) + (size_t)l * LAYER_W + (which ? W_UP_OFF : 0) + (size_t)(rg * 16) * 1024 + 16 * lane;
        const float* shb = WSF(WS_MOD) + (size_t)l * BATCH * NMODC + (which ? 3 * D : 0) + 16 * lane;
        float* cout = (which ? WSF(WS_C2) + (size_t)l * BATCH * FF : WSF(WS_C1) + (size_t)l * BATCH * NPROJ) + rg * 16;
        f32x4 sh[4][4];
#pragma unroll
        for (int b = 0; b < 4; ++b)
#pragma unroll
            for (int j = 0; j < 4; ++j) sh[b][j] = *(const f32x4*)(shb + (size_t)b * NMODC + 4 * j);
        float v[64];
#pragma unroll
        for (int row = 0; row < 16; ++row) { const v4u w0 = *(const v4u*)(wt + (size_t)row * 1024), w1 = *(const v4u*)(wt + (size_t)row * 1024 + 8);
            const f32x4 wa = (f32x4){bflo(w0.x), bfhi(w0.x), bflo(w0.y), bfhi(w0.y)}, wb = (f32x4){bflo(w0.z), bfhi(w0.z), bflo(w0.w), bfhi(w0.w)};
            const f32x4 wc = (f32x4){bflo(w1.x), bfhi(w1.x), bflo(w1.y), bfhi(w1.y)}, wd = (f32x4){bflo(w1.z), bfhi(w1.z), bflo(w1.w), bfhi(w1.w)};
#pragma unroll
            for (int b = 0; b < 4; ++b) { const f32x4 t = sh[b][0] * wa + sh[b][1] * wb + sh[b][2] * wc + sh[b][3] * wd; v[row * 4 + b] = (t[0] + t[1]) + (t[2] + t[3]); } }
#pragma unroll
        for (int st = 0; st < 6; ++st) { const int bit = 1 << st; const bool up = lane & bit;
#pragma unroll
            for (int i = 0; i < (32 >> st); ++i) { const float keep = up ? v[2 * i + 1] : v[2 * i], send = up ? v[2 * i] : v[2 * i + 1]; v[i] = keep + bperm_(lane ^ bit, send); } }
        cout[(size_t)(lane & 3) * N + (lane >> 2)] = v[0];
    }
    if (gw < DEPTH * BATCH) { const int l = gw >> 2, b = gw & 3; float a[8];
#pragma unroll
        for (int j = 0; j < 8; ++j) a[j] = 0.f;
        for (int kk = 0; kk < 16; ++kk) { const int k = 16 * lane + kk; const float shv = WSF(WS_MOD)[((size_t)l * BATCH + b) * NMODC + k];
#pragma unroll
            for (int j = 0; j < 8; ++j) a[j] += shv * W_IN[((size_t)l * D + k) * INC + NPROJ + j]; }
#pragma unroll
        for (int j = 0; j < 8; ++j) a[j] = wave_sum_(lane, a[j]);
        if (lane < 8) { float r = a[0];
#pragma unroll
            for (int j = 1; j < 8; ++j) r = (lane == j) ? a[j] : r;
            WSF(WS_CB8)[(size_t)gw * 8 + lane] = r; } }
}

template <bool WITH_BG>
DI void p_normmod(Frame& F, int l, const float* xin, const float* normw, int off_sh, int off_sc) {
    LAS float* w8 = (LAS float*)F.lds;
    if (WITH_BG) {
        for (int i = F.tid; i < D * 8; i += NWAVES * 64) w8[i] = W_IN[((size_t)l * D + (i >> 3)) * INC + NPROJ + (i & 7)];
        __syncthreads();
    }
    const int gw = F.vcu * NWAVES + F.wave, NGW = F.G * NWAVES, lane = F.lane;
    f32x4 v[4];
    if (gw < M) {
#pragma unroll
        for (int j = 0; j < 4; ++j) v[j] = *(const f32x4*)(xin + (size_t)gw * D + 4 * lane + 256 * j);
    }
    for (int m = gw; m < M; m += NGW) {
        const int b = m >> 12, mn = m + NGW;
        f32x4 vnx[4];
#pragma unroll
        for (int j = 0; j < 4; ++j) vnx[j] = (mn < M) ? *(const f32x4*)(xin + (size_t)mn * D + 4 * lane + 256 * j) : (f32x4){0.f, 0.f, 0.f, 0.f};
        const float* modp = WSF(WS_MOD) + ((size_t)l * BATCH + b) * NMODC;
        float ss = 0.f;
#pragma unroll
        for (int j = 0; j < 4; ++j) ss += (v[j].x * v[j].x + v[j].y * v[j].y) + (v[j].z * v[j].z + v[j].w * v[j].w);
        ss = wave_sum_(lane, ss);
        const float rstd = 1.0f / sqrtf(ss * (1.0f / D) + EPS);
        float a0 = 0.f, a1 = 0.f, a2 = 0.f, a3 = 0.f, a4 = 0.f, a5 = 0.f, a6 = 0.f, a7 = 0.f;
#pragma unroll
        for (int j = 0; j < 4; ++j) {
            const int col = 4 * lane + 256 * j;
            const f32x4 nw = *(const f32x4*)(normw + (size_t)l * D + col), sc = *(const f32x4*)(modp + off_sc + col), sh = *(const f32x4*)(modp + off_sh + col);
            const f32x4 hv = v[j] * rstd * nw * (sc + 1.0f) + sh;
            v2u o; o.x = pk2(hv.x, hv.y); o.y = pk2(hv.z, hv.w);
            *(v2u*)(WSH(WS_H) + (size_t)m * D + col) = o;
            if (WITH_BG) {
#pragma unroll
                for (int e = 0; e < 4; ++e) { const f32x4 wa = *(const LAS f32x4*)(w8 + (col + e) * 8), wb = *(const LAS f32x4*)(w8 + (col + e) * 8 + 4); const float hh = hv[e];
                    a0 += hh * wa.x; a1 += hh * wa.y; a2 += hh * wa.z; a3 += hh * wa.w; a4 += hh * wb.x; a5 += hh * wb.y; a6 += hh * wb.z; a7 += hh * wb.w; }
            }
        }
        if (WITH_BG) {
            const bool b0 = lane & 1, b1 = lane & 2, b2 = lane & 4;
            float k0 = b0 ? a1 : a0, k1 = b0 ? a3 : a2, k2 = b0 ? a5 : a4, k3 = b0 ? a7 : a6;
            k0 += bperm_(lane ^ 1, b0 ? a0 : a1); k1 += bperm_(lane ^ 1, b0 ? a2 : a3); k2 += bperm_(lane ^ 1, b0 ? a4 : a5); k3 += bperm_(lane ^ 1, b0 ? a6 : a7);
            float c0 = b1 ? k1 : k0, c1 = b1 ? k3 : k2;
            c0 += bperm_(lane ^ 2, b1 ? k0 : k1); c1 += bperm_(lane ^ 2, b1 ? k2 : k3);
            float d = b2 ? c1 : c0;
            d += bperm_(lane ^ 4, b2 ? c0 : c1);
            d += bperm_(lane ^ 8, d); d += bperm_(lane ^ 16, d); d += bperm_(lane ^ 32, d);
            if (lane < 8) {
                const int hh = lane & 3;
                float r;
                if (lane < 4) r = sigmoidf_(d);
                else { const float xx = d + GDN_DT_BIAS[l * GH + hh]; const float sp = xx > 20.f ? xx : log1pf(expf(xx)); r = -expf(GDN_A_LOG[l * GH + hh]) * sp; }
                WSF(WS_BG)[(size_t)m * 8 + lane] = r;
            }
        }
#pragma unroll
        for (int j = 0; j < 4; ++j) v[j] = vnx[j];
    }
}

typedef float f32x2_t __attribute__((ext_vector_type(2))); typedef __bf16 bf16x2_t __attribute__((ext_vector_type(2)));
DI unsigned cvtpk(float lo, float hi) { f32x2_t v = {lo, hi}; bf16x2_t b = __builtin_convertvector(v, bf16x2_t); return __builtin_bit_cast(unsigned, b); }
DI bf16x8 pack8(f32x4 a, f32x4 b) { v4u p; p.x = cvtpk(a.x, a.y); p.y = cvtpk(a.z, a.w); p.z = cvtpk(b.x, b.y); p.w = cvtpk(b.z, b.w); return __builtin_bit_cast(bf16x8, p); }
DI bf16x8 ldfrag(const LAS unsigned char* p) { const v2u lo = *(const LAS v2u*)p, hi = *(const LAS v2u*)(p + 32); v4u r; r.x = lo.x; r.y = lo.y; r.z = hi.x; r.w = hi.y; return __builtin_bit_cast(bf16x8, r); }
#define MFMA16(a, b, c) __builtin_amdgcn_mfma_f32_16x16x32_bf16((a), (b), (c), 0, 0, 0)

#define WG_BAR() do { asm volatile("s_waitcnt lgkmcnt(0)" ::: "memory"); __builtin_amdgcn_s_barrier(); asm volatile("" ::: "memory"); } while (0)
DI bf16x8 ld128(const LAS unsigned char* p) { return *(const LAS bf16x8*)p; }
DI int kperm4(int k4) { return k4 < 16 ? 2 * k4 : 2 * (k4 - 16) + 4; }
DI int kperm(int k) { return (k & ~31) + kperm4(k & 28) + (k & 3); }
constexpr int PG_QB = 0, PG_KB = 17408, PG_KBET = 34816, PG_VT = 53248, PG_LS = 71680, PG_TS = 89088, PG_TB = 106496, PG_ATT = 115712, PG_XS = 124928, PG_SM = 128000, PG_END = 129024, PG_BGS = 140288;
static_assert(PG_END <= RING_BYTES && PG_BGS >= 8 * 17408 && PG_BGS + 2048 <= RING_BYTES, "prep LDS map");
DI void p_prep(Frame& F, int l) {
    const int wave = F.wave;
#define PREP_IDS int tid_ = F.tid; asm volatile("" : "+v"(tid_)); const int tid = tid_, lane = tid & 63, m = lane & 15, q = lane >> 4; (void)m; (void)q;
    for (int item = blockIdx.x; item < BATCH * NCH; item += gridDim.x) {
        const int b = item / NCH, n = item % NCH, row0 = b * SEQ + n * CH, t0 = n * CH;
        LAS float* bgs = (LAS float*)(F.lds + PG_BGS);
        if (wave < 4) {
            PREP_IDS
            const int mt = wave;
            const bf16* a1 = (l > 0 ? WSH(WS_A1) : WSH(WS_H)) + (size_t)(row0 + 16 * mt + m) * D + 8 * q;
            const bf16* w8t = WSH(WS_W8T) + (size_t)l * 16 * 1024 + (size_t)m * 1024 + 8 * q;
            f32x4 acc = (f32x4){0.f, 0.f, 0.f, 0.f};
#pragma unroll 8
            for (int kb = 0; kb < 32; ++kb) acc = MFMA16(*(const bf16x8*)(a1 + 32 * kb), *(const bf16x8*)(w8t + 32 * kb), acc);
            if (m < 8) { const int hh = m & 3; const float cb = l > 0 ? WSF(WS_CB8)[((size_t)l * BATCH + b) * 8 + m] : 0.f, dtb = GDN_DT_BIAS[l * GH + hh], alog = GDN_A_LOG[l * GH + hh];
#pragma unroll
                for (int r = 0; r < 4; ++r) { const int t = 16 * mt + 4 * q + r; const f32x4* rp = (const f32x4*)(WSF(WS_RS1) + (size_t)(row0 + t) * 16);
                    const f32x4 p0 = rp[0], p1 = rp[1], p2 = rp[2], p3 = rp[3], ts = (p0 + p1) + (p2 + p3);
                    const float rstd = l > 0 ? 1.0f / sqrtf(((ts[0] + ts[1]) + (ts[2] + ts[3])) * (1.0f / D) + EPS) : 1.0f, v = acc[r] * rstd + cb;
                    float res;
                    if (m < 4) res = sigmoidf_(v); else { const float xx = v + dtb; const float sp = xx > 20.f ? xx : log1p_acc(exp_fast(xx)); res = -expf(alog) * sp; }
                    bgs[t * 8 + m] = res; } }
        }
        for (int rep_ = 0; rep_ < PREP_REP_LRU; ++rep_) {
            PREP_IDS
            const int g = wave;
            LAS float* xr = (LAS float*)(F.lds + wave * 17408);
            const int tg = lane >> 3, cg = lane & 7, c0 = 8 * cg, cc0 = g * 64 + c0;
            v4u xp[11];
#pragma unroll
            for (int i = 0; i < 11; ++i) { const int tt = t0 + 8 * tg - 3 + i;
                xp[i] = (tt >= 0) ? *(const v4u*)(WSH(WS_PROJ) + (size_t)(b * SEQ + tt) * NPROJ + O_LX + cc0) : (v4u){0u, 0u, 0u, 0u}; }
            f32x4 wl_[4], wh_[4];
#pragma unroll
            for (int k = 0; k < 4; ++k) { wl_[k] = *(const f32x4*)(LRU_CONV_W + ((size_t)l * 4 + k) * LRUW + cc0); wh_[k] = *(const f32x4*)(LRU_CONV_W + ((size_t)l * 4 + k) * LRUW + cc0 + 4); }
            const f32x4 bl_ = *(const f32x4*)(LRU_CONV_B + l * LRUW + cc0), bh_ = *(const f32x4*)(LRU_CONV_B + l * LRUW + cc0 + 4);
            float ba_[4], bx_[4], ls_[4];
#pragma unroll
            for (int nt = 0; nt < 4; ++nt) { const int cc = g * 64 + 16 * nt + m; ba_[nt] = GATE_A_B[l * LRUW + cc]; bx_[nt] = GATE_X_B[l * LRUW + cc];
                const float lam = LRU_LAMBDA[l * LRUW + cc]; ls_[nt] = -8.0f * (fmaxf(-lam, 0.f) + log1p_acc(exp_fast(-fabsf(lam)))); }
#pragma unroll
            for (int tt = 0; tt < 8; ++tt) { f32x4 al = bl_, ah = bh_;
#pragma unroll
                for (int k = 0; k < 4; ++k) { const v4u xw = xp[tt + k];
                    al += wl_[k] * (f32x4){bflo(xw.x), bfhi(xw.x), bflo(xw.y), bfhi(xw.y)}; ah += wh_[k] * (f32x4){bflo(xw.z), bfhi(xw.z), bflo(xw.w), bfhi(xw.w)}; }
                *(LAS f32x4*)(xr + (8 * tg + tt) * 68 + c0) = al; *(LAS f32x4*)(xr + (8 * tg + tt) * 68 + c0 + 4) = ah; }
            asm volatile("s_waitcnt lgkmcnt(0)" ::: "memory");
            bf16x8 Bf[2][4][2];
#pragma unroll
            for (int gate = 0; gate < 2; ++gate)
#pragma unroll
                for (int nt = 0; nt < 4; ++nt)
#pragma unroll
                    for (int ks = 0; ks < 2; ++ks) Bf[gate][nt][ks] = *(const bf16x8*)(WSH(WS_GT) + ((size_t)((l * 2 + gate) * NGB + g)) * 4096 + (size_t)(16 * nt + m) * 64 + 32 * ks + 8 * q);
            bf16x8 Af[4][2];
#pragma unroll
            for (int mt = 0; mt < 4; ++mt)
#pragma unroll
                for (int ks = 0; ks < 2; ++ks) { const LAS float* pp = xr + (16 * mt + m) * 68 + 32 * ks + 8 * q; Af[mt][ks] = pack8(*(const LAS f32x4*)pp, *(const LAS f32x4*)(pp + 4)); }
#pragma unroll
            for (int nt = 0; nt < 4; ++nt) {
                float av[4][4], bv[4][4];
#pragma unroll
                for (int mt = 0; mt < 4; ++mt) { f32x4 ra = (f32x4){0.f, 0.f, 0.f, 0.f}, ia = (f32x4){0.f, 0.f, 0.f, 0.f};
                    ra = MFMA16(Af[mt][0], Bf[0][nt][0], ra); ra = MFMA16(Af[mt][1], Bf[0][nt][1], ra);
                    ia = MFMA16(Af[mt][0], Bf[1][nt][0], ia); ia = MFMA16(Af[mt][1], Bf[1][nt][1], ia);
#pragma unroll
                    for (int r = 0; r < 4; ++r) { const float rr = sigmoid_fast(ra[r] + ba_[nt]), ig = sigmoid_fast(ia[r] + bx_[nt]);
                        const float log_a = rr * ls_[nt], aa = exp_fast(log_a), mult = __builtin_amdgcn_sqrtf(fmaxf(1.0f - exp_fast(2.0f * log_a), 1e-12f));
                        av[mt][r] = aa; bv[mt][r] = mult * (ig * xr[(16 * mt + 4 * q + r) * 68 + 16 * nt + m]); } }
                float iP[4], iH[4];
#pragma unroll
                for (int mt = 0; mt < 4; ++mt) {
#pragma unroll
                    for (int r = 1; r < 4; ++r) { bv[mt][r] = av[mt][r] * bv[mt][r - 1] + bv[mt][r]; av[mt][r] = av[mt][r] * av[mt][r - 1]; }
                    float PA = av[mt][3], HA = bv[mt][3];
                    { const float Pp = shfl_up_(lane, PA, 16), Hp = shfl_up_(lane, HA, 16); if (q >= 1) { HA = PA * Hp + HA; PA = PA * Pp; } }
                    { const float Pp = shfl_up_(lane, PA, 32), Hp = shfl_up_(lane, HA, 32); if (q >= 2) { HA = PA * Hp + HA; PA = PA * Pp; } }
                    iP[mt] = PA; iH[mt] = HA; }
                float CP = 1.f, CH = 0.f;
#pragma unroll
                for (int mt = 0; mt < 4; ++mt) {
                    const float totP = bperm_(m + 48, iP[mt]), totH = bperm_(m + 48, iH[mt]);
                    float exP = shfl_up_(lane, iP[mt], 16), exH = shfl_up_(lane, iH[mt], 16); if (q == 0) { exP = 1.f; exH = 0.f; }
                    const float EP = CP * exP, EH = exP * CH + exH;
#pragma unroll
                    for (int r = 0; r < 4; ++r) { const float Pf = EP * av[mt][r], Hf = av[mt][r] * EH + bv[mt][r];
                        *(LAS unsigned*)(xr + (16 * mt + 4 * q + r) * 68 + 16 * nt + m) = f2bf(Hf) | (f2bf(Pf) << 16); }
                    CH = totP * CH + totH; CP = CP * totP; }
                if (q == 0) { WSF(WS_AGG)[((size_t)(b * NCH + n)) * LRUW + g * 64 + 16 * nt + m] = CP; WSF(WS_AGG)[(size_t)BATCH * NCH * LRUW + ((size_t)(b * NCH + n)) * LRUW + g * 64 + 16 * nt + m] = CH; }
            }
            if (l == 0) WG_BAR(); else asm volatile("s_waitcnt lgkmcnt(0)" ::: "memory");
#pragma unroll
            for (int i = 0; i < 16; ++i) { const int pz = lane + 64 * i, row = pz >> 4, c16 = pz & 15;
                *(v4u*)((unsigned*)(F.A->ws + WS_H) + (size_t)(row0 + row) * LRUW + g * 64 + 4 * c16) = *(const LAS v4u*)(xr + row * 68 + 4 * c16); }
        }
        WG_BAR();
        {
            LAS unsigned char* qb = F.lds + PG_QB;
            LAS unsigned char* kb = F.lds + PG_KB;
            LAS unsigned char* kbeT = F.lds + PG_KBET;
            LAS unsigned char* vT = F.lds + PG_VT;
            LAS float* Ls = (LAS float*)(F.lds + PG_LS);
            LAS float* Ts = (LAS float*)(F.lds + PG_TS);
            LAS unsigned char* wst = F.lds + PG_TS;
            LAS unsigned char* Tb = F.lds + PG_TB;
            LAS unsigned char* atts = F.lds + PG_ATT;
            LAS float* Xs = (LAS float*)(F.lds + PG_XS);
            LAS float* sm4 = (LAS float*)(F.lds + PG_SM);
            if (wave < GH) { int tl_ = F.tid; asm volatile("" : "+v"(tl_)); const int ln = tl_ & 63, hh = wave;
                float gcv = bgs[ln * 8 + 4 + hh];
#pragma unroll
                for (int off = 1; off < 64; off <<= 1) { const float pv = shfl_up_(ln, gcv, off); if (ln >= off) gcv += pv; }
                const float glast = bperm_(63, gcv);
                sm4[hh * 256 + ln] = gcv; sm4[hh * 256 + 64 + ln] = bgs[ln * 8 + hh]; sm4[hh * 256 + 128 + ln] = expf(gcv); sm4[hh * 256 + 192 + ln] = expf(glast - gcv); }
            WG_BAR();
#define G1_FETCH(hh_) do { int tf_ = F.tid; asm volatile("" : "+v"(tf_)); if (tf_ < 384) { const int cgp_ = tf_ & 15, wt_ = tf_ >> 4, which_ = wt_ >> 3, tr_ = wt_ & 7, ch_ = which_ * GDNW + (hh_) * HD + cgp_ * 8; \
                _Pragma("unroll") for (int i = 0; i < 11; ++i) { const int tt = t0 + tr_ * 8 - 3 + i; \
                    xpn[i] = (tt >= 0) ? *(const v4u*)(WSH(WS_PROJ) + (size_t)(b * SEQ + tt) * NPROJ + O_Q + ch_) : (v4u){0u, 0u, 0u, 0u}; } \
                } } while (0)
#pragma unroll 1
            for (int h = -1; h < GH; ++h) {
                PREP_IDS
                v4u xpn[11], pe[8];
                G1_FETCH(h + 1 < GH ? h + 1 : GH - 1);
                const int hn = h + 1;
                const size_t item4 = (size_t)(b * GH + h) * NCH + n, item4n = (size_t)(b * GH + hn) * NCH + n;
                LAS float* sgc = sm4 + h * 256, *sbeta = sgc + 64, *seg = sgc + 128;
                LAS float* sbetan = sm4 + hn * 256 + 64, *segn = sbetan + 64, *seln = sbetan + 128;
                if (h >= 0) {
                    const int it = wave >> 1;
                    bf16x8 Ak[4], Aq[4], Bk[2][4];
#pragma unroll
                    for (int ks = 0; ks < 4; ++ks) { Ak[ks] = ld128(kb + (16 * it + m) * 272 + (32 * ks + 8 * q) * 2); Aq[ks] = ld128(qb + (16 * it + m) * 272 + (32 * ks + 8 * q) * 2);
                        Bk[0][ks] = ld128(kb + (16 * ((wave & 1) * 2) + m) * 272 + (32 * ks + 8 * q) * 2); Bk[1][ks] = ld128(kb + (16 * ((wave & 1) * 2 + 1) + m) * 272 + (32 * ks + 8 * q) * 2); }
#pragma unroll
                    for (int jj = 0; jj < 2; ++jj) { const int jt = (wave & 1) * 2 + jj;
                        f32x4 kk = (f32x4){0.f, 0.f, 0.f, 0.f}, qk = (f32x4){0.f, 0.f, 0.f, 0.f};
                        if (jt <= it) {
#pragma unroll
                            for (int ks = 0; ks < 4; ++ks) { kk = MFMA16(Ak[ks], Bk[jj][ks], kk); qk = MFMA16(Aq[ks], Bk[jj][ks], qk); } }
                        const int j = 16 * jt + m; const float gj = sgc[j];
#pragma unroll
                        for (int r = 0; r < 4; ++r) { const int i = 16 * it + 4 * q + r;
                            const float dec = (j <= i) ? exp_fast(sgc[i] - gj) : 0.f;
                            Ls[i * 68 + j] = (j < i) ? sbeta[i] * kk[r] * dec : 0.f;
                            *(LAS unsigned short*)(atts + i * 144 + kperm(j) * 2) = (unsigned short)f2bf((j <= i) ? qk[r] * dec : 0.f); } }
                    WG_BAR();
                }
                if (h >= 0 && wave == 7) {
#ifdef PROBE_G3X2
                    for (int prb_ = 0; prb_ < 2; ++prb_) {
#else
                    {
#endif
                    { const int bk = lane >> 4, c = lane & 15; float x[16];
                        const LAS float* lb = Ls + (16 * bk) * 68 + 16 * bk;
#pragma unroll
                        for (int r = 0; r < 16; ++r) { float acc = (r == c) ? 1.f : 0.f;
#pragma unroll
                            for (int m4 = 0; m4 < (r + 3) / 4; ++m4) { const f32x4 lv = *(const LAS f32x4*)(lb + r * 68 + 4 * m4);
                                if (4 * m4 + 0 < r) acc -= lv.x * x[4 * m4 + 0]; if (4 * m4 + 1 < r) acc -= lv.y * x[4 * m4 + 1]; if (4 * m4 + 2 < r) acc -= lv.z * x[4 * m4 + 2]; if (4 * m4 + 3 < r) acc -= lv.w * x[4 * m4 + 3]; }
                            x[r] = acc; Ts[(16 * bk + r) * 68 + 16 * bk + c] = acc; *(LAS unsigned short*)(Tb + (16 * bk + r) * 144 + (16 * bk + c) * 2) = (unsigned short)f2bf(acc); } }
#pragma unroll
                    for (int e = 0; e < 4; ++e) { const int idx = lane + 64 * e, bz = idx >> 7, r = (idx >> 3) & 15, w = idx & 7;
                        *(LAS unsigned*)(Tb + (32 * bz + r) * 144 + (32 * bz + 16) * 2 + w * 4) = 0u; }
                    asm volatile("s_waitcnt lgkmcnt(0)" ::: "memory");
#pragma unroll
                    for (int dl = 1; dl < 4; ++dl) {
                        f32x4 xacc[3];
#pragma unroll
                        for (int e = 0; e < 4 - dl; ++e) { const int qd = lane + 64 * e, blk = qd >> 6, r = (qd >> 2) & 15, c4 = (qd & 3) * 4, i = blk + dl, j = blk;
                            const LAS float* lrow = Ls + (16 * i + r) * 68 + 16 * j; const LAS float* tcol = Ts + (16 * j) * 68 + 16 * j + c4;
                            f32x4 pa[4];
#pragma unroll
                            for (int mm4 = 0; mm4 < 4; ++mm4) pa[mm4] = (f32x4){0.f, 0.f, 0.f, 0.f};
#pragma unroll
                            for (int kk = 0; kk < dl; ++kk) {
#pragma unroll
                                for (int mm4 = 0; mm4 < 4; ++mm4) { const int mm = 4 * mm4; const f32x4 lv = *(const LAS f32x4*)(lrow + 16 * kk + mm); const LAS float* tc = tcol + (16 * kk + mm) * 68;
                                    pa[mm4] += lv.x * *(const LAS f32x4*)(tc) + lv.y * *(const LAS f32x4*)(tc + 68) + lv.z * *(const LAS f32x4*)(tc + 136) + lv.w * *(const LAS f32x4*)(tc + 204); } }
                            xacc[e] = (pa[0] + pa[1]) + (pa[2] + pa[3]); }
#pragma unroll
                        for (int e = 0; e < 4 - dl; ++e) { const int qd = lane + 64 * e, blk = qd >> 6, r = (qd >> 2) & 15, c4 = (qd & 3) * 4; *(LAS f32x4*)(Xs + blk * 256 + r * 16 + c4) = xacc[e]; }
                        asm volatile("s_waitcnt lgkmcnt(0)" ::: "memory");
#pragma unroll
                        for (int e = 0; e < 4 - dl; ++e) { const int qd = lane + 64 * e, blk = qd >> 6, r = (qd >> 2) & 15, c4 = (qd & 3) * 4, i = blk + dl, j = blk;
                            const LAS float* trow = Ts + (16 * i + r) * 68 + 16 * i; const LAS float* xc = Xs + blk * 256 + c4;
                            f32x4 pa[4];
#pragma unroll
                            for (int mm4 = 0; mm4 < 4; ++mm4) { const int mm = 4 * mm4; const f32x4 tv = *(const LAS f32x4*)(trow + mm);
                                pa[mm4] = tv.x * *(const LAS f32x4*)(xc + (mm + 0) * 16) + tv.y * *(const LAS f32x4*)(xc + (mm + 1) * 16) + tv.z * *(const LAS f32x4*)(xc + (mm + 2) * 16) + tv.w * *(const LAS f32x4*)(xc + (mm + 3) * 16); }
                            xacc[e] = -((pa[0] + pa[1]) + (pa[2] + pa[3])); }
#pragma unroll
                        for (int e = 0; e < 4 - dl; ++e) { const int qd = lane + 64 * e, blk = qd >> 6, r = (qd >> 2) & 15, c4 = (qd & 3) * 4, i = blk + dl, j = blk; const f32x4 acc = xacc[e];
                            *(LAS f32x4*)(Ts + (16 * i + r) * 68 + 16 * j + c4) = acc;
                            v2u pb; pb.x = f2bf(acc.x) | (f2bf(acc.y) << 16); pb.y = f2bf(acc.z) | (f2bf(acc.w) << 16); *(LAS v2u*)(Tb + (16 * i + r) * 144 + (16 * j + c4) * 2) = pb; }
                        asm volatile("s_waitcnt lgkmcnt(0)" ::: "memory");
                    }
                    }
                } else if (tid < 384 && hn < GH) {
                    const int cgp = tid & 15, wt = tid >> 4, which = wt >> 3, tr = wt & 7, d0 = cgp * 8, ch0 = which * GDNW + hn * HD + d0;
                    f32x4 wl_[4], wh_[4], ol[8], oh[8];
#pragma unroll
                    for (int k = 0; k < 4; ++k) { wl_[k] = *(const f32x4*)(GDN_CONV_W + ((size_t)l * 4 + k) * (3 * GDNW) + ch0); wh_[k] = *(const f32x4*)(GDN_CONV_W + ((size_t)l * 4 + k) * (3 * GDNW) + ch0 + 4); }
                    float ss[8];
#pragma unroll
                    for (int tt = 0; tt < 8; ++tt) { f32x4 al = (f32x4){0.f, 0.f, 0.f, 0.f}, ah = (f32x4){0.f, 0.f, 0.f, 0.f};
#pragma unroll
                        for (int k = 0; k < 4; ++k) { const v4u xw = xpn[tt + k];
                            al += wl_[k] * (f32x4){bflo(xw.x), bfhi(xw.x), bflo(xw.y), bfhi(xw.y)}; ah += wh_[k] * (f32x4){bflo(xw.z), bfhi(xw.z), bflo(xw.w), bfhi(xw.w)}; }
#pragma unroll
                        for (int c = 0; c < 4; ++c) { al[c] = silu_fast(al[c]); ah[c] = silu_fast(ah[c]); }
                        ol[tt] = al; oh[tt] = ah;
                        ss[tt] = (al.x * al.x + al.y * al.y) + (al.z * al.z + al.w * al.w) + (ah.x * ah.x + ah.y * ah.y) + (ah.z * ah.z + ah.w * ah.w); }
                    if (which < 2) {
#pragma unroll
                        for (int tt = 0; tt < 8; ++tt) { float v = ss[tt]; v += bperm_(lane ^ 1, v); v += bperm_(lane ^ 2, v); v += bperm_(lane ^ 4, v); v += bperm_(lane ^ 8, v);
                            const float scl = __builtin_amdgcn_rsqf(v + 1e-6f) * (which == 0 ? 0.08838834764831845f : 1.0f); ol[tt] = ol[tt] * scl; oh[tt] = oh[tt] * scl; }
                    }
                    const int tb = tr * 8;
                    if (which == 0) {
#pragma unroll
                        for (int tt = 0; tt < 8; ++tt) { const int t = tb + tt; const float eg = segn[t];
                            v4u pk; pk.x = cvtpk(ol[tt].x, ol[tt].y); pk.y = cvtpk(ol[tt].z, ol[tt].w); pk.z = cvtpk(oh[tt].x, oh[tt].y); pk.w = cvtpk(oh[tt].z, oh[tt].w);
                            *(LAS v4u*)(qb + t * 272 + d0 * 2) = pk;
                            v4u pg; pg.x = cvtpk(ol[tt].x * eg, ol[tt].y * eg); pg.y = cvtpk(ol[tt].z * eg, ol[tt].w * eg); pg.z = cvtpk(oh[tt].x * eg, oh[tt].y * eg); pg.w = cvtpk(oh[tt].z * eg, oh[tt].w * eg);
                            { bf16* qrow = WSH(WS_GQD) + item4n * 8192 + t * 128 + (d0 & ~31); const int kl = d0 & 31;
                                v2u p0; p0.x = pg.x; p0.y = pg.y; v2u p1; p1.x = pg.z; p1.y = pg.w; *(v2u*)(qrow + kperm4(kl)) = p0; *(v2u*)(qrow + kperm4(kl + 4)) = p1; } }
                    } else if (which == 1) {
                        float fb[8], fl[8];
#pragma unroll
                        for (int tt = 0; tt < 8; ++tt) { const int t = tb + tt; fb[tt] = sbetan[t] * segn[t]; fl[tt] = seln[t];
                            v4u pk; pk.x = cvtpk(ol[tt].x, ol[tt].y); pk.y = cvtpk(ol[tt].z, ol[tt].w); pk.z = cvtpk(oh[tt].x, oh[tt].y); pk.w = cvtpk(oh[tt].z, oh[tt].w);
                            *(LAS v4u*)(kb + t * 272 + d0 * 2) = pk; }
#define KV_(tt) ((c) < 4 ? ol[tt][(c) & 3] : oh[tt][(c) & 3])
#pragma unroll
                        for (int c = 0; c < 8; ++c) {
                            pe[c].x = cvtpk(KV_(0) * fb[0], KV_(1) * fb[1]); pe[c].y = cvtpk(KV_(2) * fb[2], KV_(3) * fb[3]); pe[c].z = cvtpk(KV_(4) * fb[4], KV_(5) * fb[5]); pe[c].w = cvtpk(KV_(6) * fb[6], KV_(7) * fb[7]);
                            v4u pt; pt.x = cvtpk(KV_(0) * fl[0], KV_(1) * fl[1]); pt.y = cvtpk(KV_(2) * fl[2], KV_(3) * fl[3]); pt.z = cvtpk(KV_(4) * fl[4], KV_(5) * fl[5]); pt.w = cvtpk(KV_(6) * fl[6], KV_(7) * fl[7]);
                            { bf16* krow = WSH(WS_GKT) + item4n * 8192 + (d0 + c) * 64 + (tb & ~31); const int kl = tb & 31;
                                v2u p0; p0.x = pt.x; p0.y = pt.y; v2u p1; p1.x = pt.z; p1.y = pt.w; *(v2u*)(krow + kperm4(kl)) = p0; *(v2u*)(krow + kperm4(kl + 4)) = p1; } }
                    } else {
                        float fb[8];
#pragma unroll
                        for (int tt = 0; tt < 8; ++tt) fb[tt] = sbetan[tb + tt];
#pragma unroll
                        for (int c = 0; c < 8; ++c) { pe[c].x = cvtpk(KV_(0) * fb[0], KV_(1) * fb[1]); pe[c].y = cvtpk(KV_(2) * fb[2], KV_(3) * fb[3]); pe[c].z = cvtpk(KV_(4) * fb[4], KV_(5) * fb[5]); pe[c].w = cvtpk(KV_(6) * fb[6], KV_(7) * fb[7]); }
#undef KV_
                    }
                }
                WG_BAR();
                if (h >= 0) {
                    const int nt = wave;
#pragma unroll
                    for (int mt = 0; mt < 4; ++mt) { f32x4 ua = (f32x4){0.f, 0.f, 0.f, 0.f}, wa = (f32x4){0.f, 0.f, 0.f, 0.f};
#pragma unroll
                        for (int ks = 0; ks < 2; ++ks) if (32 * ks <= 16 * mt + 15) { const bf16x8 A = ld128(Tb + (16 * mt + m) * 144 + (32 * ks + 8 * q) * 2);
                            const int swz = (((4 * ks + q) ^ ((2 * nt + (m >> 3)) & 7)) * 16);
                            ua = MFMA16(A, ld128(vT + (16 * nt + m) * 144 + swz), ua); wa = MFMA16(A, ld128(kbeT + (16 * nt + m) * 144 + swz), wa); }
                        unsigned uts[4];
#pragma unroll
                        for (int r = 0; r < 4; ++r) { const int t = 16 * mt + 4 * q + r, d = 16 * nt + m;
                            uts[r] = f2bf(ua[r]); *(LAS unsigned short*)(wst + t * 272 + kperm(d) * 2) = (unsigned short)f2bf(-wa[r]); }
                        { v2u pu; pu.x = uts[0] | (uts[1] << 16); pu.y = uts[2] | (uts[3] << 16); *(LAS v2u*)(F.lds + PG_LS + (16 * nt + m) * 128 + (((2 * mt + (q >> 1)) ^ (m & 7)) * 16) + (q & 1) * 8) = pu; } }
                    WG_BAR();
                }
                if (h >= 0) {
#pragma unroll
                    for (int e = 0; e < 2; ++e) { const int p = tid + 512 * e, row = p >> 4, c16 = p & 15;
                        *(v4u*)((unsigned char*)(WSH(WS_MIX + 16 * MiB) + item4 * 8192) + row * 256 + c16 * 16) = *(const LAS v4u*)(wst + row * 272 + c16 * 16);
                        const int ur = p >> 3, uc = p & 7;
                        *(v4u*)((unsigned char*)(WSH(WS_MIX) + item4 * 8192) + ur * 128 + uc * 16) = *(const LAS v4u*)(F.lds + PG_LS + ur * 128 + ((uc ^ (ur & 7)) * 16)); }
                    { const int row = tid >> 3, c16 = tid & 7;
                        *(v4u*)((unsigned char*)(WSH(WS_GATT) + item4 * 4096) + row * 128 + c16 * 16) = *(const LAS v4u*)(atts + row * 144 + c16 * 16); }
                    if (tid == 0) WSF(WS_GL)[item4] = seg[63];
                }
                if (tid >= 128 && tid < 384 && hn < GH) {
                    const int cgp = tid & 15, wt = tid >> 4, which = wt >> 3, tr = wt & 7, d0 = cgp * 8;
                    LAS unsigned char* dstT = which == 1 ? kbeT : vT;
#pragma unroll
                    for (int c = 0; c < 8; ++c) *(LAS v4u*)(dstT + (d0 + c) * 144 + ((tr ^ (cgp & 7)) * 16)) = pe[c];
                }
                WG_BAR();
            }
        }
    }
}

#undef PREP_IDS
constexpr int SC_W = 0, SC_QD = 18432, SC_KT = 36864, SC_AT = 57344, SC_U = 67584, SC_STAGE = 76800;
static_assert(2 * SC_STAGE <= RING_BYTES, "scan stages fit the ring");
#define SBAR_() __builtin_amdgcn_sched_barrier(0)
constexpr int NSEG = 8, SEGC = NCH / NSEG;
constexpr size_t WS_PSI = 344 * MiB;
constexpr size_t WS_PHI = 352 * MiB;
constexpr size_t WS_SST = 356 * MiB;
static_assert(WS_SST + 8 * MiB <= WS_END, "two-level scan scratch");

#define SC_ADDR() \
        const unsigned char* gW = (const unsigned char*)(WSH(WS_MIX + 16 * MiB) + it0 * 8192); \
        const unsigned char* gQD = (const unsigned char*)(WSH(WS_GQD) + it0 * 8192); \
        const unsigned char* gKT = (const unsigned char*)(WSH(WS_GKT) + it0 * 8192); \
        const unsigned char* gAT = (const unsigned char*)(WSH(WS_GATT) + it0 * 4096); \
        const unsigned char* gU = (const unsigned char*)(WSH(WS_MIX) + it0 * 8192) + dvbase * 128;
#define SC_LOAD(rg, n_) do { const size_t cb = (size_t)(n_) * 16384, ca = (size_t)(n_) * 8192; \
            _Pragma("unroll") for (int i = 0; i < 4; ++i) { rg[i] = *(const v4u*)(gW + cb + gofW + i * 4096); if (FULL) rg[4 + i] = *(const v4u*)(gQD + cb + gofW + i * 4096); \
                rg[8 + i] = *(const v4u*)(gKT + cb + gofK + i * 4096); } \
            _Pragma("unroll") for (int i = 0; i < 2; ++i) { if (FULL) rg[12 + i] = *(const v4u*)(gAT + ca + gofK + i * 4096); rg[14 + i] = *(const v4u*)(gU + cb + gofK + i * 4096); } } while (0)
#define SC_WRITE(rg, buf_) do { LAS unsigned char* sb_ = F.lds + (buf_) * SC_STAGE; \
            _Pragma("unroll") for (int i = 0; i < 4; ++i) { *(LAS v4u*)(sb_ + SC_W + lofW + i * (16 * 288)) = rg[i]; if (FULL) *(LAS v4u*)(sb_ + SC_QD + lofW + i * (16 * 288)) = rg[4 + i]; \
                *(LAS v4u*)(sb_ + SC_KT + lofK + i * (32 * 160)) = rg[8 + i]; } \
            _Pragma("unroll") for (int i = 0; i < 2; ++i) { if (FULL) *(LAS v4u*)(sb_ + SC_AT + lofK + i * (32 * 160)) = rg[12 + i]; *(LAS v4u*)(sb_ + SC_U + lofU + i * (32 * 144)) = rg[14 + i]; } } while (0)
#define SC_LOADER_LOOP() do { \
            int lt_ = F.tid & 255; asm volatile("" : "+v"(lt_)); \
            const int gofW = (lt_ >> 4) * 256 + (lt_ & 15) * 16, gofK = (lt_ >> 3) * 128 + (lt_ & 7) * 16; \
            const int lofW = (lt_ >> 4) * 288 + (lt_ & 15) * 16, lofK = (lt_ >> 3) * 160 + (lt_ & 7) * 16, lofU = (lt_ >> 3) * 144 + (lt_ & 7) * 16; \
            const int nlast = n0 + SEGC - 1; \
            v4u ra[16], rb[16]; \
            SC_LOAD(ra, n0); SC_WRITE(ra, 0); SC_LOAD(ra, n0 + 1); SC_LOAD(rb, n0 + 2); \
            __syncthreads(); \
            _Pragma("unroll 1") for (int j = 0; j < SEGC; j += 2) { \
                  \
                  \
                SC_WRITE(ra, 1); \
                { const int nn = n0 + j + 3 < nlast ? n0 + j + 3 : nlast; SC_LOAD(ra, nn); } \
                WG_BAR(); \
                SC_WRITE(rb, 0); \
                { const int nn = n0 + j + 4 < nlast ? n0 + j + 4 : nlast; SC_LOAD(rb, nn); } \
                WG_BAR(); \
            } } while (0)

DI void p_scan1(Frame& F, int l) {
    constexpr bool FULL = false;
    const int wave = F.wave;
    { const int lane = F.lane;
        for (int p = blockIdx.x * NWAVES + wave; p < BATCH * LRUW; p += gridDim.x * NWAVES) { const int b = p / LRUW, c = p % LRUW;
            float A = WSF(WS_AGG)[((size_t)(b * NCH + lane)) * LRUW + c], B = WSF(WS_AGG)[(size_t)BATCH * NCH * LRUW + ((size_t)(b * NCH + lane)) * LRUW + c];
#pragma unroll
            for (int off = 1; off < 64; off <<= 1) { const float Ap = shfl_up_(lane, A, off), Bp = shfl_up_(lane, B, off); if (lane >= off) { B = A * Bp + B; A = A * Ap; } }
            if (lane < 63) WSF(WS_CARRY)[((size_t)(b * NCH + lane + 1)) * LRUW + c] = B; else WSF(WS_CARRY)[((size_t)(b * NCH)) * LRUW + c] = 0.f; } }
    const bool is_loader = wave >= 4;
    const int wv = wave & 3;
    for (int job = F.vcu; job < BATCH * GH * NSEG * 2; job += F.G) {
        const int bh = job >> 4, seg = (job >> 1) & (NSEG - 1), dvbase = (job & 1) * 64, n0 = seg * SEGC;
        const size_t it0 = (size_t)bh * NCH;
        SC_ADDR()
        (void)gQD; (void)gAT;
        if (seg == NSEG - 1) { __syncthreads(); continue; }
        if (is_loader) { SC_LOADER_LOOP(); }
        else {
            int tc_ = F.tid; asm volatile("" : "+v"(tc_)); const int lane = tc_ & 63, m = lane & 15, q = lane >> 4;
            const int col = dvbase + 16 * wv + m;
            f32x4 Sacc[2][8];
#pragma unroll
            for (int dt = 0; dt < 8; ++dt) { Sacc[0][dt] = (f32x4){0.f, 0.f, 0.f, 0.f};
#pragma unroll
                for (int r = 0; r < 4; ++r) Sacc[1][dt][r] = (16 * dt + 4 * q + r == col) ? 1.f : 0.f; }
            const float glv = WSF(WS_GL)[it0 + lane];
            __syncthreads();
#pragma unroll 1
            for (int j = 0; j < SEGC; ++j) {
                const LAS unsigned char* B = F.lds + (j & 1) * SC_STAGE;
                bf16x8 fa[4], fb[4], Sb[2][4], vnb[2][2];
                f32x4 vn[2][4];
                v2u ut[4];
#pragma unroll
                for (int mt = 0; mt < 4; ++mt) ut[mt] = *(const LAS v2u*)(B + SC_U + (16 * wv + m) * 144 + (16 * mt + 4 * q) * 2);
#define LDW4(dst, mt_) do { _Pragma("unroll") for (int kb = 0; kb < 4; ++kb) dst[kb] = ld128(B + SC_W + (16 * (mt_) + m) * 288 + (32 * kb + 8 * q) * 2); } while (0)
#define MMW2(src, mt_) do { _Pragma("unroll") for (int kb = 0; kb < 4; ++kb) { vn[0][mt_] = MFMA16(src[kb], Sb[0][kb], vn[0][mt_]); vn[1][mt_] = MFMA16(src[kb], Sb[1][kb], vn[1][mt_]); } } while (0)
#define LDK4(dst, dt_) do { dst[0] = ld128(B + SC_KT + (16 * (dt_) + m) * 160 + (8 * q) * 2); dst[1] = ld128(B + SC_KT + (16 * (dt_) + m) * 160 + (32 + 8 * q) * 2); \
                            dst[2] = ld128(B + SC_KT + (16 * ((dt_) + 1) + m) * 160 + (8 * q) * 2); dst[3] = ld128(B + SC_KT + (16 * ((dt_) + 1) + m) * 160 + (32 + 8 * q) * 2); } while (0)
#define MMK2(src, dt_) do { _Pragma("unroll") for (int e = 0; e < 2; ++e) { Sacc[e][dt_] = MFMA16(src[0], vnb[e][0], Sacc[e][dt_]); Sacc[e][dt_] = MFMA16(src[1], vnb[e][1], Sacc[e][dt_]); \
                            Sacc[e][(dt_) + 1] = MFMA16(src[2], vnb[e][0], Sacc[e][(dt_) + 1]); Sacc[e][(dt_) + 1] = MFMA16(src[3], vnb[e][1], Sacc[e][(dt_) + 1]); } } while (0)
                LDW4(fa, 0); SBAR_();
#pragma unroll
                for (int e = 0; e < 2; ++e)
#pragma unroll
                    for (int kb = 0; kb < 4; ++kb) Sb[e][kb] = pack8(Sacc[e][2 * kb], Sacc[e][2 * kb + 1]);
#pragma unroll
                for (int mt = 0; mt < 4; ++mt) { vn[0][mt] = (f32x4){bflo(ut[mt].x), bfhi(ut[mt].x), bflo(ut[mt].y), bfhi(ut[mt].y)}; vn[1][mt] = (f32x4){0.f, 0.f, 0.f, 0.f}; }
                const float gl = __builtin_bit_cast(float, __builtin_amdgcn_readlane(__builtin_bit_cast(int, glv), n0 + j));
                SBAR_(); LDW4(fb, 1); SBAR_(); MMW2(fa, 0); SBAR_();
                LDW4(fa, 2); SBAR_(); MMW2(fb, 1); SBAR_();
                LDW4(fb, 3); SBAR_(); MMW2(fa, 2); SBAR_();
                LDK4(fa, 0); SBAR_(); MMW2(fb, 3); SBAR_();
#pragma unroll
                for (int e = 0; e < 2; ++e) { vnb[e][0] = pack8(vn[e][0], vn[e][1]); vnb[e][1] = pack8(vn[e][2], vn[e][3]);
#pragma unroll
                    for (int dt = 0; dt < 8; ++dt) Sacc[e][dt] = Sacc[e][dt] * gl; }
                SBAR_(); LDK4(fb, 2); SBAR_(); MMK2(fa, 0); SBAR_();
                LDK4(fa, 4); SBAR_(); MMK2(fb, 2); SBAR_();
                LDK4(fb, 6); SBAR_(); MMK2(fa, 4); SBAR_();
                MMK2(fb, 6); SBAR_();
                WG_BAR();
            }
#undef LDW4
#undef MMW2
#undef LDK4
#undef MMK2
            float* psi = WSF(WS_PSI) + ((size_t)(bh * NSEG + seg) * 128) * 128 + col;
            bf16* phi = WSH(WS_PHI) + ((size_t)(bh * NSEG + seg) * 128) * 128 + kperm(col);
#pragma unroll
            for (int dt = 0; dt < 8; ++dt)
#pragma unroll
                for (int r = 0; r < 4; ++r) { const int dk = 16 * dt + 4 * q + r; psi[(size_t)dk * 128] = Sacc[0][dt][r]; phi[(size_t)dk * 128] = (bf16)f2bf(Sacc[1][dt][r]); }
        }
        __syncthreads();
    }
}

DI void p_scan2(Frame& F, int l) {
    const int wave = F.wave;
    for (int bh = blockIdx.x; bh < BATCH * GH; bh += gridDim.x) {
        int tc_ = F.tid; asm volatile("" : "+v"(tc_)); const int tid = tc_, lane = tc_ & 63, m = lane & 15, q = lane >> 4;
        const int col = 16 * wave + m;
        const int gof = (tid >> 4) * 256 + (tid & 15) * 16, lof = (tid >> 4) * 288 + (tid & 15) * 16;
        const unsigned char* phi0 = (const unsigned char*)(WSH(WS_PHI) + ((size_t)(bh * NSEG) * 128) * 128);
        const float* psi0 = WSF(WS_PSI) + ((size_t)(bh * NSEG) * 128) * 128 + col;
        float* sst0 = WSF(WS_SST) + ((size_t)(bh * NSEG) * 128) * 128 + col;
        f32x4 S[8], Ps[8]; v4u pr[4];
#pragma unroll
        for (int dt = 0; dt < 8; ++dt) { S[dt] = (f32x4){0.f, 0.f, 0.f, 0.f};
#pragma unroll
            for (int r = 0; r < 4; ++r) Ps[dt][r] = psi0[(size_t)(16 * dt + 4 * q + r) * 128]; }
#pragma unroll
        for (int i = 0; i < 4; ++i) pr[i] = *(const v4u*)(phi0 + gof + i * 8192);
#pragma unroll
        for (int i = 0; i < 4; ++i) *(LAS v4u*)(F.lds + lof + i * (32 * 288)) = pr[i];
        __syncthreads();
#pragma unroll 1
        for (int seg = 0; seg + 1 < NSEG; ++seg) {
            if (seg > 0) {
#pragma unroll
                for (int dt = 0; dt < 8; ++dt)
#pragma unroll
                    for (int r = 0; r < 4; ++r) sst0[((size_t)seg * 128 + 16 * dt + 4 * q + r) * 128] = S[dt][r]; }
            const int sn = seg + 2 < NSEG ? seg + 1 : seg;
#pragma unroll
            for (int i = 0; i < 4; ++i) pr[i] = *(const v4u*)(phi0 + (size_t)sn * 32768 + gof + i * 8192);
            f32x4 Pn[8];
#pragma unroll
            for (int dt = 0; dt < 8; ++dt)
#pragma unroll
                for (int r = 0; r < 4; ++r) Pn[dt][r] = psi0[((size_t)sn * 128 + 16 * dt + 4 * q + r) * 128];
            const LAS unsigned char* B = F.lds + (seg & 1) * 36864;
            bf16x8 Sb[4];
#pragma unroll
            for (int kb = 0; kb < 4; ++kb) Sb[kb] = pack8(S[2 * kb], S[2 * kb + 1]);
#pragma unroll
            for (int dt = 0; dt < 8; ++dt) { f32x4 acc = Ps[dt];
#pragma unroll
                for (int kb = 0; kb < 4; ++kb) acc = MFMA16(ld128(B + (16 * dt + m) * 288 + (32 * kb + 8 * q) * 2), Sb[kb], acc);
                S[dt] = acc; }
#pragma unroll
            for (int dt = 0; dt < 8; ++dt) Ps[dt] = Pn[dt];
#pragma unroll
            for (int i = 0; i < 4; ++i) *(LAS v4u*)(F.lds + ((seg + 1) & 1) * 36864 + lof + i * (32 * 288)) = pr[i];
            __syncthreads();
        }
#pragma unroll
        for (int dt = 0; dt < 8; ++dt)
#pragma unroll
            for (int r = 0; r < 4; ++r) sst0[((size_t)(NSEG - 1) * 128 + 16 * dt + 4 * q + r) * 128] = S[dt][r];
        __syncthreads();
    }
}

DI void p_scan3(Frame& F, int l) {
    constexpr bool FULL = true;
    const int wave = F.wave;
    const bool is_loader = wave >= 4;
    const int wv = wave & 3;
    for (int job = F.vcu; job < BATCH * GH * NSEG * 2; job += F.G) {
        const int bh = job >> 4, seg = (job >> 1) & (NSEG - 1), dvbase = (job & 1) * 64, n0 = seg * SEGC, b = bh >> 2, h = bh & 3;
        const size_t it0 = (size_t)bh * NCH;
        SC_ADDR()
        if (is_loader) { SC_LOADER_LOOP(); }
        else {
            int tc_ = F.tid; asm volatile("" : "+v"(tc_)); const int lane = tc_ & 63, m = lane & 15, q = lane >> 4;
            f32x4 Sacc[8];
            if (seg == 0) {
#pragma unroll
                for (int dt = 0; dt < 8; ++dt) Sacc[dt] = (f32x4){0.f, 0.f, 0.f, 0.f};
            } else { const float* sst = WSF(WS_SST) + ((size_t)(bh * NSEG + seg) * 128) * 128 + dvbase + 16 * wv + m;
#pragma unroll
                for (int dt = 0; dt < 8; ++dt)
#pragma unroll
                    for (int r = 0; r < 4; ++r) Sacc[dt][r] = sst[(size_t)(16 * dt + 4 * q + r) * 128]; }
            const float glv = WSF(WS_GL)[it0 + lane];
            __syncthreads();
#define FR_W(dst, mt_) do { _Pragma("unroll") for (int kb = 0; kb < 4; ++kb) { dst[kb] = ld128(B + SC_W + (16 * (mt_) + m) * 288 + (32 * kb + 8 * q) * 2); dst[4 + kb] = ld128(B + SC_QD + (16 * (mt_) + m) * 288 + (32 * kb + 8 * q) * 2); } } while (0)
#define MM_W(src, mt_) do { _Pragma("unroll") for (int kb = 0; kb < 4; ++kb) { vn[mt_] = MFMA16(src[kb], Sb[kb], vn[mt_]); o[mt_] = MFMA16(src[4 + kb], Sb[kb], o[mt_]); } } while (0)
#define FR_KT(dst, hf_) do { _Pragma("unroll") for (int i = 0; i < 8; ++i) dst[i] = ld128(B + SC_KT + (16 * (4 * (hf_) + (i >> 1)) + m) * 160 + (32 * (i & 1) + 8 * q) * 2); } while (0)
#define MM_KT(src, hf_) do { _Pragma("unroll") for (int i = 0; i < 8; ++i) Sacc[4 * (hf_) + (i >> 1)] = MFMA16(src[i], vnb[i & 1], Sacc[4 * (hf_) + (i >> 1)]); } while (0)
#pragma unroll 1
            for (int j = 0; j < SEGC; ++j) {
                const int n = n0 + j;
                const LAS unsigned char* B = F.lds + (j & 1) * SC_STAGE;
                bf16x8 fa[8], fb[8], Sb[4], vnb[2];
                f32x4 vn[4], o[4];
                v2u ut[4];
#pragma unroll
                for (int mt = 0; mt < 4; ++mt) ut[mt] = *(const LAS v2u*)(B + SC_U + (16 * wv + m) * 144 + (16 * mt + 4 * q) * 2);
                FR_W(fa, 0); SBAR_();
#pragma unroll
                for (int kb = 0; kb < 4; ++kb) Sb[kb] = pack8(Sacc[2 * kb], Sacc[2 * kb + 1]);
#pragma unroll
                for (int mt = 0; mt < 4; ++mt) { o[mt] = (f32x4){0.f, 0.f, 0.f, 0.f}; vn[mt] = (f32x4){bflo(ut[mt].x), bfhi(ut[mt].x), bflo(ut[mt].y), bfhi(ut[mt].y)}; }
                const float gl = __builtin_bit_cast(float, __builtin_amdgcn_readlane(__builtin_bit_cast(int, glv), n));
                SBAR_(); FR_W(fb, 1); SBAR_(); MM_W(fa, 0); SBAR_();
                FR_W(fa, 2); SBAR_(); MM_W(fb, 1); SBAR_();
                FR_W(fb, 3); SBAR_(); MM_W(fa, 2); SBAR_();
                fa[0] = ld128(B + SC_AT + (m) * 160 + (8 * q) * 2); fa[1] = ld128(B + SC_AT + (16 + m) * 160 + (8 * q) * 2);
                fa[2] = ld128(B + SC_AT + (32 + m) * 160 + (8 * q) * 2); fa[3] = ld128(B + SC_AT + (32 + m) * 160 + (32 + 8 * q) * 2);
                fa[4] = ld128(B + SC_AT + (48 + m) * 160 + (8 * q) * 2); fa[5] = ld128(B + SC_AT + (48 + m) * 160 + (32 + 8 * q) * 2);
                SBAR_(); MM_W(fb, 3); SBAR_();
                vnb[0] = pack8(vn[0], vn[1]); vnb[1] = pack8(vn[2], vn[3]);
#pragma unroll
                for (int dt = 0; dt < 8; ++dt) Sacc[dt] = Sacc[dt] * gl;
                SBAR_(); FR_KT(fb, 0); SBAR_();
                o[0] = MFMA16(fa[0], vnb[0], o[0]); o[1] = MFMA16(fa[1], vnb[0], o[1]); o[2] = MFMA16(fa[2], vnb[0], o[2]); o[3] = MFMA16(fa[4], vnb[0], o[3]);
                o[2] = MFMA16(fa[3], vnb[1], o[2]); o[3] = MFMA16(fa[5], vnb[1], o[3]);
                SBAR_(); FR_KT(fa, 1); SBAR_(); MM_KT(fb, 0); SBAR_();
                MM_KT(fa, 1); SBAR_();
                float* go = WSF(WS_GO) + (size_t)(b * SEQ + n * CH + 4 * q) * GDNW + h * HD + dvbase + 16 * wv + m;
#pragma unroll
                for (int mt = 0; mt < 4; ++mt)
#pragma unroll
                    for (int r = 0; r < 4; ++r) go[(size_t)(16 * mt + r) * GDNW] = o[mt][r];
                WG_BAR();
            }
#undef FR_W
#undef MM_W
#undef FR_KT
#undef MM_KT
        }
        __syncthreads();
    }
}
#undef SC_ADDR
#undef SC_LOAD
#undef SC_WRITE
#undef SC_LOADER_LOOP

DI float gelu_fast(float x) { const float u2 = 1.5957691216057308f * (x + 0.044715f * x * x * x); return x * rcp_(1.f + exp_fast(-u2)); }
struct PostRow { v4u hp[2]; v2u y2[2], z2[2]; f32x4 go[2], cr[2]; };
DI void post_load(Frame& F, PostRow& R, int m, int lane) {
    const int b = m >> 12, n = (m & (SEQ - 1)) >> 6;
#pragma unroll
    for (int j = 0; j < 2; ++j) { const int c = 4 * lane + 256 * j;
        R.hp[j] = *(const v4u*)((const unsigned*)(F.A->ws + WS_H) + (size_t)m * LRUW + c);
        R.cr[j] = *(const f32x4*)(WSF(WS_CARRY) + ((size_t)(b * NCH + n)) * LRUW + c);
        R.y2[j] = *(const v2u*)(WSH(WS_PROJ) + (size_t)m * NPROJ + O_LY + c);
        R.go[j] = *(const f32x4*)(WSF(WS_GO) + (size_t)m * GDNW + c);
        R.z2[j] = *(const v2u*)(WSH(WS_PROJ) + (size_t)m * NPROJ + O_Z + c); }
}
DI void p_post(Frame& F, int l) {
    const int gw = F.vcu * NWAVES + F.wave, NGW = F.G * NWAVES, lane = F.lane;
    PostRow R;
    if (gw < M) post_load(F, R, gw, lane);
    for (int m = gw; m < M; m += NGW) {
        PostRow Rn; const int mn = m + NGW;
        post_load(F, Rn, mn < M ? mn : m, lane);
        f32x4 val[2]; float ss = 0.f;
#pragma unroll
        for (int j = 0; j < 2; ++j) { const v4u hp = R.hp[j]; const v2u y2 = R.y2[j];
            const f32x4 hl = (f32x4){bflo(hp.x), bflo(hp.y), bflo(hp.z), bflo(hp.w)}, p = (f32x4){bfhi(hp.x), bfhi(hp.y), bfhi(hp.z), bfhi(hp.w)};
            const f32x4 hh = hl + p * R.cr[j];
            val[j] = (f32x4){hh.x * gelu_fast(bflo(y2.x)), hh.y * gelu_fast(bfhi(y2.x)), hh.z * gelu_fast(bflo(y2.y)), hh.w * gelu_fast(bfhi(y2.y))};
            ss += (val[j].x * val[j].x + val[j].y * val[j].y) + (val[j].z * val[j].z + val[j].w * val[j].w); }
        ss = wave_sum_(lane, ss);
        const float rl = 1.0f / sqrtf(ss * (1.0f / LRUW) + EPS);
#pragma unroll
        for (int j = 0; j < 2; ++j) { const int c = 4 * lane + 256 * j; const f32x4 nw = *(const f32x4*)(LRU_NORM_W + (size_t)l * LRUW + c);
            const f32x4 o = val[j] * rl * nw; v2u w; w.x = pk2(o.x, o.y); w.y = pk2(o.z, o.w); *(v2u*)(WSH(WS_MIX) + (size_t)m * D + c) = w; }
#pragma unroll
        for (int j = 0; j < 2; ++j) { const int c = 4 * lane + 256 * j, d = c & (HD - 1);
            const f32x4 o = R.go[j]; const v2u z2 = R.z2[j];
            const float s2 = half_sum_(lane, (o.x * o.x + o.y * o.y) + (o.z * o.z + o.w * o.w));
            const float rg = 1.0f / sqrtf(s2 * (1.0f / HD) + EPS);
            const f32x4 nw = *(const f32x4*)(GDN_NORM_W + (size_t)l * HD + d);
            const f32x4 r = (f32x4){o.x * rg * nw.x * silu_fast(bflo(z2.x)), o.y * rg * nw.y * silu_fast(bfhi(z2.x)), o.z * rg * nw.z * silu_fast(bflo(z2.y)), o.w * rg * nw.w * silu_fast(bfhi(z2.y))};
            v2u w; w.x = pk2(r.x, r.y); w.y = pk2(r.z, r.w); *(v2u*)(WSH(WS_MIX) + (size_t)m * D + LRUW + c) = w; }
        R = Rn;
    }
}

typedef _Float16 h16x4 __attribute__((ext_vector_type(4)));
DI void final_row(Frame& F, const _Float16* xrow, float* orow, int lane) {
    f32x4 v[4]; float ss = 0.f;
#pragma unroll
    for (int j = 0; j < 4; ++j) { const h16x4 hv = *(const h16x4*)(xrow + 4 * lane + 256 * j); v[j] = (f32x4){(float)hv[0], (float)hv[1], (float)hv[2], (float)hv[3]};
        ss += (v[j].x * v[j].x + v[j].y * v[j].y) + (v[j].z * v[j].z + v[j].w * v[j].w); }
    ss = wave_sum_(lane, ss);
    const float rstd = 1.0f / sqrtf(ss * (1.0f / D) + EPS);
#pragma unroll
    for (int j = 0; j < 4; ++j) { const int col = 4 * lane + 256 * j; const f32x4 nw = *(const f32x4*)(FINAL_NORM_W + col); *(f32x4*)(orow + col) = v[j] * rstd * nw; }
}
DI void p_final(Frame& F) {
    const int gw = F.vcu * NWAVES + F.wave, NGW = F.G * NWAVES, lane = F.lane;
    for (int m = gw; m < M; m += NGW) final_row(F, (const _Float16*)(F.A->ws + WS_H) + (size_t)m * D, OUT_ + (size_t)m * D, lane);
}

__device__ __forceinline__ void pg8::EpiMulti::operator()(const f32x4 (&acc)[2][2][4][2], const Unit& u, int wr, int wc, int fr, int fq, int ui) const {
    const PG8_LAS float* rtab = ui < 4 ? rt + ui * 256 : nullptr;
    const __attribute__((address_space(4))) Args* ap = (const __attribute__((address_space(4))) Args*)__builtin_amdgcn_kernarg_segment_ptr(); asm volatile("" : "+s"(ap));
    unsigned char* ws = ap->ws;
    const int b = (u.pm * BM) / SEQ;
    if (mode == 0) { EpiBf16<0> e{(bf16_t*)(ws + WS_PROJ), NPROJ, nullptr, 0, 0, 1.f, nullptr, nullptr}; e(acc, u, wr, wc, fr, fq); }
    else if (mode == 5) { EpiBf16<0> e{(bf16_t*)(ws + WS_PROJ), NPROJ, (const float*)(ws + WS_C1) + ((size_t)l * BATCH + b) * NPROJ, 0, 0, 1.f, rtab, (const float*)(ws + WS_RS1)}; e(acc, u, wr, wc, fr, fq); }
    else if (mode == 6) { EpiBf16<2> e{(bf16_t*)(ws + WS_ACT), FF, (const float*)(ws + WS_C2) + ((size_t)l * BATCH + b) * FF, 0, 0, 1.f, rtab, (const float*)(ws + WS_RS2)}; e(acc, u, wr, wc, fr, fq); }
    else if (mode == 3) { const float* modb = (const float*)(ws + WS_MOD) + ((size_t)l * BATCH + b) * NMODC; _Float16* x16 = (_Float16*)((unsigned char*)ap->out + X16_OFF);
        EpiResid2 r{ap->in[0], l == 0 ? nullptr : x16, x16, modb + 2 * D, ap->in[3] + (size_t)l * D, modb + 4 * D, (bf16_t*)(ws + WS_H), (float*)(ws + WS_RS2)}; r(acc, u, wr, wc, fr, fq); }
    else { const float* modb = (const float*)(ws + WS_MOD) + ((size_t)l * BATCH + b) * NMODC; const bool nx = l + 1 < DEPTH; _Float16* x16 = (_Float16*)((unsigned char*)ap->out + X16_OFF);
        EpiResid2 r{nullptr, x16, nx ? x16 : (_Float16*)(ws + WS_H), modb + 5 * D, nx ? ap->in[2] + (size_t)(l + 1) * D : nullptr, modb + NMODC * BATCH + D, (bf16_t*)(ws + WS_A1), (float*)(ws + WS_RS1)}; r(acc, u, wr, wc, fr, fq); }
}

__global__ void __launch_bounds__(NWAVES * 64, 2) mk_fwd(Args args) {
    extern __shared__ __attribute__((aligned(16))) unsigned char lds[];
    Frame F;
    F.lds = (LAS unsigned char*)lds;
    F.MISC = (volatile LAS unsigned*)(F.lds + MISC_OFF);
    F.tid = threadIdx.x; F.lane = F.tid & 63; F.wave = __builtin_amdgcn_readfirstlane(F.tid >> 6);
    F.G = gridDim.x; { const int bx = blockIdx.x; F.vcu = (F.G % 8 == 0) ? (bx % 8) * (F.G / 8) + bx / 8 : bx; }
    F.A = (const __attribute__((address_space(4))) Args*)__builtin_amdgcn_kernarg_segment_ptr();
    F.ctl = (gu32*)(F.A->ws + WS_CTL);
    for (int u = F.tid; u < (LDS_BYTES - LDSCTL_OFF) / 4; u += NWAVES * 64) ((LAS unsigned*)(F.lds + LDSCTL_OFF))[u] = 0u;
    __syncthreads();
    XcdBarrier bar; bar.bar = (unsigned*)(F.ctl + CW_BAR); bar.x = 0; bar.st = nullptr;
    if (N_LAUNCHES == 1) bar = xcd_barrier_post((unsigned*)(F.ctl + CW_BAR), F.MISC + 8);

    const int lo = F.A->ph_lo, hi = F.A->ph_hi;
    int rep_done = 0;
#pragma unroll 1
    for (int s = lo; s < hi; ++s) {
        { const __attribute__((address_space(4))) Args* ap = (const __attribute__((address_space(4))) Args*)__builtin_amdgcn_kernarg_segment_ptr(); asm volatile("" : "+s"(ap)); F.A = ap; }
        { int t_ = threadIdx.x; asm volatile("" : "+v"(t_)); F.tid = t_; F.lane = t_ & 63; F.wave = __builtin_amdgcn_readfirstlane(t_ >> 6); }
        if (s == 0) { if (PH_MASK & 1) { p_mod(F); __syncthreads(); p0_weights(F); xcd_barrier(bar, F.tid == 0); p_cvec(F); __syncthreads(); p_normmod<false>(F, 0, X_IN, NORM_MIX_W, 0, D); } }
        else if (s == N_STEPS - 1) { if (PH_MASK & 2) { p_final(F); } }
        else {
            const int l = (s - 1) / 9, i = (s - 1) % 9;
            if (i == 0 || i == 6) continue;
            bf16* wl = WSH(WS_W) + (size_t)l * LAYER_W;
            const float* modl = WSF(WS_MOD) + (size_t)l * BATCH * NMODC;
            if (!((PH_MASK >> (2 + i)) & 1)) {}
            else if (i == 0) { p_normmod<true>(F, l, l == 0 ? X_IN : OUT_, NORM_MIX_W, 0, D); }
            else if (i == 2) { p_prep(F, l); }
            else if (i == 3) {
                p_scan1(F, l); xcd_barrier(bar, F.tid == 0);
#if defined(SCAN_REP) && SCAN_REP == 1
                p_scan1(F, l); xcd_barrier(bar, F.tid == 0);
#endif
                p_scan2(F, l); xcd_barrier(bar, F.tid == 0);
#if defined(SCAN_REP) && SCAN_REP == 2
                p_scan2(F, l); xcd_barrier(bar, F.tid == 0);
#endif
                p_scan3(F, l);
#if defined(SCAN_REP) && SCAN_REP == 3
                xcd_barrier(bar, F.tid == 0); p_scan3(F, l);
#endif
            }
            else if (i == 4) { p_post(F, l); }
            else if (i == 6) { p_normmod<false>(F, l, OUT_, NORM_MLP_W, 3 * D, 4 * D); }
            else {
                pg8::Gemm g; pg8::EpiMulti E; E.l = l; E.rt = (const LAS float*)(F.lds + RSTAB_OFF);
                if (i == 1) { g = pg8::Gemm{l == 0 ? WSH(WS_H) : WSH(WS_A1), wl, M, NPROJ, D}; E.PERM = true; E.mode = (l == 0 ? 0 : 5); }
                else if (i == 5) { g = pg8::Gemm{WSH(WS_MIX), wl + W_OUT_OFF, M, D, D}; E.PERM = true; E.mode = 3; }
                else if (i == 7) { g = pg8::Gemm{WSH(WS_H), wl + W_UP_OFF, M, FF, D}; E.PERM = true; E.mode = 6; }
                else { g = pg8::Gemm{WSH(WS_ACT), wl + W_DOWN_OFF, M, D, FF}; E.PERM = true; E.mode = 4; }
                pg8::StaticOrder S; S.init(g.M, g.N, F.G, (int)blockIdx.x);
                if (E.mode == 5 || E.mode == 6) {
                    LAS float* tab = (LAS float*)(F.lds + RSTAB_OFF); const float* rsp = WSF(E.mode == 5 ? WS_RS1 : WS_RS2);
                    const int slot = F.tid >> 7; pg8::Unit uu;
                    if (S.next(slot, uu)) for (int rr = F.tid & 127; rr < 256; rr += 128) { const f32x4* rp = (const f32x4*)(rsp + (size_t)(uu.pm * 256 + rr) * 16);
                        const f32x4 p0 = rp[0], p1 = rp[1], p2 = rp[2], p3 = rp[3], ts = (p0 + p1) + (p2 + p3);
                        tab[slot * 256 + rr] = 1.0f / sqrtf(((ts[0] + ts[1]) + (ts[2] + ts[3])) * (1.0f / D) + EPS); }
                    __syncthreads(); }
                pg8::gemm_phase<pg8::EpiMulti, pg8::StaticOrder, PG8_ALIGN, PG8_SP2>(F.lds + RING_OFF, g, S, E);
            }
        }
        if (REP_MASK != 0 && ((s >= 1 && s < N_STEPS - 1 && ((REP_MASK >> ((s - 1) % 9)) & 1)) || (s == 0 && (REP_MASK & 0x10000))) && !rep_done) { rep_done = 1; --s; xcd_barrier(bar, F.tid == 0); continue; }
        rep_done = 0;
        if (s + 1 < hi) xcd_barrier(bar, F.tid == 0);
#ifdef PROBE_XBAR
        if (s >= 1 && s < N_STEPS - 1) { xcd_barrier(bar, F.tid == 0); xcd_barrier(bar, F.tid == 0); }
#endif
    }
}

extern "C" void kernel_launch(void* const* d_in, const int* in_sizes, int n_in, void* d_out, int out_size, void* d_ws, size_t ws_size, hipStream_t stream) {
    static int grid = 0;
    if (grid == 0) {
        if (n_in != 23 || in_sizes[0] != M * D || out_size != M * D || ws_size < WS_END) { fprintf(stderr, "kernel_launch: unexpected shapes (n_in %d, in0 %d, out %d, ws %zu); nothing launched\n", n_in, n_in > 0 ? in_sizes[0] : -1, out_size, ws_size); grid = -1; return; }
        int dev = 0, cus = 0;
        if (hipGetDevice(&dev) != hipSuccess || hipDeviceGetAttribute(&cus, hipDeviceAttributeMultiprocessorCount, dev) != hipSuccess) { grid = -1; return; }
        if (hipFuncSetAttribute((const void*)mk_fwd, hipFuncAttributeMaxDynamicSharedMemorySize, LDS_BYTES) != hipSuccess) { fprintf(stderr, "kernel_launch: hipFuncSetAttribute failed\n"); grid = -1; return; }
        (void)hipGetLastError();
        grid = cus;
    }
    if (grid < 0) return;
    if (hipMemsetAsync((char*)d_ws + WS_CTL, 0, CTL_ZERO_BYTES, stream) != hipSuccess) return;
    Args a{};
    for (int i = 0; i < 23; ++i) a.in[i] = (const float*)d_in[i];
    a.out = (float*)d_out; a.ws = (unsigned char*)d_ws;
    if (N_LAUNCHES == 1) { a.ph_lo = 0; a.ph_hi = N_STEPS; hipLaunchKernelGGL(mk_fwd, dim3(grid), dim3(NWAVES * 64), LDS_BYTES, stream, a); }
    else for (int s = 0; s < N_STEPS; ++s) { a.ph_lo = s; a.ph_hi = s + 1; hipLaunchKernelGGL(mk_fwd, dim3(grid), dim3(NWAVES * 64), LDS_BYTES, stream, a); }
}
```

```cpp
#include <hip/hip_runtime.h>
#include <cstdio>
#include <cstdint>
#include <cmath>
namespace pg8 {
#define PG8_LAS __attribute__((address_space(3)))
typedef unsigned short bf16_t;
typedef short bf16x8 __attribute__((ext_vector_type(8)));
typedef float f32x4 __attribute__((ext_vector_type(4)));
typedef unsigned u32x4 __attribute__((ext_vector_type(4)));
constexpr int BM = 256, BK = 64, HALF = 128, HTB = HALF * BK * 2  , STAGE_BYTES = 8 * HTB, NXCD = 8, WGM = 8;

__host__ __device__ __forceinline__ int lds_byte(int r, int c) { const int st = (r >> 4) * 2 + (c >> 5), rr = r & 15, cc = c & 31, ob = rr * 64 + cc * 2; return st * 1024 + (ob ^ (((ob >> 9) & 1) << 5)); }
__host__ __device__ __forceinline__ void stage_rc(int b, int& R, int& C) { const int st = b / 1024, sb = b % 1024, swz = sb ^ (((sb >> 9) & 1) << 5); R = (st >> 1) * 16 + swz / 64; C = (st & 1) * 32 + (swz % 64) / 2; }
__host__ __device__ __forceinline__ int perm32(int rho) { const int n = rho >> 4, i = rho & 15; return 8 * (i >> 2) + 4 * n + (i & 3); }

struct Unit { int pm, pn; };
struct Gemm { const bf16_t* A; const bf16_t* Bt; int M, N, K; };

struct StaticOrder {
    int nM, nN, nwg, G, c;
    __host__ __device__ void init(int M, int N, int G_, int c_) { nM = M / BM; nN = N / BM; nwg = nM * nN; G = G_; c = c_; }
    __host__ __device__ bool next(int i, Unit& u) const {
        const long L = (long)i * G + c; if (L >= nwg) return false;
        int wgid = (int)L; { const int q = nwg / NXCD, r = nwg % NXCD, xcd = wgid % NXCD, off = wgid / NXCD; wgid = (xcd < r ? xcd * (q + 1) : r * (q + 1) + (xcd - r) * q) + off; }
        const int nig = WGM * nN, gid = wgid / nig, fm = gid * WGM, gsz = (nM - fm) < WGM ? (nM - fm) : WGM;
        u.pm = fm + ((wgid % nig) % gsz); u.pn = (wgid % nig) / gsz; return true;
    }
    __device__ __forceinline__ void a_ready(const Unit&) const {}
    __device__ __forceinline__ void done(const Unit&) const {}
};

__device__ __forceinline__ unsigned cvt_pk_bf16(float lo, float hi) { unsigned r; asm volatile("v_cvt_pk_bf16_f32 %0, %1, %2" : "=v"(r) : "v"(lo), "v"(hi)); return r; }
typedef float f32x2 __attribute__((ext_vector_type(2)));
__device__ __forceinline__ f32x2 gelu_pk(f32x2 v) {
    const f32x2 av = __builtin_elementwise_abs(v), d = av * 0.2316418882f + 1.0f;
    f32x2 t; t.x = __builtin_amdgcn_rcpf(d.x); t.y = __builtin_amdgcn_rcpf(d.y);
    f32x2 q = t * 0.5307027145f + (-0.7265760135f); q = q * t + 0.7107068705f; q = q * t + (-0.142248368f); q = q * t + 0.127414796f; q = q * t;
    const f32x2 s = (v * v) * (-0.72134752044f);
    f32x2 e; e.x = __builtin_amdgcn_exp2f(s.x); e.y = __builtin_amdgcn_exp2f(s.y);
    const f32x2 m = v * (q * e), r = v - m;
    f32x2 o; o.x = v.x < 0.f ? m.x : r.x; o.y = v.y < 0.f ? m.y : r.y; return o;
}

template <int ACT  > struct EpiBf16 {
    static constexpr bool PERM = true, AFTER_DRAIN = false; static_assert(ACT == 0 || ACT == 1 || ACT == 2, "EpiBf16: ACT is 0 (none), 1 (gelu_pk) or 2 (squared relu)");
    bf16_t* O; int ldc; const float* bias; int split_cols; size_t split_stride; float scale0;
    const PG8_LAS float* rtab = nullptr;
    const float* rs = nullptr;
    __device__ __forceinline__ void operator()(const f32x4 (&acc)[2][2][4][2], const Unit& u, int wr, int wc, int fr, int fq) const {
        const int row0 = u.pm * BM + wr * 64 + fr; int colt = u.pn * BM; bf16_t* base = O;
        float sc = 1.f; if (split_cols) { const int t = colt / split_cols; base += (size_t)t * split_stride; colt -= t * split_cols; if (t == 0) sc = scale0; }
        const int col0 = colt + wc * 32 + 8 * fq, bcol0 = u.pn * BM + wc * 32 + 8 * fq;
        f32x4 bv[2][2];
#pragma unroll
        for (int bj = 0; bj < 2; ++bj)
#pragma unroll
            for (int n = 0; n < 2; ++n) bv[bj][n] = bias ? *(const f32x4*)(bias + bcol0 + bj * HALF + 4 * n) : (f32x4){0.f, 0.f, 0.f, 0.f};
#pragma unroll
        for (int ai = 0; ai < 2; ++ai)
#pragma unroll
            for (int m = 0; m < 4; ++m) { bf16_t* rowp = base + (size_t)(row0 + ai * HALF + m * 16) * ldc + col0;
                float rsc = 1.f;
                if (rtab) rsc = rtab[wr * 64 + fr + ai * HALF + m * 16];
                else if (rs) { const f32x4* rp = (const f32x4*)(rs + (size_t)(row0 + ai * HALF + m * 16) * 16); const f32x4 p0 = rp[0], p1 = rp[1], p2 = rp[2], p3 = rp[3];
                    const f32x4 t = (p0 + p1) + (p2 + p3); rsc = 1.0f / sqrtf(((t[0] + t[1]) + (t[2] + t[3])) * (1.0f / 1024.0f) + 1e-6f); }
#pragma unroll
                for (int bj = 0; bj < 2; ++bj) { f32x4 v0 = acc[ai][bj][m][0] * rsc + bv[bj][0], v1 = acc[ai][bj][m][1] * rsc + bv[bj][1];
                    if (ACT == 1) { f32x2 a = gelu_pk((f32x2){v0[0], v0[1]}), b = gelu_pk((f32x2){v0[2], v0[3]}), c = gelu_pk((f32x2){v1[0], v1[1]}), d = gelu_pk((f32x2){v1[2], v1[3]});
                        v0 = (f32x4){a.x, a.y, b.x, b.y}; v1 = (f32x4){c.x, c.y, d.x, d.y}; }
                    if (ACT == 2) { _Pragma("unroll") for (int q_ = 0; q_ < 4; ++q_) { const float a_ = fmaxf(v0[q_], 0.f), b_ = fmaxf(v1[q_], 0.f); v0[q_] = a_ * a_; v1[q_] = b_ * b_; } }
                    v0 = v0 * sc; v1 = v1 * sc; u32x4 w; w.x = cvt_pk_bf16(v0[0], v0[1]); w.y = cvt_pk_bf16(v0[2], v0[3]); w.z = cvt_pk_bf16(v1[0], v1[1]); w.w = cvt_pk_bf16(v1[2], v1[3]);
                    *(u32x4*)(rowp + bj * HALF) = w; } }
    }
};


struct EpiResid {
    static constexpr bool PERM = false, AFTER_DRAIN = false;
    const float* base; float* out; const float* gate; int ldc; int gate_stride; int rows_per_batch;
    __device__ __forceinline__ void operator()(const f32x4 (&acc)[2][2][4][2], const Unit& u, int wr, int wc, int fr, int fq) const {
        const int col0 = u.pn * BM + wc * 32 + 4 * fq;
        const float* gp = gate + (size_t)((u.pm * BM) / rows_per_batch) * gate_stride + col0;
        f32x4 gv[2][2];
#pragma unroll
        for (int bj = 0; bj < 2; ++bj)
#pragma unroll
            for (int n = 0; n < 2; ++n) gv[bj][n] = *(const f32x4*)(gp + bj * HALF + n * 16);
#pragma unroll
        for (int ai = 0; ai < 2; ++ai)
#pragma unroll
            for (int m = 0; m < 4; ++m) { const size_t off = (size_t)(u.pm * BM + ai * HALF + wr * 64 + m * 16 + fr) * ldc + col0;
#pragma unroll
                for (int bj = 0; bj < 2; ++bj)
#pragma unroll
                    for (int n = 0; n < 2; ++n) { const f32x4 bs = *(const f32x4*)(base + off + bj * HALF + n * 16);
                        *(f32x4*)(out + off + bj * HALF + n * 16) = bs + gv[bj][n] * acc[ai][bj][m][n]; } }
    }
};


typedef _Float16 f16x8 __attribute__((ext_vector_type(8)));
typedef _Float16 f16x4 __attribute__((ext_vector_type(4)));
struct EpiResid2 {
    static constexpr bool PERM = true, AFTER_DRAIN = false;
    const float* base32; const _Float16* base16; _Float16* out16; const float* gate;
    const float* nw; const float* sc;
    bf16_t* anext; float* rsum;
    __device__ __forceinline__ void operator()(const f32x4 (&acc)[2][2][4][2], const Unit& u, int wr, int wc, int fr, int fq) const {
        const int col0 = u.pn * BM + wc * 32 + 8 * fq, lane = fr + 16 * fq;
        f32x4 gv[2][2], ns[2][2];
#pragma unroll
        for (int bj = 0; bj < 2; ++bj)
#pragma unroll
            for (int n = 0; n < 2; ++n) { const int c = col0 + bj * HALF + 4 * n; gv[bj][n] = *(const f32x4*)(gate + c);
                ns[bj][n] = nw ? *(const f32x4*)(nw + c) * (*(const f32x4*)(sc + c) + 1.0f) : (f32x4){0.f, 0.f, 0.f, 0.f}; }
#pragma unroll
        for (int ai = 0; ai < 2; ++ai)
#pragma unroll
            for (int m = 0; m < 4; ++m) { const size_t off = (size_t)(u.pm * BM + ai * HALF + wr * 64 + m * 16 + fr) * 1024 + col0;
                f32x4 bs[2][2];
                if (base16) {
                    f16x8 hb[2];
#pragma unroll
                    for (int bj = 0; bj < 2; ++bj) hb[bj] = *(const f16x8*)(base16 + off + bj * HALF);
#pragma unroll
                    for (int bj = 0; bj < 2; ++bj) { bs[bj][0] = (f32x4){(float)hb[bj][0], (float)hb[bj][1], (float)hb[bj][2], (float)hb[bj][3]}; bs[bj][1] = (f32x4){(float)hb[bj][4], (float)hb[bj][5], (float)hb[bj][6], (float)hb[bj][7]}; }
                } else {
#pragma unroll
                    for (int bj = 0; bj < 2; ++bj)
#pragma unroll
                        for (int n = 0; n < 2; ++n) bs[bj][n] = *(const f32x4*)(base32 + off + bj * HALF + 4 * n);
                }
                float ssq = 0.f;
#pragma unroll
                for (int bj = 0; bj < 2; ++bj) { const f32x4 x0 = bs[bj][0] + gv[bj][0] * acc[ai][bj][m][0], x1 = bs[bj][1] + gv[bj][1] * acc[ai][bj][m][1];
                    f16x8 ho; ho[0] = (_Float16)x0[0]; ho[1] = (_Float16)x0[1]; ho[2] = (_Float16)x0[2]; ho[3] = (_Float16)x0[3]; ho[4] = (_Float16)x1[0]; ho[5] = (_Float16)x1[1]; ho[6] = (_Float16)x1[2]; ho[7] = (_Float16)x1[3];
                    *(f16x8*)(out16 + off + bj * HALF) = ho;
                    if (nw) { const f32x4 h0 = x0 * ns[bj][0], h1 = x1 * ns[bj][1]; u32x4 w; w.x = cvt_pk_bf16(h0[0], h0[1]); w.y = cvt_pk_bf16(h0[2], h0[3]); w.z = cvt_pk_bf16(h1[0], h1[1]); w.w = cvt_pk_bf16(h1[2], h1[3]);
                        *(u32x4*)(anext + off + bj * HALF) = w;
                        ssq += ((x0[0] * x0[0] + x0[1] * x0[1]) + (x0[2] * x0[2] + x0[3] * x0[3])) + ((x1[0] * x1[0] + x1[1] * x1[1]) + (x1[2] * x1[2] + x1[3] * x1[3])); } }
                if (nw) { ssq += __builtin_bit_cast(float, __builtin_amdgcn_ds_bpermute((lane ^ 16) << 2, __builtin_bit_cast(int, ssq)));
                    ssq += __builtin_bit_cast(float, __builtin_amdgcn_ds_bpermute((lane ^ 32) << 2, __builtin_bit_cast(int, ssq)));
                    if (fq == 0) rsum[(size_t)(u.pm * BM + ai * HALF + wr * 64 + m * 16 + fr) * 16 + u.pn * 4 + wc] = ssq; }
                if (m & 1) asm volatile("" ::: "memory"); }
    }
};

struct EpiMulti {
    static constexpr bool AFTER_DRAIN = false;
    bool PERM; int mode, l; const PG8_LAS float* rt;
    __device__ __forceinline__ void operator()(const f32x4 (&acc)[2][2][4][2], const Unit& u, int wr, int wc, int fr, int fq, int ui) const;
};

template <class Epi, class Sched, bool ALIGN_EPI = false, bool SP2 = false>
__device__ __forceinline__ void gemm_phase(PG8_LAS unsigned char* lds, const Gemm g, const Sched& S, const Epi& E) {
    int tid_l = threadIdx.x; asm volatile("" : "+v"(tid_l));
    const int tid = tid_l, wid = __builtin_amdgcn_readfirstlane(tid >> 6), lane = tid & 63, wr = wid >> 2, wc = wid & 3, fr = lane & 15, fq = lane >> 4;
    const int K = g.K, nt = K / BK;
    unsigned voffA[2], voffB[2];
#pragma unroll
    for (int i = 0; i < 2; ++i) { int R, C; stage_rc(tid * 16 + i * 8192, R, C); const int Rb = E.PERM ? ((R & ~31) + perm32(R & 31)) : R;
        voffA[i] = (unsigned)(R * K + C) * 2u; voffB[i] = (unsigned)(Rb * K + C) * 2u; }
    const size_t kstep = (size_t)(BK * 2);
    const size_t hstep = (size_t)HALF * K * 2;
    const size_t tstep = 2 * hstep;
    const unsigned ldsw = (unsigned)wid * 1024u;
    const int aoff = lds_byte(wr * 64 + fr, fq * 8), boff = lds_byte(wc * 32 + fr, fq * 8);
#define PG8_SA(b, h) (((b) * 2 + (h)) * HTB)
#define PG8_SB(b, h) ((4 + (b) * 2 + (h)) * HTB)
#define PG8_STAGE(bufoff, gbase, voff) do { _Pragma("unroll") for (int _i = 0; _i < 2; ++_i) \
        __builtin_amdgcn_global_load_lds((const unsigned*)((const char*)(gbase) + (voff)[_i]), (PG8_LAS unsigned*)(lds + (bufoff) + ldsw + _i * 8192), 16, 0, 0); } while (0)
#define PG8_LDA(dst, b, h) do { _Pragma("unroll") for (int m = 0; m < 4; ++m) _Pragma("unroll") for (int k = 0; k < 2; ++k) dst[m][k] = *(const PG8_LAS bf16x8*)(lds + PG8_SA(b, h) + aoff + m * 2048 + k * 1024); } while (0)
#define PG8_LDB(dst, b, h) do { _Pragma("unroll") for (int n = 0; n < 2; ++n) _Pragma("unroll") for (int k = 0; k < 2; ++k) dst[n][k] = *(const PG8_LAS bf16x8*)(lds + PG8_SB(b, h) + boff + n * 2048 + k * 1024); } while (0)
#define PG8_MMA(ai, bj, At, Bt) do { __builtin_amdgcn_s_setprio(1); _Pragma("unroll") for (int m = 0; m < 4; ++m) _Pragma("unroll") for (int n = 0; n < 2; ++n) _Pragma("unroll") for (int k = 0; k < 2; ++k) \
        acc[ai][bj][m][n] = __builtin_amdgcn_mfma_f32_16x16x32_bf16(Bt[n][k], At[m][k], acc[ai][bj][m][n], 0, 0, 0); __builtin_amdgcn_s_setprio(0); } while (0)
#define PG8_WAIT_V(n) asm volatile("s_waitcnt vmcnt(" #n ")" ::: "memory")
#define PG8_WAIT_L(n) asm volatile("s_waitcnt lgkmcnt(" #n ")" ::: "memory")
#define PG8_BAR __builtin_amdgcn_s_barrier()
#define PG8_SCHED __builtin_amdgcn_sched_barrier(0)
    Unit cur, nxt; int ui = 0;
    if (!S.next(0, cur)) return;
    f32x4 acc[2][2][4][2];
#pragma unroll
    for (int a = 0; a < 2; ++a)
#pragma unroll
        for (int b = 0; b < 2; ++b)
#pragma unroll
            for (int m = 0; m < 4; ++m)
#pragma unroll
                for (int n = 0; n < 2; ++n) acc[a][b][m][n] = (f32x4){0.f, 0.f, 0.f, 0.f};
    bf16x8 At[4][2], B0[2][2], B1[2][2];
    const char* cA = (const char*)g.A + (size_t)cur.pm * tstep; const char* cB = (const char*)g.Bt + (size_t)cur.pn * tstep;
    S.a_ready(cur);
    if constexpr (SP2) {
        PG8_STAGE(PG8_SB(0, 0), cB, voffB); PG8_STAGE(PG8_SB(0, 1), cB + hstep, voffB); PG8_STAGE(PG8_SA(0, 0), cA, voffA); PG8_STAGE(PG8_SA(0, 1), cA + hstep, voffA);
        if (wr == 1) PG8_BAR;
        PG8_WAIT_V(2); PG8_BAR;
        PG8_STAGE(PG8_SB(1, 0), cB + kstep, voffB); PG8_STAGE(PG8_SA(1, 0), cA + kstep, voffA); PG8_STAGE(PG8_SB(1, 1), cB + hstep + kstep, voffB);
        PG8_WAIT_V(6); PG8_BAR;
    } else {
        PG8_STAGE(PG8_SB(0, 0), cB, voffB); PG8_STAGE(PG8_SA(0, 0), cA, voffA); PG8_STAGE(PG8_SB(0, 1), cB + hstep, voffB); PG8_STAGE(PG8_SA(0, 1), cA + hstep, voffA);
        if (wr == 1) PG8_BAR;
        PG8_WAIT_V(4); PG8_BAR;
        PG8_STAGE(PG8_SB(1, 0), cB + kstep, voffB); PG8_STAGE(PG8_SA(1, 0), cA + kstep, voffA); PG8_STAGE(PG8_SB(1, 1), cB + hstep + kstep, voffB);
        PG8_WAIT_V(6); PG8_BAR;
    }
    for (;;) {
        const bool has_next = S.next(ui + 1, nxt);
        const char* nA = has_next ? (const char*)g.A + (size_t)nxt.pm * tstep : cA; const char* nB = has_next ? (const char*)g.Bt + (size_t)nxt.pn * tstep : cB;
        for (int t = 0; t < nt; t += 2) {
            const bool last = (t == nt - 2);
            const char* a1 = cA + (size_t)(t + 1) * kstep;
            const char* a2 = last ? nA : cA + (size_t)(t + 2) * kstep; const char* b2 = last ? nB : cB + (size_t)(t + 2) * kstep;
            const char* a3 = a2 + kstep; const char* b3 = b2 + kstep;
            if (last && has_next) S.a_ready(nxt);
            if constexpr (SP2) {
            PG8_LDB(B0, 0, 0); PG8_LDB(B1, 0, 1); PG8_SCHED; PG8_LDA(At, 0, 0); PG8_STAGE(PG8_SA(1, 1), a1 + hstep, voffA);
            PG8_WAIT_V(8); PG8_WAIT_L(0); PG8_BAR; PG8_MMA(0, 0, At, B0); PG8_MMA(0, 1, At, B1); PG8_BAR; PG8_SCHED;
            PG8_LDA(At, 0, 1); PG8_STAGE(PG8_SB(0, 0), b2, voffB); PG8_STAGE(PG8_SB(0, 1), b2 + hstep, voffB); PG8_STAGE(PG8_SA(0, 0), a2, voffA);
            PG8_WAIT_V(8); PG8_WAIT_L(0); PG8_BAR; PG8_MMA(1, 0, At, B0); PG8_MMA(1, 1, At, B1); PG8_BAR; PG8_SCHED;
            PG8_LDB(B0, 1, 0); PG8_LDB(B1, 1, 1); PG8_SCHED; PG8_LDA(At, 1, 0); PG8_STAGE(PG8_SA(0, 1), a2 + hstep, voffA);
            PG8_WAIT_V(8); PG8_WAIT_L(0); PG8_BAR; PG8_MMA(0, 0, At, B0); PG8_MMA(0, 1, At, B1); PG8_BAR; PG8_SCHED;
            PG8_LDA(At, 1, 1); PG8_STAGE(PG8_SB(1, 0), b3, voffB); PG8_STAGE(PG8_SB(1, 1), b3 + hstep, voffB); PG8_STAGE(PG8_SA(1, 0), a3, voffA);
            PG8_WAIT_V(8); PG8_WAIT_L(0); PG8_BAR; PG8_MMA(1, 0, At, B0); PG8_MMA(1, 1, At, B1); PG8_BAR; PG8_SCHED;
            } else {
            PG8_LDB(B0, 0, 0); PG8_SCHED; PG8_LDA(At, 0, 0); PG8_STAGE(PG8_SA(1, 1), a1 + hstep, voffA);
            PG8_WAIT_L(8); PG8_BAR; PG8_WAIT_L(0); PG8_MMA(0, 0, At, B0); PG8_BAR; PG8_SCHED;
            PG8_LDB(B1, 0, 1); PG8_STAGE(PG8_SB(0, 0), b2, voffB);
            PG8_BAR; PG8_WAIT_L(0); PG8_MMA(0, 1, At, B1); PG8_BAR;
            PG8_LDA(At, 0, 1); PG8_STAGE(PG8_SA(0, 0), a2, voffA);
            PG8_BAR; PG8_WAIT_L(0); PG8_MMA(1, 0, At, B0); PG8_BAR; PG8_SCHED;
            PG8_STAGE(PG8_SB(0, 1), b2 + hstep, voffB);
            PG8_WAIT_V(6); PG8_BAR; PG8_MMA(1, 1, At, B1); PG8_BAR;
            PG8_LDB(B0, 1, 0); PG8_SCHED; PG8_LDA(At, 1, 0); PG8_STAGE(PG8_SA(0, 1), a2 + hstep, voffA);
            PG8_WAIT_L(8); PG8_BAR; PG8_WAIT_L(0); PG8_MMA(0, 0, At, B0); PG8_BAR; PG8_SCHED;
            PG8_LDB(B1, 1, 1); PG8_STAGE(PG8_SB(1, 0), b3, voffB);
            PG8_BAR; PG8_WAIT_L(0); PG8_MMA(0, 1, At, B1); PG8_BAR;
            PG8_LDA(At, 1, 1); PG8_STAGE(PG8_SA(1, 0), a3, voffA);
            PG8_BAR; PG8_WAIT_L(0); PG8_MMA(1, 0, At, B0); PG8_BAR; PG8_SCHED;
            PG8_STAGE(PG8_SB(1, 1), b3 + hstep, voffB);
            PG8_WAIT_V(6); PG8_BAR; PG8_MMA(1, 1, At, B1); PG8_BAR;
            }
        }
        if constexpr (ALIGN_EPI) { if (wr == 0) PG8_BAR; }
        if constexpr (!Epi::AFTER_DRAIN) { E(acc, cur, wr, wc, fr, fq, ui); S.done(cur); }
        if (!has_next) break;
#pragma unroll
        for (int a = 0; a < 2; ++a)
#pragma unroll
            for (int b = 0; b < 2; ++b)
#pragma unroll
                for (int m = 0; m < 4; ++m)
#pragma unroll
                    for (int n = 0; n < 2; ++n) acc[a][b][m][n] = (f32x4){0.f, 0.f, 0.f, 0.f};
        cur = nxt; cA = nA; cB = nB; ++ui;
        if constexpr (ALIGN_EPI) { if (wr == 1) PG8_BAR; }
    }
    PG8_WAIT_V(0);
    if constexpr (!ALIGN_EPI) { if (wr == 0) PG8_BAR; }
    PG8_BAR;
    if constexpr (Epi::AFTER_DRAIN) { E.fused(acc, cur, wr, wc, fr, fq, lds, wid, lane); S.done(cur); }
#undef PG8_SA
#undef PG8_SB
#undef PG8_STAGE
#undef PG8_LDA
#undef PG8_LDB
#undef PG8_MMA
#undef PG8_WAIT_V
#undef PG8_WAIT_L
#undef PG8_BAR
#undef PG8_SCHED
}
}
#define GAS __attribute__((address_space(1)))
#define LAS __attribute__((address_space(3)))
typedef unsigned short bf16;
typedef unsigned v4u __attribute__((ext_vector_type(4)));
typedef float f32x4 __attribute__((ext_vector_type(4)));
typedef short bf16x8 __attribute__((ext_vector_type(8)));
typedef GAS unsigned gu32;
typedef GAS unsigned long long gu64;
#define RLX_AGENT __ATOMIC_RELAXED, __HIP_MEMORY_SCOPE_AGENT
#define LDS_WAIT() asm volatile("s_waitcnt lgkmcnt(0)" ::: "memory")
#define VM_WAIT() asm volatile("s_waitcnt vmcnt(0)" ::: "memory")
__device__ __forceinline__ unsigned long long rt() { return __builtin_amdgcn_s_memrealtime(); }
__device__ __forceinline__ unsigned f2bf(float f) { unsigned u = __builtin_bit_cast(unsigned, f); return (u + 0x7fffu + ((u >> 16) & 1u)) >> 16; }
__device__ __forceinline__ unsigned pk2(float lo, float hi) { return f2bf(lo) | (f2bf(hi) << 16); }

#define XB_TMO      128
#define XB_XCNT(j)  (256  + 64 * (j))
#define XB_XSUB(j)  (1280 + 64 * (j))
#define XB_XGEN(j)  (2304 + 64 * (j))
#define XB_TOP      3328
#define XB_TOPGEN   3392
#define XCD_BAR_WORDS 3456
#define XB_SPIN_CAP (1u << 18)

__device__ __forceinline__ unsigned xb_ld(unsigned* p)              { return __hip_atomic_load(p, __ATOMIC_RELAXED, __HIP_MEMORY_SCOPE_AGENT); }
__device__ __forceinline__ unsigned xb_add(unsigned* p, unsigned v) { return __hip_atomic_fetch_add(p, v, __ATOMIC_RELAXED, __HIP_MEMORY_SCOPE_AGENT); }
__device__ __forceinline__ unsigned xb_xcc_id() { return (unsigned)__builtin_amdgcn_s_getreg((3 << 11) | 20) & 0xFu; }
#define XB_SPIN(cond, bar) do { unsigned _sp = 0; while (cond) { __builtin_amdgcn_s_sleep(1); \
    if ((++_sp & 255u) == 0u) { if (xb_ld(&(bar)[XB_TMO])) break; if (_sp > XB_SPIN_CAP) { atomicAdd(&(bar)[XB_TMO], 1u); break; } } } } while (0)

struct XcdBarrier {
    unsigned* bar; unsigned x;
    volatile LAS unsigned* st;
};

__device__ __forceinline__ XcdBarrier xcd_barrier_post(unsigned* bar, volatile LAS unsigned* st) {
    XcdBarrier b; b.bar = bar; b.x = xb_xcc_id(); b.st = st;
    if (threadIdx.x == 0) (void)xb_add(&bar[XB_XCNT(b.x)], 1u);
    return b;
}
__device__ __forceinline__ void xcd_barrier_complete(unsigned* bar, unsigned x, unsigned& nloc, unsigned& nx) {
    const unsigned G = gridDim.x * gridDim.y * gridDim.z;
    unsigned sum, cnt, mine, sp = 0u;
    for (;;) {
        sum = 0u; cnt = 0u; mine = 0u;
#pragma unroll
        for (unsigned j = 0; j < 16; ++j) { const unsigned c = xb_ld(&bar[XB_XCNT(j)]); sum += c; cnt += (c > 0u) ? 1u : 0u; mine = (j == x) ? c : mine; }
        if (sum == G) break;
        __builtin_amdgcn_s_sleep(1);
        if ((++sp & 255u) == 0u) { if (xb_ld(&bar[XB_TMO])) break; if (sp > XB_SPIN_CAP) { atomicAdd(&bar[XB_TMO], 1u); break; } }
    }
    nloc = mine > 0u ? mine : 1u; nx = cnt > 0u ? cnt : 1u;
}

__device__ __forceinline__ void xcd_barrier(const XcdBarrier& b, const bool t0  ) {
    asm volatile("s_waitcnt vmcnt(0)" ::: "memory");
    __syncthreads();
    if (t0) {
        unsigned* bar = b.bar;
        __builtin_amdgcn_s_waitcnt(0);
        unsigned nloc = b.st[0], nx = b.st[1];
        if (nloc == 0u) { xcd_barrier_complete(bar, b.x, nloc, nx); b.st[0] = nloc; b.st[1] = nx; }
        const unsigned old = xb_add(&bar[XB_XSUB(b.x)], 1u);
        const unsigned gen = old / nloc;
        if (old + 1u == (gen + 1u) * nloc) {
            __builtin_amdgcn_fence(__ATOMIC_RELEASE, "agent");
            asm volatile("s_waitcnt vmcnt(0)" ::: "memory");
            const unsigned og = xb_add(&bar[XB_TOP], 1u);
            const unsigned tg = og / nx;
            __builtin_amdgcn_fence(__ATOMIC_ACQUIRE, "agent");
            if (og + 1u == (tg + 1u) * nx) xb_add(&bar[XB_TOPGEN], 1u);
            else XB_SPIN(xb_ld(&bar[XB_TOPGEN]) == tg, bar);
            xb_add(&bar[XB_XGEN(b.x)], 1u);
            asm volatile("s_waitcnt vmcnt(0)" ::: "memory");
        } else {
            __builtin_amdgcn_fence(__ATOMIC_ACQUIRE, "agent");
            XB_SPIN(xb_ld(&bar[XB_XGEN(b.x)]) == gen, bar);
            asm volatile("s_waitcnt vmcnt(0)" ::: "memory");
        }
    }
    __syncthreads();
}

#define GB_CNT(c)  (8192 + 64 * (c))
#define GB_GEN(c)  (12288 + 64 * (c))
#define GB_XCC(b)  (16384 + (b))
__device__ __forceinline__ void grp_barrier(unsigned* ctlw, unsigned* bar, const bool t0, const unsigned cidx, const unsigned sh) {
    asm volatile("s_waitcnt vmcnt(0)" ::: "memory");
    __syncthreads();
    if (t0) {
        const unsigned old = xb_add(&ctlw[GB_CNT(cidx)], 1u);
        const unsigned gen = old >> sh;
        __builtin_amdgcn_fence(__ATOMIC_ACQUIRE, "agent");
        if (old + 1u == ((gen + 1u) << sh)) xb_add(&ctlw[GB_GEN(cidx)], 1u);
        else XB_SPIN(xb_ld(&ctlw[GB_GEN(cidx)]) == gen, bar);
        asm volatile("s_waitcnt vmcnt(0)" ::: "memory");
    }
    __syncthreads();
}

#ifndef PG8_SP2
#define PG8_SP2 true
#endif
#ifndef PG8_ALIGN
#define PG8_ALIGN true
#endif
constexpr int NWAVES = 8;
constexpr int N_STEPS = 38;
#ifndef MK_N_LAUNCHES
#define MK_N_LAUNCHES 1
#endif
#ifndef PH_MASK
#define PH_MASK 0xffff
#endif
#ifndef REP_MASK
#define REP_MASK 0
#endif
#ifndef PREP_REP_LRU
#define PREP_REP_LRU 1
#endif
#ifndef PREP_REP_GDN
#define PREP_REP_GDN 1
#endif
constexpr int N_LAUNCHES = MK_N_LAUNCHES;

constexpr int D = 1024, BATCH = 4, SEQ = 4096, DEPTH = 4, M = BATCH * SEQ;
constexpr int LRUW = 512, NGB = 8, GBW = 64, GH = 4, HD = 128, GDNW = 512, CH = 64, NCH = SEQ / CH, FF = 4096;
constexpr int GO_LD = 1024;
constexpr int NMODC = 6 * D, INC = 3080, NPROJ = 3072, PROJ_LD = 4096;
constexpr int O_LX = 0, O_LY = 512, O_Q = 1024, O_Z = 2560;
constexpr float EPS = 1e-6f;

constexpr size_t MiB = 1u << 20;
constexpr size_t WS_CTL = 0, CTL_ZERO_BYTES = 64 * 1024;
constexpr size_t WS_MOD = 1 * MiB;
constexpr size_t WS_BG = 2 * MiB;
constexpr size_t WS_AGG = 3 * MiB;
constexpr size_t WS_CARRY = 4 * MiB;
constexpr size_t WS_GL = 5 * MiB;
constexpr size_t WS_GT = 6 * MiB;
constexpr size_t WS_C1 = 6 * MiB + 512 * 1024;
constexpr size_t WS_C2 = 6 * MiB + 768 * 1024;
constexpr size_t WS_CB8 = 7 * MiB;
constexpr size_t WS_W8T = 7 * MiB + 64 * 1024;
constexpr size_t WS_RS1 = 364 * MiB, WS_RS2 = 365 * MiB;
constexpr size_t WS_A1 = 312 * MiB;
constexpr size_t WS_W = 8 * MiB;
constexpr size_t LAYER_W = (size_t)12288 * 1024;
constexpr size_t W_OUT_OFF = (size_t)3072 * 1024, W_UP_OFF = (size_t)4096 * 1024, W_DOWN_OFF = (size_t)8192 * 1024;
constexpr size_t WS_H = 104 * MiB;
constexpr size_t WS_MIX = 136 * MiB;
constexpr size_t WS_PROJ = 168 * MiB;
constexpr size_t WS_ACT = 168 * MiB;
constexpr size_t WS_GQD = 264 * MiB, WS_GKT = 280 * MiB;
constexpr size_t WS_GATT = 296 * MiB;
constexpr size_t WS_GO = 312 * MiB;
constexpr size_t WS_LRUP = 344 * MiB;
constexpr size_t WS_XT = 366 * MiB;
constexpr size_t WS_END = 384 * MiB;
constexpr int CW_BAR = 4096;
static_assert((CW_BAR + 3456) * 4 <= (int)CTL_ZERO_BYTES, "the per-call memset covers the barrier words");
constexpr size_t X16_OFF = 32 * MiB;

constexpr int RING_OFF = 0, RING_BYTES = 155648;
constexpr int RSTAB_OFF = 131072;
constexpr int LDSCTL_OFF = RING_BYTES, MISC_OFF = LDSCTL_OFF + 320;
constexpr int LDS_BYTES = 156672;

typedef unsigned v2u __attribute__((ext_vector_type(2)));
typedef _Float16 h16x4 __attribute__((ext_vector_type(4)));
#define DI __device__ __forceinline__
DI float bf2f(unsigned b) { return __builtin_bit_cast(float, b << 16); }
DI float bflo(unsigned w) { return __builtin_bit_cast(float, w << 16); }
DI float bfhi(unsigned w) { return __builtin_bit_cast(float, w & 0xffff0000u); }
DI float sigmoidf_(float x) { return 1.f / (1.f + expf(-x)); }
DI float siluf_(float x) { return x / (1.f + expf(-x)); }
DI float rcp_(float x) { return __builtin_amdgcn_rcpf(x); }
DI float exp_fast(float x) { return __builtin_amdgcn_exp2f(x * 1.4426950408889634f); }
DI float sigmoid_fast(float x) { return rcp_(1.f + exp_fast(-x)); }
DI float silu_fast(float x) { return x * rcp_(1.f + exp_fast(-x)); }
typedef float f32x2v __attribute__((ext_vector_type(2)));
DI f32x2v exp2_2(f32x2v x) { f32x2v r; r.x = __builtin_amdgcn_exp2f(x.x); r.y = __builtin_amdgcn_exp2f(x.y); return r; }
DI f32x2v rcp_2(f32x2v x) { f32x2v r; r.x = __builtin_amdgcn_rcpf(x.x); r.y = __builtin_amdgcn_rcpf(x.y); return r; }
DI f32x2v silu_fast2(f32x2v x) { return x * rcp_2(exp2_2(x * -1.4426950408889634f) + 1.0f); }
DI float log1p_acc(float x) { float ln2 = 0.6931471805599453f; asm volatile("" : "+v"(ln2));
    const float u = 1.0f + x, d = u - 1.0f; return d == 0.f ? x : (__builtin_amdgcn_logf(u) * ln2) * (x * rcp_(d)); }
DI float gelu_tanh(float x) { const float u = 0.7978845608028654f * (x + 0.044715f * x * x * x); return 0.5f * x * (1.f + tanhf(u)); }
DI float bperm_(int src_lane, float v) { return __builtin_bit_cast(float, __builtin_amdgcn_ds_bpermute(src_lane << 2, __builtin_bit_cast(int, v))); }
DI float wave_sum_(int lane, float v) {
#pragma unroll
    for (int o = 1; o < 64; o <<= 1) v += bperm_(lane ^ o, v);
    return v;
}
DI float half_sum_(int lane, float v) {
#pragma unroll
    for (int o = 1; o < 32; o <<= 1) v += bperm_(lane ^ o, v);
    return v;
}
DI float shfl_up_(int lane, float v, int off) { return bperm_(lane >= off ? lane - off : lane, v); }
DI float row16_sum_(float v) {
    v += __builtin_bit_cast(float, __builtin_amdgcn_update_dpp(0, __builtin_bit_cast(int, v), 0x128, 0xf, 0xf, false));
    v += __builtin_bit_cast(float, __builtin_amdgcn_update_dpp(0, __builtin_bit_cast(int, v), 0x124, 0xf, 0xf, false));
    v += __builtin_bit_cast(float, __builtin_amdgcn_update_dpp(0, __builtin_bit_cast(int, v), 0x122, 0xf, 0xf, false));
    v += __builtin_bit_cast(float, __builtin_amdgcn_update_dpp(0, __builtin_bit_cast(int, v), 0x121, 0xf, 0xf, false));
    return v;
}

struct Args { const float* in[23]; float* out; unsigned char* ws; int ph_lo, ph_hi; };
static_assert(sizeof(Args) == 23 * 8 + 8 + 8 + 8, "Args has no padding");
struct Frame {
    LAS unsigned char* lds;
    volatile LAS unsigned* MISC;
    gu32* ctl;
    int tid, lane, wave;
    int vcu, G;
    const __attribute__((address_space(4))) Args* A;
};
#define IN_(k) (F.A->in[k])
#define X_IN IN_(0)
#define C_IN IN_(1)
#define NORM_MIX_W IN_(2)
#define NORM_MLP_W IN_(3)
#define W_MOD IN_(4)
#define B_MOD IN_(5)
#define W_IN IN_(6)
#define LRU_CONV_W IN_(7)
#define LRU_CONV_B IN_(8)
#define GATE_A_W IN_(9)
#define GATE_A_B IN_(10)
#define GATE_X_W IN_(11)
#define GATE_X_B IN_(12)
#define LRU_LAMBDA IN_(13)
#define LRU_NORM_W IN_(14)
#define GDN_CONV_W IN_(15)
#define GDN_A_LOG IN_(16)
#define GDN_DT_BIAS IN_(17)
#define GDN_NORM_W IN_(18)
#define W_OUT IN_(19)
#define W_UP IN_(20)
#define W_DOWN IN_(21)
#define FINAL_NORM_W IN_(22)
#define OUT_ (F.A->out)
#define WSF(off) ((float*)(F.A->ws + (off)))
#define WSH(off) ((bf16*)(F.A->ws + (off)))
#define GQD_PTR ((bf16*)OUT_)
#define GKT_PTR ((bf16*)((unsigned char*)OUT_ + 16 * MiB))

DI void p_mod(Frame& F) {
    LAS float* cs = (LAS float*)F.lds;
    LAS float* red = cs + 4096;
    for (int i = F.tid; i < BATCH * D; i += NWAVES * 64) cs[i] = siluf_(C_IN[i]);
    __syncthreads();
    const int hl = F.lane >> 5, cl = F.lane & 31, kbase = F.wave * 128 + hl * 64;
    for (int base = F.vcu; base < DEPTH * 192; base += 3 * F.G) {
        const float* wp[3]; float a[3][4];
#pragma unroll
        for (int j = 0; j < 3; ++j) { const int item = base + j * F.G < DEPTH * 192 ? base + j * F.G : base, l = item / 192, cg = item % 192;
            wp[j] = W_MOD + ((size_t)l * D + kbase) * NMODC + cg * 32 + cl; a[j][0] = a[j][1] = a[j][2] = a[j][3] = 0.f; }
#pragma unroll 16
        for (int kk = 0; kk < 64; ++kk) { const int k = kbase + kk; const float c0 = cs[k], c1 = cs[1024 + k], c2 = cs[2048 + k], c3 = cs[3072 + k];
#pragma unroll
            for (int j = 0; j < 3; ++j) { const float wv = wp[j][(size_t)kk * NMODC]; a[j][0] += c0 * wv; a[j][1] += c1 * wv; a[j][2] += c2 * wv; a[j][3] += c3 * wv; } }
        const int sl = F.wave * 2 + hl;
#pragma unroll
        for (int j = 0; j < 3; ++j)
#pragma unroll
            for (int b = 0; b < 4; ++b) red[((j * 16 + sl) * 4 + b) * 32 + cl] = a[j][b];
        __syncthreads();
        if (F.tid < 384) { const int j = F.tid >> 7, b = (F.tid >> 5) & 3, ln = F.tid & 31, item = base + j * F.G; float sum = 0.f;
#pragma unroll
            for (int w = 0; w < 16; ++w) sum += red[((j * 16 + w) * 4 + b) * 32 + ln];
            if (item < DEPTH * 192) { const int l = item / 192, cc = (item % 192) * 32 + ln; WSF(WS_MOD)[((size_t)l * BATCH + b) * NMODC + cc] = sum + B_MOD[(size_t)l * NMODC + cc]; } }
        __syncthreads();
    }
}

struct TrItem { const float* src; bf16* dst; int K, ldw; };
DI void p0_item(Frame& F, int it, TrItem& T) {
    constexpr int I_IN = (D / 64) * (NPROJ / 32), I_OUT = (D / 64) * (D / 32), I_UP = (D / 64) * (FF / 32), I_DN = (FF / 64) * (D / 32);
    constexpr int PER_LAYER = I_IN + I_OUT + I_UP + I_DN;
    const int l = it / PER_LAYER; int r = it % PER_LAYER; bf16* wl = WSH(WS_W) + (size_t)l * LAYER_W;
    const float* W; int K, ldw, N; bf16* WT;
    if (r < I_IN) { W = W_IN + (size_t)l * D * INC; K = D; ldw = INC; N = NPROJ; WT = wl; }
    else if ((r -= I_IN) < I_OUT) { W = W_OUT + (size_t)l * D * D; K = D; ldw = D; N = D; WT = wl + W_OUT_OFF; }
    else if ((r -= I_OUT) < I_UP) { W = W_UP + (size_t)l * D * FF; K = D; ldw = FF; N = FF; WT = wl + W_UP_OFF; }
    else { r -= I_UP; W = W_DOWN + (size_t)l * FF * D; K = FF; ldw = D; N = D; WT = wl + W_DOWN_OFF; }
    const int nblk = N / 32, kb = r / nblk, nb = r % nblk, k0 = 64 * kb, n0 = 32 * nb;
    T.src = W + (size_t)k0 * ldw + n0; T.dst = WT + (size_t)n0 * K + k0; T.K = K; T.ldw = ldw;
}
DI void p0_weights(Frame& F) {
    LAS float* scr = (LAS float*)(F.lds + RING_OFF + F.wave * 16384);
    const int gw = F.vcu * NWAVES + F.wave, NGW = F.G * NWAVES, lane = F.lane;
    constexpr int NIT = DEPTH * ((D / 64) * (NPROJ / 32) + (D / 64) * (D / 32) + (D / 64) * (FF / 32) + (FF / 64) * (D / 32));
    TrItem T; f32x4 v[8];
    if (gw < NIT) { p0_item(F, gw, T);
#pragma unroll
        for (int i = 0; i < 8; ++i) v[i] = *(const f32x4*)(T.src + (size_t)((lane >> 3) + 8 * i) * T.ldw + 4 * (lane & 7)); }
    for (int it = gw; it < NIT; it += NGW) {
        TrItem Tn; f32x4 vn[8]; const int itn = it + NGW < NIT ? it + NGW : it;
        p0_item(F, itn, Tn);
#pragma unroll
        for (int i = 0; i < 8; ++i) vn[i] = *(const f32x4*)(Tn.src + (size_t)((lane >> 3) + 8 * i) * Tn.ldw + 4 * (lane & 7));
#pragma unroll
        for (int i = 0; i < 8; ++i) { LAS float* d = scr + ((lane >> 3) + 8 * i) * 33 + 4 * (lane & 7); d[0] = v[i].x; d[1] = v[i].y; d[2] = v[i].z; d[3] = v[i].w; }
        LDS_WAIT(); asm volatile("" ::: "memory");
        const int c = lane & 7;
#pragma unroll
        for (int j = 0; j < 4; ++j) { const int n = (lane >> 3) + 8 * j; const LAS float* sp = scr + (8 * c) * 33 + n;
            v4u o; o.x = pk2(sp[0 * 33], sp[1 * 33]); o.y = pk2(sp[2 * 33], sp[3 * 33]); o.z = pk2(sp[4 * 33], sp[5 * 33]); o.w = pk2(sp[6 * 33], sp[7 * 33]);
            *(v4u*)(T.dst + (size_t)n * T.K + 8 * c) = o; }
        LDS_WAIT(); asm volatile("" ::: "memory");
        T = Tn;
#pragma unroll
        for (int i = 0; i < 8; ++i) v[i] = vn[i];
    }
    for (int o = (int)blockIdx.x * NWAVES * 64 + F.tid; o < DEPTH * 16 * 1024; o += (int)gridDim.x * NWAVES * 64) {
        const int k = o & 1023, j = (o >> 10) & 15, l = o >> 14;
        WSH(WS_W8T)[o] = (bf16)(j < 8 ? f2bf(W_IN[((size_t)l * D + k) * INC + NPROJ + j]) : 0u);
    }
    for (int o = (int)blockIdx.x * NWAVES * 64 + F.tid; o < DEPTH * 2 * NGB * 4096; o += (int)gridDim.x * NWAVES * 64) {
        const int i = o & 63, j = (o >> 6) & 63, g = (o >> 12) & 7, gate = (o >> 15) & 1, l = o >> 16;
        const float* src = gate ? GATE_X_W : GATE_A_W;
        WSH(WS_GT)[o] = (bf16)f2bf(src[(size_t)(l * NGB + g) * 4096 + i * 64 + j]);
    }
}

DI void p_cvec(Frame& F, const int lc2, const int lc1) {
    const int nb_ = (int)gridDim.x, first_ = nb_ < BATCH * GH ? nb_ : BATCH * GH, vb_ = (int)blockIdx.x >= first_ ? (int)blockIdx.x - first_ : (int)blockIdx.x + nb_ - first_;
    const int gw = vb_ * NWAVES + F.wave, NGW = nb_ * NWAVES, lane = F.lane;
    constexpr int IT_IN = NPROJ / 16, IT_UP = FF / 16, PER_L = IT_IN + IT_UP;
    for (int it = gw; it < (lc1 < DEPTH ? PER_L : IT_UP); it += NGW) {
        const int which = it < IT_UP, rg = which ? it : it - IT_UP, N = which ? FF : NPROJ, l = which ? lc2 : lc1;
        const bf16* wt = WSH(WS_W) + (size_t)l * LAYER_W + (which ? W_UP_OFF : 0) + (size_t)(rg * 16) * 1024 + 16 * lane;
        const float* shb = WSF(WS_MOD) + (size_t)l * BATCH * NMODC + (which ? 3 * D : 0) + 16 * lane;
        float* cout = (which ? WSF(WS_C2) + (size_t)l * BATCH * FF : WSF(WS_C1) + (size_t)l * BATCH * NPROJ) + rg * 16;
        f32x4 sh[4][4];
#pragma unroll
        for (int b = 0; b < 4; ++b)
#pragma unroll
            for (int j = 0; j < 4; ++j) sh[b][j] = *(const f32x4*)(shb + (size_t)b * NMODC + 4 * j);
        float v[64];
#pragma unroll
        for (int row = 0; row < 16; ++row) { const v4u w0 = *(const v4u*)(wt + (size_t)row * 1024), w1 = *(const v4u*)(wt + (size_t)row * 1024 + 8);
            const f32x4 wa = (f32x4){bflo(w0.x), bfhi(w0.x), bflo(w0.y), bfhi(w0.y)}, wb = (f32x4){bflo(w0.z), bfhi(w0.z), bflo(w0.w), bfhi(w0.w)};
            const f32x4 wc = (f32x4){bflo(w1.x), bfhi(w1.x), bflo(w1.y), bfhi(w1.y)}, wd = (f32x4){bflo(w1.z), bfhi(w1.z), bflo(w1.w), bfhi(w1.w)};
#pragma unroll
            for (int b = 0; b < 4; ++b) { const f32x4 t = sh[b][0] * wa + sh[b][1] * wb + sh[b][2] * wc + sh[b][3] * wd; v[row * 4 + b] = (t[0] + t[1]) + (t[2] + t[3]); } }
#pragma unroll
        for (int st = 0; st < 6; ++st) { const int bit = 1 << st; const bool up = lane & bit;
#pragma unroll
            for (int i = 0; i < (32 >> st); ++i) { const float keep = up ? v[2 * i + 1] : v[2 * i], send = up ? v[2 * i] : v[2 * i + 1]; v[i] = keep + bperm_(lane ^ bit, send); } }
        cout[(size_t)(lane & 3) * N + (lane >> 2)] = v[0];
    }
    const int cb0_ = (PER_L + BATCH <= NGW) ? PER_L : 0;
    if (lc1 < DEPTH && gw >= cb0_ && gw < cb0_ + BATCH) { const int l = lc1, b = gw - cb0_; float a[8];
#pragma unroll
        for (int j = 0; j < 8; ++j) a[j] = 0.f;
        for (int kk = 0; kk < 16; ++kk) { const int k = 16 * lane + kk; const float shv = WSF(WS_MOD)[((size_t)l * BATCH + b) * NMODC + k];
#pragma unroll
            for (int j = 0; j < 8; ++j) a[j] += shv * W_IN[((size_t)l * D + k) * INC + NPROJ + j]; }
#pragma unroll
        for (int j = 0; j < 8; ++j) a[j] = wave_sum_(lane, a[j]);
        if (lane < 8) { float r = a[0];
#pragma unroll
            for (int j = 1; j < 8; ++j) r = (lane == j) ? a[j] : r;
            WSF(WS_CB8)[((size_t)l * BATCH + b) * 8 + lane] = r; } }
}

template <bool WITH_BG>
DI void p_normmod(Frame& F, int l, const float* xin, const float* normw, int off_sh, int off_sc) {
    LAS float* w8 = (LAS float*)F.lds;
    if (WITH_BG) {
        for (int i = F.tid; i < D * 8; i += NWAVES * 64) w8[i] = W_IN[((size_t)l * D + (i >> 3)) * INC + NPROJ + (i & 7)];
        __syncthreads();
    }
    const int gw = F.vcu * NWAVES + F.wave, NGW = F.G * NWAVES, lane = F.lane;
    f32x4 v[4];
    if (gw < M) {
#pragma unroll
        for (int j = 0; j < 4; ++j) v[j] = *(const f32x4*)(xin + (size_t)gw * D + 4 * lane + 256 * j);
    }
    for (int m = gw; m < M; m += NGW) {
        const int b = m >> 12, mn = m + NGW;
        f32x4 vnx[4];
#pragma unroll
        for (int j = 0; j < 4; ++j) vnx[j] = (mn < M) ? *(const f32x4*)(xin + (size_t)mn * D + 4 * lane + 256 * j) : (f32x4){0.f, 0.f, 0.f, 0.f};
        const float* modp = WSF(WS_MOD) + ((size_t)l * BATCH + b) * NMODC;
        float ss = 0.f;
#pragma unroll
        for (int j = 0; j < 4; ++j) ss += (v[j].x * v[j].x + v[j].y * v[j].y) + (v[j].z * v[j].z + v[j].w * v[j].w);
        ss = wave_sum_(lane, ss);
        const float rstd = 1.0f / sqrtf(ss * (1.0f / D) + EPS);
        float a0 = 0.f, a1 = 0.f, a2 = 0.f, a3 = 0.f, a4 = 0.f, a5 = 0.f, a6 = 0.f, a7 = 0.f;
#pragma unroll
        for (int j = 0; j < 4; ++j) {
            const int col = 4 * lane + 256 * j;
            const f32x4 nw = *(const f32x4*)(normw + (size_t)l * D + col), sc = *(const f32x4*)(modp + off_sc + col), sh = *(const f32x4*)(modp + off_sh + col);
            const f32x4 hv = v[j] * rstd * nw * (sc + 1.0f) + sh;
            v2u o; o.x = pk2(hv.x, hv.y); o.y = pk2(hv.z, hv.w);
            *(v2u*)(WSH(WS_H) + (size_t)m * D + col) = o;
            if (WITH_BG) {
#pragma unroll
                for (int e = 0; e < 4; ++e) { const f32x4 wa = *(const LAS f32x4*)(w8 + (col + e) * 8), wb = *(const LAS f32x4*)(w8 + (col + e) * 8 + 4); const float hh = hv[e];
                    a0 += hh * wa.x; a1 += hh * wa.y; a2 += hh * wa.z; a3 += hh * wa.w; a4 += hh * wb.x; a5 += hh * wb.y; a6 += hh * wb.z; a7 += hh * wb.w; }
            }
        }
        if (WITH_BG) {
            const bool b0 = lane & 1, b1 = lane & 2, b2 = lane & 4;
            float k0 = b0 ? a1 : a0, k1 = b0 ? a3 : a2, k2 = b0 ? a5 : a4, k3 = b0 ? a7 : a6;
            k0 += bperm_(lane ^ 1, b0 ? a0 : a1); k1 += bperm_(lane ^ 1, b0 ? a2 : a3); k2 += bperm_(lane ^ 1, b0 ? a4 : a5); k3 += bperm_(lane ^ 1, b0 ? a6 : a7);
            float c0 = b1 ? k1 : k0, c1 = b1 ? k3 : k2;
            c0 += bperm_(lane ^ 2, b1 ? k0 : k1); c1 += bperm_(lane ^ 2, b1 ? k2 : k3);
            float d = b2 ? c1 : c0;
            d += bperm_(lane ^ 4, b2 ? c0 : c1);
            d += bperm_(lane ^ 8, d); d += bperm_(lane ^ 16, d); d += bperm_(lane ^ 32, d);
            if (lane < 8) {
                const int hh = lane & 3;
                float r;
                if (lane < 4) r = sigmoidf_(d);
                else { const float xx = d + GDN_DT_BIAS[l * GH + hh]; const float sp = xx > 20.f ? xx : log1pf(expf(xx)); r = -expf(GDN_A_LOG[l * GH + hh]) * sp; }
                WSF(WS_BG)[(size_t)m * 8 + lane] = r;
            }
        }
#pragma unroll
        for (int j = 0; j < 4; ++j) v[j] = vnx[j];
    }
}

typedef float f32x2_t __attribute__((ext_vector_type(2))); typedef __bf16 bf16x2_t __attribute__((ext_vector_type(2)));
DI unsigned cvtpk(float lo, float hi) { f32x2_t v = {lo, hi}; bf16x2_t b = __builtin_convertvector(v, bf16x2_t); return __builtin_bit_cast(unsigned, b); }
DI bf16x8 pack8(f32x4 a, f32x4 b) { v4u p; p.x = cvtpk(a.x, a.y); p.y = cvtpk(a.z, a.w); p.z = cvtpk(b.x, b.y); p.w = cvtpk(b.z, b.w); return __builtin_bit_cast(bf16x8, p); }
DI bf16x8 ldfrag(const LAS unsigned char* p) { const v2u lo = *(const LAS v2u*)p, hi = *(const LAS v2u*)(p + 32); v4u r; r.x = lo.x; r.y = lo.y; r.z = hi.x; r.w = hi.y; return __builtin_bit_cast(bf16x8, r); }
#define MFMA16(a, b, c) __builtin_amdgcn_mfma_f32_16x16x32_bf16((a), (b), (c), 0, 0, 0)

#define WG_BAR() do { asm volatile("s_waitcnt lgkmcnt(0)" ::: "memory"); __builtin_amdgcn_s_barrier(); asm volatile("" ::: "memory"); } while (0)
DI bf16x8 ld128(const LAS unsigned char* p) { return *(const LAS bf16x8*)p; }
DI int kperm4(int k4) { return k4 < 16 ? 2 * k4 : 2 * (k4 - 16) + 4; }
DI int kperm(int k) { return (k & ~31) + kperm4(k & 28) + (k & 3); }
constexpr int PG_QB = 0, PG_KB = 17408, PG_KBET = 34816, PG_VT = 53248, PG_LS = 71680, PG_TS = 89088, PG_TB = 106496, PG_ATT = 115712, PG_XS = 124928, PG_SM = 128000, PG_END = 129024, PG_BGS = 140288;
static_assert(PG_END <= RING_BYTES && PG_BGS >= 8 * 17408 && PG_BGS + 4224 <= RING_BYTES, "prep LDS map");
DI void p_prep(Frame& F, int l) {
    const int wave = F.wave;
#define PREP_IDS int tid_ = F.tid; asm volatile("" : "+v"(tid_)); const int tid = tid_, lane = tid & 63, m = lane & 15, q = lane >> 4; (void)m; (void)q;
    for (int item = blockIdx.x; item < BATCH * NCH; item += gridDim.x) {
        const int b = item / NCH, n = item % NCH, row0 = b * SEQ + n * CH, t0 = n * CH;
        LAS float* bgs = (LAS float*)(F.lds + PG_BGS);
        {
            PREP_IDS
            const int mt = wave & 3, kh = wave >> 2;
            const bf16* a1 = (l > 0 ? WSH(WS_A1) : WSH(WS_H)) + (size_t)(row0 + 16 * mt + m) * D + 8 * q + 512 * kh;
            const bf16* w8t = WSH(WS_W8T) + (size_t)l * 16 * 1024 + (size_t)m * 1024 + 8 * q + 512 * kh;
            f32x4 acc = (f32x4){0.f, 0.f, 0.f, 0.f};
#pragma unroll 8
            for (int kb = 0; kb < 16; ++kb) acc = MFMA16(*(const bf16x8*)(a1 + 32 * kb), *(const bf16x8*)(w8t + 32 * kb), acc);
            if (m < 8) { const int hh = m & 3;
                float add = 0.f;
                if (kh == 0) { add = (l > 0 ? WSF(WS_CB8)[((size_t)l * BATCH + b) * 8 + m] : 0.f) + (m >= 4 ? GDN_DT_BIAS[l * GH + hh] : 0.f);
                    if (m >= 4 && q == 0 && mt == 0) bgs[1024 + hh] = -expf(GDN_A_LOG[l * GH + hh]); }
#pragma unroll
                for (int r = 0; r < 4; ++r) { const int t = 16 * mt + 4 * q + r; const f32x4* rp = (const f32x4*)(WSF(WS_RS1) + (size_t)(row0 + t) * 16);
                    const f32x4 p0 = rp[0], p1 = rp[1], p2 = rp[2], p3 = rp[3], ts = (p0 + p1) + (p2 + p3);
                    const float rstd = l > 0 ? 1.0f / sqrtf(((ts[0] + ts[1]) + (ts[2] + ts[3])) * (1.0f / D) + EPS) : 1.0f;
                    bgs[kh * 512 + t * 8 + m] = acc[r] * rstd + add; } }
        }
        for (int rep_ = 0; rep_ < PREP_REP_LRU; ++rep_) {
            PREP_IDS
            const int g = wave;
            LAS float* xr = (LAS float*)(F.lds + wave * 17408);
            const int tg = lane >> 3, cg = lane & 7, c0 = 8 * cg, cc0 = g * 64 + c0;
            v4u xp[11];
#pragma unroll
            for (int i = 0; i < 11; ++i) { const int tt = t0 + 8 * tg - 3 + i;
                if (n > 0) xp[i] = *(const v4u*)(WSH(WS_PROJ) + (size_t)(b * SEQ + tt) * PROJ_LD + O_LX + cc0);
                else xp[i] = (tt >= 0) ? *(const v4u*)(WSH(WS_PROJ) + (size_t)(b * SEQ + tt) * PROJ_LD + O_LX + cc0) : (v4u){0u, 0u, 0u, 0u}; }
            f32x4 wl_[4], wh_[4];
#pragma unroll
            for (int k = 0; k < 4; ++k) { wl_[k] = *(const f32x4*)(LRU_CONV_W + ((size_t)l * 4 + k) * LRUW + cc0); wh_[k] = *(const f32x4*)(LRU_CONV_W + ((size_t)l * 4 + k) * LRUW + cc0 + 4); }
            const f32x4 bl_ = *(const f32x4*)(LRU_CONV_B + l * LRUW + cc0), bh_ = *(const f32x4*)(LRU_CONV_B + l * LRUW + cc0 + 4);
            float ba_[4], bx_[4], ls_[4];
#pragma unroll
            for (int nt = 0; nt < 4; ++nt) { const int cc = g * 64 + 16 * nt + m; ba_[nt] = GATE_A_B[l * LRUW + cc]; bx_[nt] = GATE_X_B[l * LRUW + cc];
                const float lam = LRU_LAMBDA[l * LRUW + cc]; ls_[nt] = -8.0f * (fmaxf(-lam, 0.f) + log1p_acc(exp_fast(-fabsf(lam)))); }
            float ban_[4], bxn_[4], ls2_[4];
#pragma unroll
            for (int nt = 0; nt < 4; ++nt) { ban_[nt] = ba_[nt] * -1.4426950408889634f; bxn_[nt] = bx_[nt] * -1.4426950408889634f; ls2_[nt] = ls_[nt] * 1.4426950408889634f; }
#pragma unroll
            for (int tt = 0; tt < 8; ++tt) { f32x4 al = bl_, ah = bh_;
#pragma unroll
                for (int k = 0; k < 4; ++k) { const v4u xw = xp[tt + k];
                    al += wl_[k] * (f32x4){bflo(xw.x), bfhi(xw.x), bflo(xw.y), bfhi(xw.y)}; ah += wh_[k] * (f32x4){bflo(xw.z), bfhi(xw.z), bflo(xw.w), bfhi(xw.w)}; }
                *(LAS f32x4*)(xr + (8 * tg + tt) * 68 + c0) = al; *(LAS f32x4*)(xr + (8 * tg + tt) * 68 + c0 + 4) = ah; }
            asm volatile("s_waitcnt lgkmcnt(0)" ::: "memory");
            bf16x8 Bf[2][4][2];
#define LRU_LOAD_BF(nt_lo_, nt_hi_) do { _Pragma("unroll") for (int gate = 0; gate < 2; ++gate) _Pragma("unroll") for (int nt = (nt_lo_); nt < (nt_hi_); ++nt) _Pragma("unroll") for (int ks = 0; ks < 2; ++ks) \
                Bf[gate][nt][ks] = *(const bf16x8*)(WSH(WS_GT) + ((size_t)((l * 2 + gate) * NGB + g)) * 4096 + (size_t)(16 * nt + m) * 64 + 32 * ks + 8 * q); } while (0)
            LRU_LOAD_BF(0, 2);
            bf16x8 Af[4][2];
#pragma unroll
            for (int mt = 0; mt < 4; ++mt)
#pragma unroll
                for (int ks = 0; ks < 2; ++ks) { const LAS float* pp = xr + (16 * mt + m) * 68 + 32 * ks + 8 * q; Af[mt][ks] = pack8(*(const LAS f32x4*)pp, *(const LAS f32x4*)(pp + 4)); }
#pragma unroll
            for (int nt = 0; nt < 4; ++nt) {
                if (nt == 1) { asm volatile("" ::: "memory"); LRU_LOAD_BF(2, 4); }
                float av[4][4], bv[4][4];
#pragma unroll
                for (int mt = 0; mt < 4; ++mt) { f32x4 ra = (f32x4){0.f, 0.f, 0.f, 0.f}, ia = (f32x4){0.f, 0.f, 0.f, 0.f};
                    ra = MFMA16(Af[mt][0], Bf[0][nt][0], ra); ra = MFMA16(Af[mt][1], Bf[0][nt][1], ra);
                    ia = MFMA16(Af[mt][0], Bf[1][nt][0], ia); ia = MFMA16(Af[mt][1], Bf[1][nt][1], ia);
#pragma unroll
                    for (int rp = 0; rp < 2; ++rp) {
                        const f32x2v xa = (f32x2v){ra[2 * rp], ra[2 * rp + 1]}, xi = (f32x2v){ia[2 * rp], ia[2 * rp + 1]};
                        const f32x2v da = exp2_2(xa * -1.4426950408889634f + ban_[nt]) + 1.0f, di = exp2_2(xi * -1.4426950408889634f + bxn_[nt]) + 1.0f;
                        const f32x2v aa = exp2_2(rcp_2(da) * ls2_[nt]);
                        f32x2v m2 = 1.0f - aa * aa; m2.x = fmaxf(m2.x, 1e-12f); m2.y = fmaxf(m2.y, 1e-12f);
                        const f32x2v t2 = m2 * (di * di); f32x2v rs; rs.x = __builtin_amdgcn_rsqf(t2.x); rs.y = __builtin_amdgcn_rsqf(t2.y);
                        const f32x2v xv = (f32x2v){xr[(16 * mt + 4 * q + 2 * rp) * 68 + 16 * nt + m], xr[(16 * mt + 4 * q + 2 * rp + 1) * 68 + 16 * nt + m]};
                        const f32x2v bb = (m2 * rs) * xv;
                        av[mt][2 * rp] = aa.x; av[mt][2 * rp + 1] = aa.y; bv[mt][2 * rp] = bb.x; bv[mt][2 * rp + 1] = bb.y; } }
                float iP[4], iH[4];
#pragma unroll
                for (int mt = 0; mt < 4; ++mt) {
#pragma unroll
                    for (int r = 1; r < 4; ++r) { bv[mt][r] = av[mt][r] * bv[mt][r - 1] + bv[mt][r]; av[mt][r] = av[mt][r] * av[mt][r - 1]; }
                    float PA = av[mt][3], HA = bv[mt][3];
                    { const float Pp = shfl_up_(lane, PA, 16), Hp = shfl_up_(lane, HA, 16); if (q >= 1) { HA = PA * Hp + HA; PA = PA * Pp; } }
                    { const float Pp = shfl_up_(lane, PA, 32), Hp = shfl_up_(lane, HA, 32); if (q >= 2) { HA = PA * Hp + HA; PA = PA * Pp; } }
                    iP[mt] = PA; iH[mt] = HA; }
                float CP = 1.f, CH = 0.f;
#pragma unroll
                for (int mt = 0; mt < 4; ++mt) {
                    const float totP = bperm_(m + 48, iP[mt]), totH = bperm_(m + 48, iH[mt]);
                    float exP = shfl_up_(lane, iP[mt], 16), exH = shfl_up_(lane, iH[mt], 16); if (q == 0) { exP = 1.f; exH = 0.f; }
                    const float EP = CP * exP, EH = exP * CH + exH;
#pragma unroll
                    for (int r = 0; r < 4; ++r) { const float Pf = EP * av[mt][r], Hf = av[mt][r] * EH + bv[mt][r];
                        *(LAS unsigned*)(xr + (16 * mt + 4 * q + r) * 68 + 16 * nt + m) = cvtpk(Hf, Pf); }
                    CH = totP * CH + totH; CP = CP * totP; }
                if (q == 0) { WSF(WS_AGG)[((size_t)(b * NCH + n)) * LRUW + g * 64 + 16 * nt + m] = CP; WSF(WS_AGG)[(size_t)BATCH * NCH * LRUW + ((size_t)(b * NCH + n)) * LRUW + g * 64 + 16 * nt + m] = CH; }
            }
            if (l == 0) WG_BAR(); else asm volatile("s_waitcnt lgkmcnt(0)" ::: "memory");
#pragma unroll
            for (int i = 0; i < 16; ++i) { const int pz = lane + 64 * i, row = pz >> 4, c16 = pz & 15;
                *(v4u*)((unsigned*)(F.A->ws + WS_H) + (size_t)(row0 + row) * LRUW + g * 64 + 4 * c16) = *(const LAS v4u*)(xr + row * 68 + 4 * c16); }
        }
        WG_BAR();
        {
            LAS unsigned char* qb = F.lds + PG_QB;
            LAS unsigned char* kb = F.lds + PG_KB;
            LAS unsigned char* kbeT = F.lds + PG_KBET;
            LAS unsigned char* vT = F.lds + PG_VT;
            LAS float* Ls = (LAS float*)(F.lds + PG_LS);
            LAS float* Ts = (LAS float*)(F.lds + PG_TS);
            LAS unsigned char* wst = F.lds + PG_TS;
            LAS unsigned char* Tb = F.lds + PG_TB;
            LAS unsigned char* atts = F.lds + PG_ATT;
            LAS float* Xs = (LAS float*)(F.lds + PG_XS);
            LAS float* sm4 = (LAS float*)(F.lds + PG_SM);
            if (wave < GH) { int tl_ = F.tid; asm volatile("" : "+v"(tl_)); const int ln = tl_ & 63, hh = wave;
                const float vb = bgs[ln * 8 + hh] + bgs[512 + ln * 8 + hh], xx = bgs[ln * 8 + 4 + hh] + bgs[512 + ln * 8 + 4 + hh];
                const float sp = xx > 20.f ? xx : log1p_acc(exp_fast(xx));
                float gcv = bgs[1024 + hh] * sp;
#pragma unroll
                for (int off = 1; off < 64; off <<= 1) { const float pv = shfl_up_(ln, gcv, off); if (ln >= off) gcv += pv; }
                const float glast = bperm_(63, gcv);
                sm4[hh * 256 + ln] = gcv; sm4[hh * 256 + 64 + ln] = sigmoidf_(vb); sm4[hh * 256 + 128 + ln] = expf(gcv); sm4[hh * 256 + 192 + ln] = expf(glast - gcv); }
            WG_BAR();
            if (F.tid == 0) { int z_ = 0; asm volatile("" : "+v"(z_)); *(LAS int*)(F.lds + PG_BGS + 2048) = z_; *(LAS int*)(F.lds + PG_BGS + 2052) = z_; }
#define G1_FETCH(hh_) do { int tf_ = F.tid; asm volatile("" : "+v"(tf_)); if (tf_ < 384) { const int cgp_ = tf_ & 15, wt_ = tf_ >> 4, which_ = wt_ >> 3, tr_ = wt_ & 7, ch_ = which_ * GDNW + (hh_) * HD + cgp_ * 8; \
                if (n > 0) { _Pragma("unroll") for (int i = 0; i < 11; ++i) xpn[i] = *(const v4u*)(WSH(WS_PROJ) + (size_t)(b * SEQ + t0 + tr_ * 8 - 3 + i) * PROJ_LD + O_Q + ch_); } \
                else { _Pragma("unroll") for (int i = 0; i < 11; ++i) { const int tt = t0 + tr_ * 8 - 3 + i; \
                    xpn[i] = (tt >= 0) ? *(const v4u*)(WSH(WS_PROJ) + (size_t)(b * SEQ + tt) * PROJ_LD + O_Q + ch_) : (v4u){0u, 0u, 0u, 0u}; } } \
                } } while (0)
#pragma unroll 1
            for (int h = -1; h < GH; ++h) {
                PREP_IDS
                v4u xpn[11], pe[8];
                G1_FETCH(h + 1 < GH ? h + 1 : GH - 1);
                const int hn = h + 1;
                const size_t item4 = (size_t)(b * GH + h) * NCH + n, item4n = (size_t)(b * GH + hn) * NCH + n;
                LAS float* sgc = sm4 + h * 256, *sbeta = sgc + 64, *seg = sgc + 128;
                LAS float* sbetan = sm4 + hn * 256 + 64, *segn = sbetan + 64, *seln = sbetan + 128;
                if (h >= 0) {
                    const int it = wave >> 1;
                    bf16x8 Ak[4], Aq[4], Bk[2][4];
#pragma unroll
                    for (int ks = 0; ks < 4; ++ks) { Ak[ks] = ld128(kb + (16 * it + m) * 272 + (32 * ks + 8 * q) * 2); Aq[ks] = ld128(qb + (16 * it + m) * 272 + (32 * ks + 8 * q) * 2);
                        Bk[0][ks] = ld128(kb + (16 * ((wave & 1) * 2) + m) * 272 + (32 * ks + 8 * q) * 2); Bk[1][ks] = ld128(kb + (16 * ((wave & 1) * 2 + 1) + m) * 272 + (32 * ks + 8 * q) * 2); }
#pragma unroll
                    for (int jj = 0; jj < 2; ++jj) { const int jt = (wave & 1) * 2 + jj;
                        f32x4 kk = (f32x4){0.f, 0.f, 0.f, 0.f}, qk = (f32x4){0.f, 0.f, 0.f, 0.f};
                        if (jt <= it) {
#pragma unroll
                            for (int ks = 0; ks < 4; ++ks) { kk = MFMA16(Ak[ks], Bk[jj][ks], kk); qk = MFMA16(Aq[ks], Bk[jj][ks], qk); } }
                        const int j = 16 * jt + m; const float gj = sgc[j];
#pragma unroll
                        for (int r = 0; r < 4; ++r) { const int i = 16 * it + 4 * q + r;
                            const float dec = (j <= i) ? exp_fast(sgc[i] - gj) : 0.f;
                            Ls[i * 68 + j] = (j < i) ? sbeta[i] * kk[r] * dec : 0.f;
                            *(LAS unsigned short*)(atts + i * 144 + kperm(j) * 2) = (unsigned short)cvtpk((j <= i) ? qk[r] * dec : 0.f, 0.f); } }
                    WG_BAR();
                }
                if (h >= 0 && wave >= 6) {
                    const int hw = wave - 6, r = lane >> 2, c4 = (lane & 3) * 4;
                    LAS float* Xw = hw ? (LAS float*)(F.lds + PG_BGS) : Xs;
                    volatile LAS int* gfl = (volatile LAS int*)(F.lds + PG_BGS + 2048);
#define BLK16(pa_, arow_, bcol_, bp_) do { _Pragma("unroll") for (int mm4 = 0; mm4 < 4; ++mm4) { const f32x4 av_ = *(const LAS f32x4*)((arow_) + 4 * mm4); const LAS float* bc_ = (bcol_) + (4 * mm4) * (bp_); \
                        pa_[mm4] += av_.x * *(const LAS f32x4*)(bc_) + av_.y * *(const LAS f32x4*)(bc_ + (bp_)) + av_.z * *(const LAS f32x4*)(bc_ + 2 * (bp_)) + av_.w * *(const LAS f32x4*)(bc_ + 3 * (bp_)); } } while (0)
#define ZERO4(pa_) do { _Pragma("unroll") for (int mm4 = 0; mm4 < 4; ++mm4) pa_[mm4] = (f32x4){0.f, 0.f, 0.f, 0.f}; } while (0)
#define SUM4(pa_) ((pa_[0] + pa_[1]) + (pa_[2] + pa_[3]))
#define TB_STORE(row_, col_, v_) do { v2u pb_; pb_.x = cvtpk((v_).x, (v_).y); pb_.y = cvtpk((v_).z, (v_).w); *(LAS v2u*)(Tb + (row_) * 144 + (col_) * 2) = pb_; } while (0)
                    if (lane < 32) { const int bk = 2 * hw + (lane >> 4), c = lane & 15; float x[16];
                        const LAS float* lb = Ls + (16 * bk) * 68 + 16 * bk;
#pragma unroll
                        for (int rr = 0; rr < 16; ++rr) { float acc = (rr == c) ? 1.f : 0.f;
#pragma unroll
                            for (int m4 = 0; m4 < (rr + 3) / 4; ++m4) { const f32x4 lv = *(const LAS f32x4*)(lb + rr * 68 + 4 * m4);
                                if (4 * m4 + 0 < rr) acc -= lv.x * x[4 * m4 + 0]; if (4 * m4 + 1 < rr) acc -= lv.y * x[4 * m4 + 1]; if (4 * m4 + 2 < rr) acc -= lv.z * x[4 * m4 + 2]; if (4 * m4 + 3 < rr) acc -= lv.w * x[4 * m4 + 3]; }
                            x[rr] = acc; Ts[(16 * bk + rr) * 68 + 16 * bk + c] = acc; *(LAS unsigned short*)(Tb + (16 * bk + rr) * 144 + (16 * bk + c) * 2) = (unsigned short)cvtpk(acc, 0.f); } }
#pragma unroll
                    for (int e = 0; e < 2; ++e) { const int idx = lane + 64 * e, zr = idx >> 3, w = idx & 7;
                        *(LAS unsigned*)(Tb + (32 * hw + zr) * 144 + (32 * hw + 16) * 2 + w * 4) = 0u; }
                    asm volatile("s_waitcnt lgkmcnt(0)" ::: "memory");
                    { const int i = 2 * hw + 1, j = 2 * hw; f32x4 pa[4]; ZERO4(pa);
                        BLK16(pa, Ls + (16 * i + r) * 68 + 16 * j, Ts + (16 * j) * 68 + 16 * j + c4, 68);
                        *(LAS f32x4*)(Xw + r * 16 + c4) = SUM4(pa);
                        asm volatile("s_waitcnt lgkmcnt(0)" ::: "memory");
                        f32x4 pb[4]; ZERO4(pb); BLK16(pb, Ts + (16 * i + r) * 68 + 16 * i, Xw + c4, 16);
                        const f32x4 acc = -SUM4(pb); *(LAS f32x4*)(Ts + (16 * i + r) * 68 + 16 * j + c4) = acc; TB_STORE(16 * i + r, 16 * j + c4, acc); }
                    asm volatile("s_waitcnt lgkmcnt(0)" ::: "memory");
                    if (lane == 0) gfl[hw] = h + 1;
                    while (gfl[hw ^ 1] < h + 1) __builtin_amdgcn_s_sleep(1);
                    asm volatile("" ::: "memory");
                    { const int j = hw; f32x4 x2[4], x3[4]; ZERO4(x2); ZERO4(x3);
                        for (int k = j; k < 2; ++k) { BLK16(x2, Ls + (32 + r) * 68 + 16 * k, Ts + (16 * k) * 68 + 16 * j + c4, 68); BLK16(x3, Ls + (48 + r) * 68 + 16 * k, Ts + (16 * k) * 68 + 16 * j + c4, 68); }
                        *(LAS f32x4*)(Xw + r * 16 + c4) = SUM4(x2); *(LAS f32x4*)(Xw + 256 + r * 16 + c4) = SUM4(x3);
                        asm volatile("s_waitcnt lgkmcnt(0)" ::: "memory");
                        f32x4 q2[4], q3[4]; ZERO4(q2); ZERO4(q3);
                        BLK16(q2, Ts + (32 + r) * 68 + 32, Xw + c4, 16);
                        BLK16(q3, Ts + (48 + r) * 68 + 32, Xw + c4, 16); BLK16(q3, Ts + (48 + r) * 68 + 48, Xw + 256 + c4, 16);
                        const f32x4 t2 = -SUM4(q2), t3 = -SUM4(q3); TB_STORE(32 + r, 16 * j + c4, t2); TB_STORE(48 + r, 16 * j + c4, t3); }
                    asm volatile("s_waitcnt lgkmcnt(0)" ::: "memory");
#undef BLK16
#undef ZERO4
#undef SUM4
#undef TB_STORE
                } else if (tid < 384 && hn < GH) {
                    const int cgp = tid & 15, wt = tid >> 4, which = wt >> 3, tr = wt & 7, d0 = cgp * 8, ch0 = which * GDNW + hn * HD + d0;
                    f32x4 wl_[4], wh_[4], ol[8], oh[8];
#pragma unroll
                    for (int k = 0; k < 4; ++k) { wl_[k] = *(const f32x4*)(GDN_CONV_W + ((size_t)l * 4 + k) * (3 * GDNW) + ch0); wh_[k] = *(const f32x4*)(GDN_CONV_W + ((size_t)l * 4 + k) * (3 * GDNW) + ch0 + 4); }
                    float ss[8];
#pragma unroll
                    for (int tt = 0; tt < 8; ++tt) { f32x4 al = (f32x4){0.f, 0.f, 0.f, 0.f}, ah = (f32x4){0.f, 0.f, 0.f, 0.f};
#pragma unroll
                        for (int k = 0; k < 4; ++k) { const v4u xw = xpn[tt + k];
                            al += wl_[k] * (f32x4){bflo(xw.x), bfhi(xw.x), bflo(xw.y), bfhi(xw.y)}; ah += wh_[k] * (f32x4){bflo(xw.z), bfhi(xw.z), bflo(xw.w), bfhi(xw.w)}; }
                        { const f32x2v s0 = silu_fast2((f32x2v){al.x, al.y}), s1 = silu_fast2((f32x2v){al.z, al.w}), s2 = silu_fast2((f32x2v){ah.x, ah.y}), s3 = silu_fast2((f32x2v){ah.z, ah.w});
                            al = (f32x4){s0.x, s0.y, s1.x, s1.y}; ah = (f32x4){s2.x, s2.y, s3.x, s3.y}; }
                        ol[tt] = al; oh[tt] = ah;
                        ss[tt] = (al.x * al.x + al.y * al.y) + (al.z * al.z + al.w * al.w) + (ah.x * ah.x + ah.y * ah.y) + (ah.z * ah.z + ah.w * ah.w); }
                    if (which < 2) {
#pragma unroll
                        for (int tt = 0; tt < 8; ++tt) { const float v = row16_sum_(ss[tt]);
                            const float scl = __builtin_amdgcn_rsqf(v + 1e-6f) * (which == 0 ? 0.08838834764831845f : 1.0f); ol[tt] = ol[tt] * scl; oh[tt] = oh[tt] * scl; }
                    }
                    const int tb = tr * 8;
                    if (which == 0) {
#pragma unroll
                        for (int tt = 0; tt < 8; ++tt) { const int t = tb + tt; const float eg = segn[t];
                            v4u pk; pk.x = cvtpk(ol[tt].x, ol[tt].y); pk.y = cvtpk(ol[tt].z, ol[tt].w); pk.z = cvtpk(oh[tt].x, oh[tt].y); pk.w = cvtpk(oh[tt].z, oh[tt].w);
                            *(LAS v4u*)(qb + t * 272 + d0 * 2) = pk;
                            const f32x4 gl_ = ol[tt] * eg, gh_ = oh[tt] * eg;
                            v4u pg; pg.x = cvtpk(gl_.x, gl_.y); pg.y = cvtpk(gl_.z, gl_.w); pg.z = cvtpk(gh_.x, gh_.y); pg.w = cvtpk(gh_.z, gh_.w);
                            { bf16* qrow = GQD_PTR + item4n * 8192 + t * 128 + (d0 & ~31); const int kl = d0 & 31;
                                v2u p0; p0.x = pg.x; p0.y = pg.y; v2u p1; p1.x = pg.z; p1.y = pg.w; *(v2u*)(qrow + kperm4(kl)) = p0; *(v2u*)(qrow + kperm4(kl + 4)) = p1; } }
                    } else if (which == 1) {
                        float fb[8], fl[8];
#pragma unroll
                        for (int tt = 0; tt < 8; ++tt) { const int t = tb + tt; fb[tt] = sbetan[t] * segn[t]; fl[tt] = seln[t];
                            v4u pk; pk.x = cvtpk(ol[tt].x, ol[tt].y); pk.y = cvtpk(ol[tt].z, ol[tt].w); pk.z = cvtpk(oh[tt].x, oh[tt].y); pk.w = cvtpk(oh[tt].z, oh[tt].w);
                            *(LAS v4u*)(kb + t * 272 + d0 * 2) = pk; }
#define TR_PIECE(dst_, src_, c_) do { (dst_).x = cvtpk(src_[0][c_], src_[1][c_]); (dst_).y = cvtpk(src_[2][c_], src_[3][c_]); (dst_).z = cvtpk(src_[4][c_], src_[5][c_]); (dst_).w = cvtpk(src_[6][c_], src_[7][c_]); } while (0)
#define KT_STORE(pt_, c_) do { bf16* krow = GKT_PTR + item4n * 8192 + (d0 + (c_)) * 64 + (tb & ~31); const int kl = tb & 31; \
                            v2u p0; p0.x = (pt_).x; p0.y = (pt_).y; v2u p1; p1.x = (pt_).z; p1.y = (pt_).w; *(v2u*)(krow + kperm4(kl)) = p0; *(v2u*)(krow + kperm4(kl + 4)) = p1; } while (0)
#pragma unroll
                        for (int hf = 0; hf < 2; ++hf) { f32x4 e[8], tl[8];
#pragma unroll
                            for (int tt = 0; tt < 8; ++tt) { const f32x4 sv = hf ? oh[tt] : ol[tt]; e[tt] = sv * fb[tt]; tl[tt] = sv * fl[tt]; }
#pragma unroll
                            for (int c = 0; c < 4; ++c) { TR_PIECE(pe[4 * hf + c], e, c); v4u pt; TR_PIECE(pt, tl, c); KT_STORE(pt, 4 * hf + c); } }
                    } else {
                        float fb[8];
#pragma unroll
                        for (int tt = 0; tt < 8; ++tt) fb[tt] = sbetan[tb + tt];
#pragma unroll
                        for (int hf = 0; hf < 2; ++hf) { f32x4 e[8];
#pragma unroll
                            for (int tt = 0; tt < 8; ++tt) e[tt] = (hf ? oh[tt] : ol[tt]) * fb[tt];
#pragma unroll
                            for (int c = 0; c < 4; ++c) TR_PIECE(pe[4 * hf + c], e, c); }
#undef TR_PIECE
#undef KT_STORE
                    }
                }
                WG_BAR();
                if (h >= 0) {
                    const int nt = wave;
#pragma unroll
                    for (int mt = 0; mt < 4; ++mt) { f32x4 ua = (f32x4){0.f, 0.f, 0.f, 0.f}, wa = (f32x4){0.f, 0.f, 0.f, 0.f};
#pragma unroll
                        for (int ks = 0; ks < 2; ++ks) if (32 * ks <= 16 * mt + 15) { const bf16x8 A = ld128(Tb + (16 * mt + m) * 144 + (32 * ks + 8 * q) * 2);
                            const int swz = (((4 * ks + q) ^ ((2 * nt + (m >> 3)) & 7)) * 16);
                            ua = MFMA16(A, ld128(vT + (16 * nt + m) * 144 + swz), ua); wa = MFMA16(A, ld128(kbeT + (16 * nt + m) * 144 + swz), wa); }
#pragma unroll
                        for (int r = 0; r < 4; ++r) { const int t = 16 * mt + 4 * q + r, d = 16 * nt + m;
                            *(LAS unsigned short*)(wst + t * 272 + kperm(d) * 2) = (unsigned short)cvtpk(-wa[r], 0.f); }
                        { v2u pu; pu.x = cvtpk(ua[0], ua[1]); pu.y = cvtpk(ua[2], ua[3]); *(LAS v2u*)(F.lds + PG_LS + (16 * nt + m) * 128 + (((2 * mt + (q >> 1)) ^ (m & 7)) * 16) + (q & 1) * 8) = pu; } }
                    WG_BAR();
                }
                if (h >= 0) {
#pragma unroll
                    for (int e = 0; e < 2; ++e) { const int p = tid + 512 * e, row = p >> 4, c16 = p & 15;
                        *(v4u*)((unsigned char*)(WSH(WS_MIX + 16 * MiB) + item4 * 8192) + row * 256 + c16 * 16) = *(const LAS v4u*)(wst + row * 272 + c16 * 16);
                        const int ur = p >> 3, uc = p & 7;
                        *(v4u*)((unsigned char*)(WSH(WS_MIX) + item4 * 8192) + ur * 128 + uc * 16) = *(const LAS v4u*)(F.lds + PG_LS + ur * 128 + ((uc ^ (ur & 7)) * 16)); }
                    { const int row = tid >> 3, c16 = tid & 7;
                        *(v4u*)((unsigned char*)(WSH(WS_GATT) + item4 * 4096) + row * 128 + c16 * 16) = *(const LAS v4u*)(atts + row * 144 + c16 * 16); }
                    if (tid == 0) WSF(WS_GL)[item4] = seg[63];
                }
                if (tid >= 128 && tid < 384 && hn < GH) {
                    const int cgp = tid & 15, wt = tid >> 4, which = wt >> 3, tr = wt & 7, d0 = cgp * 8;
                    LAS unsigned char* dstT = which == 1 ? kbeT : vT;
#pragma unroll
                    for (int c = 0; c < 8; ++c) *(LAS v4u*)(dstT + (d0 + c) * 144 + ((tr ^ (cgp & 7)) * 16)) = pe[c];
                }
                WG_BAR();
            }
        }
    }
}

#undef PREP_IDS
constexpr int SC_W = 0, SC_QD = 18432, SC_KT = 36864, SC_AT = 57344, SC_U = 67584, SC_STAGE = 76800;
static_assert(2 * SC_STAGE <= RING_BYTES, "scan stages fit the ring");
#define SBAR_() __builtin_amdgcn_sched_barrier(0)
constexpr int NSEG = 8, SEGC = NCH / NSEG;
constexpr size_t WS_PSI = 344 * MiB;
constexpr size_t WS_PHI = 352 * MiB;
constexpr size_t WS_SST = 356 * MiB;
static_assert(WS_SST + 8 * MiB <= WS_END, "two-level scan scratch");

#define SC_ADDR() \
        const unsigned char* gW = (const unsigned char*)(WSH(WS_MIX + 16 * MiB) + it0 * 8192); \
        const unsigned char* gQD = (const unsigned char*)(GQD_PTR + it0 * 8192); \
        const unsigned char* gKT = (const unsigned char*)(GKT_PTR + it0 * 8192); \
        const unsigned char* gAT = (const unsigned char*)(WSH(WS_GATT) + it0 * 4096); \
        const unsigned char* gU = (const unsigned char*)(WSH(WS_MIX) + it0 * 8192) + dvbase * 128;
#define SC_LOAD(rg, n_) do { const size_t cb = (size_t)(n_) * 16384, ca = (size_t)(n_) * 8192; \
            _Pragma("unroll") for (int i = 0; i < 4; ++i) { rg[i] = *(const v4u*)(gW + cb + gofW + i * 4096); if (FULL) rg[4 + i] = *(const v4u*)(gQD + cb + gofW + i * 4096); \
                rg[8 + i] = *(const v4u*)(gKT + cb + gofK + i * 4096); } \
            _Pragma("unroll") for (int i = 0; i < 2; ++i) { if (FULL) rg[12 + i] = *(const v4u*)(gAT + ca + gofK + i * 4096); rg[14 + i] = *(const v4u*)(gU + cb + gofK + i * 4096); } } while (0)
#define SC_WRITE(rg, buf_) do { LAS unsigned char* sb_ = F.lds + (buf_) * SC_STAGE; \
            _Pragma("unroll") for (int i = 0; i < 4; ++i) { *(LAS v4u*)(sb_ + SC_W + lofW + i * (16 * 288)) = rg[i]; if (FULL) *(LAS v4u*)(sb_ + SC_QD + lofW + i * (16 * 288)) = rg[4 + i]; \
                *(LAS v4u*)(sb_ + SC_KT + lofK + i * (32 * 160)) = rg[8 + i]; } \
            _Pragma("unroll") for (int i = 0; i < 2; ++i) { if (FULL) *(LAS v4u*)(sb_ + SC_AT + lofK + i * (32 * 160)) = rg[12 + i]; *(LAS v4u*)(sb_ + SC_U + lofU + i * (32 * 144)) = rg[14 + i]; } } while (0)
#define SC_LOADER_LOOP() do { \
            int lt_ = F.tid & 255; asm volatile("" : "+v"(lt_)); \
            const int gofW = (lt_ >> 4) * 256 + (lt_ & 15) * 16, gofK = (lt_ >> 3) * 128 + (lt_ & 7) * 16; \
            const int lofW = (lt_ >> 4) * 288 + (lt_ & 15) * 16, lofK = (lt_ >> 3) * 160 + (lt_ & 7) * 16, lofU = (lt_ >> 3) * 144 + (lt_ & 7) * 16; \
            const int nlast = n0 + SEGC - 1; \
            v4u ra[16], rb[16]; \
            SC_LOAD(ra, n0); SC_WRITE(ra, 0); SC_LOAD(ra, n0 + 1); SC_LOAD(rb, n0 + 2); \
            __syncthreads(); \
            _Pragma("unroll 1") for (int j = 0; j < SEGC; j += 2) { \
                  \
                  \
                SC_WRITE(ra, 1); \
                { const int nn = n0 + j + 3 < nlast ? n0 + j + 3 : nlast; SC_LOAD(ra, nn); } \
                WG_BAR(); \
                SC_WRITE(rb, 0); \
                { const int nn = n0 + j + 4 < nlast ? n0 + j + 4 : nlast; SC_LOAD(rb, nn); } \
                WG_BAR(); \
            } } while (0)

DI void p_scan1(Frame& F, int l) {
    constexpr bool FULL = false;
    const int wave = F.wave;
    { const int lane = F.lane;
        for (int p = blockIdx.x * NWAVES + wave; p < BATCH * LRUW; p += gridDim.x * NWAVES) { const int b = p / LRUW, c = p % LRUW;
            float A = WSF(WS_AGG)[((size_t)(b * NCH + lane)) * LRUW + c], B = WSF(WS_AGG)[(size_t)BATCH * NCH * LRUW + ((size_t)(b * NCH + lane)) * LRUW + c];
#pragma unroll
            for (int off = 1; off < 64; off <<= 1) { const float Ap = shfl_up_(lane, A, off), Bp = shfl_up_(lane, B, off); if (lane >= off) { B = A * Bp + B; A = A * Ap; } }
            if (lane < 63) WSF(WS_CARRY)[((size_t)(b * NCH + lane + 1)) * LRUW + c] = B; else WSF(WS_CARRY)[((size_t)(b * NCH)) * LRUW + c] = 0.f; } }
    const bool is_loader = wave >= 4;
    const int wv = wave & 3;
    for (int job = F.vcu; job < BATCH * GH * NSEG * 2; job += F.G) {
        const int bh = job >> 4, seg = (job >> 1) & (NSEG - 1), dvbase = (job & 1) * 64, n0 = seg * SEGC;
        const size_t it0 = (size_t)bh * NCH;
        SC_ADDR()
        (void)gQD; (void)gAT;
        if (seg == NSEG - 1) { __syncthreads(); continue; }
        if (is_loader) { SC_LOADER_LOOP(); }
        else {
            int tc_ = F.tid; asm volatile("" : "+v"(tc_)); const int lane = tc_ & 63, m = lane & 15, q = lane >> 4;
            const int col = dvbase + 16 * wv + m;
            f32x4 Sacc[2][8];
#pragma unroll
            for (int dt = 0; dt < 8; ++dt) { Sacc[0][dt] = (f32x4){0.f, 0.f, 0.f, 0.f};
#pragma unroll
                for (int r = 0; r < 4; ++r) Sacc[1][dt][r] = (16 * dt + 4 * q + r == col) ? 1.f : 0.f; }
            const float glv = WSF(WS_GL)[it0 + lane];
            __syncthreads();
#pragma unroll 1
            for (int j = 0; j < SEGC; ++j) {
                const LAS unsigned char* B = F.lds + (j & 1) * SC_STAGE;
                bf16x8 fa[4], fb[4], Sb[2][4], vnb[2][2];
                f32x4 vn[2][4];
                v2u ut[4];
#pragma unroll
                for (int mt = 0; mt < 4; ++mt) ut[mt] = *(const LAS v2u*)(B + SC_U + (16 * wv + m) * 144 + (16 * mt + 4 * q) * 2);
#define LDW4(dst, mt_) do { _Pragma("unroll") for (int kb = 0; kb < 4; ++kb) dst[kb] = ld128(B + SC_W + (16 * (mt_) + m) * 288 + (32 * kb + 8 * q) * 2); } while (0)
#define MMW2(src, mt_) do { _Pragma("unroll") for (int kb = 0; kb < 4; ++kb) { vn[0][mt_] = MFMA16(src[kb], Sb[0][kb], vn[0][mt_]); vn[1][mt_] = MFMA16(src[kb], Sb[1][kb], vn[1][mt_]); } } while (0)
#define LDK4(dst, dt_) do { dst[0] = ld128(B + SC_KT + (16 * (dt_) + m) * 160 + (8 * q) * 2); dst[1] = ld128(B + SC_KT + (16 * (dt_) + m) * 160 + (32 + 8 * q) * 2); \
                            dst[2] = ld128(B + SC_KT + (16 * ((dt_) + 1) + m) * 160 + (8 * q) * 2); dst[3] = ld128(B + SC_KT + (16 * ((dt_) + 1) + m) * 160 + (32 + 8 * q) * 2); } while (0)
#define MMK2(src, dt_) do { _Pragma("unroll") for (int e = 0; e < 2; ++e) { Sacc[e][dt_] = MFMA16(src[0], vnb[e][0], Sacc[e][dt_]); Sacc[e][dt_] = MFMA16(src[1], vnb[e][1], Sacc[e][dt_]); \
                            Sacc[e][(dt_) + 1] = MFMA16(src[2], vnb[e][0], Sacc[e][(dt_) + 1]); Sacc[e][(dt_) + 1] = MFMA16(src[3], vnb[e][1], Sacc[e][(dt_) + 1]); } } while (0)
                LDW4(fa, 0); SBAR_();
#pragma unroll
                for (int e = 0; e < 2; ++e)
#pragma unroll
                    for (int kb = 0; kb < 4; ++kb) Sb[e][kb] = pack8(Sacc[e][2 * kb], Sacc[e][2 * kb + 1]);
#pragma unroll
                for (int mt = 0; mt < 4; ++mt) { vn[0][mt] = (f32x4){bflo(ut[mt].x), bfhi(ut[mt].x), bflo(ut[mt].y), bfhi(ut[mt].y)}; vn[1][mt] = (f32x4){0.f, 0.f, 0.f, 0.f}; }
                const float gl = __builtin_bit_cast(float, __builtin_amdgcn_readlane(__builtin_bit_cast(int, glv), n0 + j));
                SBAR_(); LDW4(fb, 1); SBAR_(); MMW2(fa, 0); SBAR_();
                LDW4(fa, 2); SBAR_(); MMW2(fb, 1); SBAR_();
                LDW4(fb, 3); SBAR_(); MMW2(fa, 2); SBAR_();
                LDK4(fa, 0); SBAR_(); MMW2(fb, 3); SBAR_();
#pragma unroll
                for (int e = 0; e < 2; ++e) { vnb[e][0] = pack8(vn[e][0], vn[e][1]); vnb[e][1] = pack8(vn[e][2], vn[e][3]);
#pragma unroll
                    for (int dt = 0; dt < 8; ++dt) Sacc[e][dt] = Sacc[e][dt] * gl; }
                SBAR_(); LDK4(fb, 2); SBAR_(); MMK2(fa, 0); SBAR_();
                LDK4(fa, 4); SBAR_(); MMK2(fb, 2); SBAR_();
                LDK4(fb, 6); SBAR_(); MMK2(fa, 4); SBAR_();
                MMK2(fb, 6); SBAR_();
                WG_BAR();
            }
#undef LDW4
#undef MMW2
#undef LDK4
#undef MMK2
            float* psi = WSF(WS_PSI) + ((size_t)(bh * NSEG + seg) * 128) * 128;
            bf16* phi = WSH(WS_PHI) + ((size_t)(bh * NSEG + seg) * 128) * 128 + kperm(col);
#pragma unroll
            for (int dt = 0; dt < 8; ++dt) { *(f32x4*)(psi + ((size_t)(4 * dt + q) * 128 + col) * 4) = Sacc[0][dt];
#pragma unroll
                for (int r = 0; r < 4; ++r) { const int dk = 16 * dt + 4 * q + r; phi[(size_t)dk * 128] = (bf16)f2bf(Sacc[1][dt][r]); } }
        }
        __syncthreads();
    }
}

DI void p_scan2(Frame& F, int l) {
    const int wave = F.wave;
    for (int bh = blockIdx.x; bh < BATCH * GH; bh += gridDim.x) {
        int tc_ = F.tid; asm volatile("" : "+v"(tc_)); const int tid = tc_, lane = tc_ & 63, m = lane & 15, q = lane >> 4;
        const int col = 16 * wave + m;
        const int gof = (tid >> 4) * 256 + (tid & 15) * 16, lof = (tid >> 4) * 288 + (tid & 15) * 16;
        const unsigned char* phi0 = (const unsigned char*)(WSH(WS_PHI) + ((size_t)(bh * NSEG) * 128) * 128);
        const float* psi0 = WSF(WS_PSI) + ((size_t)(bh * NSEG) * 128) * 128 + (size_t)(q * 128 + col) * 4;
        float* sst0 = WSF(WS_SST) + ((size_t)(bh * NSEG) * 128) * 128 + (size_t)(q * 128 + col) * 4;
        f32x4 S[8], Ps[8]; v4u pr[4];
#pragma unroll
        for (int dt = 0; dt < 8; ++dt) { S[dt] = (f32x4){0.f, 0.f, 0.f, 0.f}; Ps[dt] = *(const f32x4*)(psi0 + dt * 2048); }
#pragma unroll
        for (int i = 0; i < 4; ++i) pr[i] = *(const v4u*)(phi0 + gof + i * 8192);
#pragma unroll
        for (int i = 0; i < 4; ++i) *(LAS v4u*)(F.lds + lof + i * (32 * 288)) = pr[i];
        __syncthreads();
#pragma unroll 1
        for (int seg = 0; seg + 1 < NSEG; ++seg) {
            if (seg > 0) {
#pragma unroll
                for (int dt = 0; dt < 8; ++dt) *(f32x4*)(sst0 + (size_t)seg * 16384 + dt * 2048) = S[dt]; }
            const int sn = seg + 2 < NSEG ? seg + 1 : seg;
#pragma unroll
            for (int i = 0; i < 4; ++i) pr[i] = *(const v4u*)(phi0 + (size_t)sn * 32768 + gof + i * 8192);
            f32x4 Pn[8];
#pragma unroll
            for (int dt = 0; dt < 8; ++dt) Pn[dt] = *(const f32x4*)(psi0 + (size_t)sn * 16384 + dt * 2048);
            const LAS unsigned char* B = F.lds + (seg & 1) * 36864;
            bf16x8 Sb[4];
#pragma unroll
            for (int kb = 0; kb < 4; ++kb) Sb[kb] = pack8(S[2 * kb], S[2 * kb + 1]);
#pragma unroll
            for (int dt = 0; dt < 8; ++dt) { f32x4 acc = Ps[dt];
#pragma unroll
                for (int kb = 0; kb < 4; ++kb) acc = MFMA16(ld128(B + (16 * dt + m) * 288 + (32 * kb + 8 * q) * 2), Sb[kb], acc);
                S[dt] = acc; }
#pragma unroll
            for (int dt = 0; dt < 8; ++dt) Ps[dt] = Pn[dt];
#pragma unroll
            for (int i = 0; i < 4; ++i) *(LAS v4u*)(F.lds + ((seg + 1) & 1) * 36864 + lof + i * (32 * 288)) = pr[i];
            __syncthreads();
        }
#pragma unroll
        for (int dt = 0; dt < 8; ++dt) *(f32x4*)(sst0 + (size_t)(NSEG - 1) * 16384 + dt * 2048) = S[dt];
        __syncthreads();
    }
}

DI void p_scan3(Frame& F, int l) {
    constexpr bool FULL = true;
    const int wave = F.wave;
    const bool is_loader = wave >= 4;
    const int wv = wave & 3;
    for (int job = F.vcu; job < BATCH * GH * NSEG * 2; job += F.G) {
        const int bh = job >> 4, seg = (job >> 1) & (NSEG - 1), dvbase = (job & 1) * 64, n0 = seg * SEGC, b = bh >> 2, h = bh & 3;
        const size_t it0 = (size_t)bh * NCH;
        SC_ADDR()
        if (is_loader) { SC_LOADER_LOOP(); }
        else {
            int tc_ = F.tid; asm volatile("" : "+v"(tc_)); const int lane = tc_ & 63, m = lane & 15, q = lane >> 4;
            f32x4 Sacc[8];
            if (seg == 0) {
#pragma unroll
                for (int dt = 0; dt < 8; ++dt) Sacc[dt] = (f32x4){0.f, 0.f, 0.f, 0.f};
            } else { const float* sst = WSF(WS_SST) + ((size_t)(bh * NSEG + seg) * 128) * 128 + (size_t)(q * 128 + dvbase + 16 * wv + m) * 4;
#pragma unroll
                for (int dt = 0; dt < 8; ++dt) Sacc[dt] = *(const f32x4*)(sst + dt * 2048); }
            const float glv = WSF(WS_GL)[it0 + lane];
            __syncthreads();
#define FR_W(dst, mt_) do { _Pragma("unroll") for (int kb = 0; kb < 4; ++kb) { dst[kb] = ld128(B + SC_W + (16 * (mt_) + m) * 288 + (32 * kb + 8 * q) * 2); dst[4 + kb] = ld128(B + SC_QD + (16 * (mt_) + m) * 288 + (32 * kb + 8 * q) * 2); } } while (0)
#define MM_W(src, mt_) do { _Pragma("unroll") for (int kb = 0; kb < 4; ++kb) { vn[mt_] = MFMA16(src[kb], Sb[kb], vn[mt_]); o[mt_] = MFMA16(Sb[kb], src[4 + kb], o[mt_]); } } while (0)
#define FR_KT(dst, hf_) do { _Pragma("unroll") for (int i = 0; i < 8; ++i) dst[i] = ld128(B + SC_KT + (16 * (4 * (hf_) + (i >> 1)) + m) * 160 + (32 * (i & 1) + 8 * q) * 2); } while (0)
#define MM_KT(src, hf_) do { _Pragma("unroll") for (int i = 0; i < 8; ++i) Sacc[4 * (hf_) + (i >> 1)] = MFMA16(src[i], vnb[i & 1], Sacc[4 * (hf_) + (i >> 1)]); } while (0)
#pragma unroll 1
            for (int j = 0; j < SEGC; ++j) {
                const int n = n0 + j;
                const LAS unsigned char* B = F.lds + (j & 1) * SC_STAGE;
                bf16x8 fa[8], fb[8], Sb[4], vnb[2];
                f32x4 vn[4], o[4];
                v2u ut[4];
#pragma unroll
                for (int mt = 0; mt < 4; ++mt) ut[mt] = *(const LAS v2u*)(B + SC_U + (16 * wv + m) * 144 + (16 * mt + 4 * q) * 2);
                FR_W(fa, 0); SBAR_();
#pragma unroll
                for (int kb = 0; kb < 4; ++kb) Sb[kb] = pack8(Sacc[2 * kb], Sacc[2 * kb + 1]);
#pragma unroll
                for (int mt = 0; mt < 4; ++mt) { o[mt] = (f32x4){0.f, 0.f, 0.f, 0.f}; vn[mt] = (f32x4){bflo(ut[mt].x), bfhi(ut[mt].x), bflo(ut[mt].y), bfhi(ut[mt].y)}; }
                const float gl = __builtin_bit_cast(float, __builtin_amdgcn_readlane(__builtin_bit_cast(int, glv), n));
                SBAR_(); FR_W(fb, 1); SBAR_(); MM_W(fa, 0); SBAR_();
                FR_W(fa, 2); SBAR_(); MM_W(fb, 1); SBAR_();
                FR_W(fb, 3); SBAR_(); MM_W(fa, 2); SBAR_();
                fa[0] = ld128(B + SC_AT + (m) * 160 + (8 * q) * 2); fa[1] = ld128(B + SC_AT + (16 + m) * 160 + (8 * q) * 2);
                fa[2] = ld128(B + SC_AT + (32 + m) * 160 + (8 * q) * 2); fa[3] = ld128(B + SC_AT + (32 + m) * 160 + (32 + 8 * q) * 2);
                fa[4] = ld128(B + SC_AT + (48 + m) * 160 + (8 * q) * 2); fa[5] = ld128(B + SC_AT + (48 + m) * 160 + (32 + 8 * q) * 2);
                SBAR_(); MM_W(fb, 3); SBAR_();
                vnb[0] = pack8(vn[0], vn[1]); vnb[1] = pack8(vn[2], vn[3]);
#pragma unroll
                for (int dt = 0; dt < 8; ++dt) Sacc[dt] = Sacc[dt] * gl;
                SBAR_(); FR_KT(fb, 0); SBAR_();
                o[0] = MFMA16(vnb[0], fa[0], o[0]); o[1] = MFMA16(vnb[0], fa[1], o[1]); o[2] = MFMA16(vnb[0], fa[2], o[2]); o[3] = MFMA16(vnb[0], fa[4], o[3]);
                o[2] = MFMA16(vnb[1], fa[3], o[2]); o[3] = MFMA16(vnb[1], fa[5], o[3]);
                SBAR_(); FR_KT(fa, 1); SBAR_(); MM_KT(fb, 0); SBAR_();
                MM_KT(fa, 1); SBAR_();
                _Float16* go = (_Float16*)(F.A->ws + WS_GO) + (size_t)(b * SEQ + n * CH + m) * GO_LD + h * HD + dvbase + 16 * wv + 4 * q;
#pragma unroll
                for (int mt = 0; mt < 4; ++mt) { h16x4 hv; hv[0] = (_Float16)o[mt][0]; hv[1] = (_Float16)o[mt][1]; hv[2] = (_Float16)o[mt][2]; hv[3] = (_Float16)o[mt][3]; *(h16x4*)(go + (size_t)(16 * mt) * GO_LD) = hv; }
                WG_BAR();
            }
#undef FR_W
#undef MM_W
#undef FR_KT
#undef MM_KT
        }
        __syncthreads();
    }
}
#undef SC_ADDR
#undef SC_LOAD
#undef SC_WRITE
#undef SC_LOADER_LOOP

DI float gelu_fast(float x) { const float u2 = 1.5957691216057308f * (x + 0.044715f * x * x * x); return x * rcp_(1.f + exp_fast(-u2)); }
struct PostRow { v4u hp[2]; v2u y2[2], z2[2]; h16x4 go[2]; f32x4 cr[2]; };
DI void post_load(Frame& F, PostRow& R, int m, int lane) {
    const int b = m >> 12, n = (m & (SEQ - 1)) >> 6;
#pragma unroll
    for (int j = 0; j < 2; ++j) { const int c = 4 * lane + 256 * j;
        R.hp[j] = *(const v4u*)((const unsigned*)(F.A->ws + WS_H) + (size_t)m * LRUW + c);
        R.cr[j] = *(const f32x4*)(WSF(WS_CARRY) + ((size_t)(b * NCH + n)) * LRUW + c);
        R.y2[j] = *(const v2u*)(WSH(WS_PROJ) + (size_t)m * PROJ_LD + O_LY + c);
        R.go[j] = *(const h16x4*)((const _Float16*)(F.A->ws + WS_GO) + (size_t)m * GO_LD + c);
        R.z2[j] = *(const v2u*)(WSH(WS_PROJ) + (size_t)m * PROJ_LD + O_Z + c); }
}
DI void p_post(Frame& F, int l, bool loc) {
    const int lane = F.lane;
    const int r0 = 256 * (8 * (int)(blockIdx.x & 7) + (int)((blockIdx.x >> 3) & 7)) + 64 * (int)(blockIdx.x >> 6);
    const int gw = loc ? r0 + F.wave : F.vcu * NWAVES + F.wave, NGW = loc ? NWAVES : F.G * NWAVES, mend = loc ? r0 + 64 : M;
    PostRow R;
    if (gw < mend) post_load(F, R, gw, lane);
    for (int m = gw; m < mend; m += NGW) {
        PostRow Rn; const int mn = m + NGW;
        post_load(F, Rn, mn < mend ? mn : m, lane);
        f32x4 val[2]; float ss = 0.f;
#pragma unroll
        for (int j = 0; j < 2; ++j) { const v4u hp = R.hp[j]; const v2u y2 = R.y2[j];
            const f32x4 hl = (f32x4){bflo(hp.x), bflo(hp.y), bflo(hp.z), bflo(hp.w)}, p = (f32x4){bfhi(hp.x), bfhi(hp.y), bfhi(hp.z), bfhi(hp.w)};
            const f32x4 hh = hl + p * R.cr[j];
            val[j] = (f32x4){hh.x * gelu_fast(bflo(y2.x)), hh.y * gelu_fast(bfhi(y2.x)), hh.z * gelu_fast(bflo(y2.y)), hh.w * gelu_fast(bfhi(y2.y))};
            ss += (val[j].x * val[j].x + val[j].y * val[j].y) + (val[j].z * val[j].z + val[j].w * val[j].w); }
        ss = wave_sum_(lane, ss);
        const float rl = 1.0f / sqrtf(ss * (1.0f / LRUW) + EPS);
#pragma unroll
        for (int j = 0; j < 2; ++j) { const int c = 4 * lane + 256 * j; const f32x4 nw = *(const f32x4*)(LRU_NORM_W + (size_t)l * LRUW + c);
            const f32x4 o = val[j] * rl * nw; v2u w; w.x = pk2(o.x, o.y); w.y = pk2(o.z, o.w); *(v2u*)(WSH(WS_MIX) + (size_t)m * D + c) = w; }
#pragma unroll
        for (int j = 0; j < 2; ++j) { const int c = 4 * lane + 256 * j, d = c & (HD - 1);
            const f32x4 o = (f32x4){(float)R.go[j][0], (float)R.go[j][1], (float)R.go[j][2], (float)R.go[j][3]}; const v2u z2 = R.z2[j];
            const float s2 = half_sum_(lane, (o.x * o.x + o.y * o.y) + (o.z * o.z + o.w * o.w));
            const float rg = 1.0f / sqrtf(s2 * (1.0f / HD) + EPS);
            const f32x4 nw = *(const f32x4*)(GDN_NORM_W + (size_t)l * HD + d);
            const f32x4 r = (f32x4){o.x * rg * nw.x * silu_fast(bflo(z2.x)), o.y * rg * nw.y * silu_fast(bfhi(z2.x)), o.z * rg * nw.z * silu_fast(bflo(z2.y)), o.w * rg * nw.w * silu_fast(bfhi(z2.y))};
            v2u w; w.x = pk2(r.x, r.y); w.y = pk2(r.z, r.w); *(v2u*)(WSH(WS_MIX) + (size_t)m * D + LRUW + c) = w; }
        R = Rn;
    }
}

DI void p_final(Frame& F) {
    const int gw = F.vcu * NWAVES + F.wave, NGW = F.G * NWAVES, lane = F.lane;
    const _Float16* xb = (const _Float16*)(F.A->ws + WS_H) + 4 * lane;
    h16x4 c0[4], c1[4];
    f32x4 nw[4];
#pragma unroll
    for (int j = 0; j < 4; ++j) { nw[j] = *(const f32x4*)(FINAL_NORM_W + 4 * lane + 256 * j);
        c0[j] = *(const h16x4*)(xb + (size_t)(gw < M ? gw : 0) * D + 256 * j); c1[j] = *(const h16x4*)(xb + (size_t)(gw + NGW < M ? gw + NGW : 0) * D + 256 * j); }
    for (int m = gw; m < M; m += NGW) {
        h16x4 c2[4]; const int mn = m + 2 * NGW < M ? m + 2 * NGW : m;
#pragma unroll
        for (int j = 0; j < 4; ++j) c2[j] = *(const h16x4*)(xb + (size_t)mn * D + 256 * j);
        f32x4 v[4]; float ss = 0.f;
#pragma unroll
        for (int j = 0; j < 4; ++j) { v[j] = (f32x4){(float)c0[j][0], (float)c0[j][1], (float)c0[j][2], (float)c0[j][3]};
            ss += (v[j].x * v[j].x + v[j].y * v[j].y) + (v[j].z * v[j].z + v[j].w * v[j].w); }
        ss = wave_sum_(lane, ss);
        const float rstd = 1.0f / sqrtf(ss * (1.0f / D) + EPS);
#pragma unroll
        for (int j = 0; j < 4; ++j) *(f32x4*)(OUT_ + (size_t)m * D + 4 * lane + 256 * j) = v[j] * rstd * nw[j];
#pragma unroll
        for (int j = 0; j < 4; ++j) { c0[j] = c1[j]; c1[j] = c2[j]; }
    }
}

__device__ __forceinline__ void pg8::EpiMulti::operator()(const f32x4 (&acc)[2][2][4][2], const Unit& u, int wr, int wc, int fr, int fq, int ui) const {
    const PG8_LAS float* rtab = ui < 4 ? rt + ui * 256 : nullptr;
    const __attribute__((address_space(4))) Args* ap = (const __attribute__((address_space(4))) Args*)__builtin_amdgcn_kernarg_segment_ptr(); asm volatile("" : "+s"(ap));
    unsigned char* ws = ap->ws;
    const int b = (u.pm * BM) / SEQ;
    if (mode == 0) { EpiBf16<0> e{(bf16_t*)(ws + WS_PROJ), PROJ_LD, nullptr, 0, 0, 1.f, nullptr, nullptr}; e(acc, u, wr, wc, fr, fq); }
    else if (mode == 5) { EpiBf16<0> e{(bf16_t*)(ws + WS_PROJ), PROJ_LD, (const float*)(ws + WS_C1) + ((size_t)l * BATCH + b) * NPROJ, 0, 0, 1.f, rtab, (const float*)(ws + WS_RS1)}; e(acc, u, wr, wc, fr, fq); }
    else if (mode == 6) { EpiBf16<2> e{(bf16_t*)(ws + WS_ACT), FF, (const float*)(ws + WS_C2) + ((size_t)l * BATCH + b) * FF, 0, 0, 1.f, rtab, (const float*)(ws + WS_RS2)}; e(acc, u, wr, wc, fr, fq); }
    else if (mode == 3) { const float* modb = (const float*)(ws + WS_MOD) + ((size_t)l * BATCH + b) * NMODC; _Float16* x16 = (_Float16*)((unsigned char*)ap->out + X16_OFF);
        EpiResid2 r{ap->in[0], l == 0 ? nullptr : x16, x16, modb + 2 * D, ap->in[3] + (size_t)l * D, modb + 4 * D, (bf16_t*)(ws + WS_H), (float*)(ws + WS_RS2)}; r(acc, u, wr, wc, fr, fq); }
    else { const float* modb = (const float*)(ws + WS_MOD) + ((size_t)l * BATCH + b) * NMODC; const bool nx = l + 1 < DEPTH; _Float16* x16 = (_Float16*)((unsigned char*)ap->out + X16_OFF);
        EpiResid2 r{nullptr, x16, nx ? x16 : (_Float16*)(ws + WS_H), modb + 5 * D, nx ? ap->in[2] + (size_t)(l + 1) * D : nullptr, modb + NMODC * BATCH + D, (bf16_t*)(ws + WS_A1), (float*)(ws + WS_RS1)}; r(acc, u, wr, wc, fr, fq); }
}

__global__ void __launch_bounds__(NWAVES * 64, 2) mk_fwd(Args args) {
    extern __shared__ __attribute__((aligned(16))) unsigned char lds[];
    Frame F;
    F.lds = (LAS unsigned char*)lds;
    F.MISC = (volatile LAS unsigned*)(F.lds + MISC_OFF);
    F.tid = threadIdx.x; F.lane = F.tid & 63; F.wave = __builtin_amdgcn_readfirstlane(F.tid >> 6);
    F.G = gridDim.x; { const int bx = blockIdx.x; F.vcu = (F.G % 8 == 0) ? (bx % 8) * (F.G / 8) + bx / 8 : bx; }
    F.A = (const __attribute__((address_space(4))) Args*)__builtin_amdgcn_kernarg_segment_ptr();
    F.ctl = (gu32*)(F.A->ws + WS_CTL);
    for (int u = F.tid; u < (LDS_BYTES - LDSCTL_OFF) / 4; u += NWAVES * 64) ((LAS unsigned*)(F.lds + LDSCTL_OFF))[u] = 0u;
    __syncthreads();
    XcdBarrier bar; bar.bar = (unsigned*)(F.ctl + CW_BAR); bar.x = 0; bar.st = nullptr;
    if (N_LAUNCHES == 1) bar = xcd_barrier_post((unsigned*)(F.ctl + CW_BAR), F.MISC + 8);
    if (N_LAUNCHES == 1 && F.tid == 0) __hip_atomic_store((unsigned*)F.ctl + GB_XCC(blockIdx.x), bar.x + 1u, RLX_AGENT);

    const int lo = F.A->ph_lo, hi = F.A->ph_hi;
    int rep_done = 0;
#pragma unroll 1
    for (int s = lo; s < hi; ++s) {
        { const __attribute__((address_space(4))) Args* ap = (const __attribute__((address_space(4))) Args*)__builtin_amdgcn_kernarg_segment_ptr(); asm volatile("" : "+s"(ap)); F.A = ap; }
        { int t_ = threadIdx.x; asm volatile("" : "+v"(t_)); F.tid = t_; F.lane = t_ & 63; F.wave = __builtin_amdgcn_readfirstlane(t_ >> 6); }
        if (s == 0) { if (PH_MASK & 1) { p_mod(F); __syncthreads(); p0_weights(F); xcd_barrier(bar, F.tid == 0);
            {
                int ok_ = 1; const int G_ = (int)gridDim.x;
                for (int bb = F.tid; bb < G_; bb += NWAVES * 64) { const unsigned v_ = xb_ld((unsigned*)F.ctl + GB_XCC(bb)), r_ = xb_ld((unsigned*)F.ctl + GB_XCC(bb & 7)); ok_ &= (v_ != 0u && v_ == r_); }
                if (!ok_) F.MISC[11] = 1u;
                __syncthreads();
                if (F.tid == 0) F.MISC[10] = (N_LAUNCHES == 1 && F.MISC[11] == 0u && (G_ & 7) == 0 && G_ >= 8 && ((G_ >> 3) & ((G_ >> 3) - 1)) == 0) ? 1u : 0u; }
            p_normmod<false>(F, 0, X_IN, NORM_MIX_W, 0, D); } }
        else if (s == N_STEPS - 1) { if (PH_MASK & 2) { p_final(F); } }
        else {
            const int l = (s - 1) / 9, i = (s - 1) % 9;
            if (i == 0 || i == 6) continue;
            bf16* wl = WSH(WS_W) + (size_t)l * LAYER_W;
            const float* modl = WSF(WS_MOD) + (size_t)l * BATCH * NMODC;
            if (!((PH_MASK >> (2 + i)) & 1)) {}
            else if (i == 0) { p_normmod<true>(F, l, l == 0 ? X_IN : OUT_, NORM_MIX_W, 0, D); }
            else if (i == 2) { p_prep(F, l); }
            else if (i == 3) {
                p_scan1(F, l); xcd_barrier(bar, F.tid == 0);
#if defined(SCAN_REP) && SCAN_REP == 1
                p_scan1(F, l); xcd_barrier(bar, F.tid == 0);
#endif
                p_scan2(F, l); p_cvec(F, l, l + 1); xcd_barrier(bar, F.tid == 0);
#if defined(SCAN_REP) && SCAN_REP == 2
                p_scan2(F, l); xcd_barrier(bar, F.tid == 0);
#endif
                p_scan3(F, l);
#if defined(SCAN_REP) && SCAN_REP == 3
                xcd_barrier(bar, F.tid == 0); p_scan3(F, l);
#endif
            }
            else if (i == 4) { p_post(F, l, F.MISC[10] != 0u && (int)gridDim.x == 256); }
            else if (i == 6) { p_normmod<false>(F, l, OUT_, NORM_MLP_W, 3 * D, 4 * D); }
            else {
                pg8::Gemm g; pg8::EpiMulti E; E.l = l; E.rt = (const LAS float*)(F.lds + RSTAB_OFF);
#ifndef PSTAG_SLEEP
#define PSTAG_SLEEP 0
#endif
                if (PSTAG_SLEEP > 0 && F.MISC[10] != 0u && (int)gridDim.x == 256 && (i == 5 || (i == 1 && l == 0))) {
                    for (int k_ = (int)((blockIdx.x >> 3) & 7); k_ > 0; --k_) __builtin_amdgcn_s_sleep(PSTAG_SLEEP); }
                if (i == 1) { g = pg8::Gemm{l == 0 ? WSH(WS_H) : WSH(WS_A1), wl, M, NPROJ, D}; E.PERM = true; E.mode = (l == 0 ? 0 : 5); }
                else if (i == 5) { g = pg8::Gemm{WSH(WS_MIX), wl + W_OUT_OFF, M, D, D}; E.PERM = true; E.mode = 3; }
                else if (i == 7) { g = pg8::Gemm{WSH(WS_H), wl + W_UP_OFF, M, FF, D}; E.PERM = true; E.mode = 6; }
                else { g = pg8::Gemm{WSH(WS_ACT), wl + W_DOWN_OFF, M, D, FF}; E.PERM = true; E.mode = 4; }
                pg8::StaticOrder S; S.init(g.M, g.N, F.G, (int)blockIdx.x);
                if (E.mode == 5 || E.mode == 6) {
                    LAS float* tab = (LAS float*)(F.lds + RSTAB_OFF); const float* rsp = WSF(E.mode == 5 ? WS_RS1 : WS_RS2);
                    const int slot = F.tid >> 7; pg8::Unit uu;
                    if (S.next(slot, uu)) for (int rr = F.tid & 127; rr < 256; rr += 128) { const f32x4* rp = (const f32x4*)(rsp + (size_t)(uu.pm * 256 + rr) * 16);
                        const f32x4 p0 = rp[0], p1 = rp[1], p2 = rp[2], p3 = rp[3], ts = (p0 + p1) + (p2 + p3);
                        tab[slot * 256 + rr] = 1.0f / sqrtf(((ts[0] + ts[1]) + (ts[2] + ts[3])) * (1.0f / D) + EPS); }
                    __syncthreads(); }
                pg8::gemm_phase<pg8::EpiMulti, pg8::StaticOrder, PG8_ALIGN, PG8_SP2>(F.lds + RING_OFF, g, S, E);
            }
        }
        if (REP_MASK != 0 && ((s >= 1 && s < N_STEPS - 1 && ((REP_MASK >> ((s - 1) % 9)) & 1)) || (s == 0 && (REP_MASK & 0x10000))) && !rep_done) { rep_done = 1; --s; xcd_barrier(bar, F.tid == 0); continue; }
        rep_done = 0;
        if (s + 1 < hi) {
            const int i_ = (s >= 1 && s < N_STEPS - 1) ? (s - 1) % 9 : -1;
            if ((i_ == 4 || i_ == 5 || i_ == 7 || (i_ == 8 && (s - 1) / 9 + 1 < DEPTH)) && F.MISC[10] != 0u && (int)gridDim.x == 256)
                grp_barrier((unsigned*)F.ctl, (unsigned*)(F.ctl + CW_BAR), F.tid == 0, (blockIdx.x & 7u) * 8u + ((blockIdx.x >> 3) & 7u), 2u);
            else xcd_barrier(bar, F.tid == 0); }
#ifdef PROBE_XBAR
        if (s >= 1 && s < N_STEPS - 1) { xcd_barrier(bar, F.tid == 0); xcd_barrier(bar, F.tid == 0); }
#endif
    }
}

extern "C" void kernel_launch(void* const* d_in, const int* in_sizes, int n_in, void* d_out, int out_size, void* d_ws, size_t ws_size, hipStream_t stream) {
    static int grid = 0;
    if (grid == 0) {
        if (n_in != 23 || in_sizes[0] != M * D || out_size != M * D || ws_size < WS_END) { fprintf(stderr, "kernel_launch: unexpected shapes (n_in %d, in0 %d, out %d, ws %zu); nothing launched\n", n_in, n_in > 0 ? in_sizes[0] : -1, out_size, ws_size); grid = -1; return; }
        int dev = 0, cus = 0;
        if (hipGetDevice(&dev) != hipSuccess || hipDeviceGetAttribute(&cus, hipDeviceAttributeMultiprocessorCount, dev) != hipSuccess) { grid = -1; return; }
        if (hipFuncSetAttribute((const void*)mk_fwd, hipFuncAttributeMaxDynamicSharedMemorySize, LDS_BYTES) != hipSuccess) { fprintf(stderr, "kernel_launch: hipFuncSetAttribute failed\n"); grid = -1; return; }
        (void)hipGetLastError();
        grid = cus;
    }
    if (grid < 0) return;
    if (hipMemsetAsync((char*)d_ws + WS_CTL, 0, CTL_ZERO_BYTES, stream) != hipSuccess) return;
    Args a{};
    for (int i = 0; i < 23; ++i) a.in[i] = (const float*)d_in[i];
    a.out = (float*)d_out; a.ws = (unsigned char*)d_ws;
    if (N_LAUNCHES == 1) { a.ph_lo = 0; a.ph_hi = N_STEPS; hipLaunchKernelGGL(mk_fwd, dim3(grid), dim3(NWAVES * 64), LDS_BYTES, stream, a); }
    else for (int s = 0; s < N_STEPS; ++s) { a.ph_lo = s; a.ph_hi = s + 1; hipLaunchKernelGGL(mk_fwd, dim3(grid), dim3(NWAVES * 64), LDS_BYTES, stream, a); }
}
```
